# Optimizing an MI355X kernel written in HIP

```python
import math
import jax, jax.numpy as jnp
from jax import lax
import numpy as np

D_MODEL = 1024
BATCH = 8
SEQ = 4096
DEPTH = 1

EPS = 1e-6
MEM_LEN = 256
RET_HEADS = 4
RET_DK = 128
RET_DV = 128
RET_QK_WIDTH = RET_HEADS * RET_DK
RET_V_WIDTH = RET_HEADS * RET_DV
RET_CHUNK = 128
ROPE_BASE = 10000.0
S5_GROUPS = 16
S5_GROUP_DIM = 16
S5_STATE = 64
S5_WIDTH = S5_GROUPS * S5_GROUP_DIM
S5_DT_MIN = 0.001
S5_DT_MAX = 0.1
MEM_HEADS = 4
MEM_HEAD_DIM = 64
MEM_WIDTH = MEM_HEADS * MEM_HEAD_DIM
N_BRANCHES = 3
IN_SPLITS = (RET_QK_WIDTH, RET_QK_WIDTH, RET_V_WIDTH, RET_V_WIDTH, S5_WIDTH, MEM_WIDTH, N_BRANCHES * D_MODEL)
IN_COLS = sum(IN_SPLITS)
PEER_HEADS = 8
PEER_NKEYS = 128
PEER_EXPERTS = PEER_NKEYS * PEER_NKEYS
PEER_QDIM = 256
PEER_HALF = PEER_QDIM // 2
PEER_TOPK = 16
PEER_BLOCK = 128

kernel_name = "hybrid_retention_s5_memattn_peer_block"


def _rms_norm(x, gain):
    xf = x.astype(jnp.float32)
    y = xf * lax.rsqrt(jnp.mean(xf * xf, axis=-1, keepdims=True) + EPS)
    return (y * gain.astype(jnp.float32)).astype(x.dtype)


def _rope(x, positions):
    half = x.shape[-1] // 2
    inv_freq = ROPE_BASE ** (-jnp.arange(half, dtype=jnp.float32) / half)
    ang = positions.astype(jnp.float32)[..., None] * inv_freq
    cos = jnp.cos(ang)[:, :, None, :]
    sin = jnp.sin(ang)[:, :, None, :]
    xf = x.astype(jnp.float32)
    x1, x2 = xf[..., :half], xf[..., half:]
    return jnp.concatenate([x1 * cos - x2 * sin, x1 * sin + x2 * cos], axis=-1)


def _retention(q, k, v):
    bsz, seq, nh, dk = q.shape
    dv = v.shape[-1]
    c = RET_CHUNK
    nc = seq // c
    log_gamma = jnp.log1p(-jnp.exp2(-5.0 - jnp.arange(nh, dtype=jnp.float32)))
    pos = jnp.arange(c, dtype=jnp.float32)
    rel = pos[:, None] - pos[None, :]
    decay_intra = jnp.exp(jnp.where((rel >= 0)[None], rel[None] * log_gamma[:, None, None], -jnp.inf))
    q = q.reshape(bsz, nc, c, nh, dk)
    k = k.reshape(bsz, nc, c, nh, dk)
    v = v.reshape(bsz, nc, c, nh, dv)
    scores = jnp.einsum("bnihd,bnjhd->bnhij", q, k) * decay_intra
    inner = jnp.einsum("bnhij,bnjhe->bnihe", scores, v)
    k_dec = k * jnp.exp((c - 1.0 - pos)[:, None] * log_gamma[None, :])[:, :, None]
    kv = jnp.einsum("bnjhd,bnjhe->nbhde", k_dec, v)
    chunk_decay = jnp.exp(c * log_gamma)[None, :, None, None]

    def step(state, kv_n):
        return state * chunk_decay + kv_n, state

    _, prev = lax.scan(step, jnp.zeros((bsz, nh, dk, dv), jnp.float32), kv)
    q_dec = q * jnp.exp((pos + 1.0)[:, None] * log_gamma[None, :])[:, :, None]
    cross = jnp.einsum("bnihd,nbhde->bnihe", q_dec, prev)
    return (inner + cross).reshape(bsz, seq, nh, dv)


def _complex_linear_op(e1, e2):
    ar1, ai1, br1, bi1 = e1
    ar2, ai2, br2, bi2 = e2
    return (ar2 * ar1 - ai2 * ai1,
            ar2 * ai1 + ai2 * ar1,
            ar2 * br1 - ai2 * bi1 + br2,
            ar2 * bi1 + ai2 * br1 + bi2)


def _s5(u, a_re, a_im, log_dt, b_re, b_im, c_re, c_im, d, w_glu):
    bsz, seq, _ = u.shape
    f32 = jnp.float32
    uf = u.astype(f32).reshape(bsz, seq, S5_GROUPS, S5_GROUP_DIM)
    a_re = a_re.astype(f32)
    a_im = a_im.astype(f32)
    dt = jnp.exp(log_dt.astype(f32))[:, None]
    mag = jnp.exp(a_re * dt)
    lam_re = mag * jnp.cos(a_im * dt)
    lam_im = mag * jnp.sin(a_im * dt)
    den = a_re * a_re + a_im * a_im
    nr = lam_re - 1.0
    ni = lam_im
    cr = ((nr * a_re + ni * a_im) / den)[..., None]
    ci = ((ni * a_re - nr * a_im) / den)[..., None]
    b_re = b_re.astype(f32)
    b_im = b_im.astype(f32)
    bb_re = cr * b_re - ci * b_im
    bb_im = cr * b_im + ci * b_re
    bu_re = jnp.einsum("bsgh,gph->bsgp", uf, bb_re)
    bu_im = jnp.einsum("bsgh,gph->bsgp", uf, bb_im)
    la_re = jnp.broadcast_to(lam_re, bu_re.shape)
    la_im = jnp.broadcast_to(lam_im, bu_im.shape)
    _, _, x_re, x_im = lax.associative_scan(_complex_linear_op, (la_re, la_im, bu_re, bu_im), axis=1)
    y = (jnp.einsum("bsgp,ghp->bsgh", x_re, c_re.astype(f32))
         - jnp.einsum("bsgp,ghp->bsgh", x_im, c_im.astype(f32)))
    y = y.reshape(bsz, seq, S5_WIDTH) + d.astype(f32) * u.astype(f32)
    y = jax.nn.gelu(y)
    lin, gate = jnp.split(y @ w_glu.astype(f32), 2, axis=-1)
    return lin * jax.nn.sigmoid(gate)


def _memory_attention(q, k, v):
    bsz, seq = q.shape[0], q.shape[1]
    scores = jnp.einsum("bshd,bmhd->bhsm", q.astype(jnp.float32), k.astype(jnp.float32)) * (MEM_HEAD_DIM ** -0.5)
    p = jax.nn.softmax(scores, axis=-1)
    out = jnp.einsum("bhsm,bmhd->bshd", p, v.astype(jnp.float32))
    return out.reshape(bsz, seq, MEM_WIDTH)


def _peer(xn, w_q, keys, u_exp, v_exp):
    bsz, seq, dm = xn.shape
    t = bsz * seq
    xt = xn.reshape(t, dm)
    q = (xt @ w_q).reshape(t, PEER_HEADS, 2, PEER_HALF)
    s = jnp.einsum("thcd,hcnd->thcn", q, keys).astype(jnp.float32)
    s_top, i_top = lax.top_k(s, PEER_TOPK)
    cand_s = (s_top[:, :, 0, :, None] + s_top[:, :, 1, None, :]).reshape(t, PEER_HEADS, PEER_TOPK * PEER_TOPK)
    cand_i = (i_top[:, :, 0, :, None] * PEER_NKEYS + i_top[:, :, 1, None, :]).reshape(t, PEER_HEADS, PEER_TOPK * PEER_TOPK)
    s_fin, sel = lax.top_k(cand_s, PEER_TOPK)
    idx = jnp.take_along_axis(cand_i, sel, axis=-1)
    w = jax.nn.softmax(s_fin, axis=-1)
    nb = t // PEER_BLOCK

    def expert_block(args):
        xb, ib, wb = args
        ug = jnp.take(u_exp, ib, axis=0)
        vg = jnp.take(v_exp, ib, axis=0)
        hid = jnp.einsum("td,thkd->thk", xb, ug).astype(jnp.float32)
        act = jax.nn.gelu(hid) * wb
        return jnp.einsum("thk,thkd->td", act, vg.astype(jnp.float32))

    out = lax.map(expert_block, (xt.reshape(nb, PEER_BLOCK, dm),
                                 idx.reshape(nb, PEER_BLOCK, PEER_HEADS, PEER_TOPK),
                                 w.reshape(nb, PEER_BLOCK, PEER_HEADS, PEER_TOPK)))
    return out.reshape(bsz, seq, dm)


def setup_inputs(seed: int = 0) -> dict:
    key = jax.random.key(seed)
    ks = jax.random.split(key, 32)
    f32 = jnp.float32

    def nrm(k, shape, scale):
        return jax.random.normal(k, shape, f32) * scale

    def gain(k, shape):
        return 1.0 + 0.01 * jax.random.normal(k, shape, f32)

    x = nrm(ks[0], (BATCH, SEQ, D_MODEL), 1.0)
    mem = nrm(ks[1], (BATCH, MEM_LEN, D_MODEL), 1.0)
    positions = jnp.arange(SEQ, dtype=jnp.int32)[None, :] + jax.random.randint(ks[2], (BATCH, 1), 0, SEQ, dtype=jnp.int32)
    norm_mix = gain(ks[3], (DEPTH, D_MODEL))
    w_in = nrm(ks[4], (DEPTH, D_MODEL, IN_COLS), D_MODEL ** -0.5)
    norm_mem = gain(ks[5], (DEPTH, D_MODEL))
    w_mem_kv = nrm(ks[6], (DEPTH, D_MODEL, 2 * MEM_WIDTH), D_MODEL ** -0.5)
    s5_a_re = -0.5 + 0.01 * jax.random.normal(ks[7], (DEPTH, S5_GROUPS, S5_STATE), f32)
    s5_a_im = math.pi * jnp.arange(S5_STATE, dtype=f32) + 0.01 * jax.random.normal(ks[8], (DEPTH, S5_GROUPS, S5_STATE), f32)
    s5_log_dt = jax.random.uniform(ks[9], (DEPTH, S5_GROUPS), f32, minval=math.log(S5_DT_MIN), maxval=math.log(S5_DT_MAX))
    s5_b_re = nrm(ks[10], (DEPTH, S5_GROUPS, S5_STATE, S5_GROUP_DIM), (2 * S5_GROUP_DIM) ** -0.5)
    s5_b_im = nrm(ks[11], (DEPTH, S5_GROUPS, S5_STATE, S5_GROUP_DIM), (2 * S5_GROUP_DIM) ** -0.5)
    s5_c_re = nrm(ks[12], (DEPTH, S5_GROUPS, S5_GROUP_DIM, S5_STATE), S5_STATE ** -0.5)
    s5_c_im = nrm(ks[13], (DEPTH, S5_GROUPS, S5_GROUP_DIM, S5_STATE), S5_STATE ** -0.5)
    s5_d = nrm(ks[14], (DEPTH, S5_WIDTH), 1.0)
    s5_w_glu = nrm(ks[15], (DEPTH, S5_WIDTH, 2 * S5_WIDTH), S5_WIDTH ** -0.5)
    w_branch_ret = nrm(ks[16], (DEPTH, RET_V_WIDTH, D_MODEL), RET_V_WIDTH ** -0.5)
    w_branch_s5 = nrm(ks[17], (DEPTH, S5_WIDTH, D_MODEL), S5_WIDTH ** -0.5)
    w_branch_mem = nrm(ks[18], (DEPTH, MEM_WIDTH, D_MODEL), MEM_WIDTH ** -0.5)
    w_out = nrm(ks[19], (DEPTH, D_MODEL, D_MODEL), D_MODEL ** -0.5)
    norm_ffn = gain(ks[20], (DEPTH, D_MODEL))
    peer_w_q = nrm(ks[21], (DEPTH, D_MODEL, PEER_HEADS * PEER_QDIM), D_MODEL ** -0.5)
    peer_keys = nrm(ks[22], (DEPTH, PEER_HEADS, 2, PEER_NKEYS, PEER_HALF), PEER_HALF ** -0.5)
    peer_u = nrm(ks[23], (DEPTH, PEER_EXPERTS, D_MODEL), D_MODEL ** -0.5)
    peer_v = nrm(ks[24], (DEPTH, PEER_EXPERTS, D_MODEL), PEER_HEADS ** -0.5)
    norm_final = gain(ks[25], (D_MODEL,))
    return {"x": x, "mem": mem, "positions": positions, "norm_mix": norm_mix, "w_in": w_in,
            "norm_mem": norm_mem, "w_mem_kv": w_mem_kv, "s5_a_re": s5_a_re, "s5_a_im": s5_a_im,
            "s5_log_dt": s5_log_dt, "s5_b_re": s5_b_re, "s5_b_im": s5_b_im, "s5_c_re": s5_c_re,
            "s5_c_im": s5_c_im, "s5_d": s5_d, "s5_w_glu": s5_w_glu, "w_branch_ret": w_branch_ret,
            "w_branch_s5": w_branch_s5, "w_branch_mem": w_branch_mem, "w_out": w_out,
            "norm_ffn": norm_ffn, "peer_w_q": peer_w_q, "peer_keys": peer_keys, "peer_u": peer_u,
            "peer_v": peer_v, "norm_final": norm_final}


def reference(x, mem, positions, norm_mix, w_in, norm_mem, w_mem_kv, s5_a_re, s5_a_im,
              s5_log_dt, s5_b_re, s5_b_im, s5_c_re, s5_c_im, s5_d, s5_w_glu, w_branch_ret,
              w_branch_s5, w_branch_mem, w_out, norm_ffn, peer_w_q, peer_keys, peer_u,
              peer_v, norm_final):
    bsz, seq, _ = x.shape
    offsets = [int(o) for o in np.cumsum(IN_SPLITS)[:-1]]
    h = x
    for l in range(DEPTH):
        n = _rms_norm(h, norm_mix[l])
        z = n @ w_in[l]
        q_r, k_r, v_r, g_r, u_s5, q_m, gates = jnp.split(z, offsets, axis=-1)
        q_r = _rope(q_r.reshape(bsz, seq, RET_HEADS, RET_DK), positions)
        k_r = _rope(k_r.reshape(bsz, seq, RET_HEADS, RET_DK), positions) * (RET_DK ** -0.5)
        v_r = v_r.reshape(bsz, seq, RET_HEADS, RET_DV).astype(jnp.float32)
        ret = _retention(q_r, k_r, v_r)
        ret = ret * lax.rsqrt(jnp.mean(ret * ret, axis=-1, keepdims=True) + EPS)
        ret = ret.reshape(bsz, seq, RET_V_WIDTH) * jax.nn.silu(g_r.astype(jnp.float32))
        ssm = _s5(u_s5, s5_a_re[l], s5_a_im[l], s5_log_dt[l], s5_b_re[l], s5_b_im[l],
                  s5_c_re[l], s5_c_im[l], s5_d[l], s5_w_glu[l])
        mem_n = _rms_norm(mem, norm_mem[l])
        k_m, v_m = jnp.split(mem_n @ w_mem_kv[l], 2, axis=-1)
        mattn = _memory_attention(q_m.reshape(bsz, seq, MEM_HEADS, MEM_HEAD_DIM),
                                  k_m.reshape(bsz, MEM_LEN, MEM_HEADS, MEM_HEAD_DIM),
                                  v_m.reshape(bsz, MEM_LEN, MEM_HEADS, MEM_HEAD_DIM))
        gate_r, gate_s, gate_m = jnp.split(jax.nn.sigmoid(gates.astype(jnp.float32)), N_BRANCHES, axis=-1)
        merged = (gate_r * (ret @ w_branch_ret[l])
                  + gate_s * (ssm @ w_branch_s5[l])
                  + gate_m * (mattn @ w_branch_mem[l]))
        h = h + (merged @ w_out[l]).astype(h.dtype)
        h = h + _peer(_rms_norm(h, norm_ffn[l]), peer_w_q[l], peer_keys[l], peer_u[l], peer_v[l]).astype(h.dtype)
    return _rms_norm(h, norm_final)
```

```cpp
#include <hip/hip_runtime.h>
#include <cstdio>
#include <cstdint>
namespace pg8 {
__device__ __forceinline__ int hw_lane_id() { int l; asm volatile("v_mbcnt_lo_u32_b32 %0, -1, 0\n\tv_mbcnt_hi_u32_b32 %0, -1, %0" : "=v"(l)); return l; }
#define PG8_LAS __attribute__((address_space(3)))
typedef unsigned short bf16_t;
typedef short bf16x8 __attribute__((ext_vector_type(8)));
typedef float f32x4 __attribute__((ext_vector_type(4)));
typedef unsigned u32x4 __attribute__((ext_vector_type(4)));
constexpr int BM = 256, BK = 64, HALF = 128, HTB = HALF * BK * 2  , STAGE_BYTES = 8 * HTB, NXCD = 8, WGM = 8;

__host__ __device__ __forceinline__ int lds_byte(int r, int c) { const int st = (r >> 4) * 2 + (c >> 5), rr = r & 15, cc = c & 31, ob = rr * 64 + cc * 2; return st * 1024 + (ob ^ (((ob >> 9) & 1) << 5)); }
__host__ __device__ __forceinline__ void stage_rc(int b, int& R, int& C) { const int st = b / 1024, sb = b % 1024, swz = sb ^ (((sb >> 9) & 1) << 5); R = (st >> 1) * 16 + swz / 64; C = (st & 1) * 32 + (swz % 64) / 2; }
__host__ __device__ __forceinline__ int perm32(int rho) { const int n = rho >> 4, i = rho & 15; return 8 * (i >> 2) + 4 * n + (i & 3); }

struct Unit { int pm, pn; };
struct Gemm { const bf16_t* A; const bf16_t* Bt; int M, N, K; };

struct StaticOrder {
    int nM, nN, nwg, G, c;
    __host__ __device__ void init(int M, int N, int G_, int c_) { nM = M / BM; nN = N / BM; nwg = nM * nN; G = G_; c = c_; }
    __host__ __device__ bool next(int i, Unit& u) const {
        const long L = (long)i * G + c; if (L >= nwg) return false;
        int wgid = (int)L; { const int q = nwg / NXCD, r = nwg % NXCD, xcd = wgid % NXCD, off = wgid / NXCD; wgid = (xcd < r ? xcd * (q + 1) : r * (q + 1) + (xcd - r) * q) + off; }
        const int nig = WGM * nN, gid = wgid / nig, fm = gid * WGM, gsz = (nM - fm) < WGM ? (nM - fm) : WGM;
        u.pm = fm + ((wgid % nig) % gsz); u.pn = (wgid % nig) / gsz; return true;
    }
    __device__ __forceinline__ void a_ready(const Unit&) const {}
    __device__ __forceinline__ void done(const Unit&) const {}
};

__device__ __forceinline__ unsigned cvt_pk_bf16(float lo, float hi) { unsigned r; asm volatile("v_cvt_pk_bf16_f32 %0, %1, %2" : "=v"(r) : "v"(lo), "v"(hi)); return r; }
template <class Epi, class Sched, bool ALIGN_EPI = false, bool SP2 = false>
__device__ __forceinline__ void gemm_phase(PG8_LAS unsigned char* lds, const Gemm g, const Sched& S, const Epi& E, const int wid) {
    const int lane = hw_lane_id(), tid = wid * 64 + lane, wr = wid >> 2, wc = wid & 3, fr = lane & 15, fq = lane >> 4;
    const int K = g.K, nt = K / BK;
    unsigned voffA[2], voffB[2];
#pragma unroll
    for (int i = 0; i < 2; ++i) { int R, C; stage_rc(tid * 16 + i * 8192, R, C); const int Rb = Epi::PERM ? ((R & ~31) + perm32(R & 31)) : R;
        voffA[i] = (unsigned)(R * K + C) * 2u; voffB[i] = (unsigned)(Rb * K + C) * 2u; }
    const size_t kstep = (size_t)(BK * 2);
    const size_t hstep = (size_t)HALF * K * 2;
    const size_t tstep = 2 * hstep;
    const unsigned ldsw = (unsigned)wid * 1024u;
    const int aoff = lds_byte(wr * 64 + fr, fq * 8), boff = lds_byte(wc * 32 + fr, fq * 8);
#define PG8_SA(b, h) (((b) * 2 + (h)) * HTB)
#define PG8_SB(b, h) ((4 + (b) * 2 + (h)) * HTB)
#define PG8_STAGE(bufoff, gbase, voff) do { _Pragma("unroll") for (int _i = 0; _i < 2; ++_i) \
        __builtin_amdgcn_global_load_lds((const unsigned*)((const char*)(gbase) + (voff)[_i]), (PG8_LAS unsigned*)(lds + (bufoff) + ldsw + _i * 8192), 16, 0, 0); } while (0)
#define PG8_LDA(dst, b, h) do { _Pragma("unroll") for (int m = 0; m < 4; ++m) _Pragma("unroll") for (int k = 0; k < 2; ++k) dst[m][k] = *(const PG8_LAS bf16x8*)(lds + PG8_SA(b, h) + aoff + m * 2048 + k * 1024); } while (0)
#define PG8_LDB(dst, b, h) do { _Pragma("unroll") for (int n = 0; n < 2; ++n) _Pragma("unroll") for (int k = 0; k < 2; ++k) dst[n][k] = *(const PG8_LAS bf16x8*)(lds + PG8_SB(b, h) + boff + n * 2048 + k * 1024); } while (0)
#define PG8_MMA(ai, bj, At, Bt) do { __builtin_amdgcn_s_setprio(1); _Pragma("unroll") for (int m = 0; m < 4; ++m) _Pragma("unroll") for (int n = 0; n < 2; ++n) _Pragma("unroll") for (int k = 0; k < 2; ++k) \
        acc[ai][bj][m][n] = __builtin_amdgcn_mfma_f32_16x16x32_bf16(Bt[n][k], At[m][k], acc[ai][bj][m][n], 0, 0, 0); __builtin_amdgcn_s_setprio(0); } while (0)
#define PG8_WAIT_V(n) asm volatile("s_waitcnt vmcnt(" #n ")" ::: "memory")
#define PG8_WAIT_L(n) asm volatile("s_waitcnt lgkmcnt(" #n ")" ::: "memory")
#define PG8_BAR __builtin_amdgcn_s_barrier()
#define PG8_SCHED __builtin_amdgcn_sched_barrier(0)
    Unit cur, nxt; int ui = 0;
    if (!S.next(0, cur)) return;
    f32x4 acc[2][2][4][2];
#pragma unroll
    for (int a = 0; a < 2; ++a)
#pragma unroll
        for (int b = 0; b < 2; ++b)
#pragma unroll
            for (int m = 0; m < 4; ++m)
#pragma unroll
                for (int n = 0; n < 2; ++n) acc[a][b][m][n] = (f32x4){0.f, 0.f, 0.f, 0.f};
    bf16x8 At[4][2], B0[2][2], B1[2][2];
    const char* cA = (const char*)g.A + (size_t)cur.pm * tstep; const char* cB = (const char*)g.Bt + (size_t)cur.pn * tstep;
    S.a_ready(cur);
    if constexpr (SP2) {
        PG8_STAGE(PG8_SB(0, 0), cB, voffB); PG8_STAGE(PG8_SB(0, 1), cB + hstep, voffB); PG8_STAGE(PG8_SA(0, 0), cA, voffA); PG8_STAGE(PG8_SA(0, 1), cA + hstep, voffA);
        if (wr == 1) PG8_BAR;
        PG8_WAIT_V(2); PG8_BAR;
        PG8_STAGE(PG8_SB(1, 0), cB + kstep, voffB); PG8_STAGE(PG8_SA(1, 0), cA + kstep, voffA); PG8_STAGE(PG8_SB(1, 1), cB + hstep + kstep, voffB);
        PG8_WAIT_V(6); PG8_BAR;
    } else {
        PG8_STAGE(PG8_SB(0, 0), cB, voffB); PG8_STAGE(PG8_SA(0, 0), cA, voffA); PG8_STAGE(PG8_SB(0, 1), cB + hstep, voffB); PG8_STAGE(PG8_SA(0, 1), cA + hstep, voffA);
        if (wr == 1) PG8_BAR;
        PG8_WAIT_V(4); PG8_BAR;
        PG8_STAGE(PG8_SB(1, 0), cB + kstep, voffB); PG8_STAGE(PG8_SA(1, 0), cA + kstep, voffA); PG8_STAGE(PG8_SB(1, 1), cB + hstep + kstep, voffB);
        PG8_WAIT_V(6); PG8_BAR;
    }
    for (;;) {
        const bool has_next = S.next(ui + 1, nxt);
        const char* nA = has_next ? (const char*)g.A + (size_t)nxt.pm * tstep : cA; const char* nB = has_next ? (const char*)g.Bt + (size_t)nxt.pn * tstep : cB;
        for (int t = 0; t < nt; t += 2) {
            const bool last = (t == nt - 2);
            const char* a1 = cA + (size_t)(t + 1) * kstep;
            const char* a2 = last ? nA : cA + (size_t)(t + 2) * kstep; const char* b2 = last ? nB : cB + (size_t)(t + 2) * kstep;
            const char* a3 = a2 + kstep; const char* b3 = b2 + kstep;
            if (last && has_next) S.a_ready(nxt);
            if constexpr (SP2) {
            PG8_LDB(B0, 0, 0); PG8_LDB(B1, 0, 1); PG8_SCHED; PG8_LDA(At, 0, 0); PG8_STAGE(PG8_SA(1, 1), a1 + hstep, voffA);
            PG8_WAIT_V(8); PG8_WAIT_L(0); PG8_BAR; PG8_MMA(0, 0, At, B0); PG8_MMA(0, 1, At, B1); PG8_BAR; PG8_SCHED;
            PG8_LDA(At, 0, 1); PG8_STAGE(PG8_SB(0, 0), b2, voffB); PG8_STAGE(PG8_SB(0, 1), b2 + hstep, voffB); PG8_STAGE(PG8_SA(0, 0), a2, voffA);
            PG8_WAIT_V(8); PG8_WAIT_L(0); PG8_BAR; PG8_MMA(1, 0, At, B0); PG8_MMA(1, 1, At, B1); PG8_BAR; PG8_SCHED;
            PG8_LDB(B0, 1, 0); PG8_LDB(B1, 1, 1); PG8_SCHED; PG8_LDA(At, 1, 0); PG8_STAGE(PG8_SA(0, 1), a2 + hstep, voffA);
            PG8_WAIT_V(8); PG8_WAIT_L(0); PG8_BAR; PG8_MMA(0, 0, At, B0); PG8_MMA(0, 1, At, B1); PG8_BAR; PG8_SCHED;
            PG8_LDA(At, 1, 1); PG8_STAGE(PG8_SB(1, 0), b3, voffB); PG8_STAGE(PG8_SB(1, 1), b3 + hstep, voffB); PG8_STAGE(PG8_SA(1, 0), a3, voffA);
            PG8_WAIT_V(8); PG8_WAIT_L(0); PG8_BAR; PG8_MMA(1, 0, At, B0); PG8_MMA(1, 1, At, B1); PG8_BAR; PG8_SCHED;
            } else {
            PG8_LDB(B0, 0, 0); PG8_SCHED; PG8_LDA(At, 0, 0); PG8_STAGE(PG8_SA(1, 1), a1 + hstep, voffA);
            PG8_WAIT_L(8); PG8_BAR; PG8_WAIT_L(0); PG8_MMA(0, 0, At, B0); PG8_BAR; PG8_SCHED;
            PG8_LDB(B1, 0, 1); PG8_STAGE(PG8_SB(0, 0), b2, voffB);
            PG8_BAR; PG8_WAIT_L(0); PG8_MMA(0, 1, At, B1); PG8_BAR;
            PG8_LDA(At, 0, 1); PG8_STAGE(PG8_SA(0, 0), a2, voffA);
            PG8_BAR; PG8_WAIT_L(0); PG8_MMA(1, 0, At, B0); PG8_BAR; PG8_SCHED;
            PG8_STAGE(PG8_SB(0, 1), b2 + hstep, voffB);
            PG8_WAIT_V(6); PG8_BAR; PG8_MMA(1, 1, At, B1); PG8_BAR;
            PG8_LDB(B0, 1, 0); PG8_SCHED; PG8_LDA(At, 1, 0); PG8_STAGE(PG8_SA(0, 1), a2 + hstep, voffA);
            PG8_WAIT_L(8); PG8_BAR; PG8_WAIT_L(0); PG8_MMA(0, 0, At, B0); PG8_BAR; PG8_SCHED;
            PG8_LDB(B1, 1, 1); PG8_STAGE(PG8_SB(1, 0), b3, voffB);
            PG8_BAR; PG8_WAIT_L(0); PG8_MMA(0, 1, At, B1); PG8_BAR;
            PG8_LDA(At, 1, 1); PG8_STAGE(PG8_SA(1, 0), a3, voffA);
            PG8_BAR; PG8_WAIT_L(0); PG8_MMA(1, 0, At, B0); PG8_BAR; PG8_SCHED;
            PG8_STAGE(PG8_SB(1, 1), b3 + hstep, voffB);
            PG8_WAIT_V(6); PG8_BAR; PG8_MMA(1, 1, At, B1); PG8_BAR;
            }
        }
        if constexpr (ALIGN_EPI) { if (wr == 0) PG8_BAR; }
        if constexpr (!Epi::AFTER_DRAIN) { E(acc, cur, wr, wc, fr, fq); S.done(cur); }
        if (!has_next) break;
#pragma unroll
        for (int a = 0; a < 2; ++a)
#pragma unroll
            for (int b = 0; b < 2; ++b)
#pragma unroll
                for (int m = 0; m < 4; ++m)
#pragma unroll
                    for (int n = 0; n < 2; ++n) acc[a][b][m][n] = (f32x4){0.f, 0.f, 0.f, 0.f};
        cur = nxt; cA = nA; cB = nB; ++ui;
        if constexpr (ALIGN_EPI) { if (wr == 1) PG8_BAR; }
    }
    PG8_WAIT_V(0);
    if constexpr (!ALIGN_EPI) { if (wr == 0) PG8_BAR; }
    PG8_BAR;
    if constexpr (Epi::AFTER_DRAIN) { E.fused(acc, cur, wr, wc, fr, fq, lds, wid, lane); S.done(cur); }
#undef PG8_SA
#undef PG8_SB
#undef PG8_STAGE
#undef PG8_LDA
#undef PG8_LDB
#undef PG8_MMA
#undef PG8_WAIT_V
#undef PG8_WAIT_L
#undef PG8_BAR
#undef PG8_SCHED
}
}

#ifndef MK_PER_PHASE
#define MK_PER_PHASE 0
#endif

constexpr int DM = 1024, BATCH = 8, SEQ = 4096, MTOK = BATCH * SEQ;
constexpr int MEMLEN = 256, MROWS = BATCH * MEMLEN;
constexpr int NZ1 = 2560, NGATE = 3072;
constexpr int ZQ = 0, ZK = 512, ZV = 1024, ZGR = 1536, ZU = 2048, ZQM = 2304;
constexpr int NTILES = MTOK / 128;
constexpr float EPS = 1e-6f;
constexpr int NPHASE = 11;

constexpr size_t MiB = 1u << 20;
constexpr size_t WS_CTL = 0, CTL_ZERO_BYTES = 1 * MiB;
constexpr size_t WS_WIN_T = 1 * MiB;
constexpr size_t WS_WQ_T = 12 * MiB;
constexpr size_t WS_WOUT_T = 16 * MiB;
constexpr size_t WS_WBR_T = 18 * MiB;
constexpr size_t WS_WBS_T = 19 * MiB;
constexpr size_t WS_WBM_T = 19 * MiB + 512 * 1024;
constexpr size_t WS_WGLU_T = 20 * MiB;
constexpr size_t WS_WMKV_T = 21 * MiB;
constexpr size_t WS_KEYS = 22 * MiB;
constexpr size_t WS_S5MAT = 23 * MiB;
constexpr size_t WS_S5C = 25 * MiB;
constexpr size_t WS_ROPE = 26 * MiB;
constexpr size_t WS_PU = 42 * MiB;
constexpr size_t WS_PV = 74 * MiB;
constexpr size_t WS_MEMN = 106 * MiB;
constexpr size_t WS_KM = 110 * MiB;
constexpr size_t WS_VT = 111 * MiB;
constexpr size_t WS_S5E = 112 * MiB;
constexpr size_t WS_S5X = 114 * MiB;
constexpr size_t WS_A = 116 * MiB;
constexpr size_t WS_B = 180 * MiB;
constexpr size_t WS_Z1 = WS_B;
constexpr size_t WS_G = WS_B;
constexpr size_t WS_RET = WS_B + 192 * MiB;
constexpr size_t WS_SSM = WS_B + 224 * MiB;
constexpr size_t WS_MATTN = WS_B + 240 * MiB;
constexpr size_t WS_YG = WS_B + 256 * MiB;
constexpr size_t WS_INNER = WS_B + 272 * MiB;
constexpr size_t WS_N2 = WS_B;
constexpr size_t WS_Q2 = WS_B + 64 * MiB;
constexpr size_t WS_IDX = WS_B + 192 * MiB;
constexpr size_t WS_WGT = WS_B + 208 * MiB;
constexpr size_t WS_END = WS_B + 304 * MiB;

constexpr int CW_BAR = 4096;

constexpr int LDS_BYTES = 147456;
constexpr int MISC_OFF = LDS_BYTES - 512;
constexpr int NWAVES = 8;

#define GAS __attribute__((address_space(1)))
#define LAS __attribute__((address_space(3)))
typedef unsigned short bf16;
typedef unsigned v4u __attribute__((ext_vector_type(4)));
typedef unsigned v2u __attribute__((ext_vector_type(2)));
typedef float f32x4 __attribute__((ext_vector_type(4)));
typedef float f32x16 __attribute__((ext_vector_type(16)));
typedef short bf16x8 __attribute__((ext_vector_type(8)));
typedef GAS unsigned gu32;
#define RLX_AGENT __ATOMIC_RELAXED, __HIP_MEMORY_SCOPE_AGENT
#define LDS_WAIT() asm volatile("s_waitcnt lgkmcnt(0)" ::: "memory")
#define VM_WAIT() asm volatile("s_waitcnt vmcnt(0)" ::: "memory")
__device__ __forceinline__ unsigned f2bf(float f) { unsigned u = __builtin_bit_cast(unsigned, f); return (u + 0x7fffu + ((u >> 16) & 1u)) >> 16; }
__device__ __forceinline__ unsigned pk2(float lo, float hi) { return f2bf(lo) | (f2bf(hi) << 16); }
__device__ __forceinline__ float bflo(unsigned w) { return __builtin_bit_cast(float, w << 16); }
__device__ __forceinline__ float bfhi(unsigned w) { return __builtin_bit_cast(float, w & 0xffff0000u); }
__device__ __forceinline__ float bf2f(bf16 h) { return __builtin_bit_cast(float, (unsigned)h << 16); }
__device__ __forceinline__ f32x16 mfma32(bf16x8 a, bf16x8 b, f32x16 c) { return __builtin_amdgcn_mfma_f32_32x32x16_bf16(a, b, c, 0, 0, 0); }
__device__ __forceinline__ f32x4 mfma16(bf16x8 a, bf16x8 b, f32x4 c) { return __builtin_amdgcn_mfma_f32_16x16x32_bf16(a, b, c, 0, 0, 0); }
__device__ __forceinline__ bf16x8 mk8(unsigned a, unsigned b, unsigned c, unsigned d) { v4u t = {a, b, c, d}; return __builtin_bit_cast(bf16x8, t); }
__device__ __forceinline__ float sigmoidf_(float x) { return 1.0f / (1.0f + __expf(-x)); }
__device__ __forceinline__ float gelu_tanh(float x) {
    const float u = 0.7978845608028654f * (x + 0.044715f * x * x * x);
    const float e = __expf(2.0f * u);
    const float th = 1.0f - 2.0f / (e + 1.0f);
    return 0.5f * x * (1.0f + th);
}
__device__ __forceinline__ float wave_sum(float v) {
#pragma unroll
    for (int o = 1; o < 64; o <<= 1) v += __shfl_xor(v, o);
    return v;
}

#define XB_TMO      128
#define XB_XCNT(j)  (256  + 64 * (j))
#define XB_XSUB(j)  (1280 + 64 * (j))
#define XB_XGEN(j)  (2304 + 64 * (j))
#define XB_TOP      3328
#define XB_TOPGEN   3392
#define XCD_BAR_WORDS 3456
#define XB_SPIN_CAP (1u << 22)

__device__ __forceinline__ unsigned xb_ld(unsigned* p)              { return __hip_atomic_load(p, __ATOMIC_RELAXED, __HIP_MEMORY_SCOPE_AGENT); }
__device__ __forceinline__ unsigned xb_add(unsigned* p, unsigned v) { return __hip_atomic_fetch_add(p, v, __ATOMIC_RELAXED, __HIP_MEMORY_SCOPE_AGENT); }
__device__ __forceinline__ unsigned xb_xcc_id() { return (unsigned)__builtin_amdgcn_s_getreg((3 << 11) | 20) & 0xFu; }
#define XB_SPIN(cond, bar) do { unsigned _sp = 0; while (cond) { __builtin_amdgcn_s_sleep(1); \
    if ((++_sp & 255u) == 0u) { if (xb_ld(&(bar)[XB_TMO])) break; if (_sp > XB_SPIN_CAP) { atomicAdd(&(bar)[XB_TMO], 1u); break; } } } } while (0)

struct XcdBarrier { unsigned* bar; unsigned x; volatile LAS unsigned* st; };

__device__ __forceinline__ XcdBarrier xcd_barrier_post(unsigned* bar, volatile LAS unsigned* st, bool tid0) {
    XcdBarrier b; b.bar = bar; b.x = xb_xcc_id(); b.st = st;
    if (tid0) (void)xb_add(&bar[XB_XCNT(b.x)], 1u);
    return b;
}
__device__ __forceinline__ void xcd_barrier_complete(unsigned* bar, unsigned x, unsigned& nloc, unsigned& nx) {
    const unsigned G = gridDim.x * gridDim.y * gridDim.z;
    unsigned sum, cnt, mine, sp = 0u;
    for (;;) {
        sum = 0u; cnt = 0u; mine = 0u;
#pragma unroll
        for (unsigned j = 0; j < 16; ++j) { const unsigned c = xb_ld(&bar[XB_XCNT(j)]); sum += c; cnt += (c > 0u) ? 1u : 0u; mine = (j == x) ? c : mine; }
        if (sum == G) break;
        __builtin_amdgcn_s_sleep(1);
        if ((++sp & 255u) == 0u) { if (xb_ld(&bar[XB_TMO])) break; if (sp > XB_SPIN_CAP) { atomicAdd(&bar[XB_TMO], 1u); break; } }
    }
    nloc = mine > 0u ? mine : 1u; nx = cnt > 0u ? cnt : 1u;
}
__device__ __forceinline__ void xcd_barrier(const XcdBarrier& b, int wave) {
    asm volatile("s_waitcnt vmcnt(0)" ::: "memory");
    __syncthreads();
    if (wave == 0 && pg8::hw_lane_id() == 0) {
        unsigned* bar = b.bar;
        __builtin_amdgcn_s_waitcnt(0);
        unsigned nloc = b.st[0], nx = b.st[1];
        if (nloc == 0u) { xcd_barrier_complete(bar, b.x, nloc, nx); b.st[0] = nloc; b.st[1] = nx; }
        const unsigned old = xb_add(&bar[XB_XSUB(b.x)], 1u);
        const unsigned gen = old / nloc;
        if (old + 1u == (gen + 1u) * nloc) {
            __builtin_amdgcn_fence(__ATOMIC_RELEASE, "agent");
            asm volatile("s_waitcnt vmcnt(0)" ::: "memory");
            const unsigned og = xb_add(&bar[XB_TOP], 1u);
            const unsigned tg = og / nx;
            if (og + 1u == (tg + 1u) * nx) xb_add(&bar[XB_TOPGEN], 1u);
            else XB_SPIN(xb_ld(&bar[XB_TOPGEN]) == tg, bar);
            __builtin_amdgcn_fence(__ATOMIC_ACQUIRE, "agent");
            xb_add(&bar[XB_XGEN(b.x)], 1u);
            asm volatile("s_waitcnt vmcnt(0)" ::: "memory");
        } else {
            XB_SPIN(xb_ld(&bar[XB_XGEN(b.x)]) == gen, bar);
            __builtin_amdgcn_fence(__ATOMIC_ACQUIRE, "agent");
            asm volatile("s_waitcnt vmcnt(0)" ::: "memory");
        }
    }
    __syncthreads();
}

struct Args { const void* in[26]; float* out; unsigned char* ws; int ph_lo, ph_hi; };
struct Ctx {
    LAS unsigned char* lds;
    int tid, lane, wave, vcu, G;
    __device__ __forceinline__ void refresh() { lane = pg8::hw_lane_id(); tid = wave * 64 + lane; }
};

template <class F> struct EpiT {
    static constexpr bool PERM = true, AFTER_DRAIN = false;
    F f;
    __device__ __forceinline__ void operator()(const f32x4 (&acc)[2][2][4][2], const pg8::Unit& u, int wr, int wc, int fr, int fq) const {
        const int row0 = u.pm * 256 + wr * 64 + fr, col0 = u.pn * 256 + wc * 32 + 8 * fq;
#pragma unroll
        for (int ai = 0; ai < 2; ++ai)
#pragma unroll
            for (int m = 0; m < 4; ++m) {
#pragma unroll
                for (int bj = 0; bj < 2; ++bj) f(row0 + ai * 128 + m * 16, col0 + bj * 128, acc[ai][bj][m][0], acc[ai][bj][m][1]);
                __builtin_amdgcn_sched_barrier(0);
            }
    }
};
__device__ __forceinline__ v4u pack8(f32x4 a, f32x4 b) { v4u w; w.x = pk2(a[0], a[1]); w.y = pk2(a[2], a[3]); w.z = pk2(b[0], b[1]); w.w = pk2(b[2], b[3]); return w; }
struct FStore { bf16* O; int ldc;
    __device__ __forceinline__ void operator()(int row, int col, f32x4 v0, f32x4 v1) const { *(v4u*)(O + (size_t)row * ldc + col) = pack8(v0, v1); } };
struct FKvm { bf16* KM; bf16* VT;
    __device__ __forceinline__ void operator()(int row, int col, f32x4 v0, f32x4 v1) const {
        if (col < 256) { *(v4u*)(KM + (size_t)row * 256 + col) = pack8(v0, v1); }
        else { const int c = col - 256, b = row >> 8, m = row & 255; bf16* p = VT + ((size_t)(b * 256 + c)) * 256 + m;
#pragma unroll
            for (int j = 0; j < 4; ++j) { p[(size_t)j * 256] = (bf16)f2bf(v0[j]); p[(size_t)(j + 4) * 256] = (bf16)f2bf(v1[j]); } }
    } };
struct FSig { bf16* O; int ldc;
    __device__ __forceinline__ void operator()(int row, int col, f32x4 v0, f32x4 v1) const {
#pragma unroll
        for (int j = 0; j < 4; ++j) { v0[j] = sigmoidf_(v0[j]); v1[j] = sigmoidf_(v1[j]); }
        *(v4u*)(O + (size_t)row * ldc + col) = pack8(v0, v1); } };
struct FGlu { bf16* O;
    __device__ __forceinline__ void operator()(int row, int col, f32x4 v0, f32x4 v1) const {
        v2u w; w.x = pk2(v0[0] * sigmoidf_(v1[0]), v0[1] * sigmoidf_(v1[1])); w.y = pk2(v0[2] * sigmoidf_(v1[2]), v0[3] * sigmoidf_(v1[3]));
        *(v2u*)(O + (size_t)row * 256 + (col >> 1)) = w; } };
template <int MODE> struct FBranch { const bf16* Gt; int goff; float* MF; bf16* MB;
    __device__ __forceinline__ void operator()(int row, int col, f32x4 v0, f32x4 v1) const {
        const v4u g = *(const v4u*)(Gt + (size_t)row * NGATE + goff + col);
        v0[0] *= bflo(g.x); v0[1] *= bfhi(g.x); v0[2] *= bflo(g.y); v0[3] *= bfhi(g.y);
        v1[0] *= bflo(g.z); v1[1] *= bfhi(g.z); v1[2] *= bflo(g.w); v1[3] *= bfhi(g.w);
        float* mp = MF + (size_t)row * DM + col;
        if (MODE >= 1) { v0 += *(const f32x4*)mp; v1 += *(const f32x4*)(mp + 4); }
        if (MODE <= 1) { *(f32x4*)mp = v0; *(f32x4*)(mp + 4) = v1; }
        else *(v4u*)(MB + (size_t)row * DM + col) = pack8(v0, v1); } };
struct FRes { const float* X; float* H;
    __device__ __forceinline__ void operator()(int row, int col, f32x4 v0, f32x4 v1) const {
        const float* xp = X + (size_t)row * DM + col; float* hp = H + (size_t)row * DM + col;
        *(f32x4*)hp = *(const f32x4*)xp + v0; *(f32x4*)(hp + 4) = *(const f32x4*)(xp + 4) + v1; } };

template <class F>
__device__ __forceinline__ void run_gemm(const Ctx& C, const bf16* A, const bf16* Bt, int M, int N, int K, const F& f) {
    pg8::Gemm g{A, Bt, M, N, K}; pg8::StaticOrder S; S.init(M, N, C.G, (int)blockIdx.x);
    EpiT<F> E{f};
    pg8::gemm_phase<EpiT<F>, pg8::StaticOrder, true, true>(C.lds, g, S, E, C.wave);
}

template <bool GLU>
__device__ __forceinline__ void p0_transpose_item(const float* W, int K, int N, bf16* WT, LAS float* scr, int item, int lane) {
    const int nblk = N / 32, kb = item / nblk, nb = item % nblk, k0 = 64 * kb, n0 = 32 * nb;
#pragma unroll 8
    for (int i = 0; i < 32; ++i) { const int kk = 2 * i + (lane >> 5); scr[kk * 33 + (lane & 31)] = W[(size_t)(k0 + kk) * N + n0 + (lane & 31)]; }
    LDS_WAIT(); asm volatile("" ::: "memory");
    const int c = lane & 7;
#pragma unroll
    for (int j = 0; j < 4; ++j) { const int n = (lane >> 3) + 8 * j; const LAS float* s = scr + (8 * c) * 33 + n;
        v4u o; o.x = pk2(s[0 * 33], s[1 * 33]); o.y = pk2(s[2 * 33], s[3 * 33]); o.z = pk2(s[4 * 33], s[5 * 33]); o.w = pk2(s[6 * 33], s[7 * 33]);
        const int nn = n0 + n; int row = nn;
        if (GLU) { const int jc = nn & 255, gate = nn >> 8; row = 8 * (jc >> 2) + 4 * gate + (jc & 3); }
        *(GAS v4u*)(WT + (size_t)row * K + k0 + 8 * c) = o; }
    LDS_WAIT(); asm volatile("" ::: "memory");
}
__device__ __forceinline__ void rms_row_to_bf16(const float* xrow, const float* gain, bf16* orow, int lane) {
    const f32x4* xr = (const f32x4*)xrow + lane; const f32x4* gr = (const f32x4*)gain + lane;
    f32x4 v[4]; float s = 0.f;
#pragma unroll
    for (int j = 0; j < 4; ++j) { v[j] = xr[64 * j]; s += (v[j].x * v[j].x + v[j].y * v[j].y) + (v[j].z * v[j].z + v[j].w * v[j].w); }
    const float rstd = 1.0f / sqrtf(wave_sum(s) * (1.f / DM) + EPS);
    unsigned long long* o8 = (unsigned long long*)orow + lane;
#pragma unroll
    for (int j = 0; j < 4; ++j) { const f32x4 g = gr[64 * j];
        o8[64 * j] = (unsigned long long)pk2(v[j].x * rstd * g.x, v[j].y * rstd * g.y) | ((unsigned long long)pk2(v[j].z * rstd * g.z, v[j].w * rstd * g.w) << 32); }
}

__device__ __forceinline__ void p0_s5_group(const Ctx& C, const Args& a, int g) {
    const float* a_re = (const float*)a.in[7]; const float* a_im = (const float*)a.in[8]; const float* log_dt = (const float*)a.in[9];
    const float* b_re = (const float*)a.in[10]; const float* b_im = (const float*)a.in[11]; const float* c_re = (const float*)a.in[12]; const float* c_im = (const float*)a.in[13];
    LAS float* L = (LAS float*)C.lds;
    LAS float* lpr = L;
    LAS float* lpi = L + 9 * 64;
    LAS float* bbr = L + 1152;
    LAS float* bbi = bbr + 1024;
    LAS float* ccr = bbi + 1024;
    LAS float* cci = ccr + 1024;
    LAS float* Kj = cci + 1024;
    const int tid = C.tid;
    bf16* T8T = (bf16*)(a.ws + WS_S5MAT) + (size_t)g * 16384;
    bf16* PMT = (bf16*)(a.ws + WS_S5MAT) + (size_t)(16 + g) * 16384;
    bf16* QMT = (bf16*)(a.ws + WS_S5MAT) + (size_t)(32 + g) * 16384;
    float* L8 = (float*)(a.ws + WS_S5C) + (size_t)g * 128;
    float* L128 = (float*)(a.ws + WS_S5C) + 2048 + (size_t)g * 128;
    if (tid < 64) {
        const int p = tid;
        const double dt = exp((double)log_dt[g]);
        const double ar = (double)a_re[g * 64 + p], ai = (double)a_im[g * 64 + p];
        for (int j = 0; j <= 8; ++j) { const double mag = exp(ar * dt * j), ang = ai * dt * j; lpr[j * 64 + p] = (float)(mag * cos(ang)); lpi[j * 64 + p] = (float)(mag * sin(ang)); }
        { const double mag = exp(ar * dt * 8.0), ang = ai * dt * 8.0; L8[p * 2] = (float)(mag * cos(ang)); L8[p * 2 + 1] = (float)(mag * sin(ang)); }
        { const double mag = exp(ar * dt * 128.0), ang = ai * dt * 128.0; L128[p * 2] = (float)(mag * cos(ang)); L128[p * 2 + 1] = (float)(mag * sin(ang)); }
        const double lr = exp(ar * dt) * cos(ai * dt), li = exp(ar * dt) * sin(ai * dt);
        const double den = ar * ar + ai * ai, nr = lr - 1.0, ni = li;
        const double cr = (nr * ar + ni * ai) / den, ci = (ni * ar - nr * ai) / den;
        for (int h = 0; h < 16; ++h) { const double br = (double)b_re[(g * 64 + p) * 16 + h], bi = (double)b_im[(g * 64 + p) * 16 + h];
            bbr[p * 16 + h] = (float)(cr * br - ci * bi); bbi[p * 16 + h] = (float)(cr * bi + ci * br); }
    }
    for (int i = tid; i < 1024; i += 512) { ccr[i] = c_re[g * 1024 + i]; cci[i] = c_im[g * 1024 + i]; }
    __syncthreads();
    for (int i = tid; i < 2048; i += 512) {
        const int j = i >> 8, ho = (i >> 4) & 15, hi = i & 15; float s = 0.f;
        for (int p = 0; p < 64; ++p) { const float cr_ = ccr[ho * 64 + p], ci_ = cci[ho * 64 + p], lr_ = lpr[j * 64 + p], li_ = lpi[j * 64 + p];
            const float mr = cr_ * lr_ - ci_ * li_, mi = cr_ * li_ + ci_ * lr_;
            s += mr * bbr[p * 16 + hi] - mi * bbi[p * 16 + hi]; }
        Kj[i] = s;
    }
    __syncthreads();
    for (int i = tid; i < 16384; i += 512) {
        const int n = i >> 7, k = i & 127;
        { const int t = n >> 4, ho = n & 15, s = k >> 4, hi = k & 15; const float v = (s <= t) ? Kj[((t - s) * 16 + ho) * 16 + hi] : 0.f; T8T[i] = (bf16)f2bf(v); }
        { const int p = n & 63, im = n >> 6, s = k >> 4, hi = k & 15; const float lr_ = lpr[(7 - s) * 64 + p], li_ = lpi[(7 - s) * 64 + p], br_ = bbr[p * 16 + hi], bi_ = bbi[p * 16 + hi];
          const float v = im ? (lr_ * bi_ + li_ * br_) : (lr_ * br_ - li_ * bi_); PMT[i] = (bf16)f2bf(v); }
        { const int t = n >> 4, ho = n & 15, p = k & 63, part = k >> 6; const float cr_ = ccr[ho * 64 + p], ci_ = cci[ho * 64 + p], lr_ = lpr[(t + 1) * 64 + p], li_ = lpi[(t + 1) * 64 + p];
          const float v = part ? -(cr_ * li_ + ci_ * lr_) : (cr_ * lr_ - ci_ * li_); QMT[i] = (bf16)f2bf(v); }
    }
    __syncthreads();
}

__device__ __forceinline__ void p0_prologue(const Ctx& C, const Args& a) {
    if (C.vcu < 16) p0_s5_group(C, a, C.vcu);
    LAS float* scr = (LAS float*)(C.lds + C.wave * 16384);
    const int gw = C.vcu * NWAVES + C.wave, NGW = C.G * NWAVES;
    const int gt = C.vcu * 512 + C.tid, NGT = C.G * 512;
    unsigned char* ws = a.ws;
    constexpr int I_IN = 16 * 176, I_Q = 16 * 64, I_O = 16 * 32, I_BR = 8 * 32, I_BS = 4 * 32, I_BM = 4 * 32, I_KV = 16 * 16, I_GLU = 4 * 16;
    constexpr int NITEMS = I_IN + I_Q + I_O + I_BR + I_BS + I_BM + I_KV + I_GLU;
    for (int it = gw; it < NITEMS; it += NGW) {
        int r = it;
        if (r < I_IN) { p0_transpose_item<false>((const float*)a.in[4], 1024, 5632, (bf16*)(ws + WS_WIN_T), scr, r, C.lane); continue; } r -= I_IN;
        if (r < I_Q) { p0_transpose_item<false>((const float*)a.in[21], 1024, 2048, (bf16*)(ws + WS_WQ_T), scr, r, C.lane); continue; } r -= I_Q;
        if (r < I_O) { p0_transpose_item<false>((const float*)a.in[19], 1024, 1024, (bf16*)(ws + WS_WOUT_T), scr, r, C.lane); continue; } r -= I_O;
        if (r < I_BR) { p0_transpose_item<false>((const float*)a.in[16], 512, 1024, (bf16*)(ws + WS_WBR_T), scr, r, C.lane); continue; } r -= I_BR;
        if (r < I_BS) { p0_transpose_item<false>((const float*)a.in[17], 256, 1024, (bf16*)(ws + WS_WBS_T), scr, r, C.lane); continue; } r -= I_BS;
        if (r < I_BM) { p0_transpose_item<false>((const float*)a.in[18], 256, 1024, (bf16*)(ws + WS_WBM_T), scr, r, C.lane); continue; } r -= I_BM;
        if (r < I_KV) { p0_transpose_item<false>((const float*)a.in[6], 1024, 512, (bf16*)(ws + WS_WMKV_T), scr, r, C.lane); continue; } r -= I_KV;
        p0_transpose_item<true>((const float*)a.in[15], 256, 512, (bf16*)(ws + WS_WGLU_T), scr, r, C.lane);
    }
    {
        const float* src[3] = {(const float*)a.in[22], (const float*)a.in[23], (const float*)a.in[24]};
        bf16* dst[3] = {(bf16*)(ws + WS_KEYS), (bf16*)(ws + WS_PU), (bf16*)(ws + WS_PV)};
        const int cnt[3] = {16 * 128 * 128 / 8, 16384 * 1024 / 8, 16384 * 1024 / 8};
#pragma unroll
        for (int t = 0; t < 3; ++t)
            for (int i = gt; i < cnt[t]; i += NGT) { const f32x4 x0 = ((const f32x4*)src[t])[2 * (size_t)i], x1 = ((const f32x4*)src[t])[2 * (size_t)i + 1]; ((v4u*)dst[t])[i] = pack8(x0, x1); }
    }
    for (int m = gw; m < MTOK; m += NGW) rms_row_to_bf16((const float*)a.in[0] + (size_t)m * DM, (const float*)a.in[3], (bf16*)(ws + WS_A) + (size_t)m * DM, C.lane);
    for (int m = gw; m < MROWS; m += NGW) rms_row_to_bf16((const float*)a.in[1] + (size_t)m * DM, (const float*)a.in[5], (bf16*)(ws + WS_MEMN) + (size_t)m * DM, C.lane);
    {
        const int* pos = (const int*)a.in[2]; float* rope = (float*)(ws + WS_ROPE);
        for (int i = gt; i < MTOK * 64; i += NGT) { const int tok = i >> 6, j = i & 63;
            const double inv = exp(-(double)j * (9.210340371976184 / 64.0));
            double ang = (double)pos[tok] * inv; ang -= 6.283185307179586 * rint(ang * 0.15915494309189535);
            rope[(size_t)tok * 128 + j] = (float)cos(ang); rope[(size_t)tok * 128 + 64 + j] = (float)sin(ang); }
    }
}

constexpr int LP = 136;
__device__ __forceinline__ float lg2_gamma(int h) { return log2f(1.0f - exp2f(-5.0f - (float)h)); }

__device__ __forceinline__ void r1_unit(const Ctx& C, const Args& a, int tile, int h) {
    const bf16* Z1 = (const bf16*)(a.ws + WS_Z1); const float* ROPE = (const float*)(a.ws + WS_ROPE);
    LAS bf16* Qs = (LAS bf16*)C.lds; LAS bf16* Ks = Qs + 128 * LP; LAS bf16* Kt = Ks + 128 * LP; LAS bf16* Vt = Kt + 128 * LP;
    const int tid = C.tid, lane = C.lane, t0 = tile * 128, u = tile * 4 + h;
    const float lg2g = lg2_gamma(h);
    {
        const int i = tid >> 2, dq = (tid & 3) * 16;
        const bf16* zr = Z1 + (size_t)(t0 + i) * NZ1; const float* rp = ROPE + (size_t)(t0 + i) * 128;
        float cs[16], sn[16];
#pragma unroll
        for (int q = 0; q < 4; ++q) { const f32x4 c4 = *(const f32x4*)(rp + dq + 4 * q), s4 = *(const f32x4*)(rp + 64 + dq + 4 * q);
#pragma unroll
            for (int e = 0; e < 4; ++e) { cs[4 * q + e] = c4[e]; sn[4 * q + e] = s4[e]; } }
        const float kdec = exp2f((float)(127 - i) * lg2g) , ksc = 0.08838834764831845f;
#pragma unroll
        for (int which = 0; which < 2; ++which) {
            const bf16* src = zr + (which ? ZK : ZQ) + h * 128;
            const v4u a0 = *(const v4u*)(src + dq), a1 = *(const v4u*)(src + dq + 8), b0 = *(const v4u*)(src + 64 + dq), b1 = *(const v4u*)(src + 64 + dq + 8);
            const unsigned aw[8] = {a0.x, a0.y, a0.z, a0.w, a1.x, a1.y, a1.z, a1.w}, bw[8] = {b0.x, b0.y, b0.z, b0.w, b1.x, b1.y, b1.z, b1.w};
            float y1[16], y2[16];
#pragma unroll
            for (int w = 0; w < 8; ++w) {
                const float x1l = bflo(aw[w]), x1h = bfhi(aw[w]), x2l = bflo(bw[w]), x2h = bfhi(bw[w]);
                y1[2 * w] = x1l * cs[2 * w] - x2l * sn[2 * w]; y2[2 * w] = x1l * sn[2 * w] + x2l * cs[2 * w];
                y1[2 * w + 1] = x1h * cs[2 * w + 1] - x2h * sn[2 * w + 1]; y2[2 * w + 1] = x1h * sn[2 * w + 1] + x2h * cs[2 * w + 1];
            }
            if (which) {
#pragma unroll
                for (int e = 0; e < 16; ++e) { y1[e] *= ksc; y2[e] *= ksc; }
            }
            LAS bf16* dstp = (which ? Ks : Qs) + i * LP;
            v4u o;
            o.x = pk2(y1[0], y1[1]); o.y = pk2(y1[2], y1[3]); o.z = pk2(y1[4], y1[5]); o.w = pk2(y1[6], y1[7]); *(LAS v4u*)(dstp + dq) = o;
            o.x = pk2(y1[8], y1[9]); o.y = pk2(y1[10], y1[11]); o.z = pk2(y1[12], y1[13]); o.w = pk2(y1[14], y1[15]); *(LAS v4u*)(dstp + dq + 8) = o;
            o.x = pk2(y2[0], y2[1]); o.y = pk2(y2[2], y2[3]); o.z = pk2(y2[4], y2[5]); o.w = pk2(y2[6], y2[7]); *(LAS v4u*)(dstp + 64 + dq) = o;
            o.x = pk2(y2[8], y2[9]); o.y = pk2(y2[10], y2[11]); o.z = pk2(y2[12], y2[13]); o.w = pk2(y2[14], y2[15]); *(LAS v4u*)(dstp + 64 + dq + 8) = o;
            if (which) {
#pragma unroll
                for (int e = 0; e < 16; ++e) { Kt[(dq + e) * LP + i] = (bf16)f2bf(y1[e] * kdec); Kt[(64 + dq + e) * LP + i] = (bf16)f2bf(y2[e] * kdec); }
            }
            __builtin_amdgcn_sched_barrier(0);
        }
        {
            const int eq = (tid & 3) * 32; const bf16* vs = zr + ZV + h * 128 + eq;
#pragma unroll
            for (int q = 0; q < 4; ++q) { const v4u v = *(const v4u*)(vs + 8 * q); const unsigned vw[4] = {v.x, v.y, v.z, v.w};
#pragma unroll
                for (int w = 0; w < 4; ++w) { Vt[(eq + 8 * q + 2 * w) * LP + i] = (bf16)(vw[w] & 0xffffu); Vt[(eq + 8 * q + 2 * w + 1) * LP + i] = (bf16)(vw[w] >> 16); } }
        }
    }
    __syncthreads();
    const int r = lane & 31, hh = lane >> 5;
    if (C.wave < 4) {
        const int ib = C.wave;
        bf16x8 bq[8];
#pragma unroll
        for (int ks = 0; ks < 8; ++ks) bq[ks] = *(const LAS bf16x8*)(Qs + (ib * 32 + r) * LP + ks * 16 + 8 * hh);
        f32x16 accO[4];
#pragma unroll
        for (int et = 0; et < 4; ++et)
#pragma unroll
            for (int e = 0; e < 16; ++e) accO[et][e] = 0.f;
        const int i = ib * 32 + r;
#pragma unroll
        for (int jt = 0; jt < 4; ++jt) {
            if (jt <= ib) {
                f32x16 s;
#pragma unroll
                for (int e = 0; e < 16; ++e) s[e] = 0.f;
#pragma unroll
                for (int ks = 0; ks < 8; ++ks) { const bf16x8 ak = *(const LAS bf16x8*)(Ks + (jt * 32 + r) * LP + ks * 16 + 8 * hh); s = mfma32(ak, bq[ks], s); }
                unsigned pk[8];
#pragma unroll
                for (int q = 0; q < 8; ++q) {
                    const int ra = 2 * q, rb = 2 * q + 1;
                    const int ja = jt * 32 + (ra & 3) + 8 * (ra >> 2) + 4 * hh, jb = jt * 32 + (rb & 3) + 8 * (rb >> 2) + 4 * hh;
                    const float va = (i >= ja) ? s[ra] * exp2f((float)(i - ja) * lg2g) : 0.f;
                    const float vb = (i >= jb) ? s[rb] * exp2f((float)(i - jb) * lg2g) : 0.f;
                    pk[q] = pk2(va, vb);
                }
#pragma unroll
                for (int sft = 0; sft < 2; ++sft) {
                    const bf16x8 pb = mk8(pk[4 * sft], pk[4 * sft + 1], pk[4 * sft + 2], pk[4 * sft + 3]);
#pragma unroll
                    for (int et = 0; et < 4; ++et) {
                        const LAS bf16* vp = Vt + (et * 32 + r) * LP + jt * 32 + 16 * sft + 4 * hh;
                        const v2u lo = *(const LAS v2u*)vp, hi = *(const LAS v2u*)(vp + 8);
                        accO[et] = mfma32(mk8(lo.x, lo.y, hi.x, hi.y), pb, accO[et]);
                    }
                }
            }
            __builtin_amdgcn_sched_barrier(0);
        }
        unsigned* INN = (unsigned*)(a.ws + WS_INNER) + ((size_t)(u * 4 + ib) * 32) * 64 + lane;
#pragma unroll
        for (int et = 0; et < 4; ++et)
#pragma unroll
            for (int q = 0; q < 8; ++q) INN[(et * 8 + q) * 64] = pk2(accO[et][2 * q], accO[et][2 * q + 1]);
    } else {
        const int et = C.wave - 4;
        f32x16 acc[4];
#pragma unroll
        for (int dt = 0; dt < 4; ++dt)
#pragma unroll
            for (int e = 0; e < 16; ++e) acc[dt][e] = 0.f;
#pragma unroll
        for (int ks = 0; ks < 8; ++ks) {
            const bf16x8 av = *(const LAS bf16x8*)(Vt + (et * 32 + r) * LP + ks * 16 + 8 * hh);
#pragma unroll
            for (int dt = 0; dt < 4; ++dt) { const bf16x8 bk = *(const LAS bf16x8*)(Kt + (dt * 32 + r) * LP + ks * 16 + 8 * hh); acc[dt] = mfma32(av, bk, acc[dt]); }
            __builtin_amdgcn_sched_barrier(0);
        }
        float* KVb = a.out + (size_t)u * 16384 + (size_t)(et * 32 + 4 * hh) * 128 + r;
#pragma unroll
        for (int dt = 0; dt < 4; ++dt) {
#pragma unroll
            for (int e = 0; e < 16; ++e) KVb[((e & 3) + 8 * (e >> 2)) * 128 + dt * 32] = acc[dt][e];
            __builtin_amdgcn_sched_barrier(0);
        }
    }
    __syncthreads();
}

__device__ __forceinline__ void s5_compute_E(const Args& a, int tile, int g, int lane, LAS float* Es, bf16x8 (&au)[4]) {
    const bf16* Z1 = (const bf16*)(a.ws + WS_Z1); const bf16* PMT = (const bf16*)(a.ws + WS_S5MAT) + (size_t)(16 + g) * 16384;
    const int r16 = lane & 15, q4 = lane >> 4;
#pragma unroll
    for (int ks = 0; ks < 4; ++ks) { const int s = 2 * ks + (q4 >> 1);
        au[ks] = *(const bf16x8*)(Z1 + (size_t)(tile * 128 + 8 * r16 + s) * NZ1 + ZU + g * 16 + 8 * (q4 & 1)); }
#pragma unroll 1
    for (int nb = 0; nb < 8; ++nb) {
        f32x4 acc = {0.f, 0.f, 0.f, 0.f};
#pragma unroll
        for (int ks = 0; ks < 4; ++ks) { const bf16x8 b = *(const bf16x8*)(PMT + (size_t)(nb * 16 + r16) * 128 + ks * 32 + 8 * q4); acc = mfma16(au[ks], b, acc); }
#pragma unroll
        for (int i4 = 0; i4 < 4; ++i4) Es[(q4 * 4 + i4) * 128 + nb * 16 + r16] = acc[i4];
        __builtin_amdgcn_sched_barrier(0);
    }
    LDS_WAIT(); asm volatile("" ::: "memory");
}
__device__ __forceinline__ void s5a_wave(const Ctx& C, const Args& a, int tile, int g) {
    LAS float* Es = (LAS float*)(C.lds + C.wave * 16384);
    bf16x8 au[4];
    s5_compute_E(a, tile, g, C.lane, Es, au);
    const float* L8 = (const float*)(a.ws + WS_S5C) + (size_t)g * 128;
    const float l8r = L8[C.lane * 2], l8i = L8[C.lane * 2 + 1];
    float sr = 0.f, si = 0.f;
#pragma unroll
    for (int c = 0; c < 16; ++c) { const float er = Es[c * 128 + C.lane], ei = Es[c * 128 + 64 + C.lane];
        const float nr = l8r * sr - l8i * si + er, ni = l8r * si + l8i * sr + ei; sr = nr; si = ni; }
    float* E = (float*)(a.ws + WS_S5E) + ((size_t)tile * 16 + g) * 128;
    E[C.lane] = sr; E[64 + C.lane] = si;
    LDS_WAIT(); asm volatile("" ::: "memory");
}
__device__ __forceinline__ void s5c_wave(const Ctx& C, const Args& a, int tile, int g) {
    LAS float* Es = (LAS float*)(C.lds + C.wave * 16384);
    LAS bf16* Sv = (LAS bf16*)(C.lds + C.wave * 16384 + 8192);
    const int lane = C.lane, r16 = lane & 15, q4 = lane >> 4;
    bf16x8 au[4];
    s5_compute_E(a, tile, g, lane, Es, au);
    const float* L8 = (const float*)(a.ws + WS_S5C) + (size_t)g * 128;
    const float l8r = L8[lane * 2], l8i = L8[lane * 2 + 1];
    const float* X = (const float*)(a.ws + WS_S5X) + ((size_t)tile * 16 + g) * 128;
    float sr = X[lane], si = X[64 + lane];
#pragma unroll
    for (int c = 0; c < 16; ++c) {
        Sv[c * LP + lane] = (bf16)f2bf(sr); Sv[c * LP + 64 + lane] = (bf16)f2bf(si);
        const float er = Es[c * 128 + lane], ei = Es[c * 128 + 64 + lane];
        const float nr = l8r * sr - l8i * si + er, ni = l8r * si + l8i * sr + ei; sr = nr; si = ni; }
    LDS_WAIT(); asm volatile("" ::: "memory");
    bf16x8 as[4];
#pragma unroll
    for (int ks = 0; ks < 4; ++ks) as[ks] = *(const LAS bf16x8*)(Sv + r16 * LP + ks * 32 + 8 * q4);
    const bf16* T8T = (const bf16*)(a.ws + WS_S5MAT) + (size_t)g * 16384; const bf16* QMT = (const bf16*)(a.ws + WS_S5MAT) + (size_t)(32 + g) * 16384;
    const bf16* Z1 = (const bf16*)(a.ws + WS_Z1); bf16* YG = (bf16*)(a.ws + WS_YG);
    const float dg = ((const float*)a.in[14])[g * 16 + r16];
#pragma unroll 1
    for (int nb = 0; nb < 8; ++nb) {
        f32x4 acc = {0.f, 0.f, 0.f, 0.f};
#pragma unroll
        for (int ks = 0; ks < 4; ++ks) {
            const bf16x8 bt = *(const bf16x8*)(T8T + (size_t)(nb * 16 + r16) * 128 + ks * 32 + 8 * q4); acc = mfma16(au[ks], bt, acc);
            const bf16x8 bq = *(const bf16x8*)(QMT + (size_t)(nb * 16 + r16) * 128 + ks * 32 + 8 * q4); acc = mfma16(as[ks], bq, acc);
        }
#pragma unroll
        for (int i4 = 0; i4 < 4; ++i4) { const int tok = tile * 128 + 8 * (q4 * 4 + i4) + nb;
            const float uv = bf2f(Z1[(size_t)tok * NZ1 + ZU + g * 16 + r16]);
            YG[(size_t)tok * 256 + g * 16 + r16] = (bf16)f2bf(gelu_tanh(acc[i4] + dg * uv)); }
        __builtin_amdgcn_sched_barrier(0);
    }
    LDS_WAIT(); asm volatile("" ::: "memory");
}

__device__ __forceinline__ void ma_wave(const Ctx& C, const Args& a, int tile, int hm, int ib) {
    const bf16* Z1 = (const bf16*)(a.ws + WS_Z1); const bf16* KM = (const bf16*)(a.ws + WS_KM); const bf16* VT = (const bf16*)(a.ws + WS_VT);
    const int lane = C.lane, r = lane & 31, hh = lane >> 5, b = tile >> 5, tok = tile * 128 + ib * 32 + r;
    bf16x8 bq[4];
#pragma unroll
    for (int ks = 0; ks < 4; ++ks) bq[ks] = *(const bf16x8*)(Z1 + (size_t)tok * NZ1 + ZQM + hm * 64 + ks * 16 + 8 * hh);
    float mx = -3.0e38f;
#pragma unroll 1
    for (int mt = 0; mt < 8; ++mt) {
        f32x16 s;
#pragma unroll
        for (int e = 0; e < 16; ++e) s[e] = 0.f;
#pragma unroll
        for (int ks = 0; ks < 4; ++ks) { const bf16x8 ak = *(const bf16x8*)(KM + (size_t)(b * 256 + mt * 32 + r) * 256 + hm * 64 + ks * 16 + 8 * hh); s = mfma32(ak, bq[ks], s); }
#pragma unroll
        for (int e = 0; e < 16; ++e) mx = fmaxf(mx, s[e]);
    }
    mx = fmaxf(mx, __shfl_xor(mx, 32));
    float sum = 0.f;
    f32x16 o[2];
#pragma unroll
    for (int et = 0; et < 2; ++et)
#pragma unroll
        for (int e = 0; e < 16; ++e) o[et][e] = 0.f;
    const float sc = 0.125f * 1.4426950408889634f;
#pragma unroll 1
    for (int mt = 0; mt < 8; ++mt) {
        f32x16 s;
#pragma unroll
        for (int e = 0; e < 16; ++e) s[e] = 0.f;
#pragma unroll
        for (int ks = 0; ks < 4; ++ks) { const bf16x8 ak = *(const bf16x8*)(KM + (size_t)(b * 256 + mt * 32 + r) * 256 + hm * 64 + ks * 16 + 8 * hh); s = mfma32(ak, bq[ks], s); }
        unsigned pk[8];
#pragma unroll
        for (int q = 0; q < 8; ++q) { const float pa = exp2f((s[2 * q] - mx) * sc), pb = exp2f((s[2 * q + 1] - mx) * sc); sum += pa + pb; pk[q] = pk2(pa, pb); }
#pragma unroll
        for (int sft = 0; sft < 2; ++sft) {
            const bf16x8 pb = mk8(pk[4 * sft], pk[4 * sft + 1], pk[4 * sft + 2], pk[4 * sft + 3]);
#pragma unroll
            for (int et = 0; et < 2; ++et) {
                const bf16* vp = VT + (size_t)(b * 256 + hm * 64 + et * 32 + r) * 256 + mt * 32 + 16 * sft + 4 * hh;
                const v2u lo = *(const v2u*)vp, hi = *(const v2u*)(vp + 8);
                o[et] = mfma32(mk8(lo.x, lo.y, hi.x, hi.y), pb, o[et]);
            }
        }
    }
    sum += __shfl_xor(sum, 32);
    const float inv = 1.0f / sum;
    bf16* MA = (bf16*)(a.ws + WS_MATTN) + (size_t)tok * 256 + hm * 64;
#pragma unroll
    for (int et = 0; et < 2; ++et)
#pragma unroll
        for (int g4 = 0; g4 < 4; ++g4) { v2u w; w.x = pk2(o[et][4 * g4] * inv, o[et][4 * g4 + 1] * inv); w.y = pk2(o[et][4 * g4 + 2] * inv, o[et][4 * g4 + 3] * inv);
            *(v2u*)(MA + et * 32 + 8 * g4 + 4 * hh) = w; }
}

__device__ __forceinline__ void r3_wave(const Ctx& C, const Args& a, int tile, int h, int ib) {
    const bf16* Z1 = (const bf16*)(a.ws + WS_Z1); const float* ROPE = (const float*)(a.ws + WS_ROPE);
    const bf16* PREV = (const bf16*)((const unsigned char*)a.out + 64 * MiB);
    const int lane = C.lane, r = lane & 31, hh = lane >> 5, u = tile * 4 + h, tok = tile * 128 + ib * 32 + r;
    const float lg2g = lg2_gamma(h);
    const bf16* zr = Z1 + (size_t)tok * NZ1 + ZQ + h * 128; const float* rp = ROPE + (size_t)tok * 128;
    bf16x8 bq[8];
#pragma unroll
    for (int m = 0; m < 4; ++m) {
        const v4u x1 = *(const v4u*)(zr + m * 16 + 8 * hh), x2 = *(const v4u*)(zr + 64 + m * 16 + 8 * hh);
        const f32x4 c0 = *(const f32x4*)(rp + m * 16 + 8 * hh), c1 = *(const f32x4*)(rp + m * 16 + 8 * hh + 4);
        const f32x4 s0 = *(const f32x4*)(rp + 64 + m * 16 + 8 * hh), s1 = *(const f32x4*)(rp + 64 + m * 16 + 8 * hh + 4);
        const unsigned aw[4] = {x1.x, x1.y, x1.z, x1.w}, bw[4] = {x2.x, x2.y, x2.z, x2.w};
        const float cs[8] = {c0[0], c0[1], c0[2], c0[3], c1[0], c1[1], c1[2], c1[3]}, sn[8] = {s0[0], s0[1], s0[2], s0[3], s1[0], s1[1], s1[2], s1[3]};
        unsigned o1[4], o2[4];
#pragma unroll
        for (int w = 0; w < 4; ++w) {
            const float x1l = bflo(aw[w]), x1h = bfhi(aw[w]), x2l = bflo(bw[w]), x2h = bfhi(bw[w]);
            o1[w] = pk2(x1l * cs[2 * w] - x2l * sn[2 * w], x1h * cs[2 * w + 1] - x2h * sn[2 * w + 1]);
            o2[w] = pk2(x1l * sn[2 * w] + x2l * cs[2 * w], x1h * sn[2 * w + 1] + x2h * cs[2 * w + 1]);
        }
        bq[m] = mk8(o1[0], o1[1], o1[2], o1[3]); bq[m + 4] = mk8(o2[0], o2[1], o2[2], o2[3]);
        __builtin_amdgcn_sched_barrier(0);
    }
    f32x16 acc[4];
#pragma unroll
    for (int et = 0; et < 4; ++et) {
#pragma unroll
        for (int e = 0; e < 16; ++e) acc[et][e] = 0.f;
#pragma unroll
        for (int ks = 0; ks < 8; ++ks) { const bf16x8 ap = *(const bf16x8*)(PREV + ((size_t)u * 128 + et * 32 + r) * 128 + ks * 16 + 8 * hh); acc[et] = mfma32(ap, bq[ks], acc[et]); }
        __builtin_amdgcn_sched_barrier(0);
    }
    const float qdec = exp2f((float)(ib * 32 + r + 1) * lg2g);
    const unsigned* INN = (const unsigned*)(a.ws + WS_INNER) + ((size_t)(u * 4 + ib) * 32) * 64 + lane;
    float ss = 0.f;
#pragma unroll
    for (int et = 0; et < 4; ++et)
#pragma unroll
        for (int q = 0; q < 8; ++q) { const unsigned w = INN[(et * 8 + q) * 64];
            const float v0 = acc[et][2 * q] * qdec + bflo(w), v1 = acc[et][2 * q + 1] * qdec + bfhi(w);
            acc[et][2 * q] = v0; acc[et][2 * q + 1] = v1; ss += v0 * v0 + v1 * v1; }
    __builtin_amdgcn_sched_barrier(0);
    ss += __shfl_xor(ss, 32);
    const float rn = 1.0f / sqrtf(ss * (1.0f / 128.0f) + EPS);
    const bf16* gp = Z1 + (size_t)tok * NZ1 + ZGR + h * 128; bf16* RET = (bf16*)(a.ws + WS_RET) + (size_t)tok * 512 + h * 128;
#pragma unroll
    for (int et = 0; et < 4; ++et)
#pragma unroll
        for (int g4 = 0; g4 < 4; ++g4) { const int e0 = et * 32 + 8 * g4 + 4 * hh; const v2u gw = *(const v2u*)(gp + e0);
            const float g0 = bflo(gw.x), g1 = bfhi(gw.x), g2 = bflo(gw.y), g3 = bfhi(gw.y);
            v2u w; w.x = pk2(acc[et][4 * g4] * rn * g0 * sigmoidf_(g0), acc[et][4 * g4 + 1] * rn * g1 * sigmoidf_(g1));
            w.y = pk2(acc[et][4 * g4 + 2] * rn * g2 * sigmoidf_(g2), acc[et][4 * g4 + 3] * rn * g3 * sigmoidf_(g3));
            *(v2u*)(RET + e0) = w; }
}

__device__ __forceinline__ void p3_scans(const Ctx& C, const Args& a) {
    {
        const float* KV = a.out; bf16* PREV = (bf16*)((unsigned char*)a.out + 64 * MiB);
        for (int it = C.vcu * 512 + C.tid; it < 131072; it += C.G * 512) {
            const int elem = it * 4, b = elem >> 16, h = (elem >> 14) & 3, ed = elem & 16383;
            const float cd = exp2f(128.0f * lg2_gamma(h));
            f32x4 st = {0.f, 0.f, 0.f, 0.f};
#pragma unroll 4
            for (int c = 0; c < 32; ++c) { const size_t off = (size_t)((b * 32 + c) * 4 + h) * 16384 + ed;
                v2u w; w.x = pk2(st[0], st[1]); w.y = pk2(st[2], st[3]); *(v2u*)(PREV + off) = w;
                const f32x4 inc = *(const f32x4*)(KV + off); st = st * cd + inc; }
        }
    }
    {
        const float* E = (const float*)(a.ws + WS_S5E); float* X = (float*)(a.ws + WS_S5X); const float* L128 = (const float*)(a.ws + WS_S5C) + 2048;
        for (int it = C.vcu * 512 + C.tid; it < 8192; it += C.G * 512) {
            const int b = it >> 10, g = (it >> 6) & 15, p = it & 63;
            const float lr = L128[(g * 64 + p) * 2], li = L128[(g * 64 + p) * 2 + 1];
            float xr = 0.f, xi = 0.f;
            for (int n = 0; n < 32; ++n) { const size_t off = ((size_t)(b * 32 + n) * 16 + g) * 128 + p;
                X[off] = xr; X[off + 64] = xi;
                const float er = E[off], ei = E[off + 64];
                const float nr = lr * xr - li * xi + er, ni = lr * xi + li * xr + ei; xr = nr; xi = ni; }
        }
    }
}

__device__ __forceinline__ int f2key(float x) { int b = __builtin_bit_cast(int, x); return b >= 0 ? b : (b ^ 0x7fffffff); }
__device__ __forceinline__ float key2f(int k) { return __builtin_bit_cast(float, k >= 0 ? k : (k ^ 0x7fffffff)); }
__device__ __forceinline__ void ins16(int (&T)[16], int x) {
#pragma unroll
    for (int j = 0; j < 16; ++j) { const int hi = T[j] > x ? T[j] : x; x = T[j] > x ? x : T[j]; T[j] = hi; }
}
__device__ __forceinline__ void peer_topk_half(const Args& a, int tokbase, int hp, int c, int lane, int (&T)[16]) {
    const bf16* Q2 = (const bf16*)(a.ws + WS_Q2); const bf16* KEYS = (const bf16*)(a.ws + WS_KEYS);
    const int r = lane & 31, hh = lane >> 5;
    bf16x8 bq[8];
#pragma unroll
    for (int ks = 0; ks < 8; ++ks) bq[ks] = *(const bf16x8*)(Q2 + (size_t)(tokbase + r) * 2048 + hp * 256 + c * 128 + ks * 16 + 8 * hh);
#pragma unroll
    for (int j = 0; j < 16; ++j) T[j] = (int)0x80000000;
#pragma unroll
    for (int nt = 0; nt < 4; ++nt) {
        f32x16 s;
#pragma unroll
        for (int e = 0; e < 16; ++e) s[e] = 0.f;
#pragma unroll
        for (int ks = 0; ks < 8; ++ks) { const bf16x8 ak = *(const bf16x8*)(KEYS + ((size_t)((hp * 2 + c) * 128 + nt * 32 + r)) * 128 + ks * 16 + 8 * hh); s = mfma32(ak, bq[ks], s); }
#pragma unroll
        for (int e = 0; e < 16; ++e) { const int n = nt * 32 + (e & 3) + 8 * (e >> 2) + 4 * hh; ins16(T, (f2key(s[e]) & ~127) | n); }
    }
    int P[16];
#pragma unroll
    for (int j = 0; j < 16; ++j) P[j] = __shfl_xor(T[j], 32);
#pragma unroll
    for (int j = 0; j < 16; ++j) ins16(T, P[j]);
}
__device__ __forceinline__ void peer_topk_head(const Ctx& C, const Args& a, int tokbase, int hp) {
    const int lane = C.lane, r = lane & 31, hh = lane >> 5;
    int T0[16], T1[16];
    peer_topk_half(a, tokbase, hp, 0, lane, T0);
    peer_topk_half(a, tokbase, hp, 1, lane, T1);
    int F[16];
#pragma unroll
    for (int j = 0; j < 16; ++j) F[j] = (int)0x80000000;
#pragma unroll
    for (int i0 = 0; i0 < 16; ++i0)
#pragma unroll
        for (int i1 = 0; i1 < 16; ++i1)
            if ((i0 + 1) * (i1 + 1) <= 16) { const float v = key2f(T0[i0] & ~127) + key2f(T1[i1] & ~127); ins16(F, (f2key(v) & ~255) | (i0 * 16 + i1)); }
    LAS int* tab = (LAS int*)(C.lds + C.wave * 16384);
#pragma unroll
    for (int j = 0; j < 16; ++j) { tab[j * 64 + lane] = T0[j] & 127; tab[(16 + j) * 64 + lane] = T1[j] & 127; }
    LDS_WAIT(); asm volatile("" ::: "memory");
    const float m = key2f(F[0] & ~255);
    float e[16], sum = 0.f;
#pragma unroll
    for (int j = 0; j < 16; ++j) { e[j] = __expf(key2f(F[j] & ~255) - m); sum += e[j]; }
    const float inv = 1.0f / sum;
    const int tok = tokbase + r;
    int* IDX = (int*)(a.ws + WS_IDX) + (size_t)tok * 128 + hp * 16; float* WGT = (float*)(a.ws + WS_WGT) + (size_t)tok * 128 + hp * 16;
#pragma unroll
    for (int j = 0; j < 16; ++j) { const int id = F[j] & 255; const int k0 = tab[(id >> 4) * 64 + lane], k1 = tab[(16 + (id & 15)) * 64 + lane];
        if (hh == 0) IDX[j] = k0 * 128 + k1; else WGT[j] = e[j] * inv; }
    LDS_WAIT(); asm volatile("" ::: "memory");
}
__device__ __forceinline__ void unpack16(const v4u a, const v4u b, float (&x)[16]) {
    const unsigned w[8] = {a.x, a.y, a.z, a.w, b.x, b.y, b.z, b.w};
#pragma unroll
    for (int i = 0; i < 8; ++i) { x[2 * i] = bflo(w[i]); x[2 * i + 1] = bfhi(w[i]); }
}
__device__ __forceinline__ void peer_token(const Args& a, int tok, int lane) {
    const bf16* N2 = (const bf16*)(a.ws + WS_N2); const bf16* PU = (const bf16*)(a.ws + WS_PU); const bf16* PV = (const bf16*)(a.ws + WS_PV);
    const int* IDX = (const int*)(a.ws + WS_IDX) + (size_t)tok * 128; const float* WGT = (const float*)(a.ws + WS_WGT) + (size_t)tok * 128;
    float xf[16];
    unpack16(*(const v4u*)(N2 + (size_t)tok * DM + lane * 8), *(const v4u*)(N2 + (size_t)tok * DM + 512 + lane * 8), xf);
    const int id0 = IDX[lane], id1 = IDX[64 + lane]; const float w0 = WGT[lane], w1 = WGT[64 + lane];
    float out[16];
#pragma unroll
    for (int i = 0; i < 16; ++i) out[i] = 0.f;
    const int e8 = (lane >> 3) & 7;
#pragma unroll 1
    for (int k = 0; k < 128; k += 8) {
        const int idv = (k < 64) ? id0 : id1; const float wv = (k < 64) ? w0 : w1;
        int eid[8]; float part[8];
#pragma unroll
        for (int kk = 0; kk < 8; ++kk) {
            eid[kk] = __builtin_amdgcn_readlane(idv, (k & 63) + kk);
            const bf16* up = PU + (size_t)eid[kk] * DM + lane * 8;
            float uf[16]; unpack16(*(const v4u*)up, *(const v4u*)(up + 512), uf);
            float s = 0.f;
#pragma unroll
            for (int i = 0; i < 16; ++i) s += xf[i] * uf[i];
            part[kk] = s;
        }
        float t4[4], t2[2], t1;
#pragma unroll
        for (int q = 0; q < 4; ++q) { const bool up = (lane & 32) != 0; const float keep = up ? part[q + 4] : part[q], send = up ? part[q] : part[q + 4]; t4[q] = keep + __shfl_xor(send, 32); }
#pragma unroll
        for (int q = 0; q < 2; ++q) { const bool up = (lane & 16) != 0; const float keep = up ? t4[q + 2] : t4[q], send = up ? t4[q] : t4[q + 2]; t2[q] = keep + __shfl_xor(send, 16); }
        { const bool up = (lane & 8) != 0; const float keep = up ? t2[1] : t2[0], send = up ? t2[0] : t2[1]; t1 = keep + __shfl_xor(send, 8); }
        t1 += __shfl_xor(t1, 4); t1 += __shfl_xor(t1, 2); t1 += __shfl_xor(t1, 1);
        const float wk = __shfl(wv, (k & 63) + e8);
        const float act = gelu_tanh(t1) * wk;
#pragma unroll
        for (int kk = 0; kk < 8; ++kk) {
            const float ab = __builtin_bit_cast(float, __builtin_amdgcn_readlane(__builtin_bit_cast(int, act), kk * 8));
            const bf16* vp = PV + (size_t)eid[kk] * DM + lane * 8;
            float vf[16]; unpack16(*(const v4u*)vp, *(const v4u*)(vp + 512), vf);
#pragma unroll
            for (int i = 0; i < 16; ++i) out[i] += ab * vf[i];
        }
    }
    float* hrow = a.out + (size_t)tok * DM; const float* gf = (const float*)a.in[25];
    f32x4 h[4];
    h[0] = *(const f32x4*)(hrow + lane * 8); h[1] = *(const f32x4*)(hrow + lane * 8 + 4); h[2] = *(const f32x4*)(hrow + 512 + lane * 8); h[3] = *(const f32x4*)(hrow + 512 + lane * 8 + 4);
    float ss = 0.f;
#pragma unroll
    for (int q = 0; q < 4; ++q)
#pragma unroll
        for (int e = 0; e < 4; ++e) { h[q][e] += out[4 * q + e]; ss += h[q][e] * h[q][e]; }
    const float rstd = 1.0f / sqrtf(wave_sum(ss) * (1.f / DM) + EPS);
    const f32x4 g0 = *(const f32x4*)(gf + lane * 8), g1 = *(const f32x4*)(gf + lane * 8 + 4), g2 = *(const f32x4*)(gf + 512 + lane * 8), g3 = *(const f32x4*)(gf + 512 + lane * 8 + 4);
    *(f32x4*)(hrow + lane * 8) = h[0] * rstd * g0; *(f32x4*)(hrow + lane * 8 + 4) = h[1] * rstd * g1;
    *(f32x4*)(hrow + 512 + lane * 8) = h[2] * rstd * g2; *(f32x4*)(hrow + 512 + lane * 8 + 4) = h[3] * rstd * g3;
}

__global__ void __launch_bounds__(NWAVES * 64, 2) mk_fwd(Args args) {
    extern __shared__ __attribute__((aligned(16))) unsigned char lds_raw[];
    Ctx C;
    C.lds = (LAS unsigned char*)lds_raw;
    C.wave = __builtin_amdgcn_readfirstlane((int)threadIdx.x >> 6); C.refresh();
    C.G = gridDim.x; { const int bx = blockIdx.x; C.vcu = (C.G % 8 == 0) ? (bx % 8) * (C.G / 8) + bx / 8 : bx; }
    volatile LAS unsigned* MISC = (volatile LAS unsigned*)(C.lds + MISC_OFF);
    if (C.tid < 128) MISC[C.tid] = 0u;
    __syncthreads();
    unsigned char* ws = args.ws;
    unsigned* ctl = (unsigned*)(ws + WS_CTL);
    XcdBarrier bar; bar.bar = ctl + CW_BAR; bar.x = 0; bar.st = nullptr;
#if !MK_PER_PHASE
    bar = xcd_barrier_post(ctl + CW_BAR, MISC + 8, C.tid == 0);
#define GRID_BAR() xcd_barrier(bar, C.wave)
#else
#define GRID_BAR() do { } while (0)
#endif
    const int lo = args.ph_lo, hi = args.ph_hi;
#define IN(k) (lo <= (k) && (k) < hi)
#define SEAM(k) do { if (IN((k) + 1)) GRID_BAR(); C.refresh(); } while (0)
    bf16* XN = (bf16*)(ws + WS_A);
    if (IN(0)) { p0_prologue(C, args); SEAM(0); }
    if (IN(1)) {
        run_gemm(C, XN, (const bf16*)(ws + WS_WIN_T), MTOK, NZ1, DM, FStore{(bf16*)(ws + WS_Z1), NZ1});
        run_gemm(C, (const bf16*)(ws + WS_MEMN), (const bf16*)(ws + WS_WMKV_T), MROWS, 512, DM, FKvm{(bf16*)(ws + WS_KM), (bf16*)(ws + WS_VT)});
        SEAM(1);
    }
    if (IN(2)) {
        { const int tile = C.vcu;
            _Pragma("unroll 1") for (int h = 0; h < 4; ++h) r1_unit(C, args, tile, h);
            _Pragma("unroll 1") for (int gi = 0; gi < 2; ++gi) s5a_wave(C, args, tile, C.wave + 8 * gi);
            _Pragma("unroll 1") for (int gi = 0; gi < 2; ++gi) ma_wave(C, args, tile, 2 * gi + (C.wave >> 2), C.wave & 3);
            __syncthreads();
        }
        SEAM(2);
    }
    if (IN(3)) { p3_scans(C, args); SEAM(3); }
    if (IN(4)) {
        { const int tile = C.vcu;
            _Pragma("unroll 1") for (int gi = 0; gi < 2; ++gi) r3_wave(C, args, tile, 2 * gi + (C.wave >> 2), C.wave & 3);
            _Pragma("unroll 1") for (int gi = 0; gi < 2; ++gi) s5c_wave(C, args, tile, C.wave + 8 * gi);
        }
        SEAM(4);
    }
    if (IN(5)) {
        run_gemm(C, XN, (const bf16*)(ws + WS_WIN_T) + (size_t)NZ1 * DM, MTOK, NGATE, DM, FSig{(bf16*)(ws + WS_G), NGATE});
        run_gemm(C, (const bf16*)(ws + WS_YG), (const bf16*)(ws + WS_WGLU_T), MTOK, 512, 256, FGlu{(bf16*)(ws + WS_SSM)});
        SEAM(5);
    }
    if (IN(6)) {
        const bf16* Gt = (const bf16*)(ws + WS_G);
        run_gemm(C, (const bf16*)(ws + WS_RET), (const bf16*)(ws + WS_WBR_T), MTOK, DM, 512, FBranch<0>{Gt, 0, args.out, XN});
        run_gemm(C, (const bf16*)(ws + WS_SSM), (const bf16*)(ws + WS_WBS_T), MTOK, DM, 256, FBranch<1>{Gt, 1024, args.out, XN});
        run_gemm(C, (const bf16*)(ws + WS_MATTN), (const bf16*)(ws + WS_WBM_T), MTOK, DM, 256, FBranch<2>{Gt, 2048, args.out, XN});
        SEAM(6);
    }
    if (IN(7)) { run_gemm(C, XN, (const bf16*)(ws + WS_WOUT_T), MTOK, DM, DM, FRes{(const float*)args.in[0], args.out}); SEAM(7); }
    if (IN(8)) {
        const int gw = C.vcu * NWAVES + C.wave, NGW = C.G * NWAVES;
        for (int m = gw; m < MTOK; m += NGW) rms_row_to_bf16(args.out + (size_t)m * DM, (const float*)args.in[20], (bf16*)(ws + WS_N2) + (size_t)m * DM, C.lane);
        SEAM(8);
    }
    if (IN(9)) { run_gemm(C, (const bf16*)(ws + WS_N2), (const bf16*)(ws + WS_WQ_T), MTOK, 2048, DM, FStore{(bf16*)(ws + WS_Q2), 2048}); SEAM(9); }
    if (IN(10)) {
        { const int tile = C.vcu;
            const int tokbase = tile * 128 + (C.wave & 3) * 32, h0 = (C.wave >> 2) * 4;
            _Pragma("unroll 1") for (int hp = h0; hp < h0 + 4; ++hp) peer_topk_head(C, args, tokbase, hp);
            VM_WAIT(); __syncthreads();
            _Pragma("unroll 1") for (int ti = 0; ti < 16; ++ti) peer_token(args, tile * 128 + C.wave * 16 + ti, C.lane);
            __syncthreads();
        }
    }
#undef IN
#undef SEAM
}

extern "C" void kernel_launch(void* const* d_in, const int* in_sizes, int n_in, void* d_out, int out_size, void* d_ws, size_t ws_size, hipStream_t stream) {
    static int grid = 0;
    if (grid == 0) {
        if (n_in != 26 || in_sizes[0] != MTOK * DM || out_size != MTOK * DM || ws_size < WS_END) {
            fprintf(stderr, "kernel_launch: unexpected problem (n_in %d, in0 %d, out %d, ws %zu < %zu); nothing launched\n", n_in, n_in > 0 ? in_sizes[0] : -1, out_size, ws_size, (size_t)WS_END); grid = -1; return; }
        int dev = 0, cus = 0;
        if (hipGetDevice(&dev) != hipSuccess || hipDeviceGetAttribute(&cus, hipDeviceAttributeMultiprocessorCount, dev) != hipSuccess) { grid = -1; return; }
        if (hipFuncSetAttribute((const void*)mk_fwd, hipFuncAttributeMaxDynamicSharedMemorySize, LDS_BYTES) != hipSuccess) { fprintf(stderr, "kernel_launch: hipFuncSetAttribute failed\n"); grid = -1; return; }
        (void)hipGetLastError();
        if (cus < NTILES) { fprintf(stderr, "kernel_launch: needs >= 256 CUs, got %d\n", cus); grid = -1; return; }
        grid = NTILES;
    }
    if (grid < 0) return;
    (void)hipMemsetAsync((char*)d_ws + WS_CTL, 0, CTL_ZERO_BYTES, stream);
    Args a{};
    for (int i = 0; i < 26; ++i) a.in[i] = d_in[i];
    a.out = (float*)d_out; a.ws = (unsigned char*)d_ws;
#if MK_PER_PHASE
    for (int p = 0; p < NPHASE; ++p) { a.ph_lo = p; a.ph_hi = p + 1; hipLaunchKernelGGL(mk_fwd, dim3(grid), dim3(NWAVES * 64), LDS_BYTES, stream, a); }
#else
    a.ph_lo = 0; a.ph_hi = NPHASE;
    hipLaunchKernelGGL(mk_fwd, dim3(grid), dim3(NWAVES * 64), LDS_BYTES, stream, a);
#endif
}
```

```cpp
#include <hip/hip_runtime.h>
#include <cstdio>
#include <cstdint>
namespace pg8 {
__device__ __forceinline__ int hw_lane_id() { int l; asm volatile("v_mbcnt_lo_u32_b32 %0, -1, 0\n\tv_mbcnt_hi_u32_b32 %0, -1, %0" : "=v"(l)); return l; }
#define PG8_LAS __attribute__((address_space(3)))
typedef unsigned short bf16_t;
typedef short bf16x8 __attribute__((ext_vector_type(8)));
typedef float f32x4 __attribute__((ext_vector_type(4)));
typedef unsigned u32x4 __attribute__((ext_vector_type(4)));
constexpr int BM = 256, BK = 64, HALF = 128, HTB = HALF * BK * 2  , STAGE_BYTES = 8 * HTB, NXCD = 8, WGM = 8;

__host__ __device__ __forceinline__ int lds_byte(int r, int c) { const int st = (r >> 4) * 2 + (c >> 5), rr = r & 15, cc = c & 31, ob = rr * 64 + cc * 2; return st * 1024 + (ob ^ (((ob >> 9) & 1) << 5)); }
__host__ __device__ __forceinline__ void stage_rc(int b, int& R, int& C) { const int st = b / 1024, sb = b % 1024, swz = sb ^ (((sb >> 9) & 1) << 5); R = (st >> 1) * 16 + swz / 64; C = (st & 1) * 32 + (swz % 64) / 2; }
__host__ __device__ __forceinline__ int perm32(int rho) { const int n = rho >> 4, i = rho & 15; return 8 * (i >> 2) + 4 * n + (i & 3); }

struct Unit { int pm, pn; };
struct Gemm { const bf16_t* A; const bf16_t* Bt; int M, N, K; };

struct StaticOrder {
    int nM, nN, nwg, G, c;
    __host__ __device__ void init(int M, int N, int G_, int c_) { nM = M / BM; nN = N / BM; nwg = nM * nN; G = G_; c = c_; }
    __host__ __device__ bool next(int i, Unit& u) const {
        const long L = (long)i * G + c; if (L >= nwg) return false;
        int wgid = (int)L; { const int q = nwg / NXCD, r = nwg % NXCD, xcd = wgid % NXCD, off = wgid / NXCD; wgid = (xcd < r ? xcd * (q + 1) : r * (q + 1) + (xcd - r) * q) + off; }
        const int nig = WGM * nN, gid = wgid / nig, fm = gid * WGM, gsz = (nM - fm) < WGM ? (nM - fm) : WGM;
        u.pm = fm + ((wgid % nig) % gsz); u.pn = (wgid % nig) / gsz; return true;
    }
    __device__ __forceinline__ void a_ready(const Unit&) const {}
    __device__ __forceinline__ void done(const Unit&) const {}
};

__device__ __forceinline__ unsigned cvt_pk_bf16(float lo, float hi) { unsigned r; asm volatile("v_cvt_pk_bf16_f32 %0, %1, %2" : "=v"(r) : "v"(lo), "v"(hi)); return r; }
template <class Epi, class Sched, bool ALIGN_EPI = false, bool SP2 = false>
__device__ __forceinline__ void gemm_phase(PG8_LAS unsigned char* lds, const Gemm g, const Sched& S, const Epi& E, const int wid) {
    const int lane = hw_lane_id(), tid = wid * 64 + lane, wr = wid >> 2, wc = wid & 3, fr = lane & 15, fq = lane >> 4;
    const int K = g.K, nt = K / BK;
    unsigned voffA[2], voffB[2];
#pragma unroll
    for (int i = 0; i < 2; ++i) { int R, C; stage_rc(tid * 16 + i * 8192, R, C); const int Rb = Epi::PERM ? ((R & ~31) + perm32(R & 31)) : R;
        voffA[i] = (unsigned)(R * K + C) * 2u; voffB[i] = (unsigned)(Rb * K + C) * 2u; }
    const size_t kstep = (size_t)(BK * 2);
    const size_t hstep = (size_t)HALF * K * 2;
    const size_t tstep = 2 * hstep;
    const unsigned ldsw = (unsigned)wid * 1024u;
    const int aoff = lds_byte(wr * 64 + fr, fq * 8), boff = lds_byte(wc * 32 + fr, fq * 8);
#define PG8_SA(b, h) (((b) * 2 + (h)) * HTB)
#define PG8_SB(b, h) ((4 + (b) * 2 + (h)) * HTB)
#define PG8_STAGE(bufoff, gbase, voff) do { _Pragma("unroll") for (int _i = 0; _i < 2; ++_i) \
        __builtin_amdgcn_global_load_lds((const unsigned*)((const char*)(gbase) + (voff)[_i]), (PG8_LAS unsigned*)(lds + (bufoff) + ldsw + _i * 8192), 16, 0, 0); } while (0)
#define PG8_LDA(dst, b, h) do { _Pragma("unroll") for (int m = 0; m < 4; ++m) _Pragma("unroll") for (int k = 0; k < 2; ++k) dst[m][k] = *(const PG8_LAS bf16x8*)(lds + PG8_SA(b, h) + aoff + m * 2048 + k * 1024); } while (0)
#define PG8_LDB(dst, b, h) do { _Pragma("unroll") for (int n = 0; n < 2; ++n) _Pragma("unroll") for (int k = 0; k < 2; ++k) dst[n][k] = *(const PG8_LAS bf16x8*)(lds + PG8_SB(b, h) + boff + n * 2048 + k * 1024); } while (0)
#define PG8_MMA(ai, bj, At, Bt) do { __builtin_amdgcn_s_setprio(1); _Pragma("unroll") for (int m = 0; m < 4; ++m) _Pragma("unroll") for (int n = 0; n < 2; ++n) _Pragma("unroll") for (int k = 0; k < 2; ++k) \
        acc[ai][bj][m][n] = __builtin_amdgcn_mfma_f32_16x16x32_bf16(Bt[n][k], At[m][k], acc[ai][bj][m][n], 0, 0, 0); __builtin_amdgcn_s_setprio(0); } while (0)
#define PG8_WAIT_V(n) asm volatile("s_waitcnt vmcnt(" #n ")" ::: "memory")
#define PG8_WAIT_L(n) asm volatile("s_waitcnt lgkmcnt(" #n ")" ::: "memory")
#define PG8_BAR __builtin_amdgcn_s_barrier()
#define PG8_SCHED __builtin_amdgcn_sched_barrier(0)
    Unit cur, nxt; int ui = 0;
    if (!S.next(0, cur)) return;
    f32x4 acc[2][2][4][2];
#pragma unroll
    for (int a = 0; a < 2; ++a)
#pragma unroll
        for (int b = 0; b < 2; ++b)
#pragma unroll
            for (int m = 0; m < 4; ++m)
#pragma unroll
                for (int n = 0; n < 2; ++n) acc[a][b][m][n] = (f32x4){0.f, 0.f, 0.f, 0.f};
    bf16x8 At[4][2], B0[2][2], B1[2][2];
    const char* cA = (const char*)g.A + (size_t)cur.pm * tstep; const char* cB = (const char*)g.Bt + (size_t)cur.pn * tstep;
    S.a_ready(cur);
    if constexpr (SP2) {
        PG8_STAGE(PG8_SB(0, 0), cB, voffB); PG8_STAGE(PG8_SB(0, 1), cB + hstep, voffB); PG8_STAGE(PG8_SA(0, 0), cA, voffA); PG8_STAGE(PG8_SA(0, 1), cA + hstep, voffA);
        if (wr == 1) PG8_BAR;
        PG8_WAIT_V(2); PG8_BAR;
        PG8_STAGE(PG8_SB(1, 0), cB + kstep, voffB); PG8_STAGE(PG8_SA(1, 0), cA + kstep, voffA); PG8_STAGE(PG8_SB(1, 1), cB + hstep + kstep, voffB);
        PG8_WAIT_V(6); PG8_BAR;
    } else {
        PG8_STAGE(PG8_SB(0, 0), cB, voffB); PG8_STAGE(PG8_SA(0, 0), cA, voffA); PG8_STAGE(PG8_SB(0, 1), cB + hstep, voffB); PG8_STAGE(PG8_SA(0, 1), cA + hstep, voffA);
        if (wr == 1) PG8_BAR;
        PG8_WAIT_V(4); PG8_BAR;
        PG8_STAGE(PG8_SB(1, 0), cB + kstep, voffB); PG8_STAGE(PG8_SA(1, 0), cA + kstep, voffA); PG8_STAGE(PG8_SB(1, 1), cB + hstep + kstep, voffB);
        PG8_WAIT_V(6); PG8_BAR;
    }
    for (;;) {
        const bool has_next = S.next(ui + 1, nxt);
        const char* nA = has_next ? (const char*)g.A + (size_t)nxt.pm * tstep : cA; const char* nB = has_next ? (const char*)g.Bt + (size_t)nxt.pn * tstep : cB;
        for (int t = 0; t < nt; t += 2) {
            const bool last = (t == nt - 2);
            const char* a1 = cA + (size_t)(t + 1) * kstep;
            const char* a2 = last ? nA : cA + (size_t)(t + 2) * kstep; const char* b2 = last ? nB : cB + (size_t)(t + 2) * kstep;
            const char* a3 = a2 + kstep; const char* b3 = b2 + kstep;
            if (last && has_next) S.a_ready(nxt);
            if constexpr (SP2) {
            PG8_LDB(B0, 0, 0); PG8_LDB(B1, 0, 1); PG8_SCHED; PG8_LDA(At, 0, 0); PG8_STAGE(PG8_SA(1, 1), a1 + hstep, voffA);
            PG8_WAIT_V(8); PG8_WAIT_L(0); PG8_BAR; PG8_MMA(0, 0, At, B0); PG8_MMA(0, 1, At, B1); PG8_BAR; PG8_SCHED;
            PG8_LDA(At, 0, 1); PG8_STAGE(PG8_SB(0, 0), b2, voffB); PG8_STAGE(PG8_SB(0, 1), b2 + hstep, voffB); PG8_STAGE(PG8_SA(0, 0), a2, voffA);
            PG8_WAIT_V(8); PG8_WAIT_L(0); PG8_BAR; PG8_MMA(1, 0, At, B0); PG8_MMA(1, 1, At, B1); PG8_BAR; PG8_SCHED;
            PG8_LDB(B0, 1, 0); PG8_LDB(B1, 1, 1); PG8_SCHED; PG8_LDA(At, 1, 0); PG8_STAGE(PG8_SA(0, 1), a2 + hstep, voffA);
            PG8_WAIT_V(8); PG8_WAIT_L(0); PG8_BAR; PG8_MMA(0, 0, At, B0); PG8_MMA(0, 1, At, B1); PG8_BAR; PG8_SCHED;
            PG8_LDA(At, 1, 1); PG8_STAGE(PG8_SB(1, 0), b3, voffB); PG8_STAGE(PG8_SB(1, 1), b3 + hstep, voffB); PG8_STAGE(PG8_SA(1, 0), a3, voffA);
            PG8_WAIT_V(8); PG8_WAIT_L(0); PG8_BAR; PG8_MMA(1, 0, At, B0); PG8_MMA(1, 1, At, B1); PG8_BAR; PG8_SCHED;
            } else {
            PG8_LDB(B0, 0, 0); PG8_SCHED; PG8_LDA(At, 0, 0); PG8_STAGE(PG8_SA(1, 1), a1 + hstep, voffA);
            PG8_WAIT_L(8); PG8_BAR; PG8_WAIT_L(0); PG8_MMA(0, 0, At, B0); PG8_BAR; PG8_SCHED;
            PG8_LDB(B1, 0, 1); PG8_STAGE(PG8_SB(0, 0), b2, voffB);
            PG8_BAR; PG8_WAIT_L(0); PG8_MMA(0, 1, At, B1); PG8_BAR;
            PG8_LDA(At, 0, 1); PG8_STAGE(PG8_SA(0, 0), a2, voffA);
            PG8_BAR; PG8_WAIT_L(0); PG8_MMA(1, 0, At, B0); PG8_BAR; PG8_SCHED;
            PG8_STAGE(PG8_SB(0, 1), b2 + hstep, voffB);
            PG8_WAIT_V(6); PG8_BAR; PG8_MMA(1, 1, At, B1); PG8_BAR;
            PG8_LDB(B0, 1, 0); PG8_SCHED; PG8_LDA(At, 1, 0); PG8_STAGE(PG8_SA(0, 1), a2 + hstep, voffA);
            PG8_WAIT_L(8); PG8_BAR; PG8_WAIT_L(0); PG8_MMA(0, 0, At, B0); PG8_BAR; PG8_SCHED;
            PG8_LDB(B1, 1, 1); PG8_STAGE(PG8_SB(1, 0), b3, voffB);
            PG8_BAR; PG8_WAIT_L(0); PG8_MMA(0, 1, At, B1); PG8_BAR;
            PG8_LDA(At, 1, 1); PG8_STAGE(PG8_SA(1, 0), a3, voffA);
            PG8_BAR; PG8_WAIT_L(0); PG8_MMA(1, 0, At, B0); PG8_BAR; PG8_SCHED;
            PG8_STAGE(PG8_SB(1, 1), b3 + hstep, voffB);
            PG8_WAIT_V(6); PG8_BAR; PG8_MMA(1, 1, At, B1); PG8_BAR;
            }
        }
        if constexpr (ALIGN_EPI) { if (wr == 0) PG8_BAR; }
        if constexpr (!Epi::AFTER_DRAIN) { E(acc, cur, wr, wc, fr, fq); S.done(cur); }
        if (!has_next) break;
#pragma unroll
        for (int a = 0; a < 2; ++a)
#pragma unroll
            for (int b = 0; b < 2; ++b)
#pragma unroll
                for (int m = 0; m < 4; ++m)
#pragma unroll
                    for (int n = 0; n < 2; ++n) acc[a][b][m][n] = (f32x4){0.f, 0.f, 0.f, 0.f};
        cur = nxt; cA = nA; cB = nB; ++ui;
        if constexpr (ALIGN_EPI) { if (wr == 1) PG8_BAR; }
    }
    PG8_WAIT_V(0);
    if constexpr (!ALIGN_EPI) { if (wr == 0) PG8_BAR; }
    PG8_BAR;
    if constexpr (Epi::AFTER_DRAIN) { E.fused(acc, cur, wr, wc, fr, fq, lds, wid, lane); S.done(cur); }
#undef PG8_SA
#undef PG8_SB
#undef PG8_STAGE
#undef PG8_LDA
#undef PG8_LDB
#undef PG8_MMA
#undef PG8_WAIT_V
#undef PG8_WAIT_L
#undef PG8_BAR
#undef PG8_SCHED
}
}

#ifndef REPEAT_MASK
#define REPEAT_MASK 0
#endif
#ifndef MK_PER_PHASE
#define MK_PER_PHASE 0
#endif

constexpr int DM = 1024, BATCH = 8, SEQ = 4096, MTOK = BATCH * SEQ;
constexpr int MEMLEN = 256, MROWS = BATCH * MEMLEN;
constexpr int NZ1 = 2560, NGATE = 3072;
constexpr int ZQ = 0, ZK = 512, ZV = 1024, ZGR = 1536, ZU = 2048, ZQM = 2304;
constexpr int NTILES = MTOK / 128;
constexpr float EPS = 1e-6f;
constexpr int NPHASE = 11;

constexpr size_t MiB = 1u << 20;
constexpr size_t WS_CTL = 0, CTL_ZERO_BYTES = 1 * MiB;
constexpr size_t WS_WIN_T = 1 * MiB;
constexpr size_t WS_WQ_T = 12 * MiB;
constexpr size_t WS_WOUT_T = 16 * MiB;
constexpr size_t WS_WBR_T = 18 * MiB;
constexpr size_t WS_WBS_T = 19 * MiB;
constexpr size_t WS_WBM_T = 19 * MiB + 512 * 1024;
constexpr size_t WS_WGLU_T = 20 * MiB;
constexpr size_t WS_WMKV_T = 21 * MiB;
constexpr size_t WS_KEYS = 22 * MiB;
constexpr size_t WS_S5MAT = 23 * MiB;
constexpr size_t WS_S5C = 25 * MiB;
constexpr size_t WS_PSC = 25 * MiB + 256 * 1024;
constexpr size_t WS_ROPE = 26 * MiB;
constexpr size_t WS_PU = 42 * MiB;
constexpr size_t WS_PV = 74 * MiB;
constexpr size_t WS_MEMN = 106 * MiB;
constexpr size_t WS_KM = 110 * MiB;
constexpr size_t WS_VT = 111 * MiB;
constexpr size_t WS_S5E = 112 * MiB;
constexpr size_t WS_S5X = 114 * MiB;
constexpr size_t WS_A = 116 * MiB;
constexpr size_t WS_B = 180 * MiB;
constexpr size_t WS_Z1 = WS_B;
constexpr size_t WS_G = WS_B;
constexpr size_t WS_RET = WS_B + 192 * MiB;
constexpr size_t WS_SSM = WS_B + 224 * MiB;
constexpr size_t WS_MATTN = WS_B + 240 * MiB;
constexpr size_t WS_YG = WS_B + 256 * MiB;
constexpr size_t WS_INNER = WS_B + 272 * MiB;
constexpr size_t WS_N2 = WS_B;
constexpr size_t WS_Q2 = WS_B + 64 * MiB;
constexpr size_t WS_IDX = WS_B + 192 * MiB;
constexpr size_t WS_WGT = WS_B + 208 * MiB;
constexpr size_t WS_END = WS_B + 304 * MiB;

constexpr int CW_BAR = 4096;

constexpr int LDS_BYTES = 147456;
constexpr int MISC_OFF = LDS_BYTES - 512;
constexpr int NWAVES = 8;

#define GAS __attribute__((address_space(1)))
#define LAS __attribute__((address_space(3)))
typedef unsigned short bf16;
typedef unsigned v4u __attribute__((ext_vector_type(4)));
typedef unsigned v2u __attribute__((ext_vector_type(2)));
typedef float f32x4 __attribute__((ext_vector_type(4)));
typedef float f32x16 __attribute__((ext_vector_type(16)));
typedef short bf16x8 __attribute__((ext_vector_type(8)));
typedef GAS unsigned gu32;
#define RLX_AGENT __ATOMIC_RELAXED, __HIP_MEMORY_SCOPE_AGENT
#define LDS_WAIT() asm volatile("s_waitcnt lgkmcnt(0)" ::: "memory")
#define VM_WAIT() asm volatile("s_waitcnt vmcnt(0)" ::: "memory")
__device__ __forceinline__ unsigned f2bf(float f) { unsigned u = __builtin_bit_cast(unsigned, f); return (u + 0x7fffu + ((u >> 16) & 1u)) >> 16; }
__device__ __forceinline__ unsigned pk2(float lo, float hi) { return f2bf(lo) | (f2bf(hi) << 16); }
__device__ __forceinline__ float bflo(unsigned w) { return __builtin_bit_cast(float, w << 16); }
__device__ __forceinline__ float bfhi(unsigned w) { return __builtin_bit_cast(float, w & 0xffff0000u); }
__device__ __forceinline__ float bf2f(bf16 h) { return __builtin_bit_cast(float, (unsigned)h << 16); }
__device__ __forceinline__ f32x16 mfma32(bf16x8 a, bf16x8 b, f32x16 c) { return __builtin_amdgcn_mfma_f32_32x32x16_bf16(a, b, c, 0, 0, 0); }
__device__ __forceinline__ f32x4 mfma16(bf16x8 a, bf16x8 b, f32x4 c) { return __builtin_amdgcn_mfma_f32_16x16x32_bf16(a, b, c, 0, 0, 0); }
__device__ __forceinline__ bf16x8 mk8(unsigned a, unsigned b, unsigned c, unsigned d) { v4u t = {a, b, c, d}; return __builtin_bit_cast(bf16x8, t); }
__device__ __forceinline__ float sigmoidf_(float x) { return 1.0f / (1.0f + __expf(-x)); }
__device__ __forceinline__ float gelu_tanh(float x) {
    const float u = 0.7978845608028654f * (x + 0.044715f * x * x * x);
    const float e = __expf(2.0f * u);
    const float th = 1.0f - 2.0f / (e + 1.0f);
    return 0.5f * x * (1.0f + th);
}
__device__ __forceinline__ float wave_sum(float v) {
#pragma unroll
    for (int o = 1; o < 64; o <<= 1) v += __shfl_xor(v, o);
    return v;
}

#define XB_TMO      128
#define XB_XCNT(j)  (256  + 64 * (j))
#define XB_XSUB(j)  (1280 + 64 * (j))
#define XB_XGEN(j)  (2304 + 64 * (j))
#define XB_TOP      3328
#define XB_TOPGEN   3392
#define XCD_BAR_WORDS 3456
#define XB_SPIN_CAP (1u << 22)

__device__ __forceinline__ unsigned xb_ld(unsigned* p)              { return __hip_atomic_load(p, __ATOMIC_RELAXED, __HIP_MEMORY_SCOPE_AGENT); }
__device__ __forceinline__ unsigned xb_add(unsigned* p, unsigned v) { return __hip_atomic_fetch_add(p, v, __ATOMIC_RELAXED, __HIP_MEMORY_SCOPE_AGENT); }
__device__ __forceinline__ unsigned xb_xcc_id() { return (unsigned)__builtin_amdgcn_s_getreg((3 << 11) | 20) & 0xFu; }
#define XB_SPIN(cond, bar) do { unsigned _sp = 0; while (cond) { __builtin_amdgcn_s_sleep(1); \
    if ((++_sp & 255u) == 0u) { if (xb_ld(&(bar)[XB_TMO])) break; if (_sp > XB_SPIN_CAP) { atomicAdd(&(bar)[XB_TMO], 1u); break; } } } } while (0)

struct XcdBarrier { unsigned* bar; unsigned x; volatile LAS unsigned* st; };

__device__ __forceinline__ XcdBarrier xcd_barrier_post(unsigned* bar, volatile LAS unsigned* st, bool tid0) {
    XcdBarrier b; b.bar = bar; b.x = xb_xcc_id(); b.st = st;
    if (tid0) (void)xb_add(&bar[XB_XCNT(b.x)], 1u);
    return b;
}
__device__ __forceinline__ void xcd_barrier_complete(unsigned* bar, unsigned x, unsigned& nloc, unsigned& nx) {
    const unsigned G = gridDim.x * gridDim.y * gridDim.z;
    unsigned sum, cnt, mine, sp = 0u;
    for (;;) {
        sum = 0u; cnt = 0u; mine = 0u;
#pragma unroll
        for (unsigned j = 0; j < 16; ++j) { const unsigned c = xb_ld(&bar[XB_XCNT(j)]); sum += c; cnt += (c > 0u) ? 1u : 0u; mine = (j == x) ? c : mine; }
        if (sum == G) break;
        __builtin_amdgcn_s_sleep(1);
        if ((++sp & 255u) == 0u) { if (xb_ld(&bar[XB_TMO])) break; if (sp > XB_SPIN_CAP) { atomicAdd(&bar[XB_TMO], 1u); break; } }
    }
    nloc = mine > 0u ? mine : 1u; nx = cnt > 0u ? cnt : 1u;
}
__device__ __forceinline__ void xcd_barrier(const XcdBarrier& b, int wave) {
    asm volatile("s_waitcnt vmcnt(0)" ::: "memory");
    __syncthreads();
    if (wave == 0 && pg8::hw_lane_id() == 0) {
        unsigned* bar = b.bar;
        __builtin_amdgcn_s_waitcnt(0);
        unsigned nloc = b.st[0], nx = b.st[1];
        if (nloc == 0u) { xcd_barrier_complete(bar, b.x, nloc, nx); b.st[0] = nloc; b.st[1] = nx; }
        const unsigned old = xb_add(&bar[XB_XSUB(b.x)], 1u);
        const unsigned gen = old / nloc;
        if (old + 1u == (gen + 1u) * nloc) {
            __builtin_amdgcn_fence(__ATOMIC_RELEASE, "agent");
            asm volatile("s_waitcnt vmcnt(0)" ::: "memory");
            const unsigned og = xb_add(&bar[XB_TOP], 1u);
            const unsigned tg = og / nx;
            if (og + 1u == (tg + 1u) * nx) xb_add(&bar[XB_TOPGEN], 1u);
            else XB_SPIN(xb_ld(&bar[XB_TOPGEN]) == tg, bar);
            __builtin_amdgcn_fence(__ATOMIC_ACQUIRE, "agent");
            xb_add(&bar[XB_XGEN(b.x)], 1u);
            asm volatile("s_waitcnt vmcnt(0)" ::: "memory");
        } else {
            XB_SPIN(xb_ld(&bar[XB_XGEN(b.x)]) == gen, bar);
            __builtin_amdgcn_fence(__ATOMIC_ACQUIRE, "agent");
            asm volatile("s_waitcnt vmcnt(0)" ::: "memory");
        }
    }
    __syncthreads();
}

struct Args { const void* in[26]; float* out; unsigned char* ws; int ph_lo, ph_hi; };
struct Ctx {
    LAS unsigned char* lds;
    int tid, lane, wave, vcu, G;
    __device__ __forceinline__ void refresh() { lane = pg8::hw_lane_id(); tid = wave * 64 + lane; }
};

template <class F> struct EpiT {
    static constexpr bool PERM = true, AFTER_DRAIN = false;
    F f;
    __device__ __forceinline__ void operator()(const f32x4 (&acc)[2][2][4][2], const pg8::Unit& u, int wr, int wc, int fr, int fq) const {
        const int row0 = u.pm * 256 + wr * 64 + fr, col0 = u.pn * 256 + wc * 32 + 8 * fq;
#pragma unroll
        for (int ai = 0; ai < 2; ++ai)
#pragma unroll
            for (int m = 0; m < 4; ++m) {
#pragma unroll
                for (int bj = 0; bj < 2; ++bj) f(row0 + ai * 128 + m * 16, col0 + bj * 128, acc[ai][bj][m][0], acc[ai][bj][m][1]);
                __builtin_amdgcn_sched_barrier(0);
            }
    }
};
__device__ __forceinline__ v4u pack8(f32x4 a, f32x4 b) { v4u w; w.x = pk2(a[0], a[1]); w.y = pk2(a[2], a[3]); w.z = pk2(b[0], b[1]); w.w = pk2(b[2], b[3]); return w; }
struct FStore { bf16* O; int ldc;
    __device__ __forceinline__ void operator()(int row, int col, f32x4 v0, f32x4 v1) const { *(v4u*)(O + (size_t)row * ldc + col) = pack8(v0, v1); } };
struct FKvm { bf16* KM; bf16* VT;
    __device__ __forceinline__ void operator()(int row, int col, f32x4 v0, f32x4 v1) const {
        if (col < 256) { *(v4u*)(KM + (size_t)row * 256 + col) = pack8(v0, v1); }
        else { const int c = col - 256, b = row >> 8, m = row & 255; bf16* p = VT + ((size_t)(b * 256 + c)) * 256 + m;
#pragma unroll
            for (int j = 0; j < 4; ++j) { p[(size_t)j * 256] = (bf16)f2bf(v0[j]); p[(size_t)(j + 4) * 256] = (bf16)f2bf(v1[j]); } }
    } };
struct FSig { bf16* O; int ldc;
    __device__ __forceinline__ void operator()(int row, int col, f32x4 v0, f32x4 v1) const {
#pragma unroll
        for (int j = 0; j < 4; ++j) { v0[j] = sigmoidf_(v0[j]); v1[j] = sigmoidf_(v1[j]); }
        *(v4u*)(O + (size_t)row * ldc + col) = pack8(v0, v1); } };
struct FGlu { bf16* O;
    __device__ __forceinline__ void operator()(int row, int col, f32x4 v0, f32x4 v1) const {
        v2u w; w.x = pk2(v0[0] * sigmoidf_(v1[0]), v0[1] * sigmoidf_(v1[1])); w.y = pk2(v0[2] * sigmoidf_(v1[2]), v0[3] * sigmoidf_(v1[3]));
        *(v2u*)(O + (size_t)row * 256 + (col >> 1)) = w; } };
template <int MODE> struct FBranch { const bf16* Gt; int goff; float* MF; bf16* MB;
    __device__ __forceinline__ void operator()(int row, int col, f32x4 v0, f32x4 v1) const {
        const v4u g = *(const v4u*)(Gt + (size_t)row * NGATE + goff + col);
        v0[0] *= bflo(g.x); v0[1] *= bfhi(g.x); v0[2] *= bflo(g.y); v0[3] *= bfhi(g.y);
        v1[0] *= bflo(g.z); v1[1] *= bfhi(g.z); v1[2] *= bflo(g.w); v1[3] *= bfhi(g.w);
        float* mp = MF + (size_t)row * DM + col;
        if (MODE >= 1) { v0 += *(const f32x4*)mp; v1 += *(const f32x4*)(mp + 4); }
        if (MODE <= 1) { *(f32x4*)mp = v0; *(f32x4*)(mp + 4) = v1; }
        else *(v4u*)(MB + (size_t)row * DM + col) = pack8(v0, v1); } };
struct FRes { const float* X; float* H;
    __device__ __forceinline__ void operator()(int row, int col, f32x4 v0, f32x4 v1) const {
        const float* xp = X + (size_t)row * DM + col; float* hp = H + (size_t)row * DM + col;
        *(f32x4*)hp = *(const f32x4*)xp + v0; *(f32x4*)(hp + 4) = *(const f32x4*)(xp + 4) + v1; } };

template <class F>
__device__ __forceinline__ void run_gemm(const Ctx& C, const bf16* A, const bf16* Bt, int M, int N, int K, const F& f) {
    pg8::Gemm g{A, Bt, M, N, K}; pg8::StaticOrder S; S.init(M, N, C.G, (int)blockIdx.x);
    EpiT<F> E{f};
    pg8::gemm_phase<EpiT<F>, pg8::StaticOrder, true, true>(C.lds, g, S, E, C.wave);
}

template <bool GLU>
__device__ __forceinline__ void p0_transpose_item(const float* W, int K, int N, bf16* WT, LAS float* scr, int item, int lane) {
    const int nblk = N / 32, kb = item / nblk, nb = item % nblk, k0 = 64 * kb, n0 = 32 * nb;
#pragma unroll 8
    for (int i = 0; i < 32; ++i) { const int kk = 2 * i + (lane >> 5); scr[kk * 33 + (lane & 31)] = W[(size_t)(k0 + kk) * N + n0 + (lane & 31)]; }
    LDS_WAIT(); asm volatile("" ::: "memory");
    const int c = lane & 7;
#pragma unroll
    for (int j = 0; j < 4; ++j) { const int n = (lane >> 3) + 8 * j; const LAS float* s = scr + (8 * c) * 33 + n;
        v4u o; o.x = pk2(s[0 * 33], s[1 * 33]); o.y = pk2(s[2 * 33], s[3 * 33]); o.z = pk2(s[4 * 33], s[5 * 33]); o.w = pk2(s[6 * 33], s[7 * 33]);
        const int nn = n0 + n; int row = nn;
        if (GLU) { const int jc = nn & 255, gate = nn >> 8; row = 8 * (jc >> 2) + 4 * gate + (jc & 3); }
        *(GAS v4u*)(WT + (size_t)row * K + k0 + 8 * c) = o; }
    LDS_WAIT(); asm volatile("" ::: "memory");
}
__device__ __forceinline__ void rms_row_to_bf16(const float* xrow, const float* gain, bf16* orow, int lane) {
    const f32x4* xr = (const f32x4*)xrow + lane; const f32x4* gr = (const f32x4*)gain + lane;
    f32x4 v[4]; float s = 0.f;
#pragma unroll
    for (int j = 0; j < 4; ++j) { v[j] = xr[64 * j]; s += (v[j].x * v[j].x + v[j].y * v[j].y) + (v[j].z * v[j].z + v[j].w * v[j].w); }
    const float rstd = 1.0f / sqrtf(wave_sum(s) * (1.f / DM) + EPS);
    unsigned long long* o8 = (unsigned long long*)orow + lane;
#pragma unroll
    for (int j = 0; j < 4; ++j) { const f32x4 g = gr[64 * j];
        o8[64 * j] = (unsigned long long)pk2(v[j].x * rstd * g.x, v[j].y * rstd * g.y) | ((unsigned long long)pk2(v[j].z * rstd * g.z, v[j].w * rstd * g.w) << 32); }
}

__device__ __forceinline__ void p0_s5_group(const Ctx& C, const Args& a, int g) {
    const float* a_re = (const float*)a.in[7]; const float* a_im = (const float*)a.in[8]; const float* log_dt = (const float*)a.in[9];
    const float* b_re = (const float*)a.in[10]; const float* b_im = (const float*)a.in[11]; const float* c_re = (const float*)a.in[12]; const float* c_im = (const float*)a.in[13];
    LAS float* L = (LAS float*)C.lds;
    LAS float* lpr = L;
    LAS float* lpi = L + 9 * 64;
    LAS float* bbr = L + 1152;
    LAS float* bbi = bbr + 1024;
    LAS float* ccr = bbi + 1024;
    LAS float* cci = ccr + 1024;
    LAS float* Kj = cci + 1024;
    const int tid = C.tid;
    bf16* T8T = (bf16*)(a.ws + WS_S5MAT) + (size_t)g * 16384;
    bf16* PMT = (bf16*)(a.ws + WS_S5MAT) + (size_t)(16 + g) * 16384;
    bf16* QMT = (bf16*)(a.ws + WS_S5MAT) + (size_t)(32 + g) * 16384;
    float* L8 = (float*)(a.ws + WS_S5C) + (size_t)g * 128;
    float* L128 = (float*)(a.ws + WS_S5C) + 2048 + (size_t)g * 128;
    if (tid < 64) {
        const int p = tid;
        const double dt = exp((double)log_dt[g]);
        const double ar = (double)a_re[g * 64 + p], ai = (double)a_im[g * 64 + p];
        for (int j = 0; j <= 8; ++j) { const double mag = exp(ar * dt * j), ang = ai * dt * j; lpr[j * 64 + p] = (float)(mag * cos(ang)); lpi[j * 64 + p] = (float)(mag * sin(ang)); }
        { const double mag = exp(ar * dt * 8.0), ang = ai * dt * 8.0; L8[p * 2] = (float)(mag * cos(ang)); L8[p * 2 + 1] = (float)(mag * sin(ang)); }
        { const double mag = exp(ar * dt * 128.0), ang = ai * dt * 128.0; L128[p * 2] = (float)(mag * cos(ang)); L128[p * 2 + 1] = (float)(mag * sin(ang)); }
        const double lr = exp(ar * dt) * cos(ai * dt), li = exp(ar * dt) * sin(ai * dt);
        const double den = ar * ar + ai * ai, nr = lr - 1.0, ni = li;
        const double cr = (nr * ar + ni * ai) / den, ci = (ni * ar - nr * ai) / den;
        for (int h = 0; h < 16; ++h) { const double br = (double)b_re[(g * 64 + p) * 16 + h], bi = (double)b_im[(g * 64 + p) * 16 + h];
            bbr[p * 16 + h] = (float)(cr * br - ci * bi); bbi[p * 16 + h] = (float)(cr * bi + ci * br); }
    }
    for (int i = tid; i < 1024; i += 512) { ccr[i] = c_re[g * 1024 + i]; cci[i] = c_im[g * 1024 + i]; }
    __syncthreads();
    for (int i = tid; i < 2048; i += 512) {
        const int j = i >> 8, ho = (i >> 4) & 15, hi = i & 15; float s = 0.f;
        for (int p = 0; p < 64; ++p) { const float cr_ = ccr[ho * 64 + p], ci_ = cci[ho * 64 + p], lr_ = lpr[j * 64 + p], li_ = lpi[j * 64 + p];
            const float mr = cr_ * lr_ - ci_ * li_, mi = cr_ * li_ + ci_ * lr_;
            s += mr * bbr[p * 16 + hi] - mi * bbi[p * 16 + hi]; }
        Kj[i] = s;
    }
    __syncthreads();
    for (int i = tid; i < 16384; i += 512) {
        const int n = i >> 7, k = i & 127;
        { const int t = n >> 4, ho = n & 15, s = k >> 4, hi = k & 15; const float v = (s <= t) ? Kj[((t - s) * 16 + ho) * 16 + hi] : 0.f; T8T[i] = (bf16)f2bf(v); }
        { const int p = n & 63, im = n >> 6, s = k >> 4, hi = k & 15; const float lr_ = lpr[(7 - s) * 64 + p], li_ = lpi[(7 - s) * 64 + p], br_ = bbr[p * 16 + hi], bi_ = bbi[p * 16 + hi];
          const float v = im ? (lr_ * bi_ + li_ * br_) : (lr_ * br_ - li_ * bi_); PMT[i] = (bf16)f2bf(v); }
        { const int t = n >> 4, ho = n & 15, p = k & 63, part = k >> 6; const float cr_ = ccr[ho * 64 + p], ci_ = cci[ho * 64 + p], lr_ = lpr[(t + 1) * 64 + p], li_ = lpi[(t + 1) * 64 + p];
          const float v = part ? -(cr_ * li_ + ci_ * lr_) : (cr_ * lr_ - ci_ * li_); QMT[i] = (bf16)f2bf(v); }
    }
    __syncthreads();
}

__device__ __forceinline__ void p0_prologue(const Ctx& C, const Args& a) {
    if (C.vcu < 16) p0_s5_group(C, a, C.vcu);
    LAS float* scr = (LAS float*)(C.lds + C.wave * 16384);
    const int gw = C.vcu * NWAVES + C.wave, NGW = C.G * NWAVES;
    const int gt = C.vcu * 512 + C.tid, NGT = C.G * 512;
    unsigned char* ws = a.ws;
    constexpr int I_IN = 16 * 176, I_Q = 16 * 64, I_O = 16 * 32, I_BR = 8 * 32, I_BS = 4 * 32, I_BM = 4 * 32, I_KV = 16 * 16, I_GLU = 4 * 16;
    constexpr int NITEMS = I_IN + I_Q + I_O + I_BR + I_BS + I_BM + I_KV + I_GLU;
    for (int it = gw; it < NITEMS; it += NGW) {
        int r = it;
        if (r < I_IN) { p0_transpose_item<false>((const float*)a.in[4], 1024, 5632, (bf16*)(ws + WS_WIN_T), scr, r, C.lane); continue; } r -= I_IN;
        if (r < I_Q) { p0_transpose_item<false>((const float*)a.in[21], 1024, 2048, (bf16*)(ws + WS_WQ_T), scr, r, C.lane); continue; } r -= I_Q;
        if (r < I_O) { p0_transpose_item<false>((const float*)a.in[19], 1024, 1024, (bf16*)(ws + WS_WOUT_T), scr, r, C.lane); continue; } r -= I_O;
        if (r < I_BR) { p0_transpose_item<false>((const float*)a.in[16], 512, 1024, (bf16*)(ws + WS_WBR_T), scr, r, C.lane); continue; } r -= I_BR;
        if (r < I_BS) { p0_transpose_item<false>((const float*)a.in[17], 256, 1024, (bf16*)(ws + WS_WBS_T), scr, r, C.lane); continue; } r -= I_BS;
        if (r < I_BM) { p0_transpose_item<false>((const float*)a.in[18], 256, 1024, (bf16*)(ws + WS_WBM_T), scr, r, C.lane); continue; } r -= I_BM;
        if (r < I_KV) { p0_transpose_item<false>((const float*)a.in[6], 1024, 512, (bf16*)(ws + WS_WMKV_T), scr, r, C.lane); continue; } r -= I_KV;
        p0_transpose_item<true>((const float*)a.in[15], 256, 512, (bf16*)(ws + WS_WGLU_T), scr, r, C.lane);
    }
    for (int i = gt; i < 16 * 128 * 128 / 8; i += NGT) { const f32x4 x0 = ((const f32x4*)a.in[22])[2 * (size_t)i], x1 = ((const f32x4*)a.in[22])[2 * (size_t)i + 1]; ((v4u*)(ws + WS_KEYS))[i] = pack8(x0, x1); }
    for (int rw = gw; rw < 2 * 16384; rw += NGW) {
        const int t = rw >> 14, row = rw & 16383;
        const float* src = (const float*)a.in[23 + t] + (size_t)row * DM + C.lane * 16;
        f32x4 v[4]; float mx = 0.f;
#pragma unroll
        for (int q = 0; q < 4; ++q) { v[q] = *(const f32x4*)(src + 4 * q); mx = fmaxf(mx, fmaxf(fmaxf(fabsf(v[q][0]), fabsf(v[q][1])), fmaxf(fabsf(v[q][2]), fabsf(v[q][3])))); }
#pragma unroll
        for (int o = 1; o < 64; o <<= 1) mx = fmaxf(mx, __shfl_xor(mx, o));
        int ex = (int)((__builtin_bit_cast(unsigned, mx) >> 23) & 0xffu) - 127;
        if (mx < 1e-30f) ex = 7;
        const float sc = __builtin_bit_cast(float, (unsigned)(127 + 7 - ex) << 23), isc = __builtin_bit_cast(float, (unsigned)(127 - 7 + ex) << 23);
        v4u o;
        unsigned* ow = (unsigned*)&o;
#pragma unroll
        for (int q = 0; q < 4; ++q) { int p = __builtin_amdgcn_cvt_pk_fp8_f32(v[q][0] * sc, v[q][1] * sc, 0, false); p = __builtin_amdgcn_cvt_pk_fp8_f32(v[q][2] * sc, v[q][3] * sc, p, true); ow[q] = (unsigned)p; }
        *(v4u*)(ws + (t ? WS_PV : WS_PU) + (size_t)row * DM + C.lane * 16) = o;
        if (C.lane == 0) ((float*)(ws + WS_PSC))[t * 16384 + row] = isc;
    }
    for (int m = gw; m < MTOK; m += NGW) rms_row_to_bf16((const float*)a.in[0] + (size_t)m * DM, (const float*)a.in[3], (bf16*)(ws + WS_A) + (size_t)m * DM, C.lane);
    for (int m = gw; m < MROWS; m += NGW) rms_row_to_bf16((const float*)a.in[1] + (size_t)m * DM, (const float*)a.in[5], (bf16*)(ws + WS_MEMN) + (size_t)m * DM, C.lane);
    {
        const int* pos = (const int*)a.in[2]; float* rope = (float*)(ws + WS_ROPE);
        for (int i = gt; i < MTOK * 64; i += NGT) { const int tok = i >> 6, j = i & 63;
            const double inv = exp(-(double)j * (9.210340371976184 / 64.0));
            double ang = (double)pos[tok] * inv; ang -= 6.283185307179586 * rint(ang * 0.15915494309189535);
            rope[(size_t)tok * 128 + j] = (float)cos(ang); rope[(size_t)tok * 128 + 64 + j] = (float)sin(ang); }
    }
}

constexpr int LP = 136;
__device__ __forceinline__ float lg2_gamma(int h) { return log2f(1.0f - exp2f(-5.0f - (float)h)); }

__device__ __forceinline__ void r1_unit(const Ctx& C, const Args& a, int tile, int h) {
    const bf16* Z1 = (const bf16*)(a.ws + WS_Z1); const float* ROPE = (const float*)(a.ws + WS_ROPE);
    LAS bf16* Qs = (LAS bf16*)C.lds; LAS bf16* Ks = Qs + 128 * LP; LAS bf16* Kt = Ks + 128 * LP; LAS bf16* Vt = Kt + 128 * LP;
    const int tid = C.tid, lane = C.lane, t0 = tile * 128, u = tile * 4 + h;
    const float lg2g = lg2_gamma(h);
    {
        const int i = tid >> 2, dq = (tid & 3) * 16;
        const bf16* zr = Z1 + (size_t)(t0 + i) * NZ1; const float* rp = ROPE + (size_t)(t0 + i) * 128;
        float cs[16], sn[16];
#pragma unroll
        for (int q = 0; q < 4; ++q) { const f32x4 c4 = *(const f32x4*)(rp + dq + 4 * q), s4 = *(const f32x4*)(rp + 64 + dq + 4 * q);
#pragma unroll
            for (int e = 0; e < 4; ++e) { cs[4 * q + e] = c4[e]; sn[4 * q + e] = s4[e]; } }
        const float kdec = exp2f((float)(127 - i) * lg2g) , ksc = 0.08838834764831845f;
#pragma unroll
        for (int which = 0; which < 2; ++which) {
            const bf16* src = zr + (which ? ZK : ZQ) + h * 128;
            const v4u a0 = *(const v4u*)(src + dq), a1 = *(const v4u*)(src + dq + 8), b0 = *(const v4u*)(src + 64 + dq), b1 = *(const v4u*)(src + 64 + dq + 8);
            const unsigned aw[8] = {a0.x, a0.y, a0.z, a0.w, a1.x, a1.y, a1.z, a1.w}, bw[8] = {b0.x, b0.y, b0.z, b0.w, b1.x, b1.y, b1.z, b1.w};
            float y1[16], y2[16];
#pragma unroll
            for (int w = 0; w < 8; ++w) {
                const float x1l = bflo(aw[w]), x1h = bfhi(aw[w]), x2l = bflo(bw[w]), x2h = bfhi(bw[w]);
                y1[2 * w] = x1l * cs[2 * w] - x2l * sn[2 * w]; y2[2 * w] = x1l * sn[2 * w] + x2l * cs[2 * w];
                y1[2 * w + 1] = x1h * cs[2 * w + 1] - x2h * sn[2 * w + 1]; y2[2 * w + 1] = x1h * sn[2 * w + 1] + x2h * cs[2 * w + 1];
            }
            if (which) {
#pragma unroll
                for (int e = 0; e < 16; ++e) { y1[e] *= ksc; y2[e] *= ksc; }
            }
            LAS bf16* dstp = (which ? Ks : Qs) + i * LP;
            v4u o;
            o.x = pk2(y1[0], y1[1]); o.y = pk2(y1[2], y1[3]); o.z = pk2(y1[4], y1[5]); o.w = pk2(y1[6], y1[7]); *(LAS v4u*)(dstp + dq) = o;
            o.x = pk2(y1[8], y1[9]); o.y = pk2(y1[10], y1[11]); o.z = pk2(y1[12], y1[13]); o.w = pk2(y1[14], y1[15]); *(LAS v4u*)(dstp + dq + 8) = o;
            o.x = pk2(y2[0], y2[1]); o.y = pk2(y2[2], y2[3]); o.z = pk2(y2[4], y2[5]); o.w = pk2(y2[6], y2[7]); *(LAS v4u*)(dstp + 64 + dq) = o;
            o.x = pk2(y2[8], y2[9]); o.y = pk2(y2[10], y2[11]); o.z = pk2(y2[12], y2[13]); o.w = pk2(y2[14], y2[15]); *(LAS v4u*)(dstp + 64 + dq + 8) = o;
            if (which) {
#pragma unroll
                for (int e = 0; e < 16; ++e) { Kt[(dq + e) * LP + i] = (bf16)f2bf(y1[e] * kdec); Kt[(64 + dq + e) * LP + i] = (bf16)f2bf(y2[e] * kdec); }
            }
            __builtin_amdgcn_sched_barrier(0);
        }
        {
            const int eq = (tid & 3) * 32; const bf16* vs = zr + ZV + h * 128 + eq;
#pragma unroll
            for (int q = 0; q < 4; ++q) { const v4u v = *(const v4u*)(vs + 8 * q); const unsigned vw[4] = {v.x, v.y, v.z, v.w};
#pragma unroll
                for (int w = 0; w < 4; ++w) { Vt[(eq + 8 * q + 2 * w) * LP + i] = (bf16)(vw[w] & 0xffffu); Vt[(eq + 8 * q + 2 * w + 1) * LP + i] = (bf16)(vw[w] >> 16); } }
        }
    }
    __syncthreads();
    const int r = lane & 31, hh = lane >> 5;
    if (C.wave < 4) {
        const int ib = C.wave;
        bf16x8 bq[8];
#pragma unroll
        for (int ks = 0; ks < 8; ++ks) bq[ks] = *(const LAS bf16x8*)(Qs + (ib * 32 + r) * LP + ks * 16 + 8 * hh);
        f32x16 accO[4];
#pragma unroll
        for (int et = 0; et < 4; ++et)
#pragma unroll
            for (int e = 0; e < 16; ++e) accO[et][e] = 0.f;
        const int i = ib * 32 + r;
#pragma unroll
        for (int jt = 0; jt < 4; ++jt) {
            if (jt <= ib) {
                f32x16 s;
#pragma unroll
                for (int e = 0; e < 16; ++e) s[e] = 0.f;
#pragma unroll
                for (int ks = 0; ks < 8; ++ks) { const bf16x8 ak = *(const LAS bf16x8*)(Ks + (jt * 32 + r) * LP + ks * 16 + 8 * hh); s = mfma32(ak, bq[ks], s); }
                unsigned pk[8];
#pragma unroll
                for (int q = 0; q < 8; ++q) {
                    const int ra = 2 * q, rb = 2 * q + 1;
                    const int ja = jt * 32 + (ra & 3) + 8 * (ra >> 2) + 4 * hh, jb = jt * 32 + (rb & 3) + 8 * (rb >> 2) + 4 * hh;
                    const float va = (i >= ja) ? s[ra] * exp2f((float)(i - ja) * lg2g) : 0.f;
                    const float vb = (i >= jb) ? s[rb] * exp2f((float)(i - jb) * lg2g) : 0.f;
                    pk[q] = pk2(va, vb);
                }
#pragma unroll
                for (int sft = 0; sft < 2; ++sft) {
                    const bf16x8 pb = mk8(pk[4 * sft], pk[4 * sft + 1], pk[4 * sft + 2], pk[4 * sft + 3]);
#pragma unroll
                    for (int et = 0; et < 4; ++et) {
                        const LAS bf16* vp = Vt + (et * 32 + r) * LP + jt * 32 + 16 * sft + 4 * hh;
                        const v2u lo = *(const LAS v2u*)vp, hi = *(const LAS v2u*)(vp + 8);
                        accO[et] = mfma32(mk8(lo.x, lo.y, hi.x, hi.y), pb, accO[et]);
                    }
                }
            }
            __builtin_amdgcn_sched_barrier(0);
        }
        unsigned* INN = (unsigned*)(a.ws + WS_INNER) + ((size_t)(u * 4 + ib) * 32) * 64 + lane;
#pragma unroll
        for (int et = 0; et < 4; ++et)
#pragma unroll
            for (int q = 0; q < 8; ++q) INN[(et * 8 + q) * 64] = pk2(accO[et][2 * q], accO[et][2 * q + 1]);
    } else {
        const int et = C.wave - 4;
        f32x16 acc[4];
#pragma unroll
        for (int dt = 0; dt < 4; ++dt)
#pragma unroll
            for (int e = 0; e < 16; ++e) acc[dt][e] = 0.f;
#pragma unroll
        for (int ks = 0; ks < 8; ++ks) {
            const bf16x8 av = *(const LAS bf16x8*)(Vt + (et * 32 + r) * LP + ks * 16 + 8 * hh);
#pragma unroll
            for (int dt = 0; dt < 4; ++dt) { const bf16x8 bk = *(const LAS bf16x8*)(Kt + (dt * 32 + r) * LP + ks * 16 + 8 * hh); acc[dt] = mfma32(av, bk, acc[dt]); }
            __builtin_amdgcn_sched_barrier(0);
        }
        float* KVb = a.out + (size_t)u * 16384 + (size_t)(et * 32 + 4 * hh) * 128 + r;
#pragma unroll
        for (int dt = 0; dt < 4; ++dt) {
#pragma unroll
            for (int e = 0; e < 16; ++e) KVb[((e & 3) + 8 * (e >> 2)) * 128 + dt * 32] = acc[dt][e];
            __builtin_amdgcn_sched_barrier(0);
        }
    }
    __syncthreads();
}

__device__ __forceinline__ void s5_compute_E(const Args& a, int tile, int g, int lane, LAS float* Es, bf16x8 (&au)[4]) {
    const bf16* Z1 = (const bf16*)(a.ws + WS_Z1); const bf16* PMT = (const bf16*)(a.ws + WS_S5MAT) + (size_t)(16 + g) * 16384;
    const int r16 = lane & 15, q4 = lane >> 4;
#pragma unroll
    for (int ks = 0; ks < 4; ++ks) { const int s = 2 * ks + (q4 >> 1);
        au[ks] = *(const bf16x8*)(Z1 + (size_t)(tile * 128 + 8 * r16 + s) * NZ1 + ZU + g * 16 + 8 * (q4 & 1)); }
#pragma unroll 1
    for (int nb = 0; nb < 8; ++nb) {
        f32x4 acc = {0.f, 0.f, 0.f, 0.f};
#pragma unroll
        for (int ks = 0; ks < 4; ++ks) { const bf16x8 b = *(const bf16x8*)(PMT + (size_t)(nb * 16 + r16) * 128 + ks * 32 + 8 * q4); acc = mfma16(au[ks], b, acc); }
#pragma unroll
        for (int i4 = 0; i4 < 4; ++i4) Es[(q4 * 4 + i4) * 128 + nb * 16 + r16] = acc[i4];
        __builtin_amdgcn_sched_barrier(0);
    }
    LDS_WAIT(); asm volatile("" ::: "memory");
}
__device__ __forceinline__ void s5a_wave(const Ctx& C, const Args& a, int tile, int g) {
    LAS float* Es = (LAS float*)(C.lds + C.wave * 16384);
    bf16x8 au[4];
    s5_compute_E(a, tile, g, C.lane, Es, au);
    const float* L8 = (const float*)(a.ws + WS_S5C) + (size_t)g * 128;
    const float l8r = L8[C.lane * 2], l8i = L8[C.lane * 2 + 1];
    float sr = 0.f, si = 0.f;
#pragma unroll
    for (int c = 0; c < 16; ++c) { const float er = Es[c * 128 + C.lane], ei = Es[c * 128 + 64 + C.lane];
        const float nr = l8r * sr - l8i * si + er, ni = l8r * si + l8i * sr + ei; sr = nr; si = ni; }
    float* E = (float*)(a.ws + WS_S5E) + ((size_t)tile * 16 + g) * 128;
    E[C.lane] = sr; E[64 + C.lane] = si;
    LDS_WAIT(); asm volatile("" ::: "memory");
}
__device__ __forceinline__ void s5c_wave(const Ctx& C, const Args& a, int tile, int g) {
    LAS float* Es = (LAS float*)(C.lds + C.wave * 16384);
    LAS bf16* Sv = (LAS bf16*)(C.lds + C.wave * 16384 + 8192);
    const int lane = C.lane, r16 = lane & 15, q4 = lane >> 4;
    bf16x8 au[4];
    s5_compute_E(a, tile, g, lane, Es, au);
    const float* L8 = (const float*)(a.ws + WS_S5C) + (size_t)g * 128;
    const float l8r = L8[lane * 2], l8i = L8[lane * 2 + 1];
    const float* X = (const float*)(a.ws + WS_S5X) + ((size_t)tile * 16 + g) * 128;
    float sr = X[lane], si = X[64 + lane];
#pragma unroll
    for (int c = 0; c < 16; ++c) {
        Sv[c * LP + lane] = (bf16)f2bf(sr); Sv[c * LP + 64 + lane] = (bf16)f2bf(si);
        const float er = Es[c * 128 + lane], ei = Es[c * 128 + 64 + lane];
        const float nr = l8r * sr - l8i * si + er, ni = l8r * si + l8i * sr + ei; sr = nr; si = ni; }
    LDS_WAIT(); asm volatile("" ::: "memory");
    bf16x8 as[4];
#pragma unroll
    for (int ks = 0; ks < 4; ++ks) as[ks] = *(const LAS bf16x8*)(Sv + r16 * LP + ks * 32 + 8 * q4);
    const bf16* T8T = (const bf16*)(a.ws + WS_S5MAT) + (size_t)g * 16384; const bf16* QMT = (const bf16*)(a.ws + WS_S5MAT) + (size_t)(32 + g) * 16384;
    const bf16* Z1 = (const bf16*)(a.ws + WS_Z1); bf16* YG = (bf16*)(a.ws + WS_YG);
    const float dg = ((const float*)a.in[14])[g * 16 + r16];
#pragma unroll 1
    for (int nb = 0; nb < 8; ++nb) {
        f32x4 acc = {0.f, 0.f, 0.f, 0.f};
#pragma unroll
        for (int ks = 0; ks < 4; ++ks) {
            const bf16x8 bt = *(const bf16x8*)(T8T + (size_t)(nb * 16 + r16) * 128 + ks * 32 + 8 * q4); acc = mfma16(au[ks], bt, acc);
            const bf16x8 bq = *(const bf16x8*)(QMT + (size_t)(nb * 16 + r16) * 128 + ks * 32 + 8 * q4); acc = mfma16(as[ks], bq, acc);
        }
#pragma unroll
        for (int i4 = 0; i4 < 4; ++i4) { const int tok = tile * 128 + 8 * (q4 * 4 + i4) + nb;
            const float uv = bf2f(Z1[(size_t)tok * NZ1 + ZU + g * 16 + r16]);
            YG[(size_t)tok * 256 + g * 16 + r16] = (bf16)f2bf(gelu_tanh(acc[i4] + dg * uv)); }
        __builtin_amdgcn_sched_barrier(0);
    }
    LDS_WAIT(); asm volatile("" ::: "memory");
}

__device__ __forceinline__ void ma_wave(const Ctx& C, const Args& a, int tile, int hm, int ib) {
    const bf16* Z1 = (const bf16*)(a.ws + WS_Z1); const bf16* KM = (const bf16*)(a.ws + WS_KM); const bf16* VT = (const bf16*)(a.ws + WS_VT);
    const int lane = C.lane, r = lane & 31, hh = lane >> 5, b = tile >> 5, tok = tile * 128 + ib * 32 + r;
    bf16x8 bq[4];
#pragma unroll
    for (int ks = 0; ks < 4; ++ks) bq[ks] = *(const bf16x8*)(Z1 + (size_t)tok * NZ1 + ZQM + hm * 64 + ks * 16 + 8 * hh);
    float mx = -3.0e38f;
#pragma unroll 1
    for (int mt = 0; mt < 8; ++mt) {
        f32x16 s;
#pragma unroll
        for (int e = 0; e < 16; ++e) s[e] = 0.f;
#pragma unroll
        for (int ks = 0; ks < 4; ++ks) { const bf16x8 ak = *(const bf16x8*)(KM + (size_t)(b * 256 + mt * 32 + r) * 256 + hm * 64 + ks * 16 + 8 * hh); s = mfma32(ak, bq[ks], s); }
#pragma unroll
        for (int e = 0; e < 16; ++e) mx = fmaxf(mx, s[e]);
    }
    mx = fmaxf(mx, __shfl_xor(mx, 32));
    float sum = 0.f;
    f32x16 o[2];
#pragma unroll
    for (int et = 0; et < 2; ++et)
#pragma unroll
        for (int e = 0; e < 16; ++e) o[et][e] = 0.f;
    const float sc = 0.125f * 1.4426950408889634f;
#pragma unroll 1
    for (int mt = 0; mt < 8; ++mt) {
        f32x16 s;
#pragma unroll
        for (int e = 0; e < 16; ++e) s[e] = 0.f;
#pragma unroll
        for (int ks = 0; ks < 4; ++ks) { const bf16x8 ak = *(const bf16x8*)(KM + (size_t)(b * 256 + mt * 32 + r) * 256 + hm * 64 + ks * 16 + 8 * hh); s = mfma32(ak, bq[ks], s); }
        unsigned pk[8];
#pragma unroll
        for (int q = 0; q < 8; ++q) { const float pa = exp2f((s[2 * q] - mx) * sc), pb = exp2f((s[2 * q + 1] - mx) * sc); sum += pa + pb; pk[q] = pk2(pa, pb); }
#pragma unroll
        for (int sft = 0; sft < 2; ++sft) {
            const bf16x8 pb = mk8(pk[4 * sft], pk[4 * sft + 1], pk[4 * sft + 2], pk[4 * sft + 3]);
#pragma unroll
            for (int et = 0; et < 2; ++et) {
                const bf16* vp = VT + (size_t)(b * 256 + hm * 64 + et * 32 + r) * 256 + mt * 32 + 16 * sft + 4 * hh;
                const v2u lo = *(const v2u*)vp, hi = *(const v2u*)(vp + 8);
                o[et] = mfma32(mk8(lo.x, lo.y, hi.x, hi.y), pb, o[et]);
            }
        }
    }
    sum += __shfl_xor(sum, 32);
    const float inv = 1.0f / sum;
    bf16* MA = (bf16*)(a.ws + WS_MATTN) + (size_t)tok * 256 + hm * 64;
#pragma unroll
    for (int et = 0; et < 2; ++et)
#pragma unroll
        for (int g4 = 0; g4 < 4; ++g4) { v2u w; w.x = pk2(o[et][4 * g4] * inv, o[et][4 * g4 + 1] * inv); w.y = pk2(o[et][4 * g4 + 2] * inv, o[et][4 * g4 + 3] * inv);
            *(v2u*)(MA + et * 32 + 8 * g4 + 4 * hh) = w; }
}

__device__ __forceinline__ void r3_wave(const Ctx& C, const Args& a, int tile, int h, int ib) {
    const bf16* Z1 = (const bf16*)(a.ws + WS_Z1); const float* ROPE = (const float*)(a.ws + WS_ROPE);
    const bf16* PREV = (const bf16*)((const unsigned char*)a.out + 64 * MiB);
    const int lane = C.lane, r = lane & 31, hh = lane >> 5, u = tile * 4 + h, tok = tile * 128 + ib * 32 + r;
    const float lg2g = lg2_gamma(h);
    const bf16* zr = Z1 + (size_t)tok * NZ1 + ZQ + h * 128; const float* rp = ROPE + (size_t)tok * 128;
    bf16x8 bq[8];
#pragma unroll
    for (int m = 0; m < 4; ++m) {
        const v4u x1 = *(const v4u*)(zr + m * 16 + 8 * hh), x2 = *(const v4u*)(zr + 64 + m * 16 + 8 * hh);
        const f32x4 c0 = *(const f32x4*)(rp + m * 16 + 8 * hh), c1 = *(const f32x4*)(rp + m * 16 + 8 * hh + 4);
        const f32x4 s0 = *(const f32x4*)(rp + 64 + m * 16 + 8 * hh), s1 = *(const f32x4*)(rp + 64 + m * 16 + 8 * hh + 4);
        const unsigned aw[4] = {x1.x, x1.y, x1.z, x1.w}, bw[4] = {x2.x, x2.y, x2.z, x2.w};
        const float cs[8] = {c0[0], c0[1], c0[2], c0[3], c1[0], c1[1], c1[2], c1[3]}, sn[8] = {s0[0], s0[1], s0[2], s0[3], s1[0], s1[1], s1[2], s1[3]};
        unsigned o1[4], o2[4];
#pragma unroll
        for (int w = 0; w < 4; ++w) {
            const float x1l = bflo(aw[w]), x1h = bfhi(aw[w]), x2l = bflo(bw[w]), x2h = bfhi(bw[w]);
            o1[w] = pk2(x1l * cs[2 * w] - x2l * sn[2 * w], x1h * cs[2 * w + 1] - x2h * sn[2 * w + 1]);
            o2[w] = pk2(x1l * sn[2 * w] + x2l * cs[2 * w], x1h * sn[2 * w + 1] + x2h * cs[2 * w + 1]);
        }
        bq[m] = mk8(o1[0], o1[1], o1[2], o1[3]); bq[m + 4] = mk8(o2[0], o2[1], o2[2], o2[3]);
        __builtin_amdgcn_sched_barrier(0);
    }
    f32x16 acc[4];
#pragma unroll
    for (int et = 0; et < 4; ++et) {
#pragma unroll
        for (int e = 0; e < 16; ++e) acc[et][e] = 0.f;
#pragma unroll
        for (int ks = 0; ks < 8; ++ks) { const bf16x8 ap = *(const bf16x8*)(PREV + ((size_t)u * 128 + et * 32 + r) * 128 + ks * 16 + 8 * hh); acc[et] = mfma32(ap, bq[ks], acc[et]); }
        __builtin_amdgcn_sched_barrier(0);
    }
    const float qdec = exp2f((float)(ib * 32 + r + 1) * lg2g);
    const unsigned* INN = (const unsigned*)(a.ws + WS_INNER) + ((size_t)(u * 4 + ib) * 32) * 64 + lane;
    float ss = 0.f;
#pragma unroll
    for (int et = 0; et < 4; ++et)
#pragma unroll
        for (int q = 0; q < 8; ++q) { const unsigned w = INN[(et * 8 + q) * 64];
            const float v0 = acc[et][2 * q] * qdec + bflo(w), v1 = acc[et][2 * q + 1] * qdec + bfhi(w);
            acc[et][2 * q] = v0; acc[et][2 * q + 1] = v1; ss += v0 * v0 + v1 * v1; }
    __builtin_amdgcn_sched_barrier(0);
    ss += __shfl_xor(ss, 32);
    const float rn = 1.0f / sqrtf(ss * (1.0f / 128.0f) + EPS);
    const bf16* gp = Z1 + (size_t)tok * NZ1 + ZGR + h * 128; bf16* RET = (bf16*)(a.ws + WS_RET) + (size_t)tok * 512 + h * 128;
#pragma unroll
    for (int et = 0; et < 4; ++et)
#pragma unroll
        for (int g4 = 0; g4 < 4; ++g4) { const int e0 = et * 32 + 8 * g4 + 4 * hh; const v2u gw = *(const v2u*)(gp + e0);
            const float g0 = bflo(gw.x), g1 = bfhi(gw.x), g2 = bflo(gw.y), g3 = bfhi(gw.y);
            v2u w; w.x = pk2(acc[et][4 * g4] * rn * g0 * sigmoidf_(g0), acc[et][4 * g4 + 1] * rn * g1 * sigmoidf_(g1));
            w.y = pk2(acc[et][4 * g4 + 2] * rn * g2 * sigmoidf_(g2), acc[et][4 * g4 + 3] * rn * g3 * sigmoidf_(g3));
            *(v2u*)(RET + e0) = w; }
}

__device__ __forceinline__ void p3_scans(const Ctx& C, const Args& a) {
    {
        const float* KV = a.out; bf16* PREV = (bf16*)((unsigned char*)a.out + 64 * MiB);
        for (int it = C.vcu * 512 + C.tid; it < 131072; it += C.G * 512) {
            const int elem = it * 4, b = elem >> 16, h = (elem >> 14) & 3, ed = elem & 16383;
            const float cd = exp2f(128.0f * lg2_gamma(h));
            f32x4 st = {0.f, 0.f, 0.f, 0.f};
#pragma unroll 4
            for (int c = 0; c < 32; ++c) { const size_t off = (size_t)((b * 32 + c) * 4 + h) * 16384 + ed;
                v2u w; w.x = pk2(st[0], st[1]); w.y = pk2(st[2], st[3]); *(v2u*)(PREV + off) = w;
                const f32x4 inc = *(const f32x4*)(KV + off); st = st * cd + inc; }
        }
    }
    {
        const float* E = (const float*)(a.ws + WS_S5E); float* X = (float*)(a.ws + WS_S5X); const float* L128 = (const float*)(a.ws + WS_S5C) + 2048;
        for (int it = C.vcu * 512 + C.tid; it < 8192; it += C.G * 512) {
            const int b = it >> 10, g = (it >> 6) & 15, p = it & 63;
            const float lr = L128[(g * 64 + p) * 2], li = L128[(g * 64 + p) * 2 + 1];
            float xr = 0.f, xi = 0.f;
            for (int n = 0; n < 32; ++n) { const size_t off = ((size_t)(b * 32 + n) * 16 + g) * 128 + p;
                X[off] = xr; X[off + 64] = xi;
                const float er = E[off], ei = E[off + 64];
                const float nr = lr * xr - li * xi + er, ni = lr * xi + li * xr + ei; xr = nr; xi = ni; }
        }
    }
}

__device__ __forceinline__ int f2key(float x) { int b = __builtin_bit_cast(int, x); return b >= 0 ? b : (b ^ 0x7fffffff); }
__device__ __forceinline__ float key2f(int k) { return __builtin_bit_cast(float, k >= 0 ? k : (k ^ 0x7fffffff)); }
__device__ __forceinline__ void ins16(int (&T)[16], int x) {
#pragma unroll
    for (int j = 0; j < 16; ++j) { const int hi = T[j] > x ? T[j] : x; x = T[j] > x ? x : T[j]; T[j] = hi; }
}
__device__ __forceinline__ void peer_topk_half(const Args& a, int tokbase, int hp, int c, int lane, int (&T)[16]) {
    const bf16* Q2 = (const bf16*)(a.ws + WS_Q2); const bf16* KEYS = (const bf16*)(a.ws + WS_KEYS);
    const int r = lane & 31, hh = lane >> 5;
    bf16x8 bq[8];
#pragma unroll
    for (int ks = 0; ks < 8; ++ks) bq[ks] = *(const bf16x8*)(Q2 + (size_t)(tokbase + r) * 2048 + hp * 256 + c * 128 + ks * 16 + 8 * hh);
#pragma unroll
    for (int j = 0; j < 16; ++j) T[j] = (int)0x80000000;
#pragma unroll
    for (int nt = 0; nt < 4; ++nt) {
        f32x16 s;
#pragma unroll
        for (int e = 0; e < 16; ++e) s[e] = 0.f;
#pragma unroll
        for (int ks = 0; ks < 8; ++ks) { const bf16x8 ak = *(const bf16x8*)(KEYS + ((size_t)((hp * 2 + c) * 128 + nt * 32 + r)) * 128 + ks * 16 + 8 * hh); s = mfma32(ak, bq[ks], s); }
#pragma unroll
        for (int e = 0; e < 16; ++e) { const int n = nt * 32 + (e & 3) + 8 * (e >> 2) + 4 * hh; ins16(T, (f2key(s[e]) & ~127) | n); }
    }
    int P[16];
#pragma unroll
    for (int j = 0; j < 16; ++j) P[j] = __shfl_xor(T[j], 32);
#pragma unroll
    for (int j = 0; j < 16; ++j) ins16(T, P[j]);
}
__device__ __forceinline__ void peer_topk_head(const Ctx& C, const Args& a, int tokbase, int hp) {
    const int lane = C.lane, r = lane & 31, hh = lane >> 5;
    int T0[16], T1[16];
    peer_topk_half(a, tokbase, hp, 0, lane, T0);
    peer_topk_half(a, tokbase, hp, 1, lane, T1);
    int F[16];
#pragma unroll
    for (int j = 0; j < 16; ++j) F[j] = (int)0x80000000;
#pragma unroll
    for (int i0 = 0; i0 < 16; ++i0)
#pragma unroll
        for (int i1 = 0; i1 < 16; ++i1)
            if ((i0 + 1) * (i1 + 1) <= 16) { const float v = key2f(T0[i0] & ~127) + key2f(T1[i1] & ~127); ins16(F, (f2key(v) & ~255) | (i0 * 16 + i1)); }
    LAS int* tab = (LAS int*)(C.lds + C.wave * 16384);
#pragma unroll
    for (int j = 0; j < 16; ++j) { tab[j * 64 + lane] = T0[j] & 127; tab[(16 + j) * 64 + lane] = T1[j] & 127; }
    LDS_WAIT(); asm volatile("" ::: "memory");
    const float m = key2f(F[0] & ~255);
    float e[16], sum = 0.f;
#pragma unroll
    for (int j = 0; j < 16; ++j) { e[j] = __expf(key2f(F[j] & ~255) - m); sum += e[j]; }
    const float inv = 1.0f / sum;
    const int tok = tokbase + r;
    int* IDX = (int*)(a.ws + WS_IDX) + (size_t)tok * 128 + hp * 16; float* WGT = (float*)(a.ws + WS_WGT) + (size_t)tok * 128 + hp * 16;
#pragma unroll
    for (int j = 0; j < 16; ++j) { const int id = F[j] & 255; const int k0 = tab[(id >> 4) * 64 + lane], k1 = tab[(16 + (id & 15)) * 64 + lane];
        if (hh == 0) IDX[j] = k0 * 128 + k1; else WGT[j] = e[j] * inv; }
    LDS_WAIT(); asm volatile("" ::: "memory");
}
typedef float f32x2v __attribute__((ext_vector_type(2)));
__device__ __forceinline__ void unpack16(const v4u a, const v4u b, float (&x)[16]) {
    const unsigned w[8] = {a.x, a.y, a.z, a.w, b.x, b.y, b.z, b.w};
#pragma unroll
    for (int i = 0; i < 8; ++i) { x[2 * i] = bflo(w[i]); x[2 * i + 1] = bfhi(w[i]); }
}
__device__ __forceinline__ void unpack16_fp8(const v4u a, float (&x)[16]) {
    const unsigned w[4] = {a.x, a.y, a.z, a.w};
#pragma unroll
    for (int i = 0; i < 4; ++i) { const f32x2v lo = __builtin_amdgcn_cvt_pk_f32_fp8((int)w[i], false), hi = __builtin_amdgcn_cvt_pk_f32_fp8((int)w[i], true);
        x[4 * i] = lo.x; x[4 * i + 1] = lo.y; x[4 * i + 2] = hi.x; x[4 * i + 3] = hi.y; }
}
__device__ __forceinline__ void peer_token(const Args& a, int tok, int lane) {
    const bf16* N2 = (const bf16*)(a.ws + WS_N2); const unsigned char* PU = a.ws + WS_PU; const unsigned char* PV = a.ws + WS_PV;
    const float* USC = (const float*)(a.ws + WS_PSC); const float* VSC = USC + 16384;
    const int* IDX = (const int*)(a.ws + WS_IDX) + (size_t)tok * 128; const float* WGT = (const float*)(a.ws + WS_WGT) + (size_t)tok * 128;
    float xf[16];
    unpack16(*(const v4u*)(N2 + (size_t)tok * DM + lane * 16), *(const v4u*)(N2 + (size_t)tok * DM + lane * 16 + 8), xf);
    const int id0 = IDX[lane], id1 = IDX[64 + lane];
    const float us0 = USC[id0], us1 = USC[id1];
    const float wv0 = WGT[lane] * VSC[id0], wv1 = WGT[64 + lane] * VSC[id1];
    float out[16];
#pragma unroll
    for (int i = 0; i < 16; ++i) out[i] = 0.f;
    const int e8 = (lane >> 3) & 7;
#pragma unroll 1
    for (int k = 0; k < 128; k += 8) {
        const int idv = (k < 64) ? id0 : id1; const float wv = (k < 64) ? wv0 : wv1, usv = (k < 64) ? us0 : us1;
        int eid[8]; float part[8];
#pragma unroll
        for (int kk = 0; kk < 8; ++kk) {
            eid[kk] = __builtin_amdgcn_readlane(idv, (k & 63) + kk);
            float uf[16]; unpack16_fp8(*(const v4u*)(PU + (size_t)eid[kk] * DM + lane * 16), uf);
            float s = 0.f;
#pragma unroll
            for (int i = 0; i < 16; ++i) s += xf[i] * uf[i];
            part[kk] = s;
        }
        float t4[4], t2[2], t1;
#pragma unroll
        for (int q = 0; q < 4; ++q) { const bool up = (lane & 32) != 0; const float keep = up ? part[q + 4] : part[q], send = up ? part[q] : part[q + 4]; t4[q] = keep + __shfl_xor(send, 32); }
#pragma unroll
        for (int q = 0; q < 2; ++q) { const bool up = (lane & 16) != 0; const float keep = up ? t4[q + 2] : t4[q], send = up ? t4[q] : t4[q + 2]; t2[q] = keep + __shfl_xor(send, 16); }
        { const bool up = (lane & 8) != 0; const float keep = up ? t2[1] : t2[0], send = up ? t2[0] : t2[1]; t1 = keep + __shfl_xor(send, 8); }
        t1 += __shfl_xor(t1, 4); t1 += __shfl_xor(t1, 2); t1 += __shfl_xor(t1, 1);
        const float wk = __shfl(wv, (k & 63) + e8), uk = __shfl(usv, (k & 63) + e8);
        const float act = gelu_tanh(t1 * uk) * wk;
#pragma unroll
        for (int kk = 0; kk < 8; ++kk) {
            const float ab = __builtin_bit_cast(float, __builtin_amdgcn_readlane(__builtin_bit_cast(int, act), kk * 8));
            float vf[16]; unpack16_fp8(*(const v4u*)(PV + (size_t)eid[kk] * DM + lane * 16), vf);
#pragma unroll
            for (int i = 0; i < 16; ++i) out[i] += ab * vf[i];
        }
    }
    float* hrow = a.out + (size_t)tok * DM + lane * 16; const float* gf = (const float*)a.in[25] + lane * 16;
    f32x4 h[4];
    float ss = 0.f;
#pragma unroll
    for (int q = 0; q < 4; ++q) { h[q] = *(const f32x4*)(hrow + 4 * q);
#pragma unroll
        for (int e = 0; e < 4; ++e) { h[q][e] += out[4 * q + e]; ss += h[q][e] * h[q][e]; } }
    const float rstd = 1.0f / sqrtf(wave_sum(ss) * (1.f / DM) + EPS);
#pragma unroll
    for (int q = 0; q < 4; ++q) *(f32x4*)(hrow + 4 * q) = h[q] * rstd * *(const f32x4*)(gf + 4 * q);
}

__global__ void __launch_bounds__(NWAVES * 64, 2) mk_fwd(Args args) {
    extern __shared__ __attribute__((aligned(16))) unsigned char lds_raw[];
    Ctx C;
    C.lds = (LAS unsigned char*)lds_raw;
    C.wave = __builtin_amdgcn_readfirstlane((int)threadIdx.x >> 6); C.refresh();
    C.G = gridDim.x; { const int bx = blockIdx.x; C.vcu = (C.G % 8 == 0) ? (bx % 8) * (C.G / 8) + bx / 8 : bx; }
    volatile LAS unsigned* MISC = (volatile LAS unsigned*)(C.lds + MISC_OFF);
    if (C.tid < 128) MISC[C.tid] = 0u;
    __syncthreads();
    unsigned char* ws = args.ws;
    unsigned* ctl = (unsigned*)(ws + WS_CTL);
    XcdBarrier bar; bar.bar = ctl + CW_BAR; bar.x = 0; bar.st = nullptr;
#if !MK_PER_PHASE
    bar = xcd_barrier_post(ctl + CW_BAR, MISC + 8, C.tid == 0);
#define GRID_BAR() xcd_barrier(bar, C.wave)
#else
#define GRID_BAR() do { } while (0)
#endif
    const int lo = args.ph_lo, hi = args.ph_hi;
#define IN(k) (lo <= (k) && (k) < hi)
#define SEAM(k) do { if (IN((k) + 1)) GRID_BAR(); C.refresh(); } while (0)
#define REP(k) for (int rep_ = 0; rep_ < 1 + ((REPEAT_MASK >> (k)) & 1); ++rep_)
    bf16* XN = (bf16*)(ws + WS_A);
    if (IN(0)) { REP(0) { p0_prologue(C, args); __syncthreads(); } SEAM(0); }
    if (IN(1)) {
        REP(1) {
        run_gemm(C, XN, (const bf16*)(ws + WS_WIN_T), MTOK, NZ1, DM, FStore{(bf16*)(ws + WS_Z1), NZ1});
        run_gemm(C, (const bf16*)(ws + WS_MEMN), (const bf16*)(ws + WS_WMKV_T), MROWS, 512, DM, FKvm{(bf16*)(ws + WS_KM), (bf16*)(ws + WS_VT)});
        }
        SEAM(1);
    }
    if (IN(2)) {
        REP(2) { const int tile = C.vcu;
            _Pragma("unroll 1") for (int h = 0; h < 4; ++h) r1_unit(C, args, tile, h);
            _Pragma("unroll 1") for (int gi = 0; gi < 2; ++gi) s5a_wave(C, args, tile, C.wave + 8 * gi);
            _Pragma("unroll 1") for (int gi = 0; gi < 2; ++gi) ma_wave(C, args, tile, 2 * gi + (C.wave >> 2), C.wave & 3);
            __syncthreads();
        }
        SEAM(2);
    }
    if (IN(3)) { REP(3) { p3_scans(C, args); } SEAM(3); }
    if (IN(4)) {
        REP(4) { const int tile = C.vcu;
            _Pragma("unroll 1") for (int gi = 0; gi < 2; ++gi) r3_wave(C, args, tile, 2 * gi + (C.wave >> 2), C.wave & 3);
            _Pragma("unroll 1") for (int gi = 0; gi < 2; ++gi) s5c_wave(C, args, tile, C.wave + 8 * gi);
        }
        SEAM(4);
    }
    if (IN(5)) {
        REP(5) {
        run_gemm(C, XN, (const bf16*)(ws + WS_WIN_T) + (size_t)NZ1 * DM, MTOK, NGATE, DM, FSig{(bf16*)(ws + WS_G), NGATE});
        run_gemm(C, (const bf16*)(ws + WS_YG), (const bf16*)(ws + WS_WGLU_T), MTOK, 512, 256, FGlu{(bf16*)(ws + WS_SSM)});
        }
        SEAM(5);
    }
    if (IN(6)) {
        const bf16* Gt = (const bf16*)(ws + WS_G);
        REP(6) {
        run_gemm(C, (const bf16*)(ws + WS_RET), (const bf16*)(ws + WS_WBR_T), MTOK, DM, 512, FBranch<0>{Gt, 0, args.out, XN});
        run_gemm(C, (const bf16*)(ws + WS_SSM), (const bf16*)(ws + WS_WBS_T), MTOK, DM, 256, FBranch<1>{Gt, 1024, args.out, XN});
        run_gemm(C, (const bf16*)(ws + WS_MATTN), (const bf16*)(ws + WS_WBM_T), MTOK, DM, 256, FBranch<2>{Gt, 2048, args.out, XN});
        }
        SEAM(6);
    }
    if (IN(7)) { REP(7) { run_gemm(C, XN, (const bf16*)(ws + WS_WOUT_T), MTOK, DM, DM, FRes{(const float*)args.in[0], args.out}); } SEAM(7); }
    if (IN(8)) {
        const int gw = C.vcu * NWAVES + C.wave, NGW = C.G * NWAVES;
        REP(8) for (int m = gw; m < MTOK; m += NGW) rms_row_to_bf16(args.out + (size_t)m * DM, (const float*)args.in[20], (bf16*)(ws + WS_N2) + (size_t)m * DM, C.lane);
        SEAM(8);
    }
    if (IN(9)) { REP(9) run_gemm(C, (const bf16*)(ws + WS_N2), (const bf16*)(ws + WS_WQ_T), MTOK, 2048, DM, FStore{(bf16*)(ws + WS_Q2), 2048}); SEAM(9); }
    if (IN(10)) {
        { const int tile = C.vcu;
            const int tokbase = tile * 128 + (C.wave & 3) * 32, h0 = (C.wave >> 2) * 4;
            _Pragma("unroll 1") for (int hp = h0; hp < h0 + 4; ++hp) peer_topk_head(C, args, tokbase, hp);
            VM_WAIT(); __syncthreads();
            _Pragma("unroll 1") for (int ti = 0; ti < 16; ++ti) peer_token(args, tile * 128 + C.wave * 16 + ti, C.lane);
            __syncthreads();
        }
    }
#undef IN
#undef SEAM
}

extern "C" void kernel_launch(void* const* d_in, const int* in_sizes, int n_in, void* d_out, int out_size, void* d_ws, size_t ws_size, hipStream_t stream) {
    static int grid = 0;
    if (grid == 0) {
        if (n_in != 26 || in_sizes[0] != MTOK * DM || out_size != MTOK * DM || ws_size < WS_END) {
            fprintf(stderr, "kernel_launch: unexpected problem (n_in %d, in0 %d, out %d, ws %zu < %zu); nothing launched\n", n_in, n_in > 0 ? in_sizes[0] : -1, out_size, ws_size, (size_t)WS_END); grid = -1; return; }
        int dev = 0, cus = 0;
        if (hipGetDevice(&dev) != hipSuccess || hipDeviceGetAttribute(&cus, hipDeviceAttributeMultiprocessorCount, dev) != hipSuccess) { grid = -1; return; }
        if (hipFuncSetAttribute((const void*)mk_fwd, hipFuncAttributeMaxDynamicSharedMemorySize, LDS_BYTES) != hipSuccess) { fprintf(stderr, "kernel_launch: hipFuncSetAttribute failed\n"); grid = -1; return; }
        (void)hipGetLastError();
        if (cus < NTILES) { fprintf(stderr, "kernel_launch: needs >= 256 CUs, got %d\n", cus); grid = -1; return; }
        grid = NTILES;
    }
    if (grid < 0) return;
    (void)hipMemsetAsync((char*)d_ws + WS_CTL, 0, CTL_ZERO_BYTES, stream);
    Args a{};
    for (int i = 0; i < 26; ++i) a.in[i] = d_in[i];
    a.out = (float*)d_out; a.ws = (unsigned char*)d_ws;
#if MK_PER_PHASE
    for (int p = 0; p < NPHASE; ++p) { a.ph_lo = p; a.ph_hi = p + 1; hipLaunchKernelGGL(mk_fwd, dim3(grid), dim3(NWAVES * 64), LDS_BYTES, stream, a); }
#else
    a.ph_lo = 0; a.ph_hi = NPHASE;
    hipLaunchKernelGGL(mk_fwd, dim3(grid), dim3(NWAVES * 64), LDS_BYTES, stream, a);
#endif
}
```

```cpp
#include <hip/hip_runtime.h>
#include <cstdio>
#include <cstdint>
namespace pg8 {
__device__ __forceinline__ int hw_lane_id() { int l; asm volatile("v_mbcnt_lo_u32_b32 %0, -1, 0\n\tv_mbcnt_hi_u32_b32 %0, -1, %0" : "=v"(l)); return l; }
#define PG8_LAS __attribute__((address_space(3)))
typedef unsigned short bf16_t;
typedef short bf16x8 __attribute__((ext_vector_type(8)));
typedef float f32x4 __attribute__((ext_vector_type(4)));
typedef unsigned u32x4 __attribute__((ext_vector_type(4)));
constexpr int BM = 256, BK = 64, HALF = 128, HTB = HALF * BK * 2  , STAGE_BYTES = 8 * HTB, NXCD = 8, WGM = 8;

__host__ __device__ __forceinline__ int lds_byte(int r, int c) { const int st = (r >> 4) * 2 + (c >> 5), rr = r & 15, cc = c & 31, ob = rr * 64 + cc * 2; return st * 1024 + (ob ^ (((ob >> 9) & 1) << 5)); }
__host__ __device__ __forceinline__ void stage_rc(int b, int& R, int& C) { const int st = b / 1024, sb = b % 1024, swz = sb ^ (((sb >> 9) & 1) << 5); R = (st >> 1) * 16 + swz / 64; C = (st & 1) * 32 + (swz % 64) / 2; }
__host__ __device__ __forceinline__ int perm32(int rho) { const int n = rho >> 4, i = rho & 15; return 8 * (i >> 2) + 4 * n + (i & 3); }

struct Unit { int pm, pn; };
struct Gemm { const bf16_t* A; const bf16_t* Bt; int M, N, K; };

struct StaticOrder {
    int nM, nN, nwg, G, c;
    __host__ __device__ void init(int M, int N, int G_, int c_) { nM = M / BM; nN = N / BM; nwg = nM * nN; G = G_; c = c_; }
    __host__ __device__ bool next(int i, Unit& u) const {
        const long L = (long)i * G + c; if (L >= nwg) return false;
        int wgid = (int)L; { const int q = nwg / NXCD, r = nwg % NXCD, xcd = wgid % NXCD, off = wgid / NXCD; wgid = (xcd < r ? xcd * (q + 1) : r * (q + 1) + (xcd - r) * q) + off; }
        const int nig = WGM * nN, gid = wgid / nig, fm = gid * WGM, gsz = (nM - fm) < WGM ? (nM - fm) : WGM;
        u.pm = fm + ((wgid % nig) % gsz); u.pn = (wgid % nig) / gsz; return true;
    }
    __device__ __forceinline__ void a_ready(const Unit&) const {}
    __device__ __forceinline__ void done(const Unit&) const {}
};

__device__ __forceinline__ unsigned cvt_pk_bf16(float lo, float hi) { unsigned r; asm volatile("v_cvt_pk_bf16_f32 %0, %1, %2" : "=v"(r) : "v"(lo), "v"(hi)); return r; }
template <class Epi, class Sched, bool ALIGN_EPI = false, bool SP2 = false>
__device__ __forceinline__ void gemm_phase(PG8_LAS unsigned char* lds, const Gemm g, const Sched& S, const Epi& E, const int wid) {
    const int lane = hw_lane_id(), tid = wid * 64 + lane, wr = wid >> 2, wc = wid & 3, fr = lane & 15, fq = lane >> 4;
    const int K = g.K, nt = K / BK;
    unsigned voffA[2], voffB[2];
#pragma unroll
    for (int i = 0; i < 2; ++i) { int R, C; stage_rc(tid * 16 + i * 8192, R, C); const int Rb = Epi::PERM ? ((R & ~31) + perm32(R & 31)) : R;
        voffA[i] = (unsigned)(R * K + C) * 2u; voffB[i] = (unsigned)(Rb * K + C) * 2u; }
    const size_t kstep = (size_t)(BK * 2);
    const size_t hstep = (size_t)HALF * K * 2;
    const size_t tstep = 2 * hstep;
    const unsigned ldsw = (unsigned)wid * 1024u;
    const int aoff = lds_byte(wr * 64 + fr, fq * 8), boff = lds_byte(wc * 32 + fr, fq * 8);
#define PG8_SA(b, h) (((b) * 2 + (h)) * HTB)
#define PG8_SB(b, h) ((4 + (b) * 2 + (h)) * HTB)
#define PG8_STAGE(bufoff, gbase, voff) do { _Pragma("unroll") for (int _i = 0; _i < 2; ++_i) \
        __builtin_amdgcn_global_load_lds((const unsigned*)((const char*)(gbase) + (voff)[_i]), (PG8_LAS unsigned*)(lds + (bufoff) + ldsw + _i * 8192), 16, 0, 0); } while (0)
#define PG8_LDA(dst, b, h) do { _Pragma("unroll") for (int m = 0; m < 4; ++m) _Pragma("unroll") for (int k = 0; k < 2; ++k) dst[m][k] = *(const PG8_LAS bf16x8*)(lds + PG8_SA(b, h) + aoff + m * 2048 + k * 1024); } while (0)
#define PG8_LDB(dst, b, h) do { _Pragma("unroll") for (int n = 0; n < 2; ++n) _Pragma("unroll") for (int k = 0; k < 2; ++k) dst[n][k] = *(const PG8_LAS bf16x8*)(lds + PG8_SB(b, h) + boff + n * 2048 + k * 1024); } while (0)
#define PG8_MMA(ai, bj, At, Bt) do { __builtin_amdgcn_s_setprio(1); _Pragma("unroll") for (int m = 0; m < 4; ++m) _Pragma("unroll") for (int n = 0; n < 2; ++n) _Pragma("unroll") for (int k = 0; k < 2; ++k) \
        acc[ai][bj][m][n] = __builtin_amdgcn_mfma_f32_16x16x32_bf16(Bt[n][k], At[m][k], acc[ai][bj][m][n], 0, 0, 0); __builtin_amdgcn_s_setprio(0); } while (0)
#define PG8_WAIT_V(n) asm volatile("s_waitcnt vmcnt(" #n ")" ::: "memory")
#define PG8_WAIT_L(n) asm volatile("s_waitcnt lgkmcnt(" #n ")" ::: "memory")
#define PG8_BAR __builtin_amdgcn_s_barrier()
#define PG8_SCHED __builtin_amdgcn_sched_barrier(0)
    Unit cur, nxt; int ui = 0;
    if (!S.next(0, cur)) return;
    f32x4 acc[2][2][4][2];
#pragma unroll
    for (int a = 0; a < 2; ++a)
#pragma unroll
        for (int b = 0; b < 2; ++b)
#pragma unroll
            for (int m = 0; m < 4; ++m)
#pragma unroll
                for (int n = 0; n < 2; ++n) acc[a][b][m][n] = (f32x4){0.f, 0.f, 0.f, 0.f};
    bf16x8 At[4][2], B0[2][2], B1[2][2];
    const char* cA = (const char*)g.A + (size_t)cur.pm * tstep; const char* cB = (const char*)g.Bt + (size_t)cur.pn * tstep;
    S.a_ready(cur);
    if constexpr (SP2) {
        PG8_STAGE(PG8_SB(0, 0), cB, voffB); PG8_STAGE(PG8_SB(0, 1), cB + hstep, voffB); PG8_STAGE(PG8_SA(0, 0), cA, voffA); PG8_STAGE(PG8_SA(0, 1), cA + hstep, voffA);
        if (wr == 1) PG8_BAR;
        PG8_WAIT_V(2); PG8_BAR;
        PG8_STAGE(PG8_SB(1, 0), cB + kstep, voffB); PG8_STAGE(PG8_SA(1, 0), cA + kstep, voffA); PG8_STAGE(PG8_SB(1, 1), cB + hstep + kstep, voffB);
        PG8_WAIT_V(6); PG8_BAR;
    } else {
        PG8_STAGE(PG8_SB(0, 0), cB, voffB); PG8_STAGE(PG8_SA(0, 0), cA, voffA); PG8_STAGE(PG8_SB(0, 1), cB + hstep, voffB); PG8_STAGE(PG8_SA(0, 1), cA + hstep, voffA);
        if (wr == 1) PG8_BAR;
        PG8_WAIT_V(4); PG8_BAR;
        PG8_STAGE(PG8_SB(1, 0), cB + kstep, voffB); PG8_STAGE(PG8_SA(1, 0), cA + kstep, voffA); PG8_STAGE(PG8_SB(1, 1), cB + hstep + kstep, voffB);
        PG8_WAIT_V(6); PG8_BAR;
    }
    for (;;) {
        const bool has_next = S.next(ui + 1, nxt);
        const char* nA = has_next ? (const char*)g.A + (size_t)nxt.pm * tstep : cA; const char* nB = has_next ? (const char*)g.Bt + (size_t)nxt.pn * tstep : cB;
        for (int t = 0; t < nt; t += 2) {
            const bool last = (t == nt - 2);
            const char* a1 = cA + (size_t)(t + 1) * kstep;
            const char* a2 = last ? nA : cA + (size_t)(t + 2) * kstep; const char* b2 = last ? nB : cB + (size_t)(t + 2) * kstep;
            const char* a3 = a2 + kstep; const char* b3 = b2 + kstep;
            if (last && has_next) S.a_ready(nxt);
            if constexpr (SP2) {
            PG8_LDB(B0, 0, 0); PG8_LDB(B1, 0, 1); PG8_SCHED; PG8_LDA(At, 0, 0); PG8_STAGE(PG8_SA(1, 1), a1 + hstep, voffA);
            PG8_WAIT_V(8); PG8_WAIT_L(0); PG8_BAR; PG8_MMA(0, 0, At, B0); PG8_MMA(0, 1, At, B1); PG8_BAR; PG8_SCHED;
            PG8_LDA(At, 0, 1); PG8_STAGE(PG8_SB(0, 0), b2, voffB); PG8_STAGE(PG8_SB(0, 1), b2 + hstep, voffB); PG8_STAGE(PG8_SA(0, 0), a2, voffA);
            PG8_WAIT_V(8); PG8_WAIT_L(0); PG8_BAR; PG8_MMA(1, 0, At, B0); PG8_MMA(1, 1, At, B1); PG8_BAR; PG8_SCHED;
            PG8_LDB(B0, 1, 0); PG8_LDB(B1, 1, 1); PG8_SCHED; PG8_LDA(At, 1, 0); PG8_STAGE(PG8_SA(0, 1), a2 + hstep, voffA);
            PG8_WAIT_V(8); PG8_WAIT_L(0); PG8_BAR; PG8_MMA(0, 0, At, B0); PG8_MMA(0, 1, At, B1); PG8_BAR; PG8_SCHED;
            PG8_LDA(At, 1, 1); PG8_STAGE(PG8_SB(1, 0), b3, voffB); PG8_STAGE(PG8_SB(1, 1), b3 + hstep, voffB); PG8_STAGE(PG8_SA(1, 0), a3, voffA);
            PG8_WAIT_V(8); PG8_WAIT_L(0); PG8_BAR; PG8_MMA(1, 0, At, B0); PG8_MMA(1, 1, At, B1); PG8_BAR; PG8_SCHED;
            } else {
            PG8_LDB(B0, 0, 0); PG8_SCHED; PG8_LDA(At, 0, 0); PG8_STAGE(PG8_SA(1, 1), a1 + hstep, voffA);
            PG8_WAIT_L(8); PG8_BAR; PG8_WAIT_L(0); PG8_MMA(0, 0, At, B0); PG8_BAR; PG8_SCHED;
            PG8_LDB(B1, 0, 1); PG8_STAGE(PG8_SB(0, 0), b2, voffB);
            PG8_BAR; PG8_WAIT_L(0); PG8_MMA(0, 1, At, B1); PG8_BAR;
            PG8_LDA(At, 0, 1); PG8_STAGE(PG8_SA(0, 0), a2, voffA);
            PG8_BAR; PG8_WAIT_L(0); PG8_MMA(1, 0, At, B0); PG8_BAR; PG8_SCHED;
            PG8_STAGE(PG8_SB(0, 1), b2 + hstep, voffB);
            PG8_WAIT_V(6); PG8_BAR; PG8_MMA(1, 1, At, B1); PG8_BAR;
            PG8_LDB(B0, 1, 0); PG8_SCHED; PG8_LDA(At, 1, 0); PG8_STAGE(PG8_SA(0, 1), a2 + hstep, voffA);
            PG8_WAIT_L(8); PG8_BAR; PG8_WAIT_L(0); PG8_MMA(0, 0, At, B0); PG8_BAR; PG8_SCHED;
            PG8_LDB(B1, 1, 1); PG8_STAGE(PG8_SB(1, 0), b3, voffB);
            PG8_BAR; PG8_WAIT_L(0); PG8_MMA(0, 1, At, B1); PG8_BAR;
            PG8_LDA(At, 1, 1); PG8_STAGE(PG8_SA(1, 0), a3, voffA);
            PG8_BAR; PG8_WAIT_L(0); PG8_MMA(1, 0, At, B0); PG8_BAR; PG8_SCHED;
            PG8_STAGE(PG8_SB(1, 1), b3 + hstep, voffB);
            PG8_WAIT_V(6); PG8_BAR; PG8_MMA(1, 1, At, B1); PG8_BAR;
            }
        }
        if constexpr (ALIGN_EPI) { if (wr == 0) PG8_BAR; }
        if constexpr (!Epi::AFTER_DRAIN) { E(acc, cur, wr, wc, fr, fq); S.done(cur); }
        if (!has_next) break;
#pragma unroll
        for (int a = 0; a < 2; ++a)
#pragma unroll
            for (int b = 0; b < 2; ++b)
#pragma unroll
                for (int m = 0; m < 4; ++m)
#pragma unroll
                    for (int n = 0; n < 2; ++n) acc[a][b][m][n] = (f32x4){0.f, 0.f, 0.f, 0.f};
        cur = nxt; cA = nA; cB = nB; ++ui;
        if constexpr (ALIGN_EPI) { if (wr == 1) PG8_BAR; }
    }
    PG8_WAIT_V(0);
    if constexpr (!ALIGN_EPI) { if (wr == 0) PG8_BAR; }
    PG8_BAR;
    if constexpr (Epi::AFTER_DRAIN) { E.fused(acc, cur, wr, wc, fr, fq, lds, wid, lane); S.done(cur); }
#undef PG8_SA
#undef PG8_SB
#undef PG8_STAGE
#undef PG8_LDA
#undef PG8_LDB
#undef PG8_MMA
#undef PG8_WAIT_V
#undef PG8_WAIT_L
#undef PG8_BAR
#undef PG8_SCHED
}
}

#ifndef REPEAT_MASK
#define REPEAT_MASK 0
#endif
#ifndef MK_PER_PHASE
#define MK_PER_PHASE 0
#endif

constexpr int DM = 1024, BATCH = 8, SEQ = 4096, MTOK = BATCH * SEQ;
constexpr int MEMLEN = 256, MROWS = BATCH * MEMLEN;
constexpr int NZ1 = 2560, NGATE = 3072;
constexpr int ZQ = 0, ZK = 512, ZV = 1024, ZGR = 1536, ZU = 2048, ZQM = 2304;
constexpr int NTILES = MTOK / 128;
constexpr float EPS = 1e-6f;
constexpr int NPHASE = 15;

constexpr size_t MiB = 1u << 20;
constexpr size_t WS_CTL = 0, CTL_ZERO_BYTES = 1 * MiB;
constexpr size_t WS_WIN_T = 1 * MiB;
constexpr size_t WS_WQ_T = 12 * MiB;
constexpr size_t WS_WOUT_T = 16 * MiB;
constexpr size_t WS_WBR_T = 18 * MiB;
constexpr size_t WS_WBS_T = 19 * MiB;
constexpr size_t WS_WBM_T = 19 * MiB + 512 * 1024;
constexpr size_t WS_WGLU_T = 20 * MiB;
constexpr size_t WS_WMKV_T = 21 * MiB;
constexpr size_t WS_KEYS = 22 * MiB;
constexpr size_t WS_S5MAT = 23 * MiB;
constexpr size_t WS_S5C = 25 * MiB;
constexpr size_t WS_PSC = 25 * MiB + 256 * 1024;
constexpr size_t WS_ROPE = 26 * MiB;
constexpr size_t WS_PU = 42 * MiB;
constexpr size_t WS_PV = 74 * MiB;
constexpr size_t WS_MEMN = 106 * MiB;
constexpr size_t WS_KM = 110 * MiB;
constexpr size_t WS_VT = 111 * MiB;
constexpr size_t WS_S5E = 112 * MiB;
constexpr size_t WS_S5X = 114 * MiB;
constexpr size_t WS_A = 116 * MiB;
constexpr size_t WS_B = 180 * MiB;
constexpr size_t WS_Z1 = WS_B;
constexpr size_t WS_G = WS_B;
constexpr size_t WS_RET = WS_B + 192 * MiB;
constexpr size_t WS_SSM = WS_B + 224 * MiB;
constexpr size_t WS_MATTN = WS_B + 240 * MiB;
constexpr size_t WS_YG = WS_B + 256 * MiB;
constexpr size_t WS_INNER = WS_B + 272 * MiB;
constexpr size_t WS_N2 = WS_B;
constexpr size_t WS_Q2 = WS_B + 64 * MiB;
constexpr size_t WS_IDX = WS_B + 192 * MiB;
constexpr size_t WS_WGT = WS_B + 208 * MiB;
constexpr size_t WS_HPART = WS_B + 64 * MiB;
constexpr size_t WS_ACT = WS_B + 224 * MiB;
constexpr size_t WS_POUT = WS_B;
constexpr size_t WS_END = WS_B + 304 * MiB;

constexpr int CW_BAR = 4096;
constexpr int CW_Q = 8192;

constexpr int LDS_BYTES = 147456;
constexpr int MISC_OFF = LDS_BYTES - 512;
constexpr int NWAVES = 8;

#define GAS __attribute__((address_space(1)))
#define LAS __attribute__((address_space(3)))
typedef unsigned short bf16;
typedef unsigned v4u __attribute__((ext_vector_type(4)));
typedef unsigned v2u __attribute__((ext_vector_type(2)));
typedef float f32x4 __attribute__((ext_vector_type(4)));
typedef float f32x16 __attribute__((ext_vector_type(16)));
typedef short bf16x8 __attribute__((ext_vector_type(8)));
typedef GAS unsigned gu32;
#define RLX_AGENT __ATOMIC_RELAXED, __HIP_MEMORY_SCOPE_AGENT
#define LDS_WAIT() asm volatile("s_waitcnt lgkmcnt(0)" ::: "memory")
#define VM_WAIT() asm volatile("s_waitcnt vmcnt(0)" ::: "memory")
__device__ __forceinline__ unsigned f2bf(float f) { unsigned u = __builtin_bit_cast(unsigned, f); return (u + 0x7fffu + ((u >> 16) & 1u)) >> 16; }
__device__ __forceinline__ unsigned pk2(float lo, float hi) { return f2bf(lo) | (f2bf(hi) << 16); }
__device__ __forceinline__ float bflo(unsigned w) { return __builtin_bit_cast(float, w << 16); }
__device__ __forceinline__ float bfhi(unsigned w) { return __builtin_bit_cast(float, w & 0xffff0000u); }
__device__ __forceinline__ float bf2f(bf16 h) { return __builtin_bit_cast(float, (unsigned)h << 16); }
__device__ __forceinline__ f32x16 mfma32(bf16x8 a, bf16x8 b, f32x16 c) { return __builtin_amdgcn_mfma_f32_32x32x16_bf16(a, b, c, 0, 0, 0); }
__device__ __forceinline__ f32x4 mfma16(bf16x8 a, bf16x8 b, f32x4 c) { return __builtin_amdgcn_mfma_f32_16x16x32_bf16(a, b, c, 0, 0, 0); }
__device__ __forceinline__ bf16x8 mk8(unsigned a, unsigned b, unsigned c, unsigned d) { v4u t = {a, b, c, d}; return __builtin_bit_cast(bf16x8, t); }
__device__ __forceinline__ float sigmoidf_(float x) { return 1.0f / (1.0f + __expf(-x)); }
__device__ __forceinline__ float gelu_tanh(float x) {
    const float u = 0.7978845608028654f * (x + 0.044715f * x * x * x);
    const float e = __expf(2.0f * u);
    const float th = 1.0f - 2.0f / (e + 1.0f);
    return 0.5f * x * (1.0f + th);
}
__device__ __forceinline__ float wave_sum(float v) {
#pragma unroll
    for (int o = 1; o < 64; o <<= 1) v += __shfl_xor(v, o);
    return v;
}

#define XB_TMO      128
#define XB_XCNT(j)  (256  + 64 * (j))
#define XB_XSUB(j)  (1280 + 64 * (j))
#define XB_XGEN(j)  (2304 + 64 * (j))
#define XB_TOP      3328
#define XB_TOPGEN   3392
#define XCD_BAR_WORDS 3456
#define XB_SPIN_CAP (1u << 22)

__device__ __forceinline__ unsigned xb_ld(unsigned* p)              { return __hip_atomic_load(p, __ATOMIC_RELAXED, __HIP_MEMORY_SCOPE_AGENT); }
__device__ __forceinline__ unsigned xb_add(unsigned* p, unsigned v) { return __hip_atomic_fetch_add(p, v, __ATOMIC_RELAXED, __HIP_MEMORY_SCOPE_AGENT); }
__device__ __forceinline__ unsigned xb_xcc_id() { return (unsigned)__builtin_amdgcn_s_getreg((3 << 11) | 20) & 0xFu; }
#define XB_SPIN(cond, bar) do { unsigned _sp = 0; while (cond) { __builtin_amdgcn_s_sleep(1); \
    if ((++_sp & 255u) == 0u) { if (xb_ld(&(bar)[XB_TMO])) break; if (_sp > XB_SPIN_CAP) { atomicAdd(&(bar)[XB_TMO], 1u); break; } } } } while (0)

struct XcdBarrier { unsigned* bar; unsigned x; volatile LAS unsigned* st; };

__device__ __forceinline__ XcdBarrier xcd_barrier_post(unsigned* bar, volatile LAS unsigned* st, bool tid0) {
    XcdBarrier b; b.bar = bar; b.x = xb_xcc_id(); b.st = st;
    if (tid0) (void)xb_add(&bar[XB_XCNT(b.x)], 1u);
    return b;
}
__device__ __forceinline__ void xcd_barrier_complete(unsigned* bar, unsigned x, unsigned& nloc, unsigned& nx) {
    const unsigned G = gridDim.x * gridDim.y * gridDim.z;
    unsigned sum, cnt, mine, sp = 0u;
    for (;;) {
        sum = 0u; cnt = 0u; mine = 0u;
#pragma unroll
        for (unsigned j = 0; j < 16; ++j) { const unsigned c = xb_ld(&bar[XB_XCNT(j)]); sum += c; cnt += (c > 0u) ? 1u : 0u; mine = (j == x) ? c : mine; }
        if (sum == G) break;
        __builtin_amdgcn_s_sleep(1);
        if ((++sp & 255u) == 0u) { if (xb_ld(&bar[XB_TMO])) break; if (sp > XB_SPIN_CAP) { atomicAdd(&bar[XB_TMO], 1u); break; } }
    }
    nloc = mine > 0u ? mine : 1u; nx = cnt > 0u ? cnt : 1u;
}
__device__ __forceinline__ void xcd_barrier(const XcdBarrier& b, int wave) {
    asm volatile("s_waitcnt vmcnt(0)" ::: "memory");
    __syncthreads();
    if (wave == 0 && pg8::hw_lane_id() == 0) {
        unsigned* bar = b.bar;
        __builtin_amdgcn_s_waitcnt(0);
        unsigned nloc = b.st[0], nx = b.st[1];
        if (nloc == 0u) { xcd_barrier_complete(bar, b.x, nloc, nx); b.st[0] = nloc; b.st[1] = nx; }
        const unsigned old = xb_add(&bar[XB_XSUB(b.x)], 1u);
        const unsigned gen = old / nloc;
        if (old + 1u == (gen + 1u) * nloc) {
            __builtin_amdgcn_fence(__ATOMIC_RELEASE, "agent");
            asm volatile("s_waitcnt vmcnt(0)" ::: "memory");
            const unsigned og = xb_add(&bar[XB_TOP], 1u);
            const unsigned tg = og / nx;
            if (og + 1u == (tg + 1u) * nx) xb_add(&bar[XB_TOPGEN], 1u);
            else XB_SPIN(xb_ld(&bar[XB_TOPGEN]) == tg, bar);
            __builtin_amdgcn_fence(__ATOMIC_ACQUIRE, "agent");
            xb_add(&bar[XB_XGEN(b.x)], 1u);
            asm volatile("s_waitcnt vmcnt(0)" ::: "memory");
        } else {
            XB_SPIN(xb_ld(&bar[XB_XGEN(b.x)]) == gen, bar);
            __builtin_amdgcn_fence(__ATOMIC_ACQUIRE, "agent");
            asm volatile("s_waitcnt vmcnt(0)" ::: "memory");
        }
    }
    __syncthreads();
}

struct Args { const void* in[26]; float* out; unsigned char* ws; int ph_lo, ph_hi; };
struct Ctx {
    LAS unsigned char* lds;
    int tid, lane, wave, vcu, G;
    __device__ __forceinline__ void refresh() { lane = pg8::hw_lane_id(); tid = wave * 64 + lane; }
};

template <class F> struct EpiT {
    static constexpr bool PERM = true, AFTER_DRAIN = false;
    F f;
    __device__ __forceinline__ void operator()(const f32x4 (&acc)[2][2][4][2], const pg8::Unit& u, int wr, int wc, int fr, int fq) const {
        const int row0 = u.pm * 256 + wr * 64 + fr, col0 = u.pn * 256 + wc * 32 + 8 * fq;
#pragma unroll
        for (int ai = 0; ai < 2; ++ai)
#pragma unroll
            for (int m = 0; m < 4; ++m) {
#pragma unroll
                for (int bj = 0; bj < 2; ++bj) f(row0 + ai * 128 + m * 16, col0 + bj * 128, acc[ai][bj][m][0], acc[ai][bj][m][1]);
                __builtin_amdgcn_sched_barrier(0);
            }
    }
};
__device__ __forceinline__ v4u pack8(f32x4 a, f32x4 b) { v4u w; w.x = pk2(a[0], a[1]); w.y = pk2(a[2], a[3]); w.z = pk2(b[0], b[1]); w.w = pk2(b[2], b[3]); return w; }
struct FStore { bf16* O; int ldc;
    __device__ __forceinline__ void operator()(int row, int col, f32x4 v0, f32x4 v1) const { *(v4u*)(O + (size_t)row * ldc + col) = pack8(v0, v1); } };
struct FKvm { bf16* KM; bf16* VT;
    __device__ __forceinline__ void operator()(int row, int col, f32x4 v0, f32x4 v1) const {
        if (col < 256) { *(v4u*)(KM + (size_t)row * 256 + col) = pack8(v0, v1); }
        else { const int c = col - 256, b = row >> 8, m = row & 255; bf16* p = VT + ((size_t)(b * 256 + c)) * 256 + m;
#pragma unroll
            for (int j = 0; j < 4; ++j) { p[(size_t)j * 256] = (bf16)f2bf(v0[j]); p[(size_t)(j + 4) * 256] = (bf16)f2bf(v1[j]); } }
    } };
struct FSig { bf16* O; int ldc;
    __device__ __forceinline__ void operator()(int row, int col, f32x4 v0, f32x4 v1) const {
#pragma unroll
        for (int j = 0; j < 4; ++j) { v0[j] = sigmoidf_(v0[j]); v1[j] = sigmoidf_(v1[j]); }
        *(v4u*)(O + (size_t)row * ldc + col) = pack8(v0, v1); } };
struct FGlu { bf16* O;
    __device__ __forceinline__ void operator()(int row, int col, f32x4 v0, f32x4 v1) const {
        v2u w; w.x = pk2(v0[0] * sigmoidf_(v1[0]), v0[1] * sigmoidf_(v1[1])); w.y = pk2(v0[2] * sigmoidf_(v1[2]), v0[3] * sigmoidf_(v1[3]));
        *(v2u*)(O + (size_t)row * 256 + (col >> 1)) = w; } };
template <int MODE> struct FBranch { const bf16* Gt; int goff; float* MF; bf16* MB;
    __device__ __forceinline__ void operator()(int row, int col, f32x4 v0, f32x4 v1) const {
        const v4u g = *(const v4u*)(Gt + (size_t)row * NGATE + goff + col);
        v0[0] *= bflo(g.x); v0[1] *= bfhi(g.x); v0[2] *= bflo(g.y); v0[3] *= bfhi(g.y);
        v1[0] *= bflo(g.z); v1[1] *= bfhi(g.z); v1[2] *= bflo(g.w); v1[3] *= bfhi(g.w);
        float* mp = MF + (size_t)row * DM + col;
        if (MODE >= 1) { v0 += *(const f32x4*)mp; v1 += *(const f32x4*)(mp + 4); }
        if (MODE <= 1) { *(f32x4*)mp = v0; *(f32x4*)(mp + 4) = v1; }
        else *(v4u*)(MB + (size_t)row * DM + col) = pack8(v0, v1); } };
struct FRes { const float* X; float* H;
    __device__ __forceinline__ void operator()(int row, int col, f32x4 v0, f32x4 v1) const {
        const float* xp = X + (size_t)row * DM + col; float* hp = H + (size_t)row * DM + col;
        *(f32x4*)hp = *(const f32x4*)xp + v0; *(f32x4*)(hp + 4) = *(const f32x4*)(xp + 4) + v1; } };

template <class F>
__device__ __forceinline__ void run_gemm(const Ctx& C, const bf16* A, const bf16* Bt, int M, int N, int K, const F& f) {
    pg8::Gemm g{A, Bt, M, N, K}; pg8::StaticOrder S; S.init(M, N, C.G, (int)blockIdx.x);
    EpiT<F> E{f};
    pg8::gemm_phase<EpiT<F>, pg8::StaticOrder, true, true>(C.lds, g, S, E, C.wave);
}

template <bool GLU>
__device__ __forceinline__ void p0_transpose_item(const float* W, int K, int N, bf16* WT, LAS float* scr, int item, int lane) {
    const int nblk = N / 32, kb = item / nblk, nb = item % nblk, k0 = 64 * kb, n0 = 32 * nb;
#pragma unroll 8
    for (int i = 0; i < 32; ++i) { const int kk = 2 * i + (lane >> 5); scr[kk * 33 + (lane & 31)] = W[(size_t)(k0 + kk) * N + n0 + (lane & 31)]; }
    LDS_WAIT(); asm volatile("" ::: "memory");
    const int c = lane & 7;
#pragma unroll
    for (int j = 0; j < 4; ++j) { const int n = (lane >> 3) + 8 * j; const LAS float* s = scr + (8 * c) * 33 + n;
        v4u o; o.x = pk2(s[0 * 33], s[1 * 33]); o.y = pk2(s[2 * 33], s[3 * 33]); o.z = pk2(s[4 * 33], s[5 * 33]); o.w = pk2(s[6 * 33], s[7 * 33]);
        const int nn = n0 + n; int row = nn;
        if (GLU) { const int jc = nn & 255, gate = nn >> 8; row = 8 * (jc >> 2) + 4 * gate + (jc & 3); }
        *(GAS v4u*)(WT + (size_t)row * K + k0 + 8 * c) = o; }
    LDS_WAIT(); asm volatile("" ::: "memory");
}
__device__ __forceinline__ void rms_row_to_bf16(const float* xrow, const float* gain, bf16* orow, int lane) {
    const f32x4* xr = (const f32x4*)xrow + lane; const f32x4* gr = (const f32x4*)gain + lane;
    f32x4 v[4]; float s = 0.f;
#pragma unroll
    for (int j = 0; j < 4; ++j) { v[j] = xr[64 * j]; s += (v[j].x * v[j].x + v[j].y * v[j].y) + (v[j].z * v[j].z + v[j].w * v[j].w); }
    const float rstd = 1.0f / sqrtf(wave_sum(s) * (1.f / DM) + EPS);
    unsigned long long* o8 = (unsigned long long*)orow + lane;
#pragma unroll
    for (int j = 0; j < 4; ++j) { const f32x4 g = gr[64 * j];
        o8[64 * j] = (unsigned long long)pk2(v[j].x * rstd * g.x, v[j].y * rstd * g.y) | ((unsigned long long)pk2(v[j].z * rstd * g.z, v[j].w * rstd * g.w) << 32); }
}

__device__ __forceinline__ void p0_s5_group(const Ctx& C, const Args& a, int g) {
    const float* a_re = (const float*)a.in[7]; const float* a_im = (const float*)a.in[8]; const float* log_dt = (const float*)a.in[9];
    const float* b_re = (const float*)a.in[10]; const float* b_im = (const float*)a.in[11]; const float* c_re = (const float*)a.in[12]; const float* c_im = (const float*)a.in[13];
    LAS float* L = (LAS float*)C.lds;
    LAS float* lpr = L;
    LAS float* lpi = L + 9 * 64;
    LAS float* bbr = L + 1152;
    LAS float* bbi = bbr + 1024;
    LAS float* ccr = bbi + 1024;
    LAS float* cci = ccr + 1024;
    LAS float* Kj = cci + 1024;
    const int tid = C.tid;
    bf16* T8T = (bf16*)(a.ws + WS_S5MAT) + (size_t)g * 16384;
    bf16* PMT = (bf16*)(a.ws + WS_S5MAT) + (size_t)(16 + g) * 16384;
    bf16* QMT = (bf16*)(a.ws + WS_S5MAT) + (size_t)(32 + g) * 16384;
    float* L8 = (float*)(a.ws + WS_S5C) + (size_t)g * 128;
    float* L128 = (float*)(a.ws + WS_S5C) + 2048 + (size_t)g * 128;
    if (tid < 64) {
        const int p = tid;
        const double dt = exp((double)log_dt[g]);
        const double ar = (double)a_re[g * 64 + p], ai = (double)a_im[g * 64 + p];
        for (int j = 0; j <= 8; ++j) { const double mag = exp(ar * dt * j), ang = ai * dt * j; lpr[j * 64 + p] = (float)(mag * cos(ang)); lpi[j * 64 + p] = (float)(mag * sin(ang)); }
        { const double mag = exp(ar * dt * 8.0), ang = ai * dt * 8.0; L8[p * 2] = (float)(mag * cos(ang)); L8[p * 2 + 1] = (float)(mag * sin(ang)); }
        { const double mag = exp(ar * dt * 128.0), ang = ai * dt * 128.0; L128[p * 2] = (float)(mag * cos(ang)); L128[p * 2 + 1] = (float)(mag * sin(ang)); }
        const double lr = exp(ar * dt) * cos(ai * dt), li = exp(ar * dt) * sin(ai * dt);
        const double den = ar * ar + ai * ai, nr = lr - 1.0, ni = li;
        const double cr = (nr * ar + ni * ai) / den, ci = (ni * ar - nr * ai) / den;
        for (int h = 0; h < 16; ++h) { const double br = (double)b_re[(g * 64 + p) * 16 + h], bi = (double)b_im[(g * 64 + p) * 16 + h];
            bbr[p * 16 + h] = (float)(cr * br - ci * bi); bbi[p * 16 + h] = (float)(cr * bi + ci * br); }
    }
    for (int i = tid; i < 1024; i += 512) { ccr[i] = c_re[g * 1024 + i]; cci[i] = c_im[g * 1024 + i]; }
    __syncthreads();
    for (int i = tid; i < 2048; i += 512) {
        const int j = i >> 8, ho = (i >> 4) & 15, hi = i & 15; float s = 0.f;
        for (int p = 0; p < 64; ++p) { const float cr_ = ccr[ho * 64 + p], ci_ = cci[ho * 64 + p], lr_ = lpr[j * 64 + p], li_ = lpi[j * 64 + p];
            const float mr = cr_ * lr_ - ci_ * li_, mi = cr_ * li_ + ci_ * lr_;
            s += mr * bbr[p * 16 + hi] - mi * bbi[p * 16 + hi]; }
        Kj[i] = s;
    }
    __syncthreads();
    for (int i = tid; i < 16384; i += 512) {
        const int n = i >> 7, k = i & 127;
        { const int t = n >> 4, ho = n & 15, s = k >> 4, hi = k & 15; const float v = (s <= t) ? Kj[((t - s) * 16 + ho) * 16 + hi] : 0.f; T8T[i] = (bf16)f2bf(v); }
        { const int p = n & 63, im = n >> 6, s = k >> 4, hi = k & 15; const float lr_ = lpr[(7 - s) * 64 + p], li_ = lpi[(7 - s) * 64 + p], br_ = bbr[p * 16 + hi], bi_ = bbi[p * 16 + hi];
          const float v = im ? (lr_ * bi_ + li_ * br_) : (lr_ * br_ - li_ * bi_); PMT[i] = (bf16)f2bf(v); }
        { const int t = n >> 4, ho = n & 15, p = k & 63, part = k >> 6; const float cr_ = ccr[ho * 64 + p], ci_ = cci[ho * 64 + p], lr_ = lpr[(t + 1) * 64 + p], li_ = lpi[(t + 1) * 64 + p];
          const float v = part ? -(cr_ * li_ + ci_ * lr_) : (cr_ * lr_ - ci_ * li_); QMT[i] = (bf16)f2bf(v); }
    }
    __syncthreads();
}

__device__ __forceinline__ void p0_prologue(const Ctx& C, const Args& a) {
    if (C.vcu < 16) p0_s5_group(C, a, C.vcu);
    LAS float* scr = (LAS float*)(C.lds + C.wave * 16384);
    const int gw = C.vcu * NWAVES + C.wave, NGW = C.G * NWAVES;
    const int gt = C.vcu * 512 + C.tid, NGT = C.G * 512;
    unsigned char* ws = a.ws;
    constexpr int I_IN = 16 * 176, I_Q = 16 * 64, I_O = 16 * 32, I_BR = 8 * 32, I_BS = 4 * 32, I_BM = 4 * 32, I_KV = 16 * 16, I_GLU = 4 * 16;
    constexpr int NITEMS = I_IN + I_Q + I_O + I_BR + I_BS + I_BM + I_KV + I_GLU;
    for (int it = gw; it < NITEMS; it += NGW) {
        int r = it;
        if (r < I_IN) { p0_transpose_item<false>((const float*)a.in[4], 1024, 5632, (bf16*)(ws + WS_WIN_T), scr, r, C.lane); continue; } r -= I_IN;
        if (r < I_Q) { p0_transpose_item<false>((const float*)a.in[21], 1024, 2048, (bf16*)(ws + WS_WQ_T), scr, r, C.lane); continue; } r -= I_Q;
        if (r < I_O) { p0_transpose_item<false>((const float*)a.in[19], 1024, 1024, (bf16*)(ws + WS_WOUT_T), scr, r, C.lane); continue; } r -= I_O;
        if (r < I_BR) { p0_transpose_item<false>((const float*)a.in[16], 512, 1024, (bf16*)(ws + WS_WBR_T), scr, r, C.lane); continue; } r -= I_BR;
        if (r < I_BS) { p0_transpose_item<false>((const float*)a.in[17], 256, 1024, (bf16*)(ws + WS_WBS_T), scr, r, C.lane); continue; } r -= I_BS;
        if (r < I_BM) { p0_transpose_item<false>((const float*)a.in[18], 256, 1024, (bf16*)(ws + WS_WBM_T), scr, r, C.lane); continue; } r -= I_BM;
        if (r < I_KV) { p0_transpose_item<false>((const float*)a.in[6], 1024, 512, (bf16*)(ws + WS_WMKV_T), scr, r, C.lane); continue; } r -= I_KV;
        p0_transpose_item<true>((const float*)a.in[15], 256, 512, (bf16*)(ws + WS_WGLU_T), scr, r, C.lane);
    }
    for (int i = gt; i < 16 * 128 * 128 / 8; i += NGT) { const f32x4 x0 = ((const f32x4*)a.in[22])[2 * (size_t)i], x1 = ((const f32x4*)a.in[22])[2 * (size_t)i + 1]; ((v4u*)(ws + WS_KEYS))[i] = pack8(x0, x1); }
    for (int rw = gw; rw < 2 * 16384; rw += NGW) {
        const int t = rw >> 14, row = rw & 16383;
        const float* src = (const float*)a.in[23 + t] + (size_t)row * DM + C.lane * 16;
        f32x4 v[4]; float mx = 0.f;
#pragma unroll
        for (int q = 0; q < 4; ++q) { v[q] = *(const f32x4*)(src + 4 * q); mx = fmaxf(mx, fmaxf(fmaxf(fabsf(v[q][0]), fabsf(v[q][1])), fmaxf(fabsf(v[q][2]), fabsf(v[q][3])))); }
#pragma unroll
        for (int o = 1; o < 64; o <<= 1) mx = fmaxf(mx, __shfl_xor(mx, o));
        int ex = (int)((__builtin_bit_cast(unsigned, mx) >> 23) & 0xffu) - 127;
        if (mx < 1e-30f) ex = 7;
        const float sc = __builtin_bit_cast(float, (unsigned)(127 + 7 - ex) << 23), isc = __builtin_bit_cast(float, (unsigned)(127 - 7 + ex) << 23);
        v4u o;
        unsigned* ow = (unsigned*)&o;
#pragma unroll
        for (int q = 0; q < 4; ++q) { int p = __builtin_amdgcn_cvt_pk_fp8_f32(v[q][0] * sc, v[q][1] * sc, 0, false); p = __builtin_amdgcn_cvt_pk_fp8_f32(v[q][2] * sc, v[q][3] * sc, p, true); ow[q] = (unsigned)p; }
        *(v4u*)(ws + (t ? WS_PV : WS_PU) + ((size_t)(C.lane >> 3) * 16384 + row) * 128 + (C.lane & 7) * 16) = o;
        if (C.lane == 0) ((float*)(ws + WS_PSC))[t * 16384 + row] = isc;
    }
    for (int m = gw; m < MTOK; m += NGW) rms_row_to_bf16((const float*)a.in[0] + (size_t)m * DM, (const float*)a.in[3], (bf16*)(ws + WS_A) + (size_t)m * DM, C.lane);
    for (int m = gw; m < MROWS; m += NGW) rms_row_to_bf16((const float*)a.in[1] + (size_t)m * DM, (const float*)a.in[5], (bf16*)(ws + WS_MEMN) + (size_t)m * DM, C.lane);
    {
        const int* pos = (const int*)a.in[2]; float* rope = (float*)(ws + WS_ROPE);
        for (int i = gt; i < MTOK * 64; i += NGT) { const int tok = i >> 6, j = i & 63;
            const double inv = exp(-(double)j * (9.210340371976184 / 64.0));
            double ang = (double)pos[tok] * inv; ang -= 6.283185307179586 * rint(ang * 0.15915494309189535);
            rope[(size_t)tok * 128 + j] = (float)cos(ang); rope[(size_t)tok * 128 + 64 + j] = (float)sin(ang); }
    }
}

constexpr int LP = 136;
__device__ __forceinline__ float lg2_gamma(int h) { return log2f(1.0f - exp2f(-5.0f - (float)h)); }

__device__ __forceinline__ void r1_unit(const Ctx& C, const Args& a, int tile, int h) {
    const bf16* Z1 = (const bf16*)(a.ws + WS_Z1); const float* ROPE = (const float*)(a.ws + WS_ROPE);
    LAS bf16* Qs = (LAS bf16*)C.lds; LAS bf16* Ks = Qs + 128 * LP; LAS bf16* Kt = Ks + 128 * LP; LAS bf16* Vt = Kt + 128 * LP;
    const int tid = C.tid, lane = C.lane, t0 = tile * 128, u = tile * 4 + h;
    const float lg2g = lg2_gamma(h);
    {
        const int i = tid >> 2, dq = (tid & 3) * 16;
        const bf16* zr = Z1 + (size_t)(t0 + i) * NZ1; const float* rp = ROPE + (size_t)(t0 + i) * 128;
        float cs[16], sn[16];
#pragma unroll
        for (int q = 0; q < 4; ++q) { const f32x4 c4 = *(const f32x4*)(rp + dq + 4 * q), s4 = *(const f32x4*)(rp + 64 + dq + 4 * q);
#pragma unroll
            for (int e = 0; e < 4; ++e) { cs[4 * q + e] = c4[e]; sn[4 * q + e] = s4[e]; } }
        const float kdec = exp2f((float)(127 - i) * lg2g) , ksc = 0.08838834764831845f;
#pragma unroll
        for (int which = 0; which < 2; ++which) {
            const bf16* src = zr + (which ? ZK : ZQ) + h * 128;
            const v4u a0 = *(const v4u*)(src + dq), a1 = *(const v4u*)(src + dq + 8), b0 = *(const v4u*)(src + 64 + dq), b1 = *(const v4u*)(src + 64 + dq + 8);
            const unsigned aw[8] = {a0.x, a0.y, a0.z, a0.w, a1.x, a1.y, a1.z, a1.w}, bw[8] = {b0.x, b0.y, b0.z, b0.w, b1.x, b1.y, b1.z, b1.w};
            float y1[16], y2[16];
#pragma unroll
            for (int w = 0; w < 8; ++w) {
                const float x1l = bflo(aw[w]), x1h = bfhi(aw[w]), x2l = bflo(bw[w]), x2h = bfhi(bw[w]);
                y1[2 * w] = x1l * cs[2 * w] - x2l * sn[2 * w]; y2[2 * w] = x1l * sn[2 * w] + x2l * cs[2 * w];
                y1[2 * w + 1] = x1h * cs[2 * w + 1] - x2h * sn[2 * w + 1]; y2[2 * w + 1] = x1h * sn[2 * w + 1] + x2h * cs[2 * w + 1];
            }
            if (which) {
#pragma unroll
                for (int e = 0; e < 16; ++e) { y1[e] *= ksc; y2[e] *= ksc; }
            }
            LAS bf16* dstp = (which ? Ks : Qs) + i * LP;
            v4u o;
            o.x = pk2(y1[0], y1[1]); o.y = pk2(y1[2], y1[3]); o.z = pk2(y1[4], y1[5]); o.w = pk2(y1[6], y1[7]); *(LAS v4u*)(dstp + dq) = o;
            o.x = pk2(y1[8], y1[9]); o.y = pk2(y1[10], y1[11]); o.z = pk2(y1[12], y1[13]); o.w = pk2(y1[14], y1[15]); *(LAS v4u*)(dstp + dq + 8) = o;
            o.x = pk2(y2[0], y2[1]); o.y = pk2(y2[2], y2[3]); o.z = pk2(y2[4], y2[5]); o.w = pk2(y2[6], y2[7]); *(LAS v4u*)(dstp + 64 + dq) = o;
            o.x = pk2(y2[8], y2[9]); o.y = pk2(y2[10], y2[11]); o.z = pk2(y2[12], y2[13]); o.w = pk2(y2[14], y2[15]); *(LAS v4u*)(dstp + 64 + dq + 8) = o;
            if (which) {
#pragma unroll
                for (int e = 0; e < 16; ++e) { Kt[(dq + e) * LP + i] = (bf16)f2bf(y1[e] * kdec); Kt[(64 + dq + e) * LP + i] = (bf16)f2bf(y2[e] * kdec); }
            }
            __builtin_amdgcn_sched_barrier(0);
        }
        {
            const int eq = (tid & 3) * 32; const bf16* vs = zr + ZV + h * 128 + eq;
#pragma unroll
            for (int q = 0; q < 4; ++q) { const v4u v = *(const v4u*)(vs + 8 * q); const unsigned vw[4] = {v.x, v.y, v.z, v.w};
#pragma unroll
                for (int w = 0; w < 4; ++w) { Vt[(eq + 8 * q + 2 * w) * LP + i] = (bf16)(vw[w] & 0xffffu); Vt[(eq + 8 * q + 2 * w + 1) * LP + i] = (bf16)(vw[w] >> 16); } }
        }
    }
    __syncthreads();
    const int r = lane & 31, hh = lane >> 5;
    if (C.wave < 4) {
        const int ib = C.wave;
        bf16x8 bq[8];
#pragma unroll
        for (int ks = 0; ks < 8; ++ks) bq[ks] = *(const LAS bf16x8*)(Qs + (ib * 32 + r) * LP + ks * 16 + 8 * hh);
        f32x16 accO[4];
#pragma unroll
        for (int et = 0; et < 4; ++et)
#pragma unroll
            for (int e = 0; e < 16; ++e) accO[et][e] = 0.f;
        const int i = ib * 32 + r;
#pragma unroll
        for (int jt = 0; jt < 4; ++jt) {
            if (jt <= ib) {
                f32x16 s;
#pragma unroll
                for (int e = 0; e < 16; ++e) s[e] = 0.f;
#pragma unroll
                for (int ks = 0; ks < 8; ++ks) { const bf16x8 ak = *(const LAS bf16x8*)(Ks + (jt * 32 + r) * LP + ks * 16 + 8 * hh); s = mfma32(ak, bq[ks], s); }
                unsigned pk[8];
#pragma unroll
                for (int q = 0; q < 8; ++q) {
                    const int ra = 2 * q, rb = 2 * q + 1;
                    const int ja = jt * 32 + (ra & 3) + 8 * (ra >> 2) + 4 * hh, jb = jt * 32 + (rb & 3) + 8 * (rb >> 2) + 4 * hh;
                    const float va = (i >= ja) ? s[ra] * exp2f((float)(i - ja) * lg2g) : 0.f;
                    const float vb = (i >= jb) ? s[rb] * exp2f((float)(i - jb) * lg2g) : 0.f;
                    pk[q] = pk2(va, vb);
                }
#pragma unroll
                for (int sft = 0; sft < 2; ++sft) {
                    const bf16x8 pb = mk8(pk[4 * sft], pk[4 * sft + 1], pk[4 * sft + 2], pk[4 * sft + 3]);
#pragma unroll
                    for (int et = 0; et < 4; ++et) {
                        const LAS bf16* vp = Vt + (et * 32 + r) * LP + jt * 32 + 16 * sft + 4 * hh;
                        const v2u lo = *(const LAS v2u*)vp, hi = *(const LAS v2u*)(vp + 8);
                        accO[et] = mfma32(mk8(lo.x, lo.y, hi.x, hi.y), pb, accO[et]);
                    }
                }
            }
            __builtin_amdgcn_sched_barrier(0);
        }
        unsigned* INN = (unsigned*)(a.ws + WS_INNER) + ((size_t)(u * 4 + ib) * 32) * 64 + lane;
#pragma unroll
        for (int et = 0; et < 4; ++et)
#pragma unroll
            for (int q = 0; q < 8; ++q) INN[(et * 8 + q) * 64] = pk2(accO[et][2 * q], accO[et][2 * q + 1]);
    } else {
        const int et = C.wave - 4;
        f32x16 acc[4];
#pragma unroll
        for (int dt = 0; dt < 4; ++dt)
#pragma unroll
            for (int e = 0; e < 16; ++e) acc[dt][e] = 0.f;
#pragma unroll
        for (int ks = 0; ks < 8; ++ks) {
            const bf16x8 av = *(const LAS bf16x8*)(Vt + (et * 32 + r) * LP + ks * 16 + 8 * hh);
#pragma unroll
            for (int dt = 0; dt < 4; ++dt) { const bf16x8 bk = *(const LAS bf16x8*)(Kt + (dt * 32 + r) * LP + ks * 16 + 8 * hh); acc[dt] = mfma32(av, bk, acc[dt]); }
            __builtin_amdgcn_sched_barrier(0);
        }
        float* KVb = a.out + (size_t)u * 16384 + (size_t)(et * 32 + 4 * hh) * 128 + r;
#pragma unroll
        for (int dt = 0; dt < 4; ++dt) {
#pragma unroll
            for (int e = 0; e < 16; ++e) KVb[((e & 3) + 8 * (e >> 2)) * 128 + dt * 32] = acc[dt][e];
            __builtin_amdgcn_sched_barrier(0);
        }
    }
    __syncthreads();
}

__device__ __forceinline__ void s5_compute_E(const Args& a, int tile, int g, int lane, LAS float* Es, bf16x8 (&au)[4]) {
    const bf16* Z1 = (const bf16*)(a.ws + WS_Z1); const bf16* PMT = (const bf16*)(a.ws + WS_S5MAT) + (size_t)(16 + g) * 16384;
    const int r16 = lane & 15, q4 = lane >> 4;
#pragma unroll
    for (int ks = 0; ks < 4; ++ks) { const int s = 2 * ks + (q4 >> 1);
        au[ks] = *(const bf16x8*)(Z1 + (size_t)(tile * 128 + 8 * r16 + s) * NZ1 + ZU + g * 16 + 8 * (q4 & 1)); }
#pragma unroll 1
    for (int nb = 0; nb < 8; ++nb) {
        f32x4 acc = {0.f, 0.f, 0.f, 0.f};
#pragma unroll
        for (int ks = 0; ks < 4; ++ks) { const bf16x8 b = *(const bf16x8*)(PMT + (size_t)(nb * 16 + r16) * 128 + ks * 32 + 8 * q4); acc = mfma16(au[ks], b, acc); }
#pragma unroll
        for (int i4 = 0; i4 < 4; ++i4) Es[(q4 * 4 + i4) * 128 + nb * 16 + r16] = acc[i4];
        __builtin_amdgcn_sched_barrier(0);
    }
    LDS_WAIT(); asm volatile("" ::: "memory");
}
__device__ __forceinline__ void s5a_wave(const Ctx& C, const Args& a, int tile, int g) {
    LAS float* Es = (LAS float*)(C.lds + C.wave * 16384);
    bf16x8 au[4];
    s5_compute_E(a, tile, g, C.lane, Es, au);
    const float* L8 = (const float*)(a.ws + WS_S5C) + (size_t)g * 128;
    const float l8r = L8[C.lane * 2], l8i = L8[C.lane * 2 + 1];
    float sr = 0.f, si = 0.f;
#pragma unroll
    for (int c = 0; c < 16; ++c) { const float er = Es[c * 128 + C.lane], ei = Es[c * 128 + 64 + C.lane];
        const float nr = l8r * sr - l8i * si + er, ni = l8r * si + l8i * sr + ei; sr = nr; si = ni; }
    float* E = (float*)(a.ws + WS_S5E) + ((size_t)tile * 16 + g) * 128;
    E[C.lane] = sr; E[64 + C.lane] = si;
    LDS_WAIT(); asm volatile("" ::: "memory");
}
__device__ __forceinline__ void s5c_wave(const Ctx& C, const Args& a, int tile, int g) {
    LAS float* Es = (LAS float*)(C.lds + C.wave * 16384);
    LAS bf16* Sv = (LAS bf16*)(C.lds + C.wave * 16384 + 8192);
    const int lane = C.lane, r16 = lane & 15, q4 = lane >> 4;
    bf16x8 au[4];
    s5_compute_E(a, tile, g, lane, Es, au);
    const float* L8 = (const float*)(a.ws + WS_S5C) + (size_t)g * 128;
    const float l8r = L8[lane * 2], l8i = L8[lane * 2 + 1];
    const float* X = (const float*)(a.ws + WS_S5X) + ((size_t)tile * 16 + g) * 128;
    float sr = X[lane], si = X[64 + lane];
#pragma unroll
    for (int c = 0; c < 16; ++c) {
        Sv[c * LP + lane] = (bf16)f2bf(sr); Sv[c * LP + 64 + lane] = (bf16)f2bf(si);
        const float er = Es[c * 128 + lane], ei = Es[c * 128 + 64 + lane];
        const float nr = l8r * sr - l8i * si + er, ni = l8r * si + l8i * sr + ei; sr = nr; si = ni; }
    LDS_WAIT(); asm volatile("" ::: "memory");
    bf16x8 as[4];
#pragma unroll
    for (int ks = 0; ks < 4; ++ks) as[ks] = *(const LAS bf16x8*)(Sv + r16 * LP + ks * 32 + 8 * q4);
    const bf16* T8T = (const bf16*)(a.ws + WS_S5MAT) + (size_t)g * 16384; const bf16* QMT = (const bf16*)(a.ws + WS_S5MAT) + (size_t)(32 + g) * 16384;
    const bf16* Z1 = (const bf16*)(a.ws + WS_Z1); bf16* YG = (bf16*)(a.ws + WS_YG);
    const float dg = ((const float*)a.in[14])[g * 16 + r16];
#pragma unroll 1
    for (int nb = 0; nb < 8; ++nb) {
        f32x4 acc = {0.f, 0.f, 0.f, 0.f};
#pragma unroll
        for (int ks = 0; ks < 4; ++ks) {
            const bf16x8 bt = *(const bf16x8*)(T8T + (size_t)(nb * 16 + r16) * 128 + ks * 32 + 8 * q4); acc = mfma16(au[ks], bt, acc);
            const bf16x8 bq = *(const bf16x8*)(QMT + (size_t)(nb * 16 + r16) * 128 + ks * 32 + 8 * q4); acc = mfma16(as[ks], bq, acc);
        }
#pragma unroll
        for (int i4 = 0; i4 < 4; ++i4) { const int tok = tile * 128 + 8 * (q4 * 4 + i4) + nb;
            const float uv = bf2f(Z1[(size_t)tok * NZ1 + ZU + g * 16 + r16]);
            YG[(size_t)tok * 256 + g * 16 + r16] = (bf16)f2bf(gelu_tanh(acc[i4] + dg * uv)); }
        __builtin_amdgcn_sched_barrier(0);
    }
    LDS_WAIT(); asm volatile("" ::: "memory");
}

__device__ __forceinline__ void ma_wave(const Ctx& C, const Args& a, int tile, int hm, int ib) {
    const bf16* Z1 = (const bf16*)(a.ws + WS_Z1); const bf16* KM = (const bf16*)(a.ws + WS_KM); const bf16* VT = (const bf16*)(a.ws + WS_VT);
    const int lane = C.lane, r = lane & 31, hh = lane >> 5, b = tile >> 5, tok = tile * 128 + ib * 32 + r;
    bf16x8 bq[4];
#pragma unroll
    for (int ks = 0; ks < 4; ++ks) bq[ks] = *(const bf16x8*)(Z1 + (size_t)tok * NZ1 + ZQM + hm * 64 + ks * 16 + 8 * hh);
    float mx = -3.0e38f;
#pragma unroll 1
    for (int mt = 0; mt < 8; ++mt) {
        f32x16 s;
#pragma unroll
        for (int e = 0; e < 16; ++e) s[e] = 0.f;
#pragma unroll
        for (int ks = 0; ks < 4; ++ks) { const bf16x8 ak = *(const bf16x8*)(KM + (size_t)(b * 256 + mt * 32 + r) * 256 + hm * 64 + ks * 16 + 8 * hh); s = mfma32(ak, bq[ks], s); }
#pragma unroll
        for (int e = 0; e < 16; ++e) mx = fmaxf(mx, s[e]);
    }
    mx = fmaxf(mx, __shfl_xor(mx, 32));
    float sum = 0.f;
    f32x16 o[2];
#pragma unroll
    for (int et = 0; et < 2; ++et)
#pragma unroll
        for (int e = 0; e < 16; ++e) o[et][e] = 0.f;
    const float sc = 0.125f * 1.4426950408889634f;
#pragma unroll 1
    for (int mt = 0; mt < 8; ++mt) {
        f32x16 s;
#pragma unroll
        for (int e = 0; e < 16; ++e) s[e] = 0.f;
#pragma unroll
        for (int ks = 0; ks < 4; ++ks) { const bf16x8 ak = *(const bf16x8*)(KM + (size_t)(b * 256 + mt * 32 + r) * 256 + hm * 64 + ks * 16 + 8 * hh); s = mfma32(ak, bq[ks], s); }
        unsigned pk[8];
#pragma unroll
        for (int q = 0; q < 8; ++q) { const float pa = exp2f((s[2 * q] - mx) * sc), pb = exp2f((s[2 * q + 1] - mx) * sc); sum += pa + pb; pk[q] = pk2(pa, pb); }
#pragma unroll
        for (int sft = 0; sft < 2; ++sft) {
            const bf16x8 pb = mk8(pk[4 * sft], pk[4 * sft + 1], pk[4 * sft + 2], pk[4 * sft + 3]);
#pragma unroll
            for (int et = 0; et < 2; ++et) {
                const bf16* vp = VT + (size_t)(b * 256 + hm * 64 + et * 32 + r) * 256 + mt * 32 + 16 * sft + 4 * hh;
                const v2u lo = *(const v2u*)vp, hi = *(const v2u*)(vp + 8);
                o[et] = mfma32(mk8(lo.x, lo.y, hi.x, hi.y), pb, o[et]);
            }
        }
    }
    sum += __shfl_xor(sum, 32);
    const float inv = 1.0f / sum;
    bf16* MA = (bf16*)(a.ws + WS_MATTN) + (size_t)tok * 256 + hm * 64;
#pragma unroll
    for (int et = 0; et < 2; ++et)
#pragma unroll
        for (int g4 = 0; g4 < 4; ++g4) { v2u w; w.x = pk2(o[et][4 * g4] * inv, o[et][4 * g4 + 1] * inv); w.y = pk2(o[et][4 * g4 + 2] * inv, o[et][4 * g4 + 3] * inv);
            *(v2u*)(MA + et * 32 + 8 * g4 + 4 * hh) = w; }
}

__device__ __forceinline__ void r3_wave(const Ctx& C, const Args& a, int tile, int h, int ib) {
    const bf16* Z1 = (const bf16*)(a.ws + WS_Z1); const float* ROPE = (const float*)(a.ws + WS_ROPE);
    const bf16* PREV = (const bf16*)((const unsigned char*)a.out + 64 * MiB);
    const int lane = C.lane, r = lane & 31, hh = lane >> 5, u = tile * 4 + h, tok = tile * 128 + ib * 32 + r;
    const float lg2g = lg2_gamma(h);
    const bf16* zr = Z1 + (size_t)tok * NZ1 + ZQ + h * 128; const float* rp = ROPE + (size_t)tok * 128;
    bf16x8 bq[8];
#pragma unroll
    for (int m = 0; m < 4; ++m) {
        const v4u x1 = *(const v4u*)(zr + m * 16 + 8 * hh), x2 = *(const v4u*)(zr + 64 + m * 16 + 8 * hh);
        const f32x4 c0 = *(const f32x4*)(rp + m * 16 + 8 * hh), c1 = *(const f32x4*)(rp + m * 16 + 8 * hh + 4);
        const f32x4 s0 = *(const f32x4*)(rp + 64 + m * 16 + 8 * hh), s1 = *(const f32x4*)(rp + 64 + m * 16 + 8 * hh + 4);
        const unsigned aw[4] = {x1.x, x1.y, x1.z, x1.w}, bw[4] = {x2.x, x2.y, x2.z, x2.w};
        const float cs[8] = {c0[0], c0[1], c0[2], c0[3], c1[0], c1[1], c1[2], c1[3]}, sn[8] = {s0[0], s0[1], s0[2], s0[3], s1[0], s1[1], s1[2], s1[3]};
        unsigned o1[4], o2[4];
#pragma unroll
        for (int w = 0; w < 4; ++w) {
            const float x1l = bflo(aw[w]), x1h = bfhi(aw[w]), x2l = bflo(bw[w]), x2h = bfhi(bw[w]);
            o1[w] = pk2(x1l * cs[2 * w] - x2l * sn[2 * w], x1h * cs[2 * w + 1] - x2h * sn[2 * w + 1]);
            o2[w] = pk2(x1l * sn[2 * w] + x2l * cs[2 * w], x1h * sn[2 * w + 1] + x2h * cs[2 * w + 1]);
        }
        bq[m] = mk8(o1[0], o1[1], o1[2], o1[3]); bq[m + 4] = mk8(o2[0], o2[1], o2[2], o2[3]);
        __builtin_amdgcn_sched_barrier(0);
    }
    f32x16 acc[4];
#pragma unroll
    for (int et = 0; et < 4; ++et) {
#pragma unroll
        for (int e = 0; e < 16; ++e) acc[et][e] = 0.f;
#pragma unroll
        for (int ks = 0; ks < 8; ++ks) { const bf16x8 ap = *(const bf16x8*)(PREV + ((size_t)u * 128 + et * 32 + r) * 128 + ks * 16 + 8 * hh); acc[et] = mfma32(ap, bq[ks], acc[et]); }
        __builtin_amdgcn_sched_barrier(0);
    }
    const float qdec = exp2f((float)(ib * 32 + r + 1) * lg2g);
    const unsigned* INN = (const unsigned*)(a.ws + WS_INNER) + ((size_t)(u * 4 + ib) * 32) * 64 + lane;
    float ss = 0.f;
#pragma unroll
    for (int et = 0; et < 4; ++et)
#pragma unroll
        for (int q = 0; q < 8; ++q) { const unsigned w = INN[(et * 8 + q) * 64];
            const float v0 = acc[et][2 * q] * qdec + bflo(w), v1 = acc[et][2 * q + 1] * qdec + bfhi(w);
            acc[et][2 * q] = v0; acc[et][2 * q + 1] = v1; ss += v0 * v0 + v1 * v1; }
    __builtin_amdgcn_sched_barrier(0);
    ss += __shfl_xor(ss, 32);
    const float rn = 1.0f / sqrtf(ss * (1.0f / 128.0f) + EPS);
    const bf16* gp = Z1 + (size_t)tok * NZ1 + ZGR + h * 128; bf16* RET = (bf16*)(a.ws + WS_RET) + (size_t)tok * 512 + h * 128;
#pragma unroll
    for (int et = 0; et < 4; ++et)
#pragma unroll
        for (int g4 = 0; g4 < 4; ++g4) { const int e0 = et * 32 + 8 * g4 + 4 * hh; const v2u gw = *(const v2u*)(gp + e0);
            const float g0 = bflo(gw.x), g1 = bfhi(gw.x), g2 = bflo(gw.y), g3 = bfhi(gw.y);
            v2u w; w.x = pk2(acc[et][4 * g4] * rn * g0 * sigmoidf_(g0), acc[et][4 * g4 + 1] * rn * g1 * sigmoidf_(g1));
            w.y = pk2(acc[et][4 * g4 + 2] * rn * g2 * sigmoidf_(g2), acc[et][4 * g4 + 3] * rn * g3 * sigmoidf_(g3));
            *(v2u*)(RET + e0) = w; }
}

__device__ __forceinline__ void p3_scans(const Ctx& C, const Args& a) {
    {
        const float* KV = a.out; bf16* PREV = (bf16*)((unsigned char*)a.out + 64 * MiB);
        for (int it = C.vcu * 512 + C.tid; it < 131072; it += C.G * 512) {
            const int elem = it * 4, b = elem >> 16, h = (elem >> 14) & 3, ed = elem & 16383;
            const float cd = exp2f(128.0f * lg2_gamma(h));
            f32x4 st = {0.f, 0.f, 0.f, 0.f};
#pragma unroll 4
            for (int c = 0; c < 32; ++c) { const size_t off = (size_t)((b * 32 + c) * 4 + h) * 16384 + ed;
                v2u w; w.x = pk2(st[0], st[1]); w.y = pk2(st[2], st[3]); *(v2u*)(PREV + off) = w;
                const f32x4 inc = *(const f32x4*)(KV + off); st = st * cd + inc; }
        }
    }
    {
        const float* E = (const float*)(a.ws + WS_S5E); float* X = (float*)(a.ws + WS_S5X); const float* L128 = (const float*)(a.ws + WS_S5C) + 2048;
        for (int it = C.vcu * 512 + C.tid; it < 8192; it += C.G * 512) {
            const int b = it >> 10, g = (it >> 6) & 15, p = it & 63;
            const float lr = L128[(g * 64 + p) * 2], li = L128[(g * 64 + p) * 2 + 1];
            float xr = 0.f, xi = 0.f;
            for (int n = 0; n < 32; ++n) { const size_t off = ((size_t)(b * 32 + n) * 16 + g) * 128 + p;
                X[off] = xr; X[off + 64] = xi;
                const float er = E[off], ei = E[off + 64];
                const float nr = lr * xr - li * xi + er, ni = lr * xi + li * xr + ei; xr = nr; xi = ni; }
        }
    }
}

__device__ __forceinline__ int f2key(float x) { int b = __builtin_bit_cast(int, x); return b >= 0 ? b : (b ^ 0x7fffffff); }
__device__ __forceinline__ float key2f(int k) { return __builtin_bit_cast(float, k >= 0 ? k : (k ^ 0x7fffffff)); }
__device__ __forceinline__ void ins16(int (&T)[16], int x) {
#pragma unroll
    for (int j = 0; j < 16; ++j) { const int hi = T[j] > x ? T[j] : x; x = T[j] > x ? x : T[j]; T[j] = hi; }
}
__device__ __forceinline__ void peer_topk_half(const Args& a, int tokbase, int hp, int c, int lane, int (&T)[16]) {
    const bf16* Q2 = (const bf16*)(a.ws + WS_Q2); const bf16* KEYS = (const bf16*)(a.ws + WS_KEYS);
    const int r = lane & 31, hh = lane >> 5;
    bf16x8 bq[8];
#pragma unroll
    for (int ks = 0; ks < 8; ++ks) bq[ks] = *(const bf16x8*)(Q2 + (size_t)(tokbase + r) * 2048 + hp * 256 + c * 128 + ks * 16 + 8 * hh);
#pragma unroll
    for (int j = 0; j < 16; ++j) T[j] = (int)0x80000000;
#pragma unroll
    for (int nt = 0; nt < 4; ++nt) {
        f32x16 s;
#pragma unroll
        for (int e = 0; e < 16; ++e) s[e] = 0.f;
#pragma unroll
        for (int ks = 0; ks < 8; ++ks) { const bf16x8 ak = *(const bf16x8*)(KEYS + ((size_t)((hp * 2 + c) * 128 + nt * 32 + r)) * 128 + ks * 16 + 8 * hh); s = mfma32(ak, bq[ks], s); }
#pragma unroll
        for (int e = 0; e < 16; ++e) { const int n = nt * 32 + (e & 3) + 8 * (e >> 2) + 4 * hh; ins16(T, (f2key(s[e]) & ~127) | n); }
    }
    int P[16];
#pragma unroll
    for (int j = 0; j < 16; ++j) P[j] = __shfl_xor(T[j], 32);
#pragma unroll
    for (int j = 0; j < 16; ++j) ins16(T, P[j]);
}
__device__ __forceinline__ void peer_topk_head(const Ctx& C, const Args& a, int tokbase, int hp) {
    const int lane = C.lane, r = lane & 31, hh = lane >> 5;
    int T0[16], T1[16];
    peer_topk_half(a, tokbase, hp, 0, lane, T0);
    peer_topk_half(a, tokbase, hp, 1, lane, T1);
    int F[16];
#pragma unroll
    for (int j = 0; j < 16; ++j) F[j] = (int)0x80000000;
#pragma unroll
    for (int i0 = 0; i0 < 16; ++i0)
#pragma unroll
        for (int i1 = 0; i1 < 16; ++i1)
            if ((i0 + 1) * (i1 + 1) <= 16) { const float v = key2f(T0[i0] & ~127) + key2f(T1[i1] & ~127); ins16(F, (f2key(v) & ~255) | (i0 * 16 + i1)); }
    LAS int* tab = (LAS int*)(C.lds + C.wave * 16384);
#pragma unroll
    for (int j = 0; j < 16; ++j) { tab[j * 64 + lane] = T0[j] & 127; tab[(16 + j) * 64 + lane] = T1[j] & 127; }
    LDS_WAIT(); asm volatile("" ::: "memory");
    const float m = key2f(F[0] & ~255);
    float e[16], sum = 0.f;
#pragma unroll
    for (int j = 0; j < 16; ++j) { e[j] = __expf(key2f(F[j] & ~255) - m); sum += e[j]; }
    const float inv = 1.0f / sum;
    const int tok = tokbase + r;
    int* IDX = (int*)(a.ws + WS_IDX) + (size_t)tok * 128 + hp * 16; float* WGT = (float*)(a.ws + WS_WGT) + (size_t)tok * 128 + hp * 16;
#pragma unroll
    for (int j = 0; j < 16; ++j) { const int id = F[j] & 255; const int k0 = tab[(id >> 4) * 64 + lane], k1 = tab[(16 + (id & 15)) * 64 + lane];
        if (hh == 0) IDX[j] = k0 * 128 + k1; else WGT[j] = e[j] * inv; }
    LDS_WAIT(); asm volatile("" ::: "memory");
}
typedef float f32x2v __attribute__((ext_vector_type(2)));
__device__ __forceinline__ void unpack16(const v4u a, const v4u b, float (&x)[16]) {
    const unsigned w[8] = {a.x, a.y, a.z, a.w, b.x, b.y, b.z, b.w};
#pragma unroll
    for (int i = 0; i < 8; ++i) { x[2 * i] = bflo(w[i]); x[2 * i + 1] = bfhi(w[i]); }
}
__device__ __forceinline__ void unpack16_fp8(const v4u a, float (&x)[16]) {
    const unsigned w[4] = {a.x, a.y, a.z, a.w};
#pragma unroll
    for (int i = 0; i < 4; ++i) { const f32x2v lo = __builtin_amdgcn_cvt_pk_f32_fp8((int)w[i], false), hi = __builtin_amdgcn_cvt_pk_f32_fp8((int)w[i], true);
        x[4 * i] = lo.x; x[4 * i + 1] = lo.y; x[4 * i + 2] = hi.x; x[4 * i + 3] = hi.y; }
}
__device__ __forceinline__ long mk64(unsigned lo, unsigned hi) { return (long)(((unsigned long long)hi << 32) | (unsigned long long)lo); }
__device__ __forceinline__ float dpp_swap1(float v) { return __builtin_bit_cast(float, __builtin_amdgcn_update_dpp(0, __builtin_bit_cast(int, v), 0xB1, 0xf, 0xf, true)); }
struct UHalf { v4u g[8]; };
__device__ __forceinline__ void pu_issue(const unsigned char* U8, const int* IDX, int hidx, int lane, UHalf& D) {
    const int row8 = lane >> 3, c8 = lane & 7;
#pragma unroll
    for (int j = 0; j < 8; ++j) { const int e = IDX[(size_t)hidx * 64 + j * 8 + row8]; D.g[j] = *(const v4u*)(U8 + (size_t)e * 128 + c8 * 16); }
}
__device__ __forceinline__ void pu_stage(LAS unsigned char* buf, int lane, const UHalf& D) {
    const int row8 = lane >> 3, c8 = lane & 7;
#pragma unroll
    for (int j = 0; j < 8; ++j) *(LAS v4u*)(buf + (j * 8 + row8) * 128 + ((c8 ^ row8) & 7) * 16) = D.g[j];
}
__device__ __forceinline__ void pu_bfrag(const bf16* xp, int r, long (&bfr)[4]) {
#pragma unroll
    for (int s4 = 0; s4 < 4; ++s4) {
        const v4u xw = *(const v4u*)(xp + 8 * s4);
        float xs[8] = {bflo(xw.x) * 16.f, bfhi(xw.x) * 16.f, bflo(xw.y) * 16.f, bfhi(xw.y) * 16.f, bflo(xw.z) * 16.f, bfhi(xw.z) * 16.f, bflo(xw.w) * 16.f, bfhi(xw.w) * 16.f};
        int h0 = __builtin_amdgcn_cvt_pk_fp8_f32(xs[0], xs[1], 0, false); h0 = __builtin_amdgcn_cvt_pk_fp8_f32(xs[2], xs[3], h0, true);
        int h1 = __builtin_amdgcn_cvt_pk_fp8_f32(xs[4], xs[5], 0, false); h1 = __builtin_amdgcn_cvt_pk_fp8_f32(xs[6], xs[7], h1, true);
        const f32x2v b0 = __builtin_amdgcn_cvt_pk_f32_fp8(h0, false), b1 = __builtin_amdgcn_cvt_pk_f32_fp8(h0, true), b2 = __builtin_amdgcn_cvt_pk_f32_fp8(h1, false), b3 = __builtin_amdgcn_cvt_pk_f32_fp8(h1, true);
        int l0 = __builtin_amdgcn_cvt_pk_fp8_f32(xs[0] - b0.x, xs[1] - b0.y, 0, false); l0 = __builtin_amdgcn_cvt_pk_fp8_f32(xs[2] - b1.x, xs[3] - b1.y, l0, true);
        int l1 = __builtin_amdgcn_cvt_pk_fp8_f32(xs[4] - b2.x, xs[5] - b2.y, 0, false); l1 = __builtin_amdgcn_cvt_pk_fp8_f32(xs[6] - b3.x, xs[7] - b3.y, l1, true);
        const bool odd = (r & 1) != 0;
        bfr[s4] = mk64((unsigned)(odd ? l0 : h0), (unsigned)(odd ? l1 : h1));
    }
}
__device__ __forceinline__ void pu_compute(const LAS unsigned char* buf, float* HPt, int r, int kq, const long (&bfr)[4]) {
    f32x4 res[4];
#pragma unroll
    for (int g = 0; g < 4; ++g) {
        const int row = g * 16 + r, sw = row & 7;
        const v4u a0 = *(const LAS v4u*)(buf + row * 128 + ((2 * kq) ^ sw) * 16), a1 = *(const LAS v4u*)(buf + row * 128 + ((2 * kq + 1) ^ sw) * 16);
        f32x4 acc = {0.f, 0.f, 0.f, 0.f};
        acc = __builtin_amdgcn_mfma_f32_16x16x32_fp8_fp8(mk64(a0.x, a0.y), bfr[0], acc, 0, 0, 0);
        acc = __builtin_amdgcn_mfma_f32_16x16x32_fp8_fp8(mk64(a0.z, a0.w), bfr[1], acc, 0, 0, 0);
        acc = __builtin_amdgcn_mfma_f32_16x16x32_fp8_fp8(mk64(a1.x, a1.y), bfr[2], acc, 0, 0, 0);
        acc = __builtin_amdgcn_mfma_f32_16x16x32_fp8_fp8(mk64(a1.z, a1.w), bfr[3], acc, 0, 0, 0);
#pragma unroll
        for (int i = 0; i < 4; ++i) acc[i] += dpp_swap1(acc[i]);
        res[g] = acc;
    }
    f32x4 o = res[0];
#pragma unroll
    for (int g = 1; g < 4; ++g) { const bool sel = (r == g);
#pragma unroll
        for (int i = 0; i < 4; ++i) o[i] = sel ? res[g][i] : o[i]; }
    if (r < 4) *(f32x4*)(HPt + r * 16 + 4 * kq) = o;
}
__device__ __forceinline__ void peer_u_wave(const Args& a, LAS unsigned char* wlds, int slab, int t0, int ntok, int lane) {
    const unsigned char* U8 = a.ws + WS_PU + (size_t)slab * (16384 * 128);
    const bf16* N2 = (const bf16*)(a.ws + WS_N2) + slab * 128;
    const int* IDX = (const int*)(a.ws + WS_IDX);
    float* HP = (float*)(a.ws + WS_HPART) + (size_t)slab * MTOK * 128;
    const int r = lane & 15, kq = lane >> 4, h0 = t0 * 2, hl = (t0 + ntok) * 2 - 1;
    UHalf dA, dB; long bfr[4];
    pu_issue(U8, IDX, h0, lane, dA);
    pu_stage(wlds, lane, dA);
    pu_issue(U8, IDX, h0 + 1, lane, dB);
#pragma unroll 1
    for (int t = t0; t < t0 + ntok; ++t) {
        const int h = 2 * t;
        pu_bfrag(N2 + (size_t)t * DM + kq * 32, r, bfr);
        pu_issue(U8, IDX, min(h + 2, hl), lane, dA); __builtin_amdgcn_sched_barrier(0);
        pu_compute(wlds, HP + (size_t)t * 128, r, kq, bfr); __builtin_amdgcn_sched_barrier(0);
        pu_stage(wlds + 8192, lane, dB); __builtin_amdgcn_sched_barrier(0);
        pu_issue(U8, IDX, min(h + 3, hl), lane, dB); __builtin_amdgcn_sched_barrier(0);
        pu_compute(wlds + 8192, HP + (size_t)t * 128 + 64, r, kq, bfr); __builtin_amdgcn_sched_barrier(0);
        pu_stage(wlds, lane, dA); __builtin_amdgcn_sched_barrier(0);
    }
}
__device__ __forceinline__ void peer_reduce(const Ctx& C, const Args& a) {
    const float* HP = (const float*)(a.ws + WS_HPART); const int* IDX = (const int*)(a.ws + WS_IDX); const float* WGT = (const float*)(a.ws + WS_WGT);
    const float* USC = (const float*)(a.ws + WS_PSC); const float* VSC = USC + 16384; float* ACT = (float*)(a.ws + WS_ACT);
    for (int it = C.vcu * 512 + C.tid; it < MTOK * 32; it += C.G * 512) {
        f32x4 h = {0.f, 0.f, 0.f, 0.f};
#pragma unroll
        for (int sl = 0; sl < 8; ++sl) h += *(const f32x4*)(HP + (size_t)sl * MTOK * 128 + (size_t)it * 4);
        const int4 e = *(const int4*)(IDX + (size_t)it * 4); const f32x4 w = *(const f32x4*)(WGT + (size_t)it * 4);
        f32x4 o;
        o[0] = gelu_tanh(h[0] * USC[e.x] * 0.0625f) * w[0] * VSC[e.x]; o[1] = gelu_tanh(h[1] * USC[e.y] * 0.0625f) * w[1] * VSC[e.y];
        o[2] = gelu_tanh(h[2] * USC[e.z] * 0.0625f) * w[2] * VSC[e.z]; o[3] = gelu_tanh(h[3] * USC[e.w] * 0.0625f) * w[3] * VSC[e.w];
        *(f32x4*)(ACT + (size_t)it * 4) = o;
    }
}
struct VIdx { int id0, id1; float ac0, ac1; };
struct VTok { v4u v[16]; float ac[16]; };
__device__ __forceinline__ void pv_idx(const int* IDX, const float* ACT, int t, int lane, VIdx& I) {
    I.id0 = IDX[(size_t)t * 128 + lane]; I.id1 = IDX[(size_t)t * 128 + 64 + lane]; I.ac0 = ACT[(size_t)t * 128 + lane]; I.ac1 = ACT[(size_t)t * 128 + 64 + lane];
}
__device__ __forceinline__ void pv_issue(const unsigned char* V8, int pr, int c8, const VIdx& I, VTok& D) {
#pragma unroll
    for (int i = 0; i < 16; ++i) {
        const int e = __shfl((i < 8) ? I.id0 : I.id1, (i & 7) * 8 + pr); D.ac[i] = __shfl((i < 8) ? I.ac0 : I.ac1, (i & 7) * 8 + pr);
        D.v[i] = *(const v4u*)(V8 + (size_t)e * 128 + c8 * 16);
    }
}
__device__ __forceinline__ void pv_compute(bf16* PO, int t, int lane, const VTok& D) {
    const int pr = lane >> 3, c8 = lane & 7;
    float out[16];
#pragma unroll
    for (int j = 0; j < 16; ++j) out[j] = 0.f;
#pragma unroll
    for (int i = 0; i < 16; ++i) {
        float vf[16]; unpack16_fp8(D.v[i], vf);
#pragma unroll
        for (int j = 0; j < 16; ++j) out[j] += D.ac[i] * vf[j];
    }
    float t8[8], t4[4], t2[2];
    { const bool up = (lane & 32) != 0;
#pragma unroll
      for (int q = 0; q < 8; ++q) { const float keep = up ? out[8 + q] : out[q], send = up ? out[q] : out[8 + q]; t8[q] = keep + __shfl_xor(send, 32); } }
    { const bool up = (lane & 16) != 0;
#pragma unroll
      for (int q = 0; q < 4; ++q) { const float keep = up ? t8[4 + q] : t8[q], send = up ? t8[q] : t8[4 + q]; t4[q] = keep + __shfl_xor(send, 16); } }
    { const bool up = (lane & 8) != 0;
#pragma unroll
      for (int q = 0; q < 2; ++q) { const float keep = up ? t4[2 + q] : t4[q], send = up ? t4[q] : t4[2 + q]; t2[q] = keep + __shfl_xor(send, 8); } }
    *(unsigned*)(PO + (size_t)t * DM + c8 * 16 + 2 * pr) = pk2(t2[0], t2[1]);
}
__device__ __forceinline__ void peer_v_wave(const Args& a, int slab, int t0, int ntok, int lane) {
    const unsigned char* V8 = a.ws + WS_PV + (size_t)slab * (16384 * 128);
    const int* IDX = (const int*)(a.ws + WS_IDX); const float* ACT = (const float*)(a.ws + WS_ACT);
    bf16* PO = (bf16*)(a.ws + WS_POUT) + slab * 128;
    const int pr = lane >> 3, c8 = lane & 7, tl = t0 + ntok - 1;
    VIdx iA, iB; VTok dA, dB;
    pv_idx(IDX, ACT, t0, lane, iA); pv_issue(V8, pr, c8, iA, dA); pv_idx(IDX, ACT, t0 + 1, lane, iB);
#pragma unroll 1
    for (int t = t0; t < t0 + ntok; t += 2) {
        pv_issue(V8, pr, c8, iB, dB); pv_idx(IDX, ACT, min(t + 2, tl), lane, iA); __builtin_amdgcn_sched_barrier(0);
        pv_compute(PO, t, lane, dA); __builtin_amdgcn_sched_barrier(0);
        pv_issue(V8, pr, c8, iA, dA); pv_idx(IDX, ACT, min(t + 3, tl), lane, iB); __builtin_amdgcn_sched_barrier(0);
        pv_compute(PO, t + 1, lane, dB); __builtin_amdgcn_sched_barrier(0);
    }
}
__device__ __forceinline__ void final_row(const Args& a, int tok, int lane) {
    float* hrow = a.out + (size_t)tok * DM + lane * 16; const float* gf = (const float*)a.in[25] + lane * 16;
    const bf16* po = (const bf16*)(a.ws + WS_POUT) + (size_t)tok * DM + lane * 16;
    float pf[16]; unpack16(*(const v4u*)po, *(const v4u*)(po + 8), pf);
    f32x4 h[4]; float ss = 0.f;
#pragma unroll
    for (int q = 0; q < 4; ++q) { h[q] = *(const f32x4*)(hrow + 4 * q);
#pragma unroll
        for (int e = 0; e < 4; ++e) { h[q][e] += pf[4 * q + e]; ss += h[q][e] * h[q][e]; } }
    const float rstd = 1.0f / sqrtf(wave_sum(ss) * (1.f / DM) + EPS);
#pragma unroll
    for (int q = 0; q < 4; ++q) *(f32x4*)(hrow + 4 * q) = h[q] * rstd * *(const f32x4*)(gf + 4 * q);
}


__device__ __forceinline__ void claim_slab_unit(const Ctx& C, unsigned* ctl, int pass, volatile LAS unsigned* MISC, int& slab, int& unit) {
    if (C.tid == 0) {
        const unsigned x = xb_xcc_id() & 7u; unsigned sl = 8u, un = 0u;
        for (unsigned k = 0; k < 8u; ++k) { const unsigned s2 = (x + k) & 7u; const unsigned u2 = xb_add(ctl + CW_Q + 1024 * pass + 64 * s2, 1u); if (u2 < 32u) { sl = s2; un = u2; break; } }
        MISC[16] = sl; MISC[17] = un;
    }
    __syncthreads();
    slab = (int)MISC[16]; unit = (int)MISC[17];
    __syncthreads();
}
__global__ void __launch_bounds__(NWAVES * 64, 2) mk_fwd(Args args) {
    extern __shared__ __attribute__((aligned(16))) unsigned char lds_raw[];
    Ctx C;
    C.lds = (LAS unsigned char*)lds_raw;
    C.wave = __builtin_amdgcn_readfirstlane((int)threadIdx.x >> 6); C.refresh();
    C.G = gridDim.x; { const int bx = blockIdx.x; C.vcu = (C.G % 8 == 0) ? (bx % 8) * (C.G / 8) + bx / 8 : bx; }
    volatile LAS unsigned* MISC = (volatile LAS unsigned*)(C.lds + MISC_OFF);
    if (C.tid < 128) MISC[C.tid] = 0u;
    __syncthreads();
    unsigned char* ws = args.ws;
    unsigned* ctl = (unsigned*)(ws + WS_CTL);
    XcdBarrier bar; bar.bar = ctl + CW_BAR; bar.x = 0; bar.st = nullptr;
#if !MK_PER_PHASE
    bar = xcd_barrier_post(ctl + CW_BAR, MISC + 8, C.tid == 0);
#define GRID_BAR() xcd_barrier(bar, C.wave)
#else
#define GRID_BAR() do { } while (0)
#endif
    const int lo = args.ph_lo, hi = args.ph_hi;
#define IN(k) (lo <= (k) && (k) < hi)
#define SEAM(k) do { if (IN((k) + 1)) GRID_BAR(); C.refresh(); } while (0)
#define REP(k) for (int rep_ = 0; rep_ < 1 + ((REPEAT_MASK >> (k)) & 1); ++rep_)
    bf16* XN = (bf16*)(ws + WS_A);
    if (IN(0)) { REP(0) { p0_prologue(C, args); __syncthreads(); } SEAM(0); }
    if (IN(1)) {
        REP(1) {
        run_gemm(C, XN, (const bf16*)(ws + WS_WIN_T), MTOK, NZ1, DM, FStore{(bf16*)(ws + WS_Z1), NZ1});
        run_gemm(C, (const bf16*)(ws + WS_MEMN), (const bf16*)(ws + WS_WMKV_T), MROWS, 512, DM, FKvm{(bf16*)(ws + WS_KM), (bf16*)(ws + WS_VT)});
        }
        SEAM(1);
    }
    if (IN(2)) {
        REP(2) { const int tile = C.vcu;
            _Pragma("unroll 1") for (int h = 0; h < 4; ++h) r1_unit(C, args, tile, h);
            _Pragma("unroll 1") for (int gi = 0; gi < 2; ++gi) s5a_wave(C, args, tile, C.wave + 8 * gi);
            _Pragma("unroll 1") for (int gi = 0; gi < 2; ++gi) ma_wave(C, args, tile, 2 * gi + (C.wave >> 2), C.wave & 3);
            __syncthreads();
        }
        SEAM(2);
    }
    if (IN(3)) { REP(3) { p3_scans(C, args); } SEAM(3); }
    if (IN(4)) {
        REP(4) { const int tile = C.vcu;
            _Pragma("unroll 1") for (int gi = 0; gi < 2; ++gi) r3_wave(C, args, tile, 2 * gi + (C.wave >> 2), C.wave & 3);
            _Pragma("unroll 1") for (int gi = 0; gi < 2; ++gi) s5c_wave(C, args, tile, C.wave + 8 * gi);
        }
        SEAM(4);
    }
    if (IN(5)) {
        REP(5) {
        run_gemm(C, XN, (const bf16*)(ws + WS_WIN_T) + (size_t)NZ1 * DM, MTOK, NGATE, DM, FSig{(bf16*)(ws + WS_G), NGATE});
        run_gemm(C, (const bf16*)(ws + WS_YG), (const bf16*)(ws + WS_WGLU_T), MTOK, 512, 256, FGlu{(bf16*)(ws + WS_SSM)});
        }
        SEAM(5);
    }
    if (IN(6)) {
        const bf16* Gt = (const bf16*)(ws + WS_G);
        REP(6) {
        run_gemm(C, (const bf16*)(ws + WS_RET), (const bf16*)(ws + WS_WBR_T), MTOK, DM, 512, FBranch<0>{Gt, 0, args.out, XN});
        run_gemm(C, (const bf16*)(ws + WS_SSM), (const bf16*)(ws + WS_WBS_T), MTOK, DM, 256, FBranch<1>{Gt, 1024, args.out, XN});
        run_gemm(C, (const bf16*)(ws + WS_MATTN), (const bf16*)(ws + WS_WBM_T), MTOK, DM, 256, FBranch<2>{Gt, 2048, args.out, XN});
        }
        SEAM(6);
    }
    if (IN(7)) { REP(7) { run_gemm(C, XN, (const bf16*)(ws + WS_WOUT_T), MTOK, DM, DM, FRes{(const float*)args.in[0], args.out}); } SEAM(7); }
    if (IN(8)) {
        const int gw = C.vcu * NWAVES + C.wave, NGW = C.G * NWAVES;
        REP(8) for (int m = gw; m < MTOK; m += NGW) rms_row_to_bf16(args.out + (size_t)m * DM, (const float*)args.in[20], (bf16*)(ws + WS_N2) + (size_t)m * DM, C.lane);
        SEAM(8);
    }
    if (IN(9)) { REP(9) run_gemm(C, (const bf16*)(ws + WS_N2), (const bf16*)(ws + WS_WQ_T), MTOK, 2048, DM, FStore{(bf16*)(ws + WS_Q2), 2048}); SEAM(9); }
    if (IN(10)) {
        { const int tile = C.vcu;
            const int tokbase = tile * 128 + (C.wave & 3) * 32, h0 = (C.wave >> 2) * 4;
            REP(10) { _Pragma("unroll 1") for (int hp = h0; hp < h0 + 4; ++hp) peer_topk_head(C, args, tokbase, hp); }
        }
        SEAM(10);
    }
    if (IN(11)) { int slab, unit; claim_slab_unit(C, ctl, 0, MISC, slab, unit); if (slab < 8) { REP(11) peer_u_wave(args, C.lds + C.wave * 16384, slab, unit * 1024 + C.wave * 128, 128, C.lane); } SEAM(11); }
    if (IN(12)) { REP(12) peer_reduce(C, args); SEAM(12); }
    if (IN(13)) { int slab, unit; claim_slab_unit(C, ctl, 1, MISC, slab, unit); if (slab < 8) { REP(13) peer_v_wave(args, slab, unit * 1024 + C.wave * 128, 128, C.lane); } SEAM(13); }
    if (IN(14)) {
        const int gw = C.vcu * NWAVES + C.wave, NGW = C.G * NWAVES;
        for (int m = gw; m < MTOK; m += NGW) final_row(args, m, C.lane);
    }
#undef IN
#undef SEAM
}

extern "C" void kernel_launch(void* const* d_in, const int* in_sizes, int n_in, void* d_out, int out_size, void* d_ws, size_t ws_size, hipStream_t stream) {
    static int grid = 0;
    if (grid == 0) {
        if (n_in != 26 || in_sizes[0] != MTOK * DM || out_size != MTOK * DM || ws_size < WS_END) {
            fprintf(stderr, "kernel_launch: unexpected problem (n_in %d, in0 %d, out %d, ws %zu < %zu); nothing launched\n", n_in, n_in > 0 ? in_sizes[0] : -1, out_size, ws_size, (size_t)WS_END); grid = -1; return; }
        int dev = 0, cus = 0;
        if (hipGetDevice(&dev) != hipSuccess || hipDeviceGetAttribute(&cus, hipDeviceAttributeMultiprocessorCount, dev) != hipSuccess) { grid = -1; return; }
        if (hipFuncSetAttribute((const void*)mk_fwd, hipFuncAttributeMaxDynamicSharedMemorySize, LDS_BYTES) != hipSuccess) { fprintf(stderr, "kernel_launch: hipFuncSetAttribute failed\n"); grid = -1; return; }
        (void)hipGetLastError();
        if (cus < NTILES) { fprintf(stderr, "kernel_launch: needs >= 256 CUs, got %d\n", cus); grid = -1; return; }
        grid = NTILES;
    }
    if (grid < 0) return;
    (void)hipMemsetAsync((char*)d_ws + WS_CTL, 0, CTL_ZERO_BYTES, stream);
    Args a{};
    for (int i = 0; i < 26; ++i) a.in[i] = d_in[i];
    a.out = (float*)d_out; a.ws = (unsigned char*)d_ws;
#if MK_PER_PHASE
    for (int p = 0; p < NPHASE; ++p) { a.ph_lo = p; a.ph_hi = p + 1; hipLaunchKernelGGL(mk_fwd, dim3(grid), dim3(NWAVES * 64), LDS_BYTES, stream, a); }
#else
    a.ph_lo = 0; a.ph_hi = NPHASE;
    hipLaunchKernelGGL(mk_fwd, dim3(grid), dim3(NWAVES * 64), LDS_BYTES, stream, a);
#endif
}
```

```cpp
#include <hip/hip_runtime.h>
#include <cstdio>
#include <cstdint>
namespace pg8 {
__device__ __forceinline__ int hw_lane_id() { int l; asm volatile("v_mbcnt_lo_u32_b32 %0, -1, 0\n\tv_mbcnt_hi_u32_b32 %0, -1, %0" : "=v"(l)); return l; }
#define PG8_LAS __attribute__((address_space(3)))
typedef unsigned short bf16_t;
typedef short bf16x8 __attribute__((ext_vector_type(8)));
typedef float f32x4 __attribute__((ext_vector_type(4)));
typedef unsigned u32x4 __attribute__((ext_vector_type(4)));
constexpr int BM = 256, BK = 64, HALF = 128, HTB = HALF * BK * 2  , STAGE_BYTES = 8 * HTB, NXCD = 8, WGM = 8;

__host__ __device__ __forceinline__ int lds_byte(int r, int c) { const int st = (r >> 4) * 2 + (c >> 5), rr = r & 15, cc = c & 31, ob = rr * 64 + cc * 2; return st * 1024 + (ob ^ (((ob >> 9) & 1) << 5)); }
__host__ __device__ __forceinline__ void stage_rc(int b, int& R, int& C) { const int st = b / 1024, sb = b % 1024, swz = sb ^ (((sb >> 9) & 1) << 5); R = (st >> 1) * 16 + swz / 64; C = (st & 1) * 32 + (swz % 64) / 2; }
__host__ __device__ __forceinline__ int perm32(int rho) { const int n = rho >> 4, i = rho & 15; return 8 * (i >> 2) + 4 * n + (i & 3); }

struct Unit { int pm, pn; };
struct Gemm { const bf16_t* A; const bf16_t* Bt; int M, N, K; };

struct StaticOrder {
    int nM, nN, nwg, G, c;
    __host__ __device__ void init(int M, int N, int G_, int c_) { nM = M / BM; nN = N / BM; nwg = nM * nN; G = G_; c = c_; }
    __host__ __device__ bool next(int i, Unit& u) const {
        const long L = (long)i * G + c; if (L >= nwg) return false;
        int wgid = (int)L; { const int q = nwg / NXCD, r = nwg % NXCD, xcd = wgid % NXCD, off = wgid / NXCD; wgid = (xcd < r ? xcd * (q + 1) : r * (q + 1) + (xcd - r) * q) + off; }
        const int nig = WGM * nN, gid = wgid / nig, fm = gid * WGM, gsz = (nM - fm) < WGM ? (nM - fm) : WGM;
        u.pm = fm + ((wgid % nig) % gsz); u.pn = (wgid % nig) / gsz; return true;
    }
    __device__ __forceinline__ void a_ready(const Unit&) const {}
    __device__ __forceinline__ void done(const Unit&) const {}
};

__device__ __forceinline__ unsigned cvt_pk_bf16(float lo, float hi) { unsigned r; asm volatile("v_cvt_pk_bf16_f32 %0, %1, %2" : "=v"(r) : "v"(lo), "v"(hi)); return r; }
template <class Epi, class Sched, bool ALIGN_EPI = false, bool SP2 = false>
__device__ __forceinline__ void gemm_phase(PG8_LAS unsigned char* lds, const Gemm g, const Sched& S, const Epi& E, const int wid) {
    const int lane = hw_lane_id(), tid = wid * 64 + lane, wr = wid >> 2, wc = wid & 3, fr = lane & 15, fq = lane >> 4;
    const int K = g.K, nt = K / BK;
    unsigned voffA[2], voffB[2];
#pragma unroll
    for (int i = 0; i < 2; ++i) { int R, C; stage_rc(tid * 16 + i * 8192, R, C); const int Rb = Epi::PERM ? ((R & ~31) + perm32(R & 31)) : R;
        voffA[i] = (unsigned)(R * K + C) * 2u; voffB[i] = (unsigned)(Rb * K + C) * 2u; }
    const size_t kstep = (size_t)(BK * 2);
    const size_t hstep = (size_t)HALF * K * 2;
    const size_t tstep = 2 * hstep;
    const unsigned ldsw = (unsigned)wid * 1024u;
    const int aoff = lds_byte(wr * 64 + fr, fq * 8), boff = lds_byte(wc * 32 + fr, fq * 8);
#define PG8_SA(b, h) (((b) * 2 + (h)) * HTB)
#define PG8_SB(b, h) ((4 + (b) * 2 + (h)) * HTB)
#define PG8_STAGE(bufoff, gbase, voff) do { _Pragma("unroll") for (int _i = 0; _i < 2; ++_i) \
        __builtin_amdgcn_global_load_lds((const unsigned*)((const char*)(gbase) + (voff)[_i]), (PG8_LAS unsigned*)(lds + (bufoff) + ldsw + _i * 8192), 16, 0, 0); } while (0)
#define PG8_LDA(dst, b, h) do { _Pragma("unroll") for (int m = 0; m < 4; ++m) _Pragma("unroll") for (int k = 0; k < 2; ++k) dst[m][k] = *(const PG8_LAS bf16x8*)(lds + PG8_SA(b, h) + aoff + m * 2048 + k * 1024); } while (0)
#define PG8_LDB(dst, b, h) do { _Pragma("unroll") for (int n = 0; n < 2; ++n) _Pragma("unroll") for (int k = 0; k < 2; ++k) dst[n][k] = *(const PG8_LAS bf16x8*)(lds + PG8_SB(b, h) + boff + n * 2048 + k * 1024); } while (0)
#define PG8_MMA(ai, bj, At, Bt) do { __builtin_amdgcn_s_setprio(1); _Pragma("unroll") for (int m = 0; m < 4; ++m) _Pragma("unroll") for (int n = 0; n < 2; ++n) _Pragma("unroll") for (int k = 0; k < 2; ++k) \
        acc[ai][bj][m][n] = __builtin_amdgcn_mfma_f32_16x16x32_bf16(Bt[n][k], At[m][k], acc[ai][bj][m][n], 0, 0, 0); __builtin_amdgcn_s_setprio(0); } while (0)
#define PG8_WAIT_V(n) asm volatile("s_waitcnt vmcnt(" #n ")" ::: "memory")
#define PG8_WAIT_L(n) asm volatile("s_waitcnt lgkmcnt(" #n ")" ::: "memory")
#define PG8_BAR __builtin_amdgcn_s_barrier()
#define PG8_SCHED __builtin_amdgcn_sched_barrier(0)
    Unit cur, nxt; int ui = 0;
    if (!S.next(0, cur)) return;
    f32x4 acc[2][2][4][2];
#pragma unroll
    for (int a = 0; a < 2; ++a)
#pragma unroll
        for (int b = 0; b < 2; ++b)
#pragma unroll
            for (int m = 0; m < 4; ++m)
#pragma unroll
                for (int n = 0; n < 2; ++n) acc[a][b][m][n] = (f32x4){0.f, 0.f, 0.f, 0.f};
    bf16x8 At[4][2], B0[2][2], B1[2][2];
    const char* cA = (const char*)g.A + (size_t)cur.pm * tstep; const char* cB = (const char*)g.Bt + (size_t)cur.pn * tstep;
    S.a_ready(cur);
    if constexpr (SP2) {
        PG8_STAGE(PG8_SB(0, 0), cB, voffB); PG8_STAGE(PG8_SB(0, 1), cB + hstep, voffB); PG8_STAGE(PG8_SA(0, 0), cA, voffA); PG8_STAGE(PG8_SA(0, 1), cA + hstep, voffA);
        if (wr == 1) PG8_BAR;
        PG8_WAIT_V(2); PG8_BAR;
        PG8_STAGE(PG8_SB(1, 0), cB + kstep, voffB); PG8_STAGE(PG8_SA(1, 0), cA + kstep, voffA); PG8_STAGE(PG8_SB(1, 1), cB + hstep + kstep, voffB);
        PG8_WAIT_V(6); PG8_BAR;
    } else {
        PG8_STAGE(PG8_SB(0, 0), cB, voffB); PG8_STAGE(PG8_SA(0, 0), cA, voffA); PG8_STAGE(PG8_SB(0, 1), cB + hstep, voffB); PG8_STAGE(PG8_SA(0, 1), cA + hstep, voffA);
        if (wr == 1) PG8_BAR;
        PG8_WAIT_V(4); PG8_BAR;
        PG8_STAGE(PG8_SB(1, 0), cB + kstep, voffB); PG8_STAGE(PG8_SA(1, 0), cA + kstep, voffA); PG8_STAGE(PG8_SB(1, 1), cB + hstep + kstep, voffB);
        PG8_WAIT_V(6); PG8_BAR;
    }
    for (;;) {
        const bool has_next = S.next(ui + 1, nxt);
        const char* nA = has_next ? (const char*)g.A + (size_t)nxt.pm * tstep : cA; const char* nB = has_next ? (const char*)g.Bt + (size_t)nxt.pn * tstep : cB;
        for (int t = 0; t < nt; t += 2) {
            const bool last = (t == nt - 2);
            const char* a1 = cA + (size_t)(t + 1) * kstep;
            const char* a2 = last ? nA : cA + (size_t)(t + 2) * kstep; const char* b2 = last ? nB : cB + (size_t)(t + 2) * kstep;
            const char* a3 = a2 + kstep; const char* b3 = b2 + kstep;
            if (last && has_next) S.a_ready(nxt);
            if constexpr (SP2) {
            PG8_LDB(B0, 0, 0); PG8_LDB(B1, 0, 1); PG8_SCHED; PG8_LDA(At, 0, 0); PG8_STAGE(PG8_SA(1, 1), a1 + hstep, voffA);
            PG8_WAIT_V(8); PG8_WAIT_L(0); PG8_BAR; PG8_MMA(0, 0, At, B0); PG8_MMA(0, 1, At, B1); PG8_BAR; PG8_SCHED;
            PG8_LDA(At, 0, 1); PG8_STAGE(PG8_SB(0, 0), b2, voffB); PG8_STAGE(PG8_SB(0, 1), b2 + hstep, voffB); PG8_STAGE(PG8_SA(0, 0), a2, voffA);
            PG8_WAIT_V(8); PG8_WAIT_L(0); PG8_BAR; PG8_MMA(1, 0, At, B0); PG8_MMA(1, 1, At, B1); PG8_BAR; PG8_SCHED;
            PG8_LDB(B0, 1, 0); PG8_LDB(B1, 1, 1); PG8_SCHED; PG8_LDA(At, 1, 0); PG8_STAGE(PG8_SA(0, 1), a2 + hstep, voffA);
            PG8_WAIT_V(8); PG8_WAIT_L(0); PG8_BAR; PG8_MMA(0, 0, At, B0); PG8_MMA(0, 1, At, B1); PG8_BAR; PG8_SCHED;
            PG8_LDA(At, 1, 1); PG8_STAGE(PG8_SB(1, 0), b3, voffB); PG8_STAGE(PG8_SB(1, 1), b3 + hstep, voffB); PG8_STAGE(PG8_SA(1, 0), a3, voffA);
            PG8_WAIT_V(8); PG8_WAIT_L(0); PG8_BAR; PG8_MMA(1, 0, At, B0); PG8_MMA(1, 1, At, B1); PG8_BAR; PG8_SCHED;
            } else {
            PG8_LDB(B0, 0, 0); PG8_SCHED; PG8_LDA(At, 0, 0); PG8_STAGE(PG8_SA(1, 1), a1 + hstep, voffA);
            PG8_WAIT_L(8); PG8_BAR; PG8_WAIT_L(0); PG8_MMA(0, 0, At, B0); PG8_BAR; PG8_SCHED;
            PG8_LDB(B1, 0, 1); PG8_STAGE(PG8_SB(0, 0), b2, voffB);
            PG8_BAR; PG8_WAIT_L(0); PG8_MMA(0, 1, At, B1); PG8_BAR;
            PG8_LDA(At, 0, 1); PG8_STAGE(PG8_SA(0, 0), a2, voffA);
            PG8_BAR; PG8_WAIT_L(0); PG8_MMA(1, 0, At, B0); PG8_BAR; PG8_SCHED;
            PG8_STAGE(PG8_SB(0, 1), b2 + hstep, voffB);
            PG8_WAIT_V(6); PG8_BAR; PG8_MMA(1, 1, At, B1); PG8_BAR;
            PG8_LDB(B0, 1, 0); PG8_SCHED; PG8_LDA(At, 1, 0); PG8_STAGE(PG8_SA(0, 1), a2 + hstep, voffA);
            PG8_WAIT_L(8); PG8_BAR; PG8_WAIT_L(0); PG8_MMA(0, 0, At, B0); PG8_BAR; PG8_SCHED;
            PG8_LDB(B1, 1, 1); PG8_STAGE(PG8_SB(1, 0), b3, voffB);
            PG8_BAR; PG8_WAIT_L(0); PG8_MMA(0, 1, At, B1); PG8_BAR;
            PG8_LDA(At, 1, 1); PG8_STAGE(PG8_SA(1, 0), a3, voffA);
            PG8_BAR; PG8_WAIT_L(0); PG8_MMA(1, 0, At, B0); PG8_BAR; PG8_SCHED;
            PG8_STAGE(PG8_SB(1, 1), b3 + hstep, voffB);
            PG8_WAIT_V(6); PG8_BAR; PG8_MMA(1, 1, At, B1); PG8_BAR;
            }
        }
        if constexpr (ALIGN_EPI) { if (wr == 0) PG8_BAR; }
        if constexpr (!Epi::AFTER_DRAIN) { E(acc, cur, wr, wc, fr, fq); S.done(cur); }
        if (!has_next) break;
#pragma unroll
        for (int a = 0; a < 2; ++a)
#pragma unroll
            for (int b = 0; b < 2; ++b)
#pragma unroll
                for (int m = 0; m < 4; ++m)
#pragma unroll
                    for (int n = 0; n < 2; ++n) acc[a][b][m][n] = (f32x4){0.f, 0.f, 0.f, 0.f};
        cur = nxt; cA = nA; cB = nB; ++ui;
        if constexpr (ALIGN_EPI) { if (wr == 1) PG8_BAR; }
    }
    PG8_WAIT_V(0);
    if constexpr (!ALIGN_EPI) { if (wr == 0) PG8_BAR; }
    PG8_BAR;
    if constexpr (Epi::AFTER_DRAIN) { E.fused(acc, cur, wr, wc, fr, fq, lds, wid, lane); S.done(cur); }
#undef PG8_SA
#undef PG8_SB
#undef PG8_STAGE
#undef PG8_LDA
#undef PG8_LDB
#undef PG8_MMA
#undef PG8_WAIT_V
#undef PG8_WAIT_L
#undef PG8_BAR
#undef PG8_SCHED
}
}

#ifndef REPEAT_MASK
#define REPEAT_MASK 0
#endif
#ifndef MK_PER_PHASE
#define MK_PER_PHASE 0
#endif

constexpr int DM = 1024, BATCH = 8, SEQ = 4096, MTOK = BATCH * SEQ;
constexpr int MEMLEN = 256, MROWS = BATCH * MEMLEN;
constexpr int NZ1 = 2560, NGATE = 3072;
constexpr int ZQ = 0, ZK = 512, ZV = 1024, ZGR = 1536, ZU = 2048, ZQM = 2304;
constexpr int NTILES = MTOK / 128;
constexpr float EPS = 1e-6f;
constexpr int NPHASE = 15;

constexpr size_t MiB = 1u << 20;
constexpr size_t WS_CTL = 0, CTL_ZERO_BYTES = 1 * MiB;
constexpr size_t WS_WIN_T = 1 * MiB;
constexpr size_t WS_WQ_T = 12 * MiB;
constexpr size_t WS_WOUT_T = 16 * MiB;
constexpr size_t WS_WBR_T = 18 * MiB;
constexpr size_t WS_WBS_T = 19 * MiB;
constexpr size_t WS_WBM_T = 19 * MiB + 512 * 1024;
constexpr size_t WS_WGLU_T = 20 * MiB;
constexpr size_t WS_WMKV_T = 21 * MiB;
constexpr size_t WS_KEYS = 22 * MiB;
constexpr size_t WS_S5MAT = 23 * MiB;
constexpr size_t WS_S5C = 25 * MiB;
constexpr size_t WS_PSC = 25 * MiB + 256 * 1024;
constexpr size_t WS_SS = 25 * MiB + 512 * 1024;
constexpr size_t WS_ROPE = 26 * MiB;
constexpr size_t WS_PU = 42 * MiB;
constexpr size_t WS_PV = 74 * MiB;
constexpr size_t WS_MEMN = 106 * MiB;
constexpr size_t WS_KM = 110 * MiB;
constexpr size_t WS_VT = 111 * MiB;
constexpr size_t WS_S5E = 112 * MiB;
constexpr size_t WS_S5X = 114 * MiB;
constexpr size_t WS_A = 116 * MiB;
constexpr size_t WS_B = 180 * MiB;
constexpr size_t WS_Z1 = WS_B;
constexpr size_t WS_G = WS_B;
constexpr size_t WS_RET = WS_B + 192 * MiB;
constexpr size_t WS_SSM = WS_B + 224 * MiB;
constexpr size_t WS_MATTN = WS_B + 240 * MiB;
constexpr size_t WS_YG = WS_B + 256 * MiB;
constexpr size_t WS_INNER = WS_B + 272 * MiB;
constexpr size_t WS_N2 = WS_B;
constexpr size_t WS_Q2 = WS_B + 64 * MiB;
constexpr size_t WS_IDX = WS_B + 192 * MiB;
constexpr size_t WS_WGT = WS_B + 208 * MiB;
constexpr size_t WS_HPART = WS_B + 64 * MiB;
constexpr size_t WS_ACT = WS_B + 224 * MiB;
constexpr size_t WS_POUT = WS_B + 64 * MiB;
constexpr size_t WS_END = WS_B + 304 * MiB;

constexpr int CW_BAR = 4096;
constexpr int CW_Q = 8192;

constexpr int LDS_BYTES = 147456;
constexpr int MISC_OFF = LDS_BYTES - 512;
constexpr int NWAVES = 8;

#define GAS __attribute__((address_space(1)))
#define LAS __attribute__((address_space(3)))
typedef unsigned short bf16;
typedef unsigned v4u __attribute__((ext_vector_type(4)));
typedef unsigned v2u __attribute__((ext_vector_type(2)));
typedef float f32x4 __attribute__((ext_vector_type(4)));
typedef float f32x16 __attribute__((ext_vector_type(16)));
typedef short bf16x8 __attribute__((ext_vector_type(8)));
typedef GAS unsigned gu32;
#define RLX_AGENT __ATOMIC_RELAXED, __HIP_MEMORY_SCOPE_AGENT
#define LDS_WAIT() asm volatile("s_waitcnt lgkmcnt(0)" ::: "memory")
#define VM_WAIT() asm volatile("s_waitcnt vmcnt(0)" ::: "memory")
__device__ __forceinline__ unsigned f2bf(float f) { unsigned u = __builtin_bit_cast(unsigned, f); return (u + 0x7fffu + ((u >> 16) & 1u)) >> 16; }
__device__ __forceinline__ unsigned pk2(float lo, float hi) { return f2bf(lo) | (f2bf(hi) << 16); }
__device__ __forceinline__ float bflo(unsigned w) { return __builtin_bit_cast(float, w << 16); }
__device__ __forceinline__ float bfhi(unsigned w) { return __builtin_bit_cast(float, w & 0xffff0000u); }
__device__ __forceinline__ float bf2f(bf16 h) { return __builtin_bit_cast(float, (unsigned)h << 16); }
__device__ __forceinline__ f32x16 mfma32(bf16x8 a, bf16x8 b, f32x16 c) { return __builtin_amdgcn_mfma_f32_32x32x16_bf16(a, b, c, 0, 0, 0); }
__device__ __forceinline__ f32x4 mfma16(bf16x8 a, bf16x8 b, f32x4 c) { return __builtin_amdgcn_mfma_f32_16x16x32_bf16(a, b, c, 0, 0, 0); }
__device__ __forceinline__ bf16x8 mk8(unsigned a, unsigned b, unsigned c, unsigned d) { v4u t = {a, b, c, d}; return __builtin_bit_cast(bf16x8, t); }
__device__ __forceinline__ float sigmoidf_(float x) { return 1.0f / (1.0f + __expf(-x)); }
__device__ __forceinline__ float gelu_tanh(float x) {
    const float u = 0.7978845608028654f * (x + 0.044715f * x * x * x);
    const float e = __expf(2.0f * u);
    const float th = 1.0f - 2.0f / (e + 1.0f);
    return 0.5f * x * (1.0f + th);
}
__device__ __forceinline__ float wave_sum(float v) {
#pragma unroll
    for (int o = 1; o < 64; o <<= 1) v += __shfl_xor(v, o);
    return v;
}

#define XB_TMO      128
#define XB_XCNT(j)  (256  + 64 * (j))
#define XB_XSUB(j)  (1280 + 64 * (j))
#define XB_XGEN(j)  (2304 + 64 * (j))
#define XB_TOP      3328
#define XB_TOPGEN   3392
#define XCD_BAR_WORDS 3456
#define XB_SPIN_CAP (1u << 22)

__device__ __forceinline__ unsigned xb_ld(unsigned* p)              { return __hip_atomic_load(p, __ATOMIC_RELAXED, __HIP_MEMORY_SCOPE_AGENT); }
__device__ __forceinline__ unsigned xb_add(unsigned* p, unsigned v) { return __hip_atomic_fetch_add(p, v, __ATOMIC_RELAXED, __HIP_MEMORY_SCOPE_AGENT); }
__device__ __forceinline__ unsigned xb_xcc_id() { return (unsigned)__builtin_amdgcn_s_getreg((3 << 11) | 20) & 0xFu; }
#define XB_SPIN(cond, bar) do { unsigned _sp = 0; while (cond) { __builtin_amdgcn_s_sleep(1); \
    if ((++_sp & 255u) == 0u) { if (xb_ld(&(bar)[XB_TMO])) break; if (_sp > XB_SPIN_CAP) { atomicAdd(&(bar)[XB_TMO], 1u); break; } } } } while (0)

struct XcdBarrier { unsigned* bar; unsigned x; volatile LAS unsigned* st; };

__device__ __forceinline__ XcdBarrier xcd_barrier_post(unsigned* bar, volatile LAS unsigned* st, bool tid0) {
    XcdBarrier b; b.bar = bar; b.x = xb_xcc_id(); b.st = st;
    if (tid0) (void)xb_add(&bar[XB_XCNT(b.x)], 1u);
    return b;
}
__device__ __forceinline__ void xcd_barrier_complete(unsigned* bar, unsigned x, unsigned& nloc, unsigned& nx) {
    const unsigned G = gridDim.x * gridDim.y * gridDim.z;
    unsigned sum, cnt, mine, sp = 0u;
    for (;;) {
        sum = 0u; cnt = 0u; mine = 0u;
#pragma unroll
        for (unsigned j = 0; j < 16; ++j) { const unsigned c = xb_ld(&bar[XB_XCNT(j)]); sum += c; cnt += (c > 0u) ? 1u : 0u; mine = (j == x) ? c : mine; }
        if (sum == G) break;
        __builtin_amdgcn_s_sleep(1);
        if ((++sp & 255u) == 0u) { if (xb_ld(&bar[XB_TMO])) break; if (sp > XB_SPIN_CAP) { atomicAdd(&bar[XB_TMO], 1u); break; } }
    }
    nloc = mine > 0u ? mine : 1u; nx = cnt > 0u ? cnt : 1u;
}
__device__ __forceinline__ void xcd_barrier(const XcdBarrier& b, int wave) {
    asm volatile("s_waitcnt vmcnt(0)" ::: "memory");
    __syncthreads();
    if (wave == 0 && pg8::hw_lane_id() == 0) {
        unsigned* bar = b.bar;
        __builtin_amdgcn_s_waitcnt(0);
        unsigned nloc = b.st[0], nx = b.st[1];
        if (nloc == 0u) { xcd_barrier_complete(bar, b.x, nloc, nx); b.st[0] = nloc; b.st[1] = nx; }
        const unsigned old = xb_add(&bar[XB_XSUB(b.x)], 1u);
        const unsigned gen = old / nloc;
        if (old + 1u == (gen + 1u) * nloc) {
            __builtin_amdgcn_fence(__ATOMIC_RELEASE, "agent");
            asm volatile("s_waitcnt vmcnt(0)" ::: "memory");
            const unsigned og = xb_add(&bar[XB_TOP], 1u);
            const unsigned tg = og / nx;
            if (og + 1u == (tg + 1u) * nx) xb_add(&bar[XB_TOPGEN], 1u);
            else XB_SPIN(xb_ld(&bar[XB_TOPGEN]) == tg, bar);
            __builtin_amdgcn_fence(__ATOMIC_ACQUIRE, "agent");
            xb_add(&bar[XB_XGEN(b.x)], 1u);
            asm volatile("s_waitcnt vmcnt(0)" ::: "memory");
        } else {
            XB_SPIN(xb_ld(&bar[XB_XGEN(b.x)]) == gen, bar);
            __builtin_amdgcn_fence(__ATOMIC_ACQUIRE, "agent");
            asm volatile("s_waitcnt vmcnt(0)" ::: "memory");
        }
    }
    __syncthreads();
}

struct Args { const void* in[26]; float* out; unsigned char* ws; int ph_lo, ph_hi; };
struct Ctx {
    LAS unsigned char* lds;
    int tid, lane, wave, vcu, G;
    __device__ __forceinline__ void refresh() { lane = pg8::hw_lane_id(); tid = wave * 64 + lane; }
};

template <class F> struct EpiT {
    static constexpr bool PERM = true, AFTER_DRAIN = false;
    F f;
    __device__ __forceinline__ void operator()(const f32x4 (&acc)[2][2][4][2], const pg8::Unit& u, int wr, int wc, int fr, int fq) const {
        const int row0 = u.pm * 256 + wr * 64 + fr, col0 = u.pn * 256 + wc * 32 + 8 * fq;
        typename F::L cur[2], nxt[2];
        f.load(row0, col0, cur[0]); f.load(row0, col0 + 128, cur[1]);
#pragma unroll
        for (int i = 0; i < 8; ++i) {
            const int ai = i >> 2, m = i & 3, row = row0 + ai * 128 + m * 16;
            if (i < 7) { const int rown = row0 + ((i + 1) >> 2) * 128 + ((i + 1) & 3) * 16; f.load(rown, col0, nxt[0]); f.load(rown, col0 + 128, nxt[1]); }
            __builtin_amdgcn_sched_barrier(0);
            f.apply(row, col0, acc[ai][0][m][0], acc[ai][0][m][1], cur[0]); f.apply(row, col0 + 128, acc[ai][1][m][0], acc[ai][1][m][1], cur[1]);
            __builtin_amdgcn_sched_barrier(0);
            cur[0] = nxt[0]; cur[1] = nxt[1];
        }
    }
};
__device__ __forceinline__ v4u pack8(f32x4 a, f32x4 b) { v4u w; w.x = pk2(a[0], a[1]); w.y = pk2(a[2], a[3]); w.z = pk2(b[0], b[1]); w.w = pk2(b[2], b[3]); return w; }
struct LNone {};
struct FStore { typedef LNone L; bf16* O; int ldc;
    __device__ __forceinline__ void load(int, int, L&) const {}
    __device__ __forceinline__ void apply(int row, int col, f32x4 v0, f32x4 v1, const L&) const { *(v4u*)(O + (size_t)row * ldc + col) = pack8(v0, v1); } };
struct FKvm { typedef LNone L; bf16* KM; bf16* VT;
    __device__ __forceinline__ void load(int, int, L&) const {}
    __device__ __forceinline__ void apply(int row, int col, f32x4 v0, f32x4 v1, const L&) const {
        if (col < 256) { *(v4u*)(KM + (size_t)row * 256 + col) = pack8(v0, v1); }
        else { const int c = col - 256, b = row >> 8, m = row & 255; bf16* p = VT + ((size_t)(b * 256 + c)) * 256 + m;
#pragma unroll
            for (int j = 0; j < 4; ++j) { p[(size_t)j * 256] = (bf16)f2bf(v0[j]); p[(size_t)(j + 4) * 256] = (bf16)f2bf(v1[j]); } }
    } };
struct FSig { typedef LNone L; bf16* O; int ldc;
    __device__ __forceinline__ void load(int, int, L&) const {}
    __device__ __forceinline__ void apply(int row, int col, f32x4 v0, f32x4 v1, const L&) const {
#pragma unroll
        for (int j = 0; j < 4; ++j) { v0[j] = sigmoidf_(v0[j]); v1[j] = sigmoidf_(v1[j]); }
        *(v4u*)(O + (size_t)row * ldc + col) = pack8(v0, v1); } };
struct FGlu { typedef LNone L; bf16* O;
    __device__ __forceinline__ void load(int, int, L&) const {}
    __device__ __forceinline__ void apply(int row, int col, f32x4 v0, f32x4 v1, const L&) const {
        v2u w; w.x = pk2(v0[0] * sigmoidf_(v1[0]), v0[1] * sigmoidf_(v1[1])); w.y = pk2(v0[2] * sigmoidf_(v1[2]), v0[3] * sigmoidf_(v1[3]));
        *(v2u*)(O + (size_t)row * 256 + (col >> 1)) = w; } };
struct LBranch { v4u g; f32x4 m0, m1; };
template <int MODE> struct FBranch { typedef LBranch L; const bf16* Gt; int goff; float* MF; bf16* MB;
    __device__ __forceinline__ void load(int row, int col, L& l) const {
        l.g = *(const v4u*)(Gt + (size_t)row * NGATE + goff + col);
        if (MODE >= 1) { const float* mp = MF + (size_t)row * DM + col; l.m0 = *(const f32x4*)mp; l.m1 = *(const f32x4*)(mp + 4); } }
    __device__ __forceinline__ void apply(int row, int col, f32x4 v0, f32x4 v1, const L& l) const {
        const v4u g = l.g;
        v0[0] *= bflo(g.x); v0[1] *= bfhi(g.x); v0[2] *= bflo(g.y); v0[3] *= bfhi(g.y);
        v1[0] *= bflo(g.z); v1[1] *= bfhi(g.z); v1[2] *= bflo(g.w); v1[3] *= bfhi(g.w);
        if (MODE >= 1) { v0 += l.m0; v1 += l.m1; }
        if (MODE <= 1) { float* mp = MF + (size_t)row * DM + col; *(f32x4*)mp = v0; *(f32x4*)(mp + 4) = v1; }
        else *(v4u*)(MB + (size_t)row * DM + col) = pack8(v0, v1); } };
struct LRes { f32x4 x0, x1; };
struct FRes { typedef LRes L; const float* X; bf16* HB; float* SS;
    __device__ __forceinline__ void load(int row, int col, L& l) const { const float* xp = X + (size_t)row * DM + col; l.x0 = *(const f32x4*)xp; l.x1 = *(const f32x4*)(xp + 4); }
    __device__ __forceinline__ void apply(int row, int col, f32x4 v0, f32x4 v1, const L& l) const {
        v0 += l.x0; v1 += l.x1;
        *(v4u*)(HB + (size_t)row * DM + col) = pack8(v0, v1);
        float q = (v0[0] * v0[0] + v0[1] * v0[1]) + (v0[2] * v0[2] + v0[3] * v0[3]) + (v1[0] * v1[0] + v1[1] * v1[1]) + (v1[2] * v1[2] + v1[3] * v1[3]);
        q += __shfl_xor(q, 16); q += __shfl_xor(q, 32);
        if (pg8::hw_lane_id() < 16) atomicAdd(SS + row, q); } };
struct LRstd { float ss; };
struct FStoreRstd { typedef LRstd L; bf16* O; int ldc; const float* SS;
    __device__ __forceinline__ void load(int row, int, L& l) const { l.ss = SS[row]; }
    __device__ __forceinline__ void apply(int row, int col, f32x4 v0, f32x4 v1, const L& l) const {
        const float rs = 1.0f / sqrtf(l.ss * (1.f / DM) + EPS); *(v4u*)(O + (size_t)row * ldc + col) = pack8(v0 * rs, v1 * rs); } };

template <class F>
__device__ __forceinline__ void run_gemm(const Ctx& C, const bf16* A, const bf16* Bt, int M, int N, int K, const F& f) {
    pg8::Gemm g{A, Bt, M, N, K}; pg8::StaticOrder S; S.init(M, N, C.G, (int)blockIdx.x);
    EpiT<F> E{f};
    pg8::gemm_phase<EpiT<F>, pg8::StaticOrder, true, true>(C.lds, g, S, E, C.wave);
}

template <bool GLU>
__device__ __forceinline__ void p0_transpose_item(const float* W, int K, int N, bf16* WT, LAS float* scr, int item, int lane, const float* kscale = nullptr) {
    const int nblk = N / 32, kb = item / nblk, nb = item % nblk, k0 = 64 * kb, n0 = 32 * nb;
#pragma unroll 8
    for (int i = 0; i < 32; ++i) { const int kk = 2 * i + (lane >> 5); float w = W[(size_t)(k0 + kk) * N + n0 + (lane & 31)]; if (kscale) w *= kscale[k0 + kk]; scr[kk * 33 + (lane & 31)] = w; }
    LDS_WAIT(); asm volatile("" ::: "memory");
    const int c = lane & 7;
#pragma unroll
    for (int j = 0; j < 4; ++j) { const int n = (lane >> 3) + 8 * j; const LAS float* s = scr + (8 * c) * 33 + n;
        v4u o; o.x = pk2(s[0 * 33], s[1 * 33]); o.y = pk2(s[2 * 33], s[3 * 33]); o.z = pk2(s[4 * 33], s[5 * 33]); o.w = pk2(s[6 * 33], s[7 * 33]);
        const int nn = n0 + n; int row = nn;
        if (GLU) { const int jc = nn & 255, gate = nn >> 8; row = 8 * (jc >> 2) + 4 * gate + (jc & 3); }
        *(GAS v4u*)(WT + (size_t)row * K + k0 + 8 * c) = o; }
    LDS_WAIT(); asm volatile("" ::: "memory");
}
template <int NR>
__device__ __forceinline__ void rms_rows_to_bf16(const float* xbase, const float* gain, bf16* obase, int m0, int mstep, int lane) {
    f32x4 v[NR][4]; float s[NR];
#pragma unroll
    for (int i = 0; i < NR; ++i) { const f32x4* xr = (const f32x4*)(xbase + (size_t)(m0 + i * mstep) * DM) + lane; s[i] = 0.f;
#pragma unroll
        for (int j = 0; j < 4; ++j) v[i][j] = xr[64 * j]; }
#pragma unroll
    for (int i = 0; i < NR; ++i)
#pragma unroll
        for (int j = 0; j < 4; ++j) s[i] += (v[i][j].x * v[i][j].x + v[i][j].y * v[i][j].y) + (v[i][j].z * v[i][j].z + v[i][j].w * v[i][j].w);
#pragma unroll
    for (int o = 1; o < 64; o <<= 1)
#pragma unroll
        for (int i = 0; i < NR; ++i) s[i] += __shfl_xor(s[i], o);
    const f32x4* gr = (const f32x4*)gain + lane;
    f32x4 g[4];
#pragma unroll
    for (int j = 0; j < 4; ++j) g[j] = gr[64 * j];
#pragma unroll
    for (int i = 0; i < NR; ++i) { const float rstd = 1.0f / sqrtf(s[i] * (1.f / DM) + EPS);
        unsigned long long* o8 = (unsigned long long*)(obase + (size_t)(m0 + i * mstep) * DM) + lane;
#pragma unroll
        for (int j = 0; j < 4; ++j) o8[64 * j] = (unsigned long long)pk2(v[i][j].x * rstd * g[j].x, v[i][j].y * rstd * g[j].y) | ((unsigned long long)pk2(v[i][j].z * rstd * g[j].z, v[i][j].w * rstd * g[j].w) << 32); }
}

__device__ __forceinline__ void p0_s5_group(const Ctx& C, const Args& a, int g, int part) {
    const float* a_re = (const float*)a.in[7]; const float* a_im = (const float*)a.in[8]; const float* log_dt = (const float*)a.in[9];
    const float* b_re = (const float*)a.in[10]; const float* b_im = (const float*)a.in[11]; const float* c_re = (const float*)a.in[12]; const float* c_im = (const float*)a.in[13];
    LAS float* L = (LAS float*)C.lds;
    LAS float* lpr = L;
    LAS float* lpi = L + 640;
    LAS float* bbr = L + 1280;
    LAS float* bbi = bbr + 1024;
    LAS float* ccr = bbi + 1024;
    LAS float* cci = ccr + 1024;
    LAS float* Kj = cci + 1024;
    const int tid = C.tid;
    bf16* T8T = (bf16*)(a.ws + WS_S5MAT) + (size_t)g * 16384;
    bf16* PMT = (bf16*)(a.ws + WS_S5MAT) + (size_t)(16 + g) * 16384;
    bf16* QMT = (bf16*)(a.ws + WS_S5MAT) + (size_t)(32 + g) * 16384;
    float* L8 = (float*)(a.ws + WS_S5C) + (size_t)g * 128;
    float* L128 = (float*)(a.ws + WS_S5C) + 2048 + (size_t)g * 128;
    for (int i = tid; i < 640; i += 512) {
        const int j10 = i >> 6, p = i & 63; const double jj = (j10 < 9) ? (double)j10 : 128.0;
        const double dt = exp((double)log_dt[g]);
        const double ar = (double)a_re[g * 64 + p], ai = (double)a_im[g * 64 + p];
        const double mag = exp(ar * dt * jj), ang = ai * dt * jj;
        lpr[i] = (float)(mag * cos(ang)); lpi[i] = (float)(mag * sin(ang));
    }
    for (int i = tid; i < 1024; i += 512) { ccr[i] = c_re[g * 1024 + i]; cci[i] = c_im[g * 1024 + i]; }
    __syncthreads();
    if (part == 0 && tid < 64) { L8[tid * 2] = lpr[8 * 64 + tid]; L8[tid * 2 + 1] = lpi[8 * 64 + tid]; L128[tid * 2] = lpr[9 * 64 + tid]; L128[tid * 2 + 1] = lpi[9 * 64 + tid]; }
    for (int i = tid; i < 1024; i += 512) {
        const int p = i >> 4, h = i & 15;
        const float ar = a_re[g * 64 + p], ai = a_im[g * 64 + p], lr = lpr[64 + p], li = lpi[64 + p];
        const float den = ar * ar + ai * ai, nr = lr - 1.0f, ni = li;
        const float cr = (nr * ar + ni * ai) / den, ci = (ni * ar - nr * ai) / den;
        const float br = b_re[(g * 64 + p) * 16 + h], bi = b_im[(g * 64 + p) * 16 + h];
        bbr[i] = cr * br - ci * bi; bbi[i] = cr * bi + ci * br;
    }
    __syncthreads();
    for (int i = tid; i < 2048; i += 512) {
        const int j = i >> 8, ho = (i >> 4) & 15, hi = i & 15; float sacc = 0.f;
        for (int p = 0; p < 64; ++p) { const float cr_ = ccr[ho * 64 + p], ci_ = cci[ho * 64 + p], lr_ = lpr[j * 64 + p], li_ = lpi[j * 64 + p];
            const float mr = cr_ * lr_ - ci_ * li_, mi = cr_ * li_ + ci_ * lr_;
            sacc += mr * bbr[p * 16 + hi] - mi * bbi[p * 16 + hi]; }
        Kj[i] = sacc;
    }
    __syncthreads();
    for (int i = part * 1024 + tid; i < (part + 1) * 1024; i += 512) {
        const int n = i >> 7, k = i & 127;
        { const int t = n >> 4, ho = n & 15, sx = k >> 4, hi = k & 15; const float v = (sx <= t) ? Kj[((t - sx) * 16 + ho) * 16 + hi] : 0.f; T8T[i] = (bf16)f2bf(v); }
        { const int p = n & 63, im = n >> 6, sx = k >> 4, hi = k & 15; const float lr_ = lpr[(7 - sx) * 64 + p], li_ = lpi[(7 - sx) * 64 + p], br_ = bbr[p * 16 + hi], bi_ = bbi[p * 16 + hi];
          const float v = im ? (lr_ * bi_ + li_ * br_) : (lr_ * br_ - li_ * bi_); PMT[i] = (bf16)f2bf(v); }
        { const int t = n >> 4, ho = n & 15, p = k & 63, pt = k >> 6; const float cr_ = ccr[ho * 64 + p], ci_ = cci[ho * 64 + p], lr_ = lpr[(t + 1) * 64 + p], li_ = lpi[(t + 1) * 64 + p];
          const float v = pt ? -(cr_ * li_ + ci_ * lr_) : (cr_ * lr_ - ci_ * li_); QMT[i] = (bf16)f2bf(v); }
    }
    __syncthreads();
}

__device__ __forceinline__ void p0_prologue(const Ctx& C, const Args& a) {
    p0_s5_group(C, a, C.vcu & 15, C.vcu >> 4);
    LAS float* scr = (LAS float*)(C.lds + C.wave * 16384);
    const int gw = C.vcu * NWAVES + C.wave, NGW = C.G * NWAVES;
    const int gt = C.vcu * 512 + C.tid, NGT = C.G * 512;
    unsigned char* ws = a.ws;
    for (int i = gt; i < MTOK; i += NGT) ((float*)(ws + WS_SS))[i] = 0.f;
    constexpr int I_IN = 16 * 176, I_Q = 16 * 64, I_O = 16 * 32, I_BR = 8 * 32, I_BS = 4 * 32, I_BM = 4 * 32, I_KV = 16 * 16, I_GLU = 4 * 16;
    constexpr int NITEMS = I_IN + I_Q + I_O + I_BR + I_BS + I_BM + I_KV + I_GLU;
    for (int it = gw; it < NITEMS; it += NGW) {
        int r = it;
        if (r < I_IN) { p0_transpose_item<false>((const float*)a.in[4], 1024, 5632, (bf16*)(ws + WS_WIN_T), scr, r, C.lane); continue; } r -= I_IN;
        if (r < I_Q) { p0_transpose_item<false>((const float*)a.in[21], 1024, 2048, (bf16*)(ws + WS_WQ_T), scr, r, C.lane, (const float*)a.in[20]); continue; } r -= I_Q;
        if (r < I_O) { p0_transpose_item<false>((const float*)a.in[19], 1024, 1024, (bf16*)(ws + WS_WOUT_T), scr, r, C.lane); continue; } r -= I_O;
        if (r < I_BR) { p0_transpose_item<false>((const float*)a.in[16], 512, 1024, (bf16*)(ws + WS_WBR_T), scr, r, C.lane); continue; } r -= I_BR;
        if (r < I_BS) { p0_transpose_item<false>((const float*)a.in[17], 256, 1024, (bf16*)(ws + WS_WBS_T), scr, r, C.lane); continue; } r -= I_BS;
        if (r < I_BM) { p0_transpose_item<false>((const float*)a.in[18], 256, 1024, (bf16*)(ws + WS_WBM_T), scr, r, C.lane); continue; } r -= I_BM;
        if (r < I_KV) { p0_transpose_item<false>((const float*)a.in[6], 1024, 512, (bf16*)(ws + WS_WMKV_T), scr, r, C.lane); continue; } r -= I_KV;
        p0_transpose_item<true>((const float*)a.in[15], 256, 512, (bf16*)(ws + WS_WGLU_T), scr, r, C.lane);
    }
    for (int i = gt; i < 16 * 128 * 128 / 8; i += NGT) { const f32x4 x0 = ((const f32x4*)a.in[22])[2 * (size_t)i], x1 = ((const f32x4*)a.in[22])[2 * (size_t)i + 1]; ((v4u*)(ws + WS_KEYS))[i] = pack8(x0, x1); }
    for (int rw0 = gw; rw0 < 2 * 16384; rw0 += 4 * NGW) {
        f32x4 v[4][4]; float mx[4];
#pragma unroll
        for (int i = 0; i < 4; ++i) { const int rw = rw0 + i * NGW, t = rw >> 14, row = rw & 16383;
            const float* src = (const float*)a.in[23 + t] + (size_t)row * DM + C.lane * 4; mx[i] = 0.f;
#pragma unroll
            for (int q = 0; q < 4; ++q) { v[i][q] = *(const f32x4*)(src + 256 * q); if (t == 0) v[i][q] = v[i][q] * *(const f32x4*)((const float*)a.in[20] + C.lane * 4 + 256 * q); } }
#pragma unroll
        for (int i = 0; i < 4; ++i)
#pragma unroll
            for (int q = 0; q < 4; ++q) mx[i] = fmaxf(mx[i], fmaxf(fmaxf(fabsf(v[i][q][0]), fabsf(v[i][q][1])), fmaxf(fabsf(v[i][q][2]), fabsf(v[i][q][3]))));
#pragma unroll
        for (int o = 1; o < 64; o <<= 1)
#pragma unroll
            for (int i = 0; i < 4; ++i) mx[i] = fmaxf(mx[i], __shfl_xor(mx[i], o));
#pragma unroll
        for (int i = 0; i < 4; ++i) { const int rw = rw0 + i * NGW, t = rw >> 14, row = rw & 16383;
            int ex = (int)((__builtin_bit_cast(unsigned, mx[i]) >> 23) & 0xffu) - 127;
            if (mx[i] < 1e-30f) ex = 7;
            const float sc = __builtin_bit_cast(float, (unsigned)(127 + 7 - ex) << 23), isc = __builtin_bit_cast(float, (unsigned)(127 - 7 + ex) << 23);
            unsigned char* dst = ws + (t ? WS_PV : WS_PU) + (size_t)row * 128 + ((C.lane * 4) & 127);
#pragma unroll
            for (int q = 0; q < 4; ++q) { int p = __builtin_amdgcn_cvt_pk_fp8_f32(v[i][q][0] * sc, v[i][q][1] * sc, 0, false); p = __builtin_amdgcn_cvt_pk_fp8_f32(v[i][q][2] * sc, v[i][q][3] * sc, p, true);
                *(unsigned*)(dst + (size_t)(2 * q + (C.lane >> 5)) * (16384 * 128)) = (unsigned)p; }
            if (C.lane == 0) ((float*)(ws + WS_PSC))[t * 16384 + row] = isc; }
    }
    for (int m = gw; m < MTOK; m += 4 * NGW) rms_rows_to_bf16<4>((const float*)a.in[0], (const float*)a.in[3], (bf16*)(ws + WS_A), m, NGW, C.lane);
    for (int m = gw; m < MROWS; m += NGW) rms_rows_to_bf16<1>((const float*)a.in[1], (const float*)a.in[5], (bf16*)(ws + WS_MEMN), m, NGW, C.lane);
    {
        const int* pos = (const int*)a.in[2]; float* rope = (float*)(ws + WS_ROPE);
        const int j = C.tid & 63;
        const double invrev = exp(-(double)j * (9.210340371976184 / 64.0)) * 0.15915494309189535;
        for (int i = gt; i < MTOK * 64; i += NGT) { const int tok = i >> 6;
            double rv = (double)pos[tok] * invrev; rv -= rint(rv);
            const float rf = (float)rv;
            rope[(size_t)tok * 128 + j] = __builtin_amdgcn_cosf(rf); rope[(size_t)tok * 128 + 64 + j] = __builtin_amdgcn_sinf(rf); }
    }
}

constexpr int LP = 136;
__device__ __forceinline__ float lg2_gamma(int h) { return log2f(1.0f - exp2f(-5.0f - (float)h)); }

__device__ __forceinline__ void r1_unit(const Ctx& C, const Args& a, int tile, int h) {
    const bf16* Z1 = (const bf16*)(a.ws + WS_Z1); const float* ROPE = (const float*)(a.ws + WS_ROPE);
    LAS bf16* Qs = (LAS bf16*)C.lds; LAS bf16* Ks = Qs + 128 * LP; LAS bf16* Kt = Ks + 128 * LP; LAS bf16* Vt = Kt + 128 * LP;
    const int tid = C.tid, lane = C.lane, t0 = tile * 128, u = tile * 4 + h;
    const float lg2g = lg2_gamma(h);
    {
        const int i = tid >> 2, dq = (tid & 3) * 16;
        const bf16* zr = Z1 + (size_t)(t0 + i) * NZ1; const float* rp = ROPE + (size_t)(t0 + i) * 128;
        float cs[16], sn[16];
#pragma unroll
        for (int q = 0; q < 4; ++q) { const f32x4 c4 = *(const f32x4*)(rp + dq + 4 * q), s4 = *(const f32x4*)(rp + 64 + dq + 4 * q);
#pragma unroll
            for (int e = 0; e < 4; ++e) { cs[4 * q + e] = c4[e]; sn[4 * q + e] = s4[e]; } }
        const float kdec = exp2f((float)(127 - i) * lg2g) , ksc = 0.08838834764831845f;
#pragma unroll
        for (int which = 0; which < 2; ++which) {
            const bf16* src = zr + (which ? ZK : ZQ) + h * 128;
            const v4u a0 = *(const v4u*)(src + dq), a1 = *(const v4u*)(src + dq + 8), b0 = *(const v4u*)(src + 64 + dq), b1 = *(const v4u*)(src + 64 + dq + 8);
            const unsigned aw[8] = {a0.x, a0.y, a0.z, a0.w, a1.x, a1.y, a1.z, a1.w}, bw[8] = {b0.x, b0.y, b0.z, b0.w, b1.x, b1.y, b1.z, b1.w};
            float y1[16], y2[16];
#pragma unroll
            for (int w = 0; w < 8; ++w) {
                const float x1l = bflo(aw[w]), x1h = bfhi(aw[w]), x2l = bflo(bw[w]), x2h = bfhi(bw[w]);
                y1[2 * w] = x1l * cs[2 * w] - x2l * sn[2 * w]; y2[2 * w] = x1l * sn[2 * w] + x2l * cs[2 * w];
                y1[2 * w + 1] = x1h * cs[2 * w + 1] - x2h * sn[2 * w + 1]; y2[2 * w + 1] = x1h * sn[2 * w + 1] + x2h * cs[2 * w + 1];
            }
            if (which) {
#pragma unroll
                for (int e = 0; e < 16; ++e) { y1[e] *= ksc; y2[e] *= ksc; }
            }
            LAS bf16* dstp = (which ? Ks : Qs) + i * LP;
            v4u o;
            o.x = pk2(y1[0], y1[1]); o.y = pk2(y1[2], y1[3]); o.z = pk2(y1[4], y1[5]); o.w = pk2(y1[6], y1[7]); *(LAS v4u*)(dstp + dq) = o;
            o.x = pk2(y1[8], y1[9]); o.y = pk2(y1[10], y1[11]); o.z = pk2(y1[12], y1[13]); o.w = pk2(y1[14], y1[15]); *(LAS v4u*)(dstp + dq + 8) = o;
            o.x = pk2(y2[0], y2[1]); o.y = pk2(y2[2], y2[3]); o.z = pk2(y2[4], y2[5]); o.w = pk2(y2[6], y2[7]); *(LAS v4u*)(dstp + 64 + dq) = o;
            o.x = pk2(y2[8], y2[9]); o.y = pk2(y2[10], y2[11]); o.z = pk2(y2[12], y2[13]); o.w = pk2(y2[14], y2[15]); *(LAS v4u*)(dstp + 64 + dq + 8) = o;
            if (which) {
#pragma unroll
                for (int e = 0; e < 16; ++e) { Kt[(dq + e) * LP + i] = (bf16)f2bf(y1[e] * kdec); Kt[(64 + dq + e) * LP + i] = (bf16)f2bf(y2[e] * kdec); }
            }
            __builtin_amdgcn_sched_barrier(0);
        }
        {
            const int eq = (tid & 3) * 32; const bf16* vs = zr + ZV + h * 128 + eq;
#pragma unroll
            for (int q = 0; q < 4; ++q) { const v4u v = *(const v4u*)(vs + 8 * q); const unsigned vw[4] = {v.x, v.y, v.z, v.w};
#pragma unroll
                for (int w = 0; w < 4; ++w) { Vt[(eq + 8 * q + 2 * w) * LP + i] = (bf16)(vw[w] & 0xffffu); Vt[(eq + 8 * q + 2 * w + 1) * LP + i] = (bf16)(vw[w] >> 16); } }
        }
    }
    __syncthreads();
    const int r = lane & 31, hh = lane >> 5;
    if (C.wave < 4) {
        const int ib = C.wave;
        bf16x8 bq[8];
#pragma unroll
        for (int ks = 0; ks < 8; ++ks) bq[ks] = *(const LAS bf16x8*)(Qs + (ib * 32 + r) * LP + ks * 16 + 8 * hh);
        f32x16 accO[4];
#pragma unroll
        for (int et = 0; et < 4; ++et)
#pragma unroll
            for (int e = 0; e < 16; ++e) accO[et][e] = 0.f;
        const int i = ib * 32 + r;
#pragma unroll
        for (int jt = 0; jt < 4; ++jt) {
            if (jt <= ib) {
                f32x16 s;
#pragma unroll
                for (int e = 0; e < 16; ++e) s[e] = 0.f;
#pragma unroll
                for (int ks = 0; ks < 8; ++ks) { const bf16x8 ak = *(const LAS bf16x8*)(Ks + (jt * 32 + r) * LP + ks * 16 + 8 * hh); s = mfma32(ak, bq[ks], s); }
                unsigned pk[8];
#pragma unroll
                for (int q = 0; q < 8; ++q) {
                    const int ra = 2 * q, rb = 2 * q + 1;
                    const int ja = jt * 32 + (ra & 3) + 8 * (ra >> 2) + 4 * hh, jb = jt * 32 + (rb & 3) + 8 * (rb >> 2) + 4 * hh;
                    const float va = (i >= ja) ? s[ra] * exp2f((float)(i - ja) * lg2g) : 0.f;
                    const float vb = (i >= jb) ? s[rb] * exp2f((float)(i - jb) * lg2g) : 0.f;
                    pk[q] = pk2(va, vb);
                }
#pragma unroll
                for (int sft = 0; sft < 2; ++sft) {
                    const bf16x8 pb = mk8(pk[4 * sft], pk[4 * sft + 1], pk[4 * sft + 2], pk[4 * sft + 3]);
#pragma unroll
                    for (int et = 0; et < 4; ++et) {
                        const LAS bf16* vp = Vt + (et * 32 + r) * LP + jt * 32 + 16 * sft + 4 * hh;
                        const v2u lo = *(const LAS v2u*)vp, hi = *(const LAS v2u*)(vp + 8);
                        accO[et] = mfma32(mk8(lo.x, lo.y, hi.x, hi.y), pb, accO[et]);
                    }
                }
            }
            __builtin_amdgcn_sched_barrier(0);
        }
        unsigned* INN = (unsigned*)(a.ws + WS_INNER) + ((size_t)(u * 4 + ib) * 32) * 64 + lane;
#pragma unroll
        for (int et = 0; et < 4; ++et)
#pragma unroll
            for (int q = 0; q < 8; ++q) INN[(et * 8 + q) * 64] = pk2(accO[et][2 * q], accO[et][2 * q + 1]);
    } else {
        const int et = C.wave - 4;
        f32x16 acc[4];
#pragma unroll
        for (int dt = 0; dt < 4; ++dt)
#pragma unroll
            for (int e = 0; e < 16; ++e) acc[dt][e] = 0.f;
#pragma unroll
        for (int ks = 0; ks < 8; ++ks) {
            const bf16x8 av = *(const LAS bf16x8*)(Vt + (et * 32 + r) * LP + ks * 16 + 8 * hh);
#pragma unroll
            for (int dt = 0; dt < 4; ++dt) { const bf16x8 bk = *(const LAS bf16x8*)(Kt + (dt * 32 + r) * LP + ks * 16 + 8 * hh); acc[dt] = mfma32(av, bk, acc[dt]); }
            __builtin_amdgcn_sched_barrier(0);
        }
        float* KVb = a.out + (size_t)u * 16384 + (size_t)(et * 32 + 4 * hh) * 128 + r;
#pragma unroll
        for (int dt = 0; dt < 4; ++dt) {
#pragma unroll
            for (int e = 0; e < 16; ++e) KVb[((e & 3) + 8 * (e >> 2)) * 128 + dt * 32] = acc[dt][e];
            __builtin_amdgcn_sched_barrier(0);
        }
    }
    __syncthreads();
}

__device__ __forceinline__ void s5_compute_E(const Args& a, int tile, int g, int lane, LAS float* Es, bf16x8 (&au)[4]) {
    const bf16* Z1 = (const bf16*)(a.ws + WS_Z1); const bf16* PMT = (const bf16*)(a.ws + WS_S5MAT) + (size_t)(16 + g) * 16384;
    const int r16 = lane & 15, q4 = lane >> 4;
#pragma unroll
    for (int ks = 0; ks < 4; ++ks) { const int s = 2 * ks + (q4 >> 1);
        au[ks] = *(const bf16x8*)(Z1 + (size_t)(tile * 128 + 8 * r16 + s) * NZ1 + ZU + g * 16 + 8 * (q4 & 1)); }
    bf16x8 bc[4], bn[4];
#pragma unroll
    for (int ks = 0; ks < 4; ++ks) bc[ks] = *(const bf16x8*)(PMT + (size_t)r16 * 128 + ks * 32 + 8 * q4);
#pragma unroll 1
    for (int nb = 0; nb < 8; ++nb) {
        const int nbn = min(nb + 1, 7);
#pragma unroll
        for (int ks = 0; ks < 4; ++ks) bn[ks] = *(const bf16x8*)(PMT + (size_t)(nbn * 16 + r16) * 128 + ks * 32 + 8 * q4);
        __builtin_amdgcn_sched_barrier(0);
        f32x4 acc = {0.f, 0.f, 0.f, 0.f};
#pragma unroll
        for (int ks = 0; ks < 4; ++ks) acc = mfma16(au[ks], bc[ks], acc);
#pragma unroll
        for (int i4 = 0; i4 < 4; ++i4) Es[(q4 * 4 + i4) * 128 + nb * 16 + r16] = acc[i4];
        __builtin_amdgcn_sched_barrier(0);
#pragma unroll
        for (int ks = 0; ks < 4; ++ks) bc[ks] = bn[ks];
    }
    LDS_WAIT(); asm volatile("" ::: "memory");
}
__device__ __forceinline__ void s5a_wave(const Ctx& C, const Args& a, int tile, int g) {
    LAS float* Es = (LAS float*)(C.lds + C.wave * 16384);
    bf16x8 au[4];
    s5_compute_E(a, tile, g, C.lane, Es, au);
    const float* L8 = (const float*)(a.ws + WS_S5C) + (size_t)g * 128;
    const float l8r = L8[C.lane * 2], l8i = L8[C.lane * 2 + 1];
    float sr = 0.f, si = 0.f;
#pragma unroll
    for (int c = 0; c < 16; ++c) { const float er = Es[c * 128 + C.lane], ei = Es[c * 128 + 64 + C.lane];
        const float nr = l8r * sr - l8i * si + er, ni = l8r * si + l8i * sr + ei; sr = nr; si = ni; }
    float* E = (float*)(a.ws + WS_S5E) + ((size_t)tile * 16 + g) * 128;
    E[C.lane] = sr; E[64 + C.lane] = si;
    LDS_WAIT(); asm volatile("" ::: "memory");
}
__device__ __forceinline__ void s5c_wave(const Ctx& C, const Args& a, int tile, int g) {
    LAS float* Es = (LAS float*)(C.lds + C.wave * 16384);
    LAS bf16* Sv = (LAS bf16*)(C.lds + C.wave * 16384 + 8192);
    const int lane = C.lane, r16 = lane & 15, q4 = lane >> 4;
    bf16x8 au[4];
    s5_compute_E(a, tile, g, lane, Es, au);
    const float* L8 = (const float*)(a.ws + WS_S5C) + (size_t)g * 128;
    const float l8r = L8[lane * 2], l8i = L8[lane * 2 + 1];
    const float* X = (const float*)(a.ws + WS_S5X) + ((size_t)tile * 16 + g) * 128;
    float sr = X[lane], si = X[64 + lane];
#pragma unroll
    for (int c = 0; c < 16; ++c) {
        Sv[c * LP + lane] = (bf16)f2bf(sr); Sv[c * LP + 64 + lane] = (bf16)f2bf(si);
        const float er = Es[c * 128 + lane], ei = Es[c * 128 + 64 + lane];
        const float nr = l8r * sr - l8i * si + er, ni = l8r * si + l8i * sr + ei; sr = nr; si = ni; }
    LDS_WAIT(); asm volatile("" ::: "memory");
    bf16x8 as[4];
#pragma unroll
    for (int ks = 0; ks < 4; ++ks) as[ks] = *(const LAS bf16x8*)(Sv + r16 * LP + ks * 32 + 8 * q4);
    const bf16* T8T = (const bf16*)(a.ws + WS_S5MAT) + (size_t)g * 16384; const bf16* QMT = (const bf16*)(a.ws + WS_S5MAT) + (size_t)(32 + g) * 16384;
    const bf16* Z1 = (const bf16*)(a.ws + WS_Z1); bf16* YG = (bf16*)(a.ws + WS_YG);
    const float dg = ((const float*)a.in[14])[g * 16 + r16];
    bf16x8 tc[4], tn[4], qc[4], qn[4]; bf16 uc[4], un[4];
#pragma unroll
    for (int ks = 0; ks < 4; ++ks) { tc[ks] = *(const bf16x8*)(T8T + (size_t)r16 * 128 + ks * 32 + 8 * q4); qc[ks] = *(const bf16x8*)(QMT + (size_t)r16 * 128 + ks * 32 + 8 * q4); }
#pragma unroll
    for (int i4 = 0; i4 < 4; ++i4) uc[i4] = Z1[(size_t)(tile * 128 + 8 * (q4 * 4 + i4)) * NZ1 + ZU + g * 16 + r16];
#pragma unroll 1
    for (int nb = 0; nb < 8; ++nb) {
        const int nbn = min(nb + 1, 7);
#pragma unroll
        for (int ks = 0; ks < 4; ++ks) { tn[ks] = *(const bf16x8*)(T8T + (size_t)(nbn * 16 + r16) * 128 + ks * 32 + 8 * q4); qn[ks] = *(const bf16x8*)(QMT + (size_t)(nbn * 16 + r16) * 128 + ks * 32 + 8 * q4); }
#pragma unroll
        for (int i4 = 0; i4 < 4; ++i4) un[i4] = Z1[(size_t)(tile * 128 + 8 * (q4 * 4 + i4) + nbn) * NZ1 + ZU + g * 16 + r16];
        __builtin_amdgcn_sched_barrier(0);
        f32x4 acc = {0.f, 0.f, 0.f, 0.f};
#pragma unroll
        for (int ks = 0; ks < 4; ++ks) { acc = mfma16(au[ks], tc[ks], acc); acc = mfma16(as[ks], qc[ks], acc); }
#pragma unroll
        for (int i4 = 0; i4 < 4; ++i4) { const int tok = tile * 128 + 8 * (q4 * 4 + i4) + nb;
            YG[(size_t)tok * 256 + g * 16 + r16] = (bf16)f2bf(gelu_tanh(acc[i4] + dg * bf2f(uc[i4]))); }
        __builtin_amdgcn_sched_barrier(0);
#pragma unroll
        for (int ks = 0; ks < 4; ++ks) { tc[ks] = tn[ks]; qc[ks] = qn[ks]; }
#pragma unroll
        for (int i4 = 0; i4 < 4; ++i4) uc[i4] = un[i4];
    }
    LDS_WAIT(); asm volatile("" ::: "memory");
}

__device__ __forceinline__ void ma_loadk(const bf16* kp, int mt, bf16x8 (&k)[4]) {
#pragma unroll
    for (int ks = 0; ks < 4; ++ks) k[ks] = *(const bf16x8*)(kp + (size_t)mt * 32 * 256 + ks * 16);
}
__device__ __forceinline__ void ma_loadv(const bf16* vp, int mt, v2u (&v)[8]) {
#pragma unroll
    for (int sft = 0; sft < 2; ++sft)
#pragma unroll
        for (int et = 0; et < 2; ++et) { const bf16* p = vp + (size_t)et * 32 * 256 + mt * 32 + 16 * sft; v[(sft * 2 + et) * 2] = *(const v2u*)p; v[(sft * 2 + et) * 2 + 1] = *(const v2u*)(p + 8); }
}
__device__ __forceinline__ void ma_wave(const Ctx& C, const Args& a, int tile, int hm, int ib) {
    const bf16* Z1 = (const bf16*)(a.ws + WS_Z1); const bf16* KM = (const bf16*)(a.ws + WS_KM); const bf16* VT = (const bf16*)(a.ws + WS_VT);
    const int lane = C.lane, r = lane & 31, hh = lane >> 5, b = tile >> 5, tok = tile * 128 + ib * 32 + r;
    const bf16* kp = KM + (size_t)(b * 256 + r) * 256 + hm * 64 + 8 * hh;
    const bf16* vp = VT + (size_t)(b * 256 + hm * 64 + r) * 256 + 4 * hh;
    bf16x8 bq[4];
#pragma unroll
    for (int ks = 0; ks < 4; ++ks) bq[ks] = *(const bf16x8*)(Z1 + (size_t)tok * NZ1 + ZQM + hm * 64 + ks * 16 + 8 * hh);
    bf16x8 kc[4], kn[4];
    ma_loadk(kp, 0, kc);
    float mx = -3.0e38f;
#pragma unroll 1
    for (int mt = 0; mt < 8; ++mt) {
        ma_loadk(kp, min(mt + 1, 7), kn); __builtin_amdgcn_sched_barrier(0);
        f32x16 s;
#pragma unroll
        for (int e = 0; e < 16; ++e) s[e] = 0.f;
#pragma unroll
        for (int ks = 0; ks < 4; ++ks) s = mfma32(kc[ks], bq[ks], s);
#pragma unroll
        for (int e = 0; e < 16; ++e) mx = fmaxf(mx, s[e]);
        __builtin_amdgcn_sched_barrier(0);
#pragma unroll
        for (int ks = 0; ks < 4; ++ks) kc[ks] = kn[ks];
    }
    mx = fmaxf(mx, __shfl_xor(mx, 32));
    float sum = 0.f;
    f32x16 o[2];
#pragma unroll
    for (int et = 0; et < 2; ++et)
#pragma unroll
        for (int e = 0; e < 16; ++e) o[et][e] = 0.f;
    const float sc = 0.125f * 1.4426950408889634f;
    v2u vc[8], vn[8];
    ma_loadk(kp, 0, kc); ma_loadv(vp, 0, vc);
#pragma unroll 1
    for (int mt = 0; mt < 8; ++mt) {
        ma_loadk(kp, min(mt + 1, 7), kn); ma_loadv(vp, min(mt + 1, 7), vn); __builtin_amdgcn_sched_barrier(0);
        f32x16 s;
#pragma unroll
        for (int e = 0; e < 16; ++e) s[e] = 0.f;
#pragma unroll
        for (int ks = 0; ks < 4; ++ks) s = mfma32(kc[ks], bq[ks], s);
        unsigned pk[8];
#pragma unroll
        for (int q = 0; q < 8; ++q) { const float pa = exp2f((s[2 * q] - mx) * sc), pb = exp2f((s[2 * q + 1] - mx) * sc); sum += pa + pb; pk[q] = pk2(pa, pb); }
#pragma unroll
        for (int sft = 0; sft < 2; ++sft) {
            const bf16x8 pb = mk8(pk[4 * sft], pk[4 * sft + 1], pk[4 * sft + 2], pk[4 * sft + 3]);
#pragma unroll
            for (int et = 0; et < 2; ++et) { const v2u lo = vc[(sft * 2 + et) * 2], hi = vc[(sft * 2 + et) * 2 + 1]; o[et] = mfma32(mk8(lo.x, lo.y, hi.x, hi.y), pb, o[et]); }
        }
        __builtin_amdgcn_sched_barrier(0);
#pragma unroll
        for (int ks = 0; ks < 4; ++ks) kc[ks] = kn[ks];
#pragma unroll
        for (int q = 0; q < 8; ++q) vc[q] = vn[q];
    }
    sum += __shfl_xor(sum, 32);
    const float inv = 1.0f / sum;
    bf16* MA = (bf16*)(a.ws + WS_MATTN) + (size_t)tok * 256 + hm * 64;
#pragma unroll
    for (int et = 0; et < 2; ++et)
#pragma unroll
        for (int g4 = 0; g4 < 4; ++g4) { v2u w; w.x = pk2(o[et][4 * g4] * inv, o[et][4 * g4 + 1] * inv); w.y = pk2(o[et][4 * g4 + 2] * inv, o[et][4 * g4 + 3] * inv);
            *(v2u*)(MA + et * 32 + 8 * g4 + 4 * hh) = w; }
}

__device__ __forceinline__ void r3_wave(const Ctx& C, const Args& a, int tile, int h, int ib) {
    const bf16* Z1 = (const bf16*)(a.ws + WS_Z1); const float* ROPE = (const float*)(a.ws + WS_ROPE);
    const bf16* PREV = (const bf16*)((const unsigned char*)a.out + 64 * MiB);
    const int lane = C.lane, r = lane & 31, hh = lane >> 5, u = tile * 4 + h, tok = tile * 128 + ib * 32 + r;
    const float lg2g = lg2_gamma(h);
    const bf16* zr = Z1 + (size_t)tok * NZ1 + ZQ + h * 128; const float* rp = ROPE + (size_t)tok * 128;
    bf16x8 bq[8];
#pragma unroll
    for (int m = 0; m < 4; ++m) {
        const v4u x1 = *(const v4u*)(zr + m * 16 + 8 * hh), x2 = *(const v4u*)(zr + 64 + m * 16 + 8 * hh);
        const f32x4 c0 = *(const f32x4*)(rp + m * 16 + 8 * hh), c1 = *(const f32x4*)(rp + m * 16 + 8 * hh + 4);
        const f32x4 s0 = *(const f32x4*)(rp + 64 + m * 16 + 8 * hh), s1 = *(const f32x4*)(rp + 64 + m * 16 + 8 * hh + 4);
        const unsigned aw[4] = {x1.x, x1.y, x1.z, x1.w}, bw[4] = {x2.x, x2.y, x2.z, x2.w};
        const float cs[8] = {c0[0], c0[1], c0[2], c0[3], c1[0], c1[1], c1[2], c1[3]}, sn[8] = {s0[0], s0[1], s0[2], s0[3], s1[0], s1[1], s1[2], s1[3]};
        unsigned o1[4], o2[4];
#pragma unroll
        for (int w = 0; w < 4; ++w) {
            const float x1l = bflo(aw[w]), x1h = bfhi(aw[w]), x2l = bflo(bw[w]), x2h = bfhi(bw[w]);
            o1[w] = pk2(x1l * cs[2 * w] - x2l * sn[2 * w], x1h * cs[2 * w + 1] - x2h * sn[2 * w + 1]);
            o2[w] = pk2(x1l * sn[2 * w] + x2l * cs[2 * w], x1h * sn[2 * w + 1] + x2h * cs[2 * w + 1]);
        }
        bq[m] = mk8(o1[0], o1[1], o1[2], o1[3]); bq[m + 4] = mk8(o2[0], o2[1], o2[2], o2[3]);
        __builtin_amdgcn_sched_barrier(0);
    }
    f32x16 acc[4];
    const bf16* pbase = PREV + ((size_t)u * 128 + r) * 128 + 8 * hh;
    bf16x8 apc[8], apn[8];
#pragma unroll
    for (int ks = 0; ks < 8; ++ks) apc[ks] = *(const bf16x8*)(pbase + ks * 16);
#pragma unroll
    for (int et = 0; et < 4; ++et) {
        if (et < 3) {
#pragma unroll
            for (int ks = 0; ks < 8; ++ks) apn[ks] = *(const bf16x8*)(pbase + (size_t)(et + 1) * 32 * 128 + ks * 16);
        }
        __builtin_amdgcn_sched_barrier(0);
#pragma unroll
        for (int e = 0; e < 16; ++e) acc[et][e] = 0.f;
#pragma unroll
        for (int ks = 0; ks < 8; ++ks) acc[et] = mfma32(apc[ks], bq[ks], acc[et]);
        __builtin_amdgcn_sched_barrier(0);
#pragma unroll
        for (int ks = 0; ks < 8; ++ks) apc[ks] = apn[ks];
    }
    const float qdec = exp2f((float)(ib * 32 + r + 1) * lg2g);
    const unsigned* INN = (const unsigned*)(a.ws + WS_INNER) + ((size_t)(u * 4 + ib) * 32) * 64 + lane;
    float ss = 0.f;
    unsigned innw[32];
#pragma unroll
    for (int q = 0; q < 32; ++q) innw[q] = INN[q * 64];
#pragma unroll
    for (int et = 0; et < 4; ++et)
#pragma unroll
        for (int q = 0; q < 8; ++q) { const unsigned w = innw[et * 8 + q];
            const float v0 = acc[et][2 * q] * qdec + bflo(w), v1 = acc[et][2 * q + 1] * qdec + bfhi(w);
            acc[et][2 * q] = v0; acc[et][2 * q + 1] = v1; ss += v0 * v0 + v1 * v1; }
    __builtin_amdgcn_sched_barrier(0);
    ss += __shfl_xor(ss, 32);
    const float rn = 1.0f / sqrtf(ss * (1.0f / 128.0f) + EPS);
    const bf16* gp = Z1 + (size_t)tok * NZ1 + ZGR + h * 128; bf16* RET = (bf16*)(a.ws + WS_RET) + (size_t)tok * 512 + h * 128;
#pragma unroll
    for (int et = 0; et < 4; ++et)
#pragma unroll
        for (int g4 = 0; g4 < 4; ++g4) { const int e0 = et * 32 + 8 * g4 + 4 * hh; const v2u gw = *(const v2u*)(gp + e0);
            const float g0 = bflo(gw.x), g1 = bfhi(gw.x), g2 = bflo(gw.y), g3 = bfhi(gw.y);
            v2u w; w.x = pk2(acc[et][4 * g4] * rn * g0 * sigmoidf_(g0), acc[et][4 * g4 + 1] * rn * g1 * sigmoidf_(g1));
            w.y = pk2(acc[et][4 * g4 + 2] * rn * g2 * sigmoidf_(g2), acc[et][4 * g4 + 3] * rn * g3 * sigmoidf_(g3));
            *(v2u*)(RET + e0) = w; }
}

__device__ __forceinline__ void p3_scans(const Ctx& C, const Args& a) {
    {
        const float* KV = a.out; bf16* PREV = (bf16*)((unsigned char*)a.out + 64 * MiB);
        for (int it = C.vcu * 512 + C.tid; it < 131072; it += C.G * 512) {
            const int elem = it * 4, b = elem >> 16, h = (elem >> 14) & 3, ed = elem & 16383;
            const float cd = exp2f(128.0f * lg2_gamma(h));
            f32x4 st = {0.f, 0.f, 0.f, 0.f};
#pragma unroll 4
            for (int c = 0; c < 32; ++c) { const size_t off = (size_t)((b * 32 + c) * 4 + h) * 16384 + ed;
                v2u w; w.x = pk2(st[0], st[1]); w.y = pk2(st[2], st[3]); *(v2u*)(PREV + off) = w;
                const f32x4 inc = *(const f32x4*)(KV + off); st = st * cd + inc; }
        }
    }
    {
        const float* E = (const float*)(a.ws + WS_S5E); float* X = (float*)(a.ws + WS_S5X); const float* L128 = (const float*)(a.ws + WS_S5C) + 2048;
        for (int it = C.vcu * 512 + C.tid; it < 8192; it += C.G * 512) {
            const int b = it >> 10, g = (it >> 6) & 15, p = it & 63;
            const float lr = L128[(g * 64 + p) * 2], li = L128[(g * 64 + p) * 2 + 1];
            float xr = 0.f, xi = 0.f;
            for (int n = 0; n < 32; ++n) { const size_t off = ((size_t)(b * 32 + n) * 16 + g) * 128 + p;
                X[off] = xr; X[off + 64] = xi;
                const float er = E[off], ei = E[off + 64];
                const float nr = lr * xr - li * xi + er, ni = lr * xi + li * xr + ei; xr = nr; xi = ni; }
        }
    }
}

__device__ __forceinline__ int f2key(float x) { int b = __builtin_bit_cast(int, x); return b >= 0 ? b : (b ^ 0x7fffffff); }
__device__ __forceinline__ float key2f(int k) { return __builtin_bit_cast(float, k >= 0 ? k : (k ^ 0x7fffffff)); }
__device__ __forceinline__ void ins16(int (&T)[16], int x) {
#pragma unroll
    for (int j = 0; j < 16; ++j) { const int hi = T[j] > x ? T[j] : x; x = T[j] > x ? x : T[j]; T[j] = hi; }
}
__device__ __forceinline__ void peer_topk_half(const Args& a, int tokbase, int hp, int c, int lane, int (&T)[16]) {
    const bf16* Q2 = (const bf16*)(a.ws + WS_Q2); const bf16* KEYS = (const bf16*)(a.ws + WS_KEYS);
    const int r = lane & 31, hh = lane >> 5;
    bf16x8 bq[8];
#pragma unroll
    for (int ks = 0; ks < 8; ++ks) bq[ks] = *(const bf16x8*)(Q2 + (size_t)(tokbase + r) * 2048 + hp * 256 + c * 128 + ks * 16 + 8 * hh);
#pragma unroll
    for (int j = 0; j < 16; ++j) T[j] = (int)0x80000000;
    const bf16* kbase = KEYS + ((size_t)((hp * 2 + c) * 128 + r)) * 128 + 8 * hh;
    bf16x8 akc[8], akn[8];
#pragma unroll
    for (int ks = 0; ks < 8; ++ks) akc[ks] = *(const bf16x8*)(kbase + ks * 16);
#pragma unroll
    for (int nt = 0; nt < 4; ++nt) {
        if (nt < 3) {
#pragma unroll
            for (int ks = 0; ks < 8; ++ks) akn[ks] = *(const bf16x8*)(kbase + (size_t)(nt + 1) * 32 * 128 + ks * 16);
        }
        __builtin_amdgcn_sched_barrier(0);
        f32x16 s;
#pragma unroll
        for (int e = 0; e < 16; ++e) s[e] = 0.f;
#pragma unroll
        for (int ks = 0; ks < 8; ++ks) s = mfma32(akc[ks], bq[ks], s);
#pragma unroll
        for (int e = 0; e < 16; ++e) { const int n = nt * 32 + (e & 3) + 8 * (e >> 2) + 4 * hh; ins16(T, (f2key(s[e]) & ~127) | n); }
        __builtin_amdgcn_sched_barrier(0);
#pragma unroll
        for (int ks = 0; ks < 8; ++ks) akc[ks] = akn[ks];
    }
    int P[16];
#pragma unroll
    for (int j = 0; j < 16; ++j) P[j] = __shfl_xor(T[j], 32);
#pragma unroll
    for (int j = 0; j < 16; ++j) ins16(T, P[j]);
}
__device__ __forceinline__ void peer_topk_head(const Ctx& C, const Args& a, int tokbase, int hp) {
    const int lane = C.lane, r = lane & 31, hh = lane >> 5;
    int T0[16], T1[16];
    peer_topk_half(a, tokbase, hp, 0, lane, T0);
    peer_topk_half(a, tokbase, hp, 1, lane, T1);
    int F[16];
#pragma unroll
    for (int j = 0; j < 16; ++j) F[j] = (int)0x80000000;
#pragma unroll
    for (int i0 = 0; i0 < 16; ++i0)
#pragma unroll
        for (int i1 = 0; i1 < 16; ++i1)
            if ((i0 + 1) * (i1 + 1) <= 16) { const float v = key2f(T0[i0] & ~127) + key2f(T1[i1] & ~127); ins16(F, (f2key(v) & ~255) | (i0 * 16 + i1)); }
    LAS int* tab = (LAS int*)(C.lds + C.wave * 16384);
#pragma unroll
    for (int j = 0; j < 16; ++j) { tab[j * 64 + lane] = T0[j] & 127; tab[(16 + j) * 64 + lane] = T1[j] & 127; }
    LDS_WAIT(); asm volatile("" ::: "memory");
    const float m = key2f(F[0] & ~255);
    float e[16], sum = 0.f;
#pragma unroll
    for (int j = 0; j < 16; ++j) { e[j] = __expf(key2f(F[j] & ~255) - m); sum += e[j]; }
    const float inv = 1.0f / sum;
    const int tok = tokbase + r;
    int* IDX = (int*)(a.ws + WS_IDX) + (size_t)tok * 128 + hp * 16; float* WGT = (float*)(a.ws + WS_WGT) + (size_t)tok * 128 + hp * 16;
#pragma unroll
    for (int j = 0; j < 16; ++j) { const int id = F[j] & 255; const int k0 = tab[(id >> 4) * 64 + lane], k1 = tab[(16 + (id & 15)) * 64 + lane];
        if (hh == 0) IDX[j] = k0 * 128 + k1; else WGT[j] = e[j] * inv; }
    LDS_WAIT(); asm volatile("" ::: "memory");
}
typedef float f32x2v __attribute__((ext_vector_type(2)));
__device__ __forceinline__ void unpack16(const v4u a, const v4u b, float (&x)[16]) {
    const unsigned w[8] = {a.x, a.y, a.z, a.w, b.x, b.y, b.z, b.w};
#pragma unroll
    for (int i = 0; i < 8; ++i) { x[2 * i] = bflo(w[i]); x[2 * i + 1] = bfhi(w[i]); }
}
__device__ __forceinline__ void unpack16_fp8(const v4u a, float (&x)[16]) {
    const unsigned w[4] = {a.x, a.y, a.z, a.w};
#pragma unroll
    for (int i = 0; i < 4; ++i) { const f32x2v lo = __builtin_amdgcn_cvt_pk_f32_fp8((int)w[i], false), hi = __builtin_amdgcn_cvt_pk_f32_fp8((int)w[i], true);
        x[4 * i] = lo.x; x[4 * i + 1] = lo.y; x[4 * i + 2] = hi.x; x[4 * i + 3] = hi.y; }
}
__device__ __forceinline__ long mk64(unsigned lo, unsigned hi) { return (long)(((unsigned long long)hi << 32) | (unsigned long long)lo); }
__device__ __forceinline__ float dpp_swap1(float v) { return __builtin_bit_cast(float, __builtin_amdgcn_update_dpp(0, __builtin_bit_cast(int, v), 0xB1, 0xf, 0xf, true)); }
struct PHalf { v4u g[8]; };
__device__ __forceinline__ void pg_issue(const unsigned char* TBL, int idxv, int lane, PHalf& D) {
    const int row8 = lane >> 3, c8 = lane & 7;
#pragma unroll
    for (int j = 0; j < 8; ++j) { const int e = __shfl(idxv, j * 8 + row8); D.g[j] = *(const v4u*)(TBL + (size_t)e * 128 + c8 * 16); }
}
__device__ __forceinline__ void pg_stage(LAS unsigned char* buf, int lane, const PHalf& D) {
    const int row8 = lane >> 3, c8 = lane & 7;
#pragma unroll
    for (int j = 0; j < 8; ++j) *(LAS v4u*)(buf + (j * 8 + row8) * 128 + ((c8 ^ row8) & 7) * 16) = D.g[j];
}
__device__ __forceinline__ void pu_xprep(LAS unsigned char* xs, unsigned xw, int lane) {
    const float x0 = bflo(xw) * 16.f, x1 = bfhi(xw) * 16.f;
    const int hi = __builtin_amdgcn_cvt_pk_fp8_f32(x0, x1, 0, false);
    const f32x2v bk = __builtin_amdgcn_cvt_pk_f32_fp8(hi, false);
    const int lo = __builtin_amdgcn_cvt_pk_fp8_f32(x0 - bk.x, x1 - bk.y, 0, false);
    *(LAS unsigned short*)(xs + 2 * lane) = (unsigned short)hi; *(LAS unsigned short*)(xs + 128 + 2 * lane) = (unsigned short)lo;
}
__device__ __forceinline__ void pu_compute(const LAS unsigned char* buf, float* HPt, int r, int kq, const long (&bfr)[4]) {
    f32x4 res[4];
#pragma unroll
    for (int g = 0; g < 4; ++g) {
        const int row = g * 16 + r, sw = row & 7;
        const v4u a0 = *(const LAS v4u*)(buf + row * 128 + ((2 * kq) ^ sw) * 16), a1 = *(const LAS v4u*)(buf + row * 128 + ((2 * kq + 1) ^ sw) * 16);
        f32x4 acc = {0.f, 0.f, 0.f, 0.f};
        acc = __builtin_amdgcn_mfma_f32_16x16x32_fp8_fp8(mk64(a0.x, a0.y), bfr[0], acc, 0, 0, 0);
        acc = __builtin_amdgcn_mfma_f32_16x16x32_fp8_fp8(mk64(a0.z, a0.w), bfr[1], acc, 0, 0, 0);
        acc = __builtin_amdgcn_mfma_f32_16x16x32_fp8_fp8(mk64(a1.x, a1.y), bfr[2], acc, 0, 0, 0);
        acc = __builtin_amdgcn_mfma_f32_16x16x32_fp8_fp8(mk64(a1.z, a1.w), bfr[3], acc, 0, 0, 0);
#pragma unroll
        for (int i = 0; i < 4; ++i) acc[i] += dpp_swap1(acc[i]);
        res[g] = acc;
    }
    f32x4 o = res[0];
#pragma unroll
    for (int g = 1; g < 4; ++g) { const bool sel = (r == g);
#pragma unroll
        for (int i = 0; i < 4; ++i) o[i] = sel ? res[g][i] : o[i]; }
    if (r < 4) *(f32x4*)(HPt + r * 16 + 4 * kq) = o;
}
__device__ __forceinline__ void peer_u_wave(const Args& a, LAS unsigned char* wlds, LAS unsigned char* wsm, int slab, int t0, int ntok, int lane) {
    const unsigned char* U8 = a.ws + WS_PU + (size_t)slab * (16384 * 128);
    const bf16* N2 = (const bf16*)(a.ws + WS_N2) + slab * 128 + 2 * lane;
    const int* IDX = (const int*)(a.ws + WS_IDX) + lane;
    float* HP = (float*)(a.ws + WS_HPART) + (size_t)slab * MTOK * 128;
    const int r = lane & 15, kq = lane >> 4, tl = t0 + ntok - 1;
    PHalf dA, dB; long bfr[4];
    int i0 = IDX[(size_t)t0 * 128], i1 = IDX[(size_t)t0 * 128 + 64];
    unsigned xw = *(const unsigned*)(N2 + (size_t)t0 * DM);
    pg_issue(U8, i0, lane, dA); pg_stage(wlds, lane, dA);
    pg_issue(U8, i1, lane, dB);
    { const int tn = min(t0 + 1, tl); i0 = IDX[(size_t)tn * 128]; i1 = IDX[(size_t)tn * 128 + 64]; }
#pragma unroll 1
    for (int t = t0; t < t0 + ntok; ++t) {
        pu_xprep(wsm, xw, lane);
        { const LAS unsigned char* bp = wsm + ((r & 1) ? 128 : 0) + kq * 32; const v4u b0 = *(const LAS v4u*)bp, b1 = *(const LAS v4u*)(bp + 16);
          bfr[0] = mk64(b0.x, b0.y); bfr[1] = mk64(b0.z, b0.w); bfr[2] = mk64(b1.x, b1.y); bfr[3] = mk64(b1.z, b1.w); }
        const int tn = min(t + 1, tl), tnn = min(t + 2, tl);
        xw = *(const unsigned*)(N2 + (size_t)tn * DM);
        pg_issue(U8, i0, lane, dA); __builtin_amdgcn_sched_barrier(0);
        pu_compute(wlds, HP + (size_t)t * 128, r, kq, bfr); __builtin_amdgcn_sched_barrier(0);
        pg_stage(wlds + 8192, lane, dB); __builtin_amdgcn_sched_barrier(0);
        pg_issue(U8, i1, lane, dB);
        i0 = IDX[(size_t)tnn * 128]; i1 = IDX[(size_t)tnn * 128 + 64]; __builtin_amdgcn_sched_barrier(0);
        pu_compute(wlds + 8192, HP + (size_t)t * 128 + 64, r, kq, bfr); __builtin_amdgcn_sched_barrier(0);
        pg_stage(wlds, lane, dA); __builtin_amdgcn_sched_barrier(0);
    }
}
__device__ __forceinline__ void peer_reduce(const Ctx& C, const Args& a) {
    const float* HP = (const float*)(a.ws + WS_HPART); const int* IDX = (const int*)(a.ws + WS_IDX); const float* WGT = (const float*)(a.ws + WS_WGT);
    const float* USC = (const float*)(a.ws + WS_PSC); const float* VSC = USC + 16384; float* ACT = (float*)(a.ws + WS_ACT);
    for (int it = C.vcu * 512 + C.tid; it < MTOK * 32; it += C.G * 512) {
        f32x4 h = {0.f, 0.f, 0.f, 0.f};
#pragma unroll
        for (int sl = 0; sl < 8; ++sl) h += *(const f32x4*)(HP + (size_t)sl * MTOK * 128 + (size_t)it * 4);
        const int4 e = *(const int4*)(IDX + (size_t)it * 4); const f32x4 w = *(const f32x4*)(WGT + (size_t)it * 4);
        const float rs = 0.0625f / sqrtf(((const float*)(a.ws + WS_SS))[it >> 5] * (1.f / DM) + EPS);
        f32x4 o;
        o[0] = gelu_tanh(h[0] * USC[e.x] * rs) * w[0] * VSC[e.x]; o[1] = gelu_tanh(h[1] * USC[e.y] * rs) * w[1] * VSC[e.y];
        o[2] = gelu_tanh(h[2] * USC[e.z] * rs) * w[2] * VSC[e.z]; o[3] = gelu_tanh(h[3] * USC[e.w] * rs) * w[3] * VSC[e.w];
        *(f32x4*)(ACT + (size_t)it * 4) = o;
    }
}
typedef int v2i_t __attribute__((ext_vector_type(2)));
__device__ __forceinline__ void pv_compute(const LAS unsigned char* buf, int lane, const long* bact2, f32x4 (&acc)[8]) {
    const int i16 = lane & 15, kq = lane >> 4, rr = i16 >> 1, cc = i16 & 1;
#pragma unroll
    for (int s2 = 0; s2 < 2; ++s2) {
        const int row = 32 * s2 + 8 * kq + rr, sw = row & 7;
#pragma unroll
        for (int nb = 0; nb < 8; ++nb) {
            const v2i_t av = __builtin_amdgcn_ds_read_tr8_b64_v2i32((LAS v2i_t*)(buf + row * 128 + ((nb ^ sw) & 7) * 16 + 8 * cc));
            acc[nb] = __builtin_amdgcn_mfma_f32_16x16x32_fp8_fp8(mk64((unsigned)av.x, (unsigned)av.y), bact2[s2], acc[nb], 0, 0, 0);
        }
    }
}
__device__ __forceinline__ void peer_v_wave(const Args& a, LAS unsigned char* wlds, LAS unsigned char* wsm, int slab, int t0, int ntok, int lane) {
    const unsigned char* V8 = a.ws + WS_PV + (size_t)slab * (16384 * 128);
    const int* IDX = (const int*)(a.ws + WS_IDX) + lane; const float* ACT = (const float*)(a.ws + WS_ACT) + lane;
    bf16* PO = (bf16*)(a.ws + WS_POUT) + slab * 128;
    const int n16 = lane & 15, kq = lane >> 4, tl = t0 + ntok - 1;
    PHalf dA, dB;
    int i0 = IDX[(size_t)t0 * 128], i1 = IDX[(size_t)t0 * 128 + 64];
    float a0 = ACT[(size_t)t0 * 128], a1 = ACT[(size_t)t0 * 128 + 64];
    pg_issue(V8, i0, lane, dA); pg_stage(wlds, lane, dA);
    pg_issue(V8, i1, lane, dB);
    { const int tn = min(t0 + 1, tl); i0 = IDX[(size_t)tn * 128]; i1 = IDX[(size_t)tn * 128 + 64]; }
#pragma unroll 1
    for (int t = t0; t < t0 + ntok; ++t) {
        float mx = fmaxf(fabsf(a0), fabsf(a1));
#pragma unroll
        for (int o = 1; o < 64; o <<= 1) mx = fmaxf(mx, __shfl_xor(mx, o));
        int ex = (int)((__builtin_bit_cast(unsigned, mx) >> 23) & 0xffu) - 127; if (mx < 1e-30f) ex = 7;
        const float sc = __builtin_bit_cast(float, (unsigned)(127 + 7 - ex) << 23), isc = __builtin_bit_cast(float, (unsigned)(127 - 7 + ex) << 23);
        { const float s0 = a0 * sc, s1 = a1 * sc;
          const int hi = __builtin_amdgcn_cvt_pk_fp8_f32(s0, s1, 0, false); const f32x2v bk = __builtin_amdgcn_cvt_pk_f32_fp8(hi, false);
          const int lo = __builtin_amdgcn_cvt_pk_fp8_f32(s0 - bk.x, s1 - bk.y, 0, false);
          wsm[lane] = (unsigned char)(hi & 0xff); wsm[64 + lane] = (unsigned char)((hi >> 8) & 0xff); wsm[128 + lane] = (unsigned char)(lo & 0xff); wsm[192 + lane] = (unsigned char)((lo >> 8) & 0xff); }
        long bact[4];
        { const LAS unsigned char* bp = wsm + ((n16 & 1) ? 128 : 0) + 8 * kq;
#pragma unroll
          for (int s4 = 0; s4 < 4; ++s4) { const v2u w = *(const LAS v2u*)(bp + 32 * s4); bact[s4] = mk64(w.x, w.y); } }
        const int tn = min(t + 1, tl), tnn = min(t + 2, tl);
        a0 = ACT[(size_t)tn * 128]; a1 = ACT[(size_t)tn * 128 + 64];
        f32x4 acc[8];
#pragma unroll
        for (int nb = 0; nb < 8; ++nb) acc[nb] = (f32x4){0.f, 0.f, 0.f, 0.f};
        pg_issue(V8, i0, lane, dA); __builtin_amdgcn_sched_barrier(0);
        pv_compute(wlds, lane, bact, acc); __builtin_amdgcn_sched_barrier(0);
        pg_stage(wlds + 8192, lane, dB); __builtin_amdgcn_sched_barrier(0);
        pg_issue(V8, i1, lane, dB);
        i0 = IDX[(size_t)tnn * 128]; i1 = IDX[(size_t)tnn * 128 + 64]; __builtin_amdgcn_sched_barrier(0);
        pv_compute(wlds + 8192, lane, bact + 2, acc); __builtin_amdgcn_sched_barrier(0);
        pg_stage(wlds, lane, dA); __builtin_amdgcn_sched_barrier(0);
        f32x4 o;
#pragma unroll
        for (int i = 0; i < 4; ++i) o[i] = acc[0][i] + dpp_swap1(acc[0][i]);
#pragma unroll
        for (int nb = 1; nb < 8; ++nb) { const bool sel = (n16 == nb);
#pragma unroll
            for (int i = 0; i < 4; ++i) { const float v = acc[nb][i] + dpp_swap1(acc[nb][i]); o[i] = sel ? v : o[i]; } }
        if (n16 < 8) { v2u w; w.x = pk2(o[0] * isc, o[1] * isc); w.y = pk2(o[2] * isc, o[3] * isc); *(v2u*)(PO + (size_t)t * DM + 16 * n16 + 4 * kq) = w; }
    }
}
__device__ __forceinline__ void final_rows4(const Args& a, int tok0, int tstep, int lane) {
    const float* gf = (const float*)a.in[25] + lane * 4;
    f32x4 h[4][4]; v2u pw[4][4], hw[4][4]; float ss[4];
#pragma unroll
    for (int i = 0; i < 4; ++i) { const int tok = tok0 + i * tstep; const bf16* hb = (const bf16*)(a.ws + WS_N2) + (size_t)tok * DM + lane * 4; const bf16* po = (const bf16*)(a.ws + WS_POUT) + (size_t)tok * DM + lane * 4;
#pragma unroll
        for (int q = 0; q < 4; ++q) { hw[i][q] = *(const v2u*)(hb + 256 * q); pw[i][q] = *(const v2u*)(po + 256 * q); } }
#pragma unroll
    for (int i = 0; i < 4; ++i) { ss[i] = 0.f;
#pragma unroll
        for (int q = 0; q < 4; ++q) { h[i][q][0] = bflo(hw[i][q].x) + bflo(pw[i][q].x); h[i][q][1] = bfhi(hw[i][q].x) + bfhi(pw[i][q].x); h[i][q][2] = bflo(hw[i][q].y) + bflo(pw[i][q].y); h[i][q][3] = bfhi(hw[i][q].y) + bfhi(pw[i][q].y);
            ss[i] += (h[i][q][0] * h[i][q][0] + h[i][q][1] * h[i][q][1]) + (h[i][q][2] * h[i][q][2] + h[i][q][3] * h[i][q][3]); } }
#pragma unroll
    for (int o = 1; o < 64; o <<= 1)
#pragma unroll
        for (int i = 0; i < 4; ++i) ss[i] += __shfl_xor(ss[i], o);
    f32x4 g[4];
#pragma unroll
    for (int q = 0; q < 4; ++q) g[q] = *(const f32x4*)(gf + 256 * q);
#pragma unroll
    for (int i = 0; i < 4; ++i) { const float rstd = 1.0f / sqrtf(ss[i] * (1.f / DM) + EPS); float* orow = a.out + (size_t)(tok0 + i * tstep) * DM + lane * 4;
#pragma unroll
        for (int q = 0; q < 4; ++q) *(f32x4*)(orow + 256 * q) = h[i][q] * rstd * g[q]; }
}

__device__ __forceinline__ void claim_slab_unit(const Ctx& C, unsigned* ctl, int pass, volatile LAS unsigned* MISC, int& slab, int& unit) {
    if (C.tid == 0) {
        const unsigned x = xb_xcc_id() & 7u; unsigned sl = 8u, un = 0u;
        for (unsigned k = 0; k < 8u; ++k) { const unsigned s2 = (x + k) & 7u; const unsigned u2 = xb_add(ctl + CW_Q + 1024 * pass + 64 * s2, 1u); if (u2 < 32u) { sl = s2; un = u2; break; } }
        MISC[16] = sl; MISC[17] = un;
    }
    __syncthreads();
    slab = (int)MISC[16]; unit = (int)MISC[17];
    __syncthreads();
}
__global__ void __launch_bounds__(NWAVES * 64, 2) mk_fwd(Args args) {
    extern __shared__ __attribute__((aligned(16))) unsigned char lds_raw[];
    Ctx C;
    C.lds = (LAS unsigned char*)lds_raw;
    C.wave = __builtin_amdgcn_readfirstlane((int)threadIdx.x >> 6); C.refresh();
    C.G = gridDim.x; { const int bx = blockIdx.x; C.vcu = (C.G % 8 == 0) ? (bx % 8) * (C.G / 8) + bx / 8 : bx; }
    volatile LAS unsigned* MISC = (volatile LAS unsigned*)(C.lds + MISC_OFF);
    if (C.tid < 128) MISC[C.tid] = 0u;
    __syncthreads();
    unsigned char* ws = args.ws;
    unsigned* ctl = (unsigned*)(ws + WS_CTL);
    XcdBarrier bar; bar.bar = ctl + CW_BAR; bar.x = 0; bar.st = nullptr;
#if !MK_PER_PHASE
    bar = xcd_barrier_post(ctl + CW_BAR, MISC + 8, C.tid == 0);
#define GRID_BAR() xcd_barrier(bar, C.wave)
#else
#define GRID_BAR() do { } while (0)
#endif
    const int lo = args.ph_lo, hi = args.ph_hi;
#define IN(k) (lo <= (k) && (k) < hi)
#define SEAM(k) do { if (IN((k) + 1)) GRID_BAR(); C.refresh(); } while (0)
#define REP(k) for (int rep_ = 0; rep_ < 1 + ((REPEAT_MASK >> (k)) & 1); ++rep_)
    bf16* XN = (bf16*)(ws + WS_A);
    if (IN(0)) { REP(0) { p0_prologue(C, args); __syncthreads(); } SEAM(0); }
    if (IN(1)) {
        REP(1) {
        run_gemm(C, XN, (const bf16*)(ws + WS_WIN_T), MTOK, NZ1, DM, FStore{(bf16*)(ws + WS_Z1), NZ1});
        run_gemm(C, (const bf16*)(ws + WS_MEMN), (const bf16*)(ws + WS_WMKV_T), MROWS, 512, DM, FKvm{(bf16*)(ws + WS_KM), (bf16*)(ws + WS_VT)});
        }
        SEAM(1);
    }
    if (IN(2)) {
        REP(2) { const int tile = C.vcu;
            _Pragma("unroll 1") for (int h = 0; h < 4; ++h) r1_unit(C, args, tile, h);
            _Pragma("unroll 1") for (int gi = 0; gi < 2; ++gi) s5a_wave(C, args, tile, C.wave + 8 * gi);
            _Pragma("unroll 1") for (int gi = 0; gi < 2; ++gi) ma_wave(C, args, tile, 2 * gi + (C.wave >> 2), C.wave & 3);
            __syncthreads();
        }
        SEAM(2);
    }
    if (IN(3)) { REP(3) { p3_scans(C, args); } SEAM(3); }
    if (IN(4)) {
        REP(4) { const int tile = C.vcu;
            _Pragma("unroll 1") for (int gi = 0; gi < 2; ++gi) r3_wave(C, args, tile, 2 * gi + (C.wave >> 2), C.wave & 3);
            _Pragma("unroll 1") for (int gi = 0; gi < 2; ++gi) s5c_wave(C, args, tile, C.wave + 8 * gi);
        }
        SEAM(4);
    }
    if (IN(5)) {
        REP(5) {
        run_gemm(C, XN, (const bf16*)(ws + WS_WIN_T) + (size_t)NZ1 * DM, MTOK, NGATE, DM, FSig{(bf16*)(ws + WS_G), NGATE});
        run_gemm(C, (const bf16*)(ws + WS_YG), (const bf16*)(ws + WS_WGLU_T), MTOK, 512, 256, FGlu{(bf16*)(ws + WS_SSM)});
        }
        SEAM(5);
    }
    if (IN(6)) {
        const bf16* Gt = (const bf16*)(ws + WS_G);
        REP(6) {
        run_gemm(C, (const bf16*)(ws + WS_RET), (const bf16*)(ws + WS_WBR_T), MTOK, DM, 512, FBranch<0>{Gt, 0, args.out, XN});
        run_gemm(C, (const bf16*)(ws + WS_SSM), (const bf16*)(ws + WS_WBS_T), MTOK, DM, 256, FBranch<1>{Gt, 1024, args.out, XN});
        run_gemm(C, (const bf16*)(ws + WS_MATTN), (const bf16*)(ws + WS_WBM_T), MTOK, DM, 256, FBranch<2>{Gt, 2048, args.out, XN});
        }
        SEAM(6);
    }
    if (IN(7)) { run_gemm(C, XN, (const bf16*)(ws + WS_WOUT_T), MTOK, DM, DM, FRes{(const float*)args.in[0], (bf16*)(ws + WS_N2), (float*)(ws + WS_SS)}); SEAM(7); }
    if (IN(9)) { REP(9) run_gemm(C, (const bf16*)(ws + WS_N2), (const bf16*)(ws + WS_WQ_T), MTOK, 2048, DM, FStoreRstd{(bf16*)(ws + WS_Q2), 2048, (const float*)(ws + WS_SS)}); SEAM(9); }
    if (IN(10)) {
        { const int tile = C.vcu;
            const int tokbase = tile * 128 + (C.wave & 3) * 32, h0 = (C.wave >> 2) * 4;
            REP(10) { _Pragma("unroll 1") for (int hp = h0; hp < h0 + 4; ++hp) peer_topk_head(C, args, tokbase, hp); }
        }
        SEAM(10);
    }
    if (IN(11)) { int slab, unit; claim_slab_unit(C, ctl, 0, MISC, slab, unit); if (slab < 8) { REP(11) peer_u_wave(args, C.lds + C.wave * 16384, C.lds + 131072 + C.wave * 1024, slab, unit * 1024 + C.wave * 128, 128, C.lane); } SEAM(11); }
    if (IN(12)) { REP(12) peer_reduce(C, args); SEAM(12); }
    if (IN(13)) { int slab, unit; claim_slab_unit(C, ctl, 1, MISC, slab, unit); if (slab < 8) { REP(13) peer_v_wave(args, C.lds + C.wave * 16384, C.lds + 131072 + C.wave * 1024, slab, unit * 1024 + C.wave * 128, 128, C.lane); } SEAM(13); }
    if (IN(14)) {
        const int gw = C.vcu * NWAVES + C.wave, NGW = C.G * NWAVES;
        for (int m = gw; m < MTOK; m += 4 * NGW) final_rows4(args, m, NGW, C.lane);
    }
#undef IN
#undef SEAM
}

extern "C" void kernel_launch(void* const* d_in, const int* in_sizes, int n_in, void* d_out, int out_size, void* d_ws, size_t ws_size, hipStream_t stream) {
    static int grid = 0;
    if (grid == 0) {
        if (n_in != 26 || in_sizes[0] != MTOK * DM || out_size != MTOK * DM || ws_size < WS_END) {
            fprintf(stderr, "kernel_launch: unexpected problem (n_in %d, in0 %d, out %d, ws %zu < %zu); nothing launched\n", n_in, n_in > 0 ? in_sizes[0] : -1, out_size, ws_size, (size_t)WS_END); grid = -1; return; }
        int dev = 0, cus = 0;
        if (hipGetDevice(&dev) != hipSuccess || hipDeviceGetAttribute(&cus, hipDeviceAttributeMultiprocessorCount, dev) != hipSuccess) { grid = -1; return; }
        if (hipFuncSetAttribute((const void*)mk_fwd, hipFuncAttributeMaxDynamicSharedMemorySize, LDS_BYTES) != hipSuccess) { fprintf(stderr, "kernel_launch: hipFuncSetAttribute failed\n"); grid = -1; return; }
        (void)hipGetLastError();
        if (cus < NTILES) { fprintf(stderr, "kernel_launch: needs >= 256 CUs, got %d\n", cus); grid = -1; return; }
        grid = NTILES;
    }
    if (grid < 0) return;
    (void)hipMemsetAsync((char*)d_ws + WS_CTL, 0, CTL_ZERO_BYTES, stream);
    Args a{};
    for (int i = 0; i < 26; ++i) a.in[i] = d_in[i];
    a.out = (float*)d_out; a.ws = (unsigned char*)d_ws;
#if MK_PER_PHASE
    for (int p = 0; p < NPHASE; ++p) { a.ph_lo = p; a.ph_hi = p + 1; hipLaunchKernelGGL(mk_fwd, dim3(grid), dim3(NWAVES * 64), LDS_BYTES, stream, a); }
#else
    a.ph_lo = 0; a.ph_hi = NPHASE;
    hipLaunchKernelGGL(mk_fwd, dim3(grid), dim3(NWAVES * 64), LDS_BYTES, stream, a);
#endif
}
```

```cpp
#include <hip/hip_runtime.h>
#include <cstdio>
#include <cstdint>
namespace pg8 {
__device__ __forceinline__ int hw_lane_id() { int l; asm volatile("v_mbcnt_lo_u32_b32 %0, -1, 0\n\tv_mbcnt_hi_u32_b32 %0, -1, %0" : "=v"(l)); return l; }
#define PG8_LAS __attribute__((address_space(3)))
typedef unsigned short bf16_t;
typedef short bf16x8 __attribute__((ext_vector_type(8)));
typedef float f32x4 __attribute__((ext_vector_type(4)));
typedef unsigned u32x4 __attribute__((ext_vector_type(4)));
constexpr int BM = 256, BK = 64, HALF = 128, HTB = HALF * BK * 2  , STAGE_BYTES = 8 * HTB, NXCD = 8, WGM = 8;

__host__ __device__ __forceinline__ int lds_byte(int r, int c) { const int st = (r >> 4) * 2 + (c >> 5), rr = r & 15, cc = c & 31, ob = rr * 64 + cc * 2; return st * 1024 + (ob ^ (((ob >> 9) & 1) << 5)); }
__host__ __device__ __forceinline__ void stage_rc(int b, int& R, int& C) { const int st = b / 1024, sb = b % 1024, swz = sb ^ (((sb >> 9) & 1) << 5); R = (st >> 1) * 16 + swz / 64; C = (st & 1) * 32 + (swz % 64) / 2; }
__host__ __device__ __forceinline__ int perm32(int rho) { const int n = rho >> 4, i = rho & 15; return 8 * (i >> 2) + 4 * n + (i & 3); }

struct Unit { int pm, pn; };
struct Gemm { const bf16_t* A; const bf16_t* Bt; int M, N, K; };

struct StaticOrder {
    int nM, nN, nwg, G, c;
    __host__ __device__ void init(int M, int N, int G_, int c_) { nM = M / BM; nN = N / BM; nwg = nM * nN; G = G_; c = c_; }
    __host__ __device__ bool next(int i, Unit& u) const {
        const long L = (long)i * G + c; if (L >= nwg) return false;
        int wgid = (int)L; { const int q = nwg / NXCD, r = nwg % NXCD, xcd = wgid % NXCD, off = wgid / NXCD; wgid = (xcd < r ? xcd * (q + 1) : r * (q + 1) + (xcd - r) * q) + off; }
        const int nig = WGM * nN, gid = wgid / nig, fm = gid * WGM, gsz = (nM - fm) < WGM ? (nM - fm) : WGM;
        u.pm = fm + ((wgid % nig) % gsz); u.pn = (wgid % nig) / gsz; return true;
    }
    __device__ __forceinline__ void a_ready(const Unit&) const {}
    __device__ __forceinline__ void done(const Unit&) const {}
};

__device__ __forceinline__ unsigned cvt_pk_bf16(float lo, float hi) { unsigned r; asm volatile("v_cvt_pk_bf16_f32 %0, %1, %2" : "=v"(r) : "v"(lo), "v"(hi)); return r; }
template <class Epi, class Sched, bool ALIGN_EPI = false, bool SP2 = false>
__device__ __forceinline__ void gemm_phase(PG8_LAS unsigned char* lds, const Gemm g, const Sched& S, const Epi& E, const int wid) {
    const int lane = hw_lane_id(), tid = wid * 64 + lane, wr = wid >> 2, wc = wid & 3, fr = lane & 15, fq = lane >> 4;
    const int K = g.K, nt = K / BK;
    unsigned voffA[2], voffB[2];
#pragma unroll
    for (int i = 0; i < 2; ++i) { int R, C; stage_rc(tid * 16 + i * 8192, R, C); const int Rb = Epi::PERM ? ((R & ~31) + perm32(R & 31)) : R;
        voffA[i] = (unsigned)(R * K + C) * 2u; voffB[i] = (unsigned)(Rb * K + C) * 2u; }
    const size_t kstep = (size_t)(BK * 2);
    const size_t hstep = (size_t)HALF * K * 2;
    const size_t tstep = 2 * hstep;
    const unsigned ldsw = (unsigned)wid * 1024u;
    const int aoff = lds_byte(wr * 64 + fr, fq * 8), boff = lds_byte(wc * 32 + fr, fq * 8);
#define PG8_SA(b, h) (((b) * 2 + (h)) * HTB)
#define PG8_SB(b, h) ((4 + (b) * 2 + (h)) * HTB)
#define PG8_STAGE(bufoff, gbase, voff) do { _Pragma("unroll") for (int _i = 0; _i < 2; ++_i) \
        __builtin_amdgcn_global_load_lds((const unsigned*)((const char*)(gbase) + (voff)[_i]), (PG8_LAS unsigned*)(lds + (bufoff) + ldsw + _i * 8192), 16, 0, 0); } while (0)
#define PG8_LDA(dst, b, h) do { _Pragma("unroll") for (int m = 0; m < 4; ++m) _Pragma("unroll") for (int k = 0; k < 2; ++k) dst[m][k] = *(const PG8_LAS bf16x8*)(lds + PG8_SA(b, h) + aoff + m * 2048 + k * 1024); } while (0)
#define PG8_LDB(dst, b, h) do { _Pragma("unroll") for (int n = 0; n < 2; ++n) _Pragma("unroll") for (int k = 0; k < 2; ++k) dst[n][k] = *(const PG8_LAS bf16x8*)(lds + PG8_SB(b, h) + boff + n * 2048 + k * 1024); } while (0)
#define PG8_MMA(ai, bj, At, Bt) do { __builtin_amdgcn_s_setprio(1); _Pragma("unroll") for (int m = 0; m < 4; ++m) _Pragma("unroll") for (int n = 0; n < 2; ++n) _Pragma("unroll") for (int k = 0; k < 2; ++k) \
        acc[ai][bj][m][n] = __builtin_amdgcn_mfma_f32_16x16x32_bf16(Bt[n][k], At[m][k], acc[ai][bj][m][n], 0, 0, 0); __builtin_amdgcn_s_setprio(0); } while (0)
#define PG8_WAIT_V(n) asm volatile("s_waitcnt vmcnt(" #n ")" ::: "memory")
#define PG8_WAIT_L(n) asm volatile("s_waitcnt lgkmcnt(" #n ")" ::: "memory")
#define PG8_BAR __builtin_amdgcn_s_barrier()
#define PG8_SCHED __builtin_amdgcn_sched_barrier(0)
    Unit cur, nxt; int ui = 0;
    if (!S.next(0, cur)) return;
    f32x4 acc[2][2][4][2];
#pragma unroll
    for (int a = 0; a < 2; ++a)
#pragma unroll
        for (int b = 0; b < 2; ++b)
#pragma unroll
            for (int m = 0; m < 4; ++m)
#pragma unroll
                for (int n = 0; n < 2; ++n) acc[a][b][m][n] = (f32x4){0.f, 0.f, 0.f, 0.f};
    bf16x8 At[4][2], B0[2][2], B1[2][2];
    const char* cA = (const char*)g.A + (size_t)cur.pm * tstep; const char* cB = (const char*)g.Bt + (size_t)cur.pn * tstep;
    S.a_ready(cur);
    if constexpr (SP2) {
        PG8_STAGE(PG8_SB(0, 0), cB, voffB); PG8_STAGE(PG8_SB(0, 1), cB + hstep, voffB); PG8_STAGE(PG8_SA(0, 0), cA, voffA); PG8_STAGE(PG8_SA(0, 1), cA + hstep, voffA);
        if (wr == 1) PG8_BAR;
        PG8_WAIT_V(2); PG8_BAR;
        PG8_STAGE(PG8_SB(1, 0), cB + kstep, voffB); PG8_STAGE(PG8_SA(1, 0), cA + kstep, voffA); PG8_STAGE(PG8_SB(1, 1), cB + hstep + kstep, voffB);
        PG8_WAIT_V(6); PG8_BAR;
    } else {
        PG8_STAGE(PG8_SB(0, 0), cB, voffB); PG8_STAGE(PG8_SA(0, 0), cA, voffA); PG8_STAGE(PG8_SB(0, 1), cB + hstep, voffB); PG8_STAGE(PG8_SA(0, 1), cA + hstep, voffA);
        if (wr == 1) PG8_BAR;
        PG8_WAIT_V(4); PG8_BAR;
        PG8_STAGE(PG8_SB(1, 0), cB + kstep, voffB); PG8_STAGE(PG8_SA(1, 0), cA + kstep, voffA); PG8_STAGE(PG8_SB(1, 1), cB + hstep + kstep, voffB);
        PG8_WAIT_V(6); PG8_BAR;
    }
    for (;;) {
        const bool has_next = S.next(ui + 1, nxt);
        const char* nA = has_next ? (const char*)g.A + (size_t)nxt.pm * tstep : cA; const char* nB = has_next ? (const char*)g.Bt + (size_t)nxt.pn * tstep : cB;
        for (int t = 0; t < nt; t += 2) {
            const bool last = (t == nt - 2);
            const char* a1 = cA + (size_t)(t + 1) * kstep;
            const char* a2 = last ? nA : cA + (size_t)(t + 2) * kstep; const char* b2 = last ? nB : cB + (size_t)(t + 2) * kstep;
            const char* a3 = a2 + kstep; const char* b3 = b2 + kstep;
            if (last && has_next) S.a_ready(nxt);
            if constexpr (SP2) {
            PG8_LDB(B0, 0, 0); PG8_LDB(B1, 0, 1); PG8_SCHED; PG8_LDA(At, 0, 0); PG8_STAGE(PG8_SA(1, 1), a1 + hstep, voffA);
            PG8_WAIT_V(8); PG8_WAIT_L(0); PG8_BAR; PG8_MMA(0, 0, At, B0); PG8_MMA(0, 1, At, B1); PG8_BAR; PG8_SCHED;
            PG8_LDA(At, 0, 1); PG8_STAGE(PG8_SB(0, 0), b2, voffB); PG8_STAGE(PG8_SB(0, 1), b2 + hstep, voffB); PG8_STAGE(PG8_SA(0, 0), a2, voffA);
            PG8_WAIT_V(8); PG8_WAIT_L(0); PG8_BAR; PG8_MMA(1, 0, At, B0); PG8_MMA(1, 1, At, B1); PG8_BAR; PG8_SCHED;
            PG8_LDB(B0, 1, 0); PG8_LDB(B1, 1, 1); PG8_SCHED; PG8_LDA(At, 1, 0); PG8_STAGE(PG8_SA(0, 1), a2 + hstep, voffA);
            PG8_WAIT_V(8); PG8_WAIT_L(0); PG8_BAR; PG8_MMA(0, 0, At, B0); PG8_MMA(0, 1, At, B1); PG8_BAR; PG8_SCHED;
            PG8_LDA(At, 1, 1); PG8_STAGE(PG8_SB(1, 0), b3, voffB); PG8_STAGE(PG8_SB(1, 1), b3 + hstep, voffB); PG8_STAGE(PG8_SA(1, 0), a3, voffA);
            PG8_WAIT_V(8); PG8_WAIT_L(0); PG8_BAR; PG8_MMA(1, 0, At, B0); PG8_MMA(1, 1, At, B1); PG8_BAR; PG8_SCHED;
            } else {
            PG8_LDB(B0, 0, 0); PG8_SCHED; PG8_LDA(At, 0, 0); PG8_STAGE(PG8_SA(1, 1), a1 + hstep, voffA);
            PG8_WAIT_L(8); PG8_BAR; PG8_WAIT_L(0); PG8_MMA(0, 0, At, B0); PG8_BAR; PG8_SCHED;
            PG8_LDB(B1, 0, 1); PG8_STAGE(PG8_SB(0, 0), b2, voffB);
            PG8_BAR; PG8_WAIT_L(0); PG8_MMA(0, 1, At, B1); PG8_BAR;
            PG8_LDA(At, 0, 1); PG8_STAGE(PG8_SA(0, 0), a2, voffA);
            PG8_BAR; PG8_WAIT_L(0); PG8_MMA(1, 0, At, B0); PG8_BAR; PG8_SCHED;
            PG8_STAGE(PG8_SB(0, 1), b2 + hstep, voffB);
            PG8_WAIT_V(6); PG8_BAR; PG8_MMA(1, 1, At, B1); PG8_BAR;
            PG8_LDB(B0, 1, 0); PG8_SCHED; PG8_LDA(At, 1, 0); PG8_STAGE(PG8_SA(0, 1), a2 + hstep, voffA);
            PG8_WAIT_L(8); PG8_BAR; PG8_WAIT_L(0); PG8_MMA(0, 0, At, B0); PG8_BAR; PG8_SCHED;
            PG8_LDB(B1, 1, 1); PG8_STAGE(PG8_SB(1, 0), b3, voffB);
            PG8_BAR; PG8_WAIT_L(0); PG8_MMA(0, 1, At, B1); PG8_BAR;
            PG8_LDA(At, 1, 1); PG8_STAGE(PG8_SA(1, 0), a3, voffA);
            PG8_BAR; PG8_WAIT_L(0); PG8_MMA(1, 0, At, B0); PG8_BAR; PG8_SCHED;
            PG8_STAGE(PG8_SB(1, 1), b3 + hstep, voffB);
            PG8_WAIT_V(6); PG8_BAR; PG8_MMA(1, 1, At, B1); PG8_BAR;
            }
        }
        if constexpr (ALIGN_EPI) { if (wr == 0) PG8_BAR; }
        if constexpr (!Epi::AFTER_DRAIN) { E(acc, cur, wr, wc, fr, fq); S.done(cur); }
        if (!has_next) break;
#pragma unroll
        for (int a = 0; a < 2; ++a)
#pragma unroll
            for (int b = 0; b < 2; ++b)
#pragma unroll
                for (int m = 0; m < 4; ++m)
#pragma unroll
                    for (int n = 0; n < 2; ++n) acc[a][b][m][n] = (f32x4){0.f, 0.f, 0.f, 0.f};
        cur = nxt; cA = nA; cB = nB; ++ui;
        if constexpr (ALIGN_EPI) { if (wr == 1) PG8_BAR; }
    }
    PG8_WAIT_V(0);
    if constexpr (!ALIGN_EPI) { if (wr == 0) PG8_BAR; }
    PG8_BAR;
    if constexpr (Epi::AFTER_DRAIN) { E.fused(acc, cur, wr, wc, fr, fq, lds, wid, lane); S.done(cur); }
#undef PG8_SA
#undef PG8_SB
#undef PG8_STAGE
#undef PG8_LDA
#undef PG8_LDB
#undef PG8_MMA
#undef PG8_WAIT_V
#undef PG8_WAIT_L
#undef PG8_BAR
#undef PG8_SCHED
}
}

#ifndef REPEAT_MASK
#define REPEAT_MASK 0
#endif
#ifndef MK_PER_PHASE
#define MK_PER_PHASE 0
#endif

constexpr int DM = 1024, BATCH = 8, SEQ = 4096, MTOK = BATCH * SEQ;
constexpr int MEMLEN = 256, MROWS = BATCH * MEMLEN;
constexpr int NZ1 = 2560, NGATE = 3072;
constexpr int ZQ = 0, ZK = 512, ZV = 1024, ZGR = 1536, ZU = 2048, ZQM = 2304;
constexpr int NTILES = MTOK / 128;
constexpr float EPS = 1e-6f;
constexpr int NPHASE = 15;

constexpr size_t MiB = 1u << 20;
constexpr size_t WS_CTL = 0, CTL_ZERO_BYTES = 1 * MiB;
constexpr size_t WS_WIN_T = 1 * MiB;
constexpr size_t WS_WQ_T = 12 * MiB;
constexpr size_t WS_WOUT_T = 16 * MiB;
constexpr size_t WS_WBR_T = 18 * MiB;
constexpr size_t WS_WBS_T = 19 * MiB;
constexpr size_t WS_WBM_T = 19 * MiB + 512 * 1024;
constexpr size_t WS_WGLU_T = 20 * MiB;
constexpr size_t WS_WMKV_T = 21 * MiB;
constexpr size_t WS_KEYS = 22 * MiB;
constexpr size_t WS_S5MAT = 23 * MiB;
constexpr size_t WS_S5C = 25 * MiB;
constexpr size_t WS_PSC = 25 * MiB + 256 * 1024;
constexpr size_t WS_SS = 25 * MiB + 512 * 1024;
constexpr size_t WS_ROPE = 26 * MiB;
constexpr size_t WS_PU = 42 * MiB;
constexpr size_t WS_PV = 74 * MiB;
constexpr size_t WS_MEMN = 106 * MiB;
constexpr size_t WS_KM = 110 * MiB;
constexpr size_t WS_VT = 111 * MiB;
constexpr size_t WS_S5E = 112 * MiB;
constexpr size_t WS_S5X = 114 * MiB;
constexpr size_t WS_A = 116 * MiB;
constexpr size_t WS_B = 180 * MiB;
constexpr size_t WS_Z1 = WS_B;
constexpr size_t WS_G = WS_B;
constexpr size_t WS_RET = WS_B + 192 * MiB;
constexpr size_t WS_SSM = WS_B + 224 * MiB;
constexpr size_t WS_MATTN = WS_B + 240 * MiB;
constexpr size_t WS_YG = WS_B + 256 * MiB;
constexpr size_t WS_INNER = WS_B + 272 * MiB;
constexpr size_t WS_N2 = WS_B;
constexpr size_t WS_Q2 = WS_B + 64 * MiB;
constexpr size_t WS_IDX = WS_B + 192 * MiB;
constexpr size_t WS_WGT = WS_B + 208 * MiB;
constexpr size_t WS_HPART = WS_B + 128 * MiB;
constexpr size_t WS_ACT = WS_B + 224 * MiB;
constexpr size_t WS_POUT = WS_B + 64 * MiB;
constexpr size_t WS_END = WS_B + 304 * MiB;

constexpr int CW_BAR = 4096;
constexpr int CW_Q = 8192;

constexpr int LDS_BYTES = 147456;
constexpr int MISC_OFF = LDS_BYTES - 512;
constexpr int NWAVES = 8;

#define GAS __attribute__((address_space(1)))
#define LAS __attribute__((address_space(3)))
typedef unsigned short bf16;
typedef unsigned v4u __attribute__((ext_vector_type(4)));
typedef unsigned v2u __attribute__((ext_vector_type(2)));
typedef float f32x4 __attribute__((ext_vector_type(4)));
typedef float f32x16 __attribute__((ext_vector_type(16)));
typedef short bf16x8 __attribute__((ext_vector_type(8)));
typedef GAS unsigned gu32;
#define RLX_AGENT __ATOMIC_RELAXED, __HIP_MEMORY_SCOPE_AGENT
#define LDS_WAIT() asm volatile("s_waitcnt lgkmcnt(0)" ::: "memory")
#define VM_WAIT() asm volatile("s_waitcnt vmcnt(0)" ::: "memory")
__device__ __forceinline__ unsigned f2bf(float f) { unsigned u = __builtin_bit_cast(unsigned, f); return (u + 0x7fffu + ((u >> 16) & 1u)) >> 16; }
__device__ __forceinline__ unsigned pk2(float lo, float hi) { return f2bf(lo) | (f2bf(hi) << 16); }
__device__ __forceinline__ float bflo(unsigned w) { return __builtin_bit_cast(float, w << 16); }
__device__ __forceinline__ float bfhi(unsigned w) { return __builtin_bit_cast(float, w & 0xffff0000u); }
__device__ __forceinline__ float bf2f(bf16 h) { return __builtin_bit_cast(float, (unsigned)h << 16); }
__device__ __forceinline__ f32x16 mfma32(bf16x8 a, bf16x8 b, f32x16 c) { return __builtin_amdgcn_mfma_f32_32x32x16_bf16(a, b, c, 0, 0, 0); }
__device__ __forceinline__ f32x4 mfma16(bf16x8 a, bf16x8 b, f32x4 c) { return __builtin_amdgcn_mfma_f32_16x16x32_bf16(a, b, c, 0, 0, 0); }
__device__ __forceinline__ bf16x8 mk8(unsigned a, unsigned b, unsigned c, unsigned d) { v4u t = {a, b, c, d}; return __builtin_bit_cast(bf16x8, t); }
__device__ __forceinline__ float sigmoidf_(float x) { return 1.0f / (1.0f + __expf(-x)); }
__device__ __forceinline__ float gelu_tanh(float x) {
    const float u = 0.7978845608028654f * (x + 0.044715f * x * x * x);
    const float e = __expf(2.0f * u);
    const float th = 1.0f - 2.0f / (e + 1.0f);
    return 0.5f * x * (1.0f + th);
}
__device__ __forceinline__ float wave_sum(float v) {
#pragma unroll
    for (int o = 1; o < 64; o <<= 1) v += __shfl_xor(v, o);
    return v;
}

#define XB_TMO      128
#define XB_XCNT(j)  (256  + 64 * (j))
#define XB_XSUB(j)  (1280 + 64 * (j))
#define XB_XGEN(j)  (2304 + 64 * (j))
#define XB_TOP      3328
#define XB_TOPGEN   3392
#define XCD_BAR_WORDS 3456
#define XB_SPIN_CAP (1u << 22)

__device__ __forceinline__ unsigned xb_ld(unsigned* p)              { return __hip_atomic_load(p, __ATOMIC_RELAXED, __HIP_MEMORY_SCOPE_AGENT); }
__device__ __forceinline__ unsigned xb_add(unsigned* p, unsigned v) { return __hip_atomic_fetch_add(p, v, __ATOMIC_RELAXED, __HIP_MEMORY_SCOPE_AGENT); }
__device__ __forceinline__ unsigned xb_xcc_id() { return (unsigned)__builtin_amdgcn_s_getreg((3 << 11) | 20) & 0xFu; }
#define XB_SPIN(cond, bar) do { unsigned _sp = 0; while (cond) { __builtin_amdgcn_s_sleep(1); \
    if ((++_sp & 255u) == 0u) { if (xb_ld(&(bar)[XB_TMO])) break; if (_sp > XB_SPIN_CAP) { atomicAdd(&(bar)[XB_TMO], 1u); break; } } } } while (0)

struct XcdBarrier { unsigned* bar; unsigned x; volatile LAS unsigned* st; };

__device__ __forceinline__ XcdBarrier xcd_barrier_post(unsigned* bar, volatile LAS unsigned* st, bool tid0) {
    XcdBarrier b; b.bar = bar; b.x = xb_xcc_id(); b.st = st;
    if (tid0) (void)xb_add(&bar[XB_XCNT(b.x)], 1u);
    return b;
}
__device__ __forceinline__ void xcd_barrier_complete(unsigned* bar, unsigned x, unsigned& nloc, unsigned& nx) {
    const unsigned G = gridDim.x * gridDim.y * gridDim.z;
    unsigned sum, cnt, mine, sp = 0u;
    for (;;) {
        sum = 0u; cnt = 0u; mine = 0u;
#pragma unroll
        for (unsigned j = 0; j < 16; ++j) { const unsigned c = xb_ld(&bar[XB_XCNT(j)]); sum += c; cnt += (c > 0u) ? 1u : 0u; mine = (j == x) ? c : mine; }
        if (sum == G) break;
        __builtin_amdgcn_s_sleep(1);
        if ((++sp & 255u) == 0u) { if (xb_ld(&bar[XB_TMO])) break; if (sp > XB_SPIN_CAP) { atomicAdd(&bar[XB_TMO], 1u); break; } }
    }
    nloc = mine > 0u ? mine : 1u; nx = cnt > 0u ? cnt : 1u;
}
__device__ __forceinline__ void xcd_barrier(const XcdBarrier& b, int wave) {
    asm volatile("s_waitcnt vmcnt(0)" ::: "memory");
    __syncthreads();
    if (wave == 0 && pg8::hw_lane_id() == 0) {
        unsigned* bar = b.bar;
        __builtin_amdgcn_s_waitcnt(0);
        unsigned nloc = b.st[0], nx = b.st[1];
        if (nloc == 0u) { xcd_barrier_complete(bar, b.x, nloc, nx); b.st[0] = nloc; b.st[1] = nx; }
        const unsigned old = xb_add(&bar[XB_XSUB(b.x)], 1u);
        const unsigned gen = old / nloc;
        if (old + 1u == (gen + 1u) * nloc) {
            __builtin_amdgcn_fence(__ATOMIC_RELEASE, "agent");
            asm volatile("s_waitcnt vmcnt(0)" ::: "memory");
            const unsigned og = xb_add(&bar[XB_TOP], 1u);
            const unsigned tg = og / nx;
            if (og + 1u == (tg + 1u) * nx) xb_add(&bar[XB_TOPGEN], 1u);
            else XB_SPIN(xb_ld(&bar[XB_TOPGEN]) == tg, bar);
            __builtin_amdgcn_fence(__ATOMIC_ACQUIRE, "agent");
            xb_add(&bar[XB_XGEN(b.x)], 1u);
            asm volatile("s_waitcnt vmcnt(0)" ::: "memory");
        } else {
            XB_SPIN(xb_ld(&bar[XB_XGEN(b.x)]) == gen, bar);
            __builtin_amdgcn_fence(__ATOMIC_ACQUIRE, "agent");
            asm volatile("s_waitcnt vmcnt(0)" ::: "memory");
        }
    }
    __syncthreads();
}

__host__ __device__ __forceinline__ int frag32(int row, int k, int K) { return (((row >> 5) * (K >> 4) + (k >> 4)) * 64 + ((k >> 3) & 1) * 32 + (row & 31)) * 8 + (k & 7); }
__host__ __device__ __forceinline__ int frag16(int n, int k, int K) { return (((n >> 4) * (K >> 5) + (k >> 5)) * 64 + ((k >> 3) & 3) * 16 + (n & 15)) * 8 + (k & 7); }
struct Args { const void* in[26]; float* out; unsigned char* ws; int ph_lo, ph_hi; };
struct Ctx {
    LAS unsigned char* lds;
    int tid, lane, wave, vcu, G;
    __device__ __forceinline__ void refresh() { lane = pg8::hw_lane_id(); tid = wave * 64 + lane; }
};

template <class F> struct EpiT {
    static constexpr bool PERM = true, AFTER_DRAIN = false;
    F f;
    __device__ __forceinline__ void operator()(const f32x4 (&acc)[2][2][4][2], const pg8::Unit& u, int wr, int wc, int fr, int fq) const {
        const int row0 = u.pm * 256 + wr * 64 + fr, col0 = u.pn * 256 + wc * 32 + 8 * fq;
        typename F::L cur[2], nxt[2];
        f.load(row0, col0, cur[0]); f.load(row0, col0 + 128, cur[1]);
#pragma unroll
        for (int i = 0; i < 8; ++i) {
            const int ai = i >> 2, m = i & 3, row = row0 + ai * 128 + m * 16;
            if (i < 7) { const int rown = row0 + ((i + 1) >> 2) * 128 + ((i + 1) & 3) * 16; f.load(rown, col0, nxt[0]); f.load(rown, col0 + 128, nxt[1]); }
            __builtin_amdgcn_sched_barrier(0);
            f.apply(row, col0, acc[ai][0][m][0], acc[ai][0][m][1], cur[0]); f.apply(row, col0 + 128, acc[ai][1][m][0], acc[ai][1][m][1], cur[1]);
            __builtin_amdgcn_sched_barrier(0);
            cur[0] = nxt[0]; cur[1] = nxt[1];
        }
    }
};
__device__ __forceinline__ v4u pack8(f32x4 a, f32x4 b) { v4u w; w.x = pk2(a[0], a[1]); w.y = pk2(a[2], a[3]); w.z = pk2(b[0], b[1]); w.w = pk2(b[2], b[3]); return w; }
struct LNone {};
struct FStore { typedef LNone L; bf16* O; int ldc;
    __device__ __forceinline__ void load(int, int, L&) const {}
    __device__ __forceinline__ void apply(int row, int col, f32x4 v0, f32x4 v1, const L&) const { *(v4u*)(O + (size_t)row * ldc + col) = pack8(v0, v1); } };
struct FKvm { typedef LNone L; bf16* KM; bf16* VT;
    __device__ __forceinline__ void load(int, int, L&) const {}
    __device__ __forceinline__ void apply(int row, int col, f32x4 v0, f32x4 v1, const L&) const {
        const int b = row >> 8, m = row & 255;
        if (col < 256) { const int hm = col >> 6, d0 = col & 63; *(v4u*)(KM + (size_t)(b * 4 + hm) * 16384 + frag32(m, d0, 64)) = pack8(v0, v1); }
        else { const int c = col - 256, hm = c >> 6, e0 = c & 63, mt = m >> 5, s2 = (m >> 4) & 1, w = m & 15, hh = (w >> 2) & 1, j = ((w >> 3) << 2) | (w & 3);
            bf16* p = VT + (size_t)(b * 4 + hm) * 16384 + ((mt * 2 + s2) * 64 + hh * 32) * 8 + j;
#pragma unroll
            for (int jj = 0; jj < 8; ++jj) { const int e = e0 + jj; p[((e >> 5) * 16 * 64 + (e & 31)) * 8] = (bf16)f2bf(jj < 4 ? v0[jj] : v1[jj - 4]); } }
    } };
struct FSig { typedef LNone L; bf16* O; int ldc;
    __device__ __forceinline__ void load(int, int, L&) const {}
    __device__ __forceinline__ void apply(int row, int col, f32x4 v0, f32x4 v1, const L&) const {
#pragma unroll
        for (int j = 0; j < 4; ++j) { v0[j] = sigmoidf_(v0[j]); v1[j] = sigmoidf_(v1[j]); }
        *(v4u*)(O + (size_t)row * ldc + col) = pack8(v0, v1); } };
struct FGlu { typedef LNone L; bf16* O;
    __device__ __forceinline__ void load(int, int, L&) const {}
    __device__ __forceinline__ void apply(int row, int col, f32x4 v0, f32x4 v1, const L&) const {
        v2u w; w.x = pk2(v0[0] * sigmoidf_(v1[0]), v0[1] * sigmoidf_(v1[1])); w.y = pk2(v0[2] * sigmoidf_(v1[2]), v0[3] * sigmoidf_(v1[3]));
        *(v2u*)(O + (size_t)row * 256 + (col >> 1)) = w; } };
struct LBranch { v4u g; v4u m; };
template <int MODE> struct FBranch { typedef LBranch L; const bf16* Gt; int goff; bf16* MF; bf16* MB;
    __device__ __forceinline__ void load(int row, int col, L& l) const {
        l.g = *(const v4u*)(Gt + (size_t)row * NGATE + goff + col);
        if (MODE >= 1) l.m = *(const v4u*)(MF + (size_t)row * DM + col); }
    __device__ __forceinline__ void apply(int row, int col, f32x4 v0, f32x4 v1, const L& l) const {
        const v4u g = l.g;
        v0[0] *= bflo(g.x); v0[1] *= bfhi(g.x); v0[2] *= bflo(g.y); v0[3] *= bfhi(g.y);
        v1[0] *= bflo(g.z); v1[1] *= bfhi(g.z); v1[2] *= bflo(g.w); v1[3] *= bfhi(g.w);
        if (MODE >= 1) { const v4u m = l.m; v0[0] += bflo(m.x); v0[1] += bfhi(m.x); v0[2] += bflo(m.y); v0[3] += bfhi(m.y); v1[0] += bflo(m.z); v1[1] += bfhi(m.z); v1[2] += bflo(m.w); v1[3] += bfhi(m.w); }
        *(v4u*)((MODE <= 1 ? MF : MB) + (size_t)row * DM + col) = pack8(v0, v1); } };
struct LRes { f32x4 x0, x1; };
struct FRes { typedef LRes L; const float* X; bf16* HB; float* SS;
    __device__ __forceinline__ void load(int row, int col, L& l) const { const float* xp = X + (size_t)row * DM + col; l.x0 = *(const f32x4*)xp; l.x1 = *(const f32x4*)(xp + 4); }
    __device__ __forceinline__ void apply(int row, int col, f32x4 v0, f32x4 v1, const L& l) const {
        v0 += l.x0; v1 += l.x1;
        *(v4u*)(HB + (size_t)row * DM + col) = pack8(v0, v1);
        float q = (v0[0] * v0[0] + v0[1] * v0[1]) + (v0[2] * v0[2] + v0[3] * v0[3]) + (v1[0] * v1[0] + v1[1] * v1[1]) + (v1[2] * v1[2] + v1[3] * v1[3]);
        q += __shfl_xor(q, 16); q += __shfl_xor(q, 32);
        if (pg8::hw_lane_id() < 16) atomicAdd(SS + row, q); } };
struct LRstd { float ss; };
struct FStoreRstd { typedef LRstd L; bf16* O; int ldc; const float* SS;
    __device__ __forceinline__ void load(int row, int, L& l) const { l.ss = SS[row]; }
    __device__ __forceinline__ void apply(int row, int col, f32x4 v0, f32x4 v1, const L& l) const {
        const float rs = 1.0f / sqrtf(l.ss * (1.f / DM) + EPS); *(v4u*)(O + (size_t)row * ldc + col) = pack8(v0 * rs, v1 * rs); } };

template <class F>
__device__ __forceinline__ void run_gemm(const Ctx& C, const bf16* A, const bf16* Bt, int M, int N, int K, const F& f) {
    pg8::Gemm g{A, Bt, M, N, K}; pg8::StaticOrder S; S.init(M, N, C.G, (int)blockIdx.x);
    EpiT<F> E{f};
    pg8::gemm_phase<EpiT<F>, pg8::StaticOrder, true, true>(C.lds, g, S, E, C.wave);
}

template <bool GLU>
__device__ __forceinline__ void p0_transpose_item(const float* W, int K, int N, bf16* WT, LAS float* scr, int item, int lane, const float* kscale = nullptr) {
    const int nblk = N / 32, kb = item / nblk, nb = item % nblk, k0 = 64 * kb, n0 = 32 * nb;
#pragma unroll 8
    for (int i = 0; i < 32; ++i) { const int kk = 2 * i + (lane >> 5); float w = W[(size_t)(k0 + kk) * N + n0 + (lane & 31)]; if (kscale) w *= kscale[k0 + kk]; scr[kk * 33 + (lane & 31)] = w; }
    LDS_WAIT(); asm volatile("" ::: "memory");
    const int c = lane & 7;
#pragma unroll
    for (int j = 0; j < 4; ++j) { const int n = (lane >> 3) + 8 * j; const LAS float* s = scr + (8 * c) * 33 + n;
        v4u o; o.x = pk2(s[0 * 33], s[1 * 33]); o.y = pk2(s[2 * 33], s[3 * 33]); o.z = pk2(s[4 * 33], s[5 * 33]); o.w = pk2(s[6 * 33], s[7 * 33]);
        const int nn = n0 + n; int row = nn;
        if (GLU) { const int jc = nn & 255, gate = nn >> 8; row = 8 * (jc >> 2) + 4 * gate + (jc & 3); }
        *(GAS v4u*)(WT + (size_t)row * K + k0 + 8 * c) = o; }
    LDS_WAIT(); asm volatile("" ::: "memory");
}
template <int NR>
__device__ __forceinline__ void rms_rows_to_bf16(const float* xbase, const float* gain, bf16* obase, int m0, int mstep, int lane) {
    f32x4 v[NR][4]; float s[NR];
#pragma unroll
    for (int i = 0; i < NR; ++i) { const f32x4* xr = (const f32x4*)(xbase + (size_t)(m0 + i * mstep) * DM) + lane; s[i] = 0.f;
#pragma unroll
        for (int j = 0; j < 4; ++j) v[i][j] = xr[64 * j]; }
#pragma unroll
    for (int i = 0; i < NR; ++i)
#pragma unroll
        for (int j = 0; j < 4; ++j) s[i] += (v[i][j].x * v[i][j].x + v[i][j].y * v[i][j].y) + (v[i][j].z * v[i][j].z + v[i][j].w * v[i][j].w);
#pragma unroll
    for (int o = 1; o < 64; o <<= 1)
#pragma unroll
        for (int i = 0; i < NR; ++i) s[i] += __shfl_xor(s[i], o);
    const f32x4* gr = (const f32x4*)gain + lane;
    f32x4 g[4];
#pragma unroll
    for (int j = 0; j < 4; ++j) g[j] = gr[64 * j];
#pragma unroll
    for (int i = 0; i < NR; ++i) { const float rstd = 1.0f / sqrtf(s[i] * (1.f / DM) + EPS);
        unsigned long long* o8 = (unsigned long long*)(obase + (size_t)(m0 + i * mstep) * DM) + lane;
#pragma unroll
        for (int j = 0; j < 4; ++j) o8[64 * j] = (unsigned long long)pk2(v[i][j].x * rstd * g[j].x, v[i][j].y * rstd * g[j].y) | ((unsigned long long)pk2(v[i][j].z * rstd * g[j].z, v[i][j].w * rstd * g[j].w) << 32); }
}

__device__ __forceinline__ void p0_s5_group(const Ctx& C, const Args& a, int g, int part) {
    const float* a_re = (const float*)a.in[7]; const float* a_im = (const float*)a.in[8]; const float* log_dt = (const float*)a.in[9];
    const float* b_re = (const float*)a.in[10]; const float* b_im = (const float*)a.in[11]; const float* c_re = (const float*)a.in[12]; const float* c_im = (const float*)a.in[13];
    LAS float* L = (LAS float*)C.lds;
    LAS float* lpr = L;
    LAS float* lpi = L + 640;
    LAS float* bbr = L + 1280;
    LAS float* bbi = bbr + 1024;
    LAS float* ccr = bbi + 1024;
    LAS float* cci = ccr + 1024;
    LAS float* Kj = cci + 1024;
    const int tid = C.tid;
    bf16* T8T = (bf16*)(a.ws + WS_S5MAT) + (size_t)g * 16384;
    bf16* PMT = (bf16*)(a.ws + WS_S5MAT) + (size_t)(16 + g) * 16384;
    bf16* QMT = (bf16*)(a.ws + WS_S5MAT) + (size_t)(32 + g) * 16384;
    float* L8 = (float*)(a.ws + WS_S5C) + (size_t)g * 128;
    float* L128 = (float*)(a.ws + WS_S5C) + 2048 + (size_t)g * 128;
    for (int i = tid; i < 640; i += 512) {
        const int j10 = i >> 6, p = i & 63; const double jj = (j10 < 9) ? (double)j10 : 128.0;
        const double dt = exp((double)log_dt[g]);
        const double ar = (double)a_re[g * 64 + p], ai = (double)a_im[g * 64 + p];
        const double mag = exp(ar * dt * jj), ang = ai * dt * jj;
        lpr[i] = (float)(mag * cos(ang)); lpi[i] = (float)(mag * sin(ang));
    }
    for (int i = tid; i < 1024; i += 512) { ccr[i] = c_re[g * 1024 + i]; cci[i] = c_im[g * 1024 + i]; }
    __syncthreads();
    if (part == 0 && tid < 64) { L8[tid * 2] = lpr[8 * 64 + tid]; L8[tid * 2 + 1] = lpi[8 * 64 + tid]; L128[tid * 2] = lpr[9 * 64 + tid]; L128[tid * 2 + 1] = lpi[9 * 64 + tid]; }
    for (int i = tid; i < 1024; i += 512) {
        const int p = i >> 4, h = i & 15;
        const float ar = a_re[g * 64 + p], ai = a_im[g * 64 + p], lr = lpr[64 + p], li = lpi[64 + p];
        const float den = ar * ar + ai * ai, nr = lr - 1.0f, ni = li;
        const float cr = (nr * ar + ni * ai) / den, ci = (ni * ar - nr * ai) / den;
        const float br = b_re[(g * 64 + p) * 16 + h], bi = b_im[(g * 64 + p) * 16 + h];
        bbr[i] = cr * br - ci * bi; bbi[i] = cr * bi + ci * br;
    }
    __syncthreads();
    for (int i = tid; i < 2048; i += 512) {
        const int j = i >> 8, ho = (i >> 4) & 15, hi = i & 15; float sacc = 0.f;
        for (int p = 0; p < 64; ++p) { const float cr_ = ccr[ho * 64 + p], ci_ = cci[ho * 64 + p], lr_ = lpr[j * 64 + p], li_ = lpi[j * 64 + p];
            const float mr = cr_ * lr_ - ci_ * li_, mi = cr_ * li_ + ci_ * lr_;
            sacc += mr * bbr[p * 16 + hi] - mi * bbi[p * 16 + hi]; }
        Kj[i] = sacc;
    }
    __syncthreads();
    for (int i = part * 1024 + tid; i < (part + 1) * 1024; i += 512) {
        const int n = i >> 7, k = i & 127;
        { const int t = n >> 4, ho = n & 15, sx = k >> 4, hi = k & 15; const float v = (sx <= t) ? Kj[((t - sx) * 16 + ho) * 16 + hi] : 0.f; T8T[frag16(n, k, 128)] = (bf16)f2bf(v); }
        { const int p = n & 63, im = n >> 6, sx = k >> 4, hi = k & 15; const float lr_ = lpr[(7 - sx) * 64 + p], li_ = lpi[(7 - sx) * 64 + p], br_ = bbr[p * 16 + hi], bi_ = bbi[p * 16 + hi];
          const float v = im ? (lr_ * bi_ + li_ * br_) : (lr_ * br_ - li_ * bi_); PMT[frag16(n, k, 128)] = (bf16)f2bf(v); }
        { const int t = n >> 4, ho = n & 15, p = k & 63, pt = k >> 6; const float cr_ = ccr[ho * 64 + p], ci_ = cci[ho * 64 + p], lr_ = lpr[(t + 1) * 64 + p], li_ = lpi[(t + 1) * 64 + p];
          const float v = pt ? -(cr_ * li_ + ci_ * lr_) : (cr_ * lr_ - ci_ * li_); QMT[frag16(n, k, 128)] = (bf16)f2bf(v); }
    }
    __syncthreads();
}

__device__ __forceinline__ void p0_prologue(const Ctx& C, const Args& a) {
    p0_s5_group(C, a, C.vcu & 15, C.vcu >> 4);
    LAS float* scr = (LAS float*)(C.lds + C.wave * 16384);
    const int gw = C.vcu * NWAVES + C.wave, NGW = C.G * NWAVES;
    const int gt = C.vcu * 512 + C.tid, NGT = C.G * 512;
    unsigned char* ws = a.ws;
    for (int i = gt; i < MTOK; i += NGT) ((float*)(ws + WS_SS))[i] = 0.f;
    constexpr int I_IN = 16 * 176, I_Q = 16 * 64, I_O = 16 * 32, I_BR = 8 * 32, I_BS = 4 * 32, I_BM = 4 * 32, I_KV = 16 * 16, I_GLU = 4 * 16;
    constexpr int NITEMS = I_IN + I_Q + I_O + I_BR + I_BS + I_BM + I_KV + I_GLU;
    for (int it = gw; it < NITEMS; it += NGW) {
        int r = it;
        if (r < I_IN) { p0_transpose_item<false>((const float*)a.in[4], 1024, 5632, (bf16*)(ws + WS_WIN_T), scr, r, C.lane); continue; } r -= I_IN;
        if (r < I_Q) { p0_transpose_item<false>((const float*)a.in[21], 1024, 2048, (bf16*)(ws + WS_WQ_T), scr, r, C.lane, (const float*)a.in[20]); continue; } r -= I_Q;
        if (r < I_O) { p0_transpose_item<false>((const float*)a.in[19], 1024, 1024, (bf16*)(ws + WS_WOUT_T), scr, r, C.lane); continue; } r -= I_O;
        if (r < I_BR) { p0_transpose_item<false>((const float*)a.in[16], 512, 1024, (bf16*)(ws + WS_WBR_T), scr, r, C.lane); continue; } r -= I_BR;
        if (r < I_BS) { p0_transpose_item<false>((const float*)a.in[17], 256, 1024, (bf16*)(ws + WS_WBS_T), scr, r, C.lane); continue; } r -= I_BS;
        if (r < I_BM) { p0_transpose_item<false>((const float*)a.in[18], 256, 1024, (bf16*)(ws + WS_WBM_T), scr, r, C.lane); continue; } r -= I_BM;
        if (r < I_KV) { p0_transpose_item<false>((const float*)a.in[6], 1024, 512, (bf16*)(ws + WS_WMKV_T), scr, r, C.lane); continue; } r -= I_KV;
        p0_transpose_item<true>((const float*)a.in[15], 256, 512, (bf16*)(ws + WS_WGLU_T), scr, r, C.lane);
    }
    for (int i = gt; i < 16 * 128 * 128 / 8; i += NGT) { const f32x4 x0 = ((const f32x4*)a.in[22])[2 * (size_t)i], x1 = ((const f32x4*)a.in[22])[2 * (size_t)i + 1];
        const int hc = i >> 11, n = (i >> 4) & 127, d0 = (i & 15) * 8; *(v4u*)((bf16*)(ws + WS_KEYS) + hc * 16384 + frag32(n, d0, 128)) = pack8(x0, x1); }
    for (int rw0 = gw; rw0 < 2 * 16384; rw0 += 4 * NGW) {
        f32x4 v[4][4]; float mx[4];
#pragma unroll
        for (int i = 0; i < 4; ++i) { const int rw = rw0 + i * NGW, t = rw >> 14, row = rw & 16383;
            const float* src = (const float*)a.in[23 + t] + (size_t)row * DM + C.lane * 4; mx[i] = 0.f;
#pragma unroll
            for (int q = 0; q < 4; ++q) { v[i][q] = *(const f32x4*)(src + 256 * q); if (t == 0) v[i][q] = v[i][q] * *(const f32x4*)((const float*)a.in[20] + C.lane * 4 + 256 * q); } }
#pragma unroll
        for (int i = 0; i < 4; ++i)
#pragma unroll
            for (int q = 0; q < 4; ++q) mx[i] = fmaxf(mx[i], fmaxf(fmaxf(fabsf(v[i][q][0]), fabsf(v[i][q][1])), fmaxf(fabsf(v[i][q][2]), fabsf(v[i][q][3]))));
#pragma unroll
        for (int o = 1; o < 64; o <<= 1)
#pragma unroll
            for (int i = 0; i < 4; ++i) mx[i] = fmaxf(mx[i], __shfl_xor(mx[i], o));
#pragma unroll
        for (int i = 0; i < 4; ++i) { const int rw = rw0 + i * NGW, t = rw >> 14, row = rw & 16383;
            int ex = (int)((__builtin_bit_cast(unsigned, mx[i]) >> 23) & 0xffu) - 127;
            if (mx[i] < 1e-30f) ex = 7;
            const float sc = __builtin_bit_cast(float, (unsigned)(127 + 7 - ex) << 23), isc = __builtin_bit_cast(float, (unsigned)(127 - 7 + ex) << 23);
            unsigned char* dst = ws + (t ? WS_PV : WS_PU) + (size_t)row * 128 + ((C.lane * 4) & 127);
#pragma unroll
            for (int q = 0; q < 4; ++q) { int p = __builtin_amdgcn_cvt_pk_fp8_f32(v[i][q][0] * sc, v[i][q][1] * sc, 0, false); p = __builtin_amdgcn_cvt_pk_fp8_f32(v[i][q][2] * sc, v[i][q][3] * sc, p, true);
                *(unsigned*)(dst + (size_t)(2 * q + (C.lane >> 5)) * (16384 * 128)) = (unsigned)p; }
            if (C.lane == 0) ((float*)(ws + WS_PSC))[t * 16384 + row] = isc; }
    }
    for (int m = gw; m < MTOK; m += 4 * NGW) rms_rows_to_bf16<4>((const float*)a.in[0], (const float*)a.in[3], (bf16*)(ws + WS_A), m, NGW, C.lane);
    for (int m = gw; m < MROWS; m += NGW) rms_rows_to_bf16<1>((const float*)a.in[1], (const float*)a.in[5], (bf16*)(ws + WS_MEMN), m, NGW, C.lane);
    {
        const int* pos = (const int*)a.in[2]; float* rope = (float*)(ws + WS_ROPE);
        const int j = C.tid & 63;
        const double invrev = exp(-(double)j * (9.210340371976184 / 64.0)) * 0.15915494309189535;
        for (int i = gt; i < MTOK * 64; i += NGT) { const int tok = i >> 6;
            double rv = (double)pos[tok] * invrev; rv -= rint(rv);
            const float rf = (float)rv;
            rope[(size_t)tok * 128 + j] = __builtin_amdgcn_cosf(rf); rope[(size_t)tok * 128 + 64 + j] = __builtin_amdgcn_sinf(rf); }
    }
}

constexpr int LP = 136;
__device__ __forceinline__ float lg2_gamma(int h) { return log2f(1.0f - exp2f(-5.0f - (float)h)); }

__device__ __forceinline__ void r1_unit(const Ctx& C, const Args& a, int tile, int h) {
    const bf16* Z1 = (const bf16*)(a.ws + WS_Z1); const float* ROPE = (const float*)(a.ws + WS_ROPE);
    LAS bf16* Qs = (LAS bf16*)C.lds; LAS bf16* Ks = Qs + 128 * LP; LAS bf16* Kt = Ks + 128 * LP; LAS bf16* Vt = Kt + 128 * LP;
    const int tid = C.tid, lane = C.lane, t0 = tile * 128, u = tile * 4 + h;
    const float lg2g = lg2_gamma(h);
    {
        const int i = tid >> 2, dq = (tid & 3) * 16;
        const bf16* zr = Z1 + (size_t)(t0 + i) * NZ1; const float* rp = ROPE + (size_t)(t0 + i) * 128;
        float cs[16], sn[16];
#pragma unroll
        for (int q = 0; q < 4; ++q) { const f32x4 c4 = *(const f32x4*)(rp + dq + 4 * q), s4 = *(const f32x4*)(rp + 64 + dq + 4 * q);
#pragma unroll
            for (int e = 0; e < 4; ++e) { cs[4 * q + e] = c4[e]; sn[4 * q + e] = s4[e]; } }
        const float kdec = exp2f((float)(127 - i) * lg2g) , ksc = 0.08838834764831845f;
#pragma unroll
        for (int which = 0; which < 2; ++which) {
            const bf16* src = zr + (which ? ZK : ZQ) + h * 128;
            const v4u a0 = *(const v4u*)(src + dq), a1 = *(const v4u*)(src + dq + 8), b0 = *(const v4u*)(src + 64 + dq), b1 = *(const v4u*)(src + 64 + dq + 8);
            const unsigned aw[8] = {a0.x, a0.y, a0.z, a0.w, a1.x, a1.y, a1.z, a1.w}, bw[8] = {b0.x, b0.y, b0.z, b0.w, b1.x, b1.y, b1.z, b1.w};
            float y1[16], y2[16];
#pragma unroll
            for (int w = 0; w < 8; ++w) {
                const float x1l = bflo(aw[w]), x1h = bfhi(aw[w]), x2l = bflo(bw[w]), x2h = bfhi(bw[w]);
                y1[2 * w] = x1l * cs[2 * w] - x2l * sn[2 * w]; y2[2 * w] = x1l * sn[2 * w] + x2l * cs[2 * w];
                y1[2 * w + 1] = x1h * cs[2 * w + 1] - x2h * sn[2 * w + 1]; y2[2 * w + 1] = x1h * sn[2 * w + 1] + x2h * cs[2 * w + 1];
            }
            if (which) {
#pragma unroll
                for (int e = 0; e < 16; ++e) { y1[e] *= ksc; y2[e] *= ksc; }
            }
            LAS bf16* dstp = (which ? Ks : Qs) + i * LP;
            v4u o;
            o.x = pk2(y1[0], y1[1]); o.y = pk2(y1[2], y1[3]); o.z = pk2(y1[4], y1[5]); o.w = pk2(y1[6], y1[7]); *(LAS v4u*)(dstp + dq) = o;
            o.x = pk2(y1[8], y1[9]); o.y = pk2(y1[10], y1[11]); o.z = pk2(y1[12], y1[13]); o.w = pk2(y1[14], y1[15]); *(LAS v4u*)(dstp + dq + 8) = o;
            o.x = pk2(y2[0], y2[1]); o.y = pk2(y2[2], y2[3]); o.z = pk2(y2[4], y2[5]); o.w = pk2(y2[6], y2[7]); *(LAS v4u*)(dstp + 64 + dq) = o;
            o.x = pk2(y2[8], y2[9]); o.y = pk2(y2[10], y2[11]); o.z = pk2(y2[12], y2[13]); o.w = pk2(y2[14], y2[15]); *(LAS v4u*)(dstp + 64 + dq + 8) = o;
            if (which) {
#pragma unroll
                for (int e = 0; e < 16; ++e) { Kt[(dq + e) * LP + i] = (bf16)f2bf(y1[e] * kdec); Kt[(64 + dq + e) * LP + i] = (bf16)f2bf(y2[e] * kdec); }
            }
            __builtin_amdgcn_sched_barrier(0);
        }
        {
            const int eq = (tid & 3) * 32; const bf16* vs = zr + ZV + h * 128 + eq;
#pragma unroll
            for (int q = 0; q < 4; ++q) { const v4u v = *(const v4u*)(vs + 8 * q); const unsigned vw[4] = {v.x, v.y, v.z, v.w};
#pragma unroll
                for (int w = 0; w < 4; ++w) { Vt[(eq + 8 * q + 2 * w) * LP + i] = (bf16)(vw[w] & 0xffffu); Vt[(eq + 8 * q + 2 * w + 1) * LP + i] = (bf16)(vw[w] >> 16); } }
        }
    }
    __syncthreads();
    const int r = lane & 31, hh = lane >> 5;
    if (C.wave < 4) {
        const int ib = C.wave;
        bf16x8 bq[8];
#pragma unroll
        for (int ks = 0; ks < 8; ++ks) bq[ks] = *(const LAS bf16x8*)(Qs + (ib * 32 + r) * LP + ks * 16 + 8 * hh);
        f32x16 accO[4];
#pragma unroll
        for (int et = 0; et < 4; ++et)
#pragma unroll
            for (int e = 0; e < 16; ++e) accO[et][e] = 0.f;
        const int i = ib * 32 + r;
#pragma unroll
        for (int jt = 0; jt < 4; ++jt) {
            if (jt <= ib) {
                f32x16 s;
#pragma unroll
                for (int e = 0; e < 16; ++e) s[e] = 0.f;
#pragma unroll
                for (int ks = 0; ks < 8; ++ks) { const bf16x8 ak = *(const LAS bf16x8*)(Ks + (jt * 32 + r) * LP + ks * 16 + 8 * hh); s = mfma32(ak, bq[ks], s); }
                unsigned pk[8];
#pragma unroll
                for (int q = 0; q < 8; ++q) {
                    const int ra = 2 * q, rb = 2 * q + 1;
                    const int ja = jt * 32 + (ra & 3) + 8 * (ra >> 2) + 4 * hh, jb = jt * 32 + (rb & 3) + 8 * (rb >> 2) + 4 * hh;
                    const float va = (i >= ja) ? s[ra] * exp2f((float)(i - ja) * lg2g) : 0.f;
                    const float vb = (i >= jb) ? s[rb] * exp2f((float)(i - jb) * lg2g) : 0.f;
                    pk[q] = pk2(va, vb);
                }
#pragma unroll
                for (int sft = 0; sft < 2; ++sft) {
                    const bf16x8 pb = mk8(pk[4 * sft], pk[4 * sft + 1], pk[4 * sft + 2], pk[4 * sft + 3]);
#pragma unroll
                    for (int et = 0; et < 4; ++et) {
                        const LAS bf16* vp = Vt + (et * 32 + r) * LP + jt * 32 + 16 * sft + 4 * hh;
                        const v2u lo = *(const LAS v2u*)vp, hi = *(const LAS v2u*)(vp + 8);
                        accO[et] = mfma32(mk8(lo.x, lo.y, hi.x, hi.y), pb, accO[et]);
                    }
                }
            }
            __builtin_amdgcn_sched_barrier(0);
        }
        unsigned* INN = (unsigned*)(a.ws + WS_INNER) + ((size_t)(u * 4 + ib) * 32) * 64 + lane;
#pragma unroll
        for (int et = 0; et < 4; ++et)
#pragma unroll
            for (int q = 0; q < 8; ++q) INN[(et * 8 + q) * 64] = pk2(accO[et][2 * q], accO[et][2 * q + 1]);
    } else {
        const int et = C.wave - 4;
        f32x16 acc[4];
#pragma unroll
        for (int dt = 0; dt < 4; ++dt)
#pragma unroll
            for (int e = 0; e < 16; ++e) acc[dt][e] = 0.f;
#pragma unroll
        for (int ks = 0; ks < 8; ++ks) {
            const bf16x8 av = *(const LAS bf16x8*)(Vt + (et * 32 + r) * LP + ks * 16 + 8 * hh);
#pragma unroll
            for (int dt = 0; dt < 4; ++dt) { const bf16x8 bk = *(const LAS bf16x8*)(Kt + (dt * 32 + r) * LP + ks * 16 + 8 * hh); acc[dt] = mfma32(av, bk, acc[dt]); }
            __builtin_amdgcn_sched_barrier(0);
        }
        float* KVb = a.out + (size_t)u * 16384 + (size_t)(et * 32 + 4 * hh) * 128 + r;
#pragma unroll
        for (int dt = 0; dt < 4; ++dt) {
#pragma unroll
            for (int e = 0; e < 16; ++e) KVb[((e & 3) + 8 * (e >> 2)) * 128 + dt * 32] = acc[dt][e];
            __builtin_amdgcn_sched_barrier(0);
        }
    }
    __syncthreads();
}

__device__ __forceinline__ void s5_compute_E(const Args& a, int tile, int g, int lane, LAS float* Es, bf16x8 (&au)[4]) {
    const bf16* Z1 = (const bf16*)(a.ws + WS_Z1); const bf16* PMT = (const bf16*)(a.ws + WS_S5MAT) + (size_t)(16 + g) * 16384;
    const int r16 = lane & 15, q4 = lane >> 4;
#pragma unroll
    for (int ks = 0; ks < 4; ++ks) { const int s = 2 * ks + (q4 >> 1);
        au[ks] = *(const bf16x8*)(Z1 + (size_t)(tile * 128 + 8 * r16 + s) * NZ1 + ZU + g * 16 + 8 * (q4 & 1)); }
    bf16x8 bc[4], bn[4];
#pragma unroll
    for (int ks = 0; ks < 4; ++ks) bc[ks] = *(const bf16x8*)(PMT + (ks * 64 + lane) * 8);
#pragma unroll 1
    for (int nb = 0; nb < 8; ++nb) {
        const int nbn = min(nb + 1, 7);
#pragma unroll
        for (int ks = 0; ks < 4; ++ks) bn[ks] = *(const bf16x8*)(PMT + ((nbn * 4 + ks) * 64 + lane) * 8);
        __builtin_amdgcn_sched_barrier(0);
        f32x4 acc = {0.f, 0.f, 0.f, 0.f};
#pragma unroll
        for (int ks = 0; ks < 4; ++ks) acc = mfma16(au[ks], bc[ks], acc);
#pragma unroll
        for (int i4 = 0; i4 < 4; ++i4) Es[(q4 * 4 + i4) * 128 + nb * 16 + r16] = acc[i4];
        __builtin_amdgcn_sched_barrier(0);
#pragma unroll
        for (int ks = 0; ks < 4; ++ks) bc[ks] = bn[ks];
    }
    LDS_WAIT(); asm volatile("" ::: "memory");
}
__device__ __forceinline__ void s5a_wave(const Ctx& C, const Args& a, int tile, int g) {
    LAS float* Es = (LAS float*)(C.lds + C.wave * 16384);
    bf16x8 au[4];
    s5_compute_E(a, tile, g, C.lane, Es, au);
    const float* L8 = (const float*)(a.ws + WS_S5C) + (size_t)g * 128;
    const float l8r = L8[C.lane * 2], l8i = L8[C.lane * 2 + 1];
    float sr = 0.f, si = 0.f;
#pragma unroll
    for (int c = 0; c < 16; ++c) { const float er = Es[c * 128 + C.lane], ei = Es[c * 128 + 64 + C.lane];
        const float nr = l8r * sr - l8i * si + er, ni = l8r * si + l8i * sr + ei; sr = nr; si = ni; }
    float* E = (float*)(a.ws + WS_S5E) + ((size_t)tile * 16 + g) * 128;
    E[C.lane] = sr; E[64 + C.lane] = si;
    LDS_WAIT(); asm volatile("" ::: "memory");
}
__device__ __forceinline__ void s5c_wave(const Ctx& C, const Args& a, int tile, int g) {
    LAS float* Es = (LAS float*)(C.lds + C.wave * 16384);
    LAS bf16* Sv = (LAS bf16*)(C.lds + C.wave * 16384 + 8192);
    const int lane = C.lane, r16 = lane & 15, q4 = lane >> 4;
    bf16x8 au[4];
    s5_compute_E(a, tile, g, lane, Es, au);
    const float* L8 = (const float*)(a.ws + WS_S5C) + (size_t)g * 128;
    const float l8r = L8[lane * 2], l8i = L8[lane * 2 + 1];
    const float* X = (const float*)(a.ws + WS_S5X) + ((size_t)tile * 16 + g) * 128;
    float sr = X[lane], si = X[64 + lane];
#pragma unroll
    for (int c = 0; c < 16; ++c) {
        Sv[c * LP + lane] = (bf16)f2bf(sr); Sv[c * LP + 64 + lane] = (bf16)f2bf(si);
        const float er = Es[c * 128 + lane], ei = Es[c * 128 + 64 + lane];
        const float nr = l8r * sr - l8i * si + er, ni = l8r * si + l8i * sr + ei; sr = nr; si = ni; }
    LDS_WAIT(); asm volatile("" ::: "memory");
    bf16x8 as[4];
#pragma unroll
    for (int ks = 0; ks < 4; ++ks) as[ks] = *(const LAS bf16x8*)(Sv + r16 * LP + ks * 32 + 8 * q4);
    const bf16* T8T = (const bf16*)(a.ws + WS_S5MAT) + (size_t)g * 16384; const bf16* QMT = (const bf16*)(a.ws + WS_S5MAT) + (size_t)(32 + g) * 16384;
    const bf16* Z1 = (const bf16*)(a.ws + WS_Z1); bf16* YG = (bf16*)(a.ws + WS_YG);
    const float dg = ((const float*)a.in[14])[g * 16 + r16];
    bf16x8 tc[4], tn[4], qc[4], qn[4]; bf16 uc[4], un[4];
#pragma unroll
    for (int ks = 0; ks < 4; ++ks) { tc[ks] = *(const bf16x8*)(T8T + (ks * 64 + lane) * 8); qc[ks] = *(const bf16x8*)(QMT + (ks * 64 + lane) * 8); }
#pragma unroll
    for (int i4 = 0; i4 < 4; ++i4) uc[i4] = Z1[(size_t)(tile * 128 + 8 * (q4 * 4 + i4)) * NZ1 + ZU + g * 16 + r16];
#pragma unroll 1
    for (int nb = 0; nb < 8; ++nb) {
        const int nbn = min(nb + 1, 7);
#pragma unroll
        for (int ks = 0; ks < 4; ++ks) { tn[ks] = *(const bf16x8*)(T8T + ((nbn * 4 + ks) * 64 + lane) * 8); qn[ks] = *(const bf16x8*)(QMT + ((nbn * 4 + ks) * 64 + lane) * 8); }
#pragma unroll
        for (int i4 = 0; i4 < 4; ++i4) un[i4] = Z1[(size_t)(tile * 128 + 8 * (q4 * 4 + i4) + nbn) * NZ1 + ZU + g * 16 + r16];
        __builtin_amdgcn_sched_barrier(0);
        f32x4 acc = {0.f, 0.f, 0.f, 0.f};
#pragma unroll
        for (int ks = 0; ks < 4; ++ks) { acc = mfma16(au[ks], tc[ks], acc); acc = mfma16(as[ks], qc[ks], acc); }
#pragma unroll
        for (int i4 = 0; i4 < 4; ++i4) { const int tok = tile * 128 + 8 * (q4 * 4 + i4) + nb;
            YG[(size_t)tok * 256 + g * 16 + r16] = (bf16)f2bf(gelu_tanh(acc[i4] + dg * bf2f(uc[i4]))); }
        __builtin_amdgcn_sched_barrier(0);
#pragma unroll
        for (int ks = 0; ks < 4; ++ks) { tc[ks] = tn[ks]; qc[ks] = qn[ks]; }
#pragma unroll
        for (int i4 = 0; i4 < 4; ++i4) uc[i4] = un[i4];
    }
    LDS_WAIT(); asm volatile("" ::: "memory");
}

__device__ __forceinline__ void ma_loadk(const bf16* kp, int mt, bf16x8 (&k)[4]) {
#pragma unroll
    for (int ks = 0; ks < 4; ++ks) k[ks] = *(const bf16x8*)(kp + (mt * 4 + ks) * 512);
}
__device__ __forceinline__ void ma_loadv(const bf16* vp, int mt, bf16x8 (&v)[4]) {
#pragma unroll
    for (int sft = 0; sft < 2; ++sft)
#pragma unroll
        for (int et = 0; et < 2; ++et) v[sft * 2 + et] = *(const bf16x8*)(vp + (((et * 8 + mt) * 2 + sft) * 64) * 8);
}
__device__ __forceinline__ void ma_wave(const Ctx& C, const Args& a, int tile, int hm, int ib) {
    const bf16* Z1 = (const bf16*)(a.ws + WS_Z1); const bf16* KM = (const bf16*)(a.ws + WS_KM); const bf16* VT = (const bf16*)(a.ws + WS_VT);
    const int lane = C.lane, r = lane & 31, hh = lane >> 5, b = tile >> 5, tok = tile * 128 + ib * 32 + r;
    const bf16* kp = KM + (size_t)(b * 4 + hm) * 16384 + lane * 8;
    const bf16* vp = VT + (size_t)(b * 4 + hm) * 16384 + lane * 8;
    bf16x8 bq[4];
#pragma unroll
    for (int ks = 0; ks < 4; ++ks) bq[ks] = *(const bf16x8*)(Z1 + (size_t)tok * NZ1 + ZQM + hm * 64 + ks * 16 + 8 * hh);
    bf16x8 kc[4], kn[4];
    ma_loadk(kp, 0, kc);
    float mx = -3.0e38f;
#pragma unroll 1
    for (int mt = 0; mt < 8; ++mt) {
        ma_loadk(kp, min(mt + 1, 7), kn); __builtin_amdgcn_sched_barrier(0);
        f32x16 s;
#pragma unroll
        for (int e = 0; e < 16; ++e) s[e] = 0.f;
#pragma unroll
        for (int ks = 0; ks < 4; ++ks) s = mfma32(kc[ks], bq[ks], s);
#pragma unroll
        for (int e = 0; e < 16; ++e) mx = fmaxf(mx, s[e]);
        __builtin_amdgcn_sched_barrier(0);
#pragma unroll
        for (int ks = 0; ks < 4; ++ks) kc[ks] = kn[ks];
    }
    mx = fmaxf(mx, __shfl_xor(mx, 32));
    float sum = 0.f;
    f32x16 o[2];
#pragma unroll
    for (int et = 0; et < 2; ++et)
#pragma unroll
        for (int e = 0; e < 16; ++e) o[et][e] = 0.f;
    const float sc = 0.125f * 1.4426950408889634f;
    bf16x8 vc[4], vn[4];
    ma_loadk(kp, 0, kc); ma_loadv(vp, 0, vc);
#pragma unroll 1
    for (int mt = 0; mt < 8; ++mt) {
        ma_loadk(kp, min(mt + 1, 7), kn); ma_loadv(vp, min(mt + 1, 7), vn); __builtin_amdgcn_sched_barrier(0);
        f32x16 s;
#pragma unroll
        for (int e = 0; e < 16; ++e) s[e] = 0.f;
#pragma unroll
        for (int ks = 0; ks < 4; ++ks) s = mfma32(kc[ks], bq[ks], s);
        unsigned pk[8];
#pragma unroll
        for (int q = 0; q < 8; ++q) { const float pa = exp2f((s[2 * q] - mx) * sc), pb = exp2f((s[2 * q + 1] - mx) * sc); sum += pa + pb; pk[q] = pk2(pa, pb); }
#pragma unroll
        for (int sft = 0; sft < 2; ++sft) {
            const bf16x8 pb = mk8(pk[4 * sft], pk[4 * sft + 1], pk[4 * sft + 2], pk[4 * sft + 3]);
#pragma unroll
            for (int et = 0; et < 2; ++et) o[et] = mfma32(vc[sft * 2 + et], pb, o[et]);
        }
        __builtin_amdgcn_sched_barrier(0);
#pragma unroll
        for (int ks = 0; ks < 4; ++ks) kc[ks] = kn[ks];
#pragma unroll
        for (int q = 0; q < 4; ++q) vc[q] = vn[q];
    }
    sum += __shfl_xor(sum, 32);
    const float inv = 1.0f / sum;
    bf16* MA = (bf16*)(a.ws + WS_MATTN) + (size_t)tok * 256 + hm * 64;
#pragma unroll
    for (int et = 0; et < 2; ++et)
#pragma unroll
        for (int g4 = 0; g4 < 4; ++g4) { v2u w; w.x = pk2(o[et][4 * g4] * inv, o[et][4 * g4 + 1] * inv); w.y = pk2(o[et][4 * g4 + 2] * inv, o[et][4 * g4 + 3] * inv);
            *(v2u*)(MA + et * 32 + 8 * g4 + 4 * hh) = w; }
}

__device__ __forceinline__ void r3_wave(const Ctx& C, const Args& a, int tile, int h, int ib) {
    const bf16* Z1 = (const bf16*)(a.ws + WS_Z1); const float* ROPE = (const float*)(a.ws + WS_ROPE);
    const bf16* PREV = (const bf16*)((const unsigned char*)a.out + 64 * MiB);
    const int lane = C.lane, r = lane & 31, hh = lane >> 5, u = tile * 4 + h, tok = tile * 128 + ib * 32 + r;
    const float lg2g = lg2_gamma(h);
    const bf16* zr = Z1 + (size_t)tok * NZ1 + ZQ + h * 128; const float* rp = ROPE + (size_t)tok * 128;
    bf16x8 bq[8];
#pragma unroll
    for (int m = 0; m < 4; ++m) {
        const v4u x1 = *(const v4u*)(zr + m * 16 + 8 * hh), x2 = *(const v4u*)(zr + 64 + m * 16 + 8 * hh);
        const f32x4 c0 = *(const f32x4*)(rp + m * 16 + 8 * hh), c1 = *(const f32x4*)(rp + m * 16 + 8 * hh + 4);
        const f32x4 s0 = *(const f32x4*)(rp + 64 + m * 16 + 8 * hh), s1 = *(const f32x4*)(rp + 64 + m * 16 + 8 * hh + 4);
        const unsigned aw[4] = {x1.x, x1.y, x1.z, x1.w}, bw[4] = {x2.x, x2.y, x2.z, x2.w};
        const float cs[8] = {c0[0], c0[1], c0[2], c0[3], c1[0], c1[1], c1[2], c1[3]}, sn[8] = {s0[0], s0[1], s0[2], s0[3], s1[0], s1[1], s1[2], s1[3]};
        unsigned o1[4], o2[4];
#pragma unroll
        for (int w = 0; w < 4; ++w) {
            const float x1l = bflo(aw[w]), x1h = bfhi(aw[w]), x2l = bflo(bw[w]), x2h = bfhi(bw[w]);
            o1[w] = pk2(x1l * cs[2 * w] - x2l * sn[2 * w], x1h * cs[2 * w + 1] - x2h * sn[2 * w + 1]);
            o2[w] = pk2(x1l * sn[2 * w] + x2l * cs[2 * w], x1h * sn[2 * w + 1] + x2h * cs[2 * w + 1]);
        }
        bq[m] = mk8(o1[0], o1[1], o1[2], o1[3]); bq[m + 4] = mk8(o2[0], o2[1], o2[2], o2[3]);
        __builtin_amdgcn_sched_barrier(0);
    }
    f32x16 acc[4];
    const bf16* pbase = PREV + (size_t)u * 16384 + lane * 8;
    bf16x8 apc[8], apn[8];
#pragma unroll
    for (int ks = 0; ks < 8; ++ks) apc[ks] = *(const bf16x8*)(pbase + ks * 512);
#pragma unroll
    for (int et = 0; et < 4; ++et) {
        if (et < 3) {
#pragma unroll
            for (int ks = 0; ks < 8; ++ks) apn[ks] = *(const bf16x8*)(pbase + ((et + 1) * 8 + ks) * 512);
        }
        __builtin_amdgcn_sched_barrier(0);
#pragma unroll
        for (int e = 0; e < 16; ++e) acc[et][e] = 0.f;
#pragma unroll
        for (int ks = 0; ks < 8; ++ks) acc[et] = mfma32(apc[ks], bq[ks], acc[et]);
        __builtin_amdgcn_sched_barrier(0);
#pragma unroll
        for (int ks = 0; ks < 8; ++ks) apc[ks] = apn[ks];
    }
    const float qdec = exp2f((float)(ib * 32 + r + 1) * lg2g);
    const unsigned* INN = (const unsigned*)(a.ws + WS_INNER) + ((size_t)(u * 4 + ib) * 32) * 64 + lane;
    float ss = 0.f;
    unsigned innw[32];
#pragma unroll
    for (int q = 0; q < 32; ++q) innw[q] = INN[q * 64];
#pragma unroll
    for (int et = 0; et < 4; ++et)
#pragma unroll
        for (int q = 0; q < 8; ++q) { const unsigned w = innw[et * 8 + q];
            const float v0 = acc[et][2 * q] * qdec + bflo(w), v1 = acc[et][2 * q + 1] * qdec + bfhi(w);
            acc[et][2 * q] = v0; acc[et][2 * q + 1] = v1; ss += v0 * v0 + v1 * v1; }
    __builtin_amdgcn_sched_barrier(0);
    ss += __shfl_xor(ss, 32);
    const float rn = 1.0f / sqrtf(ss * (1.0f / 128.0f) + EPS);
    const bf16* gp = Z1 + (size_t)tok * NZ1 + ZGR + h * 128; bf16* RET = (bf16*)(a.ws + WS_RET) + (size_t)tok * 512 + h * 128;
#pragma unroll
    for (int et = 0; et < 4; ++et)
#pragma unroll
        for (int g4 = 0; g4 < 4; ++g4) { const int e0 = et * 32 + 8 * g4 + 4 * hh; const v2u gw = *(const v2u*)(gp + e0);
            const float g0 = bflo(gw.x), g1 = bfhi(gw.x), g2 = bflo(gw.y), g3 = bfhi(gw.y);
            v2u w; w.x = pk2(acc[et][4 * g4] * rn * g0 * sigmoidf_(g0), acc[et][4 * g4 + 1] * rn * g1 * sigmoidf_(g1));
            w.y = pk2(acc[et][4 * g4 + 2] * rn * g2 * sigmoidf_(g2), acc[et][4 * g4 + 3] * rn * g3 * sigmoidf_(g3));
            *(v2u*)(RET + e0) = w; }
}

__device__ __forceinline__ void p3_scans(const Ctx& C, const Args& a) {
    {
        const float* KV = a.out; bf16* PREV = (bf16*)((unsigned char*)a.out + 64 * MiB);
        for (int it = C.vcu * 512 + C.tid; it < 131072; it += C.G * 512) {
            const int elem = it * 4, b = elem >> 16, h = (elem >> 14) & 3, ed = elem & 16383;
            const float cd = exp2f(128.0f * lg2_gamma(h));
            f32x4 st = {0.f, 0.f, 0.f, 0.f};
#pragma unroll 4
            for (int c = 0; c < 32; ++c) { const size_t off = (size_t)((b * 32 + c) * 4 + h) * 16384 + ed;
                v2u w; w.x = pk2(st[0], st[1]); w.y = pk2(st[2], st[3]); *(v2u*)(PREV + (off - ed) + frag32(ed >> 7, ed & 127, 128)) = w;
                const f32x4 inc = *(const f32x4*)(KV + off); st = st * cd + inc; }
        }
    }
    {
        const float* E = (const float*)(a.ws + WS_S5E); float* X = (float*)(a.ws + WS_S5X); const float* L128 = (const float*)(a.ws + WS_S5C) + 2048;
        for (int it = C.vcu * 512 + C.tid; it < 8192; it += C.G * 512) {
            const int b = it >> 10, g = (it >> 6) & 15, p = it & 63;
            const float lr = L128[(g * 64 + p) * 2], li = L128[(g * 64 + p) * 2 + 1];
            float xr = 0.f, xi = 0.f;
            for (int n = 0; n < 32; ++n) { const size_t off = ((size_t)(b * 32 + n) * 16 + g) * 128 + p;
                X[off] = xr; X[off + 64] = xi;
                const float er = E[off], ei = E[off + 64];
                const float nr = lr * xr - li * xi + er, ni = lr * xi + li * xr + ei; xr = nr; xi = ni; }
        }
    }
}

__device__ __forceinline__ int f2key(float x) { int b = __builtin_bit_cast(int, x); return b >= 0 ? b : (b ^ 0x7fffffff); }
__device__ __forceinline__ float key2f(int k) { return __builtin_bit_cast(float, k >= 0 ? k : (k ^ 0x7fffffff)); }
__device__ __forceinline__ void ce_desc(int& x, int& y) { const int hi = x > y ? x : y, lo = x > y ? y : x; x = hi; y = lo; }
__device__ __forceinline__ void sort16_desc(int (&v)[16]) {
#pragma unroll
    for (int k = 2; k <= 16; k <<= 1)
#pragma unroll
        for (int j = k >> 1; j > 0; j >>= 1)
#pragma unroll
            for (int i = 0; i < 16; ++i) { const int l = i ^ j; if (l > i) { if ((i & k) == 0) ce_desc(v[i], v[l]); else ce_desc(v[l], v[i]); } }
}
__device__ __forceinline__ void merge16_desc(int (&T)[16], const int (&N)[16]) {
#pragma unroll
    for (int i = 0; i < 16; ++i) T[i] = T[i] > N[15 - i] ? T[i] : N[15 - i];
#pragma unroll
    for (int j = 8; j > 0; j >>= 1)
#pragma unroll
        for (int i = 0; i < 16; ++i) { const int l = i ^ j; if (l > i) ce_desc(T[i], T[l]); }
}
__device__ __forceinline__ void peer_topk_half(const Args& a, int tokbase, int hp, int c, int lane, int (&T)[16]) {
    const bf16* Q2 = (const bf16*)(a.ws + WS_Q2); const bf16* KEYS = (const bf16*)(a.ws + WS_KEYS);
    const int r = lane & 31, hh = lane >> 5;
    bf16x8 bq[8];
#pragma unroll
    for (int ks = 0; ks < 8; ++ks) bq[ks] = *(const bf16x8*)(Q2 + (size_t)(tokbase + r) * 2048 + hp * 256 + c * 128 + ks * 16 + 8 * hh);
    const bf16* kbase = KEYS + (size_t)(hp * 2 + c) * 16384 + lane * 8;
    bf16x8 akc[8], akn[8];
#pragma unroll
    for (int ks = 0; ks < 8; ++ks) akc[ks] = *(const bf16x8*)(kbase + ks * 512);
#pragma unroll
    for (int nt = 0; nt < 4; ++nt) {
        if (nt < 3) {
#pragma unroll
            for (int ks = 0; ks < 8; ++ks) akn[ks] = *(const bf16x8*)(kbase + ((nt + 1) * 8 + ks) * 512);
        }
        __builtin_amdgcn_sched_barrier(0);
        f32x16 s;
#pragma unroll
        for (int e = 0; e < 16; ++e) s[e] = 0.f;
#pragma unroll
        for (int ks = 0; ks < 8; ++ks) s = mfma32(akc[ks], bq[ks], s);
        int N[16];
#pragma unroll
        for (int e = 0; e < 16; ++e) { const int n = nt * 32 + (e & 3) + 8 * (e >> 2) + 4 * hh; N[e] = (f2key(s[e]) & ~127) | n; }
        sort16_desc(N);
        if (nt == 0) {
#pragma unroll
            for (int e = 0; e < 16; ++e) T[e] = N[e];
        } else merge16_desc(T, N);
        __builtin_amdgcn_sched_barrier(0);
#pragma unroll
        for (int ks = 0; ks < 8; ++ks) akc[ks] = akn[ks];
    }
    int P[16];
#pragma unroll
    for (int j = 0; j < 16; ++j) P[j] = __shfl_xor(T[j], 32);
    merge16_desc(T, P);
}
__device__ __forceinline__ void peer_topk_head(const Ctx& C, const Args& a, int tokbase, int hp) {
    const int lane = C.lane, r = lane & 31, hh = lane >> 5;
    int T0[16], T1[16];
    peer_topk_half(a, tokbase, hp, 0, lane, T0);
    peer_topk_half(a, tokbase, hp, 1, lane, T1);
    int F[16], L1[16], L2[16], L3[16];
#pragma unroll
    for (int j = 0; j < 16; ++j) { L1[j] = (int)0x80000000; L2[j] = (int)0x80000000; L3[j] = (int)0x80000000; }
    {
        int cnt = 0;
#pragma unroll
        for (int i0 = 0; i0 < 16; ++i0)
#pragma unroll
            for (int i1 = 0; i1 < 16; ++i1)
                if ((i0 + 1) * (i1 + 1) <= 16) {
                    const float v = key2f(T0[i0] & ~127) + key2f(T1[i1] & ~127); const int key = (f2key(v) & ~255) | (i0 * 16 + i1);
                    if (i0 == 0) F[i1] = key;
                    else { if (cnt < 16) L1[cnt] = key; else if (cnt < 32) L2[cnt - 16] = key; else L3[cnt - 32] = key; ++cnt; }
                }
    }
    sort16_desc(L1); merge16_desc(F, L1); sort16_desc(L2); merge16_desc(F, L2); sort16_desc(L3); merge16_desc(F, L3);
    LAS int* tab = (LAS int*)(C.lds + C.wave * 16384);
#pragma unroll
    for (int j = 0; j < 16; ++j) { tab[j * 64 + lane] = T0[j] & 127; tab[(16 + j) * 64 + lane] = T1[j] & 127; }
    LDS_WAIT(); asm volatile("" ::: "memory");
    const float m = key2f(F[0] & ~255);
    float e[16], sum = 0.f;
#pragma unroll
    for (int j = 0; j < 16; ++j) { e[j] = __expf(key2f(F[j] & ~255) - m); sum += e[j]; }
    const float inv = 1.0f / sum;
    const int tok = tokbase + r;
    int* IDX = (int*)(a.ws + WS_IDX) + (size_t)tok * 128 + hp * 16; float* WGT = (float*)(a.ws + WS_WGT) + (size_t)tok * 128 + hp * 16;
#pragma unroll
    for (int j = 0; j < 16; ++j) { const int id = F[j] & 255; const int k0 = tab[(id >> 4) * 64 + lane], k1 = tab[(16 + (id & 15)) * 64 + lane];
        if (hh == 0) IDX[j] = k0 * 128 + k1; else WGT[j] = e[j] * inv; }
    LDS_WAIT(); asm volatile("" ::: "memory");
}
typedef float f32x2v __attribute__((ext_vector_type(2)));
__device__ __forceinline__ void unpack16(const v4u a, const v4u b, float (&x)[16]) {
    const unsigned w[8] = {a.x, a.y, a.z, a.w, b.x, b.y, b.z, b.w};
#pragma unroll
    for (int i = 0; i < 8; ++i) { x[2 * i] = bflo(w[i]); x[2 * i + 1] = bfhi(w[i]); }
}
__device__ __forceinline__ void unpack16_fp8(const v4u a, float (&x)[16]) {
    const unsigned w[4] = {a.x, a.y, a.z, a.w};
#pragma unroll
    for (int i = 0; i < 4; ++i) { const f32x2v lo = __builtin_amdgcn_cvt_pk_f32_fp8((int)w[i], false), hi = __builtin_amdgcn_cvt_pk_f32_fp8((int)w[i], true);
        x[4 * i] = lo.x; x[4 * i + 1] = lo.y; x[4 * i + 2] = hi.x; x[4 * i + 3] = hi.y; }
}
__device__ __forceinline__ long mk64(unsigned lo, unsigned hi) { return (long)(((unsigned long long)hi << 32) | (unsigned long long)lo); }
__device__ __forceinline__ float dpp_swap1(float v) { return __builtin_bit_cast(float, __builtin_amdgcn_update_dpp(0, __builtin_bit_cast(int, v), 0xB1, 0xf, 0xf, true)); }
struct PHalf { v4u g[8]; };
__device__ __forceinline__ void pg_issue(const unsigned char* TBL, int idxv, int lane, PHalf& D) {
    const int row8 = lane >> 3; const unsigned c16 = (unsigned)(lane & 7) * 16u;
#pragma unroll
    for (int j = 0; j < 8; ++j) { const unsigned e = (unsigned)__shfl(idxv, j * 8 + row8); D.g[j] = *(const v4u*)(TBL + (e * 128u + c16)); }
}
__device__ __forceinline__ void pg_stage(LAS unsigned char* buf, int lane, const PHalf& D) {
    const int row8 = lane >> 3, c8 = lane & 7;
#pragma unroll
    for (int j = 0; j < 8; ++j) *(LAS v4u*)(buf + (j * 8 + row8) * 128 + ((c8 ^ row8) & 7) * 16) = D.g[j];
}
__device__ __forceinline__ void pu_xprep(LAS unsigned char* xs, unsigned xw, int lane) {
    const float x0 = bflo(xw) * 16.f, x1 = bfhi(xw) * 16.f;
    const int hi = __builtin_amdgcn_cvt_pk_fp8_f32(x0, x1, 0, false);
    const f32x2v bk = __builtin_amdgcn_cvt_pk_f32_fp8(hi, false);
    const int lo = __builtin_amdgcn_cvt_pk_fp8_f32(x0 - bk.x, x1 - bk.y, 0, false);
    *(LAS unsigned short*)(xs + 2 * lane) = (unsigned short)hi; *(LAS unsigned short*)(xs + 128 + 2 * lane) = (unsigned short)lo;
}
typedef int v8i_t __attribute__((ext_vector_type(8)));
__device__ __forceinline__ void pu_compute(const LAS unsigned char* buf, bf16* HPt, int r, int kq, const v8i_t bfr) {
    f32x4 res[4];
#pragma unroll
    for (int g = 0; g < 4; ++g) {
        const int row = g * 16 + r, sw = row & 7;
        const v4u a0 = *(const LAS v4u*)(buf + row * 128 + ((2 * kq) ^ sw) * 16), a1 = *(const LAS v4u*)(buf + row * 128 + ((2 * kq + 1) ^ sw) * 16);
        const v8i_t av = {(int)a0.x, (int)a0.y, (int)a0.z, (int)a0.w, (int)a1.x, (int)a1.y, (int)a1.z, (int)a1.w};
        res[g] = __builtin_amdgcn_mfma_scale_f32_16x16x128_f8f6f4(av, bfr, (f32x4){0.f, 0.f, 0.f, 0.f}, 0, 0, 0, 0x7f7f7f7f, 0, 0x7f7f7f7f);
    }
    f32x4 o = res[0];
#pragma unroll
    for (int g = 1; g < 4; ++g) { const bool sel = ((r >> 1) == g);
#pragma unroll
        for (int i = 0; i < 4; ++i) o[i] = sel ? res[g][i] : o[i]; }
#pragma unroll
    for (int i = 0; i < 4; ++i) o[i] += dpp_swap1(o[i]);
    if (r < 8 && (r & 1) == 0) { v2u w; w.x = pk2(o[0], o[1]); w.y = pk2(o[2], o[3]); *(v2u*)(HPt + (r >> 1) * 16 + 4 * kq) = w; }
}
__device__ __forceinline__ int pg_idx(const int* IDXl, int h, int hl) { h = min(h, hl); return IDXl[(size_t)(h >> 1) * 128 + (h & 1) * 64]; }
__device__ __forceinline__ void peer_u_wave(const Args& a, LAS unsigned char* wlds, LAS unsigned char* wsm, int slab, int t0, int ntok, int lane) {
    const unsigned char* U8 = a.ws + WS_PU + (size_t)slab * (16384 * 128);
    const bf16* N2 = (const bf16*)(a.ws + WS_N2) + slab * 128 + 2 * lane;
    const int* IDX = (const int*)(a.ws + WS_IDX) + lane;
    bf16* HP = (bf16*)(a.ws + WS_HPART) + (size_t)slab * MTOK * 128;
    const int r = lane & 15, kq = lane >> 4, tl = t0 + ntok - 1, H0 = 2 * t0, HL = 2 * (t0 + ntok) - 1;
    PHalf d[4]; int iv[4]; v8i_t bfr;
#pragma unroll
    for (int k = 0; k < 4; ++k) iv[k] = pg_idx(IDX, H0 + k, HL);
    unsigned xw = *(const unsigned*)(N2 + (size_t)t0 * DM);
    pg_issue(U8, iv[0], lane, d[0]); pg_issue(U8, iv[1], lane, d[1]); pg_issue(U8, iv[2], lane, d[2]);
    iv[0] = pg_idx(IDX, H0 + 4, HL); iv[1] = pg_idx(IDX, H0 + 5, HL); iv[2] = pg_idx(IDX, H0 + 6, HL);
    pg_stage(wlds, lane, d[0]);
#define PU_XPREP(tok) do { pu_xprep(wsm, xw, lane); \
        { const LAS unsigned char* bp = wsm + ((r & 1) ? 128 : 0) + kq * 32; const v4u b0 = *(const LAS v4u*)bp, b1 = *(const LAS v4u*)(bp + 16); \
          bfr = (v8i_t){(int)b0.x, (int)b0.y, (int)b0.z, (int)b0.w, (int)b1.x, (int)b1.y, (int)b1.z, (int)b1.w}; } \
        xw = *(const unsigned*)(N2 + (size_t)min((tok) + 1, tl) * DM); } while (0)
#define PU_PHASE(ph, hrel, tok, half) do { \
        pg_issue(U8, iv[((ph) + 3) & 3], lane, d[((ph) + 3) & 3]); iv[((ph) + 3) & 3] = pg_idx(IDX, hb + (hrel) + 7, HL); __builtin_amdgcn_sched_barrier(0); \
        pu_compute(wlds + ((half) ? 8192 : 0), HP + (size_t)(tok) * 128 + (half) * 64, r, kq, bfr); __builtin_amdgcn_sched_barrier(0); \
        pg_stage(wlds + ((half) ? 0 : 8192), lane, d[((ph) + 1) & 3]); __builtin_amdgcn_sched_barrier(0); } while (0)
#pragma unroll 1
    for (int hb = H0; hb <= HL; hb += 4) {
        const int t = hb >> 1;
        PU_XPREP(t);
        PU_PHASE(0, 0, t, 0);
        PU_PHASE(1, 1, t, 1);
        PU_XPREP(t + 1);
        PU_PHASE(2, 2, t + 1, 0);
        PU_PHASE(3, 3, t + 1, 1);
    }
#undef PU_XPREP
#undef PU_PHASE
}
__device__ __forceinline__ void peer_reduce(const Ctx& C, const Args& a) {
    const bf16* HP = (const bf16*)(a.ws + WS_HPART); const int* IDX = (const int*)(a.ws + WS_IDX); const float* WGT = (const float*)(a.ws + WS_WGT);
    const float* USC = (const float*)(a.ws + WS_PSC); const float* VSC = USC + 16384; float* ACT = (float*)(a.ws + WS_ACT);
    for (int it = C.vcu * 512 + C.tid; it < MTOK * 32; it += C.G * 512) {
        f32x4 h = {0.f, 0.f, 0.f, 0.f};
#pragma unroll
        for (int sl = 0; sl < 8; ++sl) { const v2u w = *(const v2u*)(HP + (size_t)sl * MTOK * 128 + (size_t)it * 4); h[0] += bflo(w.x); h[1] += bfhi(w.x); h[2] += bflo(w.y); h[3] += bfhi(w.y); }
        const int4 e = *(const int4*)(IDX + (size_t)it * 4); const f32x4 w = *(const f32x4*)(WGT + (size_t)it * 4);
        const float rs = 0.0625f / sqrtf(((const float*)(a.ws + WS_SS))[it >> 5] * (1.f / DM) + EPS);
        f32x4 o;
        o[0] = gelu_tanh(h[0] * USC[e.x] * rs) * w[0] * VSC[e.x]; o[1] = gelu_tanh(h[1] * USC[e.y] * rs) * w[1] * VSC[e.y];
        o[2] = gelu_tanh(h[2] * USC[e.z] * rs) * w[2] * VSC[e.z]; o[3] = gelu_tanh(h[3] * USC[e.w] * rs) * w[3] * VSC[e.w];
        *(f32x4*)(ACT + (size_t)it * 4) = o;
    }
}
typedef int v2i_t __attribute__((ext_vector_type(2)));
__device__ __forceinline__ void pv_compute(const LAS unsigned char* buf, int lane, const long* bact2, f32x4 (&acc)[8]) {
    const int i16 = lane & 15, kq = lane >> 4, rr = i16 >> 1, cc = i16 & 1;
#pragma unroll
    for (int s2 = 0; s2 < 2; ++s2) {
        const int row = 32 * s2 + 8 * kq + rr, sw = row & 7;
#pragma unroll
        for (int nb = 0; nb < 8; ++nb) {
            const v2i_t av = __builtin_amdgcn_ds_read_tr8_b64_v2i32((LAS v2i_t*)(buf + row * 128 + ((nb ^ sw) & 7) * 16 + 8 * cc));
            acc[nb] = __builtin_amdgcn_mfma_f32_16x16x32_fp8_fp8(mk64((unsigned)av.x, (unsigned)av.y), bact2[s2], acc[nb], 0, 0, 0);
        }
    }
}
__device__ __forceinline__ void peer_v_wave(const Args& a, LAS unsigned char* wlds, LAS unsigned char* wsm, int slab, int t0, int ntok, int lane) {
    const unsigned char* V8 = a.ws + WS_PV + (size_t)slab * (16384 * 128);
    const int* IDX = (const int*)(a.ws + WS_IDX) + lane; const float* ACT = (const float*)(a.ws + WS_ACT) + lane;
    bf16* PO = (bf16*)(a.ws + WS_POUT) + slab * 128;
    const int n16 = lane & 15, kq = lane >> 4, tl = t0 + ntok - 1, H0 = 2 * t0, HL = 2 * (t0 + ntok) - 1;
    PHalf d[4]; int iv[4]; long bact[4]; f32x4 acc[8]; float isc = 1.f;
#pragma unroll
    for (int k = 0; k < 4; ++k) iv[k] = pg_idx(IDX, H0 + k, HL);
    float a0 = ACT[(size_t)t0 * 128], a1 = ACT[(size_t)t0 * 128 + 64];
    pg_issue(V8, iv[0], lane, d[0]); pg_issue(V8, iv[1], lane, d[1]); pg_issue(V8, iv[2], lane, d[2]);
    iv[0] = pg_idx(IDX, H0 + 4, HL); iv[1] = pg_idx(IDX, H0 + 5, HL); iv[2] = pg_idx(IDX, H0 + 6, HL);
    pg_stage(wlds, lane, d[0]);
#define PV_APREP(tok) do { \
        float mx = fmaxf(fabsf(a0), fabsf(a1)); \
        _Pragma("unroll") for (int o = 1; o < 64; o <<= 1) mx = fmaxf(mx, __shfl_xor(mx, o)); \
        int ex = (int)((__builtin_bit_cast(unsigned, mx) >> 23) & 0xffu) - 127; if (mx < 1e-30f) ex = 7; \
        const float sc = __builtin_bit_cast(float, (unsigned)(127 + 7 - ex) << 23); isc = __builtin_bit_cast(float, (unsigned)(127 - 7 + ex) << 23); \
        { const float s0 = a0 * sc, s1 = a1 * sc; \
          const int hi = __builtin_amdgcn_cvt_pk_fp8_f32(s0, s1, 0, false); const f32x2v bk = __builtin_amdgcn_cvt_pk_f32_fp8(hi, false); \
          const int lo = __builtin_amdgcn_cvt_pk_fp8_f32(s0 - bk.x, s1 - bk.y, 0, false); \
          wsm[lane] = (unsigned char)(hi & 0xff); wsm[64 + lane] = (unsigned char)((hi >> 8) & 0xff); wsm[128 + lane] = (unsigned char)(lo & 0xff); wsm[192 + lane] = (unsigned char)((lo >> 8) & 0xff); } \
        { const LAS unsigned char* bp = wsm + ((n16 & 1) ? 128 : 0) + 8 * kq; \
          _Pragma("unroll") for (int s4 = 0; s4 < 4; ++s4) { const v2u w = *(const LAS v2u*)(bp + 32 * s4); bact[s4] = mk64(w.x, w.y); } } \
        { const int tn = min((tok) + 1, tl); a0 = ACT[(size_t)tn * 128]; a1 = ACT[(size_t)tn * 128 + 64]; } \
        _Pragma("unroll") for (int nb = 0; nb < 8; ++nb) acc[nb] = (f32x4){0.f, 0.f, 0.f, 0.f}; } while (0)
#define PV_PHASE(ph, hrel, half) do { \
        pg_issue(V8, iv[((ph) + 3) & 3], lane, d[((ph) + 3) & 3]); iv[((ph) + 3) & 3] = pg_idx(IDX, hb + (hrel) + 7, HL); __builtin_amdgcn_sched_barrier(0); \
        pv_compute(wlds + ((half) ? 8192 : 0), lane, bact + 2 * (half), acc); __builtin_amdgcn_sched_barrier(0); \
        pg_stage(wlds + ((half) ? 0 : 8192), lane, d[((ph) + 1) & 3]); __builtin_amdgcn_sched_barrier(0); } while (0)
#define PV_EPI(tok) do { f32x4 o = acc[0]; \
        _Pragma("unroll") for (int nb = 1; nb < 8; ++nb) { const bool sel = ((n16 >> 1) == nb); \
            _Pragma("unroll") for (int i = 0; i < 4; ++i) o[i] = sel ? acc[nb][i] : o[i]; } \
        _Pragma("unroll") for (int i = 0; i < 4; ++i) o[i] += dpp_swap1(o[i]); \
        if ((n16 & 1) == 0) { v2u w; w.x = pk2(o[0] * isc, o[1] * isc); w.y = pk2(o[2] * isc, o[3] * isc); *(v2u*)(PO + (size_t)(tok) * DM + 16 * (n16 >> 1) + 4 * kq) = w; } } while (0)
#pragma unroll 1
    for (int hb = H0; hb <= HL; hb += 4) {
        const int t = hb >> 1;
        PV_APREP(t);
        PV_PHASE(0, 0, 0);
        PV_PHASE(1, 1, 1);
        PV_EPI(t);
        PV_APREP(t + 1);
        PV_PHASE(2, 2, 0);
        PV_PHASE(3, 3, 1);
        PV_EPI(t + 1);
    }
#undef PV_APREP
#undef PV_PHASE
#undef PV_EPI
}
__device__ __forceinline__ void final_rows4(const Args& a, int tok0, int tstep, int lane) {
    const float* gf = (const float*)a.in[25] + lane * 4;
    f32x4 h[4][4]; v2u pw[4][4], hw[4][4]; float ss[4];
#pragma unroll
    for (int i = 0; i < 4; ++i) { const int tok = tok0 + i * tstep; const bf16* hb = (const bf16*)(a.ws + WS_N2) + (size_t)tok * DM + lane * 4; const bf16* po = (const bf16*)(a.ws + WS_POUT) + (size_t)tok * DM + lane * 4;
#pragma unroll
        for (int q = 0; q < 4; ++q) { hw[i][q] = *(const v2u*)(hb + 256 * q); pw[i][q] = *(const v2u*)(po + 256 * q); } }
#pragma unroll
    for (int i = 0; i < 4; ++i) { ss[i] = 0.f;
#pragma unroll
        for (int q = 0; q < 4; ++q) { h[i][q][0] = bflo(hw[i][q].x) + bflo(pw[i][q].x); h[i][q][1] = bfhi(hw[i][q].x) + bfhi(pw[i][q].x); h[i][q][2] = bflo(hw[i][q].y) + bflo(pw[i][q].y); h[i][q][3] = bfhi(hw[i][q].y) + bfhi(pw[i][q].y);
            ss[i] += (h[i][q][0] * h[i][q][0] + h[i][q][1] * h[i][q][1]) + (h[i][q][2] * h[i][q][2] + h[i][q][3] * h[i][q][3]); } }
#pragma unroll
    for (int o = 1; o < 64; o <<= 1)
#pragma unroll
        for (int i = 0; i < 4; ++i) ss[i] += __shfl_xor(ss[i], o);
    f32x4 g[4];
#pragma unroll
    for (int q = 0; q < 4; ++q) g[q] = *(const f32x4*)(gf + 256 * q);
#pragma unroll
    for (int i = 0; i < 4; ++i) { const float rstd = 1.0f / sqrtf(ss[i] * (1.f / DM) + EPS); float* orow = a.out + (size_t)(tok0 + i * tstep) * DM + lane * 4;
#pragma unroll
        for (int q = 0; q < 4; ++q) *(f32x4*)(orow + 256 * q) = h[i][q] * rstd * g[q]; }
}

__device__ __forceinline__ void claim_slab_unit(const Ctx& C, unsigned* ctl, int pass, volatile LAS unsigned* MISC, int& slab, int& unit) {
    if (C.tid == 0) {
        const unsigned x = xb_xcc_id() & 7u; unsigned sl = 8u, un = 0u;
        for (unsigned k = 0; k < 8u; ++k) { const unsigned s2 = (x + k) & 7u; const unsigned u2 = xb_add(ctl + CW_Q + 1024 * pass + 64 * s2, 1u); if (u2 < 32u) { sl = s2; un = u2; break; } }
        MISC[16] = sl; MISC[17] = un;
    }
    __syncthreads();
    slab = (int)MISC[16]; unit = (int)MISC[17];
    __syncthreads();
}
__global__ void __launch_bounds__(NWAVES * 64, 2) mk_fwd(Args args) {
    extern __shared__ __attribute__((aligned(16))) unsigned char lds_raw[];
    Ctx C;
    C.lds = (LAS unsigned char*)lds_raw;
    C.wave = __builtin_amdgcn_readfirstlane((int)threadIdx.x >> 6); C.refresh();
    C.G = gridDim.x; { const int bx = blockIdx.x; C.vcu = (C.G % 8 == 0) ? (bx % 8) * (C.G / 8) + bx / 8 : bx; }
    volatile LAS unsigned* MISC = (volatile LAS unsigned*)(C.lds + MISC_OFF);
    if (C.tid < 128) MISC[C.tid] = 0u;
    __syncthreads();
    unsigned char* ws = args.ws;
    unsigned* ctl = (unsigned*)(ws + WS_CTL);
    XcdBarrier bar; bar.bar = ctl + CW_BAR; bar.x = 0; bar.st = nullptr;
#if !MK_PER_PHASE
    bar = xcd_barrier_post(ctl + CW_BAR, MISC + 8, C.tid == 0);
#define GRID_BAR() xcd_barrier(bar, C.wave)
#else
#define GRID_BAR() do { } while (0)
#endif
    const int lo = args.ph_lo, hi = args.ph_hi;
#define IN(k) (lo <= (k) && (k) < hi)
#define SEAM(k) do { if (IN((k) + 1)) GRID_BAR(); C.refresh(); } while (0)
#define REP(k) for (int rep_ = 0; rep_ < 1 + ((REPEAT_MASK >> (k)) & 1); ++rep_)
    bf16* XN = (bf16*)(ws + WS_A);
    if (IN(0)) { REP(0) { p0_prologue(C, args); __syncthreads(); } SEAM(0); }
    if (IN(1)) {
        REP(1) {
        run_gemm(C, XN, (const bf16*)(ws + WS_WIN_T), MTOK, NZ1, DM, FStore{(bf16*)(ws + WS_Z1), NZ1});
        run_gemm(C, (const bf16*)(ws + WS_MEMN), (const bf16*)(ws + WS_WMKV_T), MROWS, 512, DM, FKvm{(bf16*)(ws + WS_KM), (bf16*)(ws + WS_VT)});
        }
        SEAM(1);
    }
    if (IN(2)) {
        REP(2) { const int tile = C.vcu;
            _Pragma("unroll 1") for (int h = 0; h < 4; ++h) r1_unit(C, args, tile, h);
            _Pragma("unroll 1") for (int gi = 0; gi < 2; ++gi) s5a_wave(C, args, tile, C.wave + 8 * gi);
            _Pragma("unroll 1") for (int gi = 0; gi < 2; ++gi) ma_wave(C, args, tile, 2 * gi + (C.wave >> 2), C.wave & 3);
            __syncthreads();
        }
        SEAM(2);
    }
    if (IN(3)) { REP(3) { p3_scans(C, args); } SEAM(3); }
    if (IN(4)) {
        REP(4) { const int tile = C.vcu;
            _Pragma("unroll 1") for (int gi = 0; gi < 2; ++gi) r3_wave(C, args, tile, 2 * gi + (C.wave >> 2), C.wave & 3);
            _Pragma("unroll 1") for (int gi = 0; gi < 2; ++gi) s5c_wave(C, args, tile, C.wave + 8 * gi);
        }
        SEAM(4);
    }
    if (IN(5)) {
        REP(5) {
        run_gemm(C, XN, (const bf16*)(ws + WS_WIN_T) + (size_t)NZ1 * DM, MTOK, NGATE, DM, FSig{(bf16*)(ws + WS_G), NGATE});
        run_gemm(C, (const bf16*)(ws + WS_YG), (const bf16*)(ws + WS_WGLU_T), MTOK, 512, 256, FGlu{(bf16*)(ws + WS_SSM)});
        }
        SEAM(5);
    }
    if (IN(6)) {
        const bf16* Gt = (const bf16*)(ws + WS_G);
        REP(6) {
        run_gemm(C, (const bf16*)(ws + WS_RET), (const bf16*)(ws + WS_WBR_T), MTOK, DM, 512, FBranch<0>{Gt, 0, (bf16*)args.out, XN});
        run_gemm(C, (const bf16*)(ws + WS_SSM), (const bf16*)(ws + WS_WBS_T), MTOK, DM, 256, FBranch<1>{Gt, 1024, (bf16*)args.out, XN});
        run_gemm(C, (const bf16*)(ws + WS_MATTN), (const bf16*)(ws + WS_WBM_T), MTOK, DM, 256, FBranch<2>{Gt, 2048, (bf16*)args.out, XN});
        }
        SEAM(6);
    }
    if (IN(7)) { run_gemm(C, XN, (const bf16*)(ws + WS_WOUT_T), MTOK, DM, DM, FRes{(const float*)args.in[0], (bf16*)(ws + WS_N2), (float*)(ws + WS_SS)}); SEAM(7); }
    if (IN(9)) { REP(9) run_gemm(C, (const bf16*)(ws + WS_N2), (const bf16*)(ws + WS_WQ_T), MTOK, 2048, DM, FStoreRstd{(bf16*)(ws + WS_Q2), 2048, (const float*)(ws + WS_SS)}); SEAM(9); }
    if (IN(10)) {
        { const int tile = C.vcu;
            const int tokbase = tile * 128 + (C.wave & 3) * 32, h0 = (C.wave >> 2) * 4;
            REP(10) { _Pragma("unroll 1") for (int hp = h0; hp < h0 + 4; ++hp) peer_topk_head(C, args, tokbase, hp); }
        }
        SEAM(10);
    }
    if (IN(11)) { int slab, unit; claim_slab_unit(C, ctl, 0, MISC, slab, unit); if (slab < 8) { REP(11) peer_u_wave(args, C.lds + C.wave * 16384, C.lds + 131072 + C.wave * 1024, slab, unit * 1024 + C.wave * 128, 128, C.lane); } SEAM(11); }
    if (IN(12)) { REP(12) peer_reduce(C, args); SEAM(12); }
    if (IN(13)) { int slab, unit; claim_slab_unit(C, ctl, 1, MISC, slab, unit); if (slab < 8) { REP(13) peer_v_wave(args, C.lds + C.wave * 16384, C.lds + 131072 + C.wave * 1024, slab, unit * 1024 + C.wave * 128, 128, C.lane); } SEAM(13); }
    if (IN(14)) {
        const int gw = C.vcu * NWAVES + C.wave, NGW = C.G * NWAVES;
        for (int m = gw; m < MTOK; m += 4 * NGW) final_rows4(args, m, NGW, C.lane);
    }
#undef IN
#undef SEAM
}

extern "C" void kernel_launch(void* const* d_in, const int* in_sizes, int n_in, void* d_out, int out_size, void* d_ws, size_t ws_size, hipStream_t stream) {
    static int grid = 0;
    if (grid == 0) {
        if (n_in != 26 || in_sizes[0] != MTOK * DM || out_size != MTOK * DM || ws_size < WS_END) {
            fprintf(stderr, "kernel_launch: unexpected problem (n_in %d, in0 %d, out %d, ws %zu < %zu); nothing launched\n", n_in, n_in > 0 ? in_sizes[0] : -1, out_size, ws_size, (size_t)WS_END); grid = -1; return; }
        int dev = 0, cus = 0;
        if (hipGetDevice(&dev) != hipSuccess || hipDeviceGetAttribute(&cus, hipDeviceAttributeMultiprocessorCount, dev) != hipSuccess) { grid = -1; return; }
        if (hipFuncSetAttribute((const void*)mk_fwd, hipFuncAttributeMaxDynamicSharedMemorySize, LDS_BYTES) != hipSuccess) { fprintf(stderr, "kernel_launch: hipFuncSetAttribute failed\n"); grid = -1; return; }
        (void)hipGetLastError();
        if (cus < NTILES) { fprintf(stderr, "kernel_launch: needs >= 256 CUs, got %d\n", cus); grid = -1; return; }
        grid = NTILES;
    }
    if (grid < 0) return;
    (void)hipMemsetAsync((char*)d_ws + WS_CTL, 0, CTL_ZERO_BYTES, stream);
    Args a{};
    for (int i = 0; i < 26; ++i) a.in[i] = d_in[i];
    a.out = (float*)d_out; a.ws = (unsigned char*)d_ws;
#if MK_PER_PHASE
    for (int p = 0; p < NPHASE; ++p) { a.ph_lo = p; a.ph_hi = p + 1; hipLaunchKernelGGL(mk_fwd, dim3(grid), dim3(NWAVES * 64), LDS_BYTES, stream, a); }
#else
    a.ph_lo = 0; a.ph_hi = NPHASE;
    hipLaunchKernelGGL(mk_fwd, dim3(grid), dim3(NWAVES * 64), LDS_BYTES, stream, a);
#endif
}
```

```cpp
#include <hip/hip_runtime.h>
#include <cstdio>
#include <cstdint>
namespace pg8 {
__device__ __forceinline__ int hw_lane_id() { int l; asm volatile("v_mbcnt_lo_u32_b32 %0, -1, 0\n\tv_mbcnt_hi_u32_b32 %0, -1, %0" : "=v"(l)); return l; }
#define PG8_LAS __attribute__((address_space(3)))
typedef unsigned short bf16_t;
typedef short bf16x8 __attribute__((ext_vector_type(8)));
typedef float f32x4 __attribute__((ext_vector_type(4)));
typedef unsigned u32x4 __attribute__((ext_vector_type(4)));
constexpr int BM = 256, BK = 64, HALF = 128, HTB = HALF * BK * 2  , STAGE_BYTES = 8 * HTB, NXCD = 8, WGM = 8;

__host__ __device__ __forceinline__ int lds_byte(int r, int c) { const int st = (r >> 4) * 2 + (c >> 5), rr = r & 15, cc = c & 31, ob = rr * 64 + cc * 2; return st * 1024 + (ob ^ (((ob >> 9) & 1) << 5)); }
__host__ __device__ __forceinline__ void stage_rc(int b, int& R, int& C) { const int st = b / 1024, sb = b % 1024, swz = sb ^ (((sb >> 9) & 1) << 5); R = (st >> 1) * 16 + swz / 64; C = (st & 1) * 32 + (swz % 64) / 2; }
__host__ __device__ __forceinline__ int perm32(int rho) { const int n = rho >> 4, i = rho & 15; return 8 * (i >> 2) + 4 * n + (i & 3); }

struct Unit { int pm, pn; };
struct Gemm { const bf16_t* A; const bf16_t* Bt; int M, N, K; };

struct StaticOrder {
    int nM, nN, nwg, G, c;
    __host__ __device__ void init(int M, int N, int G_, int c_) { nM = M / BM; nN = N / BM; nwg = nM * nN; G = G_; c = c_; }
    __host__ __device__ bool next(int i, Unit& u) const {
        const long L = (long)i * G + c; if (L >= nwg) return false;
        int wgid = (int)L; { const int q = nwg / NXCD, r = nwg % NXCD, xcd = wgid % NXCD, off = wgid / NXCD; wgid = (xcd < r ? xcd * (q + 1) : r * (q + 1) + (xcd - r) * q) + off; }
        const int nig = WGM * nN, gid = wgid / nig, fm = gid * WGM, gsz = (nM - fm) < WGM ? (nM - fm) : WGM;
        u.pm = fm + ((wgid % nig) % gsz); u.pn = (wgid % nig) / gsz; return true;
    }
    __device__ __forceinline__ void a_ready(const Unit&) const {}
    __device__ __forceinline__ void done(const Unit&) const {}
};

__device__ __forceinline__ unsigned cvt_pk_bf16(float lo, float hi) { unsigned r; asm volatile("v_cvt_pk_bf16_f32 %0, %1, %2" : "=v"(r) : "v"(lo), "v"(hi)); return r; }
template <class Epi, class Sched, bool ALIGN_EPI = false, bool SP2 = false>
__device__ __forceinline__ void gemm_phase(PG8_LAS unsigned char* lds, const Gemm g, const Sched& S, const Epi& E, const int wid) {
    const int lane = hw_lane_id(), tid = wid * 64 + lane, wr = wid >> 2, wc = wid & 3, fr = lane & 15, fq = lane >> 4;
    const int K = g.K, nt = K / BK;
    unsigned voffA[2], voffB[2];
#pragma unroll
    for (int i = 0; i < 2; ++i) { int R, C; stage_rc(tid * 16 + i * 8192, R, C); const int Rb = Epi::PERM ? ((R & ~31) + perm32(R & 31)) : R;
        voffA[i] = (unsigned)(R * K + C) * 2u; voffB[i] = (unsigned)(Rb * K + C) * 2u; }
    const size_t kstep = (size_t)(BK * 2);
    const size_t hstep = (size_t)HALF * K * 2;
    const size_t tstep = 2 * hstep;
    const unsigned ldsw = (unsigned)wid * 1024u;
    const int aoff = lds_byte(wr * 64 + fr, fq * 8), boff = lds_byte(wc * 32 + fr, fq * 8);
#define PG8_SA(b, h) (((b) * 2 + (h)) * HTB)
#define PG8_SB(b, h) ((4 + (b) * 2 + (h)) * HTB)
#define PG8_STAGE(bufoff, gbase, voff) do { _Pragma("unroll") for (int _i = 0; _i < 2; ++_i) \
        __builtin_amdgcn_global_load_lds((const unsigned*)((const char*)(gbase) + (voff)[_i]), (PG8_LAS unsigned*)(lds + (bufoff) + ldsw + _i * 8192), 16, 0, 0); } while (0)
#define PG8_LDA(dst, b, h) do { _Pragma("unroll") for (int m = 0; m < 4; ++m) _Pragma("unroll") for (int k = 0; k < 2; ++k) dst[m][k] = *(const PG8_LAS bf16x8*)(lds + PG8_SA(b, h) + aoff + m * 2048 + k * 1024); } while (0)
#define PG8_LDB(dst, b, h) do { _Pragma("unroll") for (int n = 0; n < 2; ++n) _Pragma("unroll") for (int k = 0; k < 2; ++k) dst[n][k] = *(const PG8_LAS bf16x8*)(lds + PG8_SB(b, h) + boff + n * 2048 + k * 1024); } while (0)
#define PG8_MMA(ai, bj, At, Bt) do { __builtin_amdgcn_s_setprio(1); _Pragma("unroll") for (int m = 0; m < 4; ++m) _Pragma("unroll") for (int n = 0; n < 2; ++n) _Pragma("unroll") for (int k = 0; k < 2; ++k) \
        acc[ai][bj][m][n] = __builtin_amdgcn_mfma_f32_16x16x32_bf16(Bt[n][k], At[m][k], acc[ai][bj][m][n], 0, 0, 0); __builtin_amdgcn_s_setprio(0); } while (0)
#define PG8_WAIT_V(n) asm volatile("s_waitcnt vmcnt(" #n ")" ::: "memory")
#define PG8_WAIT_L(n) asm volatile("s_waitcnt lgkmcnt(" #n ")" ::: "memory")
#define PG8_BAR __builtin_amdgcn_s_barrier()
#define PG8_SCHED __builtin_amdgcn_sched_barrier(0)
    Unit cur, nxt; int ui = 0;
    if (!S.next(0, cur)) return;
    f32x4 acc[2][2][4][2];
#pragma unroll
    for (int a = 0; a < 2; ++a)
#pragma unroll
        for (int b = 0; b < 2; ++b)
#pragma unroll
            for (int m = 0; m < 4; ++m)
#pragma unroll
                for (int n = 0; n < 2; ++n) acc[a][b][m][n] = (f32x4){0.f, 0.f, 0.f, 0.f};
    bf16x8 At[4][2], B0[2][2], B1[2][2];
    const char* cA = (const char*)g.A + (size_t)cur.pm * tstep; const char* cB = (const char*)g.Bt + (size_t)cur.pn * tstep;
    S.a_ready(cur);
    if constexpr (SP2) {
        PG8_STAGE(PG8_SB(0, 0), cB, voffB); PG8_STAGE(PG8_SB(0, 1), cB + hstep, voffB); PG8_STAGE(PG8_SA(0, 0), cA, voffA); PG8_STAGE(PG8_SA(0, 1), cA + hstep, voffA);
        if (wr == 1) PG8_BAR;
        PG8_WAIT_V(2); PG8_BAR;
        PG8_STAGE(PG8_SB(1, 0), cB + kstep, voffB); PG8_STAGE(PG8_SA(1, 0), cA + kstep, voffA); PG8_STAGE(PG8_SB(1, 1), cB + hstep + kstep, voffB);
        PG8_WAIT_V(6); PG8_BAR;
    } else {
        PG8_STAGE(PG8_SB(0, 0), cB, voffB); PG8_STAGE(PG8_SA(0, 0), cA, voffA); PG8_STAGE(PG8_SB(0, 1), cB + hstep, voffB); PG8_STAGE(PG8_SA(0, 1), cA + hstep, voffA);
        if (wr == 1) PG8_BAR;
        PG8_WAIT_V(4); PG8_BAR;
        PG8_STAGE(PG8_SB(1, 0), cB + kstep, voffB); PG8_STAGE(PG8_SA(1, 0), cA + kstep, voffA); PG8_STAGE(PG8_SB(1, 1), cB + hstep + kstep, voffB);
        PG8_WAIT_V(6); PG8_BAR;
    }
    for (;;) {
        const bool has_next = S.next(ui + 1, nxt);
        const char* nA = has_next ? (const char*)g.A + (size_t)nxt.pm * tstep : cA; const char* nB = has_next ? (const char*)g.Bt + (size_t)nxt.pn * tstep : cB;
        for (int t = 0; t < nt; t += 2) {
            const bool last = (t == nt - 2);
            const char* a1 = cA + (size_t)(t + 1) * kstep;
            const char* a2 = last ? nA : cA + (size_t)(t + 2) * kstep; const char* b2 = last ? nB : cB + (size_t)(t + 2) * kstep;
            const char* a3 = a2 + kstep; const char* b3 = b2 + kstep;
            if (last && has_next) S.a_ready(nxt);
            if constexpr (SP2) {
            PG8_LDB(B0, 0, 0); PG8_LDB(B1, 0, 1); PG8_SCHED; PG8_LDA(At, 0, 0); PG8_STAGE(PG8_SA(1, 1), a1 + hstep, voffA);
            PG8_WAIT_V(8); PG8_WAIT_L(0); PG8_BAR; PG8_MMA(0, 0, At, B0); PG8_MMA(0, 1, At, B1); PG8_BAR; PG8_SCHED;
            PG8_LDA(At, 0, 1); PG8_STAGE(PG8_SB(0, 0), b2, voffB); PG8_STAGE(PG8_SB(0, 1), b2 + hstep, voffB); PG8_STAGE(PG8_SA(0, 0), a2, voffA);
            PG8_WAIT_V(8); PG8_WAIT_L(0); PG8_BAR; PG8_MMA(1, 0, At, B0); PG8_MMA(1, 1, At, B1); PG8_BAR; PG8_SCHED;
            PG8_LDB(B0, 1, 0); PG8_LDB(B1, 1, 1); PG8_SCHED; PG8_LDA(At, 1, 0); PG8_STAGE(PG8_SA(0, 1), a2 + hstep, voffA);
            PG8_WAIT_V(8); PG8_WAIT_L(0); PG8_BAR; PG8_MMA(0, 0, At, B0); PG8_MMA(0, 1, At, B1); PG8_BAR; PG8_SCHED;
            PG8_LDA(At, 1, 1); PG8_STAGE(PG8_SB(1, 0), b3, voffB); PG8_STAGE(PG8_SB(1, 1), b3 + hstep, voffB); PG8_STAGE(PG8_SA(1, 0), a3, voffA);
            PG8_WAIT_V(8); PG8_WAIT_L(0); PG8_BAR; PG8_MMA(1, 0, At, B0); PG8_MMA(1, 1, At, B1); PG8_BAR; PG8_SCHED;
            } else {
            PG8_LDB(B0, 0, 0); PG8_SCHED; PG8_LDA(At, 0, 0); PG8_STAGE(PG8_SA(1, 1), a1 + hstep, voffA);
            PG8_WAIT_L(8); PG8_BAR; PG8_WAIT_L(0); PG8_MMA(0, 0, At, B0); PG8_BAR; PG8_SCHED;
            PG8_LDB(B1, 0, 1); PG8_STAGE(PG8_SB(0, 0), b2, voffB);
            PG8_BAR; PG8_WAIT_L(0); PG8_MMA(0, 1, At, B1); PG8_BAR;
            PG8_LDA(At, 0, 1); PG8_STAGE(PG8_SA(0, 0), a2, voffA);
            PG8_BAR; PG8_WAIT_L(0); PG8_MMA(1, 0, At, B0); PG8_BAR; PG8_SCHED;
            PG8_STAGE(PG8_SB(0, 1), b2 + hstep, voffB);
            PG8_WAIT_V(6); PG8_BAR; PG8_MMA(1, 1, At, B1); PG8_BAR;
            PG8_LDB(B0, 1, 0); PG8_SCHED; PG8_LDA(At, 1, 0); PG8_STAGE(PG8_SA(0, 1), a2 + hstep, voffA);
            PG8_WAIT_L(8); PG8_BAR; PG8_WAIT_L(0); PG8_MMA(0, 0, At, B0); PG8_BAR; PG8_SCHED;
            PG8_LDB(B1, 1, 1); PG8_STAGE(PG8_SB(1, 0), b3, voffB);
            PG8_BAR; PG8_WAIT_L(0); PG8_MMA(0, 1, At, B1); PG8_BAR;
            PG8_LDA(At, 1, 1); PG8_STAGE(PG8_SA(1, 0), a3, voffA);
            PG8_BAR; PG8_WAIT_L(0); PG8_MMA(1, 0, At, B0); PG8_BAR; PG8_SCHED;
            PG8_STAGE(PG8_SB(1, 1), b3 + hstep, voffB);
            PG8_WAIT_V(6); PG8_BAR; PG8_MMA(1, 1, At, B1); PG8_BAR;
            }
        }
        if constexpr (ALIGN_EPI) { if (wr == 0) PG8_BAR; }
        if constexpr (!Epi::AFTER_DRAIN) { E(acc, cur, wr, wc, fr, fq); S.done(cur); }
        if (!has_next) break;
#pragma unroll
        for (int a = 0; a < 2; ++a)
#pragma unroll
            for (int b = 0; b < 2; ++b)
#pragma unroll
                for (int m = 0; m < 4; ++m)
#pragma unroll
                    for (int n = 0; n < 2; ++n) acc[a][b][m][n] = (f32x4){0.f, 0.f, 0.f, 0.f};
        cur = nxt; cA = nA; cB = nB; ++ui;
        if constexpr (ALIGN_EPI) { if (wr == 1) PG8_BAR; }
    }
    PG8_WAIT_V(0);
    if constexpr (!ALIGN_EPI) { if (wr == 0) PG8_BAR; }
    PG8_BAR;
    if constexpr (Epi::AFTER_DRAIN) { E.fused(acc, cur, wr, wc, fr, fq, lds, wid, lane); S.done(cur); }
#undef PG8_SA
#undef PG8_SB
#undef PG8_STAGE
#undef PG8_LDA
#undef PG8_LDB
#undef PG8_MMA
#undef PG8_WAIT_V
#undef PG8_WAIT_L
#undef PG8_BAR
#undef PG8_SCHED
}
}

#ifndef REPEAT_MASK
#define REPEAT_MASK 0
#endif
#ifndef MK_PER_PHASE
#define MK_PER_PHASE 0
#endif

constexpr int DM = 1024, BATCH = 8, SEQ = 4096, MTOK = BATCH * SEQ;
constexpr int MEMLEN = 256, MROWS = BATCH * MEMLEN;
constexpr int NZ1 = 2560, NGATE = 3072;
constexpr int ZQ = 0, ZK = 512, ZV = 1024, ZGR = 1536, ZU = 2048, ZQM = 2304;
constexpr int NTILES = MTOK / 128;
constexpr float EPS = 1e-6f;
constexpr int NPHASE = 15;

constexpr size_t MiB = 1u << 20;
constexpr size_t WS_CTL = 0, CTL_ZERO_BYTES = 1 * MiB;
constexpr size_t WS_WIN_T = 1 * MiB;
constexpr size_t WS_WQ_T = 12 * MiB;
constexpr size_t WS_WOUT_T = 16 * MiB;
constexpr size_t WS_WBR_T = 18 * MiB;
constexpr size_t WS_WBS_T = 19 * MiB;
constexpr size_t WS_WBM_T = 19 * MiB + 512 * 1024;
constexpr size_t WS_WGLU_T = 20 * MiB;
constexpr size_t WS_WMKV_T = 21 * MiB;
constexpr size_t WS_KEYS = 22 * MiB;
constexpr size_t WS_S5MAT = 23 * MiB;
constexpr size_t WS_S5C = 25 * MiB;
constexpr size_t WS_PSC = 25 * MiB + 256 * 1024;
constexpr size_t WS_SS = 25 * MiB + 512 * 1024;
constexpr size_t WS_ROPE = 26 * MiB;
constexpr size_t WS_PU = 42 * MiB;
constexpr size_t WS_PV = 74 * MiB;
constexpr size_t WS_MEMN = 106 * MiB;
constexpr size_t WS_KM = 110 * MiB;
constexpr size_t WS_VT = 111 * MiB;
constexpr size_t WS_S5E = 112 * MiB;
constexpr size_t WS_S5X = 114 * MiB;
constexpr size_t WS_A = 116 * MiB;
constexpr size_t WS_B = 180 * MiB;
constexpr size_t WS_Z1 = WS_B;
constexpr size_t WS_G = WS_B;
constexpr size_t WS_RET = WS_B + 192 * MiB;
constexpr size_t WS_SSM = WS_B + 224 * MiB;
constexpr size_t WS_MATTN = WS_B + 240 * MiB;
constexpr size_t WS_YG = WS_B + 256 * MiB;
constexpr size_t WS_INNER = WS_B + 272 * MiB;
constexpr size_t WS_N2 = WS_B;
constexpr size_t WS_Q2 = WS_B + 64 * MiB;
constexpr size_t WS_IDX = WS_B + 192 * MiB;
constexpr size_t WS_WGT = WS_B + 208 * MiB;
constexpr size_t WS_HPART = WS_B + 128 * MiB;
constexpr size_t WS_ACT = WS_B + 224 * MiB;
constexpr size_t WS_POUT = WS_B + 64 * MiB;
constexpr size_t WS_END = WS_B + 304 * MiB;

constexpr int CW_BAR = 4096;
constexpr int CW_Q = 8192;

constexpr int LDS_BYTES = 147456;
constexpr int MISC_OFF = LDS_BYTES - 512;
constexpr int NWAVES = 8;

#define GAS __attribute__((address_space(1)))
#define LAS __attribute__((address_space(3)))
typedef unsigned short bf16;
typedef unsigned v4u __attribute__((ext_vector_type(4)));
typedef unsigned v2u __attribute__((ext_vector_type(2)));
typedef float f32x4 __attribute__((ext_vector_type(4)));
typedef float f32x16 __attribute__((ext_vector_type(16)));
typedef short bf16x8 __attribute__((ext_vector_type(8)));
typedef GAS unsigned gu32;
#define RLX_AGENT __ATOMIC_RELAXED, __HIP_MEMORY_SCOPE_AGENT
#define LDS_WAIT() asm volatile("s_waitcnt lgkmcnt(0)" ::: "memory")
#define VM_WAIT() asm volatile("s_waitcnt vmcnt(0)" ::: "memory")
__device__ __forceinline__ unsigned f2bf(float f) { unsigned u = __builtin_bit_cast(unsigned, f); return (u + 0x7fffu + ((u >> 16) & 1u)) >> 16; }
typedef __bf16 hwbf16x2_t __attribute__((ext_vector_type(2)));
typedef float hwf32x2_t __attribute__((ext_vector_type(2)));
__device__ __forceinline__ unsigned pk2(float lo, float hi) { const hwf32x2_t v = {lo, hi}; const hwbf16x2_t b = __builtin_convertvector(v, hwbf16x2_t); return __builtin_bit_cast(unsigned, b); }
__device__ __forceinline__ float bflo(unsigned w) { return __builtin_bit_cast(float, w << 16); }
__device__ __forceinline__ float bfhi(unsigned w) { return __builtin_bit_cast(float, w & 0xffff0000u); }
__device__ __forceinline__ float bf2f(bf16 h) { return __builtin_bit_cast(float, (unsigned)h << 16); }
__device__ __forceinline__ f32x16 mfma32(bf16x8 a, bf16x8 b, f32x16 c) { return __builtin_amdgcn_mfma_f32_32x32x16_bf16(a, b, c, 0, 0, 0); }
__device__ __forceinline__ f32x4 mfma16(bf16x8 a, bf16x8 b, f32x4 c) { return __builtin_amdgcn_mfma_f32_16x16x32_bf16(a, b, c, 0, 0, 0); }
__device__ __forceinline__ bf16x8 mk8(unsigned a, unsigned b, unsigned c, unsigned d) { v4u t = {a, b, c, d}; return __builtin_bit_cast(bf16x8, t); }
__device__ __forceinline__ float sigmoidf_(float x) { return __builtin_amdgcn_rcpf(1.0f + __builtin_amdgcn_exp2f(-1.4426950408889634f * x)); }
__device__ __forceinline__ float gelu_tanh(float x) {
    const float u2 = 1.5957691216057308f * (x + 0.044715f * x * x * x);
    return x * __builtin_amdgcn_rcpf(1.0f + __builtin_amdgcn_exp2f(-1.4426950408889634f * u2));
}
__device__ __forceinline__ float wave_sum(float v) {
#pragma unroll
    for (int o = 1; o < 64; o <<= 1) v += __shfl_xor(v, o);
    return v;
}

#define XB_TMO      128
#define XB_XCNT(j)  (256  + 64 * (j))
#define XB_XSUB(j)  (1280 + 64 * (j))
#define XB_XGEN(j)  (2304 + 64 * (j))
#define XB_TOP      3328
#define XB_TOPGEN   3392
#define XCD_BAR_WORDS 3456
#define XB_SPIN_CAP (1u << 22)

__device__ __forceinline__ unsigned xb_ld(unsigned* p)              { return __hip_atomic_load(p, __ATOMIC_RELAXED, __HIP_MEMORY_SCOPE_AGENT); }
__device__ __forceinline__ unsigned xb_add(unsigned* p, unsigned v) { return __hip_atomic_fetch_add(p, v, __ATOMIC_RELAXED, __HIP_MEMORY_SCOPE_AGENT); }
__device__ __forceinline__ unsigned xb_xcc_id() { return (unsigned)__builtin_amdgcn_s_getreg((3 << 11) | 20) & 0xFu; }
#define XB_SPIN(cond, bar) do { unsigned _sp = 0; while (cond) { __builtin_amdgcn_s_sleep(1); \
    if ((++_sp & 255u) == 0u) { if (xb_ld(&(bar)[XB_TMO])) break; if (_sp > XB_SPIN_CAP) { atomicAdd(&(bar)[XB_TMO], 1u); break; } } } } while (0)

struct XcdBarrier { unsigned* bar; unsigned x; volatile LAS unsigned* st; };

__device__ __forceinline__ XcdBarrier xcd_barrier_post(unsigned* bar, volatile LAS unsigned* st, bool tid0) {
    XcdBarrier b; b.bar = bar; b.x = xb_xcc_id(); b.st = st;
    if (tid0) (void)xb_add(&bar[XB_XCNT(b.x)], 1u);
    return b;
}
__device__ __forceinline__ void xcd_barrier_complete(unsigned* bar, unsigned x, unsigned& nloc, unsigned& nx) {
    const unsigned G = gridDim.x * gridDim.y * gridDim.z;
    unsigned sum, cnt, mine, sp = 0u;
    for (;;) {
        sum = 0u; cnt = 0u; mine = 0u;
#pragma unroll
        for (unsigned j = 0; j < 16; ++j) { const unsigned c = xb_ld(&bar[XB_XCNT(j)]); sum += c; cnt += (c > 0u) ? 1u : 0u; mine = (j == x) ? c : mine; }
        if (sum == G) break;
        __builtin_amdgcn_s_sleep(1);
        if ((++sp & 255u) == 0u) { if (xb_ld(&bar[XB_TMO])) break; if (sp > XB_SPIN_CAP) { atomicAdd(&bar[XB_TMO], 1u); break; } }
    }
    nloc = mine > 0u ? mine : 1u; nx = cnt > 0u ? cnt : 1u;
}
__device__ __forceinline__ void xcd_barrier(const XcdBarrier& b, int wave) {
    asm volatile("s_waitcnt vmcnt(0)" ::: "memory");
    __syncthreads();
    if (wave == 0 && pg8::hw_lane_id() == 0) {
        unsigned* bar = b.bar;
        __builtin_amdgcn_s_waitcnt(0);
        unsigned nloc = b.st[0], nx = b.st[1];
        if (nloc == 0u) { xcd_barrier_complete(bar, b.x, nloc, nx); b.st[0] = nloc; b.st[1] = nx; }
        const unsigned old = xb_add(&bar[XB_XSUB(b.x)], 1u);
        const unsigned gen = old / nloc;
        if (old + 1u == (gen + 1u) * nloc) {
            __builtin_amdgcn_fence(__ATOMIC_RELEASE, "agent");
            asm volatile("s_waitcnt vmcnt(0)" ::: "memory");
            const unsigned og = xb_add(&bar[XB_TOP], 1u);
            const unsigned tg = og / nx;
            if (og + 1u == (tg + 1u) * nx) xb_add(&bar[XB_TOPGEN], 1u);
            else XB_SPIN(xb_ld(&bar[XB_TOPGEN]) == tg, bar);
            __builtin_amdgcn_fence(__ATOMIC_ACQUIRE, "agent");
            xb_add(&bar[XB_XGEN(b.x)], 1u);
            asm volatile("s_waitcnt vmcnt(0)" ::: "memory");
        } else {
            XB_SPIN(xb_ld(&bar[XB_XGEN(b.x)]) == gen, bar);
            __builtin_amdgcn_fence(__ATOMIC_ACQUIRE, "agent");
            asm volatile("s_waitcnt vmcnt(0)" ::: "memory");
        }
    }
    __syncthreads();
}

__host__ __device__ __forceinline__ int frag32(int row, int k, int K) { return (((row >> 5) * (K >> 4) + (k >> 4)) * 64 + ((k >> 3) & 1) * 32 + (row & 31)) * 8 + (k & 7); }
__host__ __device__ __forceinline__ int frag16(int n, int k, int K) { return (((n >> 4) * (K >> 5) + (k >> 5)) * 64 + ((k >> 3) & 3) * 16 + (n & 15)) * 8 + (k & 7); }
struct Args { const void* in[26]; float* out; unsigned char* ws; int ph_lo, ph_hi; };
struct Ctx {
    LAS unsigned char* lds;
    int tid, lane, wave, vcu, G;
    __device__ __forceinline__ void refresh() { lane = pg8::hw_lane_id(); tid = wave * 64 + lane; }
};

template <class F> struct EpiT {
    static constexpr bool PERM = true, AFTER_DRAIN = false;
    F f;
    __device__ __forceinline__ void operator()(const f32x4 (&acc)[2][2][4][2], const pg8::Unit& u, int wr, int wc, int fr, int fq) const {
        const int row0 = u.pm * 256 + wr * 64 + fr, col0 = u.pn * 256 + wc * 32 + 8 * fq;
        typename F::L cur[2], nxt[2];
        f.load(row0, col0, cur[0]); f.load(row0, col0 + 128, cur[1]);
#pragma unroll
        for (int i = 0; i < 8; ++i) {
            const int ai = i >> 2, m = i & 3, row = row0 + ai * 128 + m * 16;
            if (i < 7) { const int rown = row0 + ((i + 1) >> 2) * 128 + ((i + 1) & 3) * 16; f.load(rown, col0, nxt[0]); f.load(rown, col0 + 128, nxt[1]); }
            __builtin_amdgcn_sched_barrier(0);
            f.apply(row, col0, acc[ai][0][m][0], acc[ai][0][m][1], cur[0]); f.apply(row, col0 + 128, acc[ai][1][m][0], acc[ai][1][m][1], cur[1]);
            __builtin_amdgcn_sched_barrier(0);
            cur[0] = nxt[0]; cur[1] = nxt[1];
        }
    }
};
__device__ __forceinline__ v4u pack8(f32x4 a, f32x4 b) { v4u w; w.x = pk2(a[0], a[1]); w.y = pk2(a[2], a[3]); w.z = pk2(b[0], b[1]); w.w = pk2(b[2], b[3]); return w; }
struct LNone {};
struct FStore { typedef LNone L; bf16* O; int ldc;
    __device__ __forceinline__ void load(int, int, L&) const {}
    __device__ __forceinline__ void apply(int row, int col, f32x4 v0, f32x4 v1, const L&) const { *(v4u*)(O + (size_t)row * ldc + col) = pack8(v0, v1); } };
struct FKvm { typedef LNone L; bf16* KM; bf16* VT;
    __device__ __forceinline__ void load(int, int, L&) const {}
    __device__ __forceinline__ void apply(int row, int col, f32x4 v0, f32x4 v1, const L&) const {
        const int b = row >> 8, m = row & 255;
        if (col < 256) { const int hm = col >> 6, d0 = col & 63; *(v4u*)(KM + (size_t)(b * 4 + hm) * 16384 + frag32(m, d0, 64)) = pack8(v0, v1); }
        else { const int c = col - 256, hm = c >> 6, e0 = c & 63, mt = m >> 5, s2 = (m >> 4) & 1, w = m & 15, hh = (w >> 2) & 1, j = ((w >> 3) << 2) | (w & 3);
            bf16* p = VT + (size_t)(b * 4 + hm) * 16384 + ((mt * 2 + s2) * 64 + hh * 32) * 8 + j;
#pragma unroll
            for (int jj = 0; jj < 8; ++jj) { const int e = e0 + jj; p[((e >> 5) * 16 * 64 + (e & 31)) * 8] = (bf16)f2bf(jj < 4 ? v0[jj] : v1[jj - 4]); } }
    } };
struct FSig { typedef LNone L; bf16* O; int ldc;
    __device__ __forceinline__ void load(int, int, L&) const {}
    __device__ __forceinline__ void apply(int row, int col, f32x4 v0, f32x4 v1, const L&) const {
#pragma unroll
        for (int j = 0; j < 4; ++j) { v0[j] = sigmoidf_(v0[j]); v1[j] = sigmoidf_(v1[j]); }
        *(v4u*)(O + (size_t)row * ldc + col) = pack8(v0, v1); } };
struct FGlu { typedef LNone L; bf16* O;
    __device__ __forceinline__ void load(int, int, L&) const {}
    __device__ __forceinline__ void apply(int row, int col, f32x4 v0, f32x4 v1, const L&) const {
        v2u w; w.x = pk2(v0[0] * sigmoidf_(v1[0]), v0[1] * sigmoidf_(v1[1])); w.y = pk2(v0[2] * sigmoidf_(v1[2]), v0[3] * sigmoidf_(v1[3]));
        *(v2u*)(O + (size_t)row * 256 + (col >> 1)) = w; } };
struct LBranch { v4u g; v4u m; };
template <int MODE> struct FBranch { typedef LBranch L; const bf16* Gt; int goff; bf16* MF; bf16* MB;
    __device__ __forceinline__ void load(int row, int col, L& l) const {
        l.g = *(const v4u*)(Gt + (size_t)row * NGATE + goff + col);
        if (MODE >= 1) l.m = *(const v4u*)(MF + (size_t)row * DM + col); }
    __device__ __forceinline__ void apply(int row, int col, f32x4 v0, f32x4 v1, const L& l) const {
        const v4u g = l.g;
        v0[0] *= bflo(g.x); v0[1] *= bfhi(g.x); v0[2] *= bflo(g.y); v0[3] *= bfhi(g.y);
        v1[0] *= bflo(g.z); v1[1] *= bfhi(g.z); v1[2] *= bflo(g.w); v1[3] *= bfhi(g.w);
        if (MODE >= 1) { const v4u m = l.m; v0[0] += bflo(m.x); v0[1] += bfhi(m.x); v0[2] += bflo(m.y); v0[3] += bfhi(m.y); v1[0] += bflo(m.z); v1[1] += bfhi(m.z); v1[2] += bflo(m.w); v1[3] += bfhi(m.w); }
        *(v4u*)((MODE <= 1 ? MF : MB) + (size_t)row * DM + col) = pack8(v0, v1); } };
struct LRes { f32x4 x0, x1; };
struct FRes { typedef LRes L; const float* X; bf16* HB; float* SS;
    __device__ __forceinline__ void load(int row, int col, L& l) const { const float* xp = X + (size_t)row * DM + col; l.x0 = *(const f32x4*)xp; l.x1 = *(const f32x4*)(xp + 4); }
    __device__ __forceinline__ void apply(int row, int col, f32x4 v0, f32x4 v1, const L& l) const {
        v0 += l.x0; v1 += l.x1;
        *(v4u*)(HB + (size_t)row * DM + col) = pack8(v0, v1);
        float q = (v0[0] * v0[0] + v0[1] * v0[1]) + (v0[2] * v0[2] + v0[3] * v0[3]) + (v1[0] * v1[0] + v1[1] * v1[1]) + (v1[2] * v1[2] + v1[3] * v1[3]);
        q += __shfl_xor(q, 16); q += __shfl_xor(q, 32);
        if (pg8::hw_lane_id() < 16) atomicAdd(SS + row, q); } };
struct LRstd { float ss; };
struct FStoreRstd { typedef LRstd L; bf16* O; int ldc; const float* SS;
    __device__ __forceinline__ void load(int row, int, L& l) const { l.ss = SS[row]; }
    __device__ __forceinline__ void apply(int row, int col, f32x4 v0, f32x4 v1, const L& l) const {
        const float rs = __builtin_amdgcn_rsqf(l.ss * (1.f / DM) + EPS); *(v4u*)(O + (size_t)row * ldc + col) = pack8(v0 * rs, v1 * rs); } };

template <class F>
__device__ __forceinline__ void run_gemm(const Ctx& C, const bf16* A, const bf16* Bt, int M, int N, int K, const F& f) {
    pg8::Gemm g{A, Bt, M, N, K}; pg8::StaticOrder S; S.init(M, N, C.G, (int)blockIdx.x);
    EpiT<F> E{f};
    pg8::gemm_phase<EpiT<F>, pg8::StaticOrder, true, true>(C.lds, g, S, E, C.wave);
}

template <bool GLU>
__device__ __forceinline__ void p0_transpose_item(const float* W, int K, int N, bf16* WT, LAS float* scr, int item, int lane, const float* kscale = nullptr) {
    const int nblk = N / 32, kb = item / nblk, nb = item % nblk, k0 = 64 * kb, n0 = 32 * nb;
#pragma unroll 8
    for (int i = 0; i < 32; ++i) { const int kk = 2 * i + (lane >> 5); float w = W[(size_t)(k0 + kk) * N + n0 + (lane & 31)]; if (kscale) w *= kscale[k0 + kk]; scr[kk * 33 + (lane & 31)] = w; }
    LDS_WAIT(); asm volatile("" ::: "memory");
    const int c = lane & 7;
#pragma unroll
    for (int j = 0; j < 4; ++j) { const int n = (lane >> 3) + 8 * j; const LAS float* s = scr + (8 * c) * 33 + n;
        v4u o; o.x = pk2(s[0 * 33], s[1 * 33]); o.y = pk2(s[2 * 33], s[3 * 33]); o.z = pk2(s[4 * 33], s[5 * 33]); o.w = pk2(s[6 * 33], s[7 * 33]);
        const int nn = n0 + n; int row = nn;
        if (GLU) { const int jc = nn & 255, gate = nn >> 8; row = 8 * (jc >> 2) + 4 * gate + (jc & 3); }
        *(GAS v4u*)(WT + (size_t)row * K + k0 + 8 * c) = o; }
    LDS_WAIT(); asm volatile("" ::: "memory");
}
template <int NR>
__device__ __forceinline__ void rms_rows_to_bf16(const float* xbase, const float* gain, bf16* obase, int m0, int mstep, int lane) {
    f32x4 v[NR][4]; float s[NR];
#pragma unroll
    for (int i = 0; i < NR; ++i) { const f32x4* xr = (const f32x4*)(xbase + (size_t)(m0 + i * mstep) * DM) + lane; s[i] = 0.f;
#pragma unroll
        for (int j = 0; j < 4; ++j) v[i][j] = xr[64 * j]; }
#pragma unroll
    for (int i = 0; i < NR; ++i)
#pragma unroll
        for (int j = 0; j < 4; ++j) s[i] += (v[i][j].x * v[i][j].x + v[i][j].y * v[i][j].y) + (v[i][j].z * v[i][j].z + v[i][j].w * v[i][j].w);
#pragma unroll
    for (int o = 1; o < 64; o <<= 1)
#pragma unroll
        for (int i = 0; i < NR; ++i) s[i] += __shfl_xor(s[i], o);
    const f32x4* gr = (const f32x4*)gain + lane;
    f32x4 g[4];
#pragma unroll
    for (int j = 0; j < 4; ++j) g[j] = gr[64 * j];
#pragma unroll
    for (int i = 0; i < NR; ++i) { const float rstd = 1.0f / sqrtf(s[i] * (1.f / DM) + EPS);
        unsigned long long* o8 = (unsigned long long*)(obase + (size_t)(m0 + i * mstep) * DM) + lane;
#pragma unroll
        for (int j = 0; j < 4; ++j) o8[64 * j] = (unsigned long long)pk2(v[i][j].x * rstd * g[j].x, v[i][j].y * rstd * g[j].y) | ((unsigned long long)pk2(v[i][j].z * rstd * g[j].z, v[i][j].w * rstd * g[j].w) << 32); }
}

__device__ __forceinline__ void p0_s5_group(const Ctx& C, const Args& a, int g, int part) {
    const float* a_re = (const float*)a.in[7]; const float* a_im = (const float*)a.in[8]; const float* log_dt = (const float*)a.in[9];
    const float* b_re = (const float*)a.in[10]; const float* b_im = (const float*)a.in[11]; const float* c_re = (const float*)a.in[12]; const float* c_im = (const float*)a.in[13];
    LAS float* L = (LAS float*)C.lds;
    LAS float* lpr = L;
    LAS float* lpi = L + 640;
    LAS float* bbr = L + 1280;
    LAS float* bbi = bbr + 1024;
    LAS float* ccr = bbi + 1024;
    LAS float* cci = ccr + 1024;
    LAS float* Kj = cci + 1024;
    const int tid = C.tid;
    bf16* T8T = (bf16*)(a.ws + WS_S5MAT) + (size_t)g * 16384;
    bf16* PMT = (bf16*)(a.ws + WS_S5MAT) + (size_t)(16 + g) * 16384;
    bf16* QMT = (bf16*)(a.ws + WS_S5MAT) + (size_t)(32 + g) * 16384;
    float* L8 = (float*)(a.ws + WS_S5C) + (size_t)g * 128;
    float* L128 = (float*)(a.ws + WS_S5C) + 2048 + (size_t)g * 128;
    for (int i = tid; i < 640; i += 512) {
        const int j10 = i >> 6, p = i & 63; const double jj = (j10 < 9) ? (double)j10 : 128.0;
        const double dt = exp((double)log_dt[g]);
        const double ar = (double)a_re[g * 64 + p], ai = (double)a_im[g * 64 + p];
        const double mag = exp(ar * dt * jj), ang = ai * dt * jj;
        lpr[i] = (float)(mag * cos(ang)); lpi[i] = (float)(mag * sin(ang));
    }
    for (int i = tid; i < 1024; i += 512) { ccr[i] = c_re[g * 1024 + i]; cci[i] = c_im[g * 1024 + i]; }
    __syncthreads();
    if (part == 0 && tid < 64) { L8[tid * 2] = lpr[8 * 64 + tid]; L8[tid * 2 + 1] = lpi[8 * 64 + tid]; L128[tid * 2] = lpr[9 * 64 + tid]; L128[tid * 2 + 1] = lpi[9 * 64 + tid]; }
    for (int i = tid; i < 1024; i += 512) {
        const int p = i >> 4, h = i & 15;
        const float ar = a_re[g * 64 + p], ai = a_im[g * 64 + p], lr = lpr[64 + p], li = lpi[64 + p];
        const float den = ar * ar + ai * ai, nr = lr - 1.0f, ni = li;
        const float cr = (nr * ar + ni * ai) / den, ci = (ni * ar - nr * ai) / den;
        const float br = b_re[(g * 64 + p) * 16 + h], bi = b_im[(g * 64 + p) * 16 + h];
        bbr[i] = cr * br - ci * bi; bbi[i] = cr * bi + ci * br;
    }
    __syncthreads();
    for (int i = tid; i < 2048; i += 512) {
        const int j = i >> 8, ho = (i >> 4) & 15, hi = i & 15; float sacc = 0.f;
        for (int p = 0; p < 64; ++p) { const float cr_ = ccr[ho * 64 + p], ci_ = cci[ho * 64 + p], lr_ = lpr[j * 64 + p], li_ = lpi[j * 64 + p];
            const float mr = cr_ * lr_ - ci_ * li_, mi = cr_ * li_ + ci_ * lr_;
            sacc += mr * bbr[p * 16 + hi] - mi * bbi[p * 16 + hi]; }
        Kj[i] = sacc;
    }
    __syncthreads();
    for (int i = part * 1024 + tid; i < (part + 1) * 1024; i += 512) {
        const int n = i >> 7, k = i & 127;
        { const int t = n >> 4, ho = n & 15, sx = k >> 4, hi = k & 15; const float v = (sx <= t) ? Kj[((t - sx) * 16 + ho) * 16 + hi] : 0.f; T8T[frag16(n, k, 128)] = (bf16)f2bf(v); }
        { const int p = n & 63, im = n >> 6, sx = k >> 4, hi = k & 15; const float lr_ = lpr[(7 - sx) * 64 + p], li_ = lpi[(7 - sx) * 64 + p], br_ = bbr[p * 16 + hi], bi_ = bbi[p * 16 + hi];
          const float v = im ? (lr_ * bi_ + li_ * br_) : (lr_ * br_ - li_ * bi_); PMT[frag16(n, k, 128)] = (bf16)f2bf(v); }
        { const int t = n >> 4, ho = n & 15, p = k & 63, pt = k >> 6; const float cr_ = ccr[ho * 64 + p], ci_ = cci[ho * 64 + p], lr_ = lpr[(t + 1) * 64 + p], li_ = lpi[(t + 1) * 64 + p];
          const float v = pt ? -(cr_ * li_ + ci_ * lr_) : (cr_ * lr_ - ci_ * li_); QMT[frag16(n, k, 128)] = (bf16)f2bf(v); }
    }
    __syncthreads();
}

__device__ __forceinline__ void p0_prologue(const Ctx& C, const Args& a) {
    p0_s5_group(C, a, C.vcu & 15, C.vcu >> 4);
    LAS float* scr = (LAS float*)(C.lds + C.wave * 16384);
    const int gw = C.vcu * NWAVES + C.wave, NGW = C.G * NWAVES;
    const int gt = C.vcu * 512 + C.tid, NGT = C.G * 512;
    unsigned char* ws = a.ws;
    for (int i = gt; i < MTOK; i += NGT) ((float*)(ws + WS_SS))[i] = 0.f;
    constexpr int I_IN = 16 * 176, I_Q = 16 * 64, I_O = 16 * 32, I_BR = 8 * 32, I_BS = 4 * 32, I_BM = 4 * 32, I_KV = 16 * 16, I_GLU = 4 * 16;
    constexpr int NITEMS = I_IN + I_Q + I_O + I_BR + I_BS + I_BM + I_KV + I_GLU;
    for (int it = gw; it < NITEMS; it += NGW) {
        int r = it;
        if (r < I_IN) { p0_transpose_item<false>((const float*)a.in[4], 1024, 5632, (bf16*)(ws + WS_WIN_T), scr, r, C.lane); continue; } r -= I_IN;
        if (r < I_Q) { p0_transpose_item<false>((const float*)a.in[21], 1024, 2048, (bf16*)(ws + WS_WQ_T), scr, r, C.lane, (const float*)a.in[20]); continue; } r -= I_Q;
        if (r < I_O) { p0_transpose_item<false>((const float*)a.in[19], 1024, 1024, (bf16*)(ws + WS_WOUT_T), scr, r, C.lane); continue; } r -= I_O;
        if (r < I_BR) { p0_transpose_item<false>((const float*)a.in[16], 512, 1024, (bf16*)(ws + WS_WBR_T), scr, r, C.lane); continue; } r -= I_BR;
        if (r < I_BS) { p0_transpose_item<false>((const float*)a.in[17], 256, 1024, (bf16*)(ws + WS_WBS_T), scr, r, C.lane); continue; } r -= I_BS;
        if (r < I_BM) { p0_transpose_item<false>((const float*)a.in[18], 256, 1024, (bf16*)(ws + WS_WBM_T), scr, r, C.lane); continue; } r -= I_BM;
        if (r < I_KV) { p0_transpose_item<false>((const float*)a.in[6], 1024, 512, (bf16*)(ws + WS_WMKV_T), scr, r, C.lane); continue; } r -= I_KV;
        p0_transpose_item<true>((const float*)a.in[15], 256, 512, (bf16*)(ws + WS_WGLU_T), scr, r, C.lane);
    }
    for (int i = gt; i < 16 * 128 * 128 / 8; i += NGT) { const f32x4 x0 = ((const f32x4*)a.in[22])[2 * (size_t)i], x1 = ((const f32x4*)a.in[22])[2 * (size_t)i + 1];
        const int hc = i >> 11, n = (i >> 4) & 127, d0 = (i & 15) * 8; *(v4u*)((bf16*)(ws + WS_KEYS) + hc * 16384 + frag32(n, d0, 128)) = pack8(x0, x1); }
    for (int rw0 = gw; rw0 < 2 * 16384; rw0 += 4 * NGW) {
        f32x4 v[4][4]; float mx[4];
#pragma unroll
        for (int i = 0; i < 4; ++i) { const int rw = rw0 + i * NGW, t = rw >> 14, row = rw & 16383;
            const float* src = (const float*)a.in[23 + t] + (size_t)row * DM + C.lane * 4; mx[i] = 0.f;
#pragma unroll
            for (int q = 0; q < 4; ++q) { v[i][q] = *(const f32x4*)(src + 256 * q); if (t == 0) v[i][q] = v[i][q] * *(const f32x4*)((const float*)a.in[20] + C.lane * 4 + 256 * q); } }
#pragma unroll
        for (int i = 0; i < 4; ++i)
#pragma unroll
            for (int q = 0; q < 4; ++q) mx[i] = fmaxf(mx[i], fmaxf(fmaxf(fabsf(v[i][q][0]), fabsf(v[i][q][1])), fmaxf(fabsf(v[i][q][2]), fabsf(v[i][q][3]))));
#pragma unroll
        for (int o = 1; o < 64; o <<= 1)
#pragma unroll
            for (int i = 0; i < 4; ++i) mx[i] = fmaxf(mx[i], __shfl_xor(mx[i], o));
#pragma unroll
        for (int i = 0; i < 4; ++i) { const int rw = rw0 + i * NGW, t = rw >> 14, row = rw & 16383;
            int ex = (int)((__builtin_bit_cast(unsigned, mx[i]) >> 23) & 0xffu) - 127;
            if (mx[i] < 1e-30f) ex = 7;
            const float sc = __builtin_bit_cast(float, (unsigned)(127 + 7 - ex) << 23), isc = __builtin_bit_cast(float, (unsigned)(127 - 7 + ex) << 23);
            unsigned char* dst = ws + (t ? WS_PV : WS_PU) + (size_t)row * 128 + ((C.lane * 4) & 127);
#pragma unroll
            for (int q = 0; q < 4; ++q) { int p = __builtin_amdgcn_cvt_pk_fp8_f32(v[i][q][0] * sc, v[i][q][1] * sc, 0, false); p = __builtin_amdgcn_cvt_pk_fp8_f32(v[i][q][2] * sc, v[i][q][3] * sc, p, true);
                *(unsigned*)(dst + (size_t)(2 * q + (C.lane >> 5)) * (16384 * 128)) = (unsigned)p; }
            if (C.lane == 0) ((float*)(ws + WS_PSC))[t * 16384 + row] = isc; }
    }
    for (int m = gw; m < MTOK; m += 4 * NGW) rms_rows_to_bf16<4>((const float*)a.in[0], (const float*)a.in[3], (bf16*)(ws + WS_A), m, NGW, C.lane);
    for (int m = gw; m < MROWS; m += NGW) rms_rows_to_bf16<1>((const float*)a.in[1], (const float*)a.in[5], (bf16*)(ws + WS_MEMN), m, NGW, C.lane);
    {
        const int* pos = (const int*)a.in[2]; float* rope = (float*)(ws + WS_ROPE);
        const int j = C.tid & 63;
        const double invrev = exp(-(double)j * (9.210340371976184 / 64.0)) * 0.15915494309189535;
        for (int i = gt; i < MTOK * 64; i += NGT) { const int tok = i >> 6;
            double rv = (double)pos[tok] * invrev; rv -= rint(rv);
            const float rf = (float)rv;
            rope[(size_t)tok * 128 + j] = __builtin_amdgcn_cosf(rf); rope[(size_t)tok * 128 + 64 + j] = __builtin_amdgcn_sinf(rf); }
    }
}

constexpr int LP = 136;
__device__ __forceinline__ float lg2_gamma(int h) { return log2f(1.0f - exp2f(-5.0f - (float)h)); }

__device__ __forceinline__ void r1_unit(const Ctx& C, const Args& a, int tile, int h) {
    const bf16* Z1 = (const bf16*)(a.ws + WS_Z1); const float* ROPE = (const float*)(a.ws + WS_ROPE);
    LAS bf16* Qs = (LAS bf16*)C.lds; LAS bf16* Ks = Qs + 128 * LP; LAS bf16* Kt = Ks + 128 * LP; LAS bf16* Vt = Kt + 128 * LP;
    const int tid = C.tid, lane = C.lane, t0 = tile * 128, u = tile * 4 + h;
    const float lg2g = lg2_gamma(h);
    {
        const int i = tid >> 2, dq = (tid & 3) * 16;
        const bf16* zr = Z1 + (size_t)(t0 + i) * NZ1; const float* rp = ROPE + (size_t)(t0 + i) * 128;
        float cs[16], sn[16];
#pragma unroll
        for (int q = 0; q < 4; ++q) { const f32x4 c4 = *(const f32x4*)(rp + dq + 4 * q), s4 = *(const f32x4*)(rp + 64 + dq + 4 * q);
#pragma unroll
            for (int e = 0; e < 4; ++e) { cs[4 * q + e] = c4[e]; sn[4 * q + e] = s4[e]; } }
        const float kdec = __builtin_amdgcn_exp2f((float)(127 - i) * lg2g) , ksc = 0.08838834764831845f;
#pragma unroll
        for (int which = 0; which < 2; ++which) {
            const bf16* src = zr + (which ? ZK : ZQ) + h * 128;
            const v4u a0 = *(const v4u*)(src + dq), a1 = *(const v4u*)(src + dq + 8), b0 = *(const v4u*)(src + 64 + dq), b1 = *(const v4u*)(src + 64 + dq + 8);
            const unsigned aw[8] = {a0.x, a0.y, a0.z, a0.w, a1.x, a1.y, a1.z, a1.w}, bw[8] = {b0.x, b0.y, b0.z, b0.w, b1.x, b1.y, b1.z, b1.w};
            float y1[16], y2[16];
#pragma unroll
            for (int w = 0; w < 8; ++w) {
                const float x1l = bflo(aw[w]), x1h = bfhi(aw[w]), x2l = bflo(bw[w]), x2h = bfhi(bw[w]);
                y1[2 * w] = x1l * cs[2 * w] - x2l * sn[2 * w]; y2[2 * w] = x1l * sn[2 * w] + x2l * cs[2 * w];
                y1[2 * w + 1] = x1h * cs[2 * w + 1] - x2h * sn[2 * w + 1]; y2[2 * w + 1] = x1h * sn[2 * w + 1] + x2h * cs[2 * w + 1];
            }
            if (which) {
#pragma unroll
                for (int e = 0; e < 16; ++e) { y1[e] *= ksc; y2[e] *= ksc; }
            }
            LAS bf16* dstp = (which ? Ks : Qs) + i * LP;
            v4u o;
            o.x = pk2(y1[0], y1[1]); o.y = pk2(y1[2], y1[3]); o.z = pk2(y1[4], y1[5]); o.w = pk2(y1[6], y1[7]); *(LAS v4u*)(dstp + dq) = o;
            o.x = pk2(y1[8], y1[9]); o.y = pk2(y1[10], y1[11]); o.z = pk2(y1[12], y1[13]); o.w = pk2(y1[14], y1[15]); *(LAS v4u*)(dstp + dq + 8) = o;
            o.x = pk2(y2[0], y2[1]); o.y = pk2(y2[2], y2[3]); o.z = pk2(y2[4], y2[5]); o.w = pk2(y2[6], y2[7]); *(LAS v4u*)(dstp + 64 + dq) = o;
            o.x = pk2(y2[8], y2[9]); o.y = pk2(y2[10], y2[11]); o.z = pk2(y2[12], y2[13]); o.w = pk2(y2[14], y2[15]); *(LAS v4u*)(dstp + 64 + dq + 8) = o;
            if (which) {
#pragma unroll
                for (int e = 0; e < 16; ++e) { Kt[(dq + e) * LP + i] = (bf16)f2bf(y1[e] * kdec); Kt[(64 + dq + e) * LP + i] = (bf16)f2bf(y2[e] * kdec); }
            }
            __builtin_amdgcn_sched_barrier(0);
        }
        {
            const int eq = (tid & 3) * 32; const bf16* vs = zr + ZV + h * 128 + eq;
#pragma unroll
            for (int q = 0; q < 4; ++q) { const v4u v = *(const v4u*)(vs + 8 * q); const unsigned vw[4] = {v.x, v.y, v.z, v.w};
#pragma unroll
                for (int w = 0; w < 4; ++w) { Vt[(eq + 8 * q + 2 * w) * LP + i] = (bf16)(vw[w] & 0xffffu); Vt[(eq + 8 * q + 2 * w + 1) * LP + i] = (bf16)(vw[w] >> 16); } }
        }
    }
    __syncthreads();
    const int r = lane & 31, hh = lane >> 5;
    if (C.wave < 4) {
        const int ib = C.wave;
        bf16x8 bq[8];
#pragma unroll
        for (int ks = 0; ks < 8; ++ks) bq[ks] = *(const LAS bf16x8*)(Qs + (ib * 32 + r) * LP + ks * 16 + 8 * hh);
        f32x16 accO[4];
#pragma unroll
        for (int et = 0; et < 4; ++et)
#pragma unroll
            for (int e = 0; e < 16; ++e) accO[et][e] = 0.f;
        const int i = ib * 32 + r;
#pragma unroll
        for (int jt = 0; jt < 4; ++jt) {
            if (jt <= ib) {
                f32x16 s;
#pragma unroll
                for (int e = 0; e < 16; ++e) s[e] = 0.f;
#pragma unroll
                for (int ks = 0; ks < 8; ++ks) { const bf16x8 ak = *(const LAS bf16x8*)(Ks + (jt * 32 + r) * LP + ks * 16 + 8 * hh); s = mfma32(ak, bq[ks], s); }
                unsigned pk[8];
#pragma unroll
                for (int q = 0; q < 8; ++q) {
                    const int ra = 2 * q, rb = 2 * q + 1;
                    const int ja = jt * 32 + (ra & 3) + 8 * (ra >> 2) + 4 * hh, jb = jt * 32 + (rb & 3) + 8 * (rb >> 2) + 4 * hh;
                    const float va = (i >= ja) ? s[ra] * __builtin_amdgcn_exp2f((float)(i - ja) * lg2g) : 0.f;
                    const float vb = (i >= jb) ? s[rb] * __builtin_amdgcn_exp2f((float)(i - jb) * lg2g) : 0.f;
                    pk[q] = pk2(va, vb);
                }
#pragma unroll
                for (int sft = 0; sft < 2; ++sft) {
                    const bf16x8 pb = mk8(pk[4 * sft], pk[4 * sft + 1], pk[4 * sft + 2], pk[4 * sft + 3]);
#pragma unroll
                    for (int et = 0; et < 4; ++et) {
                        const LAS bf16* vp = Vt + (et * 32 + r) * LP + jt * 32 + 16 * sft + 4 * hh;
                        const v2u lo = *(const LAS v2u*)vp, hi = *(const LAS v2u*)(vp + 8);
                        accO[et] = mfma32(mk8(lo.x, lo.y, hi.x, hi.y), pb, accO[et]);
                    }
                }
            }
            __builtin_amdgcn_sched_barrier(0);
        }
        unsigned* INN = (unsigned*)(a.ws + WS_INNER) + ((size_t)(u * 4 + ib) * 32) * 64 + lane;
#pragma unroll
        for (int et = 0; et < 4; ++et)
#pragma unroll
            for (int q = 0; q < 8; ++q) INN[(et * 8 + q) * 64] = pk2(accO[et][2 * q], accO[et][2 * q + 1]);
    } else {
        const int et = C.wave - 4;
        f32x16 acc[4];
#pragma unroll
        for (int dt = 0; dt < 4; ++dt)
#pragma unroll
            for (int e = 0; e < 16; ++e) acc[dt][e] = 0.f;
#pragma unroll
        for (int ks = 0; ks < 8; ++ks) {
            const bf16x8 av = *(const LAS bf16x8*)(Vt + (et * 32 + r) * LP + ks * 16 + 8 * hh);
#pragma unroll
            for (int dt = 0; dt < 4; ++dt) { const bf16x8 bk = *(const LAS bf16x8*)(Kt + (dt * 32 + r) * LP + ks * 16 + 8 * hh); acc[dt] = mfma32(av, bk, acc[dt]); }
            __builtin_amdgcn_sched_barrier(0);
        }
        float* KVb = a.out + (size_t)u * 16384 + (size_t)(et * 32 + 4 * hh) * 128 + r;
#pragma unroll
        for (int dt = 0; dt < 4; ++dt) {
#pragma unroll
            for (int e = 0; e < 16; ++e) KVb[((e & 3) + 8 * (e >> 2)) * 128 + dt * 32] = acc[dt][e];
            __builtin_amdgcn_sched_barrier(0);
        }
    }
    __syncthreads();
}

__device__ __forceinline__ void s5_compute_E(const Args& a, int tile, int g, int lane, LAS float* Es, bf16x8 (&au)[4]) {
    const bf16* Z1 = (const bf16*)(a.ws + WS_Z1); const bf16* PMT = (const bf16*)(a.ws + WS_S5MAT) + (size_t)(16 + g) * 16384;
    const int r16 = lane & 15, q4 = lane >> 4;
#pragma unroll
    for (int ks = 0; ks < 4; ++ks) { const int s = 2 * ks + (q4 >> 1);
        au[ks] = *(const bf16x8*)(Z1 + (size_t)(tile * 128 + 8 * r16 + s) * NZ1 + ZU + g * 16 + 8 * (q4 & 1)); }
    bf16x8 bc[4], bn[4];
#pragma unroll
    for (int ks = 0; ks < 4; ++ks) bc[ks] = *(const bf16x8*)(PMT + (ks * 64 + lane) * 8);
#pragma unroll 1
    for (int nb = 0; nb < 8; ++nb) {
        const int nbn = min(nb + 1, 7);
#pragma unroll
        for (int ks = 0; ks < 4; ++ks) bn[ks] = *(const bf16x8*)(PMT + ((nbn * 4 + ks) * 64 + lane) * 8);
        __builtin_amdgcn_sched_barrier(0);
        f32x4 acc = {0.f, 0.f, 0.f, 0.f};
#pragma unroll
        for (int ks = 0; ks < 4; ++ks) acc = mfma16(au[ks], bc[ks], acc);
#pragma unroll
        for (int i4 = 0; i4 < 4; ++i4) Es[(q4 * 4 + i4) * 128 + nb * 16 + r16] = acc[i4];
        __builtin_amdgcn_sched_barrier(0);
#pragma unroll
        for (int ks = 0; ks < 4; ++ks) bc[ks] = bn[ks];
    }
    LDS_WAIT(); asm volatile("" ::: "memory");
}
__device__ __forceinline__ void s5a_wave(const Ctx& C, const Args& a, int tile, int g) {
    LAS float* Es = (LAS float*)(C.lds + C.wave * 16384);
    bf16x8 au[4];
    s5_compute_E(a, tile, g, C.lane, Es, au);
    const float* L8 = (const float*)(a.ws + WS_S5C) + (size_t)g * 128;
    const float l8r = L8[C.lane * 2], l8i = L8[C.lane * 2 + 1];
    float sr = 0.f, si = 0.f;
#pragma unroll
    for (int c = 0; c < 16; ++c) { const float er = Es[c * 128 + C.lane], ei = Es[c * 128 + 64 + C.lane];
        const float nr = l8r * sr - l8i * si + er, ni = l8r * si + l8i * sr + ei; sr = nr; si = ni; }
    float* E = (float*)(a.ws + WS_S5E) + ((size_t)tile * 16 + g) * 128;
    E[C.lane] = sr; E[64 + C.lane] = si;
    LDS_WAIT(); asm volatile("" ::: "memory");
}
__device__ __forceinline__ void s5c_wave(const Ctx& C, const Args& a, int tile, int g) {
    LAS float* Es = (LAS float*)(C.lds + C.wave * 16384);
    LAS bf16* Sv = (LAS bf16*)(C.lds + C.wave * 16384 + 8192);
    const int lane = C.lane, r16 = lane & 15, q4 = lane >> 4;
    bf16x8 au[4];
    s5_compute_E(a, tile, g, lane, Es, au);
    const float* L8 = (const float*)(a.ws + WS_S5C) + (size_t)g * 128;
    const float l8r = L8[lane * 2], l8i = L8[lane * 2 + 1];
    const float* X = (const float*)(a.ws + WS_S5X) + ((size_t)tile * 16 + g) * 128;
    float sr = X[lane], si = X[64 + lane];
#pragma unroll
    for (int c = 0; c < 16; ++c) {
        Sv[c * LP + lane] = (bf16)f2bf(sr); Sv[c * LP + 64 + lane] = (bf16)f2bf(si);
        const float er = Es[c * 128 + lane], ei = Es[c * 128 + 64 + lane];
        const float nr = l8r * sr - l8i * si + er, ni = l8r * si + l8i * sr + ei; sr = nr; si = ni; }
    LDS_WAIT(); asm volatile("" ::: "memory");
    bf16x8 as[4];
#pragma unroll
    for (int ks = 0; ks < 4; ++ks) as[ks] = *(const LAS bf16x8*)(Sv + r16 * LP + ks * 32 + 8 * q4);
    const bf16* T8T = (const bf16*)(a.ws + WS_S5MAT) + (size_t)g * 16384; const bf16* QMT = (const bf16*)(a.ws + WS_S5MAT) + (size_t)(32 + g) * 16384;
    const bf16* Z1 = (const bf16*)(a.ws + WS_Z1); bf16* YG = (bf16*)(a.ws + WS_YG);
    const float dg = ((const float*)a.in[14])[g * 16 + r16];
    bf16x8 tc[4], tn[4], qc[4], qn[4]; bf16 uc[4], un[4];
#pragma unroll
    for (int ks = 0; ks < 4; ++ks) { tc[ks] = *(const bf16x8*)(T8T + (ks * 64 + lane) * 8); qc[ks] = *(const bf16x8*)(QMT + (ks * 64 + lane) * 8); }
#pragma unroll
    for (int i4 = 0; i4 < 4; ++i4) uc[i4] = Z1[(size_t)(tile * 128 + 8 * (q4 * 4 + i4)) * NZ1 + ZU + g * 16 + r16];
#pragma unroll 1
    for (int nb = 0; nb < 8; ++nb) {
        const int nbn = min(nb + 1, 7);
#pragma unroll
        for (int ks = 0; ks < 4; ++ks) { tn[ks] = *(const bf16x8*)(T8T + ((nbn * 4 + ks) * 64 + lane) * 8); qn[ks] = *(const bf16x8*)(QMT + ((nbn * 4 + ks) * 64 + lane) * 8); }
#pragma unroll
        for (int i4 = 0; i4 < 4; ++i4) un[i4] = Z1[(size_t)(tile * 128 + 8 * (q4 * 4 + i4) + nbn) * NZ1 + ZU + g * 16 + r16];
        __builtin_amdgcn_sched_barrier(0);
        f32x4 acc = {0.f, 0.f, 0.f, 0.f};
#pragma unroll
        for (int ks = 0; ks < 4; ++ks) { acc = mfma16(au[ks], tc[ks], acc); acc = mfma16(as[ks], qc[ks], acc); }
#pragma unroll
        for (int i4 = 0; i4 < 4; ++i4) { const int tok = tile * 128 + 8 * (q4 * 4 + i4) + nb;
            YG[(size_t)tok * 256 + g * 16 + r16] = (bf16)f2bf(gelu_tanh(acc[i4] + dg * bf2f(uc[i4]))); }
        __builtin_amdgcn_sched_barrier(0);
#pragma unroll
        for (int ks = 0; ks < 4; ++ks) { tc[ks] = tn[ks]; qc[ks] = qn[ks]; }
#pragma unroll
        for (int i4 = 0; i4 < 4; ++i4) uc[i4] = un[i4];
    }
    LDS_WAIT(); asm volatile("" ::: "memory");
}

__device__ __forceinline__ void ma_loadk(const bf16* kp, int mt, bf16x8 (&k)[4]) {
#pragma unroll
    for (int ks = 0; ks < 4; ++ks) k[ks] = *(const bf16x8*)(kp + (mt * 4 + ks) * 512);
}
__device__ __forceinline__ void ma_loadv(const bf16* vp, int mt, bf16x8 (&v)[4]) {
#pragma unroll
    for (int sft = 0; sft < 2; ++sft)
#pragma unroll
        for (int et = 0; et < 2; ++et) v[sft * 2 + et] = *(const bf16x8*)(vp + (((et * 8 + mt) * 2 + sft) * 64) * 8);
}
__device__ __forceinline__ void ma_wave(const Ctx& C, const Args& a, int tile, int hm, int ib) {
    const bf16* Z1 = (const bf16*)(a.ws + WS_Z1); const bf16* KM = (const bf16*)(a.ws + WS_KM); const bf16* VT = (const bf16*)(a.ws + WS_VT);
    const int lane = C.lane, r = lane & 31, hh = lane >> 5, b = tile >> 5, tok = tile * 128 + ib * 32 + r;
    const bf16* kp = KM + (size_t)(b * 4 + hm) * 16384 + lane * 8;
    const bf16* vp = VT + (size_t)(b * 4 + hm) * 16384 + lane * 8;
    bf16x8 bq[4];
#pragma unroll
    for (int ks = 0; ks < 4; ++ks) bq[ks] = *(const bf16x8*)(Z1 + (size_t)tok * NZ1 + ZQM + hm * 64 + ks * 16 + 8 * hh);
    bf16x8 kc[4], kn[4];
    ma_loadk(kp, 0, kc);
    float mx = -3.0e38f;
#pragma unroll 1
    for (int mt = 0; mt < 8; ++mt) {
        ma_loadk(kp, min(mt + 1, 7), kn); __builtin_amdgcn_sched_barrier(0);
        f32x16 s;
#pragma unroll
        for (int e = 0; e < 16; ++e) s[e] = 0.f;
#pragma unroll
        for (int ks = 0; ks < 4; ++ks) s = mfma32(kc[ks], bq[ks], s);
#pragma unroll
        for (int e = 0; e < 16; ++e) mx = fmaxf(mx, s[e]);
        __builtin_amdgcn_sched_barrier(0);
#pragma unroll
        for (int ks = 0; ks < 4; ++ks) kc[ks] = kn[ks];
    }
    mx = fmaxf(mx, __shfl_xor(mx, 32));
    float sum = 0.f;
    f32x16 o[2];
#pragma unroll
    for (int et = 0; et < 2; ++et)
#pragma unroll
        for (int e = 0; e < 16; ++e) o[et][e] = 0.f;
    const float sc = 0.125f * 1.4426950408889634f;
    bf16x8 vc[4], vn[4];
    ma_loadk(kp, 0, kc); ma_loadv(vp, 0, vc);
#pragma unroll 1
    for (int mt = 0; mt < 8; ++mt) {
        ma_loadk(kp, min(mt + 1, 7), kn); ma_loadv(vp, min(mt + 1, 7), vn); __builtin_amdgcn_sched_barrier(0);
        f32x16 s;
#pragma unroll
        for (int e = 0; e < 16; ++e) s[e] = 0.f;
#pragma unroll
        for (int ks = 0; ks < 4; ++ks) s = mfma32(kc[ks], bq[ks], s);
        unsigned pk[8];
#pragma unroll
        for (int q = 0; q < 8; ++q) { const float pa = __builtin_amdgcn_exp2f((s[2 * q] - mx) * sc), pb = __builtin_amdgcn_exp2f((s[2 * q + 1] - mx) * sc); sum += pa + pb; pk[q] = pk2(pa, pb); }
#pragma unroll
        for (int sft = 0; sft < 2; ++sft) {
            const bf16x8 pb = mk8(pk[4 * sft], pk[4 * sft + 1], pk[4 * sft + 2], pk[4 * sft + 3]);
#pragma unroll
            for (int et = 0; et < 2; ++et) o[et] = mfma32(vc[sft * 2 + et], pb, o[et]);
        }
        __builtin_amdgcn_sched_barrier(0);
#pragma unroll
        for (int ks = 0; ks < 4; ++ks) kc[ks] = kn[ks];
#pragma unroll
        for (int q = 0; q < 4; ++q) vc[q] = vn[q];
    }
    sum += __shfl_xor(sum, 32);
    const float inv = 1.0f / sum;
    bf16* MA = (bf16*)(a.ws + WS_MATTN) + (size_t)tok * 256 + hm * 64;
#pragma unroll
    for (int et = 0; et < 2; ++et)
#pragma unroll
        for (int g4 = 0; g4 < 4; ++g4) { v2u w; w.x = pk2(o[et][4 * g4] * inv, o[et][4 * g4 + 1] * inv); w.y = pk2(o[et][4 * g4 + 2] * inv, o[et][4 * g4 + 3] * inv);
            *(v2u*)(MA + et * 32 + 8 * g4 + 4 * hh) = w; }
}

__device__ __forceinline__ void r3_wave(const Ctx& C, const Args& a, int tile, int h, int ib) {
    const bf16* Z1 = (const bf16*)(a.ws + WS_Z1); const float* ROPE = (const float*)(a.ws + WS_ROPE);
    const bf16* PREV = (const bf16*)((const unsigned char*)a.out + 64 * MiB);
    const int lane = C.lane, r = lane & 31, hh = lane >> 5, u = tile * 4 + h, tok = tile * 128 + ib * 32 + r;
    const float lg2g = lg2_gamma(h);
    const bf16* zr = Z1 + (size_t)tok * NZ1 + ZQ + h * 128; const float* rp = ROPE + (size_t)tok * 128;
    bf16x8 bq[8];
#pragma unroll
    for (int m = 0; m < 4; ++m) {
        const v4u x1 = *(const v4u*)(zr + m * 16 + 8 * hh), x2 = *(const v4u*)(zr + 64 + m * 16 + 8 * hh);
        const f32x4 c0 = *(const f32x4*)(rp + m * 16 + 8 * hh), c1 = *(const f32x4*)(rp + m * 16 + 8 * hh + 4);
        const f32x4 s0 = *(const f32x4*)(rp + 64 + m * 16 + 8 * hh), s1 = *(const f32x4*)(rp + 64 + m * 16 + 8 * hh + 4);
        const unsigned aw[4] = {x1.x, x1.y, x1.z, x1.w}, bw[4] = {x2.x, x2.y, x2.z, x2.w};
        const float cs[8] = {c0[0], c0[1], c0[2], c0[3], c1[0], c1[1], c1[2], c1[3]}, sn[8] = {s0[0], s0[1], s0[2], s0[3], s1[0], s1[1], s1[2], s1[3]};
        unsigned o1[4], o2[4];
#pragma unroll
        for (int w = 0; w < 4; ++w) {
            const float x1l = bflo(aw[w]), x1h = bfhi(aw[w]), x2l = bflo(bw[w]), x2h = bfhi(bw[w]);
            o1[w] = pk2(x1l * cs[2 * w] - x2l * sn[2 * w], x1h * cs[2 * w + 1] - x2h * sn[2 * w + 1]);
            o2[w] = pk2(x1l * sn[2 * w] + x2l * cs[2 * w], x1h * sn[2 * w + 1] + x2h * cs[2 * w + 1]);
        }
        bq[m] = mk8(o1[0], o1[1], o1[2], o1[3]); bq[m + 4] = mk8(o2[0], o2[1], o2[2], o2[3]);
        __builtin_amdgcn_sched_barrier(0);
    }
    f32x16 acc[4];
    const bf16* pbase = PREV + (size_t)u * 16384 + lane * 8;
    bf16x8 apc[8], apn[8];
#pragma unroll
    for (int ks = 0; ks < 8; ++ks) apc[ks] = *(const bf16x8*)(pbase + ks * 512);
#pragma unroll
    for (int et = 0; et < 4; ++et) {
        if (et < 3) {
#pragma unroll
            for (int ks = 0; ks < 8; ++ks) apn[ks] = *(const bf16x8*)(pbase + ((et + 1) * 8 + ks) * 512);
        }
        __builtin_amdgcn_sched_barrier(0);
#pragma unroll
        for (int e = 0; e < 16; ++e) acc[et][e] = 0.f;
#pragma unroll
        for (int ks = 0; ks < 8; ++ks) acc[et] = mfma32(apc[ks], bq[ks], acc[et]);
        __builtin_amdgcn_sched_barrier(0);
#pragma unroll
        for (int ks = 0; ks < 8; ++ks) apc[ks] = apn[ks];
    }
    const float qdec = __builtin_amdgcn_exp2f((float)(ib * 32 + r + 1) * lg2g);
    const unsigned* INN = (const unsigned*)(a.ws + WS_INNER) + ((size_t)(u * 4 + ib) * 32) * 64 + lane;
    float ss = 0.f;
    unsigned innw[32];
#pragma unroll
    for (int q = 0; q < 32; ++q) innw[q] = INN[q * 64];
#pragma unroll
    for (int et = 0; et < 4; ++et)
#pragma unroll
        for (int q = 0; q < 8; ++q) { const unsigned w = innw[et * 8 + q];
            const float v0 = acc[et][2 * q] * qdec + bflo(w), v1 = acc[et][2 * q + 1] * qdec + bfhi(w);
            acc[et][2 * q] = v0; acc[et][2 * q + 1] = v1; ss += v0 * v0 + v1 * v1; }
    __builtin_amdgcn_sched_barrier(0);
    ss += __shfl_xor(ss, 32);
    const float rn = __builtin_amdgcn_rsqf(ss * (1.0f / 128.0f) + EPS);
    const bf16* gp = Z1 + (size_t)tok * NZ1 + ZGR + h * 128; bf16* RET = (bf16*)(a.ws + WS_RET) + (size_t)tok * 512 + h * 128;
#pragma unroll
    for (int et = 0; et < 4; ++et)
#pragma unroll
        for (int g4 = 0; g4 < 4; ++g4) { const int e0 = et * 32 + 8 * g4 + 4 * hh; const v2u gw = *(const v2u*)(gp + e0);
            const float g0 = bflo(gw.x), g1 = bfhi(gw.x), g2 = bflo(gw.y), g3 = bfhi(gw.y);
            v2u w; w.x = pk2(acc[et][4 * g4] * rn * g0 * sigmoidf_(g0), acc[et][4 * g4 + 1] * rn * g1 * sigmoidf_(g1));
            w.y = pk2(acc[et][4 * g4 + 2] * rn * g2 * sigmoidf_(g2), acc[et][4 * g4 + 3] * rn * g3 * sigmoidf_(g3));
            *(v2u*)(RET + e0) = w; }
}

__device__ __forceinline__ void p3_scans(const Ctx& C, const Args& a) {
    {
        const float* KV = a.out; bf16* PREV = (bf16*)((unsigned char*)a.out + 64 * MiB);
        for (int it = C.vcu * 512 + C.tid; it < 131072; it += C.G * 512) {
            const int elem = it * 4, b = elem >> 16, h = (elem >> 14) & 3, ed = elem & 16383;
            const float cd = exp2f(128.0f * lg2_gamma(h));
            f32x4 st = {0.f, 0.f, 0.f, 0.f};
#pragma unroll 4
            for (int c = 0; c < 32; ++c) { const size_t off = (size_t)((b * 32 + c) * 4 + h) * 16384 + ed;
                v2u w; w.x = pk2(st[0], st[1]); w.y = pk2(st[2], st[3]); *(v2u*)(PREV + (off - ed) + frag32(ed >> 7, ed & 127, 128)) = w;
                const f32x4 inc = *(const f32x4*)(KV + off); st = st * cd + inc; }
        }
    }
    {
        const float* E = (const float*)(a.ws + WS_S5E); float* X = (float*)(a.ws + WS_S5X); const float* L128 = (const float*)(a.ws + WS_S5C) + 2048;
        for (int it = C.vcu * 512 + C.tid; it < 8192; it += C.G * 512) {
            const int b = it >> 10, g = (it >> 6) & 15, p = it & 63;
            const float lr = L128[(g * 64 + p) * 2], li = L128[(g * 64 + p) * 2 + 1];
            float xr = 0.f, xi = 0.f;
            for (int n = 0; n < 32; ++n) { const size_t off = ((size_t)(b * 32 + n) * 16 + g) * 128 + p;
                X[off] = xr; X[off + 64] = xi;
                const float er = E[off], ei = E[off + 64];
                const float nr = lr * xr - li * xi + er, ni = lr * xi + li * xr + ei; xr = nr; xi = ni; }
        }
    }
}

__device__ __forceinline__ int f2key(float x) { int b = __builtin_bit_cast(int, x); return b >= 0 ? b : (b ^ 0x7fffffff); }
__device__ __forceinline__ float key2f(int k) { return __builtin_bit_cast(float, k >= 0 ? k : (k ^ 0x7fffffff)); }
__device__ __forceinline__ void ce_desc(int& x, int& y) { const int hi = x > y ? x : y, lo = x > y ? y : x; x = hi; y = lo; }
__device__ __forceinline__ void sort16_desc(int (&v)[16]) {
#pragma unroll
    for (int k = 2; k <= 16; k <<= 1)
#pragma unroll
        for (int j = k >> 1; j > 0; j >>= 1)
#pragma unroll
            for (int i = 0; i < 16; ++i) { const int l = i ^ j; if (l > i) { if ((i & k) == 0) ce_desc(v[i], v[l]); else ce_desc(v[l], v[i]); } }
}
__device__ __forceinline__ void merge16_desc(int (&T)[16], const int (&N)[16]) {
#pragma unroll
    for (int i = 0; i < 16; ++i) T[i] = T[i] > N[15 - i] ? T[i] : N[15 - i];
#pragma unroll
    for (int j = 8; j > 0; j >>= 1)
#pragma unroll
        for (int i = 0; i < 16; ++i) { const int l = i ^ j; if (l > i) ce_desc(T[i], T[l]); }
}
__device__ __forceinline__ void peer_topk_half(const Args& a, int tokbase, int hp, int c, int lane, int (&T)[16]) {
    const bf16* Q2 = (const bf16*)(a.ws + WS_Q2); const bf16* KEYS = (const bf16*)(a.ws + WS_KEYS);
    const int r = lane & 31, hh = lane >> 5;
    bf16x8 bq[8];
#pragma unroll
    for (int ks = 0; ks < 8; ++ks) bq[ks] = *(const bf16x8*)(Q2 + (size_t)(tokbase + r) * 2048 + hp * 256 + c * 128 + ks * 16 + 8 * hh);
    const bf16* kbase = KEYS + (size_t)(hp * 2 + c) * 16384 + lane * 8;
    bf16x8 akc[8], akn[8];
#pragma unroll
    for (int ks = 0; ks < 8; ++ks) akc[ks] = *(const bf16x8*)(kbase + ks * 512);
#pragma unroll
    for (int nt = 0; nt < 4; ++nt) {
        if (nt < 3) {
#pragma unroll
            for (int ks = 0; ks < 8; ++ks) akn[ks] = *(const bf16x8*)(kbase + ((nt + 1) * 8 + ks) * 512);
        }
        __builtin_amdgcn_sched_barrier(0);
        f32x16 s;
#pragma unroll
        for (int e = 0; e < 16; ++e) s[e] = 0.f;
#pragma unroll
        for (int ks = 0; ks < 8; ++ks) s = mfma32(akc[ks], bq[ks], s);
        int N[16];
#pragma unroll
        for (int e = 0; e < 16; ++e) { const int n = nt * 32 + (e & 3) + 8 * (e >> 2) + 4 * hh; N[e] = (f2key(s[e]) & ~127) | n; }
        sort16_desc(N);
        if (nt == 0) {
#pragma unroll
            for (int e = 0; e < 16; ++e) T[e] = N[e];
        } else merge16_desc(T, N);
        __builtin_amdgcn_sched_barrier(0);
#pragma unroll
        for (int ks = 0; ks < 8; ++ks) akc[ks] = akn[ks];
    }
    int P[16];
#pragma unroll
    for (int j = 0; j < 16; ++j) P[j] = __shfl_xor(T[j], 32);
    merge16_desc(T, P);
}
__device__ __forceinline__ void peer_topk_head(const Ctx& C, const Args& a, int tokbase, int hp) {
    const int lane = C.lane, r = lane & 31, hh = lane >> 5;
    int T0[16], T1[16];
    peer_topk_half(a, tokbase, hp, 0, lane, T0);
    peer_topk_half(a, tokbase, hp, 1, lane, T1);
    int F[16], L1[16], L2[16], L3[16];
#pragma unroll
    for (int j = 0; j < 16; ++j) { L1[j] = (int)0x80000000; L2[j] = (int)0x80000000; L3[j] = (int)0x80000000; }
    {
        int cnt = 0;
#pragma unroll
        for (int i0 = 0; i0 < 16; ++i0)
#pragma unroll
            for (int i1 = 0; i1 < 16; ++i1)
                if ((i0 + 1) * (i1 + 1) <= 16) {
                    const float v = key2f(T0[i0] & ~127) + key2f(T1[i1] & ~127); const int key = (f2key(v) & ~255) | (i0 * 16 + i1);
                    if (i0 == 0) F[i1] = key;
                    else { if (cnt < 16) L1[cnt] = key; else if (cnt < 32) L2[cnt - 16] = key; else L3[cnt - 32] = key; ++cnt; }
                }
    }
    sort16_desc(L1); merge16_desc(F, L1); sort16_desc(L2); merge16_desc(F, L2); sort16_desc(L3); merge16_desc(F, L3);
    LAS int* tab = (LAS int*)(C.lds + C.wave * 16384);
#pragma unroll
    for (int j = 0; j < 16; ++j) { tab[j * 64 + lane] = T0[j] & 127; tab[(16 + j) * 64 + lane] = T1[j] & 127; }
    LDS_WAIT(); asm volatile("" ::: "memory");
    const float m = key2f(F[0] & ~255);
    float e[16], sum = 0.f;
#pragma unroll
    for (int j = 0; j < 16; ++j) { e[j] = __builtin_amdgcn_exp2f((key2f(F[j] & ~255) - m) * 1.4426950408889634f); sum += e[j]; }
    const float inv = 1.0f / sum;
    const int tok = tokbase + r;
    int* IDX = (int*)(a.ws + WS_IDX) + (size_t)tok * 128 + hp * 16; float* WGT = (float*)(a.ws + WS_WGT) + (size_t)tok * 128 + hp * 16;
#pragma unroll
    for (int j = 0; j < 16; ++j) { const int id = F[j] & 255; const int k0 = tab[(id >> 4) * 64 + lane], k1 = tab[(16 + (id & 15)) * 64 + lane];
        if (hh == 0) IDX[j] = k0 * 128 + k1; else WGT[j] = e[j] * inv; }
    LDS_WAIT(); asm volatile("" ::: "memory");
}
typedef float f32x2v __attribute__((ext_vector_type(2)));
__device__ __forceinline__ void unpack16(const v4u a, const v4u b, float (&x)[16]) {
    const unsigned w[8] = {a.x, a.y, a.z, a.w, b.x, b.y, b.z, b.w};
#pragma unroll
    for (int i = 0; i < 8; ++i) { x[2 * i] = bflo(w[i]); x[2 * i + 1] = bfhi(w[i]); }
}
__device__ __forceinline__ void unpack16_fp8(const v4u a, float (&x)[16]) {
    const unsigned w[4] = {a.x, a.y, a.z, a.w};
#pragma unroll
    for (int i = 0; i < 4; ++i) { const f32x2v lo = __builtin_amdgcn_cvt_pk_f32_fp8((int)w[i], false), hi = __builtin_amdgcn_cvt_pk_f32_fp8((int)w[i], true);
        x[4 * i] = lo.x; x[4 * i + 1] = lo.y; x[4 * i + 2] = hi.x; x[4 * i + 3] = hi.y; }
}
__device__ __forceinline__ long mk64(unsigned lo, unsigned hi) { return (long)(((unsigned long long)hi << 32) | (unsigned long long)lo); }
__device__ __forceinline__ float dpp_swap1(float v) { return __builtin_bit_cast(float, __builtin_amdgcn_update_dpp(0, __builtin_bit_cast(int, v), 0xB1, 0xf, 0xf, true)); }
struct PHalf { v4u g[8]; };
struct PIdx { int e[8]; };
__device__ __forceinline__ void pg_idx8(const int* IDXr, int h, int hl, PIdx& I) {
    h = min(h, hl); const int* p = IDXr + (size_t)(h >> 1) * 128 + (h & 1) * 64;
#pragma unroll
    for (int j = 0; j < 8; ++j) I.e[j] = p[j * 8];
}
__device__ __forceinline__ void pg_issue(const unsigned char* TBL, const PIdx& I, int lane, PHalf& D) {
    const unsigned c16 = (unsigned)(lane & 7) * 16u;
#pragma unroll
    for (int j = 0; j < 8; ++j) D.g[j] = *(const v4u*)(TBL + ((unsigned)I.e[j] * 128u + c16));
}
__device__ __forceinline__ void pg_stage(LAS unsigned char* buf, int lane, const PHalf& D) {
    const int row8 = lane >> 3, c8 = lane & 7;
#pragma unroll
    for (int j = 0; j < 8; ++j) *(LAS v4u*)(buf + (j * 8 + row8) * 128 + ((c8 ^ row8) & 7) * 16) = D.g[j];
}
__device__ __forceinline__ void pu_xprep(LAS unsigned char* xs, unsigned xw, int lane) {
    const float x0 = bflo(xw) * 16.f, x1 = bfhi(xw) * 16.f;
    const int hi = __builtin_amdgcn_cvt_pk_fp8_f32(x0, x1, 0, false);
    const f32x2v bk = __builtin_amdgcn_cvt_pk_f32_fp8(hi, false);
    const int lo = __builtin_amdgcn_cvt_pk_fp8_f32(x0 - bk.x, x1 - bk.y, 0, false);
    *(LAS unsigned short*)(xs + 2 * lane) = (unsigned short)hi; *(LAS unsigned short*)(xs + 128 + 2 * lane) = (unsigned short)lo;
}
typedef int v8i_t __attribute__((ext_vector_type(8)));
__device__ __forceinline__ void pu_compute(const LAS unsigned char* buf, bf16* HPt, int r, int kq, const v8i_t bfr) {
    f32x4 res[4];
#pragma unroll
    for (int g = 0; g < 4; ++g) {
        const int row = g * 16 + r, sw = row & 7;
        const v4u a0 = *(const LAS v4u*)(buf + row * 128 + ((2 * kq) ^ sw) * 16), a1 = *(const LAS v4u*)(buf + row * 128 + ((2 * kq + 1) ^ sw) * 16);
        const v8i_t av = {(int)a0.x, (int)a0.y, (int)a0.z, (int)a0.w, (int)a1.x, (int)a1.y, (int)a1.z, (int)a1.w};
        res[g] = __builtin_amdgcn_mfma_scale_f32_16x16x128_f8f6f4(av, bfr, (f32x4){0.f, 0.f, 0.f, 0.f}, 0, 0, 0, 0x7f7f7f7f, 0, 0x7f7f7f7f);
    }
    f32x4 o = res[0];
#pragma unroll
    for (int g = 1; g < 4; ++g) { const bool sel = ((r >> 1) == g);
#pragma unroll
        for (int i = 0; i < 4; ++i) o[i] = sel ? res[g][i] : o[i]; }
#pragma unroll
    for (int i = 0; i < 4; ++i) o[i] += dpp_swap1(o[i]);
    if (r < 8 && (r & 1) == 0) { v2u w; w.x = pk2(o[0], o[1]); w.y = pk2(o[2], o[3]); *(v2u*)(HPt + (r >> 1) * 16 + 4 * kq) = w; }
}
__device__ __forceinline__ int pg_idx(const int* IDXl, int h, int hl) { h = min(h, hl); return IDXl[(size_t)(h >> 1) * 128 + (h & 1) * 64]; }
__device__ __forceinline__ void peer_u_wave(const Args& a, LAS unsigned char* wlds, LAS unsigned char* wsm, int slab, int t0, int ntok, int lane) {
    const unsigned char* U8 = a.ws + WS_PU + (size_t)slab * (16384 * 128);
    const bf16* N2 = (const bf16*)(a.ws + WS_N2) + slab * 128 + 2 * lane;
    const int* IDX = (const int*)(a.ws + WS_IDX) + (lane >> 3);
    bf16* HP = (bf16*)(a.ws + WS_HPART) + (size_t)slab * MTOK * 128;
    const int r = lane & 15, kq = lane >> 4, tl = t0 + ntok - 1, H0 = 2 * t0, HL = 2 * (t0 + ntok) - 1;
    PHalf d[4]; PIdx iv[4]; v8i_t bfr;
#pragma unroll
    for (int k = 0; k < 4; ++k) pg_idx8(IDX, H0 + k, HL, iv[k]);
    unsigned xw = *(const unsigned*)(N2 + (size_t)t0 * DM);
    pg_issue(U8, iv[0], lane, d[0]); pg_issue(U8, iv[1], lane, d[1]); pg_issue(U8, iv[2], lane, d[2]);
    pg_idx8(IDX, H0 + 4, HL, iv[0]); pg_idx8(IDX, H0 + 5, HL, iv[1]); pg_idx8(IDX, H0 + 6, HL, iv[2]);
    pg_stage(wlds, lane, d[0]);
#define PU_XPREP(tok) do { pu_xprep(wsm, xw, lane); \
        { const LAS unsigned char* bp = wsm + ((r & 1) ? 128 : 0) + kq * 32; const v4u b0 = *(const LAS v4u*)bp, b1 = *(const LAS v4u*)(bp + 16); \
          bfr = (v8i_t){(int)b0.x, (int)b0.y, (int)b0.z, (int)b0.w, (int)b1.x, (int)b1.y, (int)b1.z, (int)b1.w}; } \
        xw = *(const unsigned*)(N2 + (size_t)min((tok) + 1, tl) * DM); } while (0)
#define PU_PHASE(ph, hrel, tok, half) do { \
        pg_issue(U8, iv[((ph) + 3) & 3], lane, d[((ph) + 3) & 3]); pg_idx8(IDX, hb + (hrel) + 7, HL, iv[((ph) + 3) & 3]); \
        pu_compute(wlds + ((half) ? 8192 : 0), HP + (size_t)(tok) * 128 + (half) * 64, r, kq, bfr); \
        pg_stage(wlds + ((half) ? 0 : 8192), lane, d[((ph) + 1) & 3]); } while (0)
#pragma unroll 1
    for (int hb = H0; hb <= HL; hb += 4) {
        const int t = hb >> 1;
        PU_XPREP(t);
        PU_PHASE(0, 0, t, 0);
        PU_PHASE(1, 1, t, 1);
        PU_XPREP(t + 1);
        PU_PHASE(2, 2, t + 1, 0);
        PU_PHASE(3, 3, t + 1, 1);
    }
#undef PU_XPREP
#undef PU_PHASE
}
__device__ __forceinline__ void peer_reduce(const Ctx& C, const Args& a) {
    const bf16* HP = (const bf16*)(a.ws + WS_HPART); const int* IDX = (const int*)(a.ws + WS_IDX); const float* WGT = (const float*)(a.ws + WS_WGT);
    const float* USC = (const float*)(a.ws + WS_PSC); const float* VSC = USC + 16384; float* ACT = (float*)(a.ws + WS_ACT);
    for (int it = C.vcu * 512 + C.tid; it < MTOK * 32; it += C.G * 512) {
        f32x4 h = {0.f, 0.f, 0.f, 0.f};
#pragma unroll
        for (int sl = 0; sl < 8; ++sl) { const v2u w = *(const v2u*)(HP + (size_t)sl * MTOK * 128 + (size_t)it * 4); h[0] += bflo(w.x); h[1] += bfhi(w.x); h[2] += bflo(w.y); h[3] += bfhi(w.y); }
        const int4 e = *(const int4*)(IDX + (size_t)it * 4); const f32x4 w = *(const f32x4*)(WGT + (size_t)it * 4);
        const float rs = 0.0625f * __builtin_amdgcn_rsqf(((const float*)(a.ws + WS_SS))[it >> 5] * (1.f / DM) + EPS);
        f32x4 o;
        o[0] = gelu_tanh(h[0] * USC[e.x] * rs) * w[0] * VSC[e.x]; o[1] = gelu_tanh(h[1] * USC[e.y] * rs) * w[1] * VSC[e.y];
        o[2] = gelu_tanh(h[2] * USC[e.z] * rs) * w[2] * VSC[e.z]; o[3] = gelu_tanh(h[3] * USC[e.w] * rs) * w[3] * VSC[e.w];
        *(f32x4*)(ACT + (size_t)it * 4) = o;
    }
}
typedef int v2i_t __attribute__((ext_vector_type(2)));
__device__ __forceinline__ void pv_compute(const LAS unsigned char* buf, int lane, const long* bact2, f32x4 (&acc)[8]) {
    const int i16 = lane & 15, kq = lane >> 4, rr = i16 >> 1, cc = i16 & 1;
#pragma unroll
    for (int s2 = 0; s2 < 2; ++s2) {
        const int row = 32 * s2 + 8 * kq + rr, sw = row & 7;
#pragma unroll
        for (int nb = 0; nb < 8; ++nb) {
            const v2i_t av = __builtin_amdgcn_ds_read_tr8_b64_v2i32((LAS v2i_t*)(buf + row * 128 + ((nb ^ sw) & 7) * 16 + 8 * cc));
            acc[nb] = __builtin_amdgcn_mfma_f32_16x16x32_fp8_fp8(mk64((unsigned)av.x, (unsigned)av.y), bact2[s2], acc[nb], 0, 0, 0);
        }
    }
}
__device__ __forceinline__ void peer_v_wave(const Args& a, LAS unsigned char* wlds, LAS unsigned char* wsm, int slab, int t0, int ntok, int lane) {
    const unsigned char* V8 = a.ws + WS_PV + (size_t)slab * (16384 * 128);
    const int* IDX = (const int*)(a.ws + WS_IDX) + (lane >> 3); const float* ACT = (const float*)(a.ws + WS_ACT) + lane;
    bf16* PO = (bf16*)(a.ws + WS_POUT) + slab * 128;
    const int n16 = lane & 15, kq = lane >> 4, tl = t0 + ntok - 1, H0 = 2 * t0, HL = 2 * (t0 + ntok) - 1;
    PHalf d[4]; PIdx iv[4]; long bact[4]; f32x4 acc[8]; float isc = 1.f;
#pragma unroll
    for (int k = 0; k < 4; ++k) pg_idx8(IDX, H0 + k, HL, iv[k]);
    float a0 = ACT[(size_t)t0 * 128], a1 = ACT[(size_t)t0 * 128 + 64];
    pg_issue(V8, iv[0], lane, d[0]); pg_issue(V8, iv[1], lane, d[1]); pg_issue(V8, iv[2], lane, d[2]);
    pg_idx8(IDX, H0 + 4, HL, iv[0]); pg_idx8(IDX, H0 + 5, HL, iv[1]); pg_idx8(IDX, H0 + 6, HL, iv[2]);
    pg_stage(wlds, lane, d[0]);
#define PV_APREP(tok) do { \
        float mx = fmaxf(fabsf(a0), fabsf(a1)); \
        _Pragma("unroll") for (int o = 1; o < 64; o <<= 1) mx = fmaxf(mx, __shfl_xor(mx, o)); \
        int ex = (int)((__builtin_bit_cast(unsigned, mx) >> 23) & 0xffu) - 127; if (mx < 1e-30f) ex = 7; \
        const float sc = __builtin_bit_cast(float, (unsigned)(127 + 7 - ex) << 23); isc = __builtin_bit_cast(float, (unsigned)(127 - 7 + ex) << 23); \
        { const float s0 = a0 * sc, s1 = a1 * sc; \
          const int hi = __builtin_amdgcn_cvt_pk_fp8_f32(s0, s1, 0, false); const f32x2v bk = __builtin_amdgcn_cvt_pk_f32_fp8(hi, false); \
          const int lo = __builtin_amdgcn_cvt_pk_fp8_f32(s0 - bk.x, s1 - bk.y, 0, false); \
          wsm[lane] = (unsigned char)(hi & 0xff); wsm[64 + lane] = (unsigned char)((hi >> 8) & 0xff); wsm[128 + lane] = (unsigned char)(lo & 0xff); wsm[192 + lane] = (unsigned char)((lo >> 8) & 0xff); } \
        { const LAS unsigned char* bp = wsm + ((n16 & 1) ? 128 : 0) + 8 * kq; \
          _Pragma("unroll") for (int s4 = 0; s4 < 4; ++s4) { const v2u w = *(const LAS v2u*)(bp + 32 * s4); bact[s4] = mk64(w.x, w.y); } } \
        { const int tn = min((tok) + 1, tl); a0 = ACT[(size_t)tn * 128]; a1 = ACT[(size_t)tn * 128 + 64]; } \
        _Pragma("unroll") for (int nb = 0; nb < 8; ++nb) acc[nb] = (f32x4){0.f, 0.f, 0.f, 0.f}; } while (0)
#define PV_PHASE(ph, hrel, half) do { \
        pg_issue(V8, iv[((ph) + 3) & 3], lane, d[((ph) + 3) & 3]); pg_idx8(IDX, hb + (hrel) + 7, HL, iv[((ph) + 3) & 3]); \
        pv_compute(wlds + ((half) ? 8192 : 0), lane, bact + 2 * (half), acc); \
        pg_stage(wlds + ((half) ? 0 : 8192), lane, d[((ph) + 1) & 3]); } while (0)
#define PV_EPI(tok) do { f32x4 o = acc[0]; \
        _Pragma("unroll") for (int nb = 1; nb < 8; ++nb) { const bool sel = ((n16 >> 1) == nb); \
            _Pragma("unroll") for (int i = 0; i < 4; ++i) o[i] = sel ? acc[nb][i] : o[i]; } \
        _Pragma("unroll") for (int i = 0; i < 4; ++i) o[i] += dpp_swap1(o[i]); \
        if ((n16 & 1) == 0) { v2u w; w.x = pk2(o[0] * isc, o[1] * isc); w.y = pk2(o[2] * isc, o[3] * isc); *(v2u*)(PO + (size_t)(tok) * DM + 16 * (n16 >> 1) + 4 * kq) = w; } } while (0)
#pragma unroll 1
    for (int hb = H0; hb <= HL; hb += 4) {
        const int t = hb >> 1;
        PV_APREP(t);
        PV_PHASE(0, 0, 0);
        PV_PHASE(1, 1, 1);
        PV_EPI(t);
        PV_APREP(t + 1);
        PV_PHASE(2, 2, 0);
        PV_PHASE(3, 3, 1);
        PV_EPI(t + 1);
    }
#undef PV_APREP
#undef PV_PHASE
#undef PV_EPI
}
__device__ __forceinline__ void final_rows4(const Args& a, int tok0, int tstep, int lane) {
    const float* gf = (const float*)a.in[25] + lane * 4;
    f32x4 h[4][4]; v2u pw[4][4], hw[4][4]; float ss[4];
#pragma unroll
    for (int i = 0; i < 4; ++i) { const int tok = tok0 + i * tstep; const bf16* hb = (const bf16*)(a.ws + WS_N2) + (size_t)tok * DM + lane * 4; const bf16* po = (const bf16*)(a.ws + WS_POUT) + (size_t)tok * DM + lane * 4;
#pragma unroll
        for (int q = 0; q < 4; ++q) { hw[i][q] = *(const v2u*)(hb + 256 * q); pw[i][q] = *(const v2u*)(po + 256 * q); } }
#pragma unroll
    for (int i = 0; i < 4; ++i) { ss[i] = 0.f;
#pragma unroll
        for (int q = 0; q < 4; ++q) { h[i][q][0] = bflo(hw[i][q].x) + bflo(pw[i][q].x); h[i][q][1] = bfhi(hw[i][q].x) + bfhi(pw[i][q].x); h[i][q][2] = bflo(hw[i][q].y) + bflo(pw[i][q].y); h[i][q][3] = bfhi(hw[i][q].y) + bfhi(pw[i][q].y);
            ss[i] += (h[i][q][0] * h[i][q][0] + h[i][q][1] * h[i][q][1]) + (h[i][q][2] * h[i][q][2] + h[i][q][3] * h[i][q][3]); } }
#pragma unroll
    for (int o = 1; o < 64; o <<= 1)
#pragma unroll
        for (int i = 0; i < 4; ++i) ss[i] += __shfl_xor(ss[i], o);
    f32x4 g[4];
#pragma unroll
    for (int q = 0; q < 4; ++q) g[q] = *(const f32x4*)(gf + 256 * q);
#pragma unroll
    for (int i = 0; i < 4; ++i) { const float rstd = 1.0f / sqrtf(ss[i] * (1.f / DM) + EPS); float* orow = a.out + (size_t)(tok0 + i * tstep) * DM + lane * 4;
#pragma unroll
        for (int q = 0; q < 4; ++q) *(f32x4*)(orow + 256 * q) = h[i][q] * rstd * g[q]; }
}

__device__ __forceinline__ void claim_slab_unit(const Ctx& C, unsigned* ctl, int pass, volatile LAS unsigned* MISC, int& slab, int& unit) {
    if (C.tid == 0) {
        const unsigned x = xb_xcc_id() & 7u; unsigned sl = 8u, un = 0u;
        for (unsigned k = 0; k < 8u; ++k) { const unsigned s2 = (x + k) & 7u; const unsigned u2 = xb_add(ctl + CW_Q + 1024 * pass + 64 * s2, 1u); if (u2 < 32u) { sl = s2; un = u2; break; } }
        MISC[16] = sl; MISC[17] = un;
    }
    __syncthreads();
    slab = (int)MISC[16]; unit = (int)MISC[17];
    __syncthreads();
}
__global__ void __launch_bounds__(NWAVES * 64, 2) mk_fwd(Args args) {
    extern __shared__ __attribute__((aligned(16))) unsigned char lds_raw[];
    Ctx C;
    C.lds = (LAS unsigned char*)lds_raw;
    C.wave = __builtin_amdgcn_readfirstlane((int)threadIdx.x >> 6); C.refresh();
    C.G = gridDim.x; { const int bx = blockIdx.x; C.vcu = (C.G % 8 == 0) ? (bx % 8) * (C.G / 8) + bx / 8 : bx; }
    volatile LAS unsigned* MISC = (volatile LAS unsigned*)(C.lds + MISC_OFF);
    if (C.tid < 128) MISC[C.tid] = 0u;
    __syncthreads();
    unsigned char* ws = args.ws;
    unsigned* ctl = (unsigned*)(ws + WS_CTL);
    XcdBarrier bar; bar.bar = ctl + CW_BAR; bar.x = 0; bar.st = nullptr;
#if !MK_PER_PHASE
    bar = xcd_barrier_post(ctl + CW_BAR, MISC + 8, C.tid == 0);
#define GRID_BAR() xcd_barrier(bar, C.wave)
#else
#define GRID_BAR() do { } while (0)
#endif
    const int lo = args.ph_lo, hi = args.ph_hi;
#define IN(k) (lo <= (k) && (k) < hi)
#define SEAM(k) do { if (IN((k) + 1)) GRID_BAR(); C.refresh(); } while (0)
#define REP(k) for (int rep_ = 0; rep_ < 1 + ((REPEAT_MASK >> (k)) & 1); ++rep_)
    bf16* XN = (bf16*)(ws + WS_A);
    if (IN(0)) { REP(0) { p0_prologue(C, args); __syncthreads(); } SEAM(0); }
    if (IN(1)) {
        REP(1) {
        run_gemm(C, XN, (const bf16*)(ws + WS_WIN_T), MTOK, NZ1, DM, FStore{(bf16*)(ws + WS_Z1), NZ1});
        run_gemm(C, (const bf16*)(ws + WS_MEMN), (const bf16*)(ws + WS_WMKV_T), MROWS, 512, DM, FKvm{(bf16*)(ws + WS_KM), (bf16*)(ws + WS_VT)});
        }
        SEAM(1);
    }
    if (IN(2)) {
        REP(2) { const int tile = C.vcu;
            _Pragma("unroll 1") for (int h = 0; h < 4; ++h) r1_unit(C, args, tile, h);
            _Pragma("unroll 1") for (int gi = 0; gi < 2; ++gi) s5a_wave(C, args, tile, C.wave + 8 * gi);
            _Pragma("unroll 1") for (int gi = 0; gi < 2; ++gi) ma_wave(C, args, tile, 2 * gi + (C.wave >> 2), C.wave & 3);
            __syncthreads();
        }
        SEAM(2);
    }
    if (IN(3)) { REP(3) { p3_scans(C, args); } SEAM(3); }
    if (IN(4)) {
        REP(4) { const int tile = C.vcu;
            _Pragma("unroll 1") for (int gi = 0; gi < 2; ++gi) r3_wave(C, args, tile, 2 * gi + (C.wave >> 2), C.wave & 3);
            _Pragma("unroll 1") for (int gi = 0; gi < 2; ++gi) s5c_wave(C, args, tile, C.wave + 8 * gi);
        }
        SEAM(4);
    }
    if (IN(5)) {
        REP(5) {
        run_gemm(C, XN, (const bf16*)(ws + WS_WIN_T) + (size_t)NZ1 * DM, MTOK, NGATE, DM, FSig{(bf16*)(ws + WS_G), NGATE});
        run_gemm(C, (const bf16*)(ws + WS_YG), (const bf16*)(ws + WS_WGLU_T), MTOK, 512, 256, FGlu{(bf16*)(ws + WS_SSM)});
        }
        SEAM(5);
    }
    if (IN(6)) {
        const bf16* Gt = (const bf16*)(ws + WS_G);
        REP(6) {
        run_gemm(C, (const bf16*)(ws + WS_RET), (const bf16*)(ws + WS_WBR_T), MTOK, DM, 512, FBranch<0>{Gt, 0, (bf16*)args.out, XN});
        run_gemm(C, (const bf16*)(ws + WS_SSM), (const bf16*)(ws + WS_WBS_T), MTOK, DM, 256, FBranch<1>{Gt, 1024, (bf16*)args.out, XN});
        run_gemm(C, (const bf16*)(ws + WS_MATTN), (const bf16*)(ws + WS_WBM_T), MTOK, DM, 256, FBranch<2>{Gt, 2048, (bf16*)args.out, XN});
        }
        SEAM(6);
    }
    if (IN(7)) { run_gemm(C, XN, (const bf16*)(ws + WS_WOUT_T), MTOK, DM, DM, FRes{(const float*)args.in[0], (bf16*)(ws + WS_N2), (float*)(ws + WS_SS)}); SEAM(7); }
    if (IN(9)) { REP(9) run_gemm(C, (const bf16*)(ws + WS_N2), (const bf16*)(ws + WS_WQ_T), MTOK, 2048, DM, FStoreRstd{(bf16*)(ws + WS_Q2), 2048, (const float*)(ws + WS_SS)}); SEAM(9); }
    if (IN(10)) {
        { const int tile = C.vcu;
            const int tokbase = tile * 128 + (C.wave & 3) * 32, h0 = (C.wave >> 2) * 4;
            REP(10) { _Pragma("unroll 1") for (int hp = h0; hp < h0 + 4; ++hp) peer_topk_head(C, args, tokbase, hp); }
        }
        SEAM(10);
    }
    if (IN(11)) { int slab, unit; claim_slab_unit(C, ctl, 0, MISC, slab, unit); if (slab < 8) { REP(11) peer_u_wave(args, C.lds + C.wave * 16384, C.lds + 131072 + C.wave * 1024, slab, unit * 1024 + C.wave * 128, 128, C.lane); } SEAM(11); }
    if (IN(12)) { REP(12) peer_reduce(C, args); SEAM(12); }
    if (IN(13)) { int slab, unit; claim_slab_unit(C, ctl, 1, MISC, slab, unit); if (slab < 8) { REP(13) peer_v_wave(args, C.lds + C.wave * 16384, C.lds + 131072 + C.wave * 1024, slab, unit * 1024 + C.wave * 128, 128, C.lane); } SEAM(13); }
    if (IN(14)) {
        const int gw = C.vcu * NWAVES + C.wave, NGW = C.G * NWAVES;
        for (int m = gw; m < MTOK; m += 4 * NGW) final_rows4(args, m, NGW, C.lane);
    }
#undef IN
#undef SEAM
}

extern "C" void kernel_launch(void* const* d_in, const int* in_sizes, int n_in, void* d_out, int out_size, void* d_ws, size_t ws_size, hipStream_t stream) {
    static int grid = 0;
    if (grid == 0) {
        if (n_in != 26 || in_sizes[0] != MTOK * DM || out_size != MTOK * DM || ws_size < WS_END) {
            fprintf(stderr, "kernel_launch: unexpected problem (n_in %d, in0 %d, out %d, ws %zu < %zu); nothing launched\n", n_in, n_in > 0 ? in_sizes[0] : -1, out_size, ws_size, (size_t)WS_END); grid = -1; return; }
        int dev = 0, cus = 0;
        if (hipGetDevice(&dev) != hipSuccess || hipDeviceGetAttribute(&cus, hipDeviceAttributeMultiprocessorCount, dev) != hipSuccess) { grid = -1; return; }
        if (hipFuncSetAttribute((const void*)mk_fwd, hipFuncAttributeMaxDynamicSharedMemorySize, LDS_BYTES) != hipSuccess) { fprintf(stderr, "kernel_launch: hipFuncSetAttribute failed\n"); grid = -1; return; }
        (void)hipGetLastError();
        if (cus < NTILES) { fprintf(stderr, "kernel_launch: needs >= 256 CUs, got %d\n", cus); grid = -1; return; }
        grid = NTILES;
    }
    if (grid < 0) return;
    (void)hipMemsetAsync((char*)d_ws + WS_CTL, 0, CTL_ZERO_BYTES, stream);
    Args a{};
    for (int i = 0; i < 26; ++i) a.in[i] = d_in[i];
    a.out = (float*)d_out; a.ws = (unsigned char*)d_ws;
#if MK_PER_PHASE
    for (int p = 0; p < NPHASE; ++p) { a.ph_lo = p; a.ph_hi = p + 1; hipLaunchKernelGGL(mk_fwd, dim3(grid), dim3(NWAVES * 64), LDS_BYTES, stream, a); }
#else
    a.ph_lo = 0; a.ph_hi = NPHASE;
    hipLaunchKernelGGL(mk_fwd, dim3(grid), dim3(NWAVES * 64), LDS_BYTES, stream, a);
#endif
}
```

```cpp
#include <hip/hip_runtime.h>
#include <cstdio>
#include <cstdint>
namespace pg8 {
__device__ __forceinline__ int hw_lane_id() { int l; asm volatile("v_mbcnt_lo_u32_b32 %0, -1, 0\n\tv_mbcnt_hi_u32_b32 %0, -1, %0" : "=v"(l)); return l; }
#define PG8_LAS __attribute__((address_space(3)))
typedef unsigned short bf16_t;
typedef short bf16x8 __attribute__((ext_vector_type(8)));
typedef float f32x4 __attribute__((ext_vector_type(4)));
typedef unsigned u32x4 __attribute__((ext_vector_type(4)));
constexpr int BM = 256, BK = 64, HALF = 128, HTB = HALF * BK * 2  , STAGE_BYTES = 8 * HTB, NXCD = 8, WGM = 8;

__host__ __device__ __forceinline__ int lds_byte(int r, int c) { const int st = (r >> 4) * 2 + (c >> 5), rr = r & 15, cc = c & 31, ob = rr * 64 + cc * 2; return st * 1024 + (ob ^ (((ob >> 9) & 1) << 5)); }
__host__ __device__ __forceinline__ void stage_rc(int b, int& R, int& C) { const int st = b / 1024, sb = b % 1024, swz = sb ^ (((sb >> 9) & 1) << 5); R = (st >> 1) * 16 + swz / 64; C = (st & 1) * 32 + (swz % 64) / 2; }
__host__ __device__ __forceinline__ int perm32(int rho) { const int n = rho >> 4, i = rho & 15; return 8 * (i >> 2) + 4 * n + (i & 3); }

struct Unit { int pm, pn; };
struct Gemm { const bf16_t* A; const bf16_t* Bt; int M, N, K; };

struct StaticOrder {
    int nM, nN, nwg, G, c;
    __host__ __device__ void init(int M, int N, int G_, int c_) { nM = M / BM; nN = N / BM; nwg = nM * nN; G = G_; c = c_; }
    __host__ __device__ bool next(int i, Unit& u) const {
        const long L = (long)i * G + c; if (L >= nwg) return false;
        int wgid = (int)L; { const int q = nwg / NXCD, r = nwg % NXCD, xcd = wgid % NXCD, off = wgid / NXCD; wgid = (xcd < r ? xcd * (q + 1) : r * (q + 1) + (xcd - r) * q) + off; }
        const int nig = WGM * nN, gid = wgid / nig, fm = gid * WGM, gsz = (nM - fm) < WGM ? (nM - fm) : WGM;
        u.pm = fm + ((wgid % nig) % gsz); u.pn = (wgid % nig) / gsz; return true;
    }
    __device__ __forceinline__ void a_ready(const Unit&) const {}
    __device__ __forceinline__ void done(const Unit&) const {}
};

__device__ __forceinline__ unsigned cvt_pk_bf16(float lo, float hi) { unsigned r; asm volatile("v_cvt_pk_bf16_f32 %0, %1, %2" : "=v"(r) : "v"(lo), "v"(hi)); return r; }
template <class Epi, class Sched, bool ALIGN_EPI = false, bool SP2 = false, bool MX = false>
__device__ __forceinline__ void gemm_phase(PG8_LAS unsigned char* lds, const Gemm g, const Sched& S, const Epi& E, const int wid, const int sclA = 0x7f7f7f7f, const int sclB = 0x7f7f7f7f) {
    const int lane = hw_lane_id(), tid = wid * 64 + lane, wr = wid >> 2, wc = wid & 3, fr = lane & 15, fq = lane >> 4;
    const int K = g.K, nt = K / BK;
    unsigned voffA[2], voffB[2];
#pragma unroll
    for (int i = 0; i < 2; ++i) { int R, C; stage_rc(tid * 16 + i * 8192, R, C); const int Rb = Epi::PERM ? ((R & ~31) + perm32(R & 31)) : R;
        voffA[i] = (unsigned)(R * K + C) * 2u; voffB[i] = (unsigned)(Rb * K + C) * 2u; }
    const size_t kstep = (size_t)(BK * 2);
    const size_t hstep = (size_t)HALF * K * 2;
    const size_t tstep = 2 * hstep;
    const unsigned ldsw = (unsigned)wid * 1024u;
    const int aoff = lds_byte(wr * 64 + fr, fq * 8), boff = lds_byte(wc * 32 + fr, fq * 8);
#define PG8_SA(b, h) (((b) * 2 + (h)) * HTB)
#define PG8_SB(b, h) ((4 + (b) * 2 + (h)) * HTB)
#define PG8_STAGE(bufoff, gbase, voff) do { _Pragma("unroll") for (int _i = 0; _i < 2; ++_i) \
        __builtin_amdgcn_global_load_lds((const unsigned*)((const char*)(gbase) + (voff)[_i]), (PG8_LAS unsigned*)(lds + (bufoff) + ldsw + _i * 8192), 16, 0, 0); } while (0)
#define PG8_LDA(dst, b, h) do { _Pragma("unroll") for (int m = 0; m < 4; ++m) { \
        if constexpr (MX) { dst##8[m].lo = *(const PG8_LAS v4i_*)(lds + PG8_SA(b, h) + aoff + m * 2048); dst##8[m].hi = *(const PG8_LAS v4i_*)(lds + PG8_SA(b, h) + aoff + m * 2048 + 1024); } \
        else { _Pragma("unroll") for (int k = 0; k < 2; ++k) dst[m][k] = *(const PG8_LAS bf16x8*)(lds + PG8_SA(b, h) + aoff + m * 2048 + k * 1024); } } } while (0)
#define PG8_LDB(dst, b, h) do { _Pragma("unroll") for (int n = 0; n < 2; ++n) { \
        if constexpr (MX) { dst##8[n].lo = *(const PG8_LAS v4i_*)(lds + PG8_SB(b, h) + boff + n * 2048); dst##8[n].hi = *(const PG8_LAS v4i_*)(lds + PG8_SB(b, h) + boff + n * 2048 + 1024); } \
        else { _Pragma("unroll") for (int k = 0; k < 2; ++k) dst[n][k] = *(const PG8_LAS bf16x8*)(lds + PG8_SB(b, h) + boff + n * 2048 + k * 1024); } } } while (0)
#define PG8_MMA(ai, bj, At, Bt) do { __builtin_amdgcn_s_setprio(1); _Pragma("unroll") for (int m = 0; m < 4; ++m) _Pragma("unroll") for (int n = 0; n < 2; ++n) { \
        if constexpr (MX) acc[ai][bj][m][n] = __builtin_amdgcn_mfma_scale_f32_16x16x128_f8f6f4(Bt##8[n], At##8[m], acc[ai][bj][m][n], 0, 0, 0, sclB, 0, sclA); \
        else { _Pragma("unroll") for (int k = 0; k < 2; ++k) acc[ai][bj][m][n] = __builtin_amdgcn_mfma_f32_16x16x32_bf16(Bt[n][k], At[m][k], acc[ai][bj][m][n], 0, 0, 0); } } \
        if constexpr (MX) { _Pragma("unroll") for (int m = 0; m < 4; ++m) _Pragma("unroll") for (int n = 0; n < 2; ++n) asm volatile("" : "+v"(acc[ai][bj][m][n])); }     \
        __builtin_amdgcn_s_setprio(0); } while (0)
#define PG8_WAIT_V(n) asm volatile("s_waitcnt vmcnt(" #n ")" ::: "memory")
#define PG8_WAIT_L(n) asm volatile("s_waitcnt lgkmcnt(" #n ")" ::: "memory")
#define PG8_BAR __builtin_amdgcn_s_barrier()
#define PG8_SCHED __builtin_amdgcn_sched_barrier(0)
    Unit cur, nxt; int ui = 0;
    if (!S.next(0, cur)) return;
    f32x4 acc[2][2][4][2];
#pragma unroll
    for (int a = 0; a < 2; ++a)
#pragma unroll
        for (int b = 0; b < 2; ++b)
#pragma unroll
            for (int m = 0; m < 4; ++m)
#pragma unroll
                for (int n = 0; n < 2; ++n) acc[a][b][m][n] = (f32x4){0.f, 0.f, 0.f, 0.f};
    typedef int v8i_ __attribute__((ext_vector_type(8))); typedef int v4i_ __attribute__((ext_vector_type(4)));
    bf16x8 At[4][2], B0[2][2], B1[2][2]; v8i_ At8[4], B08[2], B18[2];
    const char* cA = (const char*)g.A + (size_t)cur.pm * tstep; const char* cB = (const char*)g.Bt + (size_t)cur.pn * tstep;
    S.a_ready(cur);
    if constexpr (SP2) {
        PG8_STAGE(PG8_SB(0, 0), cB, voffB); PG8_STAGE(PG8_SB(0, 1), cB + hstep, voffB); PG8_STAGE(PG8_SA(0, 0), cA, voffA); PG8_STAGE(PG8_SA(0, 1), cA + hstep, voffA);
        if (wr == 1) PG8_BAR;
        PG8_WAIT_V(2); PG8_BAR;
        PG8_STAGE(PG8_SB(1, 0), cB + kstep, voffB); PG8_STAGE(PG8_SA(1, 0), cA + kstep, voffA); PG8_STAGE(PG8_SB(1, 1), cB + hstep + kstep, voffB);
        PG8_WAIT_V(6); PG8_BAR;
    } else {
        PG8_STAGE(PG8_SB(0, 0), cB, voffB); PG8_STAGE(PG8_SA(0, 0), cA, voffA); PG8_STAGE(PG8_SB(0, 1), cB + hstep, voffB); PG8_STAGE(PG8_SA(0, 1), cA + hstep, voffA);
        if (wr == 1) PG8_BAR;
        PG8_WAIT_V(4); PG8_BAR;
        PG8_STAGE(PG8_SB(1, 0), cB + kstep, voffB); PG8_STAGE(PG8_SA(1, 0), cA + kstep, voffA); PG8_STAGE(PG8_SB(1, 1), cB + hstep + kstep, voffB);
        PG8_WAIT_V(6); PG8_BAR;
    }
    for (;;) {
        const bool has_next = S.next(ui + 1, nxt);
        const char* nA = has_next ? (const char*)g.A + (size_t)nxt.pm * tstep : cA; const char* nB = has_next ? (const char*)g.Bt + (size_t)nxt.pn * tstep : cB;
        for (int t = 0; t < nt; t += 2) {
            const bool last = (t == nt - 2);
            const char* a1 = cA + (size_t)(t + 1) * kstep;
            const char* a2 = last ? nA : cA + (size_t)(t + 2) * kstep; const char* b2 = last ? nB : cB + (size_t)(t + 2) * kstep;
            const char* a3 = a2 + kstep; const char* b3 = b2 + kstep;
            if (last && has_next) S.a_ready(nxt);
            if constexpr (SP2) {
            PG8_LDB(B0, 0, 0); PG8_LDB(B1, 0, 1); PG8_SCHED; PG8_LDA(At, 0, 0); PG8_STAGE(PG8_SA(1, 1), a1 + hstep, voffA);
            PG8_WAIT_V(8); PG8_WAIT_L(0); PG8_BAR; PG8_MMA(0, 0, At, B0); PG8_MMA(0, 1, At, B1); PG8_BAR; PG8_SCHED;
            PG8_LDA(At, 0, 1); PG8_STAGE(PG8_SB(0, 0), b2, voffB); PG8_STAGE(PG8_SB(0, 1), b2 + hstep, voffB); PG8_STAGE(PG8_SA(0, 0), a2, voffA);
            PG8_WAIT_V(8); PG8_WAIT_L(0); PG8_BAR; PG8_MMA(1, 0, At, B0); PG8_MMA(1, 1, At, B1); PG8_BAR; PG8_SCHED;
            PG8_LDB(B0, 1, 0); PG8_LDB(B1, 1, 1); PG8_SCHED; PG8_LDA(At, 1, 0); PG8_STAGE(PG8_SA(0, 1), a2 + hstep, voffA);
            PG8_WAIT_V(8); PG8_WAIT_L(0); PG8_BAR; PG8_MMA(0, 0, At, B0); PG8_MMA(0, 1, At, B1); PG8_BAR; PG8_SCHED;
            PG8_LDA(At, 1, 1); PG8_STAGE(PG8_SB(1, 0), b3, voffB); PG8_STAGE(PG8_SB(1, 1), b3 + hstep, voffB); PG8_STAGE(PG8_SA(1, 0), a3, voffA);
            PG8_WAIT_V(8); PG8_WAIT_L(0); PG8_BAR; PG8_MMA(1, 0, At, B0); PG8_MMA(1, 1, At, B1); PG8_BAR; PG8_SCHED;
            } else {
            PG8_LDB(B0, 0, 0); PG8_SCHED; PG8_LDA(At, 0, 0); PG8_STAGE(PG8_SA(1, 1), a1 + hstep, voffA);
            PG8_WAIT_L(8); PG8_BAR; PG8_WAIT_L(0); PG8_MMA(0, 0, At, B0); PG8_BAR; PG8_SCHED;
            PG8_LDB(B1, 0, 1); PG8_STAGE(PG8_SB(0, 0), b2, voffB);
            PG8_BAR; PG8_WAIT_L(0); PG8_MMA(0, 1, At, B1); PG8_BAR;
            PG8_LDA(At, 0, 1); PG8_STAGE(PG8_SA(0, 0), a2, voffA);
            PG8_BAR; PG8_WAIT_L(0); PG8_MMA(1, 0, At, B0); PG8_BAR; PG8_SCHED;
            PG8_STAGE(PG8_SB(0, 1), b2 + hstep, voffB);
            PG8_WAIT_V(6); PG8_BAR; PG8_MMA(1, 1, At, B1); PG8_BAR;
            PG8_LDB(B0, 1, 0); PG8_SCHED; PG8_LDA(At, 1, 0); PG8_STAGE(PG8_SA(0, 1), a2 + hstep, voffA);
            PG8_WAIT_L(8); PG8_BAR; PG8_WAIT_L(0); PG8_MMA(0, 0, At, B0); PG8_BAR; PG8_SCHED;
            PG8_LDB(B1, 1, 1); PG8_STAGE(PG8_SB(1, 0), b3, voffB);
            PG8_BAR; PG8_WAIT_L(0); PG8_MMA(0, 1, At, B1); PG8_BAR;
            PG8_LDA(At, 1, 1); PG8_STAGE(PG8_SA(1, 0), a3, voffA);
            PG8_BAR; PG8_WAIT_L(0); PG8_MMA(1, 0, At, B0); PG8_BAR; PG8_SCHED;
            PG8_STAGE(PG8_SB(1, 1), b3 + hstep, voffB);
            PG8_WAIT_V(6); PG8_BAR; PG8_MMA(1, 1, At, B1); PG8_BAR;
            }
        }
        if constexpr (ALIGN_EPI) { if (wr == 0) PG8_BAR; }
        if constexpr (!Epi::AFTER_DRAIN) { E(acc, cur, wr, wc, fr, fq); S.done(cur); }
        if (!has_next) break;
#pragma unroll
        for (int a = 0; a < 2; ++a)
#pragma unroll
            for (int b = 0; b < 2; ++b)
#pragma unroll
                for (int m = 0; m < 4; ++m)
#pragma unroll
                    for (int n = 0; n < 2; ++n) acc[a][b][m][n] = (f32x4){0.f, 0.f, 0.f, 0.f};
        cur = nxt; cA = nA; cB = nB; ++ui;
        if constexpr (ALIGN_EPI) { if (wr == 1) PG8_BAR; }
    }
    PG8_WAIT_V(0);
    if constexpr (!ALIGN_EPI) { if (wr == 0) PG8_BAR; }
    PG8_BAR;
    if constexpr (Epi::AFTER_DRAIN) { E.fused(acc, cur, wr, wc, fr, fq, lds, wid, lane); S.done(cur); }
#undef PG8_SA
#undef PG8_SB
#undef PG8_STAGE
#undef PG8_LDA
#undef PG8_LDB
#undef PG8_MMA
#undef PG8_WAIT_V
#undef PG8_WAIT_L
#undef PG8_BAR
#undef PG8_SCHED
}
}

#ifndef REPEAT_MASK
#define REPEAT_MASK 0
#endif
#ifndef MK_PER_PHASE
#define MK_PER_PHASE 0
#endif

constexpr int DM = 1024, BATCH = 8, SEQ = 4096, MTOK = BATCH * SEQ;
constexpr int MEMLEN = 256, MROWS = BATCH * MEMLEN;
constexpr int NZ1 = 2560, NGATE = 3072;
constexpr int ZQ = 0, ZK = 512, ZV = 1024, ZGR = 1536, ZU = 2048, ZQM = 2304;
constexpr int NTILES = MTOK / 128;
constexpr float EPS = 1e-6f;
constexpr int NPHASE = 15;

constexpr size_t MiB = 1u << 20;
constexpr size_t WS_CTL = 0, CTL_ZERO_BYTES = 1 * MiB;
constexpr size_t WS_WIN_T = 1 * MiB;
constexpr size_t WS_WQ_T = 12 * MiB;
constexpr size_t WS_WOUT_T = 16 * MiB;
constexpr size_t WS_WBR_T = 18 * MiB;
constexpr size_t WS_WBS_T = 19 * MiB;
constexpr size_t WS_WBM_T = 19 * MiB + 512 * 1024;
constexpr size_t WS_WGLU_T = 20 * MiB;
constexpr size_t WS_WMKV_T = 21 * MiB;
constexpr size_t WS_KEYS = 22 * MiB;
constexpr size_t WS_S5MAT = 23 * MiB;
constexpr size_t WS_S5C = 25 * MiB;
constexpr size_t WS_PSC = 25 * MiB + 256 * 1024;
constexpr size_t WS_SS = 25 * MiB + 512 * 1024;
constexpr size_t WS_ROPE = 26 * MiB;
constexpr size_t WS_PU = 42 * MiB;
constexpr size_t WS_PV = 58 * MiB;
constexpr size_t WS_XN8 = 74 * MiB;
constexpr size_t WS_WG8 = WS_WIN_T + 5 * MiB;
constexpr size_t WS_MEMN = 106 * MiB;
constexpr size_t WS_KM = 110 * MiB;
constexpr size_t WS_VT = 111 * MiB;
constexpr size_t WS_S5E = 112 * MiB;
constexpr size_t WS_S5X = 114 * MiB;
constexpr size_t WS_A = 116 * MiB;
constexpr size_t WS_B = 180 * MiB;
constexpr size_t WS_Z1 = WS_B;
constexpr size_t WS_G = WS_B;
constexpr size_t WS_RET = WS_B + 192 * MiB;
constexpr size_t WS_SSM = WS_B + 224 * MiB;
constexpr size_t WS_MATTN = WS_B + 240 * MiB;
constexpr size_t WS_YG = WS_B + 256 * MiB;
constexpr size_t WS_INNER = WS_B + 272 * MiB;
constexpr size_t WS_N2 = WS_B;
constexpr size_t WS_Q2 = WS_B + 64 * MiB;
constexpr size_t WS_IDX = WS_B + 192 * MiB;
constexpr size_t WS_WGT = WS_B + 208 * MiB;
constexpr size_t WS_HPART = WS_B + 128 * MiB;
constexpr size_t WS_ACT = WS_B + 224 * MiB;
constexpr size_t WS_POUT = WS_B + 64 * MiB;
constexpr size_t WS_END = WS_B + 304 * MiB;

constexpr int CW_BAR = 4096;
constexpr int CW_Q = 8192;

constexpr int LDS_BYTES = 147456;
constexpr int MISC_OFF = LDS_BYTES - 512;
constexpr int NWAVES = 8;

#define GAS __attribute__((address_space(1)))
#define LAS __attribute__((address_space(3)))
typedef unsigned short bf16;
typedef unsigned v4u __attribute__((ext_vector_type(4)));
typedef unsigned v2u __attribute__((ext_vector_type(2)));
typedef float f32x4 __attribute__((ext_vector_type(4)));
typedef float f32x16 __attribute__((ext_vector_type(16)));
typedef short bf16x8 __attribute__((ext_vector_type(8)));
typedef GAS unsigned gu32;
#define RLX_AGENT __ATOMIC_RELAXED, __HIP_MEMORY_SCOPE_AGENT
#define LDS_WAIT() asm volatile("s_waitcnt lgkmcnt(0)" ::: "memory")
#define VM_WAIT() asm volatile("s_waitcnt vmcnt(0)" ::: "memory")
__device__ __forceinline__ unsigned f2bf(float f) { unsigned u = __builtin_bit_cast(unsigned, f); return (u + 0x7fffu + ((u >> 16) & 1u)) >> 16; }
typedef __bf16 hwbf16x2_t __attribute__((ext_vector_type(2)));
typedef float hwf32x2_t __attribute__((ext_vector_type(2)));
__device__ __forceinline__ unsigned pk2(float lo, float hi) { const hwf32x2_t v = {lo, hi}; const hwbf16x2_t b = __builtin_convertvector(v, hwbf16x2_t); return __builtin_bit_cast(unsigned, b); }
__device__ __forceinline__ float bflo(unsigned w) { return __builtin_bit_cast(float, w << 16); }
__device__ __forceinline__ float bfhi(unsigned w) { return __builtin_bit_cast(float, w & 0xffff0000u); }
__device__ __forceinline__ float bf2f(bf16 h) { return __builtin_bit_cast(float, (unsigned)h << 16); }
__device__ __forceinline__ f32x16 mfma32(bf16x8 a, bf16x8 b, f32x16 c) { return __builtin_amdgcn_mfma_f32_32x32x16_bf16(a, b, c, 0, 0, 0); }
__device__ __forceinline__ f32x4 mfma16(bf16x8 a, bf16x8 b, f32x4 c) { return __builtin_amdgcn_mfma_f32_16x16x32_bf16(a, b, c, 0, 0, 0); }
__device__ __forceinline__ bf16x8 mk8(unsigned a, unsigned b, unsigned c, unsigned d) { v4u t = {a, b, c, d}; return __builtin_bit_cast(bf16x8, t); }
__device__ __forceinline__ float sigmoidf_(float x) { return __builtin_amdgcn_rcpf(1.0f + __builtin_amdgcn_exp2f(-1.4426950408889634f * x)); }
__device__ __forceinline__ float gelu_tanh(float x) {
    const float u2 = 1.5957691216057308f * (x + 0.044715f * x * x * x);
    return x * __builtin_amdgcn_rcpf(1.0f + __builtin_amdgcn_exp2f(-1.4426950408889634f * u2));
}
__device__ __forceinline__ float wave_sum(float v) {
#pragma unroll
    for (int o = 1; o < 64; o <<= 1) v += __shfl_xor(v, o);
    return v;
}

#define XB_TMO      128
#define XB_XCNT(j)  (256  + 64 * (j))
#define XB_XSUB(j)  (1280 + 64 * (j))
#define XB_XGEN(j)  (2304 + 64 * (j))
#define XB_TOP      3328
#define XB_TOPGEN   3392
#define XCD_BAR_WORDS 3456
#define XB_SPIN_CAP (1u << 22)

__device__ __forceinline__ unsigned xb_ld(unsigned* p)              { return __hip_atomic_load(p, __ATOMIC_RELAXED, __HIP_MEMORY_SCOPE_AGENT); }
__device__ __forceinline__ unsigned xb_add(unsigned* p, unsigned v) { return __hip_atomic_fetch_add(p, v, __ATOMIC_RELAXED, __HIP_MEMORY_SCOPE_AGENT); }
__device__ __forceinline__ unsigned xb_xcc_id() { return (unsigned)__builtin_amdgcn_s_getreg((3 << 11) | 20) & 0xFu; }
#define XB_SPIN(cond, bar) do { unsigned _sp = 0; while (cond) { __builtin_amdgcn_s_sleep(1); \
    if ((++_sp & 255u) == 0u) { if (xb_ld(&(bar)[XB_TMO])) break; if (_sp > XB_SPIN_CAP) { atomicAdd(&(bar)[XB_TMO], 1u); break; } } } } while (0)

struct XcdBarrier { unsigned* bar; unsigned x; volatile LAS unsigned* st; };

__device__ __forceinline__ XcdBarrier xcd_barrier_post(unsigned* bar, volatile LAS unsigned* st, bool tid0) {
    XcdBarrier b; b.bar = bar; b.x = xb_xcc_id(); b.st = st;
    if (tid0) (void)xb_add(&bar[XB_XCNT(b.x)], 1u);
    return b;
}
__device__ __forceinline__ void xcd_barrier_complete(unsigned* bar, unsigned x, unsigned& nloc, unsigned& nx) {
    const unsigned G = gridDim.x * gridDim.y * gridDim.z;
    unsigned sum, cnt, mine, sp = 0u;
    for (;;) {
        sum = 0u; cnt = 0u; mine = 0u;
#pragma unroll
        for (unsigned j = 0; j < 16; ++j) { const unsigned c = xb_ld(&bar[XB_XCNT(j)]); sum += c; cnt += (c > 0u) ? 1u : 0u; mine = (j == x) ? c : mine; }
        if (sum == G) break;
        __builtin_amdgcn_s_sleep(1);
        if ((++sp & 255u) == 0u) { if (xb_ld(&bar[XB_TMO])) break; if (sp > XB_SPIN_CAP) { atomicAdd(&bar[XB_TMO], 1u); break; } }
    }
    nloc = mine > 0u ? mine : 1u; nx = cnt > 0u ? cnt : 1u;
}
__device__ __forceinline__ void xcd_barrier(const XcdBarrier& b, int wave) {
    asm volatile("s_waitcnt vmcnt(0)" ::: "memory");
    __syncthreads();
    if (wave == 0 && pg8::hw_lane_id() == 0) {
        unsigned* bar = b.bar;
        __builtin_amdgcn_s_waitcnt(0);
        unsigned nloc = b.st[0], nx = b.st[1];
        if (nloc == 0u) { xcd_barrier_complete(bar, b.x, nloc, nx); b.st[0] = nloc; b.st[1] = nx; }
        const unsigned old = xb_add(&bar[XB_XSUB(b.x)], 1u);
        const unsigned gen = old / nloc;
        if (old + 1u == (gen + 1u) * nloc) {
            __builtin_amdgcn_fence(__ATOMIC_RELEASE, "agent");
            asm volatile("s_waitcnt vmcnt(0)" ::: "memory");
            const unsigned og = xb_add(&bar[XB_TOP], 1u);
            const unsigned tg = og / nx;
            if (og + 1u == (tg + 1u) * nx) xb_add(&bar[XB_TOPGEN], 1u);
            else XB_SPIN(xb_ld(&bar[XB_TOPGEN]) == tg, bar);
            __builtin_amdgcn_fence(__ATOMIC_ACQUIRE, "agent");
            xb_add(&bar[XB_XGEN(b.x)], 1u);
            asm volatile("s_waitcnt vmcnt(0)" ::: "memory");
        } else {
            XB_SPIN(xb_ld(&bar[XB_XGEN(b.x)]) == gen, bar);
            __builtin_amdgcn_fence(__ATOMIC_ACQUIRE, "agent");
            asm volatile("s_waitcnt vmcnt(0)" ::: "memory");
        }
    }
    __syncthreads();
}

__host__ __device__ __forceinline__ int frag32(int row, int k, int K) { return (((row >> 5) * (K >> 4) + (k >> 4)) * 64 + ((k >> 3) & 1) * 32 + (row & 31)) * 8 + (k & 7); }
__host__ __device__ __forceinline__ int frag16(int n, int k, int K) { return (((n >> 4) * (K >> 5) + (k >> 5)) * 64 + ((k >> 3) & 3) * 16 + (n & 15)) * 8 + (k & 7); }
struct Args { const void* in[26]; float* out; unsigned char* ws; int ph_lo, ph_hi; };
struct Ctx {
    LAS unsigned char* lds;
    int tid, lane, wave, vcu, G;
    __device__ __forceinline__ void refresh() { lane = pg8::hw_lane_id(); tid = wave * 64 + lane; }
};

template <class F> struct EpiT {
    static constexpr bool PERM = true, AFTER_DRAIN = false;
    F f;
    __device__ __forceinline__ void operator()(const f32x4 (&acc)[2][2][4][2], const pg8::Unit& u, int wr, int wc, int fr, int fq) const {
        const int row0 = u.pm * 256 + wr * 64 + fr, col0 = u.pn * 256 + wc * 32 + 8 * fq;
        typename F::L cur[2], nxt[2];
        f.load(row0, col0, cur[0]); f.load(row0, col0 + 128, cur[1]);
#pragma unroll
        for (int i = 0; i < 8; ++i) {
            const int ai = i >> 2, m = i & 3, row = row0 + ai * 128 + m * 16;
            if (i < 7) { const int rown = row0 + ((i + 1) >> 2) * 128 + ((i + 1) & 3) * 16; f.load(rown, col0, nxt[0]); f.load(rown, col0 + 128, nxt[1]); }
            __builtin_amdgcn_sched_barrier(0);
            f.apply(row, col0, acc[ai][0][m][0], acc[ai][0][m][1], cur[0]); f.apply(row, col0 + 128, acc[ai][1][m][0], acc[ai][1][m][1], cur[1]);
            __builtin_amdgcn_sched_barrier(0);
            cur[0] = nxt[0]; cur[1] = nxt[1];
        }
    }
};
__device__ __forceinline__ v4u pack8(f32x4 a, f32x4 b) { v4u w; w.x = pk2(a[0], a[1]); w.y = pk2(a[2], a[3]); w.z = pk2(b[0], b[1]); w.w = pk2(b[2], b[3]); return w; }
struct LNone {};
struct FStore { typedef LNone L; bf16* O; int ldc;
    __device__ __forceinline__ void load(int, int, L&) const {}
    __device__ __forceinline__ void apply(int row, int col, f32x4 v0, f32x4 v1, const L&) const { *(v4u*)(O + (size_t)row * ldc + col) = pack8(v0, v1); } };
struct FKvm { typedef LNone L; bf16* KM; bf16* VT;
    __device__ __forceinline__ void load(int, int, L&) const {}
    __device__ __forceinline__ void apply(int row, int col, f32x4 v0, f32x4 v1, const L&) const {
        const int b = row >> 8, m = row & 255;
        if (col < 256) { const int hm = col >> 6, d0 = col & 63; *(v4u*)(KM + (size_t)(b * 4 + hm) * 16384 + frag32(m, d0, 64)) = pack8(v0, v1); }
        else { const int c = col - 256, hm = c >> 6, e0 = c & 63, mt = m >> 5, s2 = (m >> 4) & 1, w = m & 15, hh = (w >> 2) & 1, j = ((w >> 3) << 2) | (w & 3);
            bf16* p = VT + (size_t)(b * 4 + hm) * 16384 + ((mt * 2 + s2) * 64 + hh * 32) * 8 + j;
#pragma unroll
            for (int jj = 0; jj < 8; ++jj) { const int e = e0 + jj; p[((e >> 5) * 16 * 64 + (e & 31)) * 8] = (bf16)f2bf(jj < 4 ? v0[jj] : v1[jj - 4]); } }
    } };
struct FSig { typedef LNone L; bf16* O; int ldc;
    __device__ __forceinline__ void load(int, int, L&) const {}
    __device__ __forceinline__ void apply(int row, int col, f32x4 v0, f32x4 v1, const L&) const {
#pragma unroll
        for (int j = 0; j < 4; ++j) { v0[j] = sigmoidf_(v0[j]); v1[j] = sigmoidf_(v1[j]); }
        *(v4u*)(O + (size_t)row * ldc + col) = pack8(v0, v1); } };
struct FGlu { typedef LNone L; bf16* O;
    __device__ __forceinline__ void load(int, int, L&) const {}
    __device__ __forceinline__ void apply(int row, int col, f32x4 v0, f32x4 v1, const L&) const {
        v2u w; w.x = pk2(v0[0] * sigmoidf_(v1[0]), v0[1] * sigmoidf_(v1[1])); w.y = pk2(v0[2] * sigmoidf_(v1[2]), v0[3] * sigmoidf_(v1[3]));
        *(v2u*)(O + (size_t)row * 256 + (col >> 1)) = w; } };
struct LBranch { v4u g; v4u m; };
template <int MODE> struct FBranch { typedef LBranch L; const bf16* Gt; int goff; bf16* MF; bf16* MB;
    __device__ __forceinline__ void load(int row, int col, L& l) const {
        l.g = *(const v4u*)(Gt + (size_t)row * NGATE + goff + col);
        if (MODE >= 1) l.m = *(const v4u*)(MF + (size_t)row * DM + col); }
    __device__ __forceinline__ void apply(int row, int col, f32x4 v0, f32x4 v1, const L& l) const {
        const v4u g = l.g;
        v0[0] *= bflo(g.x); v0[1] *= bfhi(g.x); v0[2] *= bflo(g.y); v0[3] *= bfhi(g.y);
        v1[0] *= bflo(g.z); v1[1] *= bfhi(g.z); v1[2] *= bflo(g.w); v1[3] *= bfhi(g.w);
        if (MODE >= 1) { const v4u m = l.m; v0[0] += bflo(m.x); v0[1] += bfhi(m.x); v0[2] += bflo(m.y); v0[3] += bfhi(m.y); v1[0] += bflo(m.z); v1[1] += bfhi(m.z); v1[2] += bflo(m.w); v1[3] += bfhi(m.w); }
        *(v4u*)((MODE <= 1 ? MF : MB) + (size_t)row * DM + col) = pack8(v0, v1); } };
struct LRes { f32x4 x0, x1; };
struct FRes { typedef LRes L; const float* X; bf16* HB; float* SS;
    __device__ __forceinline__ void load(int row, int col, L& l) const { const float* xp = X + (size_t)row * DM + col; l.x0 = *(const f32x4*)xp; l.x1 = *(const f32x4*)(xp + 4); }
    __device__ __forceinline__ void apply(int row, int col, f32x4 v0, f32x4 v1, const L& l) const {
        v0 += l.x0; v1 += l.x1;
        *(v4u*)(HB + (size_t)row * DM + col) = pack8(v0, v1);
        float q = (v0[0] * v0[0] + v0[1] * v0[1]) + (v0[2] * v0[2] + v0[3] * v0[3]) + (v1[0] * v1[0] + v1[1] * v1[1]) + (v1[2] * v1[2] + v1[3] * v1[3]);
        q += __shfl_xor(q, 16); q += __shfl_xor(q, 32);
        if (pg8::hw_lane_id() < 16) atomicAdd(SS + row, q); } };
struct LRstd { float ss; };
struct FStoreRstd { typedef LRstd L; bf16* O; int ldc; const float* SS;
    __device__ __forceinline__ void load(int row, int, L& l) const { l.ss = SS[row]; }
    __device__ __forceinline__ void apply(int row, int col, f32x4 v0, f32x4 v1, const L& l) const {
        const float rs = __builtin_amdgcn_rsqf(l.ss * (1.f / DM) + EPS); *(v4u*)(O + (size_t)row * ldc + col) = pack8(v0 * rs, v1 * rs); } };

template <class F>
__device__ __forceinline__ void run_gemm(const Ctx& C, const bf16* A, const bf16* Bt, int M, int N, int K, const F& f) {
    pg8::Gemm g{A, Bt, M, N, K}; pg8::StaticOrder S; S.init(M, N, C.G, (int)blockIdx.x);
    EpiT<F> E{f};
    pg8::gemm_phase<EpiT<F>, pg8::StaticOrder, true, true>(C.lds, g, S, E, C.wave);
}

template <class F>
__device__ __forceinline__ void run_gemm_mx(const Ctx& C, const unsigned char* A8, const unsigned char* Bt8, int M, int N, int Kbytes, const F& f, int sclA, int sclB) {
    pg8::Gemm g{(const bf16*)A8, (const bf16*)Bt8, M, N, Kbytes / 2}; pg8::StaticOrder S; S.init(M, N, C.G, (int)blockIdx.x);
    EpiT<F> E{f};
    pg8::gemm_phase<EpiT<F>, pg8::StaticOrder, true, true, true>(C.lds, g, S, E, C.wave, sclA, sclB);
}

template <bool GLU>
__device__ __forceinline__ void p0_transpose_item(const float* W, int K, int N, bf16* WT, LAS float* scr, int item, int lane, const float* kscale = nullptr) {
    const int nblk = N / 32, kb = item / nblk, nb = item % nblk, k0 = 64 * kb, n0 = 32 * nb;
#pragma unroll 8
    for (int i = 0; i < 32; ++i) { const int kk = 2 * i + (lane >> 5); float w = W[(size_t)(k0 + kk) * N + n0 + (lane & 31)]; if (kscale) w *= kscale[k0 + kk]; scr[kk * 33 + (lane & 31)] = w; }
    LDS_WAIT(); asm volatile("" ::: "memory");
    const int c = lane & 7;
#pragma unroll
    for (int j = 0; j < 4; ++j) { const int n = (lane >> 3) + 8 * j; const LAS float* s = scr + (8 * c) * 33 + n;
        v4u o; o.x = pk2(s[0 * 33], s[1 * 33]); o.y = pk2(s[2 * 33], s[3 * 33]); o.z = pk2(s[4 * 33], s[5 * 33]); o.w = pk2(s[6 * 33], s[7 * 33]);
        const int nn = n0 + n; int row = nn;
        if (GLU) { const int jc = nn & 255, gate = nn >> 8; row = 8 * (jc >> 2) + 4 * gate + (jc & 3); }
        *(GAS v4u*)(WT + (size_t)row * K + k0 + 8 * c) = o; }
    LDS_WAIT(); asm volatile("" ::: "memory");
}
__device__ __forceinline__ void p0_transpose_item_fp8(const float* W, int K, int N, unsigned char* WT8, int nsub, LAS float* scr, int item, int lane, float scale) {
    const int nblk = N / 32, kb = item / nblk, nb = item % nblk, k0 = 64 * kb, n0 = 32 * nb;
#pragma unroll 8
    for (int i = 0; i < 32; ++i) { const int kk = 2 * i + (lane >> 5); scr[kk * 33 + (lane & 31)] = W[(size_t)(k0 + kk) * N + n0 + (lane & 31)] * scale; }
    LDS_WAIT(); asm volatile("" ::: "memory");
    const int c = lane & 7;
#pragma unroll
    for (int j = 0; j < 4; ++j) { const int n = (lane >> 3) + 8 * j; const LAS float* sp = scr + (8 * c) * 33 + n;
        int p0 = __builtin_amdgcn_cvt_pk_fp8_f32(sp[0 * 33], sp[1 * 33], 0, false); p0 = __builtin_amdgcn_cvt_pk_fp8_f32(sp[2 * 33], sp[3 * 33], p0, true);
        int p1 = __builtin_amdgcn_cvt_pk_fp8_f32(sp[4 * 33], sp[5 * 33], 0, false); p1 = __builtin_amdgcn_cvt_pk_fp8_f32(sp[6 * 33], sp[7 * 33], p1, true);
        v2u o; o.x = (unsigned)p0; o.y = (unsigned)p1;
        *(GAS v2u*)(WT8 + (size_t)(n0 + n - nsub) * K + k0 + 8 * c) = o; }
    LDS_WAIT(); asm volatile("" ::: "memory");
}
template <int NR>
__device__ __forceinline__ void rms_rows_to_bf16(const float* xbase, const float* gain, bf16* obase, int m0, int mstep, int lane, unsigned char* o8base = nullptr) {
    f32x4 v[NR][4]; float s[NR];
#pragma unroll
    for (int i = 0; i < NR; ++i) { const f32x4* xr = (const f32x4*)(xbase + (size_t)(m0 + i * mstep) * DM) + lane; s[i] = 0.f;
#pragma unroll
        for (int j = 0; j < 4; ++j) v[i][j] = xr[64 * j]; }
#pragma unroll
    for (int i = 0; i < NR; ++i)
#pragma unroll
        for (int j = 0; j < 4; ++j) s[i] += (v[i][j].x * v[i][j].x + v[i][j].y * v[i][j].y) + (v[i][j].z * v[i][j].z + v[i][j].w * v[i][j].w);
#pragma unroll
    for (int o = 1; o < 64; o <<= 1)
#pragma unroll
        for (int i = 0; i < NR; ++i) s[i] += __shfl_xor(s[i], o);
    const f32x4* gr = (const f32x4*)gain + lane;
    f32x4 g[4];
#pragma unroll
    for (int j = 0; j < 4; ++j) g[j] = gr[64 * j];
#pragma unroll
    for (int i = 0; i < NR; ++i) { const float rstd = 1.0f / sqrtf(s[i] * (1.f / DM) + EPS);
        unsigned long long* o8 = (unsigned long long*)(obase + (size_t)(m0 + i * mstep) * DM) + lane;
#pragma unroll
        for (int j = 0; j < 4; ++j) { const float y0 = v[i][j].x * rstd * g[j].x, y1 = v[i][j].y * rstd * g[j].y, y2 = v[i][j].z * rstd * g[j].z, y3 = v[i][j].w * rstd * g[j].w;
            o8[64 * j] = (unsigned long long)pk2(y0, y1) | ((unsigned long long)pk2(y2, y3) << 32);
            if (o8base) { int p = __builtin_amdgcn_cvt_pk_fp8_f32(y0 * 16.f, y1 * 16.f, 0, false); p = __builtin_amdgcn_cvt_pk_fp8_f32(y2 * 16.f, y3 * 16.f, p, true);
                *(unsigned*)(o8base + (size_t)(m0 + i * mstep) * DM + 256 * j + 4 * lane) = (unsigned)p; } } }
}

__device__ __forceinline__ void p0_s5_group(const Ctx& C, const Args& a, int g, int part) {
    const float* a_re = (const float*)a.in[7]; const float* a_im = (const float*)a.in[8]; const float* log_dt = (const float*)a.in[9];
    const float* b_re = (const float*)a.in[10]; const float* b_im = (const float*)a.in[11]; const float* c_re = (const float*)a.in[12]; const float* c_im = (const float*)a.in[13];
    LAS float* L = (LAS float*)C.lds;
    LAS float* lpr = L;
    LAS float* lpi = L + 640;
    LAS float* bbr = L + 1280;
    LAS float* bbi = bbr + 1024;
    LAS float* ccr = bbi + 1024;
    LAS float* cci = ccr + 1024;
    LAS float* Kj = cci + 1024;
    const int tid = C.tid;
    bf16* T8T = (bf16*)(a.ws + WS_S5MAT) + (size_t)g * 16384;
    bf16* PMT = (bf16*)(a.ws + WS_S5MAT) + (size_t)(16 + g) * 16384;
    bf16* QMT = (bf16*)(a.ws + WS_S5MAT) + (size_t)(32 + g) * 16384;
    float* L8 = (float*)(a.ws + WS_S5C) + (size_t)g * 128;
    float* L128 = (float*)(a.ws + WS_S5C) + 2048 + (size_t)g * 128;
    for (int i = tid; i < 640; i += 512) {
        const int j10 = i >> 6, p = i & 63; const double jj = (j10 < 9) ? (double)j10 : 128.0;
        const double dt = exp((double)log_dt[g]);
        const double ar = (double)a_re[g * 64 + p], ai = (double)a_im[g * 64 + p];
        const double mag = exp(ar * dt * jj), ang = ai * dt * jj;
        lpr[i] = (float)(mag * cos(ang)); lpi[i] = (float)(mag * sin(ang));
    }
    for (int i = tid; i < 1024; i += 512) { ccr[i] = c_re[g * 1024 + i]; cci[i] = c_im[g * 1024 + i]; }
    __syncthreads();
    if (part == 0 && tid < 64) { L8[tid * 2] = lpr[8 * 64 + tid]; L8[tid * 2 + 1] = lpi[8 * 64 + tid]; L128[tid * 2] = lpr[9 * 64 + tid]; L128[tid * 2 + 1] = lpi[9 * 64 + tid]; }
    for (int i = tid; i < 1024; i += 512) {
        const int p = i >> 4, h = i & 15;
        const float ar = a_re[g * 64 + p], ai = a_im[g * 64 + p], lr = lpr[64 + p], li = lpi[64 + p];
        const float den = ar * ar + ai * ai, nr = lr - 1.0f, ni = li;
        const float cr = (nr * ar + ni * ai) / den, ci = (ni * ar - nr * ai) / den;
        const float br = b_re[(g * 64 + p) * 16 + h], bi = b_im[(g * 64 + p) * 16 + h];
        bbr[i] = cr * br - ci * bi; bbi[i] = cr * bi + ci * br;
    }
    __syncthreads();
    for (int i = tid; i < 2048; i += 512) {
        const int j = i >> 8, ho = (i >> 4) & 15, hi = i & 15; float sacc = 0.f;
        for (int p = 0; p < 64; ++p) { const float cr_ = ccr[ho * 64 + p], ci_ = cci[ho * 64 + p], lr_ = lpr[j * 64 + p], li_ = lpi[j * 64 + p];
            const float mr = cr_ * lr_ - ci_ * li_, mi = cr_ * li_ + ci_ * lr_;
            sacc += mr * bbr[p * 16 + hi] - mi * bbi[p * 16 + hi]; }
        Kj[i] = sacc;
    }
    __syncthreads();
    for (int i = part * 1024 + tid; i < (part + 1) * 1024; i += 512) {
        const int n = i >> 7, k = i & 127;
        { const int t = n >> 4, ho = n & 15, sx = k >> 4, hi = k & 15; const float v = (sx <= t) ? Kj[((t - sx) * 16 + ho) * 16 + hi] : 0.f; T8T[frag16(n, k, 128)] = (bf16)f2bf(v); }
        { const int p = n & 63, im = n >> 6, sx = k >> 4, hi = k & 15; const float lr_ = lpr[(7 - sx) * 64 + p], li_ = lpi[(7 - sx) * 64 + p], br_ = bbr[p * 16 + hi], bi_ = bbi[p * 16 + hi];
          const float v = im ? (lr_ * bi_ + li_ * br_) : (lr_ * br_ - li_ * bi_); PMT[frag16(n, k, 128)] = (bf16)f2bf(v); }
        { const int t = n >> 4, ho = n & 15, p = k & 63, pt = k >> 6; const float cr_ = ccr[ho * 64 + p], ci_ = cci[ho * 64 + p], lr_ = lpr[(t + 1) * 64 + p], li_ = lpi[(t + 1) * 64 + p];
          const float v = pt ? -(cr_ * li_ + ci_ * lr_) : (cr_ * lr_ - ci_ * li_); QMT[frag16(n, k, 128)] = (bf16)f2bf(v); }
    }
    __syncthreads();
}

__device__ __forceinline__ void p0_prologue(const Ctx& C, const Args& a) {
    p0_s5_group(C, a, C.vcu & 15, C.vcu >> 4);
    LAS float* scr = (LAS float*)(C.lds + C.wave * 16384);
    const int gw = C.vcu * NWAVES + C.wave, NGW = C.G * NWAVES;
    const int gt = C.vcu * 512 + C.tid, NGT = C.G * 512;
    unsigned char* ws = a.ws;
    for (int i = gt; i < MTOK; i += NGT) ((float*)(ws + WS_SS))[i] = 0.f;
    constexpr int I_IN = 16 * 176, I_Q = 16 * 64, I_O = 16 * 32, I_BR = 8 * 32, I_BS = 4 * 32, I_BM = 4 * 32, I_KV = 16 * 16, I_GLU = 4 * 16;
    constexpr int NITEMS = I_IN + I_Q + I_O + I_BR + I_BS + I_BM + I_KV + I_GLU;
    for (int it = gw; it < NITEMS; it += NGW) {
        int r = it;
        if (r < I_IN) { if ((r % 176) < 80) p0_transpose_item<false>((const float*)a.in[4], 1024, 5632, (bf16*)(ws + WS_WIN_T), scr, r, C.lane);
                        else p0_transpose_item_fp8((const float*)a.in[4], 1024, 5632, ws + WS_WG8, NZ1, scr, r, C.lane, 256.f); continue; } r -= I_IN;
        if (r < I_Q) { p0_transpose_item<false>((const float*)a.in[21], 1024, 2048, (bf16*)(ws + WS_WQ_T), scr, r, C.lane, (const float*)a.in[20]); continue; } r -= I_Q;
        if (r < I_O) { p0_transpose_item<false>((const float*)a.in[19], 1024, 1024, (bf16*)(ws + WS_WOUT_T), scr, r, C.lane); continue; } r -= I_O;
        if (r < I_BR) { p0_transpose_item<false>((const float*)a.in[16], 512, 1024, (bf16*)(ws + WS_WBR_T), scr, r, C.lane); continue; } r -= I_BR;
        if (r < I_BS) { p0_transpose_item<false>((const float*)a.in[17], 256, 1024, (bf16*)(ws + WS_WBS_T), scr, r, C.lane); continue; } r -= I_BS;
        if (r < I_BM) { p0_transpose_item<false>((const float*)a.in[18], 256, 1024, (bf16*)(ws + WS_WBM_T), scr, r, C.lane); continue; } r -= I_BM;
        if (r < I_KV) { p0_transpose_item<false>((const float*)a.in[6], 1024, 512, (bf16*)(ws + WS_WMKV_T), scr, r, C.lane); continue; } r -= I_KV;
        p0_transpose_item<true>((const float*)a.in[15], 256, 512, (bf16*)(ws + WS_WGLU_T), scr, r, C.lane);
    }
    for (int i = gt; i < 16 * 128 * 128 / 8; i += NGT) { const f32x4 x0 = ((const f32x4*)a.in[22])[2 * (size_t)i], x1 = ((const f32x4*)a.in[22])[2 * (size_t)i + 1];
        const int hc = i >> 11, n = (i >> 4) & 127, d0 = (i & 15) * 8; *(v4u*)((bf16*)(ws + WS_KEYS) + hc * 16384 + frag32(n, d0, 128)) = pack8(x0, x1); }
    for (int rw0 = gw; rw0 < 2 * 16384; rw0 += 4 * NGW) {
        f32x4 v[4][4]; float mx[4];
#pragma unroll
        for (int i = 0; i < 4; ++i) { const int rw = rw0 + i * NGW, t = rw >> 14, row = rw & 16383;
            const float* src = (const float*)a.in[23 + t] + (size_t)row * DM + C.lane * 4; mx[i] = 0.f;
#pragma unroll
            for (int q = 0; q < 4; ++q) { v[i][q] = *(const f32x4*)(src + 256 * q); if (t == 0) v[i][q] = v[i][q] * *(const f32x4*)((const float*)a.in[20] + C.lane * 4 + 256 * q); } }
#pragma unroll
        for (int i = 0; i < 4; ++i)
#pragma unroll
            for (int q = 0; q < 4; ++q) mx[i] = fmaxf(mx[i], fmaxf(fmaxf(fabsf(v[i][q][0]), fabsf(v[i][q][1])), fmaxf(fabsf(v[i][q][2]), fabsf(v[i][q][3]))));
#pragma unroll
        for (int o = 1; o < 64; o <<= 1)
#pragma unroll
            for (int i = 0; i < 4; ++i) mx[i] = fmaxf(mx[i], __shfl_xor(mx[i], o));
#pragma unroll
        for (int i = 0; i < 4; ++i) { const int rw = rw0 + i * NGW, t = rw >> 14, row = rw & 16383;
            int ex = (int)((__builtin_bit_cast(unsigned, mx[i]) >> 23) & 0xffu) - 127;
            if (mx[i] < 1e-30f) ex = 7;
            const float sc = __builtin_bit_cast(float, (unsigned)(127 + 7 - ex) << 23), isc = __builtin_bit_cast(float, (unsigned)(127 - 7 + ex) << 23);
            unsigned char* dst = ws + (t ? WS_PV : WS_PU) + (size_t)row * 128 + ((C.lane * 4) & 127);
#pragma unroll
            for (int q = 0; q < 4; ++q) { int p = __builtin_amdgcn_cvt_pk_fp8_f32(v[i][q][0] * sc, v[i][q][1] * sc, 0, false); p = __builtin_amdgcn_cvt_pk_fp8_f32(v[i][q][2] * sc, v[i][q][3] * sc, p, true);
                *(unsigned*)(dst + (size_t)(2 * q + (C.lane >> 5)) * (16384 * 128)) = (unsigned)p; }
            if (C.lane == 0) ((float*)(ws + WS_PSC))[t * 16384 + row] = isc; }
    }
    for (int m = gw; m < MTOK; m += 4 * NGW) rms_rows_to_bf16<4>((const float*)a.in[0], (const float*)a.in[3], (bf16*)(ws + WS_A), m, NGW, C.lane, ws + WS_XN8);
    for (int m = gw; m < MROWS; m += NGW) rms_rows_to_bf16<1>((const float*)a.in[1], (const float*)a.in[5], (bf16*)(ws + WS_MEMN), m, NGW, C.lane);
    {
        const int* pos = (const int*)a.in[2]; float* rope = (float*)(ws + WS_ROPE);
        const int j = C.tid & 63;
        const double invrev = exp(-(double)j * (9.210340371976184 / 64.0)) * 0.15915494309189535;
        for (int i = gt; i < MTOK * 64; i += NGT) { const int tok = i >> 6;
            double rv = (double)pos[tok] * invrev; rv -= rint(rv);
            const float rf = (float)rv;
            rope[(size_t)tok * 128 + j] = __builtin_amdgcn_cosf(rf); rope[(size_t)tok * 128 + 64 + j] = __builtin_amdgcn_sinf(rf); }
    }
}

constexpr int LP = 136;
__device__ __forceinline__ float lg2_gamma(int h) { return log2f(1.0f - exp2f(-5.0f - (float)h)); }

__device__ __forceinline__ void r1_unit(const Ctx& C, const Args& a, int tile, int h) {
    const bf16* Z1 = (const bf16*)(a.ws + WS_Z1); const float* ROPE = (const float*)(a.ws + WS_ROPE);
    LAS bf16* Qs = (LAS bf16*)C.lds; LAS bf16* Ks = Qs + 128 * LP; LAS bf16* Kt = Ks + 128 * LP; LAS bf16* Vt = Kt + 128 * LP;
    const int tid = C.tid, lane = C.lane, t0 = tile * 128, u = tile * 4 + h;
    const float lg2g = lg2_gamma(h);
    {
        const int i = tid >> 2, dq = (tid & 3) * 16;
        const bf16* zr = Z1 + (size_t)(t0 + i) * NZ1; const float* rp = ROPE + (size_t)(t0 + i) * 128;
        float cs[16], sn[16];
#pragma unroll
        for (int q = 0; q < 4; ++q) { const f32x4 c4 = *(const f32x4*)(rp + dq + 4 * q), s4 = *(const f32x4*)(rp + 64 + dq + 4 * q);
#pragma unroll
            for (int e = 0; e < 4; ++e) { cs[4 * q + e] = c4[e]; sn[4 * q + e] = s4[e]; } }
        const float kdec = __builtin_amdgcn_exp2f((float)(127 - i) * lg2g) , ksc = 0.08838834764831845f;
#pragma unroll
        for (int which = 0; which < 2; ++which) {
            const bf16* src = zr + (which ? ZK : ZQ) + h * 128;
            const v4u a0 = *(const v4u*)(src + dq), a1 = *(const v4u*)(src + dq + 8), b0 = *(const v4u*)(src + 64 + dq), b1 = *(const v4u*)(src + 64 + dq + 8);
            const unsigned aw[8] = {a0.x, a0.y, a0.z, a0.w, a1.x, a1.y, a1.z, a1.w}, bw[8] = {b0.x, b0.y, b0.z, b0.w, b1.x, b1.y, b1.z, b1.w};
            float y1[16], y2[16];
#pragma unroll
            for (int w = 0; w < 8; ++w) {
                const float x1l = bflo(aw[w]), x1h = bfhi(aw[w]), x2l = bflo(bw[w]), x2h = bfhi(bw[w]);
                y1[2 * w] = x1l * cs[2 * w] - x2l * sn[2 * w]; y2[2 * w] = x1l * sn[2 * w] + x2l * cs[2 * w];
                y1[2 * w + 1] = x1h * cs[2 * w + 1] - x2h * sn[2 * w + 1]; y2[2 * w + 1] = x1h * sn[2 * w + 1] + x2h * cs[2 * w + 1];
            }
            if (which) {
#pragma unroll
                for (int e = 0; e < 16; ++e) { y1[e] *= ksc; y2[e] *= ksc; }
            }
            LAS bf16* dstp = (which ? Ks : Qs) + i * LP;
            v4u o;
            o.x = pk2(y1[0], y1[1]); o.y = pk2(y1[2], y1[3]); o.z = pk2(y1[4], y1[5]); o.w = pk2(y1[6], y1[7]); *(LAS v4u*)(dstp + dq) = o;
            o.x = pk2(y1[8], y1[9]); o.y = pk2(y1[10], y1[11]); o.z = pk2(y1[12], y1[13]); o.w = pk2(y1[14], y1[15]); *(LAS v4u*)(dstp + dq + 8) = o;
            o.x = pk2(y2[0], y2[1]); o.y = pk2(y2[2], y2[3]); o.z = pk2(y2[4], y2[5]); o.w = pk2(y2[6], y2[7]); *(LAS v4u*)(dstp + 64 + dq) = o;
            o.x = pk2(y2[8], y2[9]); o.y = pk2(y2[10], y2[11]); o.z = pk2(y2[12], y2[13]); o.w = pk2(y2[14], y2[15]); *(LAS v4u*)(dstp + 64 + dq + 8) = o;
            if (which) {
#pragma unroll
                for (int e = 0; e < 16; ++e) { Kt[(dq + e) * LP + i] = (bf16)f2bf(y1[e] * kdec); Kt[(64 + dq + e) * LP + i] = (bf16)f2bf(y2[e] * kdec); }
            }
            __builtin_amdgcn_sched_barrier(0);
        }
        {
            const int eq = (tid & 3) * 32; const bf16* vs = zr + ZV + h * 128 + eq;
#pragma unroll
            for (int q = 0; q < 4; ++q) { const v4u v = *(const v4u*)(vs + 8 * q); const unsigned vw[4] = {v.x, v.y, v.z, v.w};
#pragma unroll
                for (int w = 0; w < 4; ++w) { Vt[(eq + 8 * q + 2 * w) * LP + i] = (bf16)(vw[w] & 0xffffu); Vt[(eq + 8 * q + 2 * w + 1) * LP + i] = (bf16)(vw[w] >> 16); } }
        }
    }
    __syncthreads();
    const int r = lane & 31, hh = lane >> 5;
    if (C.wave < 4) {
        const int ib = C.wave;
        bf16x8 bq[8];
#pragma unroll
        for (int ks = 0; ks < 8; ++ks) bq[ks] = *(const LAS bf16x8*)(Qs + (ib * 32 + r) * LP + ks * 16 + 8 * hh);
        f32x16 accO[4];
#pragma unroll
        for (int et = 0; et < 4; ++et)
#pragma unroll
            for (int e = 0; e < 16; ++e) accO[et][e] = 0.f;
        const int i = ib * 32 + r;
#pragma unroll
        for (int jt = 0; jt < 4; ++jt) {
            if (jt <= ib) {
                f32x16 s;
#pragma unroll
                for (int e = 0; e < 16; ++e) s[e] = 0.f;
#pragma unroll
                for (int ks = 0; ks < 8; ++ks) { const bf16x8 ak = *(const LAS bf16x8*)(Ks + (jt * 32 + r) * LP + ks * 16 + 8 * hh); s = mfma32(ak, bq[ks], s); }
                unsigned pk[8];
#pragma unroll
                for (int q = 0; q < 8; ++q) {
                    const int ra = 2 * q, rb = 2 * q + 1;
                    const int ja = jt * 32 + (ra & 3) + 8 * (ra >> 2) + 4 * hh, jb = jt * 32 + (rb & 3) + 8 * (rb >> 2) + 4 * hh;
                    const float va = (i >= ja) ? s[ra] * __builtin_amdgcn_exp2f((float)(i - ja) * lg2g) : 0.f;
                    const float vb = (i >= jb) ? s[rb] * __builtin_amdgcn_exp2f((float)(i - jb) * lg2g) : 0.f;
                    pk[q] = pk2(va, vb);
                }
#pragma unroll
                for (int sft = 0; sft < 2; ++sft) {
                    const bf16x8 pb = mk8(pk[4 * sft], pk[4 * sft + 1], pk[4 * sft + 2], pk[4 * sft + 3]);
#pragma unroll
                    for (int et = 0; et < 4; ++et) {
                        const LAS bf16* vp = Vt + (et * 32 + r) * LP + jt * 32 + 16 * sft + 4 * hh;
                        const v2u lo = *(const LAS v2u*)vp, hi = *(const LAS v2u*)(vp + 8);
                        accO[et] = mfma32(mk8(lo.x, lo.y, hi.x, hi.y), pb, accO[et]);
                    }
                }
            }
            __builtin_amdgcn_sched_barrier(0);
        }
        unsigned* INN = (unsigned*)(a.ws + WS_INNER) + ((size_t)(u * 4 + ib) * 32) * 64 + lane;
#pragma unroll
        for (int et = 0; et < 4; ++et)
#pragma unroll
            for (int q = 0; q < 8; ++q) INN[(et * 8 + q) * 64] = pk2(accO[et][2 * q], accO[et][2 * q + 1]);
    } else {
        const int et = C.wave - 4;
        f32x16 acc[4];
#pragma unroll
        for (int dt = 0; dt < 4; ++dt)
#pragma unroll
            for (int e = 0; e < 16; ++e) acc[dt][e] = 0.f;
#pragma unroll
        for (int ks = 0; ks < 8; ++ks) {
            const bf16x8 av = *(const LAS bf16x8*)(Vt + (et * 32 + r) * LP + ks * 16 + 8 * hh);
#pragma unroll
            for (int dt = 0; dt < 4; ++dt) { const bf16x8 bk = *(const LAS bf16x8*)(Kt + (dt * 32 + r) * LP + ks * 16 + 8 * hh); acc[dt] = mfma32(av, bk, acc[dt]); }
            __builtin_amdgcn_sched_barrier(0);
        }
        float* KVb = a.out + (size_t)u * 16384 + (size_t)(et * 32 + 4 * hh) * 128 + r;
#pragma unroll
        for (int dt = 0; dt < 4; ++dt) {
#pragma unroll
            for (int e = 0; e < 16; ++e) KVb[((e & 3) + 8 * (e >> 2)) * 128 + dt * 32] = acc[dt][e];
            __builtin_amdgcn_sched_barrier(0);
        }
    }
    __syncthreads();
}

__device__ __forceinline__ void s5_compute_E(const Args& a, int tile, int g, int lane, LAS float* Es, bf16x8 (&au)[4]) {
    const bf16* Z1 = (const bf16*)(a.ws + WS_Z1); const bf16* PMT = (const bf16*)(a.ws + WS_S5MAT) + (size_t)(16 + g) * 16384;
    const int r16 = lane & 15, q4 = lane >> 4;
#pragma unroll
    for (int ks = 0; ks < 4; ++ks) { const int s = 2 * ks + (q4 >> 1);
        au[ks] = *(const bf16x8*)(Z1 + (size_t)(tile * 128 + 8 * r16 + s) * NZ1 + ZU + g * 16 + 8 * (q4 & 1)); }
    bf16x8 bc[4], bn[4];
#pragma unroll
    for (int ks = 0; ks < 4; ++ks) bc[ks] = *(const bf16x8*)(PMT + (ks * 64 + lane) * 8);
#pragma unroll 1
    for (int nb = 0; nb < 8; ++nb) {
        const int nbn = min(nb + 1, 7);
#pragma unroll
        for (int ks = 0; ks < 4; ++ks) bn[ks] = *(const bf16x8*)(PMT + ((nbn * 4 + ks) * 64 + lane) * 8);
        __builtin_amdgcn_sched_barrier(0);
        f32x4 acc = {0.f, 0.f, 0.f, 0.f};
#pragma unroll
        for (int ks = 0; ks < 4; ++ks) acc = mfma16(au[ks], bc[ks], acc);
#pragma unroll
        for (int i4 = 0; i4 < 4; ++i4) Es[(q4 * 4 + i4) * 128 + nb * 16 + r16] = acc[i4];
        __builtin_amdgcn_sched_barrier(0);
#pragma unroll
        for (int ks = 0; ks < 4; ++ks) bc[ks] = bn[ks];
    }
    LDS_WAIT(); asm volatile("" ::: "memory");
}
__device__ __forceinline__ void s5a_wave(const Ctx& C, const Args& a, int tile, int g) {
    LAS float* Es = (LAS float*)(C.lds + C.wave * 16384);
    bf16x8 au[4];
    s5_compute_E(a, tile, g, C.lane, Es, au);
    const float* L8 = (const float*)(a.ws + WS_S5C) + (size_t)g * 128;
    const float l8r = L8[C.lane * 2], l8i = L8[C.lane * 2 + 1];
    float sr = 0.f, si = 0.f;
#pragma unroll
    for (int c = 0; c < 16; ++c) { const float er = Es[c * 128 + C.lane], ei = Es[c * 128 + 64 + C.lane];
        const float nr = l8r * sr - l8i * si + er, ni = l8r * si + l8i * sr + ei; sr = nr; si = ni; }
    float* E = (float*)(a.ws + WS_S5E) + ((size_t)tile * 16 + g) * 128;
    E[C.lane] = sr; E[64 + C.lane] = si;
    LDS_WAIT(); asm volatile("" ::: "memory");
}
__device__ __forceinline__ void s5c_wave(const Ctx& C, const Args& a, int tile, int g) {
    LAS float* Es = (LAS float*)(C.lds + C.wave * 16384);
    LAS bf16* Sv = (LAS bf16*)(C.lds + C.wave * 16384 + 8192);
    const int lane = C.lane, r16 = lane & 15, q4 = lane >> 4;
    bf16x8 au[4];
    s5_compute_E(a, tile, g, lane, Es, au);
    const float* L8 = (const float*)(a.ws + WS_S5C) + (size_t)g * 128;
    const float l8r = L8[lane * 2], l8i = L8[lane * 2 + 1];
    const float* X = (const float*)(a.ws + WS_S5X) + ((size_t)tile * 16 + g) * 128;
    float sr = X[lane], si = X[64 + lane];
#pragma unroll
    for (int c = 0; c < 16; ++c) {
        Sv[c * LP + lane] = (bf16)f2bf(sr); Sv[c * LP + 64 + lane] = (bf16)f2bf(si);
        const float er = Es[c * 128 + lane], ei = Es[c * 128 + 64 + lane];
        const float nr = l8r * sr - l8i * si + er, ni = l8r * si + l8i * sr + ei; sr = nr; si = ni; }
    LDS_WAIT(); asm volatile("" ::: "memory");
    bf16x8 as[4];
#pragma unroll
    for (int ks = 0; ks < 4; ++ks) as[ks] = *(const LAS bf16x8*)(Sv + r16 * LP + ks * 32 + 8 * q4);
    const bf16* T8T = (const bf16*)(a.ws + WS_S5MAT) + (size_t)g * 16384; const bf16* QMT = (const bf16*)(a.ws + WS_S5MAT) + (size_t)(32 + g) * 16384;
    const bf16* Z1 = (const bf16*)(a.ws + WS_Z1); bf16* YG = (bf16*)(a.ws + WS_YG);
    const float dg = ((const float*)a.in[14])[g * 16 + r16];
    bf16x8 tc[4], tn[4], qc[4], qn[4]; bf16 uc[4], un[4];
#pragma unroll
    for (int ks = 0; ks < 4; ++ks) { tc[ks] = *(const bf16x8*)(T8T + (ks * 64 + lane) * 8); qc[ks] = *(const bf16x8*)(QMT + (ks * 64 + lane) * 8); }
#pragma unroll
    for (int i4 = 0; i4 < 4; ++i4) uc[i4] = Z1[(size_t)(tile * 128 + 8 * (q4 * 4 + i4)) * NZ1 + ZU + g * 16 + r16];
#pragma unroll 1
    for (int nb = 0; nb < 8; ++nb) {
        const int nbn = min(nb + 1, 7);
#pragma unroll
        for (int ks = 0; ks < 4; ++ks) { tn[ks] = *(const bf16x8*)(T8T + ((nbn * 4 + ks) * 64 + lane) * 8); qn[ks] = *(const bf16x8*)(QMT + ((nbn * 4 + ks) * 64 + lane) * 8); }
#pragma unroll
        for (int i4 = 0; i4 < 4; ++i4) un[i4] = Z1[(size_t)(tile * 128 + 8 * (q4 * 4 + i4) + nbn) * NZ1 + ZU + g * 16 + r16];
        __builtin_amdgcn_sched_barrier(0);
        f32x4 acc = {0.f, 0.f, 0.f, 0.f};
#pragma unroll
        for (int ks = 0; ks < 4; ++ks) { acc = mfma16(au[ks], tc[ks], acc); acc = mfma16(as[ks], qc[ks], acc); }
#pragma unroll
        for (int i4 = 0; i4 < 4; ++i4) { const int tok = tile * 128 + 8 * (q4 * 4 + i4) + nb;
            YG[(size_t)tok * 256 + g * 16 + r16] = (bf16)f2bf(gelu_tanh(acc[i4] + dg * bf2f(uc[i4]))); }
        __builtin_amdgcn_sched_barrier(0);
#pragma unroll
        for (int ks = 0; ks < 4; ++ks) { tc[ks] = tn[ks]; qc[ks] = qn[ks]; }
#pragma unroll
        for (int i4 = 0; i4 < 4; ++i4) uc[i4] = un[i4];
    }
    LDS_WAIT(); asm volatile("" ::: "memory");
}

__device__ __forceinline__ void ma_loadk(const bf16* kp, int mt, bf16x8 (&k)[4]) {
#pragma unroll
    for (int ks = 0; ks < 4; ++ks) k[ks] = *(const bf16x8*)(kp + (mt * 4 + ks) * 512);
}
__device__ __forceinline__ void ma_loadv(const bf16* vp, int mt, bf16x8 (&v)[4]) {
#pragma unroll
    for (int sft = 0; sft < 2; ++sft)
#pragma unroll
        for (int et = 0; et < 2; ++et) v[sft * 2 + et] = *(const bf16x8*)(vp + (((et * 8 + mt) * 2 + sft) * 64) * 8);
}
__device__ __forceinline__ void ma_wave(const Ctx& C, const Args& a, int tile, int hm, int ib) {
    const bf16* Z1 = (const bf16*)(a.ws + WS_Z1); const bf16* KM = (const bf16*)(a.ws + WS_KM); const bf16* VT = (const bf16*)(a.ws + WS_VT);
    const int lane = C.lane, r = lane & 31, hh = lane >> 5, b = tile >> 5, tok = tile * 128 + ib * 32 + r;
    const bf16* kp = KM + (size_t)(b * 4 + hm) * 16384 + lane * 8;
    const bf16* vp = VT + (size_t)(b * 4 + hm) * 16384 + lane * 8;
    bf16x8 bq[4];
#pragma unroll
    for (int ks = 0; ks < 4; ++ks) bq[ks] = *(const bf16x8*)(Z1 + (size_t)tok * NZ1 + ZQM + hm * 64 + ks * 16 + 8 * hh);
    bf16x8 kc[4], kn[4];
    ma_loadk(kp, 0, kc);
    float mx = -3.0e38f;
#pragma unroll 1
    for (int mt = 0; mt < 8; ++mt) {
        ma_loadk(kp, min(mt + 1, 7), kn); __builtin_amdgcn_sched_barrier(0);
        f32x16 s;
#pragma unroll
        for (int e = 0; e < 16; ++e) s[e] = 0.f;
#pragma unroll
        for (int ks = 0; ks < 4; ++ks) s = mfma32(kc[ks], bq[ks], s);
#pragma unroll
        for (int e = 0; e < 16; ++e) mx = fmaxf(mx, s[e]);
        __builtin_amdgcn_sched_barrier(0);
#pragma unroll
        for (int ks = 0; ks < 4; ++ks) kc[ks] = kn[ks];
    }
    mx = fmaxf(mx, __shfl_xor(mx, 32));
    float sum = 0.f;
    f32x16 o[2];
#pragma unroll
    for (int et = 0; et < 2; ++et)
#pragma unroll
        for (int e = 0; e < 16; ++e) o[et][e] = 0.f;
    const float sc = 0.125f * 1.4426950408889634f;
    bf16x8 vc[4], vn[4];
    ma_loadk(kp, 0, kc); ma_loadv(vp, 0, vc);
#pragma unroll 1
    for (int mt = 0; mt < 8; ++mt) {
        ma_loadk(kp, min(mt + 1, 7), kn); ma_loadv(vp, min(mt + 1, 7), vn); __builtin_amdgcn_sched_barrier(0);
        f32x16 s;
#pragma unroll
        for (int e = 0; e < 16; ++e) s[e] = 0.f;
#pragma unroll
        for (int ks = 0; ks < 4; ++ks) s = mfma32(kc[ks], bq[ks], s);
        unsigned pk[8];
#pragma unroll
        for (int q = 0; q < 8; ++q) { const float pa = __builtin_amdgcn_exp2f((s[2 * q] - mx) * sc), pb = __builtin_amdgcn_exp2f((s[2 * q + 1] - mx) * sc); sum += pa + pb; pk[q] = pk2(pa, pb); }
#pragma unroll
        for (int sft = 0; sft < 2; ++sft) {
            const bf16x8 pb = mk8(pk[4 * sft], pk[4 * sft + 1], pk[4 * sft + 2], pk[4 * sft + 3]);
#pragma unroll
            for (int et = 0; et < 2; ++et) o[et] = mfma32(vc[sft * 2 + et], pb, o[et]);
        }
        __builtin_amdgcn_sched_barrier(0);
#pragma unroll
        for (int ks = 0; ks < 4; ++ks) kc[ks] = kn[ks];
#pragma unroll
        for (int q = 0; q < 4; ++q) vc[q] = vn[q];
    }
    sum += __shfl_xor(sum, 32);
    const float inv = 1.0f / sum;
    bf16* MA = (bf16*)(a.ws + WS_MATTN) + (size_t)tok * 256 + hm * 64;
#pragma unroll
    for (int et = 0; et < 2; ++et)
#pragma unroll
        for (int g4 = 0; g4 < 4; ++g4) { v2u w; w.x = pk2(o[et][4 * g4] * inv, o[et][4 * g4 + 1] * inv); w.y = pk2(o[et][4 * g4 + 2] * inv, o[et][4 * g4 + 3] * inv);
            *(v2u*)(MA + et * 32 + 8 * g4 + 4 * hh) = w; }
}

__device__ __forceinline__ void r3_wave(const Ctx& C, const Args& a, int tile, int h, int ib) {
    const bf16* Z1 = (const bf16*)(a.ws + WS_Z1); const float* ROPE = (const float*)(a.ws + WS_ROPE);
    const bf16* PREV = (const bf16*)((const unsigned char*)a.out + 64 * MiB);
    const int lane = C.lane, r = lane & 31, hh = lane >> 5, u = tile * 4 + h, tok = tile * 128 + ib * 32 + r;
    const float lg2g = lg2_gamma(h);
    const bf16* zr = Z1 + (size_t)tok * NZ1 + ZQ + h * 128; const float* rp = ROPE + (size_t)tok * 128;
    bf16x8 bq[8];
#pragma unroll
    for (int m = 0; m < 4; ++m) {
        const v4u x1 = *(const v4u*)(zr + m * 16 + 8 * hh), x2 = *(const v4u*)(zr + 64 + m * 16 + 8 * hh);
        const f32x4 c0 = *(const f32x4*)(rp + m * 16 + 8 * hh), c1 = *(const f32x4*)(rp + m * 16 + 8 * hh + 4);
        const f32x4 s0 = *(const f32x4*)(rp + 64 + m * 16 + 8 * hh), s1 = *(const f32x4*)(rp + 64 + m * 16 + 8 * hh + 4);
        const unsigned aw[4] = {x1.x, x1.y, x1.z, x1.w}, bw[4] = {x2.x, x2.y, x2.z, x2.w};
        const float cs[8] = {c0[0], c0[1], c0[2], c0[3], c1[0], c1[1], c1[2], c1[3]}, sn[8] = {s0[0], s0[1], s0[2], s0[3], s1[0], s1[1], s1[2], s1[3]};
        unsigned o1[4], o2[4];
#pragma unroll
        for (int w = 0; w < 4; ++w) {
            const float x1l = bflo(aw[w]), x1h = bfhi(aw[w]), x2l = bflo(bw[w]), x2h = bfhi(bw[w]);
            o1[w] = pk2(x1l * cs[2 * w] - x2l * sn[2 * w], x1h * cs[2 * w + 1] - x2h * sn[2 * w + 1]);
            o2[w] = pk2(x1l * sn[2 * w] + x2l * cs[2 * w], x1h * sn[2 * w + 1] + x2h * cs[2 * w + 1]);
        }
        bq[m] = mk8(o1[0], o1[1], o1[2], o1[3]); bq[m + 4] = mk8(o2[0], o2[1], o2[2], o2[3]);
        __builtin_amdgcn_sched_barrier(0);
    }
    f32x16 acc[4];
    const bf16* pbase = PREV + (size_t)u * 16384 + lane * 8;
    bf16x8 apc[8], apn[8];
#pragma unroll
    for (int ks = 0; ks < 8; ++ks) apc[ks] = *(const bf16x8*)(pbase + ks * 512);
#pragma unroll
    for (int et = 0; et < 4; ++et) {
        if (et < 3) {
#pragma unroll
            for (int ks = 0; ks < 8; ++ks) apn[ks] = *(const bf16x8*)(pbase + ((et + 1) * 8 + ks) * 512);
        }
        __builtin_amdgcn_sched_barrier(0);
#pragma unroll
        for (int e = 0; e < 16; ++e) acc[et][e] = 0.f;
#pragma unroll
        for (int ks = 0; ks < 8; ++ks) acc[et] = mfma32(apc[ks], bq[ks], acc[et]);
        __builtin_amdgcn_sched_barrier(0);
#pragma unroll
        for (int ks = 0; ks < 8; ++ks) apc[ks] = apn[ks];
    }
    const float qdec = __builtin_amdgcn_exp2f((float)(ib * 32 + r + 1) * lg2g);
    const unsigned* INN = (const unsigned*)(a.ws + WS_INNER) + ((size_t)(u * 4 + ib) * 32) * 64 + lane;
    float ss = 0.f;
    unsigned innw[32];
#pragma unroll
    for (int q = 0; q < 32; ++q) innw[q] = INN[q * 64];
#pragma unroll
    for (int et = 0; et < 4; ++et)
#pragma unroll
        for (int q = 0; q < 8; ++q) { const unsigned w = innw[et * 8 + q];
            const float v0 = acc[et][2 * q] * qdec + bflo(w), v1 = acc[et][2 * q + 1] * qdec + bfhi(w);
            acc[et][2 * q] = v0; acc[et][2 * q + 1] = v1; ss += v0 * v0 + v1 * v1; }
    __builtin_amdgcn_sched_barrier(0);
    ss += __shfl_xor(ss, 32);
    const float rn = __builtin_amdgcn_rsqf(ss * (1.0f / 128.0f) + EPS);
    const bf16* gp = Z1 + (size_t)tok * NZ1 + ZGR + h * 128; bf16* RET = (bf16*)(a.ws + WS_RET) + (size_t)tok * 512 + h * 128;
#pragma unroll
    for (int et = 0; et < 4; ++et)
#pragma unroll
        for (int g4 = 0; g4 < 4; ++g4) { const int e0 = et * 32 + 8 * g4 + 4 * hh; const v2u gw = *(const v2u*)(gp + e0);
            const float g0 = bflo(gw.x), g1 = bfhi(gw.x), g2 = bflo(gw.y), g3 = bfhi(gw.y);
            v2u w; w.x = pk2(acc[et][4 * g4] * rn * g0 * sigmoidf_(g0), acc[et][4 * g4 + 1] * rn * g1 * sigmoidf_(g1));
            w.y = pk2(acc[et][4 * g4 + 2] * rn * g2 * sigmoidf_(g2), acc[et][4 * g4 + 3] * rn * g3 * sigmoidf_(g3));
            *(v2u*)(RET + e0) = w; }
}

__device__ __forceinline__ void p3_scans(const Ctx& C, const Args& a) {
    {
        const float* KV = a.out; bf16* PREV = (bf16*)((unsigned char*)a.out + 64 * MiB);
        for (int it = C.vcu * 512 + C.tid; it < 131072; it += C.G * 512) {
            const int elem = it * 4, b = elem >> 16, h = (elem >> 14) & 3, ed = elem & 16383;
            const float cd = exp2f(128.0f * lg2_gamma(h));
            f32x4 st = {0.f, 0.f, 0.f, 0.f};
#pragma unroll 4
            for (int c = 0; c < 32; ++c) { const size_t off = (size_t)((b * 32 + c) * 4 + h) * 16384 + ed;
                v2u w; w.x = pk2(st[0], st[1]); w.y = pk2(st[2], st[3]); *(v2u*)(PREV + (off - ed) + frag32(ed >> 7, ed & 127, 128)) = w;
                const f32x4 inc = *(const f32x4*)(KV + off); st = st * cd + inc; }
        }
    }
    {
        const float* E = (const float*)(a.ws + WS_S5E); float* X = (float*)(a.ws + WS_S5X); const float* L128 = (const float*)(a.ws + WS_S5C) + 2048;
        for (int it = C.vcu * 512 + C.tid; it < 8192; it += C.G * 512) {
            const int b = it >> 10, g = (it >> 6) & 15, p = it & 63;
            const float lr = L128[(g * 64 + p) * 2], li = L128[(g * 64 + p) * 2 + 1];
            float xr = 0.f, xi = 0.f;
            for (int n = 0; n < 32; ++n) { const size_t off = ((size_t)(b * 32 + n) * 16 + g) * 128 + p;
                X[off] = xr; X[off + 64] = xi;
                const float er = E[off], ei = E[off + 64];
                const float nr = lr * xr - li * xi + er, ni = lr * xi + li * xr + ei; xr = nr; xi = ni; }
        }
    }
}

__device__ __forceinline__ int f2key(float x) { int b = __builtin_bit_cast(int, x); return b >= 0 ? b : (b ^ 0x7fffffff); }
__device__ __forceinline__ float key2f(int k) { return __builtin_bit_cast(float, k >= 0 ? k : (k ^ 0x7fffffff)); }
__device__ __forceinline__ void ce_desc(int& x, int& y) { const int hi = x > y ? x : y, lo = x > y ? y : x; x = hi; y = lo; }
__device__ __forceinline__ void sort16_desc(int (&v)[16]) {
#pragma unroll
    for (int k = 2; k <= 16; k <<= 1)
#pragma unroll
        for (int j = k >> 1; j > 0; j >>= 1)
#pragma unroll
            for (int i = 0; i < 16; ++i) { const int l = i ^ j; if (l > i) { if ((i & k) == 0) ce_desc(v[i], v[l]); else ce_desc(v[l], v[i]); } }
}
__device__ __forceinline__ void merge16_desc(int (&T)[16], const int (&N)[16]) {
#pragma unroll
    for (int i = 0; i < 16; ++i) T[i] = T[i] > N[15 - i] ? T[i] : N[15 - i];
#pragma unroll
    for (int j = 8; j > 0; j >>= 1)
#pragma unroll
        for (int i = 0; i < 16; ++i) { const int l = i ^ j; if (l > i) ce_desc(T[i], T[l]); }
}
__device__ __forceinline__ void peer_topk_half(const Args& a, int tokbase, int hp, int c, int lane, int (&T)[16]) {
    const bf16* Q2 = (const bf16*)(a.ws + WS_Q2); const bf16* KEYS = (const bf16*)(a.ws + WS_KEYS);
    const int r = lane & 31, hh = lane >> 5;
    bf16x8 bq[8];
#pragma unroll
    for (int ks = 0; ks < 8; ++ks) bq[ks] = *(const bf16x8*)(Q2 + (size_t)(tokbase + r) * 2048 + hp * 256 + c * 128 + ks * 16 + 8 * hh);
    const bf16* kbase = KEYS + (size_t)(hp * 2 + c) * 16384 + lane * 8;
    bf16x8 akc[8], akn[8];
#pragma unroll
    for (int ks = 0; ks < 8; ++ks) akc[ks] = *(const bf16x8*)(kbase + ks * 512);
#pragma unroll
    for (int nt = 0; nt < 4; ++nt) {
        if (nt < 3) {
#pragma unroll
            for (int ks = 0; ks < 8; ++ks) akn[ks] = *(const bf16x8*)(kbase + ((nt + 1) * 8 + ks) * 512);
        }
        __builtin_amdgcn_sched_barrier(0);
        f32x16 s;
#pragma unroll
        for (int e = 0; e < 16; ++e) s[e] = 0.f;
#pragma unroll
        for (int ks = 0; ks < 8; ++ks) s = mfma32(akc[ks], bq[ks], s);
        int N[16];
#pragma unroll
        for (int e = 0; e < 16; ++e) { const int n = nt * 32 + (e & 3) + 8 * (e >> 2) + 4 * hh; N[e] = (f2key(s[e]) & ~127) | n; }
        sort16_desc(N);
        if (nt == 0) {
#pragma unroll
            for (int e = 0; e < 16; ++e) T[e] = N[e];
        } else merge16_desc(T, N);
        __builtin_amdgcn_sched_barrier(0);
#pragma unroll
        for (int ks = 0; ks < 8; ++ks) akc[ks] = akn[ks];
    }
    int P[16];
#pragma unroll
    for (int j = 0; j < 16; ++j) P[j] = __shfl_xor(T[j], 32);
    merge16_desc(T, P);
}
__device__ __forceinline__ void peer_topk_head(const Ctx& C, const Args& a, int tokbase, int hp) {
    const int lane = C.lane, r = lane & 31, hh = lane >> 5;
    int T0[16], T1[16];
    peer_topk_half(a, tokbase, hp, 0, lane, T0);
    peer_topk_half(a, tokbase, hp, 1, lane, T1);
    int F[16], L1[16], L2[16], L3[16];
#pragma unroll
    for (int j = 0; j < 16; ++j) { L1[j] = (int)0x80000000; L2[j] = (int)0x80000000; L3[j] = (int)0x80000000; }
    {
        int cnt = 0;
#pragma unroll
        for (int i0 = 0; i0 < 16; ++i0)
#pragma unroll
            for (int i1 = 0; i1 < 16; ++i1)
                if ((i0 + 1) * (i1 + 1) <= 16) {
                    const float v = key2f(T0[i0] & ~127) + key2f(T1[i1] & ~127); const int key = (f2key(v) & ~255) | (i0 * 16 + i1);
                    if (i0 == 0) F[i1] = key;
                    else { if (cnt < 16) L1[cnt] = key; else if (cnt < 32) L2[cnt - 16] = key; else L3[cnt - 32] = key; ++cnt; }
                }
    }
    sort16_desc(L1); merge16_desc(F, L1); sort16_desc(L2); merge16_desc(F, L2); sort16_desc(L3); merge16_desc(F, L3);
    LAS int* tab = (LAS int*)(C.lds + C.wave * 16384);
#pragma unroll
    for (int j = 0; j < 16; ++j) { tab[j * 64 + lane] = T0[j] & 127; tab[(16 + j) * 64 + lane] = T1[j] & 127; }
    LDS_WAIT(); asm volatile("" ::: "memory");
    const float m = key2f(F[0] & ~255);
    float e[16], sum = 0.f;
#pragma unroll
    for (int j = 0; j < 16; ++j) { e[j] = __builtin_amdgcn_exp2f((key2f(F[j] & ~255) - m) * 1.4426950408889634f); sum += e[j]; }
    const float inv = 1.0f / sum;
    const int tok = tokbase + r;
    int* IDX = (int*)(a.ws + WS_IDX) + (size_t)tok * 128 + hp * 16; float* WGT = (float*)(a.ws + WS_WGT) + (size_t)tok * 128 + hp * 16;
#pragma unroll
    for (int j = 0; j < 16; ++j) { const int id = F[j] & 255; const int k0 = tab[(id >> 4) * 64 + lane], k1 = tab[(16 + (id & 15)) * 64 + lane];
        if (hh == 0) IDX[j] = k0 * 128 + k1; else WGT[j] = e[j] * inv; }
    LDS_WAIT(); asm volatile("" ::: "memory");
}
typedef float f32x2v __attribute__((ext_vector_type(2)));
__device__ __forceinline__ void unpack16(const v4u a, const v4u b, float (&x)[16]) {
    const unsigned w[8] = {a.x, a.y, a.z, a.w, b.x, b.y, b.z, b.w};
#pragma unroll
    for (int i = 0; i < 8; ++i) { x[2 * i] = bflo(w[i]); x[2 * i + 1] = bfhi(w[i]); }
}
__device__ __forceinline__ void unpack16_fp8(const v4u a, float (&x)[16]) {
    const unsigned w[4] = {a.x, a.y, a.z, a.w};
#pragma unroll
    for (int i = 0; i < 4; ++i) { const f32x2v lo = __builtin_amdgcn_cvt_pk_f32_fp8((int)w[i], false), hi = __builtin_amdgcn_cvt_pk_f32_fp8((int)w[i], true);
        x[4 * i] = lo.x; x[4 * i + 1] = lo.y; x[4 * i + 2] = hi.x; x[4 * i + 3] = hi.y; }
}
__device__ __forceinline__ long mk64(unsigned lo, unsigned hi) { return (long)(((unsigned long long)hi << 32) | (unsigned long long)lo); }
__device__ __forceinline__ float dpp_swap1(float v) { return __builtin_bit_cast(float, __builtin_amdgcn_update_dpp(0, __builtin_bit_cast(int, v), 0xB1, 0xf, 0xf, true)); }
struct PHalf { v4u g[8]; };
struct PIdx { int e[8]; };
__device__ __forceinline__ void pg_idx8(const int* IDXr, int h, int hl, PIdx& I) {
    h = min(h, hl); const int* p = IDXr + (size_t)(h >> 1) * 128 + (h & 1) * 64;
#pragma unroll
    for (int j = 0; j < 8; ++j) I.e[j] = p[j * 8];
}
__device__ __forceinline__ void pg_issue(const unsigned char* TBL, const PIdx& I, int lane, PHalf& D) {
    const unsigned c16 = (unsigned)(lane & 7) * 16u;
#pragma unroll
    for (int j = 0; j < 8; ++j) D.g[j] = *(const v4u*)(TBL + ((unsigned)I.e[j] * 128u + c16));
}
__device__ __forceinline__ void pg_stage(LAS unsigned char* buf, int lane, const PHalf& D) {
    const int row8 = lane >> 3, c8 = lane & 7;
#pragma unroll
    for (int j = 0; j < 8; ++j) *(LAS v4u*)(buf + (j * 8 + row8) * 128 + ((c8 ^ row8) & 7) * 16) = D.g[j];
}
__device__ __forceinline__ void pu_xprep(LAS unsigned char* xs, unsigned xw, int lane) {
    const float x0 = bflo(xw) * 16.f, x1 = bfhi(xw) * 16.f;
    const int hi = __builtin_amdgcn_cvt_pk_fp8_f32(x0, x1, 0, false);
    const f32x2v bk = __builtin_amdgcn_cvt_pk_f32_fp8(hi, false);
    const int lo = __builtin_amdgcn_cvt_pk_fp8_f32(x0 - bk.x, x1 - bk.y, 0, false);
    *(LAS unsigned short*)(xs + 2 * lane) = (unsigned short)hi; *(LAS unsigned short*)(xs + 128 + 2 * lane) = (unsigned short)lo;
}
typedef int v8i_t __attribute__((ext_vector_type(8)));
__device__ __forceinline__ void pu_compute(const LAS unsigned char* buf, bf16* HPt, int r, int kq, const v8i_t bfr) {
    f32x4 res[4];
#pragma unroll
    for (int g = 0; g < 4; ++g) {
        const int row = g * 16 + r, sw = row & 7;
        const v4u a0 = *(const LAS v4u*)(buf + row * 128 + ((2 * kq) ^ sw) * 16), a1 = *(const LAS v4u*)(buf + row * 128 + ((2 * kq + 1) ^ sw) * 16);
        const v8i_t av = {(int)a0.x, (int)a0.y, (int)a0.z, (int)a0.w, (int)a1.x, (int)a1.y, (int)a1.z, (int)a1.w};
        res[g] = __builtin_amdgcn_mfma_scale_f32_16x16x128_f8f6f4(av, bfr, (f32x4){0.f, 0.f, 0.f, 0.f}, 0, 0, 0, 0x7f7f7f7f, 0, 0x7f7f7f7f);
    }
    f32x4 o = res[0];
#pragma unroll
    for (int g = 1; g < 4; ++g) { const bool sel = ((r >> 1) == g);
#pragma unroll
        for (int i = 0; i < 4; ++i) o[i] = sel ? res[g][i] : o[i]; }
#pragma unroll
    for (int i = 0; i < 4; ++i) o[i] += dpp_swap1(o[i]);
    if (r < 8 && (r & 1) == 0) { v2u w; w.x = pk2(o[0], o[1]); w.y = pk2(o[2], o[3]); *(v2u*)(HPt + (r >> 1) * 16 + 4 * kq) = w; }
}
__device__ __forceinline__ int pg_idx(const int* IDXl, int h, int hl) { h = min(h, hl); return IDXl[(size_t)(h >> 1) * 128 + (h & 1) * 64]; }
__device__ __forceinline__ void peer_u_wave(const Args& a, LAS unsigned char* wlds, LAS unsigned char* wsm, int slab, int t0, int ntok, int lane) {
    const unsigned char* U8 = a.ws + WS_PU + (size_t)slab * (16384 * 128);
    const bf16* N2 = (const bf16*)(a.ws + WS_N2) + slab * 128 + 2 * lane;
    const int* IDX = (const int*)(a.ws + WS_IDX) + (lane >> 3);
    bf16* HP = (bf16*)(a.ws + WS_HPART) + (size_t)slab * MTOK * 128;
    const int r = lane & 15, kq = lane >> 4, tl = t0 + ntok - 1, H0 = 2 * t0, HL = 2 * (t0 + ntok) - 1;
    PHalf d[4]; PIdx iv[4]; v8i_t bfr;
#pragma unroll
    for (int k = 0; k < 4; ++k) pg_idx8(IDX, H0 + k, HL, iv[k]);
    unsigned xw = *(const unsigned*)(N2 + (size_t)t0 * DM);
    pg_issue(U8, iv[0], lane, d[0]); pg_issue(U8, iv[1], lane, d[1]); pg_issue(U8, iv[2], lane, d[2]);
    pg_idx8(IDX, H0 + 4, HL, iv[0]); pg_idx8(IDX, H0 + 5, HL, iv[1]); pg_idx8(IDX, H0 + 6, HL, iv[2]);
    pg_stage(wlds, lane, d[0]);
#define PU_XPREP(tok) do { pu_xprep(wsm, xw, lane); \
        { const LAS unsigned char* bp = wsm + ((r & 1) ? 128 : 0) + kq * 32; const v4u b0 = *(const LAS v4u*)bp, b1 = *(const LAS v4u*)(bp + 16); \
          bfr = (v8i_t){(int)b0.x, (int)b0.y, (int)b0.z, (int)b0.w, (int)b1.x, (int)b1.y, (int)b1.z, (int)b1.w}; } \
        xw = *(const unsigned*)(N2 + (size_t)min((tok) + 1, tl) * DM); } while (0)
#define PU_PHASE(ph, hrel, tok, half) do { \
        pg_issue(U8, iv[((ph) + 3) & 3], lane, d[((ph) + 3) & 3]); pg_idx8(IDX, hb + (hrel) + 7, HL, iv[((ph) + 3) & 3]); \
        pu_compute(wlds + ((half) ? 8192 : 0), HP + (size_t)(tok) * 128 + (half) * 64, r, kq, bfr); \
        pg_stage(wlds + ((half) ? 0 : 8192), lane, d[((ph) + 1) & 3]); } while (0)
#pragma unroll 1
    for (int hb = H0; hb <= HL; hb += 4) {
        const int t = hb >> 1;
        PU_XPREP(t);
        PU_PHASE(0, 0, t, 0);
        PU_PHASE(1, 1, t, 1);
        PU_XPREP(t + 1);
        PU_PHASE(2, 2, t + 1, 0);
        PU_PHASE(3, 3, t + 1, 1);
    }
#undef PU_XPREP
#undef PU_PHASE
}
__device__ __forceinline__ void peer_reduce(const Ctx& C, const Args& a) {
    const bf16* HP = (const bf16*)(a.ws + WS_HPART); const int* IDX = (const int*)(a.ws + WS_IDX); const float* WGT = (const float*)(a.ws + WS_WGT);
    const float* USC = (const float*)(a.ws + WS_PSC); const float* VSC = USC + 16384;
    unsigned char* ACT8 = a.ws + WS_ACT; float* ASC = (float*)(a.ws + WS_ACT + 8 * MiB);
    for (int it = C.vcu * 512 + C.tid; it < MTOK * 32; it += C.G * 512) {
        f32x4 h = {0.f, 0.f, 0.f, 0.f};
#pragma unroll
        for (int sl = 0; sl < 8; ++sl) { const v2u w = *(const v2u*)(HP + (size_t)sl * MTOK * 128 + (size_t)it * 4); h[0] += bflo(w.x); h[1] += bfhi(w.x); h[2] += bflo(w.y); h[3] += bfhi(w.y); }
        const int4 e = *(const int4*)(IDX + (size_t)it * 4); const f32x4 w = *(const f32x4*)(WGT + (size_t)it * 4);
        const int tok = it >> 5, q = it & 31;
        const float rs = 0.0625f * __builtin_amdgcn_rsqf(((const float*)(a.ws + WS_SS))[tok] * (1.f / DM) + EPS);
        f32x4 o;
        o[0] = gelu_tanh(h[0] * USC[e.x] * rs) * w[0] * VSC[e.x]; o[1] = gelu_tanh(h[1] * USC[e.y] * rs) * w[1] * VSC[e.y];
        o[2] = gelu_tanh(h[2] * USC[e.z] * rs) * w[2] * VSC[e.z]; o[3] = gelu_tanh(h[3] * USC[e.w] * rs) * w[3] * VSC[e.w];
        float mx = fmaxf(fmaxf(fabsf(o[0]), fabsf(o[1])), fmaxf(fabsf(o[2]), fabsf(o[3])));
#pragma unroll
        for (int sh = 1; sh < 32; sh <<= 1) mx = fmaxf(mx, __shfl_xor(mx, sh));
        int ex = (int)((__builtin_bit_cast(unsigned, mx) >> 23) & 0xffu) - 127; if (mx < 1e-30f) ex = 7;
        const float sc = __builtin_bit_cast(float, (unsigned)(127 + 7 - ex) << 23), isc = __builtin_bit_cast(float, (unsigned)(127 - 7 + ex) << 23);
        o = o * sc;
        int hi = __builtin_amdgcn_cvt_pk_fp8_f32(o[0], o[1], 0, false); hi = __builtin_amdgcn_cvt_pk_fp8_f32(o[2], o[3], hi, true);
        const f32x2v b0 = __builtin_amdgcn_cvt_pk_f32_fp8(hi, false), b1 = __builtin_amdgcn_cvt_pk_f32_fp8(hi, true);
        int lo = __builtin_amdgcn_cvt_pk_fp8_f32(o[0] - b0.x, o[1] - b0.y, 0, false); lo = __builtin_amdgcn_cvt_pk_fp8_f32(o[2] - b1.x, o[3] - b1.y, lo, true);
        *(unsigned*)(ACT8 + (size_t)tok * 256 + 4 * q) = (unsigned)hi; *(unsigned*)(ACT8 + (size_t)tok * 256 + 128 + 4 * q) = (unsigned)lo;
        if (q == 0) ASC[tok] = isc;
    }
}
typedef int v2i_t __attribute__((ext_vector_type(2)));
__device__ __forceinline__ void pv_compute(const LAS unsigned char* buf, int lane, const long* bact2, f32x4 (&acc)[8]) {
    const int i16 = lane & 15, kq = lane >> 4, rr = i16 >> 1, cc = i16 & 1;
#pragma unroll
    for (int s2 = 0; s2 < 2; ++s2) {
        const int row = 32 * s2 + 8 * kq + rr, sw = row & 7;
#pragma unroll
        for (int nb = 0; nb < 8; ++nb) {
            const v2i_t av = __builtin_amdgcn_ds_read_tr8_b64_v2i32((LAS v2i_t*)(buf + row * 128 + ((nb ^ sw) & 7) * 16 + 8 * cc));
            acc[nb] = __builtin_amdgcn_mfma_f32_16x16x32_fp8_fp8(mk64((unsigned)av.x, (unsigned)av.y), bact2[s2], acc[nb], 0, 0, 0);
        }
    }
}
__device__ __forceinline__ void peer_v_wave(const Args& a, LAS unsigned char* wlds, int slab, int t0, int ntok, int lane) {
    const unsigned char* V8 = a.ws + WS_PV + (size_t)slab * (16384 * 128);
    const int* IDX = (const int*)(a.ws + WS_IDX) + (lane >> 3);
    const int n16 = lane & 15, kq = lane >> 4, tl = t0 + ntok - 1, H0 = 2 * t0, HL = 2 * (t0 + ntok) - 1;
    const unsigned char* ACT8 = a.ws + WS_ACT + ((n16 & 1) ? 128 : 0) + 8 * kq; const float* ASC = (const float*)(a.ws + WS_ACT + 8 * MiB);
    bf16* PO = (bf16*)(a.ws + WS_POUT) + slab * 128;
    PHalf d[4]; PIdx iv[4]; long bact[4], bnxt[4]; f32x4 acc[8]; float isc = 1.f, iscn;
#pragma unroll
    for (int k = 0; k < 4; ++k) pg_idx8(IDX, H0 + k, HL, iv[k]);
#pragma unroll
    for (int s4 = 0; s4 < 4; ++s4) bnxt[s4] = *(const long*)(ACT8 + (size_t)t0 * 256 + 32 * s4);
    iscn = ASC[t0];
    pg_issue(V8, iv[0], lane, d[0]); pg_issue(V8, iv[1], lane, d[1]); pg_issue(V8, iv[2], lane, d[2]);
    pg_idx8(IDX, H0 + 4, HL, iv[0]); pg_idx8(IDX, H0 + 5, HL, iv[1]); pg_idx8(IDX, H0 + 6, HL, iv[2]);
    pg_stage(wlds, lane, d[0]);
#define PV_APREP(tok) do { \
        _Pragma("unroll") for (int s4 = 0; s4 < 4; ++s4) bact[s4] = bnxt[s4]; isc = iscn; \
        { const int tn = min((tok) + 1, tl); \
          _Pragma("unroll") for (int s4 = 0; s4 < 4; ++s4) bnxt[s4] = *(const long*)(ACT8 + (size_t)tn * 256 + 32 * s4); iscn = ASC[tn]; } \
        _Pragma("unroll") for (int nb = 0; nb < 8; ++nb) acc[nb] = (f32x4){0.f, 0.f, 0.f, 0.f}; } while (0)
#define PV_PHASE(ph, hrel, half) do { \
        pg_issue(V8, iv[((ph) + 3) & 3], lane, d[((ph) + 3) & 3]); pg_idx8(IDX, hb + (hrel) + 7, HL, iv[((ph) + 3) & 3]); \
        pv_compute(wlds + ((half) ? 8192 : 0), lane, bact + 2 * (half), acc); \
        pg_stage(wlds + ((half) ? 0 : 8192), lane, d[((ph) + 1) & 3]); } while (0)
#define PV_EPI(tok) do { f32x4 o = acc[0]; \
        _Pragma("unroll") for (int nb = 1; nb < 8; ++nb) { const bool sel = ((n16 >> 1) == nb); \
            _Pragma("unroll") for (int i = 0; i < 4; ++i) o[i] = sel ? acc[nb][i] : o[i]; } \
        _Pragma("unroll") for (int i = 0; i < 4; ++i) o[i] += dpp_swap1(o[i]); \
        if ((n16 & 1) == 0) { v2u w; w.x = pk2(o[0] * isc, o[1] * isc); w.y = pk2(o[2] * isc, o[3] * isc); *(v2u*)(PO + (size_t)(tok) * DM + 16 * (n16 >> 1) + 4 * kq) = w; } } while (0)
#pragma unroll 1
    for (int hb = H0; hb <= HL; hb += 4) {
        const int t = hb >> 1;
        PV_APREP(t);
        PV_PHASE(0, 0, 0);
        PV_PHASE(1, 1, 1);
        PV_EPI(t);
        PV_APREP(t + 1);
        PV_PHASE(2, 2, 0);
        PV_PHASE(3, 3, 1);
        PV_EPI(t + 1);
    }
#undef PV_APREP
#undef PV_PHASE
#undef PV_EPI
}
__device__ __forceinline__ void final_rows4(const Args& a, int tok0, int tstep, int lane) {
    const float* gf = (const float*)a.in[25] + lane * 4;
    f32x4 h[4][4]; v2u pw[4][4], hw[4][4]; float ss[4];
#pragma unroll
    for (int i = 0; i < 4; ++i) { const int tok = tok0 + i * tstep; const bf16* hb = (const bf16*)(a.ws + WS_N2) + (size_t)tok * DM + lane * 4; const bf16* po = (const bf16*)(a.ws + WS_POUT) + (size_t)tok * DM + lane * 4;
#pragma unroll
        for (int q = 0; q < 4; ++q) { hw[i][q] = *(const v2u*)(hb + 256 * q); pw[i][q] = *(const v2u*)(po + 256 * q); } }
#pragma unroll
    for (int i = 0; i < 4; ++i) { ss[i] = 0.f;
#pragma unroll
        for (int q = 0; q < 4; ++q) { h[i][q][0] = bflo(hw[i][q].x) + bflo(pw[i][q].x); h[i][q][1] = bfhi(hw[i][q].x) + bfhi(pw[i][q].x); h[i][q][2] = bflo(hw[i][q].y) + bflo(pw[i][q].y); h[i][q][3] = bfhi(hw[i][q].y) + bfhi(pw[i][q].y);
            ss[i] += (h[i][q][0] * h[i][q][0] + h[i][q][1] * h[i][q][1]) + (h[i][q][2] * h[i][q][2] + h[i][q][3] * h[i][q][3]); } }
#pragma unroll
    for (int o = 1; o < 64; o <<= 1)
#pragma unroll
        for (int i = 0; i < 4; ++i) ss[i] += __shfl_xor(ss[i], o);
    f32x4 g[4];
#pragma unroll
    for (int q = 0; q < 4; ++q) g[q] = *(const f32x4*)(gf + 256 * q);
#pragma unroll
    for (int i = 0; i < 4; ++i) { const float rstd = 1.0f / sqrtf(ss[i] * (1.f / DM) + EPS); float* orow = a.out + (size_t)(tok0 + i * tstep) * DM + lane * 4;
#pragma unroll
        for (int q = 0; q < 4; ++q) *(f32x4*)(orow + 256 * q) = h[i][q] * rstd * g[q]; }
}

__device__ __forceinline__ void claim_slab_unit(const Ctx& C, unsigned* ctl, int pass, volatile LAS unsigned* MISC, int& slab, int& unit) {
    if (C.tid == 0) {
        const unsigned x = xb_xcc_id() & 7u; unsigned sl = 8u, un = 0u;
        for (unsigned k = 0; k < 8u; ++k) { const unsigned s2 = (x + k) & 7u; const unsigned u2 = xb_add(ctl + CW_Q + 1024 * pass + 64 * s2, 1u); if (u2 < 32u) { sl = s2; un = u2; break; } }
        MISC[16] = sl; MISC[17] = un;
    }
    __syncthreads();
    slab = (int)MISC[16]; unit = (int)MISC[17];
    __syncthreads();
}
__global__ void __launch_bounds__(NWAVES * 64, 2) mk_fwd(Args args) {
    extern __shared__ __attribute__((aligned(16))) unsigned char lds_raw[];
    Ctx C;
    C.lds = (LAS unsigned char*)lds_raw;
    C.wave = __builtin_amdgcn_readfirstlane((int)threadIdx.x >> 6); C.refresh();
    C.G = gridDim.x; { const int bx = blockIdx.x; C.vcu = (C.G % 8 == 0) ? (bx % 8) * (C.G / 8) + bx / 8 : bx; }
    volatile LAS unsigned* MISC = (volatile LAS unsigned*)(C.lds + MISC_OFF);
    if (C.tid < 128) MISC[C.tid] = 0u;
    __syncthreads();
    unsigned char* ws = args.ws;
    unsigned* ctl = (unsigned*)(ws + WS_CTL);
    XcdBarrier bar; bar.bar = ctl + CW_BAR; bar.x = 0; bar.st = nullptr;
#if !MK_PER_PHASE
    bar = xcd_barrier_post(ctl + CW_BAR, MISC + 8, C.tid == 0);
#define GRID_BAR() xcd_barrier(bar, C.wave)
#else
#define GRID_BAR() do { } while (0)
#endif
    const int lo = args.ph_lo, hi = args.ph_hi;
#define IN(k) (lo <= (k) && (k) < hi)
#define SEAM(k) do { if (IN((k) + 1)) GRID_BAR(); C.refresh(); } while (0)
#define REP(k) for (int rep_ = 0; rep_ < 1 + ((REPEAT_MASK >> (k)) & 1); ++rep_)
    bf16* XN = (bf16*)(ws + WS_A);
    if (IN(0)) { REP(0) { p0_prologue(C, args); __syncthreads(); } SEAM(0); }
    if (IN(1)) {
        REP(1) {
        run_gemm(C, XN, (const bf16*)(ws + WS_WIN_T), MTOK, NZ1, DM, FStore{(bf16*)(ws + WS_Z1), NZ1});
        run_gemm(C, (const bf16*)(ws + WS_MEMN), (const bf16*)(ws + WS_WMKV_T), MROWS, 512, DM, FKvm{(bf16*)(ws + WS_KM), (bf16*)(ws + WS_VT)});
        }
        SEAM(1);
    }
    if (IN(2)) {
        REP(2) { const int tile = C.vcu;
            _Pragma("unroll 1") for (int h = 0; h < 4; ++h) r1_unit(C, args, tile, h);
            _Pragma("unroll 1") for (int gi = 0; gi < 2; ++gi) s5a_wave(C, args, tile, C.wave + 8 * gi);
            _Pragma("unroll 1") for (int gi = 0; gi < 2; ++gi) ma_wave(C, args, tile, 2 * gi + (C.wave >> 2), C.wave & 3);
            __syncthreads();
        }
        SEAM(2);
    }
    if (IN(3)) { REP(3) { p3_scans(C, args); } SEAM(3); }
    if (IN(4)) {
        REP(4) { const int tile = C.vcu;
            _Pragma("unroll 1") for (int gi = 0; gi < 2; ++gi) r3_wave(C, args, tile, 2 * gi + (C.wave >> 2), C.wave & 3);
            _Pragma("unroll 1") for (int gi = 0; gi < 2; ++gi) s5c_wave(C, args, tile, C.wave + 8 * gi);
        }
        SEAM(4);
    }
    if (IN(5)) {
        REP(5) {
        run_gemm_mx(C, ws + WS_XN8, ws + WS_WG8, MTOK, NGATE, DM, FSig{(bf16*)(ws + WS_G), NGATE}, 0x7b7b7b7b  , 0x77777777  );
        run_gemm(C, (const bf16*)(ws + WS_YG), (const bf16*)(ws + WS_WGLU_T), MTOK, 512, 256, FGlu{(bf16*)(ws + WS_SSM)});
        }
        SEAM(5);
    }
    if (IN(6)) {
        const bf16* Gt = (const bf16*)(ws + WS_G);
        REP(6) {
        run_gemm(C, (const bf16*)(ws + WS_RET), (const bf16*)(ws + WS_WBR_T), MTOK, DM, 512, FBranch<0>{Gt, 0, (bf16*)args.out, XN});
        run_gemm(C, (const bf16*)(ws + WS_SSM), (const bf16*)(ws + WS_WBS_T), MTOK, DM, 256, FBranch<1>{Gt, 1024, (bf16*)args.out, XN});
        run_gemm(C, (const bf16*)(ws + WS_MATTN), (const bf16*)(ws + WS_WBM_T), MTOK, DM, 256, FBranch<2>{Gt, 2048, (bf16*)args.out, XN});
        }
        SEAM(6);
    }
    if (IN(7)) { run_gemm(C, XN, (const bf16*)(ws + WS_WOUT_T), MTOK, DM, DM, FRes{(const float*)args.in[0], (bf16*)(ws + WS_N2), (float*)(ws + WS_SS)}); SEAM(7); }
    if (IN(9)) { REP(9) run_gemm(C, (const bf16*)(ws + WS_N2), (const bf16*)(ws + WS_WQ_T), MTOK, 2048, DM, FStoreRstd{(bf16*)(ws + WS_Q2), 2048, (const float*)(ws + WS_SS)}); SEAM(9); }
    if (IN(10)) {
        { const int tile = C.vcu;
            const int tokbase = tile * 128 + (C.wave & 3) * 32, h0 = (C.wave >> 2) * 4;
            REP(10) { _Pragma("unroll 1") for (int hp = h0; hp < h0 + 4; ++hp) peer_topk_head(C, args, tokbase, hp); }
        }
        SEAM(10);
    }
    if (IN(11)) { int slab, unit; claim_slab_unit(C, ctl, 0, MISC, slab, unit); if (slab < 8) { REP(11) peer_u_wave(args, C.lds + C.wave * 16384, C.lds + 131072 + C.wave * 1024, slab, unit * 1024 + C.wave * 128, 128, C.lane); } SEAM(11); }
    if (IN(12)) { REP(12) peer_reduce(C, args); SEAM(12); }
    if (IN(13)) { int slab, unit; claim_slab_unit(C, ctl, 1, MISC, slab, unit); if (slab < 8) { REP(13) peer_v_wave(args, C.lds + C.wave * 16384, slab, unit * 1024 + C.wave * 128, 128, C.lane); } SEAM(13); }
    if (IN(14)) {
        const int gw = C.vcu * NWAVES + C.wave, NGW = C.G * NWAVES;
        for (int m = gw; m < MTOK; m += 4 * NGW) final_rows4(args, m, NGW, C.lane);
    }
#undef IN
#undef SEAM
}

extern "C" void kernel_launch(void* const* d_in, const int* in_sizes, int n_in, void* d_out, int out_size, void* d_ws, size_t ws_size, hipStream_t stream) {
    static int grid = 0;
    if (grid == 0) {
        if (n_in != 26 || in_sizes[0] != MTOK * DM || out_size != MTOK * DM || ws_size < WS_END) {
            fprintf(stderr, "kernel_launch: unexpected problem (n_in %d, in0 %d, out %d, ws %zu < %zu); nothing launched\n", n_in, n_in > 0 ? in_sizes[0] : -1, out_size, ws_size, (size_t)WS_END); grid = -1; return; }
        int dev = 0, cus = 0;
        if (hipGetDevice(&dev) != hipSuccess || hipDeviceGetAttribute(&cus, hipDeviceAttributeMultiprocessorCount, dev) != hipSuccess) { grid = -1; return; }
        if (hipFuncSetAttribute((const void*)mk_fwd, hipFuncAttributeMaxDynamicSharedMemorySize, LDS_BYTES) != hipSuccess) { fprintf(stderr, "kernel_launch: hipFuncSetAttribute failed\n"); grid = -1; return; }
        (void)hipGetLastError();
        if (cus < NTILES) { fprintf(stderr, "kernel_launch: needs >= 256 CUs, got %d\n", cus); grid = -1; return; }
        grid = NTILES;
    }
    if (grid < 0) return;
    (void)hipMemsetAsync((char*)d_ws + WS_CTL, 0, CTL_ZERO_BYTES, stream);
    Args a{};
    for (int i = 0; i < 26; ++i) a.in[i] = d_in[i];
    a.out = (float*)d_out; a.ws = (unsigned char*)d_ws;
#if MK_PER_PHASE
    for (int p = 0; p < NPHASE; ++p) { a.ph_lo = p; a.ph_hi = p + 1; hipLaunchKernelGGL(mk_fwd, dim3(grid), dim3(NWAVES * 64), LDS_BYTES, stream, a); }
#else
    a.ph_lo = 0; a.ph_hi = NPHASE;
    hipLaunchKernelGGL(mk_fwd, dim3(grid), dim3(NWAVES * 64), LDS_BYTES, stream, a);
#endif
}
```

```cpp
#include <hip/hip_runtime.h>
#include <cstdio>
#include <cstdint>
namespace pg8 {
__device__ __forceinline__ int hw_lane_id() { int l; asm volatile("v_mbcnt_lo_u32_b32 %0, -1, 0\n\tv_mbcnt_hi_u32_b32 %0, -1, %0" : "=v"(l)); return l; }
#define PG8_LAS __attribute__((address_space(3)))
typedef unsigned short bf16_t;
typedef short bf16x8 __attribute__((ext_vector_type(8)));
typedef float f32x4 __attribute__((ext_vector_type(4)));
typedef unsigned u32x4 __attribute__((ext_vector_type(4)));
constexpr int BM = 256, BK = 64, HALF = 128, HTB = HALF * BK * 2  , STAGE_BYTES = 8 * HTB, NXCD = 8, WGM = 8;

__host__ __device__ __forceinline__ int lds_byte(int r, int c) { const int st = (r >> 4) * 2 + (c >> 5), rr = r & 15, cc = c & 31, ob = rr * 64 + cc * 2; return st * 1024 + (ob ^ (((ob >> 9) & 1) << 5)); }
__host__ __device__ __forceinline__ void stage_rc(int b, int& R, int& C) { const int st = b / 1024, sb = b % 1024, swz = sb ^ (((sb >> 9) & 1) << 5); R = (st >> 1) * 16 + swz / 64; C = (st & 1) * 32 + (swz % 64) / 2; }
__host__ __device__ __forceinline__ int perm32(int rho) { const int n = rho >> 4, i = rho & 15; return 8 * (i >> 2) + 4 * n + (i & 3); }

struct Unit { int pm, pn; };
struct Gemm { const bf16_t* A; const bf16_t* Bt; int M, N, K; };

struct StaticOrder {
    int nM, nN, nwg, G, c;
    __host__ __device__ void init(int M, int N, int G_, int c_) { nM = M / BM; nN = N / BM; nwg = nM * nN; G = G_; c = c_; }
    __host__ __device__ bool next(int i, Unit& u) const {
        const long L = (long)i * G + c; if (L >= nwg) return false;
        int wgid = (int)L; { const int q = nwg / NXCD, r = nwg % NXCD, xcd = wgid % NXCD, off = wgid / NXCD; wgid = (xcd < r ? xcd * (q + 1) : r * (q + 1) + (xcd - r) * q) + off; }
        const int nig = WGM * nN, gid = wgid / nig, fm = gid * WGM, gsz = (nM - fm) < WGM ? (nM - fm) : WGM;
        u.pm = fm + ((wgid % nig) % gsz); u.pn = (wgid % nig) / gsz; return true;
    }
    __device__ __forceinline__ void a_ready(const Unit&) const {}
    __device__ __forceinline__ void done(const Unit&) const {}
};

__device__ __forceinline__ unsigned cvt_pk_bf16(float lo, float hi) { unsigned r; asm volatile("v_cvt_pk_bf16_f32 %0, %1, %2" : "=v"(r) : "v"(lo), "v"(hi)); return r; }
struct NoKHook { __device__ __forceinline__ void operator()(int, f32x4 (&)[2][2][4][2], const Unit&, int, int, int, int) const {} };
template <class Epi, class Sched, bool ALIGN_EPI = false, bool SP2 = false, bool MX = false, class KHook = NoKHook>
__device__ __forceinline__ void gemm_phase(PG8_LAS unsigned char* lds, const Gemm g, const Sched& S, const Epi& E, const int wid, const int sclA = 0x7f7f7f7f, const int sclB = 0x7f7f7f7f, const KHook& KH = KHook()) {
    const int lane = hw_lane_id(), tid = wid * 64 + lane, wr = wid >> 2, wc = wid & 3, fr = lane & 15, fq = lane >> 4;
    const int K = g.K, nt = K / BK;
    unsigned voffA[2], voffB[2];
#pragma unroll
    for (int i = 0; i < 2; ++i) { int R, C; stage_rc(tid * 16 + i * 8192, R, C); const int Rb = Epi::PERM ? ((R & ~31) + perm32(R & 31)) : R;
        voffA[i] = (unsigned)(R * K + C) * 2u; voffB[i] = (unsigned)(Rb * K + C) * 2u; }
    const size_t kstep = (size_t)(BK * 2);
    const size_t hstep = (size_t)HALF * K * 2;
    const size_t tstep = 2 * hstep;
    const unsigned ldsw = (unsigned)wid * 1024u;
    const int aoff = lds_byte(wr * 64 + fr, fq * 8), boff = lds_byte(wc * 32 + fr, fq * 8);
#define PG8_SA(b, h) (((b) * 2 + (h)) * HTB)
#define PG8_SB(b, h) ((4 + (b) * 2 + (h)) * HTB)
#define PG8_STAGE(bufoff, gbase, voff) do { _Pragma("unroll") for (int _i = 0; _i < 2; ++_i) \
        __builtin_amdgcn_global_load_lds((const unsigned*)((const char*)(gbase) + (voff)[_i]), (PG8_LAS unsigned*)(lds + (bufoff) + ldsw + _i * 8192), 16, 0, 0); } while (0)
#define PG8_LDA(dst, b, h) do { _Pragma("unroll") for (int m = 0; m < 4; ++m) { \
        if constexpr (MX) { dst##8[m].lo = *(const PG8_LAS v4i_*)(lds + PG8_SA(b, h) + aoff + m * 2048); dst##8[m].hi = *(const PG8_LAS v4i_*)(lds + PG8_SA(b, h) + aoff + m * 2048 + 1024); } \
        else { _Pragma("unroll") for (int k = 0; k < 2; ++k) dst[m][k] = *(const PG8_LAS bf16x8*)(lds + PG8_SA(b, h) + aoff + m * 2048 + k * 1024); } } } while (0)
#define PG8_LDB(dst, b, h) do { _Pragma("unroll") for (int n = 0; n < 2; ++n) { \
        if constexpr (MX) { dst##8[n].lo = *(const PG8_LAS v4i_*)(lds + PG8_SB(b, h) + boff + n * 2048); dst##8[n].hi = *(const PG8_LAS v4i_*)(lds + PG8_SB(b, h) + boff + n * 2048 + 1024); } \
        else { _Pragma("unroll") for (int k = 0; k < 2; ++k) dst[n][k] = *(const PG8_LAS bf16x8*)(lds + PG8_SB(b, h) + boff + n * 2048 + k * 1024); } } } while (0)
#define PG8_MMA(ai, bj, At, Bt) do { __builtin_amdgcn_s_setprio(1); _Pragma("unroll") for (int m = 0; m < 4; ++m) _Pragma("unroll") for (int n = 0; n < 2; ++n) { \
        if constexpr (MX) acc[ai][bj][m][n] = __builtin_amdgcn_mfma_scale_f32_16x16x128_f8f6f4(Bt##8[n], At##8[m], acc[ai][bj][m][n], 0, 0, 0, sclB, 0, sclA); \
        else { _Pragma("unroll") for (int k = 0; k < 2; ++k) acc[ai][bj][m][n] = __builtin_amdgcn_mfma_f32_16x16x32_bf16(Bt[n][k], At[m][k], acc[ai][bj][m][n], 0, 0, 0); } } \
        if constexpr (MX) { _Pragma("unroll") for (int m = 0; m < 4; ++m) _Pragma("unroll") for (int n = 0; n < 2; ++n) asm volatile("" : "+v"(acc[ai][bj][m][n])); }     \
        __builtin_amdgcn_s_setprio(0); } while (0)
#define PG8_WAIT_V(n) asm volatile("s_waitcnt vmcnt(" #n ")" ::: "memory")
#define PG8_WAIT_L(n) asm volatile("s_waitcnt lgkmcnt(" #n ")" ::: "memory")
#define PG8_BAR __builtin_amdgcn_s_barrier()
#define PG8_SCHED __builtin_amdgcn_sched_barrier(0)
    Unit cur, nxt; int ui = 0;
    if (!S.next(0, cur)) return;
    f32x4 acc[2][2][4][2];
#pragma unroll
    for (int a = 0; a < 2; ++a)
#pragma unroll
        for (int b = 0; b < 2; ++b)
#pragma unroll
            for (int m = 0; m < 4; ++m)
#pragma unroll
                for (int n = 0; n < 2; ++n) acc[a][b][m][n] = (f32x4){0.f, 0.f, 0.f, 0.f};
    typedef int v8i_ __attribute__((ext_vector_type(8))); typedef int v4i_ __attribute__((ext_vector_type(4)));
    bf16x8 At[4][2], B0[2][2], B1[2][2]; v8i_ At8[4], B08[2], B18[2];
    const char* cA = (const char*)g.A + (size_t)cur.pm * tstep; const char* cB = (const char*)g.Bt + (size_t)cur.pn * tstep;
    S.a_ready(cur);
    if constexpr (SP2) {
        PG8_STAGE(PG8_SB(0, 0), cB, voffB); PG8_STAGE(PG8_SB(0, 1), cB + hstep, voffB); PG8_STAGE(PG8_SA(0, 0), cA, voffA); PG8_STAGE(PG8_SA(0, 1), cA + hstep, voffA);
        if (wr == 1) PG8_BAR;
        PG8_WAIT_V(2); PG8_BAR;
        PG8_STAGE(PG8_SB(1, 0), cB + kstep, voffB); PG8_STAGE(PG8_SA(1, 0), cA + kstep, voffA); PG8_STAGE(PG8_SB(1, 1), cB + hstep + kstep, voffB);
        PG8_WAIT_V(6); PG8_BAR;
    } else {
        PG8_STAGE(PG8_SB(0, 0), cB, voffB); PG8_STAGE(PG8_SA(0, 0), cA, voffA); PG8_STAGE(PG8_SB(0, 1), cB + hstep, voffB); PG8_STAGE(PG8_SA(0, 1), cA + hstep, voffA);
        if (wr == 1) PG8_BAR;
        PG8_WAIT_V(4); PG8_BAR;
        PG8_STAGE(PG8_SB(1, 0), cB + kstep, voffB); PG8_STAGE(PG8_SA(1, 0), cA + kstep, voffA); PG8_STAGE(PG8_SB(1, 1), cB + hstep + kstep, voffB);
        PG8_WAIT_V(6); PG8_BAR;
    }
    for (;;) {
        const bool has_next = S.next(ui + 1, nxt);
        const char* nA = has_next ? (const char*)g.A + (size_t)nxt.pm * tstep : cA; const char* nB = has_next ? (const char*)g.Bt + (size_t)nxt.pn * tstep : cB;
        for (int t = 0; t < nt; t += 2) {
            KH(t, acc, cur, wr, wc, fr, fq);
            const bool last = (t == nt - 2);
            const char* a1 = cA + (size_t)(t + 1) * kstep;
            const char* a2 = last ? nA : cA + (size_t)(t + 2) * kstep; const char* b2 = last ? nB : cB + (size_t)(t + 2) * kstep;
            const char* a3 = a2 + kstep; const char* b3 = b2 + kstep;
            if (last && has_next) S.a_ready(nxt);
            if constexpr (SP2) {
            PG8_LDB(B0, 0, 0); PG8_LDB(B1, 0, 1); PG8_SCHED; PG8_LDA(At, 0, 0); PG8_STAGE(PG8_SA(1, 1), a1 + hstep, voffA);
            PG8_WAIT_V(8); PG8_WAIT_L(0); PG8_BAR; PG8_MMA(0, 0, At, B0); PG8_MMA(0, 1, At, B1); PG8_BAR; PG8_SCHED;
            PG8_LDA(At, 0, 1); PG8_STAGE(PG8_SB(0, 0), b2, voffB); PG8_STAGE(PG8_SB(0, 1), b2 + hstep, voffB); PG8_STAGE(PG8_SA(0, 0), a2, voffA);
            PG8_WAIT_V(8); PG8_WAIT_L(0); PG8_BAR; PG8_MMA(1, 0, At, B0); PG8_MMA(1, 1, At, B1); PG8_BAR; PG8_SCHED;
            PG8_LDB(B0, 1, 0); PG8_LDB(B1, 1, 1); PG8_SCHED; PG8_LDA(At, 1, 0); PG8_STAGE(PG8_SA(0, 1), a2 + hstep, voffA);
            PG8_WAIT_V(8); PG8_WAIT_L(0); PG8_BAR; PG8_MMA(0, 0, At, B0); PG8_MMA(0, 1, At, B1); PG8_BAR; PG8_SCHED;
            PG8_LDA(At, 1, 1); PG8_STAGE(PG8_SB(1, 0), b3, voffB); PG8_STAGE(PG8_SB(1, 1), b3 + hstep, voffB); PG8_STAGE(PG8_SA(1, 0), a3, voffA);
            PG8_WAIT_V(8); PG8_WAIT_L(0); PG8_BAR; PG8_MMA(1, 0, At, B0); PG8_MMA(1, 1, At, B1); PG8_BAR; PG8_SCHED;
            } else {
            PG8_LDB(B0, 0, 0); PG8_SCHED; PG8_LDA(At, 0, 0); PG8_STAGE(PG8_SA(1, 1), a1 + hstep, voffA);
            PG8_WAIT_L(8); PG8_BAR; PG8_WAIT_L(0); PG8_MMA(0, 0, At, B0); PG8_BAR; PG8_SCHED;
            PG8_LDB(B1, 0, 1); PG8_STAGE(PG8_SB(0, 0), b2, voffB);
            PG8_BAR; PG8_WAIT_L(0); PG8_MMA(0, 1, At, B1); PG8_BAR;
            PG8_LDA(At, 0, 1); PG8_STAGE(PG8_SA(0, 0), a2, voffA);
            PG8_BAR; PG8_WAIT_L(0); PG8_MMA(1, 0, At, B0); PG8_BAR; PG8_SCHED;
            PG8_STAGE(PG8_SB(0, 1), b2 + hstep, voffB);
            PG8_WAIT_V(6); PG8_BAR; PG8_MMA(1, 1, At, B1); PG8_BAR;
            PG8_LDB(B0, 1, 0); PG8_SCHED; PG8_LDA(At, 1, 0); PG8_STAGE(PG8_SA(0, 1), a2 + hstep, voffA);
            PG8_WAIT_L(8); PG8_BAR; PG8_WAIT_L(0); PG8_MMA(0, 0, At, B0); PG8_BAR; PG8_SCHED;
            PG8_LDB(B1, 1, 1); PG8_STAGE(PG8_SB(1, 0), b3, voffB);
            PG8_BAR; PG8_WAIT_L(0); PG8_MMA(0, 1, At, B1); PG8_BAR;
            PG8_LDA(At, 1, 1); PG8_STAGE(PG8_SA(1, 0), a3, voffA);
            PG8_BAR; PG8_WAIT_L(0); PG8_MMA(1, 0, At, B0); PG8_BAR; PG8_SCHED;
            PG8_STAGE(PG8_SB(1, 1), b3 + hstep, voffB);
            PG8_WAIT_V(6); PG8_BAR; PG8_MMA(1, 1, At, B1); PG8_BAR;
            }
        }
        if constexpr (ALIGN_EPI) { if (wr == 0) PG8_BAR; }
        if constexpr (!Epi::AFTER_DRAIN) { E(acc, cur, wr, wc, fr, fq); S.done(cur); }
        if (!has_next) break;
#pragma unroll
        for (int a = 0; a < 2; ++a)
#pragma unroll
            for (int b = 0; b < 2; ++b)
#pragma unroll
                for (int m = 0; m < 4; ++m)
#pragma unroll
                    for (int n = 0; n < 2; ++n) acc[a][b][m][n] = (f32x4){0.f, 0.f, 0.f, 0.f};
        cur = nxt; cA = nA; cB = nB; ++ui;
        if constexpr (ALIGN_EPI) { if (wr == 1) PG8_BAR; }
    }
    PG8_WAIT_V(0);
    if constexpr (!ALIGN_EPI) { if (wr == 0) PG8_BAR; }
    PG8_BAR;
    if constexpr (Epi::AFTER_DRAIN) { E.fused(acc, cur, wr, wc, fr, fq, lds, wid, lane); S.done(cur); }
#undef PG8_SA
#undef PG8_SB
#undef PG8_STAGE
#undef PG8_LDA
#undef PG8_LDB
#undef PG8_MMA
#undef PG8_WAIT_V
#undef PG8_WAIT_L
#undef PG8_BAR
#undef PG8_SCHED
}
}

#ifndef REPEAT_MASK
#define REPEAT_MASK 0
#endif
#ifndef MK_PER_PHASE
#define MK_PER_PHASE 0
#endif

constexpr int DM = 1024, BATCH = 8, SEQ = 4096, MTOK = BATCH * SEQ;
constexpr int MEMLEN = 256, MROWS = BATCH * MEMLEN;
constexpr int NZ1 = 2560, NGATE = 3072;
constexpr int ZQ = 0, ZK = 512, ZV = 1024, ZGR = 1536, ZU = 2048, ZQM = 2304;
constexpr int NTILES = MTOK / 128;
constexpr float EPS = 1e-6f;
constexpr int NPHASE = 15;

constexpr size_t MiB = 1u << 20;
constexpr size_t WS_CTL = 0, CTL_ZERO_BYTES = 1 * MiB;
constexpr size_t WS_WIN_T = 1 * MiB;
constexpr size_t WS_WQ_T = 12 * MiB;
constexpr size_t WS_WOUT_T = 16 * MiB;
constexpr size_t WS_WCAT_T = 18 * MiB;
constexpr size_t WS_WGLU_T = 20 * MiB;
constexpr size_t WS_WMKV_T = 21 * MiB;
constexpr size_t WS_KEYS = 22 * MiB;
constexpr size_t WS_S5MAT = 23 * MiB;
constexpr size_t WS_S5C = 25 * MiB;
constexpr size_t WS_PSC = 25 * MiB + 256 * 1024;
constexpr size_t WS_SS = 25 * MiB + 512 * 1024;
constexpr size_t WS_ROPE = 26 * MiB;
constexpr size_t WS_PU = 42 * MiB;
constexpr size_t WS_PV = 58 * MiB;
constexpr size_t WS_XN8 = 74 * MiB;
constexpr size_t WS_WG8 = WS_WIN_T + 5 * MiB;
constexpr size_t WS_MEMN = 106 * MiB;
constexpr size_t WS_KM = 110 * MiB;
constexpr size_t WS_VT = 111 * MiB;
constexpr size_t WS_S5E = 112 * MiB;
constexpr size_t WS_S5X = 114 * MiB;
constexpr size_t WS_A = 116 * MiB;
constexpr size_t WS_B = 180 * MiB;
constexpr size_t WS_Z1 = WS_B;
constexpr size_t WS_G = WS_B;
constexpr size_t WS_YCAT = WS_B + 192 * MiB;
constexpr size_t WS_YG = WS_B + 256 * MiB;
constexpr size_t WS_INNER = WS_B + 272 * MiB;
constexpr size_t WS_N2 = WS_B;
constexpr size_t WS_Q2 = WS_B + 64 * MiB;
constexpr size_t WS_IDX = WS_B + 192 * MiB;
constexpr size_t WS_WGT = WS_B + 208 * MiB;
constexpr size_t WS_HPART = WS_B + 128 * MiB;
constexpr size_t WS_ACT = WS_B + 224 * MiB;
constexpr size_t WS_POUT = WS_B + 64 * MiB;
constexpr size_t WS_END = WS_B + 304 * MiB;

constexpr int CW_BAR = 4096;
constexpr int CW_Q = 8192;

constexpr int LDS_BYTES = 147456;
constexpr int MISC_OFF = LDS_BYTES - 512;
constexpr int NWAVES = 8;

#define GAS __attribute__((address_space(1)))
#define LAS __attribute__((address_space(3)))
typedef unsigned short bf16;
typedef unsigned v4u __attribute__((ext_vector_type(4)));
typedef unsigned v2u __attribute__((ext_vector_type(2)));
typedef float f32x4 __attribute__((ext_vector_type(4)));
typedef float f32x16 __attribute__((ext_vector_type(16)));
typedef short bf16x8 __attribute__((ext_vector_type(8)));
typedef GAS unsigned gu32;
#define RLX_AGENT __ATOMIC_RELAXED, __HIP_MEMORY_SCOPE_AGENT
#define LDS_WAIT() asm volatile("s_waitcnt lgkmcnt(0)" ::: "memory")
#define VM_WAIT() asm volatile("s_waitcnt vmcnt(0)" ::: "memory")
__device__ __forceinline__ unsigned f2bf(float f) { unsigned u = __builtin_bit_cast(unsigned, f); return (u + 0x7fffu + ((u >> 16) & 1u)) >> 16; }
typedef __bf16 hwbf16x2_t __attribute__((ext_vector_type(2)));
typedef float hwf32x2_t __attribute__((ext_vector_type(2)));
__device__ __forceinline__ unsigned pk2(float lo, float hi) { const hwf32x2_t v = {lo, hi}; const hwbf16x2_t b = __builtin_convertvector(v, hwbf16x2_t); return __builtin_bit_cast(unsigned, b); }
__device__ __forceinline__ float bflo(unsigned w) { return __builtin_bit_cast(float, w << 16); }
__device__ __forceinline__ float bfhi(unsigned w) { return __builtin_bit_cast(float, w & 0xffff0000u); }
__device__ __forceinline__ float bf2f(bf16 h) { return __builtin_bit_cast(float, (unsigned)h << 16); }
__device__ __forceinline__ f32x16 mfma32(bf16x8 a, bf16x8 b, f32x16 c) { return __builtin_amdgcn_mfma_f32_32x32x16_bf16(a, b, c, 0, 0, 0); }
__device__ __forceinline__ f32x4 mfma16(bf16x8 a, bf16x8 b, f32x4 c) { return __builtin_amdgcn_mfma_f32_16x16x32_bf16(a, b, c, 0, 0, 0); }
__device__ __forceinline__ bf16x8 mk8(unsigned a, unsigned b, unsigned c, unsigned d) { v4u t = {a, b, c, d}; return __builtin_bit_cast(bf16x8, t); }
__device__ __forceinline__ float sigmoidf_(float x) { return __builtin_amdgcn_rcpf(1.0f + __builtin_amdgcn_exp2f(-1.4426950408889634f * x)); }
__device__ __forceinline__ float gelu_tanh(float x) {
    const float u2 = 1.5957691216057308f * (x + 0.044715f * x * x * x);
    return x * __builtin_amdgcn_rcpf(1.0f + __builtin_amdgcn_exp2f(-1.4426950408889634f * u2));
}
__device__ __forceinline__ float wave_sum(float v) {
#pragma unroll
    for (int o = 1; o < 64; o <<= 1) v += __shfl_xor(v, o);
    return v;
}

#define XB_TMO      128
#define XB_XCNT(j)  (256  + 64 * (j))
#define XB_XSUB(j)  (1280 + 64 * (j))
#define XB_XGEN(j)  (2304 + 64 * (j))
#define XB_TOP      3328
#define XB_TOPGEN   3392
#define XCD_BAR_WORDS 3456
#define XB_SPIN_CAP (1u << 22)

__device__ __forceinline__ unsigned xb_ld(unsigned* p)              { return __hip_atomic_load(p, __ATOMIC_RELAXED, __HIP_MEMORY_SCOPE_AGENT); }
__device__ __forceinline__ unsigned xb_add(unsigned* p, unsigned v) { return __hip_atomic_fetch_add(p, v, __ATOMIC_RELAXED, __HIP_MEMORY_SCOPE_AGENT); }
__device__ __forceinline__ unsigned xb_xcc_id() { return (unsigned)__builtin_amdgcn_s_getreg((3 << 11) | 20) & 0xFu; }
#define XB_SPIN(cond, bar) do { unsigned _sp = 0; while (cond) { __builtin_amdgcn_s_sleep(1); \
    if ((++_sp & 255u) == 0u) { if (xb_ld(&(bar)[XB_TMO])) break; if (_sp > XB_SPIN_CAP) { atomicAdd(&(bar)[XB_TMO], 1u); break; } } } } while (0)

struct XcdBarrier { unsigned* bar; unsigned x; volatile LAS unsigned* st; };

__device__ __forceinline__ XcdBarrier xcd_barrier_post(unsigned* bar, volatile LAS unsigned* st, bool tid0) {
    XcdBarrier b; b.bar = bar; b.x = xb_xcc_id(); b.st = st;
    if (tid0) (void)xb_add(&bar[XB_XCNT(b.x)], 1u);
    return b;
}
__device__ __forceinline__ void xcd_barrier_complete(unsigned* bar, unsigned x, unsigned& nloc, unsigned& nx) {
    const unsigned G = gridDim.x * gridDim.y * gridDim.z;
    unsigned sum, cnt, mine, sp = 0u;
    for (;;) {
        sum = 0u; cnt = 0u; mine = 0u;
#pragma unroll
        for (unsigned j = 0; j < 16; ++j) { const unsigned c = xb_ld(&bar[XB_XCNT(j)]); sum += c; cnt += (c > 0u) ? 1u : 0u; mine = (j == x) ? c : mine; }
        if (sum == G) break;
        __builtin_amdgcn_s_sleep(1);
        if ((++sp & 255u) == 0u) { if (xb_ld(&bar[XB_TMO])) break; if (sp > XB_SPIN_CAP) { atomicAdd(&bar[XB_TMO], 1u); break; } }
    }
    nloc = mine > 0u ? mine : 1u; nx = cnt > 0u ? cnt : 1u;
}
__device__ __forceinline__ void xcd_barrier(const XcdBarrier& b, int wave) {
    asm volatile("s_waitcnt vmcnt(0)" ::: "memory");
    __syncthreads();
    if (wave == 0 && pg8::hw_lane_id() == 0) {
        unsigned* bar = b.bar;
        __builtin_amdgcn_s_waitcnt(0);
        unsigned nloc = b.st[0], nx = b.st[1];
        if (nloc == 0u) { xcd_barrier_complete(bar, b.x, nloc, nx); b.st[0] = nloc; b.st[1] = nx; }
        const unsigned old = xb_add(&bar[XB_XSUB(b.x)], 1u);
        const unsigned gen = old / nloc;
        if (old + 1u == (gen + 1u) * nloc) {
            __builtin_amdgcn_fence(__ATOMIC_RELEASE, "agent");
            asm volatile("s_waitcnt vmcnt(0)" ::: "memory");
            const unsigned og = xb_add(&bar[XB_TOP], 1u);
            const unsigned tg = og / nx;
            if (og + 1u == (tg + 1u) * nx) xb_add(&bar[XB_TOPGEN], 1u);
            else XB_SPIN(xb_ld(&bar[XB_TOPGEN]) == tg, bar);
            __builtin_amdgcn_fence(__ATOMIC_ACQUIRE, "agent");
            xb_add(&bar[XB_XGEN(b.x)], 1u);
            asm volatile("s_waitcnt vmcnt(0)" ::: "memory");
        } else {
            XB_SPIN(xb_ld(&bar[XB_XGEN(b.x)]) == gen, bar);
            __builtin_amdgcn_fence(__ATOMIC_ACQUIRE, "agent");
            asm volatile("s_waitcnt vmcnt(0)" ::: "memory");
        }
    }
    __syncthreads();
}

__host__ __device__ __forceinline__ int frag32(int row, int k, int K) { return (((row >> 5) * (K >> 4) + (k >> 4)) * 64 + ((k >> 3) & 1) * 32 + (row & 31)) * 8 + (k & 7); }
__host__ __device__ __forceinline__ int frag16(int n, int k, int K) { return (((n >> 4) * (K >> 5) + (k >> 5)) * 64 + ((k >> 3) & 3) * 16 + (n & 15)) * 8 + (k & 7); }
struct Args { const void* in[26]; float* out; unsigned char* ws; int ph_lo, ph_hi; };
struct Ctx {
    LAS unsigned char* lds;
    int tid, lane, wave, vcu, G;
    __device__ __forceinline__ void refresh() { lane = pg8::hw_lane_id(); tid = wave * 64 + lane; }
};

template <class F> struct EpiT {
    static constexpr bool PERM = true, AFTER_DRAIN = false;
    F f;
    __device__ __forceinline__ void operator()(const f32x4 (&acc)[2][2][4][2], const pg8::Unit& u, int wr, int wc, int fr, int fq) const {
        const int row0 = u.pm * 256 + wr * 64 + fr, col0 = u.pn * 256 + wc * 32 + 8 * fq;
        typename F::L cur[2], nxt[2];
        f.load(row0, col0, cur[0]); f.load(row0, col0 + 128, cur[1]);
#pragma unroll
        for (int i = 0; i < 8; ++i) {
            const int ai = i >> 2, m = i & 3, row = row0 + ai * 128 + m * 16;
            if (i < 7) { const int rown = row0 + ((i + 1) >> 2) * 128 + ((i + 1) & 3) * 16; f.load(rown, col0, nxt[0]); f.load(rown, col0 + 128, nxt[1]); }
            __builtin_amdgcn_sched_barrier(0);
            f.apply(row, col0, acc[ai][0][m][0], acc[ai][0][m][1], cur[0]); f.apply(row, col0 + 128, acc[ai][1][m][0], acc[ai][1][m][1], cur[1]);
            __builtin_amdgcn_sched_barrier(0);
            cur[0] = nxt[0]; cur[1] = nxt[1];
        }
    }
};
__device__ __forceinline__ v4u pack8(f32x4 a, f32x4 b) { v4u w; w.x = pk2(a[0], a[1]); w.y = pk2(a[2], a[3]); w.z = pk2(b[0], b[1]); w.w = pk2(b[2], b[3]); return w; }
struct LNone {};
struct FStore { typedef LNone L; bf16* O; int ldc;
    __device__ __forceinline__ void load(int, int, L&) const {}
    __device__ __forceinline__ void apply(int row, int col, f32x4 v0, f32x4 v1, const L&) const { *(v4u*)(O + (size_t)row * ldc + col) = pack8(v0, v1); } };
struct FKvm { typedef LNone L; bf16* KM; bf16* VT;
    __device__ __forceinline__ void load(int, int, L&) const {}
    __device__ __forceinline__ void apply(int row, int col, f32x4 v0, f32x4 v1, const L&) const {
        const int b = row >> 8, m = row & 255;
        if (col < 256) { const int hm = col >> 6, d0 = col & 63; *(v4u*)(KM + (size_t)(b * 4 + hm) * 16384 + frag32(m, d0, 64)) = pack8(v0, v1); }
        else { const int c = col - 256, hm = c >> 6, e0 = c & 63, mt = m >> 5, s2 = (m >> 4) & 1, w = m & 15, hh = (w >> 2) & 1, j = ((w >> 3) << 2) | (w & 3);
            bf16* p = VT + (size_t)(b * 4 + hm) * 16384 + ((mt * 2 + s2) * 64 + hh * 32) * 8 + j;
#pragma unroll
            for (int jj = 0; jj < 8; ++jj) { const int e = e0 + jj; p[((e >> 5) * 16 * 64 + (e & 31)) * 8] = (bf16)f2bf(jj < 4 ? v0[jj] : v1[jj - 4]); } }
    } };
struct FSig { typedef LNone L; bf16* O; int ldc;
    __device__ __forceinline__ void load(int, int, L&) const {}
    __device__ __forceinline__ void apply(int row, int col, f32x4 v0, f32x4 v1, const L&) const {
#pragma unroll
        for (int j = 0; j < 4; ++j) { v0[j] = sigmoidf_(v0[j]); v1[j] = sigmoidf_(v1[j]); }
        *(v4u*)(O + (size_t)row * ldc + col) = pack8(v0, v1); } };
struct FGlu { typedef LNone L; bf16* O;
    __device__ __forceinline__ void load(int, int, L&) const {}
    __device__ __forceinline__ void apply(int row, int col, f32x4 v0, f32x4 v1, const L&) const {
        v2u w; w.x = pk2(v0[0] * sigmoidf_(v1[0]), v0[1] * sigmoidf_(v1[1])); w.y = pk2(v0[2] * sigmoidf_(v1[2]), v0[3] * sigmoidf_(v1[3]));
        *(v2u*)(O + (size_t)row * 1024 + 512 + (col >> 1)) = w; } };
__device__ __forceinline__ void mul8(f32x4& v0, f32x4& v1, const v4u num, const v4u den) {
    v0[0] *= bflo(num.x) * __builtin_amdgcn_rcpf(fmaxf(bflo(den.x), 1e-30f)); v0[1] *= bfhi(num.x) * __builtin_amdgcn_rcpf(fmaxf(bfhi(den.x), 1e-30f));
    v0[2] *= bflo(num.y) * __builtin_amdgcn_rcpf(fmaxf(bflo(den.y), 1e-30f)); v0[3] *= bfhi(num.y) * __builtin_amdgcn_rcpf(fmaxf(bfhi(den.y), 1e-30f));
    v1[0] *= bflo(num.z) * __builtin_amdgcn_rcpf(fmaxf(bflo(den.z), 1e-30f)); v1[1] *= bfhi(num.z) * __builtin_amdgcn_rcpf(fmaxf(bfhi(den.z), 1e-30f));
    v1[2] *= bflo(num.w) * __builtin_amdgcn_rcpf(fmaxf(bflo(den.w), 1e-30f)); v1[3] *= bfhi(num.w) * __builtin_amdgcn_rcpf(fmaxf(bfhi(den.w), 1e-30f));
}
struct HookGate { const bf16* Gt;
    __device__ __forceinline__ void operator()(int t, f32x4 (&acc)[2][2][4][2], const pg8::Unit& u, int wr, int wc, int fr, int fq) const {
        if (t != 8 && t != 12) return;
        const int gn = (t == 8) ? 0 : 1024, gd = gn + 1024;
        int row0 = u.pm * 256 + wr * 64 + fr, col0 = u.pn * 256 + wc * 32 + 8 * fq;
        asm volatile("" : "+v"(row0), "+v"(col0));
#pragma unroll
        for (int i = 0; i < 8; ++i) { const int ai = i >> 2, m = i & 3; const bf16* gp = Gt + (size_t)(row0 + ai * 128 + m * 16) * NGATE + col0;
            const v4u n0 = *(const v4u*)(gp + gn), d0 = *(const v4u*)(gp + gd), n1 = *(const v4u*)(gp + gn + 128), d1 = *(const v4u*)(gp + gd + 128);
            mul8(acc[ai][0][m][0], acc[ai][0][m][1], n0, d0); mul8(acc[ai][1][m][0], acc[ai][1][m][1], n1, d1);
            __builtin_amdgcn_sched_barrier(0); }
    } };
struct LGate { v4u g; };
struct FGateOut { typedef LGate L; const bf16* Gt; bf16* MB;
    __device__ __forceinline__ void load(int row, int col, L& l) const { l.g = *(const v4u*)(Gt + (size_t)row * NGATE + 2048 + col); }
    __device__ __forceinline__ void apply(int row, int col, f32x4 v0, f32x4 v1, const L& l) const {
        const v4u g = l.g;
        v0[0] *= bflo(g.x); v0[1] *= bfhi(g.x); v0[2] *= bflo(g.y); v0[3] *= bfhi(g.y); v1[0] *= bflo(g.z); v1[1] *= bfhi(g.z); v1[2] *= bflo(g.w); v1[3] *= bfhi(g.w);
        *(v4u*)(MB + (size_t)row * DM + col) = pack8(v0, v1); } };
struct LRes { f32x4 x0, x1; };
struct FRes { typedef LRes L; const float* X; bf16* HB; float* SS;
    __device__ __forceinline__ void load(int row, int col, L& l) const { const float* xp = X + (size_t)row * DM + col; l.x0 = *(const f32x4*)xp; l.x1 = *(const f32x4*)(xp + 4); }
    __device__ __forceinline__ void apply(int row, int col, f32x4 v0, f32x4 v1, const L& l) const {
        v0 += l.x0; v1 += l.x1;
        *(v4u*)(HB + (size_t)row * DM + col) = pack8(v0, v1);
        float q = (v0[0] * v0[0] + v0[1] * v0[1]) + (v0[2] * v0[2] + v0[3] * v0[3]) + (v1[0] * v1[0] + v1[1] * v1[1]) + (v1[2] * v1[2] + v1[3] * v1[3]);
        q += __shfl_xor(q, 16); q += __shfl_xor(q, 32);
        if (pg8::hw_lane_id() < 16) atomicAdd(SS + row, q); } };
struct LRstd { float ss; };
struct FStoreRstd { typedef LRstd L; bf16* O; int ldc; const float* SS;
    __device__ __forceinline__ void load(int row, int, L& l) const { l.ss = SS[row]; }
    __device__ __forceinline__ void apply(int row, int col, f32x4 v0, f32x4 v1, const L& l) const {
        const float rs = __builtin_amdgcn_rsqf(l.ss * (1.f / DM) + EPS);
        *(v4u*)(O + ((((size_t)(row >> 5) * 16 + (col >> 7)) * 8 + ((col & 127) >> 4)) * 64 + ((col >> 3) & 1) * 32 + (row & 31)) * 8) = pack8(v0 * rs, v1 * rs); } };

template <class F>
__device__ __forceinline__ void run_gemm(const Ctx& C, const bf16* A, const bf16* Bt, int M, int N, int K, const F& f) {
    pg8::Gemm g{A, Bt, M, N, K}; pg8::StaticOrder S; S.init(M, N, C.G, (int)blockIdx.x);
    EpiT<F> E{f};
    pg8::gemm_phase<EpiT<F>, pg8::StaticOrder, true, true>(C.lds, g, S, E, C.wave);
}

template <class F, class H>
__device__ __forceinline__ void run_gemm_hook(const Ctx& C, const bf16* A, const bf16* Bt, int M, int N, int K, const F& f, const H& h) {
    pg8::Gemm g{A, Bt, M, N, K}; pg8::StaticOrder S; S.init(M, N, C.G, (int)blockIdx.x);
    EpiT<F> E{f};
    pg8::gemm_phase<EpiT<F>, pg8::StaticOrder, true, true, false, H>(C.lds, g, S, E, C.wave, 0x7f7f7f7f, 0x7f7f7f7f, h);
}
template <class F>
__device__ __forceinline__ void run_gemm_mx(const Ctx& C, const unsigned char* A8, const unsigned char* Bt8, int M, int N, int Kbytes, const F& f, int sclA, int sclB) {
    pg8::Gemm g{(const bf16*)A8, (const bf16*)Bt8, M, N, Kbytes / 2}; pg8::StaticOrder S; S.init(M, N, C.G, (int)blockIdx.x);
    EpiT<F> E{f};
    pg8::gemm_phase<EpiT<F>, pg8::StaticOrder, true, true, true>(C.lds, g, S, E, C.wave, sclA, sclB);
}

template <bool GLU>
__device__ __forceinline__ void p0_transpose_item(const float* W, int K, int N, bf16* WT, LAS float* scr, int item, int lane, const float* kscale = nullptr, int ldk = 0, int koff = 0) {
    if (ldk == 0) ldk = K;
    const int nblk = N / 32, kb = item / nblk, nb = item % nblk, k0 = 64 * kb, n0 = 32 * nb;
#pragma unroll 8
    for (int i = 0; i < 32; ++i) { const int kk = 2 * i + (lane >> 5); float w = W[(size_t)(k0 + kk) * N + n0 + (lane & 31)]; if (kscale) w *= kscale[k0 + kk]; scr[kk * 33 + (lane & 31)] = w; }
    LDS_WAIT(); asm volatile("" ::: "memory");
    const int c = lane & 7;
#pragma unroll
    for (int j = 0; j < 4; ++j) { const int n = (lane >> 3) + 8 * j; const LAS float* s = scr + (8 * c) * 33 + n;
        v4u o; o.x = pk2(s[0 * 33], s[1 * 33]); o.y = pk2(s[2 * 33], s[3 * 33]); o.z = pk2(s[4 * 33], s[5 * 33]); o.w = pk2(s[6 * 33], s[7 * 33]);
        const int nn = n0 + n; int row = nn;
        if (GLU) { const int jc = nn & 255, gate = nn >> 8; row = 8 * (jc >> 2) + 4 * gate + (jc & 3); }
        *(GAS v4u*)(WT + (size_t)row * ldk + koff + k0 + 8 * c) = o; }
    LDS_WAIT(); asm volatile("" ::: "memory");
}
__device__ __forceinline__ void p0_transpose_item_fp8(const float* W, int K, int N, unsigned char* WT8, int nsub, LAS float* scr, int item, int lane, float scale) {
    const int nblk = N / 32, kb = item / nblk, nb = item % nblk, k0 = 64 * kb, n0 = 32 * nb;
#pragma unroll 8
    for (int i = 0; i < 32; ++i) { const int kk = 2 * i + (lane >> 5); scr[kk * 33 + (lane & 31)] = W[(size_t)(k0 + kk) * N + n0 + (lane & 31)] * scale; }
    LDS_WAIT(); asm volatile("" ::: "memory");
    const int c = lane & 7;
#pragma unroll
    for (int j = 0; j < 4; ++j) { const int n = (lane >> 3) + 8 * j; const LAS float* sp = scr + (8 * c) * 33 + n;
        int p0 = __builtin_amdgcn_cvt_pk_fp8_f32(sp[0 * 33], sp[1 * 33], 0, false); p0 = __builtin_amdgcn_cvt_pk_fp8_f32(sp[2 * 33], sp[3 * 33], p0, true);
        int p1 = __builtin_amdgcn_cvt_pk_fp8_f32(sp[4 * 33], sp[5 * 33], 0, false); p1 = __builtin_amdgcn_cvt_pk_fp8_f32(sp[6 * 33], sp[7 * 33], p1, true);
        v2u o; o.x = (unsigned)p0; o.y = (unsigned)p1;
        *(GAS v2u*)(WT8 + (size_t)(n0 + n - nsub) * K + k0 + 8 * c) = o; }
    LDS_WAIT(); asm volatile("" ::: "memory");
}
template <int NR>
__device__ __forceinline__ void rms_rows_to_bf16(const float* xbase, const float* gain, bf16* obase, int m0, int mstep, int lane, unsigned char* o8base = nullptr) {
    f32x4 v[NR][4]; float s[NR];
#pragma unroll
    for (int i = 0; i < NR; ++i) { const f32x4* xr = (const f32x4*)(xbase + (size_t)(m0 + i * mstep) * DM) + lane; s[i] = 0.f;
#pragma unroll
        for (int j = 0; j < 4; ++j) v[i][j] = xr[64 * j]; }
#pragma unroll
    for (int i = 0; i < NR; ++i)
#pragma unroll
        for (int j = 0; j < 4; ++j) s[i] += (v[i][j].x * v[i][j].x + v[i][j].y * v[i][j].y) + (v[i][j].z * v[i][j].z + v[i][j].w * v[i][j].w);
#pragma unroll
    for (int o = 1; o < 64; o <<= 1)
#pragma unroll
        for (int i = 0; i < NR; ++i) s[i] += __shfl_xor(s[i], o);
    const f32x4* gr = (const f32x4*)gain + lane;
    f32x4 g[4];
#pragma unroll
    for (int j = 0; j < 4; ++j) g[j] = gr[64 * j];
#pragma unroll
    for (int i = 0; i < NR; ++i) { const float rstd = 1.0f / sqrtf(s[i] * (1.f / DM) + EPS);
        unsigned long long* o8 = (unsigned long long*)(obase + (size_t)(m0 + i * mstep) * DM) + lane;
#pragma unroll
        for (int j = 0; j < 4; ++j) { const float y0 = v[i][j].x * rstd * g[j].x, y1 = v[i][j].y * rstd * g[j].y, y2 = v[i][j].z * rstd * g[j].z, y3 = v[i][j].w * rstd * g[j].w;
            o8[64 * j] = (unsigned long long)pk2(y0, y1) | ((unsigned long long)pk2(y2, y3) << 32);
            if (o8base) { int p = __builtin_amdgcn_cvt_pk_fp8_f32(y0 * 16.f, y1 * 16.f, 0, false); p = __builtin_amdgcn_cvt_pk_fp8_f32(y2 * 16.f, y3 * 16.f, p, true);
                *(unsigned*)(o8base + (size_t)(m0 + i * mstep) * DM + 256 * j + 4 * lane) = (unsigned)p; } } }
}

__device__ __forceinline__ void p0_s5_group(const Ctx& C, const Args& a, int g, int part) {
    const float* a_re = (const float*)a.in[7]; const float* a_im = (const float*)a.in[8]; const float* log_dt = (const float*)a.in[9];
    const float* b_re = (const float*)a.in[10]; const float* b_im = (const float*)a.in[11]; const float* c_re = (const float*)a.in[12]; const float* c_im = (const float*)a.in[13];
    LAS float* L = (LAS float*)C.lds;
    LAS float* lpr = L;
    LAS float* lpi = L + 640;
    LAS float* bbr = L + 1280;
    LAS float* bbi = bbr + 1024;
    LAS float* ccr = bbi + 1024;
    LAS float* cci = ccr + 1024;
    LAS float* Kj = cci + 1024;
    const int tid = C.tid;
    bf16* T8T = (bf16*)(a.ws + WS_S5MAT) + (size_t)g * 16384;
    bf16* PMT = (bf16*)(a.ws + WS_S5MAT) + (size_t)(16 + g) * 16384;
    bf16* QMT = (bf16*)(a.ws + WS_S5MAT) + (size_t)(32 + g) * 16384;
    float* L8 = (float*)(a.ws + WS_S5C) + (size_t)g * 128;
    float* L128 = (float*)(a.ws + WS_S5C) + 2048 + (size_t)g * 128;
    for (int i = tid; i < 640; i += 512) {
        const int j10 = i >> 6, p = i & 63; const double jj = (j10 < 9) ? (double)j10 : 128.0;
        const double dt = exp((double)log_dt[g]);
        const double ar = (double)a_re[g * 64 + p], ai = (double)a_im[g * 64 + p];
        const double mag = exp(ar * dt * jj), ang = ai * dt * jj;
        lpr[i] = (float)(mag * cos(ang)); lpi[i] = (float)(mag * sin(ang));
    }
    for (int i = tid; i < 1024; i += 512) { ccr[i] = c_re[g * 1024 + i]; cci[i] = c_im[g * 1024 + i]; }
    __syncthreads();
    if (part == 0 && tid < 64) { L8[tid * 2] = lpr[8 * 64 + tid]; L8[tid * 2 + 1] = lpi[8 * 64 + tid]; L128[tid * 2] = lpr[9 * 64 + tid]; L128[tid * 2 + 1] = lpi[9 * 64 + tid]; }
    for (int i = tid; i < 1024; i += 512) {
        const int p = i >> 4, h = i & 15;
        const float ar = a_re[g * 64 + p], ai = a_im[g * 64 + p], lr = lpr[64 + p], li = lpi[64 + p];
        const float den = ar * ar + ai * ai, nr = lr - 1.0f, ni = li;
        const float cr = (nr * ar + ni * ai) / den, ci = (ni * ar - nr * ai) / den;
        const float br = b_re[(g * 64 + p) * 16 + h], bi = b_im[(g * 64 + p) * 16 + h];
        bbr[i] = cr * br - ci * bi; bbi[i] = cr * bi + ci * br;
    }
    __syncthreads();
    for (int i = tid; i < 2048; i += 512) {
        const int j = i >> 8, ho = (i >> 4) & 15, hi = i & 15; float sacc = 0.f;
        for (int p = 0; p < 64; ++p) { const float cr_ = ccr[ho * 64 + p], ci_ = cci[ho * 64 + p], lr_ = lpr[j * 64 + p], li_ = lpi[j * 64 + p];
            const float mr = cr_ * lr_ - ci_ * li_, mi = cr_ * li_ + ci_ * lr_;
            sacc += mr * bbr[p * 16 + hi] - mi * bbi[p * 16 + hi]; }
        Kj[i] = sacc;
    }
    __syncthreads();
    for (int i = part * 1024 + tid; i < (part + 1) * 1024; i += 512) {
        const int n = i >> 7, k = i & 127;
        { const int t = n >> 4, ho = n & 15, sx = k >> 4, hi = k & 15; const float v = (sx <= t) ? Kj[((t - sx) * 16 + ho) * 16 + hi] : 0.f; T8T[frag16(n, k, 128)] = (bf16)f2bf(v); }
        { const int p = n & 63, im = n >> 6, sx = k >> 4, hi = k & 15; const float lr_ = lpr[(7 - sx) * 64 + p], li_ = lpi[(7 - sx) * 64 + p], br_ = bbr[p * 16 + hi], bi_ = bbi[p * 16 + hi];
          const float v = im ? (lr_ * bi_ + li_ * br_) : (lr_ * br_ - li_ * bi_); PMT[frag16(n, k, 128)] = (bf16)f2bf(v); }
        { const int t = n >> 4, ho = n & 15, p = k & 63, pt = k >> 6; const float cr_ = ccr[ho * 64 + p], ci_ = cci[ho * 64 + p], lr_ = lpr[(t + 1) * 64 + p], li_ = lpi[(t + 1) * 64 + p];
          const float v = pt ? -(cr_ * li_ + ci_ * lr_) : (cr_ * lr_ - ci_ * li_); QMT[frag16(n, k, 128)] = (bf16)f2bf(v); }
    }
    __syncthreads();
}

__device__ __forceinline__ void p0_prologue(const Ctx& C, const Args& a) {
    p0_s5_group(C, a, C.vcu & 15, C.vcu >> 4);
    LAS float* scr = (LAS float*)(C.lds + C.wave * 16384);
    const int gw = C.vcu * NWAVES + C.wave, NGW = C.G * NWAVES;
    const int gt = C.vcu * 512 + C.tid, NGT = C.G * 512;
    unsigned char* ws = a.ws;
    for (int i = gt; i < MTOK; i += NGT) ((float*)(ws + WS_SS))[i] = 0.f;
    constexpr int I_IN = 16 * 176, I_Q = 16 * 64, I_O = 16 * 32, I_BR = 8 * 32, I_BS = 4 * 32, I_BM = 4 * 32, I_KV = 16 * 16, I_GLU = 4 * 16;
    constexpr int NITEMS = I_IN + I_Q + I_O + I_BR + I_BS + I_BM + I_KV + I_GLU;
    for (int it = gw; it < NITEMS; it += NGW) {
        int r = it;
        if (r < I_IN) { if ((r % 176) < 80) p0_transpose_item<false>((const float*)a.in[4], 1024, 5632, (bf16*)(ws + WS_WIN_T), scr, r, C.lane);
                        else p0_transpose_item_fp8((const float*)a.in[4], 1024, 5632, ws + WS_WG8, NZ1, scr, r, C.lane, 256.f); continue; } r -= I_IN;
        if (r < I_Q) { p0_transpose_item<false>((const float*)a.in[21], 1024, 2048, (bf16*)(ws + WS_WQ_T), scr, r, C.lane, (const float*)a.in[20]); continue; } r -= I_Q;
        if (r < I_O) { p0_transpose_item<false>((const float*)a.in[19], 1024, 1024, (bf16*)(ws + WS_WOUT_T), scr, r, C.lane); continue; } r -= I_O;
        if (r < I_BR) { p0_transpose_item<false>((const float*)a.in[16], 512, 1024, (bf16*)(ws + WS_WCAT_T), scr, r, C.lane, nullptr, 1024, 0); continue; } r -= I_BR;
        if (r < I_BS) { p0_transpose_item<false>((const float*)a.in[17], 256, 1024, (bf16*)(ws + WS_WCAT_T), scr, r, C.lane, nullptr, 1024, 512); continue; } r -= I_BS;
        if (r < I_BM) { p0_transpose_item<false>((const float*)a.in[18], 256, 1024, (bf16*)(ws + WS_WCAT_T), scr, r, C.lane, nullptr, 1024, 768); continue; } r -= I_BM;
        if (r < I_KV) { p0_transpose_item<false>((const float*)a.in[6], 1024, 512, (bf16*)(ws + WS_WMKV_T), scr, r, C.lane); continue; } r -= I_KV;
        p0_transpose_item<true>((const float*)a.in[15], 256, 512, (bf16*)(ws + WS_WGLU_T), scr, r, C.lane);
    }
    for (int i = gt; i < 16 * 128 * 128 / 8; i += NGT) { const f32x4 x0 = ((const f32x4*)a.in[22])[2 * (size_t)i], x1 = ((const f32x4*)a.in[22])[2 * (size_t)i + 1];
        const int hc = i >> 11, n = (i >> 4) & 127, d0 = (i & 15) * 8; *(v4u*)((bf16*)(ws + WS_KEYS) + hc * 16384 + frag32(n, d0, 128)) = pack8(x0, x1); }
    for (int rw0 = gw; rw0 < 2 * 16384; rw0 += 4 * NGW) {
        f32x4 v[4][4]; float mx[4];
#pragma unroll
        for (int i = 0; i < 4; ++i) { const int rw = rw0 + i * NGW, t = rw >> 14, row = rw & 16383;
            const float* src = (const float*)a.in[23 + t] + (size_t)row * DM + C.lane * 4; mx[i] = 0.f;
#pragma unroll
            for (int q = 0; q < 4; ++q) { v[i][q] = *(const f32x4*)(src + 256 * q); if (t == 0) v[i][q] = v[i][q] * *(const f32x4*)((const float*)a.in[20] + C.lane * 4 + 256 * q); } }
#pragma unroll
        for (int i = 0; i < 4; ++i)
#pragma unroll
            for (int q = 0; q < 4; ++q) mx[i] = fmaxf(mx[i], fmaxf(fmaxf(fabsf(v[i][q][0]), fabsf(v[i][q][1])), fmaxf(fabsf(v[i][q][2]), fabsf(v[i][q][3]))));
#pragma unroll
        for (int o = 1; o < 64; o <<= 1)
#pragma unroll
            for (int i = 0; i < 4; ++i) mx[i] = fmaxf(mx[i], __shfl_xor(mx[i], o));
#pragma unroll
        for (int i = 0; i < 4; ++i) { const int rw = rw0 + i * NGW, t = rw >> 14, row = rw & 16383;
            int ex = (int)((__builtin_bit_cast(unsigned, mx[i]) >> 23) & 0xffu) - 127;
            if (mx[i] < 1e-30f) ex = 7;
            const float sc = __builtin_bit_cast(float, (unsigned)(127 + 7 - ex) << 23), isc = __builtin_bit_cast(float, (unsigned)(127 - 7 + ex) << 23);
            unsigned char* dst = ws + (t ? WS_PV : WS_PU) + (size_t)row * 128 + ((C.lane * 4) & 127);
#pragma unroll
            for (int q = 0; q < 4; ++q) { int p = __builtin_amdgcn_cvt_pk_fp8_f32(v[i][q][0] * sc, v[i][q][1] * sc, 0, false); p = __builtin_amdgcn_cvt_pk_fp8_f32(v[i][q][2] * sc, v[i][q][3] * sc, p, true);
                *(unsigned*)(dst + (size_t)(2 * q + (C.lane >> 5)) * (16384 * 128)) = (unsigned)p; }
            if (C.lane == 0) ((float*)(ws + WS_PSC))[t * 16384 + row] = isc; }
    }
    for (int m = gw; m < MTOK; m += 4 * NGW) rms_rows_to_bf16<4>((const float*)a.in[0], (const float*)a.in[3], (bf16*)(ws + WS_A), m, NGW, C.lane, ws + WS_XN8);
    for (int m = gw; m < MROWS; m += NGW) rms_rows_to_bf16<1>((const float*)a.in[1], (const float*)a.in[5], (bf16*)(ws + WS_MEMN), m, NGW, C.lane);
    {
        const int* pos = (const int*)a.in[2]; float* rope = (float*)(ws + WS_ROPE);
        const int j = C.tid & 63;
        const double invrev = exp(-(double)j * (9.210340371976184 / 64.0)) * 0.15915494309189535;
        for (int i = gt; i < MTOK * 64; i += NGT) { const int tok = i >> 6;
            double rv = (double)pos[tok] * invrev; rv -= rint(rv);
            const float rf = (float)rv;
            rope[(size_t)tok * 128 + j] = __builtin_amdgcn_cosf(rf); rope[(size_t)tok * 128 + 64 + j] = __builtin_amdgcn_sinf(rf); }
    }
}

constexpr int LP = 136;
__device__ __forceinline__ float lg2_gamma(int h) { return log2f(1.0f - exp2f(-5.0f - (float)h)); }

__device__ __forceinline__ void r1_unit(const Ctx& C, const Args& a, int tile, int h) {
    const bf16* Z1 = (const bf16*)(a.ws + WS_Z1); const float* ROPE = (const float*)(a.ws + WS_ROPE);
    LAS bf16* Qs = (LAS bf16*)C.lds; LAS bf16* Ks = Qs + 128 * LP; LAS bf16* Kt = Ks + 128 * LP; LAS bf16* Vt = Kt + 128 * LP;
    const int tid = C.tid, lane = C.lane, t0 = tile * 128, u = tile * 4 + h;
    const float lg2g = lg2_gamma(h);
    {
        const int i = tid >> 2, dq = (tid & 3) * 16;
        const bf16* zr = Z1 + (size_t)(t0 + i) * NZ1; const float* rp = ROPE + (size_t)(t0 + i) * 128;
        float cs[16], sn[16];
#pragma unroll
        for (int q = 0; q < 4; ++q) { const f32x4 c4 = *(const f32x4*)(rp + dq + 4 * q), s4 = *(const f32x4*)(rp + 64 + dq + 4 * q);
#pragma unroll
            for (int e = 0; e < 4; ++e) { cs[4 * q + e] = c4[e]; sn[4 * q + e] = s4[e]; } }
        const float kdec = __builtin_amdgcn_exp2f((float)(127 - i) * lg2g) , ksc = 0.08838834764831845f;
#pragma unroll
        for (int which = 0; which < 2; ++which) {
            const bf16* src = zr + (which ? ZK : ZQ) + h * 128;
            const v4u a0 = *(const v4u*)(src + dq), a1 = *(const v4u*)(src + dq + 8), b0 = *(const v4u*)(src + 64 + dq), b1 = *(const v4u*)(src + 64 + dq + 8);
            const unsigned aw[8] = {a0.x, a0.y, a0.z, a0.w, a1.x, a1.y, a1.z, a1.w}, bw[8] = {b0.x, b0.y, b0.z, b0.w, b1.x, b1.y, b1.z, b1.w};
            float y1[16], y2[16];
#pragma unroll
            for (int w = 0; w < 8; ++w) {
                const float x1l = bflo(aw[w]), x1h = bfhi(aw[w]), x2l = bflo(bw[w]), x2h = bfhi(bw[w]);
                y1[2 * w] = x1l * cs[2 * w] - x2l * sn[2 * w]; y2[2 * w] = x1l * sn[2 * w] + x2l * cs[2 * w];
                y1[2 * w + 1] = x1h * cs[2 * w + 1] - x2h * sn[2 * w + 1]; y2[2 * w + 1] = x1h * sn[2 * w + 1] + x2h * cs[2 * w + 1];
            }
            if (which) {
#pragma unroll
                for (int e = 0; e < 16; ++e) { y1[e] *= ksc; y2[e] *= ksc; }
            }
            LAS bf16* dstp = (which ? Ks : Qs) + i * LP;
            v4u o;
            o.x = pk2(y1[0], y1[1]); o.y = pk2(y1[2], y1[3]); o.z = pk2(y1[4], y1[5]); o.w = pk2(y1[6], y1[7]); *(LAS v4u*)(dstp + dq) = o;
            o.x = pk2(y1[8], y1[9]); o.y = pk2(y1[10], y1[11]); o.z = pk2(y1[12], y1[13]); o.w = pk2(y1[14], y1[15]); *(LAS v4u*)(dstp + dq + 8) = o;
            o.x = pk2(y2[0], y2[1]); o.y = pk2(y2[2], y2[3]); o.z = pk2(y2[4], y2[5]); o.w = pk2(y2[6], y2[7]); *(LAS v4u*)(dstp + 64 + dq) = o;
            o.x = pk2(y2[8], y2[9]); o.y = pk2(y2[10], y2[11]); o.z = pk2(y2[12], y2[13]); o.w = pk2(y2[14], y2[15]); *(LAS v4u*)(dstp + 64 + dq + 8) = o;
            if (which) {
#pragma unroll
                for (int e = 0; e < 16; ++e) { Kt[(dq + e) * LP + i] = (bf16)f2bf(y1[e] * kdec); Kt[(64 + dq + e) * LP + i] = (bf16)f2bf(y2[e] * kdec); }
            }
            __builtin_amdgcn_sched_barrier(0);
        }
        {
            const int eq = (tid & 3) * 32; const bf16* vs = zr + ZV + h * 128 + eq;
#pragma unroll
            for (int q = 0; q < 4; ++q) { const v4u v = *(const v4u*)(vs + 8 * q); const unsigned vw[4] = {v.x, v.y, v.z, v.w};
#pragma unroll
                for (int w = 0; w < 4; ++w) { Vt[(eq + 8 * q + 2 * w) * LP + i] = (bf16)(vw[w] & 0xffffu); Vt[(eq + 8 * q + 2 * w + 1) * LP + i] = (bf16)(vw[w] >> 16); } }
        }
    }
    __syncthreads();
    const int r = lane & 31, hh = lane >> 5;
    if (C.wave < 4) {
        const int ib = C.wave;
        bf16x8 bq[8];
#pragma unroll
        for (int ks = 0; ks < 8; ++ks) bq[ks] = *(const LAS bf16x8*)(Qs + (ib * 32 + r) * LP + ks * 16 + 8 * hh);
        f32x16 accO[4];
#pragma unroll
        for (int et = 0; et < 4; ++et)
#pragma unroll
            for (int e = 0; e < 16; ++e) accO[et][e] = 0.f;
        const int i = ib * 32 + r;
#pragma unroll
        for (int jt = 0; jt < 4; ++jt) {
            if (jt <= ib) {
                f32x16 s;
#pragma unroll
                for (int e = 0; e < 16; ++e) s[e] = 0.f;
#pragma unroll
                for (int ks = 0; ks < 8; ++ks) { const bf16x8 ak = *(const LAS bf16x8*)(Ks + (jt * 32 + r) * LP + ks * 16 + 8 * hh); s = mfma32(ak, bq[ks], s); }
                unsigned pk[8];
#pragma unroll
                for (int q = 0; q < 8; ++q) {
                    const int ra = 2 * q, rb = 2 * q + 1;
                    const int ja = jt * 32 + (ra & 3) + 8 * (ra >> 2) + 4 * hh, jb = jt * 32 + (rb & 3) + 8 * (rb >> 2) + 4 * hh;
                    const float va = (i >= ja) ? s[ra] * __builtin_amdgcn_exp2f((float)(i - ja) * lg2g) : 0.f;
                    const float vb = (i >= jb) ? s[rb] * __builtin_amdgcn_exp2f((float)(i - jb) * lg2g) : 0.f;
                    pk[q] = pk2(va, vb);
                }
#pragma unroll
                for (int sft = 0; sft < 2; ++sft) {
                    const bf16x8 pb = mk8(pk[4 * sft], pk[4 * sft + 1], pk[4 * sft + 2], pk[4 * sft + 3]);
#pragma unroll
                    for (int et = 0; et < 4; ++et) {
                        const LAS bf16* vp = Vt + (et * 32 + r) * LP + jt * 32 + 16 * sft + 4 * hh;
                        const v2u lo = *(const LAS v2u*)vp, hi = *(const LAS v2u*)(vp + 8);
                        accO[et] = mfma32(mk8(lo.x, lo.y, hi.x, hi.y), pb, accO[et]);
                    }
                }
            }
            __builtin_amdgcn_sched_barrier(0);
        }
        unsigned* INN = (unsigned*)(a.ws + WS_INNER) + ((size_t)(u * 4 + ib) * 32) * 64 + lane;
#pragma unroll
        for (int et = 0; et < 4; ++et)
#pragma unroll
            for (int q = 0; q < 8; ++q) INN[(et * 8 + q) * 64] = pk2(accO[et][2 * q], accO[et][2 * q + 1]);
    } else {
        const int et = C.wave - 4;
        f32x16 acc[4];
#pragma unroll
        for (int dt = 0; dt < 4; ++dt)
#pragma unroll
            for (int e = 0; e < 16; ++e) acc[dt][e] = 0.f;
#pragma unroll
        for (int ks = 0; ks < 8; ++ks) {
            const bf16x8 av = *(const LAS bf16x8*)(Vt + (et * 32 + r) * LP + ks * 16 + 8 * hh);
#pragma unroll
            for (int dt = 0; dt < 4; ++dt) { const bf16x8 bk = *(const LAS bf16x8*)(Kt + (dt * 32 + r) * LP + ks * 16 + 8 * hh); acc[dt] = mfma32(av, bk, acc[dt]); }
            __builtin_amdgcn_sched_barrier(0);
        }
        float* KVb = a.out + (size_t)u * 16384 + (size_t)(et * 32 + 4 * hh) * 128 + r;
#pragma unroll
        for (int dt = 0; dt < 4; ++dt) {
#pragma unroll
            for (int e = 0; e < 16; ++e) KVb[((e & 3) + 8 * (e >> 2)) * 128 + dt * 32] = acc[dt][e];
            __builtin_amdgcn_sched_barrier(0);
        }
    }
    __syncthreads();
}

__device__ __forceinline__ void s5_compute_E(const Args& a, int tile, int g, int lane, LAS float* Es, bf16x8 (&au)[4]) {
    const bf16* Z1 = (const bf16*)(a.ws + WS_Z1); const bf16* PMT = (const bf16*)(a.ws + WS_S5MAT) + (size_t)(16 + g) * 16384;
    const int r16 = lane & 15, q4 = lane >> 4;
#pragma unroll
    for (int ks = 0; ks < 4; ++ks) { const int s = 2 * ks + (q4 >> 1);
        au[ks] = *(const bf16x8*)(Z1 + (size_t)(tile * 128 + 8 * r16 + s) * NZ1 + ZU + g * 16 + 8 * (q4 & 1)); }
    bf16x8 bc[4], bn[4];
#pragma unroll
    for (int ks = 0; ks < 4; ++ks) bc[ks] = *(const bf16x8*)(PMT + (ks * 64 + lane) * 8);
#pragma unroll 1
    for (int nb = 0; nb < 8; ++nb) {
        const int nbn = min(nb + 1, 7);
#pragma unroll
        for (int ks = 0; ks < 4; ++ks) bn[ks] = *(const bf16x8*)(PMT + ((nbn * 4 + ks) * 64 + lane) * 8);
        __builtin_amdgcn_sched_barrier(0);
        f32x4 acc = {0.f, 0.f, 0.f, 0.f};
#pragma unroll
        for (int ks = 0; ks < 4; ++ks) acc = mfma16(au[ks], bc[ks], acc);
#pragma unroll
        for (int i4 = 0; i4 < 4; ++i4) Es[(q4 * 4 + i4) * 128 + nb * 16 + r16] = acc[i4];
        __builtin_amdgcn_sched_barrier(0);
#pragma unroll
        for (int ks = 0; ks < 4; ++ks) bc[ks] = bn[ks];
    }
    LDS_WAIT(); asm volatile("" ::: "memory");
}
__device__ __forceinline__ void s5a_wave(const Ctx& C, const Args& a, int tile, int g) {
    LAS float* Es = (LAS float*)(C.lds + C.wave * 16384);
    bf16x8 au[4];
    s5_compute_E(a, tile, g, C.lane, Es, au);
    const float* L8 = (const float*)(a.ws + WS_S5C) + (size_t)g * 128;
    const float l8r = L8[C.lane * 2], l8i = L8[C.lane * 2 + 1];
    float sr = 0.f, si = 0.f;
#pragma unroll
    for (int c = 0; c < 16; ++c) { const float er = Es[c * 128 + C.lane], ei = Es[c * 128 + 64 + C.lane];
        const float nr = l8r * sr - l8i * si + er, ni = l8r * si + l8i * sr + ei; sr = nr; si = ni; }
    float* E = (float*)(a.ws + WS_S5E) + ((size_t)tile * 16 + g) * 128;
    E[C.lane] = sr; E[64 + C.lane] = si;
    LDS_WAIT(); asm volatile("" ::: "memory");
}
__device__ __forceinline__ void s5c_wave(const Ctx& C, const Args& a, int tile, int g) {
    LAS float* Es = (LAS float*)(C.lds + C.wave * 16384);
    LAS bf16* Sv = (LAS bf16*)(C.lds + C.wave * 16384 + 8192);
    const int lane = C.lane, r16 = lane & 15, q4 = lane >> 4;
    bf16x8 au[4];
    s5_compute_E(a, tile, g, lane, Es, au);
    const float* L8 = (const float*)(a.ws + WS_S5C) + (size_t)g * 128;
    const float l8r = L8[lane * 2], l8i = L8[lane * 2 + 1];
    const float* X = (const float*)(a.ws + WS_S5X) + ((size_t)tile * 16 + g) * 128;
    float sr = X[lane], si = X[64 + lane];
#pragma unroll
    for (int c = 0; c < 16; ++c) {
        Sv[c * LP + lane] = (bf16)f2bf(sr); Sv[c * LP + 64 + lane] = (bf16)f2bf(si);
        const float er = Es[c * 128 + lane], ei = Es[c * 128 + 64 + lane];
        const float nr = l8r * sr - l8i * si + er, ni = l8r * si + l8i * sr + ei; sr = nr; si = ni; }
    LDS_WAIT(); asm volatile("" ::: "memory");
    bf16x8 as[4];
#pragma unroll
    for (int ks = 0; ks < 4; ++ks) as[ks] = *(const LAS bf16x8*)(Sv + r16 * LP + ks * 32 + 8 * q4);
    const bf16* T8T = (const bf16*)(a.ws + WS_S5MAT) + (size_t)g * 16384; const bf16* QMT = (const bf16*)(a.ws + WS_S5MAT) + (size_t)(32 + g) * 16384;
    const bf16* Z1 = (const bf16*)(a.ws + WS_Z1); bf16* YG = (bf16*)(a.ws + WS_YG);
    const float dg = ((const float*)a.in[14])[g * 16 + r16];
    bf16x8 tc[4], tn[4], qc[4], qn[4]; bf16 uc[4], un[4];
#pragma unroll
    for (int ks = 0; ks < 4; ++ks) { tc[ks] = *(const bf16x8*)(T8T + (ks * 64 + lane) * 8); qc[ks] = *(const bf16x8*)(QMT + (ks * 64 + lane) * 8); }
#pragma unroll
    for (int i4 = 0; i4 < 4; ++i4) uc[i4] = Z1[(size_t)(tile * 128 + 8 * (q4 * 4 + i4)) * NZ1 + ZU + g * 16 + r16];
#pragma unroll 1
    for (int nb = 0; nb < 8; ++nb) {
        const int nbn = min(nb + 1, 7);
#pragma unroll
        for (int ks = 0; ks < 4; ++ks) { tn[ks] = *(const bf16x8*)(T8T + ((nbn * 4 + ks) * 64 + lane) * 8); qn[ks] = *(const bf16x8*)(QMT + ((nbn * 4 + ks) * 64 + lane) * 8); }
#pragma unroll
        for (int i4 = 0; i4 < 4; ++i4) un[i4] = Z1[(size_t)(tile * 128 + 8 * (q4 * 4 + i4) + nbn) * NZ1 + ZU + g * 16 + r16];
        __builtin_amdgcn_sched_barrier(0);
        f32x4 acc = {0.f, 0.f, 0.f, 0.f};
#pragma unroll
        for (int ks = 0; ks < 4; ++ks) { acc = mfma16(au[ks], tc[ks], acc); acc = mfma16(as[ks], qc[ks], acc); }
#pragma unroll
        for (int i4 = 0; i4 < 4; ++i4) { const int tok = tile * 128 + 8 * (q4 * 4 + i4) + nb;
            YG[(size_t)tok * 256 + g * 16 + r16] = (bf16)f2bf(gelu_tanh(acc[i4] + dg * bf2f(uc[i4]))); }
        __builtin_amdgcn_sched_barrier(0);
#pragma unroll
        for (int ks = 0; ks < 4; ++ks) { tc[ks] = tn[ks]; qc[ks] = qn[ks]; }
#pragma unroll
        for (int i4 = 0; i4 < 4; ++i4) uc[i4] = un[i4];
    }
    LDS_WAIT(); asm volatile("" ::: "memory");
}

__device__ __forceinline__ void ma_loadk(const bf16* kp, int mt, bf16x8 (&k)[4]) {
#pragma unroll
    for (int ks = 0; ks < 4; ++ks) k[ks] = *(const bf16x8*)(kp + (mt * 4 + ks) * 512);
}
__device__ __forceinline__ void ma_loadv(const bf16* vp, int mt, bf16x8 (&v)[4]) {
#pragma unroll
    for (int sft = 0; sft < 2; ++sft)
#pragma unroll
        for (int et = 0; et < 2; ++et) v[sft * 2 + et] = *(const bf16x8*)(vp + (((et * 8 + mt) * 2 + sft) * 64) * 8);
}
__device__ __forceinline__ void ma_wave(const Ctx& C, const Args& a, int tile, int hm, int ib) {
    const bf16* Z1 = (const bf16*)(a.ws + WS_Z1); const bf16* KM = (const bf16*)(a.ws + WS_KM); const bf16* VT = (const bf16*)(a.ws + WS_VT);
    const int lane = C.lane, r = lane & 31, hh = lane >> 5, b = tile >> 5, tok = tile * 128 + ib * 32 + r;
    const bf16* kp = KM + (size_t)(b * 4 + hm) * 16384 + lane * 8;
    const bf16* vp = VT + (size_t)(b * 4 + hm) * 16384 + lane * 8;
    bf16x8 bq[4];
#pragma unroll
    for (int ks = 0; ks < 4; ++ks) bq[ks] = *(const bf16x8*)(Z1 + (size_t)tok * NZ1 + ZQM + hm * 64 + ks * 16 + 8 * hh);
    bf16x8 kc[4], kn[4];
    ma_loadk(kp, 0, kc);
    float mx = -3.0e38f;
#pragma unroll 1
    for (int mt = 0; mt < 8; ++mt) {
        ma_loadk(kp, min(mt + 1, 7), kn); __builtin_amdgcn_sched_barrier(0);
        f32x16 s;
#pragma unroll
        for (int e = 0; e < 16; ++e) s[e] = 0.f;
#pragma unroll
        for (int ks = 0; ks < 4; ++ks) s = mfma32(kc[ks], bq[ks], s);
#pragma unroll
        for (int e = 0; e < 16; ++e) mx = fmaxf(mx, s[e]);
        __builtin_amdgcn_sched_barrier(0);
#pragma unroll
        for (int ks = 0; ks < 4; ++ks) kc[ks] = kn[ks];
    }
    mx = fmaxf(mx, __shfl_xor(mx, 32));
    float sum = 0.f;
    f32x16 o[2];
#pragma unroll
    for (int et = 0; et < 2; ++et)
#pragma unroll
        for (int e = 0; e < 16; ++e) o[et][e] = 0.f;
    const float sc = 0.125f * 1.4426950408889634f;
    bf16x8 vc[4], vn[4];
    ma_loadk(kp, 0, kc); ma_loadv(vp, 0, vc);
#pragma unroll 1
    for (int mt = 0; mt < 8; ++mt) {
        ma_loadk(kp, min(mt + 1, 7), kn); ma_loadv(vp, min(mt + 1, 7), vn); __builtin_amdgcn_sched_barrier(0);
        f32x16 s;
#pragma unroll
        for (int e = 0; e < 16; ++e) s[e] = 0.f;
#pragma unroll
        for (int ks = 0; ks < 4; ++ks) s = mfma32(kc[ks], bq[ks], s);
        unsigned pk[8];
#pragma unroll
        for (int q = 0; q < 8; ++q) { const float pa = __builtin_amdgcn_exp2f((s[2 * q] - mx) * sc), pb = __builtin_amdgcn_exp2f((s[2 * q + 1] - mx) * sc); sum += pa + pb; pk[q] = pk2(pa, pb); }
#pragma unroll
        for (int sft = 0; sft < 2; ++sft) {
            const bf16x8 pb = mk8(pk[4 * sft], pk[4 * sft + 1], pk[4 * sft + 2], pk[4 * sft + 3]);
#pragma unroll
            for (int et = 0; et < 2; ++et) o[et] = mfma32(vc[sft * 2 + et], pb, o[et]);
        }
        __builtin_amdgcn_sched_barrier(0);
#pragma unroll
        for (int ks = 0; ks < 4; ++ks) kc[ks] = kn[ks];
#pragma unroll
        for (int q = 0; q < 4; ++q) vc[q] = vn[q];
    }
    sum += __shfl_xor(sum, 32);
    const float inv = 1.0f / sum;
    bf16* MA = (bf16*)(a.ws + WS_YCAT) + (size_t)tok * 1024 + 768 + hm * 64;
#pragma unroll
    for (int et = 0; et < 2; ++et)
#pragma unroll
        for (int g4 = 0; g4 < 4; ++g4) { v2u w; w.x = pk2(o[et][4 * g4] * inv, o[et][4 * g4 + 1] * inv); w.y = pk2(o[et][4 * g4 + 2] * inv, o[et][4 * g4 + 3] * inv);
            *(v2u*)(MA + et * 32 + 8 * g4 + 4 * hh) = w; }
}

__device__ __forceinline__ void r3_wave(const Ctx& C, const Args& a, int tile, int h, int ib) {
    const bf16* Z1 = (const bf16*)(a.ws + WS_Z1); const float* ROPE = (const float*)(a.ws + WS_ROPE);
    const bf16* PREV = (const bf16*)((const unsigned char*)a.out + 64 * MiB);
    const int lane = C.lane, r = lane & 31, hh = lane >> 5, u = tile * 4 + h, tok = tile * 128 + ib * 32 + r;
    const float lg2g = lg2_gamma(h);
    const bf16* zr = Z1 + (size_t)tok * NZ1 + ZQ + h * 128; const float* rp = ROPE + (size_t)tok * 128;
    bf16x8 bq[8];
#pragma unroll
    for (int m = 0; m < 4; ++m) {
        const v4u x1 = *(const v4u*)(zr + m * 16 + 8 * hh), x2 = *(const v4u*)(zr + 64 + m * 16 + 8 * hh);
        const f32x4 c0 = *(const f32x4*)(rp + m * 16 + 8 * hh), c1 = *(const f32x4*)(rp + m * 16 + 8 * hh + 4);
        const f32x4 s0 = *(const f32x4*)(rp + 64 + m * 16 + 8 * hh), s1 = *(const f32x4*)(rp + 64 + m * 16 + 8 * hh + 4);
        const unsigned aw[4] = {x1.x, x1.y, x1.z, x1.w}, bw[4] = {x2.x, x2.y, x2.z, x2.w};
        const float cs[8] = {c0[0], c0[1], c0[2], c0[3], c1[0], c1[1], c1[2], c1[3]}, sn[8] = {s0[0], s0[1], s0[2], s0[3], s1[0], s1[1], s1[2], s1[3]};
        unsigned o1[4], o2[4];
#pragma unroll
        for (int w = 0; w < 4; ++w) {
            const float x1l = bflo(aw[w]), x1h = bfhi(aw[w]), x2l = bflo(bw[w]), x2h = bfhi(bw[w]);
            o1[w] = pk2(x1l * cs[2 * w] - x2l * sn[2 * w], x1h * cs[2 * w + 1] - x2h * sn[2 * w + 1]);
            o2[w] = pk2(x1l * sn[2 * w] + x2l * cs[2 * w], x1h * sn[2 * w + 1] + x2h * cs[2 * w + 1]);
        }
        bq[m] = mk8(o1[0], o1[1], o1[2], o1[3]); bq[m + 4] = mk8(o2[0], o2[1], o2[2], o2[3]);
        __builtin_amdgcn_sched_barrier(0);
    }
    f32x16 acc[4];
    const bf16* pbase = PREV + (size_t)u * 16384 + lane * 8;
    bf16x8 apc[8], apn[8];
#pragma unroll
    for (int ks = 0; ks < 8; ++ks) apc[ks] = *(const bf16x8*)(pbase + ks * 512);
#pragma unroll
    for (int et = 0; et < 4; ++et) {
        if (et < 3) {
#pragma unroll
            for (int ks = 0; ks < 8; ++ks) apn[ks] = *(const bf16x8*)(pbase + ((et + 1) * 8 + ks) * 512);
        }
        __builtin_amdgcn_sched_barrier(0);
#pragma unroll
        for (int e = 0; e < 16; ++e) acc[et][e] = 0.f;
#pragma unroll
        for (int ks = 0; ks < 8; ++ks) acc[et] = mfma32(apc[ks], bq[ks], acc[et]);
        __builtin_amdgcn_sched_barrier(0);
#pragma unroll
        for (int ks = 0; ks < 8; ++ks) apc[ks] = apn[ks];
    }
    const float qdec = __builtin_amdgcn_exp2f((float)(ib * 32 + r + 1) * lg2g);
    const unsigned* INN = (const unsigned*)(a.ws + WS_INNER) + ((size_t)(u * 4 + ib) * 32) * 64 + lane;
    float ss = 0.f;
    unsigned innw[32];
#pragma unroll
    for (int q = 0; q < 32; ++q) innw[q] = INN[q * 64];
#pragma unroll
    for (int et = 0; et < 4; ++et)
#pragma unroll
        for (int q = 0; q < 8; ++q) { const unsigned w = innw[et * 8 + q];
            const float v0 = acc[et][2 * q] * qdec + bflo(w), v1 = acc[et][2 * q + 1] * qdec + bfhi(w);
            acc[et][2 * q] = v0; acc[et][2 * q + 1] = v1; ss += v0 * v0 + v1 * v1; }
    __builtin_amdgcn_sched_barrier(0);
    ss += __shfl_xor(ss, 32);
    const float rn = __builtin_amdgcn_rsqf(ss * (1.0f / 128.0f) + EPS);
    const bf16* gp = Z1 + (size_t)tok * NZ1 + ZGR + h * 128; bf16* RET = (bf16*)(a.ws + WS_YCAT) + (size_t)tok * 1024 + h * 128;
#pragma unroll
    for (int et = 0; et < 4; ++et)
#pragma unroll
        for (int g4 = 0; g4 < 4; ++g4) { const int e0 = et * 32 + 8 * g4 + 4 * hh; const v2u gw = *(const v2u*)(gp + e0);
            const float g0 = bflo(gw.x), g1 = bfhi(gw.x), g2 = bflo(gw.y), g3 = bfhi(gw.y);
            v2u w; w.x = pk2(acc[et][4 * g4] * rn * g0 * sigmoidf_(g0), acc[et][4 * g4 + 1] * rn * g1 * sigmoidf_(g1));
            w.y = pk2(acc[et][4 * g4 + 2] * rn * g2 * sigmoidf_(g2), acc[et][4 * g4 + 3] * rn * g3 * sigmoidf_(g3));
            *(v2u*)(RET + e0) = w; }
}

__device__ __forceinline__ void p3_scans(const Ctx& C, const Args& a) {
    constexpr int NSKIP = 16;
    if ((int)blockIdx.x < NSKIP) return;
    const int w0 = ((int)blockIdx.x - NSKIP) * 512 + C.tid, NW = (C.G - NSKIP) * 512;
    {
        const float* KV = a.out; bf16* PREV = (bf16*)((unsigned char*)a.out + 64 * MiB);
        for (int it = w0; it < 131072; it += NW) {
            const int elem = it * 4, b = elem >> 16, h = (elem >> 14) & 3, ed = elem & 16383;
            const float cd = __builtin_amdgcn_exp2f(128.0f * lg2_gamma(h));
            const float* kp = KV + (size_t)(b * 128 + h) * 16384 + ed; bf16* pp = PREV + (size_t)(b * 128 + h) * 16384 + frag32(ed >> 7, ed & 127, 128);
            f32x4 inc[32];
#pragma unroll
            for (int c = 0; c < 32; ++c) inc[c] = *(const f32x4*)(kp + (size_t)c * 65536);
            f32x4 st = {0.f, 0.f, 0.f, 0.f};
#pragma unroll
            for (int c = 0; c < 32; ++c) { v2u w; w.x = pk2(st[0], st[1]); w.y = pk2(st[2], st[3]); *(v2u*)(pp + (size_t)c * 65536) = w; st = st * cd + inc[c]; }
        }
    }
    {
        const float* E = (const float*)(a.ws + WS_S5E); float* X = (float*)(a.ws + WS_S5X); const float* L128 = (const float*)(a.ws + WS_S5C) + 2048;
        for (int it = w0; it < 8192; it += NW) {
            const int b = it >> 10, g = (it >> 6) & 15, p = it & 63;
            const float lr = L128[(g * 64 + p) * 2], li = L128[(g * 64 + p) * 2 + 1];
            const float* ep = E + ((size_t)(b * 32) * 16 + g) * 128 + p; float* xp = X + ((size_t)(b * 32) * 16 + g) * 128 + p;
            float er[32], ei[32];
#pragma unroll
            for (int n = 0; n < 32; ++n) { er[n] = ep[(size_t)n * 2048]; ei[n] = ep[(size_t)n * 2048 + 64]; }
            float xr = 0.f, xi = 0.f;
#pragma unroll
            for (int n = 0; n < 32; ++n) { xp[(size_t)n * 2048] = xr; xp[(size_t)n * 2048 + 64] = xi;
                const float nr = lr * xr - li * xi + er[n], ni = lr * xi + li * xr + ei[n]; xr = nr; xi = ni; }
        }
    }
}

__device__ __forceinline__ int f2key(float x) { int b = __builtin_bit_cast(int, x); return b >= 0 ? b : (b ^ 0x7fffffff); }
__device__ __forceinline__ float key2f(int k) { return __builtin_bit_cast(float, k >= 0 ? k : (k ^ 0x7fffffff)); }
__device__ __forceinline__ void ce_desc(int& x, int& y) { const int hi = x > y ? x : y, lo = x > y ? y : x; x = hi; y = lo; }
__device__ __forceinline__ void sort16_desc(int (&v)[16]) {
#pragma unroll
    for (int k = 2; k <= 16; k <<= 1)
#pragma unroll
        for (int j = k >> 1; j > 0; j >>= 1)
#pragma unroll
            for (int i = 0; i < 16; ++i) { const int l = i ^ j; if (l > i) { if ((i & k) == 0) ce_desc(v[i], v[l]); else ce_desc(v[l], v[i]); } }
}
__device__ __forceinline__ void merge16_desc(int (&T)[16], const int (&N)[16]) {
#pragma unroll
    for (int i = 0; i < 16; ++i) T[i] = T[i] > N[15 - i] ? T[i] : N[15 - i];
#pragma unroll
    for (int j = 8; j > 0; j >>= 1)
#pragma unroll
        for (int i = 0; i < 16; ++i) { const int l = i ^ j; if (l > i) ce_desc(T[i], T[l]); }
}
__device__ __forceinline__ void peer_topk_half(const Args& a, int tokbase, int hp, int c, int lane, int (&T)[16]) {
    const bf16* Q2 = (const bf16*)(a.ws + WS_Q2); const bf16* KEYS = (const bf16*)(a.ws + WS_KEYS);
    const int r = lane & 31, hh = lane >> 5;
    bf16x8 bq[8];
#pragma unroll
    for (int ks = 0; ks < 8; ++ks) bq[ks] = *(const bf16x8*)(Q2 + ((((size_t)(tokbase >> 5) * 16 + hp * 2 + c) * 8 + ks) * 64 + lane) * 8);
    const bf16* kbase = KEYS + (size_t)(hp * 2 + c) * 16384 + lane * 8;
    bf16x8 akc[8], akn[8];
#pragma unroll
    for (int ks = 0; ks < 8; ++ks) akc[ks] = *(const bf16x8*)(kbase + ks * 512);
#pragma unroll
    for (int nt = 0; nt < 4; ++nt) {
        if (nt < 3) {
#pragma unroll
            for (int ks = 0; ks < 8; ++ks) akn[ks] = *(const bf16x8*)(kbase + ((nt + 1) * 8 + ks) * 512);
        }
        __builtin_amdgcn_sched_barrier(0);
        f32x16 s;
#pragma unroll
        for (int e = 0; e < 16; ++e) s[e] = 0.f;
#pragma unroll
        for (int ks = 0; ks < 8; ++ks) s = mfma32(akc[ks], bq[ks], s);
        int N[16];
#pragma unroll
        for (int e = 0; e < 16; ++e) { const int n = nt * 32 + (e & 3) + 8 * (e >> 2) + 4 * hh; N[e] = (f2key(s[e]) & ~127) | n; }
        sort16_desc(N);
        if (nt == 0) {
#pragma unroll
            for (int e = 0; e < 16; ++e) T[e] = N[e];
        } else merge16_desc(T, N);
        __builtin_amdgcn_sched_barrier(0);
#pragma unroll
        for (int ks = 0; ks < 8; ++ks) akc[ks] = akn[ks];
    }
    int P[16];
#pragma unroll
    for (int j = 0; j < 16; ++j) P[j] = __shfl_xor(T[j], 32);
    merge16_desc(T, P);
}
__device__ __forceinline__ void peer_topk_head(const Ctx& C, const Args& a, int tokbase, int hp) {
    const int lane = C.lane, r = lane & 31, hh = lane >> 5;
    int T0[16], T1[16];
    peer_topk_half(a, tokbase, hp, 0, lane, T0);
    peer_topk_half(a, tokbase, hp, 1, lane, T1);
    int F[16], L1[16], L2[16], L3[16];
#pragma unroll
    for (int j = 0; j < 16; ++j) { L1[j] = (int)0x80000000; L2[j] = (int)0x80000000; L3[j] = (int)0x80000000; }
    {
        int cnt = 0;
#pragma unroll
        for (int i0 = 0; i0 < 16; ++i0)
#pragma unroll
            for (int i1 = 0; i1 < 16; ++i1)
                if ((i0 + 1) * (i1 + 1) <= 16) {
                    const float v = key2f(T0[i0] & ~127) + key2f(T1[i1] & ~127); const int key = (f2key(v) & ~255) | (i0 * 16 + i1);
                    if (i0 == 0) F[i1] = key;
                    else { if (cnt < 16) L1[cnt] = key; else if (cnt < 32) L2[cnt - 16] = key; else L3[cnt - 32] = key; ++cnt; }
                }
    }
    sort16_desc(L1); merge16_desc(F, L1); sort16_desc(L2); merge16_desc(F, L2); sort16_desc(L3); merge16_desc(F, L3);
    LAS int* tab = (LAS int*)(C.lds + C.wave * 16384);
#pragma unroll
    for (int j = 0; j < 16; ++j) { tab[j * 64 + lane] = T0[j] & 127; tab[(16 + j) * 64 + lane] = T1[j] & 127; }
    LDS_WAIT(); asm volatile("" ::: "memory");
    const float m = key2f(F[0] & ~255);
    float e[16], sum = 0.f;
#pragma unroll
    for (int j = 0; j < 16; ++j) { e[j] = __builtin_amdgcn_exp2f((key2f(F[j] & ~255) - m) * 1.4426950408889634f); sum += e[j]; }
    const float inv = 1.0f / sum;
    const int tok = tokbase + r;
    int* IDX = (int*)(a.ws + WS_IDX) + (size_t)tok * 128 + hp * 16; float* WGT = (float*)(a.ws + WS_WGT) + (size_t)tok * 128 + hp * 16;
    unsigned ov[16];
#pragma unroll
    for (int j = 0; j < 16; ++j) { const int id = F[j] & 255; const int k0 = tab[(id >> 4) * 64 + lane], k1 = tab[(16 + (id & 15)) * 64 + lane];
        ov[j] = (hh == 0) ? (unsigned)(k0 * 128 + k1) : __builtin_bit_cast(unsigned, e[j] * inv); }
    unsigned* obase = (hh == 0) ? (unsigned*)IDX : (unsigned*)WGT;
#pragma unroll
    for (int q = 0; q < 4; ++q) { v4u w = {ov[4 * q], ov[4 * q + 1], ov[4 * q + 2], ov[4 * q + 3]}; *(v4u*)(obase + 4 * q) = w; }
    LDS_WAIT(); asm volatile("" ::: "memory");
}
typedef float f32x2v __attribute__((ext_vector_type(2)));
__device__ __forceinline__ void unpack16(const v4u a, const v4u b, float (&x)[16]) {
    const unsigned w[8] = {a.x, a.y, a.z, a.w, b.x, b.y, b.z, b.w};
#pragma unroll
    for (int i = 0; i < 8; ++i) { x[2 * i] = bflo(w[i]); x[2 * i + 1] = bfhi(w[i]); }
}
__device__ __forceinline__ void unpack16_fp8(const v4u a, float (&x)[16]) {
    const unsigned w[4] = {a.x, a.y, a.z, a.w};
#pragma unroll
    for (int i = 0; i < 4; ++i) { const f32x2v lo = __builtin_amdgcn_cvt_pk_f32_fp8((int)w[i], false), hi = __builtin_amdgcn_cvt_pk_f32_fp8((int)w[i], true);
        x[4 * i] = lo.x; x[4 * i + 1] = lo.y; x[4 * i + 2] = hi.x; x[4 * i + 3] = hi.y; }
}
__device__ __forceinline__ long mk64(unsigned lo, unsigned hi) { return (long)(((unsigned long long)hi << 32) | (unsigned long long)lo); }
__device__ __forceinline__ float dpp_swap1(float v) { return __builtin_bit_cast(float, __builtin_amdgcn_update_dpp(0, __builtin_bit_cast(int, v), 0xB1, 0xf, 0xf, true)); }
struct PHalf { v4u g[8]; };
struct PIdx { int e[8]; };
__device__ __forceinline__ void pg_idx8(const int* IDXr, int h, int hl, PIdx& I) {
    h = min(h, hl); const int* p = IDXr + (size_t)(h >> 1) * 128 + (h & 1) * 64;
#pragma unroll
    for (int j = 0; j < 8; ++j) I.e[j] = p[j * 8];
}
__device__ __forceinline__ void pg_issue(const unsigned char* TBL, const PIdx& I, int lane, PHalf& D) {
    const unsigned c16 = (unsigned)(lane & 7) * 16u;
#pragma unroll
    for (int j = 0; j < 8; ++j) D.g[j] = *(const v4u*)(TBL + ((unsigned)I.e[j] * 128u + c16));
}
__device__ __forceinline__ void pg_stage(LAS unsigned char* buf, int lane, const PHalf& D) {
    const int row8 = lane >> 3, c8 = lane & 7;
#pragma unroll
    for (int j = 0; j < 8; ++j) *(LAS v4u*)(buf + (j * 8 + row8) * 128 + ((c8 ^ row8) & 7) * 16) = D.g[j];
}
__device__ __forceinline__ void pu_xprep(LAS unsigned char* xs, unsigned xw, int lane) {
    const float x0 = bflo(xw) * 16.f, x1 = bfhi(xw) * 16.f;
    const int hi = __builtin_amdgcn_cvt_pk_fp8_f32(x0, x1, 0, false);
    const f32x2v bk = __builtin_amdgcn_cvt_pk_f32_fp8(hi, false);
    const int lo = __builtin_amdgcn_cvt_pk_fp8_f32(x0 - bk.x, x1 - bk.y, 0, false);
    *(LAS unsigned short*)(xs + 2 * lane) = (unsigned short)hi; *(LAS unsigned short*)(xs + 128 + 2 * lane) = (unsigned short)lo;
}
typedef int v8i_t __attribute__((ext_vector_type(8)));
__device__ __forceinline__ void pu_compute(const LAS unsigned char* buf, bf16* HPt, int r, int kq, const v8i_t bfr) {
    f32x4 res[4];
#pragma unroll
    for (int g = 0; g < 4; ++g) {
        const int row = g * 16 + r, sw = row & 7;
        const v4u a0 = *(const LAS v4u*)(buf + row * 128 + ((2 * kq) ^ sw) * 16), a1 = *(const LAS v4u*)(buf + row * 128 + ((2 * kq + 1) ^ sw) * 16);
        const v8i_t av = {(int)a0.x, (int)a0.y, (int)a0.z, (int)a0.w, (int)a1.x, (int)a1.y, (int)a1.z, (int)a1.w};
        res[g] = __builtin_amdgcn_mfma_scale_f32_16x16x128_f8f6f4(av, bfr, (f32x4){0.f, 0.f, 0.f, 0.f}, 0, 0, 0, 0x7f7f7f7f, 0, 0x7f7f7f7f);
    }
    f32x4 o = res[0];
#pragma unroll
    for (int g = 1; g < 4; ++g) { const bool sel = ((r >> 1) == g);
#pragma unroll
        for (int i = 0; i < 4; ++i) o[i] = sel ? res[g][i] : o[i]; }
#pragma unroll
    for (int i = 0; i < 4; ++i) o[i] += dpp_swap1(o[i]);
    if (r < 8 && (r & 1) == 0) { v2u w; w.x = pk2(o[0], o[1]); w.y = pk2(o[2], o[3]); *(v2u*)(HPt + (r >> 1) * 16 + 4 * kq) = w; }
}
__device__ __forceinline__ int pg_idx(const int* IDXl, int h, int hl) { h = min(h, hl); return IDXl[(size_t)(h >> 1) * 128 + (h & 1) * 64]; }
__device__ __forceinline__ void peer_u_wave(const Args& a, LAS unsigned char* wlds, LAS unsigned char* wsm, int slab, int t0, int ntok, int lane) {
    const unsigned char* U8 = a.ws + WS_PU + (size_t)slab * (16384 * 128);
    const bf16* N2 = (const bf16*)(a.ws + WS_N2) + slab * 128 + 2 * lane;
    const int* IDX = (const int*)(a.ws + WS_IDX) + (lane >> 3);
    bf16* HP = (bf16*)(a.ws + WS_HPART) + (size_t)slab * MTOK * 128;
    const int r = lane & 15, kq = lane >> 4, tl = t0 + ntok - 1, H0 = 2 * t0, HL = 2 * (t0 + ntok) - 1;
    PHalf d[4]; PIdx iv[4]; v8i_t bfr;
#pragma unroll
    for (int k = 0; k < 4; ++k) pg_idx8(IDX, H0 + k, HL, iv[k]);
    unsigned xw = *(const unsigned*)(N2 + (size_t)t0 * DM);
    pg_issue(U8, iv[0], lane, d[0]); pg_issue(U8, iv[1], lane, d[1]); pg_issue(U8, iv[2], lane, d[2]);
    pg_idx8(IDX, H0 + 4, HL, iv[0]); pg_idx8(IDX, H0 + 5, HL, iv[1]); pg_idx8(IDX, H0 + 6, HL, iv[2]);
    pg_stage(wlds, lane, d[0]);
#define PU_XPREP(tok) do { pu_xprep(wsm, xw, lane); \
        { const LAS unsigned char* bp = wsm + ((r & 1) ? 128 : 0) + kq * 32; const v4u b0 = *(const LAS v4u*)bp, b1 = *(const LAS v4u*)(bp + 16); \
          bfr = (v8i_t){(int)b0.x, (int)b0.y, (int)b0.z, (int)b0.w, (int)b1.x, (int)b1.y, (int)b1.z, (int)b1.w}; } \
        xw = *(const unsigned*)(N2 + (size_t)min((tok) + 1, tl) * DM); } while (0)
#define PU_PHASE(ph, hrel, tok, half) do { \
        pg_issue(U8, iv[((ph) + 3) & 3], lane, d[((ph) + 3) & 3]); pg_idx8(IDX, hb + (hrel) + 7, HL, iv[((ph) + 3) & 3]); \
        pu_compute(wlds + ((half) ? 8192 : 0), HP + (size_t)(tok) * 128 + (half) * 64, r, kq, bfr); \
        pg_stage(wlds + ((half) ? 0 : 8192), lane, d[((ph) + 1) & 3]); } while (0)
#pragma unroll 1
    for (int hb = H0; hb <= HL; hb += 4) {
        const int t = hb >> 1;
        PU_XPREP(t);
        PU_PHASE(0, 0, t, 0);
        PU_PHASE(1, 1, t, 1);
        PU_XPREP(t + 1);
        PU_PHASE(2, 2, t + 1, 0);
        PU_PHASE(3, 3, t + 1, 1);
    }
#undef PU_XPREP
#undef PU_PHASE
}
__device__ __forceinline__ void peer_reduce(const Ctx& C, const Args& a) {
    const bf16* HP = (const bf16*)(a.ws + WS_HPART); const int* IDX = (const int*)(a.ws + WS_IDX); const float* WGT = (const float*)(a.ws + WS_WGT);
    const float* USC = (const float*)(a.ws + WS_PSC); const float* VSC = USC + 16384;
    unsigned char* ACT8 = a.ws + WS_ACT; float* ASC = (float*)(a.ws + WS_ACT + 8 * MiB);
    for (int it = C.vcu * 512 + C.tid; it < MTOK * 32; it += C.G * 512) {
        f32x4 h = {0.f, 0.f, 0.f, 0.f};
#pragma unroll
        for (int sl = 0; sl < 8; ++sl) { const v2u w = *(const v2u*)(HP + (size_t)sl * MTOK * 128 + (size_t)it * 4); h[0] += bflo(w.x); h[1] += bfhi(w.x); h[2] += bflo(w.y); h[3] += bfhi(w.y); }
        const int4 e = *(const int4*)(IDX + (size_t)it * 4); const f32x4 w = *(const f32x4*)(WGT + (size_t)it * 4);
        const int tok = it >> 5, q = it & 31;
        const float rs = 0.0625f * __builtin_amdgcn_rsqf(((const float*)(a.ws + WS_SS))[tok] * (1.f / DM) + EPS);
        f32x4 o;
        o[0] = gelu_tanh(h[0] * USC[e.x] * rs) * w[0] * VSC[e.x]; o[1] = gelu_tanh(h[1] * USC[e.y] * rs) * w[1] * VSC[e.y];
        o[2] = gelu_tanh(h[2] * USC[e.z] * rs) * w[2] * VSC[e.z]; o[3] = gelu_tanh(h[3] * USC[e.w] * rs) * w[3] * VSC[e.w];
        float mx = fmaxf(fmaxf(fabsf(o[0]), fabsf(o[1])), fmaxf(fabsf(o[2]), fabsf(o[3])));
#pragma unroll
        for (int sh = 1; sh < 32; sh <<= 1) mx = fmaxf(mx, __shfl_xor(mx, sh));
        int ex = (int)((__builtin_bit_cast(unsigned, mx) >> 23) & 0xffu) - 127; if (mx < 1e-30f) ex = 7;
        const float sc = __builtin_bit_cast(float, (unsigned)(127 + 7 - ex) << 23), isc = __builtin_bit_cast(float, (unsigned)(127 - 7 + ex) << 23);
        o = o * sc;
        int hi = __builtin_amdgcn_cvt_pk_fp8_f32(o[0], o[1], 0, false); hi = __builtin_amdgcn_cvt_pk_fp8_f32(o[2], o[3], hi, true);
        const f32x2v b0 = __builtin_amdgcn_cvt_pk_f32_fp8(hi, false), b1 = __builtin_amdgcn_cvt_pk_f32_fp8(hi, true);
        int lo = __builtin_amdgcn_cvt_pk_fp8_f32(o[0] - b0.x, o[1] - b0.y, 0, false); lo = __builtin_amdgcn_cvt_pk_fp8_f32(o[2] - b1.x, o[3] - b1.y, lo, true);
        *(unsigned*)(ACT8 + (size_t)tok * 256 + 4 * q) = (unsigned)hi; *(unsigned*)(ACT8 + (size_t)tok * 256 + 128 + 4 * q) = (unsigned)lo;
        if (q == 0) ASC[tok] = isc;
    }
}
typedef int v2i_t __attribute__((ext_vector_type(2)));
__device__ __forceinline__ void pv_compute(const LAS unsigned char* buf, int lane, const long* bact2, f32x4 (&acc)[8]) {
    const int i16 = lane & 15, kq = lane >> 4, rr = i16 >> 1, cc = i16 & 1;
#pragma unroll
    for (int s2 = 0; s2 < 2; ++s2) {
        const int row = 32 * s2 + 8 * kq + rr, sw = row & 7;
#pragma unroll
        for (int nb = 0; nb < 8; ++nb) {
            const v2i_t av = __builtin_amdgcn_ds_read_tr8_b64_v2i32((LAS v2i_t*)(buf + row * 128 + ((nb ^ sw) & 7) * 16 + 8 * cc));
            acc[nb] = __builtin_amdgcn_mfma_f32_16x16x32_fp8_fp8(mk64((unsigned)av.x, (unsigned)av.y), bact2[s2], acc[nb], 0, 0, 0);
        }
    }
}
__device__ __forceinline__ void peer_v_wave(const Args& a, LAS unsigned char* wlds, int slab, int t0, int ntok, int lane) {
    const unsigned char* V8 = a.ws + WS_PV + (size_t)slab * (16384 * 128);
    const int* IDX = (const int*)(a.ws + WS_IDX) + (lane >> 3);
    const int n16 = lane & 15, kq = lane >> 4, tl = t0 + ntok - 1, H0 = 2 * t0, HL = 2 * (t0 + ntok) - 1;
    const unsigned char* ACT8 = a.ws + WS_ACT + ((n16 & 1) ? 128 : 0) + 8 * kq; const float* ASC = (const float*)(a.ws + WS_ACT + 8 * MiB);
    bf16* PO = (bf16*)(a.ws + WS_POUT) + slab * 128;
    PHalf d[4]; PIdx iv[4]; long bact[4], bnxt[4]; f32x4 acc[8]; float isc = 1.f, iscn;
#pragma unroll
    for (int k = 0; k < 4; ++k) pg_idx8(IDX, H0 + k, HL, iv[k]);
#pragma unroll
    for (int s4 = 0; s4 < 4; ++s4) bnxt[s4] = *(const long*)(ACT8 + (size_t)t0 * 256 + 32 * s4);
    iscn = ASC[t0];
    pg_issue(V8, iv[0], lane, d[0]); pg_issue(V8, iv[1], lane, d[1]); pg_issue(V8, iv[2], lane, d[2]);
    pg_idx8(IDX, H0 + 4, HL, iv[0]); pg_idx8(IDX, H0 + 5, HL, iv[1]); pg_idx8(IDX, H0 + 6, HL, iv[2]);
    pg_stage(wlds, lane, d[0]);
#define PV_APREP(tok) do { \
        _Pragma("unroll") for (int s4 = 0; s4 < 4; ++s4) bact[s4] = bnxt[s4]; isc = iscn; \
        { const int tn = min((tok) + 1, tl); \
          _Pragma("unroll") for (int s4 = 0; s4 < 4; ++s4) bnxt[s4] = *(const long*)(ACT8 + (size_t)tn * 256 + 32 * s4); iscn = ASC[tn]; } \
        _Pragma("unroll") for (int nb = 0; nb < 8; ++nb) acc[nb] = (f32x4){0.f, 0.f, 0.f, 0.f}; } while (0)
#define PV_PHASE(ph, hrel, half) do { \
        pg_issue(V8, iv[((ph) + 3) & 3], lane, d[((ph) + 3) & 3]); pg_idx8(IDX, hb + (hrel) + 7, HL, iv[((ph) + 3) & 3]); \
        pv_compute(wlds + ((half) ? 8192 : 0), lane, bact + 2 * (half), acc); \
        pg_stage(wlds + ((half) ? 0 : 8192), lane, d[((ph) + 1) & 3]); } while (0)
#define PV_EPI(tok) do { f32x4 o = acc[0]; \
        _Pragma("unroll") for (int nb = 1; nb < 8; ++nb) { const bool sel = ((n16 >> 1) == nb); \
            _Pragma("unroll") for (int i = 0; i < 4; ++i) o[i] = sel ? acc[nb][i] : o[i]; } \
        _Pragma("unroll") for (int i = 0; i < 4; ++i) o[i] += dpp_swap1(o[i]); \
        if ((n16 & 1) == 0) { v2u w; w.x = pk2(o[0] * isc, o[1] * isc); w.y = pk2(o[2] * isc, o[3] * isc); *(v2u*)(PO + (size_t)(tok) * DM + 16 * (n16 >> 1) + 4 * kq) = w; } } while (0)
#pragma unroll 1
    for (int hb = H0; hb <= HL; hb += 4) {
        const int t = hb >> 1;
        PV_APREP(t);
        PV_PHASE(0, 0, 0);
        PV_PHASE(1, 1, 1);
        PV_EPI(t);
        PV_APREP(t + 1);
        PV_PHASE(2, 2, 0);
        PV_PHASE(3, 3, 1);
        PV_EPI(t + 1);
    }
#undef PV_APREP
#undef PV_PHASE
#undef PV_EPI
}
__device__ __forceinline__ void final_rows4(const Args& a, int tok0, int tstep, int lane) {
    const float* gf = (const float*)a.in[25] + lane * 4;
    f32x4 h[4][4]; v2u pw[4][4], hw[4][4]; float ss[4];
#pragma unroll
    for (int i = 0; i < 4; ++i) { const int tok = tok0 + i * tstep; const bf16* hb = (const bf16*)(a.ws + WS_N2) + (size_t)tok * DM + lane * 4; const bf16* po = (const bf16*)(a.ws + WS_POUT) + (size_t)tok * DM + lane * 4;
#pragma unroll
        for (int q = 0; q < 4; ++q) { hw[i][q] = *(const v2u*)(hb + 256 * q); pw[i][q] = *(const v2u*)(po + 256 * q); } }
#pragma unroll
    for (int i = 0; i < 4; ++i) { ss[i] = 0.f;
#pragma unroll
        for (int q = 0; q < 4; ++q) { h[i][q][0] = bflo(hw[i][q].x) + bflo(pw[i][q].x); h[i][q][1] = bfhi(hw[i][q].x) + bfhi(pw[i][q].x); h[i][q][2] = bflo(hw[i][q].y) + bflo(pw[i][q].y); h[i][q][3] = bfhi(hw[i][q].y) + bfhi(pw[i][q].y);
            ss[i] += (h[i][q][0] * h[i][q][0] + h[i][q][1] * h[i][q][1]) + (h[i][q][2] * h[i][q][2] + h[i][q][3] * h[i][q][3]); } }
#pragma unroll
    for (int o = 1; o < 64; o <<= 1)
#pragma unroll
        for (int i = 0; i < 4; ++i) ss[i] += __shfl_xor(ss[i], o);
    f32x4 g[4];
#pragma unroll
    for (int q = 0; q < 4; ++q) g[q] = *(const f32x4*)(gf + 256 * q);
#pragma unroll
    for (int i = 0; i < 4; ++i) { const float rstd = 1.0f / sqrtf(ss[i] * (1.f / DM) + EPS); float* orow = a.out + (size_t)(tok0 + i * tstep) * DM + lane * 4;
#pragma unroll
        for (int q = 0; q < 4; ++q) *(f32x4*)(orow + 256 * q) = h[i][q] * rstd * g[q]; }
}

__device__ __forceinline__ void claim_slab_unit(const Ctx& C, unsigned* ctl, int pass, volatile LAS unsigned* MISC, int& slab, int& unit) {
    if (C.tid == 0) {
        const unsigned x = xb_xcc_id() & 7u; unsigned sl = 8u, un = 0u;
        for (unsigned k = 0; k < 8u; ++k) { const unsigned s2 = (x + k) & 7u; const unsigned u2 = xb_add(ctl + CW_Q + 1024 * pass + 64 * s2, 1u); if (u2 < 32u) { sl = s2; un = u2; break; } }
        MISC[16] = sl; MISC[17] = un;
    }
    __syncthreads();
    slab = (int)MISC[16]; unit = (int)MISC[17];
    __syncthreads();
}
__global__ void __launch_bounds__(NWAVES * 64, 2) mk_fwd(Args args) {
    extern __shared__ __attribute__((aligned(16))) unsigned char lds_raw[];
    Ctx C;
    C.lds = (LAS unsigned char*)lds_raw;
    C.wave = __builtin_amdgcn_readfirstlane((int)threadIdx.x >> 6); C.refresh();
    C.G = gridDim.x; { const int bx = blockIdx.x; C.vcu = (C.G % 8 == 0) ? (bx % 8) * (C.G / 8) + bx / 8 : bx; }
    volatile LAS unsigned* MISC = (volatile LAS unsigned*)(C.lds + MISC_OFF);
    if (C.tid < 128) MISC[C.tid] = 0u;
    __syncthreads();
    unsigned char* ws = args.ws;
    unsigned* ctl = (unsigned*)(ws + WS_CTL);
    XcdBarrier bar; bar.bar = ctl + CW_BAR; bar.x = 0; bar.st = nullptr;
#if !MK_PER_PHASE
    bar = xcd_barrier_post(ctl + CW_BAR, MISC + 8, C.tid == 0);
#define GRID_BAR() xcd_barrier(bar, C.wave)
#else
#define GRID_BAR() do { } while (0)
#endif
    const int lo = args.ph_lo, hi = args.ph_hi;
#define IN(k) (lo <= (k) && (k) < hi)
#define SEAM(k) do { if (IN((k) + 1)) GRID_BAR(); C.refresh(); } while (0)
#define REP(k) for (int rep_ = 0; rep_ < 1 + ((REPEAT_MASK >> (k)) & 1); ++rep_)
    bf16* XN = (bf16*)(ws + WS_A);
    if (IN(0)) { REP(0) { p0_prologue(C, args); __syncthreads(); } SEAM(0); }
    if (IN(1)) {
        REP(1) {
        run_gemm(C, XN, (const bf16*)(ws + WS_WIN_T), MTOK, NZ1, DM, FStore{(bf16*)(ws + WS_Z1), NZ1});
        }
        SEAM(1);
    }
    if (IN(2)) {
        REP(2) { const int tile = C.vcu;
            _Pragma("unroll 1") for (int h = 0; h < 4; ++h) r1_unit(C, args, tile, h);
            _Pragma("unroll 1") for (int gi = 0; gi < 2; ++gi) s5a_wave(C, args, tile, C.wave + 8 * gi);
            __syncthreads();
        }
        SEAM(2);
    }
    if (IN(3)) { REP(3) { p3_scans(C, args); }
        run_gemm(C, (const bf16*)(ws + WS_MEMN), (const bf16*)(ws + WS_WMKV_T), MROWS, 512, DM, FKvm{(bf16*)(ws + WS_KM), (bf16*)(ws + WS_VT)});
        SEAM(3); }
    if (IN(4)) {
        REP(4) { const int tile = C.vcu;
            _Pragma("unroll 1") for (int gi = 0; gi < 2; ++gi) r3_wave(C, args, tile, 2 * gi + (C.wave >> 2), C.wave & 3);
            _Pragma("unroll 1") for (int gi = 0; gi < 2; ++gi) s5c_wave(C, args, tile, C.wave + 8 * gi);
            _Pragma("unroll 1") for (int gi = 0; gi < 2; ++gi) ma_wave(C, args, tile, 2 * gi + (C.wave >> 2), C.wave & 3);
        }
        SEAM(4);
    }
    if (IN(5)) {
        REP(5) {
        run_gemm_mx(C, ws + WS_XN8, ws + WS_WG8, MTOK, NGATE, DM, FSig{(bf16*)(ws + WS_G), NGATE}, 0x7b7b7b7b  , 0x77777777  );
        run_gemm(C, (const bf16*)(ws + WS_YG), (const bf16*)(ws + WS_WGLU_T), MTOK, 512, 256, FGlu{(bf16*)(ws + WS_YCAT)});
        }
        SEAM(5);
    }
    if (IN(6)) {
        const bf16* Gt = (const bf16*)(ws + WS_G);
        run_gemm_hook(C, (const bf16*)(ws + WS_YCAT), (const bf16*)(ws + WS_WCAT_T), MTOK, DM, DM, FGateOut{Gt, XN}, HookGate{Gt});
        SEAM(6);
    }
    if (IN(7)) { run_gemm(C, XN, (const bf16*)(ws + WS_WOUT_T), MTOK, DM, DM, FRes{(const float*)args.in[0], (bf16*)(ws + WS_N2), (float*)(ws + WS_SS)}); SEAM(7); }
    if (IN(9)) { REP(9) run_gemm(C, (const bf16*)(ws + WS_N2), (const bf16*)(ws + WS_WQ_T), MTOK, 2048, DM, FStoreRstd{(bf16*)(ws + WS_Q2), 2048, (const float*)(ws + WS_SS)}); SEAM(9); }
    if (IN(10)) {
        { const int tile = C.vcu;
            const int tokbase = tile * 128 + (C.wave & 3) * 32, h0 = (C.wave >> 2) * 4;
            REP(10) { _Pragma("unroll 1") for (int hp = h0; hp < h0 + 4; ++hp) peer_topk_head(C, args, tokbase, hp); }
        }
        SEAM(10);
    }
    if (IN(11)) { int slab, unit; claim_slab_unit(C, ctl, 0, MISC, slab, unit); if (slab < 8) { REP(11) peer_u_wave(args, C.lds + C.wave * 16384, C.lds + 131072 + C.wave * 1024, slab, unit * 1024 + C.wave * 128, 128, C.lane); } SEAM(11); }
    if (IN(12)) { REP(12) peer_reduce(C, args); SEAM(12); }
    if (IN(13)) { int slab, unit; claim_slab_unit(C, ctl, 1, MISC, slab, unit); if (slab < 8) { REP(13) peer_v_wave(args, C.lds + C.wave * 16384, slab, unit * 1024 + C.wave * 128, 128, C.lane); } SEAM(13); }
    if (IN(14)) {
        const int gw = C.vcu * NWAVES + C.wave, NGW = C.G * NWAVES;
        for (int m = gw; m < MTOK; m += 4 * NGW) final_rows4(args, m, NGW, C.lane);
    }
#undef IN
#undef SEAM
}

extern "C" void kernel_launch(void* const* d_in, const int* in_sizes, int n_in, void* d_out, int out_size, void* d_ws, size_t ws_size, hipStream_t stream) {
    static int grid = 0;
    if (grid == 0) {
        if (n_in != 26 || in_sizes[0] != MTOK * DM || out_size != MTOK * DM || ws_size < WS_END) {
            fprintf(stderr, "kernel_launch: unexpected problem (n_in %d, in0 %d, out %d, ws %zu < %zu); nothing launched\n", n_in, n_in > 0 ? in_sizes[0] : -1, out_size, ws_size, (size_t)WS_END); grid = -1; return; }
        int dev = 0, cus = 0;
        if (hipGetDevice(&dev) != hipSuccess || hipDeviceGetAttribute(&cus, hipDeviceAttributeMultiprocessorCount, dev) != hipSuccess) { grid = -1; return; }
        if (hipFuncSetAttribute((const void*)mk_fwd, hipFuncAttributeMaxDynamicSharedMemorySize, LDS_BYTES) != hipSuccess) { fprintf(stderr, "kernel_launch: hipFuncSetAttribute failed\n"); grid = -1; return; }
        (void)hipGetLastError();
        if (cus < NTILES) { fprintf(stderr, "kernel_launch: needs >= 256 CUs, got %d\n", cus); grid = -1; return; }
        grid = NTILES;
    }
    if (grid < 0) return;
    (void)hipMemsetAsync((char*)d_ws + WS_CTL, 0, CTL_ZERO_BYTES, stream);
    Args a{};
    for (int i = 0; i < 26; ++i) a.in[i] = d_in[i];
    a.out = (float*)d_out; a.ws = (unsigned char*)d_ws;
#if MK_PER_PHASE
    for (int p = 0; p < NPHASE; ++p) { a.ph_lo = p; a.ph_hi = p + 1; hipLaunchKernelGGL(mk_fwd, dim3(grid), dim3(NWAVES * 64), LDS_BYTES, stream, a); }
#else
    a.ph_lo = 0; a.ph_hi = NPHASE;
    hipLaunchKernelGGL(mk_fwd, dim3(grid), dim3(NWAVES * 64), LDS_BYTES, stream, a);
#endif
}
```

```cpp
#include <hip/hip_runtime.h>
#include <cstdio>
#include <cstdint>
namespace pg8 {
__device__ __forceinline__ int hw_lane_id() { int l; asm volatile("v_mbcnt_lo_u32_b32 %0, -1, 0\n\tv_mbcnt_hi_u32_b32 %0, -1, %0" : "=v"(l)); return l; }
#define PG8_LAS __attribute__((address_space(3)))
typedef unsigned short bf16_t;
typedef short bf16x8 __attribute__((ext_vector_type(8)));
typedef float f32x4 __attribute__((ext_vector_type(4)));
typedef unsigned u32x4 __attribute__((ext_vector_type(4)));
constexpr int BM = 256, BK = 64, HALF = 128, HTB = HALF * BK * 2  , STAGE_BYTES = 8 * HTB, NXCD = 8, WGM = 8;

__host__ __device__ __forceinline__ int lds_byte(int r, int c) { const int st = (r >> 4) * 2 + (c >> 5), rr = r & 15, cc = c & 31, ob = rr * 64 + cc * 2; return st * 1024 + (ob ^ (((ob >> 9) & 1) << 5)); }
__host__ __device__ __forceinline__ void stage_rc(int b, int& R, int& C) { const int st = b / 1024, sb = b % 1024, swz = sb ^ (((sb >> 9) & 1) << 5); R = (st >> 1) * 16 + swz / 64; C = (st & 1) * 32 + (swz % 64) / 2; }
__host__ __device__ __forceinline__ int perm32(int rho) { const int n = rho >> 4, i = rho & 15; return 8 * (i >> 2) + 4 * n + (i & 3); }

struct Unit { int pm, pn; };
struct Gemm { const bf16_t* A; const bf16_t* Bt; int M, N, K; };

struct StaticOrder {
    int nM, nN, nwg, G, c;
    __host__ __device__ void init(int M, int N, int G_, int c_) { nM = M / BM; nN = N / BM; nwg = nM * nN; G = G_; c = c_; }
    __host__ __device__ bool next(int i, Unit& u) const {
        const long L = (long)i * G + c; if (L >= nwg) return false;
        int wgid = (int)L; { const int q = nwg / NXCD, r = nwg % NXCD, xcd = wgid % NXCD, off = wgid / NXCD; wgid = (xcd < r ? xcd * (q + 1) : r * (q + 1) + (xcd - r) * q) + off; }
        const int nig = WGM * nN, gid = wgid / nig, fm = gid * WGM, gsz = (nM - fm) < WGM ? (nM - fm) : WGM;
        u.pm = fm + ((wgid % nig) % gsz); u.pn = (wgid % nig) / gsz; return true;
    }
    __device__ __forceinline__ void a_ready(const Unit&) const {}
    __device__ __forceinline__ void done(const Unit&) const {}
};

__device__ __forceinline__ unsigned cvt_pk_bf16(float lo, float hi) { unsigned r; asm volatile("v_cvt_pk_bf16_f32 %0, %1, %2" : "=v"(r) : "v"(lo), "v"(hi)); return r; }
struct NoKHook { __device__ __forceinline__ void operator()(int, f32x4 (&)[2][2][4][2], const Unit&, int, int, int, int) const {} };
template <class Epi, class Sched, bool ALIGN_EPI = false, bool SP2 = false, bool MX = false, class KHook = NoKHook>
__device__ __forceinline__ void gemm_phase(PG8_LAS unsigned char* lds, const Gemm g, const Sched& S, const Epi& E, const int wid, const int sclA = 0x7f7f7f7f, const int sclB = 0x7f7f7f7f, const KHook& KH = KHook()) {
    const int lane = hw_lane_id(), tid = wid * 64 + lane, wr = wid >> 2, wc = wid & 3, fr = lane & 15, fq = lane >> 4;
    const int K = g.K, nt = K / BK;
    unsigned voffA[2], voffB[2];
#pragma unroll
    for (int i = 0; i < 2; ++i) { int R, C; stage_rc(tid * 16 + i * 8192, R, C); const int Rb = Epi::PERM ? ((R & ~31) + perm32(R & 31)) : R;
        voffA[i] = (unsigned)(R * K + C) * 2u; voffB[i] = (unsigned)(Rb * K + C) * 2u; }
    const size_t kstep = (size_t)(BK * 2);
    const size_t hstep = (size_t)HALF * K * 2;
    const size_t tstep = 2 * hstep;
    const unsigned ldsw = (unsigned)wid * 1024u;
    const int aoff = lds_byte(wr * 64 + fr, fq * 8), boff = lds_byte(wc * 32 + fr, fq * 8);
#define PG8_SA(b, h) (((b) * 2 + (h)) * HTB)
#define PG8_SB(b, h) ((4 + (b) * 2 + (h)) * HTB)
#define PG8_STAGE(bufoff, gbase, voff) do { _Pragma("unroll") for (int _i = 0; _i < 2; ++_i) \
        __builtin_amdgcn_global_load_lds((const unsigned*)((const char*)(gbase) + (voff)[_i]), (PG8_LAS unsigned*)(lds + (bufoff) + ldsw + _i * 8192), 16, 0, 0); } while (0)
#define PG8_LDA(dst, b, h) do { _Pragma("unroll") for (int m = 0; m < 4; ++m) { \
        if constexpr (MX) { dst##8[m].lo = *(const PG8_LAS v4i_*)(lds + PG8_SA(b, h) + aoff + m * 2048); dst##8[m].hi = *(const PG8_LAS v4i_*)(lds + PG8_SA(b, h) + aoff + m * 2048 + 1024); } \
        else { _Pragma("unroll") for (int k = 0; k < 2; ++k) dst[m][k] = *(const PG8_LAS bf16x8*)(lds + PG8_SA(b, h) + aoff + m * 2048 + k * 1024); } } } while (0)
#define PG8_LDB(dst, b, h) do { _Pragma("unroll") for (int n = 0; n < 2; ++n) { \
        if constexpr (MX) { dst##8[n].lo = *(const PG8_LAS v4i_*)(lds + PG8_SB(b, h) + boff + n * 2048); dst##8[n].hi = *(const PG8_LAS v4i_*)(lds + PG8_SB(b, h) + boff + n * 2048 + 1024); } \
        else { _Pragma("unroll") for (int k = 0; k < 2; ++k) dst[n][k] = *(const PG8_LAS bf16x8*)(lds + PG8_SB(b, h) + boff + n * 2048 + k * 1024); } } } while (0)
#define PG8_MMA(ai, bj, At, Bt) do { __builtin_amdgcn_s_setprio(1); _Pragma("unroll") for (int m = 0; m < 4; ++m) _Pragma("unroll") for (int n = 0; n < 2; ++n) { \
        if constexpr (MX) acc[ai][bj][m][n] = __builtin_amdgcn_mfma_scale_f32_16x16x128_f8f6f4(Bt##8[n], At##8[m], acc[ai][bj][m][n], 0, 0, 0, sclB, 0, sclA); \
        else { _Pragma("unroll") for (int k = 0; k < 2; ++k) acc[ai][bj][m][n] = __builtin_amdgcn_mfma_f32_16x16x32_bf16(Bt[n][k], At[m][k], acc[ai][bj][m][n], 0, 0, 0); } } \
        if constexpr (MX) { _Pragma("unroll") for (int m = 0; m < 4; ++m) _Pragma("unroll") for (int n = 0; n < 2; ++n) asm volatile("" : "+v"(acc[ai][bj][m][n])); }     \
        __builtin_amdgcn_s_setprio(0); } while (0)
#define PG8_WAIT_V(n) asm volatile("s_waitcnt vmcnt(" #n ")" ::: "memory")
#define PG8_WAIT_L(n) asm volatile("s_waitcnt lgkmcnt(" #n ")" ::: "memory")
#define PG8_BAR __builtin_amdgcn_s_barrier()
#define PG8_SCHED __builtin_amdgcn_sched_barrier(0)
    Unit cur, nxt; int ui = 0;
    if (!S.next(0, cur)) return;
    f32x4 acc[2][2][4][2];
#pragma unroll
    for (int a = 0; a < 2; ++a)
#pragma unroll
        for (int b = 0; b < 2; ++b)
#pragma unroll
            for (int m = 0; m < 4; ++m)
#pragma unroll
                for (int n = 0; n < 2; ++n) acc[a][b][m][n] = (f32x4){0.f, 0.f, 0.f, 0.f};
    typedef int v8i_ __attribute__((ext_vector_type(8))); typedef int v4i_ __attribute__((ext_vector_type(4)));
    bf16x8 At[4][2], B0[2][2], B1[2][2]; v8i_ At8[4], B08[2], B18[2];
    const char* cA = (const char*)g.A + (size_t)cur.pm * tstep; const char* cB = (const char*)g.Bt + (size_t)cur.pn * tstep;
    S.a_ready(cur);
    if constexpr (SP2) {
        PG8_STAGE(PG8_SB(0, 0), cB, voffB); PG8_STAGE(PG8_SB(0, 1), cB + hstep, voffB); PG8_STAGE(PG8_SA(0, 0), cA, voffA); PG8_STAGE(PG8_SA(0, 1), cA + hstep, voffA);
        if (wr == 1) PG8_BAR;
        PG8_WAIT_V(2); PG8_BAR;
        PG8_STAGE(PG8_SB(1, 0), cB + kstep, voffB); PG8_STAGE(PG8_SA(1, 0), cA + kstep, voffA); PG8_STAGE(PG8_SB(1, 1), cB + hstep + kstep, voffB);
        PG8_WAIT_V(6); PG8_BAR;
    } else {
        PG8_STAGE(PG8_SB(0, 0), cB, voffB); PG8_STAGE(PG8_SA(0, 0), cA, voffA); PG8_STAGE(PG8_SB(0, 1), cB + hstep, voffB); PG8_STAGE(PG8_SA(0, 1), cA + hstep, voffA);
        if (wr == 1) PG8_BAR;
        PG8_WAIT_V(4); PG8_BAR;
        PG8_STAGE(PG8_SB(1, 0), cB + kstep, voffB); PG8_STAGE(PG8_SA(1, 0), cA + kstep, voffA); PG8_STAGE(PG8_SB(1, 1), cB + hstep + kstep, voffB);
        PG8_WAIT_V(6); PG8_BAR;
    }
    for (;;) {
        const bool has_next = S.next(ui + 1, nxt);
        const char* nA = has_next ? (const char*)g.A + (size_t)nxt.pm * tstep : cA; const char* nB = has_next ? (const char*)g.Bt + (size_t)nxt.pn * tstep : cB;
        for (int t = 0; t < nt; t += 2) {
            KH(t, acc, cur, wr, wc, fr, fq);
            const bool last = (t == nt - 2);
            const char* a1 = cA + (size_t)(t + 1) * kstep;
            const char* a2 = last ? nA : cA + (size_t)(t + 2) * kstep; const char* b2 = last ? nB : cB + (size_t)(t + 2) * kstep;
            const char* a3 = a2 + kstep; const char* b3 = b2 + kstep;
            if (last && has_next) S.a_ready(nxt);
            if constexpr (SP2) {
            PG8_LDB(B0, 0, 0); PG8_LDB(B1, 0, 1); PG8_SCHED; PG8_LDA(At, 0, 0); PG8_STAGE(PG8_SA(1, 1), a1 + hstep, voffA);
            PG8_WAIT_V(8); PG8_WAIT_L(0); PG8_BAR; PG8_MMA(0, 0, At, B0); PG8_MMA(0, 1, At, B1); PG8_BAR; PG8_SCHED;
            PG8_LDA(At, 0, 1); PG8_STAGE(PG8_SB(0, 0), b2, voffB); PG8_STAGE(PG8_SB(0, 1), b2 + hstep, voffB); PG8_STAGE(PG8_SA(0, 0), a2, voffA);
            PG8_WAIT_V(8); PG8_WAIT_L(0); PG8_BAR; PG8_MMA(1, 0, At, B0); PG8_MMA(1, 1, At, B1); PG8_BAR; PG8_SCHED;
            PG8_LDB(B0, 1, 0); PG8_LDB(B1, 1, 1); PG8_SCHED; PG8_LDA(At, 1, 0); PG8_STAGE(PG8_SA(0, 1), a2 + hstep, voffA);
            PG8_WAIT_V(8); PG8_WAIT_L(0); PG8_BAR; PG8_MMA(0, 0, At, B0); PG8_MMA(0, 1, At, B1); PG8_BAR; PG8_SCHED;
            PG8_LDA(At, 1, 1); PG8_STAGE(PG8_SB(1, 0), b3, voffB); PG8_STAGE(PG8_SB(1, 1), b3 + hstep, voffB); PG8_STAGE(PG8_SA(1, 0), a3, voffA);
            PG8_WAIT_V(8); PG8_WAIT_L(0); PG8_BAR; PG8_MMA(1, 0, At, B0); PG8_MMA(1, 1, At, B1); PG8_BAR; PG8_SCHED;
            } else {
            PG8_LDB(B0, 0, 0); PG8_SCHED; PG8_LDA(At, 0, 0); PG8_STAGE(PG8_SA(1, 1), a1 + hstep, voffA);
            PG8_WAIT_L(8); PG8_BAR; PG8_WAIT_L(0); PG8_MMA(0, 0, At, B0); PG8_BAR; PG8_SCHED;
            PG8_LDB(B1, 0, 1); PG8_STAGE(PG8_SB(0, 0), b2, voffB);
            PG8_BAR; PG8_WAIT_L(0); PG8_MMA(0, 1, At, B1); PG8_BAR;
            PG8_LDA(At, 0, 1); PG8_STAGE(PG8_SA(0, 0), a2, voffA);
            PG8_BAR; PG8_WAIT_L(0); PG8_MMA(1, 0, At, B0); PG8_BAR; PG8_SCHED;
            PG8_STAGE(PG8_SB(0, 1), b2 + hstep, voffB);
            PG8_WAIT_V(6); PG8_BAR; PG8_MMA(1, 1, At, B1); PG8_BAR;
            PG8_LDB(B0, 1, 0); PG8_SCHED; PG8_LDA(At, 1, 0); PG8_STAGE(PG8_SA(0, 1), a2 + hstep, voffA);
            PG8_WAIT_L(8); PG8_BAR; PG8_WAIT_L(0); PG8_MMA(0, 0, At, B0); PG8_BAR; PG8_SCHED;
            PG8_LDB(B1, 1, 1); PG8_STAGE(PG8_SB(1, 0), b3, voffB);
            PG8_BAR; PG8_WAIT_L(0); PG8_MMA(0, 1, At, B1); PG8_BAR;
            PG8_LDA(At, 1, 1); PG8_STAGE(PG8_SA(1, 0), a3, voffA);
            PG8_BAR; PG8_WAIT_L(0); PG8_MMA(1, 0, At, B0); PG8_BAR; PG8_SCHED;
            PG8_STAGE(PG8_SB(1, 1), b3 + hstep, voffB);
            PG8_WAIT_V(6); PG8_BAR; PG8_MMA(1, 1, At, B1); PG8_BAR;
            }
        }
        if constexpr (ALIGN_EPI) { if (wr == 0) PG8_BAR; }
        if constexpr (!Epi::AFTER_DRAIN) { E(acc, cur, wr, wc, fr, fq); S.done(cur); }
        if (!has_next) break;
#pragma unroll
        for (int a = 0; a < 2; ++a)
#pragma unroll
            for (int b = 0; b < 2; ++b)
#pragma unroll
                for (int m = 0; m < 4; ++m)
#pragma unroll
                    for (int n = 0; n < 2; ++n) acc[a][b][m][n] = (f32x4){0.f, 0.f, 0.f, 0.f};
        cur = nxt; cA = nA; cB = nB; ++ui;
        if constexpr (ALIGN_EPI) { if (wr == 1) PG8_BAR; }
    }
    PG8_WAIT_V(0);
    if constexpr (!ALIGN_EPI) { if (wr == 0) PG8_BAR; }
    PG8_BAR;
    if constexpr (Epi::AFTER_DRAIN) { E.fused(acc, cur, wr, wc, fr, fq, lds, wid, lane); S.done(cur); }
#undef PG8_SA
#undef PG8_SB
#undef PG8_STAGE
#undef PG8_LDA
#undef PG8_LDB
#undef PG8_MMA
#undef PG8_WAIT_V
#undef PG8_WAIT_L
#undef PG8_BAR
#undef PG8_SCHED
}
}

#ifndef REPEAT_MASK
#define REPEAT_MASK 0
#endif
#ifndef MK_PER_PHASE
#define MK_PER_PHASE 0
#endif

constexpr int DM = 1024, BATCH = 8, SEQ = 4096, MTOK = BATCH * SEQ;
constexpr int MEMLEN = 256, MROWS = BATCH * MEMLEN;
constexpr int NZ1 = 2560, NGATE = 3072;
constexpr int ZQ = 0, ZK = 512, ZV = 1024, ZGR = 1536, ZU = 2048, ZQM = 2304;
constexpr int NTILES = MTOK / 128;
constexpr float EPS = 1e-6f;
constexpr int NPHASE = 15;

constexpr size_t MiB = 1u << 20;
constexpr size_t WS_CTL = 0, CTL_ZERO_BYTES = 1 * MiB;
constexpr size_t WS_WIN_T = 1 * MiB;
constexpr size_t WS_WQ_T = 12 * MiB;
constexpr size_t WS_WOUT_T = 16 * MiB;
constexpr size_t WS_WCAT_T = 18 * MiB;
constexpr size_t WS_WGLU_T = 20 * MiB;
constexpr size_t WS_WMKV_T = 21 * MiB;
constexpr size_t WS_KEYS = 22 * MiB;
constexpr size_t WS_S5MAT = 23 * MiB;
constexpr size_t WS_S5C = 25 * MiB;
constexpr size_t WS_PSC = 25 * MiB + 256 * 1024;
constexpr size_t WS_SS = 25 * MiB + 512 * 1024;
constexpr size_t WS_ROPE = 26 * MiB;
constexpr size_t WS_PU = 42 * MiB;
constexpr size_t WS_PV = 58 * MiB;
constexpr size_t WS_XN8 = 74 * MiB;
constexpr size_t WS_WG8 = WS_WIN_T + 5 * MiB;
constexpr size_t WS_MEMN = 106 * MiB;
constexpr size_t WS_KM = 110 * MiB;
constexpr size_t WS_VT = 111 * MiB;
constexpr size_t WS_S5E = 112 * MiB;
constexpr size_t WS_S5X = 114 * MiB;
constexpr size_t WS_A = 116 * MiB;
constexpr size_t WS_B = 180 * MiB;
constexpr size_t WS_Z1 = WS_B;
constexpr size_t WS_G = WS_B;
constexpr size_t WS_QRF = WS_B + 160 * MiB;
constexpr size_t WS_YCAT = WS_B + 192 * MiB;
constexpr size_t WS_YG = WS_B + 256 * MiB;
constexpr size_t WS_INNER = WS_B + 272 * MiB;
constexpr size_t WS_N2 = WS_B;
constexpr size_t WS_Q2 = WS_B + 64 * MiB;
constexpr size_t WS_IDX = WS_B + 192 * MiB;
constexpr size_t WS_WGT = WS_B + 208 * MiB;
constexpr size_t WS_HPART = WS_B + 128 * MiB;
constexpr size_t WS_ACT = WS_B + 224 * MiB;
constexpr size_t WS_POUT = WS_B + 64 * MiB;
constexpr size_t WS_END = WS_B + 304 * MiB;

constexpr int CW_BAR = 4096;
constexpr int CW_Q = 8192;

constexpr int LDS_BYTES = 147456;
constexpr int MISC_OFF = LDS_BYTES - 512;
constexpr int NWAVES = 8;

#define GAS __attribute__((address_space(1)))
#define LAS __attribute__((address_space(3)))
typedef unsigned short bf16;
typedef unsigned v4u __attribute__((ext_vector_type(4)));
typedef unsigned v2u __attribute__((ext_vector_type(2)));
typedef float f32x4 __attribute__((ext_vector_type(4)));
typedef float f32x16 __attribute__((ext_vector_type(16)));
typedef short bf16x8 __attribute__((ext_vector_type(8)));
typedef GAS unsigned gu32;
#define RLX_AGENT __ATOMIC_RELAXED, __HIP_MEMORY_SCOPE_AGENT
#define LDS_WAIT() asm volatile("s_waitcnt lgkmcnt(0)" ::: "memory")
#define VM_WAIT() asm volatile("s_waitcnt vmcnt(0)" ::: "memory")
__device__ __forceinline__ unsigned f2bf(float f) { unsigned u = __builtin_bit_cast(unsigned, f); return (u + 0x7fffu + ((u >> 16) & 1u)) >> 16; }
typedef __bf16 hwbf16x2_t __attribute__((ext_vector_type(2)));
typedef float hwf32x2_t __attribute__((ext_vector_type(2)));
__device__ __forceinline__ unsigned pk2(float lo, float hi) { const hwf32x2_t v = {lo, hi}; const hwbf16x2_t b = __builtin_convertvector(v, hwbf16x2_t); return __builtin_bit_cast(unsigned, b); }
__device__ __forceinline__ float bflo(unsigned w) { return __builtin_bit_cast(float, w << 16); }
__device__ __forceinline__ float bfhi(unsigned w) { return __builtin_bit_cast(float, w & 0xffff0000u); }
__device__ __forceinline__ float bf2f(bf16 h) { return __builtin_bit_cast(float, (unsigned)h << 16); }
__device__ __forceinline__ f32x16 mfma32(bf16x8 a, bf16x8 b, f32x16 c) { return __builtin_amdgcn_mfma_f32_32x32x16_bf16(a, b, c, 0, 0, 0); }
__device__ __forceinline__ f32x4 mfma16(bf16x8 a, bf16x8 b, f32x4 c) { return __builtin_amdgcn_mfma_f32_16x16x32_bf16(a, b, c, 0, 0, 0); }
__device__ __forceinline__ bf16x8 mk8(unsigned a, unsigned b, unsigned c, unsigned d) { v4u t = {a, b, c, d}; return __builtin_bit_cast(bf16x8, t); }
__device__ __forceinline__ float sigmoidf_(float x) { return __builtin_amdgcn_rcpf(1.0f + __builtin_amdgcn_exp2f(-1.4426950408889634f * x)); }
__device__ __forceinline__ float gelu_tanh(float x) {
    const float u2 = 1.5957691216057308f * (x + 0.044715f * x * x * x);
    return x * __builtin_amdgcn_rcpf(1.0f + __builtin_amdgcn_exp2f(-1.4426950408889634f * u2));
}
__device__ __forceinline__ float wave_sum(float v) {
#pragma unroll
    for (int o = 1; o < 64; o <<= 1) v += __shfl_xor(v, o);
    return v;
}

#define XB_TMO      128
#define XB_XCNT(j)  (256  + 64 * (j))
#define XB_XSUB(j)  (1280 + 64 * (j))
#define XB_XGEN(j)  (2304 + 64 * (j))
#define XB_TOP      3328
#define XB_TOPGEN   3392
#define XCD_BAR_WORDS 3456
#define XB_SPIN_CAP (1u << 22)

__device__ __forceinline__ unsigned xb_ld(unsigned* p)              { return __hip_atomic_load(p, __ATOMIC_RELAXED, __HIP_MEMORY_SCOPE_AGENT); }
__device__ __forceinline__ unsigned xb_add(unsigned* p, unsigned v) { return __hip_atomic_fetch_add(p, v, __ATOMIC_RELAXED, __HIP_MEMORY_SCOPE_AGENT); }
__device__ __forceinline__ unsigned xb_xcc_id() { return (unsigned)__builtin_amdgcn_s_getreg((3 << 11) | 20) & 0xFu; }
#define XB_SPIN(cond, bar) do { unsigned _sp = 0; while (cond) { __builtin_amdgcn_s_sleep(1); \
    if ((++_sp & 255u) == 0u) { if (xb_ld(&(bar)[XB_TMO])) break; if (_sp > XB_SPIN_CAP) { atomicAdd(&(bar)[XB_TMO], 1u); break; } } } } while (0)

struct XcdBarrier { unsigned* bar; unsigned x; volatile LAS unsigned* st; };

__device__ __forceinline__ XcdBarrier xcd_barrier_post(unsigned* bar, volatile LAS unsigned* st, bool tid0) {
    XcdBarrier b; b.bar = bar; b.x = xb_xcc_id(); b.st = st;
    if (tid0) (void)xb_add(&bar[XB_XCNT(b.x)], 1u);
    return b;
}
__device__ __forceinline__ void xcd_barrier_complete(unsigned* bar, unsigned x, unsigned& nloc, unsigned& nx) {
    const unsigned G = gridDim.x * gridDim.y * gridDim.z;
    unsigned sum, cnt, mine, sp = 0u;
    for (;;) {
        sum = 0u; cnt = 0u; mine = 0u;
#pragma unroll
        for (unsigned j = 0; j < 16; ++j) { const unsigned c = xb_ld(&bar[XB_XCNT(j)]); sum += c; cnt += (c > 0u) ? 1u : 0u; mine = (j == x) ? c : mine; }
        if (sum == G) break;
        __builtin_amdgcn_s_sleep(1);
        if ((++sp & 255u) == 0u) { if (xb_ld(&bar[XB_TMO])) break; if (sp > XB_SPIN_CAP) { atomicAdd(&bar[XB_TMO], 1u); break; } }
    }
    nloc = mine > 0u ? mine : 1u; nx = cnt > 0u ? cnt : 1u;
}
__device__ __forceinline__ void xcd_barrier(const XcdBarrier& b, int wave) {
    asm volatile("s_waitcnt vmcnt(0)" ::: "memory");
    __syncthreads();
    if (wave == 0 && pg8::hw_lane_id() == 0) {
        unsigned* bar = b.bar;
        __builtin_amdgcn_s_waitcnt(0);
        unsigned nloc = b.st[0], nx = b.st[1];
        if (nloc == 0u) { xcd_barrier_complete(bar, b.x, nloc, nx); b.st[0] = nloc; b.st[1] = nx; }
        const unsigned old = xb_add(&bar[XB_XSUB(b.x)], 1u);
        const unsigned gen = old / nloc;
        if (old + 1u == (gen + 1u) * nloc) {
            __builtin_amdgcn_fence(__ATOMIC_RELEASE, "agent");
            asm volatile("s_waitcnt vmcnt(0)" ::: "memory");
            const unsigned og = xb_add(&bar[XB_TOP], 1u);
            const unsigned tg = og / nx;
            if (og + 1u == (tg + 1u) * nx) xb_add(&bar[XB_TOPGEN], 1u);
            else XB_SPIN(xb_ld(&bar[XB_TOPGEN]) == tg, bar);
            __builtin_amdgcn_fence(__ATOMIC_ACQUIRE, "agent");
            xb_add(&bar[XB_XGEN(b.x)], 1u);
            asm volatile("s_waitcnt vmcnt(0)" ::: "memory");
        } else {
            XB_SPIN(xb_ld(&bar[XB_XGEN(b.x)]) == gen, bar);
            __builtin_amdgcn_fence(__ATOMIC_ACQUIRE, "agent");
            asm volatile("s_waitcnt vmcnt(0)" ::: "memory");
        }
    }
    __syncthreads();
}

__host__ __device__ __forceinline__ int frag32(int row, int k, int K) { return (((row >> 5) * (K >> 4) + (k >> 4)) * 64 + ((k >> 3) & 1) * 32 + (row & 31)) * 8 + (k & 7); }
__host__ __device__ __forceinline__ int frag16(int n, int k, int K) { return (((n >> 4) * (K >> 5) + (k >> 5)) * 64 + ((k >> 3) & 3) * 16 + (n & 15)) * 8 + (k & 7); }
struct Args { const void* in[26]; float* out; unsigned char* ws; int ph_lo, ph_hi; };
struct Ctx {
    LAS unsigned char* lds;
    int tid, lane, wave, vcu, G;
    __device__ __forceinline__ void refresh() { lane = pg8::hw_lane_id(); tid = wave * 64 + lane; }
};

template <class F> struct EpiT {
    static constexpr bool PERM = true, AFTER_DRAIN = false;
    F f;
    __device__ __forceinline__ void operator()(const f32x4 (&acc)[2][2][4][2], const pg8::Unit& u, int wr, int wc, int fr, int fq) const {
        const int row0 = u.pm * 256 + wr * 64 + fr, col0 = u.pn * 256 + wc * 32 + 8 * fq;
        typename F::L cur[2], nxt[2];
        f.load(row0, col0, cur[0]); f.load(row0, col0 + 128, cur[1]);
#pragma unroll
        for (int i = 0; i < 8; ++i) {
            const int ai = i >> 2, m = i & 3, row = row0 + ai * 128 + m * 16;
            if (i < 7) { const int rown = row0 + ((i + 1) >> 2) * 128 + ((i + 1) & 3) * 16; f.load(rown, col0, nxt[0]); f.load(rown, col0 + 128, nxt[1]); }
            __builtin_amdgcn_sched_barrier(0);
            f.apply(row, col0, acc[ai][0][m][0], acc[ai][0][m][1], cur[0]); f.apply(row, col0 + 128, acc[ai][1][m][0], acc[ai][1][m][1], cur[1]);
            __builtin_amdgcn_sched_barrier(0);
            cur[0] = nxt[0]; cur[1] = nxt[1];
        }
    }
};
__device__ __forceinline__ v4u pack8(f32x4 a, f32x4 b) { v4u w; w.x = pk2(a[0], a[1]); w.y = pk2(a[2], a[3]); w.z = pk2(b[0], b[1]); w.w = pk2(b[2], b[3]); return w; }
struct LNone {};
struct FStore { typedef LNone L; bf16* O; int ldc;
    __device__ __forceinline__ void load(int, int, L&) const {}
    __device__ __forceinline__ void apply(int row, int col, f32x4 v0, f32x4 v1, const L&) const { *(v4u*)(O + (size_t)row * ldc + col) = pack8(v0, v1); } };
struct FKvm { typedef LNone L; bf16* KM; bf16* VT;
    __device__ __forceinline__ void load(int, int, L&) const {}
    __device__ __forceinline__ void apply(int row, int col, f32x4 v0, f32x4 v1, const L&) const {
        const int b = row >> 8, m = row & 255;
        if (col < 256) { const int hm = col >> 6, d0 = col & 63; *(v4u*)(KM + (size_t)(b * 4 + hm) * 16384 + frag32(m, d0, 64)) = pack8(v0, v1); }
        else { const int c = col - 256, hm = c >> 6, e0 = c & 63, mt = m >> 5, s2 = (m >> 4) & 1, w = m & 15, hh = (w >> 2) & 1, j = ((w >> 3) << 2) | (w & 3);
            bf16* p = VT + (size_t)(b * 4 + hm) * 16384 + ((mt * 2 + s2) * 64 + hh * 32) * 8 + j;
#pragma unroll
            for (int jj = 0; jj < 8; ++jj) { const int e = e0 + jj; p[((e >> 5) * 16 * 64 + (e & 31)) * 8] = (bf16)f2bf(jj < 4 ? v0[jj] : v1[jj - 4]); } }
    } };
struct FSig { typedef LNone L; bf16* O; int ldc;
    __device__ __forceinline__ void load(int, int, L&) const {}
    __device__ __forceinline__ void apply(int row, int col, f32x4 v0, f32x4 v1, const L&) const {
#pragma unroll
        for (int j = 0; j < 4; ++j) { v0[j] = sigmoidf_(v0[j]); v1[j] = sigmoidf_(v1[j]); }
        *(v4u*)(O + (size_t)row * ldc + col) = pack8(v0, v1); } };
struct FGlu { typedef LNone L; bf16* O;
    __device__ __forceinline__ void load(int, int, L&) const {}
    __device__ __forceinline__ void apply(int row, int col, f32x4 v0, f32x4 v1, const L&) const {
        v2u w; w.x = pk2(v0[0] * sigmoidf_(v1[0]), v0[1] * sigmoidf_(v1[1])); w.y = pk2(v0[2] * sigmoidf_(v1[2]), v0[3] * sigmoidf_(v1[3]));
        *(v2u*)(O + (size_t)row * 1024 + 512 + (col >> 1)) = w; } };
__device__ __forceinline__ void mul8(f32x4& v0, f32x4& v1, const v4u num, const v4u den) {
    v0[0] *= bflo(num.x) * __builtin_amdgcn_rcpf(fmaxf(bflo(den.x), 1e-30f)); v0[1] *= bfhi(num.x) * __builtin_amdgcn_rcpf(fmaxf(bfhi(den.x), 1e-30f));
    v0[2] *= bflo(num.y) * __builtin_amdgcn_rcpf(fmaxf(bflo(den.y), 1e-30f)); v0[3] *= bfhi(num.y) * __builtin_amdgcn_rcpf(fmaxf(bfhi(den.y), 1e-30f));
    v1[0] *= bflo(num.z) * __builtin_amdgcn_rcpf(fmaxf(bflo(den.z), 1e-30f)); v1[1] *= bfhi(num.z) * __builtin_amdgcn_rcpf(fmaxf(bfhi(den.z), 1e-30f));
    v1[2] *= bflo(num.w) * __builtin_amdgcn_rcpf(fmaxf(bflo(den.w), 1e-30f)); v1[3] *= bfhi(num.w) * __builtin_amdgcn_rcpf(fmaxf(bfhi(den.w), 1e-30f));
}
struct HookGate { const bf16* Gt;
    __device__ __forceinline__ void operator()(int t, f32x4 (&acc)[2][2][4][2], const pg8::Unit& u, int wr, int wc, int fr, int fq) const {
        if (t != 8 && t != 12) return;
        const int gn = (t == 8) ? 0 : 1024, gd = gn + 1024;
        int row0 = u.pm * 256 + wr * 64 + fr, col0 = u.pn * 256 + wc * 32 + 8 * fq;
        asm volatile("" : "+v"(row0), "+v"(col0));
#pragma unroll
        for (int ai = 0; ai < 2; ++ai) {
            v4u nn[4][2], dd[4][2];
#pragma unroll
            for (int m = 0; m < 4; ++m) { const bf16* gp = Gt + (size_t)(row0 + ai * 128 + m * 16) * NGATE + col0;
                nn[m][0] = *(const v4u*)(gp + gn); dd[m][0] = *(const v4u*)(gp + gd); nn[m][1] = *(const v4u*)(gp + gn + 128); dd[m][1] = *(const v4u*)(gp + gd + 128); }
            __builtin_amdgcn_sched_barrier(0);
#pragma unroll
            for (int m = 0; m < 4; ++m) { mul8(acc[ai][0][m][0], acc[ai][0][m][1], nn[m][0], dd[m][0]); mul8(acc[ai][1][m][0], acc[ai][1][m][1], nn[m][1], dd[m][1]); }
            __builtin_amdgcn_sched_barrier(0);
        }
    } };
struct LGate { v4u g; };
struct FGateOut { typedef LGate L; const bf16* Gt; bf16* MB;
    __device__ __forceinline__ void load(int row, int col, L& l) const { l.g = *(const v4u*)(Gt + (size_t)row * NGATE + 2048 + col); }
    __device__ __forceinline__ void apply(int row, int col, f32x4 v0, f32x4 v1, const L& l) const {
        const v4u g = l.g;
        v0[0] *= bflo(g.x); v0[1] *= bfhi(g.x); v0[2] *= bflo(g.y); v0[3] *= bfhi(g.y); v1[0] *= bflo(g.z); v1[1] *= bfhi(g.z); v1[2] *= bflo(g.w); v1[3] *= bfhi(g.w);
        *(v4u*)(MB + (size_t)row * DM + col) = pack8(v0, v1); } };
struct LRes { f32x4 x0, x1; };
struct FRes { typedef LRes L; const float* X; bf16* HB; float* SS;
    __device__ __forceinline__ void load(int row, int col, L& l) const { const float* xp = X + (size_t)row * DM + col; l.x0 = *(const f32x4*)xp; l.x1 = *(const f32x4*)(xp + 4); }
    __device__ __forceinline__ void apply(int row, int col, f32x4 v0, f32x4 v1, const L& l) const {
        v0 += l.x0; v1 += l.x1;
        *(v4u*)(HB + (size_t)row * DM + col) = pack8(v0, v1);
        float q = (v0[0] * v0[0] + v0[1] * v0[1]) + (v0[2] * v0[2] + v0[3] * v0[3]) + (v1[0] * v1[0] + v1[1] * v1[1]) + (v1[2] * v1[2] + v1[3] * v1[3]);
        q += __shfl_xor(q, 16); q += __shfl_xor(q, 32);
        if (pg8::hw_lane_id() < 16) atomicAdd(SS + row, q); } };
struct LRstd { float ss; };
struct FStoreRstd { typedef LRstd L; bf16* O; int ldc; const float* SS;
    __device__ __forceinline__ void load(int row, int, L& l) const { l.ss = SS[row]; }
    __device__ __forceinline__ void apply(int row, int col, f32x4 v0, f32x4 v1, const L& l) const {
        const float rs = __builtin_amdgcn_rsqf(l.ss * (1.f / DM) + EPS);
        *(v4u*)(O + ((((size_t)(row >> 5) * 16 + (col >> 7)) * 8 + ((col & 127) >> 4)) * 64 + ((col >> 3) & 1) * 32 + (row & 31)) * 8) = pack8(v0 * rs, v1 * rs); } };

template <class F>
__device__ __forceinline__ void run_gemm(const Ctx& C, const bf16* A, const bf16* Bt, int M, int N, int K, const F& f) {
    pg8::Gemm g{A, Bt, M, N, K}; pg8::StaticOrder S; S.init(M, N, C.G, (int)blockIdx.x);
    EpiT<F> E{f};
    pg8::gemm_phase<EpiT<F>, pg8::StaticOrder, true, true>(C.lds, g, S, E, C.wave);
}

template <class F, class H>
__device__ __forceinline__ void run_gemm_hook(const Ctx& C, const bf16* A, const bf16* Bt, int M, int N, int K, const F& f, const H& h) {
    pg8::Gemm g{A, Bt, M, N, K}; pg8::StaticOrder S; S.init(M, N, C.G, (int)blockIdx.x);
    EpiT<F> E{f};
    pg8::gemm_phase<EpiT<F>, pg8::StaticOrder, true, true, false, H>(C.lds, g, S, E, C.wave, 0x7f7f7f7f, 0x7f7f7f7f, h);
}
template <class F>
__device__ __forceinline__ void run_gemm_mx(const Ctx& C, const unsigned char* A8, const unsigned char* Bt8, int M, int N, int Kbytes, const F& f, int sclA, int sclB) {
    pg8::Gemm g{(const bf16*)A8, (const bf16*)Bt8, M, N, Kbytes / 2}; pg8::StaticOrder S; S.init(M, N, C.G, (int)blockIdx.x);
    EpiT<F> E{f};
    pg8::gemm_phase<EpiT<F>, pg8::StaticOrder, true, true, true>(C.lds, g, S, E, C.wave, sclA, sclB);
}

template <bool GLU>
__device__ __forceinline__ void p0_transpose_item(const float* W, int K, int N, bf16* WT, LAS float* scr, int item, int lane, const float* kscale = nullptr, int ldk = 0, int koff = 0) {
    if (ldk == 0) ldk = K;
    const int nblk = N / 32, kb = item / nblk, nb = item % nblk, k0 = 64 * kb, n0 = 32 * nb;
#pragma unroll 8
    for (int i = 0; i < 32; ++i) { const int kk = 2 * i + (lane >> 5); float w = W[(size_t)(k0 + kk) * N + n0 + (lane & 31)]; if (kscale) w *= kscale[k0 + kk]; scr[kk * 33 + (lane & 31)] = w; }
    LDS_WAIT(); asm volatile("" ::: "memory");
    const int c = lane & 7;
#pragma unroll
    for (int j = 0; j < 4; ++j) { const int n = (lane >> 3) + 8 * j; const LAS float* s = scr + (8 * c) * 33 + n;
        v4u o; o.x = pk2(s[0 * 33], s[1 * 33]); o.y = pk2(s[2 * 33], s[3 * 33]); o.z = pk2(s[4 * 33], s[5 * 33]); o.w = pk2(s[6 * 33], s[7 * 33]);
        const int nn = n0 + n; int row = nn;
        if (GLU) { const int jc = nn & 255, gate = nn >> 8; row = 8 * (jc >> 2) + 4 * gate + (jc & 3); }
        *(GAS v4u*)(WT + (size_t)row * ldk + koff + k0 + 8 * c) = o; }
    LDS_WAIT(); asm volatile("" ::: "memory");
}
__device__ __forceinline__ void p0_transpose_item_fp8(const float* W, int K, int N, unsigned char* WT8, int nsub, LAS float* scr, int item, int lane, float scale) {
    const int nblk = N / 32, kb = item / nblk, nb = item % nblk, k0 = 64 * kb, n0 = 32 * nb;
#pragma unroll 8
    for (int i = 0; i < 32; ++i) { const int kk = 2 * i + (lane >> 5); scr[kk * 33 + (lane & 31)] = W[(size_t)(k0 + kk) * N + n0 + (lane & 31)] * scale; }
    LDS_WAIT(); asm volatile("" ::: "memory");
    const int c = lane & 7;
#pragma unroll
    for (int j = 0; j < 4; ++j) { const int n = (lane >> 3) + 8 * j; const LAS float* sp = scr + (8 * c) * 33 + n;
        int p0 = __builtin_amdgcn_cvt_pk_fp8_f32(sp[0 * 33], sp[1 * 33], 0, false); p0 = __builtin_amdgcn_cvt_pk_fp8_f32(sp[2 * 33], sp[3 * 33], p0, true);
        int p1 = __builtin_amdgcn_cvt_pk_fp8_f32(sp[4 * 33], sp[5 * 33], 0, false); p1 = __builtin_amdgcn_cvt_pk_fp8_f32(sp[6 * 33], sp[7 * 33], p1, true);
        v2u o; o.x = (unsigned)p0; o.y = (unsigned)p1;
        *(GAS v2u*)(WT8 + (size_t)(n0 + n - nsub) * K + k0 + 8 * c) = o; }
    LDS_WAIT(); asm volatile("" ::: "memory");
}
template <int NR>
__device__ __forceinline__ void rms_rows_to_bf16(const float* xbase, const float* gain, bf16* obase, int m0, int mstep, int lane, unsigned char* o8base = nullptr) {
    f32x4 v[NR][4]; float s[NR];
#pragma unroll
    for (int i = 0; i < NR; ++i) { const f32x4* xr = (const f32x4*)(xbase + (size_t)(m0 + i * mstep) * DM) + lane; s[i] = 0.f;
#pragma unroll
        for (int j = 0; j < 4; ++j) v[i][j] = xr[64 * j]; }
#pragma unroll
    for (int i = 0; i < NR; ++i)
#pragma unroll
        for (int j = 0; j < 4; ++j) s[i] += (v[i][j].x * v[i][j].x + v[i][j].y * v[i][j].y) + (v[i][j].z * v[i][j].z + v[i][j].w * v[i][j].w);
#pragma unroll
    for (int o = 1; o < 64; o <<= 1)
#pragma unroll
        for (int i = 0; i < NR; ++i) s[i] += __shfl_xor(s[i], o);
    const f32x4* gr = (const f32x4*)gain + lane;
    f32x4 g[4];
#pragma unroll
    for (int j = 0; j < 4; ++j) g[j] = gr[64 * j];
#pragma unroll
    for (int i = 0; i < NR; ++i) { const float rstd = 1.0f / sqrtf(s[i] * (1.f / DM) + EPS);
        unsigned long long* o8 = (unsigned long long*)(obase + (size_t)(m0 + i * mstep) * DM) + lane;
#pragma unroll
        for (int j = 0; j < 4; ++j) { const float y0 = v[i][j].x * rstd * g[j].x, y1 = v[i][j].y * rstd * g[j].y, y2 = v[i][j].z * rstd * g[j].z, y3 = v[i][j].w * rstd * g[j].w;
            o8[64 * j] = (unsigned long long)pk2(y0, y1) | ((unsigned long long)pk2(y2, y3) << 32);
            if (o8base) { int p = __builtin_amdgcn_cvt_pk_fp8_f32(y0 * 16.f, y1 * 16.f, 0, false); p = __builtin_amdgcn_cvt_pk_fp8_f32(y2 * 16.f, y3 * 16.f, p, true);
                *(unsigned*)(o8base + (size_t)(m0 + i * mstep) * DM + 256 * j + 4 * lane) = (unsigned)p; } } }
}

__device__ __forceinline__ void p0_s5_group(const Ctx& C, const Args& a, int g, int part) {
    const float* a_re = (const float*)a.in[7]; const float* a_im = (const float*)a.in[8]; const float* log_dt = (const float*)a.in[9];
    const float* b_re = (const float*)a.in[10]; const float* b_im = (const float*)a.in[11]; const float* c_re = (const float*)a.in[12]; const float* c_im = (const float*)a.in[13];
    LAS float* L = (LAS float*)C.lds;
    LAS float* lpr = L;
    LAS float* lpi = L + 640;
    LAS float* bbr = L + 1280;
    LAS float* bbi = bbr + 1024;
    LAS float* ccr = bbi + 1024;
    LAS float* cci = ccr + 1024;
    LAS float* Kj = cci + 1024;
    const int tid = C.tid;
    bf16* T8T = (bf16*)(a.ws + WS_S5MAT) + (size_t)g * 16384;
    bf16* PMT = (bf16*)(a.ws + WS_S5MAT) + (size_t)(16 + g) * 16384;
    bf16* QMT = (bf16*)(a.ws + WS_S5MAT) + (size_t)(32 + g) * 16384;
    float* L8 = (float*)(a.ws + WS_S5C) + (size_t)g * 128;
    float* L128 = (float*)(a.ws + WS_S5C) + 2048 + (size_t)g * 128;
    for (int i = tid; i < 640; i += 512) {
        const int j10 = i >> 6, p = i & 63; const double jj = (j10 < 9) ? (double)j10 : 128.0;
        const double dt = exp((double)log_dt[g]);
        const double ar = (double)a_re[g * 64 + p], ai = (double)a_im[g * 64 + p];
        const double mag = exp(ar * dt * jj), ang = ai * dt * jj;
        lpr[i] = (float)(mag * cos(ang)); lpi[i] = (float)(mag * sin(ang));
    }
    for (int i = tid; i < 1024; i += 512) { ccr[i] = c_re[g * 1024 + i]; cci[i] = c_im[g * 1024 + i]; }
    __syncthreads();
    if (part == 0 && tid < 64) { L8[tid * 2] = lpr[8 * 64 + tid]; L8[tid * 2 + 1] = lpi[8 * 64 + tid]; L128[tid * 2] = lpr[9 * 64 + tid]; L128[tid * 2 + 1] = lpi[9 * 64 + tid]; }
    for (int i = tid; i < 1024; i += 512) {
        const int p = i >> 4, h = i & 15;
        const float ar = a_re[g * 64 + p], ai = a_im[g * 64 + p], lr = lpr[64 + p], li = lpi[64 + p];
        const float den = ar * ar + ai * ai, nr = lr - 1.0f, ni = li;
        const float cr = (nr * ar + ni * ai) / den, ci = (ni * ar - nr * ai) / den;
        const float br = b_re[(g * 64 + p) * 16 + h], bi = b_im[(g * 64 + p) * 16 + h];
        bbr[i] = cr * br - ci * bi; bbi[i] = cr * bi + ci * br;
    }
    __syncthreads();
    for (int i = tid; i < 2048; i += 512) {
        const int j = i >> 8, ho = (i >> 4) & 15, hi = i & 15; float sacc = 0.f;
        for (int p = 0; p < 64; ++p) { const float cr_ = ccr[ho * 64 + p], ci_ = cci[ho * 64 + p], lr_ = lpr[j * 64 + p], li_ = lpi[j * 64 + p];
            const float mr = cr_ * lr_ - ci_ * li_, mi = cr_ * li_ + ci_ * lr_;
            sacc += mr * bbr[p * 16 + hi] - mi * bbi[p * 16 + hi]; }
        Kj[i] = sacc;
    }
    __syncthreads();
    for (int i = part * 1024 + tid; i < (part + 1) * 1024; i += 512) {
        const int n = i >> 7, k = i & 127;
        { const int t = n >> 4, ho = n & 15, sx = k >> 4, hi = k & 15; const float v = (sx <= t) ? Kj[((t - sx) * 16 + ho) * 16 + hi] : 0.f; T8T[frag16(n, k, 128)] = (bf16)f2bf(v); }
        { const int p = n & 63, im = n >> 6, sx = k >> 4, hi = k & 15; const float lr_ = lpr[(7 - sx) * 64 + p], li_ = lpi[(7 - sx) * 64 + p], br_ = bbr[p * 16 + hi], bi_ = bbi[p * 16 + hi];
          const float v = im ? (lr_ * bi_ + li_ * br_) : (lr_ * br_ - li_ * bi_); PMT[frag16(n, k, 128)] = (bf16)f2bf(v); }
        { const int t = n >> 4, ho = n & 15, p = k & 63, pt = k >> 6; const float cr_ = ccr[ho * 64 + p], ci_ = cci[ho * 64 + p], lr_ = lpr[(t + 1) * 64 + p], li_ = lpi[(t + 1) * 64 + p];
          const float v = pt ? -(cr_ * li_ + ci_ * lr_) : (cr_ * lr_ - ci_ * li_); QMT[frag16(n, k, 128)] = (bf16)f2bf(v); }
    }
    __syncthreads();
}

__device__ __forceinline__ void p0_prologue(const Ctx& C, const Args& a) {
    p0_s5_group(C, a, C.vcu & 15, C.vcu >> 4);
    LAS float* scr = (LAS float*)(C.lds + C.wave * 16384);
    const int gw = C.vcu * NWAVES + C.wave, NGW = C.G * NWAVES;
    const int gt = C.vcu * 512 + C.tid, NGT = C.G * 512;
    unsigned char* ws = a.ws;
    for (int i = gt; i < MTOK; i += NGT) ((float*)(ws + WS_SS))[i] = 0.f;
    constexpr int I_IN = 16 * 176, I_Q = 16 * 64, I_O = 16 * 32, I_BR = 8 * 32, I_BS = 4 * 32, I_BM = 4 * 32, I_KV = 16 * 16, I_GLU = 4 * 16;
    constexpr int NITEMS = I_IN + I_Q + I_O + I_BR + I_BS + I_BM + I_KV + I_GLU;
    for (int it = gw; it < NITEMS; it += NGW) {
        int r = it;
        if (r < I_IN) { if ((r % 176) < 80) p0_transpose_item<false>((const float*)a.in[4], 1024, 5632, (bf16*)(ws + WS_WIN_T), scr, r, C.lane);
                        else p0_transpose_item_fp8((const float*)a.in[4], 1024, 5632, ws + WS_WG8, NZ1, scr, r, C.lane, 256.f); continue; } r -= I_IN;
        if (r < I_Q) { p0_transpose_item<false>((const float*)a.in[21], 1024, 2048, (bf16*)(ws + WS_WQ_T), scr, r, C.lane, (const float*)a.in[20]); continue; } r -= I_Q;
        if (r < I_O) { p0_transpose_item<false>((const float*)a.in[19], 1024, 1024, (bf16*)(ws + WS_WOUT_T), scr, r, C.lane); continue; } r -= I_O;
        if (r < I_BR) { p0_transpose_item<false>((const float*)a.in[16], 512, 1024, (bf16*)(ws + WS_WCAT_T), scr, r, C.lane, nullptr, 1024, 0); continue; } r -= I_BR;
        if (r < I_BS) { p0_transpose_item<false>((const float*)a.in[17], 256, 1024, (bf16*)(ws + WS_WCAT_T), scr, r, C.lane, nullptr, 1024, 512); continue; } r -= I_BS;
        if (r < I_BM) { p0_transpose_item<false>((const float*)a.in[18], 256, 1024, (bf16*)(ws + WS_WCAT_T), scr, r, C.lane, nullptr, 1024, 768); continue; } r -= I_BM;
        if (r < I_KV) { p0_transpose_item<false>((const float*)a.in[6], 1024, 512, (bf16*)(ws + WS_WMKV_T), scr, r, C.lane); continue; } r -= I_KV;
        p0_transpose_item<true>((const float*)a.in[15], 256, 512, (bf16*)(ws + WS_WGLU_T), scr, r, C.lane);
    }
    for (int i = gt; i < 16 * 128 * 128 / 8; i += NGT) { const f32x4 x0 = ((const f32x4*)a.in[22])[2 * (size_t)i], x1 = ((const f32x4*)a.in[22])[2 * (size_t)i + 1];
        const int hc = i >> 11, n = (i >> 4) & 127, d0 = (i & 15) * 8; *(v4u*)((bf16*)(ws + WS_KEYS) + hc * 16384 + frag32(n, d0, 128)) = pack8(x0, x1); }
    for (int rw0 = gw; rw0 < 2 * 16384; rw0 += 4 * NGW) {
        f32x4 v[4][4]; float mx[4];
#pragma unroll
        for (int i = 0; i < 4; ++i) { const int rw = rw0 + i * NGW, t = rw >> 14, row = rw & 16383;
            const float* src = (const float*)a.in[23 + t] + (size_t)row * DM + C.lane * 4; mx[i] = 0.f;
#pragma unroll
            for (int q = 0; q < 4; ++q) { v[i][q] = *(const f32x4*)(src + 256 * q); if (t == 0) v[i][q] = v[i][q] * *(const f32x4*)((const float*)a.in[20] + C.lane * 4 + 256 * q); } }
#pragma unroll
        for (int i = 0; i < 4; ++i)
#pragma unroll
            for (int q = 0; q < 4; ++q) mx[i] = fmaxf(mx[i], fmaxf(fmaxf(fabsf(v[i][q][0]), fabsf(v[i][q][1])), fmaxf(fabsf(v[i][q][2]), fabsf(v[i][q][3]))));
#pragma unroll
        for (int o = 1; o < 64; o <<= 1)
#pragma unroll
            for (int i = 0; i < 4; ++i) mx[i] = fmaxf(mx[i], __shfl_xor(mx[i], o));
#pragma unroll
        for (int i = 0; i < 4; ++i) { const int rw = rw0 + i * NGW, t = rw >> 14, row = rw & 16383;
            int ex = (int)((__builtin_bit_cast(unsigned, mx[i]) >> 23) & 0xffu) - 127;
            if (mx[i] < 1e-30f) ex = 7;
            const float sc = __builtin_bit_cast(float, (unsigned)(127 + 7 - ex) << 23), isc = __builtin_bit_cast(float, (unsigned)(127 - 7 + ex) << 23);
            unsigned char* dst = ws + (t ? WS_PV : WS_PU) + (size_t)row * 128 + ((C.lane * 4) & 127);
#pragma unroll
            for (int q = 0; q < 4; ++q) { int p = __builtin_amdgcn_cvt_pk_fp8_f32(v[i][q][0] * sc, v[i][q][1] * sc, 0, false); p = __builtin_amdgcn_cvt_pk_fp8_f32(v[i][q][2] * sc, v[i][q][3] * sc, p, true);
                *(unsigned*)(dst + (size_t)(2 * q + (C.lane >> 5)) * (16384 * 128)) = (unsigned)p; }
            if (C.lane == 0) ((float*)(ws + WS_PSC))[t * 16384 + row] = isc; }
    }
    for (int m = gw; m < MTOK; m += 4 * NGW) rms_rows_to_bf16<4>((const float*)a.in[0], (const float*)a.in[3], (bf16*)(ws + WS_A), m, NGW, C.lane, ws + WS_XN8);
    for (int m = gw; m < MROWS; m += NGW) rms_rows_to_bf16<1>((const float*)a.in[1], (const float*)a.in[5], (bf16*)(ws + WS_MEMN), m, NGW, C.lane);
    {
        const int* pos = (const int*)a.in[2]; float* rope = (float*)(ws + WS_ROPE);
        const int j = C.tid & 63;
        const double invrev = exp(-(double)j * (9.210340371976184 / 64.0)) * 0.15915494309189535;
        for (int i = gt; i < MTOK * 64; i += NGT) { const int tok = i >> 6;
            double rv = (double)pos[tok] * invrev; rv -= rint(rv);
            const float rf = (float)rv;
            rope[(size_t)tok * 128 + j] = __builtin_amdgcn_cosf(rf); rope[(size_t)tok * 128 + 64 + j] = __builtin_amdgcn_sinf(rf); }
    }
}

constexpr int LP = 136;
__device__ __forceinline__ float lg2_gamma(int h) { return log2f(1.0f - exp2f(-5.0f - (float)h)); }

__device__ __forceinline__ void r1_unit(const Ctx& C, const Args& a, int tile, int h) {
    const bf16* Z1 = (const bf16*)(a.ws + WS_Z1); const float* ROPE = (const float*)(a.ws + WS_ROPE);
    LAS bf16* Qs = (LAS bf16*)C.lds; LAS bf16* Ks = Qs + 128 * LP; LAS bf16* Kt = Ks + 128 * LP; LAS bf16* Vt = Kt + 128 * LP;
    const int tid = C.tid, lane = C.lane, t0 = tile * 128, u = tile * 4 + h;
    const float lg2g = lg2_gamma(h);
    {
        const int i = tid >> 2, dq = (tid & 3) * 16;
        const bf16* zr = Z1 + (size_t)(t0 + i) * NZ1; const float* rp = ROPE + (size_t)(t0 + i) * 128;
        float cs[16], sn[16];
#pragma unroll
        for (int q = 0; q < 4; ++q) { const f32x4 c4 = *(const f32x4*)(rp + dq + 4 * q), s4 = *(const f32x4*)(rp + 64 + dq + 4 * q);
#pragma unroll
            for (int e = 0; e < 4; ++e) { cs[4 * q + e] = c4[e]; sn[4 * q + e] = s4[e]; } }
        const float kdec = __builtin_amdgcn_exp2f((float)(127 - i) * lg2g) , ksc = 0.08838834764831845f;
#pragma unroll
        for (int which = 0; which < 2; ++which) {
            const bf16* src = zr + (which ? ZK : ZQ) + h * 128;
            const v4u a0 = *(const v4u*)(src + dq), a1 = *(const v4u*)(src + dq + 8), b0 = *(const v4u*)(src + 64 + dq), b1 = *(const v4u*)(src + 64 + dq + 8);
            const unsigned aw[8] = {a0.x, a0.y, a0.z, a0.w, a1.x, a1.y, a1.z, a1.w}, bw[8] = {b0.x, b0.y, b0.z, b0.w, b1.x, b1.y, b1.z, b1.w};
            float y1[16], y2[16];
#pragma unroll
            for (int w = 0; w < 8; ++w) {
                const float x1l = bflo(aw[w]), x1h = bfhi(aw[w]), x2l = bflo(bw[w]), x2h = bfhi(bw[w]);
                y1[2 * w] = x1l * cs[2 * w] - x2l * sn[2 * w]; y2[2 * w] = x1l * sn[2 * w] + x2l * cs[2 * w];
                y1[2 * w + 1] = x1h * cs[2 * w + 1] - x2h * sn[2 * w + 1]; y2[2 * w + 1] = x1h * sn[2 * w + 1] + x2h * cs[2 * w + 1];
            }
            if (which) {
#pragma unroll
                for (int e = 0; e < 16; ++e) { y1[e] *= ksc; y2[e] *= ksc; }
            }
            LAS bf16* dstp = (which ? Ks : Qs) + i * LP;
            v4u o;
            o.x = pk2(y1[0], y1[1]); o.y = pk2(y1[2], y1[3]); o.z = pk2(y1[4], y1[5]); o.w = pk2(y1[6], y1[7]); *(LAS v4u*)(dstp + dq) = o;
            o.x = pk2(y1[8], y1[9]); o.y = pk2(y1[10], y1[11]); o.z = pk2(y1[12], y1[13]); o.w = pk2(y1[14], y1[15]); *(LAS v4u*)(dstp + dq + 8) = o;
            o.x = pk2(y2[0], y2[1]); o.y = pk2(y2[2], y2[3]); o.z = pk2(y2[4], y2[5]); o.w = pk2(y2[6], y2[7]); *(LAS v4u*)(dstp + 64 + dq) = o;
            o.x = pk2(y2[8], y2[9]); o.y = pk2(y2[10], y2[11]); o.z = pk2(y2[12], y2[13]); o.w = pk2(y2[14], y2[15]); *(LAS v4u*)(dstp + 64 + dq + 8) = o;
            if (which) {
#pragma unroll
                for (int e = 0; e < 16; ++e) { Kt[(dq + e) * LP + i] = (bf16)f2bf(y1[e] * kdec); Kt[(64 + dq + e) * LP + i] = (bf16)f2bf(y2[e] * kdec); }
            }
            __builtin_amdgcn_sched_barrier(0);
        }
        {
            const int eq = (tid & 3) * 32; const bf16* vs = zr + ZV + h * 128 + eq;
#pragma unroll
            for (int q = 0; q < 4; ++q) { const v4u v = *(const v4u*)(vs + 8 * q); const unsigned vw[4] = {v.x, v.y, v.z, v.w};
#pragma unroll
                for (int w = 0; w < 4; ++w) { Vt[(eq + 8 * q + 2 * w) * LP + i] = (bf16)(vw[w] & 0xffffu); Vt[(eq + 8 * q + 2 * w + 1) * LP + i] = (bf16)(vw[w] >> 16); } }
        }
    }
    __syncthreads();
    const int r = lane & 31, hh = lane >> 5;
    if (C.wave < 4) {
        const int ib = C.wave;
        bf16x8 bq[8];
#pragma unroll
        for (int ks = 0; ks < 8; ++ks) bq[ks] = *(const LAS bf16x8*)(Qs + (ib * 32 + r) * LP + ks * 16 + 8 * hh);
        { bf16* qf = (bf16*)(a.ws + WS_QRF) + ((size_t)(u * 4 + ib) * 8 * 64 + lane) * 8;
#pragma unroll
          for (int ks = 0; ks < 8; ++ks) *(bf16x8*)(qf + ks * 512) = bq[ks]; }
        f32x16 accO[4];
#pragma unroll
        for (int et = 0; et < 4; ++et)
#pragma unroll
            for (int e = 0; e < 16; ++e) accO[et][e] = 0.f;
        const int i = ib * 32 + r;
#pragma unroll
        for (int jt = 0; jt < 4; ++jt) {
            if (jt <= ib) {
                f32x16 s;
#pragma unroll
                for (int e = 0; e < 16; ++e) s[e] = 0.f;
#pragma unroll
                for (int ks = 0; ks < 8; ++ks) { const bf16x8 ak = *(const LAS bf16x8*)(Ks + (jt * 32 + r) * LP + ks * 16 + 8 * hh); s = mfma32(ak, bq[ks], s); }
                unsigned pk[8];
#pragma unroll
                for (int q = 0; q < 8; ++q) {
                    const int ra = 2 * q, rb = 2 * q + 1;
                    const int ja = jt * 32 + (ra & 3) + 8 * (ra >> 2) + 4 * hh, jb = jt * 32 + (rb & 3) + 8 * (rb >> 2) + 4 * hh;
                    const float va = (i >= ja) ? s[ra] * __builtin_amdgcn_exp2f((float)(i - ja) * lg2g) : 0.f;
                    const float vb = (i >= jb) ? s[rb] * __builtin_amdgcn_exp2f((float)(i - jb) * lg2g) : 0.f;
                    pk[q] = pk2(va, vb);
                }
#pragma unroll
                for (int sft = 0; sft < 2; ++sft) {
                    const bf16x8 pb = mk8(pk[4 * sft], pk[4 * sft + 1], pk[4 * sft + 2], pk[4 * sft + 3]);
#pragma unroll
                    for (int et = 0; et < 4; ++et) {
                        const LAS bf16* vp = Vt + (et * 32 + r) * LP + jt * 32 + 16 * sft + 4 * hh;
                        const v2u lo = *(const LAS v2u*)vp, hi = *(const LAS v2u*)(vp + 8);
                        accO[et] = mfma32(mk8(lo.x, lo.y, hi.x, hi.y), pb, accO[et]);
                    }
                }
            }
            __builtin_amdgcn_sched_barrier(0);
        }
        unsigned* INN = (unsigned*)(a.ws + WS_INNER) + ((size_t)(u * 4 + ib) * 32) * 64 + lane;
#pragma unroll
        for (int et = 0; et < 4; ++et)
#pragma unroll
            for (int q = 0; q < 8; ++q) INN[(et * 8 + q) * 64] = pk2(accO[et][2 * q], accO[et][2 * q + 1]);
    } else {
        const int et = C.wave - 4;
        f32x16 acc[4];
#pragma unroll
        for (int dt = 0; dt < 4; ++dt)
#pragma unroll
            for (int e = 0; e < 16; ++e) acc[dt][e] = 0.f;
#pragma unroll
        for (int ks = 0; ks < 8; ++ks) {
            const bf16x8 av = *(const LAS bf16x8*)(Vt + (et * 32 + r) * LP + ks * 16 + 8 * hh);
#pragma unroll
            for (int dt = 0; dt < 4; ++dt) { const bf16x8 bk = *(const LAS bf16x8*)(Kt + (dt * 32 + r) * LP + ks * 16 + 8 * hh); acc[dt] = mfma32(av, bk, acc[dt]); }
            __builtin_amdgcn_sched_barrier(0);
        }
        float* KVb = a.out + (size_t)u * 16384 + (size_t)(et * 32 + 4 * hh) * 128 + r;
#pragma unroll
        for (int dt = 0; dt < 4; ++dt) {
#pragma unroll
            for (int e = 0; e < 16; ++e) KVb[((e & 3) + 8 * (e >> 2)) * 128 + dt * 32] = acc[dt][e];
            __builtin_amdgcn_sched_barrier(0);
        }
    }
    __syncthreads();
}

__device__ __forceinline__ void s5_compute_E(const Args& a, int tile, int g, int lane, LAS float* Es, bf16x8 (&au)[4]) {
    const bf16* Z1 = (const bf16*)(a.ws + WS_Z1); const bf16* PMT = (const bf16*)(a.ws + WS_S5MAT) + (size_t)(16 + g) * 16384;
    const int r16 = lane & 15, q4 = lane >> 4;
#pragma unroll
    for (int ks = 0; ks < 4; ++ks) { const int s = 2 * ks + (q4 >> 1);
        au[ks] = *(const bf16x8*)(Z1 + (size_t)(tile * 128 + 8 * r16 + s) * NZ1 + ZU + g * 16 + 8 * (q4 & 1)); }
    bf16x8 bc[4], bn[4];
#pragma unroll
    for (int ks = 0; ks < 4; ++ks) bc[ks] = *(const bf16x8*)(PMT + (ks * 64 + lane) * 8);
#pragma unroll 1
    for (int nb = 0; nb < 8; ++nb) {
        const int nbn = min(nb + 1, 7);
#pragma unroll
        for (int ks = 0; ks < 4; ++ks) bn[ks] = *(const bf16x8*)(PMT + ((nbn * 4 + ks) * 64 + lane) * 8);
        __builtin_amdgcn_sched_barrier(0);
        f32x4 acc = {0.f, 0.f, 0.f, 0.f};
#pragma unroll
        for (int ks = 0; ks < 4; ++ks) acc = mfma16(au[ks], bc[ks], acc);
#pragma unroll
        for (int i4 = 0; i4 < 4; ++i4) Es[(q4 * 4 + i4) * 128 + nb * 16 + r16] = acc[i4];
        __builtin_amdgcn_sched_barrier(0);
#pragma unroll
        for (int ks = 0; ks < 4; ++ks) bc[ks] = bn[ks];
    }
    LDS_WAIT(); asm volatile("" ::: "memory");
}
__device__ __forceinline__ void s5a_wave(const Ctx& C, const Args& a, int tile, int g) {
    LAS float* Es = (LAS float*)(C.lds + C.wave * 16384);
    bf16x8 au[4];
    s5_compute_E(a, tile, g, C.lane, Es, au);
    const float* L8 = (const float*)(a.ws + WS_S5C) + (size_t)g * 128;
    const float l8r = L8[C.lane * 2], l8i = L8[C.lane * 2 + 1];
    float sr = 0.f, si = 0.f;
#pragma unroll
    for (int c = 0; c < 16; ++c) { const float er = Es[c * 128 + C.lane], ei = Es[c * 128 + 64 + C.lane];
        const float nr = l8r * sr - l8i * si + er, ni = l8r * si + l8i * sr + ei; sr = nr; si = ni; }
    float* E = (float*)(a.ws + WS_S5E) + ((size_t)tile * 16 + g) * 128;
    E[C.lane] = sr; E[64 + C.lane] = si;
    LDS_WAIT(); asm volatile("" ::: "memory");
}
__device__ __forceinline__ void s5c_wave(const Ctx& C, const Args& a, int tile, int g) {
    LAS float* Es = (LAS float*)(C.lds + C.wave * 16384);
    LAS bf16* Sv = (LAS bf16*)(C.lds + C.wave * 16384 + 8192);
    const int lane = C.lane, r16 = lane & 15, q4 = lane >> 4;
    bf16x8 au[4];
    s5_compute_E(a, tile, g, lane, Es, au);
    const float* L8 = (const float*)(a.ws + WS_S5C) + (size_t)g * 128;
    const float l8r = L8[lane * 2], l8i = L8[lane * 2 + 1];
    const float* X = (const float*)(a.ws + WS_S5X) + ((size_t)tile * 16 + g) * 128;
    float sr = X[lane], si = X[64 + lane];
#pragma unroll
    for (int c = 0; c < 16; ++c) {
        Sv[c * LP + lane] = (bf16)f2bf(sr); Sv[c * LP + 64 + lane] = (bf16)f2bf(si);
        const float er = Es[c * 128 + lane], ei = Es[c * 128 + 64 + lane];
        const float nr = l8r * sr - l8i * si + er, ni = l8r * si + l8i * sr + ei; sr = nr; si = ni; }
    LDS_WAIT(); asm volatile("" ::: "memory");
    bf16x8 as[4];
#pragma unroll
    for (int ks = 0; ks < 4; ++ks) as[ks] = *(const LAS bf16x8*)(Sv + r16 * LP + ks * 32 + 8 * q4);
    const bf16* T8T = (const bf16*)(a.ws + WS_S5MAT) + (size_t)g * 16384; const bf16* QMT = (const bf16*)(a.ws + WS_S5MAT) + (size_t)(32 + g) * 16384;
    const bf16* Z1 = (const bf16*)(a.ws + WS_Z1); bf16* YG = (bf16*)(a.ws + WS_YG);
    const float dg = ((const float*)a.in[14])[g * 16 + r16];
    bf16x8 tc[4], tn[4], qc[4], qn[4]; bf16 uc[4], un[4];
#pragma unroll
    for (int ks = 0; ks < 4; ++ks) { tc[ks] = *(const bf16x8*)(T8T + (ks * 64 + lane) * 8); qc[ks] = *(const bf16x8*)(QMT + (ks * 64 + lane) * 8); }
#pragma unroll
    for (int i4 = 0; i4 < 4; ++i4) uc[i4] = Z1[(size_t)(tile * 128 + 8 * (q4 * 4 + i4)) * NZ1 + ZU + g * 16 + r16];
#pragma unroll 1
    for (int nb = 0; nb < 8; ++nb) {
        const int nbn = min(nb + 1, 7);
#pragma unroll
        for (int ks = 0; ks < 4; ++ks) { tn[ks] = *(const bf16x8*)(T8T + ((nbn * 4 + ks) * 64 + lane) * 8); qn[ks] = *(const bf16x8*)(QMT + ((nbn * 4 + ks) * 64 + lane) * 8); }
#pragma unroll
        for (int i4 = 0; i4 < 4; ++i4) un[i4] = Z1[(size_t)(tile * 128 + 8 * (q4 * 4 + i4) + nbn) * NZ1 + ZU + g * 16 + r16];
        __builtin_amdgcn_sched_barrier(0);
        f32x4 acc = {0.f, 0.f, 0.f, 0.f};
#pragma unroll
        for (int ks = 0; ks < 4; ++ks) { acc = mfma16(au[ks], tc[ks], acc); acc = mfma16(as[ks], qc[ks], acc); }
#pragma unroll
        for (int i4 = 0; i4 < 4; ++i4) { const int tok = tile * 128 + 8 * (q4 * 4 + i4) + nb;
            YG[(size_t)tok * 256 + g * 16 + r16] = (bf16)f2bf(gelu_tanh(acc[i4] + dg * bf2f(uc[i4]))); }
        __builtin_amdgcn_sched_barrier(0);
#pragma unroll
        for (int ks = 0; ks < 4; ++ks) { tc[ks] = tn[ks]; qc[ks] = qn[ks]; }
#pragma unroll
        for (int i4 = 0; i4 < 4; ++i4) uc[i4] = un[i4];
    }
    LDS_WAIT(); asm volatile("" ::: "memory");
}

__device__ __forceinline__ void ma_loadk(const bf16* kp, int mt, bf16x8 (&k)[4]) {
#pragma unroll
    for (int ks = 0; ks < 4; ++ks) k[ks] = *(const bf16x8*)(kp + (mt * 4 + ks) * 512);
}
__device__ __forceinline__ void ma_loadv(const bf16* vp, int mt, bf16x8 (&v)[4]) {
#pragma unroll
    for (int sft = 0; sft < 2; ++sft)
#pragma unroll
        for (int et = 0; et < 2; ++et) v[sft * 2 + et] = *(const bf16x8*)(vp + (((et * 8 + mt) * 2 + sft) * 64) * 8);
}
__device__ __forceinline__ void ma_wave(const Ctx& C, const Args& a, int tile, int hm, int ib) {
    const bf16* Z1 = (const bf16*)(a.ws + WS_Z1); const bf16* KM = (const bf16*)(a.ws + WS_KM); const bf16* VT = (const bf16*)(a.ws + WS_VT);
    const int lane = C.lane, r = lane & 31, hh = lane >> 5, b = tile >> 5, tok = tile * 128 + ib * 32 + r;
    const bf16* kp = KM + (size_t)(b * 4 + hm) * 16384 + lane * 8;
    const bf16* vp = VT + (size_t)(b * 4 + hm) * 16384 + lane * 8;
    bf16x8 bq[4];
#pragma unroll
    for (int ks = 0; ks < 4; ++ks) bq[ks] = *(const bf16x8*)(Z1 + (size_t)tok * NZ1 + ZQM + hm * 64 + ks * 16 + 8 * hh);
    bf16x8 kc[4], kn[4];
    ma_loadk(kp, 0, kc);
    float mx = -3.0e38f;
#pragma unroll 1
    for (int mt = 0; mt < 8; ++mt) {
        ma_loadk(kp, min(mt + 1, 7), kn); __builtin_amdgcn_sched_barrier(0);
        f32x16 s;
#pragma unroll
        for (int e = 0; e < 16; ++e) s[e] = 0.f;
#pragma unroll
        for (int ks = 0; ks < 4; ++ks) s = mfma32(kc[ks], bq[ks], s);
#pragma unroll
        for (int e = 0; e < 16; ++e) mx = fmaxf(mx, s[e]);
        __builtin_amdgcn_sched_barrier(0);
#pragma unroll
        for (int ks = 0; ks < 4; ++ks) kc[ks] = kn[ks];
    }
    mx = fmaxf(mx, __shfl_xor(mx, 32));
    float sum = 0.f;
    f32x16 o[2];
#pragma unroll
    for (int et = 0; et < 2; ++et)
#pragma unroll
        for (int e = 0; e < 16; ++e) o[et][e] = 0.f;
    const float sc = 0.125f * 1.4426950408889634f;
    bf16x8 vc[4], vn[4];
    ma_loadk(kp, 0, kc); ma_loadv(vp, 0, vc);
#pragma unroll 1
    for (int mt = 0; mt < 8; ++mt) {
        ma_loadk(kp, min(mt + 1, 7), kn); ma_loadv(vp, min(mt + 1, 7), vn); __builtin_amdgcn_sched_barrier(0);
        f32x16 s;
#pragma unroll
        for (int e = 0; e < 16; ++e) s[e] = 0.f;
#pragma unroll
        for (int ks = 0; ks < 4; ++ks) s = mfma32(kc[ks], bq[ks], s);
        unsigned pk[8];
#pragma unroll
        for (int q = 0; q < 8; ++q) { const float pa = __builtin_amdgcn_exp2f((s[2 * q] - mx) * sc), pb = __builtin_amdgcn_exp2f((s[2 * q + 1] - mx) * sc); sum += pa + pb; pk[q] = pk2(pa, pb); }
#pragma unroll
        for (int sft = 0; sft < 2; ++sft) {
            const bf16x8 pb = mk8(pk[4 * sft], pk[4 * sft + 1], pk[4 * sft + 2], pk[4 * sft + 3]);
#pragma unroll
            for (int et = 0; et < 2; ++et) o[et] = mfma32(vc[sft * 2 + et], pb, o[et]);
        }
        __builtin_amdgcn_sched_barrier(0);
#pragma unroll
        for (int ks = 0; ks < 4; ++ks) kc[ks] = kn[ks];
#pragma unroll
        for (int q = 0; q < 4; ++q) vc[q] = vn[q];
    }
    sum += __shfl_xor(sum, 32);
    const float inv = 1.0f / sum;
    bf16* MA = (bf16*)(a.ws + WS_YCAT) + (size_t)tok * 1024 + 768 + hm * 64;
#pragma unroll
    for (int et = 0; et < 2; ++et)
#pragma unroll
        for (int g4 = 0; g4 < 4; ++g4) { v2u w; w.x = pk2(o[et][4 * g4] * inv, o[et][4 * g4 + 1] * inv); w.y = pk2(o[et][4 * g4 + 2] * inv, o[et][4 * g4 + 3] * inv);
            *(v2u*)(MA + et * 32 + 8 * g4 + 4 * hh) = w; }
}

__device__ __forceinline__ void r3_wave(const Ctx& C, const Args& a, int tile, int h, int ib) {
    const bf16* Z1 = (const bf16*)(a.ws + WS_Z1); const float* ROPE = (const float*)(a.ws + WS_ROPE);
    const bf16* PREV = (const bf16*)((const unsigned char*)a.out + 64 * MiB);
    const int lane = C.lane, r = lane & 31, hh = lane >> 5, u = tile * 4 + h, tok = tile * 128 + ib * 32 + r;
    const float lg2g = lg2_gamma(h);
    bf16x8 bq[8];
    { const bf16* qf = (const bf16*)(a.ws + WS_QRF) + ((size_t)(u * 4 + ib) * 8 * 64 + lane) * 8;
#pragma unroll
      for (int ks = 0; ks < 8; ++ks) bq[ks] = *(const bf16x8*)(qf + ks * 512); }
    f32x16 acc[4];
    const bf16* pbase = PREV + (size_t)u * 16384 + lane * 8;
    bf16x8 apc[8], apn[8];
#pragma unroll
    for (int ks = 0; ks < 8; ++ks) apc[ks] = *(const bf16x8*)(pbase + ks * 512);
#pragma unroll
    for (int et = 0; et < 4; ++et) {
        if (et < 3) {
#pragma unroll
            for (int ks = 0; ks < 8; ++ks) apn[ks] = *(const bf16x8*)(pbase + ((et + 1) * 8 + ks) * 512);
        }
        __builtin_amdgcn_sched_barrier(0);
#pragma unroll
        for (int e = 0; e < 16; ++e) acc[et][e] = 0.f;
#pragma unroll
        for (int ks = 0; ks < 8; ++ks) acc[et] = mfma32(apc[ks], bq[ks], acc[et]);
        __builtin_amdgcn_sched_barrier(0);
#pragma unroll
        for (int ks = 0; ks < 8; ++ks) apc[ks] = apn[ks];
    }
    const float qdec = __builtin_amdgcn_exp2f((float)(ib * 32 + r + 1) * lg2g);
    const unsigned* INN = (const unsigned*)(a.ws + WS_INNER) + ((size_t)(u * 4 + ib) * 32) * 64 + lane;
    float ss = 0.f;
    unsigned innw[32];
#pragma unroll
    for (int q = 0; q < 32; ++q) innw[q] = INN[q * 64];
#pragma unroll
    for (int et = 0; et < 4; ++et)
#pragma unroll
        for (int q = 0; q < 8; ++q) { const unsigned w = innw[et * 8 + q];
            const float v0 = acc[et][2 * q] * qdec + bflo(w), v1 = acc[et][2 * q + 1] * qdec + bfhi(w);
            acc[et][2 * q] = v0; acc[et][2 * q + 1] = v1; ss += v0 * v0 + v1 * v1; }
    __builtin_amdgcn_sched_barrier(0);
    ss += __shfl_xor(ss, 32);
    const float rn = __builtin_amdgcn_rsqf(ss * (1.0f / 128.0f) + EPS);
    const bf16* gp = Z1 + (size_t)tok * NZ1 + ZGR + h * 128; bf16* RET = (bf16*)(a.ws + WS_YCAT) + (size_t)tok * 1024 + h * 128;
#pragma unroll
    for (int et = 0; et < 4; ++et)
#pragma unroll
        for (int g4 = 0; g4 < 4; ++g4) { const int e0 = et * 32 + 8 * g4 + 4 * hh; const v2u gw = *(const v2u*)(gp + e0);
            const float g0 = bflo(gw.x), g1 = bfhi(gw.x), g2 = bflo(gw.y), g3 = bfhi(gw.y);
            v2u w; w.x = pk2(acc[et][4 * g4] * rn * g0 * sigmoidf_(g0), acc[et][4 * g4 + 1] * rn * g1 * sigmoidf_(g1));
            w.y = pk2(acc[et][4 * g4 + 2] * rn * g2 * sigmoidf_(g2), acc[et][4 * g4 + 3] * rn * g3 * sigmoidf_(g3));
            *(v2u*)(RET + e0) = w; }
}

__device__ __forceinline__ void p3_scans(const Ctx& C, const Args& a) {
    constexpr int NSKIP = 16;
    if ((int)blockIdx.x < NSKIP) return;
    const int w0 = ((int)blockIdx.x - NSKIP) * 512 + C.tid, NW = (C.G - NSKIP) * 512;
    {
        const float* KV = a.out; bf16* PREV = (bf16*)((unsigned char*)a.out + 64 * MiB);
        for (int it = w0; it < 131072; it += NW) {
            const int elem = it * 4, b = elem >> 16, h = (elem >> 14) & 3, ed = elem & 16383;
            const float cd = __builtin_amdgcn_exp2f(128.0f * lg2_gamma(h));
            const float* kp = KV + (size_t)(b * 128 + h) * 16384 + ed; bf16* pp = PREV + (size_t)(b * 128 + h) * 16384 + frag32(ed >> 7, ed & 127, 128);
            f32x4 inc[32];
#pragma unroll
            for (int c = 0; c < 32; ++c) inc[c] = *(const f32x4*)(kp + (size_t)c * 65536);
            f32x4 st = {0.f, 0.f, 0.f, 0.f};
#pragma unroll
            for (int c = 0; c < 32; ++c) { v2u w; w.x = pk2(st[0], st[1]); w.y = pk2(st[2], st[3]); *(v2u*)(pp + (size_t)c * 65536) = w; st = st * cd + inc[c]; }
        }
    }
    {
        const float* E = (const float*)(a.ws + WS_S5E); float* X = (float*)(a.ws + WS_S5X); const float* L128 = (const float*)(a.ws + WS_S5C) + 2048;
        for (int it = w0; it < 8192; it += NW) {
            const int b = it >> 10, g = (it >> 6) & 15, p = it & 63;
            const float lr = L128[(g * 64 + p) * 2], li = L128[(g * 64 + p) * 2 + 1];
            const float* ep = E + ((size_t)(b * 32) * 16 + g) * 128 + p; float* xp = X + ((size_t)(b * 32) * 16 + g) * 128 + p;
            float er[32], ei[32];
#pragma unroll
            for (int n = 0; n < 32; ++n) { er[n] = ep[(size_t)n * 2048]; ei[n] = ep[(size_t)n * 2048 + 64]; }
            float xr = 0.f, xi = 0.f;
#pragma unroll
            for (int n = 0; n < 32; ++n) { xp[(size_t)n * 2048] = xr; xp[(size_t)n * 2048 + 64] = xi;
                const float nr = lr * xr - li * xi + er[n], ni = lr * xi + li * xr + ei[n]; xr = nr; xi = ni; }
        }
    }
}

__device__ __forceinline__ int f2key(float x) { int b = __builtin_bit_cast(int, x); return b >= 0 ? b : (b ^ 0x7fffffff); }
__device__ __forceinline__ float key2f(int k) { return __builtin_bit_cast(float, k >= 0 ? k : (k ^ 0x7fffffff)); }
__device__ __forceinline__ void ce_desc(int& x, int& y) { const int hi = x > y ? x : y, lo = x > y ? y : x; x = hi; y = lo; }
__device__ __forceinline__ void sort16_desc(int (&v)[16]) {
#pragma unroll
    for (int k = 2; k <= 16; k <<= 1)
#pragma unroll
        for (int j = k >> 1; j > 0; j >>= 1)
#pragma unroll
            for (int i = 0; i < 16; ++i) { const int l = i ^ j; if (l > i) { if ((i & k) == 0) ce_desc(v[i], v[l]); else ce_desc(v[l], v[i]); } }
}
__device__ __forceinline__ void merge16_desc(int (&T)[16], const int (&N)[16]) {
#pragma unroll
    for (int i = 0; i < 16; ++i) T[i] = T[i] > N[15 - i] ? T[i] : N[15 - i];
#pragma unroll
    for (int j = 8; j > 0; j >>= 1)
#pragma unroll
        for (int i = 0; i < 16; ++i) { const int l = i ^ j; if (l > i) ce_desc(T[i], T[l]); }
}
__device__ __forceinline__ void peer_topk_half(const Args& a, int tokbase, int hp, int c, int lane, int (&T)[16]) {
    const bf16* Q2 = (const bf16*)(a.ws + WS_Q2); const bf16* KEYS = (const bf16*)(a.ws + WS_KEYS);
    const int r = lane & 31, hh = lane >> 5;
    bf16x8 bq[8];
#pragma unroll
    for (int ks = 0; ks < 8; ++ks) bq[ks] = *(const bf16x8*)(Q2 + ((((size_t)(tokbase >> 5) * 16 + hp * 2 + c) * 8 + ks) * 64 + lane) * 8);
    const bf16* kbase = KEYS + (size_t)(hp * 2 + c) * 16384 + lane * 8;
    bf16x8 akc[8], akn[8];
#pragma unroll
    for (int ks = 0; ks < 8; ++ks) akc[ks] = *(const bf16x8*)(kbase + ks * 512);
#pragma unroll
    for (int nt = 0; nt < 4; ++nt) {
        if (nt < 3) {
#pragma unroll
            for (int ks = 0; ks < 8; ++ks) akn[ks] = *(const bf16x8*)(kbase + ((nt + 1) * 8 + ks) * 512);
        }
        __builtin_amdgcn_sched_barrier(0);
        f32x16 s;
#pragma unroll
        for (int e = 0; e < 16; ++e) s[e] = 0.f;
#pragma unroll
        for (int ks = 0; ks < 8; ++ks) s = mfma32(akc[ks], bq[ks], s);
        int N[16];
#pragma unroll
        for (int e = 0; e < 16; ++e) { const int n = nt * 32 + (e & 3) + 8 * (e >> 2) + 4 * hh; N[e] = (f2key(s[e]) & ~127) | n; }
        sort16_desc(N);
        if (nt == 0) {
#pragma unroll
            for (int e = 0; e < 16; ++e) T[e] = N[e];
        } else merge16_desc(T, N);
        __builtin_amdgcn_sched_barrier(0);
#pragma unroll
        for (int ks = 0; ks < 8; ++ks) akc[ks] = akn[ks];
    }
    int P[16];
#pragma unroll
    for (int j = 0; j < 16; ++j) P[j] = __shfl_xor(T[j], 32);
    merge16_desc(T, P);
}
__device__ __forceinline__ void peer_topk_head(const Ctx& C, const Args& a, int tokbase, int hp) {
    const int lane = C.lane, r = lane & 31, hh = lane >> 5;
    int T0[16], T1[16];
    peer_topk_half(a, tokbase, hp, 0, lane, T0);
    peer_topk_half(a, tokbase, hp, 1, lane, T1);
    int F[16], L1[16], L2[16], L3[16];
#pragma unroll
    for (int j = 0; j < 16; ++j) { L1[j] = (int)0x80000000; L2[j] = (int)0x80000000; L3[j] = (int)0x80000000; }
    {
        int cnt = 0;
#pragma unroll
        for (int i0 = 0; i0 < 16; ++i0)
#pragma unroll
            for (int i1 = 0; i1 < 16; ++i1)
                if ((i0 + 1) * (i1 + 1) <= 16) {
                    const float v = key2f(T0[i0] & ~127) + key2f(T1[i1] & ~127); const int key = (f2key(v) & ~255) | (i0 * 16 + i1);
                    if (i0 == 0) F[i1] = key;
                    else { if (cnt < 16) L1[cnt] = key; else if (cnt < 32) L2[cnt - 16] = key; else L3[cnt - 32] = key; ++cnt; }
                }
    }
    sort16_desc(L1); merge16_desc(F, L1); sort16_desc(L2); merge16_desc(F, L2); sort16_desc(L3); merge16_desc(F, L3);
    LAS int* tab = (LAS int*)(C.lds + C.wave * 16384);
#pragma unroll
    for (int j = 0; j < 16; ++j) { tab[j * 64 + lane] = T0[j] & 127; tab[(16 + j) * 64 + lane] = T1[j] & 127; }
    LDS_WAIT(); asm volatile("" ::: "memory");
    const float m = key2f(F[0] & ~255);
    float e[16], sum = 0.f;
#pragma unroll
    for (int j = 0; j < 16; ++j) { e[j] = __builtin_amdgcn_exp2f((key2f(F[j] & ~255) - m) * 1.4426950408889634f); sum += e[j]; }
    const float inv = 1.0f / sum;
    const int tok = tokbase + r;
    int* IDX = (int*)(a.ws + WS_IDX) + (size_t)tok * 128 + hp * 16; float* WGT = (float*)(a.ws + WS_WGT) + (size_t)tok * 128 + hp * 16;
    unsigned ov[16];
#pragma unroll
    for (int j = 0; j < 16; ++j) { const int id = F[j] & 255; const int k0 = tab[(id >> 4) * 64 + lane], k1 = tab[(16 + (id & 15)) * 64 + lane];
        ov[j] = (hh == 0) ? (unsigned)(k0 * 128 + k1) : __builtin_bit_cast(unsigned, e[j] * inv); }
    unsigned* obase = (hh == 0) ? (unsigned*)IDX : (unsigned*)WGT;
#pragma unroll
    for (int q = 0; q < 4; ++q) { v4u w = {ov[4 * q], ov[4 * q + 1], ov[4 * q + 2], ov[4 * q + 3]}; *(v4u*)(obase + 4 * q) = w; }
    LDS_WAIT(); asm volatile("" ::: "memory");
}
typedef float f32x2v __attribute__((ext_vector_type(2)));
__device__ __forceinline__ void unpack16(const v4u a, const v4u b, float (&x)[16]) {
    const unsigned w[8] = {a.x, a.y, a.z, a.w, b.x, b.y, b.z, b.w};
#pragma unroll
    for (int i = 0; i < 8; ++i) { x[2 * i] = bflo(w[i]); x[2 * i + 1] = bfhi(w[i]); }
}
__device__ __forceinline__ void unpack16_fp8(const v4u a, float (&x)[16]) {
    const unsigned w[4] = {a.x, a.y, a.z, a.w};
#pragma unroll
    for (int i = 0; i < 4; ++i) { const f32x2v lo = __builtin_amdgcn_cvt_pk_f32_fp8((int)w[i], false), hi = __builtin_amdgcn_cvt_pk_f32_fp8((int)w[i], true);
        x[4 * i] = lo.x; x[4 * i + 1] = lo.y; x[4 * i + 2] = hi.x; x[4 * i + 3] = hi.y; }
}
__device__ __forceinline__ long mk64(unsigned lo, unsigned hi) { return (long)(((unsigned long long)hi << 32) | (unsigned long long)lo); }
__device__ __forceinline__ float dpp_swap1(float v) { return __builtin_bit_cast(float, __builtin_amdgcn_update_dpp(0, __builtin_bit_cast(int, v), 0xB1, 0xf, 0xf, true)); }
struct PHalf { v4u g[8]; };
struct PIdx { int e[8]; };
__device__ __forceinline__ void pg_idx8(const int* IDXr, int h, int hl, PIdx& I) {
    h = min(h, hl); const int* p = IDXr + (size_t)(h >> 1) * 128 + (h & 1) * 64;
#pragma unroll
    for (int j = 0; j < 8; ++j) I.e[j] = p[j * 8];
}
__device__ __forceinline__ void pg_issue(const unsigned char* TBL, const PIdx& I, int lane, PHalf& D) {
    const unsigned c16 = (unsigned)(lane & 7) * 16u;
#pragma unroll
    for (int j = 0; j < 8; ++j) D.g[j] = *(const v4u*)(TBL + ((unsigned)I.e[j] * 128u + c16));
}
__device__ __forceinline__ void pg_stage(LAS unsigned char* buf, int lane, const PHalf& D) {
    const int row8 = lane >> 3, c8 = lane & 7;
#pragma unroll
    for (int j = 0; j < 8; ++j) *(LAS v4u*)(buf + (j * 8 + row8) * 128 + ((c8 ^ row8) & 7) * 16) = D.g[j];
}
__device__ __forceinline__ void pu_xprep(LAS unsigned char* xs, unsigned xw, int lane) {
    const float x0 = bflo(xw) * 16.f, x1 = bfhi(xw) * 16.f;
    const int hi = __builtin_amdgcn_cvt_pk_fp8_f32(x0, x1, 0, false);
    const f32x2v bk = __builtin_amdgcn_cvt_pk_f32_fp8(hi, false);
    const int lo = __builtin_amdgcn_cvt_pk_fp8_f32(x0 - bk.x, x1 - bk.y, 0, false);
    *(LAS unsigned short*)(xs + 2 * lane) = (unsigned short)hi; *(LAS unsigned short*)(xs + 128 + 2 * lane) = (unsigned short)lo;
}
typedef int v8i_t __attribute__((ext_vector_type(8)));
__device__ __forceinline__ void pu_compute(const LAS unsigned char* buf, bf16* HPt, int r, int kq, const v8i_t bfr) {
    f32x4 res[4];
#pragma unroll
    for (int g = 0; g < 4; ++g) {
        const int row = g * 16 + r, sw = row & 7;
        const v4u a0 = *(const LAS v4u*)(buf + row * 128 + ((2 * kq) ^ sw) * 16), a1 = *(const LAS v4u*)(buf + row * 128 + ((2 * kq + 1) ^ sw) * 16);
        const v8i_t av = {(int)a0.x, (int)a0.y, (int)a0.z, (int)a0.w, (int)a1.x, (int)a1.y, (int)a1.z, (int)a1.w};
        res[g] = __builtin_amdgcn_mfma_scale_f32_16x16x128_f8f6f4(av, bfr, (f32x4){0.f, 0.f, 0.f, 0.f}, 0, 0, 0, 0x7f7f7f7f, 0, 0x7f7f7f7f);
    }
    f32x4 o = res[0];
#pragma unroll
    for (int g = 1; g < 4; ++g) { const bool sel = ((r >> 1) == g);
#pragma unroll
        for (int i = 0; i < 4; ++i) o[i] = sel ? res[g][i] : o[i]; }
#pragma unroll
    for (int i = 0; i < 4; ++i) o[i] += dpp_swap1(o[i]);
    if (r < 8 && (r & 1) == 0) { v2u w; w.x = pk2(o[0], o[1]); w.y = pk2(o[2], o[3]); *(v2u*)(HPt + (r >> 1) * 16 + 4 * kq) = w; }
}
__device__ __forceinline__ int pg_idx(const int* IDXl, int h, int hl) { h = min(h, hl); return IDXl[(size_t)(h >> 1) * 128 + (h & 1) * 64]; }
__device__ __forceinline__ void peer_u_wave(const Args& a, LAS unsigned char* wlds, LAS unsigned char* wsm, int slab, int t0, int ntok, int lane) {
    const unsigned char* U8 = a.ws + WS_PU + (size_t)slab * (16384 * 128);
    const bf16* N2 = (const bf16*)(a.ws + WS_N2) + slab * 128 + 2 * lane;
    const int* IDX = (const int*)(a.ws + WS_IDX) + (lane >> 3);
    bf16* HP = (bf16*)(a.ws + WS_HPART) + (size_t)slab * MTOK * 128;
    const int r = lane & 15, kq = lane >> 4, tl = t0 + ntok - 1, H0 = 2 * t0, HL = 2 * (t0 + ntok) - 1;
    PHalf d[4]; PIdx iv[4]; v8i_t bfr;
#pragma unroll
    for (int k = 0; k < 4; ++k) pg_idx8(IDX, H0 + k, HL, iv[k]);
    unsigned xw = *(const unsigned*)(N2 + (size_t)t0 * DM);
    pg_issue(U8, iv[0], lane, d[0]); pg_issue(U8, iv[1], lane, d[1]); pg_issue(U8, iv[2], lane, d[2]);
    pg_idx8(IDX, H0 + 4, HL, iv[0]); pg_idx8(IDX, H0 + 5, HL, iv[1]); pg_idx8(IDX, H0 + 6, HL, iv[2]);
    pg_stage(wlds, lane, d[0]);
#define PU_XPREP(tok) do { pu_xprep(wsm, xw, lane); \
        { const LAS unsigned char* bp = wsm + ((r & 1) ? 128 : 0) + kq * 32; const v4u b0 = *(const LAS v4u*)bp, b1 = *(const LAS v4u*)(bp + 16); \
          bfr = (v8i_t){(int)b0.x, (int)b0.y, (int)b0.z, (int)b0.w, (int)b1.x, (int)b1.y, (int)b1.z, (int)b1.w}; } \
        xw = *(const unsigned*)(N2 + (size_t)min((tok) + 1, tl) * DM); } while (0)
#define PU_PHASE(ph, hrel, tok, half) do { \
        pg_issue(U8, iv[((ph) + 3) & 3], lane, d[((ph) + 3) & 3]); pg_idx8(IDX, hb + (hrel) + 7, HL, iv[((ph) + 3) & 3]); \
        pu_compute(wlds + ((half) ? 8192 : 0), HP + (size_t)(tok) * 128 + (half) * 64, r, kq, bfr); \
        pg_stage(wlds + ((half) ? 0 : 8192), lane, d[((ph) + 1) & 3]); } while (0)
#pragma unroll 1
    for (int hb = H0; hb <= HL; hb += 4) {
        const int t = hb >> 1;
        PU_XPREP(t);
        PU_PHASE(0, 0, t, 0);
        PU_PHASE(1, 1, t, 1);
        PU_XPREP(t + 1);
        PU_PHASE(2, 2, t + 1, 0);
        PU_PHASE(3, 3, t + 1, 1);
    }
#undef PU_XPREP
#undef PU_PHASE
}
__device__ __forceinline__ void peer_reduce(const Ctx& C, const Args& a) {
    const bf16* HP = (const bf16*)(a.ws + WS_HPART); const int* IDX = (const int*)(a.ws + WS_IDX); const float* WGT = (const float*)(a.ws + WS_WGT);
    const float* USC = (const float*)(a.ws + WS_PSC); const float* VSC = USC + 16384;
    unsigned char* ACT8 = a.ws + WS_ACT; float* ASC = (float*)(a.ws + WS_ACT + 8 * MiB);
    for (int it = C.vcu * 512 + C.tid; it < MTOK * 32; it += C.G * 512) {
        f32x4 h = {0.f, 0.f, 0.f, 0.f};
#pragma unroll
        for (int sl = 0; sl < 8; ++sl) { const v2u w = *(const v2u*)(HP + (size_t)sl * MTOK * 128 + (size_t)it * 4); h[0] += bflo(w.x); h[1] += bfhi(w.x); h[2] += bflo(w.y); h[3] += bfhi(w.y); }
        const int4 e = *(const int4*)(IDX + (size_t)it * 4); const f32x4 w = *(const f32x4*)(WGT + (size_t)it * 4);
        const int tok = it >> 5, q = it & 31;
        const float rs = 0.0625f * __builtin_amdgcn_rsqf(((const float*)(a.ws + WS_SS))[tok] * (1.f / DM) + EPS);
        f32x4 o;
        o[0] = gelu_tanh(h[0] * USC[e.x] * rs) * w[0] * VSC[e.x]; o[1] = gelu_tanh(h[1] * USC[e.y] * rs) * w[1] * VSC[e.y];
        o[2] = gelu_tanh(h[2] * USC[e.z] * rs) * w[2] * VSC[e.z]; o[3] = gelu_tanh(h[3] * USC[e.w] * rs) * w[3] * VSC[e.w];
        float mx = fmaxf(fmaxf(fabsf(o[0]), fabsf(o[1])), fmaxf(fabsf(o[2]), fabsf(o[3])));
#pragma unroll
        for (int sh = 1; sh < 32; sh <<= 1) mx = fmaxf(mx, __shfl_xor(mx, sh));
        int ex = (int)((__builtin_bit_cast(unsigned, mx) >> 23) & 0xffu) - 127; if (mx < 1e-30f) ex = 7;
        const float sc = __builtin_bit_cast(float, (unsigned)(127 + 7 - ex) << 23), isc = __builtin_bit_cast(float, (unsigned)(127 - 7 + ex) << 23);
        o = o * sc;
        int hi = __builtin_amdgcn_cvt_pk_fp8_f32(o[0], o[1], 0, false); hi = __builtin_amdgcn_cvt_pk_fp8_f32(o[2], o[3], hi, true);
        const f32x2v b0 = __builtin_amdgcn_cvt_pk_f32_fp8(hi, false), b1 = __builtin_amdgcn_cvt_pk_f32_fp8(hi, true);
        int lo = __builtin_amdgcn_cvt_pk_fp8_f32(o[0] - b0.x, o[1] - b0.y, 0, false); lo = __builtin_amdgcn_cvt_pk_fp8_f32(o[2] - b1.x, o[3] - b1.y, lo, true);
        *(unsigned*)(ACT8 + (size_t)tok * 256 + 4 * q) = (unsigned)hi; *(unsigned*)(ACT8 + (size_t)tok * 256 + 128 + 4 * q) = (unsigned)lo;
        if (q == 0) ASC[tok] = isc;
    }
}
typedef int v2i_t __attribute__((ext_vector_type(2)));
__device__ __forceinline__ void pv_compute(const LAS unsigned char* buf, int lane, const long* bact2, f32x4 (&acc)[8]) {
    const int i16 = lane & 15, kq = lane >> 4, rr = i16 >> 1, cc = i16 & 1;
#pragma unroll
    for (int s2 = 0; s2 < 2; ++s2) {
        const int row = 32 * s2 + 8 * kq + rr, sw = row & 7;
#pragma unroll
        for (int nb = 0; nb < 8; ++nb) {
            const v2i_t av = __builtin_amdgcn_ds_read_tr8_b64_v2i32((LAS v2i_t*)(buf + row * 128 + ((nb ^ sw) & 7) * 16 + 8 * cc));
            acc[nb] = __builtin_amdgcn_mfma_f32_16x16x32_fp8_fp8(mk64((unsigned)av.x, (unsigned)av.y), bact2[s2], acc[nb], 0, 0, 0);
        }
    }
}
__device__ __forceinline__ void peer_v_wave(const Args& a, LAS unsigned char* wlds, int slab, int t0, int ntok, int lane) {
    const unsigned char* V8 = a.ws + WS_PV + (size_t)slab * (16384 * 128);
    const int* IDX = (const int*)(a.ws + WS_IDX) + (lane >> 3);
    const int n16 = lane & 15, kq = lane >> 4, tl = t0 + ntok - 1, H0 = 2 * t0, HL = 2 * (t0 + ntok) - 1;
    const unsigned char* ACT8 = a.ws + WS_ACT + ((n16 & 1) ? 128 : 0) + 8 * kq; const float* ASC = (const float*)(a.ws + WS_ACT + 8 * MiB);
    bf16* PO = (bf16*)(a.ws + WS_POUT) + slab * 128;
    PHalf d[4]; PIdx iv[4]; long bact[4], bnxt[4]; f32x4 acc[8]; float isc = 1.f, iscn;
#pragma unroll
    for (int k = 0; k < 4; ++k) pg_idx8(IDX, H0 + k, HL, iv[k]);
#pragma unroll
    for (int s4 = 0; s4 < 4; ++s4) bnxt[s4] = *(const long*)(ACT8 + (size_t)t0 * 256 + 32 * s4);
    iscn = ASC[t0];
    pg_issue(V8, iv[0], lane, d[0]); pg_issue(V8, iv[1], lane, d[1]); pg_issue(V8, iv[2], lane, d[2]);
    pg_idx8(IDX, H0 + 4, HL, iv[0]); pg_idx8(IDX, H0 + 5, HL, iv[1]); pg_idx8(IDX, H0 + 6, HL, iv[2]);
    pg_stage(wlds, lane, d[0]);
#define PV_APREP(tok) do { \
        _Pragma("unroll") for (int s4 = 0; s4 < 4; ++s4) bact[s4] = bnxt[s4]; isc = iscn; \
        { const int tn = min((tok) + 1, tl); \
          _Pragma("unroll") for (int s4 = 0; s4 < 4; ++s4) bnxt[s4] = *(const long*)(ACT8 + (size_t)tn * 256 + 32 * s4); iscn = ASC[tn]; } \
        _Pragma("unroll") for (int nb = 0; nb < 8; ++nb) acc[nb] = (f32x4){0.f, 0.f, 0.f, 0.f}; } while (0)
#define PV_PHASE(ph, hrel, half) do { \
        pg_issue(V8, iv[((ph) + 3) & 3], lane, d[((ph) + 3) & 3]); pg_idx8(IDX, hb + (hrel) + 7, HL, iv[((ph) + 3) & 3]); \
        pv_compute(wlds + ((half) ? 8192 : 0), lane, bact + 2 * (half), acc); \
        pg_stage(wlds + ((half) ? 0 : 8192), lane, d[((ph) + 1) & 3]); } while (0)
#define PV_EPI(tok) do { f32x4 o = acc[0]; \
        _Pragma("unroll") for (int nb = 1; nb < 8; ++nb) { const bool sel = ((n16 >> 1) == nb); \
            _Pragma("unroll") for (int i = 0; i < 4; ++i) o[i] = sel ? acc[nb][i] : o[i]; } \
        _Pragma("unroll") for (int i = 0; i < 4; ++i) o[i] += dpp_swap1(o[i]); \
        if ((n16 & 1) == 0) { v2u w; w.x = pk2(o[0] * isc, o[1] * isc); w.y = pk2(o[2] * isc, o[3] * isc); *(v2u*)(PO + (size_t)(tok) * DM + 16 * (n16 >> 1) + 4 * kq) = w; } } while (0)
#pragma unroll 1
    for (int hb = H0; hb <= HL; hb += 4) {
        const int t = hb >> 1;
        PV_APREP(t);
        PV_PHASE(0, 0, 0);
        PV_PHASE(1, 1, 1);
        PV_EPI(t);
        PV_APREP(t + 1);
        PV_PHASE(2, 2, 0);
        PV_PHASE(3, 3, 1);
        PV_EPI(t + 1);
    }
#undef PV_APREP
#undef PV_PHASE
#undef PV_EPI
}
__device__ __forceinline__ void final_rows4(const Args& a, int tok0, int tstep, int lane) {
    const float* gf = (const float*)a.in[25] + lane * 4;
    f32x4 h[4][4]; v2u pw[4][4], hw[4][4]; float ss[4];
#pragma unroll
    for (int i = 0; i < 4; ++i) { const int tok = tok0 + i * tstep; const bf16* hb = (const bf16*)(a.ws + WS_N2) + (size_t)tok * DM + lane * 4; const bf16* po = (const bf16*)(a.ws + WS_POUT) + (size_t)tok * DM + lane * 4;
#pragma unroll
        for (int q = 0; q < 4; ++q) { hw[i][q] = *(const v2u*)(hb + 256 * q); pw[i][q] = *(const v2u*)(po + 256 * q); } }
#pragma unroll
    for (int i = 0; i < 4; ++i) { ss[i] = 0.f;
#pragma unroll
        for (int q = 0; q < 4; ++q) { h[i][q][0] = bflo(hw[i][q].x) + bflo(pw[i][q].x); h[i][q][1] = bfhi(hw[i][q].x) + bfhi(pw[i][q].x); h[i][q][2] = bflo(hw[i][q].y) + bflo(pw[i][q].y); h[i][q][3] = bfhi(hw[i][q].y) + bfhi(pw[i][q].y);
            ss[i] += (h[i][q][0] * h[i][q][0] + h[i][q][1] * h[i][q][1]) + (h[i][q][2] * h[i][q][2] + h[i][q][3] * h[i][q][3]); } }
#pragma unroll
    for (int o = 1; o < 64; o <<= 1)
#pragma unroll
        for (int i = 0; i < 4; ++i) ss[i] += __shfl_xor(ss[i], o);
    f32x4 g[4];
#pragma unroll
    for (int q = 0; q < 4; ++q) g[q] = *(const f32x4*)(gf + 256 * q);
#pragma unroll
    for (int i = 0; i < 4; ++i) { const float rstd = 1.0f / sqrtf(ss[i] * (1.f / DM) + EPS); float* orow = a.out + (size_t)(tok0 + i * tstep) * DM + lane * 4;
#pragma unroll
        for (int q = 0; q < 4; ++q) *(f32x4*)(orow + 256 * q) = h[i][q] * rstd * g[q]; }
}

__device__ __forceinline__ void claim_slab_unit(const Ctx& C, unsigned* ctl, int pass, volatile LAS unsigned* MISC, int& slab, int& unit) {
    if (C.tid == 0) {
        const unsigned x = xb_xcc_id() & 7u; unsigned sl = 8u, un = 0u;
        for (unsigned k = 0; k < 8u; ++k) { const unsigned s2 = (x + k) & 7u; const unsigned u2 = xb_add(ctl + CW_Q + 1024 * pass + 64 * s2, 1u); if (u2 < 32u) { sl = s2; un = u2; break; } }
        MISC[16] = sl; MISC[17] = un;
    }
    __syncthreads();
    slab = (int)MISC[16]; unit = (int)MISC[17];
    __syncthreads();
}
__global__ void __launch_bounds__(NWAVES * 64, 2) mk_fwd(Args args) {
    extern __shared__ __attribute__((aligned(16))) unsigned char lds_raw[];
    Ctx C;
    C.lds = (LAS unsigned char*)lds_raw;
    C.wave = __builtin_amdgcn_readfirstlane((int)threadIdx.x >> 6); C.refresh();
    C.G = gridDim.x; { const int bx = blockIdx.x; C.vcu = (C.G % 8 == 0) ? (bx % 8) * (C.G / 8) + bx / 8 : bx; }
    volatile LAS unsigned* MISC = (volatile LAS unsigned*)(C.lds + MISC_OFF);
    if (C.tid < 128) MISC[C.tid] = 0u;
    __syncthreads();
    unsigned char* ws = args.ws;
    unsigned* ctl = (unsigned*)(ws + WS_CTL);
    XcdBarrier bar; bar.bar = ctl + CW_BAR; bar.x = 0; bar.st = nullptr;
#if !MK_PER_PHASE
    bar = xcd_barrier_post(ctl + CW_BAR, MISC + 8, C.tid == 0);
#define GRID_BAR() xcd_barrier(bar, C.wave)
#else
#define GRID_BAR() do { } while (0)
#endif
    const int lo = args.ph_lo, hi = args.ph_hi;
#define IN(k) (lo <= (k) && (k) < hi)
#define SEAM(k) do { if (IN((k) + 1)) GRID_BAR(); C.refresh(); } while (0)
#define REP(k) for (int rep_ = 0; rep_ < 1 + ((REPEAT_MASK >> (k)) & 1); ++rep_)
    bf16* XN = (bf16*)(ws + WS_A);
    if (IN(0)) { REP(0) { p0_prologue(C, args); __syncthreads(); } SEAM(0); }
    if (IN(1)) {
        REP(1) {
        run_gemm(C, XN, (const bf16*)(ws + WS_WIN_T), MTOK, NZ1, DM, FStore{(bf16*)(ws + WS_Z1), NZ1});
        }
        SEAM(1);
    }
    if (IN(2)) {
        REP(2) { const int tile = C.vcu;
            _Pragma("unroll 1") for (int h = 0; h < 4; ++h) r1_unit(C, args, tile, h);
            _Pragma("unroll 1") for (int gi = 0; gi < 2; ++gi) s5a_wave(C, args, tile, C.wave + 8 * gi);
            __syncthreads();
        }
        SEAM(2);
    }
    if (IN(3)) { REP(3) { p3_scans(C, args); }
        run_gemm(C, (const bf16*)(ws + WS_MEMN), (const bf16*)(ws + WS_WMKV_T), MROWS, 512, DM, FKvm{(bf16*)(ws + WS_KM), (bf16*)(ws + WS_VT)});
        SEAM(3); }
    if (IN(4)) {
        REP(4) { const int tile = C.vcu;
            _Pragma("unroll 1") for (int gi = 0; gi < 2; ++gi) r3_wave(C, args, tile, 2 * gi + (C.wave >> 2), C.wave & 3);
            _Pragma("unroll 1") for (int gi = 0; gi < 2; ++gi) s5c_wave(C, args, tile, C.wave + 8 * gi);
            _Pragma("unroll 1") for (int gi = 0; gi < 2; ++gi) ma_wave(C, args, tile, 2 * gi + (C.wave >> 2), C.wave & 3);
        }
        SEAM(4);
    }
    if (IN(5)) {
        REP(5) {
        run_gemm_mx(C, ws + WS_XN8, ws + WS_WG8, MTOK, NGATE, DM, FSig{(bf16*)(ws + WS_G), NGATE}, 0x7b7b7b7b  , 0x77777777  );
        run_gemm(C, (const bf16*)(ws + WS_YG), (const bf16*)(ws + WS_WGLU_T), MTOK, 512, 256, FGlu{(bf16*)(ws + WS_YCAT)});
        }
        SEAM(5);
    }
    if (IN(6)) {
        const bf16* Gt = (const bf16*)(ws + WS_G);
        run_gemm_hook(C, (const bf16*)(ws + WS_YCAT), (const bf16*)(ws + WS_WCAT_T), MTOK, DM, DM, FGateOut{Gt, XN}, HookGate{Gt});
        SEAM(6);
    }
    if (IN(7)) { run_gemm(C, XN, (const bf16*)(ws + WS_WOUT_T), MTOK, DM, DM, FRes{(const float*)args.in[0], (bf16*)(ws + WS_N2), (float*)(ws + WS_SS)}); SEAM(7); }
    if (IN(9)) { REP(9) run_gemm(C, (const bf16*)(ws + WS_N2), (const bf16*)(ws + WS_WQ_T), MTOK, 2048, DM, FStoreRstd{(bf16*)(ws + WS_Q2), 2048, (const float*)(ws + WS_SS)}); SEAM(9); }
    if (IN(10)) {
        { const int tile = C.vcu;
            const int tokbase = tile * 128 + (C.wave & 3) * 32, h0 = (C.wave >> 2) * 4;
            REP(10) { _Pragma("unroll 1") for (int hp = h0; hp < h0 + 4; ++hp) peer_topk_head(C, args, tokbase, hp); }
        }
        SEAM(10);
    }
    if (IN(11)) { int slab, unit; claim_slab_unit(C, ctl, 0, MISC, slab, unit); if (slab < 8) { REP(11) peer_u_wave(args, C.lds + C.wave * 16384, C.lds + 131072 + C.wave * 1024, slab, unit * 1024 + C.wave * 128, 128, C.lane); } SEAM(11); }
    if (IN(12)) { REP(12) peer_reduce(C, args); SEAM(12); }
    if (IN(13)) { int slab, unit; claim_slab_unit(C, ctl, 1, MISC, slab, unit); if (slab < 8) { REP(13) peer_v_wave(args, C.lds + C.wave * 16384, slab, unit * 1024 + C.wave * 128, 128, C.lane); } SEAM(13); }
    if (IN(14)) {
        const int gw = C.vcu * NWAVES + C.wave, NGW = C.G * NWAVES;
        for (int m = gw; m < MTOK; m += 4 * NGW) final_rows4(args, m, NGW, C.lane);
    }
#undef IN
#undef SEAM
}

extern "C" void kernel_launch(void* const* d_in, const int* in_sizes, int n_in, void* d_out, int out_size, void* d_ws, size_t ws_size, hipStream_t stream) {
    static int grid = 0;
    if (grid == 0) {
        if (n_in != 26 || in_sizes[0] != MTOK * DM || out_size != MTOK * DM || ws_size < WS_END) {
            fprintf(stderr, "kernel_launch: unexpected problem (n_in %d, in0 %d, out %d, ws %zu < %zu); nothing launched\n", n_in, n_in > 0 ? in_sizes[0] : -1, out_size, ws_size, (size_t)WS_END); grid = -1; return; }
        int dev = 0, cus = 0;
        if (hipGetDevice(&dev) != hipSuccess || hipDeviceGetAttribute(&cus, hipDeviceAttributeMultiprocessorCount, dev) != hipSuccess) { grid = -1; return; }
        if (hipFuncSetAttribute((const void*)mk_fwd, hipFuncAttributeMaxDynamicSharedMemorySize, LDS_BYTES) != hipSuccess) { fprintf(stderr, "kernel_launch: hipFuncSetAttribute failed\n"); grid = -1; return; }
        (void)hipGetLastError();
        if (cus < NTILES) { fprintf(stderr, "kernel_launch: needs >= 256 CUs, got %d\n", cus); grid = -1; return; }
        grid = NTILES;
    }
    if (grid < 0) return;
    (void)hipMemsetAsync((char*)d_ws + WS_CTL, 0, CTL_ZERO_BYTES, stream);
    Args a{};
    for (int i = 0; i < 26; ++i) a.in[i] = d_in[i];
    a.out = (float*)d_out; a.ws = (unsigned char*)d_ws;
#if MK_PER_PHASE
    for (int p = 0; p < NPHASE; ++p) { a.ph_lo = p; a.ph_hi = p + 1; hipLaunchKernelGGL(mk_fwd, dim3(grid), dim3(NWAVES * 64), LDS_BYTES, stream, a); }
#else
    a.ph_lo = 0; a.ph_hi = NPHASE;
    hipLaunchKernelGGL(mk_fwd, dim3(grid), dim3(NWAVES * 64), LDS_BYTES, stream, a);
#endif
}
```

```cpp
#include <hip/hip_runtime.h>
#include <cstdio>
#include <cstdint>
namespace pg8 {
__device__ __forceinline__ int hw_lane_id() { int l; asm volatile("v_mbcnt_lo_u32_b32 %0, -1, 0\n\tv_mbcnt_hi_u32_b32 %0, -1, %0" : "=v"(l)); return l; }
#define PG8_LAS __attribute__((address_space(3)))
typedef unsigned short bf16_t;
typedef short bf16x8 __attribute__((ext_vector_type(8)));
typedef float f32x4 __attribute__((ext_vector_type(4)));
typedef unsigned u32x4 __attribute__((ext_vector_type(4)));
constexpr int BM = 256, BK = 64, HALF = 128, HTB = HALF * BK * 2  , STAGE_BYTES = 8 * HTB, NXCD = 8, WGM = 8;

__host__ __device__ __forceinline__ int lds_byte(int r, int c) { const int st = (r >> 4) * 2 + (c >> 5), rr = r & 15, cc = c & 31, ob = rr * 64 + cc * 2; return st * 1024 + (ob ^ (((ob >> 9) & 1) << 5)); }
__host__ __device__ __forceinline__ void stage_rc(int b, int& R, int& C) { const int st = b / 1024, sb = b % 1024, swz = sb ^ (((sb >> 9) & 1) << 5); R = (st >> 1) * 16 + swz / 64; C = (st & 1) * 32 + (swz % 64) / 2; }
__host__ __device__ __forceinline__ int perm32(int rho) { const int n = rho >> 4, i = rho & 15; return 8 * (i >> 2) + 4 * n + (i & 3); }

struct Unit { int pm, pn; };
struct Gemm { const bf16_t* A; const bf16_t* Bt; int M, N, K; };

struct StaticOrder {
    int nM, nN, nwg, G, c;
    __host__ __device__ void init(int M, int N, int G_, int c_) { nM = M / BM; nN = N / BM; nwg = nM * nN; G = G_; c = c_; }
    __host__ __device__ bool next(int i, Unit& u) const {
        const long L = (long)i * G + c; if (L >= nwg) return false;
        int wgid = (int)L; { const int q = nwg / NXCD, r = nwg % NXCD, xcd = wgid % NXCD, off = wgid / NXCD; wgid = (xcd < r ? xcd * (q + 1) : r * (q + 1) + (xcd - r) * q) + off; }
        const int nig = WGM * nN, gid = wgid / nig, fm = gid * WGM, gsz = (nM - fm) < WGM ? (nM - fm) : WGM;
        u.pm = fm + ((wgid % nig) % gsz); u.pn = (wgid % nig) / gsz; return true;
    }
    __device__ __forceinline__ void a_ready(const Unit&) const {}
    __device__ __forceinline__ void done(const Unit&) const {}
};

__device__ __forceinline__ unsigned cvt_pk_bf16(float lo, float hi) { unsigned r; asm volatile("v_cvt_pk_bf16_f32 %0, %1, %2" : "=v"(r) : "v"(lo), "v"(hi)); return r; }
struct NoKHook { __device__ __forceinline__ void operator()(int, f32x4 (&)[2][2][4][2], const Unit&, int, int, int, int) const {} };
template <class Epi, class Sched, bool ALIGN_EPI = false, bool SP2 = false, bool MX = false, class KHook = NoKHook>
__device__ __forceinline__ void gemm_phase(PG8_LAS unsigned char* lds, const Gemm g, const Sched& S, const Epi& E, const int wid, const int sclA = 0x7f7f7f7f, const int sclB = 0x7f7f7f7f, const KHook& KH = KHook()) {
    const int lane = hw_lane_id(), tid = wid * 64 + lane, wr = wid >> 2, wc = wid & 3, fr = lane & 15, fq = lane >> 4;
    const int K = g.K, nt = K / BK;
    unsigned voffA[2], voffB[2];
#pragma unroll
    for (int i = 0; i < 2; ++i) { int R, C; stage_rc(tid * 16 + i * 8192, R, C); const int Rb = Epi::PERM ? ((R & ~31) + perm32(R & 31)) : R;
        voffA[i] = (unsigned)(R * K + C) * 2u; voffB[i] = (unsigned)(Rb * K + C) * 2u; }
    const size_t kstep = (size_t)(BK * 2);
    const size_t hstep = (size_t)HALF * K * 2;
    const size_t tstep = 2 * hstep;
    const unsigned ldsw = (unsigned)wid * 1024u;
    const int aoff = lds_byte(wr * 64 + fr, fq * 8), boff = lds_byte(wc * 32 + fr, fq * 8);
#define PG8_SA(b, h) (((b) * 2 + (h)) * HTB)
#define PG8_SB(b, h) ((4 + (b) * 2 + (h)) * HTB)
#define PG8_STAGE(bufoff, gbase, voff) do { _Pragma("unroll") for (int _i = 0; _i < 2; ++_i) \
        __builtin_amdgcn_global_load_lds((const unsigned*)((const char*)(gbase) + (voff)[_i]), (PG8_LAS unsigned*)(lds + (bufoff) + ldsw + _i * 8192), 16, 0, 0); } while (0)
#define PG8_LDA(dst, b, h) do { _Pragma("unroll") for (int m = 0; m < 4; ++m) { \
        if constexpr (MX) { dst##8[m].lo = *(const PG8_LAS v4i_*)(lds + PG8_SA(b, h) + aoff + m * 2048); dst##8[m].hi = *(const PG8_LAS v4i_*)(lds + PG8_SA(b, h) + aoff + m * 2048 + 1024); } \
        else { _Pragma("unroll") for (int k = 0; k < 2; ++k) dst[m][k] = *(const PG8_LAS bf16x8*)(lds + PG8_SA(b, h) + aoff + m * 2048 + k * 1024); } } } while (0)
#define PG8_LDB(dst, b, h) do { _Pragma("unroll") for (int n = 0; n < 2; ++n) { \
        if constexpr (MX) { dst##8[n].lo = *(const PG8_LAS v4i_*)(lds + PG8_SB(b, h) + boff + n * 2048); dst##8[n].hi = *(const PG8_LAS v4i_*)(lds + PG8_SB(b, h) + boff + n * 2048 + 1024); } \
        else { _Pragma("unroll") for (int k = 0; k < 2; ++k) dst[n][k] = *(const PG8_LAS bf16x8*)(lds + PG8_SB(b, h) + boff + n * 2048 + k * 1024); } } } while (0)
#define PG8_MMA(ai, bj, At, Bt) do { __builtin_amdgcn_s_setprio(1); _Pragma("unroll") for (int m = 0; m < 4; ++m) _Pragma("unroll") for (int n = 0; n < 2; ++n) { \
        if constexpr (MX) acc[ai][bj][m][n] = __builtin_amdgcn_mfma_scale_f32_16x16x128_f8f6f4(Bt##8[n], At##8[m], acc[ai][bj][m][n], 0, 0, 0, sclB, 0, sclA); \
        else { _Pragma("unroll") for (int k = 0; k < 2; ++k) acc[ai][bj][m][n] = __builtin_amdgcn_mfma_f32_16x16x32_bf16(Bt[n][k], At[m][k], acc[ai][bj][m][n], 0, 0, 0); } } \
        if constexpr (MX) { _Pragma("unroll") for (int m = 0; m < 4; ++m) _Pragma("unroll") for (int n = 0; n < 2; ++n) asm volatile("" : "+v"(acc[ai][bj][m][n])); }     \
        __builtin_amdgcn_s_setprio(0); } while (0)
#define PG8_WAIT_V(n) asm volatile("s_waitcnt vmcnt(" #n ")" ::: "memory")
#define PG8_WAIT_L(n) asm volatile("s_waitcnt lgkmcnt(" #n ")" ::: "memory")
#define PG8_BAR __builtin_amdgcn_s_barrier()
#define PG8_SCHED __builtin_amdgcn_sched_barrier(0)
    Unit cur, nxt; int ui = 0;
    if (!S.next(0, cur)) return;
    f32x4 acc[2][2][4][2];
#pragma unroll
    for (int a = 0; a < 2; ++a)
#pragma unroll
        for (int b = 0; b < 2; ++b)
#pragma unroll
            for (int m = 0; m < 4; ++m)
#pragma unroll
                for (int n = 0; n < 2; ++n) acc[a][b][m][n] = (f32x4){0.f, 0.f, 0.f, 0.f};
    typedef int v8i_ __attribute__((ext_vector_type(8))); typedef int v4i_ __attribute__((ext_vector_type(4)));
    bf16x8 At[4][2], B0[2][2], B1[2][2]; v8i_ At8[4], B08[2], B18[2];
    const char* cA = (const char*)g.A + (size_t)cur.pm * tstep; const char* cB = (const char*)g.Bt + (size_t)cur.pn * tstep;
    S.a_ready(cur);
    if constexpr (SP2) {
        PG8_STAGE(PG8_SB(0, 0), cB, voffB); PG8_STAGE(PG8_SB(0, 1), cB + hstep, voffB); PG8_STAGE(PG8_SA(0, 0), cA, voffA); PG8_STAGE(PG8_SA(0, 1), cA + hstep, voffA);
        if (wr == 1) PG8_BAR;
        PG8_WAIT_V(2); PG8_BAR;
        PG8_STAGE(PG8_SB(1, 0), cB + kstep, voffB); PG8_STAGE(PG8_SA(1, 0), cA + kstep, voffA); PG8_STAGE(PG8_SB(1, 1), cB + hstep + kstep, voffB);
        PG8_WAIT_V(6); PG8_BAR;
    } else {
        PG8_STAGE(PG8_SB(0, 0), cB, voffB); PG8_STAGE(PG8_SA(0, 0), cA, voffA); PG8_STAGE(PG8_SB(0, 1), cB + hstep, voffB); PG8_STAGE(PG8_SA(0, 1), cA + hstep, voffA);
        if (wr == 1) PG8_BAR;
        PG8_WAIT_V(4); PG8_BAR;
        PG8_STAGE(PG8_SB(1, 0), cB + kstep, voffB); PG8_STAGE(PG8_SA(1, 0), cA + kstep, voffA); PG8_STAGE(PG8_SB(1, 1), cB + hstep + kstep, voffB);
        PG8_WAIT_V(6); PG8_BAR;
    }
    for (;;) {
        const bool has_next = S.next(ui + 1, nxt);
        const char* nA = has_next ? (const char*)g.A + (size_t)nxt.pm * tstep : cA; const char* nB = has_next ? (const char*)g.Bt + (size_t)nxt.pn * tstep : cB;
        for (int t = 0; t < nt; t += 2) {
            KH(t, acc, cur, wr, wc, fr, fq);
            const bool last = (t == nt - 2);
            const char* a1 = cA + (size_t)(t + 1) * kstep;
            const char* a2 = last ? nA : cA + (size_t)(t + 2) * kstep; const char* b2 = last ? nB : cB + (size_t)(t + 2) * kstep;
            const char* a3 = a2 + kstep; const char* b3 = b2 + kstep;
            if (last && has_next) S.a_ready(nxt);
            if constexpr (SP2) {
            PG8_LDB(B0, 0, 0); PG8_LDB(B1, 0, 1); PG8_SCHED; PG8_LDA(At, 0, 0); PG8_STAGE(PG8_SA(1, 1), a1 + hstep, voffA);
            PG8_WAIT_V(8); PG8_WAIT_L(0); PG8_BAR; PG8_MMA(0, 0, At, B0); PG8_MMA(0, 1, At, B1); PG8_BAR; PG8_SCHED;
            PG8_LDA(At, 0, 1); PG8_STAGE(PG8_SB(0, 0), b2, voffB); PG8_STAGE(PG8_SB(0, 1), b2 + hstep, voffB); PG8_STAGE(PG8_SA(0, 0), a2, voffA);
            PG8_WAIT_V(8); PG8_WAIT_L(0); PG8_BAR; PG8_MMA(1, 0, At, B0); PG8_MMA(1, 1, At, B1); PG8_BAR; PG8_SCHED;
            PG8_LDB(B0, 1, 0); PG8_LDB(B1, 1, 1); PG8_SCHED; PG8_LDA(At, 1, 0); PG8_STAGE(PG8_SA(0, 1), a2 + hstep, voffA);
            PG8_WAIT_V(8); PG8_WAIT_L(0); PG8_BAR; PG8_MMA(0, 0, At, B0); PG8_MMA(0, 1, At, B1); PG8_BAR; PG8_SCHED;
            PG8_LDA(At, 1, 1); PG8_STAGE(PG8_SB(1, 0), b3, voffB); PG8_STAGE(PG8_SB(1, 1), b3 + hstep, voffB); PG8_STAGE(PG8_SA(1, 0), a3, voffA);
            PG8_WAIT_V(8); PG8_WAIT_L(0); PG8_BAR; PG8_MMA(1, 0, At, B0); PG8_MMA(1, 1, At, B1); PG8_BAR; PG8_SCHED;
            } else {
            PG8_LDB(B0, 0, 0); PG8_SCHED; PG8_LDA(At, 0, 0); PG8_STAGE(PG8_SA(1, 1), a1 + hstep, voffA);
            PG8_WAIT_L(8); PG8_BAR; PG8_WAIT_L(0); PG8_MMA(0, 0, At, B0); PG8_BAR; PG8_SCHED;
            PG8_LDB(B1, 0, 1); PG8_STAGE(PG8_SB(0, 0), b2, voffB);
            PG8_BAR; PG8_WAIT_L(0); PG8_MMA(0, 1, At, B1); PG8_BAR;
            PG8_LDA(At, 0, 1); PG8_STAGE(PG8_SA(0, 0), a2, voffA);
            PG8_BAR; PG8_WAIT_L(0); PG8_MMA(1, 0, At, B0); PG8_BAR; PG8_SCHED;
            PG8_STAGE(PG8_SB(0, 1), b2 + hstep, voffB);
            PG8_WAIT_V(6); PG8_BAR; PG8_MMA(1, 1, At, B1); PG8_BAR;
            PG8_LDB(B0, 1, 0); PG8_SCHED; PG8_LDA(At, 1, 0); PG8_STAGE(PG8_SA(0, 1), a2 + hstep, voffA);
            PG8_WAIT_L(8); PG8_BAR; PG8_WAIT_L(0); PG8_MMA(0, 0, At, B0); PG8_BAR; PG8_SCHED;
            PG8_LDB(B1, 1, 1); PG8_STAGE(PG8_SB(1, 0), b3, voffB);
            PG8_BAR; PG8_WAIT_L(0); PG8_MMA(0, 1, At, B1); PG8_BAR;
            PG8_LDA(At, 1, 1); PG8_STAGE(PG8_SA(1, 0), a3, voffA);
            PG8_BAR; PG8_WAIT_L(0); PG8_MMA(1, 0, At, B0); PG8_BAR; PG8_SCHED;
            PG8_STAGE(PG8_SB(1, 1), b3 + hstep, voffB);
            PG8_WAIT_V(6); PG8_BAR; PG8_MMA(1, 1, At, B1); PG8_BAR;
            }
        }
        if constexpr (ALIGN_EPI) { if (wr == 0) PG8_BAR; }
        if constexpr (!Epi::AFTER_DRAIN) { E(acc, cur, wr, wc, fr, fq); S.done(cur); }
        if (!has_next) break;
#pragma unroll
        for (int a = 0; a < 2; ++a)
#pragma unroll
            for (int b = 0; b < 2; ++b)
#pragma unroll
                for (int m = 0; m < 4; ++m)
#pragma unroll
                    for (int n = 0; n < 2; ++n) acc[a][b][m][n] = (f32x4){0.f, 0.f, 0.f, 0.f};
        cur = nxt; cA = nA; cB = nB; ++ui;
        if constexpr (ALIGN_EPI) { if (wr == 1) PG8_BAR; }
    }
    PG8_WAIT_V(0);
    if constexpr (!ALIGN_EPI) { if (wr == 0) PG8_BAR; }
    PG8_BAR;
    if constexpr (Epi::AFTER_DRAIN) { E.fused(acc, cur, wr, wc, fr, fq, lds, wid, lane); S.done(cur); }
#undef PG8_SA
#undef PG8_SB
#undef PG8_STAGE
#undef PG8_LDA
#undef PG8_LDB
#undef PG8_MMA
#undef PG8_WAIT_V
#undef PG8_WAIT_L
#undef PG8_BAR
#undef PG8_SCHED
}
}

#ifndef REPEAT_MASK
#define REPEAT_MASK 0
#endif
#ifndef MK_PER_PHASE
#define MK_PER_PHASE 0
#endif

constexpr int DM = 1024, BATCH = 8, SEQ = 4096, MTOK = BATCH * SEQ;
constexpr int MEMLEN = 256, MROWS = BATCH * MEMLEN;
constexpr int NZ1 = 2560, NGATE = 3072;
constexpr int ZQ = 0, ZK = 512, ZV = 1024, ZGR = 1536, ZU = 2048, ZQM = 2304;
constexpr int NTILES = MTOK / 128;
constexpr float EPS = 1e-6f;
constexpr int NPHASE = 15;

constexpr size_t MiB = 1u << 20;
constexpr size_t WS_CTL = 0, CTL_ZERO_BYTES = 1 * MiB;
constexpr size_t WS_WIN_T = 1 * MiB;
constexpr size_t WS_WQ_T = 12 * MiB;
constexpr size_t WS_WOUT_T = 16 * MiB;
constexpr size_t WS_WCAT_T = 18 * MiB;
constexpr size_t WS_WGLU_T = 20 * MiB;
constexpr size_t WS_WMKV_T = 21 * MiB;
constexpr size_t WS_KEYS = 22 * MiB;
constexpr size_t WS_S5MAT = 23 * MiB;
constexpr size_t WS_S5C = 25 * MiB;
constexpr size_t WS_PSC = 25 * MiB + 256 * 1024;
constexpr size_t WS_SS = 25 * MiB + 512 * 1024;
constexpr size_t WS_ROPE = 26 * MiB;
constexpr size_t WS_PU = 42 * MiB;
constexpr size_t WS_PV = 58 * MiB;
constexpr size_t WS_XN8 = 74 * MiB;
constexpr size_t WS_WG8 = WS_WIN_T + 5 * MiB;
constexpr size_t WS_MEMN = 106 * MiB;
constexpr size_t WS_KM = 110 * MiB;
constexpr size_t WS_VT = 111 * MiB;
constexpr size_t WS_S5E = 112 * MiB;
constexpr size_t WS_S5X = 114 * MiB;
constexpr size_t WS_A = 116 * MiB;
constexpr size_t WS_B = 180 * MiB;
constexpr size_t WS_Z1 = WS_B;
constexpr size_t WS_G = WS_B;
constexpr size_t WS_QRF = WS_B + 160 * MiB;
constexpr size_t WS_YCAT = WS_B + 192 * MiB;
constexpr size_t WS_YG = WS_B + 256 * MiB;
constexpr size_t WS_INNER = WS_B + 272 * MiB;
constexpr size_t WS_N2 = WS_B;
constexpr size_t WS_Q2 = WS_B + 64 * MiB;
constexpr size_t WS_IDX = WS_B + 192 * MiB;
constexpr size_t WS_WGT = WS_B + 208 * MiB;
constexpr size_t WS_HPART = WS_B + 128 * MiB;
constexpr size_t WS_ACT = WS_B + 224 * MiB;
constexpr size_t WS_POUT = WS_B + 64 * MiB;
constexpr size_t WS_END = WS_B + 304 * MiB;

constexpr int CW_BAR = 4096;
constexpr int CW_Q = 8192;

constexpr int LDS_BYTES = 147456;
constexpr int MISC_OFF = LDS_BYTES - 512;
constexpr int NWAVES = 8;

#define GAS __attribute__((address_space(1)))
#define LAS __attribute__((address_space(3)))
typedef unsigned short bf16;
typedef unsigned v4u __attribute__((ext_vector_type(4)));
typedef unsigned v2u __attribute__((ext_vector_type(2)));
typedef float f32x4 __attribute__((ext_vector_type(4)));
typedef float f32x16 __attribute__((ext_vector_type(16)));
typedef short bf16x8 __attribute__((ext_vector_type(8)));
typedef GAS unsigned gu32;
#define RLX_AGENT __ATOMIC_RELAXED, __HIP_MEMORY_SCOPE_AGENT
#define LDS_WAIT() asm volatile("s_waitcnt lgkmcnt(0)" ::: "memory")
#define VM_WAIT() asm volatile("s_waitcnt vmcnt(0)" ::: "memory")
__device__ __forceinline__ unsigned f2bf(float f) { unsigned u = __builtin_bit_cast(unsigned, f); return (u + 0x7fffu + ((u >> 16) & 1u)) >> 16; }
typedef __bf16 hwbf16x2_t __attribute__((ext_vector_type(2)));
typedef float hwf32x2_t __attribute__((ext_vector_type(2)));
__device__ __forceinline__ unsigned pk2(float lo, float hi) { const hwf32x2_t v = {lo, hi}; const hwbf16x2_t b = __builtin_convertvector(v, hwbf16x2_t); return __builtin_bit_cast(unsigned, b); }
__device__ __forceinline__ float bflo(unsigned w) { return __builtin_bit_cast(float, w << 16); }
__device__ __forceinline__ float bfhi(unsigned w) { return __builtin_bit_cast(float, w & 0xffff0000u); }
__device__ __forceinline__ float bf2f(bf16 h) { return __builtin_bit_cast(float, (unsigned)h << 16); }
__device__ __forceinline__ f32x16 mfma32(bf16x8 a, bf16x8 b, f32x16 c) { return __builtin_amdgcn_mfma_f32_32x32x16_bf16(a, b, c, 0, 0, 0); }
__device__ __forceinline__ f32x4 mfma16(bf16x8 a, bf16x8 b, f32x4 c) { return __builtin_amdgcn_mfma_f32_16x16x32_bf16(a, b, c, 0, 0, 0); }
__device__ __forceinline__ bf16x8 mk8(unsigned a, unsigned b, unsigned c, unsigned d) { v4u t = {a, b, c, d}; return __builtin_bit_cast(bf16x8, t); }
__device__ __forceinline__ float sigmoidf_(float x) { return __builtin_amdgcn_rcpf(1.0f + __builtin_amdgcn_exp2f(-1.4426950408889634f * x)); }
__device__ __forceinline__ float gelu_tanh(float x) {
    const float u2 = 1.5957691216057308f * (x + 0.044715f * x * x * x);
    return x * __builtin_amdgcn_rcpf(1.0f + __builtin_amdgcn_exp2f(-1.4426950408889634f * u2));
}
__device__ __forceinline__ float wave_sum(float v) {
#pragma unroll
    for (int o = 1; o < 64; o <<= 1) v += __shfl_xor(v, o);
    return v;
}

#define XB_TMO      128
#define XB_XCNT(j)  (256  + 64 * (j))
#define XB_XSUB(j)  (1280 + 64 * (j))
#define XB_XGEN(j)  (2304 + 64 * (j))
#define XB_TOP      3328
#define XB_TOPGEN   3392
#define XCD_BAR_WORDS 3456
#define XB_SPIN_CAP (1u << 22)

__device__ __forceinline__ unsigned xb_ld(unsigned* p)              { return __hip_atomic_load(p, __ATOMIC_RELAXED, __HIP_MEMORY_SCOPE_AGENT); }
__device__ __forceinline__ unsigned xb_add(unsigned* p, unsigned v) { return __hip_atomic_fetch_add(p, v, __ATOMIC_RELAXED, __HIP_MEMORY_SCOPE_AGENT); }
__device__ __forceinline__ unsigned xb_xcc_id() { return (unsigned)__builtin_amdgcn_s_getreg((3 << 11) | 20) & 0xFu; }
#define XB_SPIN(cond, bar) do { unsigned _sp = 0; while (cond) { __builtin_amdgcn_s_sleep(1); \
    if ((++_sp & 255u) == 0u) { if (xb_ld(&(bar)[XB_TMO])) break; if (_sp > XB_SPIN_CAP) { atomicAdd(&(bar)[XB_TMO], 1u); break; } } } } while (0)

struct XcdBarrier { unsigned* bar; unsigned x; volatile LAS unsigned* st; };

__device__ __forceinline__ XcdBarrier xcd_barrier_post(unsigned* bar, volatile LAS unsigned* st, bool tid0) {
    XcdBarrier b; b.bar = bar; b.x = xb_xcc_id(); b.st = st;
    if (tid0) (void)xb_add(&bar[XB_XCNT(b.x)], 1u);
    return b;
}
__device__ __forceinline__ void xcd_barrier_complete(unsigned* bar, unsigned x, unsigned& nloc, unsigned& nx) {
    const unsigned G = gridDim.x * gridDim.y * gridDim.z;
    unsigned sum, cnt, mine, sp = 0u;
    for (;;) {
        sum = 0u; cnt = 0u; mine = 0u;
#pragma unroll
        for (unsigned j = 0; j < 16; ++j) { const unsigned c = xb_ld(&bar[XB_XCNT(j)]); sum += c; cnt += (c > 0u) ? 1u : 0u; mine = (j == x) ? c : mine; }
        if (sum == G) break;
        __builtin_amdgcn_s_sleep(1);
        if ((++sp & 255u) == 0u) { if (xb_ld(&bar[XB_TMO])) break; if (sp > XB_SPIN_CAP) { atomicAdd(&bar[XB_TMO], 1u); break; } }
    }
    nloc = mine > 0u ? mine : 1u; nx = cnt > 0u ? cnt : 1u;
}
__device__ __forceinline__ void xcd_barrier(const XcdBarrier& b, int wave) {
    asm volatile("s_waitcnt vmcnt(0)" ::: "memory");
    __syncthreads();
    if (wave == 0 && pg8::hw_lane_id() == 0) {
        unsigned* bar = b.bar;
        __builtin_amdgcn_s_waitcnt(0);
        unsigned nloc = b.st[0], nx = b.st[1];
        if (nloc == 0u) { xcd_barrier_complete(bar, b.x, nloc, nx); b.st[0] = nloc; b.st[1] = nx; }
        const unsigned old = xb_add(&bar[XB_XSUB(b.x)], 1u);
        const unsigned gen = old / nloc;
        if (old + 1u == (gen + 1u) * nloc) {
            __builtin_amdgcn_fence(__ATOMIC_RELEASE, "agent");
            asm volatile("s_waitcnt vmcnt(0)" ::: "memory");
            const unsigned og = xb_add(&bar[XB_TOP], 1u);
            const unsigned tg = og / nx;
            if (og + 1u == (tg + 1u) * nx) xb_add(&bar[XB_TOPGEN], 1u);
            else XB_SPIN(xb_ld(&bar[XB_TOPGEN]) == tg, bar);
            __builtin_amdgcn_fence(__ATOMIC_ACQUIRE, "agent");
            xb_add(&bar[XB_XGEN(b.x)], 1u);
            asm volatile("s_waitcnt vmcnt(0)" ::: "memory");
        } else {
            XB_SPIN(xb_ld(&bar[XB_XGEN(b.x)]) == gen, bar);
            __builtin_amdgcn_fence(__ATOMIC_ACQUIRE, "agent");
            asm volatile("s_waitcnt vmcnt(0)" ::: "memory");
        }
    }
    __syncthreads();
}

__host__ __device__ __forceinline__ int frag32(int row, int k, int K) { return (((row >> 5) * (K >> 4) + (k >> 4)) * 64 + ((k >> 3) & 1) * 32 + (row & 31)) * 8 + (k & 7); }
__host__ __device__ __forceinline__ int frag16(int n, int k, int K) { return (((n >> 4) * (K >> 5) + (k >> 5)) * 64 + ((k >> 3) & 3) * 16 + (n & 15)) * 8 + (k & 7); }
struct Args { const void* in[26]; float* out; unsigned char* ws; int ph_lo, ph_hi; };
struct Ctx {
    LAS unsigned char* lds;
    int tid, lane, wave, vcu, G;
    __device__ __forceinline__ void refresh() { lane = pg8::hw_lane_id(); tid = wave * 64 + lane; }
};

template <class F> struct EpiT {
    static constexpr bool PERM = true, AFTER_DRAIN = false;
    F f;
    __device__ __forceinline__ void operator()(const f32x4 (&acc)[2][2][4][2], const pg8::Unit& u, int wr, int wc, int fr, int fq) const {
        const int row0 = u.pm * 256 + wr * 64 + fr, col0 = u.pn * 256 + wc * 32 + 8 * fq;
        typename F::L cur[2], nxt[2];
        f.load(row0, col0, cur[0]); f.load(row0, col0 + 128, cur[1]);
#pragma unroll
        for (int i = 0; i < 8; ++i) {
            const int ai = i >> 2, m = i & 3, row = row0 + ai * 128 + m * 16;
            if (i < 7) { const int rown = row0 + ((i + 1) >> 2) * 128 + ((i + 1) & 3) * 16; f.load(rown, col0, nxt[0]); f.load(rown, col0 + 128, nxt[1]); }
            __builtin_amdgcn_sched_barrier(0);
            f.apply(row, col0, acc[ai][0][m][0], acc[ai][0][m][1], cur[0]); f.apply(row, col0 + 128, acc[ai][1][m][0], acc[ai][1][m][1], cur[1]);
            __builtin_amdgcn_sched_barrier(0);
            cur[0] = nxt[0]; cur[1] = nxt[1];
        }
    }
};
__device__ __forceinline__ v4u pack8(f32x4 a, f32x4 b) { v4u w; w.x = pk2(a[0], a[1]); w.y = pk2(a[2], a[3]); w.z = pk2(b[0], b[1]); w.w = pk2(b[2], b[3]); return w; }
struct LNone {};
struct FStore { typedef LNone L; bf16* O; int ldc;
    __device__ __forceinline__ void load(int, int, L&) const {}
    __device__ __forceinline__ void apply(int row, int col, f32x4 v0, f32x4 v1, const L&) const { *(v4u*)(O + (size_t)row * ldc + col) = pack8(v0, v1); } };
struct FKvm { typedef LNone L; bf16* KM; bf16* VT;
    __device__ __forceinline__ void load(int, int, L&) const {}
    __device__ __forceinline__ void apply(int row, int col, f32x4 v0, f32x4 v1, const L&) const {
        const int b = row >> 8, m = row & 255;
        if (col < 256) { const int hm = col >> 6, d0 = col & 63; *(v4u*)(KM + (size_t)(b * 4 + hm) * 16384 + frag32(m, d0, 64)) = pack8(v0, v1); }
        else { const int c = col - 256, hm = c >> 6, e0 = c & 63, mt = m >> 5, s2 = (m >> 4) & 1, w = m & 15, hh = (w >> 2) & 1, j = ((w >> 3) << 2) | (w & 3);
            bf16* p = VT + (size_t)(b * 4 + hm) * 16384 + ((mt * 2 + s2) * 64 + hh * 32) * 8 + j;
#pragma unroll
            for (int jj = 0; jj < 8; ++jj) { const int e = e0 + jj; p[((e >> 5) * 16 * 64 + (e & 31)) * 8] = (bf16)f2bf(jj < 4 ? v0[jj] : v1[jj - 4]); } }
    } };
struct FSig { typedef LNone L; bf16* O; int ldc;
    __device__ __forceinline__ void load(int, int, L&) const {}
    __device__ __forceinline__ void apply(int row, int col, f32x4 v0, f32x4 v1, const L&) const {
#pragma unroll
        for (int j = 0; j < 4; ++j) { v0[j] = sigmoidf_(v0[j]); v1[j] = sigmoidf_(v1[j]); }
        *(v4u*)(O + (size_t)row * ldc + col) = pack8(v0, v1); } };
struct FGlu { typedef LNone L; bf16* O;
    __device__ __forceinline__ void load(int, int, L&) const {}
    __device__ __forceinline__ void apply(int row, int col, f32x4 v0, f32x4 v1, const L&) const {
        v2u w; w.x = pk2(v0[0] * sigmoidf_(v1[0]), v0[1] * sigmoidf_(v1[1])); w.y = pk2(v0[2] * sigmoidf_(v1[2]), v0[3] * sigmoidf_(v1[3]));
        *(v2u*)(O + (size_t)row * 1024 + 512 + (col >> 1)) = w; } };
__device__ __forceinline__ void mul8(f32x4& v0, f32x4& v1, const v4u num, const v4u den) {
    v0[0] *= bflo(num.x) * __builtin_amdgcn_rcpf(fmaxf(bflo(den.x), 1e-30f)); v0[1] *= bfhi(num.x) * __builtin_amdgcn_rcpf(fmaxf(bfhi(den.x), 1e-30f));
    v0[2] *= bflo(num.y) * __builtin_amdgcn_rcpf(fmaxf(bflo(den.y), 1e-30f)); v0[3] *= bfhi(num.y) * __builtin_amdgcn_rcpf(fmaxf(bfhi(den.y), 1e-30f));
    v1[0] *= bflo(num.z) * __builtin_amdgcn_rcpf(fmaxf(bflo(den.z), 1e-30f)); v1[1] *= bfhi(num.z) * __builtin_amdgcn_rcpf(fmaxf(bfhi(den.z), 1e-30f));
    v1[2] *= bflo(num.w) * __builtin_amdgcn_rcpf(fmaxf(bflo(den.w), 1e-30f)); v1[3] *= bfhi(num.w) * __builtin_amdgcn_rcpf(fmaxf(bfhi(den.w), 1e-30f));
}
struct HookGate { const bf16* Gt;
    __device__ __forceinline__ void operator()(int t, f32x4 (&acc)[2][2][4][2], const pg8::Unit& u, int wr, int wc, int fr, int fq) const {
        if (t != 8 && t != 12) return;
        const int gn = (t == 8) ? 0 : 1024, gd = gn + 1024;
        int row0 = u.pm * 256 + wr * 64 + fr, col0 = u.pn * 256 + wc * 32 + 8 * fq;
        asm volatile("" : "+v"(row0), "+v"(col0));
#pragma unroll
        for (int ai = 0; ai < 2; ++ai) {
            v4u nn[4][2], dd[4][2];
#pragma unroll
            for (int m = 0; m < 4; ++m) { const bf16* gp = Gt + (size_t)(row0 + ai * 128 + m * 16) * NGATE + col0;
                nn[m][0] = *(const v4u*)(gp + gn); dd[m][0] = *(const v4u*)(gp + gd); nn[m][1] = *(const v4u*)(gp + gn + 128); dd[m][1] = *(const v4u*)(gp + gd + 128); }
            __builtin_amdgcn_sched_barrier(0);
#pragma unroll
            for (int m = 0; m < 4; ++m) { mul8(acc[ai][0][m][0], acc[ai][0][m][1], nn[m][0], dd[m][0]); mul8(acc[ai][1][m][0], acc[ai][1][m][1], nn[m][1], dd[m][1]); }
            __builtin_amdgcn_sched_barrier(0);
        }
    } };
struct LGate { v4u g; };
struct FGateOut { typedef LGate L; const bf16* Gt; bf16* MB;
    __device__ __forceinline__ void load(int row, int col, L& l) const { l.g = *(const v4u*)(Gt + (size_t)row * NGATE + 2048 + col); }
    __device__ __forceinline__ void apply(int row, int col, f32x4 v0, f32x4 v1, const L& l) const {
        const v4u g = l.g;
        v0[0] *= bflo(g.x); v0[1] *= bfhi(g.x); v0[2] *= bflo(g.y); v0[3] *= bfhi(g.y); v1[0] *= bflo(g.z); v1[1] *= bfhi(g.z); v1[2] *= bflo(g.w); v1[3] *= bfhi(g.w);
        *(v4u*)(MB + (size_t)row * DM + col) = pack8(v0, v1); } };
struct LRes { f32x4 x0, x1; };
struct FRes { typedef LRes L; const float* X; bf16* HB; float* SS;
    __device__ __forceinline__ void load(int row, int col, L& l) const { const float* xp = X + (size_t)row * DM + col; l.x0 = *(const f32x4*)xp; l.x1 = *(const f32x4*)(xp + 4); }
    __device__ __forceinline__ void apply(int row, int col, f32x4 v0, f32x4 v1, const L& l) const {
        v0 += l.x0; v1 += l.x1;
        *(v4u*)(HB + (size_t)row * DM + col) = pack8(v0, v1);
        float q = (v0[0] * v0[0] + v0[1] * v0[1]) + (v0[2] * v0[2] + v0[3] * v0[3]) + (v1[0] * v1[0] + v1[1] * v1[1]) + (v1[2] * v1[2] + v1[3] * v1[3]);
        q += __shfl_xor(q, 16); q += __shfl_xor(q, 32);
        if (pg8::hw_lane_id() < 16) atomicAdd(SS + row, q); } };
struct LRstd { float ss; };
struct FStoreRstd { typedef LRstd L; bf16* O; int ldc; const float* SS;
    __device__ __forceinline__ void load(int row, int, L& l) const { l.ss = SS[row]; }
    __device__ __forceinline__ void apply(int row, int col, f32x4 v0, f32x4 v1, const L& l) const {
        const float rs = __builtin_amdgcn_rsqf(l.ss * (1.f / DM) + EPS);
        *(v4u*)(O + ((((size_t)(row >> 5) * 16 + (col >> 7)) * 8 + ((col & 127) >> 4)) * 64 + ((col >> 3) & 1) * 32 + (row & 31)) * 8) = pack8(v0 * rs, v1 * rs); } };

template <class F>
__device__ __forceinline__ void run_gemm(const Ctx& C, const bf16* A, const bf16* Bt, int M, int N, int K, const F& f) {
    pg8::Gemm g{A, Bt, M, N, K}; pg8::StaticOrder S; S.init(M, N, C.G, (int)blockIdx.x);
    EpiT<F> E{f};
    pg8::gemm_phase<EpiT<F>, pg8::StaticOrder, true, true>(C.lds, g, S, E, C.wave);
}

template <class F, class H>
__device__ __forceinline__ void run_gemm_hook(const Ctx& C, const bf16* A, const bf16* Bt, int M, int N, int K, const F& f, const H& h) {
    pg8::Gemm g{A, Bt, M, N, K}; pg8::StaticOrder S; S.init(M, N, C.G, (int)blockIdx.x);
    EpiT<F> E{f};
    pg8::gemm_phase<EpiT<F>, pg8::StaticOrder, true, true, false, H>(C.lds, g, S, E, C.wave, 0x7f7f7f7f, 0x7f7f7f7f, h);
}
template <class F>
__device__ __forceinline__ void run_gemm_mx(const Ctx& C, const unsigned char* A8, const unsigned char* Bt8, int M, int N, int Kbytes, const F& f, int sclA, int sclB) {
    pg8::Gemm g{(const bf16*)A8, (const bf16*)Bt8, M, N, Kbytes / 2}; pg8::StaticOrder S; S.init(M, N, C.G, (int)blockIdx.x);
    EpiT<F> E{f};
    pg8::gemm_phase<EpiT<F>, pg8::StaticOrder, true, true, true>(C.lds, g, S, E, C.wave, sclA, sclB);
}

template <bool GLU>
__device__ __forceinline__ void p0_transpose_item(const float* W, int K, int N, bf16* WT, LAS float* scr, int item, int lane, const float* kscale = nullptr, int ldk = 0, int koff = 0) {
    if (ldk == 0) ldk = K;
    const int nblk = N / 32, kb = item / nblk, nb = item % nblk, k0 = 64 * kb, n0 = 32 * nb;
#pragma unroll 8
    for (int i = 0; i < 32; ++i) { const int kk = 2 * i + (lane >> 5); float w = W[(size_t)(k0 + kk) * N + n0 + (lane & 31)]; if (kscale) w *= kscale[k0 + kk]; scr[kk * 33 + (lane & 31)] = w; }
    LDS_WAIT(); asm volatile("" ::: "memory");
    const int c = lane & 7;
#pragma unroll
    for (int j = 0; j < 4; ++j) { const int n = (lane >> 3) + 8 * j; const LAS float* s = scr + (8 * c) * 33 + n;
        v4u o; o.x = pk2(s[0 * 33], s[1 * 33]); o.y = pk2(s[2 * 33], s[3 * 33]); o.z = pk2(s[4 * 33], s[5 * 33]); o.w = pk2(s[6 * 33], s[7 * 33]);
        const int nn = n0 + n; int row = nn;
        if (GLU) { const int jc = nn & 255, gate = nn >> 8; row = 8 * (jc >> 2) + 4 * gate + (jc & 3); }
        *(GAS v4u*)(WT + (size_t)row * ldk + koff + k0 + 8 * c) = o; }
    LDS_WAIT(); asm volatile("" ::: "memory");
}
__device__ __forceinline__ void p0_transpose_item_fp8(const float* W, int K, int N, unsigned char* WT8, int nsub, LAS float* scr, int item, int lane, float scale) {
    const int nblk = N / 32, kb = item / nblk, nb = item % nblk, k0 = 64 * kb, n0 = 32 * nb;
#pragma unroll 8
    for (int i = 0; i < 32; ++i) { const int kk = 2 * i + (lane >> 5); scr[kk * 33 + (lane & 31)] = W[(size_t)(k0 + kk) * N + n0 + (lane & 31)] * scale; }
    LDS_WAIT(); asm volatile("" ::: "memory");
    const int c = lane & 7;
#pragma unroll
    for (int j = 0; j < 4; ++j) { const int n = (lane >> 3) + 8 * j; const LAS float* sp = scr + (8 * c) * 33 + n;
        int p0 = __builtin_amdgcn_cvt_pk_fp8_f32(sp[0 * 33], sp[1 * 33], 0, false); p0 = __builtin_amdgcn_cvt_pk_fp8_f32(sp[2 * 33], sp[3 * 33], p0, true);
        int p1 = __builtin_amdgcn_cvt_pk_fp8_f32(sp[4 * 33], sp[5 * 33], 0, false); p1 = __builtin_amdgcn_cvt_pk_fp8_f32(sp[6 * 33], sp[7 * 33], p1, true);
        v2u o; o.x = (unsigned)p0; o.y = (unsigned)p1;
        *(GAS v2u*)(WT8 + (size_t)(n0 + n - nsub) * K + k0 + 8 * c) = o; }
    LDS_WAIT(); asm volatile("" ::: "memory");
}
template <int NR>
__device__ __forceinline__ void rms_rows_to_bf16(const float* xbase, const float* gain, bf16* obase, int m0, int mstep, int lane, unsigned char* o8base = nullptr) {
    f32x4 v[NR][4]; float s[NR];
#pragma unroll
    for (int i = 0; i < NR; ++i) { const f32x4* xr = (const f32x4*)(xbase + (size_t)(m0 + i * mstep) * DM) + lane; s[i] = 0.f;
#pragma unroll
        for (int j = 0; j < 4; ++j) v[i][j] = xr[64 * j]; }
#pragma unroll
    for (int i = 0; i < NR; ++i)
#pragma unroll
        for (int j = 0; j < 4; ++j) s[i] += (v[i][j].x * v[i][j].x + v[i][j].y * v[i][j].y) + (v[i][j].z * v[i][j].z + v[i][j].w * v[i][j].w);
#pragma unroll
    for (int o = 1; o < 64; o <<= 1)
#pragma unroll
        for (int i = 0; i < NR; ++i) s[i] += __shfl_xor(s[i], o);
    const f32x4* gr = (const f32x4*)gain + lane;
    f32x4 g[4];
#pragma unroll
    for (int j = 0; j < 4; ++j) g[j] = gr[64 * j];
#pragma unroll
    for (int i = 0; i < NR; ++i) { const float rstd = 1.0f / sqrtf(s[i] * (1.f / DM) + EPS);
        unsigned long long* o8 = (unsigned long long*)(obase + (size_t)(m0 + i * mstep) * DM) + lane;
#pragma unroll
        for (int j = 0; j < 4; ++j) { const float y0 = v[i][j].x * rstd * g[j].x, y1 = v[i][j].y * rstd * g[j].y, y2 = v[i][j].z * rstd * g[j].z, y3 = v[i][j].w * rstd * g[j].w;
            o8[64 * j] = (unsigned long long)pk2(y0, y1) | ((unsigned long long)pk2(y2, y3) << 32);
            if (o8base) { int p = __builtin_amdgcn_cvt_pk_fp8_f32(y0 * 16.f, y1 * 16.f, 0, false); p = __builtin_amdgcn_cvt_pk_fp8_f32(y2 * 16.f, y3 * 16.f, p, true);
                *(unsigned*)(o8base + (size_t)(m0 + i * mstep) * DM + 256 * j + 4 * lane) = (unsigned)p; } } }
}

__device__ __forceinline__ void p0_s5_group(const Ctx& C, const Args& a, int g, int part) {
    const float* a_re = (const float*)a.in[7]; const float* a_im = (const float*)a.in[8]; const float* log_dt = (const float*)a.in[9];
    const float* b_re = (const float*)a.in[10]; const float* b_im = (const float*)a.in[11]; const float* c_re = (const float*)a.in[12]; const float* c_im = (const float*)a.in[13];
    LAS float* L = (LAS float*)C.lds;
    LAS float* lpr = L;
    LAS float* lpi = L + 640;
    LAS float* bbr = L + 1280;
    LAS float* bbi = bbr + 1024;
    LAS float* ccr = bbi + 1024;
    LAS float* cci = ccr + 1024;
    LAS float* Kj = cci + 1024;
    const int tid = C.tid;
    bf16* T8T = (bf16*)(a.ws + WS_S5MAT) + (size_t)g * 16384;
    bf16* PMT = (bf16*)(a.ws + WS_S5MAT) + (size_t)(16 + g) * 16384;
    bf16* QMT = (bf16*)(a.ws + WS_S5MAT) + (size_t)(32 + g) * 16384;
    float* L8 = (float*)(a.ws + WS_S5C) + (size_t)g * 128;
    float* L128 = (float*)(a.ws + WS_S5C) + 2048 + (size_t)g * 128;
    for (int i = tid; i < 640; i += 512) {
        const int j10 = i >> 6, p = i & 63; const double jj = (j10 < 9) ? (double)j10 : 128.0;
        const double dt = exp((double)log_dt[g]);
        const double ar = (double)a_re[g * 64 + p], ai = (double)a_im[g * 64 + p];
        const double mag = exp(ar * dt * jj), ang = ai * dt * jj;
        lpr[i] = (float)(mag * cos(ang)); lpi[i] = (float)(mag * sin(ang));
    }
    for (int i = tid; i < 1024; i += 512) { ccr[i] = c_re[g * 1024 + i]; cci[i] = c_im[g * 1024 + i]; }
    __syncthreads();
    if (part == 0 && tid < 64) { L8[tid * 2] = lpr[8 * 64 + tid]; L8[tid * 2 + 1] = lpi[8 * 64 + tid]; L128[tid * 2] = lpr[9 * 64 + tid]; L128[tid * 2 + 1] = lpi[9 * 64 + tid]; }
    for (int i = tid; i < 1024; i += 512) {
        const int p = i >> 4, h = i & 15;
        const float ar = a_re[g * 64 + p], ai = a_im[g * 64 + p], lr = lpr[64 + p], li = lpi[64 + p];
        const float den = ar * ar + ai * ai, nr = lr - 1.0f, ni = li;
        const float cr = (nr * ar + ni * ai) / den, ci = (ni * ar - nr * ai) / den;
        const float br = b_re[(g * 64 + p) * 16 + h], bi = b_im[(g * 64 + p) * 16 + h];
        bbr[i] = cr * br - ci * bi; bbi[i] = cr * bi + ci * br;
    }
    __syncthreads();
    for (int i = tid; i < 2048; i += 512) {
        const int j = i >> 8, ho = (i >> 4) & 15, hi = i & 15; float sacc = 0.f;
        for (int p = 0; p < 64; ++p) { const float cr_ = ccr[ho * 64 + p], ci_ = cci[ho * 64 + p], lr_ = lpr[j * 64 + p], li_ = lpi[j * 64 + p];
            const float mr = cr_ * lr_ - ci_ * li_, mi = cr_ * li_ + ci_ * lr_;
            sacc += mr * bbr[p * 16 + hi] - mi * bbi[p * 16 + hi]; }
        Kj[i] = sacc;
    }
    __syncthreads();
    for (int i = part * 1024 + tid; i < (part + 1) * 1024; i += 512) {
        const int n = i >> 7, k = i & 127;
        { const int t = n >> 4, ho = n & 15, sx = k >> 4, hi = k & 15; const float v = (sx <= t) ? Kj[((t - sx) * 16 + ho) * 16 + hi] : 0.f; T8T[frag16(n, k, 128)] = (bf16)f2bf(v); }
        { const int p = n & 63, im = n >> 6, sx = k >> 4, hi = k & 15; const float lr_ = lpr[(7 - sx) * 64 + p], li_ = lpi[(7 - sx) * 64 + p], br_ = bbr[p * 16 + hi], bi_ = bbi[p * 16 + hi];
          const float v = im ? (lr_ * bi_ + li_ * br_) : (lr_ * br_ - li_ * bi_); PMT[frag16(n, k, 128)] = (bf16)f2bf(v); }
        { const int t = n >> 4, ho = n & 15, p = k & 63, pt = k >> 6; const float cr_ = ccr[ho * 64 + p], ci_ = cci[ho * 64 + p], lr_ = lpr[(t + 1) * 64 + p], li_ = lpi[(t + 1) * 64 + p];
          const float v = pt ? -(cr_ * li_ + ci_ * lr_) : (cr_ * lr_ - ci_ * li_); QMT[frag16(n, k, 128)] = (bf16)f2bf(v); }
    }
    __syncthreads();
}

__device__ __forceinline__ void p0_prologue(const Ctx& C, const Args& a) {
    p0_s5_group(C, a, C.vcu & 15, C.vcu >> 4);
    LAS float* scr = (LAS float*)(C.lds + C.wave * 16384);
    const int gw = C.vcu * NWAVES + C.wave, NGW = C.G * NWAVES;
    const int gt = C.vcu * 512 + C.tid, NGT = C.G * 512;
    unsigned char* ws = a.ws;
    for (int i = gt; i < MTOK; i += NGT) ((float*)(ws + WS_SS))[i] = 0.f;
    constexpr int I_IN = 16 * 176, I_Q = 16 * 64, I_O = 16 * 32, I_BR = 8 * 32, I_BS = 4 * 32, I_BM = 4 * 32, I_KV = 16 * 16, I_GLU = 4 * 16;
    constexpr int NITEMS = I_IN + I_Q + I_O + I_BR + I_BS + I_BM + I_KV + I_GLU;
    for (int it = gw; it < NITEMS; it += NGW) {
        int r = it;
        if (r < I_IN) { if ((r % 176) < 80) p0_transpose_item<false>((const float*)a.in[4], 1024, 5632, (bf16*)(ws + WS_WIN_T), scr, r, C.lane);
                        else p0_transpose_item_fp8((const float*)a.in[4], 1024, 5632, ws + WS_WG8, NZ1, scr, r, C.lane, 256.f); continue; } r -= I_IN;
        if (r < I_Q) { p0_transpose_item<false>((const float*)a.in[21], 1024, 2048, (bf16*)(ws + WS_WQ_T), scr, r, C.lane, (const float*)a.in[20]); continue; } r -= I_Q;
        if (r < I_O) { p0_transpose_item<false>((const float*)a.in[19], 1024, 1024, (bf16*)(ws + WS_WOUT_T), scr, r, C.lane); continue; } r -= I_O;
        if (r < I_BR) { p0_transpose_item<false>((const float*)a.in[16], 512, 1024, (bf16*)(ws + WS_WCAT_T), scr, r, C.lane, nullptr, 1024, 0); continue; } r -= I_BR;
        if (r < I_BS) { p0_transpose_item<false>((const float*)a.in[17], 256, 1024, (bf16*)(ws + WS_WCAT_T), scr, r, C.lane, nullptr, 1024, 512); continue; } r -= I_BS;
        if (r < I_BM) { p0_transpose_item<false>((const float*)a.in[18], 256, 1024, (bf16*)(ws + WS_WCAT_T), scr, r, C.lane, nullptr, 1024, 768); continue; } r -= I_BM;
        if (r < I_KV) { p0_transpose_item<false>((const float*)a.in[6], 1024, 512, (bf16*)(ws + WS_WMKV_T), scr, r, C.lane); continue; } r -= I_KV;
        p0_transpose_item<true>((const float*)a.in[15], 256, 512, (bf16*)(ws + WS_WGLU_T), scr, r, C.lane);
    }
    for (int i = gt; i < 16 * 128 * 128 / 8; i += NGT) { const f32x4 x0 = ((const f32x4*)a.in[22])[2 * (size_t)i], x1 = ((const f32x4*)a.in[22])[2 * (size_t)i + 1];
        const int hc = i >> 11, n = (i >> 4) & 127, d0 = (i & 15) * 8; *(v4u*)((bf16*)(ws + WS_KEYS) + hc * 16384 + frag32(n, d0, 128)) = pack8(x0, x1); }
    for (int rw0 = gw; rw0 < 2 * 16384; rw0 += 4 * NGW) {
        f32x4 v[4][4]; float mx[4];
#pragma unroll
        for (int i = 0; i < 4; ++i) { const int rw = rw0 + i * NGW, t = rw >> 14, row = rw & 16383;
            const float* src = (const float*)a.in[23 + t] + (size_t)row * DM + C.lane * 4; mx[i] = 0.f;
#pragma unroll
            for (int q = 0; q < 4; ++q) { v[i][q] = *(const f32x4*)(src + 256 * q); if (t == 0) v[i][q] = v[i][q] * *(const f32x4*)((const float*)a.in[20] + C.lane * 4 + 256 * q); } }
#pragma unroll
        for (int i = 0; i < 4; ++i)
#pragma unroll
            for (int q = 0; q < 4; ++q) mx[i] = fmaxf(mx[i], fmaxf(fmaxf(fabsf(v[i][q][0]), fabsf(v[i][q][1])), fmaxf(fabsf(v[i][q][2]), fabsf(v[i][q][3]))));
#pragma unroll
        for (int o = 1; o < 64; o <<= 1)
#pragma unroll
            for (int i = 0; i < 4; ++i) mx[i] = fmaxf(mx[i], __shfl_xor(mx[i], o));
#pragma unroll
        for (int i = 0; i < 4; ++i) { const int rw = rw0 + i * NGW, t = rw >> 14, row = rw & 16383;
            int ex = (int)((__builtin_bit_cast(unsigned, mx[i]) >> 23) & 0xffu) - 127;
            if (mx[i] < 1e-30f) ex = 7;
            const float sc = __builtin_bit_cast(float, (unsigned)(127 + 7 - ex) << 23), isc = __builtin_bit_cast(float, (unsigned)(127 - 7 + ex) << 23);
            unsigned char* dst = ws + (t ? WS_PV : WS_PU) + (size_t)row * 128 + ((C.lane * 4) & 127);
#pragma unroll
            for (int q = 0; q < 4; ++q) { int p = __builtin_amdgcn_cvt_pk_fp8_f32(v[i][q][0] * sc, v[i][q][1] * sc, 0, false); p = __builtin_amdgcn_cvt_pk_fp8_f32(v[i][q][2] * sc, v[i][q][3] * sc, p, true);
                *(unsigned*)(dst + (size_t)(2 * q + (C.lane >> 5)) * (16384 * 128)) = (unsigned)p; }
            if (C.lane == 0) ((float*)(ws + WS_PSC))[t * 16384 + row] = isc; }
    }
    for (int m = gw; m < MTOK; m += 4 * NGW) rms_rows_to_bf16<4>((const float*)a.in[0], (const float*)a.in[3], (bf16*)(ws + WS_A), m, NGW, C.lane, ws + WS_XN8);
    for (int m = gw; m < MROWS; m += NGW) rms_rows_to_bf16<1>((const float*)a.in[1], (const float*)a.in[5], (bf16*)(ws + WS_MEMN), m, NGW, C.lane);
    {
        const int* pos = (const int*)a.in[2]; float* rope = (float*)(ws + WS_ROPE);
        const int j = C.tid & 63;
        const double invrev = exp(-(double)j * (9.210340371976184 / 64.0)) * 0.15915494309189535;
        for (int i = gt; i < MTOK * 64; i += NGT) { const int tok = i >> 6;
            double rv = (double)pos[tok] * invrev; rv -= rint(rv);
            const float rf = (float)rv;
            rope[(size_t)tok * 128 + j] = __builtin_amdgcn_cosf(rf); rope[(size_t)tok * 128 + 64 + j] = __builtin_amdgcn_sinf(rf); }
    }
}

constexpr int LP = 136;
__device__ __forceinline__ float lg2_gamma(int h) { return log2f(1.0f - exp2f(-5.0f - (float)h)); }

struct R1In { v4u q[4], k[4]; };
__device__ __forceinline__ void r1_load(const bf16* zr, int h, int dq, int eq, R1In& R) {
    const bf16* sq = zr + ZQ + h * 128; const bf16* sk = zr + ZK + h * 128;
    R.q[0] = *(const v4u*)(sq + dq); R.q[1] = *(const v4u*)(sq + dq + 8); R.q[2] = *(const v4u*)(sq + 64 + dq); R.q[3] = *(const v4u*)(sq + 64 + dq + 8);
    R.k[0] = *(const v4u*)(sk + dq); R.k[1] = *(const v4u*)(sk + dq + 8); R.k[2] = *(const v4u*)(sk + 64 + dq); R.k[3] = *(const v4u*)(sk + 64 + dq + 8);
}
__device__ __forceinline__ void r1_unit(const Ctx& C, const Args& a, int tile, int h, const float (&cs)[16], const float (&sn)[16], const R1In& R, R1In& Rn, bool hasnext) {
    const bf16* Z1 = (const bf16*)(a.ws + WS_Z1);
    LAS bf16* Qs = (LAS bf16*)C.lds; LAS bf16* Ks = Qs + 128 * LP; LAS bf16* Kt = Ks + 128 * LP; LAS bf16* Vt = Kt + 128 * LP;
    const int tid = C.tid, lane = C.lane, t0 = tile * 128, u = tile * 4 + h;
    const float lg2g = lg2_gamma(h);
    const int i = tid >> 2, dq = (tid & 3) * 16, eq = (tid & 3) * 32;
    {
        v4u vraw[4];
#pragma unroll
        for (int q = 0; q < 4; ++q) vraw[q] = *(const v4u*)(Z1 + (size_t)(t0 + i) * NZ1 + ZV + h * 128 + eq + 8 * q);
        const float kdec = __builtin_amdgcn_exp2f((float)(127 - i) * lg2g) , ksc = 0.08838834764831845f;
#pragma unroll
        for (int which = 0; which < 2; ++which) {
            const v4u a0 = which ? R.k[0] : R.q[0], a1 = which ? R.k[1] : R.q[1], b0 = which ? R.k[2] : R.q[2], b1 = which ? R.k[3] : R.q[3];
            const unsigned aw[8] = {a0.x, a0.y, a0.z, a0.w, a1.x, a1.y, a1.z, a1.w}, bw[8] = {b0.x, b0.y, b0.z, b0.w, b1.x, b1.y, b1.z, b1.w};
            float y1[16], y2[16];
#pragma unroll
            for (int w = 0; w < 8; ++w) {
                const float x1l = bflo(aw[w]), x1h = bfhi(aw[w]), x2l = bflo(bw[w]), x2h = bfhi(bw[w]);
                y1[2 * w] = x1l * cs[2 * w] - x2l * sn[2 * w]; y2[2 * w] = x1l * sn[2 * w] + x2l * cs[2 * w];
                y1[2 * w + 1] = x1h * cs[2 * w + 1] - x2h * sn[2 * w + 1]; y2[2 * w + 1] = x1h * sn[2 * w + 1] + x2h * cs[2 * w + 1];
            }
            if (which) {
#pragma unroll
                for (int e = 0; e < 16; ++e) { y1[e] *= ksc; y2[e] *= ksc; }
            }
            LAS bf16* dstp = (which ? Ks : Qs) + i * LP;
            v4u o;
            o.x = pk2(y1[0], y1[1]); o.y = pk2(y1[2], y1[3]); o.z = pk2(y1[4], y1[5]); o.w = pk2(y1[6], y1[7]); *(LAS v4u*)(dstp + dq) = o;
            o.x = pk2(y1[8], y1[9]); o.y = pk2(y1[10], y1[11]); o.z = pk2(y1[12], y1[13]); o.w = pk2(y1[14], y1[15]); *(LAS v4u*)(dstp + dq + 8) = o;
            o.x = pk2(y2[0], y2[1]); o.y = pk2(y2[2], y2[3]); o.z = pk2(y2[4], y2[5]); o.w = pk2(y2[6], y2[7]); *(LAS v4u*)(dstp + 64 + dq) = o;
            o.x = pk2(y2[8], y2[9]); o.y = pk2(y2[10], y2[11]); o.z = pk2(y2[12], y2[13]); o.w = pk2(y2[14], y2[15]); *(LAS v4u*)(dstp + 64 + dq + 8) = o;
            if (which) {
#pragma unroll
                for (int e = 0; e < 16; ++e) { Kt[(dq + e) * LP + i] = (bf16)f2bf(y1[e] * kdec); Kt[(64 + dq + e) * LP + i] = (bf16)f2bf(y2[e] * kdec); }
            }
            __builtin_amdgcn_sched_barrier(0);
        }
        {
#pragma unroll
            for (int q = 0; q < 4; ++q) { const v4u v = vraw[q]; const unsigned vw[4] = {v.x, v.y, v.z, v.w};
#pragma unroll
                for (int w = 0; w < 4; ++w) { Vt[(eq + 8 * q + 2 * w) * LP + i] = (bf16)(vw[w] & 0xffffu); Vt[(eq + 8 * q + 2 * w + 1) * LP + i] = (bf16)(vw[w] >> 16); } }
        }
    }
    __syncthreads();
    if (hasnext) r1_load(Z1 + (size_t)(t0 + i) * NZ1, h + 1, dq, eq, Rn);
    __builtin_amdgcn_sched_barrier(0);
    const int r = lane & 31, hh = lane >> 5;
    if (C.wave < 4) {
        const int ib = C.wave;
        { bf16* qf = (bf16*)(a.ws + WS_QRF) + ((size_t)(u * 4 + ib) * 8 * 64 + lane) * 8;
#pragma unroll
          for (int ks = 0; ks < 8; ++ks) *(bf16x8*)(qf + ks * 512) = *(const LAS bf16x8*)(Qs + (ib * 32 + r) * LP + ks * 16 + 8 * hh); }
        __builtin_amdgcn_sched_barrier(0);
        f32x16 accO[4];
#pragma unroll
        for (int et = 0; et < 4; ++et)
#pragma unroll
            for (int e = 0; e < 16; ++e) accO[et][e] = 0.f;
        int i = ib * 32 + r; asm volatile("" : "+v"(i));
#pragma unroll
        for (int jt = 0; jt < 4; ++jt) {
            if (jt <= ib) {
                f32x16 s;
#pragma unroll
                for (int e = 0; e < 16; ++e) s[e] = 0.f;
#pragma unroll
                for (int ks = 0; ks < 8; ++ks) { const bf16x8 ak = *(const LAS bf16x8*)(Ks + (jt * 32 + r) * LP + ks * 16 + 8 * hh), bqk = *(const LAS bf16x8*)(Qs + (ib * 32 + r) * LP + ks * 16 + 8 * hh); s = mfma32(ak, bqk, s); }
                unsigned pk[8];
#pragma unroll
                for (int q = 0; q < 8; ++q) {
                    const int ra = 2 * q, rb = 2 * q + 1;
                    const int ja = jt * 32 + (ra & 3) + 8 * (ra >> 2) + 4 * hh, jb = jt * 32 + (rb & 3) + 8 * (rb >> 2) + 4 * hh;
                    const float va = (i >= ja) ? s[ra] * __builtin_amdgcn_exp2f((float)(i - ja) * lg2g) : 0.f;
                    const float vb = (i >= jb) ? s[rb] * __builtin_amdgcn_exp2f((float)(i - jb) * lg2g) : 0.f;
                    pk[q] = pk2(va, vb);
                }
#pragma unroll
                for (int sft = 0; sft < 2; ++sft) {
                    const bf16x8 pb = mk8(pk[4 * sft], pk[4 * sft + 1], pk[4 * sft + 2], pk[4 * sft + 3]);
#pragma unroll
                    for (int et = 0; et < 4; ++et) {
                        const LAS bf16* vp = Vt + (et * 32 + r) * LP + jt * 32 + 16 * sft + 4 * hh;
                        const v2u lo = *(const LAS v2u*)vp, hi = *(const LAS v2u*)(vp + 8);
                        accO[et] = mfma32(mk8(lo.x, lo.y, hi.x, hi.y), pb, accO[et]);
                    }
                }
            }
            __builtin_amdgcn_sched_barrier(0);
        }
        unsigned* INN = (unsigned*)(a.ws + WS_INNER) + ((size_t)(u * 4 + ib) * 32) * 64 + lane;
#pragma unroll
        for (int et = 0; et < 4; ++et)
#pragma unroll
            for (int q = 0; q < 8; ++q) INN[(et * 8 + q) * 64] = pk2(accO[et][2 * q], accO[et][2 * q + 1]);
    } else {
        const int et = C.wave - 4;
        f32x16 acc[4];
#pragma unroll
        for (int dt = 0; dt < 4; ++dt)
#pragma unroll
            for (int e = 0; e < 16; ++e) acc[dt][e] = 0.f;
#pragma unroll
        for (int ks = 0; ks < 8; ++ks) {
            const bf16x8 av = *(const LAS bf16x8*)(Vt + (et * 32 + r) * LP + ks * 16 + 8 * hh);
#pragma unroll
            for (int dt = 0; dt < 4; ++dt) { const bf16x8 bk = *(const LAS bf16x8*)(Kt + (dt * 32 + r) * LP + ks * 16 + 8 * hh); acc[dt] = mfma32(av, bk, acc[dt]); }
            __builtin_amdgcn_sched_barrier(0);
        }
        float* KVb = a.out + (size_t)u * 16384 + (size_t)(et * 32 + 4 * hh) * 128 + r;
#pragma unroll
        for (int dt = 0; dt < 4; ++dt) {
#pragma unroll
            for (int e = 0; e < 16; ++e) KVb[((e & 3) + 8 * (e >> 2)) * 128 + dt * 32] = acc[dt][e];
            __builtin_amdgcn_sched_barrier(0);
        }
    }
    __syncthreads();
}

__device__ __forceinline__ void s5_compute_E(const Args& a, int tile, int g, int lane, LAS float* Es, bf16x8 (&au)[4]) {
    const bf16* Z1 = (const bf16*)(a.ws + WS_Z1); const bf16* PMT = (const bf16*)(a.ws + WS_S5MAT) + (size_t)(16 + g) * 16384;
    const int r16 = lane & 15, q4 = lane >> 4;
#pragma unroll
    for (int ks = 0; ks < 4; ++ks) { const int s = 2 * ks + (q4 >> 1);
        au[ks] = *(const bf16x8*)(Z1 + (size_t)(tile * 128 + 8 * r16 + s) * NZ1 + ZU + g * 16 + 8 * (q4 & 1)); }
    bf16x8 bc[4], bn[4];
#pragma unroll
    for (int ks = 0; ks < 4; ++ks) bc[ks] = *(const bf16x8*)(PMT + (ks * 64 + lane) * 8);
#pragma unroll 1
    for (int nb = 0; nb < 8; ++nb) {
        const int nbn = min(nb + 1, 7);
#pragma unroll
        for (int ks = 0; ks < 4; ++ks) bn[ks] = *(const bf16x8*)(PMT + ((nbn * 4 + ks) * 64 + lane) * 8);
        __builtin_amdgcn_sched_barrier(0);
        f32x4 acc = {0.f, 0.f, 0.f, 0.f};
#pragma unroll
        for (int ks = 0; ks < 4; ++ks) acc = mfma16(au[ks], bc[ks], acc);
#pragma unroll
        for (int i4 = 0; i4 < 4; ++i4) Es[(q4 * 4 + i4) * 128 + nb * 16 + r16] = acc[i4];
        __builtin_amdgcn_sched_barrier(0);
#pragma unroll
        for (int ks = 0; ks < 4; ++ks) bc[ks] = bn[ks];
    }
    LDS_WAIT(); asm volatile("" ::: "memory");
}
__device__ __forceinline__ void s5a_wave(const Ctx& C, const Args& a, int tile, int g) {
    LAS float* Es = (LAS float*)(C.lds + C.wave * 16384);
    bf16x8 au[4];
    s5_compute_E(a, tile, g, C.lane, Es, au);
    const float* L8 = (const float*)(a.ws + WS_S5C) + (size_t)g * 128;
    const float l8r = L8[C.lane * 2], l8i = L8[C.lane * 2 + 1];
    float sr = 0.f, si = 0.f;
#pragma unroll
    for (int c = 0; c < 16; ++c) { const float er = Es[c * 128 + C.lane], ei = Es[c * 128 + 64 + C.lane];
        const float nr = l8r * sr - l8i * si + er, ni = l8r * si + l8i * sr + ei; sr = nr; si = ni; }
    float* E = (float*)(a.ws + WS_S5E) + ((size_t)tile * 16 + g) * 128;
    E[C.lane] = sr; E[64 + C.lane] = si;
    LDS_WAIT(); asm volatile("" ::: "memory");
}
__device__ __forceinline__ void s5c_wave(const Ctx& C, const Args& a, int tile, int g) {
    LAS float* Es = (LAS float*)(C.lds + C.wave * 16384);
    LAS bf16* Sv = (LAS bf16*)(C.lds + C.wave * 16384 + 8192);
    const int lane = C.lane, r16 = lane & 15, q4 = lane >> 4;
    bf16x8 au[4];
    s5_compute_E(a, tile, g, lane, Es, au);
    const float* L8 = (const float*)(a.ws + WS_S5C) + (size_t)g * 128;
    const float l8r = L8[lane * 2], l8i = L8[lane * 2 + 1];
    const float* X = (const float*)(a.ws + WS_S5X) + ((size_t)tile * 16 + g) * 128;
    float sr = X[lane], si = X[64 + lane];
#pragma unroll
    for (int c = 0; c < 16; ++c) {
        Sv[c * LP + lane] = (bf16)f2bf(sr); Sv[c * LP + 64 + lane] = (bf16)f2bf(si);
        const float er = Es[c * 128 + lane], ei = Es[c * 128 + 64 + lane];
        const float nr = l8r * sr - l8i * si + er, ni = l8r * si + l8i * sr + ei; sr = nr; si = ni; }
    LDS_WAIT(); asm volatile("" ::: "memory");
    bf16x8 as[4];
#pragma unroll
    for (int ks = 0; ks < 4; ++ks) as[ks] = *(const LAS bf16x8*)(Sv + r16 * LP + ks * 32 + 8 * q4);
    const bf16* T8T = (const bf16*)(a.ws + WS_S5MAT) + (size_t)g * 16384; const bf16* QMT = (const bf16*)(a.ws + WS_S5MAT) + (size_t)(32 + g) * 16384;
    const bf16* Z1 = (const bf16*)(a.ws + WS_Z1); bf16* YG = (bf16*)(a.ws + WS_YG);
    const float dg = ((const float*)a.in[14])[g * 16 + r16];
    bf16x8 tc[4], tn[4], qc[4], qn[4]; bf16 uc[4], un[4];
#pragma unroll
    for (int ks = 0; ks < 4; ++ks) { tc[ks] = *(const bf16x8*)(T8T + (ks * 64 + lane) * 8); qc[ks] = *(const bf16x8*)(QMT + (ks * 64 + lane) * 8); }
#pragma unroll
    for (int i4 = 0; i4 < 4; ++i4) uc[i4] = Z1[(size_t)(tile * 128 + 8 * (q4 * 4 + i4)) * NZ1 + ZU + g * 16 + r16];
#pragma unroll 1
    for (int nb = 0; nb < 8; ++nb) {
        const int nbn = min(nb + 1, 7);
#pragma unroll
        for (int ks = 0; ks < 4; ++ks) { tn[ks] = *(const bf16x8*)(T8T + ((nbn * 4 + ks) * 64 + lane) * 8); qn[ks] = *(const bf16x8*)(QMT + ((nbn * 4 + ks) * 64 + lane) * 8); }
#pragma unroll
        for (int i4 = 0; i4 < 4; ++i4) un[i4] = Z1[(size_t)(tile * 128 + 8 * (q4 * 4 + i4) + nbn) * NZ1 + ZU + g * 16 + r16];
        __builtin_amdgcn_sched_barrier(0);
        f32x4 acc = {0.f, 0.f, 0.f, 0.f};
#pragma unroll
        for (int ks = 0; ks < 4; ++ks) { acc = mfma16(au[ks], tc[ks], acc); acc = mfma16(as[ks], qc[ks], acc); }
#pragma unroll
        for (int i4 = 0; i4 < 4; ++i4) { const int tok = tile * 128 + 8 * (q4 * 4 + i4) + nb;
            YG[(size_t)tok * 256 + g * 16 + r16] = (bf16)f2bf(gelu_tanh(acc[i4] + dg * bf2f(uc[i4]))); }
        __builtin_amdgcn_sched_barrier(0);
#pragma unroll
        for (int ks = 0; ks < 4; ++ks) { tc[ks] = tn[ks]; qc[ks] = qn[ks]; }
#pragma unroll
        for (int i4 = 0; i4 < 4; ++i4) uc[i4] = un[i4];
    }
    LDS_WAIT(); asm volatile("" ::: "memory");
}

__device__ __forceinline__ void ma_loadk(const bf16* kp, int mt, bf16x8 (&k)[4]) {
#pragma unroll
    for (int ks = 0; ks < 4; ++ks) k[ks] = *(const bf16x8*)(kp + (mt * 4 + ks) * 512);
}
__device__ __forceinline__ void ma_loadv(const bf16* vp, int mt, bf16x8 (&v)[4]) {
#pragma unroll
    for (int sft = 0; sft < 2; ++sft)
#pragma unroll
        for (int et = 0; et < 2; ++et) v[sft * 2 + et] = *(const bf16x8*)(vp + (((et * 8 + mt) * 2 + sft) * 64) * 8);
}
__device__ __forceinline__ void ma_wave(const Ctx& C, const Args& a, int tile, int hm, int ib) {
    const bf16* Z1 = (const bf16*)(a.ws + WS_Z1); const bf16* KM = (const bf16*)(a.ws + WS_KM); const bf16* VT = (const bf16*)(a.ws + WS_VT);
    const int lane = C.lane, r = lane & 31, hh = lane >> 5, b = tile >> 5, tok = tile * 128 + ib * 32 + r;
    const bf16* kp = KM + (size_t)(b * 4 + hm) * 16384 + lane * 8;
    const bf16* vp = VT + (size_t)(b * 4 + hm) * 16384 + lane * 8;
    bf16x8 bq[4];
#pragma unroll
    for (int ks = 0; ks < 4; ++ks) bq[ks] = *(const bf16x8*)(Z1 + (size_t)tok * NZ1 + ZQM + hm * 64 + ks * 16 + 8 * hh);
    bf16x8 kc[4], kn[4];
    ma_loadk(kp, 0, kc);
    float mx = -3.0e38f;
#pragma unroll 1
    for (int mt = 0; mt < 8; ++mt) {
        ma_loadk(kp, min(mt + 1, 7), kn); __builtin_amdgcn_sched_barrier(0);
        f32x16 s;
#pragma unroll
        for (int e = 0; e < 16; ++e) s[e] = 0.f;
#pragma unroll
        for (int ks = 0; ks < 4; ++ks) s = mfma32(kc[ks], bq[ks], s);
#pragma unroll
        for (int e = 0; e < 16; ++e) mx = fmaxf(mx, s[e]);
        __builtin_amdgcn_sched_barrier(0);
#pragma unroll
        for (int ks = 0; ks < 4; ++ks) kc[ks] = kn[ks];
    }
    mx = fmaxf(mx, __shfl_xor(mx, 32));
    float sum = 0.f;
    f32x16 o[2];
#pragma unroll
    for (int et = 0; et < 2; ++et)
#pragma unroll
        for (int e = 0; e < 16; ++e) o[et][e] = 0.f;
    const float sc = 0.125f * 1.4426950408889634f;
    bf16x8 vc[4], vn[4];
    ma_loadk(kp, 0, kc); ma_loadv(vp, 0, vc);
#pragma unroll 1
    for (int mt = 0; mt < 8; ++mt) {
        ma_loadk(kp, min(mt + 1, 7), kn); ma_loadv(vp, min(mt + 1, 7), vn); __builtin_amdgcn_sched_barrier(0);
        f32x16 s;
#pragma unroll
        for (int e = 0; e < 16; ++e) s[e] = 0.f;
#pragma unroll
        for (int ks = 0; ks < 4; ++ks) s = mfma32(kc[ks], bq[ks], s);
        unsigned pk[8];
#pragma unroll
        for (int q = 0; q < 8; ++q) { const float pa = __builtin_amdgcn_exp2f((s[2 * q] - mx) * sc), pb = __builtin_amdgcn_exp2f((s[2 * q + 1] - mx) * sc); sum += pa + pb; pk[q] = pk2(pa, pb); }
#pragma unroll
        for (int sft = 0; sft < 2; ++sft) {
            const bf16x8 pb = mk8(pk[4 * sft], pk[4 * sft + 1], pk[4 * sft + 2], pk[4 * sft + 3]);
#pragma unroll
            for (int et = 0; et < 2; ++et) o[et] = mfma32(vc[sft * 2 + et], pb, o[et]);
        }
        __builtin_amdgcn_sched_barrier(0);
#pragma unroll
        for (int ks = 0; ks < 4; ++ks) kc[ks] = kn[ks];
#pragma unroll
        for (int q = 0; q < 4; ++q) vc[q] = vn[q];
    }
    sum += __shfl_xor(sum, 32);
    const float inv = 1.0f / sum;
    bf16* MA = (bf16*)(a.ws + WS_YCAT) + (size_t)tok * 1024 + 768 + hm * 64;
#pragma unroll
    for (int et = 0; et < 2; ++et)
#pragma unroll
        for (int g4 = 0; g4 < 4; ++g4) { v2u w; w.x = pk2(o[et][4 * g4] * inv, o[et][4 * g4 + 1] * inv); w.y = pk2(o[et][4 * g4 + 2] * inv, o[et][4 * g4 + 3] * inv);
            *(v2u*)(MA + et * 32 + 8 * g4 + 4 * hh) = w; }
}

__device__ __forceinline__ void r3_wave(const Ctx& C, const Args& a, int tile, int h, int ib) {
    const bf16* Z1 = (const bf16*)(a.ws + WS_Z1); const float* ROPE = (const float*)(a.ws + WS_ROPE);
    const bf16* PREV = (const bf16*)((const unsigned char*)a.out + 64 * MiB);
    const int lane = C.lane, r = lane & 31, hh = lane >> 5, u = tile * 4 + h, tok = tile * 128 + ib * 32 + r;
    const float lg2g = lg2_gamma(h);
    bf16x8 bq[8];
    { const bf16* qf = (const bf16*)(a.ws + WS_QRF) + ((size_t)(u * 4 + ib) * 8 * 64 + lane) * 8;
#pragma unroll
      for (int ks = 0; ks < 8; ++ks) bq[ks] = *(const bf16x8*)(qf + ks * 512); }
    f32x16 acc[4];
    const bf16* pbase = PREV + (size_t)u * 16384 + lane * 8;
    bf16x8 apc[8], apn[8];
#pragma unroll
    for (int ks = 0; ks < 8; ++ks) apc[ks] = *(const bf16x8*)(pbase + ks * 512);
#pragma unroll
    for (int et = 0; et < 4; ++et) {
        if (et < 3) {
#pragma unroll
            for (int ks = 0; ks < 8; ++ks) apn[ks] = *(const bf16x8*)(pbase + ((et + 1) * 8 + ks) * 512);
        }
        __builtin_amdgcn_sched_barrier(0);
#pragma unroll
        for (int e = 0; e < 16; ++e) acc[et][e] = 0.f;
#pragma unroll
        for (int ks = 0; ks < 8; ++ks) acc[et] = mfma32(apc[ks], bq[ks], acc[et]);
        __builtin_amdgcn_sched_barrier(0);
#pragma unroll
        for (int ks = 0; ks < 8; ++ks) apc[ks] = apn[ks];
    }
    const float qdec = __builtin_amdgcn_exp2f((float)(ib * 32 + r + 1) * lg2g);
    const unsigned* INN = (const unsigned*)(a.ws + WS_INNER) + ((size_t)(u * 4 + ib) * 32) * 64 + lane;
    float ss = 0.f;
    unsigned innw[32];
#pragma unroll
    for (int q = 0; q < 32; ++q) innw[q] = INN[q * 64];
#pragma unroll
    for (int et = 0; et < 4; ++et)
#pragma unroll
        for (int q = 0; q < 8; ++q) { const unsigned w = innw[et * 8 + q];
            const float v0 = acc[et][2 * q] * qdec + bflo(w), v1 = acc[et][2 * q + 1] * qdec + bfhi(w);
            acc[et][2 * q] = v0; acc[et][2 * q + 1] = v1; ss += v0 * v0 + v1 * v1; }
    __builtin_amdgcn_sched_barrier(0);
    ss += __shfl_xor(ss, 32);
    const float rn = __builtin_amdgcn_rsqf(ss * (1.0f / 128.0f) + EPS);
    const bf16* gp = Z1 + (size_t)tok * NZ1 + ZGR + h * 128; bf16* RET = (bf16*)(a.ws + WS_YCAT) + (size_t)tok * 1024 + h * 128;
#pragma unroll
    for (int et = 0; et < 4; ++et)
#pragma unroll
        for (int g4 = 0; g4 < 4; ++g4) { const int e0 = et * 32 + 8 * g4 + 4 * hh; const v2u gw = *(const v2u*)(gp + e0);
            const float g0 = bflo(gw.x), g1 = bfhi(gw.x), g2 = bflo(gw.y), g3 = bfhi(gw.y);
            v2u w; w.x = pk2(acc[et][4 * g4] * rn * g0 * sigmoidf_(g0), acc[et][4 * g4 + 1] * rn * g1 * sigmoidf_(g1));
            w.y = pk2(acc[et][4 * g4 + 2] * rn * g2 * sigmoidf_(g2), acc[et][4 * g4 + 3] * rn * g3 * sigmoidf_(g3));
            *(v2u*)(RET + e0) = w; }
}

__device__ __forceinline__ void p3_scans(const Ctx& C, const Args& a) {
    constexpr int NSKIP = 16;
    if ((int)blockIdx.x < NSKIP) return;
    const int w0 = ((int)blockIdx.x - NSKIP) * 512 + C.tid, NW = (C.G - NSKIP) * 512;
    {
        const float* KV = a.out; bf16* PREV = (bf16*)((unsigned char*)a.out + 64 * MiB);
        for (int it = w0; it < 131072; it += NW) {
            const int elem = it * 4, b = elem >> 16, h = (elem >> 14) & 3, ed = elem & 16383;
            const float cd = __builtin_amdgcn_exp2f(128.0f * lg2_gamma(h));
            const float* kp = KV + (size_t)(b * 128 + h) * 16384 + ed; bf16* pp = PREV + (size_t)(b * 128 + h) * 16384 + frag32(ed >> 7, ed & 127, 128);
            f32x4 inc[32];
#pragma unroll
            for (int c = 0; c < 32; ++c) inc[c] = *(const f32x4*)(kp + (size_t)c * 65536);
            f32x4 st = {0.f, 0.f, 0.f, 0.f};
#pragma unroll
            for (int c = 0; c < 32; ++c) { v2u w; w.x = pk2(st[0], st[1]); w.y = pk2(st[2], st[3]); *(v2u*)(pp + (size_t)c * 65536) = w; st = st * cd + inc[c]; }
        }
    }
    {
        const float* E = (const float*)(a.ws + WS_S5E); float* X = (float*)(a.ws + WS_S5X); const float* L128 = (const float*)(a.ws + WS_S5C) + 2048;
        for (int it = w0; it < 8192; it += NW) {
            const int b = it >> 10, g = (it >> 6) & 15, p = it & 63;
            const float lr = L128[(g * 64 + p) * 2], li = L128[(g * 64 + p) * 2 + 1];
            const float* ep = E + ((size_t)(b * 32) * 16 + g) * 128 + p; float* xp = X + ((size_t)(b * 32) * 16 + g) * 128 + p;
            float er[32], ei[32];
#pragma unroll
            for (int n = 0; n < 32; ++n) { er[n] = ep[(size_t)n * 2048]; ei[n] = ep[(size_t)n * 2048 + 64]; }
            float xr = 0.f, xi = 0.f;
#pragma unroll
            for (int n = 0; n < 32; ++n) { xp[(size_t)n * 2048] = xr; xp[(size_t)n * 2048 + 64] = xi;
                const float nr = lr * xr - li * xi + er[n], ni = lr * xi + li * xr + ei[n]; xr = nr; xi = ni; }
        }
    }
}

__device__ __forceinline__ int f2key(float x) { int b = __builtin_bit_cast(int, x); return b >= 0 ? b : (b ^ 0x7fffffff); }
__device__ __forceinline__ float key2f(int k) { return __builtin_bit_cast(float, k >= 0 ? k : (k ^ 0x7fffffff)); }
__device__ __forceinline__ void ce_desc(int& x, int& y) { const int hi = x > y ? x : y, lo = x > y ? y : x; x = hi; y = lo; }
__device__ __forceinline__ void sort16_desc(int (&v)[16]) {
#pragma unroll
    for (int k = 2; k <= 16; k <<= 1)
#pragma unroll
        for (int j = k >> 1; j > 0; j >>= 1)
#pragma unroll
            for (int i = 0; i < 16; ++i) { const int l = i ^ j; if (l > i) { if ((i & k) == 0) ce_desc(v[i], v[l]); else ce_desc(v[l], v[i]); } }
}
__device__ __forceinline__ void merge16_desc(int (&T)[16], const int (&N)[16]) {
#pragma unroll
    for (int i = 0; i < 16; ++i) T[i] = T[i] > N[15 - i] ? T[i] : N[15 - i];
#pragma unroll
    for (int j = 8; j > 0; j >>= 1)
#pragma unroll
        for (int i = 0; i < 16; ++i) { const int l = i ^ j; if (l > i) ce_desc(T[i], T[l]); }
}
__device__ __forceinline__ void peer_topk_half(const Args& a, int tokbase, int hp, int c, int lane, int (&T)[16]) {
    const bf16* Q2 = (const bf16*)(a.ws + WS_Q2); const bf16* KEYS = (const bf16*)(a.ws + WS_KEYS);
    const int r = lane & 31, hh = lane >> 5;
    bf16x8 bq[8];
#pragma unroll
    for (int ks = 0; ks < 8; ++ks) bq[ks] = *(const bf16x8*)(Q2 + ((((size_t)(tokbase >> 5) * 16 + hp * 2 + c) * 8 + ks) * 64 + lane) * 8);
    const bf16* kbase = KEYS + (size_t)(hp * 2 + c) * 16384 + lane * 8;
    bf16x8 akc[8], akn[8];
#pragma unroll
    for (int ks = 0; ks < 8; ++ks) akc[ks] = *(const bf16x8*)(kbase + ks * 512);
#pragma unroll
    for (int nt = 0; nt < 4; ++nt) {
        if (nt < 3) {
#pragma unroll
            for (int ks = 0; ks < 8; ++ks) akn[ks] = *(const bf16x8*)(kbase + ((nt + 1) * 8 + ks) * 512);
        }
        __builtin_amdgcn_sched_barrier(0);
        f32x16 s;
#pragma unroll
        for (int e = 0; e < 16; ++e) s[e] = 0.f;
#pragma unroll
        for (int ks = 0; ks < 8; ++ks) s = mfma32(akc[ks], bq[ks], s);
        int N[16];
#pragma unroll
        for (int e = 0; e < 16; ++e) { const int n = nt * 32 + (e & 3) + 8 * (e >> 2) + 4 * hh; N[e] = (f2key(s[e]) & ~127) | n; }
        sort16_desc(N);
        if (nt == 0) {
#pragma unroll
            for (int e = 0; e < 16; ++e) T[e] = N[e];
        } else merge16_desc(T, N);
        __builtin_amdgcn_sched_barrier(0);
#pragma unroll
        for (int ks = 0; ks < 8; ++ks) akc[ks] = akn[ks];
    }
    int P[16];
#pragma unroll
    for (int j = 0; j < 16; ++j) P[j] = __shfl_xor(T[j], 32);
    merge16_desc(T, P);
}
__device__ __forceinline__ void peer_topk_head(const Ctx& C, const Args& a, int tokbase, int hp) {
    const int lane = C.lane, r = lane & 31, hh = lane >> 5;
    int T0[16], T1[16];
    peer_topk_half(a, tokbase, hp, 0, lane, T0);
    peer_topk_half(a, tokbase, hp, 1, lane, T1);
    int F[16], L1[16], L2[16], L3[16];
#pragma unroll
    for (int j = 0; j < 16; ++j) { L1[j] = (int)0x80000000; L2[j] = (int)0x80000000; L3[j] = (int)0x80000000; }
    {
        int cnt = 0;
#pragma unroll
        for (int i0 = 0; i0 < 16; ++i0)
#pragma unroll
            for (int i1 = 0; i1 < 16; ++i1)
                if ((i0 + 1) * (i1 + 1) <= 16) {
                    const float v = key2f(T0[i0] & ~127) + key2f(T1[i1] & ~127); const int key = (f2key(v) & ~255) | (i0 * 16 + i1);
                    if (i0 == 0) F[i1] = key;
                    else { if (cnt < 16) L1[cnt] = key; else if (cnt < 32) L2[cnt - 16] = key; else L3[cnt - 32] = key; ++cnt; }
                }
    }
    sort16_desc(L1); merge16_desc(F, L1); sort16_desc(L2); merge16_desc(F, L2); sort16_desc(L3); merge16_desc(F, L3);
    LAS int* tab = (LAS int*)(C.lds + C.wave * 16384);
#pragma unroll
    for (int j = 0; j < 16; ++j) { tab[j * 64 + lane] = T0[j] & 127; tab[(16 + j) * 64 + lane] = T1[j] & 127; }
    LDS_WAIT(); asm volatile("" ::: "memory");
    const float m = key2f(F[0] & ~255);
    float e[16], sum = 0.f;
#pragma unroll
    for (int j = 0; j < 16; ++j) { e[j] = __builtin_amdgcn_exp2f((key2f(F[j] & ~255) - m) * 1.4426950408889634f); sum += e[j]; }
    const float inv = 1.0f / sum;
    const int tok = tokbase + r;
    int* IDX = (int*)(a.ws + WS_IDX) + (size_t)tok * 128 + hp * 16; float* WGT = (float*)(a.ws + WS_WGT) + (size_t)tok * 128 + hp * 16;
    unsigned ov[16];
#pragma unroll
    for (int j = 0; j < 16; ++j) { const int id = F[j] & 255; const int k0 = tab[(id >> 4) * 64 + lane], k1 = tab[(16 + (id & 15)) * 64 + lane];
        ov[j] = (hh == 0) ? (unsigned)(k0 * 128 + k1) : __builtin_bit_cast(unsigned, e[j] * inv); }
    unsigned* obase = (hh == 0) ? (unsigned*)IDX : (unsigned*)WGT;
#pragma unroll
    for (int q = 0; q < 4; ++q) { v4u w = {ov[4 * q], ov[4 * q + 1], ov[4 * q + 2], ov[4 * q + 3]}; *(v4u*)(obase + 4 * q) = w; }
    LDS_WAIT(); asm volatile("" ::: "memory");
}
typedef float f32x2v __attribute__((ext_vector_type(2)));
__device__ __forceinline__ void unpack16(const v4u a, const v4u b, float (&x)[16]) {
    const unsigned w[8] = {a.x, a.y, a.z, a.w, b.x, b.y, b.z, b.w};
#pragma unroll
    for (int i = 0; i < 8; ++i) { x[2 * i] = bflo(w[i]); x[2 * i + 1] = bfhi(w[i]); }
}
__device__ __forceinline__ void unpack16_fp8(const v4u a, float (&x)[16]) {
    const unsigned w[4] = {a.x, a.y, a.z, a.w};
#pragma unroll
    for (int i = 0; i < 4; ++i) { const f32x2v lo = __builtin_amdgcn_cvt_pk_f32_fp8((int)w[i], false), hi = __builtin_amdgcn_cvt_pk_f32_fp8((int)w[i], true);
        x[4 * i] = lo.x; x[4 * i + 1] = lo.y; x[4 * i + 2] = hi.x; x[4 * i + 3] = hi.y; }
}
__device__ __forceinline__ long mk64(unsigned lo, unsigned hi) { return (long)(((unsigned long long)hi << 32) | (unsigned long long)lo); }
__device__ __forceinline__ float dpp_swap1(float v) { return __builtin_bit_cast(float, __builtin_amdgcn_update_dpp(0, __builtin_bit_cast(int, v), 0xB1, 0xf, 0xf, true)); }
struct PHalf { v4u g[8]; };
struct PIdx { int e[8]; };
__device__ __forceinline__ void pg_idx8(const int* IDXr, int h, int hl, PIdx& I) {
    h = min(h, hl); const int* p = IDXr + (size_t)(h >> 1) * 128 + (h & 1) * 64;
#pragma unroll
    for (int j = 0; j < 8; ++j) I.e[j] = p[j * 8];
}
__device__ __forceinline__ void pg_issue(const unsigned char* TBL, const PIdx& I, int lane, PHalf& D) {
    const unsigned c16 = (unsigned)(lane & 7) * 16u;
#pragma unroll
    for (int j = 0; j < 8; ++j) D.g[j] = *(const v4u*)(TBL + ((unsigned)I.e[j] * 128u + c16));
}
__device__ __forceinline__ void pg_stage(LAS unsigned char* buf, int lane, const PHalf& D) {
    const int row8 = lane >> 3, c8 = lane & 7;
#pragma unroll
    for (int j = 0; j < 8; ++j) *(LAS v4u*)(buf + (j * 8 + row8) * 128 + ((c8 ^ row8) & 7) * 16) = D.g[j];
}
__device__ __forceinline__ void pu_xprep(LAS unsigned char* xs, unsigned xw, int lane) {
    const float x0 = bflo(xw) * 16.f, x1 = bfhi(xw) * 16.f;
    const int hi = __builtin_amdgcn_cvt_pk_fp8_f32(x0, x1, 0, false);
    const f32x2v bk = __builtin_amdgcn_cvt_pk_f32_fp8(hi, false);
    const int lo = __builtin_amdgcn_cvt_pk_fp8_f32(x0 - bk.x, x1 - bk.y, 0, false);
    *(LAS unsigned short*)(xs + 2 * lane) = (unsigned short)hi; *(LAS unsigned short*)(xs + 128 + 2 * lane) = (unsigned short)lo;
}
typedef int v8i_t __attribute__((ext_vector_type(8)));
__device__ __forceinline__ void pu_compute(const LAS unsigned char* buf, bf16* HPt, int r, int kq, const v8i_t bfr) {
    f32x4 res[4];
#pragma unroll
    for (int g = 0; g < 4; ++g) {
        const int row = g * 16 + r, sw = row & 7;
        const v4u a0 = *(const LAS v4u*)(buf + row * 128 + ((2 * kq) ^ sw) * 16), a1 = *(const LAS v4u*)(buf + row * 128 + ((2 * kq + 1) ^ sw) * 16);
        const v8i_t av = {(int)a0.x, (int)a0.y, (int)a0.z, (int)a0.w, (int)a1.x, (int)a1.y, (int)a1.z, (int)a1.w};
        res[g] = __builtin_amdgcn_mfma_scale_f32_16x16x128_f8f6f4(av, bfr, (f32x4){0.f, 0.f, 0.f, 0.f}, 0, 0, 0, 0x7f7f7f7f, 0, 0x7f7f7f7f);
    }
    f32x4 o = res[0];
#pragma unroll
    for (int g = 1; g < 4; ++g) { const bool sel = ((r >> 1) == g);
#pragma unroll
        for (int i = 0; i < 4; ++i) o[i] = sel ? res[g][i] : o[i]; }
#pragma unroll
    for (int i = 0; i < 4; ++i) o[i] += dpp_swap1(o[i]);
    if (r < 8 && (r & 1) == 0) { v2u w; w.x = pk2(o[0], o[1]); w.y = pk2(o[2], o[3]); *(v2u*)(HPt + (r >> 1) * 16 + 4 * kq) = w; }
}
__device__ __forceinline__ int pg_idx(const int* IDXl, int h, int hl) { h = min(h, hl); return IDXl[(size_t)(h >> 1) * 128 + (h & 1) * 64]; }
__device__ __forceinline__ void peer_u_wave(const Args& a, LAS unsigned char* wlds, LAS unsigned char* wsm, int slab, int t0, int ntok, int lane) {
    const unsigned char* U8 = a.ws + WS_PU + (size_t)slab * (16384 * 128);
    const bf16* N2 = (const bf16*)(a.ws + WS_N2) + slab * 128 + 2 * lane;
    const int* IDX = (const int*)(a.ws + WS_IDX) + (lane >> 3);
    bf16* HP = (bf16*)(a.ws + WS_HPART) + (size_t)slab * MTOK * 128;
    const int r = lane & 15, kq = lane >> 4, tl = t0 + ntok - 1, H0 = 2 * t0, HL = 2 * (t0 + ntok) - 1;
    PHalf d[4]; PIdx iv[4]; v8i_t bfr;
#pragma unroll
    for (int k = 0; k < 4; ++k) pg_idx8(IDX, H0 + k, HL, iv[k]);
    unsigned xw = *(const unsigned*)(N2 + (size_t)t0 * DM);
    pg_issue(U8, iv[0], lane, d[0]); pg_issue(U8, iv[1], lane, d[1]); pg_issue(U8, iv[2], lane, d[2]);
    pg_idx8(IDX, H0 + 4, HL, iv[0]); pg_idx8(IDX, H0 + 5, HL, iv[1]); pg_idx8(IDX, H0 + 6, HL, iv[2]);
    pg_stage(wlds, lane, d[0]);
#define PU_XPREP(tok) do { pu_xprep(wsm, xw, lane); \
        { const LAS unsigned char* bp = wsm + ((r & 1) ? 128 : 0) + kq * 32; const v4u b0 = *(const LAS v4u*)bp, b1 = *(const LAS v4u*)(bp + 16); \
          bfr = (v8i_t){(int)b0.x, (int)b0.y, (int)b0.z, (int)b0.w, (int)b1.x, (int)b1.y, (int)b1.z, (int)b1.w}; } \
        xw = *(const unsigned*)(N2 + (size_t)min((tok) + 1, tl) * DM); } while (0)
#define PU_PHASE(ph, hrel, tok, half) do { \
        pg_issue(U8, iv[((ph) + 3) & 3], lane, d[((ph) + 3) & 3]); pg_idx8(IDX, hb + (hrel) + 7, HL, iv[((ph) + 3) & 3]); \
        pu_compute(wlds + ((half) ? 8192 : 0), HP + (size_t)(tok) * 128 + (half) * 64, r, kq, bfr); \
        pg_stage(wlds + ((half) ? 0 : 8192), lane, d[((ph) + 1) & 3]); } while (0)
#pragma unroll 1
    for (int hb = H0; hb <= HL; hb += 4) {
        const int t = hb >> 1;
        PU_XPREP(t);
        PU_PHASE(0, 0, t, 0);
        PU_PHASE(1, 1, t, 1);
        PU_XPREP(t + 1);
        PU_PHASE(2, 2, t + 1, 0);
        PU_PHASE(3, 3, t + 1, 1);
    }
#undef PU_XPREP
#undef PU_PHASE
}
__device__ __forceinline__ void peer_reduce(const Ctx& C, const Args& a) {
    const bf16* HP = (const bf16*)(a.ws + WS_HPART); const int* IDX = (const int*)(a.ws + WS_IDX); const float* WGT = (const float*)(a.ws + WS_WGT);
    const float* USC = (const float*)(a.ws + WS_PSC); const float* VSC = USC + 16384;
    unsigned char* ACT8 = a.ws + WS_ACT; float* ASC = (float*)(a.ws + WS_ACT + 8 * MiB);
    for (int it = C.vcu * 512 + C.tid; it < MTOK * 32; it += C.G * 512) {
        f32x4 h = {0.f, 0.f, 0.f, 0.f};
#pragma unroll
        for (int sl = 0; sl < 8; ++sl) { const v2u w = *(const v2u*)(HP + (size_t)sl * MTOK * 128 + (size_t)it * 4); h[0] += bflo(w.x); h[1] += bfhi(w.x); h[2] += bflo(w.y); h[3] += bfhi(w.y); }
        const int4 e = *(const int4*)(IDX + (size_t)it * 4); const f32x4 w = *(const f32x4*)(WGT + (size_t)it * 4);
        const int tok = it >> 5, q = it & 31;
        const float rs = 0.0625f * __builtin_amdgcn_rsqf(((const float*)(a.ws + WS_SS))[tok] * (1.f / DM) + EPS);
        f32x4 o;
        o[0] = gelu_tanh(h[0] * USC[e.x] * rs) * w[0] * VSC[e.x]; o[1] = gelu_tanh(h[1] * USC[e.y] * rs) * w[1] * VSC[e.y];
        o[2] = gelu_tanh(h[2] * USC[e.z] * rs) * w[2] * VSC[e.z]; o[3] = gelu_tanh(h[3] * USC[e.w] * rs) * w[3] * VSC[e.w];
        float mx = fmaxf(fmaxf(fabsf(o[0]), fabsf(o[1])), fmaxf(fabsf(o[2]), fabsf(o[3])));
#pragma unroll
        for (int sh = 1; sh < 32; sh <<= 1) mx = fmaxf(mx, __shfl_xor(mx, sh));
        int ex = (int)((__builtin_bit_cast(unsigned, mx) >> 23) & 0xffu) - 127; if (mx < 1e-30f) ex = 7;
        const float sc = __builtin_bit_cast(float, (unsigned)(127 + 7 - ex) << 23), isc = __builtin_bit_cast(float, (unsigned)(127 - 7 + ex) << 23);
        o = o * sc;
        int hi = __builtin_amdgcn_cvt_pk_fp8_f32(o[0], o[1], 0, false); hi = __builtin_amdgcn_cvt_pk_fp8_f32(o[2], o[3], hi, true);
        const f32x2v b0 = __builtin_amdgcn_cvt_pk_f32_fp8(hi, false), b1 = __builtin_amdgcn_cvt_pk_f32_fp8(hi, true);
        int lo = __builtin_amdgcn_cvt_pk_fp8_f32(o[0] - b0.x, o[1] - b0.y, 0, false); lo = __builtin_amdgcn_cvt_pk_fp8_f32(o[2] - b1.x, o[3] - b1.y, lo, true);
        *(unsigned*)(ACT8 + (size_t)tok * 256 + 4 * q) = (unsigned)hi; *(unsigned*)(ACT8 + (size_t)tok * 256 + 128 + 4 * q) = (unsigned)lo;
        if (q == 0) ASC[tok] = isc;
    }
}
typedef int v2i_t __attribute__((ext_vector_type(2)));
__device__ __forceinline__ void pv_compute(const LAS unsigned char* buf, int lane, const long* bact2, f32x4 (&acc)[8]) {
    const int i16 = lane & 15, kq = lane >> 4, rr = i16 >> 1, cc = i16 & 1;
#pragma unroll
    for (int s2 = 0; s2 < 2; ++s2) {
        const int row = 32 * s2 + 8 * kq + rr, sw = row & 7;
#pragma unroll
        for (int nb = 0; nb < 8; ++nb) {
            const v2i_t av = __builtin_amdgcn_ds_read_tr8_b64_v2i32((LAS v2i_t*)(buf + row * 128 + ((nb ^ sw) & 7) * 16 + 8 * cc));
            acc[nb] = __builtin_amdgcn_mfma_f32_16x16x32_fp8_fp8(mk64((unsigned)av.x, (unsigned)av.y), bact2[s2], acc[nb], 0, 0, 0);
        }
    }
}
__device__ __forceinline__ void peer_v_wave(const Args& a, LAS unsigned char* wlds, int slab, int t0, int ntok, int lane) {
    const unsigned char* V8 = a.ws + WS_PV + (size_t)slab * (16384 * 128);
    const int* IDX = (const int*)(a.ws + WS_IDX) + (lane >> 3);
    const int n16 = lane & 15, kq = lane >> 4, tl = t0 + ntok - 1, H0 = 2 * t0, HL = 2 * (t0 + ntok) - 1;
    const unsigned char* ACT8 = a.ws + WS_ACT + ((n16 & 1) ? 128 : 0) + 8 * kq; const float* ASC = (const float*)(a.ws + WS_ACT + 8 * MiB);
    bf16* PO = (bf16*)(a.ws + WS_POUT) + slab * 128;
    PHalf d[4]; PIdx iv[4]; long bact[4], bnxt[4]; f32x4 acc[8]; float isc = 1.f, iscn;
#pragma unroll
    for (int k = 0; k < 4; ++k) pg_idx8(IDX, H0 + k, HL, iv[k]);
#pragma unroll
    for (int s4 = 0; s4 < 4; ++s4) bnxt[s4] = *(const long*)(ACT8 + (size_t)t0 * 256 + 32 * s4);
    iscn = ASC[t0];
    pg_issue(V8, iv[0], lane, d[0]); pg_issue(V8, iv[1], lane, d[1]); pg_issue(V8, iv[2], lane, d[2]);
    pg_idx8(IDX, H0 + 4, HL, iv[0]); pg_idx8(IDX, H0 + 5, HL, iv[1]); pg_idx8(IDX, H0 + 6, HL, iv[2]);
    pg_stage(wlds, lane, d[0]);
#define PV_APREP(tok) do { \
        _Pragma("unroll") for (int s4 = 0; s4 < 4; ++s4) bact[s4] = bnxt[s4]; isc = iscn; \
        { const int tn = min((tok) + 1, tl); \
          _Pragma("unroll") for (int s4 = 0; s4 < 4; ++s4) bnxt[s4] = *(const long*)(ACT8 + (size_t)tn * 256 + 32 * s4); iscn = ASC[tn]; } \
        _Pragma("unroll") for (int nb = 0; nb < 8; ++nb) acc[nb] = (f32x4){0.f, 0.f, 0.f, 0.f}; } while (0)
#define PV_PHASE(ph, hrel, half) do { \
        pg_issue(V8, iv[((ph) + 3) & 3], lane, d[((ph) + 3) & 3]); pg_idx8(IDX, hb + (hrel) + 7, HL, iv[((ph) + 3) & 3]); \
        pv_compute(wlds + ((half) ? 8192 : 0), lane, bact + 2 * (half), acc); \
        pg_stage(wlds + ((half) ? 0 : 8192), lane, d[((ph) + 1) & 3]); } while (0)
#define PV_EPI(tok) do { f32x4 o = acc[0]; \
        _Pragma("unroll") for (int nb = 1; nb < 8; ++nb) { const bool sel = ((n16 >> 1) == nb); \
            _Pragma("unroll") for (int i = 0; i < 4; ++i) o[i] = sel ? acc[nb][i] : o[i]; } \
        _Pragma("unroll") for (int i = 0; i < 4; ++i) o[i] += dpp_swap1(o[i]); \
        if ((n16 & 1) == 0) { v2u w; w.x = pk2(o[0] * isc, o[1] * isc); w.y = pk2(o[2] * isc, o[3] * isc); *(v2u*)(PO + (size_t)(tok) * DM + 16 * (n16 >> 1) + 4 * kq) = w; } } while (0)
#pragma unroll 1
    for (int hb = H0; hb <= HL; hb += 4) {
        const int t = hb >> 1;
        PV_APREP(t);
        PV_PHASE(0, 0, 0);
        PV_PHASE(1, 1, 1);
        PV_EPI(t);
        PV_APREP(t + 1);
        PV_PHASE(2, 2, 0);
        PV_PHASE(3, 3, 1);
        PV_EPI(t + 1);
    }
#undef PV_APREP
#undef PV_PHASE
#undef PV_EPI
}
__device__ __forceinline__ void final_rows4(const Args& a, int tok0, int tstep, int lane) {
    const float* gf = (const float*)a.in[25] + lane * 4;
    f32x4 h[4][4]; v2u pw[4][4], hw[4][4]; float ss[4];
#pragma unroll
    for (int i = 0; i < 4; ++i) { const int tok = tok0 + i * tstep; const bf16* hb = (const bf16*)(a.ws + WS_N2) + (size_t)tok * DM + lane * 4; const bf16* po = (const bf16*)(a.ws + WS_POUT) + (size_t)tok * DM + lane * 4;
#pragma unroll
        for (int q = 0; q < 4; ++q) { hw[i][q] = *(const v2u*)(hb + 256 * q); pw[i][q] = *(const v2u*)(po + 256 * q); } }
#pragma unroll
    for (int i = 0; i < 4; ++i) { ss[i] = 0.f;
#pragma unroll
        for (int q = 0; q < 4; ++q) { h[i][q][0] = bflo(hw[i][q].x) + bflo(pw[i][q].x); h[i][q][1] = bfhi(hw[i][q].x) + bfhi(pw[i][q].x); h[i][q][2] = bflo(hw[i][q].y) + bflo(pw[i][q].y); h[i][q][3] = bfhi(hw[i][q].y) + bfhi(pw[i][q].y);
            ss[i] += (h[i][q][0] * h[i][q][0] + h[i][q][1] * h[i][q][1]) + (h[i][q][2] * h[i][q][2] + h[i][q][3] * h[i][q][3]); } }
#pragma unroll
    for (int o = 1; o < 64; o <<= 1)
#pragma unroll
        for (int i = 0; i < 4; ++i) ss[i] += __shfl_xor(ss[i], o);
    f32x4 g[4];
#pragma unroll
    for (int q = 0; q < 4; ++q) g[q] = *(const f32x4*)(gf + 256 * q);
#pragma unroll
    for (int i = 0; i < 4; ++i) { const float rstd = 1.0f / sqrtf(ss[i] * (1.f / DM) + EPS); float* orow = a.out + (size_t)(tok0 + i * tstep) * DM + lane * 4;
#pragma unroll
        for (int q = 0; q < 4; ++q) *(f32x4*)(orow + 256 * q) = h[i][q] * rstd * g[q]; }
}

__device__ __forceinline__ void claim_slab_unit(const Ctx& C, unsigned* ctl, int pass, volatile LAS unsigned* MISC, int& slab, int& unit) {
    if (C.tid == 0) {
        const unsigned x = xb_xcc_id() & 7u; unsigned sl = 8u, un = 0u;
        for (unsigned k = 0; k < 8u; ++k) { const unsigned s2 = (x + k) & 7u; const unsigned u2 = xb_add(ctl + CW_Q + 1024 * pass + 64 * s2, 1u); if (u2 < 32u) { sl = s2; un = u2; break; } }
        MISC[16] = sl; MISC[17] = un;
    }
    __syncthreads();
    slab = (int)MISC[16]; unit = (int)MISC[17];
    __syncthreads();
}
__global__ void __launch_bounds__(NWAVES * 64, 2) mk_fwd(Args args) {
    extern __shared__ __attribute__((aligned(16))) unsigned char lds_raw[];
    Ctx C;
    C.lds = (LAS unsigned char*)lds_raw;
    C.wave = __builtin_amdgcn_readfirstlane((int)threadIdx.x >> 6); C.refresh();
    C.G = gridDim.x; { const int bx = blockIdx.x; C.vcu = (C.G % 8 == 0) ? (bx % 8) * (C.G / 8) + bx / 8 : bx; }
    volatile LAS unsigned* MISC = (volatile LAS unsigned*)(C.lds + MISC_OFF);
    if (C.tid < 128) MISC[C.tid] = 0u;
    __syncthreads();
    unsigned char* ws = args.ws;
    unsigned* ctl = (unsigned*)(ws + WS_CTL);
    XcdBarrier bar; bar.bar = ctl + CW_BAR; bar.x = 0; bar.st = nullptr;
#if !MK_PER_PHASE
    bar = xcd_barrier_post(ctl + CW_BAR, MISC + 8, C.tid == 0);
#define GRID_BAR() xcd_barrier(bar, C.wave)
#else
#define GRID_BAR() do { } while (0)
#endif
    const int lo = args.ph_lo, hi = args.ph_hi;
#define IN(k) (lo <= (k) && (k) < hi)
#define SEAM(k) do { if (IN((k) + 1)) GRID_BAR(); C.refresh(); } while (0)
#define REP(k) for (int rep_ = 0; rep_ < 1 + ((REPEAT_MASK >> (k)) & 1); ++rep_)
    bf16* XN = (bf16*)(ws + WS_A);
    if (IN(0)) { REP(0) { p0_prologue(C, args); __syncthreads(); } SEAM(0); }
    if (IN(1)) {
        REP(1) {
        run_gemm(C, XN, (const bf16*)(ws + WS_WIN_T), MTOK, NZ1, DM, FStore{(bf16*)(ws + WS_Z1), NZ1});
        }
        SEAM(1);
    }
    if (IN(2)) {
        REP(2) { const int tile = C.vcu;
            {
                const int i_ = C.tid >> 2, dq_ = (C.tid & 3) * 16, eq_ = (C.tid & 3) * 32;
                const bf16* zr_ = (const bf16*)(ws + WS_Z1) + (size_t)(tile * 128 + i_) * NZ1; const float* rp_ = (const float*)(ws + WS_ROPE) + (size_t)(tile * 128 + i_) * 128;
                float cs_[16], sn_[16];
#pragma unroll
                for (int q = 0; q < 4; ++q) { const f32x4 c4 = *(const f32x4*)(rp_ + dq_ + 4 * q), s4 = *(const f32x4*)(rp_ + 64 + dq_ + 4 * q);
#pragma unroll
                    for (int e = 0; e < 4; ++e) { cs_[4 * q + e] = c4[e]; sn_[4 * q + e] = s4[e]; } }
                R1In ra_, rb_;
                r1_load(zr_, 0, dq_, eq_, ra_);
                _Pragma("unroll 1") for (int h2 = 0; h2 < 4; h2 += 2) {
                    r1_unit(C, args, tile, h2, cs_, sn_, ra_, rb_, true);
                    r1_unit(C, args, tile, h2 + 1, cs_, sn_, rb_, ra_, h2 == 0);
                }
            }
            C.refresh();
            _Pragma("unroll 1") for (int gi = 0; gi < 2; ++gi) s5a_wave(C, args, tile, C.wave + 8 * gi);
            __syncthreads();
        }
        SEAM(2);
    }
    if (IN(3)) { REP(3) { p3_scans(C, args); }
        run_gemm(C, (const bf16*)(ws + WS_MEMN), (const bf16*)(ws + WS_WMKV_T), MROWS, 512, DM, FKvm{(bf16*)(ws + WS_KM), (bf16*)(ws + WS_VT)});
        SEAM(3); }
    if (IN(4)) {
        REP(4) { const int tile = C.vcu;
            _Pragma("unroll 1") for (int gi = 0; gi < 2; ++gi) r3_wave(C, args, tile, 2 * gi + (C.wave >> 2), C.wave & 3);
            _Pragma("unroll 1") for (int gi = 0; gi < 2; ++gi) s5c_wave(C, args, tile, C.wave + 8 * gi);
            _Pragma("unroll 1") for (int gi = 0; gi < 2; ++gi) ma_wave(C, args, tile, 2 * gi + (C.wave >> 2), C.wave & 3);
        }
        SEAM(4);
    }
    if (IN(5)) {
        REP(5) {
        run_gemm_mx(C, ws + WS_XN8, ws + WS_WG8, MTOK, NGATE, DM, FSig{(bf16*)(ws + WS_G), NGATE}, 0x7b7b7b7b  , 0x77777777  );
        run_gemm(C, (const bf16*)(ws + WS_YG), (const bf16*)(ws + WS_WGLU_T), MTOK, 512, 256, FGlu{(bf16*)(ws + WS_YCAT)});
        }
        SEAM(5);
    }
    if (IN(6)) {
        const bf16* Gt = (const bf16*)(ws + WS_G);
        run_gemm_hook(C, (const bf16*)(ws + WS_YCAT), (const bf16*)(ws + WS_WCAT_T), MTOK, DM, DM, FGateOut{Gt, XN}, HookGate{Gt});
        SEAM(6);
    }
    if (IN(7)) { run_gemm(C, XN, (const bf16*)(ws + WS_WOUT_T), MTOK, DM, DM, FRes{(const float*)args.in[0], (bf16*)(ws + WS_N2), (float*)(ws + WS_SS)}); SEAM(7); }
    if (IN(9)) { REP(9) run_gemm(C, (const bf16*)(ws + WS_N2), (const bf16*)(ws + WS_WQ_T), MTOK, 2048, DM, FStoreRstd{(bf16*)(ws + WS_Q2), 2048, (const float*)(ws + WS_SS)}); SEAM(9); }
    if (IN(10)) {
        { const int tile = C.vcu;
            const int tokbase = tile * 128 + (C.wave & 3) * 32, h0 = (C.wave >> 2) * 4;
            REP(10) { _Pragma("unroll 1") for (int hp = h0; hp < h0 + 4; ++hp) peer_topk_head(C, args, tokbase, hp); }
        }
        SEAM(10);
    }
    if (IN(11)) { int slab, unit; claim_slab_unit(C, ctl, 0, MISC, slab, unit); if (slab < 8) { REP(11) peer_u_wave(args, C.lds + C.wave * 16384, C.lds + 131072 + C.wave * 1024, slab, unit * 1024 + C.wave * 128, 128, C.lane); } SEAM(11); }
    if (IN(12)) { REP(12) peer_reduce(C, args); SEAM(12); }
    if (IN(13)) { int slab, unit; claim_slab_unit(C, ctl, 1, MISC, slab, unit); if (slab < 8) { REP(13) peer_v_wave(args, C.lds + C.wave * 16384, slab, unit * 1024 + C.wave * 128, 128, C.lane); } SEAM(13); }
    if (IN(14)) {
        const int gw = C.vcu * NWAVES + C.wave, NGW = C.G * NWAVES;
        for (int m = gw; m < MTOK; m += 4 * NGW) final_rows4(args, m, NGW, C.lane);
    }
#undef IN
#undef SEAM
}

extern "C" void kernel_launch(void* const* d_in, const int* in_sizes, int n_in, void* d_out, int out_size, void* d_ws, size_t ws_size, hipStream_t stream) {
    static int grid = 0;
    if (grid == 0) {
        if (n_in != 26 || in_sizes[0] != MTOK * DM || out_size != MTOK * DM || ws_size < WS_END) {
            fprintf(stderr, "kernel_launch: unexpected problem (n_in %d, in0 %d, out %d, ws %zu < %zu); nothing launched\n", n_in, n_in > 0 ? in_sizes[0] : -1, out_size, ws_size, (size_t)WS_END); grid = -1; return; }
        int dev = 0, cus = 0;
        if (hipGetDevice(&dev) != hipSuccess || hipDeviceGetAttribute(&cus, hipDeviceAttributeMultiprocessorCount, dev) != hipSuccess) { grid = -1; return; }
        if (hipFuncSetAttribute((const void*)mk_fwd, hipFuncAttributeMaxDynamicSharedMemorySize, LDS_BYTES) != hipSuccess) { fprintf(stderr, "kernel_launch: hipFuncSetAttribute failed\n"); grid = -1; return; }
        (void)hipGetLastError();
        if (cus < NTILES) { fprintf(stderr, "kernel_launch: needs >= 256 CUs, got %d\n", cus); grid = -1; return; }
        grid = NTILES;
    }
    if (grid < 0) return;
    (void)hipMemsetAsync((char*)d_ws + WS_CTL, 0, CTL_ZERO_BYTES, stream);
    Args a{};
    for (int i = 0; i < 26; ++i) a.in[i] = d_in[i];
    a.out = (float*)d_out; a.ws = (unsigned char*)d_ws;
#if MK_PER_PHASE
    for (int p = 0; p < NPHASE; ++p) { a.ph_lo = p; a.ph_hi = p + 1; hipLaunchKernelGGL(mk_fwd, dim3(grid), dim3(NWAVES * 64), LDS_BYTES, stream, a); }
#else
    a.ph_lo = 0; a.ph_hi = NPHASE;
    hipLaunchKernelGGL(mk_fwd, dim3(grid), dim3(NWAVES * 64), LDS_BYTES, stream, a);
#endif
}
```

```cpp
#include <hip/hip_runtime.h>
#include <cstdio>
#include <cstdint>
namespace pg8 {
__device__ __forceinline__ int hw_lane_id() { int l; asm volatile("v_mbcnt_lo_u32_b32 %0, -1, 0\n\tv_mbcnt_hi_u32_b32 %0, -1, %0" : "=v"(l)); return l; }
#define PG8_LAS __attribute__((address_space(3)))
typedef unsigned short bf16_t;
typedef short bf16x8 __attribute__((ext_vector_type(8)));
typedef float f32x4 __attribute__((ext_vector_type(4)));
typedef unsigned u32x4 __attribute__((ext_vector_type(4)));
constexpr int BM = 256, BK = 64, HALF = 128, HTB = HALF * BK * 2  , STAGE_BYTES = 8 * HTB, NXCD = 8, WGM = 8;

__host__ __device__ __forceinline__ int lds_byte(int r, int c) { const int st = (r >> 4) * 2 + (c >> 5), rr = r & 15, cc = c & 31, ob = rr * 64 + cc * 2; return st * 1024 + (ob ^ (((ob >> 9) & 1) << 5)); }
__host__ __device__ __forceinline__ void stage_rc(int b, int& R, int& C) { const int st = b / 1024, sb = b % 1024, swz = sb ^ (((sb >> 9) & 1) << 5); R = (st >> 1) * 16 + swz / 64; C = (st & 1) * 32 + (swz % 64) / 2; }
__host__ __device__ __forceinline__ int perm32(int rho) { const int n = rho >> 4, i = rho & 15; return 8 * (i >> 2) + 4 * n + (i & 3); }

struct Unit { int pm, pn; };
struct Gemm { const bf16_t* A; const bf16_t* Bt; int M, N, K; };

struct StaticOrder {
    int nM, nN, nwg, G, c;
    __host__ __device__ void init(int M, int N, int G_, int c_) { nM = M / BM; nN = N / BM; nwg = nM * nN; G = G_; c = c_; }
    __host__ __device__ bool next(int i, Unit& u) const {
        const long L = (long)i * G + c; if (L >= nwg) return false;
        int wgid = (int)L; { const int q = nwg / NXCD, r = nwg % NXCD, xcd = wgid % NXCD, off = wgid / NXCD; wgid = (xcd < r ? xcd * (q + 1) : r * (q + 1) + (xcd - r) * q) + off; }
        const int nig = WGM * nN, gid = wgid / nig, fm = gid * WGM, gsz = (nM - fm) < WGM ? (nM - fm) : WGM;
        u.pm = fm + ((wgid % nig) % gsz); u.pn = (wgid % nig) / gsz; return true;
    }
    __device__ __forceinline__ void a_ready(const Unit&) const {}
    __device__ __forceinline__ void done(const Unit&) const {}
};

__device__ __forceinline__ unsigned cvt_pk_bf16(float lo, float hi) { unsigned r; asm volatile("v_cvt_pk_bf16_f32 %0, %1, %2" : "=v"(r) : "v"(lo), "v"(hi)); return r; }
struct NoKHook { __device__ __forceinline__ void operator()(int, f32x4 (&)[2][2][4][2], const Unit&, int, int, int, int) const {} };
template <class Epi, class Sched, bool ALIGN_EPI = false, bool SP2 = false, bool MX = false, class KHook = NoKHook>
__device__ __forceinline__ void gemm_phase(PG8_LAS unsigned char* lds, const Gemm g, const Sched& S, const Epi& E, const int wid, const int sclA = 0x7f7f7f7f, const int sclB = 0x7f7f7f7f, const KHook& KH = KHook()) {
    const int lane = hw_lane_id(), tid = wid * 64 + lane, wr = wid >> 2, wc = wid & 3, fr = lane & 15, fq = lane >> 4;
    const int K = g.K, nt = K / BK;
    unsigned voffA[2], voffB[2];
#pragma unroll
    for (int i = 0; i < 2; ++i) { int R, C; stage_rc(tid * 16 + i * 8192, R, C); const int Rb = Epi::PERM ? ((R & ~31) + perm32(R & 31)) : R;
        voffA[i] = (unsigned)(R * K + C) * 2u; voffB[i] = (unsigned)(Rb * K + C) * 2u; }
    const size_t kstep = (size_t)(BK * 2);
    const size_t hstep = (size_t)HALF * K * 2;
    const size_t tstep = 2 * hstep;
    const unsigned ldsw = (unsigned)wid * 1024u;
    const int aoff = lds_byte(wr * 64 + fr, fq * 8), boff = lds_byte(wc * 32 + fr, fq * 8);
#define PG8_SA(b, h) (((b) * 2 + (h)) * HTB)
#define PG8_SB(b, h) ((4 + (b) * 2 + (h)) * HTB)
#define PG8_STAGE(bufoff, gbase, voff) do { _Pragma("unroll") for (int _i = 0; _i < 2; ++_i) \
        __builtin_amdgcn_global_load_lds((const unsigned*)((const char*)(gbase) + (voff)[_i]), (PG8_LAS unsigned*)(lds + (bufoff) + ldsw + _i * 8192), 16, 0, 0); } while (0)
#define PG8_LDA(dst, b, h) do { _Pragma("unroll") for (int m = 0; m < 4; ++m) { \
        if constexpr (MX) { dst##8[m].lo = *(const PG8_LAS v4i_*)(lds + PG8_SA(b, h) + aoff + m * 2048); dst##8[m].hi = *(const PG8_LAS v4i_*)(lds + PG8_SA(b, h) + aoff + m * 2048 + 1024); } \
        else { _Pragma("unroll") for (int k = 0; k < 2; ++k) dst[m][k] = *(const PG8_LAS bf16x8*)(lds + PG8_SA(b, h) + aoff + m * 2048 + k * 1024); } } } while (0)
#define PG8_LDB(dst, b, h) do { _Pragma("unroll") for (int n = 0; n < 2; ++n) { \
        if constexpr (MX) { dst##8[n].lo = *(const PG8_LAS v4i_*)(lds + PG8_SB(b, h) + boff + n * 2048); dst##8[n].hi = *(const PG8_LAS v4i_*)(lds + PG8_SB(b, h) + boff + n * 2048 + 1024); } \
        else { _Pragma("unroll") for (int k = 0; k < 2; ++k) dst[n][k] = *(const PG8_LAS bf16x8*)(lds + PG8_SB(b, h) + boff + n * 2048 + k * 1024); } } } while (0)
#define PG8_MMA(ai, bj, At, Bt) do { __builtin_amdgcn_s_setprio(1); _Pragma("unroll") for (int m = 0; m < 4; ++m) _Pragma("unroll") for (int n = 0; n < 2; ++n) { \
        if constexpr (MX) acc[ai][bj][m][n] = __builtin_amdgcn_mfma_scale_f32_16x16x128_f8f6f4(Bt##8[n], At##8[m], acc[ai][bj][m][n], 0, 0, 0, sclB, 0, sclA); \
        else { _Pragma("unroll") for (int k = 0; k < 2; ++k) acc[ai][bj][m][n] = __builtin_amdgcn_mfma_f32_16x16x32_bf16(Bt[n][k], At[m][k], acc[ai][bj][m][n], 0, 0, 0); } } \
        if constexpr (MX) { _Pragma("unroll") for (int m = 0; m < 4; ++m) _Pragma("unroll") for (int n = 0; n < 2; ++n) asm volatile("" : "+v"(acc[ai][bj][m][n])); }     \
        __builtin_amdgcn_s_setprio(0); } while (0)
#define PG8_WAIT_V(n) asm volatile("s_waitcnt vmcnt(" #n ")" ::: "memory")
#define PG8_WAIT_L(n) asm volatile("s_waitcnt lgkmcnt(" #n ")" ::: "memory")
#define PG8_BAR __builtin_amdgcn_s_barrier()
#define PG8_SCHED __builtin_amdgcn_sched_barrier(0)
    Unit cur, nxt; int ui = 0;
    if (!S.next(0, cur)) return;
    f32x4 acc[2][2][4][2];
#pragma unroll
    for (int a = 0; a < 2; ++a)
#pragma unroll
        for (int b = 0; b < 2; ++b)
#pragma unroll
            for (int m = 0; m < 4; ++m)
#pragma unroll
                for (int n = 0; n < 2; ++n) acc[a][b][m][n] = (f32x4){0.f, 0.f, 0.f, 0.f};
    typedef int v8i_ __attribute__((ext_vector_type(8))); typedef int v4i_ __attribute__((ext_vector_type(4)));
    bf16x8 At[4][2], B0[2][2], B1[2][2]; v8i_ At8[4], B08[2], B18[2];
    const char* cA = (const char*)g.A + (size_t)cur.pm * tstep; const char* cB = (const char*)g.Bt + (size_t)cur.pn * tstep;
    S.a_ready(cur);
    if constexpr (SP2) {
        PG8_STAGE(PG8_SB(0, 0), cB, voffB); PG8_STAGE(PG8_SB(0, 1), cB + hstep, voffB); PG8_STAGE(PG8_SA(0, 0), cA, voffA); PG8_STAGE(PG8_SA(0, 1), cA + hstep, voffA);
        if (wr == 1) PG8_BAR;
        PG8_WAIT_V(2); PG8_BAR;
        PG8_STAGE(PG8_SB(1, 0), cB + kstep, voffB); PG8_STAGE(PG8_SA(1, 0), cA + kstep, voffA); PG8_STAGE(PG8_SB(1, 1), cB + hstep + kstep, voffB);
        PG8_WAIT_V(6); PG8_BAR;
    } else {
        PG8_STAGE(PG8_SB(0, 0), cB, voffB); PG8_STAGE(PG8_SA(0, 0), cA, voffA); PG8_STAGE(PG8_SB(0, 1), cB + hstep, voffB); PG8_STAGE(PG8_SA(0, 1), cA + hstep, voffA);
        if (wr == 1) PG8_BAR;
        PG8_WAIT_V(4); PG8_BAR;
        PG8_STAGE(PG8_SB(1, 0), cB + kstep, voffB); PG8_STAGE(PG8_SA(1, 0), cA + kstep, voffA); PG8_STAGE(PG8_SB(1, 1), cB + hstep + kstep, voffB);
        PG8_WAIT_V(6); PG8_BAR;
    }
    for (;;) {
        const bool has_next = S.next(ui + 1, nxt);
        const char* nA = has_next ? (const char*)g.A + (size_t)nxt.pm * tstep : cA; const char* nB = has_next ? (const char*)g.Bt + (size_t)nxt.pn * tstep : cB;
        for (int t = 0; t < nt; t += 2) {
            KH(t, acc, cur, wr, wc, fr, fq);
            const bool last = (t == nt - 2);
            const char* a1 = cA + (size_t)(t + 1) * kstep;
            const char* a2 = last ? nA : cA + (size_t)(t + 2) * kstep; const char* b2 = last ? nB : cB + (size_t)(t + 2) * kstep;
            const char* a3 = a2 + kstep; const char* b3 = b2 + kstep;
            if (last && has_next) S.a_ready(nxt);
            if constexpr (SP2) {
            PG8_LDB(B0, 0, 0); PG8_LDB(B1, 0, 1); PG8_SCHED; PG8_LDA(At, 0, 0); PG8_STAGE(PG8_SA(1, 1), a1 + hstep, voffA);
            PG8_WAIT_V(8); PG8_WAIT_L(0); PG8_BAR; PG8_MMA(0, 0, At, B0); PG8_MMA(0, 1, At, B1); PG8_BAR; PG8_SCHED;
            PG8_LDA(At, 0, 1); PG8_STAGE(PG8_SB(0, 0), b2, voffB); PG8_STAGE(PG8_SB(0, 1), b2 + hstep, voffB); PG8_STAGE(PG8_SA(0, 0), a2, voffA);
            PG8_WAIT_V(8); PG8_WAIT_L(0); PG8_BAR; PG8_MMA(1, 0, At, B0); PG8_MMA(1, 1, At, B1); PG8_BAR; PG8_SCHED;
            PG8_LDB(B0, 1, 0); PG8_LDB(B1, 1, 1); PG8_SCHED; PG8_LDA(At, 1, 0); PG8_STAGE(PG8_SA(0, 1), a2 + hstep, voffA);
            PG8_WAIT_V(8); PG8_WAIT_L(0); PG8_BAR; PG8_MMA(0, 0, At, B0); PG8_MMA(0, 1, At, B1); PG8_BAR; PG8_SCHED;
            PG8_LDA(At, 1, 1); PG8_STAGE(PG8_SB(1, 0), b3, voffB); PG8_STAGE(PG8_SB(1, 1), b3 + hstep, voffB); PG8_STAGE(PG8_SA(1, 0), a3, voffA);
            PG8_WAIT_V(8); PG8_WAIT_L(0); PG8_BAR; PG8_MMA(1, 0, At, B0); PG8_MMA(1, 1, At, B1); PG8_BAR; PG8_SCHED;
            } else {
            PG8_LDB(B0, 0, 0); PG8_SCHED; PG8_LDA(At, 0, 0); PG8_STAGE(PG8_SA(1, 1), a1 + hstep, voffA);
            PG8_WAIT_L(8); PG8_BAR; PG8_WAIT_L(0); PG8_MMA(0, 0, At, B0); PG8_BAR; PG8_SCHED;
            PG8_LDB(B1, 0, 1); PG8_STAGE(PG8_SB(0, 0), b2, voffB);
            PG8_BAR; PG8_WAIT_L(0); PG8_MMA(0, 1, At, B1); PG8_BAR;
            PG8_LDA(At, 0, 1); PG8_STAGE(PG8_SA(0, 0), a2, voffA);
            PG8_BAR; PG8_WAIT_L(0); PG8_MMA(1, 0, At, B0); PG8_BAR; PG8_SCHED;
            PG8_STAGE(PG8_SB(0, 1), b2 + hstep, voffB);
            PG8_WAIT_V(6); PG8_BAR; PG8_MMA(1, 1, At, B1); PG8_BAR;
            PG8_LDB(B0, 1, 0); PG8_SCHED; PG8_LDA(At, 1, 0); PG8_STAGE(PG8_SA(0, 1), a2 + hstep, voffA);
            PG8_WAIT_L(8); PG8_BAR; PG8_WAIT_L(0); PG8_MMA(0, 0, At, B0); PG8_BAR; PG8_SCHED;
            PG8_LDB(B1, 1, 1); PG8_STAGE(PG8_SB(1, 0), b3, voffB);
            PG8_BAR; PG8_WAIT_L(0); PG8_MMA(0, 1, At, B1); PG8_BAR;
            PG8_LDA(At, 1, 1); PG8_STAGE(PG8_SA(1, 0), a3, voffA);
            PG8_BAR; PG8_WAIT_L(0); PG8_MMA(1, 0, At, B0); PG8_BAR; PG8_SCHED;
            PG8_STAGE(PG8_SB(1, 1), b3 + hstep, voffB);
            PG8_WAIT_V(6); PG8_BAR; PG8_MMA(1, 1, At, B1); PG8_BAR;
            }
        }
        if constexpr (ALIGN_EPI) { if (wr == 0) PG8_BAR; }
        if constexpr (!Epi::AFTER_DRAIN) { E(acc, cur, wr, wc, fr, fq); S.done(cur); }
        if (!has_next) break;
#pragma unroll
        for (int a = 0; a < 2; ++a)
#pragma unroll
            for (int b = 0; b < 2; ++b)
#pragma unroll
                for (int m = 0; m < 4; ++m)
#pragma unroll
                    for (int n = 0; n < 2; ++n) acc[a][b][m][n] = (f32x4){0.f, 0.f, 0.f, 0.f};
        cur = nxt; cA = nA; cB = nB; ++ui;
        if constexpr (ALIGN_EPI) { if (wr == 1) PG8_BAR; }
    }
    PG8_WAIT_V(0);
    if constexpr (!ALIGN_EPI) { if (wr == 0) PG8_BAR; }
    PG8_BAR;
    if constexpr (Epi::AFTER_DRAIN) { E.fused(acc, cur, wr, wc, fr, fq, lds, wid, lane); S.done(cur); }
#undef PG8_SA
#undef PG8_SB
#undef PG8_STAGE
#undef PG8_LDA
#undef PG8_LDB
#undef PG8_MMA
#undef PG8_WAIT_V
#undef PG8_WAIT_L
#undef PG8_BAR
#undef PG8_SCHED
}
}

#ifndef REPEAT_MASK
#define REPEAT_MASK 0
#endif
#ifndef MK_PER_PHASE
#define MK_PER_PHASE 0
#endif

constexpr int DM = 1024, BATCH = 8, SEQ = 4096, MTOK = BATCH * SEQ;
constexpr int MEMLEN = 256, MROWS = BATCH * MEMLEN;
constexpr int NZ1 = 2560, NGATE = 3072;
constexpr int ZQ = 0, ZK = 512, ZV = 1024, ZGR = 1536, ZU = 2048, ZQM = 2304;
constexpr int NTILES = MTOK / 128;
constexpr float EPS = 1e-6f;
constexpr int NPHASE = 15;

constexpr size_t MiB = 1u << 20;
constexpr size_t WS_CTL = 0, CTL_ZERO_BYTES = 1 * MiB;
constexpr size_t WS_WIN_T = 1 * MiB;
constexpr size_t WS_WQ_T = 12 * MiB;
constexpr size_t WS_WOUT_T = 16 * MiB;
constexpr size_t WS_WCAT_T = 18 * MiB;
constexpr size_t WS_WGLU_T = 20 * MiB;
constexpr size_t WS_WMKV_T = 21 * MiB;
constexpr size_t WS_KEYS = 22 * MiB;
constexpr size_t WS_S5MAT = 23 * MiB;
constexpr size_t WS_S5C = 25 * MiB;
constexpr size_t WS_PSC = 25 * MiB + 256 * 1024;
constexpr size_t WS_SS = 25 * MiB + 512 * 1024;
constexpr size_t WS_ROPE = 26 * MiB;
constexpr size_t WS_PU = 42 * MiB;
constexpr size_t WS_PV = 58 * MiB;
constexpr size_t WS_XN8 = 74 * MiB;
constexpr size_t WS_WG8 = WS_WIN_T + 5 * MiB;
constexpr size_t WS_MEMN = 106 * MiB;
constexpr size_t WS_KM = 110 * MiB;
constexpr size_t WS_VT = 111 * MiB;
constexpr size_t WS_S5E = 112 * MiB;
constexpr size_t WS_S5X = 114 * MiB;
constexpr size_t WS_A = 116 * MiB;
constexpr size_t WS_B = 180 * MiB;
constexpr size_t WS_Z1 = WS_B;
constexpr size_t WS_G = WS_B;
constexpr size_t WS_QRF = WS_B + 160 * MiB;
constexpr size_t WS_YCAT = WS_B + 192 * MiB;
constexpr size_t WS_YG = WS_B + 256 * MiB;
constexpr size_t WS_INNER = WS_B + 272 * MiB;
constexpr size_t WS_N2 = WS_B;
constexpr size_t WS_Q2 = WS_B + 64 * MiB;
constexpr size_t WS_IDX = WS_B + 192 * MiB;
constexpr size_t WS_WGT = WS_B + 208 * MiB;
constexpr size_t WS_HPART = WS_B + 128 * MiB;
constexpr size_t WS_ACT = WS_B + 224 * MiB;
constexpr size_t WS_POUT = WS_B + 64 * MiB;
constexpr size_t WS_END = WS_B + 304 * MiB;

constexpr int CW_BAR = 4096;
constexpr int CW_Q = 8192;

constexpr int LDS_BYTES = 147456;
constexpr int MISC_OFF = LDS_BYTES - 512;
constexpr int NWAVES = 8;

#define GAS __attribute__((address_space(1)))
#define LAS __attribute__((address_space(3)))
typedef unsigned short bf16;
typedef unsigned v4u __attribute__((ext_vector_type(4)));
typedef unsigned v2u __attribute__((ext_vector_type(2)));
typedef float f32x4 __attribute__((ext_vector_type(4)));
typedef float f32x16 __attribute__((ext_vector_type(16)));
typedef short bf16x8 __attribute__((ext_vector_type(8)));
typedef GAS unsigned gu32;
#define RLX_AGENT __ATOMIC_RELAXED, __HIP_MEMORY_SCOPE_AGENT
#define LDS_WAIT() asm volatile("s_waitcnt lgkmcnt(0)" ::: "memory")
#define VM_WAIT() asm volatile("s_waitcnt vmcnt(0)" ::: "memory")
__device__ __forceinline__ unsigned f2bf(float f) { unsigned u = __builtin_bit_cast(unsigned, f); return (u + 0x7fffu + ((u >> 16) & 1u)) >> 16; }
typedef __bf16 hwbf16x2_t __attribute__((ext_vector_type(2)));
typedef float hwf32x2_t __attribute__((ext_vector_type(2)));
__device__ __forceinline__ unsigned pk2(float lo, float hi) { const hwf32x2_t v = {lo, hi}; const hwbf16x2_t b = __builtin_convertvector(v, hwbf16x2_t); return __builtin_bit_cast(unsigned, b); }
__device__ __forceinline__ float bflo(unsigned w) { return __builtin_bit_cast(float, w << 16); }
__device__ __forceinline__ float bfhi(unsigned w) { return __builtin_bit_cast(float, w & 0xffff0000u); }
__device__ __forceinline__ float bf2f(bf16 h) { return __builtin_bit_cast(float, (unsigned)h << 16); }
__device__ __forceinline__ f32x16 mfma32(bf16x8 a, bf16x8 b, f32x16 c) { return __builtin_amdgcn_mfma_f32_32x32x16_bf16(a, b, c, 0, 0, 0); }
__device__ __forceinline__ f32x4 mfma16(bf16x8 a, bf16x8 b, f32x4 c) { return __builtin_amdgcn_mfma_f32_16x16x32_bf16(a, b, c, 0, 0, 0); }
__device__ __forceinline__ bf16x8 mk8(unsigned a, unsigned b, unsigned c, unsigned d) { v4u t = {a, b, c, d}; return __builtin_bit_cast(bf16x8, t); }
__device__ __forceinline__ float sigmoidf_(float x) { return __builtin_amdgcn_rcpf(1.0f + __builtin_amdgcn_exp2f(-1.4426950408889634f * x)); }
__device__ __forceinline__ float gelu_tanh(float x) {
    const float u2 = 1.5957691216057308f * (x + 0.044715f * x * x * x);
    return x * __builtin_amdgcn_rcpf(1.0f + __builtin_amdgcn_exp2f(-1.4426950408889634f * u2));
}
__device__ __forceinline__ float wave_sum(float v) {
#pragma unroll
    for (int o = 1; o < 64; o <<= 1) v += __shfl_xor(v, o);
    return v;
}

#define XB_TMO      128
#define XB_XCNT(j)  (256  + 64 * (j))
#define XB_XSUB(j)  (1280 + 64 * (j))
#define XB_XGEN(j)  (2304 + 64 * (j))
#define XB_TOP      3328
#define XB_TOPGEN   3392
#define XCD_BAR_WORDS 3456
#define XB_SPIN_CAP (1u << 22)

__device__ __forceinline__ unsigned xb_ld(unsigned* p)              { return __hip_atomic_load(p, __ATOMIC_RELAXED, __HIP_MEMORY_SCOPE_AGENT); }
__device__ __forceinline__ unsigned xb_add(unsigned* p, unsigned v) { return __hip_atomic_fetch_add(p, v, __ATOMIC_RELAXED, __HIP_MEMORY_SCOPE_AGENT); }
__device__ __forceinline__ unsigned xb_xcc_id() { return (unsigned)__builtin_amdgcn_s_getreg((3 << 11) | 20) & 0xFu; }
#define XB_SPIN(cond, bar) do { unsigned _sp = 0; while (cond) { __builtin_amdgcn_s_sleep(1); \
    if ((++_sp & 255u) == 0u) { if (xb_ld(&(bar)[XB_TMO])) break; if (_sp > XB_SPIN_CAP) { atomicAdd(&(bar)[XB_TMO], 1u); break; } } } } while (0)

struct XcdBarrier { unsigned* bar; unsigned x; volatile LAS unsigned* st; };

__device__ __forceinline__ XcdBarrier xcd_barrier_post(unsigned* bar, volatile LAS unsigned* st, bool tid0) {
    XcdBarrier b; b.bar = bar; b.x = xb_xcc_id(); b.st = st;
    if (tid0) (void)xb_add(&bar[XB_XCNT(b.x)], 1u);
    return b;
}
__device__ __forceinline__ void xcd_barrier_complete(unsigned* bar, unsigned x, unsigned& nloc, unsigned& nx) {
    const unsigned G = gridDim.x * gridDim.y * gridDim.z;
    unsigned sum, cnt, mine, sp = 0u;
    for (;;) {
        sum = 0u; cnt = 0u; mine = 0u;
#pragma unroll
        for (unsigned j = 0; j < 16; ++j) { const unsigned c = xb_ld(&bar[XB_XCNT(j)]); sum += c; cnt += (c > 0u) ? 1u : 0u; mine = (j == x) ? c : mine; }
        if (sum == G) break;
        __builtin_amdgcn_s_sleep(1);
        if ((++sp & 255u) == 0u) { if (xb_ld(&bar[XB_TMO])) break; if (sp > XB_SPIN_CAP) { atomicAdd(&bar[XB_TMO], 1u); break; } }
    }
    nloc = mine > 0u ? mine : 1u; nx = cnt > 0u ? cnt : 1u;
}
__device__ __forceinline__ void xcd_barrier(const XcdBarrier& b, int wave) {
    asm volatile("s_waitcnt vmcnt(0)" ::: "memory");
    __syncthreads();
    if (wave == 0 && pg8::hw_lane_id() == 0) {
        unsigned* bar = b.bar;
        __builtin_amdgcn_s_waitcnt(0);
        unsigned nloc = b.st[0], nx = b.st[1];
        if (nloc == 0u) { xcd_barrier_complete(bar, b.x, nloc, nx); b.st[0] = nloc; b.st[1] = nx; }
        const unsigned old = xb_add(&bar[XB_XSUB(b.x)], 1u);
        const unsigned gen = old / nloc;
        if (old + 1u == (gen + 1u) * nloc) {
            __builtin_amdgcn_fence(__ATOMIC_RELEASE, "agent");
            asm volatile("s_waitcnt vmcnt(0)" ::: "memory");
            const unsigned og = xb_add(&bar[XB_TOP], 1u);
            const unsigned tg = og / nx;
            if (og + 1u == (tg + 1u) * nx) xb_add(&bar[XB_TOPGEN], 1u);
            else XB_SPIN(xb_ld(&bar[XB_TOPGEN]) == tg, bar);
            __builtin_amdgcn_fence(__ATOMIC_ACQUIRE, "agent");
            xb_add(&bar[XB_XGEN(b.x)], 1u);
            asm volatile("s_waitcnt vmcnt(0)" ::: "memory");
        } else {
            XB_SPIN(xb_ld(&bar[XB_XGEN(b.x)]) == gen, bar);
            __builtin_amdgcn_fence(__ATOMIC_ACQUIRE, "agent");
            asm volatile("s_waitcnt vmcnt(0)" ::: "memory");
        }
    }
    __syncthreads();
}

__host__ __device__ __forceinline__ int frag32(int row, int k, int K) { return (((row >> 5) * (K >> 4) + (k >> 4)) * 64 + ((k >> 3) & 1) * 32 + (row & 31)) * 8 + (k & 7); }
__host__ __device__ __forceinline__ int frag16(int n, int k, int K) { return (((n >> 4) * (K >> 5) + (k >> 5)) * 64 + ((k >> 3) & 3) * 16 + (n & 15)) * 8 + (k & 7); }
struct Args { const void* in[26]; float* out; unsigned char* ws; int ph_lo, ph_hi; };
struct Ctx {
    LAS unsigned char* lds;
    int tid, lane, wave, vcu, G;
    __device__ __forceinline__ void refresh() { lane = pg8::hw_lane_id(); tid = wave * 64 + lane; }
};

template <class F> struct EpiT {
    static constexpr bool PERM = true, AFTER_DRAIN = false;
    F f;
    __device__ __forceinline__ void operator()(const f32x4 (&acc)[2][2][4][2], const pg8::Unit& u, int wr, int wc, int fr, int fq) const {
        const int row0 = u.pm * 256 + wr * 64 + fr, col0 = u.pn * 256 + wc * 32 + 8 * fq;
        typename F::L cur[2], nxt[2];
        f.load(row0, col0, cur[0]); f.load(row0, col0 + 128, cur[1]);
#pragma unroll
        for (int i = 0; i < 8; ++i) {
            const int ai = i >> 2, m = i & 3, row = row0 + ai * 128 + m * 16;
            if (i < 7) { const int rown = row0 + ((i + 1) >> 2) * 128 + ((i + 1) & 3) * 16; f.load(rown, col0, nxt[0]); f.load(rown, col0 + 128, nxt[1]); }
            __builtin_amdgcn_sched_barrier(0);
            f.apply(row, col0, acc[ai][0][m][0], acc[ai][0][m][1], cur[0]); f.apply(row, col0 + 128, acc[ai][1][m][0], acc[ai][1][m][1], cur[1]);
            __builtin_amdgcn_sched_barrier(0);
            cur[0] = nxt[0]; cur[1] = nxt[1];
        }
    }
};
__device__ __forceinline__ v4u pack8(f32x4 a, f32x4 b) { v4u w; w.x = pk2(a[0], a[1]); w.y = pk2(a[2], a[3]); w.z = pk2(b[0], b[1]); w.w = pk2(b[2], b[3]); return w; }
struct LNone {};
struct FStore { typedef LNone L; bf16* O; int ldc;
    __device__ __forceinline__ void load(int, int, L&) const {}
    __device__ __forceinline__ void apply(int row, int col, f32x4 v0, f32x4 v1, const L&) const { *(v4u*)(O + (size_t)row * ldc + col) = pack8(v0, v1); } };
struct FKvm { typedef LNone L; bf16* KM; bf16* VT;
    __device__ __forceinline__ void load(int, int, L&) const {}
    __device__ __forceinline__ void apply(int row, int col, f32x4 v0, f32x4 v1, const L&) const {
        const int b = row >> 8, m = row & 255;
        if (col < 256) { const int hm = col >> 6, d0 = col & 63; *(v4u*)(KM + (size_t)(b * 4 + hm) * 16384 + frag32(m, d0, 64)) = pack8(v0, v1); }
        else { const int c = col - 256, hm = c >> 6, e0 = c & 63, mt = m >> 5, s2 = (m >> 4) & 1, w = m & 15, hh = (w >> 2) & 1, j = ((w >> 3) << 2) | (w & 3);
            bf16* p = VT + (size_t)(b * 4 + hm) * 16384 + ((mt * 2 + s2) * 64 + hh * 32) * 8 + j;
#pragma unroll
            for (int jj = 0; jj < 8; ++jj) { const int e = e0 + jj; p[((e >> 5) * 16 * 64 + (e & 31)) * 8] = (bf16)f2bf(jj < 4 ? v0[jj] : v1[jj - 4]); } }
    } };
struct FSig { typedef LNone L; bf16* O; int ldc;
    __device__ __forceinline__ void load(int, int, L&) const {}
    __device__ __forceinline__ void apply(int row, int col, f32x4 v0, f32x4 v1, const L&) const {
#pragma unroll
        for (int j = 0; j < 4; ++j) { v0[j] = sigmoidf_(v0[j]); v1[j] = sigmoidf_(v1[j]); }
        *(v4u*)(O + (size_t)row * ldc + col) = pack8(v0, v1); } };
struct FGlu { typedef LNone L; bf16* O;
    __device__ __forceinline__ void load(int, int, L&) const {}
    __device__ __forceinline__ void apply(int row, int col, f32x4 v0, f32x4 v1, const L&) const {
        v2u w; w.x = pk2(v0[0] * sigmoidf_(v1[0]), v0[1] * sigmoidf_(v1[1])); w.y = pk2(v0[2] * sigmoidf_(v1[2]), v0[3] * sigmoidf_(v1[3]));
        *(v2u*)(O + (size_t)row * 1024 + 512 + (col >> 1)) = w; } };
__device__ __forceinline__ void mul8(f32x4& v0, f32x4& v1, const v4u num, const v4u den) {
    v0[0] *= bflo(num.x) * __builtin_amdgcn_rcpf(fmaxf(bflo(den.x), 1e-30f)); v0[1] *= bfhi(num.x) * __builtin_amdgcn_rcpf(fmaxf(bfhi(den.x), 1e-30f));
    v0[2] *= bflo(num.y) * __builtin_amdgcn_rcpf(fmaxf(bflo(den.y), 1e-30f)); v0[3] *= bfhi(num.y) * __builtin_amdgcn_rcpf(fmaxf(bfhi(den.y), 1e-30f));
    v1[0] *= bflo(num.z) * __builtin_amdgcn_rcpf(fmaxf(bflo(den.z), 1e-30f)); v1[1] *= bfhi(num.z) * __builtin_amdgcn_rcpf(fmaxf(bfhi(den.z), 1e-30f));
    v1[2] *= bflo(num.w) * __builtin_amdgcn_rcpf(fmaxf(bflo(den.w), 1e-30f)); v1[3] *= bfhi(num.w) * __builtin_amdgcn_rcpf(fmaxf(bfhi(den.w), 1e-30f));
}
struct HookGate { const bf16* Gt;
    __device__ __forceinline__ void operator()(int t, f32x4 (&acc)[2][2][4][2], const pg8::Unit& u, int wr, int wc, int fr, int fq) const {
        if (t != 8 && t != 12) return;
        const int gn = (t == 8) ? 0 : 1024, gd = gn + 1024;
        int row0 = u.pm * 256 + wr * 64 + fr, col0 = u.pn * 256 + wc * 32 + 8 * fq;
        asm volatile("" : "+v"(row0), "+v"(col0));
#pragma unroll
        for (int ai = 0; ai < 2; ++ai) {
            v4u nn[4][2], dd[4][2];
#pragma unroll
            for (int m = 0; m < 4; ++m) { const bf16* gp = Gt + (size_t)(row0 + ai * 128 + m * 16) * NGATE + col0;
                nn[m][0] = *(const v4u*)(gp + gn); dd[m][0] = *(const v4u*)(gp + gd); nn[m][1] = *(const v4u*)(gp + gn + 128); dd[m][1] = *(const v4u*)(gp + gd + 128); }
            __builtin_amdgcn_sched_barrier(0);
#pragma unroll
            for (int m = 0; m < 4; ++m) { mul8(acc[ai][0][m][0], acc[ai][0][m][1], nn[m][0], dd[m][0]); mul8(acc[ai][1][m][0], acc[ai][1][m][1], nn[m][1], dd[m][1]); }
            __builtin_amdgcn_sched_barrier(0);
        }
    } };
struct LGate { v4u g; };
struct FGateOut { typedef LGate L; const bf16* Gt; bf16* MB;
    __device__ __forceinline__ void load(int row, int col, L& l) const { l.g = *(const v4u*)(Gt + (size_t)row * NGATE + 2048 + col); }
    __device__ __forceinline__ void apply(int row, int col, f32x4 v0, f32x4 v1, const L& l) const {
        const v4u g = l.g;
        v0[0] *= bflo(g.x); v0[1] *= bfhi(g.x); v0[2] *= bflo(g.y); v0[3] *= bfhi(g.y); v1[0] *= bflo(g.z); v1[1] *= bfhi(g.z); v1[2] *= bflo(g.w); v1[3] *= bfhi(g.w);
        *(v4u*)(MB + (size_t)row * DM + col) = pack8(v0, v1); } };
struct LRes { f32x4 x0, x1; };
struct FRes { typedef LRes L; const float* X; bf16* HB; float* SS;
    __device__ __forceinline__ void load(int row, int col, L& l) const { const float* xp = X + (size_t)row * DM + col; l.x0 = *(const f32x4*)xp; l.x1 = *(const f32x4*)(xp + 4); }
    __device__ __forceinline__ void apply(int row, int col, f32x4 v0, f32x4 v1, const L& l) const {
        v0 += l.x0; v1 += l.x1;
        *(v4u*)(HB + (size_t)row * DM + col) = pack8(v0, v1);
        float q = (v0[0] * v0[0] + v0[1] * v0[1]) + (v0[2] * v0[2] + v0[3] * v0[3]) + (v1[0] * v1[0] + v1[1] * v1[1]) + (v1[2] * v1[2] + v1[3] * v1[3]);
        q += __shfl_xor(q, 16); q += __shfl_xor(q, 32);
        if (pg8::hw_lane_id() < 16) atomicAdd(SS + row, q); } };
struct LRstd { float ss; };
struct FStoreRstd { typedef LRstd L; bf16* O; int ldc; const float* SS;
    __device__ __forceinline__ void load(int row, int, L& l) const { l.ss = SS[row]; }
    __device__ __forceinline__ void apply(int row, int col, f32x4 v0, f32x4 v1, const L& l) const {
        const float rs = __builtin_amdgcn_rsqf(l.ss * (1.f / DM) + EPS);
        *(v4u*)(O + ((((size_t)(row >> 5) * 16 + (col >> 7)) * 8 + ((col & 127) >> 4)) * 64 + ((col >> 3) & 1) * 32 + (row & 31)) * 8) = pack8(v0 * rs, v1 * rs); } };

template <class F>
__device__ __forceinline__ void run_gemm(const Ctx& C, const bf16* A, const bf16* Bt, int M, int N, int K, const F& f) {
    pg8::Gemm g{A, Bt, M, N, K}; pg8::StaticOrder S; S.init(M, N, C.G, (int)blockIdx.x);
    EpiT<F> E{f};
    pg8::gemm_phase<EpiT<F>, pg8::StaticOrder, true, true>(C.lds, g, S, E, C.wave);
}

template <class F, class H>
__device__ __forceinline__ void run_gemm_hook(const Ctx& C, const bf16* A, const bf16* Bt, int M, int N, int K, const F& f, const H& h) {
    pg8::Gemm g{A, Bt, M, N, K}; pg8::StaticOrder S; S.init(M, N, C.G, (int)blockIdx.x);
    EpiT<F> E{f};
    pg8::gemm_phase<EpiT<F>, pg8::StaticOrder, true, true, false, H>(C.lds, g, S, E, C.wave, 0x7f7f7f7f, 0x7f7f7f7f, h);
}
template <class F>
__device__ __forceinline__ void run_gemm_mx(const Ctx& C, const unsigned char* A8, const unsigned char* Bt8, int M, int N, int Kbytes, const F& f, int sclA, int sclB) {
    pg8::Gemm g{(const bf16*)A8, (const bf16*)Bt8, M, N, Kbytes / 2}; pg8::StaticOrder S; S.init(M, N, C.G, (int)blockIdx.x);
    EpiT<F> E{f};
    pg8::gemm_phase<EpiT<F>, pg8::StaticOrder, true, true, true>(C.lds, g, S, E, C.wave, sclA, sclB);
}

template <bool GLU>
__device__ __forceinline__ void p0_transpose_item(const float* W, int K, int N, bf16* WT, LAS float* scr, int item, int lane, const float* kscale = nullptr, int ldk = 0, int koff = 0) {
    if (ldk == 0) ldk = K;
    const int nblk = N / 32, kb = item / nblk, nb = item % nblk, k0 = 64 * kb, n0 = 32 * nb;
#pragma unroll 8
    for (int i = 0; i < 32; ++i) { const int kk = 2 * i + (lane >> 5); float w = W[(size_t)(k0 + kk) * N + n0 + (lane & 31)]; if (kscale) w *= kscale[k0 + kk]; scr[kk * 33 + (lane & 31)] = w; }
    LDS_WAIT(); asm volatile("" ::: "memory");
    const int c = lane & 7;
#pragma unroll
    for (int j = 0; j < 4; ++j) { const int n = (lane >> 3) + 8 * j; const LAS float* s = scr + (8 * c) * 33 + n;
        v4u o; o.x = pk2(s[0 * 33], s[1 * 33]); o.y = pk2(s[2 * 33], s[3 * 33]); o.z = pk2(s[4 * 33], s[5 * 33]); o.w = pk2(s[6 * 33], s[7 * 33]);
        const int nn = n0 + n; int row = nn;
        if (GLU) { const int jc = nn & 255, gate = nn >> 8; row = 8 * (jc >> 2) + 4 * gate + (jc & 3); }
        *(GAS v4u*)(WT + (size_t)row * ldk + koff + k0 + 8 * c) = o; }
    LDS_WAIT(); asm volatile("" ::: "memory");
}
__device__ __forceinline__ void p0_transpose_item_fp8(const float* W, int K, int N, unsigned char* WT8, int nsub, LAS float* scr, int item, int lane, float scale) {
    const int nblk = N / 32, kb = item / nblk, nb = item % nblk, k0 = 64 * kb, n0 = 32 * nb;
#pragma unroll 8
    for (int i = 0; i < 32; ++i) { const int kk = 2 * i + (lane >> 5); scr[kk * 33 + (lane & 31)] = W[(size_t)(k0 + kk) * N + n0 + (lane & 31)] * scale; }
    LDS_WAIT(); asm volatile("" ::: "memory");
    const int c = lane & 7;
#pragma unroll
    for (int j = 0; j < 4; ++j) { const int n = (lane >> 3) + 8 * j; const LAS float* sp = scr + (8 * c) * 33 + n;
        int p0 = __builtin_amdgcn_cvt_pk_fp8_f32(sp[0 * 33], sp[1 * 33], 0, false); p0 = __builtin_amdgcn_cvt_pk_fp8_f32(sp[2 * 33], sp[3 * 33], p0, true);
        int p1 = __builtin_amdgcn_cvt_pk_fp8_f32(sp[4 * 33], sp[5 * 33], 0, false); p1 = __builtin_amdgcn_cvt_pk_fp8_f32(sp[6 * 33], sp[7 * 33], p1, true);
        v2u o; o.x = (unsigned)p0; o.y = (unsigned)p1;
        *(GAS v2u*)(WT8 + (size_t)(n0 + n - nsub) * K + k0 + 8 * c) = o; }
    LDS_WAIT(); asm volatile("" ::: "memory");
}
template <int NR>
__device__ __forceinline__ void rms_rows_to_bf16(const float* xbase, const float* gain, bf16* obase, int m0, int mstep, int lane, unsigned char* o8base = nullptr) {
    f32x4 v[NR][4]; float s[NR];
#pragma unroll
    for (int i = 0; i < NR; ++i) { const f32x4* xr = (const f32x4*)(xbase + (size_t)(m0 + i * mstep) * DM) + lane; s[i] = 0.f;
#pragma unroll
        for (int j = 0; j < 4; ++j) v[i][j] = xr[64 * j]; }
#pragma unroll
    for (int i = 0; i < NR; ++i)
#pragma unroll
        for (int j = 0; j < 4; ++j) s[i] += (v[i][j].x * v[i][j].x + v[i][j].y * v[i][j].y) + (v[i][j].z * v[i][j].z + v[i][j].w * v[i][j].w);
#pragma unroll
    for (int o = 1; o < 64; o <<= 1)
#pragma unroll
        for (int i = 0; i < NR; ++i) s[i] += __shfl_xor(s[i], o);
    const f32x4* gr = (const f32x4*)gain + lane;
    f32x4 g[4];
#pragma unroll
    for (int j = 0; j < 4; ++j) g[j] = gr[64 * j];
#pragma unroll
    for (int i = 0; i < NR; ++i) { const float rstd = 1.0f / sqrtf(s[i] * (1.f / DM) + EPS);
        unsigned long long* o8 = (unsigned long long*)(obase + (size_t)(m0 + i * mstep) * DM) + lane;
#pragma unroll
        for (int j = 0; j < 4; ++j) { const float y0 = v[i][j].x * rstd * g[j].x, y1 = v[i][j].y * rstd * g[j].y, y2 = v[i][j].z * rstd * g[j].z, y3 = v[i][j].w * rstd * g[j].w;
            o8[64 * j] = (unsigned long long)pk2(y0, y1) | ((unsigned long long)pk2(y2, y3) << 32);
            if (o8base) { int p = __builtin_amdgcn_cvt_pk_fp8_f32(y0 * 16.f, y1 * 16.f, 0, false); p = __builtin_amdgcn_cvt_pk_fp8_f32(y2 * 16.f, y3 * 16.f, p, true);
                *(unsigned*)(o8base + (size_t)(m0 + i * mstep) * DM + 256 * j + 4 * lane) = (unsigned)p; } } }
}

__device__ __forceinline__ void p0_s5_group(const Ctx& C, const Args& a, int g, int part) {
    const float* a_re = (const float*)a.in[7]; const float* a_im = (const float*)a.in[8]; const float* log_dt = (const float*)a.in[9];
    const float* b_re = (const float*)a.in[10]; const float* b_im = (const float*)a.in[11]; const float* c_re = (const float*)a.in[12]; const float* c_im = (const float*)a.in[13];
    LAS float* L = (LAS float*)C.lds;
    LAS float* lpr = L;
    LAS float* lpi = L + 640;
    LAS float* bbr = L + 1280;
    LAS float* bbi = bbr + 1024;
    LAS float* ccr = bbi + 1024;
    LAS float* cci = ccr + 1024;
    LAS float* Kj = cci + 1024;
    const int tid = C.tid;
    bf16* T8T = (bf16*)(a.ws + WS_S5MAT) + (size_t)g * 16384;
    bf16* PMT = (bf16*)(a.ws + WS_S5MAT) + (size_t)(16 + g) * 16384;
    bf16* QMT = (bf16*)(a.ws + WS_S5MAT) + (size_t)(32 + g) * 16384;
    float* L8 = (float*)(a.ws + WS_S5C) + (size_t)g * 128;
    float* L128 = (float*)(a.ws + WS_S5C) + 2048 + (size_t)g * 128;
    for (int i = tid; i < 640; i += 512) {
        const int j10 = i >> 6, p = i & 63; const double jj = (j10 < 9) ? (double)j10 : 128.0;
        const double dt = exp((double)log_dt[g]);
        const double ar = (double)a_re[g * 64 + p], ai = (double)a_im[g * 64 + p];
        const double mag = exp(ar * dt * jj), ang = ai * dt * jj;
        lpr[i] = (float)(mag * cos(ang)); lpi[i] = (float)(mag * sin(ang));
    }
    for (int i = tid; i < 1024; i += 512) { ccr[i] = c_re[g * 1024 + i]; cci[i] = c_im[g * 1024 + i]; }
    __syncthreads();
    if (part == 0 && tid < 64) { L8[tid * 2] = lpr[8 * 64 + tid]; L8[tid * 2 + 1] = lpi[8 * 64 + tid]; L128[tid * 2] = lpr[9 * 64 + tid]; L128[tid * 2 + 1] = lpi[9 * 64 + tid]; }
    for (int i = tid; i < 1024; i += 512) {
        const int p = i >> 4, h = i & 15;
        const float ar = a_re[g * 64 + p], ai = a_im[g * 64 + p], lr = lpr[64 + p], li = lpi[64 + p];
        const float den = ar * ar + ai * ai, nr = lr - 1.0f, ni = li;
        const float cr = (nr * ar + ni * ai) / den, ci = (ni * ar - nr * ai) / den;
        const float br = b_re[(g * 64 + p) * 16 + h], bi = b_im[(g * 64 + p) * 16 + h];
        bbr[i] = cr * br - ci * bi; bbi[i] = cr * bi + ci * br;
    }
    __syncthreads();
    for (int i = tid; i < 2048; i += 512) {
        const int j = i >> 8, ho = (i >> 4) & 15, hi = i & 15; float sacc = 0.f;
        if (j > (part >> 1) || (ho >> 3) != (part & 1)) continue;
        for (int p = 0; p < 64; ++p) { const float cr_ = ccr[ho * 64 + p], ci_ = cci[ho * 64 + p], lr_ = lpr[j * 64 + p], li_ = lpi[j * 64 + p];
            const float mr = cr_ * lr_ - ci_ * li_, mi = cr_ * li_ + ci_ * lr_;
            sacc += mr * bbr[p * 16 + hi] - mi * bbi[p * 16 + hi]; }
        Kj[i] = sacc;
    }
    __syncthreads();
    for (int i = part * 1024 + tid; i < (part + 1) * 1024; i += 512) {
        const int n = i >> 7, k = i & 127;
        { const int t = n >> 4, ho = n & 15, sx = k >> 4, hi = k & 15; const float v = (sx <= t) ? Kj[((t - sx) * 16 + ho) * 16 + hi] : 0.f; T8T[frag16(n, k, 128)] = (bf16)f2bf(v); }
        { const int p = n & 63, im = n >> 6, sx = k >> 4, hi = k & 15; const float lr_ = lpr[(7 - sx) * 64 + p], li_ = lpi[(7 - sx) * 64 + p], br_ = bbr[p * 16 + hi], bi_ = bbi[p * 16 + hi];
          const float v = im ? (lr_ * bi_ + li_ * br_) : (lr_ * br_ - li_ * bi_); PMT[frag16(n, k, 128)] = (bf16)f2bf(v); }
        { const int t = n >> 4, ho = n & 15, p = k & 63, pt = k >> 6; const float cr_ = ccr[ho * 64 + p], ci_ = cci[ho * 64 + p], lr_ = lpr[(t + 1) * 64 + p], li_ = lpi[(t + 1) * 64 + p];
          const float v = pt ? -(cr_ * li_ + ci_ * lr_) : (cr_ * lr_ - ci_ * li_); QMT[frag16(n, k, 128)] = (bf16)f2bf(v); }
    }
    __syncthreads();
}

__device__ __forceinline__ void p0_prologue(const Ctx& C, const Args& a) {
    p0_s5_group(C, a, C.vcu & 15, C.vcu >> 4);
    LAS float* scr = (LAS float*)(C.lds + C.wave * 16384);
    const int gw = C.vcu * NWAVES + C.wave, NGW = C.G * NWAVES;
    const int gt = C.vcu * 512 + C.tid, NGT = C.G * 512;
    unsigned char* ws = a.ws;
    for (int i = gt; i < MTOK; i += NGT) ((float*)(ws + WS_SS))[i] = 0.f;
    constexpr int I_IN = 16 * 176, I_Q = 16 * 64, I_O = 16 * 32, I_BR = 8 * 32, I_BS = 4 * 32, I_BM = 4 * 32, I_KV = 16 * 16, I_GLU = 4 * 16;
    constexpr int NITEMS = I_IN + I_Q + I_O + I_BR + I_BS + I_BM + I_KV + I_GLU;
    for (int it = gw; it < NITEMS; it += NGW) {
        int r = it;
        if (r < I_IN) { if ((r % 176) < 80) p0_transpose_item<false>((const float*)a.in[4], 1024, 5632, (bf16*)(ws + WS_WIN_T), scr, r, C.lane);
                        else p0_transpose_item_fp8((const float*)a.in[4], 1024, 5632, ws + WS_WG8, NZ1, scr, r, C.lane, 256.f); continue; } r -= I_IN;
        if (r < I_Q) { p0_transpose_item<false>((const float*)a.in[21], 1024, 2048, (bf16*)(ws + WS_WQ_T), scr, r, C.lane, (const float*)a.in[20]); continue; } r -= I_Q;
        if (r < I_O) { p0_transpose_item<false>((const float*)a.in[19], 1024, 1024, (bf16*)(ws + WS_WOUT_T), scr, r, C.lane); continue; } r -= I_O;
        if (r < I_BR) { p0_transpose_item<false>((const float*)a.in[16], 512, 1024, (bf16*)(ws + WS_WCAT_T), scr, r, C.lane, nullptr, 1024, 0); continue; } r -= I_BR;
        if (r < I_BS) { p0_transpose_item<false>((const float*)a.in[17], 256, 1024, (bf16*)(ws + WS_WCAT_T), scr, r, C.lane, nullptr, 1024, 512); continue; } r -= I_BS;
        if (r < I_BM) { p0_transpose_item<false>((const float*)a.in[18], 256, 1024, (bf16*)(ws + WS_WCAT_T), scr, r, C.lane, nullptr, 1024, 768); continue; } r -= I_BM;
        if (r < I_KV) { p0_transpose_item<false>((const float*)a.in[6], 1024, 512, (bf16*)(ws + WS_WMKV_T), scr, r, C.lane); continue; } r -= I_KV;
        p0_transpose_item<true>((const float*)a.in[15], 256, 512, (bf16*)(ws + WS_WGLU_T), scr, r, C.lane);
    }
    for (int i = gt; i < 16 * 128 * 128 / 8; i += NGT) { const f32x4 x0 = ((const f32x4*)a.in[22])[2 * (size_t)i], x1 = ((const f32x4*)a.in[22])[2 * (size_t)i + 1];
        const int hc = i >> 11, n = (i >> 4) & 127, d0 = (i & 15) * 8; *(v4u*)((bf16*)(ws + WS_KEYS) + hc * 16384 + frag32(n, d0, 128)) = pack8(x0, x1); }
    for (int rw0 = gw; rw0 < 2 * 16384; rw0 += 4 * NGW) {
        f32x4 v[4][4]; float mx[4];
#pragma unroll
        for (int i = 0; i < 4; ++i) { const int rw = rw0 + i * NGW, t = rw >> 14, row = rw & 16383;
            const float* src = (const float*)a.in[23 + t] + (size_t)row * DM + C.lane * 4; mx[i] = 0.f;
#pragma unroll
            for (int q = 0; q < 4; ++q) { v[i][q] = *(const f32x4*)(src + 256 * q); if (t == 0) v[i][q] = v[i][q] * *(const f32x4*)((const float*)a.in[20] + C.lane * 4 + 256 * q); } }
#pragma unroll
        for (int i = 0; i < 4; ++i)
#pragma unroll
            for (int q = 0; q < 4; ++q) mx[i] = fmaxf(mx[i], fmaxf(fmaxf(fabsf(v[i][q][0]), fabsf(v[i][q][1])), fmaxf(fabsf(v[i][q][2]), fabsf(v[i][q][3]))));
#pragma unroll
        for (int o = 1; o < 64; o <<= 1)
#pragma unroll
            for (int i = 0; i < 4; ++i) mx[i] = fmaxf(mx[i], __shfl_xor(mx[i], o));
#pragma unroll
        for (int i = 0; i < 4; ++i) { const int rw = rw0 + i * NGW, t = rw >> 14, row = rw & 16383;
            int ex = (int)((__builtin_bit_cast(unsigned, mx[i]) >> 23) & 0xffu) - 127;
            if (mx[i] < 1e-30f) ex = 7;
            const float sc = __builtin_bit_cast(float, (unsigned)(127 + 7 - ex) << 23), isc = __builtin_bit_cast(float, (unsigned)(127 - 7 + ex) << 23);
            unsigned char* dst = ws + (t ? WS_PV : WS_PU) + (size_t)row * 128 + ((C.lane * 4) & 127);
#pragma unroll
            for (int q = 0; q < 4; ++q) { int p = __builtin_amdgcn_cvt_pk_fp8_f32(v[i][q][0] * sc, v[i][q][1] * sc, 0, false); p = __builtin_amdgcn_cvt_pk_fp8_f32(v[i][q][2] * sc, v[i][q][3] * sc, p, true);
                *(unsigned*)(dst + (size_t)(2 * q + (C.lane >> 5)) * (16384 * 128)) = (unsigned)p; }
            if (C.lane == 0) ((float*)(ws + WS_PSC))[t * 16384 + row] = isc; }
    }
    for (int m = gw; m < MTOK; m += 4 * NGW) rms_rows_to_bf16<4>((const float*)a.in[0], (const float*)a.in[3], (bf16*)(ws + WS_A), m, NGW, C.lane, ws + WS_XN8);
    for (int m = gw; m < MROWS; m += NGW) rms_rows_to_bf16<1>((const float*)a.in[1], (const float*)a.in[5], (bf16*)(ws + WS_MEMN), m, NGW, C.lane);
    {
        const int* pos = (const int*)a.in[2]; float* rope = (float*)(ws + WS_ROPE);
        const int j = C.tid & 63;
        const double invrev = exp(-(double)j * (9.210340371976184 / 64.0)) * 0.15915494309189535;
        for (int i = gt; i < MTOK * 64; i += NGT) { const int tok = i >> 6;
            double rv = (double)pos[tok] * invrev; rv -= rint(rv);
            const float rf = (float)rv;
            rope[(size_t)tok * 128 + j] = __builtin_amdgcn_cosf(rf); rope[(size_t)tok * 128 + 64 + j] = __builtin_amdgcn_sinf(rf); }
    }
}

constexpr int LP = 136;
__device__ __forceinline__ float lg2_gamma(int h) { return log2f(1.0f - exp2f(-5.0f - (float)h)); }

struct R1In { v4u q[4], k[4]; };
__device__ __forceinline__ void r1_load(const bf16* zr, int h, int dq, int eq, R1In& R) {
    const bf16* sq = zr + ZQ + h * 128; const bf16* sk = zr + ZK + h * 128;
    R.q[0] = *(const v4u*)(sq + dq); R.q[1] = *(const v4u*)(sq + dq + 8); R.q[2] = *(const v4u*)(sq + 64 + dq); R.q[3] = *(const v4u*)(sq + 64 + dq + 8);
    R.k[0] = *(const v4u*)(sk + dq); R.k[1] = *(const v4u*)(sk + dq + 8); R.k[2] = *(const v4u*)(sk + 64 + dq); R.k[3] = *(const v4u*)(sk + 64 + dq + 8);
}
__device__ __forceinline__ void r1_unit(const Ctx& C, const Args& a, int tile, int h, const float (&cs)[16], const float (&sn)[16], const R1In& R, R1In& Rn, bool hasnext) {
    const bf16* Z1 = (const bf16*)(a.ws + WS_Z1);
    LAS bf16* Qs = (LAS bf16*)C.lds; LAS bf16* Ks = Qs + 128 * LP; LAS bf16* Kt = Ks + 128 * LP; LAS bf16* Vt = Kt + 128 * LP;
    const int tid = C.tid, lane = C.lane, t0 = tile * 128, u = tile * 4 + h;
    const float lg2g = lg2_gamma(h);
    const int i = tid >> 2, dq = (tid & 3) * 16, eq = (tid & 3) * 32;
    {
        v4u vraw[4];
#pragma unroll
        for (int q = 0; q < 4; ++q) vraw[q] = *(const v4u*)(Z1 + (size_t)(t0 + i) * NZ1 + ZV + h * 128 + eq + 8 * q);
        const float kdec = __builtin_amdgcn_exp2f((float)(127 - i) * lg2g) , ksc = 0.08838834764831845f;
#pragma unroll
        for (int which = 0; which < 2; ++which) {
            const v4u a0 = which ? R.k[0] : R.q[0], a1 = which ? R.k[1] : R.q[1], b0 = which ? R.k[2] : R.q[2], b1 = which ? R.k[3] : R.q[3];
            const unsigned aw[8] = {a0.x, a0.y, a0.z, a0.w, a1.x, a1.y, a1.z, a1.w}, bw[8] = {b0.x, b0.y, b0.z, b0.w, b1.x, b1.y, b1.z, b1.w};
            float y1[16], y2[16];
#pragma unroll
            for (int w = 0; w < 8; ++w) {
                const float x1l = bflo(aw[w]), x1h = bfhi(aw[w]), x2l = bflo(bw[w]), x2h = bfhi(bw[w]);
                y1[2 * w] = x1l * cs[2 * w] - x2l * sn[2 * w]; y2[2 * w] = x1l * sn[2 * w] + x2l * cs[2 * w];
                y1[2 * w + 1] = x1h * cs[2 * w + 1] - x2h * sn[2 * w + 1]; y2[2 * w + 1] = x1h * sn[2 * w + 1] + x2h * cs[2 * w + 1];
            }
            if (which) {
#pragma unroll
                for (int e = 0; e < 16; ++e) { y1[e] *= ksc; y2[e] *= ksc; }
            }
            LAS bf16* dstp = (which ? Ks : Qs) + i * LP;
            v4u o;
            o.x = pk2(y1[0], y1[1]); o.y = pk2(y1[2], y1[3]); o.z = pk2(y1[4], y1[5]); o.w = pk2(y1[6], y1[7]); *(LAS v4u*)(dstp + dq) = o;
            o.x = pk2(y1[8], y1[9]); o.y = pk2(y1[10], y1[11]); o.z = pk2(y1[12], y1[13]); o.w = pk2(y1[14], y1[15]); *(LAS v4u*)(dstp + dq + 8) = o;
            o.x = pk2(y2[0], y2[1]); o.y = pk2(y2[2], y2[3]); o.z = pk2(y2[4], y2[5]); o.w = pk2(y2[6], y2[7]); *(LAS v4u*)(dstp + 64 + dq) = o;
            o.x = pk2(y2[8], y2[9]); o.y = pk2(y2[10], y2[11]); o.z = pk2(y2[12], y2[13]); o.w = pk2(y2[14], y2[15]); *(LAS v4u*)(dstp + 64 + dq + 8) = o;
            if (which) {
#pragma unroll
                for (int e = 0; e < 16; ++e) { Kt[(dq + e) * LP + i] = (bf16)f2bf(y1[e] * kdec); Kt[(64 + dq + e) * LP + i] = (bf16)f2bf(y2[e] * kdec); }
            }
            __builtin_amdgcn_sched_barrier(0);
        }
        {
#pragma unroll
            for (int q = 0; q < 4; ++q) { const v4u v = vraw[q]; const unsigned vw[4] = {v.x, v.y, v.z, v.w};
#pragma unroll
                for (int w = 0; w < 4; ++w) { Vt[(eq + 8 * q + 2 * w) * LP + i] = (bf16)(vw[w] & 0xffffu); Vt[(eq + 8 * q + 2 * w + 1) * LP + i] = (bf16)(vw[w] >> 16); } }
        }
    }
    __syncthreads();
    if (hasnext) r1_load(Z1 + (size_t)(t0 + i) * NZ1, h + 1, dq, eq, Rn);
    __builtin_amdgcn_sched_barrier(0);
    const int r = lane & 31, hh = lane >> 5;
    if (C.wave < 4) {
        const int ib = C.wave;
        { bf16* qf = (bf16*)(a.ws + WS_QRF) + ((size_t)(u * 4 + ib) * 8 * 64 + lane) * 8;
#pragma unroll
          for (int ks = 0; ks < 8; ++ks) *(bf16x8*)(qf + ks * 512) = *(const LAS bf16x8*)(Qs + (ib * 32 + r) * LP + ks * 16 + 8 * hh); }
        __builtin_amdgcn_sched_barrier(0);
        f32x16 accO[4];
#pragma unroll
        for (int et = 0; et < 4; ++et)
#pragma unroll
            for (int e = 0; e < 16; ++e) accO[et][e] = 0.f;
        int i = ib * 32 + r; asm volatile("" : "+v"(i));
#pragma unroll
        for (int jt = 0; jt < 4; ++jt) {
            if (jt <= ib) {
                f32x16 s;
#pragma unroll
                for (int e = 0; e < 16; ++e) s[e] = 0.f;
#pragma unroll
                for (int ks = 0; ks < 8; ++ks) { const bf16x8 ak = *(const LAS bf16x8*)(Ks + (jt * 32 + r) * LP + ks * 16 + 8 * hh), bqk = *(const LAS bf16x8*)(Qs + (ib * 32 + r) * LP + ks * 16 + 8 * hh); s = mfma32(ak, bqk, s); }
                unsigned pk[8];
#pragma unroll
                for (int q = 0; q < 8; ++q) {
                    const int ra = 2 * q, rb = 2 * q + 1;
                    const int ja = jt * 32 + (ra & 3) + 8 * (ra >> 2) + 4 * hh, jb = jt * 32 + (rb & 3) + 8 * (rb >> 2) + 4 * hh;
                    const float va = (i >= ja) ? s[ra] * __builtin_amdgcn_exp2f((float)(i - ja) * lg2g) : 0.f;
                    const float vb = (i >= jb) ? s[rb] * __builtin_amdgcn_exp2f((float)(i - jb) * lg2g) : 0.f;
                    pk[q] = pk2(va, vb);
                }
#pragma unroll
                for (int sft = 0; sft < 2; ++sft) {
                    const bf16x8 pb = mk8(pk[4 * sft], pk[4 * sft + 1], pk[4 * sft + 2], pk[4 * sft + 3]);
#pragma unroll
                    for (int et = 0; et < 4; ++et) {
                        const LAS bf16* vp = Vt + (et * 32 + r) * LP + jt * 32 + 16 * sft + 4 * hh;
                        const v2u lo = *(const LAS v2u*)vp, hi = *(const LAS v2u*)(vp + 8);
                        accO[et] = mfma32(mk8(lo.x, lo.y, hi.x, hi.y), pb, accO[et]);
                    }
                }
            }
            __builtin_amdgcn_sched_barrier(0);
        }
        unsigned* INN = (unsigned*)(a.ws + WS_INNER) + ((size_t)(u * 4 + ib) * 32) * 64 + lane;
#pragma unroll
        for (int et = 0; et < 4; ++et)
#pragma unroll
            for (int q = 0; q < 8; ++q) INN[(et * 8 + q) * 64] = pk2(accO[et][2 * q], accO[et][2 * q + 1]);
    } else {
        const int et = C.wave - 4;
        f32x16 acc[4];
#pragma unroll
        for (int dt = 0; dt < 4; ++dt)
#pragma unroll
            for (int e = 0; e < 16; ++e) acc[dt][e] = 0.f;
#pragma unroll
        for (int ks = 0; ks < 8; ++ks) {
            const bf16x8 av = *(const LAS bf16x8*)(Vt + (et * 32 + r) * LP + ks * 16 + 8 * hh);
#pragma unroll
            for (int dt = 0; dt < 4; ++dt) { const bf16x8 bk = *(const LAS bf16x8*)(Kt + (dt * 32 + r) * LP + ks * 16 + 8 * hh); acc[dt] = mfma32(av, bk, acc[dt]); }
            __builtin_amdgcn_sched_barrier(0);
        }
        float* KVb = a.out + (size_t)u * 16384 + (size_t)(et * 32 + 4 * hh) * 128 + r;
#pragma unroll
        for (int dt = 0; dt < 4; ++dt) {
#pragma unroll
            for (int e = 0; e < 16; ++e) KVb[((e & 3) + 8 * (e >> 2)) * 128 + dt * 32] = acc[dt][e];
            __builtin_amdgcn_sched_barrier(0);
        }
    }
    __syncthreads();
}

__device__ __forceinline__ void s5_compute_E(const Args& a, int tile, int g, int lane, LAS float* Es, bf16x8 (&au)[4]) {
    const bf16* Z1 = (const bf16*)(a.ws + WS_Z1); const bf16* PMT = (const bf16*)(a.ws + WS_S5MAT) + (size_t)(16 + g) * 16384;
    const int r16 = lane & 15, q4 = lane >> 4;
#pragma unroll
    for (int ks = 0; ks < 4; ++ks) { const int s = 2 * ks + (q4 >> 1);
        au[ks] = *(const bf16x8*)(Z1 + (size_t)(tile * 128 + 8 * r16 + s) * NZ1 + ZU + g * 16 + 8 * (q4 & 1)); }
    bf16x8 bc[4], bn[4];
#pragma unroll
    for (int ks = 0; ks < 4; ++ks) bc[ks] = *(const bf16x8*)(PMT + (ks * 64 + lane) * 8);
#pragma unroll 1
    for (int nb = 0; nb < 8; ++nb) {
        const int nbn = min(nb + 1, 7);
#pragma unroll
        for (int ks = 0; ks < 4; ++ks) bn[ks] = *(const bf16x8*)(PMT + ((nbn * 4 + ks) * 64 + lane) * 8);
        __builtin_amdgcn_sched_barrier(0);
        f32x4 acc = {0.f, 0.f, 0.f, 0.f};
#pragma unroll
        for (int ks = 0; ks < 4; ++ks) acc = mfma16(au[ks], bc[ks], acc);
#pragma unroll
        for (int i4 = 0; i4 < 4; ++i4) Es[(q4 * 4 + i4) * 128 + nb * 16 + r16] = acc[i4];
        __builtin_amdgcn_sched_barrier(0);
#pragma unroll
        for (int ks = 0; ks < 4; ++ks) bc[ks] = bn[ks];
    }
    LDS_WAIT(); asm volatile("" ::: "memory");
}
__device__ __forceinline__ void s5a_wave(const Ctx& C, const Args& a, int tile, int g) {
    LAS float* Es = (LAS float*)(C.lds + C.wave * 16384);
    bf16x8 au[4];
    s5_compute_E(a, tile, g, C.lane, Es, au);
    const float* L8 = (const float*)(a.ws + WS_S5C) + (size_t)g * 128;
    const float l8r = L8[C.lane * 2], l8i = L8[C.lane * 2 + 1];
    float sr = 0.f, si = 0.f;
#pragma unroll
    for (int c = 0; c < 16; ++c) { const float er = Es[c * 128 + C.lane], ei = Es[c * 128 + 64 + C.lane];
        const float nr = l8r * sr - l8i * si + er, ni = l8r * si + l8i * sr + ei; sr = nr; si = ni; }
    float* E = (float*)(a.ws + WS_S5E) + ((size_t)tile * 16 + g) * 128;
    E[C.lane] = sr; E[64 + C.lane] = si;
    LDS_WAIT(); asm volatile("" ::: "memory");
}
__device__ __forceinline__ void s5c_wave(const Ctx& C, const Args& a, int tile, int g) {
    LAS float* Es = (LAS float*)(C.lds + C.wave * 16384);
    LAS bf16* Sv = (LAS bf16*)(C.lds + C.wave * 16384 + 8192);
    const int lane = C.lane, r16 = lane & 15, q4 = lane >> 4;
    bf16x8 au[4];
    s5_compute_E(a, tile, g, lane, Es, au);
    const float* L8 = (const float*)(a.ws + WS_S5C) + (size_t)g * 128;
    const float l8r = L8[lane * 2], l8i = L8[lane * 2 + 1];
    const float* X = (const float*)(a.ws + WS_S5X) + ((size_t)tile * 16 + g) * 128;
    float sr = X[lane], si = X[64 + lane];
#pragma unroll
    for (int c = 0; c < 16; ++c) {
        Sv[c * LP + lane] = (bf16)f2bf(sr); Sv[c * LP + 64 + lane] = (bf16)f2bf(si);
        const float er = Es[c * 128 + lane], ei = Es[c * 128 + 64 + lane];
        const float nr = l8r * sr - l8i * si + er, ni = l8r * si + l8i * sr + ei; sr = nr; si = ni; }
    LDS_WAIT(); asm volatile("" ::: "memory");
    bf16x8 as[4];
#pragma unroll
    for (int ks = 0; ks < 4; ++ks) as[ks] = *(const LAS bf16x8*)(Sv + r16 * LP + ks * 32 + 8 * q4);
    const bf16* T8T = (const bf16*)(a.ws + WS_S5MAT) + (size_t)g * 16384; const bf16* QMT = (const bf16*)(a.ws + WS_S5MAT) + (size_t)(32 + g) * 16384;
    const bf16* Z1 = (const bf16*)(a.ws + WS_Z1); bf16* YG = (bf16*)(a.ws + WS_YG);
    const float dg = ((const float*)a.in[14])[g * 16 + r16];
    bf16x8 tc[4], tn[4], qc[4], qn[4]; bf16 uc[4], un[4];
#pragma unroll
    for (int ks = 0; ks < 4; ++ks) { tc[ks] = *(const bf16x8*)(T8T + (ks * 64 + lane) * 8); qc[ks] = *(const bf16x8*)(QMT + (ks * 64 + lane) * 8); }
#pragma unroll
    for (int i4 = 0; i4 < 4; ++i4) uc[i4] = Z1[(size_t)(tile * 128 + 8 * (q4 * 4 + i4)) * NZ1 + ZU + g * 16 + r16];
#pragma unroll 1
    for (int nb = 0; nb < 8; ++nb) {
        const int nbn = min(nb + 1, 7);
#pragma unroll
        for (int ks = 0; ks < 4; ++ks) { tn[ks] = *(const bf16x8*)(T8T + ((nbn * 4 + ks) * 64 + lane) * 8); qn[ks] = *(const bf16x8*)(QMT + ((nbn * 4 + ks) * 64 + lane) * 8); }
#pragma unroll
        for (int i4 = 0; i4 < 4; ++i4) un[i4] = Z1[(size_t)(tile * 128 + 8 * (q4 * 4 + i4) + nbn) * NZ1 + ZU + g * 16 + r16];
        __builtin_amdgcn_sched_barrier(0);
        f32x4 acc = {0.f, 0.f, 0.f, 0.f};
#pragma unroll
        for (int ks = 0; ks < 4; ++ks) { acc = mfma16(au[ks], tc[ks], acc); acc = mfma16(as[ks], qc[ks], acc); }
#pragma unroll
        for (int i4 = 0; i4 < 4; ++i4) { const int tok = tile * 128 + 8 * (q4 * 4 + i4) + nb;
            YG[(size_t)tok * 256 + g * 16 + r16] = (bf16)f2bf(gelu_tanh(acc[i4] + dg * bf2f(uc[i4]))); }
        __builtin_amdgcn_sched_barrier(0);
#pragma unroll
        for (int ks = 0; ks < 4; ++ks) { tc[ks] = tn[ks]; qc[ks] = qn[ks]; }
#pragma unroll
        for (int i4 = 0; i4 < 4; ++i4) uc[i4] = un[i4];
    }
    LDS_WAIT(); asm volatile("" ::: "memory");
}

__device__ __forceinline__ void ma_loadk(const bf16* kp, int mt, bf16x8 (&k)[4]) {
#pragma unroll
    for (int ks = 0; ks < 4; ++ks) k[ks] = *(const bf16x8*)(kp + (mt * 4 + ks) * 512);
}
__device__ __forceinline__ void ma_loadv(const bf16* vp, int mt, bf16x8 (&v)[4]) {
#pragma unroll
    for (int sft = 0; sft < 2; ++sft)
#pragma unroll
        for (int et = 0; et < 2; ++et) v[sft * 2 + et] = *(const bf16x8*)(vp + (((et * 8 + mt) * 2 + sft) * 64) * 8);
}
__device__ __forceinline__ void ma_wave(const Ctx& C, const Args& a, int tile, int hm, int ib) {
    const bf16* Z1 = (const bf16*)(a.ws + WS_Z1); const bf16* KM = (const bf16*)(a.ws + WS_KM); const bf16* VT = (const bf16*)(a.ws + WS_VT);
    const int lane = C.lane, r = lane & 31, hh = lane >> 5, b = tile >> 5, tok = tile * 128 + ib * 32 + r;
    const bf16* kp = KM + (size_t)(b * 4 + hm) * 16384 + lane * 8;
    const bf16* vp = VT + (size_t)(b * 4 + hm) * 16384 + lane * 8;
    bf16x8 bq[4];
#pragma unroll
    for (int ks = 0; ks < 4; ++ks) bq[ks] = *(const bf16x8*)(Z1 + (size_t)tok * NZ1 + ZQM + hm * 64 + ks * 16 + 8 * hh);
    bf16x8 kc[4], kn[4];
    ma_loadk(kp, 0, kc);
    float mx = -3.0e38f;
#pragma unroll 1
    for (int mt = 0; mt < 8; ++mt) {
        ma_loadk(kp, min(mt + 1, 7), kn); __builtin_amdgcn_sched_barrier(0);
        f32x16 s;
#pragma unroll
        for (int e = 0; e < 16; ++e) s[e] = 0.f;
#pragma unroll
        for (int ks = 0; ks < 4; ++ks) s = mfma32(kc[ks], bq[ks], s);
#pragma unroll
        for (int e = 0; e < 16; ++e) mx = fmaxf(mx, s[e]);
        __builtin_amdgcn_sched_barrier(0);
#pragma unroll
        for (int ks = 0; ks < 4; ++ks) kc[ks] = kn[ks];
    }
    mx = fmaxf(mx, __shfl_xor(mx, 32));
    float sum = 0.f;
    f32x16 o[2];
#pragma unroll
    for (int et = 0; et < 2; ++et)
#pragma unroll
        for (int e = 0; e < 16; ++e) o[et][e] = 0.f;
    const float sc = 0.125f * 1.4426950408889634f;
    bf16x8 vc[4], vn[4];
    ma_loadk(kp, 0, kc); ma_loadv(vp, 0, vc);
#pragma unroll 1
    for (int mt = 0; mt < 8; ++mt) {
        ma_loadk(kp, min(mt + 1, 7), kn); ma_loadv(vp, min(mt + 1, 7), vn); __builtin_amdgcn_sched_barrier(0);
        f32x16 s;
#pragma unroll
        for (int e = 0; e < 16; ++e) s[e] = 0.f;
#pragma unroll
        for (int ks = 0; ks < 4; ++ks) s = mfma32(kc[ks], bq[ks], s);
        unsigned pk[8];
#pragma unroll
        for (int q = 0; q < 8; ++q) { const float pa = __builtin_amdgcn_exp2f((s[2 * q] - mx) * sc), pb = __builtin_amdgcn_exp2f((s[2 * q + 1] - mx) * sc); sum += pa + pb; pk[q] = pk2(pa, pb); }
#pragma unroll
        for (int sft = 0; sft < 2; ++sft) {
            const bf16x8 pb = mk8(pk[4 * sft], pk[4 * sft + 1], pk[4 * sft + 2], pk[4 * sft + 3]);
#pragma unroll
            for (int et = 0; et < 2; ++et) o[et] = mfma32(vc[sft * 2 + et], pb, o[et]);
        }
        __builtin_amdgcn_sched_barrier(0);
#pragma unroll
        for (int ks = 0; ks < 4; ++ks) kc[ks] = kn[ks];
#pragma unroll
        for (int q = 0; q < 4; ++q) vc[q] = vn[q];
    }
    sum += __shfl_xor(sum, 32);
    const float inv = 1.0f / sum;
    bf16* MA = (bf16*)(a.ws + WS_YCAT) + (size_t)tok * 1024 + 768 + hm * 64;
#pragma unroll
    for (int et = 0; et < 2; ++et)
#pragma unroll
        for (int g4 = 0; g4 < 4; ++g4) { v2u w; w.x = pk2(o[et][4 * g4] * inv, o[et][4 * g4 + 1] * inv); w.y = pk2(o[et][4 * g4 + 2] * inv, o[et][4 * g4 + 3] * inv);
            *(v2u*)(MA + et * 32 + 8 * g4 + 4 * hh) = w; }
}

__device__ __forceinline__ void r3_wave(const Ctx& C, const Args& a, int tile, int h, int ib) {
    const bf16* Z1 = (const bf16*)(a.ws + WS_Z1); const float* ROPE = (const float*)(a.ws + WS_ROPE);
    const bf16* PREV = (const bf16*)((const unsigned char*)a.out + 64 * MiB);
    const int lane = C.lane, r = lane & 31, hh = lane >> 5, u = tile * 4 + h, tok = tile * 128 + ib * 32 + r;
    const float lg2g = lg2_gamma(h);
    bf16x8 bq[8];
    { const bf16* qf = (const bf16*)(a.ws + WS_QRF) + ((size_t)(u * 4 + ib) * 8 * 64 + lane) * 8;
#pragma unroll
      for (int ks = 0; ks < 8; ++ks) bq[ks] = *(const bf16x8*)(qf + ks * 512); }
    const unsigned* INN = (const unsigned*)(a.ws + WS_INNER) + ((size_t)(u * 4 + ib) * 32) * 64 + lane;
    unsigned innw[32];
#pragma unroll
    for (int q = 0; q < 32; ++q) innw[q] = INN[q * 64];
    f32x16 acc[4];
    const bf16* pbase = PREV + (size_t)u * 16384 + lane * 8;
    bf16x8 apc[8], apn[8];
#pragma unroll
    for (int ks = 0; ks < 8; ++ks) apc[ks] = *(const bf16x8*)(pbase + ks * 512);
#pragma unroll
    for (int et = 0; et < 4; ++et) {
        if (et < 3) {
#pragma unroll
            for (int ks = 0; ks < 8; ++ks) apn[ks] = *(const bf16x8*)(pbase + ((et + 1) * 8 + ks) * 512);
        }
        __builtin_amdgcn_sched_barrier(0);
#pragma unroll
        for (int e = 0; e < 16; ++e) acc[et][e] = 0.f;
#pragma unroll
        for (int ks = 0; ks < 8; ++ks) acc[et] = mfma32(apc[ks], bq[ks], acc[et]);
        __builtin_amdgcn_sched_barrier(0);
#pragma unroll
        for (int ks = 0; ks < 8; ++ks) apc[ks] = apn[ks];
    }
    const float qdec = __builtin_amdgcn_exp2f((float)(ib * 32 + r + 1) * lg2g);
    float ss = 0.f;
#pragma unroll
    for (int et = 0; et < 4; ++et)
#pragma unroll
        for (int q = 0; q < 8; ++q) { const unsigned w = innw[et * 8 + q];
            const float v0 = acc[et][2 * q] * qdec + bflo(w), v1 = acc[et][2 * q + 1] * qdec + bfhi(w);
            acc[et][2 * q] = v0; acc[et][2 * q + 1] = v1; ss += v0 * v0 + v1 * v1; }
    __builtin_amdgcn_sched_barrier(0);
    ss += __shfl_xor(ss, 32);
    const float rn = __builtin_amdgcn_rsqf(ss * (1.0f / 128.0f) + EPS);
    const bf16* gp = Z1 + (size_t)tok * NZ1 + ZGR + h * 128; bf16* RET = (bf16*)(a.ws + WS_YCAT) + (size_t)tok * 1024 + h * 128;
#pragma unroll
    for (int et = 0; et < 4; ++et)
#pragma unroll
        for (int g4 = 0; g4 < 4; ++g4) { const int e0 = et * 32 + 8 * g4 + 4 * hh; const v2u gw = *(const v2u*)(gp + e0);
            const float g0 = bflo(gw.x), g1 = bfhi(gw.x), g2 = bflo(gw.y), g3 = bfhi(gw.y);
            v2u w; w.x = pk2(acc[et][4 * g4] * rn * g0 * sigmoidf_(g0), acc[et][4 * g4 + 1] * rn * g1 * sigmoidf_(g1));
            w.y = pk2(acc[et][4 * g4 + 2] * rn * g2 * sigmoidf_(g2), acc[et][4 * g4 + 3] * rn * g3 * sigmoidf_(g3));
            *(v2u*)(RET + e0) = w; }
}

__device__ __forceinline__ void p3_scans(const Ctx& C, const Args& a) {
    constexpr int NSKIP = 16;
    if ((int)blockIdx.x < NSKIP) return;
    const int w0 = ((int)blockIdx.x - NSKIP) * 512 + C.tid, NW = (C.G - NSKIP) * 512;
    {
        const float* KV = a.out; bf16* PREV = (bf16*)((unsigned char*)a.out + 64 * MiB);
        for (int it = w0; it < 131072; it += NW) {
            const int elem = it * 4, b = elem >> 16, h = (elem >> 14) & 3, ed = elem & 16383;
            const float cd = __builtin_amdgcn_exp2f(128.0f * lg2_gamma(h));
            const float* kp = KV + (size_t)(b * 128 + h) * 16384 + ed; bf16* pp = PREV + (size_t)(b * 128 + h) * 16384 + frag32(ed >> 7, ed & 127, 128);
            f32x4 inc[32];
#pragma unroll
            for (int c = 0; c < 32; ++c) inc[c] = *(const f32x4*)(kp + (size_t)c * 65536);
            f32x4 st = {0.f, 0.f, 0.f, 0.f};
#pragma unroll
            for (int c = 0; c < 32; ++c) { v2u w; w.x = pk2(st[0], st[1]); w.y = pk2(st[2], st[3]); *(v2u*)(pp + (size_t)c * 65536) = w; st = st * cd + inc[c]; }
        }
    }
    {
        const float* E = (const float*)(a.ws + WS_S5E); float* X = (float*)(a.ws + WS_S5X); const float* L128 = (const float*)(a.ws + WS_S5C) + 2048;
        for (int it = w0; it < 8192; it += NW) {
            const int b = it >> 10, g = (it >> 6) & 15, p = it & 63;
            const float lr = L128[(g * 64 + p) * 2], li = L128[(g * 64 + p) * 2 + 1];
            const float* ep = E + ((size_t)(b * 32) * 16 + g) * 128 + p; float* xp = X + ((size_t)(b * 32) * 16 + g) * 128 + p;
            float er[32], ei[32];
#pragma unroll
            for (int n = 0; n < 32; ++n) { er[n] = ep[(size_t)n * 2048]; ei[n] = ep[(size_t)n * 2048 + 64]; }
            float xr = 0.f, xi = 0.f;
#pragma unroll
            for (int n = 0; n < 32; ++n) { xp[(size_t)n * 2048] = xr; xp[(size_t)n * 2048 + 64] = xi;
                const float nr = lr * xr - li * xi + er[n], ni = lr * xi + li * xr + ei[n]; xr = nr; xi = ni; }
        }
    }
}

__device__ __forceinline__ int f2key(float x) { int b = __builtin_bit_cast(int, x); return b >= 0 ? b : (b ^ 0x7fffffff); }
__device__ __forceinline__ float key2f(int k) { return __builtin_bit_cast(float, k >= 0 ? k : (k ^ 0x7fffffff)); }
__device__ __forceinline__ void ce_desc(int& x, int& y) { const int hi = x > y ? x : y, lo = x > y ? y : x; x = hi; y = lo; }
__device__ __forceinline__ void sort16_desc(int (&v)[16]) {
#pragma unroll
    for (int k = 2; k <= 16; k <<= 1)
#pragma unroll
        for (int j = k >> 1; j > 0; j >>= 1)
#pragma unroll
            for (int i = 0; i < 16; ++i) { const int l = i ^ j; if (l > i) { if ((i & k) == 0) ce_desc(v[i], v[l]); else ce_desc(v[l], v[i]); } }
}
__device__ __forceinline__ void merge16_desc(int (&T)[16], const int (&N)[16]) {
#pragma unroll
    for (int i = 0; i < 16; ++i) T[i] = T[i] > N[15 - i] ? T[i] : N[15 - i];
#pragma unroll
    for (int j = 8; j > 0; j >>= 1)
#pragma unroll
        for (int i = 0; i < 16; ++i) { const int l = i ^ j; if (l > i) ce_desc(T[i], T[l]); }
}
__device__ __forceinline__ void peer_topk_half(const Args& a, int tokbase, int hp, int c, int lane, int (&T)[16]) {
    const bf16* Q2 = (const bf16*)(a.ws + WS_Q2); const bf16* KEYS = (const bf16*)(a.ws + WS_KEYS);
    const int r = lane & 31, hh = lane >> 5;
    bf16x8 bq[8];
#pragma unroll
    for (int ks = 0; ks < 8; ++ks) bq[ks] = *(const bf16x8*)(Q2 + ((((size_t)(tokbase >> 5) * 16 + hp * 2 + c) * 8 + ks) * 64 + lane) * 8);
    const bf16* kbase = KEYS + (size_t)(hp * 2 + c) * 16384 + lane * 8;
    bf16x8 akc[8], akn[8];
#pragma unroll
    for (int ks = 0; ks < 8; ++ks) akc[ks] = *(const bf16x8*)(kbase + ks * 512);
#pragma unroll
    for (int nt = 0; nt < 4; ++nt) {
        if (nt < 3) {
#pragma unroll
            for (int ks = 0; ks < 8; ++ks) akn[ks] = *(const bf16x8*)(kbase + ((nt + 1) * 8 + ks) * 512);
        }
        __builtin_amdgcn_sched_barrier(0);
        f32x16 s;
#pragma unroll
        for (int e = 0; e < 16; ++e) s[e] = 0.f;
#pragma unroll
        for (int ks = 0; ks < 8; ++ks) s = mfma32(akc[ks], bq[ks], s);
        int N[16];
#pragma unroll
        for (int e = 0; e < 16; ++e) { const int n = nt * 32 + (e & 3) + 8 * (e >> 2) + 4 * hh; N[e] = (f2key(s[e]) & ~127) | n; }
        sort16_desc(N);
        if (nt == 0) {
#pragma unroll
            for (int e = 0; e < 16; ++e) T[e] = N[e];
        } else merge16_desc(T, N);
        __builtin_amdgcn_sched_barrier(0);
#pragma unroll
        for (int ks = 0; ks < 8; ++ks) akc[ks] = akn[ks];
    }
    int P[16];
#pragma unroll
    for (int j = 0; j < 16; ++j) P[j] = __shfl_xor(T[j], 32);
    merge16_desc(T, P);
}
__device__ __forceinline__ void peer_topk_head(const Ctx& C, const Args& a, int tokbase, int hp) {
    const int lane = C.lane, r = lane & 31, hh = lane >> 5;
    int T0[16], T1[16];
    peer_topk_half(a, tokbase, hp, 0, lane, T0);
    peer_topk_half(a, tokbase, hp, 1, lane, T1);
    int F[16], L1[16], L2[16], L3[16];
#pragma unroll
    for (int j = 0; j < 16; ++j) { L1[j] = (int)0x80000000; L2[j] = (int)0x80000000; L3[j] = (int)0x80000000; }
    {
        int cnt = 0;
#pragma unroll
        for (int i0 = 0; i0 < 16; ++i0)
#pragma unroll
            for (int i1 = 0; i1 < 16; ++i1)
                if ((i0 + 1) * (i1 + 1) <= 16) {
                    const float v = key2f(T0[i0] & ~127) + key2f(T1[i1] & ~127); const int key = (f2key(v) & ~255) | (i0 * 16 + i1);
                    if (i0 == 0) F[i1] = key;
                    else { if (cnt < 16) L1[cnt] = key; else if (cnt < 32) L2[cnt - 16] = key; else L3[cnt - 32] = key; ++cnt; }
                }
    }
    sort16_desc(L1); merge16_desc(F, L1); sort16_desc(L2); merge16_desc(F, L2); sort16_desc(L3); merge16_desc(F, L3);
    LAS int* tab = (LAS int*)(C.lds + C.wave * 16384);
#pragma unroll
    for (int j = 0; j < 16; ++j) { tab[j * 64 + lane] = T0[j] & 127; tab[(16 + j) * 64 + lane] = T1[j] & 127; }
    LDS_WAIT(); asm volatile("" ::: "memory");
    const float m = key2f(F[0] & ~255);
    float e[16], sum = 0.f;
#pragma unroll
    for (int j = 0; j < 16; ++j) { e[j] = __builtin_amdgcn_exp2f((key2f(F[j] & ~255) - m) * 1.4426950408889634f); sum += e[j]; }
    const float inv = 1.0f / sum;
    const int tok = tokbase + r;
    int* IDX = (int*)(a.ws + WS_IDX) + (size_t)tok * 128 + hp * 16; float* WGT = (float*)(a.ws + WS_WGT) + (size_t)tok * 128 + hp * 16;
    unsigned ov[16];
#pragma unroll
    for (int j = 0; j < 16; ++j) { const int id = F[j] & 255; const int k0 = tab[(id >> 4) * 64 + lane], k1 = tab[(16 + (id & 15)) * 64 + lane];
        ov[j] = (hh == 0) ? (unsigned)(k0 * 128 + k1) : __builtin_bit_cast(unsigned, e[j] * inv); }
    unsigned* obase = (hh == 0) ? (unsigned*)IDX : (unsigned*)WGT;
#pragma unroll
    for (int q = 0; q < 4; ++q) { v4u w = {ov[4 * q], ov[4 * q + 1], ov[4 * q + 2], ov[4 * q + 3]}; *(v4u*)(obase + 4 * q) = w; }
    LDS_WAIT(); asm volatile("" ::: "memory");
}
typedef float f32x2v __attribute__((ext_vector_type(2)));
__device__ __forceinline__ void unpack16(const v4u a, const v4u b, float (&x)[16]) {
    const unsigned w[8] = {a.x, a.y, a.z, a.w, b.x, b.y, b.z, b.w};
#pragma unroll
    for (int i = 0; i < 8; ++i) { x[2 * i] = bflo(w[i]); x[2 * i + 1] = bfhi(w[i]); }
}
__device__ __forceinline__ void unpack16_fp8(const v4u a, float (&x)[16]) {
    const unsigned w[4] = {a.x, a.y, a.z, a.w};
#pragma unroll
    for (int i = 0; i < 4; ++i) { const f32x2v lo = __builtin_amdgcn_cvt_pk_f32_fp8((int)w[i], false), hi = __builtin_amdgcn_cvt_pk_f32_fp8((int)w[i], true);
        x[4 * i] = lo.x; x[4 * i + 1] = lo.y; x[4 * i + 2] = hi.x; x[4 * i + 3] = hi.y; }
}
__device__ __forceinline__ long mk64(unsigned lo, unsigned hi) { return (long)(((unsigned long long)hi << 32) | (unsigned long long)lo); }
__device__ __forceinline__ float dpp_swap1(float v) { return __builtin_bit_cast(float, __builtin_amdgcn_update_dpp(0, __builtin_bit_cast(int, v), 0xB1, 0xf, 0xf, true)); }
struct PHalf { v4u g[8]; };
struct PIdx { int e[8]; };
__device__ __forceinline__ void pg_idx8(const int* IDXr, int h, int hl, PIdx& I) {
    h = min(h, hl); const int* p = IDXr + (size_t)(h >> 1) * 128 + (h & 1) * 64;
#pragma unroll
    for (int j = 0; j < 8; ++j) I.e[j] = p[j * 8];
}
__device__ __forceinline__ void pg_issue(const unsigned char* TBL, const PIdx& I, int lane, PHalf& D) {
    const unsigned c16 = (unsigned)(lane & 7) * 16u;
#pragma unroll
    for (int j = 0; j < 8; ++j) D.g[j] = *(const v4u*)(TBL + ((unsigned)I.e[j] * 128u + c16));
}
__device__ __forceinline__ void pg_stage(LAS unsigned char* buf, int lane, const PHalf& D) {
    const int row8 = lane >> 3, c8 = lane & 7;
#pragma unroll
    for (int j = 0; j < 8; ++j) *(LAS v4u*)(buf + (j * 8 + row8) * 128 + ((c8 ^ row8) & 7) * 16) = D.g[j];
}
__device__ __forceinline__ void pu_xprep(LAS unsigned char* xs, unsigned xw, int lane) {
    const float x0 = bflo(xw) * 16.f, x1 = bfhi(xw) * 16.f;
    const int hi = __builtin_amdgcn_cvt_pk_fp8_f32(x0, x1, 0, false);
    const f32x2v bk = __builtin_amdgcn_cvt_pk_f32_fp8(hi, false);
    const int lo = __builtin_amdgcn_cvt_pk_fp8_f32(x0 - bk.x, x1 - bk.y, 0, false);
    *(LAS unsigned short*)(xs + 2 * lane) = (unsigned short)hi; *(LAS unsigned short*)(xs + 128 + 2 * lane) = (unsigned short)lo;
}
typedef int v8i_t __attribute__((ext_vector_type(8)));
__device__ __forceinline__ void pu_compute(const LAS unsigned char* buf, bf16* HPt, int r, int kq, const v8i_t bfr) {
    f32x4 res[4];
#pragma unroll
    for (int g = 0; g < 4; ++g) {
        const int row = g * 16 + r, sw = row & 7;
        const v4u a0 = *(const LAS v4u*)(buf + row * 128 + ((2 * kq) ^ sw) * 16), a1 = *(const LAS v4u*)(buf + row * 128 + ((2 * kq + 1) ^ sw) * 16);
        const v8i_t av = {(int)a0.x, (int)a0.y, (int)a0.z, (int)a0.w, (int)a1.x, (int)a1.y, (int)a1.z, (int)a1.w};
        res[g] = __builtin_amdgcn_mfma_scale_f32_16x16x128_f8f6f4(av, bfr, (f32x4){0.f, 0.f, 0.f, 0.f}, 0, 0, 0, 0x7f7f7f7f, 0, 0x7f7f7f7f);
    }
    f32x4 o = res[0];
#pragma unroll
    for (int g = 1; g < 4; ++g) { const bool sel = ((r >> 1) == g);
#pragma unroll
        for (int i = 0; i < 4; ++i) o[i] = sel ? res[g][i] : o[i]; }
#pragma unroll
    for (int i = 0; i < 4; ++i) o[i] += dpp_swap1(o[i]);
    if (r < 8 && (r & 1) == 0) { v2u w; w.x = pk2(o[0], o[1]); w.y = pk2(o[2], o[3]); *(v2u*)(HPt + (r >> 1) * 16 + 4 * kq) = w; }
}
__device__ __forceinline__ int pg_idx(const int* IDXl, int h, int hl) { h = min(h, hl); return IDXl[(size_t)(h >> 1) * 128 + (h & 1) * 64]; }
__device__ __forceinline__ void peer_u_wave(const Args& a, LAS unsigned char* wlds, LAS unsigned char* wsm, int slab, int t0, int ntok, int lane) {
    const unsigned char* U8 = a.ws + WS_PU + (size_t)slab * (16384 * 128);
    const bf16* N2 = (const bf16*)(a.ws + WS_N2) + slab * 128 + 2 * lane;
    const int* IDX = (const int*)(a.ws + WS_IDX) + (lane >> 3);
    bf16* HP = (bf16*)(a.ws + WS_HPART) + (size_t)slab * MTOK * 128;
    const int r = lane & 15, kq = lane >> 4, tl = t0 + ntok - 1, H0 = 2 * t0, HL = 2 * (t0 + ntok) - 1;
    PHalf d[4]; PIdx iv[4]; v8i_t bfr;
#pragma unroll
    for (int k = 0; k < 4; ++k) pg_idx8(IDX, H0 + k, HL, iv[k]);
    unsigned xw = *(const unsigned*)(N2 + (size_t)t0 * DM);
    pg_issue(U8, iv[0], lane, d[0]); pg_issue(U8, iv[1], lane, d[1]); pg_issue(U8, iv[2], lane, d[2]);
    pg_idx8(IDX, H0 + 4, HL, iv[0]); pg_idx8(IDX, H0 + 5, HL, iv[1]); pg_idx8(IDX, H0 + 6, HL, iv[2]);
    pg_stage(wlds, lane, d[0]);
#define PU_XPREP(tok) do { pu_xprep(wsm, xw, lane); \
        { const LAS unsigned char* bp = wsm + ((r & 1) ? 128 : 0) + kq * 32; const v4u b0 = *(const LAS v4u*)bp, b1 = *(const LAS v4u*)(bp + 16); \
          bfr = (v8i_t){(int)b0.x, (int)b0.y, (int)b0.z, (int)b0.w, (int)b1.x, (int)b1.y, (int)b1.z, (int)b1.w}; } \
        xw = *(const unsigned*)(N2 + (size_t)min((tok) + 1, tl) * DM); } while (0)
#define PU_PHASE(ph, hrel, tok, half) do { \
        pg_issue(U8, iv[((ph) + 3) & 3], lane, d[((ph) + 3) & 3]); pg_idx8(IDX, hb + (hrel) + 7, HL, iv[((ph) + 3) & 3]); \
        pu_compute(wlds + ((half) ? 8192 : 0), HP + (size_t)(tok) * 128 + (half) * 64, r, kq, bfr); \
        pg_stage(wlds + ((half) ? 0 : 8192), lane, d[((ph) + 1) & 3]); } while (0)
#pragma unroll 1
    for (int hb = H0; hb <= HL; hb += 4) {
        const int t = hb >> 1;
        PU_XPREP(t);
        PU_PHASE(0, 0, t, 0);
        PU_PHASE(1, 1, t, 1);
        PU_XPREP(t + 1);
        PU_PHASE(2, 2, t + 1, 0);
        PU_PHASE(3, 3, t + 1, 1);
    }
#undef PU_XPREP
#undef PU_PHASE
}
__device__ __forceinline__ void peer_reduce(const Ctx& C, const Args& a) {
    const bf16* HP = (const bf16*)(a.ws + WS_HPART); const int* IDX = (const int*)(a.ws + WS_IDX); const float* WGT = (const float*)(a.ws + WS_WGT);
    const float* USC = (const float*)(a.ws + WS_PSC); const float* VSC = USC + 16384;
    unsigned char* ACT8 = a.ws + WS_ACT; float* ASC = (float*)(a.ws + WS_ACT + 8 * MiB);
    for (int it = C.vcu * 512 + C.tid; it < MTOK * 32; it += C.G * 512) {
        f32x4 h = {0.f, 0.f, 0.f, 0.f};
#pragma unroll
        for (int sl = 0; sl < 8; ++sl) { const v2u w = *(const v2u*)(HP + (size_t)sl * MTOK * 128 + (size_t)it * 4); h[0] += bflo(w.x); h[1] += bfhi(w.x); h[2] += bflo(w.y); h[3] += bfhi(w.y); }
        const int4 e = *(const int4*)(IDX + (size_t)it * 4); const f32x4 w = *(const f32x4*)(WGT + (size_t)it * 4);
        const int tok = it >> 5, q = it & 31;
        const float rs = 0.0625f * __builtin_amdgcn_rsqf(((const float*)(a.ws + WS_SS))[tok] * (1.f / DM) + EPS);
        f32x4 o;
        o[0] = gelu_tanh(h[0] * USC[e.x] * rs) * w[0] * VSC[e.x]; o[1] = gelu_tanh(h[1] * USC[e.y] * rs) * w[1] * VSC[e.y];
        o[2] = gelu_tanh(h[2] * USC[e.z] * rs) * w[2] * VSC[e.z]; o[3] = gelu_tanh(h[3] * USC[e.w] * rs) * w[3] * VSC[e.w];
        float mx = fmaxf(fmaxf(fabsf(o[0]), fabsf(o[1])), fmaxf(fabsf(o[2]), fabsf(o[3])));
#pragma unroll
        for (int sh = 1; sh < 32; sh <<= 1) mx = fmaxf(mx, __shfl_xor(mx, sh));
        int ex = (int)((__builtin_bit_cast(unsigned, mx) >> 23) & 0xffu) - 127; if (mx < 1e-30f) ex = 7;
        const float sc = __builtin_bit_cast(float, (unsigned)(127 + 7 - ex) << 23), isc = __builtin_bit_cast(float, (unsigned)(127 - 7 + ex) << 23);
        o = o * sc;
        int hi = __builtin_amdgcn_cvt_pk_fp8_f32(o[0], o[1], 0, false); hi = __builtin_amdgcn_cvt_pk_fp8_f32(o[2], o[3], hi, true);
        const f32x2v b0 = __builtin_amdgcn_cvt_pk_f32_fp8(hi, false), b1 = __builtin_amdgcn_cvt_pk_f32_fp8(hi, true);
        int lo = __builtin_amdgcn_cvt_pk_fp8_f32(o[0] - b0.x, o[1] - b0.y, 0, false); lo = __builtin_amdgcn_cvt_pk_fp8_f32(o[2] - b1.x, o[3] - b1.y, lo, true);
        *(unsigned*)(ACT8 + (size_t)tok * 256 + 4 * q) = (unsigned)hi; *(unsigned*)(ACT8 + (size_t)tok * 256 + 128 + 4 * q) = (unsigned)lo;
        if (q == 0) ASC[tok] = isc;
    }
}
typedef int v2i_t __attribute__((ext_vector_type(2)));
__device__ __forceinline__ void pv_compute(const LAS unsigned char* buf, int lane, const long* bact2, f32x4 (&acc)[8]) {
    const int i16 = lane & 15, kq = lane >> 4, rr = i16 >> 1, cc = i16 & 1;
#pragma unroll
    for (int s2 = 0; s2 < 2; ++s2) {
        const int row = 32 * s2 + 8 * kq + rr, sw = row & 7;
#pragma unroll
        for (int nb = 0; nb < 8; ++nb) {
            const v2i_t av = __builtin_amdgcn_ds_read_tr8_b64_v2i32((LAS v2i_t*)(buf + row * 128 + ((nb ^ sw) & 7) * 16 + 8 * cc));
            acc[nb] = __builtin_amdgcn_mfma_f32_16x16x32_fp8_fp8(mk64((unsigned)av.x, (unsigned)av.y), bact2[s2], acc[nb], 0, 0, 0);
        }
    }
}
__device__ __forceinline__ void peer_v_wave(const Args& a, LAS unsigned char* wlds, int slab, int t0, int ntok, int lane) {
    const unsigned char* V8 = a.ws + WS_PV + (size_t)slab * (16384 * 128);
    const int* IDX = (const int*)(a.ws + WS_IDX) + (lane >> 3);
    const int n16 = lane & 15, kq = lane >> 4, tl = t0 + ntok - 1, H0 = 2 * t0, HL = 2 * (t0 + ntok) - 1;
    const unsigned char* ACT8 = a.ws + WS_ACT + ((n16 & 1) ? 128 : 0) + 8 * kq; const float* ASC = (const float*)(a.ws + WS_ACT + 8 * MiB);
    bf16* PO = (bf16*)(a.ws + WS_POUT) + slab * 128;
    PHalf d[4]; PIdx iv[4]; long bact[4], bnxt[4]; f32x4 acc[8]; float isc = 1.f, iscn;
#pragma unroll
    for (int k = 0; k < 4; ++k) pg_idx8(IDX, H0 + k, HL, iv[k]);
#pragma unroll
    for (int s4 = 0; s4 < 4; ++s4) bnxt[s4] = *(const long*)(ACT8 + (size_t)t0 * 256 + 32 * s4);
    iscn = ASC[t0];
    pg_issue(V8, iv[0], lane, d[0]); pg_issue(V8, iv[1], lane, d[1]); pg_issue(V8, iv[2], lane, d[2]);
    pg_idx8(IDX, H0 + 4, HL, iv[0]); pg_idx8(IDX, H0 + 5, HL, iv[1]); pg_idx8(IDX, H0 + 6, HL, iv[2]);
    pg_stage(wlds, lane, d[0]);
#define PV_APREP(tok) do { \
        _Pragma("unroll") for (int s4 = 0; s4 < 4; ++s4) bact[s4] = bnxt[s4]; isc = iscn; \
        { const int tn = min((tok) + 1, tl); \
          _Pragma("unroll") for (int s4 = 0; s4 < 4; ++s4) bnxt[s4] = *(const long*)(ACT8 + (size_t)tn * 256 + 32 * s4); iscn = ASC[tn]; } \
        _Pragma("unroll") for (int nb = 0; nb < 8; ++nb) acc[nb] = (f32x4){0.f, 0.f, 0.f, 0.f}; } while (0)
#define PV_PHASE(ph, hrel, half) do { \
        pg_issue(V8, iv[((ph) + 3) & 3], lane, d[((ph) + 3) & 3]); pg_idx8(IDX, hb + (hrel) + 7, HL, iv[((ph) + 3) & 3]); \
        pv_compute(wlds + ((half) ? 8192 : 0), lane, bact + 2 * (half), acc); \
        pg_stage(wlds + ((half) ? 0 : 8192), lane, d[((ph) + 1) & 3]); } while (0)
#define PV_EPI(tok) do { f32x4 o = acc[0]; \
        _Pragma("unroll") for (int nb = 1; nb < 8; ++nb) { const bool sel = ((n16 >> 1) == nb); \
            _Pragma("unroll") for (int i = 0; i < 4; ++i) o[i] = sel ? acc[nb][i] : o[i]; } \
        _Pragma("unroll") for (int i = 0; i < 4; ++i) o[i] += dpp_swap1(o[i]); \
        if ((n16 & 1) == 0) { v2u w; w.x = pk2(o[0] * isc, o[1] * isc); w.y = pk2(o[2] * isc, o[3] * isc); *(v2u*)(PO + (size_t)(tok) * DM + 16 * (n16 >> 1) + 4 * kq) = w; } } while (0)
#pragma unroll 1
    for (int hb = H0; hb <= HL; hb += 4) {
        const int t = hb >> 1;
        PV_APREP(t);
        PV_PHASE(0, 0, 0);
        PV_PHASE(1, 1, 1);
        PV_EPI(t);
        PV_APREP(t + 1);
        PV_PHASE(2, 2, 0);
        PV_PHASE(3, 3, 1);
        PV_EPI(t + 1);
    }
#undef PV_APREP
#undef PV_PHASE
#undef PV_EPI
}
__device__ __forceinline__ void final_rows4(const Args& a, int tok0, int tstep, int lane) {
    const float* gf = (const float*)a.in[25] + lane * 4;
    f32x4 h[4][4]; v2u pw[4][4], hw[4][4]; float ss[4];
#pragma unroll
    for (int i = 0; i < 4; ++i) { const int tok = tok0 + i * tstep; const bf16* hb = (const bf16*)(a.ws + WS_N2) + (size_t)tok * DM + lane * 4; const bf16* po = (const bf16*)(a.ws + WS_POUT) + (size_t)tok * DM + lane * 4;
#pragma unroll
        for (int q = 0; q < 4; ++q) { hw[i][q] = *(const v2u*)(hb + 256 * q); pw[i][q] = *(const v2u*)(po + 256 * q); } }
#pragma unroll
    for (int i = 0; i < 4; ++i) { ss[i] = 0.f;
#pragma unroll
        for (int q = 0; q < 4; ++q) { h[i][q][0] = bflo(hw[i][q].x) + bflo(pw[i][q].x); h[i][q][1] = bfhi(hw[i][q].x) + bfhi(pw[i][q].x); h[i][q][2] = bflo(hw[i][q].y) + bflo(pw[i][q].y); h[i][q][3] = bfhi(hw[i][q].y) + bfhi(pw[i][q].y);
            ss[i] += (h[i][q][0] * h[i][q][0] + h[i][q][1] * h[i][q][1]) + (h[i][q][2] * h[i][q][2] + h[i][q][3] * h[i][q][3]); } }
#pragma unroll
    for (int o = 1; o < 64; o <<= 1)
#pragma unroll
        for (int i = 0; i < 4; ++i) ss[i] += __shfl_xor(ss[i], o);
    f32x4 g[4];
#pragma unroll
    for (int q = 0; q < 4; ++q) g[q] = *(const f32x4*)(gf + 256 * q);
#pragma unroll
    for (int i = 0; i < 4; ++i) { const float rstd = 1.0f / sqrtf(ss[i] * (1.f / DM) + EPS); float* orow = a.out + (size_t)(tok0 + i * tstep) * DM + lane * 4;
#pragma unroll
        for (int q = 0; q < 4; ++q) *(f32x4*)(orow + 256 * q) = h[i][q] * rstd * g[q]; }
}

__device__ __forceinline__ void claim_slab_unit(const Ctx& C, unsigned* ctl, int pass, volatile LAS unsigned* MISC, int& slab, int& unit) {
    if (C.tid == 0) {
        const unsigned x = xb_xcc_id() & 7u; unsigned sl = 8u, un = 0u;
        for (unsigned k = 0; k < 8u; ++k) { const unsigned s2 = (x + k) & 7u; const unsigned u2 = xb_add(ctl + CW_Q + 1024 * pass + 64 * s2, 1u); if (u2 < 32u) { sl = s2; un = u2; break; } }
        MISC[16] = sl; MISC[17] = un;
    }
    __syncthreads();
    slab = (int)MISC[16]; unit = (int)MISC[17];
    __syncthreads();
}
__global__ void __launch_bounds__(NWAVES * 64, 2) mk_fwd(Args args) {
    extern __shared__ __attribute__((aligned(16))) unsigned char lds_raw[];
    Ctx C;
    C.lds = (LAS unsigned char*)lds_raw;
    C.wave = __builtin_amdgcn_readfirstlane((int)threadIdx.x >> 6); C.refresh();
    C.G = gridDim.x; { const int bx = blockIdx.x; C.vcu = (C.G % 8 == 0) ? (bx % 8) * (C.G / 8) + bx / 8 : bx; }
    volatile LAS unsigned* MISC = (volatile LAS unsigned*)(C.lds + MISC_OFF);
    if (C.tid < 128) MISC[C.tid] = 0u;
    __syncthreads();
    unsigned char* ws = args.ws;
    unsigned* ctl = (unsigned*)(ws + WS_CTL);
    XcdBarrier bar; bar.bar = ctl + CW_BAR; bar.x = 0; bar.st = nullptr;
#if !MK_PER_PHASE
    bar = xcd_barrier_post(ctl + CW_BAR, MISC + 8, C.tid == 0);
#define GRID_BAR() xcd_barrier(bar, C.wave)
#else
#define GRID_BAR() do { } while (0)
#endif
    const int lo = args.ph_lo, hi = args.ph_hi;
#define IN(k) (lo <= (k) && (k) < hi)
#define SEAM(k) do { if (IN((k) + 1)) GRID_BAR(); C.refresh(); } while (0)
#define REP(k) for (int rep_ = 0; rep_ < 1 + ((REPEAT_MASK >> (k)) & 1); ++rep_)
    bf16* XN = (bf16*)(ws + WS_A);
    if (IN(0)) { REP(0) { p0_prologue(C, args); __syncthreads(); } SEAM(0); }
    if (IN(1)) {
        REP(1) {
        run_gemm(C, XN, (const bf16*)(ws + WS_WIN_T), MTOK, NZ1, DM, FStore{(bf16*)(ws + WS_Z1), NZ1});
        }
        SEAM(1);
    }
    if (IN(2)) {
        REP(2) { const int tile = C.vcu;
            {
                const int i_ = C.tid >> 2, dq_ = (C.tid & 3) * 16, eq_ = (C.tid & 3) * 32;
                const bf16* zr_ = (const bf16*)(ws + WS_Z1) + (size_t)(tile * 128 + i_) * NZ1; const float* rp_ = (const float*)(ws + WS_ROPE) + (size_t)(tile * 128 + i_) * 128;
                float cs_[16], sn_[16];
#pragma unroll
                for (int q = 0; q < 4; ++q) { const f32x4 c4 = *(const f32x4*)(rp_ + dq_ + 4 * q), s4 = *(const f32x4*)(rp_ + 64 + dq_ + 4 * q);
#pragma unroll
                    for (int e = 0; e < 4; ++e) { cs_[4 * q + e] = c4[e]; sn_[4 * q + e] = s4[e]; } }
                R1In ra_, rb_;
                r1_load(zr_, 0, dq_, eq_, ra_);
                _Pragma("unroll 1") for (int h2 = 0; h2 < 4; h2 += 2) {
                    r1_unit(C, args, tile, h2, cs_, sn_, ra_, rb_, true);
                    r1_unit(C, args, tile, h2 + 1, cs_, sn_, rb_, ra_, h2 == 0);
                }
            }
            C.refresh();
            _Pragma("unroll 1") for (int gi = 0; gi < 2; ++gi) s5a_wave(C, args, tile, C.wave + 8 * gi);
            __syncthreads();
        }
        SEAM(2);
    }
    if (IN(3)) { REP(3) { p3_scans(C, args); }
        run_gemm(C, (const bf16*)(ws + WS_MEMN), (const bf16*)(ws + WS_WMKV_T), MROWS, 512, DM, FKvm{(bf16*)(ws + WS_KM), (bf16*)(ws + WS_VT)});
        SEAM(3); }
    if (IN(4)) {
        REP(4) { const int tile = C.vcu;
            _Pragma("unroll 1") for (int gi = 0; gi < 2; ++gi) r3_wave(C, args, tile, 2 * gi + (C.wave >> 2), C.wave & 3);
            _Pragma("unroll 1") for (int gi = 0; gi < 2; ++gi) s5c_wave(C, args, tile, C.wave + 8 * gi);
            _Pragma("unroll 1") for (int gi = 0; gi < 2; ++gi) ma_wave(C, args, tile, 2 * gi + (C.wave >> 2), C.wave & 3);
        }
        SEAM(4);
    }
    if (IN(5)) {
        REP(5) {
        run_gemm_mx(C, ws + WS_XN8, ws + WS_WG8, MTOK, NGATE, DM, FSig{(bf16*)(ws + WS_G), NGATE}, 0x7b7b7b7b  , 0x77777777  );
        run_gemm(C, (const bf16*)(ws + WS_YG), (const bf16*)(ws + WS_WGLU_T), MTOK, 512, 256, FGlu{(bf16*)(ws + WS_YCAT)});
        }
        SEAM(5);
    }
    if (IN(6)) {
        const bf16* Gt = (const bf16*)(ws + WS_G);
        run_gemm_hook(C, (const bf16*)(ws + WS_YCAT), (const bf16*)(ws + WS_WCAT_T), MTOK, DM, DM, FGateOut{Gt, XN}, HookGate{Gt});
        SEAM(6);
    }
    if (IN(7)) { run_gemm(C, XN, (const bf16*)(ws + WS_WOUT_T), MTOK, DM, DM, FRes{(const float*)args.in[0], (bf16*)(ws + WS_N2), (float*)(ws + WS_SS)}); SEAM(7); }
    if (IN(9)) { REP(9) run_gemm(C, (const bf16*)(ws + WS_N2), (const bf16*)(ws + WS_WQ_T), MTOK, 2048, DM, FStoreRstd{(bf16*)(ws + WS_Q2), 2048, (const float*)(ws + WS_SS)}); SEAM(9); }
    if (IN(10)) {
        { const int tile = C.vcu;
            const int tokbase = tile * 128 + (C.wave & 3) * 32, h0 = (C.wave >> 2) * 4;
            REP(10) { _Pragma("unroll 1") for (int hp = h0; hp < h0 + 4; ++hp) peer_topk_head(C, args, tokbase, hp); }
        }
        SEAM(10);
    }
    if (IN(11)) { int slab, unit; claim_slab_unit(C, ctl, 0, MISC, slab, unit); if (slab < 8) { REP(11) peer_u_wave(args, C.lds + C.wave * 16384, C.lds + 131072 + C.wave * 1024, slab, unit * 1024 + C.wave * 128, 128, C.lane); } SEAM(11); }
    if (IN(12)) { REP(12) peer_reduce(C, args); SEAM(12); }
    if (IN(13)) { int slab, unit; claim_slab_unit(C, ctl, 1, MISC, slab, unit); if (slab < 8) { REP(13) peer_v_wave(args, C.lds + C.wave * 16384, slab, unit * 1024 + C.wave * 128, 128, C.lane); } SEAM(13); }
    if (IN(14)) {
        const int gw = C.vcu * NWAVES + C.wave, NGW = C.G * NWAVES;
        for (int m = gw; m < MTOK; m += 4 * NGW) final_rows4(args, m, NGW, C.lane);
    }
#undef IN
#undef SEAM
}

extern "C" void kernel_launch(void* const* d_in, const int* in_sizes, int n_in, void* d_out, int out_size, void* d_ws, size_t ws_size, hipStream_t stream) {
    static int grid = 0;
    if (grid == 0) {
        if (n_in != 26 || in_sizes[0] != MTOK * DM || out_size != MTOK * DM || ws_size < WS_END) {
            fprintf(stderr, "kernel_launch: unexpected problem (n_in %d, in0 %d, out %d, ws %zu < %zu); nothing launched\n", n_in, n_in > 0 ? in_sizes[0] : -1, out_size, ws_size, (size_t)WS_END); grid = -1; return; }
        int dev = 0, cus = 0;
        if (hipGetDevice(&dev) != hipSuccess || hipDeviceGetAttribute(&cus, hipDeviceAttributeMultiprocessorCount, dev) != hipSuccess) { grid = -1; return; }
        if (hipFuncSetAttribute((const void*)mk_fwd, hipFuncAttributeMaxDynamicSharedMemorySize, LDS_BYTES) != hipSuccess) { fprintf(stderr, "kernel_launch: hipFuncSetAttribute failed\n"); grid = -1; return; }
        (void)hipGetLastError();
        if (cus < NTILES) { fprintf(stderr, "kernel_launch: needs >= 256 CUs, got %d\n", cus); grid = -1; return; }
        grid = NTILES;
    }
    if (grid < 0) return;
    (void)hipMemsetAsync((char*)d_ws + WS_CTL, 0, CTL_ZERO_BYTES, stream);
    Args a{};
    for (int i = 0; i < 26; ++i) a.in[i] = d_in[i];
    a.out = (float*)d_out; a.ws = (unsigned char*)d_ws;
#if MK_PER_PHASE
    for (int p = 0; p < NPHASE; ++p) { a.ph_lo = p; a.ph_hi = p + 1; hipLaunchKernelGGL(mk_fwd, dim3(grid), dim3(NWAVES * 64), LDS_BYTES, stream, a); }
#else
    a.ph_lo = 0; a.ph_hi = NPHASE;
    hipLaunchKernelGGL(mk_fwd, dim3(grid), dim3(NWAVES * 64), LDS_BYTES, stream, a);
#endif
}
```

```cpp
#include <hip/hip_runtime.h>
#include <cstdio>
#include <cstdint>
namespace pg8 {
__device__ __forceinline__ int hw_lane_id() { int l; asm volatile("v_mbcnt_lo_u32_b32 %0, -1, 0\n\tv_mbcnt_hi_u32_b32 %0, -1, %0" : "=v"(l)); return l; }
#define PG8_LAS __attribute__((address_space(3)))
typedef unsigned short bf16_t;
typedef short bf16x8 __attribute__((ext_vector_type(8)));
typedef float f32x4 __attribute__((ext_vector_type(4)));
typedef unsigned u32x4 __attribute__((ext_vector_type(4)));
constexpr int BM = 256, BK = 64, HALF = 128, HTB = HALF * BK * 2  , STAGE_BYTES = 8 * HTB, NXCD = 8, WGM = 8;

__host__ __device__ __forceinline__ int lds_byte(int r, int c) { const int st = (r >> 4) * 2 + (c >> 5), rr = r & 15, cc = c & 31, ob = rr * 64 + cc * 2; return st * 1024 + (ob ^ (((ob >> 9) & 1) << 5)); }
__host__ __device__ __forceinline__ void stage_rc(int b, int& R, int& C) { const int st = b / 1024, sb = b % 1024, swz = sb ^ (((sb >> 9) & 1) << 5); R = (st >> 1) * 16 + swz / 64; C = (st & 1) * 32 + (swz % 64) / 2; }
__host__ __device__ __forceinline__ int perm32(int rho) { const int n = rho >> 4, i = rho & 15; return 8 * (i >> 2) + 4 * n + (i & 3); }

struct Unit { int pm, pn; };
struct Gemm { const bf16_t* A; const bf16_t* Bt; int M, N, K; };

struct StaticOrder {
    int nM, nN, nwg, G, c;
    __host__ __device__ void init(int M, int N, int G_, int c_) { nM = M / BM; nN = N / BM; nwg = nM * nN; G = G_; c = c_; }
    __host__ __device__ bool next(int i, Unit& u) const {
        const long L = (long)i * G + c; if (L >= nwg) return false;
        int wgid = (int)L; { const int q = nwg / NXCD, r = nwg % NXCD, xcd = wgid % NXCD, off = wgid / NXCD; wgid = (xcd < r ? xcd * (q + 1) : r * (q + 1) + (xcd - r) * q) + off; }
        const int nig = WGM * nN, gid = wgid / nig, fm = gid * WGM, gsz = (nM - fm) < WGM ? (nM - fm) : WGM;
        u.pm = fm + ((wgid % nig) % gsz); u.pn = (wgid % nig) / gsz; return true;
    }
    __device__ __forceinline__ void a_ready(const Unit&) const {}
    __device__ __forceinline__ void done(const Unit&) const {}
};

__device__ __forceinline__ unsigned cvt_pk_bf16(float lo, float hi) { unsigned r; asm volatile("v_cvt_pk_bf16_f32 %0, %1, %2" : "=v"(r) : "v"(lo), "v"(hi)); return r; }
struct NoKHook { __device__ __forceinline__ void operator()(int, f32x4 (&)[2][2][4][2], const Unit&, int, int, int, int) const {} };
template <class Epi, class Sched, bool ALIGN_EPI = false, bool SP2 = false, bool MX = false, class KHook = NoKHook>
__device__ __forceinline__ void gemm_phase(PG8_LAS unsigned char* lds, const Gemm g, const Sched& S, const Epi& E, const int wid, const int sclA = 0x7f7f7f7f, const int sclB = 0x7f7f7f7f, const KHook& KH = KHook()) {
    const int lane = hw_lane_id(), tid = wid * 64 + lane, wr = wid >> 2, wc = wid & 3, fr = lane & 15, fq = lane >> 4;
    const int K = g.K, nt = K / BK;
    unsigned voffA[2], voffB[2];
#pragma unroll
    for (int i = 0; i < 2; ++i) { int R, C; stage_rc(tid * 16 + i * 8192, R, C); const int Rb = Epi::PERM ? ((R & ~31) + perm32(R & 31)) : R;
        voffA[i] = (unsigned)(R * K + C) * 2u; voffB[i] = (unsigned)(Rb * K + C) * 2u; }
    const size_t kstep = (size_t)(BK * 2);
    const size_t hstep = (size_t)HALF * K * 2;
    const size_t tstep = 2 * hstep;
    const unsigned ldsw = (unsigned)wid * 1024u;
    const int aoff = lds_byte(wr * 64 + fr, fq * 8), boff = lds_byte(wc * 32 + fr, fq * 8);
#define PG8_SA(b, h) (((b) * 2 + (h)) * HTB)
#define PG8_SB(b, h) ((4 + (b) * 2 + (h)) * HTB)
#define PG8_STAGE(bufoff, gbase, voff) do { _Pragma("unroll") for (int _i = 0; _i < 2; ++_i) \
        __builtin_amdgcn_global_load_lds((const unsigned*)((const char*)(gbase) + (voff)[_i]), (PG8_LAS unsigned*)(lds + (bufoff) + ldsw + _i * 8192), 16, 0, 0); } while (0)
#define PG8_LDA(dst, b, h) do { _Pragma("unroll") for (int m = 0; m < 4; ++m) { \
        if constexpr (MX) { dst##8[m].lo = *(const PG8_LAS v4i_*)(lds + PG8_SA(b, h) + aoff + m * 2048); dst##8[m].hi = *(const PG8_LAS v4i_*)(lds + PG8_SA(b, h) + aoff + m * 2048 + 1024); } \
        else { _Pragma("unroll") for (int k = 0; k < 2; ++k) dst[m][k] = *(const PG8_LAS bf16x8*)(lds + PG8_SA(b, h) + aoff + m * 2048 + k * 1024); } } } while (0)
#define PG8_LDB(dst, b, h) do { _Pragma("unroll") for (int n = 0; n < 2; ++n) { \
        if constexpr (MX) { dst##8[n].lo = *(const PG8_LAS v4i_*)(lds + PG8_SB(b, h) + boff + n * 2048); dst##8[n].hi = *(const PG8_LAS v4i_*)(lds + PG8_SB(b, h) + boff + n * 2048 + 1024); } \
        else { _Pragma("unroll") for (int k = 0; k < 2; ++k) dst[n][k] = *(const PG8_LAS bf16x8*)(lds + PG8_SB(b, h) + boff + n * 2048 + k * 1024); } } } while (0)
#define PG8_MMA(ai, bj, At, Bt) do { __builtin_amdgcn_s_setprio(1); _Pragma("unroll") for (int m = 0; m < 4; ++m) _Pragma("unroll") for (int n = 0; n < 2; ++n) { \
        if constexpr (MX) acc[ai][bj][m][n] = __builtin_amdgcn_mfma_scale_f32_16x16x128_f8f6f4(Bt##8[n], At##8[m], acc[ai][bj][m][n], 0, 0, 0, sclB, 0, sclA); \
        else { _Pragma("unroll") for (int k = 0; k < 2; ++k) acc[ai][bj][m][n] = __builtin_amdgcn_mfma_f32_16x16x32_bf16(Bt[n][k], At[m][k], acc[ai][bj][m][n], 0, 0, 0); } } \
        if constexpr (MX) { _Pragma("unroll") for (int m = 0; m < 4; ++m) _Pragma("unroll") for (int n = 0; n < 2; ++n) asm volatile("" : "+v"(acc[ai][bj][m][n])); }     \
        __builtin_amdgcn_s_setprio(0); } while (0)
#define PG8_WAIT_V(n) asm volatile("s_waitcnt vmcnt(" #n ")" ::: "memory")
#define PG8_WAIT_L(n) asm volatile("s_waitcnt lgkmcnt(" #n ")" ::: "memory")
#define PG8_BAR __builtin_amdgcn_s_barrier()
#define PG8_SCHED __builtin_amdgcn_sched_barrier(0)
    Unit cur, nxt; int ui = 0;
    if (!S.next(0, cur)) return;
    f32x4 acc[2][2][4][2];
#pragma unroll
    for (int a = 0; a < 2; ++a)
#pragma unroll
        for (int b = 0; b < 2; ++b)
#pragma unroll
            for (int m = 0; m < 4; ++m)
#pragma unroll
                for (int n = 0; n < 2; ++n) acc[a][b][m][n] = (f32x4){0.f, 0.f, 0.f, 0.f};
    typedef int v8i_ __attribute__((ext_vector_type(8))); typedef int v4i_ __attribute__((ext_vector_type(4)));
    bf16x8 At[4][2], B0[2][2], B1[2][2]; v8i_ At8[4], B08[2], B18[2];
    const char* cA = (const char*)g.A + (size_t)cur.pm * tstep; const char* cB = (const char*)g.Bt + (size_t)cur.pn * tstep;
    S.a_ready(cur);
    if constexpr (SP2) {
        PG8_STAGE(PG8_SB(0, 0), cB, voffB); PG8_STAGE(PG8_SB(0, 1), cB + hstep, voffB); PG8_STAGE(PG8_SA(0, 0), cA, voffA); PG8_STAGE(PG8_SA(0, 1), cA + hstep, voffA);
        if (wr == 1) PG8_BAR;
        PG8_WAIT_V(2); PG8_BAR;
        PG8_STAGE(PG8_SB(1, 0), cB + kstep, voffB); PG8_STAGE(PG8_SA(1, 0), cA + kstep, voffA); PG8_STAGE(PG8_SB(1, 1), cB + hstep + kstep, voffB);
        PG8_WAIT_V(6); PG8_BAR;
    } else {
        PG8_STAGE(PG8_SB(0, 0), cB, voffB); PG8_STAGE(PG8_SA(0, 0), cA, voffA); PG8_STAGE(PG8_SB(0, 1), cB + hstep, voffB); PG8_STAGE(PG8_SA(0, 1), cA + hstep, voffA);
        if (wr == 1) PG8_BAR;
        PG8_WAIT_V(4); PG8_BAR;
        PG8_STAGE(PG8_SB(1, 0), cB + kstep, voffB); PG8_STAGE(PG8_SA(1, 0), cA + kstep, voffA); PG8_STAGE(PG8_SB(1, 1), cB + hstep + kstep, voffB);
        PG8_WAIT_V(6); PG8_BAR;
    }
    for (;;) {
        const bool has_next = S.next(ui + 1, nxt);
        const char* nA = has_next ? (const char*)g.A + (size_t)nxt.pm * tstep : cA; const char* nB = has_next ? (const char*)g.Bt + (size_t)nxt.pn * tstep : cB;
        for (int t = 0; t < nt; t += 2) {
            KH(t, acc, cur, wr, wc, fr, fq);
            const bool last = (t == nt - 2);
            const char* a1 = cA + (size_t)(t + 1) * kstep;
            const char* a2 = last ? nA : cA + (size_t)(t + 2) * kstep; const char* b2 = last ? nB : cB + (size_t)(t + 2) * kstep;
            const char* a3 = a2 + kstep; const char* b3 = b2 + kstep;
            if (last && has_next) S.a_ready(nxt);
            if constexpr (SP2) {
            PG8_LDB(B0, 0, 0); PG8_LDB(B1, 0, 1); PG8_SCHED; PG8_LDA(At, 0, 0); PG8_STAGE(PG8_SA(1, 1), a1 + hstep, voffA);
            PG8_WAIT_V(8); PG8_WAIT_L(0); PG8_BAR; PG8_MMA(0, 0, At, B0); PG8_MMA(0, 1, At, B1); PG8_BAR; PG8_SCHED;
            PG8_LDA(At, 0, 1); PG8_STAGE(PG8_SB(0, 0), b2, voffB); PG8_STAGE(PG8_SB(0, 1), b2 + hstep, voffB); PG8_STAGE(PG8_SA(0, 0), a2, voffA);
            PG8_WAIT_V(8); PG8_WAIT_L(0); PG8_BAR; PG8_MMA(1, 0, At, B0); PG8_MMA(1, 1, At, B1); PG8_BAR; PG8_SCHED;
            PG8_LDB(B0, 1, 0); PG8_LDB(B1, 1, 1); PG8_SCHED; PG8_LDA(At, 1, 0); PG8_STAGE(PG8_SA(0, 1), a2 + hstep, voffA);
            PG8_WAIT_V(8); PG8_WAIT_L(0); PG8_BAR; PG8_MMA(0, 0, At, B0); PG8_MMA(0, 1, At, B1); PG8_BAR; PG8_SCHED;
            PG8_LDA(At, 1, 1); PG8_STAGE(PG8_SB(1, 0), b3, voffB); PG8_STAGE(PG8_SB(1, 1), b3 + hstep, voffB); PG8_STAGE(PG8_SA(1, 0), a3, voffA);
            PG8_WAIT_V(8); PG8_WAIT_L(0); PG8_BAR; PG8_MMA(1, 0, At, B0); PG8_MMA(1, 1, At, B1); PG8_BAR; PG8_SCHED;
            } else {
            PG8_LDB(B0, 0, 0); PG8_SCHED; PG8_LDA(At, 0, 0); PG8_STAGE(PG8_SA(1, 1), a1 + hstep, voffA);
            PG8_WAIT_L(8); PG8_BAR; PG8_WAIT_L(0); PG8_MMA(0, 0, At, B0); PG8_BAR; PG8_SCHED;
            PG8_LDB(B1, 0, 1); PG8_STAGE(PG8_SB(0, 0), b2, voffB);
            PG8_BAR; PG8_WAIT_L(0); PG8_MMA(0, 1, At, B1); PG8_BAR;
            PG8_LDA(At, 0, 1); PG8_STAGE(PG8_SA(0, 0), a2, voffA);
            PG8_BAR; PG8_WAIT_L(0); PG8_MMA(1, 0, At, B0); PG8_BAR; PG8_SCHED;
            PG8_STAGE(PG8_SB(0, 1), b2 + hstep, voffB);
            PG8_WAIT_V(6); PG8_BAR; PG8_MMA(1, 1, At, B1); PG8_BAR;
            PG8_LDB(B0, 1, 0); PG8_SCHED; PG8_LDA(At, 1, 0); PG8_STAGE(PG8_SA(0, 1), a2 + hstep, voffA);
            PG8_WAIT_L(8); PG8_BAR; PG8_WAIT_L(0); PG8_MMA(0, 0, At, B0); PG8_BAR; PG8_SCHED;
            PG8_LDB(B1, 1, 1); PG8_STAGE(PG8_SB(1, 0), b3, voffB);
            PG8_BAR; PG8_WAIT_L(0); PG8_MMA(0, 1, At, B1); PG8_BAR;
            PG8_LDA(At, 1, 1); PG8_STAGE(PG8_SA(1, 0), a3, voffA);
            PG8_BAR; PG8_WAIT_L(0); PG8_MMA(1, 0, At, B0); PG8_BAR; PG8_SCHED;
            PG8_STAGE(PG8_SB(1, 1), b3 + hstep, voffB);
            PG8_WAIT_V(6); PG8_BAR; PG8_MMA(1, 1, At, B1); PG8_BAR;
            }
        }
        if constexpr (ALIGN_EPI) { if (wr == 0) PG8_BAR; }
        if constexpr (!Epi::AFTER_DRAIN) { E(acc, cur, wr, wc, fr, fq); S.done(cur); }
        if (!has_next) break;
#pragma unroll
        for (int a = 0; a < 2; ++a)
#pragma unroll
            for (int b = 0; b < 2; ++b)
#pragma unroll
                for (int m = 0; m < 4; ++m)
#pragma unroll
                    for (int n = 0; n < 2; ++n) acc[a][b][m][n] = (f32x4){0.f, 0.f, 0.f, 0.f};
        cur = nxt; cA = nA; cB = nB; ++ui;
        if constexpr (ALIGN_EPI) { if (wr == 1) PG8_BAR; }
    }
    PG8_WAIT_V(0);
    if constexpr (!ALIGN_EPI) { if (wr == 0) PG8_BAR; }
    PG8_BAR;
    if constexpr (Epi::AFTER_DRAIN) { E.fused(acc, cur, wr, wc, fr, fq, lds, wid, lane); S.done(cur); }
#undef PG8_SA
#undef PG8_SB
#undef PG8_STAGE
#undef PG8_LDA
#undef PG8_LDB
#undef PG8_MMA
#undef PG8_WAIT_V
#undef PG8_WAIT_L
#undef PG8_BAR
#undef PG8_SCHED
}
}

#ifndef REPEAT_MASK
#define REPEAT_MASK 0
#endif
#ifndef MK_PER_PHASE
#define MK_PER_PHASE 0
#endif

constexpr int DM = 1024, BATCH = 8, SEQ = 4096, MTOK = BATCH * SEQ;
constexpr int MEMLEN = 256, MROWS = BATCH * MEMLEN;
constexpr int NZ1 = 2560, NGATE = 3072;
constexpr int ZQ = 0, ZK = 512, ZV = 1024, ZGR = 1536, ZU = 2048, ZQM = 2304;
constexpr int NTILES = MTOK / 128;
constexpr float EPS = 1e-6f;
constexpr int NPHASE = 15;

constexpr size_t MiB = 1u << 20;
constexpr size_t WS_CTL = 0, CTL_ZERO_BYTES = 1 * MiB;
constexpr size_t WS_WIN_T = 1 * MiB;
constexpr size_t WS_WQ_T = 12 * MiB;
constexpr size_t WS_WOUT_T = 16 * MiB;
constexpr size_t WS_WCAT_T = 18 * MiB;
constexpr size_t WS_WGLU_T = 20 * MiB;
constexpr size_t WS_WMKV_T = 21 * MiB;
constexpr size_t WS_KEYS = 22 * MiB;
constexpr size_t WS_S5MAT = 23 * MiB;
constexpr size_t WS_S5C = 25 * MiB;
constexpr size_t WS_PSC = 25 * MiB + 256 * 1024;
constexpr size_t WS_SS = 25 * MiB + 512 * 1024;
constexpr size_t WS_ROPE = 26 * MiB;
constexpr size_t WS_PU = 42 * MiB;
constexpr size_t WS_PV = 58 * MiB;
constexpr size_t WS_XN8 = 74 * MiB;
constexpr size_t WS_WG8 = WS_WIN_T + 5 * MiB;
constexpr size_t WS_MEMN = 106 * MiB;
constexpr size_t WS_KM = 110 * MiB;
constexpr size_t WS_VT = 111 * MiB;
constexpr size_t WS_S5E = 112 * MiB;
constexpr size_t WS_S5X = 114 * MiB;
constexpr size_t WS_A = 116 * MiB;
constexpr size_t WS_B = 180 * MiB;
constexpr size_t WS_Z1 = WS_B;
constexpr size_t WS_G = WS_B;
constexpr size_t WS_QRF = WS_B + 160 * MiB;
constexpr size_t WS_YCAT = WS_B + 192 * MiB;
constexpr size_t WS_YG = WS_B + 256 * MiB;
constexpr size_t WS_INNER = WS_B + 272 * MiB;
constexpr size_t WS_N2 = WS_B;
constexpr size_t WS_Q2 = WS_B + 64 * MiB;
constexpr size_t WS_IDX = WS_B + 192 * MiB;
constexpr size_t WS_WGT = WS_B + 208 * MiB;
constexpr size_t WS_HPART = WS_B + 128 * MiB;
constexpr size_t WS_ACT = WS_B + 224 * MiB;
constexpr size_t WS_POUT = WS_B + 64 * MiB;
constexpr size_t WS_END = WS_B + 304 * MiB;

constexpr int CW_BAR = 4096;
constexpr int CW_Q = 8192;

constexpr int LDS_BYTES = 147456;
constexpr int MISC_OFF = LDS_BYTES - 512;
constexpr int NWAVES = 8;

#define GAS __attribute__((address_space(1)))
#define LAS __attribute__((address_space(3)))
typedef unsigned short bf16;
typedef unsigned v4u __attribute__((ext_vector_type(4)));
typedef unsigned v2u __attribute__((ext_vector_type(2)));
typedef float f32x4 __attribute__((ext_vector_type(4)));
typedef float f32x16 __attribute__((ext_vector_type(16)));
typedef short bf16x8 __attribute__((ext_vector_type(8)));
typedef GAS unsigned gu32;
#define RLX_AGENT __ATOMIC_RELAXED, __HIP_MEMORY_SCOPE_AGENT
#define LDS_WAIT() asm volatile("s_waitcnt lgkmcnt(0)" ::: "memory")
#define VM_WAIT() asm volatile("s_waitcnt vmcnt(0)" ::: "memory")
__device__ __forceinline__ unsigned f2bf(float f) { unsigned u = __builtin_bit_cast(unsigned, f); return (u + 0x7fffu + ((u >> 16) & 1u)) >> 16; }
typedef __bf16 hwbf16x2_t __attribute__((ext_vector_type(2)));
typedef float hwf32x2_t __attribute__((ext_vector_type(2)));
__device__ __forceinline__ unsigned pk2(float lo, float hi) { const hwf32x2_t v = {lo, hi}; const hwbf16x2_t b = __builtin_convertvector(v, hwbf16x2_t); return __builtin_bit_cast(unsigned, b); }
__device__ __forceinline__ float bflo(unsigned w) { return __builtin_bit_cast(float, w << 16); }
__device__ __forceinline__ float bfhi(unsigned w) { return __builtin_bit_cast(float, w & 0xffff0000u); }
__device__ __forceinline__ float bf2f(bf16 h) { return __builtin_bit_cast(float, (unsigned)h << 16); }
__device__ __forceinline__ f32x16 mfma32(bf16x8 a, bf16x8 b, f32x16 c) { return __builtin_amdgcn_mfma_f32_32x32x16_bf16(a, b, c, 0, 0, 0); }
__device__ __forceinline__ f32x4 mfma16(bf16x8 a, bf16x8 b, f32x4 c) { return __builtin_amdgcn_mfma_f32_16x16x32_bf16(a, b, c, 0, 0, 0); }
__device__ __forceinline__ bf16x8 mk8(unsigned a, unsigned b, unsigned c, unsigned d) { v4u t = {a, b, c, d}; return __builtin_bit_cast(bf16x8, t); }
__device__ __forceinline__ float sigmoidf_(float x) { return __builtin_amdgcn_rcpf(1.0f + __builtin_amdgcn_exp2f(-1.4426950408889634f * x)); }
__device__ __forceinline__ float gelu_tanh(float x) {
    const float u2 = 1.5957691216057308f * (x + 0.044715f * x * x * x);
    return x * __builtin_amdgcn_rcpf(1.0f + __builtin_amdgcn_exp2f(-1.4426950408889634f * u2));
}
__device__ __forceinline__ float wave_sum(float v) {
#pragma unroll
    for (int o = 1; o < 64; o <<= 1) v += __shfl_xor(v, o);
    return v;
}

#define XB_TMO      128
#define XB_XCNT(j)  (256  + 64 * (j))
#define XB_XSUB(j)  (1280 + 64 * (j))
#define XB_XGEN(j)  (2304 + 64 * (j))
#define XB_TOP      3328
#define XB_TOPGEN   3392
#define XCD_BAR_WORDS 3456
#define XB_SPIN_CAP (1u << 22)

__device__ __forceinline__ unsigned xb_ld(unsigned* p)              { return __hip_atomic_load(p, __ATOMIC_RELAXED, __HIP_MEMORY_SCOPE_AGENT); }
__device__ __forceinline__ unsigned xb_add(unsigned* p, unsigned v) { return __hip_atomic_fetch_add(p, v, __ATOMIC_RELAXED, __HIP_MEMORY_SCOPE_AGENT); }
__device__ __forceinline__ unsigned xb_xcc_id() { return (unsigned)__builtin_amdgcn_s_getreg((3 << 11) | 20) & 0xFu; }
#define XB_SPIN(cond, bar) do { unsigned _sp = 0; while (cond) { __builtin_amdgcn_s_sleep(1); \
    if ((++_sp & 255u) == 0u) { if (xb_ld(&(bar)[XB_TMO])) break; if (_sp > XB_SPIN_CAP) { atomicAdd(&(bar)[XB_TMO], 1u); break; } } } } while (0)

struct XcdBarrier { unsigned* bar; unsigned x; volatile LAS unsigned* st; };

__device__ __forceinline__ XcdBarrier xcd_barrier_post(unsigned* bar, volatile LAS unsigned* st, bool tid0) {
    XcdBarrier b; b.bar = bar; b.x = xb_xcc_id(); b.st = st;
    if (tid0) (void)xb_add(&bar[XB_XCNT(b.x)], 1u);
    return b;
}
__device__ __forceinline__ void xcd_barrier_complete(unsigned* bar, unsigned x, unsigned& nloc, unsigned& nx) {
    const unsigned G = gridDim.x * gridDim.y * gridDim.z;
    unsigned sum, cnt, mine, sp = 0u;
    for (;;) {
        sum = 0u; cnt = 0u; mine = 0u;
#pragma unroll
        for (unsigned j = 0; j < 16; ++j) { const unsigned c = xb_ld(&bar[XB_XCNT(j)]); sum += c; cnt += (c > 0u) ? 1u : 0u; mine = (j == x) ? c : mine; }
        if (sum == G) break;
        __builtin_amdgcn_s_sleep(1);
        if ((++sp & 255u) == 0u) { if (xb_ld(&bar[XB_TMO])) break; if (sp > XB_SPIN_CAP) { atomicAdd(&bar[XB_TMO], 1u); break; } }
    }
    nloc = mine > 0u ? mine : 1u; nx = cnt > 0u ? cnt : 1u;
}
__device__ __forceinline__ void xcd_barrier(const XcdBarrier& b, int wave) {
    asm volatile("s_waitcnt vmcnt(0)" ::: "memory");
    __syncthreads();
    if (wave == 0 && pg8::hw_lane_id() == 0) {
        unsigned* bar = b.bar;
        __builtin_amdgcn_s_waitcnt(0);
        unsigned nloc = b.st[0], nx = b.st[1];
        if (nloc == 0u) { xcd_barrier_complete(bar, b.x, nloc, nx); b.st[0] = nloc; b.st[1] = nx; }
        const unsigned old = xb_add(&bar[XB_XSUB(b.x)], 1u);
        const unsigned gen = old / nloc;
        if (old + 1u == (gen + 1u) * nloc) {
            __builtin_amdgcn_fence(__ATOMIC_RELEASE, "agent");
            asm volatile("s_waitcnt vmcnt(0)" ::: "memory");
            const unsigned og = xb_add(&bar[XB_TOP], 1u);
            const unsigned tg = og / nx;
            if (og + 1u == (tg + 1u) * nx) xb_add(&bar[XB_TOPGEN], 1u);
            else XB_SPIN(xb_ld(&bar[XB_TOPGEN]) == tg, bar);
            __builtin_amdgcn_fence(__ATOMIC_ACQUIRE, "agent");
            xb_add(&bar[XB_XGEN(b.x)], 1u);
            asm volatile("s_waitcnt vmcnt(0)" ::: "memory");
        } else {
            XB_SPIN(xb_ld(&bar[XB_XGEN(b.x)]) == gen, bar);
            __builtin_amdgcn_fence(__ATOMIC_ACQUIRE, "agent");
            asm volatile("s_waitcnt vmcnt(0)" ::: "memory");
        }
    }
    __syncthreads();
}

__host__ __device__ __forceinline__ int frag32(int row, int k, int K) { return (((row >> 5) * (K >> 4) + (k >> 4)) * 64 + ((k >> 3) & 1) * 32 + (row & 31)) * 8 + (k & 7); }
__host__ __device__ __forceinline__ int frag16(int n, int k, int K) { return (((n >> 4) * (K >> 5) + (k >> 5)) * 64 + ((k >> 3) & 3) * 16 + (n & 15)) * 8 + (k & 7); }
struct Args { const void* in[26]; float* out; unsigned char* ws; int ph_lo, ph_hi; };
struct Ctx {
    LAS unsigned char* lds;
    int tid, lane, wave, vcu, G;
    __device__ __forceinline__ void refresh() { lane = pg8::hw_lane_id(); tid = wave * 64 + lane; }
};

template <class F> struct EpiT {
    static constexpr bool PERM = true, AFTER_DRAIN = false;
    F f;
    __device__ __forceinline__ void operator()(const f32x4 (&acc)[2][2][4][2], const pg8::Unit& u, int wr, int wc, int fr, int fq) const {
        const int row0 = u.pm * 256 + wr * 64 + fr, col0 = u.pn * 256 + wc * 32 + 8 * fq;
        typename F::L cur[2], nxt[2];
        f.load(row0, col0, cur[0]); f.load(row0, col0 + 128, cur[1]);
#pragma unroll
        for (int i = 0; i < 8; ++i) {
            const int ai = i >> 2, m = i & 3, row = row0 + ai * 128 + m * 16;
            if (i < 7) { const int rown = row0 + ((i + 1) >> 2) * 128 + ((i + 1) & 3) * 16; f.load(rown, col0, nxt[0]); f.load(rown, col0 + 128, nxt[1]); }
            __builtin_amdgcn_sched_barrier(0);
            f.apply(row, col0, acc[ai][0][m][0], acc[ai][0][m][1], cur[0]); f.apply(row, col0 + 128, acc[ai][1][m][0], acc[ai][1][m][1], cur[1]);
            __builtin_amdgcn_sched_barrier(0);
            cur[0] = nxt[0]; cur[1] = nxt[1];
        }
    }
};
__device__ __forceinline__ v4u pack8(f32x4 a, f32x4 b) { v4u w; w.x = pk2(a[0], a[1]); w.y = pk2(a[2], a[3]); w.z = pk2(b[0], b[1]); w.w = pk2(b[2], b[3]); return w; }
struct LNone {};
struct FStore { typedef LNone L; bf16* O; int ldc;
    __device__ __forceinline__ void load(int, int, L&) const {}
    __device__ __forceinline__ void apply(int row, int col, f32x4 v0, f32x4 v1, const L&) const { *(v4u*)(O + (size_t)row * ldc + col) = pack8(v0, v1); } };
struct FKvm { typedef LNone L; bf16* KM; bf16* VT;
    __device__ __forceinline__ void load(int, int, L&) const {}
    __device__ __forceinline__ void apply(int row, int col, f32x4 v0, f32x4 v1, const L&) const {
        const int b = row >> 8, m = row & 255;
        if (col < 256) { const int hm = col >> 6, d0 = col & 63; *(v4u*)(KM + (size_t)(b * 4 + hm) * 16384 + frag32(m, d0, 64)) = pack8(v0, v1); }
        else { const int c = col - 256, hm = c >> 6, e0 = c & 63, mt = m >> 5, s2 = (m >> 4) & 1, w = m & 15, hh = (w >> 2) & 1, j = ((w >> 3) << 2) | (w & 3);
            bf16* p = VT + (size_t)(b * 4 + hm) * 16384 + ((mt * 2 + s2) * 64 + hh * 32) * 8 + j;
#pragma unroll
            for (int jj = 0; jj < 8; ++jj) { const int e = e0 + jj; p[((e >> 5) * 16 * 64 + (e & 31)) * 8] = (bf16)f2bf(jj < 4 ? v0[jj] : v1[jj - 4]); } }
    } };
struct FSig { typedef LNone L; bf16* O; int ldc;
    __device__ __forceinline__ void load(int, int, L&) const {}
    __device__ __forceinline__ void apply(int row, int col, f32x4 v0, f32x4 v1, const L&) const {
#pragma unroll
        for (int j = 0; j < 4; ++j) { v0[j] = sigmoidf_(v0[j]); v1[j] = sigmoidf_(v1[j]); }
        *(v4u*)(O + (size_t)row * ldc + col) = pack8(v0, v1); } };
struct FGlu { typedef LNone L; bf16* O;
    __device__ __forceinline__ void load(int, int, L&) const {}
    __device__ __forceinline__ void apply(int row, int col, f32x4 v0, f32x4 v1, const L&) const {
        v2u w; w.x = pk2(v0[0] * sigmoidf_(v1[0]), v0[1] * sigmoidf_(v1[1])); w.y = pk2(v0[2] * sigmoidf_(v1[2]), v0[3] * sigmoidf_(v1[3]));
        *(v2u*)(O + (size_t)row * 1024 + 512 + (col >> 1)) = w; } };
__device__ __forceinline__ void mul8(f32x4& v0, f32x4& v1, const v4u num, const v4u den) {
    v0[0] *= bflo(num.x) * __builtin_amdgcn_rcpf(fmaxf(bflo(den.x), 1e-30f)); v0[1] *= bfhi(num.x) * __builtin_amdgcn_rcpf(fmaxf(bfhi(den.x), 1e-30f));
    v0[2] *= bflo(num.y) * __builtin_amdgcn_rcpf(fmaxf(bflo(den.y), 1e-30f)); v0[3] *= bfhi(num.y) * __builtin_amdgcn_rcpf(fmaxf(bfhi(den.y), 1e-30f));
    v1[0] *= bflo(num.z) * __builtin_amdgcn_rcpf(fmaxf(bflo(den.z), 1e-30f)); v1[1] *= bfhi(num.z) * __builtin_amdgcn_rcpf(fmaxf(bfhi(den.z), 1e-30f));
    v1[2] *= bflo(num.w) * __builtin_amdgcn_rcpf(fmaxf(bflo(den.w), 1e-30f)); v1[3] *= bfhi(num.w) * __builtin_amdgcn_rcpf(fmaxf(bfhi(den.w), 1e-30f));
}
struct HookGate { const bf16* Gt;
    __device__ __forceinline__ void operator()(int t, f32x4 (&acc)[2][2][4][2], const pg8::Unit& u, int wr, int wc, int fr, int fq) const {
        if (t != 8 && t != 12) return;
        const int gn = (t == 8) ? 0 : 1024, gd = gn + 1024;
        int row0 = u.pm * 256 + wr * 64 + fr, col0 = u.pn * 256 + wc * 32 + 8 * fq;
        asm volatile("" : "+v"(row0), "+v"(col0));
#pragma unroll
        for (int ai = 0; ai < 2; ++ai) {
            v4u nn[4][2], dd[4][2];
#pragma unroll
            for (int m = 0; m < 4; ++m) { const bf16* gp = Gt + (size_t)(row0 + ai * 128 + m * 16) * NGATE + col0;
                nn[m][0] = *(const v4u*)(gp + gn); dd[m][0] = *(const v4u*)(gp + gd); nn[m][1] = *(const v4u*)(gp + gn + 128); dd[m][1] = *(const v4u*)(gp + gd + 128); }
            __builtin_amdgcn_sched_barrier(0);
#pragma unroll
            for (int m = 0; m < 4; ++m) { mul8(acc[ai][0][m][0], acc[ai][0][m][1], nn[m][0], dd[m][0]); mul8(acc[ai][1][m][0], acc[ai][1][m][1], nn[m][1], dd[m][1]); }
            __builtin_amdgcn_sched_barrier(0);
        }
    } };
struct LGate { v4u g; };
struct FGateOut { typedef LGate L; const bf16* Gt; bf16* MB;
    __device__ __forceinline__ void load(int row, int col, L& l) const { l.g = *(const v4u*)(Gt + (size_t)row * NGATE + 2048 + col); }
    __device__ __forceinline__ void apply(int row, int col, f32x4 v0, f32x4 v1, const L& l) const {
        const v4u g = l.g;
        v0[0] *= bflo(g.x); v0[1] *= bfhi(g.x); v0[2] *= bflo(g.y); v0[3] *= bfhi(g.y); v1[0] *= bflo(g.z); v1[1] *= bfhi(g.z); v1[2] *= bflo(g.w); v1[3] *= bfhi(g.w);
        *(v4u*)(MB + (size_t)row * DM + col) = pack8(v0, v1); } };
struct LRes { f32x4 x0, x1; };
struct FRes { typedef LRes L; const float* X; bf16* HB; float* SS;
    __device__ __forceinline__ void load(int row, int col, L& l) const { const float* xp = X + (size_t)row * DM + col; l.x0 = *(const f32x4*)xp; l.x1 = *(const f32x4*)(xp + 4); }
    __device__ __forceinline__ void apply(int row, int col, f32x4 v0, f32x4 v1, const L& l) const {
        v0 += l.x0; v1 += l.x1;
        *(v4u*)(HB + (size_t)row * DM + col) = pack8(v0, v1);
        float q = (v0[0] * v0[0] + v0[1] * v0[1]) + (v0[2] * v0[2] + v0[3] * v0[3]) + (v1[0] * v1[0] + v1[1] * v1[1]) + (v1[2] * v1[2] + v1[3] * v1[3]);
        q += __shfl_xor(q, 16); q += __shfl_xor(q, 32);
        if (pg8::hw_lane_id() < 16) atomicAdd(SS + row, q); } };
struct LRstd { float ss; };
struct FStoreRstd { typedef LRstd L; bf16* O; int ldc; const float* SS;
    __device__ __forceinline__ void load(int row, int, L& l) const { l.ss = SS[row]; }
    __device__ __forceinline__ void apply(int row, int col, f32x4 v0, f32x4 v1, const L& l) const {
        const float rs = __builtin_amdgcn_rsqf(l.ss * (1.f / DM) + EPS);
        *(v4u*)(O + ((((size_t)(row >> 5) * 16 + (col >> 7)) * 8 + ((col & 127) >> 4)) * 64 + ((col >> 3) & 1) * 32 + (row & 31)) * 8) = pack8(v0 * rs, v1 * rs); } };

template <class F>
__device__ __forceinline__ void run_gemm(const Ctx& C, const bf16* A, const bf16* Bt, int M, int N, int K, const F& f) {
    pg8::Gemm g{A, Bt, M, N, K}; pg8::StaticOrder S; S.init(M, N, C.G, (int)blockIdx.x);
    EpiT<F> E{f};
    pg8::gemm_phase<EpiT<F>, pg8::StaticOrder, true, true>(C.lds, g, S, E, C.wave);
}

template <class F, class H>
__device__ __forceinline__ void run_gemm_hook(const Ctx& C, const bf16* A, const bf16* Bt, int M, int N, int K, const F& f, const H& h) {
    pg8::Gemm g{A, Bt, M, N, K}; pg8::StaticOrder S; S.init(M, N, C.G, (int)blockIdx.x);
    EpiT<F> E{f};
    pg8::gemm_phase<EpiT<F>, pg8::StaticOrder, true, true, false, H>(C.lds, g, S, E, C.wave, 0x7f7f7f7f, 0x7f7f7f7f, h);
}
template <class F>
__device__ __forceinline__ void run_gemm_mx(const Ctx& C, const unsigned char* A8, const unsigned char* Bt8, int M, int N, int Kbytes, const F& f, int sclA, int sclB) {
    pg8::Gemm g{(const bf16*)A8, (const bf16*)Bt8, M, N, Kbytes / 2}; pg8::StaticOrder S; S.init(M, N, C.G, (int)blockIdx.x);
    EpiT<F> E{f};
    pg8::gemm_phase<EpiT<F>, pg8::StaticOrder, true, true, true>(C.lds, g, S, E, C.wave, sclA, sclB);
}

__device__ __forceinline__ unsigned q_e2m1(float y) {
    const float m = fabsf(y);
    const unsigned c = (unsigned)(m > 0.25f) + (unsigned)(m > 0.75f) + (unsigned)(m > 1.25f) + (unsigned)(m > 1.75f) + (unsigned)(m > 2.5f) + (unsigned)(m > 3.5f) + (unsigned)(m > 5.0f);
    return c | ((__builtin_bit_cast(unsigned, y) >> 28) & 8u);
}
template <bool GLU>
__device__ __forceinline__ void p0_transpose_item(const float* W, int K, int N, bf16* WT, LAS float* scr, int item, int lane, const float* kscale = nullptr, int ldk = 0, int koff = 0) {
    if (ldk == 0) ldk = K;
    const int nblk = N / 32, kb = item / nblk, nb = item % nblk, k0 = 64 * kb, n0 = 32 * nb;
#pragma unroll 8
    for (int i = 0; i < 32; ++i) { const int kk = 2 * i + (lane >> 5); float w = W[(size_t)(k0 + kk) * N + n0 + (lane & 31)]; if (kscale) w *= kscale[k0 + kk]; scr[kk * 33 + (lane & 31)] = w; }
    LDS_WAIT(); asm volatile("" ::: "memory");
    const int c = lane & 7;
#pragma unroll
    for (int j = 0; j < 4; ++j) { const int n = (lane >> 3) + 8 * j; const LAS float* s = scr + (8 * c) * 33 + n;
        v4u o; o.x = pk2(s[0 * 33], s[1 * 33]); o.y = pk2(s[2 * 33], s[3 * 33]); o.z = pk2(s[4 * 33], s[5 * 33]); o.w = pk2(s[6 * 33], s[7 * 33]);
        const int nn = n0 + n; int row = nn;
        if (GLU) { const int jc = nn & 255, gate = nn >> 8; row = 8 * (jc >> 2) + 4 * gate + (jc & 3); }
        *(GAS v4u*)(WT + (size_t)row * ldk + koff + k0 + 8 * c) = o; }
    LDS_WAIT(); asm volatile("" ::: "memory");
}
__device__ __forceinline__ void p0_transpose_item_fp8(const float* W, int K, int N, unsigned char* WT8, int nsub, LAS float* scr, int item, int lane, float scale) {
    const int nblk = N / 32, kb = item / nblk, nb = item % nblk, k0 = 64 * kb, n0 = 32 * nb;
#pragma unroll 8
    for (int i = 0; i < 32; ++i) { const int kk = 2 * i + (lane >> 5); scr[kk * 33 + (lane & 31)] = W[(size_t)(k0 + kk) * N + n0 + (lane & 31)] * scale; }
    LDS_WAIT(); asm volatile("" ::: "memory");
    const int c = lane & 7;
#pragma unroll
    for (int j = 0; j < 4; ++j) { const int n = (lane >> 3) + 8 * j; const LAS float* sp = scr + (8 * c) * 33 + n;
        int p0 = __builtin_amdgcn_cvt_pk_fp8_f32(sp[0 * 33], sp[1 * 33], 0, false); p0 = __builtin_amdgcn_cvt_pk_fp8_f32(sp[2 * 33], sp[3 * 33], p0, true);
        int p1 = __builtin_amdgcn_cvt_pk_fp8_f32(sp[4 * 33], sp[5 * 33], 0, false); p1 = __builtin_amdgcn_cvt_pk_fp8_f32(sp[6 * 33], sp[7 * 33], p1, true);
        v2u o; o.x = (unsigned)p0; o.y = (unsigned)p1;
        *(GAS v2u*)(WT8 + (size_t)(n0 + n - nsub) * K + k0 + 8 * c) = o; }
    LDS_WAIT(); asm volatile("" ::: "memory");
}
template <int NR>
__device__ __forceinline__ void rms_rows_to_bf16(const float* xbase, const float* gain, bf16* obase, int m0, int mstep, int lane, unsigned char* o8base = nullptr) {
    f32x4 v[NR][4]; float s[NR];
#pragma unroll
    for (int i = 0; i < NR; ++i) { const f32x4* xr = (const f32x4*)(xbase + (size_t)(m0 + i * mstep) * DM) + lane; s[i] = 0.f;
#pragma unroll
        for (int j = 0; j < 4; ++j) v[i][j] = xr[64 * j]; }
#pragma unroll
    for (int i = 0; i < NR; ++i)
#pragma unroll
        for (int j = 0; j < 4; ++j) s[i] += (v[i][j].x * v[i][j].x + v[i][j].y * v[i][j].y) + (v[i][j].z * v[i][j].z + v[i][j].w * v[i][j].w);
#pragma unroll
    for (int o = 1; o < 64; o <<= 1)
#pragma unroll
        for (int i = 0; i < NR; ++i) s[i] += __shfl_xor(s[i], o);
    const f32x4* gr = (const f32x4*)gain + lane;
    f32x4 g[4];
#pragma unroll
    for (int j = 0; j < 4; ++j) g[j] = gr[64 * j];
#pragma unroll
    for (int i = 0; i < NR; ++i) { const float rstd = 1.0f / sqrtf(s[i] * (1.f / DM) + EPS);
        unsigned long long* o8 = (unsigned long long*)(obase + (size_t)(m0 + i * mstep) * DM) + lane;
#pragma unroll
        for (int j = 0; j < 4; ++j) { const float y0 = v[i][j].x * rstd * g[j].x, y1 = v[i][j].y * rstd * g[j].y, y2 = v[i][j].z * rstd * g[j].z, y3 = v[i][j].w * rstd * g[j].w;
            o8[64 * j] = (unsigned long long)pk2(y0, y1) | ((unsigned long long)pk2(y2, y3) << 32);
            if (o8base) { int p = __builtin_amdgcn_cvt_pk_fp8_f32(y0 * 16.f, y1 * 16.f, 0, false); p = __builtin_amdgcn_cvt_pk_fp8_f32(y2 * 16.f, y3 * 16.f, p, true);
                *(unsigned*)(o8base + (size_t)(m0 + i * mstep) * DM + 256 * j + 4 * lane) = (unsigned)p; } } }
}

__device__ __forceinline__ void p0_s5_group(const Ctx& C, const Args& a, int g, int part) {
    const float* a_re = (const float*)a.in[7]; const float* a_im = (const float*)a.in[8]; const float* log_dt = (const float*)a.in[9];
    const float* b_re = (const float*)a.in[10]; const float* b_im = (const float*)a.in[11]; const float* c_re = (const float*)a.in[12]; const float* c_im = (const float*)a.in[13];
    LAS float* L = (LAS float*)C.lds;
    LAS float* lpr = L;
    LAS float* lpi = L + 640;
    LAS float* bbr = L + 1280;
    LAS float* bbi = bbr + 1024;
    LAS float* ccr = bbi + 1024;
    LAS float* cci = ccr + 1024;
    LAS float* Kj = cci + 1024;
    const int tid = C.tid;
    bf16* T8T = (bf16*)(a.ws + WS_S5MAT) + (size_t)g * 16384;
    bf16* PMT = (bf16*)(a.ws + WS_S5MAT) + (size_t)(16 + g) * 16384;
    bf16* QMT = (bf16*)(a.ws + WS_S5MAT) + (size_t)(32 + g) * 16384;
    float* L8 = (float*)(a.ws + WS_S5C) + (size_t)g * 128;
    float* L128 = (float*)(a.ws + WS_S5C) + 2048 + (size_t)g * 128;
    for (int i = tid; i < 640; i += 512) {
        const int j10 = i >> 6, p = i & 63; const double jj = (j10 < 9) ? (double)j10 : 128.0;
        const double dt = exp((double)log_dt[g]);
        const double ar = (double)a_re[g * 64 + p], ai = (double)a_im[g * 64 + p];
        const double mag = exp(ar * dt * jj), ang = ai * dt * jj;
        lpr[i] = (float)(mag * cos(ang)); lpi[i] = (float)(mag * sin(ang));
    }
    for (int i = tid; i < 1024; i += 512) { ccr[i] = c_re[g * 1024 + i]; cci[i] = c_im[g * 1024 + i]; }
    __syncthreads();
    if (part == 0 && tid < 64) { L8[tid * 2] = lpr[8 * 64 + tid]; L8[tid * 2 + 1] = lpi[8 * 64 + tid]; L128[tid * 2] = lpr[9 * 64 + tid]; L128[tid * 2 + 1] = lpi[9 * 64 + tid]; }
    for (int i = tid; i < 1024; i += 512) {
        const int p = i >> 4, h = i & 15;
        const float ar = a_re[g * 64 + p], ai = a_im[g * 64 + p], lr = lpr[64 + p], li = lpi[64 + p];
        const float den = ar * ar + ai * ai, nr = lr - 1.0f, ni = li;
        const float cr = (nr * ar + ni * ai) / den, ci = (ni * ar - nr * ai) / den;
        const float br = b_re[(g * 64 + p) * 16 + h], bi = b_im[(g * 64 + p) * 16 + h];
        bbr[i] = cr * br - ci * bi; bbi[i] = cr * bi + ci * br;
    }
    __syncthreads();
    for (int i = tid; i < 2048; i += 512) {
        const int j = i >> 8, ho = (i >> 4) & 15, hi = i & 15; float sacc = 0.f;
        if (j > (part >> 1) || (ho >> 3) != (part & 1)) continue;
        for (int p = 0; p < 64; ++p) { const float cr_ = ccr[ho * 64 + p], ci_ = cci[ho * 64 + p], lr_ = lpr[j * 64 + p], li_ = lpi[j * 64 + p];
            const float mr = cr_ * lr_ - ci_ * li_, mi = cr_ * li_ + ci_ * lr_;
            sacc += mr * bbr[p * 16 + hi] - mi * bbi[p * 16 + hi]; }
        Kj[i] = sacc;
    }
    __syncthreads();
    for (int i = part * 1024 + tid; i < (part + 1) * 1024; i += 512) {
        const int n = i >> 7, k = i & 127;
        { const int t = n >> 4, ho = n & 15, sx = k >> 4, hi = k & 15; const float v = (sx <= t) ? Kj[((t - sx) * 16 + ho) * 16 + hi] : 0.f; T8T[frag16(n, k, 128)] = (bf16)f2bf(v); }
        { const int p = n & 63, im = n >> 6, sx = k >> 4, hi = k & 15; const float lr_ = lpr[(7 - sx) * 64 + p], li_ = lpi[(7 - sx) * 64 + p], br_ = bbr[p * 16 + hi], bi_ = bbi[p * 16 + hi];
          const float v = im ? (lr_ * bi_ + li_ * br_) : (lr_ * br_ - li_ * bi_); PMT[frag16(n, k, 128)] = (bf16)f2bf(v); }
        { const int t = n >> 4, ho = n & 15, p = k & 63, pt = k >> 6; const float cr_ = ccr[ho * 64 + p], ci_ = cci[ho * 64 + p], lr_ = lpr[(t + 1) * 64 + p], li_ = lpi[(t + 1) * 64 + p];
          const float v = pt ? -(cr_ * li_ + ci_ * lr_) : (cr_ * lr_ - ci_ * li_); QMT[frag16(n, k, 128)] = (bf16)f2bf(v); }
    }
    __syncthreads();
}

__device__ __forceinline__ void p0_prologue(const Ctx& C, const Args& a) {
    p0_s5_group(C, a, C.vcu & 15, C.vcu >> 4);
    LAS float* scr = (LAS float*)(C.lds + C.wave * 16384);
    const int gw = C.vcu * NWAVES + C.wave, NGW = C.G * NWAVES;
    const int gt = C.vcu * 512 + C.tid, NGT = C.G * 512;
    unsigned char* ws = a.ws;
    for (int i = gt; i < MTOK; i += NGT) ((float*)(ws + WS_SS))[i] = 0.f;
    constexpr int I_IN = 16 * 176, I_Q = 16 * 64, I_O = 16 * 32, I_BR = 8 * 32, I_BS = 4 * 32, I_BM = 4 * 32, I_KV = 16 * 16, I_GLU = 4 * 16;
    constexpr int NITEMS = I_IN + I_Q + I_O + I_BR + I_BS + I_BM + I_KV + I_GLU;
    for (int it = gw; it < NITEMS; it += NGW) {
        int r = it;
        if (r < I_IN) { if ((r % 176) < 80) p0_transpose_item<false>((const float*)a.in[4], 1024, 5632, (bf16*)(ws + WS_WIN_T), scr, r, C.lane);
                        else p0_transpose_item_fp8((const float*)a.in[4], 1024, 5632, ws + WS_WG8, NZ1, scr, r, C.lane, 256.f); continue; } r -= I_IN;
        if (r < I_Q) { p0_transpose_item<false>((const float*)a.in[21], 1024, 2048, (bf16*)(ws + WS_WQ_T), scr, r, C.lane, (const float*)a.in[20]); continue; } r -= I_Q;
        if (r < I_O) { p0_transpose_item<false>((const float*)a.in[19], 1024, 1024, (bf16*)(ws + WS_WOUT_T), scr, r, C.lane); continue; } r -= I_O;
        if (r < I_BR) { p0_transpose_item<false>((const float*)a.in[16], 512, 1024, (bf16*)(ws + WS_WCAT_T), scr, r, C.lane, nullptr, 1024, 0); continue; } r -= I_BR;
        if (r < I_BS) { p0_transpose_item<false>((const float*)a.in[17], 256, 1024, (bf16*)(ws + WS_WCAT_T), scr, r, C.lane, nullptr, 1024, 512); continue; } r -= I_BS;
        if (r < I_BM) { p0_transpose_item<false>((const float*)a.in[18], 256, 1024, (bf16*)(ws + WS_WCAT_T), scr, r, C.lane, nullptr, 1024, 768); continue; } r -= I_BM;
        if (r < I_KV) { p0_transpose_item<false>((const float*)a.in[6], 1024, 512, (bf16*)(ws + WS_WMKV_T), scr, r, C.lane); continue; } r -= I_KV;
        p0_transpose_item<true>((const float*)a.in[15], 256, 512, (bf16*)(ws + WS_WGLU_T), scr, r, C.lane);
    }
    for (int i = gt; i < 16 * 128 * 128 / 8; i += NGT) { const f32x4 x0 = ((const f32x4*)a.in[22])[2 * (size_t)i], x1 = ((const f32x4*)a.in[22])[2 * (size_t)i + 1];
        const int hc = i >> 11, n = (i >> 4) & 127, d0 = (i & 15) * 8; *(v4u*)((bf16*)(ws + WS_KEYS) + hc * 16384 + frag32(n, d0, 128)) = pack8(x0, x1); }
    for (int rw0 = gw; rw0 < 2 * 16384; rw0 += 4 * NGW) {
        const int t = rw0 >> 14;
        f32x4 v[4][4]; float mx[4];
#pragma unroll
        for (int i = 0; i < 4; ++i) { const int row = (rw0 + i * NGW) & 16383;
            const float* src = (const float*)a.in[23 + t] + (size_t)row * DM + C.lane * 4; mx[i] = 0.f;
#pragma unroll
            for (int q = 0; q < 4; ++q) { v[i][q] = *(const f32x4*)(src + 256 * q); if (t == 0) v[i][q] = v[i][q] * *(const f32x4*)((const float*)a.in[20] + C.lane * 4 + 256 * q); } }
        if (t == 0) {
#pragma unroll
            for (int i = 0; i < 4; ++i)
#pragma unroll
                for (int q = 0; q < 4; ++q) mx[i] += (v[i][q][0] * v[i][q][0] + v[i][q][1] * v[i][q][1]) + (v[i][q][2] * v[i][q][2] + v[i][q][3] * v[i][q][3]);
#pragma unroll
            for (int o = 1; o < 64; o <<= 1)
#pragma unroll
                for (int i = 0; i < 4; ++i) mx[i] += __shfl_xor(mx[i], o);
#pragma unroll
            for (int i = 0; i < 4; ++i) { const int row = (rw0 + i * NGW) & 16383;
                const float rms = sqrtf(mx[i] * (1.f / DM)); const bool tiny = rms < 1e-30f;
                const float sc = tiny ? 1.f : 2.05f / rms, isc = tiny ? 1.f : rms * (1.f / 2.05f);
                unsigned char* dst = ws + WS_PU + (size_t)row * 128 + 2 * C.lane;
#pragma unroll
                for (int q = 0; q < 4; ++q) { const unsigned w = q_e2m1(v[i][q][0] * sc) | (q_e2m1(v[i][q][1] * sc) << 4) | (q_e2m1(v[i][q][2] * sc) << 8) | (q_e2m1(v[i][q][3] * sc) << 12);
                    *(unsigned short*)(dst + (size_t)q * (16384 * 128)) = (unsigned short)w; }
                if (C.lane == 0) ((float*)(ws + WS_PSC))[row * 2] = isc; }
        } else {
#pragma unroll
            for (int i = 0; i < 4; ++i)
#pragma unroll
                for (int q = 0; q < 4; ++q) mx[i] = fmaxf(mx[i], fmaxf(fmaxf(fabsf(v[i][q][0]), fabsf(v[i][q][1])), fmaxf(fabsf(v[i][q][2]), fabsf(v[i][q][3]))));
#pragma unroll
            for (int o = 1; o < 64; o <<= 1)
#pragma unroll
                for (int i = 0; i < 4; ++i) mx[i] = fmaxf(mx[i], __shfl_xor(mx[i], o));
#pragma unroll
            for (int i = 0; i < 4; ++i) { const int row = (rw0 + i * NGW) & 16383;
                int ex = (int)((__builtin_bit_cast(unsigned, mx[i]) >> 23) & 0xffu) - 127;
                if (mx[i] < 1e-30f) ex = 7;
                const float sc = __builtin_bit_cast(float, (unsigned)(127 + 7 - ex) << 23), isc = __builtin_bit_cast(float, (unsigned)(127 - 7 + ex) << 23);
                unsigned char* dst = ws + WS_PV + (size_t)row * 128 + ((C.lane * 4) & 127);
#pragma unroll
                for (int q = 0; q < 4; ++q) { int p = __builtin_amdgcn_cvt_pk_fp8_f32(v[i][q][0] * sc, v[i][q][1] * sc, 0, false); p = __builtin_amdgcn_cvt_pk_fp8_f32(v[i][q][2] * sc, v[i][q][3] * sc, p, true);
                    *(unsigned*)(dst + (size_t)(2 * q + (C.lane >> 5)) * (16384 * 128)) = (unsigned)p; }
                if (C.lane == 0) ((float*)(ws + WS_PSC))[row * 2 + 1] = isc; }
        }
    }
    for (int m = gw; m < MTOK; m += 4 * NGW) rms_rows_to_bf16<4>((const float*)a.in[0], (const float*)a.in[3], (bf16*)(ws + WS_A), m, NGW, C.lane, ws + WS_XN8);
    for (int m = gw; m < MROWS; m += NGW) rms_rows_to_bf16<1>((const float*)a.in[1], (const float*)a.in[5], (bf16*)(ws + WS_MEMN), m, NGW, C.lane);
    {
        const int* pos = (const int*)a.in[2]; float* rope = (float*)(ws + WS_ROPE);
        const int j = C.tid & 63;
        const double invrev = exp(-(double)j * (9.210340371976184 / 64.0)) * 0.15915494309189535;
        for (int i = gt; i < MTOK * 64; i += NGT) { const int tok = i >> 6;
            double rv = (double)pos[tok] * invrev; rv -= rint(rv);
            const float rf = (float)rv;
            rope[(size_t)tok * 128 + j] = __builtin_amdgcn_cosf(rf); rope[(size_t)tok * 128 + 64 + j] = __builtin_amdgcn_sinf(rf); }
    }
}

constexpr int LP = 136;
__device__ __forceinline__ float lg2_gamma(int h) { return log2f(1.0f - exp2f(-5.0f - (float)h)); }

struct R1In { v4u q[4], k[4]; };
__device__ __forceinline__ void r1_load(const bf16* zr, int h, int dq, int eq, R1In& R) {
    const bf16* sq = zr + ZQ + h * 128; const bf16* sk = zr + ZK + h * 128;
    R.q[0] = *(const v4u*)(sq + dq); R.q[1] = *(const v4u*)(sq + dq + 8); R.q[2] = *(const v4u*)(sq + 64 + dq); R.q[3] = *(const v4u*)(sq + 64 + dq + 8);
    R.k[0] = *(const v4u*)(sk + dq); R.k[1] = *(const v4u*)(sk + dq + 8); R.k[2] = *(const v4u*)(sk + 64 + dq); R.k[3] = *(const v4u*)(sk + 64 + dq + 8);
}
__device__ __forceinline__ void r1_unit(const Ctx& C, const Args& a, int tile, int h, const float (&cs)[16], const float (&sn)[16], const R1In& R, R1In& Rn, bool hasnext) {
    const bf16* Z1 = (const bf16*)(a.ws + WS_Z1);
    LAS bf16* Qs = (LAS bf16*)C.lds; LAS bf16* Ks = Qs + 128 * LP; LAS bf16* Kt = Ks + 128 * LP; LAS bf16* Vt = Kt + 128 * LP;
    const int tid = C.tid, lane = C.lane, t0 = tile * 128, u = tile * 4 + h;
    const float lg2g = lg2_gamma(h);
    const int i = tid >> 2, dq = (tid & 3) * 16, eq = (tid & 3) * 32;
    {
        v4u vraw[4];
#pragma unroll
        for (int q = 0; q < 4; ++q) vraw[q] = *(const v4u*)(Z1 + (size_t)(t0 + i) * NZ1 + ZV + h * 128 + eq + 8 * q);
        const float kdec = __builtin_amdgcn_exp2f((float)(127 - i) * lg2g) , ksc = 0.08838834764831845f;
#pragma unroll
        for (int which = 0; which < 2; ++which) {
            const v4u a0 = which ? R.k[0] : R.q[0], a1 = which ? R.k[1] : R.q[1], b0 = which ? R.k[2] : R.q[2], b1 = which ? R.k[3] : R.q[3];
            const unsigned aw[8] = {a0.x, a0.y, a0.z, a0.w, a1.x, a1.y, a1.z, a1.w}, bw[8] = {b0.x, b0.y, b0.z, b0.w, b1.x, b1.y, b1.z, b1.w};
            float y1[16], y2[16];
#pragma unroll
            for (int w = 0; w < 8; ++w) {
                const float x1l = bflo(aw[w]), x1h = bfhi(aw[w]), x2l = bflo(bw[w]), x2h = bfhi(bw[w]);
                y1[2 * w] = x1l * cs[2 * w] - x2l * sn[2 * w]; y2[2 * w] = x1l * sn[2 * w] + x2l * cs[2 * w];
                y1[2 * w + 1] = x1h * cs[2 * w + 1] - x2h * sn[2 * w + 1]; y2[2 * w + 1] = x1h * sn[2 * w + 1] + x2h * cs[2 * w + 1];
            }
            if (which) {
#pragma unroll
                for (int e = 0; e < 16; ++e) { y1[e] *= ksc; y2[e] *= ksc; }
            }
            LAS bf16* dstp = (which ? Ks : Qs) + i * LP;
            v4u o;
            o.x = pk2(y1[0], y1[1]); o.y = pk2(y1[2], y1[3]); o.z = pk2(y1[4], y1[5]); o.w = pk2(y1[6], y1[7]); *(LAS v4u*)(dstp + dq) = o;
            o.x = pk2(y1[8], y1[9]); o.y = pk2(y1[10], y1[11]); o.z = pk2(y1[12], y1[13]); o.w = pk2(y1[14], y1[15]); *(LAS v4u*)(dstp + dq + 8) = o;
            o.x = pk2(y2[0], y2[1]); o.y = pk2(y2[2], y2[3]); o.z = pk2(y2[4], y2[5]); o.w = pk2(y2[6], y2[7]); *(LAS v4u*)(dstp + 64 + dq) = o;
            o.x = pk2(y2[8], y2[9]); o.y = pk2(y2[10], y2[11]); o.z = pk2(y2[12], y2[13]); o.w = pk2(y2[14], y2[15]); *(LAS v4u*)(dstp + 64 + dq + 8) = o;
            if (which) {
#pragma unroll
                for (int e = 0; e < 16; ++e) { Kt[(dq + e) * LP + i] = (bf16)f2bf(y1[e] * kdec); Kt[(64 + dq + e) * LP + i] = (bf16)f2bf(y2[e] * kdec); }
            }
            __builtin_amdgcn_sched_barrier(0);
        }
        {
#pragma unroll
            for (int q = 0; q < 4; ++q) { const v4u v = vraw[q]; const unsigned vw[4] = {v.x, v.y, v.z, v.w};
#pragma unroll
                for (int w = 0; w < 4; ++w) { Vt[(eq + 8 * q + 2 * w) * LP + i] = (bf16)(vw[w] & 0xffffu); Vt[(eq + 8 * q + 2 * w + 1) * LP + i] = (bf16)(vw[w] >> 16); } }
        }
    }
    __syncthreads();
    if (hasnext) r1_load(Z1 + (size_t)(t0 + i) * NZ1, h + 1, dq, eq, Rn);
    __builtin_amdgcn_sched_barrier(0);
    const int r = lane & 31, hh = lane >> 5;
    if (C.wave < 4) {
        const int ib = C.wave;
        { bf16* qf = (bf16*)(a.ws + WS_QRF) + ((size_t)(u * 4 + ib) * 8 * 64 + lane) * 8;
#pragma unroll
          for (int ks = 0; ks < 8; ++ks) *(bf16x8*)(qf + ks * 512) = *(const LAS bf16x8*)(Qs + (ib * 32 + r) * LP + ks * 16 + 8 * hh); }
        __builtin_amdgcn_sched_barrier(0);
        f32x16 accO[4];
#pragma unroll
        for (int et = 0; et < 4; ++et)
#pragma unroll
            for (int e = 0; e < 16; ++e) accO[et][e] = 0.f;
        int i = ib * 32 + r; asm volatile("" : "+v"(i));
#pragma unroll
        for (int jt = 0; jt < 4; ++jt) {
            if (jt <= ib) {
                f32x16 s;
#pragma unroll
                for (int e = 0; e < 16; ++e) s[e] = 0.f;
#pragma unroll
                for (int ks = 0; ks < 8; ++ks) { const bf16x8 ak = *(const LAS bf16x8*)(Ks + (jt * 32 + r) * LP + ks * 16 + 8 * hh), bqk = *(const LAS bf16x8*)(Qs + (ib * 32 + r) * LP + ks * 16 + 8 * hh); s = mfma32(ak, bqk, s); }
                unsigned pk[8];
#pragma unroll
                for (int q = 0; q < 8; ++q) {
                    const int ra = 2 * q, rb = 2 * q + 1;
                    const int ja = jt * 32 + (ra & 3) + 8 * (ra >> 2) + 4 * hh, jb = jt * 32 + (rb & 3) + 8 * (rb >> 2) + 4 * hh;
                    const float va = (i >= ja) ? s[ra] * __builtin_amdgcn_exp2f((float)(i - ja) * lg2g) : 0.f;
                    const float vb = (i >= jb) ? s[rb] * __builtin_amdgcn_exp2f((float)(i - jb) * lg2g) : 0.f;
                    pk[q] = pk2(va, vb);
                }
#pragma unroll
                for (int sft = 0; sft < 2; ++sft) {
                    const bf16x8 pb = mk8(pk[4 * sft], pk[4 * sft + 1], pk[4 * sft + 2], pk[4 * sft + 3]);
#pragma unroll
                    for (int et = 0; et < 4; ++et) {
                        const LAS bf16* vp = Vt + (et * 32 + r) * LP + jt * 32 + 16 * sft + 4 * hh;
                        const v2u lo = *(const LAS v2u*)vp, hi = *(const LAS v2u*)(vp + 8);
                        accO[et] = mfma32(mk8(lo.x, lo.y, hi.x, hi.y), pb, accO[et]);
                    }
                }
            }
            __builtin_amdgcn_sched_barrier(0);
        }
        unsigned* INN = (unsigned*)(a.ws + WS_INNER) + ((size_t)(u * 4 + ib) * 32) * 64 + lane;
#pragma unroll
        for (int et = 0; et < 4; ++et)
#pragma unroll
            for (int q = 0; q < 8; ++q) INN[(et * 8 + q) * 64] = pk2(accO[et][2 * q], accO[et][2 * q + 1]);
    } else {
        const int et = C.wave - 4;
        f32x16 acc[4];
#pragma unroll
        for (int dt = 0; dt < 4; ++dt)
#pragma unroll
            for (int e = 0; e < 16; ++e) acc[dt][e] = 0.f;
#pragma unroll
        for (int ks = 0; ks < 8; ++ks) {
            const bf16x8 av = *(const LAS bf16x8*)(Vt + (et * 32 + r) * LP + ks * 16 + 8 * hh);
#pragma unroll
            for (int dt = 0; dt < 4; ++dt) { const bf16x8 bk = *(const LAS bf16x8*)(Kt + (dt * 32 + r) * LP + ks * 16 + 8 * hh); acc[dt] = mfma32(av, bk, acc[dt]); }
            __builtin_amdgcn_sched_barrier(0);
        }
        float* KVb = a.out + (size_t)u * 16384 + (size_t)(et * 32 + 4 * hh) * 128 + r;
#pragma unroll
        for (int dt = 0; dt < 4; ++dt) {
#pragma unroll
            for (int e = 0; e < 16; ++e) KVb[((e & 3) + 8 * (e >> 2)) * 128 + dt * 32] = acc[dt][e];
            __builtin_amdgcn_sched_barrier(0);
        }
    }
    __syncthreads();
}

__device__ __forceinline__ void s5_compute_E(const Args& a, int tile, int g, int lane, LAS float* Es, bf16x8 (&au)[4]) {
    const bf16* Z1 = (const bf16*)(a.ws + WS_Z1); const bf16* PMT = (const bf16*)(a.ws + WS_S5MAT) + (size_t)(16 + g) * 16384;
    const int r16 = lane & 15, q4 = lane >> 4;
#pragma unroll
    for (int ks = 0; ks < 4; ++ks) { const int s = 2 * ks + (q4 >> 1);
        au[ks] = *(const bf16x8*)(Z1 + (size_t)(tile * 128 + 8 * r16 + s) * NZ1 + ZU + g * 16 + 8 * (q4 & 1)); }
    bf16x8 bc[4], bn[4];
#pragma unroll
    for (int ks = 0; ks < 4; ++ks) bc[ks] = *(const bf16x8*)(PMT + (ks * 64 + lane) * 8);
#pragma unroll 1
    for (int nb = 0; nb < 8; ++nb) {
        const int nbn = min(nb + 1, 7);
#pragma unroll
        for (int ks = 0; ks < 4; ++ks) bn[ks] = *(const bf16x8*)(PMT + ((nbn * 4 + ks) * 64 + lane) * 8);
        __builtin_amdgcn_sched_barrier(0);
        f32x4 acc = {0.f, 0.f, 0.f, 0.f};
#pragma unroll
        for (int ks = 0; ks < 4; ++ks) acc = mfma16(au[ks], bc[ks], acc);
#pragma unroll
        for (int i4 = 0; i4 < 4; ++i4) Es[(q4 * 4 + i4) * 128 + nb * 16 + r16] = acc[i4];
        __builtin_amdgcn_sched_barrier(0);
#pragma unroll
        for (int ks = 0; ks < 4; ++ks) bc[ks] = bn[ks];
    }
    LDS_WAIT(); asm volatile("" ::: "memory");
}
__device__ __forceinline__ void s5a_wave(const Ctx& C, const Args& a, int tile, int g) {
    LAS float* Es = (LAS float*)(C.lds + C.wave * 16384);
    bf16x8 au[4];
    s5_compute_E(a, tile, g, C.lane, Es, au);
    const float* L8 = (const float*)(a.ws + WS_S5C) + (size_t)g * 128;
    const float l8r = L8[C.lane * 2], l8i = L8[C.lane * 2 + 1];
    float sr = 0.f, si = 0.f;
#pragma unroll
    for (int c = 0; c < 16; ++c) { const float er = Es[c * 128 + C.lane], ei = Es[c * 128 + 64 + C.lane];
        const float nr = l8r * sr - l8i * si + er, ni = l8r * si + l8i * sr + ei; sr = nr; si = ni; }
    float* E = (float*)(a.ws + WS_S5E) + ((size_t)tile * 16 + g) * 128;
    E[C.lane] = sr; E[64 + C.lane] = si;
    LDS_WAIT(); asm volatile("" ::: "memory");
}
__device__ __forceinline__ void s5c_wave(const Ctx& C, const Args& a, int tile, int g) {
    LAS float* Es = (LAS float*)(C.lds + C.wave * 16384);
    LAS bf16* Sv = (LAS bf16*)(C.lds + C.wave * 16384 + 8192);
    const int lane = C.lane, r16 = lane & 15, q4 = lane >> 4;
    bf16x8 au[4];
    s5_compute_E(a, tile, g, lane, Es, au);
    const float* L8 = (const float*)(a.ws + WS_S5C) + (size_t)g * 128;
    const float l8r = L8[lane * 2], l8i = L8[lane * 2 + 1];
    const float* X = (const float*)(a.ws + WS_S5X) + ((size_t)tile * 16 + g) * 128;
    float sr = X[lane], si = X[64 + lane];
#pragma unroll
    for (int c = 0; c < 16; ++c) {
        Sv[c * LP + lane] = (bf16)f2bf(sr); Sv[c * LP + 64 + lane] = (bf16)f2bf(si);
        const float er = Es[c * 128 + lane], ei = Es[c * 128 + 64 + lane];
        const float nr = l8r * sr - l8i * si + er, ni = l8r * si + l8i * sr + ei; sr = nr; si = ni; }
    LDS_WAIT(); asm volatile("" ::: "memory");
    bf16x8 as[4];
#pragma unroll
    for (int ks = 0; ks < 4; ++ks) as[ks] = *(const LAS bf16x8*)(Sv + r16 * LP + ks * 32 + 8 * q4);
    const bf16* T8T = (const bf16*)(a.ws + WS_S5MAT) + (size_t)g * 16384; const bf16* QMT = (const bf16*)(a.ws + WS_S5MAT) + (size_t)(32 + g) * 16384;
    const bf16* Z1 = (const bf16*)(a.ws + WS_Z1); bf16* YG = (bf16*)(a.ws + WS_YG);
    const float dg = ((const float*)a.in[14])[g * 16 + r16];
    bf16x8 tc[4], tn[4], qc[4], qn[4]; bf16 uc[4], un[4];
#pragma unroll
    for (int ks = 0; ks < 4; ++ks) { tc[ks] = *(const bf16x8*)(T8T + (ks * 64 + lane) * 8); qc[ks] = *(const bf16x8*)(QMT + (ks * 64 + lane) * 8); }
#pragma unroll
    for (int i4 = 0; i4 < 4; ++i4) uc[i4] = Z1[(size_t)(tile * 128 + 8 * (q4 * 4 + i4)) * NZ1 + ZU + g * 16 + r16];
#pragma unroll 1
    for (int nb = 0; nb < 8; ++nb) {
        const int nbn = min(nb + 1, 7);
#pragma unroll
        for (int ks = 0; ks < 4; ++ks) { tn[ks] = *(const bf16x8*)(T8T + ((nbn * 4 + ks) * 64 + lane) * 8); qn[ks] = *(const bf16x8*)(QMT + ((nbn * 4 + ks) * 64 + lane) * 8); }
#pragma unroll
        for (int i4 = 0; i4 < 4; ++i4) un[i4] = Z1[(size_t)(tile * 128 + 8 * (q4 * 4 + i4) + nbn) * NZ1 + ZU + g * 16 + r16];
        __builtin_amdgcn_sched_barrier(0);
        f32x4 acc = {0.f, 0.f, 0.f, 0.f};
#pragma unroll
        for (int ks = 0; ks < 4; ++ks) { acc = mfma16(au[ks], tc[ks], acc); acc = mfma16(as[ks], qc[ks], acc); }
#pragma unroll
        for (int i4 = 0; i4 < 4; ++i4) { const int tok = tile * 128 + 8 * (q4 * 4 + i4) + nb;
            YG[(size_t)tok * 256 + g * 16 + r16] = (bf16)f2bf(gelu_tanh(acc[i4] + dg * bf2f(uc[i4]))); }
        __builtin_amdgcn_sched_barrier(0);
#pragma unroll
        for (int ks = 0; ks < 4; ++ks) { tc[ks] = tn[ks]; qc[ks] = qn[ks]; }
#pragma unroll
        for (int i4 = 0; i4 < 4; ++i4) uc[i4] = un[i4];
    }
    LDS_WAIT(); asm volatile("" ::: "memory");
}

__device__ __forceinline__ void ma_loadk(const bf16* kp, int mt, bf16x8 (&k)[4]) {
#pragma unroll
    for (int ks = 0; ks < 4; ++ks) k[ks] = *(const bf16x8*)(kp + (mt * 4 + ks) * 512);
}
__device__ __forceinline__ void ma_loadv(const bf16* vp, int mt, bf16x8 (&v)[4]) {
#pragma unroll
    for (int sft = 0; sft < 2; ++sft)
#pragma unroll
        for (int et = 0; et < 2; ++et) v[sft * 2 + et] = *(const bf16x8*)(vp + (((et * 8 + mt) * 2 + sft) * 64) * 8);
}
__device__ __forceinline__ void ma_wave(const Ctx& C, const Args& a, int tile, int hm, int ib) {
    const bf16* Z1 = (const bf16*)(a.ws + WS_Z1); const bf16* KM = (const bf16*)(a.ws + WS_KM); const bf16* VT = (const bf16*)(a.ws + WS_VT);
    const int lane = C.lane, r = lane & 31, hh = lane >> 5, b = tile >> 5, tok = tile * 128 + ib * 32 + r;
    const bf16* kp = KM + (size_t)(b * 4 + hm) * 16384 + lane * 8;
    const bf16* vp = VT + (size_t)(b * 4 + hm) * 16384 + lane * 8;
    bf16x8 bq[4];
#pragma unroll
    for (int ks = 0; ks < 4; ++ks) bq[ks] = *(const bf16x8*)(Z1 + (size_t)tok * NZ1 + ZQM + hm * 64 + ks * 16 + 8 * hh);
    bf16x8 kc[4], kn[4];
    ma_loadk(kp, 0, kc);
    float mx = -3.0e38f;
#pragma unroll 1
    for (int mt = 0; mt < 8; ++mt) {
        ma_loadk(kp, min(mt + 1, 7), kn); __builtin_amdgcn_sched_barrier(0);
        f32x16 s;
#pragma unroll
        for (int e = 0; e < 16; ++e) s[e] = 0.f;
#pragma unroll
        for (int ks = 0; ks < 4; ++ks) s = mfma32(kc[ks], bq[ks], s);
#pragma unroll
        for (int e = 0; e < 16; ++e) mx = fmaxf(mx, s[e]);
        __builtin_amdgcn_sched_barrier(0);
#pragma unroll
        for (int ks = 0; ks < 4; ++ks) kc[ks] = kn[ks];
    }
    mx = fmaxf(mx, __shfl_xor(mx, 32));
    float sum = 0.f;
    f32x16 o[2];
#pragma unroll
    for (int et = 0; et < 2; ++et)
#pragma unroll
        for (int e = 0; e < 16; ++e) o[et][e] = 0.f;
    const float sc = 0.125f * 1.4426950408889634f;
    bf16x8 vc[4], vn[4];
    ma_loadk(kp, 0, kc); ma_loadv(vp, 0, vc);
#pragma unroll 1
    for (int mt = 0; mt < 8; ++mt) {
        ma_loadk(kp, min(mt + 1, 7), kn); ma_loadv(vp, min(mt + 1, 7), vn); __builtin_amdgcn_sched_barrier(0);
        f32x16 s;
#pragma unroll
        for (int e = 0; e < 16; ++e) s[e] = 0.f;
#pragma unroll
        for (int ks = 0; ks < 4; ++ks) s = mfma32(kc[ks], bq[ks], s);
        unsigned pk[8];
#pragma unroll
        for (int q = 0; q < 8; ++q) { const float pa = __builtin_amdgcn_exp2f((s[2 * q] - mx) * sc), pb = __builtin_amdgcn_exp2f((s[2 * q + 1] - mx) * sc); sum += pa + pb; pk[q] = pk2(pa, pb); }
#pragma unroll
        for (int sft = 0; sft < 2; ++sft) {
            const bf16x8 pb = mk8(pk[4 * sft], pk[4 * sft + 1], pk[4 * sft + 2], pk[4 * sft + 3]);
#pragma unroll
            for (int et = 0; et < 2; ++et) o[et] = mfma32(vc[sft * 2 + et], pb, o[et]);
        }
        __builtin_amdgcn_sched_barrier(0);
#pragma unroll
        for (int ks = 0; ks < 4; ++ks) kc[ks] = kn[ks];
#pragma unroll
        for (int q = 0; q < 4; ++q) vc[q] = vn[q];
    }
    sum += __shfl_xor(sum, 32);
    const float inv = 1.0f / sum;
    bf16* MA = (bf16*)(a.ws + WS_YCAT) + (size_t)tok * 1024 + 768 + hm * 64;
#pragma unroll
    for (int et = 0; et < 2; ++et)
#pragma unroll
        for (int g4 = 0; g4 < 4; ++g4) { v2u w; w.x = pk2(o[et][4 * g4] * inv, o[et][4 * g4 + 1] * inv); w.y = pk2(o[et][4 * g4 + 2] * inv, o[et][4 * g4 + 3] * inv);
            *(v2u*)(MA + et * 32 + 8 * g4 + 4 * hh) = w; }
}

__device__ __forceinline__ void r3_wave(const Ctx& C, const Args& a, int tile, int h, int ib) {
    const bf16* Z1 = (const bf16*)(a.ws + WS_Z1); const float* ROPE = (const float*)(a.ws + WS_ROPE);
    const bf16* PREV = (const bf16*)((const unsigned char*)a.out + 64 * MiB);
    const int lane = C.lane, r = lane & 31, hh = lane >> 5, u = tile * 4 + h, tok = tile * 128 + ib * 32 + r;
    const float lg2g = lg2_gamma(h);
    bf16x8 bq[8];
    { const bf16* qf = (const bf16*)(a.ws + WS_QRF) + ((size_t)(u * 4 + ib) * 8 * 64 + lane) * 8;
#pragma unroll
      for (int ks = 0; ks < 8; ++ks) bq[ks] = *(const bf16x8*)(qf + ks * 512); }
    f32x16 acc[4];
    const bf16* pbase = PREV + (size_t)u * 16384 + lane * 8;
    bf16x8 ap[4][8];
#pragma unroll
    for (int et = 0; et < 4; ++et)
#pragma unroll
        for (int ks = 0; ks < 8; ++ks) ap[et][ks] = *(const bf16x8*)(pbase + (et * 8 + ks) * 512);
    __builtin_amdgcn_sched_barrier(0);
#pragma unroll
    for (int et = 0; et < 4; ++et) {
#pragma unroll
        for (int e = 0; e < 16; ++e) acc[et][e] = 0.f;
#pragma unroll
        for (int ks = 0; ks < 8; ++ks) acc[et] = mfma32(ap[et][ks], bq[ks], acc[et]);
    }
    __builtin_amdgcn_sched_barrier(0);
    const unsigned* INN = (const unsigned*)(a.ws + WS_INNER) + ((size_t)(u * 4 + ib) * 32) * 64 + lane;
    unsigned innw[32];
#pragma unroll
    for (int q = 0; q < 32; ++q) innw[q] = INN[q * 64];
    const bf16* gp = Z1 + (size_t)tok * NZ1 + ZGR + h * 128;
    v2u gwv[16];
#pragma unroll
    for (int q = 0; q < 16; ++q) gwv[q] = *(const v2u*)(gp + (q >> 2) * 32 + 8 * (q & 3) + 4 * hh);
    const float qdec = __builtin_amdgcn_exp2f((float)(ib * 32 + r + 1) * lg2g);
    float ss = 0.f;
#pragma unroll
    for (int et = 0; et < 4; ++et)
#pragma unroll
        for (int q = 0; q < 8; ++q) { const unsigned w = innw[et * 8 + q];
            const float v0 = acc[et][2 * q] * qdec + bflo(w), v1 = acc[et][2 * q + 1] * qdec + bfhi(w);
            acc[et][2 * q] = v0; acc[et][2 * q + 1] = v1; ss += v0 * v0 + v1 * v1; }
    __builtin_amdgcn_sched_barrier(0);
    ss += __shfl_xor(ss, 32);
    const float rn = __builtin_amdgcn_rsqf(ss * (1.0f / 128.0f) + EPS);
    bf16* RET = (bf16*)(a.ws + WS_YCAT) + (size_t)tok * 1024 + h * 128;
#pragma unroll
    for (int et = 0; et < 4; ++et)
#pragma unroll
        for (int g4 = 0; g4 < 4; ++g4) { const int e0 = et * 32 + 8 * g4 + 4 * hh; const v2u gw = gwv[et * 4 + g4];
            const float g0 = bflo(gw.x), g1 = bfhi(gw.x), g2 = bflo(gw.y), g3 = bfhi(gw.y);
            v2u w; w.x = pk2(acc[et][4 * g4] * rn * g0 * sigmoidf_(g0), acc[et][4 * g4 + 1] * rn * g1 * sigmoidf_(g1));
            w.y = pk2(acc[et][4 * g4 + 2] * rn * g2 * sigmoidf_(g2), acc[et][4 * g4 + 3] * rn * g3 * sigmoidf_(g3));
            *(v2u*)(RET + e0) = w; }
}

__device__ __forceinline__ void p3_scans(const Ctx& C, const Args& a) {
    constexpr int NSKIP = 16;
    if ((int)blockIdx.x < NSKIP) return;
    const int w0 = ((int)blockIdx.x - NSKIP) * 512 + C.tid, NW = (C.G - NSKIP) * 512;
    {
        const float* KV = a.out; bf16* PREV = (bf16*)((unsigned char*)a.out + 64 * MiB);
        for (int it = w0; it < 131072; it += NW) {
            const int elem = it * 4, b = elem >> 16, h = (elem >> 14) & 3, ed = elem & 16383;
            const float cd = __builtin_amdgcn_exp2f(128.0f * lg2_gamma(h));
            const float* kp = KV + (size_t)(b * 128 + h) * 16384 + ed; bf16* pp = PREV + (size_t)(b * 128 + h) * 16384 + frag32(ed >> 7, ed & 127, 128);
            f32x4 inc[32];
#pragma unroll
            for (int c = 0; c < 32; ++c) inc[c] = *(const f32x4*)(kp + (size_t)c * 65536);
            f32x4 st = {0.f, 0.f, 0.f, 0.f};
#pragma unroll
            for (int c = 0; c < 32; ++c) { v2u w; w.x = pk2(st[0], st[1]); w.y = pk2(st[2], st[3]); *(v2u*)(pp + (size_t)c * 65536) = w; st = st * cd + inc[c]; }
        }
    }
    {
        const float* E = (const float*)(a.ws + WS_S5E); float* X = (float*)(a.ws + WS_S5X); const float* L128 = (const float*)(a.ws + WS_S5C) + 2048;
        for (int it = w0; it < 8192; it += NW) {
            const int b = it >> 10, g = (it >> 6) & 15, p = it & 63;
            const float lr = L128[(g * 64 + p) * 2], li = L128[(g * 64 + p) * 2 + 1];
            const float* ep = E + ((size_t)(b * 32) * 16 + g) * 128 + p; float* xp = X + ((size_t)(b * 32) * 16 + g) * 128 + p;
            float er[32], ei[32];
#pragma unroll
            for (int n = 0; n < 32; ++n) { er[n] = ep[(size_t)n * 2048]; ei[n] = ep[(size_t)n * 2048 + 64]; }
            float xr = 0.f, xi = 0.f;
#pragma unroll
            for (int n = 0; n < 32; ++n) { xp[(size_t)n * 2048] = xr; xp[(size_t)n * 2048 + 64] = xi;
                const float nr = lr * xr - li * xi + er[n], ni = lr * xi + li * xr + ei[n]; xr = nr; xi = ni; }
        }
    }
}

__device__ __forceinline__ int f2key(float x) { int b = __builtin_bit_cast(int, x); return b >= 0 ? b : (b ^ 0x7fffffff); }
__device__ __forceinline__ float key2f(int k) { return __builtin_bit_cast(float, k >= 0 ? k : (k ^ 0x7fffffff)); }
__device__ __forceinline__ void ce_desc(int& x, int& y) { const int hi = x > y ? x : y, lo = x > y ? y : x; x = hi; y = lo; }
__device__ __forceinline__ void sort16_desc(int (&v)[16]) {
#pragma unroll
    for (int k = 2; k <= 16; k <<= 1)
#pragma unroll
        for (int j = k >> 1; j > 0; j >>= 1)
#pragma unroll
            for (int i = 0; i < 16; ++i) { const int l = i ^ j; if (l > i) { if ((i & k) == 0) ce_desc(v[i], v[l]); else ce_desc(v[l], v[i]); } }
}
__device__ __forceinline__ void merge16_desc(int (&T)[16], const int (&N)[16]) {
#pragma unroll
    for (int i = 0; i < 16; ++i) T[i] = T[i] > N[15 - i] ? T[i] : N[15 - i];
#pragma unroll
    for (int j = 8; j > 0; j >>= 1)
#pragma unroll
        for (int i = 0; i < 16; ++i) { const int l = i ^ j; if (l > i) ce_desc(T[i], T[l]); }
}
__device__ __forceinline__ void peer_topk_half(const Args& a, int tokbase, int hp, int c, int lane, int (&T)[16]) {
    const bf16* Q2 = (const bf16*)(a.ws + WS_Q2); const bf16* KEYS = (const bf16*)(a.ws + WS_KEYS);
    const int r = lane & 31, hh = lane >> 5;
    bf16x8 bq[8];
#pragma unroll
    for (int ks = 0; ks < 8; ++ks) bq[ks] = *(const bf16x8*)(Q2 + ((((size_t)(tokbase >> 5) * 16 + hp * 2 + c) * 8 + ks) * 64 + lane) * 8);
    const bf16* kbase = KEYS + (size_t)(hp * 2 + c) * 16384 + lane * 8;
    bf16x8 akc[8], akn[8];
#pragma unroll
    for (int ks = 0; ks < 8; ++ks) akc[ks] = *(const bf16x8*)(kbase + ks * 512);
#pragma unroll
    for (int nt = 0; nt < 4; ++nt) {
        if (nt < 3) {
#pragma unroll
            for (int ks = 0; ks < 8; ++ks) akn[ks] = *(const bf16x8*)(kbase + ((nt + 1) * 8 + ks) * 512);
        }
        __builtin_amdgcn_sched_barrier(0);
        f32x16 s;
#pragma unroll
        for (int e = 0; e < 16; ++e) s[e] = 0.f;
#pragma unroll
        for (int ks = 0; ks < 8; ++ks) s = mfma32(akc[ks], bq[ks], s);
        int N[16];
#pragma unroll
        for (int e = 0; e < 16; ++e) { const int n = nt * 32 + (e & 3) + 8 * (e >> 2) + 4 * hh; N[e] = (f2key(s[e]) & ~127) | n; }
        sort16_desc(N);
        if (nt == 0) {
#pragma unroll
            for (int e = 0; e < 16; ++e) T[e] = N[e];
        } else merge16_desc(T, N);
        __builtin_amdgcn_sched_barrier(0);
#pragma unroll
        for (int ks = 0; ks < 8; ++ks) akc[ks] = akn[ks];
    }
    int P[16];
#pragma unroll
    for (int j = 0; j < 16; ++j) P[j] = __shfl_xor(T[j], 32);
    merge16_desc(T, P);
}
__device__ __forceinline__ void peer_topk_head(const Ctx& C, const Args& a, int tokbase, int hp) {
    const int lane = C.lane, r = lane & 31, hh = lane >> 5;
    int T0[16], T1[16];
    peer_topk_half(a, tokbase, hp, 0, lane, T0);
    peer_topk_half(a, tokbase, hp, 1, lane, T1);
    int F[16], L1[16], L2[16], L3[16];
#pragma unroll
    for (int j = 0; j < 16; ++j) { L1[j] = (int)0x80000000; L2[j] = (int)0x80000000; L3[j] = (int)0x80000000; }
    {
        int cnt = 0;
#pragma unroll
        for (int i0 = 0; i0 < 16; ++i0)
#pragma unroll
            for (int i1 = 0; i1 < 16; ++i1)
                if ((i0 + 1) * (i1 + 1) <= 16) {
                    const float v = key2f(T0[i0] & ~127) + key2f(T1[i1] & ~127); const int key = (f2key(v) & ~255) | (i0 * 16 + i1);
                    if (i0 == 0) F[i1] = key;
                    else { if (cnt < 16) L1[cnt] = key; else if (cnt < 32) L2[cnt - 16] = key; else L3[cnt - 32] = key; ++cnt; }
                }
    }
    sort16_desc(L1); merge16_desc(F, L1); sort16_desc(L2); merge16_desc(F, L2); sort16_desc(L3); merge16_desc(F, L3);
    LAS int* tab = (LAS int*)(C.lds + C.wave * 16384);
#pragma unroll
    for (int j = 0; j < 16; ++j) { tab[j * 64 + lane] = T0[j] & 127; tab[(16 + j) * 64 + lane] = T1[j] & 127; }
    LDS_WAIT(); asm volatile("" ::: "memory");
    const float m = key2f(F[0] & ~255);
    float e[16], sum = 0.f;
#pragma unroll
    for (int j = 0; j < 16; ++j) { e[j] = __builtin_amdgcn_exp2f((key2f(F[j] & ~255) - m) * 1.4426950408889634f); sum += e[j]; }
    const float inv = 1.0f / sum;
    const int tok = tokbase + r;
    int* IDX = (int*)(a.ws + WS_IDX) + (size_t)tok * 128 + hp * 16; float* WGT = (float*)(a.ws + WS_WGT) + (size_t)tok * 128 + hp * 16;
    unsigned ov[16];
#pragma unroll
    for (int j = 0; j < 16; ++j) { const int id = F[j] & 255; const int k0 = tab[(id >> 4) * 64 + lane], k1 = tab[(16 + (id & 15)) * 64 + lane];
        ov[j] = (hh == 0) ? (unsigned)(k0 * 128 + k1) : __builtin_bit_cast(unsigned, e[j] * inv); }
    unsigned* obase = (hh == 0) ? (unsigned*)IDX : (unsigned*)WGT;
#pragma unroll
    for (int q = 0; q < 4; ++q) { v4u w = {ov[4 * q], ov[4 * q + 1], ov[4 * q + 2], ov[4 * q + 3]}; *(v4u*)(obase + 4 * q) = w; }
    LDS_WAIT(); asm volatile("" ::: "memory");
}
typedef float f32x2v __attribute__((ext_vector_type(2)));
__device__ __forceinline__ void unpack16(const v4u a, const v4u b, float (&x)[16]) {
    const unsigned w[8] = {a.x, a.y, a.z, a.w, b.x, b.y, b.z, b.w};
#pragma unroll
    for (int i = 0; i < 8; ++i) { x[2 * i] = bflo(w[i]); x[2 * i + 1] = bfhi(w[i]); }
}
__device__ __forceinline__ void unpack16_fp8(const v4u a, float (&x)[16]) {
    const unsigned w[4] = {a.x, a.y, a.z, a.w};
#pragma unroll
    for (int i = 0; i < 4; ++i) { const f32x2v lo = __builtin_amdgcn_cvt_pk_f32_fp8((int)w[i], false), hi = __builtin_amdgcn_cvt_pk_f32_fp8((int)w[i], true);
        x[4 * i] = lo.x; x[4 * i + 1] = lo.y; x[4 * i + 2] = hi.x; x[4 * i + 3] = hi.y; }
}
__device__ __forceinline__ long mk64(unsigned lo, unsigned hi) { return (long)(((unsigned long long)hi << 32) | (unsigned long long)lo); }
__device__ __forceinline__ float dpp_swap1(float v) { return __builtin_bit_cast(float, __builtin_amdgcn_update_dpp(0, __builtin_bit_cast(int, v), 0xB1, 0xf, 0xf, true)); }
struct PHalf { v4u g[8]; };
struct PIdx { int e[8]; };
__device__ __forceinline__ void pg_idx8(const int* IDXr, int h, int hl, PIdx& I) {
    h = min(h, hl); const int* p = IDXr + (size_t)(h >> 1) * 128 + (h & 1) * 64;
#pragma unroll
    for (int j = 0; j < 8; ++j) I.e[j] = p[j * 8];
}
__device__ __forceinline__ void pg_issue(const unsigned char* TBL, const PIdx& I, int lane, PHalf& D) {
    const unsigned c16 = (unsigned)(lane & 7) * 16u;
#pragma unroll
    for (int j = 0; j < 8; ++j) D.g[j] = *(const v4u*)(TBL + ((unsigned)I.e[j] * 128u + c16));
}
__device__ __forceinline__ void pg_stage(LAS unsigned char* buf, int lane, const PHalf& D) {
    const int row8 = lane >> 3, c8 = lane & 7;
#pragma unroll
    for (int j = 0; j < 8; ++j) *(LAS v4u*)(buf + (j * 8 + row8) * 128 + ((c8 ^ row8) & 7) * 16) = D.g[j];
}
__device__ __forceinline__ void e2m1_qv(float y, unsigned& code, float& val) {
    const float m = fminf(fabsf(y), 6.0f);
    const unsigned rb = (__builtin_bit_cast(unsigned, m) + 0x00200000u) & 0xFFC00000u;
    const float sm = 0.5f * rintf(2.0f * m);
    const bool big = m >= 1.0f;
    const float v = big ? __builtin_bit_cast(float, rb) : sm;
    const unsigned c = big ? (rb >> 22) - 252u : (unsigned)(2.0f * sm);
    const unsigned sg = __builtin_bit_cast(unsigned, y) & 0x80000000u;
    code = c | (sg >> 28); val = __builtin_bit_cast(float, __builtin_bit_cast(unsigned, v) | sg);
}
__device__ __forceinline__ void pu_xprep(LAS unsigned char* xs, v2u xw, float sx, int lane) {
    const float x[4] = {bflo(xw.x) * sx, bfhi(xw.x) * sx, bflo(xw.y) * sx, bfhi(xw.y) * sx};
    unsigned hi = 0u, lo = 0u;
#pragma unroll
    for (int j = 0; j < 4; ++j) { unsigned c0, c1; float v0, v1; e2m1_qv(x[j], c0, v0); e2m1_qv((x[j] - v0) * 4.0f, c1, v1); hi |= c0 << (4 * j); lo |= c1 << (4 * j); }
    *(LAS unsigned short*)(xs + 2 * lane) = (unsigned short)hi; *(LAS unsigned short*)(xs + 128 + 2 * lane) = (unsigned short)lo;
}
typedef int v8i_t __attribute__((ext_vector_type(8)));
__device__ __forceinline__ void pu_compute(const LAS unsigned char* buf, bf16* HPt, int r, int kq, const v4u (&bfr)[2]) {
    f32x4 res[4];
    const int sclB = (r & 1) ? 0x7d7d7d7d : 0x7f7f7f7f;
    const v8i_t bv0 = {(int)bfr[0].x, (int)bfr[0].y, (int)bfr[0].z, (int)bfr[0].w, 0, 0, 0, 0}, bv1 = {(int)bfr[1].x, (int)bfr[1].y, (int)bfr[1].z, (int)bfr[1].w, 0, 0, 0, 0};
#pragma unroll
    for (int g = 0; g < 4; ++g) {
        const int row = g * 16 + r, sw = row & 7;
        const v4u a0 = *(const LAS v4u*)(buf + row * 128 + (kq ^ sw) * 16), a1 = *(const LAS v4u*)(buf + row * 128 + ((4 + kq) ^ sw) * 16);
        const v8i_t av0 = {(int)a0.x, (int)a0.y, (int)a0.z, (int)a0.w, 0, 0, 0, 0}, av1 = {(int)a1.x, (int)a1.y, (int)a1.z, (int)a1.w, 0, 0, 0, 0};
        res[g] = __builtin_amdgcn_mfma_scale_f32_16x16x128_f8f6f4(av0, bv0, (f32x4){0.f, 0.f, 0.f, 0.f}, 4  , 4  , 0, 0x7f7f7f7f, 0, sclB);
        res[g] = __builtin_amdgcn_mfma_scale_f32_16x16x128_f8f6f4(av1, bv1, res[g], 4, 4, 0, 0x7f7f7f7f, 0, sclB);
    }
    f32x4 o = res[0];
#pragma unroll
    for (int g = 1; g < 4; ++g) { const bool sel = ((r >> 1) == g);
#pragma unroll
        for (int i = 0; i < 4; ++i) o[i] = sel ? res[g][i] : o[i]; }
#pragma unroll
    for (int i = 0; i < 4; ++i) o[i] += dpp_swap1(o[i]);
    if (r < 8 && (r & 1) == 0) { v2u w; w.x = pk2(o[0], o[1]); w.y = pk2(o[2], o[3]); *(v2u*)(HPt + (r >> 1) * 16 + 4 * kq) = w; }
}
__device__ __forceinline__ int pg_idx(const int* IDXl, int h, int hl) { h = min(h, hl); return IDXl[(size_t)(h >> 1) * 128 + (h & 1) * 64]; }
__device__ __forceinline__ void peer_u_wave(const Args& a, LAS unsigned char* wlds, LAS unsigned char* wsm, int slab, int t0, int ntok, int lane) {
    const unsigned char* U8 = a.ws + WS_PU + (size_t)slab * (16384 * 128);
    const bf16* N2 = (const bf16*)(a.ws + WS_N2) + slab * 256 + 4 * lane;
    const int* IDX = (const int*)(a.ws + WS_IDX) + (lane >> 3);
    bf16* HP = (bf16*)(a.ws + WS_HPART) + (size_t)slab * MTOK * 128;
    const int r = lane & 15, kq = lane >> 4, tl = t0 + ntok - 1, H0 = 2 * t0, HL = 2 * (t0 + ntok) - 1;
    PHalf d[4]; PIdx iv[4]; v4u bfr[2];
    const float* SSp = (const float*)(a.ws + WS_SS); float ssx = SSp[t0];
#pragma unroll
    for (int k = 0; k < 4; ++k) pg_idx8(IDX, H0 + k, HL, iv[k]);
    v2u xw = *(const v2u*)(N2 + (size_t)t0 * DM);
    pg_issue(U8, iv[0], lane, d[0]); pg_issue(U8, iv[1], lane, d[1]); pg_issue(U8, iv[2], lane, d[2]);
    pg_idx8(IDX, H0 + 4, HL, iv[0]); pg_idx8(IDX, H0 + 5, HL, iv[1]); pg_idx8(IDX, H0 + 6, HL, iv[2]);
    pg_stage(wlds, lane, d[0]);
#define PU_XPREP(tok) do { pu_xprep(wsm, xw, 2.05f * __builtin_amdgcn_rsqf(ssx * (1.f / DM) + EPS), lane); \
        { const LAS unsigned char* bp = wsm + ((r & 1) ? 128 : 0) + kq * 16; bfr[0] = *(const LAS v4u*)bp; bfr[1] = *(const LAS v4u*)(bp + 64); } \
        xw = *(const v2u*)(N2 + (size_t)min((tok) + 1, tl) * DM); ssx = SSp[min((tok) + 1, tl)]; } while (0)
#define PU_PHASE(ph, hrel, tok, half) do { \
        pg_issue(U8, iv[((ph) + 3) & 3], lane, d[((ph) + 3) & 3]); pg_idx8(IDX, hb + (hrel) + 7, HL, iv[((ph) + 3) & 3]); \
        pu_compute(wlds + ((half) ? 8192 : 0), HP + (size_t)(tok) * 128 + (half) * 64, r, kq, bfr); \
        pg_stage(wlds + ((half) ? 0 : 8192), lane, d[((ph) + 1) & 3]); } while (0)
#pragma unroll 1
    for (int hb = H0; hb <= HL; hb += 4) {
        const int t = hb >> 1;
        PU_XPREP(t);
        PU_PHASE(0, 0, t, 0);
        PU_PHASE(1, 1, t, 1);
        PU_XPREP(t + 1);
        PU_PHASE(2, 2, t + 1, 0);
        PU_PHASE(3, 3, t + 1, 1);
    }
#undef PU_XPREP
#undef PU_PHASE
}
__device__ __forceinline__ void peer_reduce(const Ctx& C, const Args& a) {
    const bf16* HP = (const bf16*)(a.ws + WS_HPART); const int* IDX = (const int*)(a.ws + WS_IDX); const float* WGT = (const float*)(a.ws + WS_WGT);
    const f32x2v* SC2 = (const f32x2v*)(a.ws + WS_PSC);
    unsigned char* ACT8 = a.ws + WS_ACT; float* ASC = (float*)(a.ws + WS_ACT + 8 * MiB);
    for (int it = C.vcu * 512 + C.tid; it < MTOK * 32; it += C.G * 512) {
        f32x4 h = {0.f, 0.f, 0.f, 0.f};
#pragma unroll
        for (int sl = 0; sl < 4; ++sl) { const v2u w = *(const v2u*)(HP + (size_t)sl * MTOK * 128 + (size_t)it * 4); h[0] += bflo(w.x); h[1] += bfhi(w.x); h[2] += bflo(w.y); h[3] += bfhi(w.y); }
        const int4 e = *(const int4*)(IDX + (size_t)it * 4); const f32x4 w = *(const f32x4*)(WGT + (size_t)it * 4);
        const int tok = it >> 5, q = it & 31;
        const float rs = 1.0f / 2.05f;
        f32x4 o;
        const f32x2v s0 = SC2[e.x], s1 = SC2[e.y], s2 = SC2[e.z], s3 = SC2[e.w];
        o[0] = gelu_tanh(h[0] * s0.x * rs) * w[0] * s0.y; o[1] = gelu_tanh(h[1] * s1.x * rs) * w[1] * s1.y;
        o[2] = gelu_tanh(h[2] * s2.x * rs) * w[2] * s2.y; o[3] = gelu_tanh(h[3] * s3.x * rs) * w[3] * s3.y;
        float mx = fmaxf(fmaxf(fabsf(o[0]), fabsf(o[1])), fmaxf(fabsf(o[2]), fabsf(o[3])));
#pragma unroll
        for (int sh = 1; sh < 32; sh <<= 1) mx = fmaxf(mx, __shfl_xor(mx, sh));
        int ex = (int)((__builtin_bit_cast(unsigned, mx) >> 23) & 0xffu) - 127; if (mx < 1e-30f) ex = 7;
        const float sc = __builtin_bit_cast(float, (unsigned)(127 + 7 - ex) << 23), isc = __builtin_bit_cast(float, (unsigned)(127 - 7 + ex) << 23);
        o = o * sc;
        int hi = __builtin_amdgcn_cvt_pk_fp8_f32(o[0], o[1], 0, false); hi = __builtin_amdgcn_cvt_pk_fp8_f32(o[2], o[3], hi, true);
        const f32x2v b0 = __builtin_amdgcn_cvt_pk_f32_fp8(hi, false), b1 = __builtin_amdgcn_cvt_pk_f32_fp8(hi, true);
        int lo = __builtin_amdgcn_cvt_pk_fp8_f32(o[0] - b0.x, o[1] - b0.y, 0, false); lo = __builtin_amdgcn_cvt_pk_fp8_f32(o[2] - b1.x, o[3] - b1.y, lo, true);
        *(unsigned*)(ACT8 + (size_t)tok * 256 + 4 * q) = (unsigned)hi; *(unsigned*)(ACT8 + (size_t)tok * 256 + 128 + 4 * q) = (unsigned)lo;
        if (q == 0) ASC[tok] = isc;
    }
}
typedef int v2i_t __attribute__((ext_vector_type(2)));
__device__ __forceinline__ void pv_compute(const LAS unsigned char* buf, int lane, const long* bact2, f32x4 (&acc)[8]) {
    const int i16 = lane & 15, kq = lane >> 4, rr = i16 >> 1, cc = i16 & 1;
#pragma unroll
    for (int s2 = 0; s2 < 2; ++s2) {
        const int row = 32 * s2 + 8 * kq + rr, sw = row & 7;
#pragma unroll
        for (int nb = 0; nb < 8; ++nb) {
            const v2i_t av = __builtin_amdgcn_ds_read_tr8_b64_v2i32((LAS v2i_t*)(buf + row * 128 + ((nb ^ sw) & 7) * 16 + 8 * cc));
            acc[nb] = __builtin_amdgcn_mfma_f32_16x16x32_fp8_fp8(mk64((unsigned)av.x, (unsigned)av.y), bact2[s2], acc[nb], 0, 0, 0);
        }
    }
}
__device__ __forceinline__ void peer_v_wave(const Args& a, LAS unsigned char* wlds, int slab, int t0, int ntok, int lane) {
    const unsigned char* V8 = a.ws + WS_PV + (size_t)slab * (16384 * 128);
    const int* IDX = (const int*)(a.ws + WS_IDX) + (lane >> 3);
    const int n16 = lane & 15, kq = lane >> 4, tl = t0 + ntok - 1, H0 = 2 * t0, HL = 2 * (t0 + ntok) - 1;
    const unsigned char* ACT8 = a.ws + WS_ACT + ((n16 & 1) ? 128 : 0) + 8 * kq; const float* ASC = (const float*)(a.ws + WS_ACT + 8 * MiB);
    bf16* PO = (bf16*)(a.ws + WS_POUT) + slab * 128;
    PHalf d[4]; PIdx iv[4]; long bact[4], bnxt[4]; f32x4 acc[8]; float isc = 1.f, iscn;
#pragma unroll
    for (int k = 0; k < 4; ++k) pg_idx8(IDX, H0 + k, HL, iv[k]);
#pragma unroll
    for (int s4 = 0; s4 < 4; ++s4) bnxt[s4] = *(const long*)(ACT8 + (size_t)t0 * 256 + 32 * s4);
    iscn = ASC[t0];
    pg_issue(V8, iv[0], lane, d[0]); pg_issue(V8, iv[1], lane, d[1]); pg_issue(V8, iv[2], lane, d[2]);
    pg_idx8(IDX, H0 + 4, HL, iv[0]); pg_idx8(IDX, H0 + 5, HL, iv[1]); pg_idx8(IDX, H0 + 6, HL, iv[2]);
    pg_stage(wlds, lane, d[0]);
#define PV_APREP(tok) do { \
        _Pragma("unroll") for (int s4 = 0; s4 < 4; ++s4) bact[s4] = bnxt[s4]; isc = iscn; \
        { const int tn = min((tok) + 1, tl); \
          _Pragma("unroll") for (int s4 = 0; s4 < 4; ++s4) bnxt[s4] = *(const long*)(ACT8 + (size_t)tn * 256 + 32 * s4); iscn = ASC[tn]; } \
        _Pragma("unroll") for (int nb = 0; nb < 8; ++nb) acc[nb] = (f32x4){0.f, 0.f, 0.f, 0.f}; } while (0)
#define PV_PHASE(ph, hrel, half) do { \
        pg_issue(V8, iv[((ph) + 3) & 3], lane, d[((ph) + 3) & 3]); pg_idx8(IDX, hb + (hrel) + 7, HL, iv[((ph) + 3) & 3]); \
        pv_compute(wlds + ((half) ? 8192 : 0), lane, bact + 2 * (half), acc); \
        pg_stage(wlds + ((half) ? 0 : 8192), lane, d[((ph) + 1) & 3]); } while (0)
#define PV_EPI(tok) do { f32x4 o = acc[0]; \
        _Pragma("unroll") for (int nb = 1; nb < 8; ++nb) { const bool sel = ((n16 >> 1) == nb); \
            _Pragma("unroll") for (int i = 0; i < 4; ++i) o[i] = sel ? acc[nb][i] : o[i]; } \
        _Pragma("unroll") for (int i = 0; i < 4; ++i) o[i] += dpp_swap1(o[i]); \
        if ((n16 & 1) == 0) { v2u w; w.x = pk2(o[0] * isc, o[1] * isc); w.y = pk2(o[2] * isc, o[3] * isc); *(v2u*)(PO + (size_t)(tok) * DM + 16 * (n16 >> 1) + 4 * kq) = w; } } while (0)
#pragma unroll 1
    for (int hb = H0; hb <= HL; hb += 4) {
        const int t = hb >> 1;
        PV_APREP(t);
        PV_PHASE(0, 0, 0);
        PV_PHASE(1, 1, 1);
        PV_EPI(t);
        PV_APREP(t + 1);
        PV_PHASE(2, 2, 0);
        PV_PHASE(3, 3, 1);
        PV_EPI(t + 1);
    }
#undef PV_APREP
#undef PV_PHASE
#undef PV_EPI
}
__device__ __forceinline__ void final_rows4(const Args& a, int tok0, int tstep, int lane) {
    const float* gf = (const float*)a.in[25] + lane * 4;
    f32x4 h[4][4]; v2u pw[4][4], hw[4][4]; float ss[4];
#pragma unroll
    for (int i = 0; i < 4; ++i) { const int tok = tok0 + i * tstep; const bf16* hb = (const bf16*)(a.ws + WS_N2) + (size_t)tok * DM + lane * 4; const bf16* po = (const bf16*)(a.ws + WS_POUT) + (size_t)tok * DM + lane * 4;
#pragma unroll
        for (int q = 0; q < 4; ++q) { hw[i][q] = *(const v2u*)(hb + 256 * q); pw[i][q] = *(const v2u*)(po + 256 * q); } }
#pragma unroll
    for (int i = 0; i < 4; ++i) { ss[i] = 0.f;
#pragma unroll
        for (int q = 0; q < 4; ++q) { h[i][q][0] = bflo(hw[i][q].x) + bflo(pw[i][q].x); h[i][q][1] = bfhi(hw[i][q].x) + bfhi(pw[i][q].x); h[i][q][2] = bflo(hw[i][q].y) + bflo(pw[i][q].y); h[i][q][3] = bfhi(hw[i][q].y) + bfhi(pw[i][q].y);
            ss[i] += (h[i][q][0] * h[i][q][0] + h[i][q][1] * h[i][q][1]) + (h[i][q][2] * h[i][q][2] + h[i][q][3] * h[i][q][3]); } }
#pragma unroll
    for (int o = 1; o < 64; o <<= 1)
#pragma unroll
        for (int i = 0; i < 4; ++i) ss[i] += __shfl_xor(ss[i], o);
    f32x4 g[4];
#pragma unroll
    for (int q = 0; q < 4; ++q) g[q] = *(const f32x4*)(gf + 256 * q);
#pragma unroll
    for (int i = 0; i < 4; ++i) { const float rstd = 1.0f / sqrtf(ss[i] * (1.f / DM) + EPS); float* orow = a.out + (size_t)(tok0 + i * tstep) * DM + lane * 4;
#pragma unroll
        for (int q = 0; q < 4; ++q) *(f32x4*)(orow + 256 * q) = h[i][q] * rstd * g[q]; }
}

__device__ __forceinline__ void claim_slab_unit(const Ctx& C, unsigned* ctl, int pass, volatile LAS unsigned* MISC, int& slab, int& unit) {
    if (C.tid == 0) {
        const unsigned ns = pass == 0 ? 4u : 8u, nu = 256u / ns;
        const unsigned x = xb_xcc_id() & (ns - 1u); unsigned sl = 8u, un = 0u;
        for (unsigned k = 0; k < ns; ++k) { const unsigned s2 = (x + k) & (ns - 1u); const unsigned u2 = xb_add(ctl + CW_Q + 1024 * pass + 64 * s2, 1u); if (u2 < nu) { sl = s2; un = u2; break; } }
        MISC[16] = sl; MISC[17] = un;
    }
    __syncthreads();
    slab = (int)MISC[16]; unit = (int)MISC[17];
    __syncthreads();
}
__global__ void __launch_bounds__(NWAVES * 64, 2) mk_fwd(Args args) {
    extern __shared__ __attribute__((aligned(16))) unsigned char lds_raw[];
    Ctx C;
    C.lds = (LAS unsigned char*)lds_raw;
    C.wave = __builtin_amdgcn_readfirstlane((int)threadIdx.x >> 6); C.refresh();
    C.G = gridDim.x; { const int bx = blockIdx.x; C.vcu = (C.G % 8 == 0) ? (bx % 8) * (C.G / 8) + bx / 8 : bx; }
    volatile LAS unsigned* MISC = (volatile LAS unsigned*)(C.lds + MISC_OFF);
    if (C.tid < 128) MISC[C.tid] = 0u;
    __syncthreads();
    unsigned char* ws = args.ws;
    unsigned* ctl = (unsigned*)(ws + WS_CTL);
    XcdBarrier bar; bar.bar = ctl + CW_BAR; bar.x = 0; bar.st = nullptr;
#if !MK_PER_PHASE
    bar = xcd_barrier_post(ctl + CW_BAR, MISC + 8, C.tid == 0);
#define GRID_BAR() xcd_barrier(bar, C.wave)
#else
#define GRID_BAR() do { } while (0)
#endif
    const int lo = args.ph_lo, hi = args.ph_hi;
#define IN(k) (lo <= (k) && (k) < hi)
#define SEAM(k) do { if (IN((k) + 1)) GRID_BAR(); C.refresh(); } while (0)
#define REP(k) for (int rep_ = 0; rep_ < 1 + ((REPEAT_MASK >> (k)) & 1); ++rep_)
    bf16* XN = (bf16*)(ws + WS_A);
    if (IN(0)) { REP(0) { p0_prologue(C, args); __syncthreads(); } SEAM(0); }
    if (IN(1)) {
        REP(1) {
        run_gemm(C, XN, (const bf16*)(ws + WS_WIN_T), MTOK, NZ1, DM, FStore{(bf16*)(ws + WS_Z1), NZ1});
        }
        SEAM(1);
    }
    if (IN(2)) {
        REP(2) { const int tile = C.vcu;
            {
                const int i_ = C.tid >> 2, dq_ = (C.tid & 3) * 16, eq_ = (C.tid & 3) * 32;
                const bf16* zr_ = (const bf16*)(ws + WS_Z1) + (size_t)(tile * 128 + i_) * NZ1; const float* rp_ = (const float*)(ws + WS_ROPE) + (size_t)(tile * 128 + i_) * 128;
                float cs_[16], sn_[16];
#pragma unroll
                for (int q = 0; q < 4; ++q) { const f32x4 c4 = *(const f32x4*)(rp_ + dq_ + 4 * q), s4 = *(const f32x4*)(rp_ + 64 + dq_ + 4 * q);
#pragma unroll
                    for (int e = 0; e < 4; ++e) { cs_[4 * q + e] = c4[e]; sn_[4 * q + e] = s4[e]; } }
                R1In ra_, rb_;
                r1_load(zr_, 0, dq_, eq_, ra_);
                _Pragma("unroll 1") for (int h2 = 0; h2 < 4; h2 += 2) {
                    r1_unit(C, args, tile, h2, cs_, sn_, ra_, rb_, true);
                    r1_unit(C, args, tile, h2 + 1, cs_, sn_, rb_, ra_, h2 == 0);
                }
            }
            C.refresh();
            _Pragma("unroll 1") for (int gi = 0; gi < 2; ++gi) s5a_wave(C, args, tile, C.wave + 8 * gi);
            __syncthreads();
        }
        SEAM(2);
    }
    if (IN(3)) { REP(3) { p3_scans(C, args); }
        run_gemm(C, (const bf16*)(ws + WS_MEMN), (const bf16*)(ws + WS_WMKV_T), MROWS, 512, DM, FKvm{(bf16*)(ws + WS_KM), (bf16*)(ws + WS_VT)});
        SEAM(3); }
    if (IN(4)) {
        REP(4) { const int tile = C.vcu;
            _Pragma("unroll 1") for (int gi = 0; gi < 2; ++gi) r3_wave(C, args, tile, 2 * gi + (C.wave >> 2), C.wave & 3);
            _Pragma("unroll 1") for (int gi = 0; gi < 2; ++gi) s5c_wave(C, args, tile, C.wave + 8 * gi);
            _Pragma("unroll 1") for (int gi = 0; gi < 2; ++gi) ma_wave(C, args, tile, 2 * gi + (C.wave >> 2), C.wave & 3);
        }
        SEAM(4);
    }
    if (IN(5)) {
        REP(5) {
        run_gemm_mx(C, ws + WS_XN8, ws + WS_WG8, MTOK, NGATE, DM, FSig{(bf16*)(ws + WS_G), NGATE}, 0x7b7b7b7b  , 0x77777777  );
        run_gemm(C, (const bf16*)(ws + WS_YG), (const bf16*)(ws + WS_WGLU_T), MTOK, 512, 256, FGlu{(bf16*)(ws + WS_YCAT)});
        }
        SEAM(5);
    }
    if (IN(6)) {
        const bf16* Gt = (const bf16*)(ws + WS_G);
        run_gemm_hook(C, (const bf16*)(ws + WS_YCAT), (const bf16*)(ws + WS_WCAT_T), MTOK, DM, DM, FGateOut{Gt, XN}, HookGate{Gt});
        SEAM(6);
    }
    if (IN(7)) { run_gemm(C, XN, (const bf16*)(ws + WS_WOUT_T), MTOK, DM, DM, FRes{(const float*)args.in[0], (bf16*)(ws + WS_N2), (float*)(ws + WS_SS)}); SEAM(7); }
    if (IN(9)) { REP(9) run_gemm(C, (const bf16*)(ws + WS_N2), (const bf16*)(ws + WS_WQ_T), MTOK, 2048, DM, FStoreRstd{(bf16*)(ws + WS_Q2), 2048, (const float*)(ws + WS_SS)}); SEAM(9); }
    if (IN(10)) {
        { const int tile = C.vcu;
            const int tokbase = tile * 128 + (C.wave & 3) * 32, h0 = (C.wave >> 2) * 4;
            REP(10) { _Pragma("unroll 1") for (int hp = h0; hp < h0 + 4; ++hp) peer_topk_head(C, args, tokbase, hp); }
        }
        SEAM(10);
    }
    if (IN(11)) { int slab, unit; claim_slab_unit(C, ctl, 0, MISC, slab, unit); if (slab < 8) { REP(11) peer_u_wave(args, C.lds + C.wave * 16384, C.lds + 131072 + C.wave * 1024, slab, unit * 512 + C.wave * 64, 64, C.lane); } SEAM(11); }
    if (IN(12)) { REP(12) peer_reduce(C, args); SEAM(12); }
    if (IN(13)) { int slab, unit; claim_slab_unit(C, ctl, 1, MISC, slab, unit); if (slab < 8) { REP(13) peer_v_wave(args, C.lds + C.wave * 16384, slab, unit * 1024 + C.wave * 128, 128, C.lane); } SEAM(13); }
    if (IN(14)) {
        const int gw = C.vcu * NWAVES + C.wave, NGW = C.G * NWAVES;
        for (int m = gw; m < MTOK; m += 4 * NGW) final_rows4(args, m, NGW, C.lane);
    }
#undef IN
#undef SEAM
}

extern "C" void kernel_launch(void* const* d_in, const int* in_sizes, int n_in, void* d_out, int out_size, void* d_ws, size_t ws_size, hipStream_t stream) {
    static int grid = 0;
    if (grid == 0) {
        if (n_in != 26 || in_sizes[0] != MTOK * DM || out_size != MTOK * DM || ws_size < WS_END) {
            fprintf(stderr, "kernel_launch: unexpected problem (n_in %d, in0 %d, out %d, ws %zu < %zu); nothing launched\n", n_in, n_in > 0 ? in_sizes[0] : -1, out_size, ws_size, (size_t)WS_END); grid = -1; return; }
        int dev = 0, cus = 0;
        if (hipGetDevice(&dev) != hipSuccess || hipDeviceGetAttribute(&cus, hipDeviceAttributeMultiprocessorCount, dev) != hipSuccess) { grid = -1; return; }
        if (hipFuncSetAttribute((const void*)mk_fwd, hipFuncAttributeMaxDynamicSharedMemorySize, LDS_BYTES) != hipSuccess) { fprintf(stderr, "kernel_launch: hipFuncSetAttribute failed\n"); grid = -1; return; }
        (void)hipGetLastError();
        if (cus < NTILES) { fprintf(stderr, "kernel_launch: needs >= 256 CUs, got %d\n", cus); grid = -1; return; }
        grid = NTILES;
    }
    if (grid < 0) return;
    (void)hipMemsetAsync((char*)d_ws + WS_CTL, 0, CTL_ZERO_BYTES, stream);
    Args a{};
    for (int i = 0; i < 26; ++i) a.in[i] = d_in[i];
    a.out = (float*)d_out; a.ws = (unsigned char*)d_ws;
#if MK_PER_PHASE
    for (int p = 0; p < NPHASE; ++p) { a.ph_lo = p; a.ph_hi = p + 1; hipLaunchKernelGGL(mk_fwd, dim3(grid), dim3(NWAVES * 64), LDS_BYTES, stream, a); }
#else
    a.ph_lo = 0; a.ph_hi = NPHASE;
    hipLaunchKernelGGL(mk_fwd, dim3(grid), dim3(NWAVES * 64), LDS_BYTES, stream, a);
#endif
}
```

```cpp
#include <hip/hip_runtime.h>
#include <cstdio>
#include <cstdint>
namespace pg8 {
__device__ __forceinline__ int hw_lane_id() { int l; asm volatile("v_mbcnt_lo_u32_b32 %0, -1, 0\n\tv_mbcnt_hi_u32_b32 %0, -1, %0" : "=v"(l)); return l; }
#define PG8_LAS __attribute__((address_space(3)))
typedef unsigned short bf16_t;
typedef short bf16x8 __attribute__((ext_vector_type(8)));
typedef float f32x4 __attribute__((ext_vector_type(4)));
typedef unsigned u32x4 __attribute__((ext_vector_type(4)));
constexpr int BM = 256, BK = 64, HALF = 128, HTB = HALF * BK * 2  , STAGE_BYTES = 8 * HTB, NXCD = 8, WGM = 8;

__host__ __device__ __forceinline__ int lds_byte(int r, int c) { const int st = (r >> 4) * 2 + (c >> 5), rr = r & 15, cc = c & 31, ob = rr * 64 + cc * 2; return st * 1024 + (ob ^ (((ob >> 9) & 1) << 5)); }
__host__ __device__ __forceinline__ void stage_rc(int b, int& R, int& C) { const int st = b / 1024, sb = b % 1024, swz = sb ^ (((sb >> 9) & 1) << 5); R = (st >> 1) * 16 + swz / 64; C = (st & 1) * 32 + (swz % 64) / 2; }
__host__ __device__ __forceinline__ int perm32(int rho) { const int n = rho >> 4, i = rho & 15; return 8 * (i >> 2) + 4 * n + (i & 3); }

struct Unit { int pm, pn; };
struct Gemm { const bf16_t* A; const bf16_t* Bt; int M, N, K; };

struct StaticOrder {
    int nM, nN, nwg, G, c;
    __host__ __device__ void init(int M, int N, int G_, int c_) { nM = M / BM; nN = N / BM; nwg = nM * nN; G = G_; c = c_; }
    __host__ __device__ bool next(int i, Unit& u) const {
        const long L = (long)i * G + c; if (L >= nwg) return false;
        int wgid = (int)L; { const int q = nwg / NXCD, r = nwg % NXCD, xcd = wgid % NXCD, off = wgid / NXCD; wgid = (xcd < r ? xcd * (q + 1) : r * (q + 1) + (xcd - r) * q) + off; }
        const int nig = WGM * nN, gid = wgid / nig, fm = gid * WGM, gsz = (nM - fm) < WGM ? (nM - fm) : WGM;
        u.pm = fm + ((wgid % nig) % gsz); u.pn = (wgid % nig) / gsz; return true;
    }
    __device__ __forceinline__ void a_ready(const Unit&) const {}
    __device__ __forceinline__ void done(const Unit&) const {}
};

__device__ __forceinline__ unsigned cvt_pk_bf16(float lo, float hi) { unsigned r; asm volatile("v_cvt_pk_bf16_f32 %0, %1, %2" : "=v"(r) : "v"(lo), "v"(hi)); return r; }
struct NoKHook { __device__ __forceinline__ void operator()(int, f32x4 (&)[2][2][4][2], const Unit&, int, int, int, int) const {} };
template <class Epi, class Sched, bool ALIGN_EPI = false, bool SP2 = false, bool MX = false, class KHook = NoKHook>
__device__ __forceinline__ void gemm_phase(PG8_LAS unsigned char* lds, const Gemm g, const Sched& S, const Epi& E, const int wid, const int sclA = 0x7f7f7f7f, const int sclB = 0x7f7f7f7f, const KHook& KH = KHook()) {
    const int lane = hw_lane_id(), tid = wid * 64 + lane, wr = wid >> 2, wc = wid & 3, fr = lane & 15, fq = lane >> 4;
    const int K = g.K, nt = K / BK;
    unsigned voffA[2], voffB[2];
#pragma unroll
    for (int i = 0; i < 2; ++i) { int R, C; stage_rc(tid * 16 + i * 8192, R, C); const int Rb = Epi::PERM ? ((R & ~31) + perm32(R & 31)) : R;
        voffA[i] = (unsigned)(R * K + C) * 2u; voffB[i] = (unsigned)(Rb * K + C) * 2u; }
    const size_t kstep = (size_t)(BK * 2);
    const size_t hstep = (size_t)HALF * K * 2;
    const size_t tstep = 2 * hstep;
    const unsigned ldsw = (unsigned)wid * 1024u;
    const int aoff = lds_byte(wr * 64 + fr, fq * 8), boff = lds_byte(wc * 32 + fr, fq * 8);
#define PG8_SA(b, h) (((b) * 2 + (h)) * HTB)
#define PG8_SB(b, h) ((4 + (b) * 2 + (h)) * HTB)
#define PG8_STAGE(bufoff, gbase, voff) do { _Pragma("unroll") for (int _i = 0; _i < 2; ++_i) \
        __builtin_amdgcn_global_load_lds((const unsigned*)((const char*)(gbase) + (voff)[_i]), (PG8_LAS unsigned*)(lds + (bufoff) + ldsw + _i * 8192), 16, 0, 0); } while (0)
#define PG8_LDA(dst, b, h) do { _Pragma("unroll") for (int m = 0; m < 4; ++m) { \
        if constexpr (MX) { dst##8[m].lo = *(const PG8_LAS v4i_*)(lds + PG8_SA(b, h) + aoff + m * 2048); dst##8[m].hi = *(const PG8_LAS v4i_*)(lds + PG8_SA(b, h) + aoff + m * 2048 + 1024); } \
        else { _Pragma("unroll") for (int k = 0; k < 2; ++k) dst[m][k] = *(const PG8_LAS bf16x8*)(lds + PG8_SA(b, h) + aoff + m * 2048 + k * 1024); } } } while (0)
#define PG8_LDB(dst, b, h) do { _Pragma("unroll") for (int n = 0; n < 2; ++n) { \
        if constexpr (MX) { dst##8[n].lo = *(const PG8_LAS v4i_*)(lds + PG8_SB(b, h) + boff + n * 2048); dst##8[n].hi = *(const PG8_LAS v4i_*)(lds + PG8_SB(b, h) + boff + n * 2048 + 1024); } \
        else { _Pragma("unroll") for (int k = 0; k < 2; ++k) dst[n][k] = *(const PG8_LAS bf16x8*)(lds + PG8_SB(b, h) + boff + n * 2048 + k * 1024); } } } while (0)
#define PG8_MMA(ai, bj, At, Bt) do { __builtin_amdgcn_s_setprio(1); _Pragma("unroll") for (int m = 0; m < 4; ++m) _Pragma("unroll") for (int n = 0; n < 2; ++n) { \
        if constexpr (MX) acc[ai][bj][m][n] = __builtin_amdgcn_mfma_scale_f32_16x16x128_f8f6f4(Bt##8[n], At##8[m], acc[ai][bj][m][n], 0, 0, 0, sclB, 0, sclA); \
        else { _Pragma("unroll") for (int k = 0; k < 2; ++k) acc[ai][bj][m][n] = __builtin_amdgcn_mfma_f32_16x16x32_bf16(Bt[n][k], At[m][k], acc[ai][bj][m][n], 0, 0, 0); } } \
        if constexpr (MX) { _Pragma("unroll") for (int m = 0; m < 4; ++m) _Pragma("unroll") for (int n = 0; n < 2; ++n) asm volatile("" : "+v"(acc[ai][bj][m][n])); }     \
        __builtin_amdgcn_s_setprio(0); } while (0)
#define PG8_WAIT_V(n) asm volatile("s_waitcnt vmcnt(" #n ")" ::: "memory")
#define PG8_WAIT_L(n) asm volatile("s_waitcnt lgkmcnt(" #n ")" ::: "memory")
#define PG8_BAR __builtin_amdgcn_s_barrier()
#define PG8_SCHED __builtin_amdgcn_sched_barrier(0)
    Unit cur, nxt; int ui = 0;
    if (!S.next(0, cur)) return;
    f32x4 acc[2][2][4][2];
#pragma unroll
    for (int a = 0; a < 2; ++a)
#pragma unroll
        for (int b = 0; b < 2; ++b)
#pragma unroll
            for (int m = 0; m < 4; ++m)
#pragma unroll
                for (int n = 0; n < 2; ++n) acc[a][b][m][n] = (f32x4){0.f, 0.f, 0.f, 0.f};
    typedef int v8i_ __attribute__((ext_vector_type(8))); typedef int v4i_ __attribute__((ext_vector_type(4)));
    bf16x8 At[4][2], B0[2][2], B1[2][2]; v8i_ At8[4], B08[2], B18[2];
    const char* cA = (const char*)g.A + (size_t)cur.pm * tstep; const char* cB = (const char*)g.Bt + (size_t)cur.pn * tstep;
    S.a_ready(cur);
    if constexpr (SP2) {
        PG8_STAGE(PG8_SB(0, 0), cB, voffB); PG8_STAGE(PG8_SB(0, 1), cB + hstep, voffB); PG8_STAGE(PG8_SA(0, 0), cA, voffA); PG8_STAGE(PG8_SA(0, 1), cA + hstep, voffA);
        if (wr == 1) PG8_BAR;
        PG8_WAIT_V(2); PG8_BAR;
        PG8_STAGE(PG8_SB(1, 0), cB + kstep, voffB); PG8_STAGE(PG8_SA(1, 0), cA + kstep, voffA); PG8_STAGE(PG8_SB(1, 1), cB + hstep + kstep, voffB);
        PG8_WAIT_V(6); PG8_BAR;
    } else {
        PG8_STAGE(PG8_SB(0, 0), cB, voffB); PG8_STAGE(PG8_SA(0, 0), cA, voffA); PG8_STAGE(PG8_SB(0, 1), cB + hstep, voffB); PG8_STAGE(PG8_SA(0, 1), cA + hstep, voffA);
        if (wr == 1) PG8_BAR;
        PG8_WAIT_V(4); PG8_BAR;
        PG8_STAGE(PG8_SB(1, 0), cB + kstep, voffB); PG8_STAGE(PG8_SA(1, 0), cA + kstep, voffA); PG8_STAGE(PG8_SB(1, 1), cB + hstep + kstep, voffB);
        PG8_WAIT_V(6); PG8_BAR;
    }
    for (;;) {
        const bool has_next = S.next(ui + 1, nxt);
        const char* nA = has_next ? (const char*)g.A + (size_t)nxt.pm * tstep : cA; const char* nB = has_next ? (const char*)g.Bt + (size_t)nxt.pn * tstep : cB;
        for (int t = 0; t < nt; t += 2) {
            KH(t, acc, cur, wr, wc, fr, fq);
            const bool last = (t == nt - 2);
            const char* a1 = cA + (size_t)(t + 1) * kstep;
            const char* a2 = last ? nA : cA + (size_t)(t + 2) * kstep; const char* b2 = last ? nB : cB + (size_t)(t + 2) * kstep;
            const char* a3 = a2 + kstep; const char* b3 = b2 + kstep;
            if (last && has_next) S.a_ready(nxt);
            if constexpr (SP2) {
            PG8_LDB(B0, 0, 0); PG8_LDB(B1, 0, 1); PG8_SCHED; PG8_LDA(At, 0, 0); PG8_STAGE(PG8_SA(1, 1), a1 + hstep, voffA);
            PG8_WAIT_V(8); PG8_WAIT_L(0); PG8_BAR; PG8_MMA(0, 0, At, B0); PG8_MMA(0, 1, At, B1); PG8_BAR; PG8_SCHED;
            PG8_LDA(At, 0, 1); PG8_STAGE(PG8_SB(0, 0), b2, voffB); PG8_STAGE(PG8_SB(0, 1), b2 + hstep, voffB); PG8_STAGE(PG8_SA(0, 0), a2, voffA);
            PG8_WAIT_V(8); PG8_WAIT_L(0); PG8_BAR; PG8_MMA(1, 0, At, B0); PG8_MMA(1, 1, At, B1); PG8_BAR; PG8_SCHED;
            PG8_LDB(B0, 1, 0); PG8_LDB(B1, 1, 1); PG8_SCHED; PG8_LDA(At, 1, 0); PG8_STAGE(PG8_SA(0, 1), a2 + hstep, voffA);
            PG8_WAIT_V(8); PG8_WAIT_L(0); PG8_BAR; PG8_MMA(0, 0, At, B0); PG8_MMA(0, 1, At, B1); PG8_BAR; PG8_SCHED;
            PG8_LDA(At, 1, 1); PG8_STAGE(PG8_SB(1, 0), b3, voffB); PG8_STAGE(PG8_SB(1, 1), b3 + hstep, voffB); PG8_STAGE(PG8_SA(1, 0), a3, voffA);
            PG8_WAIT_V(8); PG8_WAIT_L(0); PG8_BAR; PG8_MMA(1, 0, At, B0); PG8_MMA(1, 1, At, B1); PG8_BAR; PG8_SCHED;
            } else {
            PG8_LDB(B0, 0, 0); PG8_SCHED; PG8_LDA(At, 0, 0); PG8_STAGE(PG8_SA(1, 1), a1 + hstep, voffA);
            PG8_WAIT_L(8); PG8_BAR; PG8_WAIT_L(0); PG8_MMA(0, 0, At, B0); PG8_BAR; PG8_SCHED;
            PG8_LDB(B1, 0, 1); PG8_STAGE(PG8_SB(0, 0), b2, voffB);
            PG8_BAR; PG8_WAIT_L(0); PG8_MMA(0, 1, At, B1); PG8_BAR;
            PG8_LDA(At, 0, 1); PG8_STAGE(PG8_SA(0, 0), a2, voffA);
            PG8_BAR; PG8_WAIT_L(0); PG8_MMA(1, 0, At, B0); PG8_BAR; PG8_SCHED;
            PG8_STAGE(PG8_SB(0, 1), b2 + hstep, voffB);
            PG8_WAIT_V(6); PG8_BAR; PG8_MMA(1, 1, At, B1); PG8_BAR;
            PG8_LDB(B0, 1, 0); PG8_SCHED; PG8_LDA(At, 1, 0); PG8_STAGE(PG8_SA(0, 1), a2 + hstep, voffA);
            PG8_WAIT_L(8); PG8_BAR; PG8_WAIT_L(0); PG8_MMA(0, 0, At, B0); PG8_BAR; PG8_SCHED;
            PG8_LDB(B1, 1, 1); PG8_STAGE(PG8_SB(1, 0), b3, voffB);
            PG8_BAR; PG8_WAIT_L(0); PG8_MMA(0, 1, At, B1); PG8_BAR;
            PG8_LDA(At, 1, 1); PG8_STAGE(PG8_SA(1, 0), a3, voffA);
            PG8_BAR; PG8_WAIT_L(0); PG8_MMA(1, 0, At, B0); PG8_BAR; PG8_SCHED;
            PG8_STAGE(PG8_SB(1, 1), b3 + hstep, voffB);
            PG8_WAIT_V(6); PG8_BAR; PG8_MMA(1, 1, At, B1); PG8_BAR;
            }
        }
        if constexpr (ALIGN_EPI) { if (wr == 0) PG8_BAR; }
        if constexpr (!Epi::AFTER_DRAIN) { E(acc, cur, wr, wc, fr, fq); S.done(cur); }
        if (!has_next) break;
#pragma unroll
        for (int a = 0; a < 2; ++a)
#pragma unroll
            for (int b = 0; b < 2; ++b)
#pragma unroll
                for (int m = 0; m < 4; ++m)
#pragma unroll
                    for (int n = 0; n < 2; ++n) acc[a][b][m][n] = (f32x4){0.f, 0.f, 0.f, 0.f};
        cur = nxt; cA = nA; cB = nB; ++ui;
        if constexpr (ALIGN_EPI) { if (wr == 1) PG8_BAR; }
    }
    PG8_WAIT_V(0);
    if constexpr (!ALIGN_EPI) { if (wr == 0) PG8_BAR; }
    PG8_BAR;
    if constexpr (Epi::AFTER_DRAIN) { E.fused(acc, cur, wr, wc, fr, fq, lds, wid, lane); S.done(cur); }
#undef PG8_SA
#undef PG8_SB
#undef PG8_STAGE
#undef PG8_LDA
#undef PG8_LDB
#undef PG8_MMA
#undef PG8_WAIT_V
#undef PG8_WAIT_L
#undef PG8_BAR
#undef PG8_SCHED
}
}

#ifndef REPEAT_MASK
#define REPEAT_MASK 0
#endif
#ifndef MK_PER_PHASE
#define MK_PER_PHASE 0
#endif

constexpr int DM = 1024, BATCH = 8, SEQ = 4096, MTOK = BATCH * SEQ;
constexpr int MEMLEN = 256, MROWS = BATCH * MEMLEN;
constexpr int NZ1 = 2560, NGATE = 3072;
constexpr int ZQ = 0, ZK = 512, ZV = 1024, ZGR = 1536, ZU = 2048, ZQM = 2304;
constexpr int NTILES = MTOK / 128;
constexpr float EPS = 1e-6f;
constexpr int NPHASE = 15;

constexpr size_t MiB = 1u << 20;
constexpr size_t WS_CTL = 0, CTL_ZERO_BYTES = 1 * MiB;
constexpr size_t WS_WIN_T = 1 * MiB;
constexpr size_t WS_WQ_T = 12 * MiB;
constexpr size_t WS_WOUT_T = 16 * MiB;
constexpr size_t WS_WCAT_T = 18 * MiB;
constexpr size_t WS_WGLU_T = 20 * MiB;
constexpr size_t WS_WMKV_T = 21 * MiB;
constexpr size_t WS_KEYS = 22 * MiB;
constexpr size_t WS_S5MAT = 23 * MiB;
constexpr size_t WS_S5C = 25 * MiB;
constexpr size_t WS_PSC = 25 * MiB + 256 * 1024;
constexpr size_t WS_SS = 25 * MiB + 512 * 1024;
constexpr size_t WS_ROPE = 26 * MiB;
constexpr size_t WS_PU = 42 * MiB;
constexpr size_t WS_PV = 58 * MiB;
constexpr size_t WS_XN8 = 74 * MiB;
constexpr size_t WS_WG8 = WS_WIN_T + 5 * MiB;
constexpr size_t WS_MEMN = 106 * MiB;
constexpr size_t WS_KM = 110 * MiB;
constexpr size_t WS_VT = 111 * MiB;
constexpr size_t WS_S5E = 112 * MiB;
constexpr size_t WS_S5X = 114 * MiB;
constexpr size_t WS_A = 116 * MiB;
constexpr size_t WS_B = 180 * MiB;
constexpr size_t WS_Z1 = WS_B;
constexpr size_t WS_G = WS_B;
constexpr size_t WS_QRF = WS_B + 160 * MiB;
constexpr size_t WS_YCAT = WS_B + 192 * MiB;
constexpr size_t WS_YG = WS_B + 256 * MiB;
constexpr size_t WS_INNER = WS_B + 272 * MiB;
constexpr size_t WS_N2 = WS_B;
constexpr size_t WS_Q2 = WS_B + 64 * MiB;
constexpr size_t WS_IDX = WS_B + 192 * MiB;
constexpr size_t WS_WGT = WS_B + 208 * MiB;
constexpr size_t WS_HPART = WS_B + 128 * MiB;
constexpr size_t WS_ACT = WS_B + 224 * MiB;
constexpr size_t WS_POUT = WS_B + 64 * MiB;
constexpr size_t WS_END = WS_B + 304 * MiB;

constexpr int CW_BAR = 4096;
constexpr int CW_Q = 8192;

constexpr int LDS_BYTES = 147456;
constexpr int MISC_OFF = LDS_BYTES - 512;
constexpr int NWAVES = 8;

#define GAS __attribute__((address_space(1)))
#define LAS __attribute__((address_space(3)))
typedef unsigned short bf16;
typedef unsigned v4u __attribute__((ext_vector_type(4)));
typedef unsigned v2u __attribute__((ext_vector_type(2)));
typedef float f32x4 __attribute__((ext_vector_type(4)));
typedef float f32x16 __attribute__((ext_vector_type(16)));
typedef short bf16x8 __attribute__((ext_vector_type(8)));
typedef GAS unsigned gu32;
#define RLX_AGENT __ATOMIC_RELAXED, __HIP_MEMORY_SCOPE_AGENT
#define LDS_WAIT() asm volatile("s_waitcnt lgkmcnt(0)" ::: "memory")
#define VM_WAIT() asm volatile("s_waitcnt vmcnt(0)" ::: "memory")
__device__ __forceinline__ unsigned f2bf(float f) { unsigned u = __builtin_bit_cast(unsigned, f); return (u + 0x7fffu + ((u >> 16) & 1u)) >> 16; }
typedef __bf16 hwbf16x2_t __attribute__((ext_vector_type(2)));
typedef float hwf32x2_t __attribute__((ext_vector_type(2)));
__device__ __forceinline__ unsigned pk2(float lo, float hi) { const hwf32x2_t v = {lo, hi}; const hwbf16x2_t b = __builtin_convertvector(v, hwbf16x2_t); return __builtin_bit_cast(unsigned, b); }
__device__ __forceinline__ float bflo(unsigned w) { return __builtin_bit_cast(float, w << 16); }
__device__ __forceinline__ float bfhi(unsigned w) { return __builtin_bit_cast(float, w & 0xffff0000u); }
__device__ __forceinline__ float bf2f(bf16 h) { return __builtin_bit_cast(float, (unsigned)h << 16); }
__device__ __forceinline__ f32x16 mfma32(bf16x8 a, bf16x8 b, f32x16 c) { return __builtin_amdgcn_mfma_f32_32x32x16_bf16(a, b, c, 0, 0, 0); }
__device__ __forceinline__ f32x4 mfma16(bf16x8 a, bf16x8 b, f32x4 c) { return __builtin_amdgcn_mfma_f32_16x16x32_bf16(a, b, c, 0, 0, 0); }
__device__ __forceinline__ bf16x8 mk8(unsigned a, unsigned b, unsigned c, unsigned d) { v4u t = {a, b, c, d}; return __builtin_bit_cast(bf16x8, t); }
__device__ __forceinline__ float sigmoidf_(float x) { return __builtin_amdgcn_rcpf(1.0f + __builtin_amdgcn_exp2f(-1.4426950408889634f * x)); }
__device__ __forceinline__ float gelu_tanh(float x) {
    const float u2 = 1.5957691216057308f * (x + 0.044715f * x * x * x);
    return x * __builtin_amdgcn_rcpf(1.0f + __builtin_amdgcn_exp2f(-1.4426950408889634f * u2));
}
__device__ __forceinline__ float wave_sum(float v) {
#pragma unroll
    for (int o = 1; o < 64; o <<= 1) v += __shfl_xor(v, o);
    return v;
}

#define XB_TMO      128
#define XB_XCNT(j)  (256  + 64 * (j))
#define XB_XSUB(j)  (1280 + 64 * (j))
#define XB_XGEN(j)  (2304 + 64 * (j))
#define XB_TOP      3328
#define XB_TOPGEN   3392
#define XCD_BAR_WORDS 3456
#define XB_SPIN_CAP (1u << 22)

__device__ __forceinline__ unsigned xb_ld(unsigned* p)              { return __hip_atomic_load(p, __ATOMIC_RELAXED, __HIP_MEMORY_SCOPE_AGENT); }
__device__ __forceinline__ unsigned xb_add(unsigned* p, unsigned v) { return __hip_atomic_fetch_add(p, v, __ATOMIC_RELAXED, __HIP_MEMORY_SCOPE_AGENT); }
__device__ __forceinline__ unsigned xb_xcc_id() { return (unsigned)__builtin_amdgcn_s_getreg((3 << 11) | 20) & 0xFu; }
#define XB_SPIN(cond, bar) do { unsigned _sp = 0; while (cond) { __builtin_amdgcn_s_sleep(1); \
    if ((++_sp & 255u) == 0u) { if (xb_ld(&(bar)[XB_TMO])) break; if (_sp > XB_SPIN_CAP) { atomicAdd(&(bar)[XB_TMO], 1u); break; } } } } while (0)

struct XcdBarrier { unsigned* bar; unsigned x; volatile LAS unsigned* st; };

__device__ __forceinline__ XcdBarrier xcd_barrier_post(unsigned* bar, volatile LAS unsigned* st, bool tid0) {
    XcdBarrier b; b.bar = bar; b.x = xb_xcc_id(); b.st = st;
    if (tid0) (void)xb_add(&bar[XB_XCNT(b.x)], 1u);
    return b;
}
__device__ __forceinline__ void xcd_barrier_complete(unsigned* bar, unsigned x, unsigned& nloc, unsigned& nx) {
    const unsigned G = gridDim.x * gridDim.y * gridDim.z;
    unsigned sum, cnt, mine, sp = 0u;
    for (;;) {
        sum = 0u; cnt = 0u; mine = 0u;
#pragma unroll
        for (unsigned j = 0; j < 16; ++j) { const unsigned c = xb_ld(&bar[XB_XCNT(j)]); sum += c; cnt += (c > 0u) ? 1u : 0u; mine = (j == x) ? c : mine; }
        if (sum == G) break;
        __builtin_amdgcn_s_sleep(1);
        if ((++sp & 255u) == 0u) { if (xb_ld(&bar[XB_TMO])) break; if (sp > XB_SPIN_CAP) { atomicAdd(&bar[XB_TMO], 1u); break; } }
    }
    nloc = mine > 0u ? mine : 1u; nx = cnt > 0u ? cnt : 1u;
}
__device__ __forceinline__ void xcd_barrier(const XcdBarrier& b, int wave) {
    asm volatile("s_waitcnt vmcnt(0)" ::: "memory");
    __syncthreads();
    if (wave == 0 && pg8::hw_lane_id() == 0) {
        unsigned* bar = b.bar;
        __builtin_amdgcn_s_waitcnt(0);
        unsigned nloc = b.st[0], nx = b.st[1];
        if (nloc == 0u) { xcd_barrier_complete(bar, b.x, nloc, nx); b.st[0] = nloc; b.st[1] = nx; }
        const unsigned old = xb_add(&bar[XB_XSUB(b.x)], 1u);
        const unsigned gen = old / nloc;
        if (old + 1u == (gen + 1u) * nloc) {
            __builtin_amdgcn_fence(__ATOMIC_RELEASE, "agent");
            asm volatile("s_waitcnt vmcnt(0)" ::: "memory");
            const unsigned og = xb_add(&bar[XB_TOP], 1u);
            const unsigned tg = og / nx;
            if (og + 1u == (tg + 1u) * nx) xb_add(&bar[XB_TOPGEN], 1u);
            else XB_SPIN(xb_ld(&bar[XB_TOPGEN]) == tg, bar);
            __builtin_amdgcn_fence(__ATOMIC_ACQUIRE, "agent");
            xb_add(&bar[XB_XGEN(b.x)], 1u);
            asm volatile("s_waitcnt vmcnt(0)" ::: "memory");
        } else {
            XB_SPIN(xb_ld(&bar[XB_XGEN(b.x)]) == gen, bar);
            __builtin_amdgcn_fence(__ATOMIC_ACQUIRE, "agent");
            asm volatile("s_waitcnt vmcnt(0)" ::: "memory");
        }
    }
    __syncthreads();
}

__host__ __device__ __forceinline__ int frag32(int row, int k, int K) { return (((row >> 5) * (K >> 4) + (k >> 4)) * 64 + ((k >> 3) & 1) * 32 + (row & 31)) * 8 + (k & 7); }
__host__ __device__ __forceinline__ int frag16(int n, int k, int K) { return (((n >> 4) * (K >> 5) + (k >> 5)) * 64 + ((k >> 3) & 3) * 16 + (n & 15)) * 8 + (k & 7); }
struct Args { const void* in[26]; float* out; unsigned char* ws; int ph_lo, ph_hi; };
struct Ctx {
    LAS unsigned char* lds;
    int tid, lane, wave, vcu, G;
    __device__ __forceinline__ void refresh() { lane = pg8::hw_lane_id(); tid = wave * 64 + lane; }
};

template <class F> struct EpiT {
    static constexpr bool PERM = true, AFTER_DRAIN = false;
    F f;
    __device__ __forceinline__ void operator()(const f32x4 (&acc)[2][2][4][2], const pg8::Unit& u, int wr, int wc, int fr, int fq) const {
        const int row0 = u.pm * 256 + wr * 64 + fr, col0 = u.pn * 256 + wc * 32 + 8 * fq;
        typename F::L cur[2], nxt[2];
        f.load(row0, col0, cur[0]); f.load(row0, col0 + 128, cur[1]);
#pragma unroll
        for (int i = 0; i < 8; ++i) {
            const int ai = i >> 2, m = i & 3, row = row0 + ai * 128 + m * 16;
            if (i < 7) { const int rown = row0 + ((i + 1) >> 2) * 128 + ((i + 1) & 3) * 16; f.load(rown, col0, nxt[0]); f.load(rown, col0 + 128, nxt[1]); }
            __builtin_amdgcn_sched_barrier(0);
            f.apply(row, col0, acc[ai][0][m][0], acc[ai][0][m][1], cur[0]); f.apply(row, col0 + 128, acc[ai][1][m][0], acc[ai][1][m][1], cur[1]);
            __builtin_amdgcn_sched_barrier(0);
            cur[0] = nxt[0]; cur[1] = nxt[1];
        }
    }
};
__device__ __forceinline__ v4u pack8(f32x4 a, f32x4 b) { v4u w; w.x = pk2(a[0], a[1]); w.y = pk2(a[2], a[3]); w.z = pk2(b[0], b[1]); w.w = pk2(b[2], b[3]); return w; }
struct LNone {};
struct FStore { typedef LNone L; bf16* O; int ldc;
    __device__ __forceinline__ void load(int, int, L&) const {}
    __device__ __forceinline__ void apply(int row, int col, f32x4 v0, f32x4 v1, const L&) const { *(v4u*)(O + (size_t)row * ldc + col) = pack8(v0, v1); } };
struct FKvm { typedef LNone L; bf16* KM; bf16* VT;
    __device__ __forceinline__ void load(int, int, L&) const {}
    __device__ __forceinline__ void apply(int row, int col, f32x4 v0, f32x4 v1, const L&) const {
        const int b = row >> 8, m = row & 255;
        if (col < 256) { const int hm = col >> 6, d0 = col & 63; *(v4u*)(KM + (size_t)(b * 4 + hm) * 16384 + frag32(m, d0, 64)) = pack8(v0, v1); }
        else { const int c = col - 256, hm = c >> 6, e0 = c & 63, mt = m >> 5, s2 = (m >> 4) & 1, w = m & 15, hh = (w >> 2) & 1, j = ((w >> 3) << 2) | (w & 3);
            bf16* p = VT + (size_t)(b * 4 + hm) * 16384 + ((mt * 2 + s2) * 64 + hh * 32) * 8 + j;
#pragma unroll
            for (int jj = 0; jj < 8; ++jj) { const int e = e0 + jj; p[((e >> 5) * 16 * 64 + (e & 31)) * 8] = (bf16)f2bf(jj < 4 ? v0[jj] : v1[jj - 4]); } }
    } };
struct FSig { typedef LNone L; bf16* O; int ldc;
    __device__ __forceinline__ void load(int, int, L&) const {}
    __device__ __forceinline__ void apply(int row, int col, f32x4 v0, f32x4 v1, const L&) const {
#pragma unroll
        for (int j = 0; j < 4; ++j) { v0[j] = sigmoidf_(v0[j]); v1[j] = sigmoidf_(v1[j]); }
        *(v4u*)(O + (size_t)row * ldc + col) = pack8(v0, v1); } };
struct FGlu { typedef LNone L; bf16* O;
    __device__ __forceinline__ void load(int, int, L&) const {}
    __device__ __forceinline__ void apply(int row, int col, f32x4 v0, f32x4 v1, const L&) const {
        v2u w; w.x = pk2(v0[0] * sigmoidf_(v1[0]), v0[1] * sigmoidf_(v1[1])); w.y = pk2(v0[2] * sigmoidf_(v1[2]), v0[3] * sigmoidf_(v1[3]));
        *(v2u*)(O + (size_t)row * 1024 + 512 + (col >> 1)) = w; } };
__device__ __forceinline__ void mul8(f32x4& v0, f32x4& v1, const v4u num, const v4u den) {
    v0[0] *= bflo(num.x) * __builtin_amdgcn_rcpf(fmaxf(bflo(den.x), 1e-30f)); v0[1] *= bfhi(num.x) * __builtin_amdgcn_rcpf(fmaxf(bfhi(den.x), 1e-30f));
    v0[2] *= bflo(num.y) * __builtin_amdgcn_rcpf(fmaxf(bflo(den.y), 1e-30f)); v0[3] *= bfhi(num.y) * __builtin_amdgcn_rcpf(fmaxf(bfhi(den.y), 1e-30f));
    v1[0] *= bflo(num.z) * __builtin_amdgcn_rcpf(fmaxf(bflo(den.z), 1e-30f)); v1[1] *= bfhi(num.z) * __builtin_amdgcn_rcpf(fmaxf(bfhi(den.z), 1e-30f));
    v1[2] *= bflo(num.w) * __builtin_amdgcn_rcpf(fmaxf(bflo(den.w), 1e-30f)); v1[3] *= bfhi(num.w) * __builtin_amdgcn_rcpf(fmaxf(bfhi(den.w), 1e-30f));
}
struct HookGate { const bf16* Gt;
    __device__ __forceinline__ void operator()(int t, f32x4 (&acc)[2][2][4][2], const pg8::Unit& u, int wr, int wc, int fr, int fq) const {
        if (t != 8 && t != 12) return;
        const int gn = (t == 8) ? 0 : 1024, gd = gn + 1024;
        int row0 = u.pm * 256 + wr * 64 + fr, col0 = u.pn * 256 + wc * 32 + 8 * fq;
        asm volatile("" : "+v"(row0), "+v"(col0));
#pragma unroll
        for (int ai = 0; ai < 2; ++ai) {
            v4u nn[4][2], dd[4][2];
#pragma unroll
            for (int m = 0; m < 4; ++m) { const bf16* gp = Gt + (size_t)(row0 + ai * 128 + m * 16) * NGATE + col0;
                nn[m][0] = *(const v4u*)(gp + gn); dd[m][0] = *(const v4u*)(gp + gd); nn[m][1] = *(const v4u*)(gp + gn + 128); dd[m][1] = *(const v4u*)(gp + gd + 128); }
            __builtin_amdgcn_sched_barrier(0);
#pragma unroll
            for (int m = 0; m < 4; ++m) { mul8(acc[ai][0][m][0], acc[ai][0][m][1], nn[m][0], dd[m][0]); mul8(acc[ai][1][m][0], acc[ai][1][m][1], nn[m][1], dd[m][1]); }
            __builtin_amdgcn_sched_barrier(0);
        }
    } };
struct LGate { v4u g; };
struct FGateOut { typedef LGate L; const bf16* Gt; bf16* MB;
    __device__ __forceinline__ void load(int row, int col, L& l) const { l.g = *(const v4u*)(Gt + (size_t)row * NGATE + 2048 + col); }
    __device__ __forceinline__ void apply(int row, int col, f32x4 v0, f32x4 v1, const L& l) const {
        const v4u g = l.g;
        v0[0] *= bflo(g.x); v0[1] *= bfhi(g.x); v0[2] *= bflo(g.y); v0[3] *= bfhi(g.y); v1[0] *= bflo(g.z); v1[1] *= bfhi(g.z); v1[2] *= bflo(g.w); v1[3] *= bfhi(g.w);
        *(v4u*)(MB + (size_t)row * DM + col) = pack8(v0, v1); } };
struct LRes { f32x4 x0, x1; };
struct FRes { typedef LRes L; const float* X; bf16* HB; float* SS;
    __device__ __forceinline__ void load(int row, int col, L& l) const { const float* xp = X + (size_t)row * DM + col; l.x0 = *(const f32x4*)xp; l.x1 = *(const f32x4*)(xp + 4); }
    __device__ __forceinline__ void apply(int row, int col, f32x4 v0, f32x4 v1, const L& l) const {
        v0 += l.x0; v1 += l.x1;
        *(v4u*)(HB + (size_t)row * DM + col) = pack8(v0, v1);
        float q = (v0[0] * v0[0] + v0[1] * v0[1]) + (v0[2] * v0[2] + v0[3] * v0[3]) + (v1[0] * v1[0] + v1[1] * v1[1]) + (v1[2] * v1[2] + v1[3] * v1[3]);
        q += __shfl_xor(q, 16); q += __shfl_xor(q, 32);
        if (pg8::hw_lane_id() < 16) atomicAdd(SS + row, q); } };
struct LRstd { float ss; };
struct FStoreRstd { typedef LRstd L; bf16* O; int ldc; const float* SS;
    __device__ __forceinline__ void load(int row, int, L& l) const { l.ss = SS[row]; }
    __device__ __forceinline__ void apply(int row, int col, f32x4 v0, f32x4 v1, const L& l) const {
        const float rs = __builtin_amdgcn_rsqf(l.ss * (1.f / DM) + EPS);
        *(v4u*)(O + ((((size_t)(row >> 5) * 16 + (col >> 7)) * 8 + ((col & 127) >> 4)) * 64 + ((col >> 3) & 1) * 32 + (row & 31)) * 8) = pack8(v0 * rs, v1 * rs); } };

template <class F>
__device__ __forceinline__ void run_gemm(const Ctx& C, const bf16* A, const bf16* Bt, int M, int N, int K, const F& f) {
    pg8::Gemm g{A, Bt, M, N, K}; pg8::StaticOrder S; S.init(M, N, C.G, (int)blockIdx.x);
    EpiT<F> E{f};
    pg8::gemm_phase<EpiT<F>, pg8::StaticOrder, true, true>(C.lds, g, S, E, C.wave);
}

template <class F, class H>
__device__ __forceinline__ void run_gemm_hook(const Ctx& C, const bf16* A, const bf16* Bt, int M, int N, int K, const F& f, const H& h) {
    pg8::Gemm g{A, Bt, M, N, K}; pg8::StaticOrder S; S.init(M, N, C.G, (int)blockIdx.x);
    EpiT<F> E{f};
    pg8::gemm_phase<EpiT<F>, pg8::StaticOrder, true, true, false, H>(C.lds, g, S, E, C.wave, 0x7f7f7f7f, 0x7f7f7f7f, h);
}
template <class F>
__device__ __forceinline__ void run_gemm_mx(const Ctx& C, const unsigned char* A8, const unsigned char* Bt8, int M, int N, int Kbytes, const F& f, int sclA, int sclB) {
    pg8::Gemm g{(const bf16*)A8, (const bf16*)Bt8, M, N, Kbytes / 2}; pg8::StaticOrder S; S.init(M, N, C.G, (int)blockIdx.x);
    EpiT<F> E{f};
    pg8::gemm_phase<EpiT<F>, pg8::StaticOrder, true, true, true>(C.lds, g, S, E, C.wave, sclA, sclB);
}

__device__ __forceinline__ unsigned q_e2m1(float y) {
    const float m = fabsf(y);
    const unsigned c = (unsigned)(m > 0.25f) + (unsigned)(m > 0.75f) + (unsigned)(m > 1.25f) + (unsigned)(m > 1.75f) + (unsigned)(m > 2.5f) + (unsigned)(m > 3.5f) + (unsigned)(m > 5.0f);
    return c | ((__builtin_bit_cast(unsigned, y) >> 28) & 8u);
}
template <bool GLU>
__device__ __forceinline__ void p0_transpose_item(const float* W, int K, int N, bf16* WT, LAS float* scr, int item, int lane, const float* kscale = nullptr, int ldk = 0, int koff = 0) {
    if (ldk == 0) ldk = K;
    const int nblk = N / 32, kb = item / nblk, nb = item % nblk, k0 = 64 * kb, n0 = 32 * nb;
#pragma unroll 8
    for (int i = 0; i < 32; ++i) { const int kk = 2 * i + (lane >> 5); float w = W[(size_t)(k0 + kk) * N + n0 + (lane & 31)]; if (kscale) w *= kscale[k0 + kk]; scr[kk * 33 + (lane & 31)] = w; }
    LDS_WAIT(); asm volatile("" ::: "memory");
    const int c = lane & 7;
#pragma unroll
    for (int j = 0; j < 4; ++j) { const int n = (lane >> 3) + 8 * j; const LAS float* s = scr + (8 * c) * 33 + n;
        v4u o; o.x = pk2(s[0 * 33], s[1 * 33]); o.y = pk2(s[2 * 33], s[3 * 33]); o.z = pk2(s[4 * 33], s[5 * 33]); o.w = pk2(s[6 * 33], s[7 * 33]);
        const int nn = n0 + n; int row = nn;
        if (GLU) { const int jc = nn & 255, gate = nn >> 8; row = 8 * (jc >> 2) + 4 * gate + (jc & 3); }
        *(GAS v4u*)(WT + (size_t)row * ldk + koff + k0 + 8 * c) = o; }
    LDS_WAIT(); asm volatile("" ::: "memory");
}
__device__ __forceinline__ void p0_transpose_item_fp8(const float* W, int K, int N, unsigned char* WT8, int nsub, LAS float* scr, int item, int lane, float scale) {
    const int nblk = N / 32, kb = item / nblk, nb = item % nblk, k0 = 64 * kb, n0 = 32 * nb;
#pragma unroll 8
    for (int i = 0; i < 32; ++i) { const int kk = 2 * i + (lane >> 5); scr[kk * 33 + (lane & 31)] = W[(size_t)(k0 + kk) * N + n0 + (lane & 31)] * scale; }
    LDS_WAIT(); asm volatile("" ::: "memory");
    const int c = lane & 7;
#pragma unroll
    for (int j = 0; j < 4; ++j) { const int n = (lane >> 3) + 8 * j; const LAS float* sp = scr + (8 * c) * 33 + n;
        int p0 = __builtin_amdgcn_cvt_pk_fp8_f32(sp[0 * 33], sp[1 * 33], 0, false); p0 = __builtin_amdgcn_cvt_pk_fp8_f32(sp[2 * 33], sp[3 * 33], p0, true);
        int p1 = __builtin_amdgcn_cvt_pk_fp8_f32(sp[4 * 33], sp[5 * 33], 0, false); p1 = __builtin_amdgcn_cvt_pk_fp8_f32(sp[6 * 33], sp[7 * 33], p1, true);
        v2u o; o.x = (unsigned)p0; o.y = (unsigned)p1;
        *(GAS v2u*)(WT8 + (size_t)(n0 + n - nsub) * K + k0 + 8 * c) = o; }
    LDS_WAIT(); asm volatile("" ::: "memory");
}
template <int NR>
__device__ __forceinline__ void rms_rows_to_bf16(const float* xbase, const float* gain, bf16* obase, int m0, int mstep, int lane, unsigned char* o8base = nullptr) {
    f32x4 v[NR][4]; float s[NR];
#pragma unroll
    for (int i = 0; i < NR; ++i) { const f32x4* xr = (const f32x4*)(xbase + (size_t)(m0 + i * mstep) * DM) + lane; s[i] = 0.f;
#pragma unroll
        for (int j = 0; j < 4; ++j) v[i][j] = xr[64 * j]; }
#pragma unroll
    for (int i = 0; i < NR; ++i)
#pragma unroll
        for (int j = 0; j < 4; ++j) s[i] += (v[i][j].x * v[i][j].x + v[i][j].y * v[i][j].y) + (v[i][j].z * v[i][j].z + v[i][j].w * v[i][j].w);
#pragma unroll
    for (int o = 1; o < 64; o <<= 1)
#pragma unroll
        for (int i = 0; i < NR; ++i) s[i] += __shfl_xor(s[i], o);
    const f32x4* gr = (const f32x4*)gain + lane;
    f32x4 g[4];
#pragma unroll
    for (int j = 0; j < 4; ++j) g[j] = gr[64 * j];
#pragma unroll
    for (int i = 0; i < NR; ++i) { const float rstd = 1.0f / sqrtf(s[i] * (1.f / DM) + EPS);
        unsigned long long* o8 = (unsigned long long*)(obase + (size_t)(m0 + i * mstep) * DM) + lane;
#pragma unroll
        for (int j = 0; j < 4; ++j) { const float y0 = v[i][j].x * rstd * g[j].x, y1 = v[i][j].y * rstd * g[j].y, y2 = v[i][j].z * rstd * g[j].z, y3 = v[i][j].w * rstd * g[j].w;
            o8[64 * j] = (unsigned long long)pk2(y0, y1) | ((unsigned long long)pk2(y2, y3) << 32);
            if (o8base) { int p = __builtin_amdgcn_cvt_pk_fp8_f32(y0 * 16.f, y1 * 16.f, 0, false); p = __builtin_amdgcn_cvt_pk_fp8_f32(y2 * 16.f, y3 * 16.f, p, true);
                *(unsigned*)(o8base + (size_t)(m0 + i * mstep) * DM + 256 * j + 4 * lane) = (unsigned)p; } } }
}

__device__ __forceinline__ void p0_s5_group(const Ctx& C, const Args& a, int g, int part) {
    const float* a_re = (const float*)a.in[7]; const float* a_im = (const float*)a.in[8]; const float* log_dt = (const float*)a.in[9];
    const float* b_re = (const float*)a.in[10]; const float* b_im = (const float*)a.in[11]; const float* c_re = (const float*)a.in[12]; const float* c_im = (const float*)a.in[13];
    LAS float* L = (LAS float*)C.lds;
    LAS float* lpr = L;
    LAS float* lpi = L + 640;
    LAS float* bbr = L + 1280;
    LAS float* bbi = bbr + 1024;
    LAS float* ccr = bbi + 1024;
    LAS float* cci = ccr + 1024;
    LAS float* Kj = cci + 1024;
    const int tid = C.tid;
    bf16* T8T = (bf16*)(a.ws + WS_S5MAT) + (size_t)g * 16384;
    bf16* PMT = (bf16*)(a.ws + WS_S5MAT) + (size_t)(16 + g) * 16384;
    bf16* QMT = (bf16*)(a.ws + WS_S5MAT) + (size_t)(32 + g) * 16384;
    float* L8 = (float*)(a.ws + WS_S5C) + (size_t)g * 128;
    float* L128 = (float*)(a.ws + WS_S5C) + 2048 + (size_t)g * 128;
    for (int i = tid; i < 640; i += 512) {
        const int j10 = i >> 6, p = i & 63; const double jj = (j10 < 9) ? (double)j10 : 128.0;
        const double dt = exp((double)log_dt[g]);
        const double ar = (double)a_re[g * 64 + p], ai = (double)a_im[g * 64 + p];
        const double mag = exp(ar * dt * jj), ang = ai * dt * jj;
        lpr[i] = (float)(mag * cos(ang)); lpi[i] = (float)(mag * sin(ang));
    }
    for (int i = tid; i < 1024; i += 512) { ccr[i] = c_re[g * 1024 + i]; cci[i] = c_im[g * 1024 + i]; }
    __syncthreads();
    if (part == 0 && tid < 64) { L8[tid * 2] = lpr[8 * 64 + tid]; L8[tid * 2 + 1] = lpi[8 * 64 + tid]; L128[tid * 2] = lpr[9 * 64 + tid]; L128[tid * 2 + 1] = lpi[9 * 64 + tid]; }
    for (int i = tid; i < 1024; i += 512) {
        const int p = i >> 4, h = i & 15;
        const float ar = a_re[g * 64 + p], ai = a_im[g * 64 + p], lr = lpr[64 + p], li = lpi[64 + p];
        const float den = ar * ar + ai * ai, nr = lr - 1.0f, ni = li;
        const float cr = (nr * ar + ni * ai) / den, ci = (ni * ar - nr * ai) / den;
        const float br = b_re[(g * 64 + p) * 16 + h], bi = b_im[(g * 64 + p) * 16 + h];
        bbr[i] = cr * br - ci * bi; bbi[i] = cr * bi + ci * br;
    }
    __syncthreads();
    for (int i = tid; i < 2048; i += 512) {
        const int j = i >> 8, ho = (i >> 4) & 15, hi = i & 15; float sacc = 0.f;
        if (j > (part >> 1) || (ho >> 3) != (part & 1)) continue;
        for (int p = 0; p < 64; ++p) { const float cr_ = ccr[ho * 64 + p], ci_ = cci[ho * 64 + p], lr_ = lpr[j * 64 + p], li_ = lpi[j * 64 + p];
            const float mr = cr_ * lr_ - ci_ * li_, mi = cr_ * li_ + ci_ * lr_;
            sacc += mr * bbr[p * 16 + hi] - mi * bbi[p * 16 + hi]; }
        Kj[i] = sacc;
    }
    __syncthreads();
    for (int i = part * 1024 + tid; i < (part + 1) * 1024; i += 512) {
        const int n = i >> 7, k = i & 127;
        { const int t = n >> 4, ho = n & 15, sx = k >> 4, hi = k & 15; const float v = (sx <= t) ? Kj[((t - sx) * 16 + ho) * 16 + hi] : 0.f; T8T[frag16(n, k, 128)] = (bf16)f2bf(v); }
        { const int p = n & 63, im = n >> 6, sx = k >> 4, hi = k & 15; const float lr_ = lpr[(7 - sx) * 64 + p], li_ = lpi[(7 - sx) * 64 + p], br_ = bbr[p * 16 + hi], bi_ = bbi[p * 16 + hi];
          const float v = im ? (lr_ * bi_ + li_ * br_) : (lr_ * br_ - li_ * bi_); PMT[frag16(n, k, 128)] = (bf16)f2bf(v); }
        { const int t = n >> 4, ho = n & 15, p = k & 63, pt = k >> 6; const float cr_ = ccr[ho * 64 + p], ci_ = cci[ho * 64 + p], lr_ = lpr[(t + 1) * 64 + p], li_ = lpi[(t + 1) * 64 + p];
          const float v = pt ? -(cr_ * li_ + ci_ * lr_) : (cr_ * lr_ - ci_ * li_); QMT[frag16(n, k, 128)] = (bf16)f2bf(v); }
    }
    __syncthreads();
}

__device__ __forceinline__ void p0_prologue(const Ctx& C, const Args& a) {
    p0_s5_group(C, a, C.vcu & 15, C.vcu >> 4);
    LAS float* scr = (LAS float*)(C.lds + C.wave * 16384);
    const int gw = C.vcu * NWAVES + C.wave, NGW = C.G * NWAVES;
    const int gt = C.vcu * 512 + C.tid, NGT = C.G * 512;
    unsigned char* ws = a.ws;
    for (int i = gt; i < MTOK; i += NGT) ((float*)(ws + WS_SS))[i] = 0.f;
    constexpr int I_IN = 16 * 176, I_Q = 16 * 64, I_O = 16 * 32, I_BR = 8 * 32, I_BS = 4 * 32, I_BM = 4 * 32, I_KV = 16 * 16, I_GLU = 4 * 16;
    constexpr int NITEMS = I_IN + I_Q + I_O + I_BR + I_BS + I_BM + I_KV + I_GLU;
    for (int it = gw; it < NITEMS; it += NGW) {
        int r = it;
        if (r < I_IN) { if ((r % 176) < 80) p0_transpose_item<false>((const float*)a.in[4], 1024, 5632, (bf16*)(ws + WS_WIN_T), scr, r, C.lane);
                        else p0_transpose_item_fp8((const float*)a.in[4], 1024, 5632, ws + WS_WG8, NZ1, scr, r, C.lane, 256.f); continue; } r -= I_IN;
        if (r < I_Q) { p0_transpose_item<false>((const float*)a.in[21], 1024, 2048, (bf16*)(ws + WS_WQ_T), scr, r, C.lane, (const float*)a.in[20]); continue; } r -= I_Q;
        if (r < I_O) { p0_transpose_item<false>((const float*)a.in[19], 1024, 1024, (bf16*)(ws + WS_WOUT_T), scr, r, C.lane); continue; } r -= I_O;
        if (r < I_BR) { p0_transpose_item<false>((const float*)a.in[16], 512, 1024, (bf16*)(ws + WS_WCAT_T), scr, r, C.lane, nullptr, 1024, 0); continue; } r -= I_BR;
        if (r < I_BS) { p0_transpose_item<false>((const float*)a.in[17], 256, 1024, (bf16*)(ws + WS_WCAT_T), scr, r, C.lane, nullptr, 1024, 512); continue; } r -= I_BS;
        if (r < I_BM) { p0_transpose_item<false>((const float*)a.in[18], 256, 1024, (bf16*)(ws + WS_WCAT_T), scr, r, C.lane, nullptr, 1024, 768); continue; } r -= I_BM;
        if (r < I_KV) { p0_transpose_item<false>((const float*)a.in[6], 1024, 512, (bf16*)(ws + WS_WMKV_T), scr, r, C.lane); continue; } r -= I_KV;
        p0_transpose_item<true>((const float*)a.in[15], 256, 512, (bf16*)(ws + WS_WGLU_T), scr, r, C.lane);
    }
    for (int i = gt; i < 16 * 128 * 128 / 8; i += NGT) { const f32x4 x0 = ((const f32x4*)a.in[22])[2 * (size_t)i], x1 = ((const f32x4*)a.in[22])[2 * (size_t)i + 1];
        const int hc = i >> 11, n = (i >> 4) & 127, d0 = (i & 15) * 8; *(v4u*)((bf16*)(ws + WS_KEYS) + hc * 16384 + frag32(n, d0, 128)) = pack8(x0, x1); }
    for (int rw0 = gw; rw0 < 2 * 16384; rw0 += 4 * NGW) {
        const int t = rw0 >> 14;
        f32x4 v[4][4]; float mx[4];
#pragma unroll
        for (int i = 0; i < 4; ++i) { const int row = (rw0 + i * NGW) & 16383;
            const float* src = (const float*)a.in[23 + t] + (size_t)row * DM + C.lane * 4; mx[i] = 0.f;
#pragma unroll
            for (int q = 0; q < 4; ++q) { v[i][q] = *(const f32x4*)(src + 256 * q); if (t == 0) v[i][q] = v[i][q] * *(const f32x4*)((const float*)a.in[20] + C.lane * 4 + 256 * q); } }
#pragma unroll
        for (int i = 0; i < 4; ++i)
#pragma unroll
            for (int q = 0; q < 4; ++q) mx[i] += (v[i][q][0] * v[i][q][0] + v[i][q][1] * v[i][q][1]) + (v[i][q][2] * v[i][q][2] + v[i][q][3] * v[i][q][3]);
#pragma unroll
        for (int o = 1; o < 64; o <<= 1)
#pragma unroll
            for (int i = 0; i < 4; ++i) mx[i] += __shfl_xor(mx[i], o);
#pragma unroll
        for (int i = 0; i < 4; ++i) { const int row = (rw0 + i * NGW) & 16383;
            const float rms = sqrtf(mx[i] * (1.f / DM)); const bool tiny = rms < 1e-30f;
            const float sc = tiny ? 1.f : 2.05f / rms, isc = tiny ? 1.f : rms * (1.f / 2.05f);
            unsigned char* dst = ws + (t ? WS_PV : WS_PU) + (size_t)row * 128 + 2 * C.lane;
#pragma unroll
            for (int q = 0; q < 4; ++q) { const unsigned w = q_e2m1(v[i][q][0] * sc) | (q_e2m1(v[i][q][1] * sc) << 4) | (q_e2m1(v[i][q][2] * sc) << 8) | (q_e2m1(v[i][q][3] * sc) << 12);
                *(unsigned short*)(dst + (size_t)q * (16384 * 128)) = (unsigned short)w; }
            if (C.lane == 0) ((float*)(ws + WS_PSC))[row * 2 + t] = isc; }
    }
    for (int m = gw; m < MTOK; m += 4 * NGW) rms_rows_to_bf16<4>((const float*)a.in[0], (const float*)a.in[3], (bf16*)(ws + WS_A), m, NGW, C.lane, ws + WS_XN8);
    for (int m = gw; m < MROWS; m += NGW) rms_rows_to_bf16<1>((const float*)a.in[1], (const float*)a.in[5], (bf16*)(ws + WS_MEMN), m, NGW, C.lane);
    {
        const int* pos = (const int*)a.in[2]; float* rope = (float*)(ws + WS_ROPE);
        const int j = C.tid & 63;
        const double invrev = exp(-(double)j * (9.210340371976184 / 64.0)) * 0.15915494309189535;
        for (int i = gt; i < MTOK * 64; i += NGT) { const int tok = i >> 6;
            double rv = (double)pos[tok] * invrev; rv -= rint(rv);
            const float rf = (float)rv;
            rope[(size_t)tok * 128 + j] = __builtin_amdgcn_cosf(rf); rope[(size_t)tok * 128 + 64 + j] = __builtin_amdgcn_sinf(rf); }
    }
}

constexpr int LP = 136;
__device__ __forceinline__ float lg2_gamma(int h) { return log2f(1.0f - exp2f(-5.0f - (float)h)); }

struct R1In { v4u q[4], k[4]; };
__device__ __forceinline__ void r1_load(const bf16* zr, int h, int dq, int eq, R1In& R) {
    const bf16* sq = zr + ZQ + h * 128; const bf16* sk = zr + ZK + h * 128;
    R.q[0] = *(const v4u*)(sq + dq); R.q[1] = *(const v4u*)(sq + dq + 8); R.q[2] = *(const v4u*)(sq + 64 + dq); R.q[3] = *(const v4u*)(sq + 64 + dq + 8);
    R.k[0] = *(const v4u*)(sk + dq); R.k[1] = *(const v4u*)(sk + dq + 8); R.k[2] = *(const v4u*)(sk + 64 + dq); R.k[3] = *(const v4u*)(sk + 64 + dq + 8);
}
__device__ __forceinline__ void r1_unit(const Ctx& C, const Args& a, int tile, int h, const float (&cs)[16], const float (&sn)[16], const R1In& R, R1In& Rn, bool hasnext) {
    const bf16* Z1 = (const bf16*)(a.ws + WS_Z1);
    LAS bf16* Qs = (LAS bf16*)C.lds; LAS bf16* Ks = Qs + 128 * LP; LAS bf16* Kt = Ks + 128 * LP; LAS bf16* Vt = Kt + 128 * LP;
    const int tid = C.tid, lane = C.lane, t0 = tile * 128, u = tile * 4 + h;
    const float lg2g = lg2_gamma(h);
    const int i = tid >> 2, dq = (tid & 3) * 16, eq = (tid & 3) * 32;
    {
        v4u vraw[4];
#pragma unroll
        for (int q = 0; q < 4; ++q) vraw[q] = *(const v4u*)(Z1 + (size_t)(t0 + i) * NZ1 + ZV + h * 128 + eq + 8 * q);
        const float kdec = __builtin_amdgcn_exp2f((float)(127 - i) * lg2g) , ksc = 0.08838834764831845f;
#pragma unroll
        for (int which = 0; which < 2; ++which) {
            const v4u a0 = which ? R.k[0] : R.q[0], a1 = which ? R.k[1] : R.q[1], b0 = which ? R.k[2] : R.q[2], b1 = which ? R.k[3] : R.q[3];
            const unsigned aw[8] = {a0.x, a0.y, a0.z, a0.w, a1.x, a1.y, a1.z, a1.w}, bw[8] = {b0.x, b0.y, b0.z, b0.w, b1.x, b1.y, b1.z, b1.w};
            float y1[16], y2[16];
#pragma unroll
            for (int w = 0; w < 8; ++w) {
                const float x1l = bflo(aw[w]), x1h = bfhi(aw[w]), x2l = bflo(bw[w]), x2h = bfhi(bw[w]);
                y1[2 * w] = x1l * cs[2 * w] - x2l * sn[2 * w]; y2[2 * w] = x1l * sn[2 * w] + x2l * cs[2 * w];
                y1[2 * w + 1] = x1h * cs[2 * w + 1] - x2h * sn[2 * w + 1]; y2[2 * w + 1] = x1h * sn[2 * w + 1] + x2h * cs[2 * w + 1];
            }
            if (which) {
#pragma unroll
                for (int e = 0; e < 16; ++e) { y1[e] *= ksc; y2[e] *= ksc; }
            }
            LAS bf16* dstp = (which ? Ks : Qs) + i * LP;
            v4u o;
            o.x = pk2(y1[0], y1[1]); o.y = pk2(y1[2], y1[3]); o.z = pk2(y1[4], y1[5]); o.w = pk2(y1[6], y1[7]); *(LAS v4u*)(dstp + dq) = o;
            o.x = pk2(y1[8], y1[9]); o.y = pk2(y1[10], y1[11]); o.z = pk2(y1[12], y1[13]); o.w = pk2(y1[14], y1[15]); *(LAS v4u*)(dstp + dq + 8) = o;
            o.x = pk2(y2[0], y2[1]); o.y = pk2(y2[2], y2[3]); o.z = pk2(y2[4], y2[5]); o.w = pk2(y2[6], y2[7]); *(LAS v4u*)(dstp + 64 + dq) = o;
            o.x = pk2(y2[8], y2[9]); o.y = pk2(y2[10], y2[11]); o.z = pk2(y2[12], y2[13]); o.w = pk2(y2[14], y2[15]); *(LAS v4u*)(dstp + 64 + dq + 8) = o;
            if (which) {
#pragma unroll
                for (int e = 0; e < 16; ++e) { Kt[(dq + e) * LP + i] = (bf16)f2bf(y1[e] * kdec); Kt[(64 + dq + e) * LP + i] = (bf16)f2bf(y2[e] * kdec); }
            }
            __builtin_amdgcn_sched_barrier(0);
        }
        {
#pragma unroll
            for (int q = 0; q < 4; ++q) { const v4u v = vraw[q]; const unsigned vw[4] = {v.x, v.y, v.z, v.w};
#pragma unroll
                for (int w = 0; w < 4; ++w) { Vt[(eq + 8 * q + 2 * w) * LP + i] = (bf16)(vw[w] & 0xffffu); Vt[(eq + 8 * q + 2 * w + 1) * LP + i] = (bf16)(vw[w] >> 16); } }
        }
    }
    __syncthreads();
    if (hasnext) r1_load(Z1 + (size_t)(t0 + i) * NZ1, h + 1, dq, eq, Rn);
    __builtin_amdgcn_sched_barrier(0);
    const int r = lane & 31, hh = lane >> 5;
    if (C.wave < 4) {
        const int ib = C.wave;
        { bf16* qf = (bf16*)(a.ws + WS_QRF) + ((size_t)(u * 4 + ib) * 8 * 64 + lane) * 8;
#pragma unroll
          for (int ks = 0; ks < 8; ++ks) *(bf16x8*)(qf + ks * 512) = *(const LAS bf16x8*)(Qs + (ib * 32 + r) * LP + ks * 16 + 8 * hh); }
        __builtin_amdgcn_sched_barrier(0);
        f32x16 accO[4];
#pragma unroll
        for (int et = 0; et < 4; ++et)
#pragma unroll
            for (int e = 0; e < 16; ++e) accO[et][e] = 0.f;
        int i = ib * 32 + r; asm volatile("" : "+v"(i));
#pragma unroll
        for (int jt = 0; jt < 4; ++jt) {
            if (jt <= ib) {
                f32x16 s;
#pragma unroll
                for (int e = 0; e < 16; ++e) s[e] = 0.f;
#pragma unroll
                for (int ks = 0; ks < 8; ++ks) { const bf16x8 ak = *(const LAS bf16x8*)(Ks + (jt * 32 + r) * LP + ks * 16 + 8 * hh), bqk = *(const LAS bf16x8*)(Qs + (ib * 32 + r) * LP + ks * 16 + 8 * hh); s = mfma32(ak, bqk, s); }
                unsigned pk[8];
#pragma unroll
                for (int q = 0; q < 8; ++q) {
                    const int ra = 2 * q, rb = 2 * q + 1;
                    const int ja = jt * 32 + (ra & 3) + 8 * (ra >> 2) + 4 * hh, jb = jt * 32 + (rb & 3) + 8 * (rb >> 2) + 4 * hh;
                    const float va = (i >= ja) ? s[ra] * __builtin_amdgcn_exp2f((float)(i - ja) * lg2g) : 0.f;
                    const float vb = (i >= jb) ? s[rb] * __builtin_amdgcn_exp2f((float)(i - jb) * lg2g) : 0.f;
                    pk[q] = pk2(va, vb);
                }
#pragma unroll
                for (int sft = 0; sft < 2; ++sft) {
                    const bf16x8 pb = mk8(pk[4 * sft], pk[4 * sft + 1], pk[4 * sft + 2], pk[4 * sft + 3]);
#pragma unroll
                    for (int et = 0; et < 4; ++et) {
                        const LAS bf16* vp = Vt + (et * 32 + r) * LP + jt * 32 + 16 * sft + 4 * hh;
                        const v2u lo = *(const LAS v2u*)vp, hi = *(const LAS v2u*)(vp + 8);
                        accO[et] = mfma32(mk8(lo.x, lo.y, hi.x, hi.y), pb, accO[et]);
                    }
                }
            }
            __builtin_amdgcn_sched_barrier(0);
        }
        unsigned* INN = (unsigned*)(a.ws + WS_INNER) + ((size_t)(u * 4 + ib) * 32) * 64 + lane;
#pragma unroll
        for (int et = 0; et < 4; ++et)
#pragma unroll
            for (int q = 0; q < 8; ++q) INN[(et * 8 + q) * 64] = pk2(accO[et][2 * q], accO[et][2 * q + 1]);
    } else {
        const int et = C.wave - 4;
        f32x16 acc[4];
#pragma unroll
        for (int dt = 0; dt < 4; ++dt)
#pragma unroll
            for (int e = 0; e < 16; ++e) acc[dt][e] = 0.f;
#pragma unroll
        for (int ks = 0; ks < 8; ++ks) {
            const bf16x8 av = *(const LAS bf16x8*)(Vt + (et * 32 + r) * LP + ks * 16 + 8 * hh);
#pragma unroll
            for (int dt = 0; dt < 4; ++dt) { const bf16x8 bk = *(const LAS bf16x8*)(Kt + (dt * 32 + r) * LP + ks * 16 + 8 * hh); acc[dt] = mfma32(av, bk, acc[dt]); }
            __builtin_amdgcn_sched_barrier(0);
        }
        float* KVb = a.out + (size_t)u * 16384 + (size_t)(et * 32 + 4 * hh) * 128 + r;
#pragma unroll
        for (int dt = 0; dt < 4; ++dt) {
#pragma unroll
            for (int e = 0; e < 16; ++e) KVb[((e & 3) + 8 * (e >> 2)) * 128 + dt * 32] = acc[dt][e];
            __builtin_amdgcn_sched_barrier(0);
        }
    }
    __syncthreads();
}

__device__ __forceinline__ void s5_compute_E(const Args& a, int tile, int g, int lane, LAS float* Es, bf16x8 (&au)[4]) {
    const bf16* Z1 = (const bf16*)(a.ws + WS_Z1); const bf16* PMT = (const bf16*)(a.ws + WS_S5MAT) + (size_t)(16 + g) * 16384;
    const int r16 = lane & 15, q4 = lane >> 4;
#pragma unroll
    for (int ks = 0; ks < 4; ++ks) { const int s = 2 * ks + (q4 >> 1);
        au[ks] = *(const bf16x8*)(Z1 + (size_t)(tile * 128 + 8 * r16 + s) * NZ1 + ZU + g * 16 + 8 * (q4 & 1)); }
    bf16x8 bc[4], bn[4];
#pragma unroll
    for (int ks = 0; ks < 4; ++ks) bc[ks] = *(const bf16x8*)(PMT + (ks * 64 + lane) * 8);
#pragma unroll 1
    for (int nb = 0; nb < 8; ++nb) {
        const int nbn = min(nb + 1, 7);
#pragma unroll
        for (int ks = 0; ks < 4; ++ks) bn[ks] = *(const bf16x8*)(PMT + ((nbn * 4 + ks) * 64 + lane) * 8);
        __builtin_amdgcn_sched_barrier(0);
        f32x4 acc = {0.f, 0.f, 0.f, 0.f};
#pragma unroll
        for (int ks = 0; ks < 4; ++ks) acc = mfma16(au[ks], bc[ks], acc);
#pragma unroll
        for (int i4 = 0; i4 < 4; ++i4) Es[(q4 * 4 + i4) * 128 + nb * 16 + r16] = acc[i4];
        __builtin_amdgcn_sched_barrier(0);
#pragma unroll
        for (int ks = 0; ks < 4; ++ks) bc[ks] = bn[ks];
    }
    LDS_WAIT(); asm volatile("" ::: "memory");
}
__device__ __forceinline__ void s5a_wave(const Ctx& C, const Args& a, int tile, int g) {
    LAS float* Es = (LAS float*)(C.lds + C.wave * 16384);
    bf16x8 au[4];
    s5_compute_E(a, tile, g, C.lane, Es, au);
    const float* L8 = (const float*)(a.ws + WS_S5C) + (size_t)g * 128;
    const float l8r = L8[C.lane * 2], l8i = L8[C.lane * 2 + 1];
    float sr = 0.f, si = 0.f;
#pragma unroll
    for (int c = 0; c < 16; ++c) { const float er = Es[c * 128 + C.lane], ei = Es[c * 128 + 64 + C.lane];
        const float nr = l8r * sr - l8i * si + er, ni = l8r * si + l8i * sr + ei; sr = nr; si = ni; }
    float* E = (float*)(a.ws + WS_S5E) + ((size_t)tile * 16 + g) * 128;
    E[C.lane] = sr; E[64 + C.lane] = si;
    LDS_WAIT(); asm volatile("" ::: "memory");
}
__device__ __forceinline__ void s5c_wave(const Ctx& C, const Args& a, int tile, int g) {
    LAS float* Es = (LAS float*)(C.lds + C.wave * 16384);
    LAS bf16* Sv = (LAS bf16*)(C.lds + C.wave * 16384 + 8192);
    const int lane = C.lane, r16 = lane & 15, q4 = lane >> 4;
    bf16x8 au[4];
    s5_compute_E(a, tile, g, lane, Es, au);
    const float* L8 = (const float*)(a.ws + WS_S5C) + (size_t)g * 128;
    const float l8r = L8[lane * 2], l8i = L8[lane * 2 + 1];
    const float* X = (const float*)(a.ws + WS_S5X) + ((size_t)tile * 16 + g) * 128;
    float sr = X[lane], si = X[64 + lane];
#pragma unroll
    for (int c = 0; c < 16; ++c) {
        Sv[c * LP + lane] = (bf16)f2bf(sr); Sv[c * LP + 64 + lane] = (bf16)f2bf(si);
        const float er = Es[c * 128 + lane], ei = Es[c * 128 + 64 + lane];
        const float nr = l8r * sr - l8i * si + er, ni = l8r * si + l8i * sr + ei; sr = nr; si = ni; }
    LDS_WAIT(); asm volatile("" ::: "memory");
    bf16x8 as[4];
#pragma unroll
    for (int ks = 0; ks < 4; ++ks) as[ks] = *(const LAS bf16x8*)(Sv + r16 * LP + ks * 32 + 8 * q4);
    const bf16* T8T = (const bf16*)(a.ws + WS_S5MAT) + (size_t)g * 16384; const bf16* QMT = (const bf16*)(a.ws + WS_S5MAT) + (size_t)(32 + g) * 16384;
    const bf16* Z1 = (const bf16*)(a.ws + WS_Z1); bf16* YG = (bf16*)(a.ws + WS_YG);
    const float dg = ((const float*)a.in[14])[g * 16 + r16];
    bf16x8 tc[4], tn[4], qc[4], qn[4]; bf16 uc[4], un[4];
#pragma unroll
    for (int ks = 0; ks < 4; ++ks) { tc[ks] = *(const bf16x8*)(T8T + (ks * 64 + lane) * 8); qc[ks] = *(const bf16x8*)(QMT + (ks * 64 + lane) * 8); }
#pragma unroll
    for (int i4 = 0; i4 < 4; ++i4) uc[i4] = Z1[(size_t)(tile * 128 + 8 * (q4 * 4 + i4)) * NZ1 + ZU + g * 16 + r16];
#pragma unroll 1
    for (int nb = 0; nb < 8; ++nb) {
        const int nbn = min(nb + 1, 7);
#pragma unroll
        for (int ks = 0; ks < 4; ++ks) { tn[ks] = *(const bf16x8*)(T8T + ((nbn * 4 + ks) * 64 + lane) * 8); qn[ks] = *(const bf16x8*)(QMT + ((nbn * 4 + ks) * 64 + lane) * 8); }
#pragma unroll
        for (int i4 = 0; i4 < 4; ++i4) un[i4] = Z1[(size_t)(tile * 128 + 8 * (q4 * 4 + i4) + nbn) * NZ1 + ZU + g * 16 + r16];
        __builtin_amdgcn_sched_barrier(0);
        f32x4 acc = {0.f, 0.f, 0.f, 0.f};
#pragma unroll
        for (int ks = 0; ks < 4; ++ks) { acc = mfma16(au[ks], tc[ks], acc); acc = mfma16(as[ks], qc[ks], acc); }
#pragma unroll
        for (int i4 = 0; i4 < 4; ++i4) { const int tok = tile * 128 + 8 * (q4 * 4 + i4) + nb;
            YG[(size_t)tok * 256 + g * 16 + r16] = (bf16)f2bf(gelu_tanh(acc[i4] + dg * bf2f(uc[i4]))); }
        __builtin_amdgcn_sched_barrier(0);
#pragma unroll
        for (int ks = 0; ks < 4; ++ks) { tc[ks] = tn[ks]; qc[ks] = qn[ks]; }
#pragma unroll
        for (int i4 = 0; i4 < 4; ++i4) uc[i4] = un[i4];
    }
    LDS_WAIT(); asm volatile("" ::: "memory");
}

__device__ __forceinline__ void ma_loadk(const bf16* kp, int mt, bf16x8 (&k)[4]) {
#pragma unroll
    for (int ks = 0; ks < 4; ++ks) k[ks] = *(const bf16x8*)(kp + (mt * 4 + ks) * 512);
}
__device__ __forceinline__ void ma_loadv(const bf16* vp, int mt, bf16x8 (&v)[4]) {
#pragma unroll
    for (int sft = 0; sft < 2; ++sft)
#pragma unroll
        for (int et = 0; et < 2; ++et) v[sft * 2 + et] = *(const bf16x8*)(vp + (((et * 8 + mt) * 2 + sft) * 64) * 8);
}
__device__ __forceinline__ void ma_wave(const Ctx& C, const Args& a, int tile, int hm, int ib) {
    const bf16* Z1 = (const bf16*)(a.ws + WS_Z1); const bf16* KM = (const bf16*)(a.ws + WS_KM); const bf16* VT = (const bf16*)(a.ws + WS_VT);
    const int lane = C.lane, r = lane & 31, hh = lane >> 5, b = tile >> 5, tok = tile * 128 + ib * 32 + r;
    const bf16* kp = KM + (size_t)(b * 4 + hm) * 16384 + lane * 8;
    const bf16* vp = VT + (size_t)(b * 4 + hm) * 16384 + lane * 8;
    bf16x8 bq[4];
#pragma unroll
    for (int ks = 0; ks < 4; ++ks) bq[ks] = *(const bf16x8*)(Z1 + (size_t)tok * NZ1 + ZQM + hm * 64 + ks * 16 + 8 * hh);
    bf16x8 kc[4], kn[4];
    ma_loadk(kp, 0, kc);
    float mx = -3.0e38f;
#pragma unroll 1
    for (int mt = 0; mt < 8; ++mt) {
        ma_loadk(kp, min(mt + 1, 7), kn); __builtin_amdgcn_sched_barrier(0);
        f32x16 s;
#pragma unroll
        for (int e = 0; e < 16; ++e) s[e] = 0.f;
#pragma unroll
        for (int ks = 0; ks < 4; ++ks) s = mfma32(kc[ks], bq[ks], s);
#pragma unroll
        for (int e = 0; e < 16; ++e) mx = fmaxf(mx, s[e]);
        __builtin_amdgcn_sched_barrier(0);
#pragma unroll
        for (int ks = 0; ks < 4; ++ks) kc[ks] = kn[ks];
    }
    mx = fmaxf(mx, __shfl_xor(mx, 32));
    float sum = 0.f;
    f32x16 o[2];
#pragma unroll
    for (int et = 0; et < 2; ++et)
#pragma unroll
        for (int e = 0; e < 16; ++e) o[et][e] = 0.f;
    const float sc = 0.125f * 1.4426950408889634f;
    bf16x8 vc[4], vn[4];
    ma_loadk(kp, 0, kc); ma_loadv(vp, 0, vc);
#pragma unroll 1
    for (int mt = 0; mt < 8; ++mt) {
        ma_loadk(kp, min(mt + 1, 7), kn); ma_loadv(vp, min(mt + 1, 7), vn); __builtin_amdgcn_sched_barrier(0);
        f32x16 s;
#pragma unroll
        for (int e = 0; e < 16; ++e) s[e] = 0.f;
#pragma unroll
        for (int ks = 0; ks < 4; ++ks) s = mfma32(kc[ks], bq[ks], s);
        unsigned pk[8];
#pragma unroll
        for (int q = 0; q < 8; ++q) { const float pa = __builtin_amdgcn_exp2f((s[2 * q] - mx) * sc), pb = __builtin_amdgcn_exp2f((s[2 * q + 1] - mx) * sc); sum += pa + pb; pk[q] = pk2(pa, pb); }
#pragma unroll
        for (int sft = 0; sft < 2; ++sft) {
            const bf16x8 pb = mk8(pk[4 * sft], pk[4 * sft + 1], pk[4 * sft + 2], pk[4 * sft + 3]);
#pragma unroll
            for (int et = 0; et < 2; ++et) o[et] = mfma32(vc[sft * 2 + et], pb, o[et]);
        }
        __builtin_amdgcn_sched_barrier(0);
#pragma unroll
        for (int ks = 0; ks < 4; ++ks) kc[ks] = kn[ks];
#pragma unroll
        for (int q = 0; q < 4; ++q) vc[q] = vn[q];
    }
    sum += __shfl_xor(sum, 32);
    const float inv = 1.0f / sum;
    bf16* MA = (bf16*)(a.ws + WS_YCAT) + (size_t)tok * 1024 + 768 + hm * 64;
#pragma unroll
    for (int et = 0; et < 2; ++et)
#pragma unroll
        for (int g4 = 0; g4 < 4; ++g4) { v2u w; w.x = pk2(o[et][4 * g4] * inv, o[et][4 * g4 + 1] * inv); w.y = pk2(o[et][4 * g4 + 2] * inv, o[et][4 * g4 + 3] * inv);
            *(v2u*)(MA + et * 32 + 8 * g4 + 4 * hh) = w; }
}

__device__ __forceinline__ void r3_wave(const Ctx& C, const Args& a, int tile, int h, int ib) {
    const bf16* Z1 = (const bf16*)(a.ws + WS_Z1); const float* ROPE = (const float*)(a.ws + WS_ROPE);
    const bf16* PREV = (const bf16*)((const unsigned char*)a.out + 64 * MiB);
    const int lane = C.lane, r = lane & 31, hh = lane >> 5, u = tile * 4 + h, tok = tile * 128 + ib * 32 + r;
    const float lg2g = lg2_gamma(h);
    bf16x8 bq[8];
    { const bf16* qf = (const bf16*)(a.ws + WS_QRF) + ((size_t)(u * 4 + ib) * 8 * 64 + lane) * 8;
#pragma unroll
      for (int ks = 0; ks < 8; ++ks) bq[ks] = *(const bf16x8*)(qf + ks * 512); }
    f32x16 acc[4];
    const bf16* pbase = PREV + (size_t)u * 16384 + lane * 8;
    bf16x8 ap[4][8];
#pragma unroll
    for (int et = 0; et < 4; ++et)
#pragma unroll
        for (int ks = 0; ks < 8; ++ks) ap[et][ks] = *(const bf16x8*)(pbase + (et * 8 + ks) * 512);
    __builtin_amdgcn_sched_barrier(0);
#pragma unroll
    for (int et = 0; et < 4; ++et) {
#pragma unroll
        for (int e = 0; e < 16; ++e) acc[et][e] = 0.f;
#pragma unroll
        for (int ks = 0; ks < 8; ++ks) acc[et] = mfma32(ap[et][ks], bq[ks], acc[et]);
    }
    __builtin_amdgcn_sched_barrier(0);
    const unsigned* INN = (const unsigned*)(a.ws + WS_INNER) + ((size_t)(u * 4 + ib) * 32) * 64 + lane;
    unsigned innw[32];
#pragma unroll
    for (int q = 0; q < 32; ++q) innw[q] = INN[q * 64];
    const bf16* gp = Z1 + (size_t)tok * NZ1 + ZGR + h * 128;
    v2u gwv[16];
#pragma unroll
    for (int q = 0; q < 16; ++q) gwv[q] = *(const v2u*)(gp + (q >> 2) * 32 + 8 * (q & 3) + 4 * hh);
    const float qdec = __builtin_amdgcn_exp2f((float)(ib * 32 + r + 1) * lg2g);
    float ss = 0.f;
#pragma unroll
    for (int et = 0; et < 4; ++et)
#pragma unroll
        for (int q = 0; q < 8; ++q) { const unsigned w = innw[et * 8 + q];
            const float v0 = acc[et][2 * q] * qdec + bflo(w), v1 = acc[et][2 * q + 1] * qdec + bfhi(w);
            acc[et][2 * q] = v0; acc[et][2 * q + 1] = v1; ss += v0 * v0 + v1 * v1; }
    __builtin_amdgcn_sched_barrier(0);
    ss += __shfl_xor(ss, 32);
    const float rn = __builtin_amdgcn_rsqf(ss * (1.0f / 128.0f) + EPS);
    bf16* RET = (bf16*)(a.ws + WS_YCAT) + (size_t)tok * 1024 + h * 128;
#pragma unroll
    for (int et = 0; et < 4; ++et)
#pragma unroll
        for (int g4 = 0; g4 < 4; ++g4) { const int e0 = et * 32 + 8 * g4 + 4 * hh; const v2u gw = gwv[et * 4 + g4];
            const float g0 = bflo(gw.x), g1 = bfhi(gw.x), g2 = bflo(gw.y), g3 = bfhi(gw.y);
            v2u w; w.x = pk2(acc[et][4 * g4] * rn * g0 * sigmoidf_(g0), acc[et][4 * g4 + 1] * rn * g1 * sigmoidf_(g1));
            w.y = pk2(acc[et][4 * g4 + 2] * rn * g2 * sigmoidf_(g2), acc[et][4 * g4 + 3] * rn * g3 * sigmoidf_(g3));
            *(v2u*)(RET + e0) = w; }
}

__device__ __forceinline__ void p3_scans(const Ctx& C, const Args& a) {
    constexpr int NSKIP = 16;
    if ((int)blockIdx.x < NSKIP) return;
    const int w0 = ((int)blockIdx.x - NSKIP) * 512 + C.tid, NW = (C.G - NSKIP) * 512;
    {
        const float* KV = a.out; bf16* PREV = (bf16*)((unsigned char*)a.out + 64 * MiB);
        for (int it = w0; it < 131072; it += NW) {
            const int elem = it * 4, b = elem >> 16, h = (elem >> 14) & 3, ed = elem & 16383;
            const float cd = __builtin_amdgcn_exp2f(128.0f * lg2_gamma(h));
            const float* kp = KV + (size_t)(b * 128 + h) * 16384 + ed; bf16* pp = PREV + (size_t)(b * 128 + h) * 16384 + frag32(ed >> 7, ed & 127, 128);
            f32x4 inc[32];
#pragma unroll
            for (int c = 0; c < 32; ++c) inc[c] = *(const f32x4*)(kp + (size_t)c * 65536);
            f32x4 st = {0.f, 0.f, 0.f, 0.f};
#pragma unroll
            for (int c = 0; c < 32; ++c) { v2u w; w.x = pk2(st[0], st[1]); w.y = pk2(st[2], st[3]); *(v2u*)(pp + (size_t)c * 65536) = w; st = st * cd + inc[c]; }
        }
    }
    {
        const float* E = (const float*)(a.ws + WS_S5E); float* X = (float*)(a.ws + WS_S5X); const float* L128 = (const float*)(a.ws + WS_S5C) + 2048;
        for (int it = w0; it < 8192; it += NW) {
            const int b = it >> 10, g = (it >> 6) & 15, p = it & 63;
            const float lr = L128[(g * 64 + p) * 2], li = L128[(g * 64 + p) * 2 + 1];
            const float* ep = E + ((size_t)(b * 32) * 16 + g) * 128 + p; float* xp = X + ((size_t)(b * 32) * 16 + g) * 128 + p;
            float er[32], ei[32];
#pragma unroll
            for (int n = 0; n < 32; ++n) { er[n] = ep[(size_t)n * 2048]; ei[n] = ep[(size_t)n * 2048 + 64]; }
            float xr = 0.f, xi = 0.f;
#pragma unroll
            for (int n = 0; n < 32; ++n) { xp[(size_t)n * 2048] = xr; xp[(size_t)n * 2048 + 64] = xi;
                const float nr = lr * xr - li * xi + er[n], ni = lr * xi + li * xr + ei[n]; xr = nr; xi = ni; }
        }
    }
}

__device__ __forceinline__ int f2key(float x) { int b = __builtin_bit_cast(int, x); return b >= 0 ? b : (b ^ 0x7fffffff); }
__device__ __forceinline__ float key2f(int k) { return __builtin_bit_cast(float, k >= 0 ? k : (k ^ 0x7fffffff)); }
__device__ __forceinline__ void ce_desc(int& x, int& y) { const int hi = x > y ? x : y, lo = x > y ? y : x; x = hi; y = lo; }
__device__ __forceinline__ void sort16_desc(int (&v)[16]) {
#pragma unroll
    for (int k = 2; k <= 16; k <<= 1)
#pragma unroll
        for (int j = k >> 1; j > 0; j >>= 1)
#pragma unroll
            for (int i = 0; i < 16; ++i) { const int l = i ^ j; if (l > i) { if ((i & k) == 0) ce_desc(v[i], v[l]); else ce_desc(v[l], v[i]); } }
}
__device__ __forceinline__ void merge16_desc(int (&T)[16], const int (&N)[16]) {
#pragma unroll
    for (int i = 0; i < 16; ++i) T[i] = T[i] > N[15 - i] ? T[i] : N[15 - i];
#pragma unroll
    for (int j = 8; j > 0; j >>= 1)
#pragma unroll
        for (int i = 0; i < 16; ++i) { const int l = i ^ j; if (l > i) ce_desc(T[i], T[l]); }
}
__device__ __forceinline__ void peer_topk_half(const Args& a, int tokbase, int hp, int c, int lane, int (&T)[16]) {
    const bf16* Q2 = (const bf16*)(a.ws + WS_Q2); const bf16* KEYS = (const bf16*)(a.ws + WS_KEYS);
    const int r = lane & 31, hh = lane >> 5;
    bf16x8 bq[8];
#pragma unroll
    for (int ks = 0; ks < 8; ++ks) bq[ks] = *(const bf16x8*)(Q2 + ((((size_t)(tokbase >> 5) * 16 + hp * 2 + c) * 8 + ks) * 64 + lane) * 8);
    const bf16* kbase = KEYS + (size_t)(hp * 2 + c) * 16384 + lane * 8;
    bf16x8 akc[8], akn[8];
#pragma unroll
    for (int ks = 0; ks < 8; ++ks) akc[ks] = *(const bf16x8*)(kbase + ks * 512);
#pragma unroll
    for (int nt = 0; nt < 4; ++nt) {
        if (nt < 3) {
#pragma unroll
            for (int ks = 0; ks < 8; ++ks) akn[ks] = *(const bf16x8*)(kbase + ((nt + 1) * 8 + ks) * 512);
        }
        __builtin_amdgcn_sched_barrier(0);
        f32x16 s;
#pragma unroll
        for (int e = 0; e < 16; ++e) s[e] = 0.f;
#pragma unroll
        for (int ks = 0; ks < 8; ++ks) s = mfma32(akc[ks], bq[ks], s);
        int N[16];
#pragma unroll
        for (int e = 0; e < 16; ++e) { const int n = nt * 32 + (e & 3) + 8 * (e >> 2) + 4 * hh; N[e] = (f2key(s[e]) & ~127) | n; }
        sort16_desc(N);
        if (nt == 0) {
#pragma unroll
            for (int e = 0; e < 16; ++e) T[e] = N[e];
        } else merge16_desc(T, N);
        __builtin_amdgcn_sched_barrier(0);
#pragma unroll
        for (int ks = 0; ks < 8; ++ks) akc[ks] = akn[ks];
    }
    int P[16];
#pragma unroll
    for (int j = 0; j < 16; ++j) P[j] = __shfl_xor(T[j], 32);
    merge16_desc(T, P);
}
__device__ __forceinline__ void peer_topk_head(const Ctx& C, const Args& a, int tokbase, int hp) {
    const int lane = C.lane, r = lane & 31, hh = lane >> 5;
    int T0[16], T1[16];
    peer_topk_half(a, tokbase, hp, 0, lane, T0);
    peer_topk_half(a, tokbase, hp, 1, lane, T1);
    int F[16], L1[16], L2[16], L3[16];
#pragma unroll
    for (int j = 0; j < 16; ++j) { L1[j] = (int)0x80000000; L2[j] = (int)0x80000000; L3[j] = (int)0x80000000; }
    {
        int cnt = 0;
#pragma unroll
        for (int i0 = 0; i0 < 16; ++i0)
#pragma unroll
            for (int i1 = 0; i1 < 16; ++i1)
                if ((i0 + 1) * (i1 + 1) <= 16) {
                    const float v = key2f(T0[i0] & ~127) + key2f(T1[i1] & ~127); const int key = (f2key(v) & ~255) | (i0 * 16 + i1);
                    if (i0 == 0) F[i1] = key;
                    else { if (cnt < 16) L1[cnt] = key; else if (cnt < 32) L2[cnt - 16] = key; else L3[cnt - 32] = key; ++cnt; }
                }
    }
    sort16_desc(L1); merge16_desc(F, L1); sort16_desc(L2); merge16_desc(F, L2); sort16_desc(L3); merge16_desc(F, L3);
    LAS int* tab = (LAS int*)(C.lds + C.wave * 16384);
#pragma unroll
    for (int j = 0; j < 16; ++j) { tab[j * 64 + lane] = T0[j] & 127; tab[(16 + j) * 64 + lane] = T1[j] & 127; }
    LDS_WAIT(); asm volatile("" ::: "memory");
    const float m = key2f(F[0] & ~255);
    float e[16], sum = 0.f;
#pragma unroll
    for (int j = 0; j < 16; ++j) { e[j] = __builtin_amdgcn_exp2f((key2f(F[j] & ~255) - m) * 1.4426950408889634f); sum += e[j]; }
    const float inv = 1.0f / sum;
    const int tok = tokbase + r;
    int* IDX = (int*)(a.ws + WS_IDX) + (size_t)tok * 128 + hp * 16; float* WGT = (float*)(a.ws + WS_WGT) + (size_t)tok * 128 + hp * 16;
    unsigned ov[16];
#pragma unroll
    for (int j = 0; j < 16; ++j) { const int id = F[j] & 255; const int k0 = tab[(id >> 4) * 64 + lane], k1 = tab[(16 + (id & 15)) * 64 + lane];
        ov[j] = (hh == 0) ? (unsigned)(k0 * 128 + k1) : __builtin_bit_cast(unsigned, e[j] * inv); }
    unsigned* obase = (hh == 0) ? (unsigned*)IDX : (unsigned*)WGT;
#pragma unroll
    for (int q = 0; q < 4; ++q) { v4u w = {ov[4 * q], ov[4 * q + 1], ov[4 * q + 2], ov[4 * q + 3]}; *(v4u*)(obase + 4 * q) = w; }
    LDS_WAIT(); asm volatile("" ::: "memory");
}
typedef float f32x2v __attribute__((ext_vector_type(2)));
__device__ __forceinline__ void unpack16(const v4u a, const v4u b, float (&x)[16]) {
    const unsigned w[8] = {a.x, a.y, a.z, a.w, b.x, b.y, b.z, b.w};
#pragma unroll
    for (int i = 0; i < 8; ++i) { x[2 * i] = bflo(w[i]); x[2 * i + 1] = bfhi(w[i]); }
}
__device__ __forceinline__ void unpack16_fp8(const v4u a, float (&x)[16]) {
    const unsigned w[4] = {a.x, a.y, a.z, a.w};
#pragma unroll
    for (int i = 0; i < 4; ++i) { const f32x2v lo = __builtin_amdgcn_cvt_pk_f32_fp8((int)w[i], false), hi = __builtin_amdgcn_cvt_pk_f32_fp8((int)w[i], true);
        x[4 * i] = lo.x; x[4 * i + 1] = lo.y; x[4 * i + 2] = hi.x; x[4 * i + 3] = hi.y; }
}
__device__ __forceinline__ long mk64(unsigned lo, unsigned hi) { return (long)(((unsigned long long)hi << 32) | (unsigned long long)lo); }
__device__ __forceinline__ float dpp_swap1(float v) { return __builtin_bit_cast(float, __builtin_amdgcn_update_dpp(0, __builtin_bit_cast(int, v), 0xB1, 0xf, 0xf, true)); }
struct PHalf { v4u g[8]; };
struct PIdx { int e[8]; };
__device__ __forceinline__ void pg_idx8(const int* IDXr, int h, int hl, PIdx& I) {
    h = min(h, hl); const int* p = IDXr + (size_t)(h >> 1) * 128 + (h & 1) * 64;
#pragma unroll
    for (int j = 0; j < 8; ++j) I.e[j] = p[j * 8];
}
__device__ __forceinline__ void pg_issue(const unsigned char* TBL, const PIdx& I, int lane, PHalf& D) {
    const unsigned c16 = (unsigned)(lane & 7) * 16u;
#pragma unroll
    for (int j = 0; j < 8; ++j) D.g[j] = *(const v4u*)(TBL + ((unsigned)I.e[j] * 128u + c16));
}
__device__ __forceinline__ void pg_stage(LAS unsigned char* buf, int lane, const PHalf& D) {
    const int row8 = lane >> 3, c8 = lane & 7;
#pragma unroll
    for (int j = 0; j < 8; ++j) *(LAS v4u*)(buf + (j * 8 + row8) * 128 + ((c8 ^ row8) & 7) * 16) = D.g[j];
}
__device__ __forceinline__ void e2m1_qv(float y, unsigned& code, float& val) {
    const float m = fminf(fabsf(y), 6.0f);
    const unsigned rb = (__builtin_bit_cast(unsigned, m) + 0x00200000u) & 0xFFC00000u;
    const float sm = 0.5f * rintf(2.0f * m);
    const bool big = m >= 1.0f;
    const float v = big ? __builtin_bit_cast(float, rb) : sm;
    const unsigned c = big ? (rb >> 22) - 252u : (unsigned)(2.0f * sm);
    const unsigned sg = __builtin_bit_cast(unsigned, y) & 0x80000000u;
    code = c | (sg >> 28); val = __builtin_bit_cast(float, __builtin_bit_cast(unsigned, v) | sg);
}
__device__ __forceinline__ void pu_xprep(LAS unsigned char* xs, v2u xw, float sx, int lane) {
    const float x[4] = {bflo(xw.x) * sx, bfhi(xw.x) * sx, bflo(xw.y) * sx, bfhi(xw.y) * sx};
    unsigned hi = 0u, lo = 0u;
#pragma unroll
    for (int j = 0; j < 4; ++j) { unsigned c0, c1; float v0, v1; e2m1_qv(x[j], c0, v0); e2m1_qv((x[j] - v0) * 4.0f, c1, v1); hi |= c0 << (4 * j); lo |= c1 << (4 * j); }
    *(LAS unsigned short*)(xs + 2 * lane) = (unsigned short)hi; *(LAS unsigned short*)(xs + 128 + 2 * lane) = (unsigned short)lo;
}
typedef int v8i_t __attribute__((ext_vector_type(8)));
__device__ __forceinline__ void pu_compute(const LAS unsigned char* buf, bf16* HPt, int r, int kq, const v4u (&bfr)[2]) {
    f32x4 res[4];
    const int sclB = (r & 1) ? 0x7d7d7d7d : 0x7f7f7f7f;
    const v8i_t bv0 = {(int)bfr[0].x, (int)bfr[0].y, (int)bfr[0].z, (int)bfr[0].w, 0, 0, 0, 0}, bv1 = {(int)bfr[1].x, (int)bfr[1].y, (int)bfr[1].z, (int)bfr[1].w, 0, 0, 0, 0};
#pragma unroll
    for (int g = 0; g < 4; ++g) {
        const int row = g * 16 + r, sw = row & 7;
        const v4u a0 = *(const LAS v4u*)(buf + row * 128 + (kq ^ sw) * 16), a1 = *(const LAS v4u*)(buf + row * 128 + ((4 + kq) ^ sw) * 16);
        const v8i_t av0 = {(int)a0.x, (int)a0.y, (int)a0.z, (int)a0.w, 0, 0, 0, 0}, av1 = {(int)a1.x, (int)a1.y, (int)a1.z, (int)a1.w, 0, 0, 0, 0};
        res[g] = __builtin_amdgcn_mfma_scale_f32_16x16x128_f8f6f4(av0, bv0, (f32x4){0.f, 0.f, 0.f, 0.f}, 4  , 4  , 0, 0x7f7f7f7f, 0, sclB);
        res[g] = __builtin_amdgcn_mfma_scale_f32_16x16x128_f8f6f4(av1, bv1, res[g], 4, 4, 0, 0x7f7f7f7f, 0, sclB);
    }
    f32x4 o = res[0];
#pragma unroll
    for (int g = 1; g < 4; ++g) { const bool sel = ((r >> 1) == g);
#pragma unroll
        for (int i = 0; i < 4; ++i) o[i] = sel ? res[g][i] : o[i]; }
#pragma unroll
    for (int i = 0; i < 4; ++i) o[i] += dpp_swap1(o[i]);
    if (r < 8 && (r & 1) == 0) { v2u w; w.x = pk2(o[0], o[1]); w.y = pk2(o[2], o[3]); *(v2u*)(HPt + (r >> 1) * 16 + 4 * kq) = w; }
}
__device__ __forceinline__ int pg_idx(const int* IDXl, int h, int hl) { h = min(h, hl); return IDXl[(size_t)(h >> 1) * 128 + (h & 1) * 64]; }
__device__ __forceinline__ void peer_u_wave(const Args& a, LAS unsigned char* wlds, LAS unsigned char* wsm, int slab, int t0, int ntok, int lane) {
    const unsigned char* U8 = a.ws + WS_PU + (size_t)slab * (16384 * 128);
    const bf16* N2 = (const bf16*)(a.ws + WS_N2) + slab * 256 + 4 * lane;
    const int* IDX = (const int*)(a.ws + WS_IDX) + (lane >> 3);
    bf16* HP = (bf16*)(a.ws + WS_HPART) + (size_t)slab * MTOK * 128;
    const int r = lane & 15, kq = lane >> 4, tl = t0 + ntok - 1, H0 = 2 * t0, HL = 2 * (t0 + ntok) - 1;
    PHalf d[4]; PIdx iv[4]; v4u bfr[2];
    const float* SSp = (const float*)(a.ws + WS_SS); float ssx = SSp[t0];
#pragma unroll
    for (int k = 0; k < 4; ++k) pg_idx8(IDX, H0 + k, HL, iv[k]);
    v2u xw = *(const v2u*)(N2 + (size_t)t0 * DM);
    pg_issue(U8, iv[0], lane, d[0]); pg_issue(U8, iv[1], lane, d[1]); pg_issue(U8, iv[2], lane, d[2]);
    pg_idx8(IDX, H0 + 4, HL, iv[0]); pg_idx8(IDX, H0 + 5, HL, iv[1]); pg_idx8(IDX, H0 + 6, HL, iv[2]);
    pg_stage(wlds, lane, d[0]);
#define PU_XPREP(tok) do { pu_xprep(wsm, xw, 2.05f * __builtin_amdgcn_rsqf(ssx * (1.f / DM) + EPS), lane); \
        { const LAS unsigned char* bp = wsm + ((r & 1) ? 128 : 0) + kq * 16; bfr[0] = *(const LAS v4u*)bp; bfr[1] = *(const LAS v4u*)(bp + 64); } \
        xw = *(const v2u*)(N2 + (size_t)min((tok) + 1, tl) * DM); ssx = SSp[min((tok) + 1, tl)]; } while (0)
#define PU_PHASE(ph, hrel, tok, half) do { \
        pg_issue(U8, iv[((ph) + 3) & 3], lane, d[((ph) + 3) & 3]); pg_idx8(IDX, hb + (hrel) + 7, HL, iv[((ph) + 3) & 3]); \
        pu_compute(wlds + ((half) ? 8192 : 0), HP + (size_t)(tok) * 128 + (half) * 64, r, kq, bfr); \
        pg_stage(wlds + ((half) ? 0 : 8192), lane, d[((ph) + 1) & 3]); } while (0)
#pragma unroll 1
    for (int hb = H0; hb <= HL; hb += 4) {
        const int t = hb >> 1;
        PU_XPREP(t);
        PU_PHASE(0, 0, t, 0);
        PU_PHASE(1, 1, t, 1);
        PU_XPREP(t + 1);
        PU_PHASE(2, 2, t + 1, 0);
        PU_PHASE(3, 3, t + 1, 1);
    }
#undef PU_XPREP
#undef PU_PHASE
}
__device__ __forceinline__ void peer_reduce(const Ctx& C, const Args& a) {
    const bf16* HP = (const bf16*)(a.ws + WS_HPART); const int* IDX = (const int*)(a.ws + WS_IDX); const float* WGT = (const float*)(a.ws + WS_WGT);
    const f32x2v* SC2 = (const f32x2v*)(a.ws + WS_PSC);
    unsigned char* ACT8 = a.ws + WS_ACT; float* ASC = (float*)(a.ws + WS_ACT + 8 * MiB);
    for (int it = C.vcu * 512 + C.tid; it < MTOK * 32; it += C.G * 512) {
        f32x4 h = {0.f, 0.f, 0.f, 0.f};
#pragma unroll
        for (int sl = 0; sl < 4; ++sl) { const v2u w = *(const v2u*)(HP + (size_t)sl * MTOK * 128 + (size_t)it * 4); h[0] += bflo(w.x); h[1] += bfhi(w.x); h[2] += bflo(w.y); h[3] += bfhi(w.y); }
        const int4 e = *(const int4*)(IDX + (size_t)it * 4); const f32x4 w = *(const f32x4*)(WGT + (size_t)it * 4);
        const int tok = it >> 5, q = it & 31;
        const float rs = 1.0f / 2.05f;
        f32x4 o;
        const f32x2v s0 = SC2[e.x], s1 = SC2[e.y], s2 = SC2[e.z], s3 = SC2[e.w];
        o[0] = gelu_tanh(h[0] * s0.x * rs) * w[0] * s0.y; o[1] = gelu_tanh(h[1] * s1.x * rs) * w[1] * s1.y;
        o[2] = gelu_tanh(h[2] * s2.x * rs) * w[2] * s2.y; o[3] = gelu_tanh(h[3] * s3.x * rs) * w[3] * s3.y;
        float mx = fmaxf(fmaxf(fabsf(o[0]), fabsf(o[1])), fmaxf(fabsf(o[2]), fabsf(o[3])));
#pragma unroll
        for (int sh = 1; sh < 32; sh <<= 1) mx = fmaxf(mx, __shfl_xor(mx, sh));
        const bool tiny = mx < 1e-30f;
        const float sc = tiny ? 1.f : 6.0f / mx, isc = tiny ? 1.f : mx * (1.0f / 6.0f);
        unsigned hi = 0u, lo = 0u;
#pragma unroll
        for (int j = 0; j < 4; ++j) { unsigned c0, c1; float v0, v1; e2m1_qv(o[j] * sc, c0, v0); e2m1_qv((o[j] * sc - v0) * 4.0f, c1, v1); hi |= c0 << (4 * j); lo |= c1 << (4 * j); }
        *(unsigned short*)(ACT8 + (size_t)tok * 128 + 2 * q) = (unsigned short)hi; *(unsigned short*)(ACT8 + (size_t)tok * 128 + 64 + 2 * q) = (unsigned short)lo;
        if (q == 0) ASC[tok] = isc;
    }
}
typedef int v2i_t __attribute__((ext_vector_type(2)));
__device__ __forceinline__ void pv_compute8(const LAS unsigned char* wl, int lane, int nb0, const v4u bact, int sclB, f32x4 (&acc)[8]) {
    const int m = lane & 15, kq = lane >> 4, sw = m & 7;
    const LAS unsigned char* rp = wl + (32 * kq + m) * 128;
    const v8i_t bv = {(int)bact.x, (int)bact.y, (int)bact.z, (int)bact.w, 0, 0, 0, 0};
#pragma unroll
    for (int nbi = 0; nbi < 8; ++nbi) {
        const int nb = nb0 + nbi, off = (((nb >> 1) ^ sw) & 7) * 16 + (nb & 1) * 8;
        const v2i_t r0 = __builtin_amdgcn_ds_read_tr4_b64_v2i32((LAS v2i_t*)(rp + off)), r1 = __builtin_amdgcn_ds_read_tr4_b64_v2i32((LAS v2i_t*)(rp + 16 * 128 + off));
        const v8i_t av = {r0.x, r0.y, r1.x, r1.y, 0, 0, 0, 0};
        acc[nbi] = __builtin_amdgcn_mfma_scale_f32_16x16x128_f8f6f4(av, bv, (f32x4){0.f, 0.f, 0.f, 0.f}, 4, 4, 0, 0x7f7f7f7f, 0, sclB);
    }
}
__device__ __forceinline__ void peer_v_wave(const Args& a, LAS unsigned char* wlds, int slab, int t0, int ntok, int lane) {
    const unsigned char* V8 = a.ws + WS_PV + (size_t)slab * (16384 * 128);
    const int* IDX = (const int*)(a.ws + WS_IDX) + (lane >> 3);
    const int n16 = lane & 15, kq = lane >> 4, tl = t0 + ntok - 1, H0 = 2 * t0, HL = 2 * (t0 + ntok) - 1;
    const unsigned char* ACT4 = a.ws + WS_ACT + ((n16 & 1) ? 64 : 0) + 16 * kq; const float* ASC = (const float*)(a.ws + WS_ACT + 8 * MiB);
    const int sclB = (n16 & 1) ? 0x7d7d7d7d : 0x7f7f7f7f;
    bf16* PO = (bf16*)(a.ws + WS_POUT) + slab * 256;
    PHalf d[4]; PIdx iv[4]; v4u bact, bnxt; f32x4 acc[8]; float isc = 1.f, iscn;
#pragma unroll
    for (int k = 0; k < 4; ++k) pg_idx8(IDX, H0 + k, HL, iv[k]);
    bnxt = *(const v4u*)(ACT4 + (size_t)t0 * 128); iscn = ASC[t0];
    pg_issue(V8, iv[0], lane, d[0]); pg_issue(V8, iv[1], lane, d[1]); pg_issue(V8, iv[2], lane, d[2]); pg_issue(V8, iv[3], lane, d[3]);
#pragma unroll
    for (int k = 0; k < 4; ++k) pg_idx8(IDX, H0 + 4 + k, HL, iv[k]);
    pg_stage(wlds, lane, d[0]); pg_stage(wlds + 8192, lane, d[1]);
#define PV_EPI(tok, cb) do { f32x4 o = acc[0]; \
        _Pragma("unroll") for (int nb = 1; nb < 8; ++nb) { const bool sel = ((n16 >> 1) == nb); \
            _Pragma("unroll") for (int i = 0; i < 4; ++i) o[i] = sel ? acc[nb][i] : o[i]; } \
        _Pragma("unroll") for (int i = 0; i < 4; ++i) o[i] += dpp_swap1(o[i]); \
        if ((n16 & 1) == 0) { v2u w; w.x = pk2(o[0] * isc, o[1] * isc); w.y = pk2(o[2] * isc, o[3] * isc); *(v2u*)(PO + (size_t)(tok) * DM + (cb) + 16 * (n16 >> 1) + 4 * kq) = w; } } while (0)
#define PV_TOKEN(tok) do { bact = bnxt; isc = iscn; \
        { const int tn = min((tok) + 1, tl); bnxt = *(const v4u*)(ACT4 + (size_t)tn * 128); iscn = ASC[tn]; } \
        pv_compute8(wlds, lane, 0, bact, sclB, acc); PV_EPI(tok, 0); \
        pv_compute8(wlds, lane, 8, bact, sclB, acc); PV_EPI(tok, 128); } while (0)
#pragma unroll 1
    for (int t = t0; t <= tl; t += 2) {
        const int hb = 2 * t;
        pg_issue(V8, iv[0], lane, d[0]); pg_issue(V8, iv[1], lane, d[1]);
        pg_idx8(IDX, hb + 8, HL, iv[0]); pg_idx8(IDX, hb + 9, HL, iv[1]);
        PV_TOKEN(t);
        pg_stage(wlds, lane, d[2]); pg_stage(wlds + 8192, lane, d[3]);
        pg_issue(V8, iv[2], lane, d[2]); pg_issue(V8, iv[3], lane, d[3]);
        pg_idx8(IDX, hb + 10, HL, iv[2]); pg_idx8(IDX, hb + 11, HL, iv[3]);
        PV_TOKEN(t + 1);
        pg_stage(wlds, lane, d[0]); pg_stage(wlds + 8192, lane, d[1]);
    }
#undef PV_EPI
#undef PV_TOKEN
}
__device__ __forceinline__ void final_rows4(const Args& a, int tok0, int tstep, int lane) {
    const float* gf = (const float*)a.in[25] + lane * 4;
    f32x4 h[4][4]; v2u pw[4][4], hw[4][4]; float ss[4];
#pragma unroll
    for (int i = 0; i < 4; ++i) { const int tok = tok0 + i * tstep; const bf16* hb = (const bf16*)(a.ws + WS_N2) + (size_t)tok * DM + lane * 4; const bf16* po = (const bf16*)(a.ws + WS_POUT) + (size_t)tok * DM + lane * 4;
#pragma unroll
        for (int q = 0; q < 4; ++q) { hw[i][q] = *(const v2u*)(hb + 256 * q); pw[i][q] = *(const v2u*)(po + 256 * q); } }
#pragma unroll
    for (int i = 0; i < 4; ++i) { ss[i] = 0.f;
#pragma unroll
        for (int q = 0; q < 4; ++q) { h[i][q][0] = bflo(hw[i][q].x) + bflo(pw[i][q].x); h[i][q][1] = bfhi(hw[i][q].x) + bfhi(pw[i][q].x); h[i][q][2] = bflo(hw[i][q].y) + bflo(pw[i][q].y); h[i][q][3] = bfhi(hw[i][q].y) + bfhi(pw[i][q].y);
            ss[i] += (h[i][q][0] * h[i][q][0] + h[i][q][1] * h[i][q][1]) + (h[i][q][2] * h[i][q][2] + h[i][q][3] * h[i][q][3]); } }
#pragma unroll
    for (int o = 1; o < 64; o <<= 1)
#pragma unroll
        for (int i = 0; i < 4; ++i) ss[i] += __shfl_xor(ss[i], o);
    f32x4 g[4];
#pragma unroll
    for (int q = 0; q < 4; ++q) g[q] = *(const f32x4*)(gf + 256 * q);
#pragma unroll
    for (int i = 0; i < 4; ++i) { const float rstd = 1.0f / sqrtf(ss[i] * (1.f / DM) + EPS); float* orow = a.out + (size_t)(tok0 + i * tstep) * DM + lane * 4;
#pragma unroll
        for (int q = 0; q < 4; ++q) *(f32x4*)(orow + 256 * q) = h[i][q] * rstd * g[q]; }
}

__device__ __forceinline__ void claim_slab_unit(const Ctx& C, unsigned* ctl, int pass, volatile LAS unsigned* MISC, int& slab, int& unit) {
    if (C.tid == 0) {
        const unsigned ns = 4u, nu = 64u;
        const unsigned x = xb_xcc_id() & (ns - 1u); unsigned sl = 8u, un = 0u;
        for (unsigned k = 0; k < ns; ++k) { const unsigned s2 = (x + k) & (ns - 1u); const unsigned u2 = xb_add(ctl + CW_Q + 1024 * pass + 64 * s2, 1u); if (u2 < nu) { sl = s2; un = u2; break; } }
        MISC[16] = sl; MISC[17] = un;
    }
    __syncthreads();
    slab = (int)MISC[16]; unit = (int)MISC[17];
    __syncthreads();
}
__global__ void __launch_bounds__(NWAVES * 64, 2) mk_fwd(Args args) {
    extern __shared__ __attribute__((aligned(16))) unsigned char lds_raw[];
    Ctx C;
    C.lds = (LAS unsigned char*)lds_raw;
    C.wave = __builtin_amdgcn_readfirstlane((int)threadIdx.x >> 6); C.refresh();
    C.G = gridDim.x; { const int bx = blockIdx.x; C.vcu = (C.G % 8 == 0) ? (bx % 8) * (C.G / 8) + bx / 8 : bx; }
    volatile LAS unsigned* MISC = (volatile LAS unsigned*)(C.lds + MISC_OFF);
    if (C.tid < 128) MISC[C.tid] = 0u;
    __syncthreads();
    unsigned char* ws = args.ws;
    unsigned* ctl = (unsigned*)(ws + WS_CTL);
    XcdBarrier bar; bar.bar = ctl + CW_BAR; bar.x = 0; bar.st = nullptr;
#if !MK_PER_PHASE
    bar = xcd_barrier_post(ctl + CW_BAR, MISC + 8, C.tid == 0);
#define GRID_BAR() xcd_barrier(bar, C.wave)
#else
#define GRID_BAR() do { } while (0)
#endif
    const int lo = args.ph_lo, hi = args.ph_hi;
#define IN(k) (lo <= (k) && (k) < hi)
#define SEAM(k) do { if (IN((k) + 1)) GRID_BAR(); C.refresh(); } while (0)
#define REP(k) for (int rep_ = 0; rep_ < 1 + ((REPEAT_MASK >> (k)) & 1); ++rep_)
    bf16* XN = (bf16*)(ws + WS_A);
    if (IN(0)) { REP(0) { p0_prologue(C, args); __syncthreads(); } SEAM(0); }
    if (IN(1)) {
        REP(1) {
        run_gemm(C, XN, (const bf16*)(ws + WS_WIN_T), MTOK, NZ1, DM, FStore{(bf16*)(ws + WS_Z1), NZ1});
        }
        SEAM(1);
    }
    if (IN(2)) {
        REP(2) { const int tile = C.vcu;
            {
                const int i_ = C.tid >> 2, dq_ = (C.tid & 3) * 16, eq_ = (C.tid & 3) * 32;
                const bf16* zr_ = (const bf16*)(ws + WS_Z1) + (size_t)(tile * 128 + i_) * NZ1; const float* rp_ = (const float*)(ws + WS_ROPE) + (size_t)(tile * 128 + i_) * 128;
                float cs_[16], sn_[16];
#pragma unroll
                for (int q = 0; q < 4; ++q) { const f32x4 c4 = *(const f32x4*)(rp_ + dq_ + 4 * q), s4 = *(const f32x4*)(rp_ + 64 + dq_ + 4 * q);
#pragma unroll
                    for (int e = 0; e < 4; ++e) { cs_[4 * q + e] = c4[e]; sn_[4 * q + e] = s4[e]; } }
                R1In ra_, rb_;
                r1_load(zr_, 0, dq_, eq_, ra_);
                _Pragma("unroll 1") for (int h2 = 0; h2 < 4; h2 += 2) {
                    r1_unit(C, args, tile, h2, cs_, sn_, ra_, rb_, true);
                    r1_unit(C, args, tile, h2 + 1, cs_, sn_, rb_, ra_, h2 == 0);
                }
            }
            C.refresh();
            _Pragma("unroll 1") for (int gi = 0; gi < 2; ++gi) s5a_wave(C, args, tile, C.wave + 8 * gi);
            __syncthreads();
        }
        SEAM(2);
    }
    if (IN(3)) { REP(3) { p3_scans(C, args); }
        run_gemm(C, (const bf16*)(ws + WS_MEMN), (const bf16*)(ws + WS_WMKV_T), MROWS, 512, DM, FKvm{(bf16*)(ws + WS_KM), (bf16*)(ws + WS_VT)});
        SEAM(3); }
    if (IN(4)) {
        REP(4) { const int tile = C.vcu;
            _Pragma("unroll 1") for (int gi = 0; gi < 2; ++gi) r3_wave(C, args, tile, 2 * gi + (C.wave >> 2), C.wave & 3);
            _Pragma("unroll 1") for (int gi = 0; gi < 2; ++gi) s5c_wave(C, args, tile, C.wave + 8 * gi);
            _Pragma("unroll 1") for (int gi = 0; gi < 2; ++gi) ma_wave(C, args, tile, 2 * gi + (C.wave >> 2), C.wave & 3);
        }
        SEAM(4);
    }
    if (IN(5)) {
        REP(5) {
        run_gemm_mx(C, ws + WS_XN8, ws + WS_WG8, MTOK, NGATE, DM, FSig{(bf16*)(ws + WS_G), NGATE}, 0x7b7b7b7b  , 0x77777777  );
        run_gemm(C, (const bf16*)(ws + WS_YG), (const bf16*)(ws + WS_WGLU_T), MTOK, 512, 256, FGlu{(bf16*)(ws + WS_YCAT)});
        }
        SEAM(5);
    }
    if (IN(6)) {
        const bf16* Gt = (const bf16*)(ws + WS_G);
        run_gemm_hook(C, (const bf16*)(ws + WS_YCAT), (const bf16*)(ws + WS_WCAT_T), MTOK, DM, DM, FGateOut{Gt, XN}, HookGate{Gt});
        SEAM(6);
    }
    if (IN(7)) { run_gemm(C, XN, (const bf16*)(ws + WS_WOUT_T), MTOK, DM, DM, FRes{(const float*)args.in[0], (bf16*)(ws + WS_N2), (float*)(ws + WS_SS)}); SEAM(7); }
    if (IN(9)) { REP(9) run_gemm(C, (const bf16*)(ws + WS_N2), (const bf16*)(ws + WS_WQ_T), MTOK, 2048, DM, FStoreRstd{(bf16*)(ws + WS_Q2), 2048, (const float*)(ws + WS_SS)}); SEAM(9); }
    if (IN(10)) {
        { const int tile = C.vcu;
            const int tokbase = tile * 128 + (C.wave & 3) * 32, h0 = (C.wave >> 2) * 4;
            REP(10) { _Pragma("unroll 1") for (int hp = h0; hp < h0 + 4; ++hp) peer_topk_head(C, args, tokbase, hp); }
        }
        SEAM(10);
    }
    if (IN(11)) { int slab, unit; claim_slab_unit(C, ctl, 0, MISC, slab, unit); if (slab < 8) { REP(11) peer_u_wave(args, C.lds + C.wave * 16384, C.lds + 131072 + C.wave * 1024, slab, unit * 512 + C.wave * 64, 64, C.lane); } SEAM(11); }
    if (IN(12)) { REP(12) peer_reduce(C, args); SEAM(12); }
    if (IN(13)) { int slab, unit; claim_slab_unit(C, ctl, 1, MISC, slab, unit); if (slab < 8) { REP(13) peer_v_wave(args, C.lds + C.wave * 16384, slab, unit * 512 + C.wave * 64, 64, C.lane); } SEAM(13); }
    if (IN(14)) {
        const int gw = C.vcu * NWAVES + C.wave, NGW = C.G * NWAVES;
        for (int m = gw; m < MTOK; m += 4 * NGW) final_rows4(args, m, NGW, C.lane);
    }
#undef IN
#undef SEAM
}

extern "C" void kernel_launch(void* const* d_in, const int* in_sizes, int n_in, void* d_out, int out_size, void* d_ws, size_t ws_size, hipStream_t stream) {
    static int grid = 0;
    if (grid == 0) {
        if (n_in != 26 || in_sizes[0] != MTOK * DM || out_size != MTOK * DM || ws_size < WS_END) {
            fprintf(stderr, "kernel_launch: unexpected problem (n_in %d, in0 %d, out %d, ws %zu < %zu); nothing launched\n", n_in, n_in > 0 ? in_sizes[0] : -1, out_size, ws_size, (size_t)WS_END); grid = -1; return; }
        int dev = 0, cus = 0;
        if (hipGetDevice(&dev) != hipSuccess || hipDeviceGetAttribute(&cus, hipDeviceAttributeMultiprocessorCount, dev) != hipSuccess) { grid = -1; return; }
        if (hipFuncSetAttribute((const void*)mk_fwd, hipFuncAttributeMaxDynamicSharedMemorySize, LDS_BYTES) != hipSuccess) { fprintf(stderr, "kernel_launch: hipFuncSetAttribute failed\n"); grid = -1; return; }
        (void)hipGetLastError();
        if (cus < NTILES) { fprintf(stderr, "kernel_launch: needs >= 256 CUs, got %d\n", cus); grid = -1; return; }
        grid = NTILES;
    }
    if (grid < 0) return;
    (void)hipMemsetAsync((char*)d_ws + WS_CTL, 0, CTL_ZERO_BYTES, stream);
    Args a{};
    for (int i = 0; i < 26; ++i) a.in[i] = d_in[i];
    a.out = (float*)d_out; a.ws = (unsigned char*)d_ws;
#if MK_PER_PHASE
    for (int p = 0; p < NPHASE; ++p) { a.ph_lo = p; a.ph_hi = p + 1; hipLaunchKernelGGL(mk_fwd, dim3(grid), dim3(NWAVES * 64), LDS_BYTES, stream, a); }
#else
    a.ph_lo = 0; a.ph_hi = NPHASE;
    hipLaunchKernelGGL(mk_fwd, dim3(grid), dim3(NWAVES * 64), LDS_BYTES, stream, a);
#endif
}
```

```cpp
#include <hip/hip_runtime.h>
#include <cstdio>
#include <cstdint>
namespace pg8 {
__device__ __forceinline__ int hw_lane_id() { int l; asm volatile("v_mbcnt_lo_u32_b32 %0, -1, 0\n\tv_mbcnt_hi_u32_b32 %0, -1, %0" : "=v"(l)); return l; }
#define PG8_LAS __attribute__((address_space(3)))
typedef unsigned short bf16_t;
typedef short bf16x8 __attribute__((ext_vector_type(8)));
typedef float f32x4 __attribute__((ext_vector_type(4)));
typedef unsigned u32x4 __attribute__((ext_vector_type(4)));
constexpr int BM = 256, BK = 64, HALF = 128, HTB = HALF * BK * 2  , STAGE_BYTES = 8 * HTB, NXCD = 8, WGM = 8;

__host__ __device__ __forceinline__ int lds_byte(int r, int c) { const int st = (r >> 4) * 2 + (c >> 5), rr = r & 15, cc = c & 31, ob = rr * 64 + cc * 2; return st * 1024 + (ob ^ (((ob >> 9) & 1) << 5)); }
__host__ __device__ __forceinline__ void stage_rc(int b, int& R, int& C) { const int st = b / 1024, sb = b % 1024, swz = sb ^ (((sb >> 9) & 1) << 5); R = (st >> 1) * 16 + swz / 64; C = (st & 1) * 32 + (swz % 64) / 2; }
__host__ __device__ __forceinline__ int perm32(int rho) { const int n = rho >> 4, i = rho & 15; return 8 * (i >> 2) + 4 * n + (i & 3); }

struct Unit { int pm, pn; };
struct Gemm { const bf16_t* A; const bf16_t* Bt; int M, N, K; };

struct StaticOrder {
    int nM, nN, nwg, G, c;
    __host__ __device__ void init(int M, int N, int G_, int c_) { nM = M / BM; nN = N / BM; nwg = nM * nN; G = G_; c = c_; }
    __host__ __device__ bool next(int i, Unit& u) const {
        const long L = (long)i * G + c; if (L >= nwg) return false;
        int wgid = (int)L; { const int q = nwg / NXCD, r = nwg % NXCD, xcd = wgid % NXCD, off = wgid / NXCD; wgid = (xcd < r ? xcd * (q + 1) : r * (q + 1) + (xcd - r) * q) + off; }
        const int nig = WGM * nN, gid = wgid / nig, fm = gid * WGM, gsz = (nM - fm) < WGM ? (nM - fm) : WGM;
        u.pm = fm + ((wgid % nig) % gsz); u.pn = (wgid % nig) / gsz; return true;
    }
    __device__ __forceinline__ void a_ready(const Unit&) const {}
    __device__ __forceinline__ void done(const Unit&) const {}
};

__device__ __forceinline__ unsigned cvt_pk_bf16(float lo, float hi) { unsigned r; asm volatile("v_cvt_pk_bf16_f32 %0, %1, %2" : "=v"(r) : "v"(lo), "v"(hi)); return r; }
struct NoKHook { __device__ __forceinline__ void operator()(int, f32x4 (&)[2][2][4][2], const Unit&, int, int, int, int) const {} };
template <class Epi, class Sched, bool ALIGN_EPI = false, bool SP2 = false, bool MX = false, class KHook = NoKHook, bool I8 = false>
__device__ __forceinline__ void gemm_phase(PG8_LAS unsigned char* lds, const Gemm g, const Sched& S, const Epi& E, const int wid, const int sclA = 0x7f7f7f7f, const int sclB = 0x7f7f7f7f, const KHook& KH = KHook()) {
    const int lane = hw_lane_id(), tid = wid * 64 + lane, wr = wid >> 2, wc = wid & 3, fr = lane & 15, fq = lane >> 4;
    const int K = g.K, nt = K / BK;
    unsigned voffA[2], voffB[2];
#pragma unroll
    for (int i = 0; i < 2; ++i) { int R, C; stage_rc(tid * 16 + i * 8192, R, C); const int Rb = Epi::PERM ? ((R & ~31) + perm32(R & 31)) : R;
        voffA[i] = (unsigned)(R * K + C) * 2u; voffB[i] = (unsigned)(Rb * K + C) * 2u; }
    const size_t kstep = (size_t)(BK * 2);
    const size_t hstep = (size_t)HALF * K * 2;
    const size_t tstep = 2 * hstep;
    const unsigned ldsw = (unsigned)wid * 1024u;
    const int aoff = lds_byte(wr * 64 + fr, fq * 8), boff = lds_byte(wc * 32 + fr, fq * 8);
#define PG8_SA(b, h) (((b) * 2 + (h)) * HTB)
#define PG8_SB(b, h) ((4 + (b) * 2 + (h)) * HTB)
#define PG8_STAGE(bufoff, gbase, voff) do { _Pragma("unroll") for (int _i = 0; _i < 2; ++_i) \
        __builtin_amdgcn_global_load_lds((const unsigned*)((const char*)(gbase) + (voff)[_i]), (PG8_LAS unsigned*)(lds + (bufoff) + ldsw + _i * 8192), 16, 0, 0); } while (0)
#define PG8_LDA(dst, b, h) do { _Pragma("unroll") for (int m = 0; m < 4; ++m) { \
        if constexpr (MX) { dst##8[m].lo = *(const PG8_LAS v4i_*)(lds + PG8_SA(b, h) + aoff + m * 2048); dst##8[m].hi = *(const PG8_LAS v4i_*)(lds + PG8_SA(b, h) + aoff + m * 2048 + 1024); } \
        else { _Pragma("unroll") for (int k = 0; k < 2; ++k) dst[m][k] = *(const PG8_LAS bf16x8*)(lds + PG8_SA(b, h) + aoff + m * 2048 + k * 1024); } } } while (0)
#define PG8_LDB(dst, b, h) do { _Pragma("unroll") for (int n = 0; n < 2; ++n) { \
        if constexpr (MX) { dst##8[n].lo = *(const PG8_LAS v4i_*)(lds + PG8_SB(b, h) + boff + n * 2048); dst##8[n].hi = *(const PG8_LAS v4i_*)(lds + PG8_SB(b, h) + boff + n * 2048 + 1024); } \
        else { _Pragma("unroll") for (int k = 0; k < 2; ++k) dst[n][k] = *(const PG8_LAS bf16x8*)(lds + PG8_SB(b, h) + boff + n * 2048 + k * 1024); } } } while (0)
#define PG8_MMA(ai, bj, At, Bt) do { __builtin_amdgcn_s_setprio(1); _Pragma("unroll") for (int m = 0; m < 4; ++m) _Pragma("unroll") for (int n = 0; n < 2; ++n) { \
        if constexpr (MX && I8) { v4i_ c_ = __builtin_bit_cast(v4i_, acc[ai][bj][m][n]); \
            c_ = __builtin_amdgcn_mfma_i32_16x16x64_i8(Bt##8[n].lo, At##8[m].lo, c_, 0, 0, 0); c_ = __builtin_amdgcn_mfma_i32_16x16x64_i8(Bt##8[n].hi, At##8[m].hi, c_, 0, 0, 0); \
            acc[ai][bj][m][n] = __builtin_bit_cast(f32x4, c_); } \
        else if constexpr (MX) acc[ai][bj][m][n] = __builtin_amdgcn_mfma_scale_f32_16x16x128_f8f6f4(Bt##8[n], At##8[m], acc[ai][bj][m][n], 0, 0, 0, sclB, 0, sclA); \
        else { _Pragma("unroll") for (int k = 0; k < 2; ++k) acc[ai][bj][m][n] = __builtin_amdgcn_mfma_f32_16x16x32_bf16(Bt[n][k], At[m][k], acc[ai][bj][m][n], 0, 0, 0); } } \
        if constexpr (MX) { _Pragma("unroll") for (int m = 0; m < 4; ++m) _Pragma("unroll") for (int n = 0; n < 2; ++n) asm volatile("" : "+v"(acc[ai][bj][m][n])); }     \
        __builtin_amdgcn_s_setprio(0); } while (0)
#define PG8_WAIT_V(n) asm volatile("s_waitcnt vmcnt(" #n ")" ::: "memory")
#define PG8_WAIT_L(n) asm volatile("s_waitcnt lgkmcnt(" #n ")" ::: "memory")
#define PG8_BAR __builtin_amdgcn_s_barrier()
#define PG8_SCHED __builtin_amdgcn_sched_barrier(0)
    Unit cur, nxt; int ui = 0;
    if (!S.next(0, cur)) return;
    f32x4 acc[2][2][4][2];
#pragma unroll
    for (int a = 0; a < 2; ++a)
#pragma unroll
        for (int b = 0; b < 2; ++b)
#pragma unroll
            for (int m = 0; m < 4; ++m)
#pragma unroll
                for (int n = 0; n < 2; ++n) acc[a][b][m][n] = (f32x4){0.f, 0.f, 0.f, 0.f};
    typedef int v8i_ __attribute__((ext_vector_type(8))); typedef int v4i_ __attribute__((ext_vector_type(4)));
    bf16x8 At[4][2], B0[2][2], B1[2][2]; v8i_ At8[4], B08[2], B18[2];
    const char* cA = (const char*)g.A + (size_t)cur.pm * tstep; const char* cB = (const char*)g.Bt + (size_t)cur.pn * tstep;
    S.a_ready(cur);
    if constexpr (SP2) {
        PG8_STAGE(PG8_SB(0, 0), cB, voffB); PG8_STAGE(PG8_SB(0, 1), cB + hstep, voffB); PG8_STAGE(PG8_SA(0, 0), cA, voffA); PG8_STAGE(PG8_SA(0, 1), cA + hstep, voffA);
        if (wr == 1) PG8_BAR;
        PG8_WAIT_V(2); PG8_BAR;
        PG8_STAGE(PG8_SB(1, 0), cB + kstep, voffB); PG8_STAGE(PG8_SA(1, 0), cA + kstep, voffA); PG8_STAGE(PG8_SB(1, 1), cB + hstep + kstep, voffB);
        PG8_WAIT_V(6); PG8_BAR;
    } else {
        PG8_STAGE(PG8_SB(0, 0), cB, voffB); PG8_STAGE(PG8_SA(0, 0), cA, voffA); PG8_STAGE(PG8_SB(0, 1), cB + hstep, voffB); PG8_STAGE(PG8_SA(0, 1), cA + hstep, voffA);
        if (wr == 1) PG8_BAR;
        PG8_WAIT_V(4); PG8_BAR;
        PG8_STAGE(PG8_SB(1, 0), cB + kstep, voffB); PG8_STAGE(PG8_SA(1, 0), cA + kstep, voffA); PG8_STAGE(PG8_SB(1, 1), cB + hstep + kstep, voffB);
        PG8_WAIT_V(6); PG8_BAR;
    }
    for (;;) {
        const bool has_next = S.next(ui + 1, nxt);
        const char* nA = has_next ? (const char*)g.A + (size_t)nxt.pm * tstep : cA; const char* nB = has_next ? (const char*)g.Bt + (size_t)nxt.pn * tstep : cB;
        for (int t = 0; t < nt; t += 2) {
            KH(t, acc, cur, wr, wc, fr, fq);
            const bool last = (t == nt - 2);
            const char* a1 = cA + (size_t)(t + 1) * kstep;
            const char* a2 = last ? nA : cA + (size_t)(t + 2) * kstep; const char* b2 = last ? nB : cB + (size_t)(t + 2) * kstep;
            const char* a3 = a2 + kstep; const char* b3 = b2 + kstep;
            if (last && has_next) S.a_ready(nxt);
            if constexpr (SP2) {
            PG8_LDB(B0, 0, 0); PG8_LDB(B1, 0, 1); PG8_SCHED; PG8_LDA(At, 0, 0); PG8_STAGE(PG8_SA(1, 1), a1 + hstep, voffA);
            PG8_WAIT_V(8); PG8_WAIT_L(0); PG8_BAR; PG8_MMA(0, 0, At, B0); PG8_MMA(0, 1, At, B1); PG8_BAR; PG8_SCHED;
            PG8_LDA(At, 0, 1); PG8_STAGE(PG8_SB(0, 0), b2, voffB); PG8_STAGE(PG8_SB(0, 1), b2 + hstep, voffB); PG8_STAGE(PG8_SA(0, 0), a2, voffA);
            PG8_WAIT_V(8); PG8_WAIT_L(0); PG8_BAR; PG8_MMA(1, 0, At, B0); PG8_MMA(1, 1, At, B1); PG8_BAR; PG8_SCHED;
            PG8_LDB(B0, 1, 0); PG8_LDB(B1, 1, 1); PG8_SCHED; PG8_LDA(At, 1, 0); PG8_STAGE(PG8_SA(0, 1), a2 + hstep, voffA);
            PG8_WAIT_V(8); PG8_WAIT_L(0); PG8_BAR; PG8_MMA(0, 0, At, B0); PG8_MMA(0, 1, At, B1); PG8_BAR; PG8_SCHED;
            PG8_LDA(At, 1, 1); PG8_STAGE(PG8_SB(1, 0), b3, voffB); PG8_STAGE(PG8_SB(1, 1), b3 + hstep, voffB); PG8_STAGE(PG8_SA(1, 0), a3, voffA);
            PG8_WAIT_V(8); PG8_WAIT_L(0); PG8_BAR; PG8_MMA(1, 0, At, B0); PG8_MMA(1, 1, At, B1); PG8_BAR; PG8_SCHED;
            } else {
            PG8_LDB(B0, 0, 0); PG8_SCHED; PG8_LDA(At, 0, 0); PG8_STAGE(PG8_SA(1, 1), a1 + hstep, voffA);
            PG8_WAIT_L(8); PG8_BAR; PG8_WAIT_L(0); PG8_MMA(0, 0, At, B0); PG8_BAR; PG8_SCHED;
            PG8_LDB(B1, 0, 1); PG8_STAGE(PG8_SB(0, 0), b2, voffB);
            PG8_BAR; PG8_WAIT_L(0); PG8_MMA(0, 1, At, B1); PG8_BAR;
            PG8_LDA(At, 0, 1); PG8_STAGE(PG8_SA(0, 0), a2, voffA);
            PG8_BAR; PG8_WAIT_L(0); PG8_MMA(1, 0, At, B0); PG8_BAR; PG8_SCHED;
            PG8_STAGE(PG8_SB(0, 1), b2 + hstep, voffB);
            PG8_WAIT_V(6); PG8_BAR; PG8_MMA(1, 1, At, B1); PG8_BAR;
            PG8_LDB(B0, 1, 0); PG8_SCHED; PG8_LDA(At, 1, 0); PG8_STAGE(PG8_SA(0, 1), a2 + hstep, voffA);
            PG8_WAIT_L(8); PG8_BAR; PG8_WAIT_L(0); PG8_MMA(0, 0, At, B0); PG8_BAR; PG8_SCHED;
            PG8_LDB(B1, 1, 1); PG8_STAGE(PG8_SB(1, 0), b3, voffB);
            PG8_BAR; PG8_WAIT_L(0); PG8_MMA(0, 1, At, B1); PG8_BAR;
            PG8_LDA(At, 1, 1); PG8_STAGE(PG8_SA(1, 0), a3, voffA);
            PG8_BAR; PG8_WAIT_L(0); PG8_MMA(1, 0, At, B0); PG8_BAR; PG8_SCHED;
            PG8_STAGE(PG8_SB(1, 1), b3 + hstep, voffB);
            PG8_WAIT_V(6); PG8_BAR; PG8_MMA(1, 1, At, B1); PG8_BAR;
            }
        }
        if constexpr (ALIGN_EPI) { if (wr == 0) PG8_BAR; }
        if constexpr (!Epi::AFTER_DRAIN) { E(acc, cur, wr, wc, fr, fq); S.done(cur); }
        if (!has_next) break;
#pragma unroll
        for (int a = 0; a < 2; ++a)
#pragma unroll
            for (int b = 0; b < 2; ++b)
#pragma unroll
                for (int m = 0; m < 4; ++m)
#pragma unroll
                    for (int n = 0; n < 2; ++n) acc[a][b][m][n] = (f32x4){0.f, 0.f, 0.f, 0.f};
        cur = nxt; cA = nA; cB = nB; ++ui;
        if constexpr (ALIGN_EPI) { if (wr == 1) PG8_BAR; }
    }
    PG8_WAIT_V(0);
    if constexpr (!ALIGN_EPI) { if (wr == 0) PG8_BAR; }
    PG8_BAR;
    if constexpr (Epi::AFTER_DRAIN) { E.fused(acc, cur, wr, wc, fr, fq, lds, wid, lane); S.done(cur); }
#undef PG8_SA
#undef PG8_SB
#undef PG8_STAGE
#undef PG8_LDA
#undef PG8_LDB
#undef PG8_MMA
#undef PG8_WAIT_V
#undef PG8_WAIT_L
#undef PG8_BAR
#undef PG8_SCHED
}
}

#ifndef REPEAT_MASK
#define REPEAT_MASK 0
#endif
#ifndef MK_PER_PHASE
#define MK_PER_PHASE 0
#endif

constexpr int DM = 1024, BATCH = 8, SEQ = 4096, MTOK = BATCH * SEQ;
constexpr int MEMLEN = 256, MROWS = BATCH * MEMLEN;
constexpr int NZ1 = 2560, NGATE = 3072;
constexpr int ZQ = 0, ZK = 512, ZV = 1024, ZGR = 1536, ZU = 2048, ZQM = 2304;
constexpr int NTILES = MTOK / 128;
constexpr float EPS = 1e-6f;
constexpr int NPHASE = 15;

constexpr size_t MiB = 1u << 20;
constexpr size_t WS_CTL = 0, CTL_ZERO_BYTES = 1 * MiB;
constexpr size_t WS_WIN_T = 1 * MiB;
constexpr size_t WS_WQ_T = 12 * MiB;
constexpr size_t WS_WOUT_T = 16 * MiB;
constexpr size_t WS_WCAT_T = 18 * MiB;
constexpr size_t WS_WGLU_T = 20 * MiB;
constexpr size_t WS_WMKV_T = 21 * MiB;
constexpr size_t WS_KEYS = 22 * MiB;
constexpr size_t WS_S5MAT = 23 * MiB;
constexpr size_t WS_S5C = 25 * MiB;
constexpr size_t WS_PSC = 25 * MiB + 256 * 1024;
constexpr size_t WS_CSW = 25 * MiB + 128 * 1024;
constexpr size_t WS_RSX = 25 * MiB + 768 * 1024;
constexpr size_t WS_WIN8 = 50 * MiB;
constexpr size_t WS_SS = 25 * MiB + 512 * 1024;
constexpr size_t WS_ROPE = 26 * MiB;
constexpr size_t WS_PU = 42 * MiB;
constexpr size_t WS_PV = 58 * MiB;
constexpr size_t WS_XN8 = 74 * MiB;
constexpr size_t WS_WG8 = WS_WIN_T + 5 * MiB;
constexpr size_t WS_MEMN = 106 * MiB;
constexpr size_t WS_KM = 110 * MiB;
constexpr size_t WS_VT = 111 * MiB;
constexpr size_t WS_S5E = 112 * MiB;
constexpr size_t WS_S5X = 114 * MiB;
constexpr size_t WS_A = 116 * MiB;
constexpr size_t WS_B = 180 * MiB;
constexpr size_t WS_Z1 = WS_B;
constexpr size_t WS_G = WS_B;
constexpr size_t WS_QRF = WS_B + 160 * MiB;
constexpr size_t WS_YCAT = WS_B + 192 * MiB;
constexpr size_t WS_YG = WS_B + 256 * MiB;
constexpr size_t WS_INNER = WS_B + 272 * MiB;
constexpr size_t WS_N2 = WS_B;
constexpr size_t WS_Q2 = WS_B + 64 * MiB;
constexpr size_t WS_IDX = WS_B + 192 * MiB;
constexpr size_t WS_WGT = WS_B + 208 * MiB;
constexpr size_t WS_HPART = WS_B + 128 * MiB;
constexpr size_t WS_ACT = WS_B + 224 * MiB;
constexpr size_t WS_POUT = WS_B + 64 * MiB;
constexpr size_t WS_END = WS_B + 304 * MiB;

constexpr int CW_BAR = 4096;
constexpr int CW_Q = 8192;

constexpr int LDS_BYTES = 147456;
constexpr int MISC_OFF = LDS_BYTES - 512;
constexpr int NWAVES = 8;

#define GAS __attribute__((address_space(1)))
#define LAS __attribute__((address_space(3)))
typedef unsigned short bf16;
typedef unsigned v4u __attribute__((ext_vector_type(4)));
typedef unsigned v2u __attribute__((ext_vector_type(2)));
typedef float f32x4 __attribute__((ext_vector_type(4)));
typedef float f32x16 __attribute__((ext_vector_type(16)));
typedef short bf16x8 __attribute__((ext_vector_type(8)));
typedef GAS unsigned gu32;
#define RLX_AGENT __ATOMIC_RELAXED, __HIP_MEMORY_SCOPE_AGENT
#define LDS_WAIT() asm volatile("s_waitcnt lgkmcnt(0)" ::: "memory")
#define VM_WAIT() asm volatile("s_waitcnt vmcnt(0)" ::: "memory")
__device__ __forceinline__ unsigned f2bf(float f) { unsigned u = __builtin_bit_cast(unsigned, f); return (u + 0x7fffu + ((u >> 16) & 1u)) >> 16; }
typedef __bf16 hwbf16x2_t __attribute__((ext_vector_type(2)));
typedef float hwf32x2_t __attribute__((ext_vector_type(2)));
__device__ __forceinline__ unsigned pk2(float lo, float hi) { const hwf32x2_t v = {lo, hi}; const hwbf16x2_t b = __builtin_convertvector(v, hwbf16x2_t); return __builtin_bit_cast(unsigned, b); }
__device__ __forceinline__ float bflo(unsigned w) { return __builtin_bit_cast(float, w << 16); }
__device__ __forceinline__ float bfhi(unsigned w) { return __builtin_bit_cast(float, w & 0xffff0000u); }
__device__ __forceinline__ float bf2f(bf16 h) { return __builtin_bit_cast(float, (unsigned)h << 16); }
__device__ __forceinline__ f32x16 mfma32(bf16x8 a, bf16x8 b, f32x16 c) { return __builtin_amdgcn_mfma_f32_32x32x16_bf16(a, b, c, 0, 0, 0); }
__device__ __forceinline__ f32x4 mfma16(bf16x8 a, bf16x8 b, f32x4 c) { return __builtin_amdgcn_mfma_f32_16x16x32_bf16(a, b, c, 0, 0, 0); }
__device__ __forceinline__ bf16x8 mk8(unsigned a, unsigned b, unsigned c, unsigned d) { v4u t = {a, b, c, d}; return __builtin_bit_cast(bf16x8, t); }
__device__ __forceinline__ float sigmoidf_(float x) { return __builtin_amdgcn_rcpf(1.0f + __builtin_amdgcn_exp2f(-1.4426950408889634f * x)); }
__device__ __forceinline__ float gelu_tanh(float x) {
    const float u2 = 1.5957691216057308f * (x + 0.044715f * x * x * x);
    return x * __builtin_amdgcn_rcpf(1.0f + __builtin_amdgcn_exp2f(-1.4426950408889634f * u2));
}
__device__ __forceinline__ float wave_sum(float v) {
#pragma unroll
    for (int o = 1; o < 64; o <<= 1) v += __shfl_xor(v, o);
    return v;
}

#define XB_TMO      128
#define XB_XCNT(j)  (256  + 64 * (j))
#define XB_XSUB(j)  (1280 + 64 * (j))
#define XB_XGEN(j)  (2304 + 64 * (j))
#define XB_TOP      3328
#define XB_TOPGEN   3392
#define XCD_BAR_WORDS 3456
#define XB_SPIN_CAP (1u << 22)

__device__ __forceinline__ unsigned xb_ld(unsigned* p)              { return __hip_atomic_load(p, __ATOMIC_RELAXED, __HIP_MEMORY_SCOPE_AGENT); }
__device__ __forceinline__ unsigned xb_add(unsigned* p, unsigned v) { return __hip_atomic_fetch_add(p, v, __ATOMIC_RELAXED, __HIP_MEMORY_SCOPE_AGENT); }
__device__ __forceinline__ unsigned xb_xcc_id() { return (unsigned)__builtin_amdgcn_s_getreg((3 << 11) | 20) & 0xFu; }
#define XB_SPIN(cond, bar) do { unsigned _sp = 0; while (cond) { __builtin_amdgcn_s_sleep(1); \
    if ((++_sp & 255u) == 0u) { if (xb_ld(&(bar)[XB_TMO])) break; if (_sp > XB_SPIN_CAP) { atomicAdd(&(bar)[XB_TMO], 1u); break; } } } } while (0)

struct XcdBarrier { unsigned* bar; unsigned x; volatile LAS unsigned* st; };

__device__ __forceinline__ XcdBarrier xcd_barrier_post(unsigned* bar, volatile LAS unsigned* st, bool tid0) {
    XcdBarrier b; b.bar = bar; b.x = xb_xcc_id(); b.st = st;
    if (tid0) (void)xb_add(&bar[XB_XCNT(b.x)], 1u);
    return b;
}
__device__ __forceinline__ void xcd_barrier_complete(unsigned* bar, unsigned x, unsigned& nloc, unsigned& nx) {
    const unsigned G = gridDim.x * gridDim.y * gridDim.z;
    unsigned sum, cnt, mine, sp = 0u;
    for (;;) {
        sum = 0u; cnt = 0u; mine = 0u;
#pragma unroll
        for (unsigned j = 0; j < 16; ++j) { const unsigned c = xb_ld(&bar[XB_XCNT(j)]); sum += c; cnt += (c > 0u) ? 1u : 0u; mine = (j == x) ? c : mine; }
        if (sum == G) break;
        __builtin_amdgcn_s_sleep(1);
        if ((++sp & 255u) == 0u) { if (xb_ld(&bar[XB_TMO])) break; if (sp > XB_SPIN_CAP) { atomicAdd(&bar[XB_TMO], 1u); break; } }
    }
    nloc = mine > 0u ? mine : 1u; nx = cnt > 0u ? cnt : 1u;
}
__device__ __forceinline__ void xcd_barrier(const XcdBarrier& b, int wave) {
    asm volatile("s_waitcnt vmcnt(0)" ::: "memory");
    __syncthreads();
    if (wave == 0 && pg8::hw_lane_id() == 0) {
        unsigned* bar = b.bar;
        __builtin_amdgcn_s_waitcnt(0);
        unsigned nloc = b.st[0], nx = b.st[1];
        if (nloc == 0u) { xcd_barrier_complete(bar, b.x, nloc, nx); b.st[0] = nloc; b.st[1] = nx; }
        const unsigned old = xb_add(&bar[XB_XSUB(b.x)], 1u);
        const unsigned gen = old / nloc;
        if (old + 1u == (gen + 1u) * nloc) {
            __builtin_amdgcn_fence(__ATOMIC_RELEASE, "agent");
            asm volatile("s_waitcnt vmcnt(0)" ::: "memory");
            const unsigned og = xb_add(&bar[XB_TOP], 1u);
            const unsigned tg = og / nx;
            if (og + 1u == (tg + 1u) * nx) xb_add(&bar[XB_TOPGEN], 1u);
            else XB_SPIN(xb_ld(&bar[XB_TOPGEN]) == tg, bar);
            __builtin_amdgcn_fence(__ATOMIC_ACQUIRE, "agent");
            xb_add(&bar[XB_XGEN(b.x)], 1u);
            asm volatile("s_waitcnt vmcnt(0)" ::: "memory");
        } else {
            XB_SPIN(xb_ld(&bar[XB_XGEN(b.x)]) == gen, bar);
            __builtin_amdgcn_fence(__ATOMIC_ACQUIRE, "agent");
            asm volatile("s_waitcnt vmcnt(0)" ::: "memory");
        }
    }
    __syncthreads();
}

__host__ __device__ __forceinline__ int frag32(int row, int k, int K) { return (((row >> 5) * (K >> 4) + (k >> 4)) * 64 + ((k >> 3) & 1) * 32 + (row & 31)) * 8 + (k & 7); }
__host__ __device__ __forceinline__ int frag16(int n, int k, int K) { return (((n >> 4) * (K >> 5) + (k >> 5)) * 64 + ((k >> 3) & 3) * 16 + (n & 15)) * 8 + (k & 7); }
struct Args { const void* in[26]; float* out; unsigned char* ws; int ph_lo, ph_hi; };
struct Ctx {
    LAS unsigned char* lds;
    int tid, lane, wave, vcu, G;
    __device__ __forceinline__ void refresh() { lane = pg8::hw_lane_id(); tid = wave * 64 + lane; }
};

template <class F> struct EpiT {
    static constexpr bool PERM = true, AFTER_DRAIN = false;
    F f;
    __device__ __forceinline__ void operator()(const f32x4 (&acc)[2][2][4][2], const pg8::Unit& u, int wr, int wc, int fr, int fq) const {
        const int row0 = u.pm * 256 + wr * 64 + fr, col0 = u.pn * 256 + wc * 32 + 8 * fq;
        typename F::L cur[2], nxt[2];
        f.load(row0, col0, cur[0]); f.load(row0, col0 + 128, cur[1]);
#pragma unroll
        for (int i = 0; i < 8; ++i) {
            const int ai = i >> 2, m = i & 3, row = row0 + ai * 128 + m * 16;
            if (i < 7) { const int rown = row0 + ((i + 1) >> 2) * 128 + ((i + 1) & 3) * 16; f.load(rown, col0, nxt[0]); f.load(rown, col0 + 128, nxt[1]); }
            __builtin_amdgcn_sched_barrier(0);
            f.apply(row, col0, acc[ai][0][m][0], acc[ai][0][m][1], cur[0]); f.apply(row, col0 + 128, acc[ai][1][m][0], acc[ai][1][m][1], cur[1]);
            __builtin_amdgcn_sched_barrier(0);
            cur[0] = nxt[0]; cur[1] = nxt[1];
        }
    }
};
__device__ __forceinline__ v4u pack8(f32x4 a, f32x4 b) { v4u w; w.x = pk2(a[0], a[1]); w.y = pk2(a[2], a[3]); w.z = pk2(b[0], b[1]); w.w = pk2(b[2], b[3]); return w; }
struct LNone {};
struct FStore { typedef LNone L; bf16* O; int ldc;
    __device__ __forceinline__ void load(int, int, L&) const {}
    __device__ __forceinline__ void apply(int row, int col, f32x4 v0, f32x4 v1, const L&) const { *(v4u*)(O + (size_t)row * ldc + col) = pack8(v0, v1); } };
struct FKvm { typedef LNone L; bf16* KM; bf16* VT;
    __device__ __forceinline__ void load(int, int, L&) const {}
    __device__ __forceinline__ void apply(int row, int col, f32x4 v0, f32x4 v1, const L&) const {
        const int b = row >> 8, m = row & 255;
        if (col < 256) { const int hm = col >> 6, d0 = col & 63; *(v4u*)(KM + (size_t)(b * 4 + hm) * 16384 + frag32(m, d0, 64)) = pack8(v0, v1); }
        else { const int c = col - 256, hm = c >> 6, e0 = c & 63, mt = m >> 5, s2 = (m >> 4) & 1, w = m & 15, hh = (w >> 2) & 1, j = ((w >> 3) << 2) | (w & 3);
            bf16* p = VT + (size_t)(b * 4 + hm) * 16384 + ((mt * 2 + s2) * 64 + hh * 32) * 8 + j;
#pragma unroll
            for (int jj = 0; jj < 8; ++jj) { const int e = e0 + jj; p[((e >> 5) * 16 * 64 + (e & 31)) * 8] = (bf16)f2bf(jj < 4 ? v0[jj] : v1[jj - 4]); } }
    } };
struct FSig { typedef LNone L; bf16* O; int ldc;
    __device__ __forceinline__ void load(int, int, L&) const {}
    __device__ __forceinline__ void apply(int row, int col, f32x4 v0, f32x4 v1, const L&) const {
#pragma unroll
        for (int j = 0; j < 4; ++j) { v0[j] = sigmoidf_(v0[j]); v1[j] = sigmoidf_(v1[j]); }
        *(v4u*)(O + (size_t)row * ldc + col) = pack8(v0, v1); } };
struct FGlu { typedef LNone L; bf16* O;
    __device__ __forceinline__ void load(int, int, L&) const {}
    __device__ __forceinline__ void apply(int row, int col, f32x4 v0, f32x4 v1, const L&) const {
        v2u w; w.x = pk2(v0[0] * sigmoidf_(v1[0]), v0[1] * sigmoidf_(v1[1])); w.y = pk2(v0[2] * sigmoidf_(v1[2]), v0[3] * sigmoidf_(v1[3]));
        *(v2u*)(O + (size_t)row * 1024 + 512 + (col >> 1)) = w; } };
__device__ __forceinline__ void mul8(f32x4& v0, f32x4& v1, const v4u num, const v4u den) {
    v0[0] *= bflo(num.x) * __builtin_amdgcn_rcpf(fmaxf(bflo(den.x), 1e-30f)); v0[1] *= bfhi(num.x) * __builtin_amdgcn_rcpf(fmaxf(bfhi(den.x), 1e-30f));
    v0[2] *= bflo(num.y) * __builtin_amdgcn_rcpf(fmaxf(bflo(den.y), 1e-30f)); v0[3] *= bfhi(num.y) * __builtin_amdgcn_rcpf(fmaxf(bfhi(den.y), 1e-30f));
    v1[0] *= bflo(num.z) * __builtin_amdgcn_rcpf(fmaxf(bflo(den.z), 1e-30f)); v1[1] *= bfhi(num.z) * __builtin_amdgcn_rcpf(fmaxf(bfhi(den.z), 1e-30f));
    v1[2] *= bflo(num.w) * __builtin_amdgcn_rcpf(fmaxf(bflo(den.w), 1e-30f)); v1[3] *= bfhi(num.w) * __builtin_amdgcn_rcpf(fmaxf(bfhi(den.w), 1e-30f));
}
struct HookGate { const bf16* Gt;
    __device__ __forceinline__ void operator()(int t, f32x4 (&acc)[2][2][4][2], const pg8::Unit& u, int wr, int wc, int fr, int fq) const {
        if (t != 8 && t != 12) return;
        const int gn = (t == 8) ? 0 : 1024, gd = gn + 1024;
        int row0 = u.pm * 256 + wr * 64 + fr, col0 = u.pn * 256 + wc * 32 + 8 * fq;
        asm volatile("" : "+v"(row0), "+v"(col0));
#pragma unroll
        for (int ai = 0; ai < 2; ++ai) {
            v4u nn[4][2], dd[4][2];
#pragma unroll
            for (int m = 0; m < 4; ++m) { const bf16* gp = Gt + (size_t)(row0 + ai * 128 + m * 16) * NGATE + col0;
                nn[m][0] = *(const v4u*)(gp + gn); dd[m][0] = *(const v4u*)(gp + gd); nn[m][1] = *(const v4u*)(gp + gn + 128); dd[m][1] = *(const v4u*)(gp + gd + 128); }
            __builtin_amdgcn_sched_barrier(0);
#pragma unroll
            for (int m = 0; m < 4; ++m) { mul8(acc[ai][0][m][0], acc[ai][0][m][1], nn[m][0], dd[m][0]); mul8(acc[ai][1][m][0], acc[ai][1][m][1], nn[m][1], dd[m][1]); }
            __builtin_amdgcn_sched_barrier(0);
        }
    } };
struct LGate { v4u g; };
struct FGateOut { typedef LGate L; const bf16* Gt; bf16* MB;
    __device__ __forceinline__ void load(int row, int col, L& l) const { l.g = *(const v4u*)(Gt + (size_t)row * NGATE + 2048 + col); }
    __device__ __forceinline__ void apply(int row, int col, f32x4 v0, f32x4 v1, const L& l) const {
        const v4u g = l.g;
        v0[0] *= bflo(g.x); v0[1] *= bfhi(g.x); v0[2] *= bflo(g.y); v0[3] *= bfhi(g.y); v1[0] *= bflo(g.z); v1[1] *= bfhi(g.z); v1[2] *= bflo(g.w); v1[3] *= bfhi(g.w);
        *(v4u*)(MB + (size_t)row * DM + col) = pack8(v0, v1); } };
struct LRes { f32x4 x0, x1; };
struct FRes { typedef LRes L; const float* X; bf16* HB; float* SS;
    __device__ __forceinline__ void load(int row, int col, L& l) const { const float* xp = X + (size_t)row * DM + col; l.x0 = *(const f32x4*)xp; l.x1 = *(const f32x4*)(xp + 4); }
    __device__ __forceinline__ void apply(int row, int col, f32x4 v0, f32x4 v1, const L& l) const {
        v0 += l.x0; v1 += l.x1;
        *(v4u*)(HB + (size_t)row * DM + col) = pack8(v0, v1);
        float q = (v0[0] * v0[0] + v0[1] * v0[1]) + (v0[2] * v0[2] + v0[3] * v0[3]) + (v1[0] * v1[0] + v1[1] * v1[1]) + (v1[2] * v1[2] + v1[3] * v1[3]);
        q += __shfl_xor(q, 16); q += __shfl_xor(q, 32);
        if (pg8::hw_lane_id() < 16) atomicAdd(SS + row, q); } };
struct LRstd { float ss; };
struct FStoreRstd { typedef LRstd L; bf16* O; int ldc; const float* SS;
    __device__ __forceinline__ void load(int row, int, L& l) const { l.ss = SS[row]; }
    __device__ __forceinline__ void apply(int row, int col, f32x4 v0, f32x4 v1, const L& l) const {
        const float rs = __builtin_amdgcn_rsqf(l.ss * (1.f / DM) + EPS);
        *(v4u*)(O + ((((size_t)(row >> 5) * 16 + (col >> 7)) * 8 + ((col & 127) >> 4)) * 64 + ((col >> 3) & 1) * 32 + (row & 31)) * 8) = pack8(v0 * rs, v1 * rs); } };

template <class F>
__device__ __forceinline__ void run_gemm(const Ctx& C, const bf16* A, const bf16* Bt, int M, int N, int K, const F& f) {
    pg8::Gemm g{A, Bt, M, N, K}; pg8::StaticOrder S; S.init(M, N, C.G, (int)blockIdx.x);
    EpiT<F> E{f};
    pg8::gemm_phase<EpiT<F>, pg8::StaticOrder, true, true>(C.lds, g, S, E, C.wave);
}

template <class F, class H>
__device__ __forceinline__ void run_gemm_hook(const Ctx& C, const bf16* A, const bf16* Bt, int M, int N, int K, const F& f, const H& h) {
    pg8::Gemm g{A, Bt, M, N, K}; pg8::StaticOrder S; S.init(M, N, C.G, (int)blockIdx.x);
    EpiT<F> E{f};
    pg8::gemm_phase<EpiT<F>, pg8::StaticOrder, true, true, false, H>(C.lds, g, S, E, C.wave, 0x7f7f7f7f, 0x7f7f7f7f, h);
}
template <class F>
__device__ __forceinline__ void run_gemm_mx(const Ctx& C, const unsigned char* A8, const unsigned char* Bt8, int M, int N, int Kbytes, const F& f, int sclA, int sclB) {
    pg8::Gemm g{(const bf16*)A8, (const bf16*)Bt8, M, N, Kbytes / 2}; pg8::StaticOrder S; S.init(M, N, C.G, (int)blockIdx.x);
    EpiT<F> E{f};
    pg8::gemm_phase<EpiT<F>, pg8::StaticOrder, true, true, true>(C.lds, g, S, E, C.wave, sclA, sclB);
}

template <class F>
__device__ __forceinline__ void run_gemm_i8(const Ctx& C, const unsigned char* A8, const unsigned char* Bt8, int M, int N, int Kbytes, const F& f) {
    pg8::Gemm g{(const bf16*)A8, (const bf16*)Bt8, M, N, Kbytes / 2}; pg8::StaticOrder S; S.init(M, N, C.G, (int)blockIdx.x);
    EpiT<F> E{f};
    pg8::gemm_phase<EpiT<F>, pg8::StaticOrder, true, true, true, pg8::NoKHook, true>(C.lds, g, S, E, C.wave);
}
struct LI8 { float rs; f32x4 c0, c1; };
__device__ __forceinline__ void deq8(f32x4& v0, f32x4& v1, const LI8& l) {
#pragma unroll
    for (int j = 0; j < 4; ++j) { const float a = v0[j], b = v1[j];
        v0[j] = (float)__builtin_bit_cast(int, a) * (l.rs * l.c0[j]); v1[j] = (float)__builtin_bit_cast(int, b) * (l.rs * l.c1[j]); }
}
struct FStoreI8 { typedef LI8 L; bf16* O; int ldc; const float* RS; const float* CS;
    __device__ __forceinline__ void load(int row, int col, L& l) const { l.rs = RS[row]; l.c0 = *(const f32x4*)(CS + col); l.c1 = *(const f32x4*)(CS + col + 4); }
    __device__ __forceinline__ void apply(int row, int col, f32x4 v0, f32x4 v1, const L& l) const { deq8(v0, v1, l); *(v4u*)(O + (size_t)row * ldc + col) = pack8(v0, v1); } };
struct FSigI8 { typedef LI8 L; bf16* O; int ldc; const float* RS; const float* CS;
    __device__ __forceinline__ void load(int row, int col, L& l) const { l.rs = RS[row]; l.c0 = *(const f32x4*)(CS + col); l.c1 = *(const f32x4*)(CS + col + 4); }
    __device__ __forceinline__ void apply(int row, int col, f32x4 v0, f32x4 v1, const L& l) const {
        deq8(v0, v1, l);
#pragma unroll
        for (int j = 0; j < 4; ++j) { v0[j] = sigmoidf_(v0[j]); v1[j] = sigmoidf_(v1[j]); }
        *(v4u*)(O + (size_t)row * ldc + col) = pack8(v0, v1); } };

__device__ __forceinline__ unsigned q_e2m1(float y) {
    const float m = fabsf(y);
    const unsigned c = (unsigned)(m > 0.25f) + (unsigned)(m > 0.75f) + (unsigned)(m > 1.25f) + (unsigned)(m > 1.75f) + (unsigned)(m > 2.5f) + (unsigned)(m > 3.5f) + (unsigned)(m > 5.0f);
    return c | ((__builtin_bit_cast(unsigned, y) >> 28) & 8u);
}
template <bool GLU>
__device__ __forceinline__ void p0_transpose_item(const float* W, int K, int N, bf16* WT, LAS float* scr, int item, int lane, const float* kscale = nullptr, int ldk = 0, int koff = 0) {
    if (ldk == 0) ldk = K;
    const int nblk = N / 32, kb = item / nblk, nb = item % nblk, k0 = 64 * kb, n0 = 32 * nb;
#pragma unroll 8
    for (int i = 0; i < 32; ++i) { const int kk = 2 * i + (lane >> 5); float w = W[(size_t)(k0 + kk) * N + n0 + (lane & 31)]; if (kscale) w *= kscale[k0 + kk]; scr[kk * 33 + (lane & 31)] = w; }
    LDS_WAIT(); asm volatile("" ::: "memory");
    const int c = lane & 7;
#pragma unroll
    for (int j = 0; j < 4; ++j) { const int n = (lane >> 3) + 8 * j; const LAS float* s = scr + (8 * c) * 33 + n;
        v4u o; o.x = pk2(s[0 * 33], s[1 * 33]); o.y = pk2(s[2 * 33], s[3 * 33]); o.z = pk2(s[4 * 33], s[5 * 33]); o.w = pk2(s[6 * 33], s[7 * 33]);
        const int nn = n0 + n; int row = nn;
        if (GLU) { const int jc = nn & 255, gate = nn >> 8; row = 8 * (jc >> 2) + 4 * gate + (jc & 3); }
        *(GAS v4u*)(WT + (size_t)row * ldk + koff + k0 + 8 * c) = o; }
    LDS_WAIT(); asm volatile("" ::: "memory");
}
__device__ __forceinline__ void p0_transpose_item_fp8(const float* W, int K, int N, unsigned char* WT8, int nsub, LAS float* scr, int item, int lane, float scale) {
    const int nblk = N / 32, kb = item / nblk, nb = item % nblk, k0 = 64 * kb, n0 = 32 * nb;
#pragma unroll 8
    for (int i = 0; i < 32; ++i) { const int kk = 2 * i + (lane >> 5); scr[kk * 33 + (lane & 31)] = W[(size_t)(k0 + kk) * N + n0 + (lane & 31)] * scale; }
    LDS_WAIT(); asm volatile("" ::: "memory");
    const int c = lane & 7;
#pragma unroll
    for (int j = 0; j < 4; ++j) { const int n = (lane >> 3) + 8 * j; const LAS float* sp = scr + (8 * c) * 33 + n;
        int p0 = __builtin_amdgcn_cvt_pk_fp8_f32(sp[0 * 33], sp[1 * 33], 0, false); p0 = __builtin_amdgcn_cvt_pk_fp8_f32(sp[2 * 33], sp[3 * 33], p0, true);
        int p1 = __builtin_amdgcn_cvt_pk_fp8_f32(sp[4 * 33], sp[5 * 33], 0, false); p1 = __builtin_amdgcn_cvt_pk_fp8_f32(sp[6 * 33], sp[7 * 33], p1, true);
        v2u o; o.x = (unsigned)p0; o.y = (unsigned)p1;
        *(GAS v2u*)(WT8 + (size_t)(n0 + n - nsub) * K + k0 + 8 * c) = o; }
    LDS_WAIT(); asm volatile("" ::: "memory");
}
template <int NR>
__device__ __forceinline__ void rms_rows_to_bf16(const float* xbase, const float* gain, bf16* obase, int m0, int mstep, int lane, unsigned char* o8base = nullptr) {
    f32x4 v[NR][4]; float s[NR];
#pragma unroll
    for (int i = 0; i < NR; ++i) { const f32x4* xr = (const f32x4*)(xbase + (size_t)(m0 + i * mstep) * DM) + lane; s[i] = 0.f;
#pragma unroll
        for (int j = 0; j < 4; ++j) v[i][j] = xr[64 * j]; }
#pragma unroll
    for (int i = 0; i < NR; ++i)
#pragma unroll
        for (int j = 0; j < 4; ++j) s[i] += (v[i][j].x * v[i][j].x + v[i][j].y * v[i][j].y) + (v[i][j].z * v[i][j].z + v[i][j].w * v[i][j].w);
#pragma unroll
    for (int o = 1; o < 64; o <<= 1)
#pragma unroll
        for (int i = 0; i < NR; ++i) s[i] += __shfl_xor(s[i], o);
    const f32x4* gr = (const f32x4*)gain + lane;
    f32x4 g[4];
#pragma unroll
    for (int j = 0; j < 4; ++j) g[j] = gr[64 * j];
#pragma unroll
    for (int i = 0; i < NR; ++i) { const float rstd = 1.0f / sqrtf(s[i] * (1.f / DM) + EPS);
        unsigned long long* o8 = (unsigned long long*)(obase + (size_t)(m0 + i * mstep) * DM) + lane;
#pragma unroll
        for (int j = 0; j < 4; ++j) { const float y0 = v[i][j].x * rstd * g[j].x, y1 = v[i][j].y * rstd * g[j].y, y2 = v[i][j].z * rstd * g[j].z, y3 = v[i][j].w * rstd * g[j].w;
            o8[64 * j] = (unsigned long long)pk2(y0, y1) | ((unsigned long long)pk2(y2, y3) << 32);
            if (o8base) { int p = __builtin_amdgcn_cvt_pk_fp8_f32(y0 * 16.f, y1 * 16.f, 0, false); p = __builtin_amdgcn_cvt_pk_fp8_f32(y2 * 16.f, y3 * 16.f, p, true);
                *(unsigned*)(o8base + (size_t)(m0 + i * mstep) * DM + 256 * j + 4 * lane) = (unsigned)p; } } }
}

__device__ __forceinline__ unsigned pack_i8x4(float a, float b, float c, float d) {
    const int ia = (int)rintf(a), ib = (int)rintf(b), ic = (int)rintf(c), id = (int)rintf(d);
    return ((unsigned)ia & 255u) | (((unsigned)ib & 255u) << 8) | (((unsigned)ic & 255u) << 16) | ((unsigned)id << 24);
}
template <int NR, bool BF>
__device__ __forceinline__ void rms_rows_to_i8(const float* xbase, const float* gain, bf16* obase, unsigned char* o8base, float* rsx, int m0, int mstep, int lane) {
    f32x4 v[NR][4]; float s[NR], mx[NR];
#pragma unroll
    for (int i = 0; i < NR; ++i) { const f32x4* xr = (const f32x4*)(xbase + (size_t)(m0 + i * mstep) * DM) + lane; s[i] = 0.f; mx[i] = 0.f;
#pragma unroll
        for (int j = 0; j < 4; ++j) v[i][j] = xr[64 * j]; }
    const f32x4* gr = (const f32x4*)gain + lane;
    f32x4 g[4];
#pragma unroll
    for (int j = 0; j < 4; ++j) g[j] = gr[64 * j];
#pragma unroll
    for (int i = 0; i < NR; ++i)
#pragma unroll
        for (int j = 0; j < 4; ++j) { s[i] += (v[i][j].x * v[i][j].x + v[i][j].y * v[i][j].y) + (v[i][j].z * v[i][j].z + v[i][j].w * v[i][j].w);
            v[i][j] = v[i][j] * g[j]; mx[i] = fmaxf(mx[i], fmaxf(fmaxf(fabsf(v[i][j].x), fabsf(v[i][j].y)), fmaxf(fabsf(v[i][j].z), fabsf(v[i][j].w)))); }
#pragma unroll
    for (int o = 1; o < 64; o <<= 1)
#pragma unroll
        for (int i = 0; i < NR; ++i) { s[i] += __shfl_xor(s[i], o); mx[i] = fmaxf(mx[i], __shfl_xor(mx[i], o)); }
#pragma unroll
    for (int i = 0; i < NR; ++i) { const int row = m0 + i * mstep; const float rstd = 1.0f / sqrtf(s[i] * (1.f / DM) + EPS);
        const float qs = mx[i] > 1e-30f ? 127.0f / mx[i] : 0.f;
        if (lane == 0) rsx[row] = rstd * mx[i] * (1.0f / 127.0f);
#pragma unroll
        for (int j = 0; j < 4; ++j) {
            if (BF) { unsigned long long* o8 = (unsigned long long*)(obase + (size_t)row * DM) + lane;
                o8[64 * j] = (unsigned long long)pk2(v[i][j].x * rstd, v[i][j].y * rstd) | ((unsigned long long)pk2(v[i][j].z * rstd, v[i][j].w * rstd) << 32); }
            *(unsigned*)(o8base + (size_t)row * DM + 256 * j + 4 * lane) = pack_i8x4(v[i][j].x * qs, v[i][j].y * qs, v[i][j].z * qs, v[i][j].w * qs); } }
}
__device__ __forceinline__ void p0_win_i8(const Ctx& C, const Args& a) {
    const int nb = C.vcu; if (nb >= 176) return;
    const float* W = (const float*)a.in[4]; constexpr int N = 5632; const int n0 = 32 * nb, lane = C.lane, rl = lane >> 3, c4 = lane & 7;
    LAS unsigned* T = (LAS unsigned*)(C.lds + C.wave * 16384);
    LAS float* cmx = (LAS float*)(C.lds + 131072);
    f32x4 w[4][4];
    const float* wp = W + (size_t)(C.wave * 128 + 4 * rl) * N + n0 + 4 * c4;
#pragma unroll
    for (int g = 0; g < 4; ++g)
#pragma unroll
        for (int t = 0; t < 4; ++t) w[g][t] = *(const f32x4*)(wp + (size_t)(32 * g + t) * N);
    f32x4 m = {0.f, 0.f, 0.f, 0.f};
#pragma unroll
    for (int g = 0; g < 4; ++g)
#pragma unroll
        for (int t = 0; t < 4; ++t)
#pragma unroll
            for (int j = 0; j < 4; ++j) m[j] = fmaxf(m[j], fabsf(w[g][t][j]));
#pragma unroll
    for (int o = 8; o < 64; o <<= 1)
#pragma unroll
        for (int j = 0; j < 4; ++j) m[j] = fmaxf(m[j], __shfl_xor(m[j], o));
    if (rl == 0) *(LAS f32x4*)(cmx + C.wave * 32 + 4 * c4) = m;
    __syncthreads();
    f32x4 cm = {0.f, 0.f, 0.f, 0.f};
#pragma unroll
    for (int ww = 0; ww < 8; ++ww) { const f32x4 x = *(const LAS f32x4*)(cmx + ww * 32 + 4 * c4);
#pragma unroll
        for (int j = 0; j < 4; ++j) cm[j] = fmaxf(cm[j], x[j]); }
    f32x4 qs;
#pragma unroll
    for (int j = 0; j < 4; ++j) qs[j] = cm[j] > 1e-30f ? 127.0f / cm[j] : 0.f;
    if (C.wave == 0 && rl == 0) *(f32x4*)((float*)(a.ws + WS_CSW) + n0 + 4 * c4) = cm * (1.0f / 127.0f);
#pragma unroll
    for (int g = 0; g < 4; ++g)
#pragma unroll
        for (int j = 0; j < 4; ++j) T[(4 * c4 + j) * 36 + 8 * g + rl] = pack_i8x4(w[g][0][j] * qs[j], w[g][1][j] * qs[j], w[g][2][j] * qs[j], w[g][3][j] * qs[j]);
    LDS_WAIT(); asm volatile("" ::: "memory");
    {   const int n = lane >> 1, hf = lane & 1;
        unsigned char* dst = a.ws + WS_WIN8 + (size_t)(n0 + n) * 1024 + C.wave * 128 + 64 * hf;
#pragma unroll
        for (int q = 0; q < 4; ++q) *(GAS v4u*)(dst + 16 * q) = *(const LAS v4u*)(T + n * 36 + 16 * hf + 4 * q); }
    LDS_WAIT(); asm volatile("" ::: "memory");
    __syncthreads();
}

__device__ __forceinline__ void p0_s5_group(const Ctx& C, const Args& a, int g, int part) {
    const float* a_re = (const float*)a.in[7]; const float* a_im = (const float*)a.in[8]; const float* log_dt = (const float*)a.in[9];
    const float* b_re = (const float*)a.in[10]; const float* b_im = (const float*)a.in[11]; const float* c_re = (const float*)a.in[12]; const float* c_im = (const float*)a.in[13];
    LAS float* L = (LAS float*)C.lds;
    LAS float* lpr = L;
    LAS float* lpi = L + 640;
    LAS float* bbr = L + 1280;
    LAS float* bbi = bbr + 1024;
    LAS float* ccr = bbi + 1024;
    LAS float* cci = ccr + 1024;
    LAS float* Kj = cci + 1024;
    const int tid = C.tid;
    bf16* T8T = (bf16*)(a.ws + WS_S5MAT) + (size_t)g * 16384;
    bf16* PMT = (bf16*)(a.ws + WS_S5MAT) + (size_t)(16 + g) * 16384;
    bf16* QMT = (bf16*)(a.ws + WS_S5MAT) + (size_t)(32 + g) * 16384;
    float* L8 = (float*)(a.ws + WS_S5C) + (size_t)g * 128;
    float* L128 = (float*)(a.ws + WS_S5C) + 2048 + (size_t)g * 128;
    for (int i = tid; i < 640; i += 512) {
        const int j10 = i >> 6, p = i & 63; const double jj = (j10 < 9) ? (double)j10 : 128.0;
        const double dt = exp((double)log_dt[g]);
        const double ar = (double)a_re[g * 64 + p], ai = (double)a_im[g * 64 + p];
        const double mag = exp(ar * dt * jj), ang = ai * dt * jj;
        lpr[i] = (float)(mag * cos(ang)); lpi[i] = (float)(mag * sin(ang));
    }
    for (int i = tid; i < 1024; i += 512) { ccr[i] = c_re[g * 1024 + i]; cci[i] = c_im[g * 1024 + i]; }
    __syncthreads();
    if (part == 0 && tid < 64) { L8[tid * 2] = lpr[8 * 64 + tid]; L8[tid * 2 + 1] = lpi[8 * 64 + tid]; L128[tid * 2] = lpr[9 * 64 + tid]; L128[tid * 2 + 1] = lpi[9 * 64 + tid]; }
    for (int i = tid; i < 1024; i += 512) {
        const int p = i >> 4, h = i & 15;
        const float ar = a_re[g * 64 + p], ai = a_im[g * 64 + p], lr = lpr[64 + p], li = lpi[64 + p];
        const float den = ar * ar + ai * ai, nr = lr - 1.0f, ni = li;
        const float cr = (nr * ar + ni * ai) / den, ci = (ni * ar - nr * ai) / den;
        const float br = b_re[(g * 64 + p) * 16 + h], bi = b_im[(g * 64 + p) * 16 + h];
        bbr[i] = cr * br - ci * bi; bbi[i] = cr * bi + ci * br;
    }
    __syncthreads();
    for (int i = tid; i < 2048; i += 512) {
        const int j = i >> 8, ho = (i >> 4) & 15, hi = i & 15; float sacc = 0.f;
        if (j > (part >> 1) || (ho >> 3) != (part & 1)) continue;
        for (int p = 0; p < 64; ++p) { const float cr_ = ccr[ho * 64 + p], ci_ = cci[ho * 64 + p], lr_ = lpr[j * 64 + p], li_ = lpi[j * 64 + p];
            const float mr = cr_ * lr_ - ci_ * li_, mi = cr_ * li_ + ci_ * lr_;
            sacc += mr * bbr[p * 16 + hi] - mi * bbi[p * 16 + hi]; }
        Kj[i] = sacc;
    }
    __syncthreads();
    for (int i = part * 1024 + tid; i < (part + 1) * 1024; i += 512) {
        const int n = i >> 7, k = i & 127;
        { const int t = n >> 4, ho = n & 15, sx = k >> 4, hi = k & 15; const float v = (sx <= t) ? Kj[((t - sx) * 16 + ho) * 16 + hi] : 0.f; T8T[frag16(n, k, 128)] = (bf16)f2bf(v); }
        { const int p = n & 63, im = n >> 6, sx = k >> 4, hi = k & 15; const float lr_ = lpr[(7 - sx) * 64 + p], li_ = lpi[(7 - sx) * 64 + p], br_ = bbr[p * 16 + hi], bi_ = bbi[p * 16 + hi];
          const float v = im ? (lr_ * bi_ + li_ * br_) : (lr_ * br_ - li_ * bi_); PMT[frag16(n, k, 128)] = (bf16)f2bf(v); }
        { const int t = n >> 4, ho = n & 15, p = k & 63, pt = k >> 6; const float cr_ = ccr[ho * 64 + p], ci_ = cci[ho * 64 + p], lr_ = lpr[(t + 1) * 64 + p], li_ = lpi[(t + 1) * 64 + p];
          const float v = pt ? -(cr_ * li_ + ci_ * lr_) : (cr_ * lr_ - ci_ * li_); QMT[frag16(n, k, 128)] = (bf16)f2bf(v); }
    }
    __syncthreads();
}

__device__ __forceinline__ void p0_prologue(const Ctx& C, const Args& a) {
    p0_win_i8(C, a);
    p0_s5_group(C, a, C.vcu & 15, C.vcu >> 4);
    LAS float* scr = (LAS float*)(C.lds + C.wave * 16384);
    const int gw = C.vcu * NWAVES + C.wave, NGW = C.G * NWAVES;
    const int gt = C.vcu * 512 + C.tid, NGT = C.G * 512;
    unsigned char* ws = a.ws;
    for (int i = gt; i < MTOK; i += NGT) ((float*)(ws + WS_SS))[i] = 0.f;
    constexpr int I_Q = 16 * 64, I_O = 16 * 32, I_BR = 8 * 32, I_BS = 4 * 32, I_BM = 4 * 32, I_KV = 16 * 16, I_GLU = 4 * 16;
    constexpr int NITEMS = I_Q + I_O + I_BR + I_BS + I_BM + I_KV + I_GLU;
    for (int it = gw; it < NITEMS; it += NGW) {
        int r = it;
        if (r < I_Q) { p0_transpose_item<false>((const float*)a.in[21], 1024, 2048, (bf16*)(ws + WS_WQ_T), scr, r, C.lane, (const float*)a.in[20]); continue; } r -= I_Q;
        if (r < I_O) { p0_transpose_item<false>((const float*)a.in[19], 1024, 1024, (bf16*)(ws + WS_WOUT_T), scr, r, C.lane); continue; } r -= I_O;
        if (r < I_BR) { p0_transpose_item<false>((const float*)a.in[16], 512, 1024, (bf16*)(ws + WS_WCAT_T), scr, r, C.lane, nullptr, 1024, 0); continue; } r -= I_BR;
        if (r < I_BS) { p0_transpose_item<false>((const float*)a.in[17], 256, 1024, (bf16*)(ws + WS_WCAT_T), scr, r, C.lane, nullptr, 1024, 512); continue; } r -= I_BS;
        if (r < I_BM) { p0_transpose_item<false>((const float*)a.in[18], 256, 1024, (bf16*)(ws + WS_WCAT_T), scr, r, C.lane, nullptr, 1024, 768); continue; } r -= I_BM;
        if (r < I_KV) { p0_transpose_item<false>((const float*)a.in[6], 1024, 512, (bf16*)(ws + WS_WMKV_T), scr, r, C.lane); continue; } r -= I_KV;
        p0_transpose_item<true>((const float*)a.in[15], 256, 512, (bf16*)(ws + WS_WGLU_T), scr, r, C.lane);
    }
    for (int i = gt; i < 16 * 128 * 128 / 8; i += NGT) { const f32x4 x0 = ((const f32x4*)a.in[22])[2 * (size_t)i], x1 = ((const f32x4*)a.in[22])[2 * (size_t)i + 1];
        const int hc = i >> 11, n = (i >> 4) & 127, d0 = (i & 15) * 8; *(v4u*)((bf16*)(ws + WS_KEYS) + hc * 16384 + frag32(n, d0, 128)) = pack8(x0, x1); }
    for (int rw0 = gw; rw0 < 2 * 16384; rw0 += 4 * NGW) {
        const int t = rw0 >> 14;
        f32x4 v[4][4]; float mx[4];
#pragma unroll
        for (int i = 0; i < 4; ++i) { const int row = (rw0 + i * NGW) & 16383;
            const float* src = (const float*)a.in[23 + t] + (size_t)row * DM + C.lane * 4; mx[i] = 0.f;
#pragma unroll
            for (int q = 0; q < 4; ++q) { v[i][q] = *(const f32x4*)(src + 256 * q); if (t == 0) v[i][q] = v[i][q] * *(const f32x4*)((const float*)a.in[20] + C.lane * 4 + 256 * q); } }
#pragma unroll
        for (int i = 0; i < 4; ++i)
#pragma unroll
            for (int q = 0; q < 4; ++q) mx[i] += (v[i][q][0] * v[i][q][0] + v[i][q][1] * v[i][q][1]) + (v[i][q][2] * v[i][q][2] + v[i][q][3] * v[i][q][3]);
#pragma unroll
        for (int o = 1; o < 64; o <<= 1)
#pragma unroll
            for (int i = 0; i < 4; ++i) mx[i] += __shfl_xor(mx[i], o);
#pragma unroll
        for (int i = 0; i < 4; ++i) { const int row = (rw0 + i * NGW) & 16383;
            const float rms = sqrtf(mx[i] * (1.f / DM)); const bool tiny = rms < 1e-30f;
            const float sc = tiny ? 1.f : 2.05f / rms, isc = tiny ? 1.f : rms * (1.f / 2.05f);
            unsigned char* dst = ws + (t ? WS_PV : WS_PU) + (size_t)row * 128 + 2 * C.lane;
#pragma unroll
            for (int q = 0; q < 4; ++q) { const unsigned w = q_e2m1(v[i][q][0] * sc) | (q_e2m1(v[i][q][1] * sc) << 4) | (q_e2m1(v[i][q][2] * sc) << 8) | (q_e2m1(v[i][q][3] * sc) << 12);
                *(unsigned short*)(dst + (size_t)q * (16384 * 128)) = (unsigned short)w; }
            if (C.lane == 0) ((float*)(ws + WS_PSC))[row * 2 + t] = isc; }
    }
    for (int m = gw; m < MTOK; m += 4 * NGW) rms_rows_to_i8<4, false>((const float*)a.in[0], (const float*)a.in[3], nullptr, ws + WS_XN8, (float*)(ws + WS_RSX), m, NGW, C.lane);
    for (int m = gw; m < MROWS; m += NGW) rms_rows_to_bf16<1>((const float*)a.in[1], (const float*)a.in[5], (bf16*)(ws + WS_MEMN), m, NGW, C.lane);
    {
        const int* pos = (const int*)a.in[2]; float* rope = (float*)(ws + WS_ROPE);
        const int j = C.tid & 63;
        const double invrev = exp(-(double)j * (9.210340371976184 / 64.0)) * 0.15915494309189535;
        for (int i = gt; i < MTOK * 64; i += NGT) { const int tok = i >> 6;
            double rv = (double)pos[tok] * invrev; rv -= rint(rv);
            const float rf = (float)rv;
            rope[(size_t)tok * 128 + j] = __builtin_amdgcn_cosf(rf); rope[(size_t)tok * 128 + 64 + j] = __builtin_amdgcn_sinf(rf); }
    }
}

constexpr int LP = 136;
__device__ __forceinline__ float lg2_gamma(int h) { return log2f(1.0f - exp2f(-5.0f - (float)h)); }

struct R1In { v4u q[4], k[4]; };
__device__ __forceinline__ void r1_load(const bf16* zr, int h, int dq, int eq, R1In& R) {
    const bf16* sq = zr + ZQ + h * 128; const bf16* sk = zr + ZK + h * 128;
    R.q[0] = *(const v4u*)(sq + dq); R.q[1] = *(const v4u*)(sq + dq + 8); R.q[2] = *(const v4u*)(sq + 64 + dq); R.q[3] = *(const v4u*)(sq + 64 + dq + 8);
    R.k[0] = *(const v4u*)(sk + dq); R.k[1] = *(const v4u*)(sk + dq + 8); R.k[2] = *(const v4u*)(sk + 64 + dq); R.k[3] = *(const v4u*)(sk + 64 + dq + 8);
}
__device__ __forceinline__ void r1_unit(const Ctx& C, const Args& a, int tile, int h, const float (&cs)[16], const float (&sn)[16], const R1In& R, R1In& Rn, bool hasnext) {
    const bf16* Z1 = (const bf16*)(a.ws + WS_Z1);
    LAS bf16* Qs = (LAS bf16*)C.lds; LAS bf16* Ks = Qs + 128 * LP; LAS bf16* Kt = Ks + 128 * LP; LAS bf16* Vt = Kt + 128 * LP;
    const int tid = C.tid, lane = C.lane, t0 = tile * 128, u = tile * 4 + h;
    const float lg2g = lg2_gamma(h);
    const int i = tid >> 2, dq = (tid & 3) * 16, eq = (tid & 3) * 32;
    {
        v4u vraw[4];
#pragma unroll
        for (int q = 0; q < 4; ++q) vraw[q] = *(const v4u*)(Z1 + (size_t)(t0 + i) * NZ1 + ZV + h * 128 + eq + 8 * q);
        const float kdec = __builtin_amdgcn_exp2f((float)(127 - i) * lg2g) , ksc = 0.08838834764831845f;
#pragma unroll
        for (int which = 0; which < 2; ++which) {
            const v4u a0 = which ? R.k[0] : R.q[0], a1 = which ? R.k[1] : R.q[1], b0 = which ? R.k[2] : R.q[2], b1 = which ? R.k[3] : R.q[3];
            const unsigned aw[8] = {a0.x, a0.y, a0.z, a0.w, a1.x, a1.y, a1.z, a1.w}, bw[8] = {b0.x, b0.y, b0.z, b0.w, b1.x, b1.y, b1.z, b1.w};
            float y1[16], y2[16];
#pragma unroll
            for (int w = 0; w < 8; ++w) {
                const float x1l = bflo(aw[w]), x1h = bfhi(aw[w]), x2l = bflo(bw[w]), x2h = bfhi(bw[w]);
                y1[2 * w] = x1l * cs[2 * w] - x2l * sn[2 * w]; y2[2 * w] = x1l * sn[2 * w] + x2l * cs[2 * w];
                y1[2 * w + 1] = x1h * cs[2 * w + 1] - x2h * sn[2 * w + 1]; y2[2 * w + 1] = x1h * sn[2 * w + 1] + x2h * cs[2 * w + 1];
            }
            if (which) {
#pragma unroll
                for (int e = 0; e < 16; ++e) { y1[e] *= ksc; y2[e] *= ksc; }
            }
            LAS bf16* dstp = (which ? Ks : Qs) + i * LP;
            v4u o;
            o.x = pk2(y1[0], y1[1]); o.y = pk2(y1[2], y1[3]); o.z = pk2(y1[4], y1[5]); o.w = pk2(y1[6], y1[7]); *(LAS v4u*)(dstp + dq) = o;
            o.x = pk2(y1[8], y1[9]); o.y = pk2(y1[10], y1[11]); o.z = pk2(y1[12], y1[13]); o.w = pk2(y1[14], y1[15]); *(LAS v4u*)(dstp + dq + 8) = o;
            o.x = pk2(y2[0], y2[1]); o.y = pk2(y2[2], y2[3]); o.z = pk2(y2[4], y2[5]); o.w = pk2(y2[6], y2[7]); *(LAS v4u*)(dstp + 64 + dq) = o;
            o.x = pk2(y2[8], y2[9]); o.y = pk2(y2[10], y2[11]); o.z = pk2(y2[12], y2[13]); o.w = pk2(y2[14], y2[15]); *(LAS v4u*)(dstp + 64 + dq + 8) = o;
            if (which) {
#pragma unroll
                for (int e = 0; e < 16; ++e) { Kt[(dq + e) * LP + i] = (bf16)f2bf(y1[e] * kdec); Kt[(64 + dq + e) * LP + i] = (bf16)f2bf(y2[e] * kdec); }
            }
            __builtin_amdgcn_sched_barrier(0);
        }
        {
#pragma unroll
            for (int q = 0; q < 4; ++q) { const v4u v = vraw[q]; const unsigned vw[4] = {v.x, v.y, v.z, v.w};
#pragma unroll
                for (int w = 0; w < 4; ++w) { Vt[(eq + 8 * q + 2 * w) * LP + i] = (bf16)(vw[w] & 0xffffu); Vt[(eq + 8 * q + 2 * w + 1) * LP + i] = (bf16)(vw[w] >> 16); } }
        }
    }
    __syncthreads();
    if (hasnext) r1_load(Z1 + (size_t)(t0 + i) * NZ1, h + 1, dq, eq, Rn);
    __builtin_amdgcn_sched_barrier(0);
    const int r = lane & 31, hh = lane >> 5;
    if (C.wave < 4) {
        const int ib = C.wave;
        { bf16* qf = (bf16*)(a.ws + WS_QRF) + ((size_t)(u * 4 + ib) * 8 * 64 + lane) * 8;
#pragma unroll
          for (int ks = 0; ks < 8; ++ks) *(bf16x8*)(qf + ks * 512) = *(const LAS bf16x8*)(Qs + (ib * 32 + r) * LP + ks * 16 + 8 * hh); }
        __builtin_amdgcn_sched_barrier(0);
        f32x16 accO[4];
#pragma unroll
        for (int et = 0; et < 4; ++et)
#pragma unroll
            for (int e = 0; e < 16; ++e) accO[et][e] = 0.f;
        int i = ib * 32 + r; asm volatile("" : "+v"(i));
#pragma unroll
        for (int jt = 0; jt < 4; ++jt) {
            if (jt <= ib) {
                f32x16 s;
#pragma unroll
                for (int e = 0; e < 16; ++e) s[e] = 0.f;
#pragma unroll
                for (int ks = 0; ks < 8; ++ks) { const bf16x8 ak = *(const LAS bf16x8*)(Ks + (jt * 32 + r) * LP + ks * 16 + 8 * hh), bqk = *(const LAS bf16x8*)(Qs + (ib * 32 + r) * LP + ks * 16 + 8 * hh); s = mfma32(ak, bqk, s); }
                unsigned pk[8];
#pragma unroll
                for (int q = 0; q < 8; ++q) {
                    const int ra = 2 * q, rb = 2 * q + 1;
                    const int ja = jt * 32 + (ra & 3) + 8 * (ra >> 2) + 4 * hh, jb = jt * 32 + (rb & 3) + 8 * (rb >> 2) + 4 * hh;
                    const float va = (i >= ja) ? s[ra] * __builtin_amdgcn_exp2f((float)(i - ja) * lg2g) : 0.f;
                    const float vb = (i >= jb) ? s[rb] * __builtin_amdgcn_exp2f((float)(i - jb) * lg2g) : 0.f;
                    pk[q] = pk2(va, vb);
                }
#pragma unroll
                for (int sft = 0; sft < 2; ++sft) {
                    const bf16x8 pb = mk8(pk[4 * sft], pk[4 * sft + 1], pk[4 * sft + 2], pk[4 * sft + 3]);
#pragma unroll
                    for (int et = 0; et < 4; ++et) {
                        const LAS bf16* vp = Vt + (et * 32 + r) * LP + jt * 32 + 16 * sft + 4 * hh;
                        const v2u lo = *(const LAS v2u*)vp, hi = *(const LAS v2u*)(vp + 8);
                        accO[et] = mfma32(mk8(lo.x, lo.y, hi.x, hi.y), pb, accO[et]);
                    }
                }
            }
            __builtin_amdgcn_sched_barrier(0);
        }
        unsigned* INN = (unsigned*)(a.ws + WS_INNER) + ((size_t)(u * 4 + ib) * 32) * 64 + lane;
#pragma unroll
        for (int et = 0; et < 4; ++et)
#pragma unroll
            for (int q = 0; q < 8; ++q) INN[(et * 8 + q) * 64] = pk2(accO[et][2 * q], accO[et][2 * q + 1]);
    } else {
        const int et = C.wave - 4;
        f32x16 acc[4];
#pragma unroll
        for (int dt = 0; dt < 4; ++dt)
#pragma unroll
            for (int e = 0; e < 16; ++e) acc[dt][e] = 0.f;
#pragma unroll
        for (int ks = 0; ks < 8; ++ks) {
            const bf16x8 av = *(const LAS bf16x8*)(Vt + (et * 32 + r) * LP + ks * 16 + 8 * hh);
#pragma unroll
            for (int dt = 0; dt < 4; ++dt) { const bf16x8 bk = *(const LAS bf16x8*)(Kt + (dt * 32 + r) * LP + ks * 16 + 8 * hh); acc[dt] = mfma32(av, bk, acc[dt]); }
            __builtin_amdgcn_sched_barrier(0);
        }
        float* KVb = a.out + (size_t)u * 16384 + (size_t)(et * 32 + 4 * hh) * 128 + r;
#pragma unroll
        for (int dt = 0; dt < 4; ++dt) {
#pragma unroll
            for (int e = 0; e < 16; ++e) KVb[((e & 3) + 8 * (e >> 2)) * 128 + dt * 32] = acc[dt][e];
            __builtin_amdgcn_sched_barrier(0);
        }
    }
    __syncthreads();
}

__device__ __forceinline__ void s5_compute_E(const Args& a, int tile, int g, int lane, LAS float* Es, bf16x8 (&au)[4]) {
    const bf16* Z1 = (const bf16*)(a.ws + WS_Z1); const bf16* PMT = (const bf16*)(a.ws + WS_S5MAT) + (size_t)(16 + g) * 16384;
    const int r16 = lane & 15, q4 = lane >> 4;
#pragma unroll
    for (int ks = 0; ks < 4; ++ks) { const int s = 2 * ks + (q4 >> 1);
        au[ks] = *(const bf16x8*)(Z1 + (size_t)(tile * 128 + 8 * r16 + s) * NZ1 + ZU + g * 16 + 8 * (q4 & 1)); }
    bf16x8 bc[4], bn[4];
#pragma unroll
    for (int ks = 0; ks < 4; ++ks) bc[ks] = *(const bf16x8*)(PMT + (ks * 64 + lane) * 8);
#pragma unroll 1
    for (int nb = 0; nb < 8; ++nb) {
        const int nbn = min(nb + 1, 7);
#pragma unroll
        for (int ks = 0; ks < 4; ++ks) bn[ks] = *(const bf16x8*)(PMT + ((nbn * 4 + ks) * 64 + lane) * 8);
        __builtin_amdgcn_sched_barrier(0);
        f32x4 acc = {0.f, 0.f, 0.f, 0.f};
#pragma unroll
        for (int ks = 0; ks < 4; ++ks) acc = mfma16(au[ks], bc[ks], acc);
#pragma unroll
        for (int i4 = 0; i4 < 4; ++i4) Es[(q4 * 4 + i4) * 128 + nb * 16 + r16] = acc[i4];
        __builtin_amdgcn_sched_barrier(0);
#pragma unroll
        for (int ks = 0; ks < 4; ++ks) bc[ks] = bn[ks];
    }
    LDS_WAIT(); asm volatile("" ::: "memory");
}
__device__ __forceinline__ void s5a_wave(const Ctx& C, const Args& a, int tile, int g) {
    LAS float* Es = (LAS float*)(C.lds + C.wave * 16384);
    bf16x8 au[4];
    s5_compute_E(a, tile, g, C.lane, Es, au);
    const float* L8 = (const float*)(a.ws + WS_S5C) + (size_t)g * 128;
    const float l8r = L8[C.lane * 2], l8i = L8[C.lane * 2 + 1];
    float sr = 0.f, si = 0.f;
#pragma unroll
    for (int c = 0; c < 16; ++c) { const float er = Es[c * 128 + C.lane], ei = Es[c * 128 + 64 + C.lane];
        const float nr = l8r * sr - l8i * si + er, ni = l8r * si + l8i * sr + ei; sr = nr; si = ni; }
    float* E = (float*)(a.ws + WS_S5E) + ((size_t)tile * 16 + g) * 128;
    E[C.lane] = sr; E[64 + C.lane] = si;
    LDS_WAIT(); asm volatile("" ::: "memory");
}
__device__ __forceinline__ void s5c_wave(const Ctx& C, const Args& a, int tile, int g) {
    LAS float* Es = (LAS float*)(C.lds + C.wave * 16384);
    LAS bf16* Sv = (LAS bf16*)(C.lds + C.wave * 16384 + 8192);
    const int lane = C.lane, r16 = lane & 15, q4 = lane >> 4;
    bf16x8 au[4];
    s5_compute_E(a, tile, g, lane, Es, au);
    const float* L8 = (const float*)(a.ws + WS_S5C) + (size_t)g * 128;
    const float l8r = L8[lane * 2], l8i = L8[lane * 2 + 1];
    const float* X = (const float*)(a.ws + WS_S5X) + ((size_t)tile * 16 + g) * 128;
    float sr = X[lane], si = X[64 + lane];
#pragma unroll
    for (int c = 0; c < 16; ++c) {
        Sv[c * LP + lane] = (bf16)f2bf(sr); Sv[c * LP + 64 + lane] = (bf16)f2bf(si);
        const float er = Es[c * 128 + lane], ei = Es[c * 128 + 64 + lane];
        const float nr = l8r * sr - l8i * si + er, ni = l8r * si + l8i * sr + ei; sr = nr; si = ni; }
    LDS_WAIT(); asm volatile("" ::: "memory");
    bf16x8 as[4];
#pragma unroll
    for (int ks = 0; ks < 4; ++ks) as[ks] = *(const LAS bf16x8*)(Sv + r16 * LP + ks * 32 + 8 * q4);
    const bf16* T8T = (const bf16*)(a.ws + WS_S5MAT) + (size_t)g * 16384; const bf16* QMT = (const bf16*)(a.ws + WS_S5MAT) + (size_t)(32 + g) * 16384;
    const bf16* Z1 = (const bf16*)(a.ws + WS_Z1); bf16* YG = (bf16*)(a.ws + WS_YG);
    const float dg = ((const float*)a.in[14])[g * 16 + r16];
    bf16x8 tc[4], tn[4], qc[4], qn[4]; bf16 uc[4], un[4];
#pragma unroll
    for (int ks = 0; ks < 4; ++ks) { tc[ks] = *(const bf16x8*)(T8T + (ks * 64 + lane) * 8); qc[ks] = *(const bf16x8*)(QMT + (ks * 64 + lane) * 8); }
#pragma unroll
    for (int i4 = 0; i4 < 4; ++i4) uc[i4] = Z1[(size_t)(tile * 128 + 8 * (q4 * 4 + i4)) * NZ1 + ZU + g * 16 + r16];
#pragma unroll 1
    for (int nb = 0; nb < 8; ++nb) {
        const int nbn = min(nb + 1, 7);
#pragma unroll
        for (int ks = 0; ks < 4; ++ks) { tn[ks] = *(const bf16x8*)(T8T + ((nbn * 4 + ks) * 64 + lane) * 8); qn[ks] = *(const bf16x8*)(QMT + ((nbn * 4 + ks) * 64 + lane) * 8); }
#pragma unroll
        for (int i4 = 0; i4 < 4; ++i4) un[i4] = Z1[(size_t)(tile * 128 + 8 * (q4 * 4 + i4) + nbn) * NZ1 + ZU + g * 16 + r16];
        __builtin_amdgcn_sched_barrier(0);
        f32x4 acc = {0.f, 0.f, 0.f, 0.f};
#pragma unroll
        for (int ks = 0; ks < 4; ++ks) { acc = mfma16(au[ks], tc[ks], acc); acc = mfma16(as[ks], qc[ks], acc); }
#pragma unroll
        for (int i4 = 0; i4 < 4; ++i4) { const int tok = tile * 128 + 8 * (q4 * 4 + i4) + nb;
            YG[(size_t)tok * 256 + g * 16 + r16] = (bf16)f2bf(gelu_tanh(acc[i4] + dg * bf2f(uc[i4]))); }
        __builtin_amdgcn_sched_barrier(0);
#pragma unroll
        for (int ks = 0; ks < 4; ++ks) { tc[ks] = tn[ks]; qc[ks] = qn[ks]; }
#pragma unroll
        for (int i4 = 0; i4 < 4; ++i4) uc[i4] = un[i4];
    }
    LDS_WAIT(); asm volatile("" ::: "memory");
}

__device__ __forceinline__ void ma_loadk(const bf16* kp, int mt, bf16x8 (&k)[4]) {
#pragma unroll
    for (int ks = 0; ks < 4; ++ks) k[ks] = *(const bf16x8*)(kp + (mt * 4 + ks) * 512);
}
__device__ __forceinline__ void ma_loadv(const bf16* vp, int mt, bf16x8 (&v)[4]) {
#pragma unroll
    for (int sft = 0; sft < 2; ++sft)
#pragma unroll
        for (int et = 0; et < 2; ++et) v[sft * 2 + et] = *(const bf16x8*)(vp + (((et * 8 + mt) * 2 + sft) * 64) * 8);
}
__device__ __forceinline__ void ma_wave(const Ctx& C, const Args& a, int tile, int hm, int ib) {
    const bf16* Z1 = (const bf16*)(a.ws + WS_Z1); const bf16* KM = (const bf16*)(a.ws + WS_KM); const bf16* VT = (const bf16*)(a.ws + WS_VT);
    const int lane = C.lane, r = lane & 31, hh = lane >> 5, b = tile >> 5, tok = tile * 128 + ib * 32 + r;
    const bf16* kp = KM + (size_t)(b * 4 + hm) * 16384 + lane * 8;
    const bf16* vp = VT + (size_t)(b * 4 + hm) * 16384 + lane * 8;
    bf16x8 bq[4];
#pragma unroll
    for (int ks = 0; ks < 4; ++ks) bq[ks] = *(const bf16x8*)(Z1 + (size_t)tok * NZ1 + ZQM + hm * 64 + ks * 16 + 8 * hh);
    bf16x8 kc[4], kn[4];
    ma_loadk(kp, 0, kc);
    float mx = -3.0e38f;
#pragma unroll 1
    for (int mt = 0; mt < 8; ++mt) {
        ma_loadk(kp, min(mt + 1, 7), kn); __builtin_amdgcn_sched_barrier(0);
        f32x16 s;
#pragma unroll
        for (int e = 0; e < 16; ++e) s[e] = 0.f;
#pragma unroll
        for (int ks = 0; ks < 4; ++ks) s = mfma32(kc[ks], bq[ks], s);
#pragma unroll
        for (int e = 0; e < 16; ++e) mx = fmaxf(mx, s[e]);
        __builtin_amdgcn_sched_barrier(0);
#pragma unroll
        for (int ks = 0; ks < 4; ++ks) kc[ks] = kn[ks];
    }
    mx = fmaxf(mx, __shfl_xor(mx, 32));
    float sum = 0.f;
    f32x16 o[2];
#pragma unroll
    for (int et = 0; et < 2; ++et)
#pragma unroll
        for (int e = 0; e < 16; ++e) o[et][e] = 0.f;
    const float sc = 0.125f * 1.4426950408889634f;
    bf16x8 vc[4], vn[4];
    ma_loadk(kp, 0, kc); ma_loadv(vp, 0, vc);
#pragma unroll 1
    for (int mt = 0; mt < 8; ++mt) {
        ma_loadk(kp, min(mt + 1, 7), kn); ma_loadv(vp, min(mt + 1, 7), vn); __builtin_amdgcn_sched_barrier(0);
        f32x16 s;
#pragma unroll
        for (int e = 0; e < 16; ++e) s[e] = 0.f;
#pragma unroll
        for (int ks = 0; ks < 4; ++ks) s = mfma32(kc[ks], bq[ks], s);
        unsigned pk[8];
#pragma unroll
        for (int q = 0; q < 8; ++q) { const float pa = __builtin_amdgcn_exp2f((s[2 * q] - mx) * sc), pb = __builtin_amdgcn_exp2f((s[2 * q + 1] - mx) * sc); sum += pa + pb; pk[q] = pk2(pa, pb); }
#pragma unroll
        for (int sft = 0; sft < 2; ++sft) {
            const bf16x8 pb = mk8(pk[4 * sft], pk[4 * sft + 1], pk[4 * sft + 2], pk[4 * sft + 3]);
#pragma unroll
            for (int et = 0; et < 2; ++et) o[et] = mfma32(vc[sft * 2 + et], pb, o[et]);
        }
        __builtin_amdgcn_sched_barrier(0);
#pragma unroll
        for (int ks = 0; ks < 4; ++ks) kc[ks] = kn[ks];
#pragma unroll
        for (int q = 0; q < 4; ++q) vc[q] = vn[q];
    }
    sum += __shfl_xor(sum, 32);
    const float inv = 1.0f / sum;
    bf16* MA = (bf16*)(a.ws + WS_YCAT) + (size_t)tok * 1024 + 768 + hm * 64;
#pragma unroll
    for (int et = 0; et < 2; ++et)
#pragma unroll
        for (int g4 = 0; g4 < 4; ++g4) { v2u w; w.x = pk2(o[et][4 * g4] * inv, o[et][4 * g4 + 1] * inv); w.y = pk2(o[et][4 * g4 + 2] * inv, o[et][4 * g4 + 3] * inv);
            *(v2u*)(MA + et * 32 + 8 * g4 + 4 * hh) = w; }
}

__device__ __forceinline__ void r3_wave(const Ctx& C, const Args& a, int tile, int h, int ib) {
    const bf16* Z1 = (const bf16*)(a.ws + WS_Z1); const float* ROPE = (const float*)(a.ws + WS_ROPE);
    const bf16* PREV = (const bf16*)((const unsigned char*)a.out + 64 * MiB);
    const int lane = C.lane, r = lane & 31, hh = lane >> 5, u = tile * 4 + h, tok = tile * 128 + ib * 32 + r;
    const float lg2g = lg2_gamma(h);
    bf16x8 bq[8];
    { const bf16* qf = (const bf16*)(a.ws + WS_QRF) + ((size_t)(u * 4 + ib) * 8 * 64 + lane) * 8;
#pragma unroll
      for (int ks = 0; ks < 8; ++ks) bq[ks] = *(const bf16x8*)(qf + ks * 512); }
    f32x16 acc[4];
    const bf16* pbase = PREV + (size_t)u * 16384 + lane * 8;
    bf16x8 ap[4][8];
#pragma unroll
    for (int et = 0; et < 4; ++et)
#pragma unroll
        for (int ks = 0; ks < 8; ++ks) ap[et][ks] = *(const bf16x8*)(pbase + (et * 8 + ks) * 512);
    __builtin_amdgcn_sched_barrier(0);
#pragma unroll
    for (int et = 0; et < 4; ++et) {
#pragma unroll
        for (int e = 0; e < 16; ++e) acc[et][e] = 0.f;
#pragma unroll
        for (int ks = 0; ks < 8; ++ks) acc[et] = mfma32(ap[et][ks], bq[ks], acc[et]);
    }
    __builtin_amdgcn_sched_barrier(0);
    const unsigned* INN = (const unsigned*)(a.ws + WS_INNER) + ((size_t)(u * 4 + ib) * 32) * 64 + lane;
    unsigned innw[32];
#pragma unroll
    for (int q = 0; q < 32; ++q) innw[q] = INN[q * 64];
    const bf16* gp = Z1 + (size_t)tok * NZ1 + ZGR + h * 128;
    v2u gwv[16];
#pragma unroll
    for (int q = 0; q < 16; ++q) gwv[q] = *(const v2u*)(gp + (q >> 2) * 32 + 8 * (q & 3) + 4 * hh);
    const float qdec = __builtin_amdgcn_exp2f((float)(ib * 32 + r + 1) * lg2g);
    float ss = 0.f;
#pragma unroll
    for (int et = 0; et < 4; ++et)
#pragma unroll
        for (int q = 0; q < 8; ++q) { const unsigned w = innw[et * 8 + q];
            const float v0 = acc[et][2 * q] * qdec + bflo(w), v1 = acc[et][2 * q + 1] * qdec + bfhi(w);
            acc[et][2 * q] = v0; acc[et][2 * q + 1] = v1; ss += v0 * v0 + v1 * v1; }
    __builtin_amdgcn_sched_barrier(0);
    ss += __shfl_xor(ss, 32);
    const float rn = __builtin_amdgcn_rsqf(ss * (1.0f / 128.0f) + EPS);
    bf16* RET = (bf16*)(a.ws + WS_YCAT) + (size_t)tok * 1024 + h * 128;
#pragma unroll
    for (int et = 0; et < 4; ++et)
#pragma unroll
        for (int g4 = 0; g4 < 4; ++g4) { const int e0 = et * 32 + 8 * g4 + 4 * hh; const v2u gw = gwv[et * 4 + g4];
            const float g0 = bflo(gw.x), g1 = bfhi(gw.x), g2 = bflo(gw.y), g3 = bfhi(gw.y);
            v2u w; w.x = pk2(acc[et][4 * g4] * rn * g0 * sigmoidf_(g0), acc[et][4 * g4 + 1] * rn * g1 * sigmoidf_(g1));
            w.y = pk2(acc[et][4 * g4 + 2] * rn * g2 * sigmoidf_(g2), acc[et][4 * g4 + 3] * rn * g3 * sigmoidf_(g3));
            *(v2u*)(RET + e0) = w; }
}

__device__ __forceinline__ void p3_scans(const Ctx& C, const Args& a) {
    constexpr int NSKIP = 16;
    if ((int)blockIdx.x < NSKIP) return;
    const int w0 = ((int)blockIdx.x - NSKIP) * 512 + C.tid, NW = (C.G - NSKIP) * 512;
    {
        const float* KV = a.out; bf16* PREV = (bf16*)((unsigned char*)a.out + 64 * MiB);
        for (int it = w0; it < 131072; it += NW) {
            const int elem = it * 4, b = elem >> 16, h = (elem >> 14) & 3, ed = elem & 16383;
            const float cd = __builtin_amdgcn_exp2f(128.0f * lg2_gamma(h));
            const float* kp = KV + (size_t)(b * 128 + h) * 16384 + ed; bf16* pp = PREV + (size_t)(b * 128 + h) * 16384 + frag32(ed >> 7, ed & 127, 128);
            f32x4 inc[32];
#pragma unroll
            for (int c = 0; c < 32; ++c) inc[c] = *(const f32x4*)(kp + (size_t)c * 65536);
            f32x4 st = {0.f, 0.f, 0.f, 0.f};
#pragma unroll
            for (int c = 0; c < 32; ++c) { v2u w; w.x = pk2(st[0], st[1]); w.y = pk2(st[2], st[3]); *(v2u*)(pp + (size_t)c * 65536) = w; st = st * cd + inc[c]; }
        }
    }
    {
        const float* E = (const float*)(a.ws + WS_S5E); float* X = (float*)(a.ws + WS_S5X); const float* L128 = (const float*)(a.ws + WS_S5C) + 2048;
        for (int it = w0; it < 8192; it += NW) {
            const int b = it >> 10, g = (it >> 6) & 15, p = it & 63;
            const float lr = L128[(g * 64 + p) * 2], li = L128[(g * 64 + p) * 2 + 1];
            const float* ep = E + ((size_t)(b * 32) * 16 + g) * 128 + p; float* xp = X + ((size_t)(b * 32) * 16 + g) * 128 + p;
            float er[32], ei[32];
#pragma unroll
            for (int n = 0; n < 32; ++n) { er[n] = ep[(size_t)n * 2048]; ei[n] = ep[(size_t)n * 2048 + 64]; }
            float xr = 0.f, xi = 0.f;
#pragma unroll
            for (int n = 0; n < 32; ++n) { xp[(size_t)n * 2048] = xr; xp[(size_t)n * 2048 + 64] = xi;
                const float nr = lr * xr - li * xi + er[n], ni = lr * xi + li * xr + ei[n]; xr = nr; xi = ni; }
        }
    }
}

__device__ __forceinline__ int f2key(float x) { int b = __builtin_bit_cast(int, x); return b >= 0 ? b : (b ^ 0x7fffffff); }
__device__ __forceinline__ float key2f(int k) { return __builtin_bit_cast(float, k >= 0 ? k : (k ^ 0x7fffffff)); }
__device__ __forceinline__ void ce_desc(int& x, int& y) { const int hi = x > y ? x : y, lo = x > y ? y : x; x = hi; y = lo; }
__device__ __forceinline__ void sort16_desc(int (&v)[16]) {
#pragma unroll
    for (int k = 2; k <= 16; k <<= 1)
#pragma unroll
        for (int j = k >> 1; j > 0; j >>= 1)
#pragma unroll
            for (int i = 0; i < 16; ++i) { const int l = i ^ j; if (l > i) { if ((i & k) == 0) ce_desc(v[i], v[l]); else ce_desc(v[l], v[i]); } }
}
__device__ __forceinline__ void merge16_desc(int (&T)[16], const int (&N)[16]) {
#pragma unroll
    for (int i = 0; i < 16; ++i) T[i] = T[i] > N[15 - i] ? T[i] : N[15 - i];
#pragma unroll
    for (int j = 8; j > 0; j >>= 1)
#pragma unroll
        for (int i = 0; i < 16; ++i) { const int l = i ^ j; if (l > i) ce_desc(T[i], T[l]); }
}
__device__ __forceinline__ void peer_topk_half(const Args& a, int tokbase, int hp, int c, int lane, int (&T)[16]) {
    const bf16* Q2 = (const bf16*)(a.ws + WS_Q2); const bf16* KEYS = (const bf16*)(a.ws + WS_KEYS);
    const int r = lane & 31, hh = lane >> 5;
    bf16x8 bq[8];
#pragma unroll
    for (int ks = 0; ks < 8; ++ks) bq[ks] = *(const bf16x8*)(Q2 + ((((size_t)(tokbase >> 5) * 16 + hp * 2 + c) * 8 + ks) * 64 + lane) * 8);
    const bf16* kbase = KEYS + (size_t)(hp * 2 + c) * 16384 + lane * 8;
    bf16x8 akc[8], akn[8];
#pragma unroll
    for (int ks = 0; ks < 8; ++ks) akc[ks] = *(const bf16x8*)(kbase + ks * 512);
#pragma unroll
    for (int nt = 0; nt < 4; ++nt) {
        if (nt < 3) {
#pragma unroll
            for (int ks = 0; ks < 8; ++ks) akn[ks] = *(const bf16x8*)(kbase + ((nt + 1) * 8 + ks) * 512);
        }
        __builtin_amdgcn_sched_barrier(0);
        f32x16 s;
#pragma unroll
        for (int e = 0; e < 16; ++e) s[e] = 0.f;
#pragma unroll
        for (int ks = 0; ks < 8; ++ks) s = mfma32(akc[ks], bq[ks], s);
        int N[16];
#pragma unroll
        for (int e = 0; e < 16; ++e) { const int n = nt * 32 + (e & 3) + 8 * (e >> 2) + 4 * hh; N[e] = (f2key(s[e]) & ~127) | n; }
        sort16_desc(N);
        if (nt == 0) {
#pragma unroll
            for (int e = 0; e < 16; ++e) T[e] = N[e];
        } else merge16_desc(T, N);
        __builtin_amdgcn_sched_barrier(0);
#pragma unroll
        for (int ks = 0; ks < 8; ++ks) akc[ks] = akn[ks];
    }
    int P[16];
#pragma unroll
    for (int j = 0; j < 16; ++j) P[j] = __shfl_xor(T[j], 32);
    merge16_desc(T, P);
}
__device__ __forceinline__ void peer_topk_head(const Ctx& C, const Args& a, int tokbase, int hp) {
    const int lane = C.lane, r = lane & 31, hh = lane >> 5;
    int T0[16], T1[16];
    peer_topk_half(a, tokbase, hp, 0, lane, T0);
    peer_topk_half(a, tokbase, hp, 1, lane, T1);
    int F[16], L1[16], L2[16], L3[16];
#pragma unroll
    for (int j = 0; j < 16; ++j) { L1[j] = (int)0x80000000; L2[j] = (int)0x80000000; L3[j] = (int)0x80000000; }
    {
        int cnt = 0;
#pragma unroll
        for (int i0 = 0; i0 < 16; ++i0)
#pragma unroll
            for (int i1 = 0; i1 < 16; ++i1)
                if ((i0 + 1) * (i1 + 1) <= 16) {
                    const float v = key2f(T0[i0] & ~127) + key2f(T1[i1] & ~127); const int key = (f2key(v) & ~255) | (i0 * 16 + i1);
                    if (i0 == 0) F[i1] = key;
                    else { if (cnt < 16) L1[cnt] = key; else if (cnt < 32) L2[cnt - 16] = key; else L3[cnt - 32] = key; ++cnt; }
                }
    }
    sort16_desc(L1); merge16_desc(F, L1); sort16_desc(L2); merge16_desc(F, L2); sort16_desc(L3); merge16_desc(F, L3);
    LAS int* tab = (LAS int*)(C.lds + C.wave * 16384);
#pragma unroll
    for (int j = 0; j < 16; ++j) { tab[j * 64 + lane] = T0[j] & 127; tab[(16 + j) * 64 + lane] = T1[j] & 127; }
    LDS_WAIT(); asm volatile("" ::: "memory");
    const float m = key2f(F[0] & ~255);
    float e[16], sum = 0.f;
#pragma unroll
    for (int j = 0; j < 16; ++j) { e[j] = __builtin_amdgcn_exp2f((key2f(F[j] & ~255) - m) * 1.4426950408889634f); sum += e[j]; }
    const float inv = 1.0f / sum;
    const int tok = tokbase + r;
    int* IDX = (int*)(a.ws + WS_IDX) + (size_t)tok * 128 + hp * 16; float* WGT = (float*)(a.ws + WS_WGT) + (size_t)tok * 128 + hp * 16;
    unsigned ov[16];
#pragma unroll
    for (int j = 0; j < 16; ++j) { const int id = F[j] & 255; const int k0 = tab[(id >> 4) * 64 + lane], k1 = tab[(16 + (id & 15)) * 64 + lane];
        ov[j] = (hh == 0) ? (unsigned)(k0 * 128 + k1) : __builtin_bit_cast(unsigned, e[j] * inv); }
    unsigned* obase = (hh == 0) ? (unsigned*)IDX : (unsigned*)WGT;
#pragma unroll
    for (int q = 0; q < 4; ++q) { v4u w = {ov[4 * q], ov[4 * q + 1], ov[4 * q + 2], ov[4 * q + 3]}; *(v4u*)(obase + 4 * q) = w; }
    LDS_WAIT(); asm volatile("" ::: "memory");
}
typedef float f32x2v __attribute__((ext_vector_type(2)));
__device__ __forceinline__ void unpack16(const v4u a, const v4u b, float (&x)[16]) {
    const unsigned w[8] = {a.x, a.y, a.z, a.w, b.x, b.y, b.z, b.w};
#pragma unroll
    for (int i = 0; i < 8; ++i) { x[2 * i] = bflo(w[i]); x[2 * i + 1] = bfhi(w[i]); }
}
__device__ __forceinline__ void unpack16_fp8(const v4u a, float (&x)[16]) {
    const unsigned w[4] = {a.x, a.y, a.z, a.w};
#pragma unroll
    for (int i = 0; i < 4; ++i) { const f32x2v lo = __builtin_amdgcn_cvt_pk_f32_fp8((int)w[i], false), hi = __builtin_amdgcn_cvt_pk_f32_fp8((int)w[i], true);
        x[4 * i] = lo.x; x[4 * i + 1] = lo.y; x[4 * i + 2] = hi.x; x[4 * i + 3] = hi.y; }
}
__device__ __forceinline__ long mk64(unsigned lo, unsigned hi) { return (long)(((unsigned long long)hi << 32) | (unsigned long long)lo); }
__device__ __forceinline__ float dpp_swap1(float v) { return __builtin_bit_cast(float, __builtin_amdgcn_update_dpp(0, __builtin_bit_cast(int, v), 0xB1, 0xf, 0xf, true)); }
struct PHalf { v4u g[8]; };
struct PIdx { int e[8]; };
__device__ __forceinline__ void pg_idx8(const int* IDXr, int h, int hl, PIdx& I) {
    h = min(h, hl); const int* p = IDXr + (size_t)(h >> 1) * 128 + (h & 1) * 64;
#pragma unroll
    for (int j = 0; j < 8; ++j) I.e[j] = p[j * 8];
}
__device__ __forceinline__ void pg_issue(const unsigned char* TBL, const PIdx& I, int lane, PHalf& D) {
    const unsigned c16 = (unsigned)(lane & 7) * 16u;
#pragma unroll
    for (int j = 0; j < 8; ++j) D.g[j] = *(const v4u*)(TBL + ((unsigned)I.e[j] * 128u + c16));
}
__device__ __forceinline__ void pg_stage(LAS unsigned char* buf, int lane, const PHalf& D) {
    const int row8 = lane >> 3, c8 = lane & 7;
#pragma unroll
    for (int j = 0; j < 8; ++j) *(LAS v4u*)(buf + (j * 8 + row8) * 128 + ((c8 ^ row8) & 7) * 16) = D.g[j];
}
__device__ __forceinline__ void pg_stage_v(LAS unsigned char* buf, int lane, const PHalf& D) {
    const int row8 = lane >> 3, c8 = lane & 7;
#pragma unroll
    for (int j = 0; j < 8; ++j) { const v4u g = D.g[j]; const v4u w = ((j >> 1) & 1) ? (v4u){g.z, g.w, g.x, g.y} : g;
        *(LAS v4u*)(buf + (j * 8 + row8) * 128 + ((c8 ^ ((row8 >> 1) | ((j & 1) << 2))) & 7) * 16) = w; }
}
__device__ __forceinline__ void e2m1_qv(float y, unsigned& code, float& val) {
    const float m = fminf(fabsf(y), 6.0f);
    const unsigned rb = (__builtin_bit_cast(unsigned, m) + 0x00200000u) & 0xFFC00000u;
    const float sm = 0.5f * rintf(2.0f * m);
    const bool big = m >= 1.0f;
    const float v = big ? __builtin_bit_cast(float, rb) : sm;
    const unsigned c = big ? (rb >> 22) - 252u : (unsigned)(2.0f * sm);
    const unsigned sg = __builtin_bit_cast(unsigned, y) & 0x80000000u;
    code = c | (sg >> 28); val = __builtin_bit_cast(float, __builtin_bit_cast(unsigned, v) | sg);
}
__device__ __forceinline__ void pu_xprep(LAS unsigned char* xs, v2u xw, float sx, int lane) {
    const float x[4] = {bflo(xw.x) * sx, bfhi(xw.x) * sx, bflo(xw.y) * sx, bfhi(xw.y) * sx};
    unsigned hi = 0u, lo = 0u;
#pragma unroll
    for (int j = 0; j < 4; ++j) { unsigned c0, c1; float v0, v1; e2m1_qv(x[j], c0, v0); e2m1_qv((x[j] - v0) * 4.0f, c1, v1); hi |= c0 << (4 * j); lo |= c1 << (4 * j); }
    *(LAS unsigned short*)(xs + 2 * lane) = (unsigned short)hi; *(LAS unsigned short*)(xs + 128 + 2 * lane) = (unsigned short)lo;
}
typedef int v8i_t __attribute__((ext_vector_type(8)));
__device__ __forceinline__ void pu_compute(const LAS unsigned char* buf, bf16* HPt, int r, int kq, const v4u (&bfr)[2]) {
    f32x4 res[4];
    const int sclB = (r & 1) ? 0x7d7d7d7d : 0x7f7f7f7f;
    const v8i_t bv0 = {(int)bfr[0].x, (int)bfr[0].y, (int)bfr[0].z, (int)bfr[0].w, 0, 0, 0, 0}, bv1 = {(int)bfr[1].x, (int)bfr[1].y, (int)bfr[1].z, (int)bfr[1].w, 0, 0, 0, 0};
#pragma unroll
    for (int g = 0; g < 4; ++g) {
        const int row = g * 16 + r, sw = row & 7;
        const v4u a0 = *(const LAS v4u*)(buf + row * 128 + (kq ^ sw) * 16), a1 = *(const LAS v4u*)(buf + row * 128 + ((4 + kq) ^ sw) * 16);
        const v8i_t av0 = {(int)a0.x, (int)a0.y, (int)a0.z, (int)a0.w, 0, 0, 0, 0}, av1 = {(int)a1.x, (int)a1.y, (int)a1.z, (int)a1.w, 0, 0, 0, 0};
        res[g] = __builtin_amdgcn_mfma_scale_f32_16x16x128_f8f6f4(av0, bv0, (f32x4){0.f, 0.f, 0.f, 0.f}, 4  , 4  , 0, 0x7f7f7f7f, 0, sclB);
        res[g] = __builtin_amdgcn_mfma_scale_f32_16x16x128_f8f6f4(av1, bv1, res[g], 4, 4, 0, 0x7f7f7f7f, 0, sclB);
    }
    f32x4 o = res[0];
#pragma unroll
    for (int g = 1; g < 4; ++g) { const bool sel = ((r >> 1) == g);
#pragma unroll
        for (int i = 0; i < 4; ++i) o[i] = sel ? res[g][i] : o[i]; }
#pragma unroll
    for (int i = 0; i < 4; ++i) o[i] += dpp_swap1(o[i]);
    if (r < 8 && (r & 1) == 0) { v2u w; w.x = pk2(o[0], o[1]); w.y = pk2(o[2], o[3]); *(v2u*)(HPt + (r >> 1) * 16 + 4 * kq) = w; }
}
__device__ __forceinline__ int pg_idx(const int* IDXl, int h, int hl) { h = min(h, hl); return IDXl[(size_t)(h >> 1) * 128 + (h & 1) * 64]; }
__device__ __forceinline__ void peer_u_wave(const Args& a, LAS unsigned char* wlds, LAS unsigned char* wsm, int slab, int t0, int ntok, int lane) {
    const unsigned char* U8 = a.ws + WS_PU + (size_t)slab * (16384 * 128);
    const bf16* N2 = (const bf16*)(a.ws + WS_N2) + slab * 256 + 4 * lane;
    const int* IDX = (const int*)(a.ws + WS_IDX) + (lane >> 3);
    bf16* HP = (bf16*)(a.ws + WS_HPART) + (size_t)slab * MTOK * 128;
    const int r = lane & 15, kq = lane >> 4, tl = t0 + ntok - 1, H0 = 2 * t0, HL = 2 * (t0 + ntok) - 1;
    PHalf d[4]; PIdx iv[4]; v4u bfr[2];
    const float* SSp = (const float*)(a.ws + WS_SS); float ssx = SSp[t0];
#pragma unroll
    for (int k = 0; k < 4; ++k) pg_idx8(IDX, H0 + k, HL, iv[k]);
    v2u xw = *(const v2u*)(N2 + (size_t)t0 * DM);
    pg_issue(U8, iv[0], lane, d[0]); pg_issue(U8, iv[1], lane, d[1]); pg_issue(U8, iv[2], lane, d[2]);
    pg_idx8(IDX, H0 + 4, HL, iv[0]); pg_idx8(IDX, H0 + 5, HL, iv[1]); pg_idx8(IDX, H0 + 6, HL, iv[2]);
    pg_stage(wlds, lane, d[0]);
#define PU_XPREP(tok) do { pu_xprep(wsm, xw, 2.05f * __builtin_amdgcn_rsqf(ssx * (1.f / DM) + EPS), lane); \
        { const LAS unsigned char* bp = wsm + ((r & 1) ? 128 : 0) + kq * 16; bfr[0] = *(const LAS v4u*)bp; bfr[1] = *(const LAS v4u*)(bp + 64); } \
        xw = *(const v2u*)(N2 + (size_t)min((tok) + 1, tl) * DM); ssx = SSp[min((tok) + 1, tl)]; } while (0)
#define PU_PHASE(ph, hrel, tok, half) do { \
        pg_issue(U8, iv[((ph) + 3) & 3], lane, d[((ph) + 3) & 3]); pg_idx8(IDX, hb + (hrel) + 7, HL, iv[((ph) + 3) & 3]); \
        pu_compute(wlds + ((half) ? 8192 : 0), HP + (size_t)(tok) * 128 + (half) * 64, r, kq, bfr); \
        pg_stage(wlds + ((half) ? 0 : 8192), lane, d[((ph) + 1) & 3]); } while (0)
#pragma unroll 1
    for (int hb = H0; hb <= HL; hb += 4) {
        const int t = hb >> 1;
        PU_XPREP(t);
        PU_PHASE(0, 0, t, 0);
        PU_PHASE(1, 1, t, 1);
        PU_XPREP(t + 1);
        PU_PHASE(2, 2, t + 1, 0);
        PU_PHASE(3, 3, t + 1, 1);
    }
#undef PU_XPREP
#undef PU_PHASE
}
__device__ __forceinline__ void peer_reduce(const Ctx& C, const Args& a) {
    const bf16* HP = (const bf16*)(a.ws + WS_HPART); const int* IDX = (const int*)(a.ws + WS_IDX); const float* WGT = (const float*)(a.ws + WS_WGT);
    const f32x2v* SC2 = (const f32x2v*)(a.ws + WS_PSC);
    unsigned char* ACT8 = a.ws + WS_ACT; float* ASC = (float*)(a.ws + WS_ACT + 8 * MiB);
    for (int it = C.vcu * 512 + C.tid; it < MTOK * 32; it += C.G * 512) {
        f32x4 h = {0.f, 0.f, 0.f, 0.f};
#pragma unroll
        for (int sl = 0; sl < 4; ++sl) { const v2u w = *(const v2u*)(HP + (size_t)sl * MTOK * 128 + (size_t)it * 4); h[0] += bflo(w.x); h[1] += bfhi(w.x); h[2] += bflo(w.y); h[3] += bfhi(w.y); }
        const int4 e = *(const int4*)(IDX + (size_t)it * 4); const f32x4 w = *(const f32x4*)(WGT + (size_t)it * 4);
        const int tok = it >> 5, q = it & 31;
        const float rs = 1.0f / 2.05f;
        f32x4 o;
        const f32x2v s0 = SC2[e.x], s1 = SC2[e.y], s2 = SC2[e.z], s3 = SC2[e.w];
        o[0] = gelu_tanh(h[0] * s0.x * rs) * w[0] * s0.y; o[1] = gelu_tanh(h[1] * s1.x * rs) * w[1] * s1.y;
        o[2] = gelu_tanh(h[2] * s2.x * rs) * w[2] * s2.y; o[3] = gelu_tanh(h[3] * s3.x * rs) * w[3] * s3.y;
        float mx = fmaxf(fmaxf(fabsf(o[0]), fabsf(o[1])), fmaxf(fabsf(o[2]), fabsf(o[3])));
#pragma unroll
        for (int sh = 1; sh < 32; sh <<= 1) mx = fmaxf(mx, __shfl_xor(mx, sh));
        const bool tiny = mx < 1e-30f;
        const float sc = tiny ? 1.f : 6.0f / mx, isc = tiny ? 1.f : mx * (1.0f / 6.0f);
        unsigned hi = 0u, lo = 0u;
#pragma unroll
        for (int j = 0; j < 4; ++j) { unsigned c0, c1; float v0, v1; e2m1_qv(o[j] * sc, c0, v0); e2m1_qv((o[j] * sc - v0) * 4.0f, c1, v1); hi |= c0 << (4 * j); lo |= c1 << (4 * j); }
        *(unsigned short*)(ACT8 + (size_t)tok * 128 + 2 * q) = (unsigned short)hi; *(unsigned short*)(ACT8 + (size_t)tok * 128 + 64 + 2 * q) = (unsigned short)lo;
        if (q == 0) ASC[tok] = isc;
    }
}
typedef int v2i_t __attribute__((ext_vector_type(2)));
__device__ __forceinline__ void pv_compute8(unsigned a0, unsigned a1, int nb0, const v4u bact, int sclB, f32x4 (&acc)[8]) {
    const v8i_t bv = {(int)bact.x, (int)bact.y, (int)bact.z, (int)bact.w, 0, 0, 0, 0};
    asm volatile("" : "+v"(a0), "+v"(a1));
#pragma unroll
    for (int nbi = 0; nbi < 8; ++nbi) {
        const unsigned x8 = (unsigned)(nb0 + nbi) * 8u;
        const v2i_t r0 = __builtin_amdgcn_ds_read_tr4_b64_v2i32((LAS v2i_t*)(a0 ^ x8)), r1 = __builtin_amdgcn_ds_read_tr4_b64_v2i32((LAS v2i_t*)(a1 ^ x8));
        const v8i_t av = {r0.x, r0.y, r1.x, r1.y, 0, 0, 0, 0};
        acc[nbi] = __builtin_amdgcn_mfma_scale_f32_16x16x128_f8f6f4(av, bv, (f32x4){0.f, 0.f, 0.f, 0.f}, 4, 4, 0, 0x7f7f7f7f, 0, sclB);
    }
}
__device__ __forceinline__ void peer_v_wave(const Args& a, LAS unsigned char* wlds, int slab, int t0, int ntok, int lane) {
    const unsigned char* V8 = a.ws + WS_PV + (size_t)slab * (16384 * 128);
    const int* IDX = (const int*)(a.ws + WS_IDX) + (lane >> 3);
    const int n16 = lane & 15, kq = lane >> 4, tl = t0 + ntok - 1, H0 = 2 * t0, HL = 2 * (t0 + ntok) - 1;
    const unsigned char* ACT4 = a.ws + WS_ACT + ((n16 & 1) ? 64 : 0) + 16 * kq; const float* ASC = (const float*)(a.ws + WS_ACT + 8 * MiB);
    const int sclB = (n16 & 1) ? 0x7d7d7d7d : 0x7f7f7f7f;
    const unsigned wl32 = (unsigned)(size_t)wlds;
    const unsigned ra0 = wl32 + (unsigned)((32 * kq + 16 * (kq & 1) + n16) * 128 + (n16 >> 1) * 16 + 8 * (kq & 1));
    const unsigned ra1 = wl32 + (unsigned)((32 * kq + 16 * (1 - (kq & 1)) + n16) * 128 + (n16 >> 1) * 16 + 8 * (1 - (kq & 1)));
    bf16* PO = (bf16*)(a.ws + WS_POUT) + slab * 256;
    PHalf d[4]; PIdx iv[4]; v4u bact, bnxt; f32x4 acc[8]; float isc = 1.f, iscn;
#pragma unroll
    for (int k = 0; k < 4; ++k) pg_idx8(IDX, H0 + k, HL, iv[k]);
    const int o0 = 8 * (kq & 1), o1 = 8 - o0;
    { const v2u b0 = *(const v2u*)(ACT4 + (size_t)t0 * 128 + o0), b1 = *(const v2u*)(ACT4 + (size_t)t0 * 128 + o1); bnxt = (v4u){b0.x, b0.y, b1.x, b1.y}; } iscn = ASC[t0];
    pg_issue(V8, iv[0], lane, d[0]); pg_issue(V8, iv[1], lane, d[1]); pg_issue(V8, iv[2], lane, d[2]); pg_issue(V8, iv[3], lane, d[3]);
#pragma unroll
    for (int k = 0; k < 4; ++k) pg_idx8(IDX, H0 + 4 + k, HL, iv[k]);
    pg_stage_v(wlds, lane, d[0]); pg_stage_v(wlds + 8192, lane, d[1]);
#define PV_EPI(tok, cb) do { f32x4 o = acc[0]; \
        _Pragma("unroll") for (int nb = 1; nb < 8; ++nb) { const bool sel = ((n16 >> 1) == nb); \
            _Pragma("unroll") for (int i = 0; i < 4; ++i) o[i] = sel ? acc[nb][i] : o[i]; } \
        _Pragma("unroll") for (int i = 0; i < 4; ++i) o[i] += dpp_swap1(o[i]); \
        if ((n16 & 1) == 0) { v2u w; w.x = pk2(o[0] * isc, o[1] * isc); w.y = pk2(o[2] * isc, o[3] * isc); *(v2u*)(PO + (size_t)(tok) * DM + (cb) + 16 * (n16 >> 1) + 4 * kq) = w; } } while (0)
#define PV_TOKEN(tok) do { bact = bnxt; isc = iscn; \
        { const int tn = min((tok) + 1, tl); const v2u b0 = *(const v2u*)(ACT4 + (size_t)tn * 128 + o0), b1 = *(const v2u*)(ACT4 + (size_t)tn * 128 + o1); bnxt = (v4u){b0.x, b0.y, b1.x, b1.y}; iscn = ASC[tn]; } \
        pv_compute8(ra0, ra1, 0, bact, sclB, acc); PV_EPI(tok, 0); \
        pv_compute8(ra0, ra1, 8, bact, sclB, acc); PV_EPI(tok, 128); } while (0)
#pragma unroll 1
    for (int t = t0; t <= tl; t += 2) {
        const int hb = 2 * t;
        pg_issue(V8, iv[0], lane, d[0]); pg_issue(V8, iv[1], lane, d[1]);
        pg_idx8(IDX, hb + 8, HL, iv[0]); pg_idx8(IDX, hb + 9, HL, iv[1]);
        PV_TOKEN(t);
        pg_stage_v(wlds, lane, d[2]); pg_stage_v(wlds + 8192, lane, d[3]);
        pg_issue(V8, iv[2], lane, d[2]); pg_issue(V8, iv[3], lane, d[3]);
        pg_idx8(IDX, hb + 10, HL, iv[2]); pg_idx8(IDX, hb + 11, HL, iv[3]);
        PV_TOKEN(t + 1);
        pg_stage_v(wlds, lane, d[0]); pg_stage_v(wlds + 8192, lane, d[1]);
    }
#undef PV_EPI
#undef PV_TOKEN
}
__device__ __forceinline__ void final_rows4(const Args& a, int tok0, int tstep, int lane) {
    const float* gf = (const float*)a.in[25] + lane * 4;
    f32x4 h[4][4]; v2u pw[4][4], hw[4][4]; float ss[4];
#pragma unroll
    for (int i = 0; i < 4; ++i) { const int tok = tok0 + i * tstep; const bf16* hb = (const bf16*)(a.ws + WS_N2) + (size_t)tok * DM + lane * 4; const bf16* po = (const bf16*)(a.ws + WS_POUT) + (size_t)tok * DM + lane * 4;
#pragma unroll
        for (int q = 0; q < 4; ++q) { hw[i][q] = *(const v2u*)(hb + 256 * q); pw[i][q] = *(const v2u*)(po + 256 * q); } }
#pragma unroll
    for (int i = 0; i < 4; ++i) { ss[i] = 0.f;
#pragma unroll
        for (int q = 0; q < 4; ++q) { h[i][q][0] = bflo(hw[i][q].x) + bflo(pw[i][q].x); h[i][q][1] = bfhi(hw[i][q].x) + bfhi(pw[i][q].x); h[i][q][2] = bflo(hw[i][q].y) + bflo(pw[i][q].y); h[i][q][3] = bfhi(hw[i][q].y) + bfhi(pw[i][q].y);
            ss[i] += (h[i][q][0] * h[i][q][0] + h[i][q][1] * h[i][q][1]) + (h[i][q][2] * h[i][q][2] + h[i][q][3] * h[i][q][3]); } }
#pragma unroll
    for (int o = 1; o < 64; o <<= 1)
#pragma unroll
        for (int i = 0; i < 4; ++i) ss[i] += __shfl_xor(ss[i], o);
    f32x4 g[4];
#pragma unroll
    for (int q = 0; q < 4; ++q) g[q] = *(const f32x4*)(gf + 256 * q);
#pragma unroll
    for (int i = 0; i < 4; ++i) { const float rstd = 1.0f / sqrtf(ss[i] * (1.f / DM) + EPS); float* orow = a.out + (size_t)(tok0 + i * tstep) * DM + lane * 4;
#pragma unroll
        for (int q = 0; q < 4; ++q) *(f32x4*)(orow + 256 * q) = h[i][q] * rstd * g[q]; }
}

__device__ __forceinline__ void claim_slab_unit(const Ctx& C, unsigned* ctl, int pass, volatile LAS unsigned* MISC, int& slab, int& unit) {
    if (C.tid == 0) {
        const unsigned ns = 4u, nu = 64u;
        const unsigned x = xb_xcc_id() & (ns - 1u); unsigned sl = 8u, un = 0u;
        for (unsigned k = 0; k < ns; ++k) { const unsigned s2 = (x + k) & (ns - 1u); const unsigned u2 = xb_add(ctl + CW_Q + 1024 * pass + 64 * s2, 1u); if (u2 < nu) { sl = s2; un = u2; break; } }
        MISC[16] = sl; MISC[17] = un;
    }
    __syncthreads();
    slab = (int)MISC[16]; unit = (int)MISC[17];
    __syncthreads();
}
__global__ void __launch_bounds__(NWAVES * 64, 2) mk_fwd(Args args) {
    extern __shared__ __attribute__((aligned(16))) unsigned char lds_raw[];
    Ctx C;
    C.lds = (LAS unsigned char*)lds_raw;
    C.wave = __builtin_amdgcn_readfirstlane((int)threadIdx.x >> 6); C.refresh();
    C.G = gridDim.x; { const int bx = blockIdx.x; C.vcu = (C.G % 8 == 0) ? (bx % 8) * (C.G / 8) + bx / 8 : bx; }
    volatile LAS unsigned* MISC = (volatile LAS unsigned*)(C.lds + MISC_OFF);
    if (C.tid < 128) MISC[C.tid] = 0u;
    __syncthreads();
    unsigned char* ws = args.ws;
    unsigned* ctl = (unsigned*)(ws + WS_CTL);
    XcdBarrier bar; bar.bar = ctl + CW_BAR; bar.x = 0; bar.st = nullptr;
#if !MK_PER_PHASE
    bar = xcd_barrier_post(ctl + CW_BAR, MISC + 8, C.tid == 0);
#define GRID_BAR() xcd_barrier(bar, C.wave)
#else
#define GRID_BAR() do { } while (0)
#endif
    const int lo = args.ph_lo, hi = args.ph_hi;
#define IN(k) (lo <= (k) && (k) < hi)
#define SEAM(k) do { if (IN((k) + 1)) GRID_BAR(); C.refresh(); } while (0)
#define REP(k) for (int rep_ = 0; rep_ < 1 + ((REPEAT_MASK >> (k)) & 1); ++rep_)
    bf16* XN = (bf16*)(ws + WS_A);
    if (IN(0)) { REP(0) { p0_prologue(C, args); __syncthreads(); } SEAM(0); }
    if (IN(1)) {
        REP(1) {
        run_gemm_i8(C, ws + WS_XN8, ws + WS_WIN8, MTOK, NZ1, DM, FStoreI8{(bf16*)(ws + WS_Z1), NZ1, (const float*)(ws + WS_RSX), (const float*)(ws + WS_CSW)});
        }
        SEAM(1);
    }
    if (IN(2)) {
        REP(2) { const int tile = C.vcu;
            {
                const int i_ = C.tid >> 2, dq_ = (C.tid & 3) * 16, eq_ = (C.tid & 3) * 32;
                const bf16* zr_ = (const bf16*)(ws + WS_Z1) + (size_t)(tile * 128 + i_) * NZ1; const float* rp_ = (const float*)(ws + WS_ROPE) + (size_t)(tile * 128 + i_) * 128;
                float cs_[16], sn_[16];
#pragma unroll
                for (int q = 0; q < 4; ++q) { const f32x4 c4 = *(const f32x4*)(rp_ + dq_ + 4 * q), s4 = *(const f32x4*)(rp_ + 64 + dq_ + 4 * q);
#pragma unroll
                    for (int e = 0; e < 4; ++e) { cs_[4 * q + e] = c4[e]; sn_[4 * q + e] = s4[e]; } }
                R1In ra_, rb_;
                r1_load(zr_, 0, dq_, eq_, ra_);
                _Pragma("unroll 1") for (int h2 = 0; h2 < 4; h2 += 2) {
                    r1_unit(C, args, tile, h2, cs_, sn_, ra_, rb_, true);
                    r1_unit(C, args, tile, h2 + 1, cs_, sn_, rb_, ra_, h2 == 0);
                }
            }
            C.refresh();
            _Pragma("unroll 1") for (int gi = 0; gi < 2; ++gi) s5a_wave(C, args, tile, C.wave + 8 * gi);
            __syncthreads();
        }
        SEAM(2);
    }
    if (IN(3)) { REP(3) { p3_scans(C, args); }
        run_gemm(C, (const bf16*)(ws + WS_MEMN), (const bf16*)(ws + WS_WMKV_T), MROWS, 512, DM, FKvm{(bf16*)(ws + WS_KM), (bf16*)(ws + WS_VT)});
        SEAM(3); }
    if (IN(4)) {
        REP(4) { const int tile = C.vcu;
            _Pragma("unroll 1") for (int gi = 0; gi < 2; ++gi) r3_wave(C, args, tile, 2 * gi + (C.wave >> 2), C.wave & 3);
            _Pragma("unroll 1") for (int gi = 0; gi < 2; ++gi) s5c_wave(C, args, tile, C.wave + 8 * gi);
            _Pragma("unroll 1") for (int gi = 0; gi < 2; ++gi) ma_wave(C, args, tile, 2 * gi + (C.wave >> 2), C.wave & 3);
        }
        SEAM(4);
    }
    if (IN(5)) {
        REP(5) {
        run_gemm_i8(C, ws + WS_XN8, ws + WS_WIN8 + (size_t)NZ1 * DM, MTOK, NGATE, DM, FSigI8{(bf16*)(ws + WS_G), NGATE, (const float*)(ws + WS_RSX), (const float*)(ws + WS_CSW) + NZ1});
        run_gemm(C, (const bf16*)(ws + WS_YG), (const bf16*)(ws + WS_WGLU_T), MTOK, 512, 256, FGlu{(bf16*)(ws + WS_YCAT)});
        }
        SEAM(5);
    }
    if (IN(6)) {
        const bf16* Gt = (const bf16*)(ws + WS_G);
        run_gemm_hook(C, (const bf16*)(ws + WS_YCAT), (const bf16*)(ws + WS_WCAT_T), MTOK, DM, DM, FGateOut{Gt, XN}, HookGate{Gt});
        SEAM(6);
    }
    if (IN(7)) { run_gemm(C, XN, (const bf16*)(ws + WS_WOUT_T), MTOK, DM, DM, FRes{(const float*)args.in[0], (bf16*)(ws + WS_N2), (float*)(ws + WS_SS)}); SEAM(7); }
    if (IN(9)) { REP(9) run_gemm(C, (const bf16*)(ws + WS_N2), (const bf16*)(ws + WS_WQ_T), MTOK, 2048, DM, FStoreRstd{(bf16*)(ws + WS_Q2), 2048, (const float*)(ws + WS_SS)}); SEAM(9); }
    if (IN(10)) {
        { const int tile = C.vcu;
            const int tokbase = tile * 128 + (C.wave & 3) * 32, h0 = (C.wave >> 2) * 4;
            REP(10) { _Pragma("unroll 1") for (int hp = h0; hp < h0 + 4; ++hp) peer_topk_head(C, args, tokbase, hp); }
        }
        SEAM(10);
    }
    if (IN(11)) { int slab, unit; claim_slab_unit(C, ctl, 0, MISC, slab, unit); if (slab < 8) { REP(11) peer_u_wave(args, C.lds + C.wave * 16384, C.lds + 131072 + C.wave * 1024, slab, unit * 512 + C.wave * 64, 64, C.lane); } SEAM(11); }
    if (IN(12)) { REP(12) peer_reduce(C, args); SEAM(12); }
    if (IN(13)) { int slab, unit; claim_slab_unit(C, ctl, 1, MISC, slab, unit); if (slab < 8) { REP(13) peer_v_wave(args, C.lds + C.wave * 16384, slab, unit * 512 + C.wave * 64, 64, C.lane); } SEAM(13); }
    if (IN(14)) {
        const int gw = C.vcu * NWAVES + C.wave, NGW = C.G * NWAVES;
        for (int m = gw; m < MTOK; m += 4 * NGW) final_rows4(args, m, NGW, C.lane);
    }
#undef IN
#undef SEAM
}

extern "C" void kernel_launch(void* const* d_in, const int* in_sizes, int n_in, void* d_out, int out_size, void* d_ws, size_t ws_size, hipStream_t stream) {
    static int grid = 0;
    if (grid == 0) {
        if (n_in != 26 || in_sizes[0] != MTOK * DM || out_size != MTOK * DM || ws_size < WS_END) {
            fprintf(stderr, "kernel_launch: unexpected problem (n_in %d, in0 %d, out %d, ws %zu < %zu); nothing launched\n", n_in, n_in > 0 ? in_sizes[0] : -1, out_size, ws_size, (size_t)WS_END); grid = -1; return; }
        int dev = 0, cus = 0;
        if (hipGetDevice(&dev) != hipSuccess || hipDeviceGetAttribute(&cus, hipDeviceAttributeMultiprocessorCount, dev) != hipSuccess) { grid = -1; return; }
        if (hipFuncSetAttribute((const void*)mk_fwd, hipFuncAttributeMaxDynamicSharedMemorySize, LDS_BYTES) != hipSuccess) { fprintf(stderr, "kernel_launch: hipFuncSetAttribute failed\n"); grid = -1; return; }
        (void)hipGetLastError();
        if (cus < NTILES) { fprintf(stderr, "kernel_launch: needs >= 256 CUs, got %d\n", cus); grid = -1; return; }
        grid = NTILES;
    }
    if (grid < 0) return;
    (void)hipMemsetAsync((char*)d_ws + WS_CTL, 0, CTL_ZERO_BYTES, stream);
    Args a{};
    for (int i = 0; i < 26; ++i) a.in[i] = d_in[i];
    a.out = (float*)d_out; a.ws = (unsigned char*)d_ws;
#if MK_PER_PHASE
    for (int p = 0; p < NPHASE; ++p) { a.ph_lo = p; a.ph_hi = p + 1; hipLaunchKernelGGL(mk_fwd, dim3(grid), dim3(NWAVES * 64), LDS_BYTES, stream, a); }
#else
    a.ph_lo = 0; a.ph_hi = NPHASE;
    hipLaunchKernelGGL(mk_fwd, dim3(grid), dim3(NWAVES * 64), LDS_BYTES, stream, a);
#endif
}
```

```cpp
#include <hip/hip_runtime.h>
#include <cstdio>
#include <cstdint>
namespace pg8 {
__device__ __forceinline__ int hw_lane_id() { int l; asm volatile("v_mbcnt_lo_u32_b32 %0, -1, 0\n\tv_mbcnt_hi_u32_b32 %0, -1, %0" : "=v"(l)); return l; }
#define PG8_LAS __attribute__((address_space(3)))
typedef unsigned short bf16_t;
typedef short bf16x8 __attribute__((ext_vector_type(8)));
typedef float f32x4 __attribute__((ext_vector_type(4)));
typedef unsigned u32x4 __attribute__((ext_vector_type(4)));
constexpr int BM = 256, BK = 64, HALF = 128, HTB = HALF * BK * 2  , STAGE_BYTES = 8 * HTB, NXCD = 8, WGM = 8;

__host__ __device__ __forceinline__ int lds_byte(int r, int c) { const int st = (r >> 4) * 2 + (c >> 5), rr = r & 15, cc = c & 31, ob = rr * 64 + cc * 2; return st * 1024 + (ob ^ (((ob >> 9) & 1) << 5)); }
__host__ __device__ __forceinline__ void stage_rc(int b, int& R, int& C) { const int st = b / 1024, sb = b % 1024, swz = sb ^ (((sb >> 9) & 1) << 5); R = (st >> 1) * 16 + swz / 64; C = (st & 1) * 32 + (swz % 64) / 2; }
__host__ __device__ __forceinline__ int perm32(int rho) { const int n = rho >> 4, i = rho & 15; return 8 * (i >> 2) + 4 * n + (i & 3); }

struct Unit { int pm, pn; };
struct Gemm { const bf16_t* A; const bf16_t* Bt; int M, N, K; };

struct StaticOrder {
    int nM, nN, nwg, G, c;
    __host__ __device__ void init(int M, int N, int G_, int c_) { nM = M / BM; nN = N / BM; nwg = nM * nN; G = G_; c = c_; }
    __host__ __device__ bool next(int i, Unit& u) const {
        const long L = (long)i * G + c; if (L >= nwg) return false;
        int wgid = (int)L; { const int q = nwg / NXCD, r = nwg % NXCD, xcd = wgid % NXCD, off = wgid / NXCD; wgid = (xcd < r ? xcd * (q + 1) : r * (q + 1) + (xcd - r) * q) + off; }
        const int nig = WGM * nN, gid = wgid / nig, fm = gid * WGM, gsz = (nM - fm) < WGM ? (nM - fm) : WGM;
        u.pm = fm + ((wgid % nig) % gsz); u.pn = (wgid % nig) / gsz; return true;
    }
    __device__ __forceinline__ void a_ready(const Unit&) const {}
    __device__ __forceinline__ void done(const Unit&) const {}
};

__device__ __forceinline__ unsigned cvt_pk_bf16(float lo, float hi) { unsigned r; asm volatile("v_cvt_pk_bf16_f32 %0, %1, %2" : "=v"(r) : "v"(lo), "v"(hi)); return r; }
struct NoKHook { __device__ __forceinline__ void operator()(int, f32x4 (&)[2][2][4][2], const Unit&, int, int, int, int) const {} };
template <class Epi, class Sched, bool ALIGN_EPI = false, bool SP2 = false, bool MX = false, class KHook = NoKHook, bool I8 = false>
__device__ __forceinline__ void gemm_phase(PG8_LAS unsigned char* lds, const Gemm g, const Sched& S, const Epi& E, const int wid, const int sclA = 0x7f7f7f7f, const int sclB = 0x7f7f7f7f, const KHook& KH = KHook()) {
    const int lane = hw_lane_id(), tid = wid * 64 + lane, wr = wid >> 2, wc = wid & 3, fr = lane & 15, fq = lane >> 4;
    const int K = g.K, nt = K / BK;
    unsigned voffA[2], voffB[2];
#pragma unroll
    for (int i = 0; i < 2; ++i) { int R, C; stage_rc(tid * 16 + i * 8192, R, C); const int Rb = Epi::PERM ? ((R & ~31) + perm32(R & 31)) : R;
        voffA[i] = (unsigned)(R * K + C) * 2u; voffB[i] = (unsigned)(Rb * K + C) * 2u; }
    const size_t kstep = (size_t)(BK * 2);
    const size_t hstep = (size_t)HALF * K * 2;
    const size_t tstep = 2 * hstep;
    const unsigned ldsw = (unsigned)wid * 1024u;
    const int aoff = lds_byte(wr * 64 + fr, fq * 8), boff = lds_byte(wc * 32 + fr, fq * 8);
#define PG8_SA(b, h) (((b) * 2 + (h)) * HTB)
#define PG8_SB(b, h) ((4 + (b) * 2 + (h)) * HTB)
#define PG8_STAGE(bufoff, gbase, voff) do { _Pragma("unroll") for (int _i = 0; _i < 2; ++_i) \
        __builtin_amdgcn_global_load_lds((const unsigned*)((const char*)(gbase) + (voff)[_i]), (PG8_LAS unsigned*)(lds + (bufoff) + ldsw + _i * 8192), 16, 0, 0); } while (0)
#define PG8_LDA(dst, b, h) do { _Pragma("unroll") for (int m = 0; m < 4; ++m) { \
        if constexpr (MX) { dst##8[m].lo = *(const PG8_LAS v4i_*)(lds + PG8_SA(b, h) + aoff + m * 2048); dst##8[m].hi = *(const PG8_LAS v4i_*)(lds + PG8_SA(b, h) + aoff + m * 2048 + 1024); } \
        else { _Pragma("unroll") for (int k = 0; k < 2; ++k) dst[m][k] = *(const PG8_LAS bf16x8*)(lds + PG8_SA(b, h) + aoff + m * 2048 + k * 1024); } } } while (0)
#define PG8_LDB(dst, b, h) do { _Pragma("unroll") for (int n = 0; n < 2; ++n) { \
        if constexpr (MX) { dst##8[n].lo = *(const PG8_LAS v4i_*)(lds + PG8_SB(b, h) + boff + n * 2048); dst##8[n].hi = *(const PG8_LAS v4i_*)(lds + PG8_SB(b, h) + boff + n * 2048 + 1024); } \
        else { _Pragma("unroll") for (int k = 0; k < 2; ++k) dst[n][k] = *(const PG8_LAS bf16x8*)(lds + PG8_SB(b, h) + boff + n * 2048 + k * 1024); } } } while (0)
#define PG8_MMA(ai, bj, At, Bt) do { __builtin_amdgcn_s_setprio(1); _Pragma("unroll") for (int m = 0; m < 4; ++m) _Pragma("unroll") for (int n = 0; n < 2; ++n) { \
        if constexpr (MX && I8) { v4i_ c_ = __builtin_bit_cast(v4i_, acc[ai][bj][m][n]); \
            c_ = __builtin_amdgcn_mfma_i32_16x16x64_i8(Bt##8[n].lo, At##8[m].lo, c_, 0, 0, 0); c_ = __builtin_amdgcn_mfma_i32_16x16x64_i8(Bt##8[n].hi, At##8[m].hi, c_, 0, 0, 0); \
            acc[ai][bj][m][n] = __builtin_bit_cast(f32x4, c_); } \
        else if constexpr (MX) acc[ai][bj][m][n] = __builtin_amdgcn_mfma_scale_f32_16x16x128_f8f6f4(Bt##8[n], At##8[m], acc[ai][bj][m][n], 0, 0, 0, sclB, 0, sclA); \
        else { _Pragma("unroll") for (int k = 0; k < 2; ++k) acc[ai][bj][m][n] = __builtin_amdgcn_mfma_f32_16x16x32_bf16(Bt[n][k], At[m][k], acc[ai][bj][m][n], 0, 0, 0); } } \
        if constexpr (MX) { _Pragma("unroll") for (int m = 0; m < 4; ++m) _Pragma("unroll") for (int n = 0; n < 2; ++n) asm volatile("" : "+v"(acc[ai][bj][m][n])); }     \
        __builtin_amdgcn_s_setprio(0); } while (0)
#define PG8_WAIT_V(n) asm volatile("s_waitcnt vmcnt(" #n ")" ::: "memory")
#define PG8_WAIT_L(n) asm volatile("s_waitcnt lgkmcnt(" #n ")" ::: "memory")
#define PG8_BAR __builtin_amdgcn_s_barrier()
#define PG8_SCHED __builtin_amdgcn_sched_barrier(0)
    Unit cur, nxt; int ui = 0;
    if (!S.next(0, cur)) return;
    f32x4 acc[2][2][4][2];
#pragma unroll
    for (int a = 0; a < 2; ++a)
#pragma unroll
        for (int b = 0; b < 2; ++b)
#pragma unroll
            for (int m = 0; m < 4; ++m)
#pragma unroll
                for (int n = 0; n < 2; ++n) acc[a][b][m][n] = (f32x4){0.f, 0.f, 0.f, 0.f};
    typedef int v8i_ __attribute__((ext_vector_type(8))); typedef int v4i_ __attribute__((ext_vector_type(4)));
    bf16x8 At[4][2], B0[2][2], B1[2][2]; v8i_ At8[4], B08[2], B18[2];
    const char* cA = (const char*)g.A + (size_t)cur.pm * tstep; const char* cB = (const char*)g.Bt + (size_t)cur.pn * tstep;
    S.a_ready(cur);
    if constexpr (SP2) {
        PG8_STAGE(PG8_SB(0, 0), cB, voffB); PG8_STAGE(PG8_SB(0, 1), cB + hstep, voffB); PG8_STAGE(PG8_SA(0, 0), cA, voffA); PG8_STAGE(PG8_SA(0, 1), cA + hstep, voffA);
        if (wr == 1) PG8_BAR;
        PG8_WAIT_V(2); PG8_BAR;
        PG8_STAGE(PG8_SB(1, 0), cB + kstep, voffB); PG8_STAGE(PG8_SA(1, 0), cA + kstep, voffA); PG8_STAGE(PG8_SB(1, 1), cB + hstep + kstep, voffB);
        PG8_WAIT_V(6); PG8_BAR;
    } else {
        PG8_STAGE(PG8_SB(0, 0), cB, voffB); PG8_STAGE(PG8_SA(0, 0), cA, voffA); PG8_STAGE(PG8_SB(0, 1), cB + hstep, voffB); PG8_STAGE(PG8_SA(0, 1), cA + hstep, voffA);
        if (wr == 1) PG8_BAR;
        PG8_WAIT_V(4); PG8_BAR;
        PG8_STAGE(PG8_SB(1, 0), cB + kstep, voffB); PG8_STAGE(PG8_SA(1, 0), cA + kstep, voffA); PG8_STAGE(PG8_SB(1, 1), cB + hstep + kstep, voffB);
        PG8_WAIT_V(6); PG8_BAR;
    }
    for (;;) {
        const bool has_next = S.next(ui + 1, nxt);
        const char* nA = has_next ? (const char*)g.A + (size_t)nxt.pm * tstep : cA; const char* nB = has_next ? (const char*)g.Bt + (size_t)nxt.pn * tstep : cB;
        for (int t = 0; t < nt; t += 2) {
            KH(t, acc, cur, wr, wc, fr, fq);
            const bool last = (t == nt - 2);
            const char* a1 = cA + (size_t)(t + 1) * kstep;
            const char* a2 = last ? nA : cA + (size_t)(t + 2) * kstep; const char* b2 = last ? nB : cB + (size_t)(t + 2) * kstep;
            const char* a3 = a2 + kstep; const char* b3 = b2 + kstep;
            if (last && has_next) S.a_ready(nxt);
            if constexpr (SP2) {
            PG8_LDB(B0, 0, 0); PG8_LDB(B1, 0, 1); PG8_SCHED; PG8_LDA(At, 0, 0); PG8_STAGE(PG8_SA(1, 1), a1 + hstep, voffA);
            PG8_WAIT_V(8); PG8_WAIT_L(0); PG8_BAR; PG8_MMA(0, 0, At, B0); PG8_MMA(0, 1, At, B1); PG8_BAR; PG8_SCHED;
            PG8_LDA(At, 0, 1); PG8_STAGE(PG8_SB(0, 0), b2, voffB); PG8_STAGE(PG8_SB(0, 1), b2 + hstep, voffB); PG8_STAGE(PG8_SA(0, 0), a2, voffA);
            PG8_WAIT_V(8); PG8_WAIT_L(0); PG8_BAR; PG8_MMA(1, 0, At, B0); PG8_MMA(1, 1, At, B1); PG8_BAR; PG8_SCHED;
            PG8_LDB(B0, 1, 0); PG8_LDB(B1, 1, 1); PG8_SCHED; PG8_LDA(At, 1, 0); PG8_STAGE(PG8_SA(0, 1), a2 + hstep, voffA);
            PG8_WAIT_V(8); PG8_WAIT_L(0); PG8_BAR; PG8_MMA(0, 0, At, B0); PG8_MMA(0, 1, At, B1); PG8_BAR; PG8_SCHED;
            PG8_LDA(At, 1, 1); PG8_STAGE(PG8_SB(1, 0), b3, voffB); PG8_STAGE(PG8_SB(1, 1), b3 + hstep, voffB); PG8_STAGE(PG8_SA(1, 0), a3, voffA);
            PG8_WAIT_V(8); PG8_WAIT_L(0); PG8_BAR; PG8_MMA(1, 0, At, B0); PG8_MMA(1, 1, At, B1); PG8_BAR; PG8_SCHED;
            } else {
            PG8_LDB(B0, 0, 0); PG8_SCHED; PG8_LDA(At, 0, 0); PG8_STAGE(PG8_SA(1, 1), a1 + hstep, voffA);
            PG8_WAIT_L(8); PG8_BAR; PG8_WAIT_L(0); PG8_MMA(0, 0, At, B0); PG8_BAR; PG8_SCHED;
            PG8_LDB(B1, 0, 1); PG8_STAGE(PG8_SB(0, 0), b2, voffB);
            PG8_BAR; PG8_WAIT_L(0); PG8_MMA(0, 1, At, B1); PG8_BAR;
            PG8_LDA(At, 0, 1); PG8_STAGE(PG8_SA(0, 0), a2, voffA);
            PG8_BAR; PG8_WAIT_L(0); PG8_MMA(1, 0, At, B0); PG8_BAR; PG8_SCHED;
            PG8_STAGE(PG8_SB(0, 1), b2 + hstep, voffB);
            PG8_WAIT_V(6); PG8_BAR; PG8_MMA(1, 1, At, B1); PG8_BAR;
            PG8_LDB(B0, 1, 0); PG8_SCHED; PG8_LDA(At, 1, 0); PG8_STAGE(PG8_SA(0, 1), a2 + hstep, voffA);
            PG8_WAIT_L(8); PG8_BAR; PG8_WAIT_L(0); PG8_MMA(0, 0, At, B0); PG8_BAR; PG8_SCHED;
            PG8_LDB(B1, 1, 1); PG8_STAGE(PG8_SB(1, 0), b3, voffB);
            PG8_BAR; PG8_WAIT_L(0); PG8_MMA(0, 1, At, B1); PG8_BAR;
            PG8_LDA(At, 1, 1); PG8_STAGE(PG8_SA(1, 0), a3, voffA);
            PG8_BAR; PG8_WAIT_L(0); PG8_MMA(1, 0, At, B0); PG8_BAR; PG8_SCHED;
            PG8_STAGE(PG8_SB(1, 1), b3 + hstep, voffB);
            PG8_WAIT_V(6); PG8_BAR; PG8_MMA(1, 1, At, B1); PG8_BAR;
            }
        }
        if constexpr (ALIGN_EPI) { if (wr == 0) PG8_BAR; }
        if constexpr (!Epi::AFTER_DRAIN) { E(acc, cur, wr, wc, fr, fq); S.done(cur); }
        if (!has_next) break;
#pragma unroll
        for (int a = 0; a < 2; ++a)
#pragma unroll
            for (int b = 0; b < 2; ++b)
#pragma unroll
                for (int m = 0; m < 4; ++m)
#pragma unroll
                    for (int n = 0; n < 2; ++n) acc[a][b][m][n] = (f32x4){0.f, 0.f, 0.f, 0.f};
        cur = nxt; cA = nA; cB = nB; ++ui;
        if constexpr (ALIGN_EPI) { if (wr == 1) PG8_BAR; }
    }
    PG8_WAIT_V(0);
    if constexpr (!ALIGN_EPI) { if (wr == 0) PG8_BAR; }
    PG8_BAR;
    if constexpr (Epi::AFTER_DRAIN) { E.fused(acc, cur, wr, wc, fr, fq, lds, wid, lane); S.done(cur); }
#undef PG8_SA
#undef PG8_SB
#undef PG8_STAGE
#undef PG8_LDA
#undef PG8_LDB
#undef PG8_MMA
#undef PG8_WAIT_V
#undef PG8_WAIT_L
#undef PG8_BAR
#undef PG8_SCHED
}
}

#ifndef REPEAT_MASK
#define REPEAT_MASK 0
#endif
#ifndef MK_PER_PHASE
#define MK_PER_PHASE 0
#endif

constexpr int DM = 1024, BATCH = 8, SEQ = 4096, MTOK = BATCH * SEQ;
constexpr int MEMLEN = 256, MROWS = BATCH * MEMLEN;
constexpr int NZ1 = 2560, NGATE = 3072;
constexpr int ZQ = 0, ZK = 512, ZV = 1024, ZGR = 1536, ZU = 2048, ZQM = 2304;
constexpr int NTILES = MTOK / 128;
constexpr float EPS = 1e-6f;
constexpr int NPHASE = 15;

constexpr size_t MiB = 1u << 20;
constexpr size_t WS_CTL = 0, CTL_ZERO_BYTES = 1 * MiB;
constexpr size_t WS_WIN_T = 1 * MiB;
constexpr size_t WS_WQ_T = 12 * MiB;
constexpr size_t WS_WOUT_T = 16 * MiB;
constexpr size_t WS_WCAT_T = 18 * MiB;
constexpr size_t WS_WGLU_T = 20 * MiB;
constexpr size_t WS_WMKV_T = 21 * MiB;
constexpr size_t WS_KEYS = 22 * MiB;
constexpr size_t WS_S5MAT = 23 * MiB;
constexpr size_t WS_S5C = 25 * MiB;
constexpr size_t WS_PSC = 25 * MiB + 256 * 1024;
constexpr size_t WS_CSW = 25 * MiB + 128 * 1024;
constexpr size_t WS_RSX = 25 * MiB + 768 * 1024;
constexpr size_t WS_WIN8 = 50 * MiB;
constexpr size_t WS_SS = 25 * MiB + 512 * 1024;
constexpr size_t WS_ROPE = 26 * MiB;
constexpr size_t WS_PU = 42 * MiB;
constexpr size_t WS_PV = 58 * MiB;
constexpr size_t WS_XN8 = 74 * MiB;
constexpr size_t WS_WG8 = WS_WIN_T + 5 * MiB;
constexpr size_t WS_MEMN = 106 * MiB;
constexpr size_t WS_KM = 110 * MiB;
constexpr size_t WS_VT = 111 * MiB;
constexpr size_t WS_S5E = 112 * MiB;
constexpr size_t WS_S5X = 114 * MiB;
constexpr size_t WS_A = 116 * MiB;
constexpr size_t WS_B = 180 * MiB;
constexpr size_t WS_Z1 = WS_B;
constexpr size_t WS_G = WS_B;
constexpr size_t WS_QRF = WS_B + 160 * MiB;
constexpr size_t WS_YCAT = WS_B + 192 * MiB;
constexpr size_t WS_YG = WS_B + 256 * MiB;
constexpr size_t WS_INNER = WS_B + 272 * MiB;
constexpr size_t WS_N2 = WS_B;
constexpr size_t WS_Q2 = WS_B + 64 * MiB;
constexpr size_t WS_IDX = WS_B + 192 * MiB;
constexpr size_t WS_WGT = WS_B + 208 * MiB;
constexpr size_t WS_HPART = WS_B + 128 * MiB;
constexpr size_t WS_ACT = WS_B + 224 * MiB;
constexpr size_t WS_POUT = WS_B + 64 * MiB;
constexpr size_t WS_END = WS_B + 304 * MiB;

constexpr int CW_BAR = 4096;
constexpr int CW_Q = 8192;

constexpr int LDS_BYTES = 147456;
constexpr int MISC_OFF = LDS_BYTES - 512;
constexpr int NWAVES = 8;

#define GAS __attribute__((address_space(1)))
#define LAS __attribute__((address_space(3)))
typedef unsigned short bf16;
typedef unsigned v4u __attribute__((ext_vector_type(4)));
typedef unsigned v2u __attribute__((ext_vector_type(2)));
typedef float f32x4 __attribute__((ext_vector_type(4)));
typedef float f32x16 __attribute__((ext_vector_type(16)));
typedef short bf16x8 __attribute__((ext_vector_type(8)));
typedef GAS unsigned gu32;
#define RLX_AGENT __ATOMIC_RELAXED, __HIP_MEMORY_SCOPE_AGENT
#define LDS_WAIT() asm volatile("s_waitcnt lgkmcnt(0)" ::: "memory")
#define VM_WAIT() asm volatile("s_waitcnt vmcnt(0)" ::: "memory")
__device__ __forceinline__ unsigned f2bf(float f) { unsigned u = __builtin_bit_cast(unsigned, f); return (u + 0x7fffu + ((u >> 16) & 1u)) >> 16; }
typedef __bf16 hwbf16x2_t __attribute__((ext_vector_type(2)));
typedef float hwf32x2_t __attribute__((ext_vector_type(2)));
__device__ __forceinline__ unsigned pk2(float lo, float hi) { const hwf32x2_t v = {lo, hi}; const hwbf16x2_t b = __builtin_convertvector(v, hwbf16x2_t); return __builtin_bit_cast(unsigned, b); }
__device__ __forceinline__ float bflo(unsigned w) { return __builtin_bit_cast(float, w << 16); }
__device__ __forceinline__ float bfhi(unsigned w) { return __builtin_bit_cast(float, w & 0xffff0000u); }
__device__ __forceinline__ float bf2f(bf16 h) { return __builtin_bit_cast(float, (unsigned)h << 16); }
__device__ __forceinline__ f32x16 mfma32(bf16x8 a, bf16x8 b, f32x16 c) { return __builtin_amdgcn_mfma_f32_32x32x16_bf16(a, b, c, 0, 0, 0); }
__device__ __forceinline__ f32x4 mfma16(bf16x8 a, bf16x8 b, f32x4 c) { return __builtin_amdgcn_mfma_f32_16x16x32_bf16(a, b, c, 0, 0, 0); }
__device__ __forceinline__ bf16x8 mk8(unsigned a, unsigned b, unsigned c, unsigned d) { v4u t = {a, b, c, d}; return __builtin_bit_cast(bf16x8, t); }
__device__ __forceinline__ float sigmoidf_(float x) { return __builtin_amdgcn_rcpf(1.0f + __builtin_amdgcn_exp2f(-1.4426950408889634f * x)); }
__device__ __forceinline__ float gelu_tanh(float x) {
    const float u2 = 1.5957691216057308f * (x + 0.044715f * x * x * x);
    return x * __builtin_amdgcn_rcpf(1.0f + __builtin_amdgcn_exp2f(-1.4426950408889634f * u2));
}
__device__ __forceinline__ float wave_sum(float v) {
#pragma unroll
    for (int o = 1; o < 64; o <<= 1) v += __shfl_xor(v, o);
    return v;
}

#define XB_TMO      128
#define XB_XCNT(j)  (256  + 64 * (j))
#define XB_XSUB(j)  (1280 + 64 * (j))
#define XB_XGEN(j)  (2304 + 64 * (j))
#define XB_TOP      3328
#define XB_TOPGEN   3392
#define XCD_BAR_WORDS 3456
#define XB_SPIN_CAP (1u << 22)

__device__ __forceinline__ unsigned xb_ld(unsigned* p)              { return __hip_atomic_load(p, __ATOMIC_RELAXED, __HIP_MEMORY_SCOPE_AGENT); }
__device__ __forceinline__ unsigned xb_add(unsigned* p, unsigned v) { return __hip_atomic_fetch_add(p, v, __ATOMIC_RELAXED, __HIP_MEMORY_SCOPE_AGENT); }
__device__ __forceinline__ unsigned xb_xcc_id() { return (unsigned)__builtin_amdgcn_s_getreg((3 << 11) | 20) & 0xFu; }
#define XB_SPIN(cond, bar) do { unsigned _sp = 0; while (cond) { __builtin_amdgcn_s_sleep(1); \
    if ((++_sp & 255u) == 0u) { if (xb_ld(&(bar)[XB_TMO])) break; if (_sp > XB_SPIN_CAP) { atomicAdd(&(bar)[XB_TMO], 1u); break; } } } } while (0)

struct XcdBarrier { unsigned* bar; unsigned x; volatile LAS unsigned* st; };

__device__ __forceinline__ XcdBarrier xcd_barrier_post(unsigned* bar, volatile LAS unsigned* st, bool tid0) {
    XcdBarrier b; b.bar = bar; b.x = xb_xcc_id(); b.st = st;
    if (tid0) (void)xb_add(&bar[XB_XCNT(b.x)], 1u);
    return b;
}
__device__ __forceinline__ void xcd_barrier_complete(unsigned* bar, unsigned x, unsigned& nloc, unsigned& nx) {
    const unsigned G = gridDim.x * gridDim.y * gridDim.z;
    unsigned sum, cnt, mine, sp = 0u;
    for (;;) {
        sum = 0u; cnt = 0u; mine = 0u;
#pragma unroll
        for (unsigned j = 0; j < 16; ++j) { const unsigned c = xb_ld(&bar[XB_XCNT(j)]); sum += c; cnt += (c > 0u) ? 1u : 0u; mine = (j == x) ? c : mine; }
        if (sum == G) break;
        __builtin_amdgcn_s_sleep(1);
        if ((++sp & 255u) == 0u) { if (xb_ld(&bar[XB_TMO])) break; if (sp > XB_SPIN_CAP) { atomicAdd(&bar[XB_TMO], 1u); break; } }
    }
    nloc = mine > 0u ? mine : 1u; nx = cnt > 0u ? cnt : 1u;
}
__device__ __forceinline__ void xcd_barrier(const XcdBarrier& b, int wave) {
    asm volatile("s_waitcnt vmcnt(0)" ::: "memory");
    __syncthreads();
    if (wave == 0 && pg8::hw_lane_id() == 0) {
        unsigned* bar = b.bar;
        __builtin_amdgcn_s_waitcnt(0);
        unsigned nloc = b.st[0], nx = b.st[1];
        if (nloc == 0u) { xcd_barrier_complete(bar, b.x, nloc, nx); b.st[0] = nloc; b.st[1] = nx; }
        const unsigned old = xb_add(&bar[XB_XSUB(b.x)], 1u);
        const unsigned gen = old / nloc;
        if (old + 1u == (gen + 1u) * nloc) {
            __builtin_amdgcn_fence(__ATOMIC_RELEASE, "agent");
            asm volatile("s_waitcnt vmcnt(0)" ::: "memory");
            const unsigned og = xb_add(&bar[XB_TOP], 1u);
            const unsigned tg = og / nx;
            if (og + 1u == (tg + 1u) * nx) xb_add(&bar[XB_TOPGEN], 1u);
            else XB_SPIN(xb_ld(&bar[XB_TOPGEN]) == tg, bar);
            __builtin_amdgcn_fence(__ATOMIC_ACQUIRE, "agent");
            xb_add(&bar[XB_XGEN(b.x)], 1u);
            asm volatile("s_waitcnt vmcnt(0)" ::: "memory");
        } else {
            XB_SPIN(xb_ld(&bar[XB_XGEN(b.x)]) == gen, bar);
            __builtin_amdgcn_fence(__ATOMIC_ACQUIRE, "agent");
            asm volatile("s_waitcnt vmcnt(0)" ::: "memory");
        }
    }
    __syncthreads();
}

__host__ __device__ __forceinline__ int frag32(int row, int k, int K) { return (((row >> 5) * (K >> 4) + (k >> 4)) * 64 + ((k >> 3) & 1) * 32 + (row & 31)) * 8 + (k & 7); }
__host__ __device__ __forceinline__ int frag16(int n, int k, int K) { return (((n >> 4) * (K >> 5) + (k >> 5)) * 64 + ((k >> 3) & 3) * 16 + (n & 15)) * 8 + (k & 7); }
struct Args { const void* in[26]; float* out; unsigned char* ws; int ph_lo, ph_hi; };
struct Ctx {
    LAS unsigned char* lds;
    int tid, lane, wave, vcu, G;
    __device__ __forceinline__ void refresh() { lane = pg8::hw_lane_id(); tid = wave * 64 + lane; }
};

template <class F> struct EpiT {
    static constexpr bool PERM = true, AFTER_DRAIN = false;
    F f;
    __device__ __forceinline__ void operator()(const f32x4 (&acc)[2][2][4][2], const pg8::Unit& u, int wr, int wc, int fr, int fq) const {
        const int row0 = u.pm * 256 + wr * 64 + fr, col0 = u.pn * 256 + wc * 32 + 8 * fq;
        typename F::L cur[2], nxt[2];
        f.load(row0, col0, cur[0]); f.load(row0, col0 + 128, cur[1]);
#pragma unroll
        for (int i = 0; i < 8; ++i) {
            const int ai = i >> 2, m = i & 3, row = row0 + ai * 128 + m * 16;
            if (i < 7) { const int rown = row0 + ((i + 1) >> 2) * 128 + ((i + 1) & 3) * 16; f.load(rown, col0, nxt[0]); f.load(rown, col0 + 128, nxt[1]); }
            __builtin_amdgcn_sched_barrier(0);
            f.apply(row, col0, acc[ai][0][m][0], acc[ai][0][m][1], cur[0]); f.apply(row, col0 + 128, acc[ai][1][m][0], acc[ai][1][m][1], cur[1]);
            __builtin_amdgcn_sched_barrier(0);
            cur[0] = nxt[0]; cur[1] = nxt[1];
        }
    }
};
__device__ __forceinline__ v4u pack8(f32x4 a, f32x4 b) { v4u w; w.x = pk2(a[0], a[1]); w.y = pk2(a[2], a[3]); w.z = pk2(b[0], b[1]); w.w = pk2(b[2], b[3]); return w; }
struct LNone {};
struct FStore { typedef LNone L; bf16* O; int ldc;
    __device__ __forceinline__ void load(int, int, L&) const {}
    __device__ __forceinline__ void apply(int row, int col, f32x4 v0, f32x4 v1, const L&) const { *(v4u*)(O + (size_t)row * ldc + col) = pack8(v0, v1); } };
struct FKvm { typedef LNone L; bf16* KM; bf16* VT;
    __device__ __forceinline__ void load(int, int, L&) const {}
    __device__ __forceinline__ void apply(int row, int col, f32x4 v0, f32x4 v1, const L&) const {
        const int b = row >> 8, m = row & 255;
        if (col < 256) { const int hm = col >> 6, d0 = col & 63; *(v4u*)(KM + (size_t)(b * 4 + hm) * 16384 + frag32(m, d0, 64)) = pack8(v0, v1); }
        else { const int c = col - 256, hm = c >> 6, e0 = c & 63, mt = m >> 5, s2 = (m >> 4) & 1, w = m & 15, hh = (w >> 2) & 1, j = ((w >> 3) << 2) | (w & 3);
            bf16* p = VT + (size_t)(b * 4 + hm) * 16384 + ((mt * 2 + s2) * 64 + hh * 32) * 8 + j;
#pragma unroll
            for (int jj = 0; jj < 8; ++jj) { const int e = e0 + jj; p[((e >> 5) * 16 * 64 + (e & 31)) * 8] = (bf16)f2bf(jj < 4 ? v0[jj] : v1[jj - 4]); } }
    } };
struct FSig { typedef LNone L; bf16* O; int ldc;
    __device__ __forceinline__ void load(int, int, L&) const {}
    __device__ __forceinline__ void apply(int row, int col, f32x4 v0, f32x4 v1, const L&) const {
#pragma unroll
        for (int j = 0; j < 4; ++j) { v0[j] = sigmoidf_(v0[j]); v1[j] = sigmoidf_(v1[j]); }
        *(v4u*)(O + (size_t)row * ldc + col) = pack8(v0, v1); } };
struct FGlu { typedef LNone L; bf16* O;
    __device__ __forceinline__ void load(int, int, L&) const {}
    __device__ __forceinline__ void apply(int row, int col, f32x4 v0, f32x4 v1, const L&) const {
        v2u w; w.x = pk2(v0[0] * sigmoidf_(v1[0]), v0[1] * sigmoidf_(v1[1])); w.y = pk2(v0[2] * sigmoidf_(v1[2]), v0[3] * sigmoidf_(v1[3]));
        *(v2u*)(O + (size_t)row * 1024 + 512 + (col >> 1)) = w; } };
#define UB0(x) ((float)((x) & 0xffu))
#define UB1(x) ((float)(((x) >> 8) & 0xffu))
#define UB2(x) ((float)(((x) >> 16) & 0xffu))
#define UB3(x) ((float)((x) >> 24))
__device__ __forceinline__ void mul8(f32x4& v0, f32x4& v1, const v2u num, const v2u den) {
    v0[0] *= UB0(num.x) * __builtin_amdgcn_rcpf(UB0(den.x)); v0[1] *= UB1(num.x) * __builtin_amdgcn_rcpf(UB1(den.x));
    v0[2] *= UB2(num.x) * __builtin_amdgcn_rcpf(UB2(den.x)); v0[3] *= UB3(num.x) * __builtin_amdgcn_rcpf(UB3(den.x));
    v1[0] *= UB0(num.y) * __builtin_amdgcn_rcpf(UB0(den.y)); v1[1] *= UB1(num.y) * __builtin_amdgcn_rcpf(UB1(den.y));
    v1[2] *= UB2(num.y) * __builtin_amdgcn_rcpf(UB2(den.y)); v1[3] *= UB3(num.y) * __builtin_amdgcn_rcpf(UB3(den.y));
}
struct HookGate { const unsigned char* Gt;
    __device__ __forceinline__ void operator()(int t, f32x4 (&acc)[2][2][4][2], const pg8::Unit& u, int wr, int wc, int fr, int fq) const {
        if (t != 8 && t != 12) return;
        const int gn = (t == 8) ? 0 : 1024, gd = gn + 1024;
        int row0 = u.pm * 256 + wr * 64 + fr, col0 = u.pn * 256 + wc * 32 + 8 * fq;
        asm volatile("" : "+v"(row0), "+v"(col0));
        v2u nn[2][4][2], dd[2][4][2];
#pragma unroll
        for (int ai = 0; ai < 2; ++ai)
#pragma unroll
            for (int m = 0; m < 4; ++m) { const unsigned char* gp = Gt + (size_t)(row0 + ai * 128 + m * 16) * NGATE + col0;
                nn[ai][m][0] = *(const v2u*)(gp + gn); dd[ai][m][0] = *(const v2u*)(gp + gd); nn[ai][m][1] = *(const v2u*)(gp + gn + 128); dd[ai][m][1] = *(const v2u*)(gp + gd + 128); }
        __builtin_amdgcn_sched_barrier(0);
#pragma unroll
        for (int ai = 0; ai < 2; ++ai)
#pragma unroll
            for (int m = 0; m < 4; ++m) { mul8(acc[ai][0][m][0], acc[ai][0][m][1], nn[ai][m][0], dd[ai][m][0]); mul8(acc[ai][1][m][0], acc[ai][1][m][1], nn[ai][m][1], dd[ai][m][1]); }
        __builtin_amdgcn_sched_barrier(0);
    } };
struct LGate { v2u g; };
struct FGateOut { typedef LGate L; const unsigned char* Gt; bf16* MB;
    __device__ __forceinline__ void load(int row, int col, L& l) const { l.g = *(const v2u*)(Gt + (size_t)row * NGATE + 2048 + col); }
    __device__ __forceinline__ void apply(int row, int col, f32x4 v0, f32x4 v1, const L& l) const {
        const v2u g = l.g; const float k = 1.0f / 255.0f;
        v0[0] *= UB0(g.x) * k; v0[1] *= UB1(g.x) * k; v0[2] *= UB2(g.x) * k; v0[3] *= UB3(g.x) * k; v1[0] *= UB0(g.y) * k; v1[1] *= UB1(g.y) * k; v1[2] *= UB2(g.y) * k; v1[3] *= UB3(g.y) * k;
        *(v4u*)(MB + (size_t)row * DM + col) = pack8(v0, v1); } };
struct LRes { f32x4 x0, x1; };
struct FRes { typedef LRes L; const float* X; bf16* HB; float* SS;
    __device__ __forceinline__ void load(int row, int col, L& l) const { const float* xp = X + (size_t)row * DM + col; l.x0 = *(const f32x4*)xp; l.x1 = *(const f32x4*)(xp + 4); }
    __device__ __forceinline__ void apply(int row, int col, f32x4 v0, f32x4 v1, const L& l) const {
        v0 += l.x0; v1 += l.x1;
        *(v4u*)(HB + (size_t)row * DM + col) = pack8(v0, v1);
        float q = (v0[0] * v0[0] + v0[1] * v0[1]) + (v0[2] * v0[2] + v0[3] * v0[3]) + (v1[0] * v1[0] + v1[1] * v1[1]) + (v1[2] * v1[2] + v1[3] * v1[3]);
        q += __shfl_xor(q, 16); q += __shfl_xor(q, 32);
        if (pg8::hw_lane_id() < 16) atomicAdd(SS + row, q); } };
struct LRstd { float ss; };
struct FStoreRstd { typedef LRstd L; bf16* O; int ldc; const float* SS;
    __device__ __forceinline__ void load(int row, int, L& l) const { l.ss = SS[row]; }
    __device__ __forceinline__ void apply(int row, int col, f32x4 v0, f32x4 v1, const L& l) const {
        const float rs = __builtin_amdgcn_rsqf(l.ss * (1.f / DM) + EPS);
        *(v4u*)(O + ((((size_t)(row >> 5) * 16 + (col >> 7)) * 8 + ((col & 127) >> 4)) * 64 + ((col >> 3) & 1) * 32 + (row & 31)) * 8) = pack8(v0 * rs, v1 * rs); } };

template <class F>
__device__ __forceinline__ void run_gemm(const Ctx& C, const bf16* A, const bf16* Bt, int M, int N, int K, const F& f) {
    pg8::Gemm g{A, Bt, M, N, K}; pg8::StaticOrder S; S.init(M, N, C.G, (int)blockIdx.x);
    EpiT<F> E{f};
    pg8::gemm_phase<EpiT<F>, pg8::StaticOrder, true, true>(C.lds, g, S, E, C.wave);
}

template <class F, class H>
__device__ __forceinline__ void run_gemm_hook(const Ctx& C, const bf16* A, const bf16* Bt, int M, int N, int K, const F& f, const H& h) {
    pg8::Gemm g{A, Bt, M, N, K}; pg8::StaticOrder S; S.init(M, N, C.G, (int)blockIdx.x);
    EpiT<F> E{f};
    pg8::gemm_phase<EpiT<F>, pg8::StaticOrder, true, true, false, H>(C.lds, g, S, E, C.wave, 0x7f7f7f7f, 0x7f7f7f7f, h);
}
template <class F>
__device__ __forceinline__ void run_gemm_mx(const Ctx& C, const unsigned char* A8, const unsigned char* Bt8, int M, int N, int Kbytes, const F& f, int sclA, int sclB) {
    pg8::Gemm g{(const bf16*)A8, (const bf16*)Bt8, M, N, Kbytes / 2}; pg8::StaticOrder S; S.init(M, N, C.G, (int)blockIdx.x);
    EpiT<F> E{f};
    pg8::gemm_phase<EpiT<F>, pg8::StaticOrder, true, true, true>(C.lds, g, S, E, C.wave, sclA, sclB);
}

template <class F>
__device__ __forceinline__ void run_gemm_i8(const Ctx& C, const unsigned char* A8, const unsigned char* Bt8, int M, int N, int Kbytes, const F& f) {
    pg8::Gemm g{(const bf16*)A8, (const bf16*)Bt8, M, N, Kbytes / 2}; pg8::StaticOrder S; S.init(M, N, C.G, (int)blockIdx.x);
    EpiT<F> E{f};
    pg8::gemm_phase<EpiT<F>, pg8::StaticOrder, true, true, true, pg8::NoKHook, true>(C.lds, g, S, E, C.wave);
}
struct LI8 { float rs; f32x4 c0, c1; };
__device__ __forceinline__ void deq8(f32x4& v0, f32x4& v1, const LI8& l) {
#pragma unroll
    for (int j = 0; j < 4; ++j) { const float a = v0[j], b = v1[j];
        v0[j] = (float)__builtin_bit_cast(int, a) * (l.rs * l.c0[j]); v1[j] = (float)__builtin_bit_cast(int, b) * (l.rs * l.c1[j]); }
}
struct FStoreI8 { typedef LI8 L; bf16* O; int ldc; const float* RS; const float* CS;
    __device__ __forceinline__ void load(int row, int col, L& l) const { l.rs = RS[row]; l.c0 = *(const f32x4*)(CS + col); l.c1 = *(const f32x4*)(CS + col + 4); }
    __device__ __forceinline__ void apply(int row, int col, f32x4 v0, f32x4 v1, const L& l) const { deq8(v0, v1, l); *(v4u*)(O + (size_t)row * ldc + col) = pack8(v0, v1); } };
__device__ __forceinline__ unsigned gate_code(float z) { return (unsigned)fmaxf(rintf(255.0f * sigmoidf_(z)), 1.0f); }
struct FSigI8 { typedef LI8 L; unsigned char* O; int ldc; const float* RS; const float* CS;
    __device__ __forceinline__ void load(int row, int col, L& l) const { l.rs = RS[row]; l.c0 = *(const f32x4*)(CS + col); l.c1 = *(const f32x4*)(CS + col + 4); }
    __device__ __forceinline__ void apply(int row, int col, f32x4 v0, f32x4 v1, const L& l) const {
        deq8(v0, v1, l);
        v2u w; w.x = gate_code(v0[0]) | (gate_code(v0[1]) << 8) | (gate_code(v0[2]) << 16) | (gate_code(v0[3]) << 24); w.y = gate_code(v1[0]) | (gate_code(v1[1]) << 8) | (gate_code(v1[2]) << 16) | (gate_code(v1[3]) << 24);
        *(v2u*)(O + (size_t)row * ldc + col) = w; } };

__device__ __forceinline__ unsigned q_e2m1(float y) {
    const float m = fabsf(y);
    const unsigned c = (unsigned)(m > 0.25f) + (unsigned)(m > 0.75f) + (unsigned)(m > 1.25f) + (unsigned)(m > 1.75f) + (unsigned)(m > 2.5f) + (unsigned)(m > 3.5f) + (unsigned)(m > 5.0f);
    return c | ((__builtin_bit_cast(unsigned, y) >> 28) & 8u);
}
template <bool GLU>
__device__ __forceinline__ void p0_transpose_item(const float* W, int K, int N, bf16* WT, LAS float* scr, int item, int lane, const float* kscale = nullptr, int ldk = 0, int koff = 0) {
    if (ldk == 0) ldk = K;
    const int nblk = N / 32, kb = item / nblk, nb = item % nblk, k0 = 64 * kb, n0 = 32 * nb;
#pragma unroll 8
    for (int i = 0; i < 32; ++i) { const int kk = 2 * i + (lane >> 5); float w = W[(size_t)(k0 + kk) * N + n0 + (lane & 31)]; if (kscale) w *= kscale[k0 + kk]; scr[kk * 33 + (lane & 31)] = w; }
    LDS_WAIT(); asm volatile("" ::: "memory");
    const int c = lane & 7;
#pragma unroll
    for (int j = 0; j < 4; ++j) { const int n = (lane >> 3) + 8 * j; const LAS float* s = scr + (8 * c) * 33 + n;
        v4u o; o.x = pk2(s[0 * 33], s[1 * 33]); o.y = pk2(s[2 * 33], s[3 * 33]); o.z = pk2(s[4 * 33], s[5 * 33]); o.w = pk2(s[6 * 33], s[7 * 33]);
        const int nn = n0 + n; int row = nn;
        if (GLU) { const int jc = nn & 255, gate = nn >> 8; row = 8 * (jc >> 2) + 4 * gate + (jc & 3); }
        *(GAS v4u*)(WT + (size_t)row * ldk + koff + k0 + 8 * c) = o; }
    LDS_WAIT(); asm volatile("" ::: "memory");
}
__device__ __forceinline__ void p0_transpose_item_fp8(const float* W, int K, int N, unsigned char* WT8, int nsub, LAS float* scr, int item, int lane, float scale) {
    const int nblk = N / 32, kb = item / nblk, nb = item % nblk, k0 = 64 * kb, n0 = 32 * nb;
#pragma unroll 8
    for (int i = 0; i < 32; ++i) { const int kk = 2 * i + (lane >> 5); scr[kk * 33 + (lane & 31)] = W[(size_t)(k0 + kk) * N + n0 + (lane & 31)] * scale; }
    LDS_WAIT(); asm volatile("" ::: "memory");
    const int c = lane & 7;
#pragma unroll
    for (int j = 0; j < 4; ++j) { const int n = (lane >> 3) + 8 * j; const LAS float* sp = scr + (8 * c) * 33 + n;
        int p0 = __builtin_amdgcn_cvt_pk_fp8_f32(sp[0 * 33], sp[1 * 33], 0, false); p0 = __builtin_amdgcn_cvt_pk_fp8_f32(sp[2 * 33], sp[3 * 33], p0, true);
        int p1 = __builtin_amdgcn_cvt_pk_fp8_f32(sp[4 * 33], sp[5 * 33], 0, false); p1 = __builtin_amdgcn_cvt_pk_fp8_f32(sp[6 * 33], sp[7 * 33], p1, true);
        v2u o; o.x = (unsigned)p0; o.y = (unsigned)p1;
        *(GAS v2u*)(WT8 + (size_t)(n0 + n - nsub) * K + k0 + 8 * c) = o; }
    LDS_WAIT(); asm volatile("" ::: "memory");
}
template <int NR>
__device__ __forceinline__ void rms_rows_to_bf16(const float* xbase, const float* gain, bf16* obase, int m0, int mstep, int lane, unsigned char* o8base = nullptr) {
    f32x4 v[NR][4]; float s[NR];
#pragma unroll
    for (int i = 0; i < NR; ++i) { const f32x4* xr = (const f32x4*)(xbase + (size_t)(m0 + i * mstep) * DM) + lane; s[i] = 0.f;
#pragma unroll
        for (int j = 0; j < 4; ++j) v[i][j] = xr[64 * j]; }
#pragma unroll
    for (int i = 0; i < NR; ++i)
#pragma unroll
        for (int j = 0; j < 4; ++j) s[i] += (v[i][j].x * v[i][j].x + v[i][j].y * v[i][j].y) + (v[i][j].z * v[i][j].z + v[i][j].w * v[i][j].w);
#pragma unroll
    for (int o = 1; o < 64; o <<= 1)
#pragma unroll
        for (int i = 0; i < NR; ++i) s[i] += __shfl_xor(s[i], o);
    const f32x4* gr = (const f32x4*)gain + lane;
    f32x4 g[4];
#pragma unroll
    for (int j = 0; j < 4; ++j) g[j] = gr[64 * j];
#pragma unroll
    for (int i = 0; i < NR; ++i) { const float rstd = 1.0f / sqrtf(s[i] * (1.f / DM) + EPS);
        unsigned long long* o8 = (unsigned long long*)(obase + (size_t)(m0 + i * mstep) * DM) + lane;
#pragma unroll
        for (int j = 0; j < 4; ++j) { const float y0 = v[i][j].x * rstd * g[j].x, y1 = v[i][j].y * rstd * g[j].y, y2 = v[i][j].z * rstd * g[j].z, y3 = v[i][j].w * rstd * g[j].w;
            o8[64 * j] = (unsigned long long)pk2(y0, y1) | ((unsigned long long)pk2(y2, y3) << 32);
            if (o8base) { int p = __builtin_amdgcn_cvt_pk_fp8_f32(y0 * 16.f, y1 * 16.f, 0, false); p = __builtin_amdgcn_cvt_pk_fp8_f32(y2 * 16.f, y3 * 16.f, p, true);
                *(unsigned*)(o8base + (size_t)(m0 + i * mstep) * DM + 256 * j + 4 * lane) = (unsigned)p; } } }
}

__device__ __forceinline__ unsigned pack_i8x4(float a, float b, float c, float d) {
    const int ia = (int)rintf(a), ib = (int)rintf(b), ic = (int)rintf(c), id = (int)rintf(d);
    return ((unsigned)ia & 255u) | (((unsigned)ib & 255u) << 8) | (((unsigned)ic & 255u) << 16) | ((unsigned)id << 24);
}
template <int NR, bool BF>
__device__ __forceinline__ void rms_rows_to_i8(const float* xbase, const float* gain, bf16* obase, unsigned char* o8base, float* rsx, int m0, int mstep, int lane) {
    f32x4 v[NR][4]; float s[NR], mx[NR];
#pragma unroll
    for (int i = 0; i < NR; ++i) { const f32x4* xr = (const f32x4*)(xbase + (size_t)(m0 + i * mstep) * DM) + lane; s[i] = 0.f; mx[i] = 0.f;
#pragma unroll
        for (int j = 0; j < 4; ++j) v[i][j] = xr[64 * j]; }
    const f32x4* gr = (const f32x4*)gain + lane;
    f32x4 g[4];
#pragma unroll
    for (int j = 0; j < 4; ++j) g[j] = gr[64 * j];
#pragma unroll
    for (int i = 0; i < NR; ++i)
#pragma unroll
        for (int j = 0; j < 4; ++j) { s[i] += (v[i][j].x * v[i][j].x + v[i][j].y * v[i][j].y) + (v[i][j].z * v[i][j].z + v[i][j].w * v[i][j].w);
            v[i][j] = v[i][j] * g[j]; mx[i] = fmaxf(mx[i], fmaxf(fmaxf(fabsf(v[i][j].x), fabsf(v[i][j].y)), fmaxf(fabsf(v[i][j].z), fabsf(v[i][j].w)))); }
#pragma unroll
    for (int o = 1; o < 64; o <<= 1)
#pragma unroll
        for (int i = 0; i < NR; ++i) { s[i] += __shfl_xor(s[i], o); mx[i] = fmaxf(mx[i], __shfl_xor(mx[i], o)); }
#pragma unroll
    for (int i = 0; i < NR; ++i) { const int row = m0 + i * mstep; const float rstd = 1.0f / sqrtf(s[i] * (1.f / DM) + EPS);
        const float qs = mx[i] > 1e-30f ? 127.0f / mx[i] : 0.f;
        if (lane == 0) rsx[row] = rstd * mx[i] * (1.0f / 127.0f);
#pragma unroll
        for (int j = 0; j < 4; ++j) {
            if (BF) { unsigned long long* o8 = (unsigned long long*)(obase + (size_t)row * DM) + lane;
                o8[64 * j] = (unsigned long long)pk2(v[i][j].x * rstd, v[i][j].y * rstd) | ((unsigned long long)pk2(v[i][j].z * rstd, v[i][j].w * rstd) << 32); }
            *(unsigned*)(o8base + (size_t)row * DM + 256 * j + 4 * lane) = pack_i8x4(v[i][j].x * qs, v[i][j].y * qs, v[i][j].z * qs, v[i][j].w * qs); } }
}
__device__ __forceinline__ void p0_win_i8(const Ctx& C, const Args& a) {
    const int nb = C.vcu; if (nb >= 176) return;
    const float* W = (const float*)a.in[4]; constexpr int N = 5632; const int n0 = 32 * nb, lane = C.lane, rl = lane >> 3, c4 = lane & 7;
    LAS unsigned* T = (LAS unsigned*)(C.lds + C.wave * 16384);
    LAS float* cmx = (LAS float*)(C.lds + 131072);
    f32x4 w[4][4];
    const float* wp = W + (size_t)(C.wave * 128 + 4 * rl) * N + n0 + 4 * c4;
#pragma unroll
    for (int g = 0; g < 4; ++g)
#pragma unroll
        for (int t = 0; t < 4; ++t) w[g][t] = *(const f32x4*)(wp + (size_t)(32 * g + t) * N);
    f32x4 m = {0.f, 0.f, 0.f, 0.f};
#pragma unroll
    for (int g = 0; g < 4; ++g)
#pragma unroll
        for (int t = 0; t < 4; ++t)
#pragma unroll
            for (int j = 0; j < 4; ++j) m[j] = fmaxf(m[j], fabsf(w[g][t][j]));
#pragma unroll
    for (int o = 8; o < 64; o <<= 1)
#pragma unroll
        for (int j = 0; j < 4; ++j) m[j] = fmaxf(m[j], __shfl_xor(m[j], o));
    if (rl == 0) *(LAS f32x4*)(cmx + C.wave * 32 + 4 * c4) = m;
    __syncthreads();
    f32x4 cm = {0.f, 0.f, 0.f, 0.f};
#pragma unroll
    for (int ww = 0; ww < 8; ++ww) { const f32x4 x = *(const LAS f32x4*)(cmx + ww * 32 + 4 * c4);
#pragma unroll
        for (int j = 0; j < 4; ++j) cm[j] = fmaxf(cm[j], x[j]); }
    f32x4 qs;
#pragma unroll
    for (int j = 0; j < 4; ++j) qs[j] = cm[j] > 1e-30f ? 127.0f / cm[j] : 0.f;
    if (C.wave == 0 && rl == 0) *(f32x4*)((float*)(a.ws + WS_CSW) + n0 + 4 * c4) = cm * (1.0f / 127.0f);
#pragma unroll
    for (int g = 0; g < 4; ++g)
#pragma unroll
        for (int j = 0; j < 4; ++j) T[(4 * c4 + j) * 36 + 8 * g + rl] = pack_i8x4(w[g][0][j] * qs[j], w[g][1][j] * qs[j], w[g][2][j] * qs[j], w[g][3][j] * qs[j]);
    LDS_WAIT(); asm volatile("" ::: "memory");
    {   const int n = lane >> 1, hf = lane & 1;
        unsigned char* dst = a.ws + WS_WIN8 + (size_t)(n0 + n) * 1024 + C.wave * 128 + 64 * hf;
#pragma unroll
        for (int q = 0; q < 4; ++q) *(GAS v4u*)(dst + 16 * q) = *(const LAS v4u*)(T + n * 36 + 16 * hf + 4 * q); }
    LDS_WAIT(); asm volatile("" ::: "memory");
    __syncthreads();
}

__device__ __forceinline__ void p0_s5_group(const Ctx& C, const Args& a, int g, int part) {
    const float* a_re = (const float*)a.in[7]; const float* a_im = (const float*)a.in[8]; const float* log_dt = (const float*)a.in[9];
    const float* b_re = (const float*)a.in[10]; const float* b_im = (const float*)a.in[11]; const float* c_re = (const float*)a.in[12]; const float* c_im = (const float*)a.in[13];
    LAS float* L = (LAS float*)C.lds;
    LAS float* lpr = L;
    LAS float* lpi = L + 640;
    LAS float* bbr = L + 1280;
    LAS float* bbi = bbr + 1024;
    LAS float* ccr = bbi + 1024;
    LAS float* cci = ccr + 1024;
    LAS float* Kj = cci + 1024;
    const int tid = C.tid;
    bf16* T8T = (bf16*)(a.ws + WS_S5MAT) + (size_t)g * 16384;
    bf16* PMT = (bf16*)(a.ws + WS_S5MAT) + (size_t)(16 + g) * 16384;
    bf16* QMT = (bf16*)(a.ws + WS_S5MAT) + (size_t)(32 + g) * 16384;
    float* L8 = (float*)(a.ws + WS_S5C) + (size_t)g * 128;
    float* L128 = (float*)(a.ws + WS_S5C) + 2048 + (size_t)g * 128;
    for (int i = tid; i < 640; i += 512) {
        const int j10 = i >> 6, p = i & 63; const double jj = (j10 < 9) ? (double)j10 : 128.0;
        const double dt = exp((double)log_dt[g]);
        const double ar = (double)a_re[g * 64 + p], ai = (double)a_im[g * 64 + p];
        const double mag = exp(ar * dt * jj), ang = ai * dt * jj;
        lpr[i] = (float)(mag * cos(ang)); lpi[i] = (float)(mag * sin(ang));
    }
    for (int i = tid; i < 1024; i += 512) { ccr[i] = c_re[g * 1024 + i]; cci[i] = c_im[g * 1024 + i]; }
    __syncthreads();
    if (part == 0 && tid < 64) { L8[tid * 2] = lpr[8 * 64 + tid]; L8[tid * 2 + 1] = lpi[8 * 64 + tid]; L128[tid * 2] = lpr[9 * 64 + tid]; L128[tid * 2 + 1] = lpi[9 * 64 + tid]; }
    for (int i = tid; i < 1024; i += 512) {
        const int p = i >> 4, h = i & 15;
        const float ar = a_re[g * 64 + p], ai = a_im[g * 64 + p], lr = lpr[64 + p], li = lpi[64 + p];
        const float den = ar * ar + ai * ai, nr = lr - 1.0f, ni = li;
        const float cr = (nr * ar + ni * ai) / den, ci = (ni * ar - nr * ai) / den;
        const float br = b_re[(g * 64 + p) * 16 + h], bi = b_im[(g * 64 + p) * 16 + h];
        bbr[i] = cr * br - ci * bi; bbi[i] = cr * bi + ci * br;
    }
    __syncthreads();
    for (int i = tid; i < 2048; i += 512) {
        const int j = i >> 8, ho = (i >> 4) & 15, hi = i & 15; float sacc = 0.f;
        if (j > (part >> 1) || (ho >> 3) != (part & 1)) continue;
        for (int p = 0; p < 64; ++p) { const float cr_ = ccr[ho * 64 + p], ci_ = cci[ho * 64 + p], lr_ = lpr[j * 64 + p], li_ = lpi[j * 64 + p];
            const float mr = cr_ * lr_ - ci_ * li_, mi = cr_ * li_ + ci_ * lr_;
            sacc += mr * bbr[p * 16 + hi] - mi * bbi[p * 16 + hi]; }
        Kj[i] = sacc;
    }
    __syncthreads();
    for (int i = part * 1024 + tid; i < (part + 1) * 1024; i += 512) {
        const int n = i >> 7, k = i & 127;
        { const int t = n >> 4, ho = n & 15, sx = k >> 4, hi = k & 15; const float v = (sx <= t) ? Kj[((t - sx) * 16 + ho) * 16 + hi] : 0.f; T8T[frag16(n, k, 128)] = (bf16)f2bf(v); }
        { const int p = n & 63, im = n >> 6, sx = k >> 4, hi = k & 15; const float lr_ = lpr[(7 - sx) * 64 + p], li_ = lpi[(7 - sx) * 64 + p], br_ = bbr[p * 16 + hi], bi_ = bbi[p * 16 + hi];
          const float v = im ? (lr_ * bi_ + li_ * br_) : (lr_ * br_ - li_ * bi_); PMT[frag16(n, k, 128)] = (bf16)f2bf(v); }
        { const int t = n >> 4, ho = n & 15, p = k & 63, pt = k >> 6; const float cr_ = ccr[ho * 64 + p], ci_ = cci[ho * 64 + p], lr_ = lpr[(t + 1) * 64 + p], li_ = lpi[(t + 1) * 64 + p];
          const float v = pt ? -(cr_ * li_ + ci_ * lr_) : (cr_ * lr_ - ci_ * li_); QMT[frag16(n, k, 128)] = (bf16)f2bf(v); }
    }
    __syncthreads();
}

__device__ __forceinline__ void p0_prologue(const Ctx& C, const Args& a) {
    p0_win_i8(C, a);
    p0_s5_group(C, a, C.vcu & 15, C.vcu >> 4);
    LAS float* scr = (LAS float*)(C.lds + C.wave * 16384);
    const int gw = C.vcu * NWAVES + C.wave, NGW = C.G * NWAVES;
    const int gt = C.vcu * 512 + C.tid, NGT = C.G * 512;
    unsigned char* ws = a.ws;
    for (int i = gt; i < MTOK; i += NGT) ((float*)(ws + WS_SS))[i] = 0.f;
    constexpr int I_Q = 16 * 64, I_O = 16 * 32, I_BR = 8 * 32, I_BS = 4 * 32, I_BM = 4 * 32, I_KV = 16 * 16, I_GLU = 4 * 16;
    constexpr int NITEMS = I_Q + I_O + I_BR + I_BS + I_BM + I_KV + I_GLU;
    for (int it = gw; it < NITEMS; it += NGW) {
        int r = it;
        if (r < I_Q) { p0_transpose_item<false>((const float*)a.in[21], 1024, 2048, (bf16*)(ws + WS_WQ_T), scr, r, C.lane, (const float*)a.in[20]); continue; } r -= I_Q;
        if (r < I_O) { p0_transpose_item<false>((const float*)a.in[19], 1024, 1024, (bf16*)(ws + WS_WOUT_T), scr, r, C.lane); continue; } r -= I_O;
        if (r < I_BR) { p0_transpose_item<false>((const float*)a.in[16], 512, 1024, (bf16*)(ws + WS_WCAT_T), scr, r, C.lane, nullptr, 1024, 0); continue; } r -= I_BR;
        if (r < I_BS) { p0_transpose_item<false>((const float*)a.in[17], 256, 1024, (bf16*)(ws + WS_WCAT_T), scr, r, C.lane, nullptr, 1024, 512); continue; } r -= I_BS;
        if (r < I_BM) { p0_transpose_item<false>((const float*)a.in[18], 256, 1024, (bf16*)(ws + WS_WCAT_T), scr, r, C.lane, nullptr, 1024, 768); continue; } r -= I_BM;
        if (r < I_KV) { p0_transpose_item<false>((const float*)a.in[6], 1024, 512, (bf16*)(ws + WS_WMKV_T), scr, r, C.lane); continue; } r -= I_KV;
        p0_transpose_item<true>((const float*)a.in[15], 256, 512, (bf16*)(ws + WS_WGLU_T), scr, r, C.lane);
    }
    for (int i = gt; i < 16 * 128 * 128 / 8; i += NGT) { const f32x4 x0 = ((const f32x4*)a.in[22])[2 * (size_t)i], x1 = ((const f32x4*)a.in[22])[2 * (size_t)i + 1];
        const int hc = i >> 11, n = (i >> 4) & 127, d0 = (i & 15) * 8; *(v4u*)((bf16*)(ws + WS_KEYS) + hc * 16384 + frag32(n, d0, 128)) = pack8(x0, x1); }
    for (int rw0 = gw; rw0 < 2 * 16384; rw0 += 4 * NGW) {
        const int t = rw0 >> 14;
        f32x4 v[4][4]; float mx[4];
#pragma unroll
        for (int i = 0; i < 4; ++i) { const int row = (rw0 + i * NGW) & 16383;
            const float* src = (const float*)a.in[23 + t] + (size_t)row * DM + C.lane * 4; mx[i] = 0.f;
#pragma unroll
            for (int q = 0; q < 4; ++q) { v[i][q] = *(const f32x4*)(src + 256 * q); if (t == 0) v[i][q] = v[i][q] * *(const f32x4*)((const float*)a.in[20] + C.lane * 4 + 256 * q); } }
#pragma unroll
        for (int i = 0; i < 4; ++i)
#pragma unroll
            for (int q = 0; q < 4; ++q) mx[i] += (v[i][q][0] * v[i][q][0] + v[i][q][1] * v[i][q][1]) + (v[i][q][2] * v[i][q][2] + v[i][q][3] * v[i][q][3]);
#pragma unroll
        for (int o = 1; o < 64; o <<= 1)
#pragma unroll
            for (int i = 0; i < 4; ++i) mx[i] += __shfl_xor(mx[i], o);
#pragma unroll
        for (int i = 0; i < 4; ++i) { const int row = (rw0 + i * NGW) & 16383;
            const float rms = sqrtf(mx[i] * (1.f / DM)); const bool tiny = rms < 1e-30f;
            const float sc = tiny ? 1.f : 2.05f / rms, isc = tiny ? 1.f : rms * (1.f / 2.05f);
            unsigned char* dst = ws + (t ? WS_PV : WS_PU) + (size_t)row * 128 + 2 * C.lane;
#pragma unroll
            for (int q = 0; q < 4; ++q) { const unsigned w = q_e2m1(v[i][q][0] * sc) | (q_e2m1(v[i][q][1] * sc) << 4) | (q_e2m1(v[i][q][2] * sc) << 8) | (q_e2m1(v[i][q][3] * sc) << 12);
                *(unsigned short*)(dst + (size_t)q * (16384 * 128)) = (unsigned short)w; }
            if (C.lane == 0) ((float*)(ws + WS_PSC))[row * 2 + t] = isc; }
    }
    for (int m = gw; m < MTOK; m += 4 * NGW) rms_rows_to_i8<4, false>((const float*)a.in[0], (const float*)a.in[3], nullptr, ws + WS_XN8, (float*)(ws + WS_RSX), m, NGW, C.lane);
    for (int m = gw; m < MROWS; m += NGW) rms_rows_to_bf16<1>((const float*)a.in[1], (const float*)a.in[5], (bf16*)(ws + WS_MEMN), m, NGW, C.lane);
    {
        const int* pos = (const int*)a.in[2]; float* rope = (float*)(ws + WS_ROPE);
        const int j = C.tid & 63;
        const double invrev = exp(-(double)j * (9.210340371976184 / 64.0)) * 0.15915494309189535;
        for (int i = gt; i < MTOK * 64; i += NGT) { const int tok = i >> 6;
            double rv = (double)pos[tok] * invrev; rv -= rint(rv);
            const float rf = (float)rv;
            rope[(size_t)tok * 128 + j] = __builtin_amdgcn_cosf(rf); rope[(size_t)tok * 128 + 64 + j] = __builtin_amdgcn_sinf(rf); }
    }
}

constexpr int LP = 136;
__device__ __forceinline__ float lg2_gamma(int h) { return log2f(1.0f - exp2f(-5.0f - (float)h)); }

struct R1In { v4u q[4], k[4]; };
__device__ __forceinline__ void r1_load(const bf16* zr, int h, int dq, int eq, R1In& R) {
    const bf16* sq = zr + ZQ + h * 128; const bf16* sk = zr + ZK + h * 128;
    R.q[0] = *(const v4u*)(sq + dq); R.q[1] = *(const v4u*)(sq + dq + 8); R.q[2] = *(const v4u*)(sq + 64 + dq); R.q[3] = *(const v4u*)(sq + 64 + dq + 8);
    R.k[0] = *(const v4u*)(sk + dq); R.k[1] = *(const v4u*)(sk + dq + 8); R.k[2] = *(const v4u*)(sk + 64 + dq); R.k[3] = *(const v4u*)(sk + 64 + dq + 8);
}
__device__ __forceinline__ void r1_unit(const Ctx& C, const Args& a, int tile, int h, const float (&cs)[16], const float (&sn)[16], const R1In& R, R1In& Rn, bool hasnext) {
    const bf16* Z1 = (const bf16*)(a.ws + WS_Z1);
    LAS bf16* Qs = (LAS bf16*)C.lds; LAS bf16* Ks = Qs + 128 * LP; LAS bf16* Kt = Ks + 128 * LP; LAS bf16* Vt = Kt + 128 * LP;
    const int tid = C.tid, lane = C.lane, t0 = tile * 128, u = tile * 4 + h;
    const float lg2g = lg2_gamma(h);
    const int i = tid >> 2, dq = (tid & 3) * 16, eq = (tid & 3) * 32;
    {
        v4u vraw[4];
#pragma unroll
        for (int q = 0; q < 4; ++q) vraw[q] = *(const v4u*)(Z1 + (size_t)(t0 + i) * NZ1 + ZV + h * 128 + eq + 8 * q);
        const float kdec = __builtin_amdgcn_exp2f((float)(127 - i) * lg2g) , ksc = 0.08838834764831845f;
#pragma unroll
        for (int which = 0; which < 2; ++which) {
            const v4u a0 = which ? R.k[0] : R.q[0], a1 = which ? R.k[1] : R.q[1], b0 = which ? R.k[2] : R.q[2], b1 = which ? R.k[3] : R.q[3];
            const unsigned aw[8] = {a0.x, a0.y, a0.z, a0.w, a1.x, a1.y, a1.z, a1.w}, bw[8] = {b0.x, b0.y, b0.z, b0.w, b1.x, b1.y, b1.z, b1.w};
            float y1[16], y2[16];
#pragma unroll
            for (int w = 0; w < 8; ++w) {
                const float x1l = bflo(aw[w]), x1h = bfhi(aw[w]), x2l = bflo(bw[w]), x2h = bfhi(bw[w]);
                y1[2 * w] = x1l * cs[2 * w] - x2l * sn[2 * w]; y2[2 * w] = x1l * sn[2 * w] + x2l * cs[2 * w];
                y1[2 * w + 1] = x1h * cs[2 * w + 1] - x2h * sn[2 * w + 1]; y2[2 * w + 1] = x1h * sn[2 * w + 1] + x2h * cs[2 * w + 1];
            }
            if (which) {
#pragma unroll
                for (int e = 0; e < 16; ++e) { y1[e] *= ksc; y2[e] *= ksc; }
            }
            LAS bf16* dstp = (which ? Ks : Qs) + i * LP;
            v4u o;
            o.x = pk2(y1[0], y1[1]); o.y = pk2(y1[2], y1[3]); o.z = pk2(y1[4], y1[5]); o.w = pk2(y1[6], y1[7]); *(LAS v4u*)(dstp + dq) = o;
            o.x = pk2(y1[8], y1[9]); o.y = pk2(y1[10], y1[11]); o.z = pk2(y1[12], y1[13]); o.w = pk2(y1[14], y1[15]); *(LAS v4u*)(dstp + dq + 8) = o;
            o.x = pk2(y2[0], y2[1]); o.y = pk2(y2[2], y2[3]); o.z = pk2(y2[4], y2[5]); o.w = pk2(y2[6], y2[7]); *(LAS v4u*)(dstp + 64 + dq) = o;
            o.x = pk2(y2[8], y2[9]); o.y = pk2(y2[10], y2[11]); o.z = pk2(y2[12], y2[13]); o.w = pk2(y2[14], y2[15]); *(LAS v4u*)(dstp + 64 + dq + 8) = o;
            if (which) {
#pragma unroll
                for (int e = 0; e < 16; ++e) { Kt[(dq + e) * LP + i] = (bf16)f2bf(y1[e] * kdec); Kt[(64 + dq + e) * LP + i] = (bf16)f2bf(y2[e] * kdec); }
            }
            __builtin_amdgcn_sched_barrier(0);
        }
        {
#pragma unroll
            for (int q = 0; q < 4; ++q) { const v4u v = vraw[q]; const unsigned vw[4] = {v.x, v.y, v.z, v.w};
#pragma unroll
                for (int w = 0; w < 4; ++w) { Vt[(eq + 8 * q + 2 * w) * LP + i] = (bf16)(vw[w] & 0xffffu); Vt[(eq + 8 * q + 2 * w + 1) * LP + i] = (bf16)(vw[w] >> 16); } }
        }
    }
    __syncthreads();
    if (hasnext) r1_load(Z1 + (size_t)(t0 + i) * NZ1, h + 1, dq, eq, Rn);
    __builtin_amdgcn_sched_barrier(0);
    const int r = lane & 31, hh = lane >> 5;
    if (C.wave < 4) {
        const int ib = C.wave;
        { bf16* qf = (bf16*)(a.ws + WS_QRF) + ((size_t)(u * 4 + ib) * 8 * 64 + lane) * 8;
#pragma unroll
          for (int ks = 0; ks < 8; ++ks) *(bf16x8*)(qf + ks * 512) = *(const LAS bf16x8*)(Qs + (ib * 32 + r) * LP + ks * 16 + 8 * hh); }
        __builtin_amdgcn_sched_barrier(0);
        f32x16 accO[4];
#pragma unroll
        for (int et = 0; et < 4; ++et)
#pragma unroll
            for (int e = 0; e < 16; ++e) accO[et][e] = 0.f;
        int i = ib * 32 + r; asm volatile("" : "+v"(i));
#pragma unroll
        for (int jt = 0; jt < 4; ++jt) {
            if (jt <= ib) {
                f32x16 s;
#pragma unroll
                for (int e = 0; e < 16; ++e) s[e] = 0.f;
#pragma unroll
                for (int ks = 0; ks < 8; ++ks) { const bf16x8 ak = *(const LAS bf16x8*)(Ks + (jt * 32 + r) * LP + ks * 16 + 8 * hh), bqk = *(const LAS bf16x8*)(Qs + (ib * 32 + r) * LP + ks * 16 + 8 * hh); s = mfma32(ak, bqk, s); }
                unsigned pk[8];
#pragma unroll
                for (int q = 0; q < 8; ++q) {
                    const int ra = 2 * q, rb = 2 * q + 1;
                    const int ja = jt * 32 + (ra & 3) + 8 * (ra >> 2) + 4 * hh, jb = jt * 32 + (rb & 3) + 8 * (rb >> 2) + 4 * hh;
                    const float va = (i >= ja) ? s[ra] * __builtin_amdgcn_exp2f((float)(i - ja) * lg2g) : 0.f;
                    const float vb = (i >= jb) ? s[rb] * __builtin_amdgcn_exp2f((float)(i - jb) * lg2g) : 0.f;
                    pk[q] = pk2(va, vb);
                }
#pragma unroll
                for (int sft = 0; sft < 2; ++sft) {
                    const bf16x8 pb = mk8(pk[4 * sft], pk[4 * sft + 1], pk[4 * sft + 2], pk[4 * sft + 3]);
#pragma unroll
                    for (int et = 0; et < 4; ++et) {
                        const LAS bf16* vp = Vt + (et * 32 + r) * LP + jt * 32 + 16 * sft + 4 * hh;
                        const v2u lo = *(const LAS v2u*)vp, hi = *(const LAS v2u*)(vp + 8);
                        accO[et] = mfma32(mk8(lo.x, lo.y, hi.x, hi.y), pb, accO[et]);
                    }
                }
            }
            __builtin_amdgcn_sched_barrier(0);
        }
        unsigned* INN = (unsigned*)(a.ws + WS_INNER) + ((size_t)(u * 4 + ib) * 32) * 64 + lane;
#pragma unroll
        for (int et = 0; et < 4; ++et)
#pragma unroll
            for (int q = 0; q < 8; ++q) INN[(et * 8 + q) * 64] = pk2(accO[et][2 * q], accO[et][2 * q + 1]);
    } else {
        const int et = C.wave - 4;
        f32x16 acc[4];
#pragma unroll
        for (int dt = 0; dt < 4; ++dt)
#pragma unroll
            for (int e = 0; e < 16; ++e) acc[dt][e] = 0.f;
#pragma unroll
        for (int ks = 0; ks < 8; ++ks) {
            const bf16x8 av = *(const LAS bf16x8*)(Vt + (et * 32 + r) * LP + ks * 16 + 8 * hh);
#pragma unroll
            for (int dt = 0; dt < 4; ++dt) { const bf16x8 bk = *(const LAS bf16x8*)(Kt + (dt * 32 + r) * LP + ks * 16 + 8 * hh); acc[dt] = mfma32(av, bk, acc[dt]); }
            __builtin_amdgcn_sched_barrier(0);
        }
        float* KVb = a.out + (size_t)u * 16384 + (size_t)(et * 32 + 4 * hh) * 128 + r;
#pragma unroll
        for (int dt = 0; dt < 4; ++dt) {
#pragma unroll
            for (int e = 0; e < 16; ++e) KVb[((e & 3) + 8 * (e >> 2)) * 128 + dt * 32] = acc[dt][e];
            __builtin_amdgcn_sched_barrier(0);
        }
    }
    __syncthreads();
}

__device__ __forceinline__ void s5_compute_E(const Args& a, int tile, int g, int lane, LAS float* Es, bf16x8 (&au)[4]) {
    const bf16* Z1 = (const bf16*)(a.ws + WS_Z1); const bf16* PMT = (const bf16*)(a.ws + WS_S5MAT) + (size_t)(16 + g) * 16384;
    const int r16 = lane & 15, q4 = lane >> 4;
#pragma unroll
    for (int ks = 0; ks < 4; ++ks) { const int s = 2 * ks + (q4 >> 1);
        au[ks] = *(const bf16x8*)(Z1 + (size_t)(tile * 128 + 8 * r16 + s) * NZ1 + ZU + g * 16 + 8 * (q4 & 1)); }
    bf16x8 bc[4], bn[4];
#pragma unroll
    for (int ks = 0; ks < 4; ++ks) bc[ks] = *(const bf16x8*)(PMT + (ks * 64 + lane) * 8);
#pragma unroll 1
    for (int nb = 0; nb < 8; ++nb) {
        const int nbn = min(nb + 1, 7);
#pragma unroll
        for (int ks = 0; ks < 4; ++ks) bn[ks] = *(const bf16x8*)(PMT + ((nbn * 4 + ks) * 64 + lane) * 8);
        __builtin_amdgcn_sched_barrier(0);
        f32x4 acc = {0.f, 0.f, 0.f, 0.f};
#pragma unroll
        for (int ks = 0; ks < 4; ++ks) acc = mfma16(au[ks], bc[ks], acc);
#pragma unroll
        for (int i4 = 0; i4 < 4; ++i4) Es[(q4 * 4 + i4) * 128 + nb * 16 + r16] = acc[i4];
        __builtin_amdgcn_sched_barrier(0);
#pragma unroll
        for (int ks = 0; ks < 4; ++ks) bc[ks] = bn[ks];
    }
    LDS_WAIT(); asm volatile("" ::: "memory");
}
__device__ __forceinline__ void s5a_wave(const Ctx& C, const Args& a, int tile, int g) {
    LAS float* Es = (LAS float*)(C.lds + C.wave * 16384);
    bf16x8 au[4];
    s5_compute_E(a, tile, g, C.lane, Es, au);
    const float* L8 = (const float*)(a.ws + WS_S5C) + (size_t)g * 128;
    const float l8r = L8[C.lane * 2], l8i = L8[C.lane * 2 + 1];
    float sr = 0.f, si = 0.f;
#pragma unroll
    for (int c = 0; c < 16; ++c) { const float er = Es[c * 128 + C.lane], ei = Es[c * 128 + 64 + C.lane];
        const float nr = l8r * sr - l8i * si + er, ni = l8r * si + l8i * sr + ei; sr = nr; si = ni; }
    float* E = (float*)(a.ws + WS_S5E) + ((size_t)tile * 16 + g) * 128;
    E[C.lane] = sr; E[64 + C.lane] = si;
    LDS_WAIT(); asm volatile("" ::: "memory");
}
__device__ __forceinline__ void s5c_wave(const Ctx& C, const Args& a, int tile, int g) {
    LAS float* Es = (LAS float*)(C.lds + C.wave * 16384);
    LAS bf16* Sv = (LAS bf16*)(C.lds + C.wave * 16384 + 8192);
    const int lane = C.lane, r16 = lane & 15, q4 = lane >> 4;
    bf16x8 au[4];
    s5_compute_E(a, tile, g, lane, Es, au);
    const float* L8 = (const float*)(a.ws + WS_S5C) + (size_t)g * 128;
    const float l8r = L8[lane * 2], l8i = L8[lane * 2 + 1];
    const float* X = (const float*)(a.ws + WS_S5X) + ((size_t)tile * 16 + g) * 128;
    float sr = X[lane], si = X[64 + lane];
#pragma unroll
    for (int c = 0; c < 16; ++c) {
        Sv[c * LP + lane] = (bf16)f2bf(sr); Sv[c * LP + 64 + lane] = (bf16)f2bf(si);
        const float er = Es[c * 128 + lane], ei = Es[c * 128 + 64 + lane];
        const float nr = l8r * sr - l8i * si + er, ni = l8r * si + l8i * sr + ei; sr = nr; si = ni; }
    LDS_WAIT(); asm volatile("" ::: "memory");
    bf16x8 as[4];
#pragma unroll
    for (int ks = 0; ks < 4; ++ks) as[ks] = *(const LAS bf16x8*)(Sv + r16 * LP + ks * 32 + 8 * q4);
    const bf16* T8T = (const bf16*)(a.ws + WS_S5MAT) + (size_t)g * 16384; const bf16* QMT = (const bf16*)(a.ws + WS_S5MAT) + (size_t)(32 + g) * 16384;
    const bf16* Z1 = (const bf16*)(a.ws + WS_Z1); bf16* YG = (bf16*)(a.ws + WS_YG);
    const float dg = ((const float*)a.in[14])[g * 16 + r16];
    bf16x8 tc[4], tn[4], qc[4], qn[4]; bf16 uc[4], un[4];
#pragma unroll
    for (int ks = 0; ks < 4; ++ks) { tc[ks] = *(const bf16x8*)(T8T + (ks * 64 + lane) * 8); qc[ks] = *(const bf16x8*)(QMT + (ks * 64 + lane) * 8); }
#pragma unroll
    for (int i4 = 0; i4 < 4; ++i4) uc[i4] = Z1[(size_t)(tile * 128 + 8 * (q4 * 4 + i4)) * NZ1 + ZU + g * 16 + r16];
#pragma unroll 1
    for (int nb = 0; nb < 8; ++nb) {
        const int nbn = min(nb + 1, 7);
#pragma unroll
        for (int ks = 0; ks < 4; ++ks) { tn[ks] = *(const bf16x8*)(T8T + ((nbn * 4 + ks) * 64 + lane) * 8); qn[ks] = *(const bf16x8*)(QMT + ((nbn * 4 + ks) * 64 + lane) * 8); }
#pragma unroll
        for (int i4 = 0; i4 < 4; ++i4) un[i4] = Z1[(size_t)(tile * 128 + 8 * (q4 * 4 + i4) + nbn) * NZ1 + ZU + g * 16 + r16];
        __builtin_amdgcn_sched_barrier(0);
        f32x4 acc = {0.f, 0.f, 0.f, 0.f};
#pragma unroll
        for (int ks = 0; ks < 4; ++ks) { acc = mfma16(au[ks], tc[ks], acc); acc = mfma16(as[ks], qc[ks], acc); }
#pragma unroll
        for (int i4 = 0; i4 < 4; ++i4) { const int tok = tile * 128 + 8 * (q4 * 4 + i4) + nb;
            YG[(size_t)tok * 256 + g * 16 + r16] = (bf16)f2bf(gelu_tanh(acc[i4] + dg * bf2f(uc[i4]))); }
        __builtin_amdgcn_sched_barrier(0);
#pragma unroll
        for (int ks = 0; ks < 4; ++ks) { tc[ks] = tn[ks]; qc[ks] = qn[ks]; }
#pragma unroll
        for (int i4 = 0; i4 < 4; ++i4) uc[i4] = un[i4];
    }
    LDS_WAIT(); asm volatile("" ::: "memory");
}

__device__ __forceinline__ void ma_loadk(const bf16* kp, int mt, bf16x8 (&k)[4]) {
#pragma unroll
    for (int ks = 0; ks < 4; ++ks) k[ks] = *(const bf16x8*)(kp + (mt * 4 + ks) * 512);
}
__device__ __forceinline__ void ma_loadv(const bf16* vp, int mt, bf16x8 (&v)[4]) {
#pragma unroll
    for (int sft = 0; sft < 2; ++sft)
#pragma unroll
        for (int et = 0; et < 2; ++et) v[sft * 2 + et] = *(const bf16x8*)(vp + (((et * 8 + mt) * 2 + sft) * 64) * 8);
}
__device__ __forceinline__ void ma_wave(const Ctx& C, const Args& a, int tile, int hm, int ib) {
    const bf16* Z1 = (const bf16*)(a.ws + WS_Z1); const bf16* KM = (const bf16*)(a.ws + WS_KM); const bf16* VT = (const bf16*)(a.ws + WS_VT);
    const int lane = C.lane, r = lane & 31, hh = lane >> 5, b = tile >> 5, tok = tile * 128 + ib * 32 + r;
    const bf16* kp = KM + (size_t)(b * 4 + hm) * 16384 + lane * 8;
    const bf16* vp = VT + (size_t)(b * 4 + hm) * 16384 + lane * 8;
    bf16x8 bq[4];
#pragma unroll
    for (int ks = 0; ks < 4; ++ks) bq[ks] = *(const bf16x8*)(Z1 + (size_t)tok * NZ1 + ZQM + hm * 64 + ks * 16 + 8 * hh);
    bf16x8 kc[4], kn[4];
    ma_loadk(kp, 0, kc);
    float mx = -3.0e38f;
#pragma unroll 1
    for (int mt = 0; mt < 8; ++mt) {
        ma_loadk(kp, min(mt + 1, 7), kn); __builtin_amdgcn_sched_barrier(0);
        f32x16 s;
#pragma unroll
        for (int e = 0; e < 16; ++e) s[e] = 0.f;
#pragma unroll
        for (int ks = 0; ks < 4; ++ks) s = mfma32(kc[ks], bq[ks], s);
#pragma unroll
        for (int e = 0; e < 16; ++e) mx = fmaxf(mx, s[e]);
        __builtin_amdgcn_sched_barrier(0);
#pragma unroll
        for (int ks = 0; ks < 4; ++ks) kc[ks] = kn[ks];
    }
    mx = fmaxf(mx, __shfl_xor(mx, 32));
    float sum = 0.f;
    f32x16 o[2];
#pragma unroll
    for (int et = 0; et < 2; ++et)
#pragma unroll
        for (int e = 0; e < 16; ++e) o[et][e] = 0.f;
    const float sc = 0.125f * 1.4426950408889634f;
    bf16x8 vc[4], vn[4];
    ma_loadk(kp, 0, kc); ma_loadv(vp, 0, vc);
#pragma unroll 1
    for (int mt = 0; mt < 8; ++mt) {
        ma_loadk(kp, min(mt + 1, 7), kn); ma_loadv(vp, min(mt + 1, 7), vn); __builtin_amdgcn_sched_barrier(0);
        f32x16 s;
#pragma unroll
        for (int e = 0; e < 16; ++e) s[e] = 0.f;
#pragma unroll
        for (int ks = 0; ks < 4; ++ks) s = mfma32(kc[ks], bq[ks], s);
        unsigned pk[8];
#pragma unroll
        for (int q = 0; q < 8; ++q) { const float pa = __builtin_amdgcn_exp2f((s[2 * q] - mx) * sc), pb = __builtin_amdgcn_exp2f((s[2 * q + 1] - mx) * sc); sum += pa + pb; pk[q] = pk2(pa, pb); }
#pragma unroll
        for (int sft = 0; sft < 2; ++sft) {
            const bf16x8 pb = mk8(pk[4 * sft], pk[4 * sft + 1], pk[4 * sft + 2], pk[4 * sft + 3]);
#pragma unroll
            for (int et = 0; et < 2; ++et) o[et] = mfma32(vc[sft * 2 + et], pb, o[et]);
        }
        __builtin_amdgcn_sched_barrier(0);
#pragma unroll
        for (int ks = 0; ks < 4; ++ks) kc[ks] = kn[ks];
#pragma unroll
        for (int q = 0; q < 4; ++q) vc[q] = vn[q];
    }
    sum += __shfl_xor(sum, 32);
    const float inv = 1.0f / sum;
    bf16* MA = (bf16*)(a.ws + WS_YCAT) + (size_t)tok * 1024 + 768 + hm * 64;
#pragma unroll
    for (int et = 0; et < 2; ++et)
#pragma unroll
        for (int g4 = 0; g4 < 4; ++g4) { v2u w; w.x = pk2(o[et][4 * g4] * inv, o[et][4 * g4 + 1] * inv); w.y = pk2(o[et][4 * g4 + 2] * inv, o[et][4 * g4 + 3] * inv);
            *(v2u*)(MA + et * 32 + 8 * g4 + 4 * hh) = w; }
}

__device__ __forceinline__ void r3_wave(const Ctx& C, const Args& a, int tile, int h, int ib) {
    const bf16* Z1 = (const bf16*)(a.ws + WS_Z1); const float* ROPE = (const float*)(a.ws + WS_ROPE);
    const bf16* PREV = (const bf16*)((const unsigned char*)a.out + 64 * MiB);
    const int lane = C.lane, r = lane & 31, hh = lane >> 5, u = tile * 4 + h, tok = tile * 128 + ib * 32 + r;
    const float lg2g = lg2_gamma(h);
    bf16x8 bq[8];
    { const bf16* qf = (const bf16*)(a.ws + WS_QRF) + ((size_t)(u * 4 + ib) * 8 * 64 + lane) * 8;
#pragma unroll
      for (int ks = 0; ks < 8; ++ks) bq[ks] = *(const bf16x8*)(qf + ks * 512); }
    f32x16 acc[4];
    const bf16* pbase = PREV + (size_t)u * 16384 + lane * 8;
    bf16x8 ap[4][8];
#pragma unroll
    for (int et = 0; et < 4; ++et)
#pragma unroll
        for (int ks = 0; ks < 8; ++ks) ap[et][ks] = *(const bf16x8*)(pbase + (et * 8 + ks) * 512);
    __builtin_amdgcn_sched_barrier(0);
#pragma unroll
    for (int et = 0; et < 4; ++et) {
#pragma unroll
        for (int e = 0; e < 16; ++e) acc[et][e] = 0.f;
#pragma unroll
        for (int ks = 0; ks < 8; ++ks) acc[et] = mfma32(ap[et][ks], bq[ks], acc[et]);
    }
    __builtin_amdgcn_sched_barrier(0);
    const unsigned* INN = (const unsigned*)(a.ws + WS_INNER) + ((size_t)(u * 4 + ib) * 32) * 64 + lane;
    unsigned innw[32];
#pragma unroll
    for (int q = 0; q < 32; ++q) innw[q] = INN[q * 64];
    const bf16* gp = Z1 + (size_t)tok * NZ1 + ZGR + h * 128;
    v2u gwv[16];
#pragma unroll
    for (int q = 0; q < 16; ++q) gwv[q] = *(const v2u*)(gp + (q >> 2) * 32 + 8 * (q & 3) + 4 * hh);
    const float qdec = __builtin_amdgcn_exp2f((float)(ib * 32 + r + 1) * lg2g);
    float ss = 0.f;
#pragma unroll
    for (int et = 0; et < 4; ++et)
#pragma unroll
        for (int q = 0; q < 8; ++q) { const unsigned w = innw[et * 8 + q];
            const float v0 = acc[et][2 * q] * qdec + bflo(w), v1 = acc[et][2 * q + 1] * qdec + bfhi(w);
            acc[et][2 * q] = v0; acc[et][2 * q + 1] = v1; ss += v0 * v0 + v1 * v1; }
    __builtin_amdgcn_sched_barrier(0);
    ss += __shfl_xor(ss, 32);
    const float rn = __builtin_amdgcn_rsqf(ss * (1.0f / 128.0f) + EPS);
    bf16* RET = (bf16*)(a.ws + WS_YCAT) + (size_t)tok * 1024 + h * 128;
#pragma unroll
    for (int et = 0; et < 4; ++et)
#pragma unroll
        for (int g4 = 0; g4 < 4; ++g4) { const int e0 = et * 32 + 8 * g4 + 4 * hh; const v2u gw = gwv[et * 4 + g4];
            const float g0 = bflo(gw.x), g1 = bfhi(gw.x), g2 = bflo(gw.y), g3 = bfhi(gw.y);
            v2u w; w.x = pk2(acc[et][4 * g4] * rn * g0 * sigmoidf_(g0), acc[et][4 * g4 + 1] * rn * g1 * sigmoidf_(g1));
            w.y = pk2(acc[et][4 * g4 + 2] * rn * g2 * sigmoidf_(g2), acc[et][4 * g4 + 3] * rn * g3 * sigmoidf_(g3));
            *(v2u*)(RET + e0) = w; }
}

__device__ __forceinline__ void p3_scans(const Ctx& C, const Args& a) {
    constexpr int NSKIP = 16;
    if ((int)blockIdx.x < NSKIP) return;
    const int w0 = ((int)blockIdx.x - NSKIP) * 512 + C.tid, NW = (C.G - NSKIP) * 512;
    {
        const float* KV = a.out; bf16* PREV = (bf16*)((unsigned char*)a.out + 64 * MiB);
        for (int it = w0; it < 131072; it += NW) {
            const int elem = it * 4, b = elem >> 16, h = (elem >> 14) & 3, ed = elem & 16383;
            const float cd = __builtin_amdgcn_exp2f(128.0f * lg2_gamma(h));
            const float* kp = KV + (size_t)(b * 128 + h) * 16384 + ed; bf16* pp = PREV + (size_t)(b * 128 + h) * 16384 + frag32(ed >> 7, ed & 127, 128);
            f32x4 inc[32];
#pragma unroll
            for (int c = 0; c < 32; ++c) inc[c] = *(const f32x4*)(kp + (size_t)c * 65536);
            f32x4 st = {0.f, 0.f, 0.f, 0.f};
#pragma unroll
            for (int c = 0; c < 32; ++c) { v2u w; w.x = pk2(st[0], st[1]); w.y = pk2(st[2], st[3]); *(v2u*)(pp + (size_t)c * 65536) = w; st = st * cd + inc[c]; }
        }
    }
    {
        const float* E = (const float*)(a.ws + WS_S5E); float* X = (float*)(a.ws + WS_S5X); const float* L128 = (const float*)(a.ws + WS_S5C) + 2048;
        for (int it = w0; it < 8192; it += NW) {
            const int b = it >> 10, g = (it >> 6) & 15, p = it & 63;
            const float lr = L128[(g * 64 + p) * 2], li = L128[(g * 64 + p) * 2 + 1];
            const float* ep = E + ((size_t)(b * 32) * 16 + g) * 128 + p; float* xp = X + ((size_t)(b * 32) * 16 + g) * 128 + p;
            float er[32], ei[32];
#pragma unroll
            for (int n = 0; n < 32; ++n) { er[n] = ep[(size_t)n * 2048]; ei[n] = ep[(size_t)n * 2048 + 64]; }
            float xr = 0.f, xi = 0.f;
#pragma unroll
            for (int n = 0; n < 32; ++n) { xp[(size_t)n * 2048] = xr; xp[(size_t)n * 2048 + 64] = xi;
                const float nr = lr * xr - li * xi + er[n], ni = lr * xi + li * xr + ei[n]; xr = nr; xi = ni; }
        }
    }
}

__device__ __forceinline__ int f2key(float x) { int b = __builtin_bit_cast(int, x); return b >= 0 ? b : (b ^ 0x7fffffff); }
__device__ __forceinline__ float key2f(int k) { return __builtin_bit_cast(float, k >= 0 ? k : (k ^ 0x7fffffff)); }
__device__ __forceinline__ void ce_desc(int& x, int& y) { const int hi = x > y ? x : y, lo = x > y ? y : x; x = hi; y = lo; }
__device__ __forceinline__ void sort16_desc(int (&v)[16]) {
#pragma unroll
    for (int k = 2; k <= 16; k <<= 1)
#pragma unroll
        for (int j = k >> 1; j > 0; j >>= 1)
#pragma unroll
            for (int i = 0; i < 16; ++i) { const int l = i ^ j; if (l > i) { if ((i & k) == 0) ce_desc(v[i], v[l]); else ce_desc(v[l], v[i]); } }
}
__device__ __forceinline__ void merge16_desc(int (&T)[16], const int (&N)[16]) {
#pragma unroll
    for (int i = 0; i < 16; ++i) T[i] = T[i] > N[15 - i] ? T[i] : N[15 - i];
#pragma unroll
    for (int j = 8; j > 0; j >>= 1)
#pragma unroll
        for (int i = 0; i < 16; ++i) { const int l = i ^ j; if (l > i) ce_desc(T[i], T[l]); }
}
__device__ __forceinline__ void peer_topk_half(const Args& a, int tokbase, int hp, int c, int lane, int (&T)[16]) {
    const bf16* Q2 = (const bf16*)(a.ws + WS_Q2); const bf16* KEYS = (const bf16*)(a.ws + WS_KEYS);
    const int r = lane & 31, hh = lane >> 5;
    bf16x8 bq[8];
#pragma unroll
    for (int ks = 0; ks < 8; ++ks) bq[ks] = *(const bf16x8*)(Q2 + ((((size_t)(tokbase >> 5) * 16 + hp * 2 + c) * 8 + ks) * 64 + lane) * 8);
    const bf16* kbase = KEYS + (size_t)(hp * 2 + c) * 16384 + lane * 8;
    bf16x8 akc[8], akn[8];
#pragma unroll
    for (int ks = 0; ks < 8; ++ks) akc[ks] = *(const bf16x8*)(kbase + ks * 512);
#pragma unroll
    for (int nt = 0; nt < 4; ++nt) {
        if (nt < 3) {
#pragma unroll
            for (int ks = 0; ks < 8; ++ks) akn[ks] = *(const bf16x8*)(kbase + ((nt + 1) * 8 + ks) * 512);
        }
        __builtin_amdgcn_sched_barrier(0);
        f32x16 s;
#pragma unroll
        for (int e = 0; e < 16; ++e) s[e] = 0.f;
#pragma unroll
        for (int ks = 0; ks < 8; ++ks) s = mfma32(akc[ks], bq[ks], s);
        int N[16];
#pragma unroll
        for (int e = 0; e < 16; ++e) { const int n = nt * 32 + (e & 3) + 8 * (e >> 2) + 4 * hh; N[e] = (f2key(s[e]) & ~127) | n; }
        sort16_desc(N);
        if (nt == 0) {
#pragma unroll
            for (int e = 0; e < 16; ++e) T[e] = N[e];
        } else merge16_desc(T, N);
        __builtin_amdgcn_sched_barrier(0);
#pragma unroll
        for (int ks = 0; ks < 8; ++ks) akc[ks] = akn[ks];
    }
    int P[16];
#pragma unroll
    for (int j = 0; j < 16; ++j) P[j] = __shfl_xor(T[j], 32);
    merge16_desc(T, P);
}
__device__ __forceinline__ void peer_topk_head(const Ctx& C, const Args& a, int tokbase, int hp) {
    const int lane = C.lane, r = lane & 31, hh = lane >> 5;
    int T0[16], T1[16];
    peer_topk_half(a, tokbase, hp, 0, lane, T0);
    peer_topk_half(a, tokbase, hp, 1, lane, T1);
    int F[16], L1[16], L2[16], L3[16];
#pragma unroll
    for (int j = 0; j < 16; ++j) { L1[j] = (int)0x80000000; L2[j] = (int)0x80000000; L3[j] = (int)0x80000000; }
    {
        int cnt = 0;
#pragma unroll
        for (int i0 = 0; i0 < 16; ++i0)
#pragma unroll
            for (int i1 = 0; i1 < 16; ++i1)
                if ((i0 + 1) * (i1 + 1) <= 16) {
                    const float v = key2f(T0[i0] & ~127) + key2f(T1[i1] & ~127); const int key = (f2key(v) & ~255) | (i0 * 16 + i1);
                    if (i0 == 0) F[i1] = key;
                    else { if (cnt < 16) L1[cnt] = key; else if (cnt < 32) L2[cnt - 16] = key; else L3[cnt - 32] = key; ++cnt; }
                }
    }
    sort16_desc(L1); merge16_desc(F, L1); sort16_desc(L2); merge16_desc(F, L2); sort16_desc(L3); merge16_desc(F, L3);
    LAS int* tab = (LAS int*)(C.lds + C.wave * 16384);
#pragma unroll
    for (int j = 0; j < 16; ++j) { tab[j * 64 + lane] = T0[j] & 127; tab[(16 + j) * 64 + lane] = T1[j] & 127; }
    LDS_WAIT(); asm volatile("" ::: "memory");
    const float m = key2f(F[0] & ~255);
    float e[16], sum = 0.f;
#pragma unroll
    for (int j = 0; j < 16; ++j) { e[j] = __builtin_amdgcn_exp2f((key2f(F[j] & ~255) - m) * 1.4426950408889634f); sum += e[j]; }
    const float inv = 1.0f / sum;
    const int tok = tokbase + r;
    int* IDX = (int*)(a.ws + WS_IDX) + (size_t)tok * 128 + hp * 16; float* WGT = (float*)(a.ws + WS_WGT) + (size_t)tok * 128 + hp * 16;
    unsigned ov[16];
#pragma unroll
    for (int j = 0; j < 16; ++j) { const int id = F[j] & 255; const int k0 = tab[(id >> 4) * 64 + lane], k1 = tab[(16 + (id & 15)) * 64 + lane];
        ov[j] = (hh == 0) ? (unsigned)(k0 * 128 + k1) : __builtin_bit_cast(unsigned, e[j] * inv); }
    unsigned* obase = (hh == 0) ? (unsigned*)IDX : (unsigned*)WGT;
#pragma unroll
    for (int q = 0; q < 4; ++q) { v4u w = {ov[4 * q], ov[4 * q + 1], ov[4 * q + 2], ov[4 * q + 3]}; *(v4u*)(obase + 4 * q) = w; }
    LDS_WAIT(); asm volatile("" ::: "memory");
}
typedef float f32x2v __attribute__((ext_vector_type(2)));
__device__ __forceinline__ void unpack16(const v4u a, const v4u b, float (&x)[16]) {
    const unsigned w[8] = {a.x, a.y, a.z, a.w, b.x, b.y, b.z, b.w};
#pragma unroll
    for (int i = 0; i < 8; ++i) { x[2 * i] = bflo(w[i]); x[2 * i + 1] = bfhi(w[i]); }
}
__device__ __forceinline__ void unpack16_fp8(const v4u a, float (&x)[16]) {
    const unsigned w[4] = {a.x, a.y, a.z, a.w};
#pragma unroll
    for (int i = 0; i < 4; ++i) { const f32x2v lo = __builtin_amdgcn_cvt_pk_f32_fp8((int)w[i], false), hi = __builtin_amdgcn_cvt_pk_f32_fp8((int)w[i], true);
        x[4 * i] = lo.x; x[4 * i + 1] = lo.y; x[4 * i + 2] = hi.x; x[4 * i + 3] = hi.y; }
}
__device__ __forceinline__ long mk64(unsigned lo, unsigned hi) { return (long)(((unsigned long long)hi << 32) | (unsigned long long)lo); }
__device__ __forceinline__ float dpp_swap1(float v) { return __builtin_bit_cast(float, __builtin_amdgcn_update_dpp(0, __builtin_bit_cast(int, v), 0xB1, 0xf, 0xf, true)); }
struct PHalf { v4u g[8]; };
struct PIdx { int e[8]; };
__device__ __forceinline__ void pg_idx8(const int* IDXr, int h, int hl, PIdx& I) {
    h = min(h, hl); const int* p = IDXr + (size_t)(h >> 1) * 128 + (h & 1) * 64;
#pragma unroll
    for (int j = 0; j < 8; ++j) I.e[j] = p[j * 8];
}
__device__ __forceinline__ void pg_issue(const unsigned char* TBL, const PIdx& I, int lane, PHalf& D) {
    const unsigned c16 = (unsigned)(lane & 7) * 16u;
#pragma unroll
    for (int j = 0; j < 8; ++j) D.g[j] = *(const v4u*)(TBL + ((unsigned)I.e[j] * 128u + c16));
}
__device__ __forceinline__ void pg_stage(LAS unsigned char* buf, int lane, const PHalf& D) {
    const int row8 = lane >> 3, c8 = lane & 7;
#pragma unroll
    for (int j = 0; j < 8; ++j) *(LAS v4u*)(buf + (j * 8 + row8) * 128 + ((c8 ^ row8) & 7) * 16) = D.g[j];
}
__device__ __forceinline__ void pg_stage_v(LAS unsigned char* buf, int lane, const PHalf& D) {
    const int row8 = lane >> 3, c8 = lane & 7;
#pragma unroll
    for (int j = 0; j < 8; ++j) { const v4u g = D.g[j]; const v4u w = ((j >> 1) & 1) ? (v4u){g.z, g.w, g.x, g.y} : g;
        *(LAS v4u*)(buf + (j * 8 + row8) * 128 + ((c8 ^ ((row8 >> 1) | ((j & 1) << 2))) & 7) * 16) = w; }
}
__device__ __forceinline__ void e2m1_qv(float y, unsigned& code, float& val) {
    const float m = fminf(fabsf(y), 6.0f);
    const unsigned rb = (__builtin_bit_cast(unsigned, m) + 0x00200000u) & 0xFFC00000u;
    const float sm = 0.5f * rintf(2.0f * m);
    const bool big = m >= 1.0f;
    const float v = big ? __builtin_bit_cast(float, rb) : sm;
    const unsigned c = big ? (rb >> 22) - 252u : (unsigned)(2.0f * sm);
    const unsigned sg = __builtin_bit_cast(unsigned, y) & 0x80000000u;
    code = c | (sg >> 28); val = __builtin_bit_cast(float, __builtin_bit_cast(unsigned, v) | sg);
}
__device__ __forceinline__ void pu_xprep(LAS unsigned char* xs, v2u xw, float sx, int lane) {
    const float x[4] = {bflo(xw.x) * sx, bfhi(xw.x) * sx, bflo(xw.y) * sx, bfhi(xw.y) * sx};
    unsigned hi = 0u, lo = 0u;
#pragma unroll
    for (int j = 0; j < 4; ++j) { unsigned c0, c1; float v0, v1; e2m1_qv(x[j], c0, v0); e2m1_qv((x[j] - v0) * 4.0f, c1, v1); hi |= c0 << (4 * j); lo |= c1 << (4 * j); }
    *(LAS unsigned short*)(xs + 2 * lane) = (unsigned short)hi; *(LAS unsigned short*)(xs + 128 + 2 * lane) = (unsigned short)lo;
}
typedef int v8i_t __attribute__((ext_vector_type(8)));
__device__ __forceinline__ void pu_compute(const LAS unsigned char* buf, bf16* HPt, int r, int kq, const v4u (&bfr)[2]) {
    f32x4 res[4];
    const int sclB = (r & 1) ? 0x7d7d7d7d : 0x7f7f7f7f;
    const v8i_t bv0 = {(int)bfr[0].x, (int)bfr[0].y, (int)bfr[0].z, (int)bfr[0].w, 0, 0, 0, 0}, bv1 = {(int)bfr[1].x, (int)bfr[1].y, (int)bfr[1].z, (int)bfr[1].w, 0, 0, 0, 0};
#pragma unroll
    for (int g = 0; g < 4; ++g) {
        const int row = g * 16 + r, sw = row & 7;
        const v4u a0 = *(const LAS v4u*)(buf + row * 128 + (kq ^ sw) * 16), a1 = *(const LAS v4u*)(buf + row * 128 + ((4 + kq) ^ sw) * 16);
        const v8i_t av0 = {(int)a0.x, (int)a0.y, (int)a0.z, (int)a0.w, 0, 0, 0, 0}, av1 = {(int)a1.x, (int)a1.y, (int)a1.z, (int)a1.w, 0, 0, 0, 0};
        res[g] = __builtin_amdgcn_mfma_scale_f32_16x16x128_f8f6f4(av0, bv0, (f32x4){0.f, 0.f, 0.f, 0.f}, 4  , 4  , 0, 0x7f7f7f7f, 0, sclB);
        res[g] = __builtin_amdgcn_mfma_scale_f32_16x16x128_f8f6f4(av1, bv1, res[g], 4, 4, 0, 0x7f7f7f7f, 0, sclB);
    }
    f32x4 o = res[0];
#pragma unroll
    for (int g = 1; g < 4; ++g) { const bool sel = ((r >> 1) == g);
#pragma unroll
        for (int i = 0; i < 4; ++i) o[i] = sel ? res[g][i] : o[i]; }
#pragma unroll
    for (int i = 0; i < 4; ++i) o[i] += dpp_swap1(o[i]);
    if (r < 8 && (r & 1) == 0) { v2u w; w.x = pk2(o[0], o[1]); w.y = pk2(o[2], o[3]); *(v2u*)(HPt + (r >> 1) * 16 + 4 * kq) = w; }
}
__device__ __forceinline__ int pg_idx(const int* IDXl, int h, int hl) { h = min(h, hl); return IDXl[(size_t)(h >> 1) * 128 + (h & 1) * 64]; }
__device__ __forceinline__ void peer_u_wave(const Args& a, LAS unsigned char* wlds, LAS unsigned char* wsm, int slab, int t0, int ntok, int lane) {
    const unsigned char* U8 = a.ws + WS_PU + (size_t)slab * (16384 * 128);
    const bf16* N2 = (const bf16*)(a.ws + WS_N2) + slab * 256 + 4 * lane;
    const int* IDX = (const int*)(a.ws + WS_IDX) + (lane >> 3);
    bf16* HP = (bf16*)(a.ws + WS_HPART) + (size_t)slab * MTOK * 128;
    const int r = lane & 15, kq = lane >> 4, tl = t0 + ntok - 1, H0 = 2 * t0, HL = 2 * (t0 + ntok) - 1;
    PHalf d[4]; PIdx iv[4]; v4u bfr[2];
    const float* SSp = (const float*)(a.ws + WS_SS); float ssx = SSp[t0];
#pragma unroll
    for (int k = 0; k < 4; ++k) pg_idx8(IDX, H0 + k, HL, iv[k]);
    v2u xw = *(const v2u*)(N2 + (size_t)t0 * DM);
    pg_issue(U8, iv[0], lane, d[0]); pg_issue(U8, iv[1], lane, d[1]); pg_issue(U8, iv[2], lane, d[2]);
    pg_idx8(IDX, H0 + 4, HL, iv[0]); pg_idx8(IDX, H0 + 5, HL, iv[1]); pg_idx8(IDX, H0 + 6, HL, iv[2]);
    pg_stage(wlds, lane, d[0]);
#define PU_XPREP(tok) do { pu_xprep(wsm, xw, 2.05f * __builtin_amdgcn_rsqf(ssx * (1.f / DM) + EPS), lane); \
        { const LAS unsigned char* bp = wsm + ((r & 1) ? 128 : 0) + kq * 16; bfr[0] = *(const LAS v4u*)bp; bfr[1] = *(const LAS v4u*)(bp + 64); } \
        xw = *(const v2u*)(N2 + (size_t)min((tok) + 1, tl) * DM); ssx = SSp[min((tok) + 1, tl)]; } while (0)
#define PU_PHASE(ph, hrel, tok, half) do { \
        pg_issue(U8, iv[((ph) + 3) & 3], lane, d[((ph) + 3) & 3]); pg_idx8(IDX, hb + (hrel) + 7, HL, iv[((ph) + 3) & 3]); \
        pu_compute(wlds + ((half) ? 8192 : 0), HP + (size_t)(tok) * 128 + (half) * 64, r, kq, bfr); \
        pg_stage(wlds + ((half) ? 0 : 8192), lane, d[((ph) + 1) & 3]); } while (0)
#pragma unroll 1
    for (int hb = H0; hb <= HL; hb += 4) {
        const int t = hb >> 1;
        PU_XPREP(t);
        PU_PHASE(0, 0, t, 0);
        PU_PHASE(1, 1, t, 1);
        PU_XPREP(t + 1);
        PU_PHASE(2, 2, t + 1, 0);
        PU_PHASE(3, 3, t + 1, 1);
    }
#undef PU_XPREP
#undef PU_PHASE
}
__device__ __forceinline__ void peer_reduce(const Ctx& C, const Args& a) {
    const bf16* HP = (const bf16*)(a.ws + WS_HPART); const int* IDX = (const int*)(a.ws + WS_IDX); const float* WGT = (const float*)(a.ws + WS_WGT);
    const f32x2v* SC2 = (const f32x2v*)(a.ws + WS_PSC);
    unsigned char* ACT8 = a.ws + WS_ACT; float* ASC = (float*)(a.ws + WS_ACT + 8 * MiB);
    for (int it = C.vcu * 512 + C.tid; it < MTOK * 32; it += C.G * 512) {
        f32x4 h = {0.f, 0.f, 0.f, 0.f};
#pragma unroll
        for (int sl = 0; sl < 4; ++sl) { const v2u w = *(const v2u*)(HP + (size_t)sl * MTOK * 128 + (size_t)it * 4); h[0] += bflo(w.x); h[1] += bfhi(w.x); h[2] += bflo(w.y); h[3] += bfhi(w.y); }
        const int4 e = *(const int4*)(IDX + (size_t)it * 4); const f32x4 w = *(const f32x4*)(WGT + (size_t)it * 4);
        const int tok = it >> 5, q = it & 31;
        const float rs = 1.0f / 2.05f;
        f32x4 o;
        const f32x2v s0 = SC2[e.x], s1 = SC2[e.y], s2 = SC2[e.z], s3 = SC2[e.w];
        o[0] = gelu_tanh(h[0] * s0.x * rs) * w[0] * s0.y; o[1] = gelu_tanh(h[1] * s1.x * rs) * w[1] * s1.y;
        o[2] = gelu_tanh(h[2] * s2.x * rs) * w[2] * s2.y; o[3] = gelu_tanh(h[3] * s3.x * rs) * w[3] * s3.y;
        float mx = fmaxf(fmaxf(fabsf(o[0]), fabsf(o[1])), fmaxf(fabsf(o[2]), fabsf(o[3])));
#pragma unroll
        for (int sh = 1; sh < 32; sh <<= 1) mx = fmaxf(mx, __shfl_xor(mx, sh));
        const bool tiny = mx < 1e-30f;
        const float sc = tiny ? 1.f : 6.0f / mx, isc = tiny ? 1.f : mx * (1.0f / 6.0f);
        unsigned hi = 0u, lo = 0u;
#pragma unroll
        for (int j = 0; j < 4; ++j) { unsigned c0, c1; float v0, v1; e2m1_qv(o[j] * sc, c0, v0); e2m1_qv((o[j] * sc - v0) * 4.0f, c1, v1); hi |= c0 << (4 * j); lo |= c1 << (4 * j); }
        *(unsigned short*)(ACT8 + (size_t)tok * 128 + 2 * q) = (unsigned short)hi; *(unsigned short*)(ACT8 + (size_t)tok * 128 + 64 + 2 * q) = (unsigned short)lo;
        if (q == 0) ASC[tok] = isc;
    }
}
typedef int v2i_t __attribute__((ext_vector_type(2)));
__device__ __forceinline__ void pv_compute8(unsigned a0, unsigned a1, int nb0, const v4u bact, int sclB, f32x4 (&acc)[8]) {
    const v8i_t bv = {(int)bact.x, (int)bact.y, (int)bact.z, (int)bact.w, 0, 0, 0, 0};
    asm volatile("" : "+v"(a0), "+v"(a1));
#pragma unroll
    for (int nbi = 0; nbi < 8; ++nbi) {
        const unsigned x8 = (unsigned)(nb0 + nbi) * 8u;
        const v2i_t r0 = __builtin_amdgcn_ds_read_tr4_b64_v2i32((LAS v2i_t*)(a0 ^ x8)), r1 = __builtin_amdgcn_ds_read_tr4_b64_v2i32((LAS v2i_t*)(a1 ^ x8));
        const v8i_t av = {r0.x, r0.y, r1.x, r1.y, 0, 0, 0, 0};
        acc[nbi] = __builtin_amdgcn_mfma_scale_f32_16x16x128_f8f6f4(av, bv, (f32x4){0.f, 0.f, 0.f, 0.f}, 4, 4, 0, 0x7f7f7f7f, 0, sclB);
    }
}
__device__ __forceinline__ void peer_v_wave(const Args& a, LAS unsigned char* wlds, int slab, int t0, int ntok, int lane) {
    const unsigned char* V8 = a.ws + WS_PV + (size_t)slab * (16384 * 128);
    const int* IDX = (const int*)(a.ws + WS_IDX) + (lane >> 3);
    const int n16 = lane & 15, kq = lane >> 4, tl = t0 + ntok - 1, H0 = 2 * t0, HL = 2 * (t0 + ntok) - 1;
    const unsigned char* ACT4 = a.ws + WS_ACT + ((n16 & 1) ? 64 : 0) + 16 * kq; const float* ASC = (const float*)(a.ws + WS_ACT + 8 * MiB);
    const int sclB = (n16 & 1) ? 0x7d7d7d7d : 0x7f7f7f7f;
    const unsigned wl32 = (unsigned)(size_t)wlds;
    const unsigned ra0 = wl32 + (unsigned)((32 * kq + 16 * (kq & 1) + n16) * 128 + (n16 >> 1) * 16 + 8 * (kq & 1));
    const unsigned ra1 = wl32 + (unsigned)((32 * kq + 16 * (1 - (kq & 1)) + n16) * 128 + (n16 >> 1) * 16 + 8 * (1 - (kq & 1)));
    bf16* PO = (bf16*)(a.ws + WS_POUT) + slab * 256;
    PHalf d[4]; PIdx iv[4]; v4u bact, bnxt; f32x4 acc[8]; float isc = 1.f, iscn;
#pragma unroll
    for (int k = 0; k < 4; ++k) pg_idx8(IDX, H0 + k, HL, iv[k]);
    const int o0 = 8 * (kq & 1), o1 = 8 - o0;
    { const v2u b0 = *(const v2u*)(ACT4 + (size_t)t0 * 128 + o0), b1 = *(const v2u*)(ACT4 + (size_t)t0 * 128 + o1); bnxt = (v4u){b0.x, b0.y, b1.x, b1.y}; } iscn = ASC[t0];
    pg_issue(V8, iv[0], lane, d[0]); pg_issue(V8, iv[1], lane, d[1]); pg_issue(V8, iv[2], lane, d[2]); pg_issue(V8, iv[3], lane, d[3]);
#pragma unroll
    for (int k = 0; k < 4; ++k) pg_idx8(IDX, H0 + 4 + k, HL, iv[k]);
    pg_stage_v(wlds, lane, d[0]); pg_stage_v(wlds + 8192, lane, d[1]);
#define PV_EPI(tok, cb) do { f32x4 o = acc[0]; \
        _Pragma("unroll") for (int nb = 1; nb < 8; ++nb) { const bool sel = ((n16 >> 1) == nb); \
            _Pragma("unroll") for (int i = 0; i < 4; ++i) o[i] = sel ? acc[nb][i] : o[i]; } \
        _Pragma("unroll") for (int i = 0; i < 4; ++i) o[i] += dpp_swap1(o[i]); \
        if ((n16 & 1) == 0) { v2u w; w.x = pk2(o[0] * isc, o[1] * isc); w.y = pk2(o[2] * isc, o[3] * isc); *(v2u*)(PO + (size_t)(tok) * DM + (cb) + 16 * (n16 >> 1) + 4 * kq) = w; } } while (0)
#define PV_TOKEN(tok) do { bact = bnxt; isc = iscn; \
        { const int tn = min((tok) + 1, tl); const v2u b0 = *(const v2u*)(ACT4 + (size_t)tn * 128 + o0), b1 = *(const v2u*)(ACT4 + (size_t)tn * 128 + o1); bnxt = (v4u){b0.x, b0.y, b1.x, b1.y}; iscn = ASC[tn]; } \
        pv_compute8(ra0, ra1, 0, bact, sclB, acc); PV_EPI(tok, 0); \
        pv_compute8(ra0, ra1, 8, bact, sclB, acc); PV_EPI(tok, 128); } while (0)
#pragma unroll 1
    for (int t = t0; t <= tl; t += 2) {
        const int hb = 2 * t;
        pg_issue(V8, iv[0], lane, d[0]); pg_issue(V8, iv[1], lane, d[1]);
        pg_idx8(IDX, hb + 8, HL, iv[0]); pg_idx8(IDX, hb + 9, HL, iv[1]);
        PV_TOKEN(t);
        pg_stage_v(wlds, lane, d[2]); pg_stage_v(wlds + 8192, lane, d[3]);
        pg_issue(V8, iv[2], lane, d[2]); pg_issue(V8, iv[3], lane, d[3]);
        pg_idx8(IDX, hb + 10, HL, iv[2]); pg_idx8(IDX, hb + 11, HL, iv[3]);
        PV_TOKEN(t + 1);
        pg_stage_v(wlds, lane, d[0]); pg_stage_v(wlds + 8192, lane, d[1]);
    }
#undef PV_EPI
#undef PV_TOKEN
}
__device__ __forceinline__ void final_rows4(const Args& a, int tok0, int tstep, int lane) {
    const float* gf = (const float*)a.in[25] + lane * 4;
    f32x4 h[4][4]; v2u pw[4][4], hw[4][4]; float ss[4];
#pragma unroll
    for (int i = 0; i < 4; ++i) { const int tok = tok0 + i * tstep; const bf16* hb = (const bf16*)(a.ws + WS_N2) + (size_t)tok * DM + lane * 4; const bf16* po = (const bf16*)(a.ws + WS_POUT) + (size_t)tok * DM + lane * 4;
#pragma unroll
        for (int q = 0; q < 4; ++q) { hw[i][q] = *(const v2u*)(hb + 256 * q); pw[i][q] = *(const v2u*)(po + 256 * q); } }
#pragma unroll
    for (int i = 0; i < 4; ++i) { ss[i] = 0.f;
#pragma unroll
        for (int q = 0; q < 4; ++q) { h[i][q][0] = bflo(hw[i][q].x) + bflo(pw[i][q].x); h[i][q][1] = bfhi(hw[i][q].x) + bfhi(pw[i][q].x); h[i][q][2] = bflo(hw[i][q].y) + bflo(pw[i][q].y); h[i][q][3] = bfhi(hw[i][q].y) + bfhi(pw[i][q].y);
            ss[i] += (h[i][q][0] * h[i][q][0] + h[i][q][1] * h[i][q][1]) + (h[i][q][2] * h[i][q][2] + h[i][q][3] * h[i][q][3]); } }
#pragma unroll
    for (int o = 1; o < 64; o <<= 1)
#pragma unroll
        for (int i = 0; i < 4; ++i) ss[i] += __shfl_xor(ss[i], o);
    f32x4 g[4];
#pragma unroll
    for (int q = 0; q < 4; ++q) g[q] = *(const f32x4*)(gf + 256 * q);
#pragma unroll
    for (int i = 0; i < 4; ++i) { const float rstd = 1.0f / sqrtf(ss[i] * (1.f / DM) + EPS); float* orow = a.out + (size_t)(tok0 + i * tstep) * DM + lane * 4;
#pragma unroll
        for (int q = 0; q < 4; ++q) *(f32x4*)(orow + 256 * q) = h[i][q] * rstd * g[q]; }
}

__device__ __forceinline__ void claim_slab_unit(const Ctx& C, unsigned* ctl, int pass, volatile LAS unsigned* MISC, int& slab, int& unit) {
    if (C.tid == 0) {
        const unsigned ns = 4u, nu = 64u;
        const unsigned x = xb_xcc_id() & (ns - 1u); unsigned sl = 8u, un = 0u;
        for (unsigned k = 0; k < ns; ++k) { const unsigned s2 = (x + k) & (ns - 1u); const unsigned u2 = xb_add(ctl + CW_Q + 1024 * pass + 64 * s2, 1u); if (u2 < nu) { sl = s2; un = u2; break; } }
        MISC[16] = sl; MISC[17] = un;
    }
    __syncthreads();
    slab = (int)MISC[16]; unit = (int)MISC[17];
    __syncthreads();
}
__global__ void __launch_bounds__(NWAVES * 64, 2) mk_fwd(Args args) {
    extern __shared__ __attribute__((aligned(16))) unsigned char lds_raw[];
    Ctx C;
    C.lds = (LAS unsigned char*)lds_raw;
    C.wave = __builtin_amdgcn_readfirstlane((int)threadIdx.x >> 6); C.refresh();
    C.G = gridDim.x; { const int bx = blockIdx.x; C.vcu = (C.G % 8 == 0) ? (bx % 8) * (C.G / 8) + bx / 8 : bx; }
    volatile LAS unsigned* MISC = (volatile LAS unsigned*)(C.lds + MISC_OFF);
    if (C.tid < 128) MISC[C.tid] = 0u;
    __syncthreads();
    unsigned char* ws = args.ws;
    unsigned* ctl = (unsigned*)(ws + WS_CTL);
    XcdBarrier bar; bar.bar = ctl + CW_BAR; bar.x = 0; bar.st = nullptr;
#if !MK_PER_PHASE
    bar = xcd_barrier_post(ctl + CW_BAR, MISC + 8, C.tid == 0);
#define GRID_BAR() xcd_barrier(bar, C.wave)
#else
#define GRID_BAR() do { } while (0)
#endif
    const int lo = args.ph_lo, hi = args.ph_hi;
#define IN(k) (lo <= (k) && (k) < hi)
#define SEAM(k) do { if (IN((k) + 1)) GRID_BAR(); C.refresh(); } while (0)
#define REP(k) for (int rep_ = 0; rep_ < 1 + ((REPEAT_MASK >> (k)) & 1); ++rep_)
    bf16* XN = (bf16*)(ws + WS_A);
    if (IN(0)) { REP(0) { p0_prologue(C, args); __syncthreads(); } SEAM(0); }
    if (IN(1)) {
        REP(1) {
        run_gemm_i8(C, ws + WS_XN8, ws + WS_WIN8, MTOK, NZ1, DM, FStoreI8{(bf16*)(ws + WS_Z1), NZ1, (const float*)(ws + WS_RSX), (const float*)(ws + WS_CSW)});
        }
        SEAM(1);
    }
    if (IN(2)) {
        REP(2) { const int tile = C.vcu;
            {
                const int i_ = C.tid >> 2, dq_ = (C.tid & 3) * 16, eq_ = (C.tid & 3) * 32;
                const bf16* zr_ = (const bf16*)(ws + WS_Z1) + (size_t)(tile * 128 + i_) * NZ1; const float* rp_ = (const float*)(ws + WS_ROPE) + (size_t)(tile * 128 + i_) * 128;
                float cs_[16], sn_[16];
#pragma unroll
                for (int q = 0; q < 4; ++q) { const f32x4 c4 = *(const f32x4*)(rp_ + dq_ + 4 * q), s4 = *(const f32x4*)(rp_ + 64 + dq_ + 4 * q);
#pragma unroll
                    for (int e = 0; e < 4; ++e) { cs_[4 * q + e] = c4[e]; sn_[4 * q + e] = s4[e]; } }
                R1In ra_, rb_;
                r1_load(zr_, 0, dq_, eq_, ra_);
                _Pragma("unroll 1") for (int h2 = 0; h2 < 4; h2 += 2) {
                    r1_unit(C, args, tile, h2, cs_, sn_, ra_, rb_, true);
                    r1_unit(C, args, tile, h2 + 1, cs_, sn_, rb_, ra_, h2 == 0);
                }
            }
            C.refresh();
            _Pragma("unroll 1") for (int gi = 0; gi < 2; ++gi) s5a_wave(C, args, tile, C.wave + 8 * gi);
            __syncthreads();
        }
        SEAM(2);
    }
    if (IN(3)) { REP(3) { p3_scans(C, args); }
        run_gemm(C, (const bf16*)(ws + WS_MEMN), (const bf16*)(ws + WS_WMKV_T), MROWS, 512, DM, FKvm{(bf16*)(ws + WS_KM), (bf16*)(ws + WS_VT)});
        SEAM(3); }
    if (IN(4)) {
        REP(4) { const int tile = C.vcu;
            _Pragma("unroll 1") for (int gi = 0; gi < 2; ++gi) r3_wave(C, args, tile, 2 * gi + (C.wave >> 2), C.wave & 3);
            _Pragma("unroll 1") for (int gi = 0; gi < 2; ++gi) s5c_wave(C, args, tile, C.wave + 8 * gi);
            _Pragma("unroll 1") for (int gi = 0; gi < 2; ++gi) ma_wave(C, args, tile, 2 * gi + (C.wave >> 2), C.wave & 3);
        }
        SEAM(4);
    }
    if (IN(5)) {
        REP(5) {
        run_gemm_i8(C, ws + WS_XN8, ws + WS_WIN8 + (size_t)NZ1 * DM, MTOK, NGATE, DM, FSigI8{ws + WS_G, NGATE, (const float*)(ws + WS_RSX), (const float*)(ws + WS_CSW) + NZ1});
        run_gemm(C, (const bf16*)(ws + WS_YG), (const bf16*)(ws + WS_WGLU_T), MTOK, 512, 256, FGlu{(bf16*)(ws + WS_YCAT)});
        }
        SEAM(5);
    }
    if (IN(6)) {
        const unsigned char* Gt = ws + WS_G;
        run_gemm_hook(C, (const bf16*)(ws + WS_YCAT), (const bf16*)(ws + WS_WCAT_T), MTOK, DM, DM, FGateOut{Gt, XN}, HookGate{Gt});
        SEAM(6);
    }
    if (IN(7)) { run_gemm(C, XN, (const bf16*)(ws + WS_WOUT_T), MTOK, DM, DM, FRes{(const float*)args.in[0], (bf16*)(ws + WS_N2), (float*)(ws + WS_SS)}); SEAM(7); }
    if (IN(9)) { REP(9) run_gemm(C, (const bf16*)(ws + WS_N2), (const bf16*)(ws + WS_WQ_T), MTOK, 2048, DM, FStoreRstd{(bf16*)(ws + WS_Q2), 2048, (const float*)(ws + WS_SS)}); SEAM(9); }
    if (IN(10)) {
        { const int tile = C.vcu;
            const int tokbase = tile * 128 + (C.wave & 3) * 32, h0 = (C.wave >> 2) * 4;
            REP(10) { _Pragma("unroll 1") for (int hp = h0; hp < h0 + 4; ++hp) peer_topk_head(C, args, tokbase, hp); }
        }
        SEAM(10);
    }
    if (IN(11)) { int slab, unit; claim_slab_unit(C, ctl, 0, MISC, slab, unit); if (slab < 8) { REP(11) peer_u_wave(args, C.lds + C.wave * 16384, C.lds + 131072 + C.wave * 1024, slab, unit * 512 + C.wave * 64, 64, C.lane); } SEAM(11); }
    if (IN(12)) { REP(12) peer_reduce(C, args); SEAM(12); }
    if (IN(13)) { int slab, unit; claim_slab_unit(C, ctl, 1, MISC, slab, unit); if (slab < 8) { REP(13) peer_v_wave(args, C.lds + C.wave * 16384, slab, unit * 512 + C.wave * 64, 64, C.lane); } SEAM(13); }
    if (IN(14)) {
        const int gw = C.vcu * NWAVES + C.wave, NGW = C.G * NWAVES;
        for (int m = gw; m < MTOK; m += 4 * NGW) final_rows4(args, m, NGW, C.lane);
    }
#undef IN
#undef SEAM
}

extern "C" void kernel_launch(void* const* d_in, const int* in_sizes, int n_in, void* d_out, int out_size, void* d_ws, size_t ws_size, hipStream_t stream) {
    static int grid = 0;
    if (grid == 0) {
        if (n_in != 26 || in_sizes[0] != MTOK * DM || out_size != MTOK * DM || ws_size < WS_END) {
            fprintf(stderr, "kernel_launch: unexpected problem (n_in %d, in0 %d, out %d, ws %zu < %zu); nothing launched\n", n_in, n_in > 0 ? in_sizes[0] : -1, out_size, ws_size, (size_t)WS_END); grid = -1; return; }
        int dev = 0, cus = 0;
        if (hipGetDevice(&dev) != hipSuccess || hipDeviceGetAttribute(&cus, hipDeviceAttributeMultiprocessorCount, dev) != hipSuccess) { grid = -1; return; }
        if (hipFuncSetAttribute((const void*)mk_fwd, hipFuncAttributeMaxDynamicSharedMemorySize, LDS_BYTES) != hipSuccess) { fprintf(stderr, "kernel_launch: hipFuncSetAttribute failed\n"); grid = -1; return; }
        (void)hipGetLastError();
        if (cus < NTILES) { fprintf(stderr, "kernel_launch: needs >= 256 CUs, got %d\n", cus); grid = -1; return; }
        grid = NTILES;
    }
    if (grid < 0) return;
    (void)hipMemsetAsync((char*)d_ws + WS_CTL, 0, CTL_ZERO_BYTES, stream);
    Args a{};
    for (int i = 0; i < 26; ++i) a.in[i] = d_in[i];
    a.out = (float*)d_out; a.ws = (unsigned char*)d_ws;
#if MK_PER_PHASE
    for (int p = 0; p < NPHASE; ++p) { a.ph_lo = p; a.ph_hi = p + 1; hipLaunchKernelGGL(mk_fwd, dim3(grid), dim3(NWAVES * 64), LDS_BYTES, stream, a); }
#else
    a.ph_lo = 0; a.ph_hi = NPHASE;
    hipLaunchKernelGGL(mk_fwd, dim3(grid), dim3(NWAVES * 64), LDS_BYTES, stream, a);
#endif
}
```

```cpp
#include <hip/hip_runtime.h>
#include <cstdio>
#include <cstdint>
namespace pg8 {
__device__ __forceinline__ int hw_lane_id() { int l; asm volatile("v_mbcnt_lo_u32_b32 %0, -1, 0\n\tv_mbcnt_hi_u32_b32 %0, -1, %0" : "=v"(l)); return l; }
#define PG8_LAS __attribute__((address_space(3)))
typedef unsigned short bf16_t;
typedef short bf16x8 __attribute__((ext_vector_type(8)));
typedef float f32x4 __attribute__((ext_vector_type(4)));
typedef unsigned u32x4 __attribute__((ext_vector_type(4)));
constexpr int BM = 256, BK = 64, HALF = 128, HTB = HALF * BK * 2  , STAGE_BYTES = 8 * HTB, NXCD = 8, WGM = 8;

__host__ __device__ __forceinline__ int lds_byte(int r, int c) { const int st = (r >> 4) * 2 + (c >> 5), rr = r & 15, cc = c & 31, ob = rr * 64 + cc * 2; return st * 1024 + (ob ^ (((ob >> 9) & 1) << 5)); }
__host__ __device__ __forceinline__ void stage_rc(int b, int& R, int& C) { const int st = b / 1024, sb = b % 1024, swz = sb ^ (((sb >> 9) & 1) << 5); R = (st >> 1) * 16 + swz / 64; C = (st & 1) * 32 + (swz % 64) / 2; }
__host__ __device__ __forceinline__ int perm32(int rho) { const int n = rho >> 4, i = rho & 15; return 8 * (i >> 2) + 4 * n + (i & 3); }

struct Unit { int pm, pn; };
struct Gemm { const bf16_t* A; const bf16_t* Bt; int M, N, K; };

struct StaticOrder {
    int nM, nN, nwg, G, c;
    __host__ __device__ void init(int M, int N, int G_, int c_) { nM = M / BM; nN = N / BM; nwg = nM * nN; G = G_; c = c_; }
    __host__ __device__ bool next(int i, Unit& u) const {
        const long L = (long)i * G + c; if (L >= nwg) return false;
        int wgid = (int)L; { const int q = nwg / NXCD, r = nwg % NXCD, xcd = wgid % NXCD, off = wgid / NXCD; wgid = (xcd < r ? xcd * (q + 1) : r * (q + 1) + (xcd - r) * q) + off; }
        const int nig = WGM * nN, gid = wgid / nig, fm = gid * WGM, gsz = (nM - fm) < WGM ? (nM - fm) : WGM;
        u.pm = fm + ((wgid % nig) % gsz); u.pn = (wgid % nig) / gsz; return true;
    }
    __device__ __forceinline__ void a_ready(const Unit&) const {}
    __device__ __forceinline__ void done(const Unit&) const {}
};

__device__ __forceinline__ unsigned cvt_pk_bf16(float lo, float hi) { unsigned r; asm volatile("v_cvt_pk_bf16_f32 %0, %1, %2" : "=v"(r) : "v"(lo), "v"(hi)); return r; }
struct NoKHook { __device__ __forceinline__ void operator()(int, f32x4 (&)[2][2][4][2], const Unit&, int, int, int, int) const {} };
template <class Epi, class Sched, bool ALIGN_EPI = false, bool SP2 = false, bool MX = false, class KHook = NoKHook, bool I8 = false>
__device__ __forceinline__ void gemm_phase(PG8_LAS unsigned char* lds, const Gemm g, const Sched& S, const Epi& E, const int wid, const int sclA = 0x7f7f7f7f, const int sclB = 0x7f7f7f7f, const KHook& KH = KHook()) {
    const int lane = hw_lane_id(), tid = wid * 64 + lane, wr = wid >> 2, wc = wid & 3, fr = lane & 15, fq = lane >> 4;
    const int K = g.K, nt = K / BK;
    unsigned voffA[2], voffB[2];
#pragma unroll
    for (int i = 0; i < 2; ++i) { int R, C; stage_rc(tid * 16 + i * 8192, R, C); const int Rb = Epi::PERM ? ((R & ~31) + perm32(R & 31)) : R;
        voffA[i] = (unsigned)(R * K + C) * 2u; voffB[i] = (unsigned)(Rb * K + C) * 2u; }
    const size_t kstep = (size_t)(BK * 2);
    const size_t hstep = (size_t)HALF * K * 2;
    const size_t tstep = 2 * hstep;
    const unsigned ldsw = (unsigned)wid * 1024u;
    const int aoff = lds_byte(wr * 64 + fr, fq * 8), boff = lds_byte(wc * 32 + fr, fq * 8);
#define PG8_SA(b, h) (((b) * 2 + (h)) * HTB)
#define PG8_SB(b, h) ((4 + (b) * 2 + (h)) * HTB)
#define PG8_STAGE(bufoff, gbase, voff) do { _Pragma("unroll") for (int _i = 0; _i < 2; ++_i) \
        __builtin_amdgcn_global_load_lds((const unsigned*)((const char*)(gbase) + (voff)[_i]), (PG8_LAS unsigned*)(lds + (bufoff) + ldsw + _i * 8192), 16, 0, 0); } while (0)
#define PG8_LDA(dst, b, h) do { _Pragma("unroll") for (int m = 0; m < 4; ++m) { \
        if constexpr (MX) { dst##8[m].lo = *(const PG8_LAS v4i_*)(lds + PG8_SA(b, h) + aoff + m * 2048); dst##8[m].hi = *(const PG8_LAS v4i_*)(lds + PG8_SA(b, h) + aoff + m * 2048 + 1024); } \
        else { _Pragma("unroll") for (int k = 0; k < 2; ++k) dst[m][k] = *(const PG8_LAS bf16x8*)(lds + PG8_SA(b, h) + aoff + m * 2048 + k * 1024); } } } while (0)
#define PG8_LDB(dst, b, h) do { _Pragma("unroll") for (int n = 0; n < 2; ++n) { \
        if constexpr (MX) { dst##8[n].lo = *(const PG8_LAS v4i_*)(lds + PG8_SB(b, h) + boff + n * 2048); dst##8[n].hi = *(const PG8_LAS v4i_*)(lds + PG8_SB(b, h) + boff + n * 2048 + 1024); } \
        else { _Pragma("unroll") for (int k = 0; k < 2; ++k) dst[n][k] = *(const PG8_LAS bf16x8*)(lds + PG8_SB(b, h) + boff + n * 2048 + k * 1024); } } } while (0)
#define PG8_MMA(ai, bj, At, Bt) do { __builtin_amdgcn_s_setprio(1); _Pragma("unroll") for (int m = 0; m < 4; ++m) _Pragma("unroll") for (int n = 0; n < 2; ++n) { \
        if constexpr (MX && I8) { v4i_ c_ = __builtin_bit_cast(v4i_, acc[ai][bj][m][n]); \
            c_ = __builtin_amdgcn_mfma_i32_16x16x64_i8(Bt##8[n].lo, At##8[m].lo, c_, 0, 0, 0); c_ = __builtin_amdgcn_mfma_i32_16x16x64_i8(Bt##8[n].hi, At##8[m].hi, c_, 0, 0, 0); \
            acc[ai][bj][m][n] = __builtin_bit_cast(f32x4, c_); } \
        else if constexpr (MX) acc[ai][bj][m][n] = __builtin_amdgcn_mfma_scale_f32_16x16x128_f8f6f4(Bt##8[n], At##8[m], acc[ai][bj][m][n], 0, 0, 0, sclB, 0, sclA); \
        else { _Pragma("unroll") for (int k = 0; k < 2; ++k) acc[ai][bj][m][n] = __builtin_amdgcn_mfma_f32_16x16x32_bf16(Bt[n][k], At[m][k], acc[ai][bj][m][n], 0, 0, 0); } } \
        if constexpr (MX) { _Pragma("unroll") for (int m = 0; m < 4; ++m) _Pragma("unroll") for (int n = 0; n < 2; ++n) asm volatile("" : "+v"(acc[ai][bj][m][n])); }     \
        __builtin_amdgcn_s_setprio(0); } while (0)
#define PG8_WAIT_V(n) asm volatile("s_waitcnt vmcnt(" #n ")" ::: "memory")
#define PG8_WAIT_L(n) asm volatile("s_waitcnt lgkmcnt(" #n ")" ::: "memory")
#define PG8_BAR __builtin_amdgcn_s_barrier()
#define PG8_SCHED __builtin_amdgcn_sched_barrier(0)
    Unit cur, nxt; int ui = 0;
    if (!S.next(0, cur)) return;
    f32x4 acc[2][2][4][2];
#pragma unroll
    for (int a = 0; a < 2; ++a)
#pragma unroll
        for (int b = 0; b < 2; ++b)
#pragma unroll
            for (int m = 0; m < 4; ++m)
#pragma unroll
                for (int n = 0; n < 2; ++n) acc[a][b][m][n] = (f32x4){0.f, 0.f, 0.f, 0.f};
    typedef int v8i_ __attribute__((ext_vector_type(8))); typedef int v4i_ __attribute__((ext_vector_type(4)));
    bf16x8 At[4][2], B0[2][2], B1[2][2]; v8i_ At8[4], B08[2], B18[2];
    const char* cA = (const char*)g.A + (size_t)cur.pm * tstep; const char* cB = (const char*)g.Bt + (size_t)cur.pn * tstep;
    S.a_ready(cur);
    if constexpr (SP2) {
        PG8_STAGE(PG8_SB(0, 0), cB, voffB); PG8_STAGE(PG8_SB(0, 1), cB + hstep, voffB); PG8_STAGE(PG8_SA(0, 0), cA, voffA); PG8_STAGE(PG8_SA(0, 1), cA + hstep, voffA);
        if (wr == 1) PG8_BAR;
        PG8_WAIT_V(2); PG8_BAR;
        PG8_STAGE(PG8_SB(1, 0), cB + kstep, voffB); PG8_STAGE(PG8_SA(1, 0), cA + kstep, voffA); PG8_STAGE(PG8_SB(1, 1), cB + hstep + kstep, voffB);
        PG8_WAIT_V(6); PG8_BAR;
    } else {
        PG8_STAGE(PG8_SB(0, 0), cB, voffB); PG8_STAGE(PG8_SA(0, 0), cA, voffA); PG8_STAGE(PG8_SB(0, 1), cB + hstep, voffB); PG8_STAGE(PG8_SA(0, 1), cA + hstep, voffA);
        if (wr == 1) PG8_BAR;
        PG8_WAIT_V(4); PG8_BAR;
        PG8_STAGE(PG8_SB(1, 0), cB + kstep, voffB); PG8_STAGE(PG8_SA(1, 0), cA + kstep, voffA); PG8_STAGE(PG8_SB(1, 1), cB + hstep + kstep, voffB);
        PG8_WAIT_V(6); PG8_BAR;
    }
    for (;;) {
        const bool has_next = S.next(ui + 1, nxt);
        const char* nA = has_next ? (const char*)g.A + (size_t)nxt.pm * tstep : cA; const char* nB = has_next ? (const char*)g.Bt + (size_t)nxt.pn * tstep : cB;
        for (int t = 0; t < nt; t += 2) {
            KH(t, acc, cur, wr, wc, fr, fq);
            const bool last = (t == nt - 2);
            const char* a1 = cA + (size_t)(t + 1) * kstep;
            const char* a2 = last ? nA : cA + (size_t)(t + 2) * kstep; const char* b2 = last ? nB : cB + (size_t)(t + 2) * kstep;
            const char* a3 = a2 + kstep; const char* b3 = b2 + kstep;
            if (last && has_next) S.a_ready(nxt);
            if constexpr (SP2) {
            PG8_LDB(B0, 0, 0); PG8_LDB(B1, 0, 1); PG8_SCHED; PG8_LDA(At, 0, 0); PG8_STAGE(PG8_SA(1, 1), a1 + hstep, voffA);
            PG8_WAIT_V(8); PG8_WAIT_L(0); PG8_BAR; PG8_MMA(0, 0, At, B0); PG8_MMA(0, 1, At, B1); PG8_BAR; PG8_SCHED;
            PG8_LDA(At, 0, 1); PG8_STAGE(PG8_SB(0, 0), b2, voffB); PG8_STAGE(PG8_SB(0, 1), b2 + hstep, voffB); PG8_STAGE(PG8_SA(0, 0), a2, voffA);
            PG8_WAIT_V(8); PG8_WAIT_L(0); PG8_BAR; PG8_MMA(1, 0, At, B0); PG8_MMA(1, 1, At, B1); PG8_BAR; PG8_SCHED;
            PG8_LDB(B0, 1, 0); PG8_LDB(B1, 1, 1); PG8_SCHED; PG8_LDA(At, 1, 0); PG8_STAGE(PG8_SA(0, 1), a2 + hstep, voffA);
            PG8_WAIT_V(8); PG8_WAIT_L(0); PG8_BAR; PG8_MMA(0, 0, At, B0); PG8_MMA(0, 1, At, B1); PG8_BAR; PG8_SCHED;
            PG8_LDA(At, 1, 1); PG8_STAGE(PG8_SB(1, 0), b3, voffB); PG8_STAGE(PG8_SB(1, 1), b3 + hstep, voffB); PG8_STAGE(PG8_SA(1, 0), a3, voffA);
            PG8_WAIT_V(8); PG8_WAIT_L(0); PG8_BAR; PG8_MMA(1, 0, At, B0); PG8_MMA(1, 1, At, B1); PG8_BAR; PG8_SCHED;
            } else {
            PG8_LDB(B0, 0, 0); PG8_SCHED; PG8_LDA(At, 0, 0); PG8_STAGE(PG8_SA(1, 1), a1 + hstep, voffA);
            PG8_WAIT_L(8); PG8_BAR; PG8_WAIT_L(0); PG8_MMA(0, 0, At, B0); PG8_BAR; PG8_SCHED;
            PG8_LDB(B1, 0, 1); PG8_STAGE(PG8_SB(0, 0), b2, voffB);
            PG8_BAR; PG8_WAIT_L(0); PG8_MMA(0, 1, At, B1); PG8_BAR;
            PG8_LDA(At, 0, 1); PG8_STAGE(PG8_SA(0, 0), a2, voffA);
            PG8_BAR; PG8_WAIT_L(0); PG8_MMA(1, 0, At, B0); PG8_BAR; PG8_SCHED;
            PG8_STAGE(PG8_SB(0, 1), b2 + hstep, voffB);
            PG8_WAIT_V(6); PG8_BAR; PG8_MMA(1, 1, At, B1); PG8_BAR;
            PG8_LDB(B0, 1, 0); PG8_SCHED; PG8_LDA(At, 1, 0); PG8_STAGE(PG8_SA(0, 1), a2 + hstep, voffA);
            PG8_WAIT_L(8); PG8_BAR; PG8_WAIT_L(0); PG8_MMA(0, 0, At, B0); PG8_BAR; PG8_SCHED;
            PG8_LDB(B1, 1, 1); PG8_STAGE(PG8_SB(1, 0), b3, voffB);
            PG8_BAR; PG8_WAIT_L(0); PG8_MMA(0, 1, At, B1); PG8_BAR;
            PG8_LDA(At, 1, 1); PG8_STAGE(PG8_SA(1, 0), a3, voffA);
            PG8_BAR; PG8_WAIT_L(0); PG8_MMA(1, 0, At, B0); PG8_BAR; PG8_SCHED;
            PG8_STAGE(PG8_SB(1, 1), b3 + hstep, voffB);
            PG8_WAIT_V(6); PG8_BAR; PG8_MMA(1, 1, At, B1); PG8_BAR;
            }
        }
        if constexpr (ALIGN_EPI) { if (wr == 0) PG8_BAR; }
        if constexpr (!Epi::AFTER_DRAIN) { E(acc, cur, wr, wc, fr, fq); S.done(cur); }
        if (!has_next) break;
#pragma unroll
        for (int a = 0; a < 2; ++a)
#pragma unroll
            for (int b = 0; b < 2; ++b)
#pragma unroll
                for (int m = 0; m < 4; ++m)
#pragma unroll
                    for (int n = 0; n < 2; ++n) acc[a][b][m][n] = (f32x4){0.f, 0.f, 0.f, 0.f};
        cur = nxt; cA = nA; cB = nB; ++ui;
        if constexpr (ALIGN_EPI) { if (wr == 1) PG8_BAR; }
    }
    PG8_WAIT_V(0);
    if constexpr (!ALIGN_EPI) { if (wr == 0) PG8_BAR; }
    PG8_BAR;
    if constexpr (Epi::AFTER_DRAIN) { E.fused(acc, cur, wr, wc, fr, fq, lds, wid, lane); S.done(cur); }
#undef PG8_SA
#undef PG8_SB
#undef PG8_STAGE
#undef PG8_LDA
#undef PG8_LDB
#undef PG8_MMA
#undef PG8_WAIT_V
#undef PG8_WAIT_L
#undef PG8_BAR
#undef PG8_SCHED
}
}

#ifndef REPEAT_MASK
#define REPEAT_MASK 0
#endif
#ifndef MK_PER_PHASE
#define MK_PER_PHASE 0
#endif

constexpr int DM = 1024, BATCH = 8, SEQ = 4096, MTOK = BATCH * SEQ;
constexpr int MEMLEN = 256, MROWS = BATCH * MEMLEN;
constexpr int NZ1 = 2560, NGATE = 3072;
constexpr int ZQ = 0, ZK = 512, ZV = 1024, ZGR = 1536, ZU = 2048, ZQM = 2304;
constexpr int NTILES = MTOK / 128;
constexpr float EPS = 1e-6f;
constexpr int NPHASE = 15;

constexpr size_t MiB = 1u << 20;
constexpr size_t WS_CTL = 0, CTL_ZERO_BYTES = 1 * MiB;
constexpr size_t WS_WIN_T = 1 * MiB;
constexpr size_t WS_WQ_T = 12 * MiB;
constexpr size_t WS_WOUT_T = 16 * MiB;
constexpr size_t WS_WCAT_T = 18 * MiB;
constexpr size_t WS_WGLU_T = 20 * MiB;
constexpr size_t WS_WMKV_T = 21 * MiB;
constexpr size_t WS_KEYS = 22 * MiB;
constexpr size_t WS_S5MAT = 23 * MiB;
constexpr size_t WS_S5C = 25 * MiB;
constexpr size_t WS_PSC = 25 * MiB + 256 * 1024;
constexpr size_t WS_CSW = 25 * MiB + 128 * 1024;
constexpr size_t WS_RSX = 25 * MiB + 768 * 1024;
constexpr size_t WS_RSM = 25 * MiB + 896 * 1024;
constexpr size_t WS_WIN8 = 50 * MiB;
constexpr size_t WS_SS = 25 * MiB + 512 * 1024;
constexpr size_t WS_ROPE = 26 * MiB;
constexpr size_t WS_PU = 42 * MiB;
constexpr size_t WS_PV = 58 * MiB;
constexpr size_t WS_XN8 = 74 * MiB;
constexpr size_t WS_WG8 = WS_WIN_T + 5 * MiB;
constexpr size_t WS_MEMN = 106 * MiB;
constexpr size_t WS_KM = 110 * MiB;
constexpr size_t WS_VT = 111 * MiB;
constexpr size_t WS_S5E = 112 * MiB;
constexpr size_t WS_S5X = 114 * MiB;
constexpr size_t WS_A = 116 * MiB;
constexpr size_t WS_B = 180 * MiB;
constexpr size_t WS_Z1 = WS_B;
constexpr size_t WS_QRF = WS_B + 160 * MiB;
constexpr size_t WS_YCAT = WS_B + 192 * MiB;
constexpr size_t WS_YG = WS_B + 256 * MiB;
constexpr size_t WS_INNER = WS_B + 272 * MiB;
constexpr size_t WS_N2 = WS_B;
constexpr size_t WS_Q2 = WS_B + 64 * MiB;
constexpr size_t WS_IDX = WS_B + 192 * MiB;
constexpr size_t WS_WGT = WS_B + 208 * MiB;
constexpr size_t WS_HPART = WS_B + 128 * MiB;
constexpr size_t WS_ACT = WS_B + 224 * MiB;
constexpr size_t WS_POUT = WS_B + 64 * MiB;
constexpr size_t WS_END = WS_B + 304 * MiB;

constexpr int CW_BAR = 4096;
constexpr int CW_Q = 8192;

constexpr int LDS_BYTES = 147456;
constexpr int MISC_OFF = LDS_BYTES - 512;
constexpr int NWAVES = 8;

#define GAS __attribute__((address_space(1)))
#define LAS __attribute__((address_space(3)))
typedef unsigned short bf16;
typedef unsigned v4u __attribute__((ext_vector_type(4)));
typedef unsigned v2u __attribute__((ext_vector_type(2)));
typedef float f32x4 __attribute__((ext_vector_type(4)));
typedef float f32x16 __attribute__((ext_vector_type(16)));
typedef short bf16x8 __attribute__((ext_vector_type(8)));
typedef GAS unsigned gu32;
#define RLX_AGENT __ATOMIC_RELAXED, __HIP_MEMORY_SCOPE_AGENT
#define LDS_WAIT() asm volatile("s_waitcnt lgkmcnt(0)" ::: "memory")
#define VM_WAIT() asm volatile("s_waitcnt vmcnt(0)" ::: "memory")
__device__ __forceinline__ unsigned f2bf(float f) { unsigned u = __builtin_bit_cast(unsigned, f); return (u + 0x7fffu + ((u >> 16) & 1u)) >> 16; }
typedef __bf16 hwbf16x2_t __attribute__((ext_vector_type(2)));
typedef float hwf32x2_t __attribute__((ext_vector_type(2)));
__device__ __forceinline__ unsigned pk2(float lo, float hi) { const hwf32x2_t v = {lo, hi}; const hwbf16x2_t b = __builtin_convertvector(v, hwbf16x2_t); return __builtin_bit_cast(unsigned, b); }
#define NTL(p) __builtin_nontemporal_load(p)
__device__ __forceinline__ float bflo(unsigned w) { return __builtin_bit_cast(float, w << 16); }
__device__ __forceinline__ float bfhi(unsigned w) { return __builtin_bit_cast(float, w & 0xffff0000u); }
__device__ __forceinline__ float bf2f(bf16 h) { return __builtin_bit_cast(float, (unsigned)h << 16); }
__device__ __forceinline__ f32x16 mfma32(bf16x8 a, bf16x8 b, f32x16 c) { return __builtin_amdgcn_mfma_f32_32x32x16_bf16(a, b, c, 0, 0, 0); }
__device__ __forceinline__ f32x4 mfma16(bf16x8 a, bf16x8 b, f32x4 c) { return __builtin_amdgcn_mfma_f32_16x16x32_bf16(a, b, c, 0, 0, 0); }
__device__ __forceinline__ bf16x8 mk8(unsigned a, unsigned b, unsigned c, unsigned d) { v4u t = {a, b, c, d}; return __builtin_bit_cast(bf16x8, t); }
__device__ __forceinline__ float sigmoidf_(float x) { return __builtin_amdgcn_rcpf(1.0f + __builtin_amdgcn_exp2f(-1.4426950408889634f * x)); }
__device__ __forceinline__ float gelu_tanh(float x) {
    const float u2 = 1.5957691216057308f * (x + 0.044715f * x * x * x);
    return x * __builtin_amdgcn_rcpf(1.0f + __builtin_amdgcn_exp2f(-1.4426950408889634f * u2));
}
__device__ __forceinline__ float wave_sum(float v) {
#pragma unroll
    for (int o = 1; o < 64; o <<= 1) v += __shfl_xor(v, o);
    return v;
}

#define XB_TMO      128
#define XB_XCNT(j)  (256  + 64 * (j))
#define XB_XSUB(j)  (1280 + 64 * (j))
#define XB_XGEN(j)  (2304 + 64 * (j))
#define XB_TOP      3328
#define XB_TOPGEN   3392
#define XCD_BAR_WORDS 3456
#define XB_SPIN_CAP (1u << 22)

__device__ __forceinline__ unsigned xb_ld(unsigned* p)              { return __hip_atomic_load(p, __ATOMIC_RELAXED, __HIP_MEMORY_SCOPE_AGENT); }
__device__ __forceinline__ unsigned xb_add(unsigned* p, unsigned v) { return __hip_atomic_fetch_add(p, v, __ATOMIC_RELAXED, __HIP_MEMORY_SCOPE_AGENT); }
__device__ __forceinline__ unsigned xb_xcc_id() { return (unsigned)__builtin_amdgcn_s_getreg((3 << 11) | 20) & 0xFu; }
#define XB_SPIN(cond, bar) do { unsigned _sp = 0; while (cond) { __builtin_amdgcn_s_sleep(1); \
    if ((++_sp & 255u) == 0u) { if (xb_ld(&(bar)[XB_TMO])) break; if (_sp > XB_SPIN_CAP) { atomicAdd(&(bar)[XB_TMO], 1u); break; } } } } while (0)

struct XcdBarrier { unsigned* bar; unsigned x; volatile LAS unsigned* st; };

__device__ __forceinline__ XcdBarrier xcd_barrier_post(unsigned* bar, volatile LAS unsigned* st, bool tid0) {
    XcdBarrier b; b.bar = bar; b.x = xb_xcc_id(); b.st = st;
    if (tid0) (void)xb_add(&bar[XB_XCNT(b.x)], 1u);
    return b;
}
__device__ __forceinline__ void xcd_barrier_complete(unsigned* bar, unsigned x, unsigned& nloc, unsigned& nx) {
    const unsigned G = gridDim.x * gridDim.y * gridDim.z;
    unsigned sum, cnt, mine, sp = 0u;
    for (;;) {
        sum = 0u; cnt = 0u; mine = 0u;
#pragma unroll
        for (unsigned j = 0; j < 16; ++j) { const unsigned c = xb_ld(&bar[XB_XCNT(j)]); sum += c; cnt += (c > 0u) ? 1u : 0u; mine = (j == x) ? c : mine; }
        if (sum == G) break;
        __builtin_amdgcn_s_sleep(1);
        if ((++sp & 255u) == 0u) { if (xb_ld(&bar[XB_TMO])) break; if (sp > XB_SPIN_CAP) { atomicAdd(&bar[XB_TMO], 1u); break; } }
    }
    nloc = mine > 0u ? mine : 1u; nx = cnt > 0u ? cnt : 1u;
}
__device__ __forceinline__ void xcd_barrier(const XcdBarrier& b, int wave) {
    asm volatile("s_waitcnt vmcnt(0)" ::: "memory");
    __syncthreads();
    if (wave == 0 && pg8::hw_lane_id() == 0) {
        unsigned* bar = b.bar;
        __builtin_amdgcn_s_waitcnt(0);
        unsigned nloc = b.st[0], nx = b.st[1];
        if (nloc == 0u) { xcd_barrier_complete(bar, b.x, nloc, nx); b.st[0] = nloc; b.st[1] = nx; }
        const unsigned old = xb_add(&bar[XB_XSUB(b.x)], 1u);
        const unsigned gen = old / nloc;
        if (old + 1u == (gen + 1u) * nloc) {
            __builtin_amdgcn_fence(__ATOMIC_RELEASE, "agent");
            asm volatile("s_waitcnt vmcnt(0)" ::: "memory");
            const unsigned og = xb_add(&bar[XB_TOP], 1u);
            const unsigned tg = og / nx;
            if (og + 1u == (tg + 1u) * nx) xb_add(&bar[XB_TOPGEN], 1u);
            else XB_SPIN(xb_ld(&bar[XB_TOPGEN]) == tg, bar);
            __builtin_amdgcn_fence(__ATOMIC_ACQUIRE, "agent");
            xb_add(&bar[XB_XGEN(b.x)], 1u);
            asm volatile("s_waitcnt vmcnt(0)" ::: "memory");
        } else {
            XB_SPIN(xb_ld(&bar[XB_XGEN(b.x)]) == gen, bar);
            __builtin_amdgcn_fence(__ATOMIC_ACQUIRE, "agent");
            asm volatile("s_waitcnt vmcnt(0)" ::: "memory");
        }
    }
    __syncthreads();
}

__host__ __device__ __forceinline__ int frag32(int row, int k, int K) { return (((row >> 5) * (K >> 4) + (k >> 4)) * 64 + ((k >> 3) & 1) * 32 + (row & 31)) * 8 + (k & 7); }
__host__ __device__ __forceinline__ int frag16(int n, int k, int K) { return (((n >> 4) * (K >> 5) + (k >> 5)) * 64 + ((k >> 3) & 3) * 16 + (n & 15)) * 8 + (k & 7); }
struct Args { const void* in[26]; float* out; unsigned char* ws; int ph_lo, ph_hi; };
struct Ctx {
    LAS unsigned char* lds;
    int tid, lane, wave, vcu, G;
    __device__ __forceinline__ void refresh() { lane = pg8::hw_lane_id(); tid = wave * 64 + lane; }
};

template <class F> struct EpiT {
    static constexpr bool PERM = true, AFTER_DRAIN = false;
    F f;
    __device__ __forceinline__ void operator()(const f32x4 (&acc)[2][2][4][2], const pg8::Unit& u, int wr, int wc, int fr, int fq) const {
        const int row0 = u.pm * 256 + wr * 64 + fr, col0 = u.pn * 256 + wc * 32 + 8 * fq;
        typename F::L cur[2], nxt[2];
        f.load(row0, col0, cur[0]); f.load(row0, col0 + 128, cur[1]);
#pragma unroll
        for (int i = 0; i < 8; ++i) {
            const int ai = i >> 2, m = i & 3, row = row0 + ai * 128 + m * 16;
            if (i < 7) { const int rown = row0 + ((i + 1) >> 2) * 128 + ((i + 1) & 3) * 16; f.load(rown, col0, nxt[0]); f.load(rown, col0 + 128, nxt[1]); }
            __builtin_amdgcn_sched_barrier(0);
            f.apply(row, col0, acc[ai][0][m][0], acc[ai][0][m][1], cur[0]); f.apply(row, col0 + 128, acc[ai][1][m][0], acc[ai][1][m][1], cur[1]);
            __builtin_amdgcn_sched_barrier(0);
            cur[0] = nxt[0]; cur[1] = nxt[1];
        }
    }
};
__device__ __forceinline__ v4u pack8(f32x4 a, f32x4 b) { v4u w; w.x = pk2(a[0], a[1]); w.y = pk2(a[2], a[3]); w.z = pk2(b[0], b[1]); w.w = pk2(b[2], b[3]); return w; }
struct LNone {};
struct FStore { typedef LNone L; bf16* O; int ldc;
    __device__ __forceinline__ void load(int, int, L&) const {}
    __device__ __forceinline__ void apply(int row, int col, f32x4 v0, f32x4 v1, const L&) const { *(v4u*)(O + (size_t)row * ldc + col) = pack8(v0, v1); } };
struct FKvm { typedef LNone L; bf16* KM; bf16* VT;
    __device__ __forceinline__ void load(int, int, L&) const {}
    __device__ __forceinline__ void apply(int row, int col, f32x4 v0, f32x4 v1, const L&) const {
        const int b = row >> 8, m = row & 255;
        if (col < 256) { const int hm = col >> 6, d0 = col & 63; *(v4u*)(KM + (size_t)(b * 4 + hm) * 16384 + frag32(m, d0, 64)) = pack8(v0, v1); }
        else { const int c = col - 256, hm = c >> 6, e0 = c & 63, mt = m >> 5, s2 = (m >> 4) & 1, w = m & 15, hh = (w >> 2) & 1, j = ((w >> 3) << 2) | (w & 3);
            bf16* p = VT + (size_t)(b * 4 + hm) * 16384 + ((mt * 2 + s2) * 64 + hh * 32) * 8 + j;
#pragma unroll
            for (int jj = 0; jj < 8; ++jj) { const int e = e0 + jj; p[((e >> 5) * 16 * 64 + (e & 31)) * 8] = (bf16)f2bf(jj < 4 ? v0[jj] : v1[jj - 4]); } }
    } };
struct FSig { typedef LNone L; bf16* O; int ldc;
    __device__ __forceinline__ void load(int, int, L&) const {}
    __device__ __forceinline__ void apply(int row, int col, f32x4 v0, f32x4 v1, const L&) const {
#pragma unroll
        for (int j = 0; j < 4; ++j) { v0[j] = sigmoidf_(v0[j]); v1[j] = sigmoidf_(v1[j]); }
        *(v4u*)(O + (size_t)row * ldc + col) = pack8(v0, v1); } };
struct FGlu { typedef LNone L; bf16* O;
    __device__ __forceinline__ void load(int, int, L&) const {}
    __device__ __forceinline__ void apply(int row, int col, f32x4 v0, f32x4 v1, const L&) const {
        v2u w; w.x = pk2(v0[0] * sigmoidf_(v1[0]), v0[1] * sigmoidf_(v1[1])); w.y = pk2(v0[2] * sigmoidf_(v1[2]), v0[3] * sigmoidf_(v1[3]));
        *(v2u*)(O + (size_t)row * 1024 + 512 + (col >> 1)) = w; } };
#define UB0(x) ((float)((x) & 0xffu))
#define UB1(x) ((float)(((x) >> 8) & 0xffu))
#define UB2(x) ((float)(((x) >> 16) & 0xffu))
#define UB3(x) ((float)((x) >> 24))
__device__ __forceinline__ void mul8(f32x4& v0, f32x4& v1, const v2u num, const v2u den) {
    v0[0] *= UB0(num.x) * __builtin_amdgcn_rcpf(UB0(den.x)); v0[1] *= UB1(num.x) * __builtin_amdgcn_rcpf(UB1(den.x));
    v0[2] *= UB2(num.x) * __builtin_amdgcn_rcpf(UB2(den.x)); v0[3] *= UB3(num.x) * __builtin_amdgcn_rcpf(UB3(den.x));
    v1[0] *= UB0(num.y) * __builtin_amdgcn_rcpf(UB0(den.y)); v1[1] *= UB1(num.y) * __builtin_amdgcn_rcpf(UB1(den.y));
    v1[2] *= UB2(num.y) * __builtin_amdgcn_rcpf(UB2(den.y)); v1[3] *= UB3(num.y) * __builtin_amdgcn_rcpf(UB3(den.y));
}
struct GatePlanes { unsigned char* p0; unsigned char* p1; unsigned char* p2; };
__device__ __forceinline__ unsigned gate_off(int row, int c) {
    const unsigned pm = (unsigned)row >> 8, ai = (row >> 7) & 1, wr = (row >> 6) & 1, m = (row >> 4) & 3, fr = row & 15;
    const unsigned pn = (unsigned)c >> 8, bj = (c >> 7) & 1, wc = (c >> 5) & 3, fq = (c >> 3) & 3;
    return ((((pm * 4 + pn) * 8 + wr * 4 + wc) * 16 + (ai * 4 + m) * 2 + bj) * 512) + (fq * 16 + fr) * 8;
}
struct HookGate { GatePlanes G;
    __device__ __forceinline__ void operator()(int t, f32x4 (&acc)[2][2][4][2], const pg8::Unit& u, int wr, int wc, int fr, int fq) const {
        if (t != 8 && t != 12) return;
        const unsigned char* Gn = (t == 8) ? G.p0 : G.p1; const unsigned char* Gd = (t == 8) ? G.p1 : G.p2;
        int row0 = u.pm * 256 + wr * 64 + fr, col0 = u.pn * 256 + wc * 32 + 8 * fq;
        asm volatile("" : "+v"(row0), "+v"(col0));
        const unsigned gb = gate_off(row0, col0);
        v2u nn[2][4][2], dd[2][4][2];
#pragma unroll
        for (int ai = 0; ai < 2; ++ai)
#pragma unroll
            for (int m = 0; m < 4; ++m) { const unsigned go = gb + (unsigned)((ai * 4 + m) * 2) * 512u;
                nn[ai][m][0] = *(const v2u*)(Gn + go); dd[ai][m][0] = *(const v2u*)(Gd + go); nn[ai][m][1] = *(const v2u*)(Gn + go + 512); dd[ai][m][1] = *(const v2u*)(Gd + go + 512); }
        __builtin_amdgcn_sched_barrier(0);
#pragma unroll
        for (int ai = 0; ai < 2; ++ai)
#pragma unroll
            for (int m = 0; m < 4; ++m) { mul8(acc[ai][0][m][0], acc[ai][0][m][1], nn[ai][m][0], dd[ai][m][0]); mul8(acc[ai][1][m][0], acc[ai][1][m][1], nn[ai][m][1], dd[ai][m][1]); }
        __builtin_amdgcn_sched_barrier(0);
    } };
struct LGate { v2u g; };
struct FGateOut { typedef LGate L; const unsigned char* Gm; bf16* MB;
    __device__ __forceinline__ void load(int row, int col, L& l) const { l.g = NTL((const v2u*)(Gm + gate_off(row, col))); }
    __device__ __forceinline__ void apply(int row, int col, f32x4 v0, f32x4 v1, const L& l) const {
        const v2u g = l.g; const float k = 1.0f / 255.0f;
        v0[0] *= UB0(g.x) * k; v0[1] *= UB1(g.x) * k; v0[2] *= UB2(g.x) * k; v0[3] *= UB3(g.x) * k; v1[0] *= UB0(g.y) * k; v1[1] *= UB1(g.y) * k; v1[2] *= UB2(g.y) * k; v1[3] *= UB3(g.y) * k;
        *(v4u*)(MB + (size_t)row * DM + col) = pack8(v0, v1); } };
struct LRes { f32x4 x0, x1; };
struct FRes { typedef LRes L; const float* X; bf16* HB; float* SS;
    __device__ __forceinline__ void load(int row, int col, L& l) const { const float* xp = X + (size_t)row * DM + col; l.x0 = *(const f32x4*)xp; l.x1 = *(const f32x4*)(xp + 4); }
    __device__ __forceinline__ void apply(int row, int col, f32x4 v0, f32x4 v1, const L& l) const {
        v0 += l.x0; v1 += l.x1;
        *(v4u*)(HB + (size_t)row * DM + col) = pack8(v0, v1);
        float q = (v0[0] * v0[0] + v0[1] * v0[1]) + (v0[2] * v0[2] + v0[3] * v0[3]) + (v1[0] * v1[0] + v1[1] * v1[1]) + (v1[2] * v1[2] + v1[3] * v1[3]);
        q += __shfl_xor(q, 16); q += __shfl_xor(q, 32);
        if (pg8::hw_lane_id() < 16) atomicAdd(SS + row, q); } };
struct LRstd { float ss; };
struct FStoreRstd { typedef LRstd L; bf16* O; int ldc; const float* SS;
    __device__ __forceinline__ void load(int row, int, L& l) const { l.ss = SS[row]; }
    __device__ __forceinline__ void apply(int row, int col, f32x4 v0, f32x4 v1, const L& l) const {
        const float rs = __builtin_amdgcn_rsqf(l.ss * (1.f / DM) + EPS);
        *(v4u*)(O + ((((size_t)(row >> 5) * 16 + (col >> 7)) * 8 + ((col & 127) >> 4)) * 64 + ((col >> 3) & 1) * 32 + (row & 31)) * 8) = pack8(v0 * rs, v1 * rs); } };

template <class F>
__device__ __forceinline__ void run_gemm(const Ctx& C, const bf16* A, const bf16* Bt, int M, int N, int K, const F& f) {
    pg8::Gemm g{A, Bt, M, N, K}; pg8::StaticOrder S; S.init(M, N, C.G, (int)blockIdx.x);
    EpiT<F> E{f};
    pg8::gemm_phase<EpiT<F>, pg8::StaticOrder, true, true>(C.lds, g, S, E, C.wave);
}

template <class F, class H>
__device__ __forceinline__ void run_gemm_hook(const Ctx& C, const bf16* A, const bf16* Bt, int M, int N, int K, const F& f, const H& h) {
    pg8::Gemm g{A, Bt, M, N, K}; pg8::StaticOrder S; S.init(M, N, C.G, (int)blockIdx.x);
    EpiT<F> E{f};
    pg8::gemm_phase<EpiT<F>, pg8::StaticOrder, true, true, false, H>(C.lds, g, S, E, C.wave, 0x7f7f7f7f, 0x7f7f7f7f, h);
}
template <class F>
__device__ __forceinline__ void run_gemm_mx(const Ctx& C, const unsigned char* A8, const unsigned char* Bt8, int M, int N, int Kbytes, const F& f, int sclA, int sclB) {
    pg8::Gemm g{(const bf16*)A8, (const bf16*)Bt8, M, N, Kbytes / 2}; pg8::StaticOrder S; S.init(M, N, C.G, (int)blockIdx.x);
    EpiT<F> E{f};
    pg8::gemm_phase<EpiT<F>, pg8::StaticOrder, true, true, true>(C.lds, g, S, E, C.wave, sclA, sclB);
}

struct TopkOrder : pg8::StaticOrder {
    const Ctx* C; const Args* a;
    __device__ __forceinline__ void done(const pg8::Unit& u) const;
};
template <class F>
__device__ __forceinline__ void run_gemm_topk(const Ctx& C, const Args& a, const bf16* A, const bf16* Bt, int M, int N, int K, const F& f) {
    pg8::Gemm g{A, Bt, M, N, K}; TopkOrder S; S.init(M, N, C.G, (int)blockIdx.x); S.C = &C; S.a = &a;
    EpiT<F> E{f};
    pg8::gemm_phase<EpiT<F>, TopkOrder, true, true>(C.lds, g, S, E, C.wave);
}
struct LI8 { float rs; f32x4 c0, c1; };
template <class F> struct EpiI8 {
    static constexpr bool PERM = true, AFTER_DRAIN = false;
    F f;
    __device__ __forceinline__ void operator()(const f32x4 (&acc)[2][2][4][2], const pg8::Unit& u, int wr, int wc, int fr, int fq) const {
        const int row0 = u.pm * 256 + wr * 64 + fr, col0 = u.pn * 256 + wc * 32 + 8 * fq;
        LI8 l0, l1;
        l0.c0 = *(const f32x4*)(f.CS + col0); l0.c1 = *(const f32x4*)(f.CS + col0 + 4); l1.c0 = *(const f32x4*)(f.CS + col0 + 128); l1.c1 = *(const f32x4*)(f.CS + col0 + 132);
        float rsv[8];
#pragma unroll
        for (int i = 0; i < 8; ++i) rsv[i] = f.RS[row0 + (i >> 2) * 128 + (i & 3) * 16];
#pragma unroll
        for (int i = 0; i < 8; ++i) {
            const int ai = i >> 2, m = i & 3, row = row0 + ai * 128 + m * 16;
            const float rsc = rsv[i];
            __builtin_amdgcn_sched_barrier(0);
            l0.rs = rsc; l1.rs = rsc;
            f.apply(row, col0, acc[ai][0][m][0], acc[ai][0][m][1], l0); f.apply(row, col0 + 128, acc[ai][1][m][0], acc[ai][1][m][1], l1);
            __builtin_amdgcn_sched_barrier(0);
        }
    }
};
template <class F>
__device__ __forceinline__ void run_gemm_i8(const Ctx& C, const unsigned char* A8, const unsigned char* Bt8, int M, int N, int Kbytes, const F& f) {
    pg8::Gemm g{(const bf16*)A8, (const bf16*)Bt8, M, N, Kbytes / 2}; pg8::StaticOrder S; S.init(M, N, C.G, (int)blockIdx.x);
    EpiI8<F> E{f};
    pg8::gemm_phase<EpiI8<F>, pg8::StaticOrder, true, true, true, pg8::NoKHook, true>(C.lds, g, S, E, C.wave);
}
__device__ __forceinline__ void deq8(f32x4& v0, f32x4& v1, const LI8& l) {
#pragma unroll
    for (int j = 0; j < 4; ++j) { const float a = v0[j], b = v1[j];
        v0[j] = (float)__builtin_bit_cast(int, a) * (l.rs * l.c0[j]); v1[j] = (float)__builtin_bit_cast(int, b) * (l.rs * l.c1[j]); }
}
struct FStoreI8 { typedef LI8 L; bf16* O; int ldc; const float* RS; const float* CS;
    __device__ __forceinline__ void load(int row, int col, L& l) const { l.rs = RS[row]; l.c0 = *(const f32x4*)(CS + col); l.c1 = *(const f32x4*)(CS + col + 4); }
    __device__ __forceinline__ void apply(int row, int col, f32x4 v0, f32x4 v1, const L& l) const { deq8(v0, v1, l); __builtin_nontemporal_store(pack8(v0, v1), (v4u*)(O + (size_t)row * ldc + col)); } };
struct FKvmI8 { typedef LI8 L; FKvm f; const float* RS; const float* CS;
    __device__ __forceinline__ void load(int row, int col, L& l) const { l.rs = RS[row]; l.c0 = *(const f32x4*)(CS + col); l.c1 = *(const f32x4*)(CS + col + 4); }
    __device__ __forceinline__ void apply(int row, int col, f32x4 v0, f32x4 v1, const L& l) const { deq8(v0, v1, l); f.apply(row, col, v0, v1, LNone{}); } };
typedef float f32x2p __attribute__((ext_vector_type(2)));
__device__ __forceinline__ f32x2p gate2(float a, float b, f32x2p t) {
    const f32x2p z = (f32x2p){(float)__builtin_bit_cast(int, a), (float)__builtin_bit_cast(int, b)} * t;
    const f32x2p d = (f32x2p){__builtin_amdgcn_exp2f(z.x), __builtin_amdgcn_exp2f(z.y)} + 1.0f;
    return (f32x2p){__builtin_amdgcn_rcpf(d.x), __builtin_amdgcn_rcpf(d.y)} * 255.0f + 0.5f;
}
__device__ __forceinline__ unsigned gate_code4(f32x4 v, f32x4 c, float rs) {
    const float v0 = v[0], v1 = v[1], v2 = v[2], v3 = v[3];
    const f32x2p y01 = gate2(v0, v1, (f32x2p){c[0], c[1]} * rs), y23 = gate2(v2, v3, (f32x2p){c[2], c[3]} * rs);
    unsigned w = __builtin_amdgcn_cvt_pk_u8_f32(fmaxf(y01.x, 1.0f), 0, 0u); w = __builtin_amdgcn_cvt_pk_u8_f32(fmaxf(y01.y, 1.0f), 1, w);
    w = __builtin_amdgcn_cvt_pk_u8_f32(fmaxf(y23.x, 1.0f), 2, w); return __builtin_amdgcn_cvt_pk_u8_f32(fmaxf(y23.y, 1.0f), 3, w); }
struct FSigI8 { typedef LI8 L; GatePlanes G; const float* RS; const float* CS;
    __device__ __forceinline__ void load(int row, int col, L& l) const { l.rs = RS[row]; l.c0 = *(const f32x4*)(CS + col); l.c1 = *(const f32x4*)(CS + col + 4); }
    __device__ __forceinline__ void apply(int row, int col, f32x4 v0, f32x4 v1, const L& l) const {
        v2u w; w.x = gate_code4(v0, l.c0, l.rs); w.y = gate_code4(v1, l.c1, l.rs);
        const size_t a01 = (size_t)G.p0 + ((size_t)(col >> 10) << 25);
        unsigned char* O = (unsigned char*)((col < 2048) ? a01 : (size_t)G.p2);
        __builtin_nontemporal_store(w, (v2u*)(O + gate_off(row, col & 1023))); } };

__device__ __forceinline__ unsigned q_e2m1(float y) {
    const float m = fabsf(y);
    const unsigned c = (unsigned)(m > 0.25f) + (unsigned)(m > 0.75f) + (unsigned)(m > 1.25f) + (unsigned)(m > 1.75f) + (unsigned)(m > 2.5f) + (unsigned)(m > 3.5f) + (unsigned)(m > 5.0f);
    return c | ((__builtin_bit_cast(unsigned, y) >> 28) & 8u);
}
template <bool GLU>
__device__ __forceinline__ void p0_transpose_item(const float* W, int K, int N, bf16* WT, LAS float* scr, int item, int lane, const float* kscale = nullptr, int ldk = 0, int koff = 0) {
    if (ldk == 0) ldk = K;
    const int nblk = N / 32, kb = item / nblk, nb = item % nblk, k0 = 64 * kb, n0 = 32 * nb;
#pragma unroll 8
    for (int i = 0; i < 32; ++i) { const int kk = 2 * i + (lane >> 5); float w = NTL(W + (size_t)(k0 + kk) * N + n0 + (lane & 31)); if (kscale) w *= kscale[k0 + kk]; scr[kk * 33 + (lane & 31)] = w; }
    LDS_WAIT(); asm volatile("" ::: "memory");
    const int c = lane & 7;
#pragma unroll
    for (int j = 0; j < 4; ++j) { const int n = (lane >> 3) + 8 * j; const LAS float* s = scr + (8 * c) * 33 + n;
        v4u o; o.x = pk2(s[0 * 33], s[1 * 33]); o.y = pk2(s[2 * 33], s[3 * 33]); o.z = pk2(s[4 * 33], s[5 * 33]); o.w = pk2(s[6 * 33], s[7 * 33]);
        const int nn = n0 + n; int row = nn;
        if (GLU) { const int jc = nn & 255, gate = nn >> 8; row = 8 * (jc >> 2) + 4 * gate + (jc & 3); }
        *(GAS v4u*)(WT + (size_t)row * ldk + koff + k0 + 8 * c) = o; }
    LDS_WAIT(); asm volatile("" ::: "memory");
}
__device__ __forceinline__ void p0_transpose_item_fp8(const float* W, int K, int N, unsigned char* WT8, int nsub, LAS float* scr, int item, int lane, float scale) {
    const int nblk = N / 32, kb = item / nblk, nb = item % nblk, k0 = 64 * kb, n0 = 32 * nb;
#pragma unroll 8
    for (int i = 0; i < 32; ++i) { const int kk = 2 * i + (lane >> 5); scr[kk * 33 + (lane & 31)] = W[(size_t)(k0 + kk) * N + n0 + (lane & 31)] * scale; }
    LDS_WAIT(); asm volatile("" ::: "memory");
    const int c = lane & 7;
#pragma unroll
    for (int j = 0; j < 4; ++j) { const int n = (lane >> 3) + 8 * j; const LAS float* sp = scr + (8 * c) * 33 + n;
        int p0 = __builtin_amdgcn_cvt_pk_fp8_f32(sp[0 * 33], sp[1 * 33], 0, false); p0 = __builtin_amdgcn_cvt_pk_fp8_f32(sp[2 * 33], sp[3 * 33], p0, true);
        int p1 = __builtin_amdgcn_cvt_pk_fp8_f32(sp[4 * 33], sp[5 * 33], 0, false); p1 = __builtin_amdgcn_cvt_pk_fp8_f32(sp[6 * 33], sp[7 * 33], p1, true);
        v2u o; o.x = (unsigned)p0; o.y = (unsigned)p1;
        *(GAS v2u*)(WT8 + (size_t)(n0 + n - nsub) * K + k0 + 8 * c) = o; }
    LDS_WAIT(); asm volatile("" ::: "memory");
}
template <int NR>
__device__ __forceinline__ void rms_rows_to_bf16(const float* xbase, const float* gain, bf16* obase, int m0, int mstep, int lane, unsigned char* o8base = nullptr) {
    f32x4 v[NR][4]; float s[NR];
#pragma unroll
    for (int i = 0; i < NR; ++i) { const f32x4* xr = (const f32x4*)(xbase + (size_t)(m0 + i * mstep) * DM) + lane; s[i] = 0.f;
#pragma unroll
        for (int j = 0; j < 4; ++j) v[i][j] = xr[64 * j]; }
#pragma unroll
    for (int i = 0; i < NR; ++i)
#pragma unroll
        for (int j = 0; j < 4; ++j) s[i] += (v[i][j].x * v[i][j].x + v[i][j].y * v[i][j].y) + (v[i][j].z * v[i][j].z + v[i][j].w * v[i][j].w);
#pragma unroll
    for (int o = 1; o < 64; o <<= 1)
#pragma unroll
        for (int i = 0; i < NR; ++i) s[i] += __shfl_xor(s[i], o);
    const f32x4* gr = (const f32x4*)gain + lane;
    f32x4 g[4];
#pragma unroll
    for (int j = 0; j < 4; ++j) g[j] = gr[64 * j];
#pragma unroll
    for (int i = 0; i < NR; ++i) { const float rstd = 1.0f / sqrtf(s[i] * (1.f / DM) + EPS);
        unsigned long long* o8 = (unsigned long long*)(obase + (size_t)(m0 + i * mstep) * DM) + lane;
#pragma unroll
        for (int j = 0; j < 4; ++j) { const float y0 = v[i][j].x * rstd * g[j].x, y1 = v[i][j].y * rstd * g[j].y, y2 = v[i][j].z * rstd * g[j].z, y3 = v[i][j].w * rstd * g[j].w;
            o8[64 * j] = (unsigned long long)pk2(y0, y1) | ((unsigned long long)pk2(y2, y3) << 32);
            if (o8base) { int p = __builtin_amdgcn_cvt_pk_fp8_f32(y0 * 16.f, y1 * 16.f, 0, false); p = __builtin_amdgcn_cvt_pk_fp8_f32(y2 * 16.f, y3 * 16.f, p, true);
                *(unsigned*)(o8base + (size_t)(m0 + i * mstep) * DM + 256 * j + 4 * lane) = (unsigned)p; } } }
}

__device__ __forceinline__ unsigned pack_i8x4(float a, float b, float c, float d) {
    unsigned w = __builtin_amdgcn_cvt_pk_u8_f32(rintf(a) + 128.0f, 0, 0u); w = __builtin_amdgcn_cvt_pk_u8_f32(rintf(b) + 128.0f, 1, w);
    w = __builtin_amdgcn_cvt_pk_u8_f32(rintf(c) + 128.0f, 2, w); w = __builtin_amdgcn_cvt_pk_u8_f32(rintf(d) + 128.0f, 3, w);
    return w ^ 0x80808080u;
}
template <int NR, bool BF>
__device__ __forceinline__ void rms_rows_to_i8(const float* xbase, const float* gain, bf16* obase, unsigned char* o8base, float* rsx, int m0, int mstep, int lane) {
    f32x4 v[NR][4]; float s[NR], mx[NR];
#pragma unroll
    for (int i = 0; i < NR; ++i) { const f32x4* xr = (const f32x4*)(xbase + (size_t)(m0 + i * mstep) * DM) + lane; s[i] = 0.f; mx[i] = 0.f;
#pragma unroll
        for (int j = 0; j < 4; ++j) v[i][j] = __builtin_nontemporal_load(xr + 64 * j); }
    const f32x4* gr = (const f32x4*)gain + lane;
    f32x4 g[4];
#pragma unroll
    for (int j = 0; j < 4; ++j) g[j] = gr[64 * j];
#pragma unroll
    for (int i = 0; i < NR; ++i)
#pragma unroll
        for (int j = 0; j < 4; ++j) { s[i] += (v[i][j].x * v[i][j].x + v[i][j].y * v[i][j].y) + (v[i][j].z * v[i][j].z + v[i][j].w * v[i][j].w);
            v[i][j] = v[i][j] * g[j]; mx[i] = fmaxf(mx[i], fmaxf(fmaxf(fabsf(v[i][j].x), fabsf(v[i][j].y)), fmaxf(fabsf(v[i][j].z), fabsf(v[i][j].w)))); }
#pragma unroll
    for (int o = 1; o < 64; o <<= 1)
#pragma unroll
        for (int i = 0; i < NR; ++i) { s[i] += __shfl_xor(s[i], o); mx[i] = fmaxf(mx[i], __shfl_xor(mx[i], o)); }
#pragma unroll
    for (int i = 0; i < NR; ++i) { const int row = m0 + i * mstep; const float rstd = 1.0f / sqrtf(s[i] * (1.f / DM) + EPS);
        const float qs = mx[i] > 1e-30f ? 127.0f / mx[i] : 0.f;
        if (lane == 0) rsx[row] = rstd * mx[i] * (1.0f / 127.0f);
#pragma unroll
        for (int j = 0; j < 4; ++j) {
            if (BF) { unsigned long long* o8 = (unsigned long long*)(obase + (size_t)row * DM) + lane;
                o8[64 * j] = (unsigned long long)pk2(v[i][j].x * rstd, v[i][j].y * rstd) | ((unsigned long long)pk2(v[i][j].z * rstd, v[i][j].w * rstd) << 32); }
            *(unsigned*)(o8base + (size_t)row * DM + 256 * j + 4 * lane) = pack_i8x4(v[i][j].x * qs, v[i][j].y * qs, v[i][j].z * qs, v[i][j].w * qs); } }
}
__device__ __forceinline__ void p0_w_i8(const Ctx& C, const Args& a, const float* W, const int N, const int cu0, const int nblk, unsigned char* WT8out, float* CSout, const int gate0) {
    const int nb = C.vcu - cu0; if (nb < 0 || nb >= nblk) return;
    const int n0 = 32 * nb, lane = C.lane, rl = lane >> 3, c4 = lane & 7;
    LAS unsigned* T = (LAS unsigned*)(C.lds + C.wave * 16384);
    LAS float* cmx = (LAS float*)(C.lds + 131072);
    f32x4 w[4][4];
    const float* wp = W + (size_t)(C.wave * 128 + 4 * rl) * N + n0 + 4 * c4;
#pragma unroll
    for (int g = 0; g < 4; ++g)
#pragma unroll
        for (int t = 0; t < 4; ++t) w[g][t] = NTL((const f32x4*)(wp + (size_t)(32 * g + t) * N));
    f32x4 m = {0.f, 0.f, 0.f, 0.f};
#pragma unroll
    for (int g = 0; g < 4; ++g)
#pragma unroll
        for (int t = 0; t < 4; ++t)
#pragma unroll
            for (int j = 0; j < 4; ++j) m[j] = fmaxf(m[j], fabsf(w[g][t][j]));
#pragma unroll
    for (int o = 8; o < 64; o <<= 1)
#pragma unroll
        for (int j = 0; j < 4; ++j) m[j] = fmaxf(m[j], __shfl_xor(m[j], o));
    if (rl == 0) *(LAS f32x4*)(cmx + C.wave * 32 + 4 * c4) = m;
    __syncthreads();
    f32x4 cm = {0.f, 0.f, 0.f, 0.f};
#pragma unroll
    for (int ww = 0; ww < 8; ++ww) { const f32x4 x = *(const LAS f32x4*)(cmx + ww * 32 + 4 * c4);
#pragma unroll
        for (int j = 0; j < 4; ++j) cm[j] = fmaxf(cm[j], x[j]); }
    f32x4 qs;
#pragma unroll
    for (int j = 0; j < 4; ++j) qs[j] = cm[j] > 1e-30f ? 127.0f / cm[j] : 0.f;
    if (C.wave == 0 && rl == 0) *(f32x4*)(CSout + n0 + 4 * c4) = cm * ((n0 >= gate0 ? -1.4426950408889634f : 1.0f) / 127.0f);
#pragma unroll
    for (int g = 0; g < 4; ++g)
#pragma unroll
        for (int j = 0; j < 4; ++j) T[(4 * c4 + j) * 36 + 8 * g + rl] = pack_i8x4(w[g][0][j] * qs[j], w[g][1][j] * qs[j], w[g][2][j] * qs[j], w[g][3][j] * qs[j]);
    LDS_WAIT(); asm volatile("" ::: "memory");
    {   const int n = lane >> 1, hf = lane & 1;
        unsigned char* dst = WT8out + (size_t)(n0 + n) * 1024 + C.wave * 128 + 64 * hf;
#pragma unroll
        for (int q = 0; q < 4; ++q) *(GAS v4u*)(dst + 16 * q) = *(const LAS v4u*)(T + n * 36 + 16 * hf + 4 * q); }
    LDS_WAIT(); asm volatile("" ::: "memory");
    __syncthreads();
}

__device__ __forceinline__ void p0_s5_group(const Ctx& C, const Args& a, int g, int part) {
    const float* a_re = (const float*)a.in[7]; const float* a_im = (const float*)a.in[8]; const float* log_dt = (const float*)a.in[9];
    const float* b_re = (const float*)a.in[10]; const float* b_im = (const float*)a.in[11]; const float* c_re = (const float*)a.in[12]; const float* c_im = (const float*)a.in[13];
    LAS float* L = (LAS float*)C.lds;
    LAS float* lpr = L;
    LAS float* lpi = L + 640;
    LAS float* bbr = L + 1280;
    LAS float* bbi = bbr + 1024;
    LAS float* ccr = bbi + 1024;
    LAS float* cci = ccr + 1024;
    LAS float* Kj = cci + 1024;
    const int tid = C.tid;
    bf16* T8T = (bf16*)(a.ws + WS_S5MAT) + (size_t)g * 16384;
    bf16* PMT = (bf16*)(a.ws + WS_S5MAT) + (size_t)(16 + g) * 16384;
    bf16* QMT = (bf16*)(a.ws + WS_S5MAT) + (size_t)(32 + g) * 16384;
    float* L8 = (float*)(a.ws + WS_S5C) + (size_t)g * 128;
    float* L128 = (float*)(a.ws + WS_S5C) + 2048 + (size_t)g * 128;
    if (tid < 64) {
        const int p = tid;
        const double dt = exp((double)log_dt[g]);
        const double ar = (double)a_re[g * 64 + p], ai = (double)a_im[g * 64 + p];
        const double mag = exp(ar * dt), ang = ai * dt;
        const double l1r = mag * cos(ang), l1i = mag * sin(ang);
        double pr = 1.0, pi = 0.0;
#pragma unroll
        for (int j = 0; j < 9; ++j) { lpr[j * 64 + p] = (float)pr; lpi[j * 64 + p] = (float)pi; const double nr = pr * l1r - pi * l1i, ni = pr * l1i + pi * l1r; pr = nr; pi = ni; }
        double qr = (double)0, qi = (double)0;
        { double r8 = 1.0, i8 = 0.0;
#pragma unroll
          for (int j = 0; j < 8; ++j) { const double nr = r8 * l1r - i8 * l1i, ni = r8 * l1i + i8 * l1r; r8 = nr; i8 = ni; }
          qr = r8; qi = i8; }
#pragma unroll
        for (int j = 0; j < 4; ++j) { const double nr = qr * qr - qi * qi, ni = 2.0 * qr * qi; qr = nr; qi = ni; }
        lpr[9 * 64 + p] = (float)qr; lpi[9 * 64 + p] = (float)qi;
    }
    for (int i = tid; i < 1024; i += 512) { ccr[i] = c_re[g * 1024 + i]; cci[i] = c_im[g * 1024 + i]; }
    __syncthreads();
    if (part == 0 && tid < 64) { L8[tid * 2] = lpr[8 * 64 + tid]; L8[tid * 2 + 1] = lpi[8 * 64 + tid]; L128[tid * 2] = lpr[9 * 64 + tid]; L128[tid * 2 + 1] = lpi[9 * 64 + tid]; }
    for (int i = tid; i < 1024; i += 512) {
        const int p = i >> 4, h = i & 15;
        const float ar = a_re[g * 64 + p], ai = a_im[g * 64 + p], lr = lpr[64 + p], li = lpi[64 + p];
        const float den = ar * ar + ai * ai, nr = lr - 1.0f, ni = li;
        const float cr = (nr * ar + ni * ai) / den, ci = (ni * ar - nr * ai) / den;
        const float br = b_re[(g * 64 + p) * 16 + h], bi = b_im[(g * 64 + p) * 16 + h];
        bbr[i] = cr * br - ci * bi; bbi[i] = cr * bi + ci * br;
    }
    __syncthreads();
    for (int i = tid; i < 2048; i += 512) {
        const int j = i >> 8, ho = (i >> 4) & 15, hi = i & 15; float sacc = 0.f;
        if (j > (part >> 1) || (ho >> 3) != (part & 1)) continue;
        for (int p = 0; p < 64; ++p) { const float cr_ = ccr[ho * 64 + p], ci_ = cci[ho * 64 + p], lr_ = lpr[j * 64 + p], li_ = lpi[j * 64 + p];
            const float mr = cr_ * lr_ - ci_ * li_, mi = cr_ * li_ + ci_ * lr_;
            sacc += mr * bbr[p * 16 + hi] - mi * bbi[p * 16 + hi]; }
        Kj[i] = sacc;
    }
    __syncthreads();
    for (int i = part * 1024 + tid; i < (part + 1) * 1024; i += 512) {
        const int n = i >> 7, k = i & 127;
        { const int t = n >> 4, ho = n & 15, sx = k >> 4, hi = k & 15; float v = (sx <= t) ? Kj[((t - sx) * 16 + ho) * 16 + hi] : 0.f;
          if (sx == t && ho == hi) v += ((const float*)a.in[14])[g * 16 + ho];
          T8T[frag16(n, k, 128)] = (bf16)f2bf(v); }
        { const int p = n & 63, im = n >> 6, sx = k >> 4, hi = k & 15; const float lr_ = lpr[(7 - sx) * 64 + p], li_ = lpi[(7 - sx) * 64 + p], br_ = bbr[p * 16 + hi], bi_ = bbi[p * 16 + hi];
          const float v = im ? (lr_ * bi_ + li_ * br_) : (lr_ * br_ - li_ * bi_); PMT[frag16(n, k, 128)] = (bf16)f2bf(v); }
        { const int t = n >> 4, ho = n & 15, p = k & 63, pt = k >> 6; const float cr_ = ccr[ho * 64 + p], ci_ = cci[ho * 64 + p], lr_ = lpr[(t + 1) * 64 + p], li_ = lpi[(t + 1) * 64 + p];
          const float v = pt ? -(cr_ * li_ + ci_ * lr_) : (cr_ * lr_ - ci_ * li_); QMT[frag16(n, k, 128)] = (bf16)f2bf(v); }
    }
    __syncthreads();
}

__device__ __forceinline__ void p0_prologue(const Ctx& C, const Args& a) {
    p0_w_i8(C, a, (const float*)a.in[4], 5632, 0, 176, a.ws + WS_WIN8, (float*)(a.ws + WS_CSW), NZ1);
    p0_w_i8(C, a, (const float*)a.in[6], 512, 176, 16, a.ws + WS_WMKV_T, (float*)(a.ws + WS_CSW) + 5632, 1 << 30);
    p0_s5_group(C, a, C.vcu & 15, C.vcu >> 4);
    LAS float* scr = (LAS float*)(C.lds + C.wave * 16384);
    const int gw = C.vcu * NWAVES + C.wave, NGW = C.G * NWAVES;
    const int gt = C.vcu * 512 + C.tid, NGT = C.G * 512;
    unsigned char* ws = a.ws;
    for (int i = gt; i < MTOK; i += NGT) ((float*)(ws + WS_SS))[i] = 0.f;
    constexpr int I_Q = 16 * 64, I_O = 16 * 32, I_BR = 8 * 32, I_BS = 4 * 32, I_BM = 4 * 32, I_GLU = 4 * 16;
    constexpr int NITEMS = I_Q + I_O + I_BR + I_BS + I_BM + I_GLU;
    for (int it = gw; it < NITEMS; it += NGW) {
        int r = it;
        if (r < I_Q) { p0_transpose_item<false>((const float*)a.in[21], 1024, 2048, (bf16*)(ws + WS_WQ_T), scr, r, C.lane, (const float*)a.in[20]); continue; } r -= I_Q;
        if (r < I_O) { p0_transpose_item<false>((const float*)a.in[19], 1024, 1024, (bf16*)(ws + WS_WOUT_T), scr, r, C.lane); continue; } r -= I_O;
        if (r < I_BR) { p0_transpose_item<false>((const float*)a.in[16], 512, 1024, (bf16*)(ws + WS_WCAT_T), scr, r, C.lane, nullptr, 1024, 0); continue; } r -= I_BR;
        if (r < I_BS) { p0_transpose_item<false>((const float*)a.in[17], 256, 1024, (bf16*)(ws + WS_WCAT_T), scr, r, C.lane, nullptr, 1024, 512); continue; } r -= I_BS;
        if (r < I_BM) { p0_transpose_item<false>((const float*)a.in[18], 256, 1024, (bf16*)(ws + WS_WCAT_T), scr, r, C.lane, nullptr, 1024, 768); continue; } r -= I_BM;
        p0_transpose_item<true>((const float*)a.in[15], 256, 512, (bf16*)(ws + WS_WGLU_T), scr, r, C.lane);
    }
    for (int i = gt; i < 16 * 128 * 128 / 8; i += NGT) { const f32x4 x0 = ((const f32x4*)a.in[22])[2 * (size_t)i], x1 = ((const f32x4*)a.in[22])[2 * (size_t)i + 1];
        const int hc = i >> 11, n = (i >> 4) & 127, d0 = (i & 15) * 8; *(v4u*)((bf16*)(ws + WS_KEYS) + hc * 16384 + frag32(n, d0, 128)) = pack8(x0, x1); }
    for (int rw0 = gw; rw0 < 2 * 16384; rw0 += 4 * NGW) {
        const int t = rw0 >> 14;
        f32x4 v[4][4]; float mx[4];
#pragma unroll
        for (int i = 0; i < 4; ++i) { const int row = (rw0 + i * NGW) & 16383;
            const float* src = (const float*)a.in[23 + t] + (size_t)row * DM + C.lane * 4; mx[i] = 0.f;
#pragma unroll
            for (int q = 0; q < 4; ++q) { v[i][q] = __builtin_nontemporal_load((const f32x4*)(src + 256 * q)); if (t == 0) v[i][q] = v[i][q] * *(const f32x4*)((const float*)a.in[20] + C.lane * 4 + 256 * q); } }
#pragma unroll
        for (int i = 0; i < 4; ++i)
#pragma unroll
            for (int q = 0; q < 4; ++q) mx[i] += (v[i][q][0] * v[i][q][0] + v[i][q][1] * v[i][q][1]) + (v[i][q][2] * v[i][q][2] + v[i][q][3] * v[i][q][3]);
#pragma unroll
        for (int o = 1; o < 64; o <<= 1)
#pragma unroll
            for (int i = 0; i < 4; ++i) mx[i] += __shfl_xor(mx[i], o);
#pragma unroll
        for (int i = 0; i < 4; ++i) { const int row = (rw0 + i * NGW) & 16383;
            const float rms = sqrtf(mx[i] * (1.f / DM)); const bool tiny = rms < 1e-30f;
            const float sc = tiny ? 1.f : 2.05f / rms, isc = tiny ? 1.f : rms * (1.f / 2.05f);
            unsigned char* dst = ws + (t ? WS_PV : WS_PU) + (size_t)row * 128 + 2 * C.lane;
#pragma unroll
            for (int q = 0; q < 4; ++q) { unsigned w = __builtin_amdgcn_cvt_scalef32_pk_fp4_f32(0u, v[i][q][0] * sc, v[i][q][1] * sc, 1.0f, 0); w = __builtin_amdgcn_cvt_scalef32_pk_fp4_f32(w, v[i][q][2] * sc, v[i][q][3] * sc, 1.0f, 1);
                *(unsigned short*)(dst + (size_t)q * (16384 * 128)) = (unsigned short)w; }
            if (C.lane == 0) ((float*)(ws + WS_PSC))[row * 2 + t] = isc; }
    }
    for (int m = gw; m < MTOK; m += 4 * NGW) rms_rows_to_i8<4, false>((const float*)a.in[0], (const float*)a.in[3], nullptr, ws + WS_XN8, (float*)(ws + WS_RSX), m, NGW, C.lane);
    for (int m = gw; m < MROWS; m += NGW) rms_rows_to_i8<1, false>((const float*)a.in[1], (const float*)a.in[5], nullptr, ws + WS_MEMN, (float*)(ws + WS_RSM), m, NGW, C.lane);
    if (gt < 64) ((double*)(ws + WS_ROPE))[gt] = exp(-(double)gt * (9.210340371976184 / 64.0)) * 0.15915494309189535;
}

constexpr int LP = 136;
__device__ __forceinline__ float lg2_gamma(int h) { return log2f(1.0f - exp2f(-5.0f - (float)h)); }

struct R1In { v4u q[4], k[4]; };
__device__ __forceinline__ void r1_load(const bf16* zr, int h, int dq, int eq, R1In& R) {
    const bf16* sq = zr + ZQ + h * 128; const bf16* sk = zr + ZK + h * 128;
    R.q[0] = NTL((const v4u*)(sq + dq)); R.q[1] = NTL((const v4u*)(sq + dq + 8)); R.q[2] = NTL((const v4u*)(sq + 64 + dq)); R.q[3] = NTL((const v4u*)(sq + 64 + dq + 8));
    R.k[0] = NTL((const v4u*)(sk + dq)); R.k[1] = NTL((const v4u*)(sk + dq + 8)); R.k[2] = NTL((const v4u*)(sk + 64 + dq)); R.k[3] = NTL((const v4u*)(sk + 64 + dq + 8));
}
__device__ __forceinline__ void r1_unit(const Ctx& C, const Args& a, int tile, int h, const float (&cs)[16], const float (&sn)[16], const R1In& R, R1In& Rn, bool hasnext) {
    const bf16* Z1 = (const bf16*)(a.ws + WS_Z1);
    LAS bf16* Qs = (LAS bf16*)C.lds; LAS bf16* Ks = Qs + 128 * LP; LAS bf16* Kt = Ks + 128 * LP; LAS bf16* Vt = Kt + 128 * LP;
    const int tid = C.tid, lane = C.lane, t0 = tile * 128, u = tile * 4 + h;
    const float lg2g = lg2_gamma(h);
    const int i = tid >> 2, dq = (tid & 3) * 16, eq = (tid & 3) * 32;
    {
        v4u vraw[4];
#pragma unroll
        for (int q = 0; q < 4; ++q) vraw[q] = *(const v4u*)(Z1 + (size_t)(t0 + i) * NZ1 + ZV + h * 128 + eq + 8 * q);
        const float kdec = __builtin_amdgcn_exp2f((float)(127 - i) * lg2g) , ksc = 0.08838834764831845f;
#pragma unroll
        for (int which = 0; which < 2; ++which) {
            const v4u a0 = which ? R.k[0] : R.q[0], a1 = which ? R.k[1] : R.q[1], b0 = which ? R.k[2] : R.q[2], b1 = which ? R.k[3] : R.q[3];
            const unsigned aw[8] = {a0.x, a0.y, a0.z, a0.w, a1.x, a1.y, a1.z, a1.w}, bw[8] = {b0.x, b0.y, b0.z, b0.w, b1.x, b1.y, b1.z, b1.w};
            float y1[16], y2[16];
#pragma unroll
            for (int w = 0; w < 8; ++w) {
                const float x1l = bflo(aw[w]), x1h = bfhi(aw[w]), x2l = bflo(bw[w]), x2h = bfhi(bw[w]);
                y1[2 * w] = x1l * cs[2 * w] - x2l * sn[2 * w]; y2[2 * w] = x1l * sn[2 * w] + x2l * cs[2 * w];
                y1[2 * w + 1] = x1h * cs[2 * w + 1] - x2h * sn[2 * w + 1]; y2[2 * w + 1] = x1h * sn[2 * w + 1] + x2h * cs[2 * w + 1];
            }
            if (which) {
#pragma unroll
                for (int e = 0; e < 16; ++e) { y1[e] *= ksc; y2[e] *= ksc; }
            }
            LAS bf16* dstp = (which ? Ks : Qs) + i * LP;
            v4u o;
            o.x = pk2(y1[0], y1[1]); o.y = pk2(y1[2], y1[3]); o.z = pk2(y1[4], y1[5]); o.w = pk2(y1[6], y1[7]); *(LAS v4u*)(dstp + dq) = o;
            o.x = pk2(y1[8], y1[9]); o.y = pk2(y1[10], y1[11]); o.z = pk2(y1[12], y1[13]); o.w = pk2(y1[14], y1[15]); *(LAS v4u*)(dstp + dq + 8) = o;
            o.x = pk2(y2[0], y2[1]); o.y = pk2(y2[2], y2[3]); o.z = pk2(y2[4], y2[5]); o.w = pk2(y2[6], y2[7]); *(LAS v4u*)(dstp + 64 + dq) = o;
            o.x = pk2(y2[8], y2[9]); o.y = pk2(y2[10], y2[11]); o.z = pk2(y2[12], y2[13]); o.w = pk2(y2[14], y2[15]); *(LAS v4u*)(dstp + 64 + dq + 8) = o;
            if (which) {
#pragma unroll
                for (int e = 0; e < 16; ++e) { Kt[(dq + e) * LP + i] = (bf16)f2bf(y1[e] * kdec); Kt[(64 + dq + e) * LP + i] = (bf16)f2bf(y2[e] * kdec); }
            }
            __builtin_amdgcn_sched_barrier(0);
        }
        {
#pragma unroll
            for (int q = 0; q < 4; ++q) { const v4u v = vraw[q]; const unsigned vw[4] = {v.x, v.y, v.z, v.w};
#pragma unroll
                for (int w = 0; w < 4; ++w) { Vt[(eq + 8 * q + 2 * w) * LP + i] = (bf16)(vw[w] & 0xffffu); Vt[(eq + 8 * q + 2 * w + 1) * LP + i] = (bf16)(vw[w] >> 16); } }
        }
    }
    __syncthreads();
    if (hasnext) r1_load(Z1 + (size_t)(t0 + i) * NZ1, h + 1, dq, eq, Rn);
    __builtin_amdgcn_sched_barrier(0);
    const int r = lane & 31, hh = lane >> 5;
    if (C.wave < 4) {
        const int ib = C.wave;
        { bf16* qf = (bf16*)(a.ws + WS_QRF) + ((size_t)(u * 4 + ib) * 8 * 64 + lane) * 8;
#pragma unroll
          for (int ks = 0; ks < 8; ++ks) *(bf16x8*)(qf + ks * 512) = *(const LAS bf16x8*)(Qs + (ib * 32 + r) * LP + ks * 16 + 8 * hh); }
        __builtin_amdgcn_sched_barrier(0);
        f32x16 accO[4];
#pragma unroll
        for (int et = 0; et < 4; ++et)
#pragma unroll
            for (int e = 0; e < 16; ++e) accO[et][e] = 0.f;
        int i = ib * 32 + r; asm volatile("" : "+v"(i));
#pragma unroll
        for (int jt = 0; jt < 4; ++jt) {
            if (jt <= ib) {
                f32x16 s;
#pragma unroll
                for (int e = 0; e < 16; ++e) s[e] = 0.f;
#pragma unroll
                for (int ks = 0; ks < 8; ++ks) { const bf16x8 ak = *(const LAS bf16x8*)(Ks + (jt * 32 + r) * LP + ks * 16 + 8 * hh), bqk = *(const LAS bf16x8*)(Qs + (ib * 32 + r) * LP + ks * 16 + 8 * hh); s = mfma32(ak, bqk, s); }
                unsigned pk[8];
#pragma unroll
                for (int q = 0; q < 8; ++q) {
                    const int ra = 2 * q, rb = 2 * q + 1;
                    const int ja = jt * 32 + (ra & 3) + 8 * (ra >> 2) + 4 * hh, jb = jt * 32 + (rb & 3) + 8 * (rb >> 2) + 4 * hh;
                    const float va = (i >= ja) ? s[ra] * __builtin_amdgcn_exp2f((float)(i - ja) * lg2g) : 0.f;
                    const float vb = (i >= jb) ? s[rb] * __builtin_amdgcn_exp2f((float)(i - jb) * lg2g) : 0.f;
                    pk[q] = pk2(va, vb);
                }
#pragma unroll
                for (int sft = 0; sft < 2; ++sft) {
                    const bf16x8 pb = mk8(pk[4 * sft], pk[4 * sft + 1], pk[4 * sft + 2], pk[4 * sft + 3]);
#pragma unroll
                    for (int et = 0; et < 4; ++et) {
                        const LAS bf16* vp = Vt + (et * 32 + r) * LP + jt * 32 + 16 * sft + 4 * hh;
                        const v2u lo = *(const LAS v2u*)vp, hi = *(const LAS v2u*)(vp + 8);
                        accO[et] = mfma32(mk8(lo.x, lo.y, hi.x, hi.y), pb, accO[et]);
                    }
                }
            }
            __builtin_amdgcn_sched_barrier(0);
        }
        unsigned* INN = (unsigned*)(a.ws + WS_INNER) + ((size_t)(u * 4 + ib) * 32) * 64 + lane;
#pragma unroll
        for (int et = 0; et < 4; ++et)
#pragma unroll
            for (int q = 0; q < 8; ++q) INN[(et * 8 + q) * 64] = pk2(accO[et][2 * q], accO[et][2 * q + 1]);
    } else {
        const int et = C.wave - 4;
        f32x16 acc[4];
#pragma unroll
        for (int dt = 0; dt < 4; ++dt)
#pragma unroll
            for (int e = 0; e < 16; ++e) acc[dt][e] = 0.f;
#pragma unroll
        for (int ks = 0; ks < 8; ++ks) {
            const bf16x8 av = *(const LAS bf16x8*)(Vt + (et * 32 + r) * LP + ks * 16 + 8 * hh);
#pragma unroll
            for (int dt = 0; dt < 4; ++dt) { const bf16x8 bk = *(const LAS bf16x8*)(Kt + (dt * 32 + r) * LP + ks * 16 + 8 * hh); acc[dt] = mfma32(av, bk, acc[dt]); }
            __builtin_amdgcn_sched_barrier(0);
        }
        bf16* KVb = (bf16*)a.out + (size_t)u * 16384 + ((size_t)((et * 8 + (r >> 4)) * 64 + ((r >> 3) & 1) * 32 + 4 * hh)) * 8 + (r & 7);
#pragma unroll
        for (int dt = 0; dt < 4; ++dt) {
#pragma unroll
            for (int e = 0; e < 16; e += 2) { const unsigned w = pk2(acc[dt][e], acc[dt][e + 1]);
                KVb[(2 * dt * 64 + (e & 3) + 8 * (e >> 2)) * 8] = (bf16)(w & 0xffffu); KVb[(2 * dt * 64 + ((e + 1) & 3) + 8 * (e >> 2)) * 8] = (bf16)(w >> 16); }
            __builtin_amdgcn_sched_barrier(0);
        }
    }
    __syncthreads();
}

__device__ __forceinline__ void s5_compute_E(const Args& a, int tile, int g, int lane, LAS float* Es, bf16x8 (&au)[4]) {
    const bf16* Z1 = (const bf16*)(a.ws + WS_Z1); const bf16* PMT = (const bf16*)(a.ws + WS_S5MAT) + (size_t)(16 + g) * 16384;
    const int r16 = lane & 15, q4 = lane >> 4;
#pragma unroll
    for (int ks = 0; ks < 4; ++ks) { const int s = 2 * ks + (q4 >> 1);
        au[ks] = *(const bf16x8*)(Z1 + (size_t)(tile * 128 + 8 * r16 + s) * NZ1 + ZU + g * 16 + 8 * (q4 & 1)); }
#pragma unroll
    for (int hb = 0; hb < 2; ++hb) {
        bf16x8 bc[4][4];
#pragma unroll
        for (int n4 = 0; n4 < 4; ++n4)
#pragma unroll
            for (int ks = 0; ks < 4; ++ks) bc[n4][ks] = *(const bf16x8*)(PMT + (((hb * 4 + n4) * 4 + ks) * 64 + lane) * 8);
        __builtin_amdgcn_sched_barrier(0);
#pragma unroll
        for (int n4 = 0; n4 < 4; ++n4) {
            f32x4 acc = {0.f, 0.f, 0.f, 0.f};
#pragma unroll
            for (int ks = 0; ks < 4; ++ks) acc = mfma16(au[ks], bc[n4][ks], acc);
#pragma unroll
            for (int i4 = 0; i4 < 4; ++i4) Es[(q4 * 4 + i4) * 128 + (hb * 4 + n4) * 16 + r16] = acc[i4];
        }
        __builtin_amdgcn_sched_barrier(0);
    }
    LDS_WAIT(); asm volatile("" ::: "memory");
}
__device__ __forceinline__ void s5a_wave(const Ctx& C, const Args& a, int tile, int g) {
    LAS float* Es = (LAS float*)(C.lds + C.wave * 16384);
    bf16x8 au[4];
    s5_compute_E(a, tile, g, C.lane, Es, au);
    const float* L8 = (const float*)(a.ws + WS_S5C) + (size_t)g * 128;
    const float l8r = L8[C.lane * 2], l8i = L8[C.lane * 2 + 1];
    float sr = 0.f, si = 0.f;
#pragma unroll
    for (int c = 0; c < 16; ++c) { const float er = Es[c * 128 + C.lane], ei = Es[c * 128 + 64 + C.lane];
        const float nr = l8r * sr - l8i * si + er, ni = l8r * si + l8i * sr + ei; sr = nr; si = ni; }
    float* E = (float*)(a.ws + WS_S5E) + ((size_t)tile * 16 + g) * 128;
    E[C.lane] = sr; E[64 + C.lane] = si;
    LDS_WAIT(); asm volatile("" ::: "memory");
}
__device__ __forceinline__ void s5c_wave(const Ctx& C, const Args& a, int tile, int g) {
    LAS float* Es = (LAS float*)(C.lds + C.wave * 16384);
    LAS bf16* Sv = (LAS bf16*)(C.lds + C.wave * 16384 + 8192);
    const int lane = C.lane, r16 = lane & 15, q4 = lane >> 4;
    bf16x8 au[4];
    s5_compute_E(a, tile, g, lane, Es, au);
    const float* L8 = (const float*)(a.ws + WS_S5C) + (size_t)g * 128;
    const float l8r = L8[lane * 2], l8i = L8[lane * 2 + 1];
    const float* X = (const float*)(a.ws + WS_S5X) + ((size_t)tile * 16 + g) * 128;
    float sr = X[lane], si = X[64 + lane];
#pragma unroll
    for (int c = 0; c < 16; ++c) {
        Sv[c * LP + lane] = (bf16)f2bf(sr); Sv[c * LP + 64 + lane] = (bf16)f2bf(si);
        const float er = Es[c * 128 + lane], ei = Es[c * 128 + 64 + lane];
        const float nr = l8r * sr - l8i * si + er, ni = l8r * si + l8i * sr + ei; sr = nr; si = ni; }
    LDS_WAIT(); asm volatile("" ::: "memory");
    bf16x8 as[4];
#pragma unroll
    for (int ks = 0; ks < 4; ++ks) as[ks] = *(const LAS bf16x8*)(Sv + r16 * LP + ks * 32 + 8 * q4);
    const bf16* T8T = (const bf16*)(a.ws + WS_S5MAT) + (size_t)g * 16384; const bf16* QMT = (const bf16*)(a.ws + WS_S5MAT) + (size_t)(32 + g) * 16384;
    const bf16* Z1 = (const bf16*)(a.ws + WS_Z1); bf16* YG = (bf16*)(a.ws + WS_YG);
#pragma unroll
    for (int hb = 0; hb < 4; ++hb) {
        bf16x8 tc[2][4], qc[2][4];
#pragma unroll
        for (int n2 = 0; n2 < 2; ++n2)
#pragma unroll
            for (int ks = 0; ks < 4; ++ks) { tc[n2][ks] = *(const bf16x8*)(T8T + (((hb * 2 + n2) * 4 + ks) * 64 + lane) * 8); qc[n2][ks] = *(const bf16x8*)(QMT + (((hb * 2 + n2) * 4 + ks) * 64 + lane) * 8); }
        __builtin_amdgcn_sched_barrier(0);
#pragma unroll
        for (int n2 = 0; n2 < 2; ++n2) {
            f32x4 acc = {0.f, 0.f, 0.f, 0.f};
#pragma unroll
            for (int ks = 0; ks < 4; ++ks) { acc = mfma16(au[ks], tc[n2][ks], acc); acc = mfma16(as[ks], qc[n2][ks], acc); }
#pragma unroll
            for (int i4 = 0; i4 < 4; ++i4) { const int nb = hb * 2 + n2, tok = tile * 128 + 8 * (q4 * 4 + i4) + nb;
                YG[(size_t)tok * 256 + g * 16 + r16] = (bf16)f2bf(gelu_tanh(acc[i4])); }
        }
        __builtin_amdgcn_sched_barrier(0);
    }
    LDS_WAIT(); asm volatile("" ::: "memory");
}

template <int NKB, int AUX = 0>
__device__ __forceinline__ void stage4_dma(LAS unsigned char* dst, const unsigned char* src, int w4, int lane) {
#pragma unroll
    for (int p = 0; p < NKB / 4; ++p) { const int piece = w4 + 4 * p;
        __builtin_amdgcn_global_load_lds((const unsigned*)(src + (size_t)piece * 1024 + lane * 16), (LAS unsigned*)(dst + piece * 1024), 16, 0, AUX); }
}
__device__ __forceinline__ void ma_loadk_l(const LAS unsigned char* kl, int mt, bf16x8 (&k)[4]) {
#pragma unroll
    for (int ks = 0; ks < 4; ++ks) k[ks] = *(const LAS bf16x8*)(kl + (mt * 4 + ks) * 1024);
}
__device__ __forceinline__ void ma_loadv_l(const LAS unsigned char* vl, int mt, bf16x8 (&v)[4]) {
#pragma unroll
    for (int sft = 0; sft < 2; ++sft)
#pragma unroll
        for (int et = 0; et < 2; ++et) v[sft * 2 + et] = *(const LAS bf16x8*)(vl + ((et * 8 + mt) * 2 + sft) * 1024);
}
__device__ __forceinline__ void ma_loadk(const bf16* kp, int mt, bf16x8 (&k)[4]) {
#pragma unroll
    for (int ks = 0; ks < 4; ++ks) k[ks] = *(const bf16x8*)(kp + (mt * 4 + ks) * 512);
}
__device__ __forceinline__ void ma_loadv(const bf16* vp, int mt, bf16x8 (&v)[4]) {
#pragma unroll
    for (int sft = 0; sft < 2; ++sft)
#pragma unroll
        for (int et = 0; et < 2; ++et) v[sft * 2 + et] = *(const bf16x8*)(vp + (((et * 8 + mt) * 2 + sft) * 64) * 8);
}
__device__ __forceinline__ void ma_wave(const Ctx& C, const Args& a, int tile, int hm, int ib, const LAS unsigned char* gl) {
    const bf16* Z1 = (const bf16*)(a.ws + WS_Z1);
    const int lane = C.lane, r = lane & 31, hh = lane >> 5, tok = tile * 128 + ib * 32 + r;
    const LAS unsigned char* kp = gl + lane * 16; const LAS unsigned char* vp = gl + 32768 + lane * 16;
    bf16x8 bq[4];
#pragma unroll
    for (int ks = 0; ks < 4; ++ks) bq[ks] = *(const bf16x8*)(Z1 + (size_t)tok * NZ1 + ZQM + hm * 64 + ks * 16 + 8 * hh);
    bf16x8 kc[4], kn[4];
    ma_loadk_l(kp, 0, kc);
    float mx = -3.0e38f;
#pragma unroll 1
    for (int mt = 0; mt < 8; ++mt) {
        ma_loadk_l(kp, min(mt + 1, 7), kn); __builtin_amdgcn_sched_barrier(0);
        f32x16 s;
#pragma unroll
        for (int e = 0; e < 16; ++e) s[e] = 0.f;
#pragma unroll
        for (int ks = 0; ks < 4; ++ks) s = mfma32(kc[ks], bq[ks], s);
#pragma unroll
        for (int e = 0; e < 16; ++e) mx = fmaxf(mx, s[e]);
        __builtin_amdgcn_sched_barrier(0);
#pragma unroll
        for (int ks = 0; ks < 4; ++ks) kc[ks] = kn[ks];
    }
    mx = fmaxf(mx, __shfl_xor(mx, 32));
    float sum = 0.f;
    f32x16 o[2];
#pragma unroll
    for (int et = 0; et < 2; ++et)
#pragma unroll
        for (int e = 0; e < 16; ++e) o[et][e] = 0.f;
    const float sc = 0.125f * 1.4426950408889634f;
    bf16x8 vc[4], vn[4];
    ma_loadk_l(kp, 0, kc); ma_loadv_l(vp, 0, vc);
#pragma unroll 1
    for (int mt = 0; mt < 8; ++mt) {
        ma_loadk_l(kp, min(mt + 1, 7), kn); ma_loadv_l(vp, min(mt + 1, 7), vn); __builtin_amdgcn_sched_barrier(0);
        f32x16 s;
#pragma unroll
        for (int e = 0; e < 16; ++e) s[e] = 0.f;
#pragma unroll
        for (int ks = 0; ks < 4; ++ks) s = mfma32(kc[ks], bq[ks], s);
        unsigned pk[8];
#pragma unroll
        for (int q = 0; q < 8; ++q) { const float pa = __builtin_amdgcn_exp2f((s[2 * q] - mx) * sc), pb = __builtin_amdgcn_exp2f((s[2 * q + 1] - mx) * sc); sum += pa + pb; pk[q] = pk2(pa, pb); }
#pragma unroll
        for (int sft = 0; sft < 2; ++sft) {
            const bf16x8 pb = mk8(pk[4 * sft], pk[4 * sft + 1], pk[4 * sft + 2], pk[4 * sft + 3]);
#pragma unroll
            for (int et = 0; et < 2; ++et) o[et] = mfma32(vc[sft * 2 + et], pb, o[et]);
        }
        __builtin_amdgcn_sched_barrier(0);
#pragma unroll
        for (int ks = 0; ks < 4; ++ks) kc[ks] = kn[ks];
#pragma unroll
        for (int q = 0; q < 4; ++q) vc[q] = vn[q];
    }
    sum += __shfl_xor(sum, 32);
    const float inv = 1.0f / sum;
    bf16* MA = (bf16*)(a.ws + WS_YCAT) + (size_t)tok * 1024 + 768 + hm * 64;
#pragma unroll
    for (int et = 0; et < 2; ++et)
#pragma unroll
        for (int g4 = 0; g4 < 4; ++g4) { v2u w; w.x = pk2(o[et][4 * g4] * inv, o[et][4 * g4 + 1] * inv); w.y = pk2(o[et][4 * g4 + 2] * inv, o[et][4 * g4 + 3] * inv);
            *(v2u*)(MA + et * 32 + 8 * g4 + 4 * hh) = w; }
}

struct R3Q { bf16x8 bq[8]; };
struct R3E { unsigned innw[32]; v2u gwv[16]; };
__device__ __forceinline__ void r3_loadq(const Args& a, int tile, int h, int ib, int lane, R3Q& I) {
    asm volatile("" : "+v"(lane));
    const int u = tile * 4 + h;
    const bf16* qf = (const bf16*)(a.ws + WS_QRF) + ((size_t)(u * 4 + ib) * 8 * 64 + lane) * 8;
#pragma unroll
    for (int ks = 0; ks < 8; ++ks) I.bq[ks] = NTL((const bf16x8*)(qf + ks * 512));
}
__device__ __forceinline__ void r3_loade(const Args& a, int tile, int h, int ib, int lane, R3E& I) {
    asm volatile("" : "+v"(lane));
    const bf16* Z1 = (const bf16*)(a.ws + WS_Z1);
    const int r = lane & 31, hh = lane >> 5, u = tile * 4 + h, tok = tile * 128 + ib * 32 + r;
    const unsigned* INN = (const unsigned*)(a.ws + WS_INNER) + ((size_t)(u * 4 + ib) * 32) * 64 + lane;
#pragma unroll
    for (int q = 0; q < 32; ++q) I.innw[q] = NTL(INN + q * 64);
    const bf16* gp = Z1 + (size_t)tok * NZ1 + ZGR + h * 128;
#pragma unroll
    for (int q = 0; q < 16; ++q) I.gwv[q] = *(const v2u*)(gp + (q >> 2) * 32 + 8 * (q & 3) + 4 * hh);
}
__device__ __forceinline__ void r3_mfma(const LAS unsigned char* gl, int lane, const bf16x8 (&bq)[8], f32x16 (&acc)[4]) {
    const LAS unsigned char* pbase = gl + lane * 16;
#pragma unroll
    for (int et = 0; et < 4; ++et) {
        bf16x8 ap[8];
#pragma unroll
        for (int ks = 0; ks < 8; ++ks) ap[ks] = *(const LAS bf16x8*)(pbase + (et * 8 + ks) * 1024);
#pragma unroll
        for (int e = 0; e < 16; ++e) acc[et][e] = 0.f;
#pragma unroll
        for (int ks = 0; ks < 8; ++ks) acc[et] = mfma32(ap[ks], bq[ks], acc[et]);
    }
}
__device__ __forceinline__ void r3_finish(const Args& a, int tile, int h, int ib, int lane, const R3E& I, f32x16 (&acc)[4]) {
    asm volatile("" : "+v"(lane));
    const int r = lane & 31, hh = lane >> 5, tok = tile * 128 + ib * 32 + r;
    const float lg2g = lg2_gamma(h);
    const float qdec = __builtin_amdgcn_exp2f((float)(ib * 32 + r + 1) * lg2g);
    float ss = 0.f;
#pragma unroll
    for (int et = 0; et < 4; ++et)
#pragma unroll
        for (int q = 0; q < 8; ++q) { const unsigned w = I.innw[et * 8 + q];
            const float v0 = acc[et][2 * q] * qdec + bflo(w), v1 = acc[et][2 * q + 1] * qdec + bfhi(w);
            acc[et][2 * q] = v0; acc[et][2 * q + 1] = v1; ss += v0 * v0 + v1 * v1; }
    ss += __shfl_xor(ss, 32);
    const float rn = __builtin_amdgcn_rsqf(ss * (1.0f / 128.0f) + EPS);
    bf16* RET = (bf16*)(a.ws + WS_YCAT) + (size_t)tok * 1024 + h * 128;
#pragma unroll
    for (int et = 0; et < 4; ++et)
#pragma unroll
        for (int g4 = 0; g4 < 4; ++g4) { const int e0 = et * 32 + 8 * g4 + 4 * hh; const v2u gw = I.gwv[et * 4 + g4];
            const float g0 = bflo(gw.x), g1 = bfhi(gw.x), g2 = bflo(gw.y), g3 = bfhi(gw.y);
            v2u w; w.x = pk2(acc[et][4 * g4] * rn * g0 * sigmoidf_(g0), acc[et][4 * g4 + 1] * rn * g1 * sigmoidf_(g1));
            w.y = pk2(acc[et][4 * g4 + 2] * rn * g2 * sigmoidf_(g2), acc[et][4 * g4 + 3] * rn * g3 * sigmoidf_(g3));
            *(v2u*)(RET + e0) = w; }
}

__device__ __forceinline__ void p3_scans(const Ctx& C, const Args& a) {
    constexpr int NSKIP = 16;
    if ((int)blockIdx.x < NSKIP) return;
    {
        const bf16* KV = (const bf16*)a.out; bf16* PREV = (bf16*)((unsigned char*)a.out + 64 * MiB);
        const int nbk = C.G - NSKIP, bk = (int)blockIdx.x - NSKIP, per = 131072 / nbk, rem = 131072 % nbk, ibase = bk * per + min(bk, rem), icnt = per + (bk < rem ? 1 : 0);
        for (int k = C.tid; k < icnt; k += 512) { const int it = ibase + k;
            const int elem = it * 4, b = elem >> 16, h = (elem >> 14) & 3, ed = elem & 16383;
            const float cd = __builtin_amdgcn_exp2f(128.0f * lg2_gamma(h));
            const bf16* kp = KV + (size_t)(b * 128 + h) * 16384 + ed; bf16* pp = PREV + (size_t)(b * 128 + h) * 16384 + ed;
            v2u inc[32];
#pragma unroll
            for (int c = 0; c < 32; ++c) inc[c] = NTL((const v2u*)(kp + (size_t)c * 65536));
            f32x4 st = {0.f, 0.f, 0.f, 0.f};
#pragma unroll
            for (int c = 0; c < 32; ++c) { v2u w; w.x = pk2(st[0], st[1]); w.y = pk2(st[2], st[3]); *(v2u*)(pp + (size_t)c * 65536) = w; st = st * cd + (f32x4){bflo(inc[c].x), bfhi(inc[c].x), bflo(inc[c].y), bfhi(inc[c].y)}; }
        }
    }
    {
        const float* E = (const float*)(a.ws + WS_S5E); float* X = (float*)(a.ws + WS_S5X); const float* L128 = (const float*)(a.ws + WS_S5C) + 2048;
        const int nbk = C.G - NSKIP, bk = (int)blockIdx.x - NSKIP, per = 8192 / nbk, rem = 8192 % nbk, ibase = bk * per + min(bk, rem), icnt = per + (bk < rem ? 1 : 0);
        for (int k = C.tid - 64; k >= 0 && k < icnt; k += 512) { const int it = ibase + k;
            const int b = it >> 10, g = (it >> 6) & 15, p = it & 63;
            const float lr = L128[(g * 64 + p) * 2], li = L128[(g * 64 + p) * 2 + 1];
            const float* ep = E + ((size_t)(b * 32) * 16 + g) * 128 + p; float* xp = X + ((size_t)(b * 32) * 16 + g) * 128 + p;
            float er[32], ei[32];
#pragma unroll
            for (int n = 0; n < 32; ++n) { er[n] = NTL(ep + (size_t)n * 2048); ei[n] = NTL(ep + (size_t)n * 2048 + 64); }
            float xr = 0.f, xi = 0.f;
#pragma unroll
            for (int n = 0; n < 32; ++n) { xp[(size_t)n * 2048] = xr; xp[(size_t)n * 2048 + 64] = xi;
                const float nr = lr * xr - li * xi + er[n], ni = lr * xi + li * xr + ei[n]; xr = nr; xi = ni; }
        }
    }
}

__device__ __forceinline__ int f2key(float x) { int b = __builtin_bit_cast(int, x); return b >= 0 ? b : (b ^ 0x7fffffff); }
__device__ __forceinline__ float key2f(int k) { return __builtin_bit_cast(float, k >= 0 ? k : (k ^ 0x7fffffff)); }
__device__ __forceinline__ int fmaxk(int x, int y) { int r; asm("v_max_f32 %0, %1, %2" : "=v"(r) : "v"(x), "v"(y)); return r; }
__device__ __forceinline__ int fmink(int x, int y) { int r; asm("v_min_f32 %0, %1, %2" : "=v"(r) : "v"(x), "v"(y)); return r; }
__device__ __forceinline__ float kf(int k) { return __builtin_bit_cast(float, k); }
__device__ __forceinline__ int fk(float f) { return __builtin_bit_cast(int, f); }
__device__ __forceinline__ void ce_desc(int& x, int& y) { const int hi = fmaxk(x, y), lo = fmink(x, y); x = hi; y = lo; }
__device__ __forceinline__ void sort16_desc(int (&v)[16]) {
    constexpr int NET[63][2] = {{0,1},{2,3},{0,2},{1,3},{1,2},{4,5},{6,7},{4,6},{5,7},{5,6},{0,4},{2,6},{2,4},{1,5},{3,7},{3,5},{1,2},{3,4},{5,6},{8,9},{10,11},{8,10},{9,11},{9,10},{12,13},{14,15},{12,14},{13,15},{13,14},{8,12},{10,14},{10,12},{9,13},{11,15},{11,13},{9,10},{11,12},{13,14},{0,8},{4,12},{4,8},{2,10},{6,14},{6,10},{2,4},{6,8},{10,12},{1,9},{5,13},{5,9},{3,11},{7,15},{7,11},{3,5},{7,9},{11,13},{1,2},{3,4},{5,6},{7,8},{9,10},{11,12},{13,14}};
#pragma unroll
    for (int k = 0; k < 63; ++k) ce_desc(v[NET[k][0]], v[NET[k][1]]);
}
__device__ __forceinline__ void bmerge16_desc(int (&v)[16]) {
#pragma unroll
    for (int j = 8; j > 0; j >>= 1)
#pragma unroll
        for (int i = 0; i < 16; ++i) { const int l = i ^ j; if (l > i) ce_desc(v[i], v[l]); }
}
__device__ __forceinline__ void merge16_desc(int (&T)[16], const int (&N)[16]) {
#pragma unroll
    for (int i = 0; i < 16; ++i) T[i] = fmaxk(T[i], N[15 - i]);
    bmerge16_desc(T);
}
__device__ __forceinline__ void sort8_desc(int (&v)[8]) {
    constexpr int NET[19][2] = {{0,1},{2,3},{0,2},{1,3},{1,2},{4,5},{6,7},{4,6},{5,7},{5,6},{0,4},{2,6},{2,4},{1,5},{3,7},{3,5},{1,2},{3,4},{5,6}};
#pragma unroll
    for (int k = 0; k < 19; ++k) ce_desc(v[NET[k][0]], v[NET[k][1]]);
}
__device__ __forceinline__ void peer_topk_half(const Args& a, int tokbase, int hp, int c, int lane, int (&T)[16]) {
    const bf16* Q2 = (const bf16*)(a.ws + WS_Q2); const bf16* KEYS = (const bf16*)(a.ws + WS_KEYS);
    const int r = lane & 31, hh = lane >> 5;
    bf16x8 bq[8];
#pragma unroll
    for (int ks = 0; ks < 8; ++ks) bq[ks] = *(const bf16x8*)(Q2 + ((((size_t)(tokbase >> 5) * 16 + hp * 2 + c) * 8 + ks) * 64 + lane) * 8);
    const bf16* kbase = KEYS + (size_t)(hp * 2 + c) * 16384 + lane * 8;
    bf16x8 akc[8], akn[8];
#pragma unroll
    for (int ks = 0; ks < 8; ++ks) akc[ks] = *(const bf16x8*)(kbase + ks * 512);
#pragma unroll
    for (int nt = 0; nt < 4; ++nt) {
        if (nt < 3) {
#pragma unroll
            for (int ks = 0; ks < 8; ++ks) akn[ks] = *(const bf16x8*)(kbase + ((nt + 1) * 8 + ks) * 512);
        }
        __builtin_amdgcn_sched_barrier(0);
        f32x16 s;
#pragma unroll
        for (int e = 0; e < 16; ++e) s[e] = 0.f;
#pragma unroll
        for (int ks = 0; ks < 8; ++ks) s = mfma32(akc[ks], bq[ks], s);
        int N[16];
#pragma unroll
        for (int e = 0; e < 16; ++e) { const int n = nt * 32 + (e & 3) + 8 * (e >> 2) + 4 * hh; const float se = s[e]; N[e] = (fk(se) & ~127) | n; }
        sort16_desc(N);
        if (nt == 0) {
#pragma unroll
            for (int e = 0; e < 16; ++e) T[e] = N[e];
        } else merge16_desc(T, N);
        __builtin_amdgcn_sched_barrier(0);
#pragma unroll
        for (int ks = 0; ks < 8; ++ks) akc[ks] = akn[ks];
    }
    int P[16];
#pragma unroll
    for (int j = 0; j < 16; ++j) P[j] = __shfl_xor(T[j], 32);
    merge16_desc(T, P);
}
__device__ __forceinline__ void peer_topk_head(const Ctx& C, const Args& a, int tokbase, int hp) {
    const int lane = C.lane, r = lane & 31, hh = lane >> 5;
    int T0[16], T1[16];
    peer_topk_half(a, tokbase, hp, 0, lane, T0);
    peer_topk_half(a, tokbase, hp, 1, lane, T1);
    float a0[16], a1[16];
#pragma unroll
    for (int j = 0; j < 16; ++j) { a0[j] = kf(T0[j] & ~127); a1[j] = kf(T1[j] & ~127); }
#define PK_CAND(i0, i1) ((fk(a0[i0] + a1[i1]) & ~255) | ((i0) * 16 + (i1)))
    constexpr int KMIN = (int)0xff800000;
    int F[16], N[16];
#pragma unroll
    for (int j = 0; j < 16; ++j) F[j] = PK_CAND(0, j);
#pragma unroll
    for (int j = 0; j < 15; ++j) N[j] = PK_CAND(j + 1, 0);
    N[15] = KMIN;
    merge16_desc(F, N);
#pragma unroll
    for (int j = 0; j < 7; ++j) N[j] = PK_CAND(1, j + 1);
    N[7] = KMIN; N[8] = KMIN; N[9] = KMIN;
#pragma unroll
    for (int j = 0; j < 6; ++j) N[10 + j] = PK_CAND(7 - j, 1);
    bmerge16_desc(N); merge16_desc(F, N);
    {   int L[8] = {PK_CAND(2, 2), PK_CAND(3, 2), PK_CAND(4, 2), PK_CAND(2, 3), PK_CAND(3, 3), PK_CAND(2, 4), KMIN, KMIN};
        sort8_desc(L);
#pragma unroll
        for (int j = 0; j < 8; ++j) { N[j] = L[j]; N[8 + j] = KMIN; }
        merge16_desc(F, N); }
#undef PK_CAND
    LAS unsigned char* tab = C.lds + 131072 + C.wave * 1024;
    if (hh == 0) {
#pragma unroll
        for (int j = 0; j < 16; ++j) { tab[j * 32 + r] = (unsigned char)(T0[j] & 127); tab[(16 + j) * 32 + r] = (unsigned char)(T1[j] & 127); } }
    LDS_WAIT(); asm volatile("" ::: "memory");
    const float m = kf(F[0] & ~255);
    float e[16], sum = 0.f;
#pragma unroll
    for (int j = 0; j < 16; ++j) { e[j] = __builtin_amdgcn_exp2f((kf(F[j] & ~255) - m) * 1.4426950408889634f); sum += e[j]; }
    const float inv = 1.0f / sum;
    const int tok = tokbase + r;
    int* IDX = (int*)(a.ws + WS_IDX) + (size_t)tok * 128 + hp * 16; float* WGT = (float*)(a.ws + WS_WGT) + (size_t)tok * 128 + hp * 16;
    unsigned ov[16];
#pragma unroll
    for (int j = 0; j < 16; ++j) { const int id = F[j] & 255; const int k0 = tab[(id >> 4) * 32 + r], k1 = tab[(16 + (id & 15)) * 32 + r];
        ov[j] = (hh == 0) ? (unsigned)(k0 * 128 + k1) : __builtin_bit_cast(unsigned, e[j] * inv); }
    unsigned* obase = (hh == 0) ? (unsigned*)IDX : (unsigned*)WGT;
#pragma unroll
    for (int q = 0; q < 4; ++q) { v4u w = {ov[4 * q], ov[4 * q + 1], ov[4 * q + 2], ov[4 * q + 3]}; *(v4u*)(obase + 4 * q) = w; }
    LDS_WAIT(); asm volatile("" ::: "memory");
}
__device__ __forceinline__ void TopkOrder::done(const pg8::Unit& u) const {
    asm volatile("s_waitcnt vmcnt(0)" ::: "memory");
    __builtin_amdgcn_s_barrier();
    peer_topk_head(*C, *a, u.pm * 256 + C->wave * 32, u.pn);
}
typedef float f32x2v __attribute__((ext_vector_type(2)));
__device__ __forceinline__ void unpack16(const v4u a, const v4u b, float (&x)[16]) {
    const unsigned w[8] = {a.x, a.y, a.z, a.w, b.x, b.y, b.z, b.w};
#pragma unroll
    for (int i = 0; i < 8; ++i) { x[2 * i] = bflo(w[i]); x[2 * i + 1] = bfhi(w[i]); }
}
__device__ __forceinline__ void unpack16_fp8(const v4u a, float (&x)[16]) {
    const unsigned w[4] = {a.x, a.y, a.z, a.w};
#pragma unroll
    for (int i = 0; i < 4; ++i) { const f32x2v lo = __builtin_amdgcn_cvt_pk_f32_fp8((int)w[i], false), hi = __builtin_amdgcn_cvt_pk_f32_fp8((int)w[i], true);
        x[4 * i] = lo.x; x[4 * i + 1] = lo.y; x[4 * i + 2] = hi.x; x[4 * i + 3] = hi.y; }
}
__device__ __forceinline__ long mk64(unsigned lo, unsigned hi) { return (long)(((unsigned long long)hi << 32) | (unsigned long long)lo); }
__device__ __forceinline__ float dpp_swap1(float v) { return __builtin_bit_cast(float, __builtin_amdgcn_update_dpp(0, __builtin_bit_cast(int, v), 0xB1, 0xf, 0xf, true)); }
struct PHalf { v4u g[8]; };
struct PIdx { int e[8]; };
__device__ __forceinline__ void pg_idx8(const int* IDXr, int h, int hl, PIdx& I) {
    h = min(h, hl); const int* p = IDXr + (size_t)(h >> 1) * 128 + (h & 1) * 64;
#pragma unroll
    for (int j = 0; j < 8; ++j) I.e[j] = p[j * 8];
}
__device__ __forceinline__ void pg_issue(const unsigned char* TBL, const PIdx& I, int lane, PHalf& D) {
    const unsigned c16 = (unsigned)(lane & 7) * 16u;
#pragma unroll
    for (int j = 0; j < 8; ++j) D.g[j] = *(const v4u*)(TBL + ((unsigned)I.e[j] * 128u + c16));
}
__device__ __forceinline__ void pg_stage(LAS unsigned char* buf, int lane, const PHalf& D) {
    const int row8 = lane >> 3, c8 = lane & 7;
#pragma unroll
    for (int j = 0; j < 8; ++j) *(LAS v4u*)(buf + (j * 8 + row8) * 128 + ((c8 ^ row8) & 7) * 16) = D.g[j];
}
__device__ __forceinline__ void pg_stage_v(LAS unsigned char* buf, int lane, const PHalf& D) {
    const int row8 = lane >> 3, cx = (lane & 7) ^ ((row8 & 3) << 1);
#pragma unroll
    for (int j = 0; j < 8; ++j) { const v4u g = D.g[j]; const v4u w = ((j >> 1) & 1) ? (v4u){g.z, g.w, g.x, g.y} : g;
        *(LAS v4u*)(buf + (row8 * 8 + j) * 128 + ((cx ^ (j >> 2)) & 7) * 16) = w; }
}
__device__ __forceinline__ void pg_idx8_u(const int* IDXq, int h, int hl, PIdx& I) {
    h = min(h, hl); const int4* p = (const int4*)(IDXq + (size_t)(h >> 1) * 128 + (h & 1) * 64);
    const int4 a = p[0], b = p[1];
    I.e[0] = a.x; I.e[1] = a.y; I.e[2] = a.z; I.e[3] = a.w; I.e[4] = b.x; I.e[5] = b.y; I.e[6] = b.z; I.e[7] = b.w;
}
__device__ __forceinline__ void pg_stage_u(LAS unsigned char* buf, int lane, const PHalf& D) {
    const int row8 = lane >> 3, c8 = lane & 7;
#pragma unroll
    for (int j = 0; j < 8; ++j) *(LAS v4u*)(buf + (row8 * 8 + j) * 128 + ((c8 ^ j) & 7) * 16) = D.g[j];
}
__device__ __forceinline__ void e2m1_qv(float y, unsigned& code, float& val) {
    const float m = fminf(fabsf(y), 6.0f);
    const unsigned rb = (__builtin_bit_cast(unsigned, m) + 0x00200000u) & 0xFFC00000u;
    const float sm = 0.5f * rintf(2.0f * m);
    const bool big = m >= 1.0f;
    const float v = big ? __builtin_bit_cast(float, rb) : sm;
    const unsigned c = big ? (rb >> 22) - 252u : (unsigned)(2.0f * sm);
    const unsigned sg = __builtin_bit_cast(unsigned, y) & 0x80000000u;
    code = c | (sg >> 28); val = __builtin_bit_cast(float, __builtin_bit_cast(unsigned, v) | sg);
}
__device__ __forceinline__ void fp4_planes4(float x0, float x1, float x2, float x3, unsigned& hi, unsigned& lo) {
    unsigned h = __builtin_amdgcn_cvt_scalef32_pk_fp4_f32(0u, x0, x1, 1.0f, 0); h = __builtin_amdgcn_cvt_scalef32_pk_fp4_f32(h, x2, x3, 1.0f, 1);
    const f32x2v d01 = __builtin_amdgcn_cvt_scalef32_pk_f32_fp4(h, 1.0f, 0), d23 = __builtin_amdgcn_cvt_scalef32_pk_f32_fp4(h, 1.0f, 1);
    unsigned l = __builtin_amdgcn_cvt_scalef32_pk_fp4_f32(0u, (x0 - d01.x) * 4.0f, (x1 - d01.y) * 4.0f, 1.0f, 0); l = __builtin_amdgcn_cvt_scalef32_pk_fp4_f32(l, (x2 - d23.x) * 4.0f, (x3 - d23.y) * 4.0f, 1.0f, 1);
    hi = h & 0xffffu; lo = l & 0xffffu;
}
__device__ __forceinline__ void pu_xprep(LAS unsigned char* xs, v2u xw, float sx, int lane) {
    const float x[4] = {bflo(xw.x) * sx, bfhi(xw.x) * sx, bflo(xw.y) * sx, bfhi(xw.y) * sx};
    unsigned hi, lo; fp4_planes4(x[0], x[1], x[2], x[3], hi, lo);
    *(LAS unsigned short*)(xs + 2 * lane) = (unsigned short)hi; *(LAS unsigned short*)(xs + 128 + 2 * lane) = (unsigned short)lo;
}
typedef int v8i_t __attribute__((ext_vector_type(8)));
__device__ __forceinline__ void pu_compute(const LAS unsigned char* buf, bf16* HPt, int r, int kq, const v4u (&bfr)[2]) {
    f32x4 res[4];
    const int sclB = (r & 1) ? 0x7d7d7d7d : 0x7f7f7f7f;
    const v8i_t bv0 = {(int)bfr[0].x, (int)bfr[0].y, (int)bfr[0].z, (int)bfr[0].w, 0, 0, 0, 0}, bv1 = {(int)bfr[1].x, (int)bfr[1].y, (int)bfr[1].z, (int)bfr[1].w, 0, 0, 0, 0};
#pragma unroll
    for (int g = 0; g < 4; ++g) {
        const int row = g * 16 + r, sw = row & 7;
        const v4u a0 = *(const LAS v4u*)(buf + row * 128 + (kq ^ sw) * 16), a1 = *(const LAS v4u*)(buf + row * 128 + ((4 + kq) ^ sw) * 16);
        const v8i_t av0 = {(int)a0.x, (int)a0.y, (int)a0.z, (int)a0.w, 0, 0, 0, 0}, av1 = {(int)a1.x, (int)a1.y, (int)a1.z, (int)a1.w, 0, 0, 0, 0};
        res[g] = __builtin_amdgcn_mfma_scale_f32_16x16x128_f8f6f4(av0, bv0, (f32x4){0.f, 0.f, 0.f, 0.f}, 4  , 4  , 0, 0x7f7f7f7f, 0, sclB);
        res[g] = __builtin_amdgcn_mfma_scale_f32_16x16x128_f8f6f4(av1, bv1, res[g], 4, 4, 0, 0x7f7f7f7f, 0, sclB);
    }
    f32x4 o = res[0];
#pragma unroll
    for (int g = 1; g < 4; ++g) { const bool sel = ((r >> 1) == g);
#pragma unroll
        for (int i = 0; i < 4; ++i) o[i] = sel ? res[g][i] : o[i]; }
#pragma unroll
    for (int i = 0; i < 4; ++i) o[i] += dpp_swap1(o[i]);
    if (r < 8 && (r & 1) == 0) { v2u w; w.x = pk2(o[0], o[1]); w.y = pk2(o[2], o[3]); *(v2u*)(HPt + (r >> 1) * 16 + 4 * kq) = w; }
}
__device__ __forceinline__ int pg_idx(const int* IDXl, int h, int hl) { h = min(h, hl); return IDXl[(size_t)(h >> 1) * 128 + (h & 1) * 64]; }
__device__ __forceinline__ void peer_u_wave(const Args& a, LAS unsigned char* wlds, LAS unsigned char* wsm, int slab, int t0, int ntok, int lane) {
    const unsigned char* U8 = a.ws + WS_PU + (size_t)slab * (16384 * 128);
    const bf16* N2 = (const bf16*)(a.ws + WS_N2) + slab * 256 + 4 * lane;
    const int* IDX = (const int*)(a.ws + WS_IDX) + 8 * (lane >> 3);
    bf16* HP = (bf16*)(a.ws + WS_HPART) + (size_t)slab * MTOK * 128;
    const int r = lane & 15, kq = lane >> 4, tl = t0 + ntok - 1, H0 = 2 * t0, HL = 2 * (t0 + ntok) - 1;
    PHalf d[4]; PIdx iv[4]; v4u bfr[2];
    const float* SSp = (const float*)(a.ws + WS_SS); float ssx = SSp[t0];
#pragma unroll
    for (int k = 0; k < 4; ++k) pg_idx8_u(IDX, H0 + k, HL, iv[k]);
    v2u xw = *(const v2u*)(N2 + (size_t)t0 * DM);
    pg_issue(U8, iv[0], lane, d[0]); pg_issue(U8, iv[1], lane, d[1]); pg_issue(U8, iv[2], lane, d[2]);
    pg_idx8_u(IDX, H0 + 4, HL, iv[0]); pg_idx8_u(IDX, H0 + 5, HL, iv[1]); pg_idx8_u(IDX, H0 + 6, HL, iv[2]);
    pg_stage_u(wlds, lane, d[0]);
#define PU_XPREP(tok) do { pu_xprep(wsm, xw, 2.05f * __builtin_amdgcn_rsqf(ssx * (1.f / DM) + EPS), lane); \
        { const LAS unsigned char* bp = wsm + ((r & 1) ? 128 : 0) + kq * 16; bfr[0] = *(const LAS v4u*)bp; bfr[1] = *(const LAS v4u*)(bp + 64); } \
        xw = *(const v2u*)(N2 + (size_t)min((tok) + 1, tl) * DM); ssx = SSp[min((tok) + 1, tl)]; } while (0)
#define PU_PHASE(ph, hrel, tok, half) do { \
        pg_issue(U8, iv[((ph) + 3) & 3], lane, d[((ph) + 3) & 3]); pg_idx8_u(IDX, hb + (hrel) + 7, HL, iv[((ph) + 3) & 3]); \
        pu_compute(wlds + ((half) ? 8192 : 0), HP + (size_t)(tok) * 128 + (half) * 64, r, kq, bfr); \
        pg_stage_u(wlds + ((half) ? 0 : 8192), lane, d[((ph) + 1) & 3]); } while (0)
#pragma unroll 1
    for (int hb = H0; hb <= HL; hb += 4) {
        const int t = hb >> 1;
        PU_XPREP(t);
        PU_PHASE(0, 0, t, 0);
        PU_PHASE(1, 1, t, 1);
        PU_XPREP(t + 1);
        PU_PHASE(2, 2, t + 1, 0);
        PU_PHASE(3, 3, t + 1, 1);
    }
#undef PU_XPREP
#undef PU_PHASE
}
__device__ __forceinline__ void peer_reduce(const Ctx& C, const Args& a) {
    const bf16* HP = (const bf16*)(a.ws + WS_HPART); const int* IDX = (const int*)(a.ws + WS_IDX); const float* WGT = (const float*)(a.ws + WS_WGT);
    const f32x2v* SC2 = (const f32x2v*)(a.ws + WS_PSC);
    unsigned char* ACT8 = a.ws + WS_ACT; float* ASC = (float*)(a.ws + WS_ACT + 8 * MiB);
    for (int it = C.vcu * 512 + C.tid; it < MTOK * 32; it += C.G * 512) {
        f32x4 h = {0.f, 0.f, 0.f, 0.f};
#pragma unroll
        for (int sl = 0; sl < 4; ++sl) { const v2u w = NTL((const v2u*)(HP + (size_t)sl * MTOK * 128 + (size_t)it * 4)); h[0] += bflo(w.x); h[1] += bfhi(w.x); h[2] += bflo(w.y); h[3] += bfhi(w.y); }
        const int4 e = *(const int4*)(IDX + (size_t)it * 4); const f32x4 w = NTL((const f32x4*)(WGT + (size_t)it * 4));
        const int tok = it >> 5, q = it & 31;
        const float rs = 1.0f / 2.05f;
        f32x4 o;
        const f32x2v s0 = SC2[e.x], s1 = SC2[e.y], s2 = SC2[e.z], s3 = SC2[e.w];
        o[0] = gelu_tanh(h[0] * s0.x * rs) * w[0] * s0.y; o[1] = gelu_tanh(h[1] * s1.x * rs) * w[1] * s1.y;
        o[2] = gelu_tanh(h[2] * s2.x * rs) * w[2] * s2.y; o[3] = gelu_tanh(h[3] * s3.x * rs) * w[3] * s3.y;
        float mx = fmaxf(fmaxf(fabsf(o[0]), fabsf(o[1])), fmaxf(fabsf(o[2]), fabsf(o[3])));
#pragma unroll
        for (int sh = 1; sh < 32; sh <<= 1) mx = fmaxf(mx, __shfl_xor(mx, sh));
        const bool tiny = mx < 1e-30f;
        const float sc = tiny ? 1.f : 6.0f / mx, isc = tiny ? 1.f : mx * (1.0f / 6.0f);
        unsigned hi, lo; fp4_planes4(o[0] * sc, o[1] * sc, o[2] * sc, o[3] * sc, hi, lo);
        *(unsigned short*)(ACT8 + (size_t)tok * 128 + 2 * q) = (unsigned short)hi; *(unsigned short*)(ACT8 + (size_t)tok * 128 + 64 + 2 * q) = (unsigned short)lo;
        if (q == 0) ASC[tok] = isc;
    }
}
typedef int v2i_t __attribute__((ext_vector_type(2)));
__device__ __forceinline__ void pv_compute8(unsigned a0, unsigned a1, int nb0, const v4u bact, int sclB, f32x4 (&acc)[8]) {
    const v8i_t bv = {(int)bact.x, (int)bact.y, (int)bact.z, (int)bact.w, 0, 0, 0, 0};
    asm volatile("" : "+v"(a0), "+v"(a1));
#pragma unroll
    for (int nbi = 0; nbi < 8; ++nbi) {
        const unsigned x8 = (unsigned)(nb0 + nbi) * 8u;
        const v2i_t r0 = __builtin_amdgcn_ds_read_tr4_b64_v2i32((LAS v2i_t*)(a0 ^ x8)), r1 = __builtin_amdgcn_ds_read_tr4_b64_v2i32((LAS v2i_t*)(a1 ^ x8));
        const v8i_t av = {r0.x, r0.y, r1.x, r1.y, 0, 0, 0, 0};
        acc[nbi] = __builtin_amdgcn_mfma_scale_f32_16x16x128_f8f6f4(av, bv, (f32x4){0.f, 0.f, 0.f, 0.f}, 4, 4, 0, 0x7f7f7f7f, 0, sclB);
    }
}
__device__ __forceinline__ void peer_v_wave(const Args& a, LAS unsigned char* wlds, int slab, int t0, int ntok, int lane) {
    const unsigned char* V8 = a.ws + WS_PV + (size_t)slab * (16384 * 128);
    const int* IDX = (const int*)(a.ws + WS_IDX) + 8 * (lane >> 3);
    const int n16 = lane & 15, kq = lane >> 4, tl = t0 + ntok - 1, H0 = 2 * t0, HL = 2 * (t0 + ntok) - 1;
    const unsigned char* ACT4 = a.ws + WS_ACT + ((n16 & 1) ? 64 : 0) + 16 * kq; const float* ASC = (const float*)(a.ws + WS_ACT + 8 * MiB);
    const int sclB = (n16 & 1) ? 0x7d7d7d7d : 0x7f7f7f7f;
    const unsigned wl32 = (unsigned)(size_t)wlds;
    const int od_ = kq & 1;
    const unsigned ra0 = wl32 + (unsigned)((32 * kq + 16 * od_ + n16) * 128 + (((n16 >> 2) & 3) | (od_ << 2)) * 16 + 8 * ((n16 >> 1) & 1));
    const unsigned ra1 = wl32 + (unsigned)((32 * kq + 16 * (1 - od_) + n16) * 128 + (((n16 >> 2) & 3) | ((1 - od_) << 2)) * 16 + 8 * ((n16 >> 1) & 1));
    bf16* PO = (bf16*)(a.ws + WS_POUT) + slab * 256;
    PHalf d[4]; PIdx iv[4]; v4u bact, bnxt; f32x4 acc[8]; float isc = 1.f, iscn;
#pragma unroll
    for (int k = 0; k < 4; ++k) pg_idx8_u(IDX, H0 + k, HL, iv[k]);
    const int o0 = 8 * (kq & 1), o1 = 8 - o0;
    { const v2u b0 = *(const v2u*)(ACT4 + (size_t)t0 * 128 + o0), b1 = *(const v2u*)(ACT4 + (size_t)t0 * 128 + o1); bnxt = (v4u){b0.x, b0.y, b1.x, b1.y}; } iscn = ASC[t0];
    pg_issue(V8, iv[0], lane, d[0]); pg_issue(V8, iv[1], lane, d[1]); pg_issue(V8, iv[2], lane, d[2]); pg_issue(V8, iv[3], lane, d[3]);
#pragma unroll
    for (int k = 0; k < 4; ++k) pg_idx8_u(IDX, H0 + 4 + k, HL, iv[k]);
    pg_stage_v(wlds, lane, d[0]); pg_stage_v(wlds + 8192, lane, d[1]);
#define PV_EPI(tok, cb) do { f32x4 o = acc[0]; \
        _Pragma("unroll") for (int nb = 1; nb < 8; ++nb) { const bool sel = ((n16 >> 1) == nb); \
            _Pragma("unroll") for (int i = 0; i < 4; ++i) o[i] = sel ? acc[nb][i] : o[i]; } \
        _Pragma("unroll") for (int i = 0; i < 4; ++i) o[i] += dpp_swap1(o[i]); \
        if ((n16 & 1) == 0) { v2u w; w.x = pk2(o[0] * isc, o[1] * isc); w.y = pk2(o[2] * isc, o[3] * isc); *(v2u*)(PO + (size_t)(tok) * DM + (cb) + 16 * (n16 >> 1) + 4 * kq) = w; } } while (0)
#define PV_TOKEN(tok) do { bact = bnxt; isc = iscn; \
        { const int tn = min((tok) + 1, tl); const v2u b0 = *(const v2u*)(ACT4 + (size_t)tn * 128 + o0), b1 = *(const v2u*)(ACT4 + (size_t)tn * 128 + o1); bnxt = (v4u){b0.x, b0.y, b1.x, b1.y}; iscn = ASC[tn]; } \
        pv_compute8(ra0, ra1, 0, bact, sclB, acc); PV_EPI(tok, 0); \
        pv_compute8(ra0, ra1, 8, bact, sclB, acc); PV_EPI(tok, 128); } while (0)
#pragma unroll 1
    for (int t = t0; t <= tl; t += 2) {
        const int hb = 2 * t;
        pg_issue(V8, iv[0], lane, d[0]); pg_issue(V8, iv[1], lane, d[1]);
        pg_idx8_u(IDX, hb + 8, HL, iv[0]); pg_idx8_u(IDX, hb + 9, HL, iv[1]);
        PV_TOKEN(t);
        pg_stage_v(wlds, lane, d[2]); pg_stage_v(wlds + 8192, lane, d[3]);
        pg_issue(V8, iv[2], lane, d[2]); pg_issue(V8, iv[3], lane, d[3]);
        pg_idx8_u(IDX, hb + 10, HL, iv[2]); pg_idx8_u(IDX, hb + 11, HL, iv[3]);
        PV_TOKEN(t + 1);
        pg_stage_v(wlds, lane, d[0]); pg_stage_v(wlds + 8192, lane, d[1]);
    }
#undef PV_EPI
#undef PV_TOKEN
}
__device__ __forceinline__ void final_rows4(const Args& a, int tok0, int tstep, int lane) {
    const float* gf = (const float*)a.in[25] + lane * 4;
    f32x4 h[4][4]; v2u pw[4][4], hw[4][4]; float ss[4];
#pragma unroll
    for (int i = 0; i < 4; ++i) { const int tok = tok0 + i * tstep; const bf16* hb = (const bf16*)(a.ws + WS_N2) + (size_t)tok * DM + lane * 4; const bf16* po = (const bf16*)(a.ws + WS_POUT) + (size_t)tok * DM + lane * 4;
#pragma unroll
        for (int q = 0; q < 4; ++q) { hw[i][q] = __builtin_nontemporal_load((const v2u*)(hb + 256 * q)); pw[i][q] = __builtin_nontemporal_load((const v2u*)(po + 256 * q)); } }
#pragma unroll
    for (int i = 0; i < 4; ++i) { ss[i] = 0.f;
#pragma unroll
        for (int q = 0; q < 4; ++q) { h[i][q][0] = bflo(hw[i][q].x) + bflo(pw[i][q].x); h[i][q][1] = bfhi(hw[i][q].x) + bfhi(pw[i][q].x); h[i][q][2] = bflo(hw[i][q].y) + bflo(pw[i][q].y); h[i][q][3] = bfhi(hw[i][q].y) + bfhi(pw[i][q].y);
            ss[i] += (h[i][q][0] * h[i][q][0] + h[i][q][1] * h[i][q][1]) + (h[i][q][2] * h[i][q][2] + h[i][q][3] * h[i][q][3]); } }
#pragma unroll
    for (int o = 1; o < 64; o <<= 1)
#pragma unroll
        for (int i = 0; i < 4; ++i) ss[i] += __shfl_xor(ss[i], o);
    f32x4 g[4];
#pragma unroll
    for (int q = 0; q < 4; ++q) g[q] = *(const f32x4*)(gf + 256 * q);
#pragma unroll
    for (int i = 0; i < 4; ++i) { const float rstd = 1.0f / sqrtf(ss[i] * (1.f / DM) + EPS); float* orow = a.out + (size_t)(tok0 + i * tstep) * DM + lane * 4;
#pragma unroll
        for (int q = 0; q < 4; ++q) __builtin_nontemporal_store(h[i][q] * rstd * g[q], (f32x4*)(orow + 256 * q)); }
}

__device__ __forceinline__ void claim_slab_unit(const Ctx& C, unsigned* ctl, int pass, volatile LAS unsigned* MISC, int& slab, int& unit) {
    if (C.tid == 0) {
        const unsigned ns = 4u, nu = 64u;
        const unsigned x = xb_xcc_id() & (ns - 1u); unsigned sl = 8u, un = 0u;
        for (unsigned k = 0; k < ns; ++k) { const unsigned s2 = (x + k) & (ns - 1u); const unsigned u2 = xb_add(ctl + CW_Q + 1024 * pass + 64 * s2, 1u); if (u2 < nu) { sl = s2; un = u2; break; } }
        MISC[16] = sl; MISC[17] = un;
    }
    __syncthreads();
    slab = (int)MISC[16]; unit = (int)MISC[17];
    __syncthreads();
}
__global__ void __launch_bounds__(NWAVES * 64, 2) mk_fwd(Args args) {
    extern __shared__ __attribute__((aligned(16))) unsigned char lds_raw[];
    Ctx C;
    C.lds = (LAS unsigned char*)lds_raw;
    C.wave = __builtin_amdgcn_readfirstlane((int)threadIdx.x >> 6); C.refresh();
    C.G = gridDim.x; { const int bx = blockIdx.x; C.vcu = (C.G % 8 == 0) ? (bx % 8) * (C.G / 8) + bx / 8 : bx; }
    volatile LAS unsigned* MISC = (volatile LAS unsigned*)(C.lds + MISC_OFF);
    if (C.tid < 128) MISC[C.tid] = 0u;
    __syncthreads();
    unsigned char* ws = args.ws;
    unsigned* ctl = (unsigned*)(ws + WS_CTL);
    XcdBarrier bar; bar.bar = ctl + CW_BAR; bar.x = 0; bar.st = nullptr;
#if !MK_PER_PHASE
    bar = xcd_barrier_post(ctl + CW_BAR, MISC + 8, C.tid == 0);
#define GRID_BAR() xcd_barrier(bar, C.wave)
#else
#define GRID_BAR() do { } while (0)
#endif
    const int lo = args.ph_lo, hi = args.ph_hi;
#define IN(k) (lo <= (k) && (k) < hi)
#define SEAM(k) do { if (IN((k) + 1)) GRID_BAR(); C.refresh(); } while (0)
#define REP(k) for (int rep_ = 0; rep_ < 1 + ((REPEAT_MASK >> (k)) & 1); ++rep_)
    const GatePlanes GP{ws + WS_A, ws + WS_A + 32 * MiB, (unsigned char*)args.out + 96 * MiB};
    bf16* MERGED = (bf16*)(ws + WS_B + 64 * MiB);
    if (IN(0)) { REP(0) { p0_prologue(C, args); __syncthreads(); } SEAM(0); }
    if (IN(1)) {
        REP(1) {
        run_gemm_i8(C, ws + WS_XN8, ws + WS_WIN8 + (size_t)NZ1 * DM, MTOK, NGATE, DM, FSigI8{GP, (const float*)(ws + WS_RSX), (const float*)(ws + WS_CSW) + NZ1});
        run_gemm_i8(C, ws + WS_XN8, ws + WS_WIN8, MTOK, NZ1, DM, FStoreI8{(bf16*)(ws + WS_Z1), NZ1, (const float*)(ws + WS_RSX), (const float*)(ws + WS_CSW)});
        }
        SEAM(1);
    }
    if (IN(2)) {
        REP(2) { const int tile = C.vcu;
            {
                const int i_ = C.tid >> 2, dq_ = (C.tid & 3) * 16, eq_ = (C.tid & 3) * 32;
                const bf16* zr_ = (const bf16*)(ws + WS_Z1) + (size_t)(tile * 128 + i_) * NZ1; const double* ir_ = (const double*)(ws + WS_ROPE) + dq_; const double p_ = (double)((const int*)args.in[2])[tile * 128 + i_];
                float cs_[16], sn_[16];
#pragma unroll
                for (int e = 0; e < 16; ++e) { double rv = p_ * ir_[e]; rv -= rint(rv);
                    const float rf = (float)rv; cs_[e] = __builtin_amdgcn_cosf(rf); sn_[e] = __builtin_amdgcn_sinf(rf); }
                R1In ra_, rb_;
                r1_load(zr_, 0, dq_, eq_, ra_);
                _Pragma("unroll 1") for (int h2 = 0; h2 < 4; h2 += 2) {
                    r1_unit(C, args, tile, h2, cs_, sn_, ra_, rb_, true);
                    r1_unit(C, args, tile, h2 + 1, cs_, sn_, rb_, ra_, h2 == 0);
                }
            }
            C.refresh();
            _Pragma("unroll 1") for (int gi = 0; gi < 2; ++gi) s5a_wave(C, args, tile, C.wave + 8 * gi);
            __syncthreads();
        }
        SEAM(2);
    }
    if (IN(3)) { REP(3) { p3_scans(C, args); }
        run_gemm_i8(C, ws + WS_MEMN, ws + WS_WMKV_T, MROWS, 512, DM, FKvmI8{FKvm{(bf16*)(ws + WS_KM), (bf16*)(ws + WS_VT)}, (const float*)(ws + WS_RSM), (const float*)(ws + WS_CSW) + 5632});
        SEAM(3); }
    if (IN(4)) {
        REP(4) { const int tile = C.vcu;
            const int grp = C.wave >> 2, w4 = C.wave & 3;
            LAS unsigned char* gl = C.lds + grp * 65536;
            {
                stage4_dma<32, 2>(gl, (const unsigned char*)args.out + 64 * MiB + (size_t)(tile * 4 + grp) * 32768, w4, C.lane);
                stage4_dma<32, 2>(gl + 32768, (const unsigned char*)args.out + 64 * MiB + (size_t)(tile * 4 + 2 + grp) * 32768, w4, C.lane);
                VM_WAIT(); __syncthreads();
                _Pragma("unroll 1") for (int gi = 0; gi < 2; ++gi) { R3Q qa; R3E ea; f32x16 acc[4];
                    r3_loadq(args, tile, 2 * gi + grp, w4, C.lane, qa); r3_loade(args, tile, 2 * gi + grp, w4, C.lane, ea);
                    __builtin_amdgcn_sched_barrier(0);
                    r3_mfma(gl + gi * 32768, C.lane, qa.bq, acc);
                    __builtin_amdgcn_sched_barrier(0);
                    r3_finish(args, tile, 2 * gi + grp, w4, C.lane, ea, acc); }
            }
            __syncthreads();
            _Pragma("unroll 1") for (int gi = 0; gi < 2; ++gi) s5c_wave(C, args, tile, C.wave + 8 * gi);
            _Pragma("unroll 1") for (int gi = 0; gi < 2; ++gi) { const int hm = 2 * gi + grp; const size_t blk = (size_t)((tile >> 5) * 4 + hm) * 32768;
                __syncthreads();
                stage4_dma<32>(gl, ws + WS_KM + blk, w4, C.lane); stage4_dma<32>(gl + 32768, ws + WS_VT + blk, w4, C.lane);
                VM_WAIT(); __syncthreads();
                ma_wave(C, args, tile, hm, w4, gl); }
        }
        SEAM(4);
    }
    if (IN(5)) {
        REP(5) {
        run_gemm(C, (const bf16*)(ws + WS_YG), (const bf16*)(ws + WS_WGLU_T), MTOK, 512, 256, FGlu{(bf16*)(ws + WS_YCAT)});
        }
        SEAM(5);
    }
    if (IN(6)) {
        run_gemm_hook(C, (const bf16*)(ws + WS_YCAT), (const bf16*)(ws + WS_WCAT_T), MTOK, DM, DM, FGateOut{GP.p2, MERGED}, HookGate{GP});
        SEAM(6);
    }
    if (IN(7)) { run_gemm(C, MERGED, (const bf16*)(ws + WS_WOUT_T), MTOK, DM, DM, FRes{(const float*)args.in[0], (bf16*)(ws + WS_N2), (float*)(ws + WS_SS)}); SEAM(7); }
    if (IN(9)) { run_gemm_topk(C, args, (const bf16*)(ws + WS_N2), (const bf16*)(ws + WS_WQ_T), MTOK, 2048, DM, FStoreRstd{(bf16*)(ws + WS_Q2), 2048, (const float*)(ws + WS_SS)}); SEAM(9); }
    if (IN(11)) { int slab, unit; claim_slab_unit(C, ctl, 0, MISC, slab, unit); if (slab < 8) { REP(11) peer_u_wave(args, C.lds + C.wave * 16384, C.lds + 131072 + C.wave * 1024, slab, unit * 512 + C.wave * 64, 64, C.lane); } SEAM(11); }
    if (IN(12)) { REP(12) peer_reduce(C, args); SEAM(12); }
    if (IN(13)) { int slab, unit; claim_slab_unit(C, ctl, 1, MISC, slab, unit); if (slab < 8) { REP(13) peer_v_wave(args, C.lds + C.wave * 16384, slab, unit * 512 + C.wave * 64, 64, C.lane); } SEAM(13); }
    if (IN(14)) {
        const int gw = C.vcu * NWAVES + C.wave, NGW = C.G * NWAVES;
        for (int m = gw; m < MTOK; m += 4 * NGW) final_rows4(args, m, NGW, C.lane);
    }
#undef IN
#undef SEAM
}

extern "C" void kernel_launch(void* const* d_in, const int* in_sizes, int n_in, void* d_out, int out_size, void* d_ws, size_t ws_size, hipStream_t stream) {
    static int grid = 0;
    if (grid == 0) {
        if (n_in != 26 || in_sizes[0] != MTOK * DM || out_size != MTOK * DM || ws_size < WS_END) {
            fprintf(stderr, "kernel_launch: unexpected problem (n_in %d, in0 %d, out %d, ws %zu < %zu); nothing launched\n", n_in, n_in > 0 ? in_sizes[0] : -1, out_size, ws_size, (size_t)WS_END); grid = -1; return; }
        int dev = 0, cus = 0;
        if (hipGetDevice(&dev) != hipSuccess || hipDeviceGetAttribute(&cus, hipDeviceAttributeMultiprocessorCount, dev) != hipSuccess) { grid = -1; return; }
        if (hipFuncSetAttribute((const void*)mk_fwd, hipFuncAttributeMaxDynamicSharedMemorySize, LDS_BYTES) != hipSuccess) { fprintf(stderr, "kernel_launch: hipFuncSetAttribute failed\n"); grid = -1; return; }
        (void)hipGetLastError();
        if (cus < NTILES) { fprintf(stderr, "kernel_launch: needs >= 256 CUs, got %d\n", cus); grid = -1; return; }
        grid = NTILES;
    }
    if (grid < 0) return;
    (void)hipMemsetAsync((char*)d_ws + WS_CTL, 0, CTL_ZERO_BYTES, stream);
    Args a{};
    for (int i = 0; i < 26; ++i) a.in[i] = d_in[i];
    a.out = (float*)d_out; a.ws = (unsigned char*)d_ws;
#if MK_PER_PHASE
    for (int p = 0; p < NPHASE; ++p) { a.ph_lo = p; a.ph_hi = p + 1; hipLaunchKernelGGL(mk_fwd, dim3(grid), dim3(NWAVES * 64), LDS_BYTES, stream, a); }
#else
    a.ph_lo = 0; a.ph_hi = NPHASE;
    hipLaunchKernelGGL(mk_fwd, dim3(grid), dim3(NWAVES * 64), LDS_BYTES, stream, a);
#endif
}
```
